# Optimizing an MI355X kernel written in HIP

```python
import jax, jax.numpy as jnp
from jax import lax
import numpy as np

D_MODEL = 1024
BATCH = 32
SEQ = 2048
DEPTH = 1

CTX_LEN = 256
GRID_W = 64

D_MIX = D_MODEL
DA = D_MIX // 2
NA = 64
HA = DA // NA
DECAY_LORA = 64
AAA_LORA = 64
GATE_LORA = 128
RWKV_COLS = 3 * DA + 2 * DECAY_LORA + 2 * AAA_LORA + GATE_LORA
RWKV_EPS = 64e-5

DB = D_MIX - DA
HB = 4
KB = DB // HB
GDN_CONV = 5
GDN_CHUNK = 64
GDN_COLS = 4 * DB + 4 * HB
IN_COLS = RWKV_COLS + GDN_COLS

N_EXPERTS = 256
TOP_K = 8
N_GROUPS = 8
TOPK_GROUPS = 4
D_EXPERT = 256
D_SHARED = 256
ROUTED_SCALE = 2.5
MOE_BLOCK = 256
NORM_EPS = 1e-6

kernel_name = 'hybrid_rwkv7_gdn_moe_dit_layer'


def rmsnorm(x, g):
    xf = x.astype(jnp.float32)
    y = xf * lax.rsqrt(jnp.mean(xf * xf, axis=-1, keepdims=True) + NORM_EPS)
    return (y * g.astype(jnp.float32)).astype(x.dtype)


def l2norm(x):
    xf = x.astype(jnp.float32)
    return xf * lax.rsqrt(jnp.sum(xf * xf, axis=-1, keepdims=True) + 1e-6)


def shift_seq(p):
    h = p.shape[-1] // 2
    prev = jnp.pad(p[:, :-1, :h], ((0, 0), (1, 0), (0, 0)))
    nxt = jnp.pad(p[:, 1:, h:], ((0, 0), (0, 1), (0, 0)))
    return jnp.concatenate([prev, nxt], axis=-1)


def shift_grid(p):
    B, T, C = p.shape
    rows = T // GRID_W
    q = C // 4
    g = p.reshape(B, rows, GRID_W, C)
    left = jnp.pad(g[:, :, :-1, :q], ((0, 0), (0, 0), (1, 0), (0, 0)))
    right = jnp.pad(g[:, :, 1:, q:2 * q], ((0, 0), (0, 0), (0, 1), (0, 0)))
    up = jnp.pad(g[:, :-1, :, 2 * q:3 * q], ((0, 0), (1, 0), (0, 0), (0, 0)))
    down = jnp.pad(g[:, 1:, :, 3 * q:], ((0, 0), (0, 1), (0, 0), (0, 0)))
    return jnp.concatenate([left, right, up, down], axis=-1).reshape(B, T, C)


def rwkv7_prepare(p, shifted, mu, w0, w_up, a0, a_up, g_up, k_k, k_a):
    p = (p + mu * (shifted - p)).astype(jnp.float32)
    p = jnp.swapaxes(p, 0, 1)
    T, B = p.shape[:2]
    cuts = [DA, 2 * DA, 3 * DA, 3 * DA + 2 * DECAY_LORA, 3 * DA + 2 * DECAY_LORA + 2 * AAA_LORA]
    r, k, v, wl, al, gl = jnp.split(p, cuts, axis=-1)
    wl = wl.reshape(T, B, 2, DECAY_LORA)
    al = al.reshape(T, B, 2, AAA_LORA)
    w_log = -jax.nn.softplus(-(w0 + jnp.einsum('tbdl,dlc->tbdc', jnp.tanh(wl), w_up))) - 0.5
    decay = jnp.exp(-jnp.exp(w_log))
    a = jax.nn.sigmoid(a0 + jnp.einsum('tbdl,dlc->tbdc', al, a_up))
    g = jax.nn.sigmoid(gl) @ g_up
    kk = l2norm((k * k_k).reshape(T, B, HA, NA))
    k_dir = k[:, :, None] * (1.0 + (a - 1.0) * k_a)
    b_dir = kk.reshape(T, B, 1, DA) * a
    heads = lambda t: t.reshape(t.shape[:-1] + (HA, NA))
    return heads(r), heads(v), kk, heads(decay), heads(k_dir), heads(b_dir), g


def wkv7_scan(r, decay, k, v, kk, b, s0, reverse):
    def step(S, inp):
        r_t, w_t, k_t, v_t, kk_t, b_t = inp
        sa = -jnp.einsum('bhvk,bhk->bhv', S, kk_t)
        S = S * w_t[:, :, None, :] + sa[..., None] * b_t[:, :, None, :] + v_t[..., None] * k_t[:, :, None, :]
        return S, jnp.einsum('bhvk,bhk->bhv', S, r_t)
    return lax.scan(step, s0, (r, decay, k, v, kk, b), reverse=reverse)


def rwkv7_mixer(p_ctx, p_lat, mu, w0, w_up, a0, a_up, g_up, k_k, k_a, r_k, lnx_w, lnx_b):
    args = (mu, w0, w_up, a0, a_up, g_up, k_k, k_a)
    ctx_t = rwkv7_prepare(p_ctx, shift_seq(p_ctx), *args)
    lat_t = rwkv7_prepare(p_lat, shift_grid(p_lat), *args)
    zero = jnp.zeros((p_lat.shape[0], HA, NA, NA), jnp.float32)

    def run(t, s_f, s_b):
        r, v, kk, decay, k_dir, b_dir, g = t
        T, B = r.shape[:2]
        s_f, y_f = wkv7_scan(r, decay[:, :, 0], k_dir[:, :, 0], v, kk, b_dir[:, :, 0], s_f, False)
        s_b, y_b = wkv7_scan(r, decay[:, :, 1], k_dir[:, :, 1], v, kk, b_dir[:, :, 1], s_b, True)
        y = y_f + y_b
        m = jnp.mean(y, axis=-1, keepdims=True)
        var = jnp.mean(jnp.square(y - m), axis=-1, keepdims=True)
        y = ((y - m) * lax.rsqrt(var + RWKV_EPS)).reshape(T, B, DA) * lnx_w + lnx_b
        bonus = jnp.sum(r[:, :, None] * k_dir * r_k, axis=(2, 4))
        y = (y + (bonus[..., None] * v).reshape(T, B, DA)) * g
        return jnp.swapaxes(y, 0, 1), s_f, s_b

    y_ctx, s_f, s_b = run(ctx_t, zero, zero)
    y_lat, _, _ = run(lat_t, s_f, s_b)
    return y_ctx, y_lat


def dwconv_centered(x, w):
    C = x.shape[-1]
    return lax.conv_general_dilated(
        x, w[:, None, :].astype(x.dtype), window_strides=(1,),
        padding=[(GDN_CONV // 2, GDN_CONV // 2)],
        dimension_numbers=('NWC', 'WIO', 'NWC'), feature_group_count=C)


def gdn_prepare(p, conv_w, A_log, dt_bias):
    B, T, _ = p.shape
    qkv = jax.nn.silu(dwconv_centered(p[..., :3 * DB], conv_w)).astype(jnp.float32)
    q, k, v = jnp.split(qkv, 3, axis=-1)
    q = l2norm(q.reshape(B, T, HB, KB)) * (KB ** -0.5)
    k = l2norm(k.reshape(B, T, HB, KB))
    v = v.reshape(B, T, HB, KB)
    z = p[..., 3 * DB:4 * DB]
    gl = p[..., 4 * DB:].astype(jnp.float32).reshape(B, T, 2, 2, HB)
    g = -jnp.exp(A_log) * jax.nn.softplus(gl[:, :, 0] + dt_bias)
    beta = jax.nn.sigmoid(gl[:, :, 1])
    return q, k, v, g, beta, z


def gdn_chunked(q, k, v, g, beta, s0):
    B, T, H, K = q.shape
    V = v.shape[-1]
    C = GDN_CHUNK
    n = T // C
    blk = lambda t: jnp.moveaxis(t.reshape((B, n, C, H) + t.shape[3:]), 3, 1)
    q, k, v, g, beta = (blk(t) for t in (q, k, v, g, beta))
    gc = jnp.cumsum(g, axis=-1)
    idx = jnp.arange(C)
    incl = idx[:, None] >= idx[None, :]
    strict = idx[:, None] > idx[None, :]
    decay = jnp.where(incl, jnp.exp(jnp.where(incl, gc[..., :, None] - gc[..., None, :], 0.0)), 0.0)
    kb = k * beta[..., None]
    a_low = jnp.where(strict, jnp.einsum('bhnik,bhnjk->bhnij', kb, k) * decay, 0.0)
    rhs = jnp.concatenate([v * beta[..., None], kb * jnp.exp(gc)[..., None]], axis=-1)
    sol = lax.linalg.triangular_solve(a_low + jnp.eye(C, dtype=jnp.float32), rhs,
                                      left_side=True, lower=True, unit_diagonal=True)
    u, w = sol[..., :V], sol[..., V:]
    attn = jnp.einsum('bhnik,bhnjk->bhnij', q, k) * decay
    qg = q * jnp.exp(gc)[..., None]
    kg = k * jnp.exp(gc[..., -1:] - gc)[..., None]
    g_last = jnp.exp(gc[..., -1])

    def step(S, inp):
        u_i, w_i, a_i, qg_i, kg_i, gl_i = inp
        v_new = u_i - jnp.einsum('bhck,bhkv->bhcv', w_i, S)
        o = jnp.einsum('bhck,bhkv->bhcv', qg_i, S) + jnp.einsum('bhcs,bhsv->bhcv', a_i, v_new)
        S = S * gl_i[..., None, None] + jnp.einsum('bhck,bhcv->bhkv', kg_i, v_new)
        return S, o

    xs = tuple(jnp.moveaxis(t, 2, 0) for t in (u, w, attn, qg, kg, g_last))
    S, o = lax.scan(step, s0, xs)
    o = jnp.transpose(o, (1, 0, 3, 2, 4)).reshape(B, T, H, V)
    return S, o


def gdn_mixer(p_ctx, p_lat, conv_w, A_log, dt_bias, onorm_g):
    ctx_t = gdn_prepare(p_ctx, conv_w, A_log, dt_bias)
    lat_t = gdn_prepare(p_lat, conv_w, A_log, dt_bias)
    zero = jnp.zeros((p_lat.shape[0], HB, KB, KB), jnp.float32)
    flip = lambda t: jnp.flip(t, axis=1)

    def run(t, s_f, s_b):
        q, k, v, g, beta, z = t
        B, T = q.shape[:2]
        s_f, o_f = gdn_chunked(q, k, v, g[:, :, 0], beta[:, :, 0], s_f)
        s_b, o_b = gdn_chunked(flip(q), flip(k), flip(v), flip(g[:, :, 1]), flip(beta[:, :, 1]), s_b)
        o = o_f + flip(o_b)
        o = o * lax.rsqrt(jnp.mean(o * o, axis=-1, keepdims=True) + NORM_EPS) * onorm_g
        return o.reshape(B, T, DB) * jax.nn.silu(z.astype(jnp.float32)), s_f, s_b

    y_ctx, s_f, s_b = run(ctx_t, zero, zero)
    y_lat, _, _ = run(lat_t, s_f, s_b)
    return y_ctx, y_lat


def moe_ffn(h, router_w, router_b, w1, w3, w2, sw1, sw3, sw2):
    B, T, D = h.shape
    N = B * T
    xs = h.reshape(N, D)
    scores = jax.nn.sigmoid((xs @ router_w).astype(jnp.float32))
    sel = scores + router_b.astype(jnp.float32)
    grp_score = jnp.sum(lax.top_k(sel.reshape(N, N_GROUPS, N_EXPERTS // N_GROUPS), 2)[0], axis=-1)
    top_g = lax.top_k(grp_score, TOPK_GROUPS)[1]
    gmask = jnp.any(top_g[:, :, None] == jnp.arange(N_GROUPS)[None, None, :], axis=1)
    emask = jnp.repeat(gmask, N_EXPERTS // N_GROUPS, axis=1)
    top_e = lax.top_k(jnp.where(emask, sel, -jnp.inf), TOP_K)[1]
    wts = jnp.take_along_axis(scores, top_e, axis=1)
    wts = wts / jnp.sum(wts, axis=-1, keepdims=True) * ROUTED_SCALE

    nk = N * TOP_K
    e_flat = top_e.reshape(nk)
    order = jnp.argsort(e_flat)
    e_sorted = e_flat[order]
    tok_sorted = (jnp.arange(nk, dtype=jnp.int32) // TOP_K)[order]
    w_sorted = wts.reshape(nk)[order]
    cnt = jnp.bincount(e_flat, length=N_EXPERTS)
    padded = (cnt + MOE_BLOCK - 1) // MOE_BLOCK * MOE_BLOCK
    pend = jnp.cumsum(padded)
    dest = (pend - padded)[e_sorted] + jnp.arange(nk, dtype=jnp.int32) - (jnp.cumsum(cnt) - cnt)[e_sorted]
    n_blk = (nk + N_EXPERTS * (MOE_BLOCK - 1) + MOE_BLOCK - 1) // MOE_BLOCK
    buf_tok = jnp.full((n_blk * MOE_BLOCK,), N, jnp.int32).at[dest].set(tok_sorted)
    buf_w = jnp.zeros((n_blk * MOE_BLOCK,), h.dtype).at[dest].set(w_sorted.astype(h.dtype))
    blk_e = jnp.minimum(jnp.searchsorted(pend, jnp.arange(n_blk, dtype=jnp.int32) * MOE_BLOCK, side='right'),
                        N_EXPERTS - 1)
    x_pad = jnp.concatenate([xs, jnp.zeros((1, D), xs.dtype)], axis=0)

    def block(acc, inp):
        tok, wt, e = inp
        xb = x_pad[tok]
        yb = (jax.nn.silu(xb @ w1[e]) * (xb @ w3[e])) @ w2[e]
        return acc.at[tok].add(yb * wt[:, None]), None

    acc, _ = lax.scan(block, jnp.zeros((N + 1, D), h.dtype),
                      (buf_tok.reshape(n_blk, MOE_BLOCK), buf_w.reshape(n_blk, MOE_BLOCK), blk_e))
    shared = (jax.nn.silu(xs @ sw1) * (xs @ sw3)) @ sw2
    return (acc[:N] + shared).reshape(B, T, D)


def setup_inputs(seed: int = 0) -> dict:
    key = jax.random.key(seed)
    ks = iter(jax.random.split(key, 48))
    nrm = lambda shape, s: jax.random.normal(next(ks), shape, jnp.float32) * s
    unif = lambda shape, lo, hi: jax.random.uniform(next(ks), shape, jnp.float32, lo, hi)
    L, D = DEPTH, D_MODEL
    dt = unif((L, 2, HB), 1e-3, 1e-1)
    return {
        'x': nrm((BATCH, SEQ, D), 1.0),
        'c': nrm((BATCH, D), 1.0),
        'ctx': nrm((BATCH, CTX_LEN, D), 1.0),
        'c_ctx': nrm((D,), 1.0),
        'w_ada': nrm((L, D, 6 * D), 0.5 * D ** -0.5),
        'b_ada': nrm((L, 6 * D), 0.02),
        'norm1_g': 1.0 + nrm((L, D), 0.02),
        'w_in': nrm((L, D, IN_COLS), D ** -0.5),
        'mu_shift': unif((L, RWKV_COLS), 0.0, 1.0),
        'w0': unif((L, 2, DA), -6.0, -1.0),
        'w_up': nrm((L, 2, DECAY_LORA, DA), 0.1),
        'a0': nrm((L, 2, DA), 0.1),
        'a_up': nrm((L, 2, AAA_LORA, DA), 0.1),
        'g_up': nrm((L, GATE_LORA, DA), GATE_LORA ** -0.5),
        'k_k': 0.85 + nrm((L, DA), 0.05),
        'k_a': 1.0 + nrm((L, DA), 0.05),
        'r_k': nrm((L, HA, NA), 0.1),
        'lnx_w': 1.0 + nrm((L, DA), 0.02),
        'lnx_b': nrm((L, DA), 0.02),
        'conv_w': nrm((L, GDN_CONV, 3 * DB), GDN_CONV ** -0.5),
        'A_log': jnp.log(unif((L, 2, HB), 1.0, 16.0)),
        'dt_bias': dt + jnp.log(-jnp.expm1(-dt)),
        'onorm_g': 1.0 + nrm((L, KB), 0.02),
        'w_out': nrm((L, D_MIX, D), D_MIX ** -0.5),
        'norm2_g': 1.0 + nrm((L, D), 0.02),
        'router_w': nrm((L, D, N_EXPERTS), D ** -0.5),
        'router_b': nrm((L, N_EXPERTS), 0.01),
        'exp_w1': nrm((L, N_EXPERTS, D, D_EXPERT), D ** -0.5),
        'exp_w3': nrm((L, N_EXPERTS, D, D_EXPERT), D ** -0.5),
        'exp_w2': nrm((L, N_EXPERTS, D_EXPERT, D), D_EXPERT ** -0.5),
        'sh_w1': nrm((L, D, D_SHARED), D ** -0.5),
        'sh_w3': nrm((L, D, D_SHARED), D ** -0.5),
        'sh_w2': nrm((L, D_SHARED, D), D_SHARED ** -0.5),
        'final_g': 1.0 + nrm((D,), 0.02),
    }


def reference(x, c, ctx, c_ctx, w_ada, b_ada, norm1_g, w_in, mu_shift, w0, w_up, a0, a_up, g_up,
              k_k, k_a, r_k, lnx_w, lnx_b, conv_w, A_log, dt_bias, onorm_g, w_out, norm2_g,
              router_w, router_b, exp_w1, exp_w3, exp_w2, sh_w1, sh_w3, sh_w2, final_g):
    h_x, h_c = x, ctx
    for l in range(DEPTH):
        mod = jax.nn.silu(c) @ w_ada[l] + b_ada[l]
        mod_c = jax.nn.silu(c_ctx) @ w_ada[l] + b_ada[l]
        sh1, sc1, gt1, sh2, sc2, gt2 = (m[:, None] for m in jnp.split(mod, 6, axis=-1))
        sh1c, sc1c, gt1c, sh2c, sc2c, gt2c = jnp.split(mod_c, 6, axis=-1)

        p_x = (rmsnorm(h_x, norm1_g[l]) * (1.0 + sc1) + sh1) @ w_in[l]
        p_c = (rmsnorm(h_c, norm1_g[l]) * (1.0 + sc1c) + sh1c) @ w_in[l]
        ya_c, ya_x = rwkv7_mixer(p_c[..., :RWKV_COLS], p_x[..., :RWKV_COLS], mu_shift[l], w0[l], w_up[l],
                                 a0[l], a_up[l], g_up[l], k_k[l], k_a[l], r_k[l], lnx_w[l], lnx_b[l])
        yb_c, yb_x = gdn_mixer(p_c[..., RWKV_COLS:], p_x[..., RWKV_COLS:], conv_w[l], A_log[l],
                               dt_bias[l], onorm_g[l])
        h_x = h_x + gt1 * (jnp.concatenate([ya_x, yb_x], axis=-1).astype(x.dtype) @ w_out[l])

        h_x = h_x + gt2 * moe_ffn(rmsnorm(h_x, norm2_g[l]) * (1.0 + sc2) + sh2, router_w[l], router_b[l],
                                  exp_w1[l], exp_w3[l], exp_w2[l], sh_w1[l], sh_w3[l], sh_w2[l])

        if l < DEPTH - 1:
            h_c = h_c + gt1c * (jnp.concatenate([ya_c, yb_c], axis=-1).astype(x.dtype) @ w_out[l])
            h_c = h_c + gt2c * moe_ffn(rmsnorm(h_c, norm2_g[l]) * (1.0 + sc2c) + sh2c, router_w[l], router_b[l],
                                       exp_w1[l], exp_w3[l], exp_w2[l], sh_w1[l], sh_w3[l], sh_w2[l])
    return rmsnorm(h_x, final_g)
```

```cpp
#include <hip/hip_runtime.h>
#include <cstdio>
#include <cstdint>

#ifndef MK_PER_PHASE
#define MK_PER_PHASE 0
#endif

#define LAS __attribute__((address_space(3)))
typedef unsigned short bf16_t;
typedef short bf16x8 __attribute__((ext_vector_type(8)));
typedef float f32x4 __attribute__((ext_vector_type(4)));
typedef float f32x2 __attribute__((ext_vector_type(2)));
typedef unsigned u32x4 __attribute__((ext_vector_type(4)));
typedef unsigned u32x2 __attribute__((ext_vector_type(2)));
typedef LAS float lfloat;
typedef LAS unsigned char lbyte;

constexpr int D = 1024, NB = 32, SEQ = 2048, CTX = 256, GW = 64;
constexpr int NLAT = NB * SEQ;
constexpr int NCTX = NB * CTX;
constexpr int NROWS = NLAT + NCTX;
constexpr int DA = 512, HA = 8, NA = 64;
constexpr int RW_COLS = 1920, GD_COLS = 2064, IN_COLS = 3984, PLD = 4096;
constexpr int DB = 512, HB = 4, KB = 128;
constexpr int NE = 256, TOPK = 8, DE = 256;
constexpr int MODW = 6 * D;
constexpr float NORM_EPS = 1e-6f, RWKV_EPS = 64e-5f;
constexpr int MAXTILES = (NLAT * TOPK + NE * 255) / 256 + 1;

constexpr size_t MiB = 1u << 20;
constexpr size_t WS_CTL = 0, CTL_BYTES = 1 * MiB;
constexpr size_t WS_MOD = 1 * MiB;
constexpr size_t WS_BTIN = 2 * MiB, WS_BTOUT = 10 * MiB, WS_BTR = 12 * MiB, WS_BON = 13 * MiB, WS_GUPT = 17 * MiB, WS_NRM = 978 * MiB;
constexpr size_t WS_P = 18 * MiB, WS_XN = 594 * MiB, WS_YDIR = 594 * MiB, WS_YMIX = 850 * MiB;
constexpr size_t WS_H2N = 18 * MiB, WS_LOGIT = 146 * MiB, WS_TOPE = 210 * MiB, WS_TOPW = 212 * MiB, WS_POS = 214 * MiB, WS_Y = 146 * MiB;
constexpr size_t WS_ROWL = 658 * MiB, WS_ROWW = 661 * MiB, WS_TILEE = 664 * MiB, WS_HS = 672 * MiB, WS_WEXP = 704 * MiB;
constexpr size_t WEXP_STRIDE = (size_t)(512 * 1024 + 1024 * 256) * 2;
constexpr size_t WS_END = 1090 * MiB;
static_assert(WS_WEXP + 257 * WEXP_STRIDE <= WS_END && WS_Y + (size_t)NLAT * 8 * D <= WS_ROWL, "ws map");
constexpr int CW_BAR = 4096;
constexpr int CW_CNT = 16384;

constexpr int LDS_BYTES = 159744;
constexpr int LDS_MISC = LDS_BYTES - 64;

__device__ __forceinline__ unsigned f2bf(float f) { unsigned u = __builtin_bit_cast(unsigned, f); return (u + 0x7fffu + ((u >> 16) & 1u)) >> 16; }
typedef __bf16 bf16x2_t __attribute__((ext_vector_type(2)));
__device__ __forceinline__ unsigned cvtpk(float lo, float hi) { f32x2 v = {lo, hi}; return __builtin_bit_cast(unsigned, __builtin_convertvector(v, bf16x2_t)); }
__device__ __forceinline__ unsigned pk2(float lo, float hi) { return cvtpk(lo, hi); }
__device__ __forceinline__ float bf2f(unsigned short b) { return __builtin_bit_cast(float, ((unsigned)b) << 16); }
__device__ __forceinline__ float bflo(unsigned w) { return __builtin_bit_cast(float, w << 16); }
__device__ __forceinline__ float bfhi(unsigned w) { return __builtin_bit_cast(float, w & 0xffff0000u); }
template <int CTRL> __device__ __forceinline__ float dpp_f(float v) { return __builtin_bit_cast(float, __builtin_amdgcn_update_dpp(0, __builtin_bit_cast(int, v), CTRL, 0xf, 0xf, false)); }
__device__ __forceinline__ float wave_sum(float v) {
    v += dpp_f<0x128>(v);
    v += dpp_f<0x124>(v);
    v += dpp_f<0x122>(v);
    v += dpp_f<0x121>(v);
    const int vi = __builtin_bit_cast(int, v);
    const float r0 = __builtin_bit_cast(float, __builtin_amdgcn_readlane(vi, 0)), r1 = __builtin_bit_cast(float, __builtin_amdgcn_readlane(vi, 16)),
                r2 = __builtin_bit_cast(float, __builtin_amdgcn_readlane(vi, 32)), r3 = __builtin_bit_cast(float, __builtin_amdgcn_readlane(vi, 48));
    return (r0 + r1) + (r2 + r3);
}
__device__ __forceinline__ float sigmoidf_(float x) { return __builtin_amdgcn_rcpf(1.f + __expf(-x)); }
__device__ __forceinline__ float siluf_(float x) { return x * __builtin_amdgcn_rcpf(1.f + __expf(-x)); }
__device__ __forceinline__ float softplusf_(float x) { return fmaxf(x, 0.f) + __logf(1.f + __expf(-fabsf(x))); }
__device__ __forceinline__ float tanhf_(float x) { const float e = __expf(-2.f * fabsf(x)); const float t = (1.f - e) * __builtin_amdgcn_rcpf(1.f + e); return x < 0.f ? -t : t; }

#define XB_TMO      128
#define XB_XCNT(j)  (256  + 64 * (j))
#define XB_XSUB(j)  (1280 + 64 * (j))
#define XB_XGEN(j)  (2304 + 64 * (j))
#define XB_TOP      3328
#define XB_TOPGEN   3392
#define XCD_BAR_WORDS 3456
#define XB_SPIN_CAP (1u << 22)
__device__ __forceinline__ unsigned xb_ld(unsigned* p)              { return __hip_atomic_load(p, __ATOMIC_RELAXED, __HIP_MEMORY_SCOPE_AGENT); }
__device__ __forceinline__ unsigned xb_add(unsigned* p, unsigned v) { return __hip_atomic_fetch_add(p, v, __ATOMIC_RELAXED, __HIP_MEMORY_SCOPE_AGENT); }
__device__ __forceinline__ unsigned xb_xcc_id() { return (unsigned)__builtin_amdgcn_s_getreg((3 << 11) | 20) & 0xFu; }
#define XB_SPIN(cond, bar) do { unsigned _sp = 0; while (cond) { __builtin_amdgcn_s_sleep(1); \
    if ((++_sp & 255u) == 0u) { if (xb_ld(&(bar)[XB_TMO])) break; if (_sp > XB_SPIN_CAP) { atomicAdd(&(bar)[XB_TMO], 1u); break; } } } } while (0)
struct XcdBarrier { unsigned* bar; unsigned x; volatile LAS unsigned* st; };
__device__ __forceinline__ XcdBarrier xcd_barrier_post(unsigned* bar, volatile LAS unsigned* st) {
    XcdBarrier b; b.bar = bar; b.x = xb_xcc_id(); b.st = st;
    if (threadIdx.x == 0) (void)xb_add(&bar[XB_XCNT(b.x)], 1u);
    return b;
}
__device__ __forceinline__ void xcd_barrier_complete(unsigned* bar, unsigned x, unsigned& nloc, unsigned& nx) {
    const unsigned G = gridDim.x * gridDim.y * gridDim.z;
    unsigned sum, cnt, mine, sp = 0u;
    for (;;) {
        sum = 0u; cnt = 0u; mine = 0u;
#pragma unroll
        for (unsigned j = 0; j < 16; ++j) { const unsigned c = xb_ld(&bar[XB_XCNT(j)]); sum += c; cnt += (c > 0u) ? 1u : 0u; mine = (j == x) ? c : mine; }
        if (sum == G) break;
        __builtin_amdgcn_s_sleep(1);
        if ((++sp & 255u) == 0u) { if (xb_ld(&bar[XB_TMO])) break; if (sp > XB_SPIN_CAP) { atomicAdd(&bar[XB_TMO], 1u); break; } }
    }
    nloc = mine > 0u ? mine : 1u; nx = cnt > 0u ? cnt : 1u;
}
__device__ __forceinline__ void xcd_barrier(const XcdBarrier& b) {
    asm volatile("s_waitcnt vmcnt(0)" ::: "memory");
    __syncthreads();
    if (threadIdx.x == 0) {
        unsigned* bar = b.bar;
        __builtin_amdgcn_s_waitcnt(0);
        unsigned nloc = b.st[0], nx = b.st[1];
        if (nloc == 0u) { xcd_barrier_complete(bar, b.x, nloc, nx); b.st[0] = nloc; b.st[1] = nx; }
        const unsigned old = xb_add(&bar[XB_XSUB(b.x)], 1u);
        const unsigned gen = old / nloc;
        if (old + 1u == (gen + 1u) * nloc) {
            __builtin_amdgcn_fence(__ATOMIC_RELEASE, "agent");
            asm volatile("s_waitcnt vmcnt(0)" ::: "memory");
            const unsigned og = xb_add(&bar[XB_TOP], 1u);
            const unsigned tg = og / nx;
            if (og + 1u == (tg + 1u) * nx) xb_add(&bar[XB_TOPGEN], 1u);
            else XB_SPIN(xb_ld(&bar[XB_TOPGEN]) == tg, bar);
            __builtin_amdgcn_fence(__ATOMIC_ACQUIRE, "agent");
            xb_add(&bar[XB_XGEN(b.x)], 1u);
            asm volatile("s_waitcnt vmcnt(0)" ::: "memory");
        } else {
            XB_SPIN(xb_ld(&bar[XB_XGEN(b.x)]) == gen, bar);
            __builtin_amdgcn_fence(__ATOMIC_ACQUIRE, "agent");
            asm volatile("s_waitcnt vmcnt(0)" ::: "memory");
        }
    }
    __syncthreads();
}

struct Args {
    const float* in[34];
    float* out;
    unsigned char* ws;
    int ph_lo, ph_hi;
};
enum { I_X = 0, I_C, I_CTX, I_CCTX, I_WADA, I_BADA, I_N1G, I_WIN, I_MU, I_W0, I_WUP, I_A0, I_AUP, I_GUP, I_KK, I_KA, I_RK, I_LNW, I_LNB,
       I_CONVW, I_ALOG, I_DTB, I_ONG, I_WOUT, I_N2G, I_RW, I_RB, I_EW1, I_EW3, I_EW2, I_SW1, I_SW3, I_SW2, I_FG };

namespace pg8 {
constexpr int BM = 256, BK = 64, HALF = 128, HTB = HALF * BK * 2, STAGE_BYTES = 8 * HTB, NXCD = 8, WGM = 8;
__host__ __device__ __forceinline__ int lds_byte(int r, int c) { const int st = (r >> 4) * 2 + (c >> 5), rr = r & 15, cc = c & 31, ob = rr * 64 + cc * 2; return st * 1024 + (ob ^ (((ob >> 9) & 1) << 5)); }
__host__ __device__ __forceinline__ void stage_rc(int b, int& R, int& C) { const int st = b / 1024, sb = b % 1024, swz = sb ^ (((sb >> 9) & 1) << 5); R = (st >> 1) * 16 + swz / 64; C = (st & 1) * 32 + (swz % 64) / 2; }
__host__ __device__ __forceinline__ int perm32(int rho) { const int n = rho >> 4, i = rho & 15; return 8 * (i >> 2) + 4 * n + (i & 3); }
__host__ __device__ __forceinline__ int perm_wide(int R) { return 64 * (R >> 5) + 16 * ((R & 15) >> 2) + 4 * ((R >> 4) & 1) + (R & 3); }
struct Unit { int pm, pn; };
struct Gemm { const bf16_t* A; int K; };
struct StaticOrder {
    int nM, nN, nwg, G, c; const char* Bt; size_t tstepB;
    __device__ void init(int M, int N, int G_, int c_, const void* Bt_, int K) { nM = M / BM; nN = N / BM; nwg = nM * nN; G = G_; c = c_; Bt = (const char*)Bt_; tstepB = (size_t)BM * K * 2; }
    __device__ bool next(int i, Unit& u) const {
        const long L = (long)i * G + c; if (L >= nwg) return false;
        int wgid = (int)L; { const int q = nwg / NXCD, r = nwg % NXCD, xcd = wgid % NXCD, off = wgid / NXCD; wgid = (xcd < r ? xcd * (q + 1) : r * (q + 1) + (xcd - r) * q) + off; }
        const int nig = WGM * nN, gid = wgid / nig, fm = gid * WGM, gsz = (nM - fm) < WGM ? (nM - fm) : WGM;
        u.pm = fm + ((wgid % nig) % gsz); u.pn = (wgid % nig) / gsz; return true;
    }
    __device__ __forceinline__ const char* bptr(const Unit& u) const { return Bt + (size_t)u.pn * tstepB; }
    __device__ __forceinline__ int rowsel(const Unit&, int) const { return 0; }
};
struct TileOrder {
    int nunits, npn, G, c; const int* tile_e; const char* wbase; size_t wstride, woff, tstepB; const int* rowl;
    __device__ bool next(int i, Unit& u) const { const int L = i * G + c; if (L >= nunits) return false; u.pm = L / npn; u.pn = L - u.pm * npn; return true; }
    __device__ __forceinline__ const char* bptr(const Unit& u) const { const int e = __builtin_amdgcn_readfirstlane(tile_e[u.pm]); return wbase + (size_t)e * wstride + woff + (size_t)u.pn * tstepB; }
    __device__ __forceinline__ int rowsel(const Unit& u, int r) const { const int t = rowl[(size_t)u.pm * 256 + r]; return t < 0 ? 0 : t; }
};
struct SeqOrder {
    int n; const char* Bt; size_t tstepB; const LAS int* rsel;
    __device__ bool next(int i, Unit& u) const { if (i >= n) return false; u.pm = 0; u.pn = i; return true; }
    __device__ __forceinline__ const char* bptr(const Unit& u) const { return Bt + (size_t)u.pn * tstepB; }
    __device__ __forceinline__ int rowsel(const Unit&, int r) const { return rsel[r]; }
};
__device__ __forceinline__ unsigned cvt_pk_bf16(float lo, float hi) { return cvtpk(lo, hi); }

template <class Epi, class Sched, bool GATHER, int A_AUX = 0, bool ALIGN = true>
__device__ __forceinline__ void gemm_phase(lbyte* lds, const Gemm g, const Sched& S, const Epi& E) {
    int tid_ = threadIdx.x; asm volatile("" : "+v"(tid_));
    const int tid = tid_, wid = __builtin_amdgcn_readfirstlane(tid >> 6), lane = tid & 63, wr = wid >> 2, wc = wid & 3, fr = lane & 15, fq = lane >> 4;
    const int K = g.K, nt = K / BK;
    Unit cur, nxt; int ui = 0;
    if (!S.next(0, cur)) return;
    int Rst[2], Cst[2];
    unsigned voffA[2], voffA1[2], voffB[2], nvA[2], nvA1[2];
#pragma unroll
    for (int i = 0; i < 2; ++i) { int R, C; stage_rc(tid * 16 + i * 8192, R, C); const int Rb = Epi::WIDE ? perm_wide(R) : (Epi::PERM ? ((R & ~31) + perm32(R & 31)) : R); Rst[i] = R; Cst[i] = C;
        if (GATHER) { voffA[i] = ((unsigned)S.rowsel(cur, R) * (unsigned)K + (unsigned)C) * 2u; voffA1[i] = ((unsigned)S.rowsel(cur, 128 + R) * (unsigned)K + (unsigned)C) * 2u; }
        else { voffA[i] = (unsigned)(R * K + C) * 2u; voffA1[i] = voffA[i]; }
        nvA[i] = voffA[i]; nvA1[i] = voffA1[i];
        voffB[i] = (unsigned)(Rb * K + C) * 2u; }
    const size_t kstep = (size_t)(BK * 2);
    const size_t hstep = (size_t)HALF * K * 2;
    const size_t hstepA = GATHER ? 0 : hstep;
    const size_t hstepB = Epi::WIDE ? (size_t)8 * K * 2 : hstep;
    const size_t tstep = 2 * hstep;
    const unsigned ldsw = (unsigned)wid * 1024u;
    const int aoff = lds_byte(wr * 64 + fr, fq * 8), boff = lds_byte(wc * 32 + fr, fq * 8);
#define PG8_SA(b, h) (((b) * 2 + (h)) * HTB)
#define PG8_SB(b, h) ((4 + (b) * 2 + (h)) * HTB)
#define PG8_STAGE2(bufoff, gbase, v0, v1) do { \
        __builtin_amdgcn_global_load_lds((const unsigned*)((const char*)(gbase) + (v0)), (LAS unsigned*)(lds + (bufoff) + ldsw), 16, 0, 0); \
        __builtin_amdgcn_global_load_lds((const unsigned*)((const char*)(gbase) + (v1)), (LAS unsigned*)(lds + (bufoff) + ldsw + 8192), 16, 0, 0); } while (0)
#define PG8_STAGE2A(bufoff, gbase, v0, v1) do { if constexpr (A_AUX == 16) { \
        __builtin_amdgcn_global_load_lds((const unsigned*)((const char*)(gbase) + (v0)), (LAS unsigned*)(lds + (bufoff) + ldsw), 16, 0, 16); \
        __builtin_amdgcn_global_load_lds((const unsigned*)((const char*)(gbase) + (v1)), (LAS unsigned*)(lds + (bufoff) + ldsw + 8192), 16, 0, 16); } else { PG8_STAGE2(bufoff, gbase, v0, v1); } } while (0)
#define PG8_STAGE(bufoff, gbase, voff) PG8_STAGE2(bufoff, gbase, (voff)[0], (voff)[1])
#define PG8_STAGEA(bufoff, gbase, voff) PG8_STAGE2A(bufoff, gbase, (voff)[0], (voff)[1])
#define PG8_LDA(dst, b, h) do { _Pragma("unroll") for (int m = 0; m < 4; ++m) _Pragma("unroll") for (int k = 0; k < 2; ++k) dst[m][k] = *(const LAS bf16x8*)(lds + PG8_SA(b, h) + aoff + m * 2048 + k * 1024); } while (0)
#define PG8_LDB(dst, b, h) do { _Pragma("unroll") for (int n = 0; n < 2; ++n) _Pragma("unroll") for (int k = 0; k < 2; ++k) dst[n][k] = *(const LAS bf16x8*)(lds + PG8_SB(b, h) + boff + n * 2048 + k * 1024); } while (0)
#define PG8_MMA(ai, bj, At, Bt) do { __builtin_amdgcn_s_setprio(1); _Pragma("unroll") for (int m = 0; m < 4; ++m) _Pragma("unroll") for (int n = 0; n < 2; ++n) _Pragma("unroll") for (int k = 0; k < 2; ++k) \
        acc[ai][bj][m][n] = __builtin_amdgcn_mfma_f32_16x16x32_bf16(Bt[n][k], At[m][k], acc[ai][bj][m][n], 0, 0, 0); __builtin_amdgcn_s_setprio(0); } while (0)
#define PG8_WAIT_V(n) asm volatile("s_waitcnt vmcnt(" #n ")" ::: "memory")
#define PG8_WAIT_L(n) asm volatile("s_waitcnt lgkmcnt(" #n ")" ::: "memory")
#define PG8_BAR __builtin_amdgcn_s_barrier()
#define PG8_SCHED __builtin_amdgcn_sched_barrier(0)
    f32x4 acc[2][2][4][2];
#pragma unroll
    for (int a = 0; a < 2; ++a)
#pragma unroll
        for (int b = 0; b < 2; ++b)
#pragma unroll
            for (int m = 0; m < 4; ++m)
#pragma unroll
                for (int n = 0; n < 2; ++n) acc[a][b][m][n] = (f32x4){0.f, 0.f, 0.f, 0.f};
    bf16x8 At[4][2], B0[2][2], B1[2][2];
    const char* cA = (const char*)g.A + (GATHER ? (size_t)0 : (size_t)cur.pm * tstep); const char* cB = S.bptr(cur);
    PG8_STAGE(PG8_SB(0, 0), cB, voffB); PG8_STAGE(PG8_SB(0, 1), cB + hstepB, voffB); PG8_STAGEA(PG8_SA(0, 0), cA, voffA); PG8_STAGEA(PG8_SA(0, 1), cA + hstepA, voffA1);
    if (wr == 1) PG8_BAR;
    PG8_WAIT_V(2); PG8_BAR;
    PG8_STAGE(PG8_SB(1, 0), cB + kstep, voffB); PG8_STAGEA(PG8_SA(1, 0), cA + kstep, voffA); PG8_STAGE(PG8_SB(1, 1), cB + hstepB + kstep, voffB);
    PG8_WAIT_V(6); PG8_BAR;
    for (;;) {
        const bool has_next = S.next(ui + 1, nxt);
        const char* nA = has_next ? (const char*)g.A + (GATHER ? (size_t)0 : (size_t)nxt.pm * tstep) : cA; const char* nB = has_next ? S.bptr(nxt) : cB;
        for (int t = 0; t < nt; t += 2) {
            const bool last = (t == nt - 2);
            const char* a1 = cA + (size_t)(t + 1) * kstep;
            const char* a2 = last ? nA : cA + (size_t)(t + 2) * kstep; const char* b2 = last ? nB : cB + (size_t)(t + 2) * kstep;
            const char* a3 = a2 + kstep; const char* b3 = b2 + kstep;
            if (GATHER && last && has_next) {
#pragma unroll
                for (int i = 0; i < 2; ++i) { nvA[i] = ((unsigned)S.rowsel(nxt, Rst[i]) * (unsigned)K + (unsigned)Cst[i]) * 2u; nvA1[i] = ((unsigned)S.rowsel(nxt, 128 + Rst[i]) * (unsigned)K + (unsigned)Cst[i]) * 2u; }
            }
            const unsigned x0 = (GATHER && last) ? nvA[0] : voffA[0], x1 = (GATHER && last) ? nvA[1] : voffA[1];
            const unsigned y0 = (GATHER && last) ? nvA1[0] : voffA1[0], y1 = (GATHER && last) ? nvA1[1] : voffA1[1];
            PG8_LDB(B0, 0, 0); PG8_LDB(B1, 0, 1); PG8_SCHED; PG8_LDA(At, 0, 0); PG8_STAGEA(PG8_SA(1, 1), a1 + hstepA, voffA1);
            PG8_WAIT_V(8); PG8_WAIT_L(0); PG8_BAR; PG8_MMA(0, 0, At, B0); PG8_MMA(0, 1, At, B1); PG8_BAR; PG8_SCHED;
            PG8_LDA(At, 0, 1); PG8_STAGE(PG8_SB(0, 0), b2, voffB); PG8_STAGE(PG8_SB(0, 1), b2 + hstepB, voffB); PG8_STAGE2A(PG8_SA(0, 0), a2, x0, x1);
            PG8_WAIT_V(8); PG8_WAIT_L(0); PG8_BAR; PG8_MMA(1, 0, At, B0); PG8_MMA(1, 1, At, B1); PG8_BAR; PG8_SCHED;
            PG8_LDB(B0, 1, 0); PG8_LDB(B1, 1, 1); PG8_SCHED; PG8_LDA(At, 1, 0); PG8_STAGE2A(PG8_SA(0, 1), a2 + hstepA, y0, y1);
            PG8_WAIT_V(8); PG8_WAIT_L(0); PG8_BAR; PG8_MMA(0, 0, At, B0); PG8_MMA(0, 1, At, B1); PG8_BAR; PG8_SCHED;
            PG8_LDA(At, 1, 1); PG8_STAGE(PG8_SB(1, 0), b3, voffB); PG8_STAGE(PG8_SB(1, 1), b3 + hstepB, voffB); PG8_STAGE2A(PG8_SA(1, 0), a3, x0, x1);
            PG8_WAIT_V(8); PG8_WAIT_L(0); PG8_BAR; PG8_MMA(1, 0, At, B0); PG8_MMA(1, 1, At, B1); PG8_BAR; PG8_SCHED;
        }
        if (ALIGN && wr == 0) PG8_BAR;
        E(acc, cur, wr, wc, fr, fq);
        if (!has_next) break;
#pragma unroll
        for (int a = 0; a < 2; ++a)
#pragma unroll
            for (int b = 0; b < 2; ++b)
#pragma unroll
                for (int m = 0; m < 4; ++m)
#pragma unroll
                    for (int n = 0; n < 2; ++n) acc[a][b][m][n] = (f32x4){0.f, 0.f, 0.f, 0.f};
        cur = nxt; cA = nA; cB = nB; ++ui;
        if (GATHER) { voffA[0] = nvA[0]; voffA[1] = nvA[1]; voffA1[0] = nvA1[0]; voffA1[1] = nvA1[1]; }
        if (ALIGN && wr == 1) PG8_BAR;
    }
    PG8_WAIT_V(0);
    if (!ALIGN && wr == 0) PG8_BAR;
    PG8_BAR;
#undef PG8_SA
#undef PG8_SB
#undef PG8_STAGE
#undef PG8_STAGE2
#undef PG8_STAGE2A
#undef PG8_STAGEA
#undef PG8_LDA
#undef PG8_LDB
#undef PG8_MMA
#undef PG8_WAIT_V
#undef PG8_WAIT_L
#undef PG8_BAR
#undef PG8_SCHED
}

struct EpiBf16 {
    static constexpr bool WIDE = false;
    static constexpr bool PERM = true;
    bf16_t* O; int ldc;
    __device__ __forceinline__ void operator()(const f32x4 (&acc)[2][2][4][2], const Unit& u, int wr, int wc, int fr, int fq) const {
        const int row0 = u.pm * BM + wr * 64 + fr; const int col0 = u.pn * BM + wc * 32 + 8 * fq;
#pragma unroll
        for (int ai = 0; ai < 2; ++ai)
#pragma unroll
            for (int m = 0; m < 4; ++m) { bf16_t* rowp = O + (size_t)(row0 + ai * HALF + m * 16) * ldc + col0;
#pragma unroll
                for (int bj = 0; bj < 2; ++bj) { const f32x4 v0 = acc[ai][bj][m][0], v1 = acc[ai][bj][m][1];
                    u32x4 w; w.x = cvt_pk_bf16(v0[0], v0[1]); w.y = cvt_pk_bf16(v0[2], v0[3]); w.z = cvt_pk_bf16(v1[0], v1[1]); w.w = cvt_pk_bf16(v1[2], v1[3]);
                    *(u32x4*)(rowp + bj * HALF) = w; } }
    }
};
struct EpiBf16W {
    static constexpr bool PERM = true, WIDE = true;
    bf16_t* O; int ldc;
    __device__ __forceinline__ void operator()(const f32x4 (&acc)[2][2][4][2], const Unit& u, int wr, int wc, int fr, int fq) const {
        const int row0 = u.pm * BM + wr * 64 + fr; const int col0 = u.pn * BM + wc * 64 + 16 * fq;
#pragma unroll
        for (int ai = 0; ai < 2; ++ai)
#pragma unroll
            for (int m = 0; m < 4; ++m) { bf16_t* rowp = O + (size_t)(row0 + ai * HALF + m * 16) * ldc + col0;
#pragma unroll
                for (int bj = 0; bj < 2; ++bj) { const f32x4 v0 = acc[ai][bj][m][0], v1 = acc[ai][bj][m][1];
                    u32x4 w; w.x = cvt_pk_bf16(v0[0], v0[1]); w.y = cvt_pk_bf16(v0[2], v0[3]); w.z = cvt_pk_bf16(v1[0], v1[1]); w.w = cvt_pk_bf16(v1[2], v1[3]);
                    *(u32x4*)(rowp + bj * 8) = w; } }
    }
};
struct EpiF32 {
    static constexpr bool WIDE = false;
    static constexpr bool PERM = false;
    float* C; int ldc;
    __device__ __forceinline__ void operator()(const f32x4 (&acc)[2][2][4][2], const Unit& u, int wr, int wc, int fr, int fq) const {
        const int row0 = u.pm * BM + wr * 64 + fr, col0 = u.pn * BM + wc * 32 + 4 * fq;
#pragma unroll
        for (int ai = 0; ai < 2; ++ai)
#pragma unroll
            for (int m = 0; m < 4; ++m) { float* rowp = C + (size_t)(row0 + ai * HALF + m * 16) * ldc + col0;
#pragma unroll
                for (int bj = 0; bj < 2; ++bj)
#pragma unroll
                    for (int n = 0; n < 2; ++n) *(f32x4*)(rowp + bj * HALF + n * 16) = acc[ai][bj][m][n]; }
    }
};
struct EpiResGate {
    static constexpr bool WIDE = false;
    static constexpr bool PERM = false;
    const float* x; float* out; const float* mod; int gate_off;
    __device__ __forceinline__ void operator()(const f32x4 (&acc)[2][2][4][2], const Unit& u, int wr, int wc, int fr, int fq) const {
        const int row0 = u.pm * BM + wr * 64 + fr, col0 = u.pn * BM + wc * 32 + 4 * fq;
        const float* gp = mod + (size_t)((u.pm * BM) >> 11) * MODW + gate_off + col0;
        f32x4 gv[2][2];
#pragma unroll
        for (int bj = 0; bj < 2; ++bj)
#pragma unroll
            for (int n = 0; n < 2; ++n) gv[bj][n] = *(const f32x4*)(gp + bj * HALF + n * 16);
#pragma unroll
        for (int ai = 0; ai < 2; ++ai)
#pragma unroll
            for (int m = 0; m < 4; ++m) { const size_t off = (size_t)(row0 + ai * HALF + m * 16) * D + col0;
#pragma unroll
                for (int bj = 0; bj < 2; ++bj)
#pragma unroll
                    for (int n = 0; n < 2; ++n) { const f32x4 xv = *(const f32x4*)(x + off + bj * HALF + n * 16);
                        *(f32x4*)(out + off + bj * HALF + n * 16) = xv + gv[bj][n] * acc[ai][bj][m][n]; }
                asm volatile("" ::: "memory"); }
    }
};
struct EpiGLU {
    static constexpr bool WIDE = false;
    static constexpr bool PERM = true;
    bf16_t* H;
    __device__ __forceinline__ void operator()(const f32x4 (&acc)[2][2][4][2], const Unit& u, int wr, int wc, int fr, int fq) const {
        const int row0 = u.pm * BM + wr * 64 + fr; const int col0 = u.pn * 128 + wc * 32 + 8 * fq;
#pragma unroll
        for (int ai = 0; ai < 2; ++ai)
#pragma unroll
            for (int m = 0; m < 4; ++m) { bf16_t* rowp = H + (size_t)(row0 + ai * HALF + m * 16) * 256 + col0;
                f32x4 h0, h1;
#pragma unroll
                for (int j = 0; j < 4; ++j) { const float a0 = acc[ai][0][m][0][j], a1 = acc[ai][0][m][1][j];
                    h0[j] = siluf_(a0) * acc[ai][1][m][0][j]; h1[j] = siluf_(a1) * acc[ai][1][m][1][j]; }
                u32x4 w; w.x = cvt_pk_bf16(h0[0], h0[1]); w.y = cvt_pk_bf16(h0[2], h0[3]); w.z = cvt_pk_bf16(h1[0], h1[1]); w.w = cvt_pk_bf16(h1[2], h1[3]);
                *(u32x4*)rowp = w; }
    }
};
constexpr float YSCALE = 16.f;
struct EpiY {
    static constexpr bool WIDE = false;
    static constexpr bool PERM = true;
    unsigned char* Y; float* out; const float* mod; const LAS int* rtok; const LAS float* rw; int shared;
    __device__ __forceinline__ void operator()(const f32x4 (&acc)[2][2][4][2], const Unit& u, int wr, int wc, int fr, int fq) const {
        const int col0 = u.pn * BM + wc * 32 + 8 * fq;
#pragma unroll
        for (int ai = 0; ai < 2; ++ai)
#pragma unroll
            for (int m = 0; m < 4; ++m) { const int r = wr * 64 + fr + ai * HALF + m * 16; const int ts = rtok[r]; const float w = rw[r];
                if (ts >= 0) {
                    if (shared) { const unsigned goff = (unsigned)(ts >> 11) * MODW + 5 * D + col0; const unsigned ooff = (unsigned)ts * D + col0;
#pragma unroll
                        for (int bj = 0; bj < 2; ++bj)
#pragma unroll
                            for (int n = 0; n < 2; ++n) { const f32x4 gv = *(const f32x4*)(mod + goff + bj * HALF + n * 4); f32x4* op = (f32x4*)(out + ooff + bj * HALF + n * 4);
                                *op = *op + gv * acc[ai][bj][m][n]; }
                    } else { unsigned char* yp = Y + (size_t)(unsigned)ts * D + col0; const float ws_ = w * YSCALE;
#pragma unroll
                        for (int bj = 0; bj < 2; ++bj) { const f32x4 v0 = acc[ai][bj][m][0] * ws_, v1 = acc[ai][bj][m][1] * ws_;
                            unsigned lo = 0u, hi = 0u;
                            lo = __builtin_amdgcn_cvt_pk_fp8_f32(v0[0], v0[1], lo, false); lo = __builtin_amdgcn_cvt_pk_fp8_f32(v0[2], v0[3], lo, true);
                            hi = __builtin_amdgcn_cvt_pk_fp8_f32(v1[0], v1[1], hi, false); hi = __builtin_amdgcn_cvt_pk_fp8_f32(v1[2], v1[3], hi, true);
                            u32x2 pk; pk.x = lo; pk.y = hi; *(u32x2*)(yp + bj * HALF) = pk; } } }
                asm volatile("" ::: "memory"); }
    }
};

struct MoeCtx {
    int ntiles, nrt, G, vc;
    const LAS int* tb; LAS int* tbl;
    const unsigned* cnt; const int* rowl; const float* roww;
    const char* wexp; const char* h2n; char* Hs; unsigned char* Y; float* out; const float* mod; int dry_shared;
};
__device__ __forceinline__ void gemm_moe(lbyte* lds, const MoeCtx& M) {
    int tid_ = threadIdx.x; asm volatile("" : "+v"(tid_));
    const int tid = tid_, wid = __builtin_amdgcn_readfirstlane(tid >> 6), lane = tid & 63, wr = wid >> 2, wc = wid & 3, fr = lane & 15, fq = lane >> 4;
    const int ntl = (M.ntiles - M.vc + M.G - 1) / M.G;
    if (M.vc >= M.ntiles) return;
    const int nunits = ntl * 6;
    const unsigned ldsw = (unsigned)wid * 1024u;
    const int aoff = lds_byte(wr * 64 + fr, fq * 8), boff = lds_byte(wc * 32 + fr, fq * 8);
    auto tile_expert = [&](int tile, int& e, int& k) { if (tile < M.nrt) { int lo = 0, hi = NE - 1; while (lo < hi) { const int mid = (lo + hi + 1) >> 1; if (M.tb[mid] <= tile) lo = mid; else hi = mid - 1; } e = lo; k = tile - M.tb[lo]; } else { e = NE; k = tile - M.nrt; } };
    auto fill = [&](int j) { if (j < ntl && tid < 256) { const int tile = M.vc + j * M.G; int e, k; tile_expert(tile, e, k); LAS int* T = M.tbl + (j & 1) * 768;
            int ts; float w;
            if (e < NE) { const int valid = (int)M.cnt[e] - 256 * k; if (tid < valid) { ts = M.rowl[(size_t)tile * 256 + tid]; w = M.roww[(size_t)tile * 256 + tid]; } else { ts = -1; w = 0.f; } T[tid] = ts < 0 ? 0 : (ts >> 3); }
            else { ts = k * 256 + tid; w = 1.f; T[tid] = ts; }
            T[256 + tid] = ts; ((LAS float*)T)[512 + tid] = w; } };
    struct UP { const char* aB; const char* bB; unsigned bh; int nt, kind, pn, slot, shared, e; };
    auto unit_params = [&](int ui, int prev_e, UP& u, unsigned (&oa)[4], unsigned (&ob)[2]) {
        int tq = threadIdx.x; asm volatile("" : "+v"(tq));
        int Rst[2], Cst[2], Rbp[2];
#pragma unroll
        for (int i = 0; i < 2; ++i) { int R, C; stage_rc(tq * 16 + i * 8192, R, C); Rst[i] = R; Cst[i] = C; Rbp[i] = (R & ~31) + perm32(R & 31); }
        const int j = ui / 6, sub = ui - 6 * j, tile = M.vc + j * M.G; int e, k;
        if (sub == 0) tile_expert(tile, e, k); else e = prev_e;
        u.e = e;
        const char* w = M.wexp + (size_t)e * WEXP_STRIDE;
        u.slot = j & 1; u.shared = (e == NE) ? 1 : 0;
        if (sub < 2) { u.kind = 0; u.pn = sub; u.nt = D / BK; u.aB = M.h2n; u.bB = w + (size_t)sub * 256 * D * 2; u.bh = 128u * D * 2u;
            const LAS int* T = M.tbl + (j & 1) * 768;
#pragma unroll
            for (int i = 0; i < 2; ++i) { oa[i] = ((unsigned)T[Rst[i]] * (unsigned)D + (unsigned)Cst[i]) * 2u; oa[2 + i] = ((unsigned)T[128 + Rst[i]] * (unsigned)D + (unsigned)Cst[i]) * 2u; ob[i] = (unsigned)(Rbp[i] * D + Cst[i]) * 2u; } }
        else { u.kind = 1; u.pn = sub - 2; u.nt = DE / BK; u.aB = M.Hs; u.bB = w + (size_t)512 * 1024 * 2 + (size_t)(sub - 2) * 256 * DE * 2; u.bh = 128u * DE * 2u;
#pragma unroll
            for (int i = 0; i < 2; ++i) { oa[i] = (unsigned)(Rst[i] * DE + Cst[i]) * 2u; oa[2 + i] = (unsigned)((128 + Rst[i]) * DE + Cst[i]) * 2u; ob[i] = (unsigned)(Rbp[i] * DE + Cst[i]) * 2u; } }
    };
#define PG8_SA(b, h) (((b) * 2 + (h)) * HTB)
#define PG8_SB(b, h) ((4 + (b) * 2 + (h)) * HTB)
#define MOE_DMA(bufoff, ptr, aux) __builtin_amdgcn_global_load_lds((const unsigned*)(ptr), (LAS unsigned*)(lds + (bufoff)), 16, 0, aux)
#define MOE_STA(bufoff, base, o0, o1) do { MOE_DMA((bufoff) + ldsw, (base) + (o0), 16); MOE_DMA((bufoff) + ldsw + 8192, (base) + (o1), 16); } while (0)
#define MOE_STAK(kindv, bufoff, base, o0, o1) do { if ((kindv) == 0) { MOE_DMA((bufoff) + ldsw, (base) + (o0), 0); MOE_DMA((bufoff) + ldsw + 8192, (base) + (o1), 0); } else MOE_STA(bufoff, base, o0, o1); } while (0)
#define MOE_STB(bufoff, base, o0, o1) do { MOE_DMA((bufoff) + ldsw, (base) + (o0), 0); MOE_DMA((bufoff) + ldsw + 8192, (base) + (o1), 0); } while (0)
#define PG8_LDA(dst, b, h) do { _Pragma("unroll") for (int m = 0; m < 4; ++m) _Pragma("unroll") for (int k = 0; k < 2; ++k) dst[m][k] = *(const LAS bf16x8*)(lds + PG8_SA(b, h) + aoff + m * 2048 + k * 1024); } while (0)
#define PG8_LDB(dst, b, h) do { _Pragma("unroll") for (int n = 0; n < 2; ++n) _Pragma("unroll") for (int k = 0; k < 2; ++k) dst[n][k] = *(const LAS bf16x8*)(lds + PG8_SB(b, h) + boff + n * 2048 + k * 1024); } while (0)
#define PG8_MMA(ai, bj, At, Bt) do { __builtin_amdgcn_s_setprio(1); _Pragma("unroll") for (int m = 0; m < 4; ++m) _Pragma("unroll") for (int n = 0; n < 2; ++n) _Pragma("unroll") for (int k = 0; k < 2; ++k) \
        acc[ai][bj][m][n] = __builtin_amdgcn_mfma_f32_16x16x32_bf16(Bt[n][k], At[m][k], acc[ai][bj][m][n], 0, 0, 0); __builtin_amdgcn_s_setprio(0); } while (0)
#define PG8_WAIT_V(n) asm volatile("s_waitcnt vmcnt(" #n ")" ::: "memory")
#define PG8_WAIT_L(n) asm volatile("s_waitcnt lgkmcnt(" #n ")" ::: "memory")
#define PG8_BAR __builtin_amdgcn_s_barrier()
#define PG8_SCHED __builtin_amdgcn_sched_barrier(0)
    fill(0);
    asm volatile("s_waitcnt vmcnt(0) lgkmcnt(0)" ::: "memory");
    __syncthreads();
    UP cu, nu; unsigned oa[4], ob[2], na[4], nb[2];
    unit_params(0, 0, cu, oa, ob);
    nu = cu;
#pragma unroll
    for (int i = 0; i < 4; ++i) na[i] = oa[i];
    nb[0] = ob[0]; nb[1] = ob[1];
    f32x4 acc[2][2][4][2];
#pragma unroll
    for (int a = 0; a < 2; ++a)
#pragma unroll
        for (int b = 0; b < 2; ++b)
#pragma unroll
            for (int m = 0; m < 4; ++m)
#pragma unroll
                for (int n = 0; n < 2; ++n) acc[a][b][m][n] = (f32x4){0.f, 0.f, 0.f, 0.f};
    bf16x8 At[4][2], B0[2][2], B1[2][2];
    const size_t kstep = (size_t)(BK * 2);
    {   const char* cA = cu.aB; const char* cB = cu.bB;
        MOE_STB(PG8_SB(0, 0), cB, ob[0], ob[1]); MOE_STB(PG8_SB(0, 1), cB + cu.bh, ob[0], ob[1]); MOE_STAK(cu.kind, PG8_SA(0, 0), cA, oa[0], oa[1]); MOE_STAK(cu.kind, PG8_SA(0, 1), cA, oa[2], oa[3]);
        if (wr == 1) PG8_BAR;
        PG8_WAIT_V(2); PG8_BAR;
        MOE_STB(PG8_SB(1, 0), cB + kstep, ob[0], ob[1]); MOE_STAK(cu.kind, PG8_SA(1, 0), cA + kstep, oa[0], oa[1]); MOE_STB(PG8_SB(1, 1), cB + cu.bh + kstep, ob[0], ob[1]);
        PG8_WAIT_V(6); PG8_BAR; }
    for (int ui = 0;; ++ui) {
        const bool has_next = (ui + 1 < nunits);
        { const int j = ui / 6; if (ui - 6 * j == 2) fill(j + 1); }
        const char* cA = cu.aB; const char* cB = cu.bB; const int nt = cu.nt; const unsigned bh = cu.bh;
        for (int t = 0; t < nt; t += 2) {
            const bool last = (t == nt - 2);
            if (last && has_next) unit_params(ui + 1, cu.e, nu, na, nb);
            const char* a1 = cA + (size_t)(t + 1) * kstep;
            const char* a2 = last ? nu.aB : cA + (size_t)(t + 2) * kstep; const char* b2 = last ? nu.bB : cB + (size_t)(t + 2) * kstep;
            const char* a3 = a2 + kstep; const char* b3 = b2 + kstep;
            const unsigned bh2 = last ? nu.bh : bh;
            const unsigned x0 = last ? na[0] : oa[0], x1 = last ? na[1] : oa[1], y0 = last ? na[2] : oa[2], y1 = last ? na[3] : oa[3];
            const unsigned z0 = last ? nb[0] : ob[0], z1 = last ? nb[1] : ob[1];
            const int k2 = last ? nu.kind : cu.kind;
            PG8_LDB(B0, 0, 0); PG8_LDB(B1, 0, 1); PG8_SCHED; PG8_LDA(At, 0, 0); MOE_STAK(cu.kind, PG8_SA(1, 1), a1, oa[2], oa[3]);
            PG8_WAIT_V(8); PG8_WAIT_L(0); PG8_BAR; PG8_MMA(0, 0, At, B0); PG8_MMA(0, 1, At, B1); PG8_BAR; PG8_SCHED;
            PG8_LDA(At, 0, 1); MOE_STB(PG8_SB(0, 0), b2, z0, z1); MOE_STB(PG8_SB(0, 1), b2 + bh2, z0, z1); MOE_STAK(k2, PG8_SA(0, 0), a2, x0, x1);
            PG8_WAIT_V(8); PG8_WAIT_L(0); PG8_BAR; PG8_MMA(1, 0, At, B0); PG8_MMA(1, 1, At, B1); PG8_BAR; PG8_SCHED;
            PG8_LDB(B0, 1, 0); PG8_LDB(B1, 1, 1); PG8_SCHED; PG8_LDA(At, 1, 0); MOE_STAK(k2, PG8_SA(0, 1), a2, y0, y1);
            PG8_WAIT_V(8); PG8_WAIT_L(0); PG8_BAR; PG8_MMA(0, 0, At, B0); PG8_MMA(0, 1, At, B1); PG8_BAR; PG8_SCHED;
            PG8_LDA(At, 1, 1); MOE_STB(PG8_SB(1, 0), b3, z0, z1); MOE_STB(PG8_SB(1, 1), b3 + bh2, z0, z1); MOE_STAK(k2, PG8_SA(1, 0), a3, x0, x1);
            PG8_WAIT_V(8); PG8_WAIT_L(0); PG8_BAR; PG8_MMA(1, 0, At, B0); PG8_MMA(1, 1, At, B1); PG8_BAR; PG8_SCHED;
        }
        if (wr == 0) PG8_BAR;
        if (cu.kind == 0) {
            const int row0 = wr * 64 + fr; const int col0 = cu.pn * 128 + wc * 32 + 8 * fq;
#pragma unroll
            for (int ai = 0; ai < 2; ++ai)
#pragma unroll
                for (int m = 0; m < 4; ++m) { bf16_t* rowp = (bf16_t*)M.Hs + (size_t)(row0 + ai * HALF + m * 16) * 256 + col0;
                    f32x4 h0, h1;
#pragma unroll
                    for (int j = 0; j < 4; ++j) { h0[j] = siluf_(acc[ai][0][m][0][j]) * acc[ai][1][m][0][j]; h1[j] = siluf_(acc[ai][0][m][1][j]) * acc[ai][1][m][1][j]; }
                    u32x4 w; w.x = cvt_pk_bf16(h0[0], h0[1]); w.y = cvt_pk_bf16(h0[2], h0[3]); w.z = cvt_pk_bf16(h1[0], h1[1]); w.w = cvt_pk_bf16(h1[2], h1[3]);
                    *(u32x4*)rowp = w; }
            if (cu.pn == 1) PG8_WAIT_V(0);
        } else {
            const LAS int* rtok = M.tbl + cu.slot * 768 + 256; const LAS float* rw = (const LAS float*)(M.tbl + cu.slot * 768 + 512);
            const int col0 = cu.pn * BM + wc * 32 + 8 * fq;
#pragma unroll
            for (int ai = 0; ai < 2; ++ai)
#pragma unroll
                for (int m = 0; m < 4; ++m) { const int r = wr * 64 + fr + ai * HALF + m * 16; const int ts = rtok[r]; const float w = rw[r];
                    if (ts >= 0) {
                        if (cu.shared) { const unsigned goff = (unsigned)(ts >> 11) * MODW + 5 * D + col0; const unsigned ooff = (unsigned)ts * D + col0;
#pragma unroll
                            for (int bj = 0; bj < 2; ++bj)
#pragma unroll
                                for (int n = 0; n < 2; ++n) { const f32x4 gv = *(const f32x4*)(M.mod + goff + bj * HALF + n * 4); f32x4* op = (f32x4*)(M.out + ooff + bj * HALF + n * 4);
                                    const f32x4 nv = *op + gv * acc[ai][bj][m][n]; if (!M.dry_shared) *op = nv; else asm volatile("" :: "v"(nv)); }
                        } else { unsigned char* yp = M.Y + (size_t)(unsigned)ts * D + col0; const float ws_ = w * YSCALE;
#pragma unroll
                            for (int bj = 0; bj < 2; ++bj) { const f32x4 v0 = acc[ai][bj][m][0] * ws_, v1 = acc[ai][bj][m][1] * ws_;
                                unsigned lo = 0u, hi = 0u;
                                lo = __builtin_amdgcn_cvt_pk_fp8_f32(v0[0], v0[1], lo, false); lo = __builtin_amdgcn_cvt_pk_fp8_f32(v0[2], v0[3], lo, true);
                                hi = __builtin_amdgcn_cvt_pk_fp8_f32(v1[0], v1[1], hi, false); hi = __builtin_amdgcn_cvt_pk_fp8_f32(v1[2], v1[3], hi, true);
                                u32x2 pk; pk.x = lo; pk.y = hi; *(u32x2*)(yp + bj * HALF) = pk; } } }
                    asm volatile("" ::: "memory"); }
        }
        if (!has_next) break;
#pragma unroll
        for (int a = 0; a < 2; ++a)
#pragma unroll
            for (int b = 0; b < 2; ++b)
#pragma unroll
                for (int m = 0; m < 4; ++m)
#pragma unroll
                    for (int n = 0; n < 2; ++n) acc[a][b][m][n] = (f32x4){0.f, 0.f, 0.f, 0.f};
        cu = nu;
#pragma unroll
        for (int i = 0; i < 4; ++i) oa[i] = na[i];
        ob[0] = nb[0]; ob[1] = nb[1];
        if (wr == 1) PG8_BAR;
    }
    PG8_WAIT_V(0);
    PG8_BAR;
#undef PG8_SA
#undef PG8_SB
#undef MOE_DMA
#undef MOE_STA
#undef MOE_STAK
#undef MOE_STB
#undef PG8_LDA
#undef PG8_LDB
#undef PG8_MMA
#undef PG8_WAIT_V
#undef PG8_WAIT_L
#undef PG8_BAR
#undef PG8_SCHED
}
}

struct Ctx {
    lbyte* lds; int tid, lane, wave, G, bid;
    const Args* a;
};
#define WSP(T, off) ((T*)(A.ws + (off)))

template <class RowMap>
__device__ __forceinline__ void transpose_item(const float* W, int K, int N, bf16_t* WT, RowMap rowmap, lfloat* scr, int item, int lane) {
    const int nblk = N / 32, kb = item / nblk, nb = item % nblk, k0 = 64 * kb, n0 = 32 * nb;
#pragma unroll 8
    for (int i = 0; i < 32; ++i) { const int kk = 2 * i + (lane >> 5); scr[kk * 33 + (lane & 31)] = W[(size_t)(k0 + kk) * N + n0 + (lane & 31)]; }
    asm volatile("s_waitcnt lgkmcnt(0)" ::: "memory");
    const int c = lane & 7;
#pragma unroll
    for (int j = 0; j < 4; ++j) { const int n = (lane >> 3) + 8 * j; const lfloat* s = scr + (8 * c) * 33 + n;
        u32x4 o; o.x = pk2(s[0 * 33], s[1 * 33]); o.y = pk2(s[2 * 33], s[3 * 33]); o.z = pk2(s[4 * 33], s[5 * 33]); o.w = pk2(s[6 * 33], s[7 * 33]);
        *(u32x4*)(WT + (size_t)rowmap(n0 + n) * K + k0 + 8 * c) = o; }
    asm volatile("s_waitcnt lgkmcnt(0)" ::: "memory");
}
struct RowId { __device__ int operator()(int n) const { return n; } };
struct RowGLU { int base; __device__ int operator()(int n) const { return ((n >> 7) << 8) + base + (n & 127); } };

__device__ __forceinline__ void norm_mod_row(const float* xrow, const float* g, const float* sc, const float* sh, bf16_t* orow, int lane) {
    const f32x4* xr = (const f32x4*)xrow + lane;
    f32x4 v[4]; float s = 0.f;
#pragma unroll
    for (int j = 0; j < 4; ++j) { v[j] = xr[64 * j]; s += (v[j].x * v[j].x + v[j].y * v[j].y) + (v[j].z * v[j].z + v[j].w * v[j].w); }
    const float rstd = __builtin_amdgcn_rsqf(wave_sum(s) * (1.f / D) + NORM_EPS);
    u32x2* o8 = (u32x2*)orow + lane;
#pragma unroll
    for (int j = 0; j < 4; ++j) { const f32x4 gg = ((const f32x4*)g)[lane + 64 * j], ss = ((const f32x4*)sc)[lane + 64 * j], hh = ((const f32x4*)sh)[lane + 64 * j];
        const f32x4 y = v[j] * rstd * gg * (ss + 1.f) + hh;
        u32x2 w; w.x = pk2(y.x, y.y); w.y = pk2(y.z, y.w); o8[64 * j] = w; }
}

__device__ __forceinline__ void phase_p0(const Args& A, Ctx& C) {
    float* mod = WSP(float, WS_MOD);
    {
        lfloat* sc = (lfloat*)C.lds;
        lfloat* red = (lfloat*)(C.lds + 17 * 1024 * 4);
        const float* wada = A.in[I_WADA]; const float* bada = A.in[I_BADA];
        for (int it = C.bid; it < 96 * 2; it += C.G) {
            const int chunk = it >> 1, pass = it & 1, r0 = pass * 17, nr = pass ? 16 : 17, col0 = chunk * 64;
            __syncthreads();
            for (int i = C.tid; i < nr * 1024; i += 512) { const int r = i >> 10, k = i & 1023; const int rr = r0 + r;
                const float cv = rr < 32 ? A.in[I_C][rr * 1024 + k] : A.in[I_CCTX][k]; sc[r * 1024 + k] = siluf_(cv); }
            __syncthreads();
            const int col = C.tid & 63, kq = C.tid >> 6;
            float acc[17];
#pragma unroll
            for (int r = 0; r < 17; ++r) acc[r] = 0.f;
            for (int k = kq * 128; k < kq * 128 + 128; k += 4) {
                float w[4];
#pragma unroll
                for (int j = 0; j < 4; ++j) w[j] = wada[(size_t)(k + j) * MODW + col0 + col];
#pragma unroll
                for (int r = 0; r < 17; ++r) { const f32x4 s4 = *(const LAS f32x4*)(sc + r * 1024 + k); acc[r] += s4.x * w[0] + s4.y * w[1] + s4.z * w[2] + s4.w * w[3]; }
            }
#pragma unroll
            for (int r = 0; r < 17; ++r) red[(kq * 17 + r) * 64 + col] = acc[r];
            __syncthreads();
            for (int i = C.tid; i < nr * 64; i += 512) { const int r = i >> 6, cc = i & 63; float s = 0.f;
#pragma unroll
                for (int q = 0; q < 8; ++q) s += red[(q * 17 + r) * 64 + cc];
                mod[(size_t)(r0 + r) * MODW + col0 + cc] = s + bada[col0 + cc]; }
        }
        __syncthreads();
    }
    {
        lfloat* scr = (lfloat*)(C.lds + C.wave * 16384);
        const int gw = C.bid * 8 + C.wave, NGW = C.G * 8;
        bf16_t* btin = WSP(bf16_t, WS_BTIN); bf16_t* btout = WSP(bf16_t, WS_BTOUT); bf16_t* btr = WSP(bf16_t, WS_BTR);
        constexpr int I_IN = (D / 64) * 124, I_OUT = (D / 64) * (D / 32), I_R = (D / 64) * (NE / 32), I_G = (128 / 64) * (DA / 32);
        for (int it = gw; it < I_IN + I_OUT + I_R + I_G; it += NGW) {
            int r = it;
            if (r < I_IN) {
                const int kb = r / 124, nb = r % 124, k0 = 64 * kb, n0 = 32 * nb; const float* W = A.in[I_WIN];
#pragma unroll 8
                for (int i = 0; i < 32; ++i) { const int kk = 2 * i + (C.lane >> 5); scr[kk * 33 + (C.lane & 31)] = W[(size_t)(k0 + kk) * IN_COLS + n0 + (C.lane & 31)]; }
                asm volatile("s_waitcnt lgkmcnt(0)" ::: "memory");
                const int c = C.lane & 7;
#pragma unroll
                for (int j = 0; j < 4; ++j) { const int n = (C.lane >> 3) + 8 * j; const lfloat* s = scr + (8 * c) * 33 + n;
                    u32x4 o; o.x = pk2(s[0 * 33], s[1 * 33]); o.y = pk2(s[2 * 33], s[3 * 33]); o.z = pk2(s[4 * 33], s[5 * 33]); o.w = pk2(s[6 * 33], s[7 * 33]);
                    *(u32x4*)(btin + (size_t)(n0 + n) * D + k0 + 8 * c) = o; }
                asm volatile("s_waitcnt lgkmcnt(0)" ::: "memory");
                continue; }
            r -= I_IN;
            if (r < I_OUT) { transpose_item(A.in[I_WOUT], D, D, btout, RowId(), scr, r, C.lane); continue; } r -= I_OUT;
            if (r < I_R) { transpose_item(A.in[I_RW], D, NE, btr, RowId(), scr, r, C.lane); continue; } r -= I_R;
            transpose_item(A.in[I_GUP], 128, DA, WSP(bf16_t, WS_GUPT), RowId(), scr, r, C.lane);
        }
        for (int i = C.bid * 512 + C.tid; i < 16 * D; i += C.G * 512) { const int n = 3968 + (i >> 10), k = i & 1023; btin[(size_t)n * D + k] = (bf16_t)f2bf(A.in[I_WIN][(size_t)k * IN_COLS + n]); }
        for (int i = C.bid * 512 + C.tid; i < (PLD - IN_COLS) * D / 8; i += C.G * 512) ((u32x4*)(btin + (size_t)IN_COLS * D))[i] = (u32x4){0u, 0u, 0u, 0u};
    }
}

__device__ __forceinline__ void phase_p1(const Args& A, Ctx& C) {
    const float* mod = WSP(float, WS_MOD); bf16_t* xn = WSP(bf16_t, WS_XN);
    const int gw = C.bid * 8 + C.wave, NGW = C.G * 8;
    for (int row = gw; row < NROWS; row += NGW) {
        const float* xr; int mb;
        if (row < NLAT) { xr = A.in[I_X] + (size_t)row * D; mb = row >> 11; } else { xr = A.in[I_CTX] + (size_t)(row - NLAT) * D; mb = 32; }
        const float* m = mod + (size_t)mb * MODW;
        norm_mod_row(xr, A.in[I_N1G], m + D, m, xn + (size_t)row * D, C.lane);
    }
}

template <int NK>
__device__ __forceinline__ f32x4 mm_tile(const lbyte* Ap, int lda, const lbyte* Bp, int ldb, f32x4 acc, int lane) {
    const int r = lane & 15, g = lane >> 4;
#pragma unroll
    for (int ks = 0; ks < NK; ++ks) {
        const bf16x8 a = *(const LAS bf16x8*)(Ap + r * lda + ks * 64 + g * 16);
        const bf16x8 b = *(const LAS bf16x8*)(Bp + r * ldb + ks * 64 + g * 16);
        acc = __builtin_amdgcn_mfma_f32_16x16x32_bf16(a, b, acc, 0, 0, 0);
    }
    return acc;
}

__device__ __forceinline__ void st_bf16x4(lbyte* p, f32x4 v) { u32x2 w; w.x = cvtpk(v.x, v.y); w.y = cvtpk(v.z, v.w); *(LAS u32x2*)p = w; }
__device__ __forceinline__ void st_bf16(lbyte* p, float v) { *(LAS unsigned short*)p = (unsigned short)cvtpk(v, v); }
__device__ __forceinline__ float rdlane(float v, int l) { return __builtin_bit_cast(float, __builtin_amdgcn_readlane(__builtin_bit_cast(int, v), l)); }

__device__ __forceinline__ void tri_inv16(const f32x4 m, int lane, float (&X)[16]) {
#pragma unroll
    for (int i = 0; i < 16; ++i) {
        float x0 = (lane == i) ? 1.f : 0.f, x1 = 0.f;
#pragma unroll
        for (int k = 0; k < i; ++k) { const float t = rdlane(m[k & 3], i + 16 * (k >> 2)) * X[k]; if (k & 1) x1 -= t; else x0 -= t; }
        X[i] = x0 + x1;
    }
}

namespace rk {
constexpr int S64 = 160, S32 = 80, SW = 144;
constexpr int O_WUP = 0, O_AUP = O_WUP + 64 * SW, O_WLT = O_AUP + 64 * SW, O_ALT = O_WLT + 16 * S64, O_LW = O_ALT + 16 * S64, O_LA = O_LW + 4096,
              O_KKT = O_LA + 4096, O_RT = O_KKT + 16 * S64, O_BT = O_RT + 16 * S64, O_KDT = O_BT + 16 * S64,
              O_VT = O_KDT + 16 * S64, O_BHT = O_VT + 64 * S32, O_KHT = O_BHT + 64 * S32, O_UT = O_KHT + 64 * S32, O_UTT = O_WLT  ,
              O_TI = O_UT + 64 * S32, O_MK = O_TI + 16 * S32, O_NB = O_MK + 16 * S32, O_NK = O_NB + 16 * S32,
              O_SBF = O_NK + 16 * S32, O_WC = O_SBF + 64 * S64, TEAM_BYTES = O_WC + 256;
static_assert(2 * TEAM_BYTES <= LDS_MISC, "rwkv LDS");
}
__device__ __forceinline__ void rwkv_pair_chunked(const Args& A, Ctx& C, int pair) {
    using namespace rk;
    const int b = pair >> 3, h = pair & 7;
    const int dir = C.wave >> 2;
    const int t4 = C.tid & 255, q = C.wave & 3, lane = C.lane;
    lbyte* L = C.lds + dir * TEAM_BYTES;
    const bf16_t* P = WSP(bf16_t, WS_P);
    bf16_t* ydir = WSP(bf16_t, WS_YDIR) + (size_t)dir * NLAT * D;
    float* bon = WSP(float, WS_BON) + (size_t)dir * NLAT * 8;
    __syncthreads();
#pragma unroll 2
    for (int i = t4; i < 4096; i += 256) { const int l = i >> 6, c = i & 63;
        st_bf16(L + O_WUP + c * SW + l * 2, A.in[I_WUP][((size_t)dir * 64 + l) * DA + 64 * h + c]);
        st_bf16(L + O_AUP + c * SW + l * 2, A.in[I_AUP][((size_t)dir * 64 + l) * DA + 64 * h + c]); }
#pragma unroll 2
    for (int i = t4; i < (4 * 64 * S32 + 4 * 16 * S32 + 64 * S64) / 4; i += 256) ((LAS unsigned*)(L + O_VT))[i] = 0u;
    for (int i = t4; i < (2 * 16 * S64) / 4; i += 256) ((LAS unsigned*)(L + O_WLT))[i] = 0u;
    const int c = lane;
    int col5[5] = {64 * h + c, 512 + 64 * h + c, 1024 + 64 * h + c, 1536 + 64 * dir + c, 1664 + 64 * dir + c};
    float mu5[5]; int dl5[5], cl5[5], dc5[5], cc5[5];
#pragma unroll
    for (int e = 0; e < 5; ++e) { const int col = col5[e]; mu5[e] = A.in[I_MU][col];
        cl5[e] = col < 480 ? 0 : (col < 960 ? 1 : (col < 1440 ? 2 : 3)); dl5[e] = (cl5[e] == 0 ? -PLD : (cl5[e] == 1 ? PLD : (cl5[e] == 2 ? -64 * PLD : 64 * PLD)));
        cc5[e] = col < 960 ? 0 : 1; dc5[e] = col < 960 ? -PLD : PLD; }
    const float kkc = A.in[I_KK][64 * h + c], kac = A.in[I_KA][64 * h + c], rkc = A.in[I_RK][64 * h + c];
    const float w0c = A.in[I_W0][dir * DA + 64 * h + c], a0c = A.in[I_A0][dir * DA + 64 * h + c];
    f32x4 Sacc[4];
#pragma unroll
    for (int i = 0; i < 4; ++i) Sacc[i] = (f32x4){0.f, 0.f, 0.f, 0.f};
    const int fr = lane & 15, fg = lane >> 4;
    unsigned short rawp[4][5], raws[4][5];
    auto chunk_geom = [&](int ch, bool& isctx, int& sbase, int& T, size_t& rowbase) { isctx = ch < 16; sbase = isctx ? ch * 16 : (ch - 16) * 16; T = isctx ? CTX : SEQ; rowbase = isctx ? (size_t)NLAT + (size_t)b * CTX : (size_t)b * SEQ; };
    auto okmask = [&](bool isctx, int t) -> int { return isctx ? ((t >= 1 ? 1 : 0) | (t <= CTX - 2 ? 2 : 0)) : (((t & 63) >= 1 ? 1 : 0) | ((t & 63) <= 62 ? 2 : 0) | (t >= 64 ? 4 : 0) | (t < SEQ - 64 ? 8 : 0)); };
    auto issue_loads = [&](int ch) { bool isctx; int sbase, T; size_t rowbase; chunk_geom(ch, isctx, sbase, T, rowbase);
#pragma unroll
        for (int j = 0; j < 4; ++j) { const int i = q + 4 * j; const int t = __builtin_amdgcn_readfirstlane(dir ? (T - 1 - (sbase + i)) : (sbase + i));
            const bf16_t* pr = P + (rowbase + t) * PLD; const int okm = okmask(isctx, t);
#pragma unroll
            for (int e = 0; e < 5; ++e) { const int cls = isctx ? cc5[e] : cl5[e]; const bool ok = (okm >> cls) & 1; const int off = col5[e] + (ok ? (isctx ? dc5[e] : dl5[e]) : 0);
                rawp[j][e] = pr[col5[e]]; raws[j][e] = pr[off]; } } };
    issue_loads(0);
    for (int ch = 0; ch < 144; ++ch) {
        bool isctx; int sbase, T; size_t rowbase; chunk_geom(ch, isctx, sbase, T, rowbase);
        float vr[4], vk[4], vv[4], vkk[4], lw[4], av[4];
        __syncthreads();
        float mxa[4][5];
#pragma unroll
        for (int j = 0; j < 4; ++j) { const int i = q + 4 * j; const int t = __builtin_amdgcn_readfirstlane(dir ? (T - 1 - (sbase + i)) : (sbase + i)); const int okm = okmask(isctx, t);
#pragma unroll
            for (int e = 0; e < 5; ++e) { const int cls = isctx ? cc5[e] : cl5[e]; const bool ok = (okm >> cls) & 1;
                const float pv = bf2f(rawp[j][e]); const float sv = bf2f(raws[j][e]); mxa[j][e] = pv + mu5[e] * ((ok ? sv : 0.f) - pv); } }
        if (ch + 1 < 144) issue_loads(ch + 1);
#pragma unroll
        for (int j = 0; j < 4; ++j) {
            const int i = q + 4 * j;
            float mx[5];
#pragma unroll
            for (int e = 0; e < 5; ++e) mx[e] = mxa[j][e];
            vr[j] = mx[0]; vk[j] = mx[1]; vv[j] = mx[2];
            *(LAS unsigned short*)(L + O_WLT + i * S64 + c * 2) = (unsigned short)cvtpk(tanhf_(mx[3]), 0.f); *(LAS unsigned short*)(L + O_ALT + i * S64 + c * 2) = (unsigned short)cvtpk(mx[4], 0.f);
            const float kx = vk[j] * kkc; const float ss = wave_sum(kx * kx);
            vkk[j] = kx * __builtin_amdgcn_rsqf(ss + 1e-6f);
        }
        __syncthreads();
        {
            const f32x4 z = (f32x4){0.f, 0.f, 0.f, 0.f};
            const f32x4 tw = mm_tile<2>(L + O_WLT, S64, L + O_WUP + 16 * q * SW, SW, z, lane);
            const f32x4 ta = mm_tile<2>(L + O_ALT, S64, L + O_AUP + 16 * q * SW, SW, z, lane);
#pragma unroll
            for (int e = 0; e < 4; ++e) { ((LAS float*)(L + O_LW))[(4 * fg + e) * 64 + 16 * q + fr] = tw[e]; ((LAS float*)(L + O_LA))[(4 * fg + e) * 64 + 16 * q + fr] = ta[e]; }
        }
        __syncthreads();
#pragma unroll
        for (int j = 0; j < 4; ++j) { const int i = q + 4 * j;
            const float wlog = -softplusf_(-(w0c + ((LAS float*)(L + O_LW))[i * 64 + c])) - 0.5f;
            lw[j] = -__expf(wlog);
            av[j] = sigmoidf_(a0c + ((LAS float*)(L + O_LA))[i * 64 + c]);
            ((LAS float*)(L + O_LW))[i * 64 + c] = lw[j]; }
        __syncthreads();
        if (t4 < 64) { float cum = 0.f;
#pragma unroll
            for (int t = 0; t < 16; ++t) { cum += ((LAS float*)(L + O_LW))[t * 64 + c]; ((LAS float*)(L + O_LW))[t * 64 + c] = cum; } }
        __syncthreads();
        {
            const float cumC = ((LAS float*)(L + O_LW))[15 * 64 + c];
#pragma unroll
            for (int j = 0; j < 4; ++j) { const int i = q + 4 * j;
                const float cum = ((LAS float*)(L + O_LW))[i * 64 + c];
                const float Wt = __expf(cum), Wp = __expf(cum - lw[j]), Wi = __expf(-cum), Wc = __expf(cumC - cum);
                const float kd = vk[j] * (1.f + (av[j] - 1.f) * kac), bb = vkk[j] * av[j];
                const unsigned p0 = cvtpk(vkk[j] * Wp, vr[j] * Wt), p1 = cvtpk(bb * Wi, kd * Wi), p2 = cvtpk(vv[j], bb * Wc), p3 = cvtpk(kd * Wc, 0.f);
                *(LAS unsigned short*)(L + O_KKT + i * S64 + c * 2) = (unsigned short)p0; *(LAS unsigned short*)(L + O_RT + i * S64 + c * 2) = (unsigned short)(p0 >> 16);
                *(LAS unsigned short*)(L + O_BT + i * S64 + c * 2) = (unsigned short)p1; *(LAS unsigned short*)(L + O_KDT + i * S64 + c * 2) = (unsigned short)(p1 >> 16);
                *(LAS unsigned short*)(L + O_VT + c * S32 + i * 2) = (unsigned short)p2; *(LAS unsigned short*)(L + O_BHT + c * S32 + i * 2) = (unsigned short)(p2 >> 16);
                *(LAS unsigned short*)(L + O_KHT + c * S32 + i * 2) = (unsigned short)p3;
                const float bs = wave_sum(vr[j] * kd * rkc);
                if (!isctx && lane == 0) { const int t = dir ? (T - 1 - (sbase + i)) : (sbase + i); bon[((size_t)b * SEQ + t) * 8 + h] = bs; }
            }
            if (q == 3) ((LAS float*)(L + O_WC))[c] = __expf(cumC);
        }
        __syncthreads();
        {
            const lbyte* Aj = L + ((q & 1) ? O_KDT : O_BT);
            const lbyte* Bt = L + ((q & 2) ? O_RT : O_KKT);
            f32x4 g4 = mm_tile<2>(Aj, S64, Bt, S64, (f32x4){0.f, 0.f, 0.f, 0.f}, lane);
#pragma unroll
            for (int e = 0; e < 4; ++e) { const int j = 4 * fg + e; const bool keep = (q & 2) ? (j <= fr) : (j < fr); g4[e] = keep ? g4[e] : 0.f; }
            if (q == 0) { float X[16]; tri_inv16(g4, lane, X);
                if (lane < 16) {
#pragma unroll
                    for (int i = 0; i < 16; ++i) *(LAS unsigned short*)(L + O_TI + i * S32 + lane * 2) = (unsigned short)cvtpk(X[i], 0.f); } }
            else st_bf16x4(L + (q == 1 ? O_MK : (q == 2 ? O_NB : O_NK)) + fr * S32 + fg * 8, g4);
        }
        __syncthreads();
        f32x4 yacc;
        {
            f32x4 u4 = mm_tile<2>(L + O_KKT, S64, L + O_SBF + 16 * q * S64, S64, (f32x4){0.f, 0.f, 0.f, 0.f}, lane);
            u4 = mm_tile<1>(L + O_MK, S32, L + O_VT + 16 * q * S32, S32, u4, lane);
            st_bf16x4(L + O_UTT + (16 * q + fr) * S32 + fg * 8, u4);
            yacc = mm_tile<2>(L + O_SBF + 16 * q * S64, S64, L + O_RT, S64, (f32x4){0.f, 0.f, 0.f, 0.f}, lane);
            yacc = mm_tile<1>(L + O_VT + 16 * q * S32, S32, L + O_NK, S32, yacc, lane);
        }
        asm volatile("s_waitcnt lgkmcnt(0)" ::: "memory");
        {
            f32x4 u4 = mm_tile<1>(L + O_TI, S32, L + O_UTT + 16 * q * S32, S32, (f32x4){0.f, 0.f, 0.f, 0.f}, lane);
            st_bf16x4(L + O_UT + (16 * q + fr) * S32 + fg * 8, -u4);
        }
        __syncthreads();
        {
            yacc = mm_tile<1>(L + O_UT + 16 * q * S32, S32, L + O_NB, S32, yacc, lane);
            if (!isctx) { const int t = dir ? (T - 1 - (sbase + fr)) : (sbase + fr);
                u32x2 w; w.x = cvtpk(yacc[0], yacc[1]); w.y = cvtpk(yacc[2], yacc[3]);
                *(u32x2*)(ydir + ((size_t)b * SEQ + t) * D + 64 * h + 16 * q + 4 * fg) = w; }
            const f32x4 wc4 = *(LAS f32x4*)(L + O_WC + (16 * q + 4 * fg) * 4);
#pragma unroll
            for (int vi = 0; vi < 4; ++vi) {
                f32x4 s4 = Sacc[vi] * wc4;
                s4 = mm_tile<1>(L + O_KHT + 16 * q * S32, S32, L + O_VT + 16 * vi * S32, S32, s4, lane);
                s4 = mm_tile<1>(L + O_BHT + 16 * q * S32, S32, L + O_UT + 16 * vi * S32, S32, s4, lane);
                Sacc[vi] = s4;
                st_bf16x4(L + O_SBF + (16 * vi + fr) * S64 + (16 * q + 4 * fg) * 2, s4);
            }
        }
    }
    __syncthreads();
}

__device__ __forceinline__ void phase_gdn_prep(const Args& A, Ctx& C) {
    const bf16_t* P = WSP(bf16_t, WS_P);
    bf16_t* QKV = (bf16_t*)A.out; float* NRM = WSP(float, WS_NRM);
    lfloat* part = (lfloat*)C.lds;
    const int tid = C.tid, lane = C.lane, w = C.wave;
    float cw[3][5];
#pragma unroll
    for (int g = 0; g < 3; ++g)
#pragma unroll
        for (int e = 0; e < 5; ++e) cw[g][e] = A.in[I_CONVW][e * 1536 + g * 512 + tid];
    for (int tile = C.bid; tile < NROWS / 16; tile += C.G) {
        const int row0 = tile * 16;
        int T, ta; size_t rowbase;
        if (row0 < NLAT) { T = SEQ; rowbase = (size_t)(row0 >> 11) * SEQ; ta = row0 & (SEQ - 1); } else { T = CTX; const int r = row0 - NLAT; rowbase = (size_t)NLAT + (size_t)(r >> 8) * CTX; ta = r & (CTX - 1); }
        float x[3][20];
#pragma unroll
        for (int e = 0; e < 20; ++e) { const int t = ta - 2 + e; const bool ok = (t >= 0 && t < T); const bf16_t* pr = P + (rowbase + (ok ? t : ta)) * PLD + RW_COLS + tid;
#pragma unroll
            for (int g = 0; g < 3; ++g) { const float xv = bf2f(pr[g * 512]); x[g][e] = ok ? xv : 0.f; } }
        __syncthreads();
#pragma unroll
        for (int i = 0; i < 16; ++i) { float y[3];
#pragma unroll
            for (int g = 0; g < 3; ++g) { float sacc = 0.f;
#pragma unroll
                for (int f = 0; f < 5; ++f) sacc += cw[g][f] * x[g][i + f];
                y[g] = siluf_(sacc); }
            bf16_t* orow = QKV + (rowbase + ta + i) * 1536 + tid;
            orow[0] = (bf16_t)cvtpk(y[0], 0.f); orow[512] = (bf16_t)cvtpk(y[1], 0.f); orow[1024] = (bf16_t)cvtpk(y[2], 0.f);
            const float sq = wave_sum(y[0] * y[0]), sk = wave_sum(y[1] * y[1]);
            if (lane == 0) { part[(i * 8 + w) * 2] = sq; part[(i * 8 + w) * 2 + 1] = sk; } }
        __syncthreads();
        if (tid < 128) { const int i = tid >> 3, sidx = tid & 7, h = sidx & 3, sel = sidx >> 2;
            const float ss = part[(i * 8 + 2 * h) * 2 + sel] + part[(i * 8 + 2 * h + 1) * 2 + sel];
            NRM[(rowbase + ta + i) * 8 + sidx] = __builtin_amdgcn_rsqf(ss + 1e-6f) * (sel ? 1.f : 0.08838834764831845f); }
    }
    __syncthreads();
}

namespace gd {
constexpr int S128 = 288, S32 = 80;
constexpr int O_QR = 0, O_KR = O_QR + 8192, O_KT = O_KR + 8192, O_QT = O_KT + 16 * S128, O_KKT = O_QT + 16 * S128, O_RT = O_KKT + 16 * S128,
              O_VT = O_RT + 16 * S128, O_BHT = O_VT + 128 * S32, O_KHT = O_BHT + 128 * S32, O_UT = O_KHT + 128 * S32, O_UTT = O_UT + 128 * S32,
              O_TI = O_UTT + 128 * S32, O_MK = O_TI + 16 * S32, O_NB = O_MK + 16 * S32, O_NK = O_NB + 16 * S32,
              O_SBF = O_NK + 16 * S32, O_SC = O_SBF + 128 * S128, GD_BYTES = O_SC + 512;
static_assert(GD_BYTES <= LDS_MISC, "gdn LDS");
}
__device__ __forceinline__ void gdn_chain_chunked(const Args& A, Ctx& C, int chain) {
    using namespace gd;
    const int b = chain >> 3, h = (chain >> 1) & 3, dir = chain & 1;
    lbyte* L = C.lds;
    LAS float* SC = (LAS float*)(L + O_SC);
    const bf16_t* P = WSP(bf16_t, WS_P);
    bf16_t* ydir = WSP(bf16_t, WS_YDIR) + (size_t)dir * NLAT * D;
    const int tid = C.tid, lane = C.lane, w = C.wave, fr = lane & 15, fg = lane >> 4;
    const int grp = tid >> 7, idx = tid & 127;
    const int ccol = grp * 512 + 128 * h + idx;
    float cw[5];
#pragma unroll
    for (int e = 0; e < 5; ++e) cw[e] = grp < 3 ? A.in[I_CONVW][e * 1536 + ccol] : 0.f;
    const float Aexp = __expf(A.in[I_ALOG][dir * 4 + h]), dtb = A.in[I_DTB][dir * 4 + h];
    __syncthreads();
#pragma unroll 2
    for (int i = tid; i < (5 * 128 * S32 + 4 * 16 * S32 + 128 * S128) / 4; i += 512) ((LAS unsigned*)(L + O_VT))[i] = 0u;
    f32x4 Sacc[8];
#pragma unroll
    for (int i = 0; i < 8; ++i) Sacc[i] = (f32x4){0.f, 0.f, 0.f, 0.f};
    const bf16_t* QKV = (const bf16_t*)A.out; const float* NRM = WSP(const float, WS_NRM);
    unsigned short rq[4], rk[4], rv[4]; float nq[4], nk[4]; unsigned short raw_al = 0, raw_be = 0;
    auto chunk_geom = [&](int ch, bool& isctx, int& sbase, int& T, size_t& rowbase) { isctx = ch < 16; sbase = isctx ? ch * 16 : (ch - 16) * 16; T = isctx ? CTX : SEQ;
        rowbase = isctx ? (size_t)NLAT + (size_t)b * CTX : (size_t)b * SEQ; };
    auto issue_loads = [&](int ch) { bool isctx; int sbase, T; size_t rowbase; chunk_geom(ch, isctx, sbase, T, rowbase);
#pragma unroll
        for (int j = 0; j < 4; ++j) { const int i = grp + 4 * j; const int t = dir ? (T - 1 - (sbase + i)) : (sbase + i); const size_t row = rowbase + t;
            const bf16_t* qr = QKV + row * 1536 + 128 * h + idx; rq[j] = qr[0]; rk[j] = qr[512]; rv[j] = qr[1024]; nq[j] = NRM[row * 8 + h]; nk[j] = NRM[row * 8 + 4 + h]; }
        if (w == 7 && lane < 16) { const int t = dir ? (T - 1 - (sbase + lane)) : (sbase + lane); const bf16_t* pr = P + (rowbase + t) * PLD + RW_COLS + 2048; raw_al = pr[dir * 4 + h]; raw_be = pr[8 + dir * 4 + h]; } };
    issue_loads(0);
    for (int ch = 0; ch < 144; ++ch) {
        bool isctx; int sbase, T; size_t rowbase; chunk_geom(ch, isctx, sbase, T, rowbase);
        __syncthreads();
        float qv[4], kv[4], vv[4], nqv[4], nkv[4];
#pragma unroll
        for (int j = 0; j < 4; ++j) { qv[j] = bf2f(rq[j]); kv[j] = bf2f(rk[j]); vv[j] = bf2f(rv[j]); nqv[j] = nq[j]; nkv[j] = nk[j]; }
        if (w == 7) {
            const float gi = (lane < 16) ? -Aexp * softplusf_(bf2f(raw_al) + dtb) : 0.f;
            float cum = gi;
            cum += __builtin_bit_cast(float, __builtin_amdgcn_update_dpp(0, __builtin_bit_cast(int, cum), 0x111, 0xf, 0xf, true));
            cum += __builtin_bit_cast(float, __builtin_amdgcn_update_dpp(0, __builtin_bit_cast(int, cum), 0x112, 0xf, 0xf, true));
            cum += __builtin_bit_cast(float, __builtin_amdgcn_update_dpp(0, __builtin_bit_cast(int, cum), 0x114, 0xf, 0xf, true));
            cum += __builtin_bit_cast(float, __builtin_amdgcn_update_dpp(0, __builtin_bit_cast(int, cum), 0x118, 0xf, 0xf, true));
            if (lane < 16) { SC[16 + lane] = sigmoidf_(bf2f(raw_be)); SC[64 + lane + 1] = cum; if (lane == 0) SC[64] = 0.f; }
        }
        if (ch + 1 < 144) issue_loads(ch + 1);
        __syncthreads();
        {
            const int c = idx; const float gcC = SC[64 + 16];
#pragma unroll
            for (int j = 0; j < 4; ++j) { const int i = grp + 4 * j;
                const float kn = kv[j] * nkv[j], qn = qv[j] * nqv[j];
                const float gm = SC[64 + i], gi = SC[64 + i + 1], be = SC[16 + i];
                const unsigned p0 = cvtpk(kn, qn), p1 = cvtpk(kn * __expf(gm), qn * __expf(gi)), p2 = cvtpk(be * kn * __expf(gcC - gm), be * kn * __expf(gcC - gi));
                *(LAS unsigned short*)(L + O_KT + i * S128 + c * 2) = (unsigned short)p0; *(LAS unsigned short*)(L + O_QT + i * S128 + c * 2) = (unsigned short)(p0 >> 16);
                *(LAS unsigned short*)(L + O_KKT + i * S128 + c * 2) = (unsigned short)p1; *(LAS unsigned short*)(L + O_RT + i * S128 + c * 2) = (unsigned short)(p1 >> 16);
                *(LAS unsigned short*)(L + O_BHT + c * S32 + i * 2) = (unsigned short)p2; *(LAS unsigned short*)(L + O_KHT + c * S32 + i * 2) = (unsigned short)(p2 >> 16);
                *(LAS unsigned short*)(L + O_VT + c * S32 + i * 2) = (unsigned short)cvtpk(vv[j], 0.f); }
        }
        __syncthreads();
        if (w < 2) {
            const f32x4 g4 = mm_tile<4>(L + O_KT, S128, L + (w ? O_QT : O_KT), S128, (f32x4){0.f, 0.f, 0.f, 0.f}, lane);
            const float gt = w ? SC[64 + fr + 1] : SC[64 + fr];
            f32x4 m0, m1;
#pragma unroll
            for (int e = 0; e < 4; ++e) { const int j = 4 * fg + e; const bool keep = w ? (j <= fr) : (j < fr);
                const float bj = SC[16 + j] * g4[e];
                m0[e] = keep ? bj * __expf(gt - SC[64 + j]) : 0.f;
                m1[e] = keep ? bj * __expf(gt - SC[64 + j + 1]) : 0.f; }
            if (w == 0) { st_bf16x4(L + O_MK + fr * S32 + fg * 8, m1);
                float X[16]; tri_inv16(m0, lane, X);
                if (lane < 16) {
#pragma unroll
                    for (int i = 0; i < 16; ++i) *(LAS unsigned short*)(L + O_TI + i * S32 + lane * 2) = (unsigned short)cvtpk(X[i], 0.f); } }
            else { st_bf16x4(L + O_NB + fr * S32 + fg * 8, m0); st_bf16x4(L + O_NK + fr * S32 + fg * 8, m1); }
        }
        __syncthreads();
        f32x4 yacc;
        {
            f32x4 u4 = mm_tile<4>(L + O_KKT, S128, L + O_SBF + 16 * w * S128, S128, (f32x4){0.f, 0.f, 0.f, 0.f}, lane);
            u4 = mm_tile<1>(L + O_MK, S32, L + O_VT + 16 * w * S32, S32, u4, lane);
            st_bf16x4(L + O_UTT + (16 * w + fr) * S32 + fg * 8, u4);
            yacc = mm_tile<4>(L + O_SBF + 16 * w * S128, S128, L + O_RT, S128, (f32x4){0.f, 0.f, 0.f, 0.f}, lane);
            yacc = mm_tile<1>(L + O_VT + 16 * w * S32, S32, L + O_NK, S32, yacc, lane);
        }
        asm volatile("s_waitcnt lgkmcnt(0)" ::: "memory");
        {
            const f32x4 u4 = mm_tile<1>(L + O_TI, S32, L + O_UTT + 16 * w * S32, S32, (f32x4){0.f, 0.f, 0.f, 0.f}, lane);
            st_bf16x4(L + O_UT + (16 * w + fr) * S32 + fg * 8, -u4);
        }
        __syncthreads();
        {
            yacc = mm_tile<1>(L + O_UT + 16 * w * S32, S32, L + O_NB, S32, yacc, lane);
            if (!isctx) { const int t = dir ? (T - 1 - (sbase + fr)) : (sbase + fr);
                u32x2 pk; pk.x = cvtpk(yacc[0], yacc[1]); pk.y = cvtpk(yacc[2], yacc[3]);
                *(u32x2*)(ydir + ((size_t)b * SEQ + t) * D + 512 + 128 * h + 16 * w + 4 * fg) = pk; }
            const float wc = __expf(SC[64 + 16]);
#pragma unroll
            for (int vi = 0; vi < 8; ++vi) {
                f32x4 s4 = Sacc[vi] * wc;
                s4 = mm_tile<1>(L + O_KHT + 16 * w * S32, S32, L + O_VT + 16 * vi * S32, S32, s4, lane);
                s4 = mm_tile<1>(L + O_BHT + 16 * w * S32, S32, L + O_UT + 16 * vi * S32, S32, s4, lane);
                Sacc[vi] = s4;
                st_bf16x4(L + O_SBF + (16 * vi + fr) * S128 + (16 * w + 4 * fg) * 2, s4);
            }
        }
    }
    __syncthreads();
}

__device__ __forceinline__ void unpack8(const u32x4 w, float (&f)[8]) { f[0] = bflo(w.x); f[1] = bfhi(w.x); f[2] = bflo(w.y); f[3] = bfhi(w.y); f[4] = bflo(w.z); f[5] = bfhi(w.z); f[6] = bflo(w.w); f[7] = bfhi(w.w); }
__device__ __forceinline__ void phase_p4(const Args& A, Ctx& C) {
    const bf16_t* P = WSP(bf16_t, WS_P);
    const bf16_t* yf = WSP(bf16_t, WS_YDIR); const bf16_t* yb = yf + (size_t)NLAT * D;
    const float* bon = WSP(float, WS_BON);
    bf16_t* ymix = WSP(bf16_t, WS_YMIX);
    lbyte* SGb = C.lds;
    lfloat* GO = (lfloat*)(C.lds + 8192);
    const int tid = C.tid, lane = C.lane, w = C.wave;
    const bf16_t* gupt = WSP(const bf16_t, WS_GUPT);
    const int fr = lane & 15, fg = lane >> 4;
    const int c8 = 8 * lane;
    float lnw[8], lnb[8], ong[8], muv[8];
#pragma unroll
    for (int e = 0; e < 8; ++e) { lnw[e] = A.in[I_LNW][c8 + e]; lnb[e] = A.in[I_LNB][c8 + e]; ong[e] = A.in[I_ONG][(c8 + e) & 127]; muv[e] = A.in[I_MU][1024 + c8 + e]; }
    const int tkA = tid >> 5, lA = 4 * (tid & 31);
    float muA[4];
#pragma unroll
    for (int e = 0; e < 4; ++e) muA[e] = A.in[I_MU][1792 + lA + e];
    const bool vup = (1024 + c8) < 1440;
    for (int tile = C.bid; tile < NLAT / 16; tile += C.G) {
        const int row0 = tile * 16;
        __syncthreads();
        {
            const int row = row0 + tkA, t = row & (SEQ - 1); const bool ok = t < SEQ - 64;
            const u32x2 pw = *(const u32x2*)(P + (size_t)row * PLD + 1792 + lA); const u32x2 sw = *(const u32x2*)(P + (size_t)(row + (ok ? 64 : 0)) * PLD + 1792 + lA);
            const float pv[4] = {bflo(pw.x), bfhi(pw.x), bflo(pw.y), bfhi(pw.y)}; const float sv[4] = {bflo(sw.x), bfhi(sw.x), bflo(sw.y), bfhi(sw.y)};
            float o[4];
#pragma unroll
            for (int e = 0; e < 4; ++e) o[e] = sigmoidf_(pv[e] + muA[e] * ((ok ? sv[e] : 0.f) - pv[e]));
            u32x2 ow; ow.x = cvtpk(o[0], o[1]); ow.y = cvtpk(o[2], o[3]); *(LAS u32x2*)(SGb + tkA * 288 + lA * 2) = ow;
        }
        __syncthreads();
#pragma unroll
        for (int i = 0; i < 4; ++i) { const int c0 = 64 * w + 16 * i; f32x4 acc = (f32x4){0.f, 0.f, 0.f, 0.f};
#pragma unroll
            for (int ks = 0; ks < 4; ++ks) { const bf16x8 a = *(const LAS bf16x8*)(SGb + fr * 288 + ks * 64 + fg * 16);
                const bf16x8 bq = *(const bf16x8*)(gupt + (size_t)(c0 + fr) * 128 + ks * 32 + fg * 8);
                acc = __builtin_amdgcn_mfma_f32_16x16x32_bf16(a, bq, acc, 0, 0, 0); }
#pragma unroll
            for (int e = 0; e < 4; ++e) GO[(4 * fg + e) * 512 + c0 + fr] = acc[e]; }
        __syncthreads();
#pragma unroll
        for (int tt = 0; tt < 2; ++tt) {
            const int tk = 2 * w + tt, row = row0 + tk, t = row & (SEQ - 1);
            const bool okv = vup ? (t >= 64) : (t < SEQ - 64);
            const u32x4 wyf = *(const u32x4*)(yf + (size_t)row * D + c8), wyb = *(const u32x4*)(yb + (size_t)row * D + c8);
            const u32x4 wpv = *(const u32x4*)(P + (size_t)row * PLD + 1024 + c8), wsv = *(const u32x4*)(P + (size_t)(row + (okv ? (vup ? -64 : 64) : 0)) * PLD + 1024 + c8);
            const u32x4 wof = *(const u32x4*)(yf + (size_t)row * D + 512 + c8), wob = *(const u32x4*)(yb + (size_t)row * D + 512 + c8);
            const u32x4 wz = *(const u32x4*)(P + (size_t)row * PLD + RW_COLS + 1536 + c8);
            const float bs = bon[(size_t)row * 8 + (lane >> 3)] + bon[((size_t)NLAT + row) * 8 + (lane >> 3)];
            const f32x4 g0 = *(const LAS f32x4*)(GO + tk * 512 + c8), g1 = *(const LAS f32x4*)(GO + tk * 512 + c8 + 4);
            const float gg[8] = {g0.x, g0.y, g0.z, g0.w, g1.x, g1.y, g1.z, g1.w};
            float a[8], bq[8], pv[8], sv[8], y[8];
            unpack8(wyf, a); unpack8(wyb, bq); unpack8(wpv, pv); unpack8(wsv, sv);
            float s1 = 0.f;
#pragma unroll
            for (int e = 0; e < 8; ++e) { y[e] = a[e] + bq[e]; s1 += y[e]; }
            s1 += __shfl_xor(s1, 1); s1 += __shfl_xor(s1, 2); s1 += __shfl_xor(s1, 4);
            const float m = s1 * (1.f / 64.f);
            float s2 = 0.f;
#pragma unroll
            for (int e = 0; e < 8; ++e) { y[e] -= m; s2 += y[e] * y[e]; }
            s2 += __shfl_xor(s2, 1); s2 += __shfl_xor(s2, 2); s2 += __shfl_xor(s2, 4);
            const float rs = __builtin_amdgcn_rsqf(s2 * (1.f / 64.f) + RWKV_EPS);
            float o[8];
#pragma unroll
            for (int e = 0; e < 8; ++e) { const float vv = pv[e] + muv[e] * ((okv ? sv[e] : 0.f) - pv[e]); o[e] = (y[e] * rs * lnw[e] + lnb[e] + bs * vv) * gg[e]; }
            u32x4 ow; ow.x = cvtpk(o[0], o[1]); ow.y = cvtpk(o[2], o[3]); ow.z = cvtpk(o[4], o[5]); ow.w = cvtpk(o[6], o[7]);
            *(u32x4*)(ymix + (size_t)row * D + c8) = ow;
            float of[8], ob[8], z[8];
            unpack8(wof, of); unpack8(wob, ob); unpack8(wz, z);
            float s3 = 0.f;
#pragma unroll
            for (int e = 0; e < 8; ++e) { of[e] += ob[e]; s3 += of[e] * of[e]; }
            s3 += __shfl_xor(s3, 1); s3 += __shfl_xor(s3, 2); s3 += __shfl_xor(s3, 4); s3 += __shfl_xor(s3, 8);
            const float rg = __builtin_amdgcn_rsqf(s3 * (1.f / 128.f) + NORM_EPS);
#pragma unroll
            for (int e = 0; e < 8; ++e) o[e] = of[e] * rg * ong[e] * siluf_(z[e]);
            ow.x = cvtpk(o[0], o[1]); ow.y = cvtpk(o[2], o[3]); ow.z = cvtpk(o[4], o[5]); ow.w = cvtpk(o[6], o[7]);
            *(u32x4*)(ymix + (size_t)row * D + 512 + c8) = ow;
        }
    }
}

__device__ __forceinline__ void convert_experts(const Args& A, Ctx& C) {
    lfloat* scr = (lfloat*)(C.lds + C.wave * 16384);
    const int gw = C.bid * 8 + C.wave, NGW = C.G * 8;
    constexpr int I13 = (D / 64) * (DE / 32);
    constexpr int I2 = (DE / 64) * (D / 32);
    constexpr int PER = 2 * I13 + I2;
    for (int it = gw; it < 257 * PER; it += NGW) {
        const int e = it / PER; int r = it % PER;
        bf16_t* bt13 = (bf16_t*)(A.ws + WS_WEXP + (size_t)e * WEXP_STRIDE); bf16_t* bt2 = bt13 + 512 * 1024;
        const float* w1 = e < NE ? A.in[I_EW1] + (size_t)e * D * DE : A.in[I_SW1];
        const float* w3 = e < NE ? A.in[I_EW3] + (size_t)e * D * DE : A.in[I_SW3];
        const float* w2 = e < NE ? A.in[I_EW2] + (size_t)e * DE * D : A.in[I_SW2];
        if (r < I13) { transpose_item(w1, D, DE, bt13, RowGLU{0}, scr, r, C.lane); continue; } r -= I13;
        if (r < I13) { transpose_item(w3, D, DE, bt13, RowGLU{128}, scr, r, C.lane); continue; } r -= I13;
        transpose_item(w2, DE, D, bt2, RowId(), scr, r, C.lane);
    }
}

__device__ __forceinline__ void phase_p6(const Args& A, Ctx& C) {
    const float* mod = WSP(float, WS_MOD); bf16_t* h2n = WSP(bf16_t, WS_H2N);
    const int gw = C.bid * 8 + C.wave, NGW = C.G * 8;
    for (int row = gw; row < NLAT; row += NGW) {
        const float* m = mod + (size_t)(row >> 11) * MODW;
        norm_mod_row(A.out + (size_t)row * D, A.in[I_N2G], m + 4 * D, m + 3 * D, h2n + (size_t)row * D, C.lane);
    }
}

__device__ __forceinline__ void phase_p8(const Args& A, Ctx& C) {
    const float* logit = WSP(float, WS_LOGIT);
    int* tope = WSP(int, WS_TOPE); float* topw = WSP(float, WS_TOPW); int* pos = WSP(int, WS_POS);
    unsigned* cnt = WSP(unsigned, WS_CTL) + CW_CNT;
    const int gw = C.bid * 8 + C.wave, NGW = C.G * 8, lane = C.lane;
    const f32x4 rb = ((const f32x4*)A.in[I_RB])[lane];
    for (int tok = gw; tok < NLAT; tok += NGW) {
        const f32x4 lg = ((const f32x4*)(logit + (size_t)tok * NE))[lane];
        float s[4], sel[4];
#pragma unroll
        for (int i = 0; i < 4; ++i) { s[i] = sigmoidf_(lg[i]); sel[i] = s[i] + rb[i]; }
        float m1 = fmaxf(fmaxf(sel[0], sel[1]), fmaxf(sel[2], sel[3]));
        float m2;
        {
            float a = fmaxf(sel[0], sel[1]), bq = fminf(sel[0], sel[1]), cq = fmaxf(sel[2], sel[3]), dq = fminf(sel[2], sel[3]);
            m2 = fmaxf(fminf(a, cq), fmaxf(bq, dq)); }
#pragma unroll
        for (int o = 1; o < 8; o <<= 1) { const float o1 = __shfl_xor(m1, o), o2 = __shfl_xor(m2, o);
            const float n1 = fmaxf(m1, o1); const float n2 = fmaxf(fminf(m1, o1), fmaxf(m2, o2)); m1 = n1; m2 = n2; }
        const float gs = m1 + m2;
        const int grp = lane >> 3;
        int rank = 0;
#pragma unroll
        for (int gq = 0; gq < 8; ++gq) { const float og = __shfl(gs, gq * 8); rank += (og > gs || (og == gs && gq < grp)) ? 1 : 0; }
        const bool gsel = rank < 4;
        float cand[4];
#pragma unroll
        for (int i = 0; i < 4; ++i) cand[i] = gsel ? sel[i] : -INFINITY;
        int my_e = 0; float my_w = 0.f; float wsum = 0.f;
#pragma unroll
        for (int r = 0; r < 8; ++r) {
            float bv = cand[0]; int bi = 0;
#pragma unroll
            for (int i = 1; i < 4; ++i) if (cand[i] > bv) { bv = cand[i]; bi = i; }
            int be = lane * 4 + bi;
#define P8_STEP(CTRL) { const float ov = dpp_f<CTRL>(bv); const int oe = __builtin_amdgcn_update_dpp(0, be, CTRL, 0xf, 0xf, false); if (ov > bv || (ov == bv && oe < be)) { bv = ov; be = oe; } }
            P8_STEP(0x128) P8_STEP(0x124) P8_STEP(0x122) P8_STEP(0x121)
#undef P8_STEP
            float gv = rdlane(bv, 0); int ge = __builtin_amdgcn_readlane(be, 0);
#pragma unroll
            for (int rr = 1; rr < 4; ++rr) { const float ov = rdlane(bv, 16 * rr); const int oe = __builtin_amdgcn_readlane(be, 16 * rr); if (ov > gv || (ov == gv && oe < ge)) { gv = ov; ge = oe; } }
            be = ge;
            const int ol = be >> 2, oi = be & 3;
            const float mys = oi == 0 ? s[0] : (oi == 1 ? s[1] : (oi == 2 ? s[2] : s[3]));
            const float ws_ = __shfl(mys, ol);
            if (lane == ol) { if (oi == 0) cand[0] = -INFINITY; else if (oi == 1) cand[1] = -INFINITY; else if (oi == 2) cand[2] = -INFINITY; else cand[3] = -INFINITY; }
            wsum += ws_;
            if (lane == r) { my_e = be; my_w = ws_; }
        }
        if (lane < 8) {
            const float w = my_w / wsum * 2.5f;
            const unsigned p = atomicAdd(cnt + my_e, 1u);
            tope[(size_t)tok * 8 + lane] = my_e; topw[(size_t)tok * 8 + lane] = w; pos[(size_t)tok * 8 + lane] = (int)p;
        }
    }
}

__device__ __forceinline__ void tile_prefix(const Args& A, Ctx& C, LAS int* tb) {
    const unsigned* cnt = WSP(unsigned, WS_CTL) + CW_CNT;
    if (C.tid == 0) { int acc = 0; for (int e = 0; e < NE; ++e) { tb[e] = acc; acc += ((int)cnt[e] + 255) >> 8; } tb[NE] = acc; }
    __syncthreads();
}
__device__ __forceinline__ void phase_p9(const Args& A, Ctx& C) {
    LAS int* tb = (LAS int*)C.lds;
    tile_prefix(A, C, tb);
    const unsigned* cnt = WSP(unsigned, WS_CTL) + CW_CNT;
    const int* tope = WSP(int, WS_TOPE); const float* topw = WSP(float, WS_TOPW); const int* pos = WSP(int, WS_POS);
    int* rowl = WSP(int, WS_ROWL); float* roww = WSP(float, WS_ROWW); int* tile_e = WSP(int, WS_TILEE);
    const int nrt = tb[NE];
    for (int i = C.bid * 512 + C.tid; i < NLAT * 8; i += C.G * 512) { const int e = tope[i]; const int pr = tb[e] * 256 + pos[i]; rowl[pr] = i; roww[pr] = topw[i]; }
    for (int e = C.bid; e < NE; e += C.G) { const int n = (int)cnt[e], nt = tb[e + 1] - tb[e];
        for (int j = n + C.tid; j < nt * 256; j += 512) { rowl[tb[e] * 256 + j] = -1; roww[tb[e] * 256 + j] = 0.f; }
        for (int k = C.tid; k < nt; k += 512) tile_e[tb[e] + k] = e; }
    for (int i = C.bid * 512 + C.tid; i < NLAT; i += C.G * 512) { rowl[nrt * 256 + i] = i; roww[nrt * 256 + i] = 1.f; }
    for (int k = C.bid * 512 + C.tid; k < NLAT / 256; k += C.G * 512) tile_e[nrt + k] = NE;
    __syncthreads();
}

__device__ __forceinline__ void phase_moe(const Args& A, Ctx& C, int dry_shared) {
    LAS int* tb = (LAS int*)(C.lds + 131072);
    LAS int* tbl = tb + 320;
    tile_prefix(A, C, tb);
    pg8::MoeCtx M;
    M.nrt = tb[NE]; M.ntiles = M.nrt + NLAT / 256; M.G = C.G; M.vc = (C.G % 8 == 0) ? (C.bid % 8) * (C.G / 8) + C.bid / 8 : C.bid;
    M.tb = tb; M.tbl = tbl; M.cnt = WSP(unsigned, WS_CTL) + CW_CNT; M.rowl = WSP(int, WS_ROWL); M.roww = WSP(float, WS_ROWW);
    M.wexp = (const char*)(A.ws + WS_WEXP); M.h2n = (const char*)(A.ws + WS_H2N); M.Hs = (char*)(A.ws + WS_HS) + (size_t)C.bid * 256 * 256 * 2;
    M.Y = (unsigned char*)(A.ws + WS_Y); M.out = A.out; M.mod = WSP(const float, WS_MOD); M.dry_shared = dry_shared;
    pg8::gemm_moe(C.lds, M);
    __syncthreads();
}

__device__ __forceinline__ void phase_final(const Args& A, Ctx& C, float* dst) {
    const int gw = C.bid * 8 + C.wave, NGW = C.G * 8;
    const float* fg = A.in[I_FG]; const float* mod = WSP(const float, WS_MOD);
    const unsigned* Y = (const unsigned*)(A.ws + WS_Y);
    for (int row = gw; row < NLAT; row += NGW) {
        f32x4* xr = (f32x4*)(A.out + (size_t)row * D) + C.lane;
        const f32x4* gt = (const f32x4*)(mod + (size_t)(row >> 11) * MODW + 5 * D) + C.lane;
        const unsigned* yr = Y + (size_t)row * 8 * (D / 4) + C.lane;
        f32x4 v[4]; float s = 0.f;
#pragma unroll
        for (int j = 0; j < 4; ++j) {
            f32x4 a = (f32x4){0.f, 0.f, 0.f, 0.f};
#pragma unroll
            for (int sl = 0; sl < 8; ++sl) { const unsigned w = yr[sl * (D / 4) + 64 * j];
                const f32x2 lo = __builtin_amdgcn_cvt_pk_f32_fp8(w, false), hi = __builtin_amdgcn_cvt_pk_f32_fp8(w, true);
                a.x += lo.x; a.y += lo.y; a.z += hi.x; a.w += hi.y; }
            v[j] = xr[64 * j] + gt[64 * j] * a * (1.f / pg8::YSCALE);
            s += (v[j].x * v[j].x + v[j].y * v[j].y) + (v[j].z * v[j].z + v[j].w * v[j].w); }
        const float rstd = __builtin_amdgcn_rsqf(wave_sum(s) * (1.f / D) + NORM_EPS);
        f32x4* orow = (f32x4*)(dst + (size_t)row * D) + C.lane;
#pragma unroll
        for (int j = 0; j < 4; ++j) orow[64 * j] = v[j] * rstd * ((const f32x4*)fg)[C.lane + 64 * j];
    }
}

constexpr int NPHASE = 13;
__global__ void __launch_bounds__(512, 2) fwd_kernel(Args A) {
    extern __shared__ __attribute__((aligned(16))) unsigned char lds_raw[];
    Ctx C; C.lds = (lbyte*)lds_raw; C.tid = threadIdx.x; C.lane = C.tid & 63; C.wave = __builtin_amdgcn_readfirstlane(C.tid >> 6);
    C.G = gridDim.x; C.bid = blockIdx.x; C.a = &A;
    volatile LAS unsigned* misc = (volatile LAS unsigned*)(C.lds + LDS_MISC);
    if (C.tid < 16) misc[C.tid] = 0u;
    __syncthreads();
    XcdBarrier bar; bar.bar = WSP(unsigned, WS_CTL) + CW_BAR; bar.x = 0; bar.st = nullptr;
    const int lo = A.ph_lo, hi = A.ph_hi;
    const bool multi = (hi - lo) > 1;
    if (multi) bar = xcd_barrier_post(WSP(unsigned, WS_CTL) + CW_BAR, misc);
#ifndef PHASE_MASK
#define PHASE_MASK 0x1FFF
#endif
#define IN(k) (((PHASE_MASK >> (k)) & 1) && lo <= (k) && (k) < hi)
#define SEAM(k) do { if (IN(k) && IN((k) + 1)) xcd_barrier(bar); } while (0)
#ifndef REP_MASK
#define REP_MASK 0
#endif
#define REPS(k) (((REP_MASK >> (k)) & 1) ? 2 : 1)

    if (IN(0)) _Pragma("unroll") for (int rep = 0; rep < REPS(0); ++rep) { phase_p0(A, C); __syncthreads(); } SEAM(0);
    if (IN(1)) _Pragma("unroll") for (int rep = 0; rep < REPS(1); ++rep) { phase_p1(A, C); } SEAM(1);
    if (IN(2)) _Pragma("unroll") for (int rep = 0; rep < REPS(2); ++rep) {
        pg8::Gemm g{WSP(bf16_t, WS_XN), D}; pg8::StaticOrder S; S.init(NROWS, PLD, C.G, C.bid, WSP(bf16_t, WS_BTIN), D);
        pg8::EpiBf16W E{WSP(bf16_t, WS_P), PLD};
        pg8::gemm_phase<pg8::EpiBf16W, pg8::StaticOrder, false, 0, false>(C.lds, g, S, E);
    } SEAM(2);
    if (IN(3)) _Pragma("unroll") for (int rep = 0; rep < REPS(3); ++rep) { phase_gdn_prep(A, C); } SEAM(3);
#ifdef PROBE_BARRIERS
    if (multi) for (int kq = 0; kq < PROBE_BARRIERS; ++kq) xcd_barrier(bar);
#endif
    if (IN(4)) {
        for (int ch = C.bid; ch < NB * HB * 2; ch += C.G) gdn_chain_chunked(A, C, ch);
        for (int pr = C.bid; pr < NB * HA; pr += C.G) rwkv_pair_chunked(A, C, pr);
    } SEAM(4);
    if (IN(5)) _Pragma("unroll") for (int rep = 0; rep < REPS(5); ++rep) { phase_p4(A, C); } SEAM(5);
    if (IN(6)) _Pragma("unroll") for (int rep = 0; rep < REPS(6); ++rep) {
        pg8::Gemm g{WSP(bf16_t, WS_YMIX), D}; pg8::StaticOrder S; S.init(NLAT, D, C.G, C.bid, WSP(bf16_t, WS_BTOUT), D);
        pg8::EpiResGate E{A.in[I_X], A.out, WSP(float, WS_MOD), 2 * D};
        pg8::gemm_phase<pg8::EpiResGate, pg8::StaticOrder, false>(C.lds, g, S, E);
    } SEAM(6);
    if (IN(7)) _Pragma("unroll") for (int rep = 0; rep < REPS(7); ++rep) { phase_p6(A, C); __syncthreads(); convert_experts(A, C); __syncthreads(); } SEAM(7);
    if (IN(8)) _Pragma("unroll") for (int rep = 0; rep < REPS(8); ++rep) {
        pg8::Gemm g{WSP(bf16_t, WS_H2N), D}; pg8::StaticOrder S; S.init(NLAT, NE, C.G, C.bid, WSP(bf16_t, WS_BTR), D);
        pg8::EpiF32 E{WSP(float, WS_LOGIT), NE};
        pg8::gemm_phase<pg8::EpiF32, pg8::StaticOrder, false>(C.lds, g, S, E);
    } SEAM(8);
    if (IN(9)) { phase_p8(A, C); } SEAM(9);
    if (IN(10)) _Pragma("unroll") for (int rep = 0; rep < REPS(10); ++rep) { phase_p9(A, C); } SEAM(10);
    if (IN(11)) { phase_moe(A, C, 0); if (REPS(11) > 1) { __syncthreads(); phase_moe(A, C, 1); } } SEAM(11);
    if (IN(12)) { if (REPS(12) > 1) { phase_final(A, C, (float*)(A.ws + WS_WEXP)); __syncthreads(); } phase_final(A, C, A.out); }
#undef IN
#undef SEAM
}

extern "C" void kernel_launch(void* const* d_in, const int* in_sizes, int n_in, void* d_out, int out_size, void* d_ws, size_t ws_size, hipStream_t stream) {
    static int grid = 0;
    if (grid == 0) {
        if (n_in != 34 || out_size != NLAT * D || ws_size < WS_END) { fprintf(stderr, "kernel_launch: unexpected shapes (n_in %d out %d ws %zu need %zu)\n", n_in, out_size, ws_size, (size_t)WS_END); grid = -1; return; }
        int dev = 0, cus = 0;
        if (hipGetDevice(&dev) != hipSuccess || hipDeviceGetAttribute(&cus, hipDeviceAttributeMultiprocessorCount, dev) != hipSuccess) { grid = -1; return; }
        if (hipFuncSetAttribute((const void*)fwd_kernel, hipFuncAttributeMaxDynamicSharedMemorySize, LDS_BYTES) != hipSuccess) { fprintf(stderr, "kernel_launch: hipFuncSetAttribute failed\n"); grid = -1; return; }
        int per_cu = 0;
        if (hipOccupancyMaxActiveBlocksPerMultiprocessor(&per_cu, (const void*)fwd_kernel, 512, LDS_BYTES) != hipSuccess || per_cu < 1) { fprintf(stderr, "kernel_launch: occupancy query says %d\n", per_cu); }
        (void)hipGetLastError();
        grid = cus;
    }
    if (grid < 0) return;
    (void)hipMemsetAsync((char*)d_ws + WS_CTL, 0, CTL_BYTES, stream);
    Args a{};
    for (int i = 0; i < 34; ++i) a.in[i] = (const float*)d_in[i];
    a.out = (float*)d_out; a.ws = (unsigned char*)d_ws;
#if MK_PER_PHASE
    for (int p = 0; p < NPHASE; ++p) { a.ph_lo = p; a.ph_hi = p + 1; hipLaunchKernelGGL(fwd_kernel, dim3(grid), dim3(512), LDS_BYTES, stream, a); }
#else
    a.ph_lo = 0; a.ph_hi = NPHASE; hipLaunchKernelGGL(fwd_kernel, dim3(grid), dim3(512), LDS_BYTES, stream, a);
#endif
}
```

```cpp
#include <hip/hip_runtime.h>
#include <cstdio>
#include <cstdint>

#ifndef MK_PER_PHASE
#define MK_PER_PHASE 0
#endif

#define LAS __attribute__((address_space(3)))
typedef unsigned short bf16_t;
typedef short bf16x8 __attribute__((ext_vector_type(8)));
typedef float f32x4 __attribute__((ext_vector_type(4)));
typedef float f32x2 __attribute__((ext_vector_type(2)));
typedef unsigned u32x4 __attribute__((ext_vector_type(4)));
typedef unsigned u32x2 __attribute__((ext_vector_type(2)));
typedef LAS float lfloat;
typedef LAS unsigned char lbyte;

constexpr int D = 1024, NB = 32, SEQ = 2048, CTX = 256, GW = 64;
constexpr int NLAT = NB * SEQ;
constexpr int NCTX = NB * CTX;
constexpr int NROWS = NLAT + NCTX;
constexpr int DA = 512, HA = 8, NA = 64;
constexpr int RW_COLS = 1920, GD_COLS = 2064, IN_COLS = 3984, PLD = 4096;
constexpr int DB = 512, HB = 4, KB = 128;
constexpr int NE = 256, TOPK = 8, DE = 256;
constexpr int MODW = 6 * D;
constexpr float NORM_EPS = 1e-6f, RWKV_EPS = 64e-5f;
constexpr int MAXTILES = (NLAT * TOPK + NE * 255) / 256 + 1;

constexpr size_t MiB = 1u << 20;
constexpr size_t WS_CTL = 0, CTL_BYTES = 1 * MiB;
constexpr size_t WS_MOD = 1 * MiB;
constexpr size_t WS_BTIN = 2 * MiB, WS_BTOUT = 10 * MiB, WS_BTR = 12 * MiB, WS_BON = 13 * MiB, WS_GUPT = 17 * MiB, WS_NRM = 978 * MiB;
constexpr size_t WS_P = 18 * MiB, WS_XN = 594 * MiB, WS_YDIR = 594 * MiB, WS_YMIX = 850 * MiB;
constexpr size_t WS_H2N = 18 * MiB, WS_LOGIT = 146 * MiB, WS_TOPE = 210 * MiB, WS_TOPW = 212 * MiB, WS_POS = 214 * MiB, WS_Y = 146 * MiB;
constexpr size_t WS_ROWL = 658 * MiB, WS_ROWW = 661 * MiB, WS_TILEE = 664 * MiB, WS_HS = 672 * MiB, WS_WEXP = 704 * MiB;
constexpr size_t WEXP_STRIDE = (size_t)(512 * 1024 + 1024 * 256) * 2;
constexpr size_t WS_END = 1090 * MiB;
static_assert(WS_WEXP + 257 * WEXP_STRIDE <= WS_END && WS_Y + (size_t)NLAT * 8 * D <= WS_ROWL, "ws map");
constexpr int CW_BAR = 4096;
constexpr int CW_CNT = 16384;

constexpr int LDS_BYTES = 159744;
constexpr int LDS_MISC = LDS_BYTES - 64;

__device__ __forceinline__ unsigned f2bf(float f) { unsigned u = __builtin_bit_cast(unsigned, f); return (u + 0x7fffu + ((u >> 16) & 1u)) >> 16; }
typedef __bf16 bf16x2_t __attribute__((ext_vector_type(2)));
__device__ __forceinline__ unsigned cvtpk(float lo, float hi) { f32x2 v = {lo, hi}; return __builtin_bit_cast(unsigned, __builtin_convertvector(v, bf16x2_t)); }
__device__ __forceinline__ unsigned pk2(float lo, float hi) { return cvtpk(lo, hi); }
__device__ __forceinline__ float bf2f(unsigned short b) { return __builtin_bit_cast(float, ((unsigned)b) << 16); }
__device__ __forceinline__ float bflo(unsigned w) { return __builtin_bit_cast(float, w << 16); }
__device__ __forceinline__ float bfhi(unsigned w) { return __builtin_bit_cast(float, w & 0xffff0000u); }
template <int CTRL> __device__ __forceinline__ float dpp_f(float v) { return __builtin_bit_cast(float, __builtin_amdgcn_update_dpp(0, __builtin_bit_cast(int, v), CTRL, 0xf, 0xf, false)); }
__device__ __forceinline__ float wave_sum(float v) {
    v += dpp_f<0x128>(v);
    v += dpp_f<0x124>(v);
    v += dpp_f<0x122>(v);
    v += dpp_f<0x121>(v);
    const int vi = __builtin_bit_cast(int, v);
    const float r0 = __builtin_bit_cast(float, __builtin_amdgcn_readlane(vi, 0)), r1 = __builtin_bit_cast(float, __builtin_amdgcn_readlane(vi, 16)),
                r2 = __builtin_bit_cast(float, __builtin_amdgcn_readlane(vi, 32)), r3 = __builtin_bit_cast(float, __builtin_amdgcn_readlane(vi, 48));
    return (r0 + r1) + (r2 + r3);
}
__device__ __forceinline__ float sigmoidf_(float x) { return __builtin_amdgcn_rcpf(1.f + __expf(-x)); }
__device__ __forceinline__ float siluf_(float x) { return x * __builtin_amdgcn_rcpf(1.f + __expf(-x)); }
__device__ __forceinline__ float softplusf_(float x) { return fmaxf(x, 0.f) + __logf(1.f + __expf(-fabsf(x))); }
__device__ __forceinline__ float tanhf_(float x) { const float e = __expf(-2.f * fabsf(x)); const float t = (1.f - e) * __builtin_amdgcn_rcpf(1.f + e); return x < 0.f ? -t : t; }

#define XB_TMO      128
#define XB_XCNT(j)  (256  + 64 * (j))
#define XB_XSUB(j)  (1280 + 64 * (j))
#define XB_XGEN(j)  (2304 + 64 * (j))
#define XB_TOP      3328
#define XB_TOPGEN   3392
#define XCD_BAR_WORDS 3456
#define XB_SPIN_CAP (1u << 22)
__device__ __forceinline__ unsigned xb_ld(unsigned* p)              { return __hip_atomic_load(p, __ATOMIC_RELAXED, __HIP_MEMORY_SCOPE_AGENT); }
__device__ __forceinline__ unsigned xb_add(unsigned* p, unsigned v) { return __hip_atomic_fetch_add(p, v, __ATOMIC_RELAXED, __HIP_MEMORY_SCOPE_AGENT); }
__device__ __forceinline__ unsigned xb_xcc_id() { return (unsigned)__builtin_amdgcn_s_getreg((3 << 11) | 20) & 0xFu; }
#define XB_SPIN(cond, bar) do { unsigned _sp = 0; while (cond) { __builtin_amdgcn_s_sleep(1); \
    if ((++_sp & 255u) == 0u) { if (xb_ld(&(bar)[XB_TMO])) break; if (_sp > XB_SPIN_CAP) { atomicAdd(&(bar)[XB_TMO], 1u); break; } } } } while (0)
struct XcdBarrier { unsigned* bar; unsigned x; volatile LAS unsigned* st; };
__device__ __forceinline__ XcdBarrier xcd_barrier_post(unsigned* bar, volatile LAS unsigned* st) {
    XcdBarrier b; b.bar = bar; b.x = xb_xcc_id(); b.st = st;
    if (threadIdx.x == 0) (void)xb_add(&bar[XB_XCNT(b.x)], 1u);
    return b;
}
__device__ __forceinline__ void xcd_barrier_complete(unsigned* bar, unsigned x, unsigned& nloc, unsigned& nx) {
    const unsigned G = gridDim.x * gridDim.y * gridDim.z;
    unsigned sum, cnt, mine, sp = 0u;
    for (;;) {
        sum = 0u; cnt = 0u; mine = 0u;
#pragma unroll
        for (unsigned j = 0; j < 16; ++j) { const unsigned c = xb_ld(&bar[XB_XCNT(j)]); sum += c; cnt += (c > 0u) ? 1u : 0u; mine = (j == x) ? c : mine; }
        if (sum == G) break;
        __builtin_amdgcn_s_sleep(1);
        if ((++sp & 255u) == 0u) { if (xb_ld(&bar[XB_TMO])) break; if (sp > XB_SPIN_CAP) { atomicAdd(&bar[XB_TMO], 1u); break; } }
    }
    nloc = mine > 0u ? mine : 1u; nx = cnt > 0u ? cnt : 1u;
}
__device__ __forceinline__ void xcd_barrier(const XcdBarrier& b) {
    asm volatile("s_waitcnt vmcnt(0)" ::: "memory");
    __syncthreads();
    if (threadIdx.x == 0) {
        unsigned* bar = b.bar;
        __builtin_amdgcn_s_waitcnt(0);
        unsigned nloc = b.st[0], nx = b.st[1];
        if (nloc == 0u) { xcd_barrier_complete(bar, b.x, nloc, nx); b.st[0] = nloc; b.st[1] = nx; }
        const unsigned old = xb_add(&bar[XB_XSUB(b.x)], 1u);
        const unsigned gen = old / nloc;
        if (old + 1u == (gen + 1u) * nloc) {
            __builtin_amdgcn_fence(__ATOMIC_RELEASE, "agent");
            asm volatile("s_waitcnt vmcnt(0)" ::: "memory");
            const unsigned og = xb_add(&bar[XB_TOP], 1u);
            const unsigned tg = og / nx;
            if (og + 1u == (tg + 1u) * nx) xb_add(&bar[XB_TOPGEN], 1u);
            else XB_SPIN(xb_ld(&bar[XB_TOPGEN]) == tg, bar);
            __builtin_amdgcn_fence(__ATOMIC_ACQUIRE, "agent");
            xb_add(&bar[XB_XGEN(b.x)], 1u);
            asm volatile("s_waitcnt vmcnt(0)" ::: "memory");
        } else {
            XB_SPIN(xb_ld(&bar[XB_XGEN(b.x)]) == gen, bar);
            __builtin_amdgcn_fence(__ATOMIC_ACQUIRE, "agent");
            asm volatile("s_waitcnt vmcnt(0)" ::: "memory");
        }
    }
    __syncthreads();
}

struct Args {
    const float* in[34];
    float* out;
    unsigned char* ws;
    int ph_lo, ph_hi;
};
enum { I_X = 0, I_C, I_CTX, I_CCTX, I_WADA, I_BADA, I_N1G, I_WIN, I_MU, I_W0, I_WUP, I_A0, I_AUP, I_GUP, I_KK, I_KA, I_RK, I_LNW, I_LNB,
       I_CONVW, I_ALOG, I_DTB, I_ONG, I_WOUT, I_N2G, I_RW, I_RB, I_EW1, I_EW3, I_EW2, I_SW1, I_SW3, I_SW2, I_FG };

namespace pg8 {
constexpr int BM = 256, BK = 64, HALF = 128, HTB = HALF * BK * 2, STAGE_BYTES = 8 * HTB, NXCD = 8, WGM = 8;
__host__ __device__ __forceinline__ int lds_byte(int r, int c) { const int st = (r >> 4) * 2 + (c >> 5), rr = r & 15, cc = c & 31, ob = rr * 64 + cc * 2; return st * 1024 + (ob ^ (((ob >> 9) & 1) << 5)); }
__host__ __device__ __forceinline__ void stage_rc(int b, int& R, int& C) { const int st = b / 1024, sb = b % 1024, swz = sb ^ (((sb >> 9) & 1) << 5); R = (st >> 1) * 16 + swz / 64; C = (st & 1) * 32 + (swz % 64) / 2; }
__host__ __device__ __forceinline__ int perm32(int rho) { const int n = rho >> 4, i = rho & 15; return 8 * (i >> 2) + 4 * n + (i & 3); }
struct Unit { int pm, pn; };
struct Gemm { const bf16_t* A; int K; };
struct StaticOrder {
    int nM, nN, nwg, G, c; const char* Bt; size_t tstepB;
    __device__ void init(int M, int N, int G_, int c_, const void* Bt_, int K) { nM = M / BM; nN = N / BM; nwg = nM * nN; G = G_; c = c_; Bt = (const char*)Bt_; tstepB = (size_t)BM * K * 2; }
    __device__ bool next(int i, Unit& u) const {
        const long L = (long)i * G + c; if (L >= nwg) return false;
        int wgid = (int)L; { const int q = nwg / NXCD, r = nwg % NXCD, xcd = wgid % NXCD, off = wgid / NXCD; wgid = (xcd < r ? xcd * (q + 1) : r * (q + 1) + (xcd - r) * q) + off; }
        const int nig = WGM * nN, gid = wgid / nig, fm = gid * WGM, gsz = (nM - fm) < WGM ? (nM - fm) : WGM;
        u.pm = fm + ((wgid % nig) % gsz); u.pn = (wgid % nig) / gsz; return true;
    }
    __device__ __forceinline__ const char* bptr(const Unit& u) const { return Bt + (size_t)u.pn * tstepB; }
    __device__ __forceinline__ int rowsel(const Unit&, int) const { return 0; }
};
struct TileOrder {
    int nunits, npn, G, c; const int* tile_e; const char* wbase; size_t wstride, woff, tstepB; const int* rowl;
    __device__ bool next(int i, Unit& u) const { const int L = i * G + c; if (L >= nunits) return false; u.pm = L / npn; u.pn = L - u.pm * npn; return true; }
    __device__ __forceinline__ const char* bptr(const Unit& u) const { const int e = __builtin_amdgcn_readfirstlane(tile_e[u.pm]); return wbase + (size_t)e * wstride + woff + (size_t)u.pn * tstepB; }
    __device__ __forceinline__ int rowsel(const Unit& u, int r) const { const int t = rowl[(size_t)u.pm * 256 + r]; return t < 0 ? 0 : t; }
};
struct SeqOrder {
    int n; const char* Bt; size_t tstepB; const LAS int* rsel;
    __device__ bool next(int i, Unit& u) const { if (i >= n) return false; u.pm = 0; u.pn = i; return true; }
    __device__ __forceinline__ const char* bptr(const Unit& u) const { return Bt + (size_t)u.pn * tstepB; }
    __device__ __forceinline__ int rowsel(const Unit&, int r) const { return rsel[r]; }
};
__device__ __forceinline__ unsigned cvt_pk_bf16(float lo, float hi) { return cvtpk(lo, hi); }

template <class Epi, class Sched, bool GATHER, int A_AUX = 0, bool ALIGN = true>
__device__ __forceinline__ void gemm_phase(lbyte* lds, const Gemm g, const Sched& S, const Epi& E) {
    int tid_ = threadIdx.x; asm volatile("" : "+v"(tid_));
    const int tid = tid_, wid = __builtin_amdgcn_readfirstlane(tid >> 6), lane = tid & 63, wr = wid >> 2, wc = wid & 3, fr = lane & 15, fq = lane >> 4;
    const int K = g.K, nt = K / BK;
    Unit cur, nxt; int ui = 0;
    if (!S.next(0, cur)) return;
    int Rst[2], Cst[2];
    unsigned voffA[2], voffA1[2], voffB[2], nvA[2], nvA1[2];
#pragma unroll
    for (int i = 0; i < 2; ++i) { int R, C; stage_rc(tid * 16 + i * 8192, R, C); const int Rb = Epi::PERM ? ((R & ~31) + perm32(R & 31)) : R; Rst[i] = R; Cst[i] = C;
        if (GATHER) { voffA[i] = ((unsigned)S.rowsel(cur, R) * (unsigned)K + (unsigned)C) * 2u; voffA1[i] = ((unsigned)S.rowsel(cur, 128 + R) * (unsigned)K + (unsigned)C) * 2u; }
        else { voffA[i] = (unsigned)(R * K + C) * 2u; voffA1[i] = voffA[i]; }
        nvA[i] = voffA[i]; nvA1[i] = voffA1[i];
        voffB[i] = (unsigned)(Rb * K + C) * 2u; }
    const size_t kstep = (size_t)(BK * 2);
    const size_t hstep = (size_t)HALF * K * 2;
    const size_t hstepA = GATHER ? 0 : hstep;
    const size_t tstep = 2 * hstep;
    const unsigned ldsw = (unsigned)wid * 1024u;
    const int aoff = lds_byte(wr * 64 + fr, fq * 8), boff = lds_byte(wc * 32 + fr, fq * 8);
#define PG8_SA(b, h) (((b) * 2 + (h)) * HTB)
#define PG8_SB(b, h) ((4 + (b) * 2 + (h)) * HTB)
#define PG8_STAGE2(bufoff, gbase, v0, v1) do { \
        __builtin_amdgcn_global_load_lds((const unsigned*)((const char*)(gbase) + (v0)), (LAS unsigned*)(lds + (bufoff) + ldsw), 16, 0, 0); \
        __builtin_amdgcn_global_load_lds((const unsigned*)((const char*)(gbase) + (v1)), (LAS unsigned*)(lds + (bufoff) + ldsw + 8192), 16, 0, 0); } while (0)
#define PG8_STAGE2A(bufoff, gbase, v0, v1) do { if constexpr (A_AUX == 16) { \
        __builtin_amdgcn_global_load_lds((const unsigned*)((const char*)(gbase) + (v0)), (LAS unsigned*)(lds + (bufoff) + ldsw), 16, 0, 16); \
        __builtin_amdgcn_global_load_lds((const unsigned*)((const char*)(gbase) + (v1)), (LAS unsigned*)(lds + (bufoff) + ldsw + 8192), 16, 0, 16); } else { PG8_STAGE2(bufoff, gbase, v0, v1); } } while (0)
#define PG8_STAGE(bufoff, gbase, voff) PG8_STAGE2(bufoff, gbase, (voff)[0], (voff)[1])
#define PG8_STAGEA(bufoff, gbase, voff) PG8_STAGE2A(bufoff, gbase, (voff)[0], (voff)[1])
#define PG8_LDA(dst, b, h) do { _Pragma("unroll") for (int m = 0; m < 4; ++m) _Pragma("unroll") for (int k = 0; k < 2; ++k) dst[m][k] = *(const LAS bf16x8*)(lds + PG8_SA(b, h) + aoff + m * 2048 + k * 1024); } while (0)
#define PG8_LDB(dst, b, h) do { _Pragma("unroll") for (int n = 0; n < 2; ++n) _Pragma("unroll") for (int k = 0; k < 2; ++k) dst[n][k] = *(const LAS bf16x8*)(lds + PG8_SB(b, h) + boff + n * 2048 + k * 1024); } while (0)
#define PG8_MMA(ai, bj, At, Bt) do { __builtin_amdgcn_s_setprio(1); _Pragma("unroll") for (int m = 0; m < 4; ++m) _Pragma("unroll") for (int n = 0; n < 2; ++n) _Pragma("unroll") for (int k = 0; k < 2; ++k) \
        acc[ai][bj][m][n] = __builtin_amdgcn_mfma_f32_16x16x32_bf16(Bt[n][k], At[m][k], acc[ai][bj][m][n], 0, 0, 0); __builtin_amdgcn_s_setprio(0); } while (0)
#define PG8_WAIT_V(n) asm volatile("s_waitcnt vmcnt(" #n ")" ::: "memory")
#define PG8_WAIT_L(n) asm volatile("s_waitcnt lgkmcnt(" #n ")" ::: "memory")
#define PG8_BAR __builtin_amdgcn_s_barrier()
#define PG8_SCHED __builtin_amdgcn_sched_barrier(0)
    f32x4 acc[2][2][4][2];
#pragma unroll
    for (int a = 0; a < 2; ++a)
#pragma unroll
        for (int b = 0; b < 2; ++b)
#pragma unroll
            for (int m = 0; m < 4; ++m)
#pragma unroll
                for (int n = 0; n < 2; ++n) acc[a][b][m][n] = (f32x4){0.f, 0.f, 0.f, 0.f};
    bf16x8 At[4][2], B0[2][2], B1[2][2];
    const char* cA = (const char*)g.A + (GATHER ? (size_t)0 : (size_t)cur.pm * tstep); const char* cB = S.bptr(cur);
    PG8_STAGE(PG8_SB(0, 0), cB, voffB); PG8_STAGE(PG8_SB(0, 1), cB + hstep, voffB); PG8_STAGEA(PG8_SA(0, 0), cA, voffA); PG8_STAGEA(PG8_SA(0, 1), cA + hstepA, voffA1);
    if (wr == 1) PG8_BAR;
    PG8_WAIT_V(2); PG8_BAR;
    PG8_STAGE(PG8_SB(1, 0), cB + kstep, voffB); PG8_STAGEA(PG8_SA(1, 0), cA + kstep, voffA); PG8_STAGE(PG8_SB(1, 1), cB + hstep + kstep, voffB);
    PG8_WAIT_V(6); PG8_BAR;
    for (;;) {
        const bool has_next = S.next(ui + 1, nxt);
        const char* nA = has_next ? (const char*)g.A + (GATHER ? (size_t)0 : (size_t)nxt.pm * tstep) : cA; const char* nB = has_next ? S.bptr(nxt) : cB;
        for (int t = 0; t < nt; t += 2) {
            const bool last = (t == nt - 2);
            const char* a1 = cA + (size_t)(t + 1) * kstep;
            const char* a2 = last ? nA : cA + (size_t)(t + 2) * kstep; const char* b2 = last ? nB : cB + (size_t)(t + 2) * kstep;
            const char* a3 = a2 + kstep; const char* b3 = b2 + kstep;
            if (GATHER && last && has_next) {
#pragma unroll
                for (int i = 0; i < 2; ++i) { nvA[i] = ((unsigned)S.rowsel(nxt, Rst[i]) * (unsigned)K + (unsigned)Cst[i]) * 2u; nvA1[i] = ((unsigned)S.rowsel(nxt, 128 + Rst[i]) * (unsigned)K + (unsigned)Cst[i]) * 2u; }
            }
            const unsigned x0 = (GATHER && last) ? nvA[0] : voffA[0], x1 = (GATHER && last) ? nvA[1] : voffA[1];
            const unsigned y0 = (GATHER && last) ? nvA1[0] : voffA1[0], y1 = (GATHER && last) ? nvA1[1] : voffA1[1];
            PG8_LDB(B0, 0, 0); PG8_LDB(B1, 0, 1); PG8_SCHED; PG8_LDA(At, 0, 0); PG8_STAGEA(PG8_SA(1, 1), a1 + hstepA, voffA1);
            PG8_WAIT_V(8); PG8_WAIT_L(0); PG8_BAR; PG8_MMA(0, 0, At, B0); PG8_MMA(0, 1, At, B1); PG8_BAR; PG8_SCHED;
            PG8_LDA(At, 0, 1); PG8_STAGE(PG8_SB(0, 0), b2, voffB); PG8_STAGE(PG8_SB(0, 1), b2 + hstep, voffB); PG8_STAGE2A(PG8_SA(0, 0), a2, x0, x1);
            PG8_WAIT_V(8); PG8_WAIT_L(0); PG8_BAR; PG8_MMA(1, 0, At, B0); PG8_MMA(1, 1, At, B1); PG8_BAR; PG8_SCHED;
            PG8_LDB(B0, 1, 0); PG8_LDB(B1, 1, 1); PG8_SCHED; PG8_LDA(At, 1, 0); PG8_STAGE2A(PG8_SA(0, 1), a2 + hstepA, y0, y1);
            PG8_WAIT_V(8); PG8_WAIT_L(0); PG8_BAR; PG8_MMA(0, 0, At, B0); PG8_MMA(0, 1, At, B1); PG8_BAR; PG8_SCHED;
            PG8_LDA(At, 1, 1); PG8_STAGE(PG8_SB(1, 0), b3, voffB); PG8_STAGE(PG8_SB(1, 1), b3 + hstep, voffB); PG8_STAGE2A(PG8_SA(1, 0), a3, x0, x1);
            PG8_WAIT_V(8); PG8_WAIT_L(0); PG8_BAR; PG8_MMA(1, 0, At, B0); PG8_MMA(1, 1, At, B1); PG8_BAR; PG8_SCHED;
        }
        if (ALIGN && wr == 0) PG8_BAR;
        E(acc, cur, wr, wc, fr, fq);
        if (!has_next) break;
#pragma unroll
        for (int a = 0; a < 2; ++a)
#pragma unroll
            for (int b = 0; b < 2; ++b)
#pragma unroll
                for (int m = 0; m < 4; ++m)
#pragma unroll
                    for (int n = 0; n < 2; ++n) acc[a][b][m][n] = (f32x4){0.f, 0.f, 0.f, 0.f};
        cur = nxt; cA = nA; cB = nB; ++ui;
        if (GATHER) { voffA[0] = nvA[0]; voffA[1] = nvA[1]; voffA1[0] = nvA1[0]; voffA1[1] = nvA1[1]; }
        if (ALIGN && wr == 1) PG8_BAR;
    }
    PG8_WAIT_V(0);
    if (!ALIGN && wr == 0) PG8_BAR;
    PG8_BAR;
#undef PG8_SA
#undef PG8_SB
#undef PG8_STAGE
#undef PG8_STAGE2
#undef PG8_STAGE2A
#undef PG8_STAGEA
#undef PG8_LDA
#undef PG8_LDB
#undef PG8_MMA
#undef PG8_WAIT_V
#undef PG8_WAIT_L
#undef PG8_BAR
#undef PG8_SCHED
}

struct EpiBf16 {
    static constexpr bool PERM = true;
    bf16_t* O; int ldc;
    __device__ __forceinline__ void operator()(const f32x4 (&acc)[2][2][4][2], const Unit& u, int wr, int wc, int fr, int fq) const {
        const int row0 = u.pm * BM + wr * 64 + fr; const int col0 = u.pn * BM + wc * 32 + 8 * fq;
#pragma unroll
        for (int ai = 0; ai < 2; ++ai)
#pragma unroll
            for (int m = 0; m < 4; ++m) { bf16_t* rowp = O + (size_t)(row0 + ai * HALF + m * 16) * ldc + col0;
#pragma unroll
                for (int bj = 0; bj < 2; ++bj) { const f32x4 v0 = acc[ai][bj][m][0], v1 = acc[ai][bj][m][1];
                    u32x4 w; w.x = cvt_pk_bf16(v0[0], v0[1]); w.y = cvt_pk_bf16(v0[2], v0[3]); w.z = cvt_pk_bf16(v1[0], v1[1]); w.w = cvt_pk_bf16(v1[2], v1[3]);
                    *(u32x4*)(rowp + bj * HALF) = w; } }
    }
};
struct EpiF32 {
    static constexpr bool PERM = false;
    float* C; int ldc;
    __device__ __forceinline__ void operator()(const f32x4 (&acc)[2][2][4][2], const Unit& u, int wr, int wc, int fr, int fq) const {
        const int row0 = u.pm * BM + wr * 64 + fr, col0 = u.pn * BM + wc * 32 + 4 * fq;
#pragma unroll
        for (int ai = 0; ai < 2; ++ai)
#pragma unroll
            for (int m = 0; m < 4; ++m) { float* rowp = C + (size_t)(row0 + ai * HALF + m * 16) * ldc + col0;
#pragma unroll
                for (int bj = 0; bj < 2; ++bj)
#pragma unroll
                    for (int n = 0; n < 2; ++n) *(f32x4*)(rowp + bj * HALF + n * 16) = acc[ai][bj][m][n]; }
    }
};
struct EpiResGate {
    static constexpr bool PERM = false;
    const float* x; float* out; const float* mod; int gate_off;
    __device__ __forceinline__ void operator()(const f32x4 (&acc)[2][2][4][2], const Unit& u, int wr, int wc, int fr, int fq) const {
        const int row0 = u.pm * BM + wr * 64 + fr, col0 = u.pn * BM + wc * 32 + 4 * fq;
        const float* gp = mod + (size_t)((u.pm * BM) >> 11) * MODW + gate_off + col0;
        f32x4 gv[2][2];
#pragma unroll
        for (int bj = 0; bj < 2; ++bj)
#pragma unroll
            for (int n = 0; n < 2; ++n) gv[bj][n] = *(const f32x4*)(gp + bj * HALF + n * 16);
#pragma unroll
        for (int ai = 0; ai < 2; ++ai)
#pragma unroll
            for (int m = 0; m < 4; ++m) { const size_t off = (size_t)(row0 + ai * HALF + m * 16) * D + col0;
#pragma unroll
                for (int bj = 0; bj < 2; ++bj)
#pragma unroll
                    for (int n = 0; n < 2; ++n) { const f32x4 xv = *(const f32x4*)(x + off + bj * HALF + n * 16);
                        *(f32x4*)(out + off + bj * HALF + n * 16) = xv + gv[bj][n] * acc[ai][bj][m][n]; }
                asm volatile("" ::: "memory"); }
    }
};
struct EpiGLU {
    static constexpr bool PERM = true;
    bf16_t* H;
    __device__ __forceinline__ void operator()(const f32x4 (&acc)[2][2][4][2], const Unit& u, int wr, int wc, int fr, int fq) const {
        const int row0 = u.pm * BM + wr * 64 + fr; const int col0 = u.pn * 128 + wc * 32 + 8 * fq;
#pragma unroll
        for (int ai = 0; ai < 2; ++ai)
#pragma unroll
            for (int m = 0; m < 4; ++m) { bf16_t* rowp = H + (size_t)(row0 + ai * HALF + m * 16) * 256 + col0;
                f32x4 h0, h1;
#pragma unroll
                for (int j = 0; j < 4; ++j) { const float a0 = acc[ai][0][m][0][j], a1 = acc[ai][0][m][1][j];
                    h0[j] = siluf_(a0) * acc[ai][1][m][0][j]; h1[j] = siluf_(a1) * acc[ai][1][m][1][j]; }
                u32x4 w; w.x = cvt_pk_bf16(h0[0], h0[1]); w.y = cvt_pk_bf16(h0[2], h0[3]); w.z = cvt_pk_bf16(h1[0], h1[1]); w.w = cvt_pk_bf16(h1[2], h1[3]);
                *(u32x4*)rowp = w; }
    }
};
constexpr float YSCALE = 8.f;
struct EpiY {
    static constexpr bool PERM = true;
    unsigned char* Y; float* out; const float* mod; const LAS int* rtok; const LAS float* rw; int shared;
    __device__ __forceinline__ void operator()(const f32x4 (&acc)[2][2][4][2], const Unit& u, int wr, int wc, int fr, int fq) const {
        const int col0 = u.pn * BM + wc * 32 + 8 * fq;
#pragma unroll
        for (int ai = 0; ai < 2; ++ai)
#pragma unroll
            for (int m = 0; m < 4; ++m) { const int r = wr * 64 + fr + ai * HALF + m * 16; const int ts = rtok[r]; const float w = rw[r];
                if (ts >= 0) {
                    if (shared) { const unsigned goff = (unsigned)(ts >> 11) * MODW + 5 * D + col0; const unsigned ooff = (unsigned)ts * D + col0;
#pragma unroll
                        for (int bj = 0; bj < 2; ++bj)
#pragma unroll
                            for (int n = 0; n < 2; ++n) { const f32x4 gv = *(const f32x4*)(mod + goff + bj * HALF + n * 4); f32x4* op = (f32x4*)(out + ooff + bj * HALF + n * 4);
                                *op = *op + gv * acc[ai][bj][m][n]; }
                    } else { unsigned char* yp = Y + (size_t)(unsigned)ts * D + col0; const float ws_ = w * YSCALE;
#pragma unroll
                        for (int bj = 0; bj < 2; ++bj) { f32x4 v0 = acc[ai][bj][m][0] * ws_, v1 = acc[ai][bj][m][1] * ws_;
#pragma unroll
                                for (int j = 0; j < 4; ++j) { v0[j] = __builtin_amdgcn_fmed3f(v0[j], -448.f, 448.f); v1[j] = __builtin_amdgcn_fmed3f(v1[j], -448.f, 448.f); }
                            unsigned lo = 0u, hi = 0u;
                            lo = __builtin_amdgcn_cvt_pk_fp8_f32(v0[0], v0[1], lo, false); lo = __builtin_amdgcn_cvt_pk_fp8_f32(v0[2], v0[3], lo, true);
                            hi = __builtin_amdgcn_cvt_pk_fp8_f32(v1[0], v1[1], hi, false); hi = __builtin_amdgcn_cvt_pk_fp8_f32(v1[2], v1[3], hi, true);
                            u32x2 pk; pk.x = lo; pk.y = hi; *(u32x2*)(yp + bj * HALF) = pk; } } }
                asm volatile("" ::: "memory"); }
    }
};

struct MoeCtx {
    int ntiles, nrt, G, vc;
    const LAS int* tb; LAS int* tbl;
    const unsigned* cnt; const int* rowl; const float* roww;
    const char* wexp; const char* h2n; char* Hs; unsigned char* Y; float* out; const float* mod; int dry_shared;
};
__device__ __forceinline__ void gemm_moe(lbyte* lds, const MoeCtx& M) {
    int tid_ = threadIdx.x; asm volatile("" : "+v"(tid_));
    const int tid = tid_, wid = __builtin_amdgcn_readfirstlane(tid >> 6), lane = tid & 63, wr = wid >> 2, wc = wid & 3, fr = lane & 15, fq = lane >> 4;
    const int ntl = (M.ntiles - M.vc + M.G - 1) / M.G;
    if (M.vc >= M.ntiles) return;
    const int nunits = ntl * 6;
    const unsigned ldsw = (unsigned)wid * 1024u;
    const int aoff = lds_byte(wr * 64 + fr, fq * 8), boff = lds_byte(wc * 32 + fr, fq * 8);
    auto tile_expert = [&](int tile, int& e, int& k) { if (tile < M.nrt) { int lo = 0, hi = NE - 1; while (lo < hi) { const int mid = (lo + hi + 1) >> 1; if (M.tb[mid] <= tile) lo = mid; else hi = mid - 1; } e = lo; k = tile - M.tb[lo]; } else { e = NE; k = tile - M.nrt; } };
    auto fill = [&](int j) { if (j < ntl && tid < 256) { const int tile = M.vc + j * M.G; int e, k; tile_expert(tile, e, k); LAS int* T = M.tbl + (j & 1) * 768;
            int ts; float w;
            if (e < NE) { const int valid = (int)M.cnt[e] - 256 * k; if (tid < valid) { ts = M.rowl[(size_t)tile * 256 + tid]; w = M.roww[(size_t)tile * 256 + tid]; } else { ts = -1; w = 0.f; } T[tid] = ts < 0 ? 0 : (ts >> 3); }
            else { ts = k * 256 + tid; w = 1.f; T[tid] = ts; }
            T[256 + tid] = ts; ((LAS float*)T)[512 + tid] = w; } };
    struct UP { const char* aB; const char* bB; unsigned bh; int nt, kind, pn, slot, shared, e; };
    auto unit_params = [&](int ui, int prev_e, UP& u, unsigned (&oa)[4], unsigned (&ob)[2]) {
        int tq = threadIdx.x; asm volatile("" : "+v"(tq));
        int Rst[2], Cst[2], Rbp[2];
#pragma unroll
        for (int i = 0; i < 2; ++i) { int R, C; stage_rc(tq * 16 + i * 8192, R, C); Rst[i] = R; Cst[i] = C; Rbp[i] = (R & ~31) + perm32(R & 31); }
        const int j = ui / 6, sub = ui - 6 * j, tile = M.vc + j * M.G; int e, k;
        if (sub == 0) tile_expert(tile, e, k); else e = prev_e;
        u.e = e;
        const char* w = M.wexp + (size_t)e * WEXP_STRIDE;
        u.slot = j & 1; u.shared = (e == NE) ? 1 : 0;
        if (sub < 2) { u.kind = 0; u.pn = sub; u.nt = D / BK; u.aB = M.h2n; u.bB = w + (size_t)sub * 256 * D * 2; u.bh = 128u * D * 2u;
            const LAS int* T = M.tbl + (j & 1) * 768;
#pragma unroll
            for (int i = 0; i < 2; ++i) { oa[i] = ((unsigned)T[Rst[i]] * (unsigned)D + (unsigned)Cst[i]) * 2u; oa[2 + i] = ((unsigned)T[128 + Rst[i]] * (unsigned)D + (unsigned)Cst[i]) * 2u; ob[i] = (unsigned)(Rbp[i] * D + Cst[i]) * 2u; } }
        else { u.kind = 1; u.pn = sub - 2; u.nt = DE / BK; u.aB = M.Hs; u.bB = w + (size_t)512 * 1024 * 2 + (size_t)(sub - 2) * 256 * DE * 2; u.bh = 128u * DE * 2u;
#pragma unroll
            for (int i = 0; i < 2; ++i) { oa[i] = (unsigned)(Rst[i] * DE + Cst[i]) * 2u; oa[2 + i] = (unsigned)((128 + Rst[i]) * DE + Cst[i]) * 2u; ob[i] = (unsigned)(Rbp[i] * DE + Cst[i]) * 2u; } }
    };
#define PG8_SA(b, h) (((b) * 2 + (h)) * HTB)
#define PG8_SB(b, h) ((4 + (b) * 2 + (h)) * HTB)
#define MOE_DMA(bufoff, ptr, aux) __builtin_amdgcn_global_load_lds((const unsigned*)(ptr), (LAS unsigned*)(lds + (bufoff)), 16, 0, aux)
#define MOE_STA(bufoff, base, o0, o1) do { MOE_DMA((bufoff) + ldsw, (base) + (o0), 16); MOE_DMA((bufoff) + ldsw + 8192, (base) + (o1), 16); } while (0)
#define MOE_STAK(kindv, bufoff, base, o0, o1) do { if ((kindv) == 0) { MOE_DMA((bufoff) + ldsw, (base) + (o0), 0); MOE_DMA((bufoff) + ldsw + 8192, (base) + (o1), 0); } else MOE_STA(bufoff, base, o0, o1); } while (0)
#define MOE_STB(bufoff, base, o0, o1) do { MOE_DMA((bufoff) + ldsw, (base) + (o0), 0); MOE_DMA((bufoff) + ldsw + 8192, (base) + (o1), 0); } while (0)
#define PG8_LDA(dst, b, h) do { _Pragma("unroll") for (int m = 0; m < 4; ++m) _Pragma("unroll") for (int k = 0; k < 2; ++k) dst[m][k] = *(const LAS bf16x8*)(lds + PG8_SA(b, h) + aoff + m * 2048 + k * 1024); } while (0)
#define PG8_LDB(dst, b, h) do { _Pragma("unroll") for (int n = 0; n < 2; ++n) _Pragma("unroll") for (int k = 0; k < 2; ++k) dst[n][k] = *(const LAS bf16x8*)(lds + PG8_SB(b, h) + boff + n * 2048 + k * 1024); } while (0)
#define PG8_MMA(ai, bj, At, Bt) do { __builtin_amdgcn_s_setprio(1); _Pragma("unroll") for (int m = 0; m < 4; ++m) _Pragma("unroll") for (int n = 0; n < 2; ++n) _Pragma("unroll") for (int k = 0; k < 2; ++k) \
        acc[ai][bj][m][n] = __builtin_amdgcn_mfma_f32_16x16x32_bf16(Bt[n][k], At[m][k], acc[ai][bj][m][n], 0, 0, 0); __builtin_amdgcn_s_setprio(0); } while (0)
#define PG8_WAIT_V(n) asm volatile("s_waitcnt vmcnt(" #n ")" ::: "memory")
#define PG8_WAIT_L(n) asm volatile("s_waitcnt lgkmcnt(" #n ")" ::: "memory")
#define PG8_BAR __builtin_amdgcn_s_barrier()
#define PG8_SCHED __builtin_amdgcn_sched_barrier(0)
    fill(0);
    asm volatile("s_waitcnt vmcnt(0) lgkmcnt(0)" ::: "memory");
    __syncthreads();
    UP cu, nu; unsigned oa[4], ob[2], na[4], nb[2];
    unit_params(0, 0, cu, oa, ob);
    nu = cu;
#pragma unroll
    for (int i = 0; i < 4; ++i) na[i] = oa[i];
    nb[0] = ob[0]; nb[1] = ob[1];
    f32x4 acc[2][2][4][2];
#pragma unroll
    for (int a = 0; a < 2; ++a)
#pragma unroll
        for (int b = 0; b < 2; ++b)
#pragma unroll
            for (int m = 0; m < 4; ++m)
#pragma unroll
                for (int n = 0; n < 2; ++n) acc[a][b][m][n] = (f32x4){0.f, 0.f, 0.f, 0.f};
    bf16x8 At[4][2], B0[2][2], B1[2][2];
    const size_t kstep = (size_t)(BK * 2);
    {   const char* cA = cu.aB; const char* cB = cu.bB;
        MOE_STB(PG8_SB(0, 0), cB, ob[0], ob[1]); MOE_STB(PG8_SB(0, 1), cB + cu.bh, ob[0], ob[1]); MOE_STAK(cu.kind, PG8_SA(0, 0), cA, oa[0], oa[1]); MOE_STAK(cu.kind, PG8_SA(0, 1), cA, oa[2], oa[3]);
        if (wr == 1) PG8_BAR;
        PG8_WAIT_V(2); PG8_BAR;
        MOE_STB(PG8_SB(1, 0), cB + kstep, ob[0], ob[1]); MOE_STAK(cu.kind, PG8_SA(1, 0), cA + kstep, oa[0], oa[1]); MOE_STB(PG8_SB(1, 1), cB + cu.bh + kstep, ob[0], ob[1]);
        PG8_WAIT_V(6); PG8_BAR; }
    for (int ui = 0;; ++ui) {
        const bool has_next = (ui + 1 < nunits);
        { const int j = ui / 6; if (ui - 6 * j == 2) fill(j + 1); }
        const char* cA = cu.aB; const char* cB = cu.bB; const int nt = cu.nt; const unsigned bh = cu.bh;
        for (int t = 0; t < nt; t += 2) {
            const bool last = (t == nt - 2);
            if (last && has_next) unit_params(ui + 1, cu.e, nu, na, nb);
            const char* a1 = cA + (size_t)(t + 1) * kstep;
            const char* a2 = last ? nu.aB : cA + (size_t)(t + 2) * kstep; const char* b2 = last ? nu.bB : cB + (size_t)(t + 2) * kstep;
            const char* a3 = a2 + kstep; const char* b3 = b2 + kstep;
            const unsigned bh2 = last ? nu.bh : bh;
            const unsigned x0 = last ? na[0] : oa[0], x1 = last ? na[1] : oa[1], y0 = last ? na[2] : oa[2], y1 = last ? na[3] : oa[3];
            const unsigned z0 = last ? nb[0] : ob[0], z1 = last ? nb[1] : ob[1];
            const int k2 = last ? nu.kind : cu.kind;
            PG8_LDB(B0, 0, 0); PG8_LDB(B1, 0, 1); PG8_SCHED; PG8_LDA(At, 0, 0); MOE_STAK(cu.kind, PG8_SA(1, 1), a1, oa[2], oa[3]);
            PG8_WAIT_V(8); PG8_WAIT_L(0); PG8_BAR; PG8_MMA(0, 0, At, B0); PG8_MMA(0, 1, At, B1); PG8_BAR; PG8_SCHED;
            PG8_LDA(At, 0, 1); MOE_STB(PG8_SB(0, 0), b2, z0, z1); MOE_STB(PG8_SB(0, 1), b2 + bh2, z0, z1); MOE_STAK(k2, PG8_SA(0, 0), a2, x0, x1);
            PG8_WAIT_V(8); PG8_WAIT_L(0); PG8_BAR; PG8_MMA(1, 0, At, B0); PG8_MMA(1, 1, At, B1); PG8_BAR; PG8_SCHED;
            PG8_LDB(B0, 1, 0); PG8_LDB(B1, 1, 1); PG8_SCHED; PG8_LDA(At, 1, 0); MOE_STAK(k2, PG8_SA(0, 1), a2, y0, y1);
            PG8_WAIT_V(8); PG8_WAIT_L(0); PG8_BAR; PG8_MMA(0, 0, At, B0); PG8_MMA(0, 1, At, B1); PG8_BAR; PG8_SCHED;
            PG8_LDA(At, 1, 1); MOE_STB(PG8_SB(1, 0), b3, z0, z1); MOE_STB(PG8_SB(1, 1), b3 + bh2, z0, z1); MOE_STAK(k2, PG8_SA(1, 0), a3, x0, x1);
            PG8_WAIT_V(8); PG8_WAIT_L(0); PG8_BAR; PG8_MMA(1, 0, At, B0); PG8_MMA(1, 1, At, B1); PG8_BAR; PG8_SCHED;
        }
        if (wr == 0) PG8_BAR;
        if (cu.kind == 0) {
            const int row0 = wr * 64 + fr; const int col0 = cu.pn * 128 + wc * 32 + 8 * fq;
#pragma unroll
            for (int ai = 0; ai < 2; ++ai)
#pragma unroll
                for (int m = 0; m < 4; ++m) { bf16_t* rowp = (bf16_t*)M.Hs + (size_t)(row0 + ai * HALF + m * 16) * 256 + col0;
                    f32x4 h0, h1;
#pragma unroll
                    for (int j = 0; j < 4; ++j) { h0[j] = siluf_(acc[ai][0][m][0][j]) * acc[ai][1][m][0][j]; h1[j] = siluf_(acc[ai][0][m][1][j]) * acc[ai][1][m][1][j]; }
                    u32x4 w; w.x = cvt_pk_bf16(h0[0], h0[1]); w.y = cvt_pk_bf16(h0[2], h0[3]); w.z = cvt_pk_bf16(h1[0], h1[1]); w.w = cvt_pk_bf16(h1[2], h1[3]);
                    *(u32x4*)rowp = w; }
            if (cu.pn == 1) PG8_WAIT_V(0);
        } else {
            const LAS int* rtok = M.tbl + cu.slot * 768 + 256; const LAS float* rw = (const LAS float*)(M.tbl + cu.slot * 768 + 512);
            const int col0 = cu.pn * BM + wc * 32 + 8 * fq;
#pragma unroll
            for (int ai = 0; ai < 2; ++ai)
#pragma unroll
                for (int m = 0; m < 4; ++m) { const int r = wr * 64 + fr + ai * HALF + m * 16; const int ts = rtok[r]; const float w = rw[r];
                    if (ts >= 0) {
                        if (cu.shared) { const unsigned goff = (unsigned)(ts >> 11) * MODW + 5 * D + col0; const unsigned ooff = (unsigned)ts * D + col0;
#pragma unroll
                            for (int bj = 0; bj < 2; ++bj)
#pragma unroll
                                for (int n = 0; n < 2; ++n) { const f32x4 gv = *(const f32x4*)(M.mod + goff + bj * HALF + n * 4); f32x4* op = (f32x4*)(M.out + ooff + bj * HALF + n * 4);
                                    const f32x4 nv = *op + gv * acc[ai][bj][m][n]; if (!M.dry_shared) *op = nv; else asm volatile("" :: "v"(nv)); }
                        } else { unsigned char* yp = M.Y + (size_t)(unsigned)ts * D + col0; const float ws_ = w * YSCALE;
#pragma unroll
                            for (int bj = 0; bj < 2; ++bj) { f32x4 v0 = acc[ai][bj][m][0] * ws_, v1 = acc[ai][bj][m][1] * ws_;
#pragma unroll
                                for (int j = 0; j < 4; ++j) { v0[j] = __builtin_amdgcn_fmed3f(v0[j], -448.f, 448.f); v1[j] = __builtin_amdgcn_fmed3f(v1[j], -448.f, 448.f); }
                                unsigned lo = 0u, hi = 0u;
                                lo = __builtin_amdgcn_cvt_pk_fp8_f32(v0[0], v0[1], lo, false); lo = __builtin_amdgcn_cvt_pk_fp8_f32(v0[2], v0[3], lo, true);
                                hi = __builtin_amdgcn_cvt_pk_fp8_f32(v1[0], v1[1], hi, false); hi = __builtin_amdgcn_cvt_pk_fp8_f32(v1[2], v1[3], hi, true);
                                u32x2 pk; pk.x = lo; pk.y = hi; *(u32x2*)(yp + bj * HALF) = pk; } } }
                    asm volatile("" ::: "memory"); }
        }
        if (!has_next) break;
#pragma unroll
        for (int a = 0; a < 2; ++a)
#pragma unroll
            for (int b = 0; b < 2; ++b)
#pragma unroll
                for (int m = 0; m < 4; ++m)
#pragma unroll
                    for (int n = 0; n < 2; ++n) acc[a][b][m][n] = (f32x4){0.f, 0.f, 0.f, 0.f};
        cu = nu;
#pragma unroll
        for (int i = 0; i < 4; ++i) oa[i] = na[i];
        ob[0] = nb[0]; ob[1] = nb[1];
        if (wr == 1) PG8_BAR;
    }
    PG8_WAIT_V(0);
    PG8_BAR;
#undef PG8_SA
#undef PG8_SB
#undef MOE_DMA
#undef MOE_STA
#undef MOE_STAK
#undef MOE_STB
#undef PG8_LDA
#undef PG8_LDB
#undef PG8_MMA
#undef PG8_WAIT_V
#undef PG8_WAIT_L
#undef PG8_BAR
#undef PG8_SCHED
}
}

struct Ctx {
    lbyte* lds; int tid, lane, wave, G, bid;
    const Args* a;
};
#define WSP(T, off) ((T*)(A.ws + (off)))

template <class RowMap>
__device__ __forceinline__ void transpose_item(const float* W, int K, int N, bf16_t* WT, RowMap rowmap, lfloat* scr, int item, int lane) {
    const int nblk = N / 32, kb = item / nblk, nb = item % nblk, k0 = 64 * kb, n0 = 32 * nb;
#pragma unroll 8
    for (int i = 0; i < 32; ++i) { const int kk = 2 * i + (lane >> 5); scr[kk * 33 + (lane & 31)] = W[(size_t)(k0 + kk) * N + n0 + (lane & 31)]; }
    asm volatile("s_waitcnt lgkmcnt(0)" ::: "memory");
    const int c = lane & 7;
#pragma unroll
    for (int j = 0; j < 4; ++j) { const int n = (lane >> 3) + 8 * j; const lfloat* s = scr + (8 * c) * 33 + n;
        u32x4 o; o.x = pk2(s[0 * 33], s[1 * 33]); o.y = pk2(s[2 * 33], s[3 * 33]); o.z = pk2(s[4 * 33], s[5 * 33]); o.w = pk2(s[6 * 33], s[7 * 33]);
        *(u32x4*)(WT + (size_t)rowmap(n0 + n) * K + k0 + 8 * c) = o; }
    asm volatile("s_waitcnt lgkmcnt(0)" ::: "memory");
}
struct RowId { __device__ int operator()(int n) const { return n; } };
struct RowGLU { int base; __device__ int operator()(int n) const { return ((n >> 7) << 8) + base + (n & 127); } };

__device__ __forceinline__ void norm_mod_row(const float* xrow, const float* g, const float* sc, const float* sh, bf16_t* orow, int lane) {
    const f32x4* xr = (const f32x4*)xrow + lane;
    f32x4 v[4]; float s = 0.f;
#pragma unroll
    for (int j = 0; j < 4; ++j) { v[j] = xr[64 * j]; s += (v[j].x * v[j].x + v[j].y * v[j].y) + (v[j].z * v[j].z + v[j].w * v[j].w); }
    const float rstd = __builtin_amdgcn_rsqf(wave_sum(s) * (1.f / D) + NORM_EPS);
    u32x2* o8 = (u32x2*)orow + lane;
#pragma unroll
    for (int j = 0; j < 4; ++j) { const f32x4 gg = ((const f32x4*)g)[lane + 64 * j], ss = ((const f32x4*)sc)[lane + 64 * j], hh = ((const f32x4*)sh)[lane + 64 * j];
        const f32x4 y = v[j] * rstd * gg * (ss + 1.f) + hh;
        u32x2 w; w.x = pk2(y.x, y.y); w.y = pk2(y.z, y.w); o8[64 * j] = w; }
}

__device__ __forceinline__ void phase_p0(const Args& A, Ctx& C) {
    float* mod = WSP(float, WS_MOD);
    {
        lfloat* sc = (lfloat*)C.lds;
        lfloat* red = (lfloat*)(C.lds + 17 * 1024 * 4);
        const float* wada = A.in[I_WADA]; const float* bada = A.in[I_BADA];
        for (int it = C.bid; it < 96 * 2; it += C.G) {
            const int chunk = it >> 1, pass = it & 1, r0 = pass * 17, nr = pass ? 16 : 17, col0 = chunk * 64;
            __syncthreads();
            for (int i = C.tid; i < nr * 1024; i += 512) { const int r = i >> 10, k = i & 1023; const int rr = r0 + r;
                const float cv = rr < 32 ? A.in[I_C][rr * 1024 + k] : A.in[I_CCTX][k]; sc[r * 1024 + k] = siluf_(cv); }
            __syncthreads();
            const int col = C.tid & 63, kq = C.tid >> 6;
            float acc[17];
#pragma unroll
            for (int r = 0; r < 17; ++r) acc[r] = 0.f;
            for (int k = kq * 128; k < kq * 128 + 128; k += 4) {
                float w[4];
#pragma unroll
                for (int j = 0; j < 4; ++j) w[j] = wada[(size_t)(k + j) * MODW + col0 + col];
#pragma unroll
                for (int r = 0; r < 17; ++r) { const f32x4 s4 = *(const LAS f32x4*)(sc + r * 1024 + k); acc[r] += s4.x * w[0] + s4.y * w[1] + s4.z * w[2] + s4.w * w[3]; }
            }
#pragma unroll
            for (int r = 0; r < 17; ++r) red[(kq * 17 + r) * 64 + col] = acc[r];
            __syncthreads();
            for (int i = C.tid; i < nr * 64; i += 512) { const int r = i >> 6, cc = i & 63; float s = 0.f;
#pragma unroll
                for (int q = 0; q < 8; ++q) s += red[(q * 17 + r) * 64 + cc];
                mod[(size_t)(r0 + r) * MODW + col0 + cc] = s + bada[col0 + cc]; }
        }
        __syncthreads();
    }
    {
        lfloat* scr = (lfloat*)(C.lds + C.wave * 16384);
        const int gw = C.bid * 8 + C.wave, NGW = C.G * 8;
        bf16_t* btin = WSP(bf16_t, WS_BTIN); bf16_t* btout = WSP(bf16_t, WS_BTOUT); bf16_t* btr = WSP(bf16_t, WS_BTR);
        constexpr int I_IN = (D / 64) * 124, I_OUT = (D / 64) * (D / 32), I_R = (D / 64) * (NE / 32), I_G = (128 / 64) * (DA / 32);
        for (int it = gw; it < I_IN + I_OUT + I_R + I_G; it += NGW) {
            int r = it;
            if (r < I_IN) {
                const int kb = r / 124, nb = r % 124, k0 = 64 * kb, n0 = 32 * nb; const float* W = A.in[I_WIN];
#pragma unroll 8
                for (int i = 0; i < 32; ++i) { const int kk = 2 * i + (C.lane >> 5); scr[kk * 33 + (C.lane & 31)] = W[(size_t)(k0 + kk) * IN_COLS + n0 + (C.lane & 31)]; }
                asm volatile("s_waitcnt lgkmcnt(0)" ::: "memory");
                const int c = C.lane & 7;
#pragma unroll
                for (int j = 0; j < 4; ++j) { const int n = (C.lane >> 3) + 8 * j; const lfloat* s = scr + (8 * c) * 33 + n;
                    u32x4 o; o.x = pk2(s[0 * 33], s[1 * 33]); o.y = pk2(s[2 * 33], s[3 * 33]); o.z = pk2(s[4 * 33], s[5 * 33]); o.w = pk2(s[6 * 33], s[7 * 33]);
                    *(u32x4*)(btin + (size_t)(n0 + n) * D + k0 + 8 * c) = o; }
                asm volatile("s_waitcnt lgkmcnt(0)" ::: "memory");
                continue; }
            r -= I_IN;
            if (r < I_OUT) { transpose_item(A.in[I_WOUT], D, D, btout, RowId(), scr, r, C.lane); continue; } r -= I_OUT;
            if (r < I_R) { transpose_item(A.in[I_RW], D, NE, btr, RowId(), scr, r, C.lane); continue; } r -= I_R;
            transpose_item(A.in[I_GUP], 128, DA, WSP(bf16_t, WS_GUPT), RowId(), scr, r, C.lane);
        }
        for (int i = C.bid * 512 + C.tid; i < 16 * D; i += C.G * 512) { const int n = 3968 + (i >> 10), k = i & 1023; btin[(size_t)n * D + k] = (bf16_t)f2bf(A.in[I_WIN][(size_t)k * IN_COLS + n]); }
        for (int i = C.bid * 512 + C.tid; i < (PLD - IN_COLS) * D / 8; i += C.G * 512) ((u32x4*)(btin + (size_t)IN_COLS * D))[i] = (u32x4){0u, 0u, 0u, 0u};
    }
}

__device__ __forceinline__ void phase_p1(const Args& A, Ctx& C) {
    const float* mod = WSP(float, WS_MOD); bf16_t* xn = WSP(bf16_t, WS_XN);
    const int gw = C.bid * 8 + C.wave, NGW = C.G * 8;
    for (int row = gw; row < NROWS; row += NGW) {
        const float* xr; int mb;
        if (row < NLAT) { xr = A.in[I_X] + (size_t)row * D; mb = row >> 11; } else { xr = A.in[I_CTX] + (size_t)(row - NLAT) * D; mb = 32; }
        const float* m = mod + (size_t)mb * MODW;
        norm_mod_row(xr, A.in[I_N1G], m + D, m, xn + (size_t)row * D, C.lane);
    }
}

template <int NK>
__device__ __forceinline__ f32x4 mm_tile(const lbyte* Ap, int lda, const lbyte* Bp, int ldb, f32x4 acc, int lane) {
    const int r = lane & 15, g = lane >> 4;
#pragma unroll
    for (int ks = 0; ks < NK; ++ks) {
        const bf16x8 a = *(const LAS bf16x8*)(Ap + r * lda + ks * 64 + g * 16);
        const bf16x8 b = *(const LAS bf16x8*)(Bp + r * ldb + ks * 64 + g * 16);
        acc = __builtin_amdgcn_mfma_f32_16x16x32_bf16(a, b, acc, 0, 0, 0);
    }
    return acc;
}

__device__ __forceinline__ void st_bf16x4(lbyte* p, f32x4 v) { u32x2 w; w.x = cvtpk(v.x, v.y); w.y = cvtpk(v.z, v.w); *(LAS u32x2*)p = w; }
__device__ __forceinline__ void st_bf16(lbyte* p, float v) { *(LAS unsigned short*)p = (unsigned short)cvtpk(v, v); }
__device__ __forceinline__ float rdlane(float v, int l) { return __builtin_bit_cast(float, __builtin_amdgcn_readlane(__builtin_bit_cast(int, v), l)); }

__device__ __forceinline__ void tri_inv16(const f32x4 m, int lane, float (&X)[16]) {
#pragma unroll
    for (int i = 0; i < 16; ++i) {
        float x0 = (lane == i) ? 1.f : 0.f, x1 = 0.f;
#pragma unroll
        for (int k = 0; k < i; ++k) { const float t = rdlane(m[k & 3], i + 16 * (k >> 2)) * X[k]; if (k & 1) x1 -= t; else x0 -= t; }
        X[i] = x0 + x1;
    }
}

namespace rk {
constexpr int S64 = 160, S32 = 80, SW = 144;
constexpr int O_WUP = 0, O_AUP = O_WUP + 64 * SW, O_WLT = O_AUP + 64 * SW, O_ALT = O_WLT + 16 * S64, O_LW = O_ALT + 16 * S64, O_LA = O_LW + 4096,
              O_KKT = O_LA + 4096, O_RT = O_KKT + 16 * S64, O_BT = O_RT + 16 * S64, O_KDT = O_BT + 16 * S64,
              O_VT = O_KDT + 16 * S64, O_BHT = O_VT + 64 * S32, O_KHT = O_BHT + 64 * S32, O_UT = O_KHT + 64 * S32, O_UTT = O_WLT  ,
              O_TI = O_UT + 64 * S32, O_MK = O_TI + 16 * S32, O_NB = O_MK + 16 * S32, O_NK = O_NB + 16 * S32,
              O_SBF = O_NK + 16 * S32, O_WC = O_SBF + 64 * S64, TEAM_BYTES = O_WC + 256;
static_assert(2 * TEAM_BYTES <= LDS_MISC, "rwkv LDS");
}
__device__ __forceinline__ void rwkv_pair_chunked(const Args& A, Ctx& C, int pair) {
    using namespace rk;
    const int b = pair >> 3, h = pair & 7;
    const int dir = C.wave >> 2;
    const int t4 = C.tid & 255, q = C.wave & 3, lane = C.lane;
    lbyte* L = C.lds + dir * TEAM_BYTES;
    const bf16_t* P = WSP(bf16_t, WS_P);
    bf16_t* ydir = WSP(bf16_t, WS_YDIR) + (size_t)dir * NLAT * D;
    float* bon = WSP(float, WS_BON) + (size_t)dir * NLAT * 8;
    __syncthreads();
#pragma unroll 2
    for (int i = t4; i < 4096; i += 256) { const int l = i >> 6, c = i & 63;
        st_bf16(L + O_WUP + c * SW + l * 2, A.in[I_WUP][((size_t)dir * 64 + l) * DA + 64 * h + c]);
        st_bf16(L + O_AUP + c * SW + l * 2, A.in[I_AUP][((size_t)dir * 64 + l) * DA + 64 * h + c]); }
#pragma unroll 2
    for (int i = t4; i < (4 * 64 * S32 + 4 * 16 * S32 + 64 * S64) / 4; i += 256) ((LAS unsigned*)(L + O_VT))[i] = 0u;
    for (int i = t4; i < (2 * 16 * S64) / 4; i += 256) ((LAS unsigned*)(L + O_WLT))[i] = 0u;
    const int c = lane;
    int col5[5] = {64 * h + c, 512 + 64 * h + c, 1024 + 64 * h + c, 1536 + 64 * dir + c, 1664 + 64 * dir + c};
    float mu5[5]; int dl5[5], cl5[5], dc5[5], cc5[5];
#pragma unroll
    for (int e = 0; e < 5; ++e) { const int col = col5[e]; mu5[e] = A.in[I_MU][col];
        cl5[e] = col < 480 ? 0 : (col < 960 ? 1 : (col < 1440 ? 2 : 3)); dl5[e] = (cl5[e] == 0 ? -PLD : (cl5[e] == 1 ? PLD : (cl5[e] == 2 ? -64 * PLD : 64 * PLD)));
        cc5[e] = col < 960 ? 0 : 1; dc5[e] = col < 960 ? -PLD : PLD; }
    const float kkc = A.in[I_KK][64 * h + c], kac = A.in[I_KA][64 * h + c], rkc = A.in[I_RK][64 * h + c];
    const float w0c = A.in[I_W0][dir * DA + 64 * h + c], a0c = A.in[I_A0][dir * DA + 64 * h + c];
    f32x4 Sacc[4];
#pragma unroll
    for (int i = 0; i < 4; ++i) Sacc[i] = (f32x4){0.f, 0.f, 0.f, 0.f};
    const int fr = lane & 15, fg = lane >> 4;
    unsigned short rawp[4][5], raws[4][5];
    auto chunk_geom = [&](int ch, bool& isctx, int& sbase, int& T, size_t& rowbase) { isctx = ch < 16; sbase = isctx ? ch * 16 : (ch - 16) * 16; T = isctx ? CTX : SEQ; rowbase = isctx ? (size_t)NLAT + (size_t)b * CTX : (size_t)b * SEQ; };
    auto okmask = [&](bool isctx, int t) -> int { return isctx ? ((t >= 1 ? 1 : 0) | (t <= CTX - 2 ? 2 : 0)) : (((t & 63) >= 1 ? 1 : 0) | ((t & 63) <= 62 ? 2 : 0) | (t >= 64 ? 4 : 0) | (t < SEQ - 64 ? 8 : 0)); };
    auto issue_loads = [&](int ch) { bool isctx; int sbase, T; size_t rowbase; chunk_geom(ch, isctx, sbase, T, rowbase);
#pragma unroll
        for (int j = 0; j < 4; ++j) { const int i = q + 4 * j; const int t = __builtin_amdgcn_readfirstlane(dir ? (T - 1 - (sbase + i)) : (sbase + i));
            const bf16_t* pr = P + (rowbase + t) * PLD; const int okm = okmask(isctx, t);
#pragma unroll
            for (int e = 0; e < 5; ++e) { const int cls = isctx ? cc5[e] : cl5[e]; const bool ok = (okm >> cls) & 1; const int off = col5[e] + (ok ? (isctx ? dc5[e] : dl5[e]) : 0);
                rawp[j][e] = pr[col5[e]]; raws[j][e] = pr[off]; } } };
    issue_loads(0);
    for (int ch = 0; ch < 144; ++ch) {
        bool isctx; int sbase, T; size_t rowbase; chunk_geom(ch, isctx, sbase, T, rowbase);
        float vr[4], vk[4], vv[4], vkk[4], lw[4], av[4];
        __syncthreads();
        float mxa[4][5];
#pragma unroll
        for (int j = 0; j < 4; ++j) { const int i = q + 4 * j; const int t = __builtin_amdgcn_readfirstlane(dir ? (T - 1 - (sbase + i)) : (sbase + i)); const int okm = okmask(isctx, t);
#pragma unroll
            for (int e = 0; e < 5; ++e) { const int cls = isctx ? cc5[e] : cl5[e]; const bool ok = (okm >> cls) & 1;
                const float pv = bf2f(rawp[j][e]); const float sv = bf2f(raws[j][e]); mxa[j][e] = pv + mu5[e] * ((ok ? sv : 0.f) - pv); } }
        if (ch + 1 < 144) issue_loads(ch + 1);
#pragma unroll
        for (int j = 0; j < 4; ++j) {
            const int i = q + 4 * j;
            float mx[5];
#pragma unroll
            for (int e = 0; e < 5; ++e) mx[e] = mxa[j][e];
            vr[j] = mx[0]; vk[j] = mx[1]; vv[j] = mx[2];
            *(LAS unsigned short*)(L + O_WLT + i * S64 + c * 2) = (unsigned short)cvtpk(tanhf_(mx[3]), 0.f); *(LAS unsigned short*)(L + O_ALT + i * S64 + c * 2) = (unsigned short)cvtpk(mx[4], 0.f);
            const float kx = vk[j] * kkc; const float ss = wave_sum(kx * kx);
            vkk[j] = kx * __builtin_amdgcn_rsqf(ss + 1e-6f);
        }
        __syncthreads();
        {
            const f32x4 z = (f32x4){0.f, 0.f, 0.f, 0.f};
            const f32x4 tw = mm_tile<2>(L + O_WLT, S64, L + O_WUP + 16 * q * SW, SW, z, lane);
            const f32x4 ta = mm_tile<2>(L + O_ALT, S64, L + O_AUP + 16 * q * SW, SW, z, lane);
#pragma unroll
            for (int e = 0; e < 4; ++e) { ((LAS float*)(L + O_LW))[(4 * fg + e) * 64 + 16 * q + fr] = tw[e]; ((LAS float*)(L + O_LA))[(4 * fg + e) * 64 + 16 * q + fr] = ta[e]; }
        }
        __syncthreads();
#pragma unroll
        for (int j = 0; j < 4; ++j) { const int i = q + 4 * j;
            const float wlog = -softplusf_(-(w0c + ((LAS float*)(L + O_LW))[i * 64 + c])) - 0.5f;
            lw[j] = -__expf(wlog);
            av[j] = sigmoidf_(a0c + ((LAS float*)(L + O_LA))[i * 64 + c]);
            ((LAS float*)(L + O_LW))[i * 64 + c] = lw[j]; }
        __syncthreads();
        if (t4 < 64) { float cum = 0.f;
#pragma unroll
            for (int t = 0; t < 16; ++t) { cum += ((LAS float*)(L + O_LW))[t * 64 + c]; ((LAS float*)(L + O_LW))[t * 64 + c] = cum; } }
        __syncthreads();
        {
            const float cumC = ((LAS float*)(L + O_LW))[15 * 64 + c];
#pragma unroll
            for (int j = 0; j < 4; ++j) { const int i = q + 4 * j;
                const float cum = ((LAS float*)(L + O_LW))[i * 64 + c];
                const float Wt = __expf(cum), Wp = __expf(cum - lw[j]), Wi = __expf(-cum), Wc = __expf(cumC - cum);
                const float kd = vk[j] * (1.f + (av[j] - 1.f) * kac), bb = vkk[j] * av[j];
                const unsigned p0 = cvtpk(vkk[j] * Wp, vr[j] * Wt), p1 = cvtpk(bb * Wi, kd * Wi), p2 = cvtpk(vv[j], bb * Wc), p3 = cvtpk(kd * Wc, 0.f);
                *(LAS unsigned short*)(L + O_KKT + i * S64 + c * 2) = (unsigned short)p0; *(LAS unsigned short*)(L + O_RT + i * S64 + c * 2) = (unsigned short)(p0 >> 16);
                *(LAS unsigned short*)(L + O_BT + i * S64 + c * 2) = (unsigned short)p1; *(LAS unsigned short*)(L + O_KDT + i * S64 + c * 2) = (unsigned short)(p1 >> 16);
                *(LAS unsigned short*)(L + O_VT + c * S32 + i * 2) = (unsigned short)p2; *(LAS unsigned short*)(L + O_BHT + c * S32 + i * 2) = (unsigned short)(p2 >> 16);
                *(LAS unsigned short*)(L + O_KHT + c * S32 + i * 2) = (unsigned short)p3;
                const float bs = wave_sum(vr[j] * kd * rkc);
                if (!isctx && lane == 0) { const int t = dir ? (T - 1 - (sbase + i)) : (sbase + i); bon[((size_t)b * SEQ + t) * 8 + h] = bs; }
            }
            if (q == 3) ((LAS float*)(L + O_WC))[c] = __expf(cumC);
        }
        __syncthreads();
        {
            const lbyte* Aj = L + ((q & 1) ? O_KDT : O_BT);
            const lbyte* Bt = L + ((q & 2) ? O_RT : O_KKT);
            f32x4 g4 = mm_tile<2>(Aj, S64, Bt, S64, (f32x4){0.f, 0.f, 0.f, 0.f}, lane);
#pragma unroll
            for (int e = 0; e < 4; ++e) { const int j = 4 * fg + e; const bool keep = (q & 2) ? (j <= fr) : (j < fr); g4[e] = keep ? g4[e] : 0.f; }
            if (q == 0) { float X[16]; tri_inv16(g4, lane, X);
                if (lane < 16) {
#pragma unroll
                    for (int i = 0; i < 16; ++i) *(LAS unsigned short*)(L + O_TI + i * S32 + lane * 2) = (unsigned short)cvtpk(X[i], 0.f); } }
            else st_bf16x4(L + (q == 1 ? O_MK : (q == 2 ? O_NB : O_NK)) + fr * S32 + fg * 8, g4);
        }
        __syncthreads();
        f32x4 yacc;
        {
            f32x4 u4 = mm_tile<2>(L + O_KKT, S64, L + O_SBF + 16 * q * S64, S64, (f32x4){0.f, 0.f, 0.f, 0.f}, lane);
            u4 = mm_tile<1>(L + O_MK, S32, L + O_VT + 16 * q * S32, S32, u4, lane);
            st_bf16x4(L + O_UTT + (16 * q + fr) * S32 + fg * 8, u4);
            yacc = mm_tile<2>(L + O_SBF + 16 * q * S64, S64, L + O_RT, S64, (f32x4){0.f, 0.f, 0.f, 0.f}, lane);
            yacc = mm_tile<1>(L + O_VT + 16 * q * S32, S32, L + O_NK, S32, yacc, lane);
        }
        asm volatile("s_waitcnt lgkmcnt(0)" ::: "memory");
        {
            f32x4 u4 = mm_tile<1>(L + O_TI, S32, L + O_UTT + 16 * q * S32, S32, (f32x4){0.f, 0.f, 0.f, 0.f}, lane);
            st_bf16x4(L + O_UT + (16 * q + fr) * S32 + fg * 8, -u4);
        }
        __syncthreads();
        {
            yacc = mm_tile<1>(L + O_UT + 16 * q * S32, S32, L + O_NB, S32, yacc, lane);
            if (!isctx) { const int t = dir ? (T - 1 - (sbase + fr)) : (sbase + fr);
                u32x2 w; w.x = cvtpk(yacc[0], yacc[1]); w.y = cvtpk(yacc[2], yacc[3]);
                *(u32x2*)(ydir + ((size_t)b * SEQ + t) * D + 64 * h + 16 * q + 4 * fg) = w; }
            const f32x4 wc4 = *(LAS f32x4*)(L + O_WC + (16 * q + 4 * fg) * 4);
#pragma unroll
            for (int vi = 0; vi < 4; ++vi) {
                f32x4 s4 = Sacc[vi] * wc4;
                s4 = mm_tile<1>(L + O_KHT + 16 * q * S32, S32, L + O_VT + 16 * vi * S32, S32, s4, lane);
                s4 = mm_tile<1>(L + O_BHT + 16 * q * S32, S32, L + O_UT + 16 * vi * S32, S32, s4, lane);
                Sacc[vi] = s4;
                st_bf16x4(L + O_SBF + (16 * vi + fr) * S64 + (16 * q + 4 * fg) * 2, s4);
            }
        }
    }
    __syncthreads();
}

__device__ __forceinline__ void phase_gdn_prep(const Args& A, Ctx& C) {
    const bf16_t* P = WSP(bf16_t, WS_P);
    bf16_t* QKV = (bf16_t*)A.out; float* NRM = WSP(float, WS_NRM);
    lfloat* part = (lfloat*)C.lds;
    const int tid = C.tid, lane = C.lane, w = C.wave;
    float cw[3][5];
#pragma unroll
    for (int g = 0; g < 3; ++g)
#pragma unroll
        for (int e = 0; e < 5; ++e) cw[g][e] = A.in[I_CONVW][e * 1536 + g * 512 + tid];
    for (int tile = C.bid; tile < NROWS / 16; tile += C.G) {
        const int row0 = tile * 16;
        int T, ta; size_t rowbase;
        if (row0 < NLAT) { T = SEQ; rowbase = (size_t)(row0 >> 11) * SEQ; ta = row0 & (SEQ - 1); } else { T = CTX; const int r = row0 - NLAT; rowbase = (size_t)NLAT + (size_t)(r >> 8) * CTX; ta = r & (CTX - 1); }
        float x[3][20];
#pragma unroll
        for (int e = 0; e < 20; ++e) { const int t = ta - 2 + e; const bool ok = (t >= 0 && t < T); const bf16_t* pr = P + (rowbase + (ok ? t : ta)) * PLD + RW_COLS + tid;
#pragma unroll
            for (int g = 0; g < 3; ++g) { const float xv = bf2f(pr[g * 512]); x[g][e] = ok ? xv : 0.f; } }
        __syncthreads();
#pragma unroll
        for (int i = 0; i < 16; ++i) { float y[3];
#pragma unroll
            for (int g = 0; g < 3; ++g) { float sacc = 0.f;
#pragma unroll
                for (int f = 0; f < 5; ++f) sacc += cw[g][f] * x[g][i + f];
                y[g] = siluf_(sacc); }
            bf16_t* orow = QKV + (rowbase + ta + i) * 1536 + tid;
            orow[0] = (bf16_t)cvtpk(y[0], 0.f); orow[512] = (bf16_t)cvtpk(y[1], 0.f); orow[1024] = (bf16_t)cvtpk(y[2], 0.f);
            const float sq = wave_sum(y[0] * y[0]), sk = wave_sum(y[1] * y[1]);
            if (lane == 0) { part[(i * 8 + w) * 2] = sq; part[(i * 8 + w) * 2 + 1] = sk; } }
        __syncthreads();
        if (tid < 128) { const int i = tid >> 3, sidx = tid & 7, h = sidx & 3, sel = sidx >> 2;
            const float ss = part[(i * 8 + 2 * h) * 2 + sel] + part[(i * 8 + 2 * h + 1) * 2 + sel];
            NRM[(rowbase + ta + i) * 8 + sidx] = __builtin_amdgcn_rsqf(ss + 1e-6f) * (sel ? 1.f : 0.08838834764831845f); }
    }
    __syncthreads();
}

namespace gd {
constexpr int S128 = 288, S32 = 80;
constexpr int O_QR = 0, O_KR = O_QR + 8192, O_KT = O_KR + 8192, O_QT = O_KT + 16 * S128, O_KKT = O_QT + 16 * S128, O_RT = O_KKT + 16 * S128,
              O_VT = O_RT + 16 * S128, O_BHT = O_VT + 128 * S32, O_KHT = O_BHT + 128 * S32, O_UT = O_KHT + 128 * S32, O_UTT = O_UT + 128 * S32,
              O_TI = O_UTT + 128 * S32, O_MK = O_TI + 16 * S32, O_NB = O_MK + 16 * S32, O_NK = O_NB + 16 * S32,
              O_SBF = O_NK + 16 * S32, O_SC = O_SBF + 128 * S128, GD_BYTES = O_SC + 512;
static_assert(GD_BYTES <= LDS_MISC, "gdn LDS");
}
__device__ __forceinline__ void gdn_chain_chunked(const Args& A, Ctx& C, int chain) {
    using namespace gd;
    const int b = chain >> 3, h = (chain >> 1) & 3, dir = chain & 1;
    lbyte* L = C.lds;
    LAS float* SC = (LAS float*)(L + O_SC);
    const bf16_t* P = WSP(bf16_t, WS_P);
    bf16_t* ydir = WSP(bf16_t, WS_YDIR) + (size_t)dir * NLAT * D;
    const int tid = C.tid, lane = C.lane, w = C.wave, fr = lane & 15, fg = lane >> 4;
    const int grp = tid >> 7, idx = tid & 127;
    const int ccol = grp * 512 + 128 * h + idx;
    float cw[5];
#pragma unroll
    for (int e = 0; e < 5; ++e) cw[e] = grp < 3 ? A.in[I_CONVW][e * 1536 + ccol] : 0.f;
    const float Aexp = __expf(A.in[I_ALOG][dir * 4 + h]), dtb = A.in[I_DTB][dir * 4 + h];
    __syncthreads();
#pragma unroll 2
    for (int i = tid; i < (5 * 128 * S32 + 4 * 16 * S32 + 128 * S128) / 4; i += 512) ((LAS unsigned*)(L + O_VT))[i] = 0u;
    f32x4 Sacc[8];
#pragma unroll
    for (int i = 0; i < 8; ++i) Sacc[i] = (f32x4){0.f, 0.f, 0.f, 0.f};
    const bf16_t* QKV = (const bf16_t*)A.out; const float* NRM = WSP(const float, WS_NRM);
    unsigned short rq[4], rk[4], rv[4]; float nq[4], nk[4]; unsigned short raw_al = 0, raw_be = 0;
    auto chunk_geom = [&](int ch, bool& isctx, int& sbase, int& T, size_t& rowbase) { isctx = ch < 16; sbase = isctx ? ch * 16 : (ch - 16) * 16; T = isctx ? CTX : SEQ;
        rowbase = isctx ? (size_t)NLAT + (size_t)b * CTX : (size_t)b * SEQ; };
    auto issue_loads = [&](int ch) { bool isctx; int sbase, T; size_t rowbase; chunk_geom(ch, isctx, sbase, T, rowbase);
#pragma unroll
        for (int j = 0; j < 4; ++j) { const int i = grp + 4 * j; const int t = dir ? (T - 1 - (sbase + i)) : (sbase + i); const size_t row = rowbase + t;
            const bf16_t* qr = QKV + row * 1536 + 128 * h + idx; rq[j] = qr[0]; rk[j] = qr[512]; rv[j] = qr[1024]; nq[j] = NRM[row * 8 + h]; nk[j] = NRM[row * 8 + 4 + h]; }
        if (w == 7 && lane < 16) { const int t = dir ? (T - 1 - (sbase + lane)) : (sbase + lane); const bf16_t* pr = P + (rowbase + t) * PLD + RW_COLS + 2048; raw_al = pr[dir * 4 + h]; raw_be = pr[8 + dir * 4 + h]; } };
    issue_loads(0);
    for (int ch = 0; ch < 144; ++ch) {
        bool isctx; int sbase, T; size_t rowbase; chunk_geom(ch, isctx, sbase, T, rowbase);
        __syncthreads();
        float qv[4], kv[4], vv[4], nqv[4], nkv[4];
#pragma unroll
        for (int j = 0; j < 4; ++j) { qv[j] = bf2f(rq[j]); kv[j] = bf2f(rk[j]); vv[j] = bf2f(rv[j]); nqv[j] = nq[j]; nkv[j] = nk[j]; }
        if (w == 7) {
            const float gi = (lane < 16) ? -Aexp * softplusf_(bf2f(raw_al) + dtb) : 0.f;
            float cum = gi;
            cum += __builtin_bit_cast(float, __builtin_amdgcn_update_dpp(0, __builtin_bit_cast(int, cum), 0x111, 0xf, 0xf, true));
            cum += __builtin_bit_cast(float, __builtin_amdgcn_update_dpp(0, __builtin_bit_cast(int, cum), 0x112, 0xf, 0xf, true));
            cum += __builtin_bit_cast(float, __builtin_amdgcn_update_dpp(0, __builtin_bit_cast(int, cum), 0x114, 0xf, 0xf, true));
            cum += __builtin_bit_cast(float, __builtin_amdgcn_update_dpp(0, __builtin_bit_cast(int, cum), 0x118, 0xf, 0xf, true));
            if (lane < 16) { SC[16 + lane] = sigmoidf_(bf2f(raw_be)); SC[64 + lane + 1] = cum; if (lane == 0) SC[64] = 0.f; }
        }
        if (ch + 1 < 144) issue_loads(ch + 1);
        __syncthreads();
        {
            const int c = idx; const float gcC = SC[64 + 16];
#pragma unroll
            for (int j = 0; j < 4; ++j) { const int i = grp + 4 * j;
                const float kn = kv[j] * nkv[j], qn = qv[j] * nqv[j];
                const float gm = SC[64 + i], gi = SC[64 + i + 1], be = SC[16 + i];
                const unsigned p0 = cvtpk(kn, qn), p1 = cvtpk(kn * __expf(gm), qn * __expf(gi)), p2 = cvtpk(be * kn * __expf(gcC - gm), be * kn * __expf(gcC - gi));
                *(LAS unsigned short*)(L + O_KT + i * S128 + c * 2) = (unsigned short)p0; *(LAS unsigned short*)(L + O_QT + i * S128 + c * 2) = (unsigned short)(p0 >> 16);
                *(LAS unsigned short*)(L + O_KKT + i * S128 + c * 2) = (unsigned short)p1; *(LAS unsigned short*)(L + O_RT + i * S128 + c * 2) = (unsigned short)(p1 >> 16);
                *(LAS unsigned short*)(L + O_BHT + c * S32 + i * 2) = (unsigned short)p2; *(LAS unsigned short*)(L + O_KHT + c * S32 + i * 2) = (unsigned short)(p2 >> 16);
                *(LAS unsigned short*)(L + O_VT + c * S32 + i * 2) = (unsigned short)cvtpk(vv[j], 0.f); }
        }
        __syncthreads();
        if (w < 2) {
            const f32x4 g4 = mm_tile<4>(L + O_KT, S128, L + (w ? O_QT : O_KT), S128, (f32x4){0.f, 0.f, 0.f, 0.f}, lane);
            const float gt = w ? SC[64 + fr + 1] : SC[64 + fr];
            f32x4 m0, m1;
#pragma unroll
            for (int e = 0; e < 4; ++e) { const int j = 4 * fg + e; const bool keep = w ? (j <= fr) : (j < fr);
                const float bj = SC[16 + j] * g4[e];
                m0[e] = keep ? bj * __expf(gt - SC[64 + j]) : 0.f;
                m1[e] = keep ? bj * __expf(gt - SC[64 + j + 1]) : 0.f; }
            if (w == 0) { st_bf16x4(L + O_MK + fr * S32 + fg * 8, m1);
                float X[16]; tri_inv16(m0, lane, X);
                if (lane < 16) {
#pragma unroll
                    for (int i = 0; i < 16; ++i) *(LAS unsigned short*)(L + O_TI + i * S32 + lane * 2) = (unsigned short)cvtpk(X[i], 0.f); } }
            else { st_bf16x4(L + O_NB + fr * S32 + fg * 8, m0); st_bf16x4(L + O_NK + fr * S32 + fg * 8, m1); }
        }
        __syncthreads();
        f32x4 yacc;
        {
            f32x4 u4 = mm_tile<4>(L + O_KKT, S128, L + O_SBF + 16 * w * S128, S128, (f32x4){0.f, 0.f, 0.f, 0.f}, lane);
            u4 = mm_tile<1>(L + O_MK, S32, L + O_VT + 16 * w * S32, S32, u4, lane);
            st_bf16x4(L + O_UTT + (16 * w + fr) * S32 + fg * 8, u4);
            yacc = mm_tile<4>(L + O_SBF + 16 * w * S128, S128, L + O_RT, S128, (f32x4){0.f, 0.f, 0.f, 0.f}, lane);
            yacc = mm_tile<1>(L + O_VT + 16 * w * S32, S32, L + O_NK, S32, yacc, lane);
        }
        asm volatile("s_waitcnt lgkmcnt(0)" ::: "memory");
        {
            const f32x4 u4 = mm_tile<1>(L + O_TI, S32, L + O_UTT + 16 * w * S32, S32, (f32x4){0.f, 0.f, 0.f, 0.f}, lane);
            st_bf16x4(L + O_UT + (16 * w + fr) * S32 + fg * 8, -u4);
        }
        __syncthreads();
        {
            yacc = mm_tile<1>(L + O_UT + 16 * w * S32, S32, L + O_NB, S32, yacc, lane);
            if (!isctx) { const int t = dir ? (T - 1 - (sbase + fr)) : (sbase + fr);
                u32x2 pk; pk.x = cvtpk(yacc[0], yacc[1]); pk.y = cvtpk(yacc[2], yacc[3]);
                *(u32x2*)(ydir + ((size_t)b * SEQ + t) * D + 512 + 128 * h + 16 * w + 4 * fg) = pk; }
            const float wc = __expf(SC[64 + 16]);
#pragma unroll
            for (int vi = 0; vi < 8; ++vi) {
                f32x4 s4 = Sacc[vi] * wc;
                s4 = mm_tile<1>(L + O_KHT + 16 * w * S32, S32, L + O_VT + 16 * vi * S32, S32, s4, lane);
                s4 = mm_tile<1>(L + O_BHT + 16 * w * S32, S32, L + O_UT + 16 * vi * S32, S32, s4, lane);
                Sacc[vi] = s4;
                st_bf16x4(L + O_SBF + (16 * vi + fr) * S128 + (16 * w + 4 * fg) * 2, s4);
            }
        }
    }
    __syncthreads();
}

__device__ __forceinline__ void unpack8(const u32x4 w, float (&f)[8]) { f[0] = bflo(w.x); f[1] = bfhi(w.x); f[2] = bflo(w.y); f[3] = bfhi(w.y); f[4] = bflo(w.z); f[5] = bfhi(w.z); f[6] = bflo(w.w); f[7] = bfhi(w.w); }
__device__ __forceinline__ void phase_p4(const Args& A, Ctx& C) {
    const bf16_t* P = WSP(bf16_t, WS_P);
    const bf16_t* yf = WSP(bf16_t, WS_YDIR); const bf16_t* yb = yf + (size_t)NLAT * D;
    const float* bon = WSP(float, WS_BON);
    bf16_t* ymix = WSP(bf16_t, WS_YMIX);
    lbyte* SGb = C.lds;
    lfloat* GO = (lfloat*)(C.lds + 8192);
    const int tid = C.tid, lane = C.lane, w = C.wave;
    const bf16_t* gupt = WSP(const bf16_t, WS_GUPT);
    const int fr = lane & 15, fg = lane >> 4;
    const int c8 = 8 * lane;
    float lnw[8], lnb[8], ong[8], muv[8];
#pragma unroll
    for (int e = 0; e < 8; ++e) { lnw[e] = A.in[I_LNW][c8 + e]; lnb[e] = A.in[I_LNB][c8 + e]; ong[e] = A.in[I_ONG][(c8 + e) & 127]; muv[e] = A.in[I_MU][1024 + c8 + e]; }
    const int tkA = tid >> 5, lA = 4 * (tid & 31);
    float muA[4];
#pragma unroll
    for (int e = 0; e < 4; ++e) muA[e] = A.in[I_MU][1792 + lA + e];
    const bool vup = (1024 + c8) < 1440;
    for (int tile = C.bid; tile < NLAT / 16; tile += C.G) {
        const int row0 = tile * 16;
        __syncthreads();
        {
            const int row = row0 + tkA, t = row & (SEQ - 1); const bool ok = t < SEQ - 64;
            const u32x2 pw = *(const u32x2*)(P + (size_t)row * PLD + 1792 + lA); const u32x2 sw = *(const u32x2*)(P + (size_t)(row + (ok ? 64 : 0)) * PLD + 1792 + lA);
            const float pv[4] = {bflo(pw.x), bfhi(pw.x), bflo(pw.y), bfhi(pw.y)}; const float sv[4] = {bflo(sw.x), bfhi(sw.x), bflo(sw.y), bfhi(sw.y)};
            float o[4];
#pragma unroll
            for (int e = 0; e < 4; ++e) o[e] = sigmoidf_(pv[e] + muA[e] * ((ok ? sv[e] : 0.f) - pv[e]));
            u32x2 ow; ow.x = cvtpk(o[0], o[1]); ow.y = cvtpk(o[2], o[3]); *(LAS u32x2*)(SGb + tkA * 288 + lA * 2) = ow;
        }
        __syncthreads();
#pragma unroll
        for (int i = 0; i < 4; ++i) { const int c0 = 64 * w + 16 * i; f32x4 acc = (f32x4){0.f, 0.f, 0.f, 0.f};
#pragma unroll
            for (int ks = 0; ks < 4; ++ks) { const bf16x8 a = *(const LAS bf16x8*)(SGb + fr * 288 + ks * 64 + fg * 16);
                const bf16x8 bq = *(const bf16x8*)(gupt + (size_t)(c0 + fr) * 128 + ks * 32 + fg * 8);
                acc = __builtin_amdgcn_mfma_f32_16x16x32_bf16(a, bq, acc, 0, 0, 0); }
#pragma unroll
            for (int e = 0; e < 4; ++e) GO[(4 * fg + e) * 512 + c0 + fr] = acc[e]; }
        __syncthreads();
#pragma unroll
        for (int tt = 0; tt < 2; ++tt) {
            const int tk = 2 * w + tt, row = row0 + tk, t = row & (SEQ - 1);
            const bool okv = vup ? (t >= 64) : (t < SEQ - 64);
            const u32x4 wyf = *(const u32x4*)(yf + (size_t)row * D + c8), wyb = *(const u32x4*)(yb + (size_t)row * D + c8);
            const u32x4 wpv = *(const u32x4*)(P + (size_t)row * PLD + 1024 + c8), wsv = *(const u32x4*)(P + (size_t)(row + (okv ? (vup ? -64 : 64) : 0)) * PLD + 1024 + c8);
            const u32x4 wof = *(const u32x4*)(yf + (size_t)row * D + 512 + c8), wob = *(const u32x4*)(yb + (size_t)row * D + 512 + c8);
            const u32x4 wz = *(const u32x4*)(P + (size_t)row * PLD + RW_COLS + 1536 + c8);
            const float bs = bon[(size_t)row * 8 + (lane >> 3)] + bon[((size_t)NLAT + row) * 8 + (lane >> 3)];
            const f32x4 g0 = *(const LAS f32x4*)(GO + tk * 512 + c8), g1 = *(const LAS f32x4*)(GO + tk * 512 + c8 + 4);
            const float gg[8] = {g0.x, g0.y, g0.z, g0.w, g1.x, g1.y, g1.z, g1.w};
            float a[8], bq[8], pv[8], sv[8], y[8];
            unpack8(wyf, a); unpack8(wyb, bq); unpack8(wpv, pv); unpack8(wsv, sv);
            float s1 = 0.f;
#pragma unroll
            for (int e = 0; e < 8; ++e) { y[e] = a[e] + bq[e]; s1 += y[e]; }
            s1 += __shfl_xor(s1, 1); s1 += __shfl_xor(s1, 2); s1 += __shfl_xor(s1, 4);
            const float m = s1 * (1.f / 64.f);
            float s2 = 0.f;
#pragma unroll
            for (int e = 0; e < 8; ++e) { y[e] -= m; s2 += y[e] * y[e]; }
            s2 += __shfl_xor(s2, 1); s2 += __shfl_xor(s2, 2); s2 += __shfl_xor(s2, 4);
            const float rs = __builtin_amdgcn_rsqf(s2 * (1.f / 64.f) + RWKV_EPS);
            float o[8];
#pragma unroll
            for (int e = 0; e < 8; ++e) { const float vv = pv[e] + muv[e] * ((okv ? sv[e] : 0.f) - pv[e]); o[e] = (y[e] * rs * lnw[e] + lnb[e] + bs * vv) * gg[e]; }
            u32x4 ow; ow.x = cvtpk(o[0], o[1]); ow.y = cvtpk(o[2], o[3]); ow.z = cvtpk(o[4], o[5]); ow.w = cvtpk(o[6], o[7]);
            *(u32x4*)(ymix + (size_t)row * D + c8) = ow;
            float of[8], ob[8], z[8];
            unpack8(wof, of); unpack8(wob, ob); unpack8(wz, z);
            float s3 = 0.f;
#pragma unroll
            for (int e = 0; e < 8; ++e) { of[e] += ob[e]; s3 += of[e] * of[e]; }
            s3 += __shfl_xor(s3, 1); s3 += __shfl_xor(s3, 2); s3 += __shfl_xor(s3, 4); s3 += __shfl_xor(s3, 8);
            const float rg = __builtin_amdgcn_rsqf(s3 * (1.f / 128.f) + NORM_EPS);
#pragma unroll
            for (int e = 0; e < 8; ++e) o[e] = of[e] * rg * ong[e] * siluf_(z[e]);
            ow.x = cvtpk(o[0], o[1]); ow.y = cvtpk(o[2], o[3]); ow.z = cvtpk(o[4], o[5]); ow.w = cvtpk(o[6], o[7]);
            *(u32x4*)(ymix + (size_t)row * D + 512 + c8) = ow;
        }
    }
}

__device__ __forceinline__ void convert_experts(const Args& A, Ctx& C) {
    lfloat* scr = (lfloat*)(C.lds + C.wave * 16384);
    const int gw = C.bid * 8 + C.wave, NGW = C.G * 8;
    constexpr int I13 = (D / 64) * (DE / 32);
    constexpr int I2 = (DE / 64) * (D / 32);
    constexpr int PER = 2 * I13 + I2;
    for (int it = gw; it < 257 * PER; it += NGW) {
        const int e = it / PER; int r = it % PER;
        bf16_t* bt13 = (bf16_t*)(A.ws + WS_WEXP + (size_t)e * WEXP_STRIDE); bf16_t* bt2 = bt13 + 512 * 1024;
        const float* w1 = e < NE ? A.in[I_EW1] + (size_t)e * D * DE : A.in[I_SW1];
        const float* w3 = e < NE ? A.in[I_EW3] + (size_t)e * D * DE : A.in[I_SW3];
        const float* w2 = e < NE ? A.in[I_EW2] + (size_t)e * DE * D : A.in[I_SW2];
        if (r < I13) { transpose_item(w1, D, DE, bt13, RowGLU{0}, scr, r, C.lane); continue; } r -= I13;
        if (r < I13) { transpose_item(w3, D, DE, bt13, RowGLU{128}, scr, r, C.lane); continue; } r -= I13;
        transpose_item(w2, DE, D, bt2, RowId(), scr, r, C.lane);
    }
}

__device__ __forceinline__ void phase_p6(const Args& A, Ctx& C) {
    const float* mod = WSP(float, WS_MOD); bf16_t* h2n = WSP(bf16_t, WS_H2N);
    const int gw = C.bid * 8 + C.wave, NGW = C.G * 8;
    for (int row = gw; row < NLAT; row += NGW) {
        const float* m = mod + (size_t)(row >> 11) * MODW;
        norm_mod_row(A.out + (size_t)row * D, A.in[I_N2G], m + 4 * D, m + 3 * D, h2n + (size_t)row * D, C.lane);
    }
}

__device__ __forceinline__ void phase_p8(const Args& A, Ctx& C) {
    const float* logit = WSP(float, WS_LOGIT);
    int* tope = WSP(int, WS_TOPE); float* topw = WSP(float, WS_TOPW); int* pos = WSP(int, WS_POS);
    unsigned* cnt = WSP(unsigned, WS_CTL) + CW_CNT;
    const int gw = C.bid * 8 + C.wave, NGW = C.G * 8, lane = C.lane;
    const f32x4 rb = ((const f32x4*)A.in[I_RB])[lane];
    for (int tok = gw; tok < NLAT; tok += NGW) {
        const f32x4 lg = ((const f32x4*)(logit + (size_t)tok * NE))[lane];
        float s[4], sel[4];
#pragma unroll
        for (int i = 0; i < 4; ++i) { s[i] = sigmoidf_(lg[i]); sel[i] = s[i] + rb[i]; }
        float m1 = fmaxf(fmaxf(sel[0], sel[1]), fmaxf(sel[2], sel[3]));
        float m2;
        {
            float a = fmaxf(sel[0], sel[1]), bq = fminf(sel[0], sel[1]), cq = fmaxf(sel[2], sel[3]), dq = fminf(sel[2], sel[3]);
            m2 = fmaxf(fminf(a, cq), fmaxf(bq, dq)); }
#pragma unroll
        for (int o = 1; o < 8; o <<= 1) { const float o1 = __shfl_xor(m1, o), o2 = __shfl_xor(m2, o);
            const float n1 = fmaxf(m1, o1); const float n2 = fmaxf(fminf(m1, o1), fmaxf(m2, o2)); m1 = n1; m2 = n2; }
        const float gs = m1 + m2;
        const int grp = lane >> 3;
        int rank = 0;
#pragma unroll
        for (int gq = 0; gq < 8; ++gq) { const float og = __shfl(gs, gq * 8); rank += (og > gs || (og == gs && gq < grp)) ? 1 : 0; }
        const bool gsel = rank < 4;
        float cand[4];
#pragma unroll
        for (int i = 0; i < 4; ++i) cand[i] = gsel ? sel[i] : -INFINITY;
        int my_e = 0; float my_w = 0.f; float wsum = 0.f;
#pragma unroll
        for (int r = 0; r < 8; ++r) {
            float bv = cand[0]; int bi = 0;
#pragma unroll
            for (int i = 1; i < 4; ++i) if (cand[i] > bv) { bv = cand[i]; bi = i; }
            int be = lane * 4 + bi;
#define P8_STEP(CTRL) { const float ov = dpp_f<CTRL>(bv); const int oe = __builtin_amdgcn_update_dpp(0, be, CTRL, 0xf, 0xf, false); if (ov > bv || (ov == bv && oe < be)) { bv = ov; be = oe; } }
            P8_STEP(0x128) P8_STEP(0x124) P8_STEP(0x122) P8_STEP(0x121)
#undef P8_STEP
            float gv = rdlane(bv, 0); int ge = __builtin_amdgcn_readlane(be, 0);
#pragma unroll
            for (int rr = 1; rr < 4; ++rr) { const float ov = rdlane(bv, 16 * rr); const int oe = __builtin_amdgcn_readlane(be, 16 * rr); if (ov > gv || (ov == gv && oe < ge)) { gv = ov; ge = oe; } }
            be = ge;
            const int ol = be >> 2, oi = be & 3;
            const float mys = oi == 0 ? s[0] : (oi == 1 ? s[1] : (oi == 2 ? s[2] : s[3]));
            const float ws_ = __shfl(mys, ol);
            if (lane == ol) { if (oi == 0) cand[0] = -INFINITY; else if (oi == 1) cand[1] = -INFINITY; else if (oi == 2) cand[2] = -INFINITY; else cand[3] = -INFINITY; }
            wsum += ws_;
            if (lane == r) { my_e = be; my_w = ws_; }
        }
        if (lane < 8) {
            const float w = my_w / wsum * 2.5f;
            const unsigned p = atomicAdd(cnt + my_e, 1u);
            tope[(size_t)tok * 8 + lane] = my_e; topw[(size_t)tok * 8 + lane] = w; pos[(size_t)tok * 8 + lane] = (int)p;
        }
    }
}

__device__ __forceinline__ void tile_prefix(const Args& A, Ctx& C, LAS int* tb) {
    const unsigned* cnt = WSP(unsigned, WS_CTL) + CW_CNT;
    if (C.tid == 0) { int acc = 0; for (int e = 0; e < NE; ++e) { tb[e] = acc; acc += ((int)cnt[e] + 255) >> 8; } tb[NE] = acc; }
    __syncthreads();
}
__device__ __forceinline__ void phase_p9(const Args& A, Ctx& C) {
    LAS int* tb = (LAS int*)C.lds;
    tile_prefix(A, C, tb);
    const unsigned* cnt = WSP(unsigned, WS_CTL) + CW_CNT;
    const int* tope = WSP(int, WS_TOPE); const float* topw = WSP(float, WS_TOPW); const int* pos = WSP(int, WS_POS);
    int* rowl = WSP(int, WS_ROWL); float* roww = WSP(float, WS_ROWW); int* tile_e = WSP(int, WS_TILEE);
    const int nrt = tb[NE];
    for (int i = C.bid * 512 + C.tid; i < NLAT * 8; i += C.G * 512) { const int e = tope[i]; const int pr = tb[e] * 256 + pos[i]; rowl[pr] = i; roww[pr] = topw[i]; }
    for (int e = C.bid; e < NE; e += C.G) { const int n = (int)cnt[e], nt = tb[e + 1] - tb[e];
        for (int j = n + C.tid; j < nt * 256; j += 512) { rowl[tb[e] * 256 + j] = -1; roww[tb[e] * 256 + j] = 0.f; }
        for (int k = C.tid; k < nt; k += 512) tile_e[tb[e] + k] = e; }
    for (int i = C.bid * 512 + C.tid; i < NLAT; i += C.G * 512) { rowl[nrt * 256 + i] = i; roww[nrt * 256 + i] = 1.f; }
    for (int k = C.bid * 512 + C.tid; k < NLAT / 256; k += C.G * 512) tile_e[nrt + k] = NE;
    __syncthreads();
}

__device__ __forceinline__ void phase_moe(const Args& A, Ctx& C, int dry_shared) {
    LAS int* tb = (LAS int*)(C.lds + 131072);
    LAS int* tbl = tb + 320;
    tile_prefix(A, C, tb);
    pg8::MoeCtx M;
    M.nrt = tb[NE]; M.ntiles = M.nrt + NLAT / 256; M.G = C.G; M.vc = (C.G % 8 == 0) ? (C.bid % 8) * (C.G / 8) + C.bid / 8 : C.bid;
    M.tb = tb; M.tbl = tbl; M.cnt = WSP(unsigned, WS_CTL) + CW_CNT; M.rowl = WSP(int, WS_ROWL); M.roww = WSP(float, WS_ROWW);
    M.wexp = (const char*)(A.ws + WS_WEXP); M.h2n = (const char*)(A.ws + WS_H2N); M.Hs = (char*)(A.ws + WS_HS) + (size_t)C.bid * 256 * 256 * 2;
    M.Y = (unsigned char*)(A.ws + WS_Y); M.out = A.out; M.mod = WSP(const float, WS_MOD); M.dry_shared = dry_shared;
    pg8::gemm_moe(C.lds, M);
    __syncthreads();
}

__device__ __forceinline__ void phase_final(const Args& A, Ctx& C, float* dst) {
    const int gw = C.bid * 8 + C.wave, NGW = C.G * 8;
    const float* fg = A.in[I_FG]; const float* mod = WSP(const float, WS_MOD);
    const unsigned* Y = (const unsigned*)(A.ws + WS_Y);
    for (int row = gw; row < NLAT; row += NGW) {
        f32x4* xr = (f32x4*)(A.out + (size_t)row * D) + C.lane;
        const f32x4* gt = (const f32x4*)(mod + (size_t)(row >> 11) * MODW + 5 * D) + C.lane;
        const unsigned* yr = Y + (size_t)row * 8 * (D / 4) + C.lane;
        f32x4 v[4]; float s = 0.f;
#pragma unroll
        for (int j = 0; j < 4; ++j) {
            f32x4 a = (f32x4){0.f, 0.f, 0.f, 0.f};
#pragma unroll
            for (int sl = 0; sl < 8; ++sl) { const unsigned w = yr[sl * (D / 4) + 64 * j];
                const f32x2 lo = __builtin_amdgcn_cvt_pk_f32_fp8(w, false), hi = __builtin_amdgcn_cvt_pk_f32_fp8(w, true);
                a.x += lo.x; a.y += lo.y; a.z += hi.x; a.w += hi.y; }
            v[j] = xr[64 * j] + gt[64 * j] * a * (1.f / pg8::YSCALE);
            s += (v[j].x * v[j].x + v[j].y * v[j].y) + (v[j].z * v[j].z + v[j].w * v[j].w); }
        const float rstd = __builtin_amdgcn_rsqf(wave_sum(s) * (1.f / D) + NORM_EPS);
        f32x4* orow = (f32x4*)(dst + (size_t)row * D) + C.lane;
#pragma unroll
        for (int j = 0; j < 4; ++j) orow[64 * j] = v[j] * rstd * ((const f32x4*)fg)[C.lane + 64 * j];
    }
}

constexpr int NPHASE = 13;
__global__ void __launch_bounds__(512, 2) fwd_kernel(Args A) {
    extern __shared__ __attribute__((aligned(16))) unsigned char lds_raw[];
    Ctx C; C.lds = (lbyte*)lds_raw; C.tid = threadIdx.x; C.lane = C.tid & 63; C.wave = __builtin_amdgcn_readfirstlane(C.tid >> 6);
    C.G = gridDim.x; C.bid = blockIdx.x; C.a = &A;
    volatile LAS unsigned* misc = (volatile LAS unsigned*)(C.lds + LDS_MISC);
    if (C.tid < 16) misc[C.tid] = 0u;
    __syncthreads();
    XcdBarrier bar; bar.bar = WSP(unsigned, WS_CTL) + CW_BAR; bar.x = 0; bar.st = nullptr;
    const int lo = A.ph_lo, hi = A.ph_hi;
    const bool multi = (hi - lo) > 1;
    if (multi) bar = xcd_barrier_post(WSP(unsigned, WS_CTL) + CW_BAR, misc);
#ifndef PHASE_MASK
#define PHASE_MASK 0x1FFF
#endif
#define IN(k) (((PHASE_MASK >> (k)) & 1) && lo <= (k) && (k) < hi)
#define SEAM(k) do { if (IN(k) && IN((k) + 1)) xcd_barrier(bar); } while (0)
#ifndef REP_MASK
#define REP_MASK 0
#endif
#define REPS(k) (((REP_MASK >> (k)) & 1) ? 2 : 1)

    if (IN(0)) _Pragma("unroll") for (int rep = 0; rep < REPS(0); ++rep) { phase_p0(A, C); __syncthreads(); } SEAM(0);
    if (IN(1)) _Pragma("unroll") for (int rep = 0; rep < REPS(1); ++rep) { phase_p1(A, C); } SEAM(1);
    if (IN(2)) _Pragma("unroll") for (int rep = 0; rep < REPS(2); ++rep) {
        pg8::Gemm g{WSP(bf16_t, WS_XN), D}; pg8::StaticOrder S; S.init(NROWS, PLD, C.G, C.bid, WSP(bf16_t, WS_BTIN), D);
        pg8::EpiBf16 E{WSP(bf16_t, WS_P), PLD};
        pg8::gemm_phase<pg8::EpiBf16, pg8::StaticOrder, false, 0, false>(C.lds, g, S, E);
    } SEAM(2);
    if (IN(3)) _Pragma("unroll") for (int rep = 0; rep < REPS(3); ++rep) { phase_gdn_prep(A, C); } SEAM(3);
#ifdef PROBE_BARRIERS
    if (multi) for (int kq = 0; kq < PROBE_BARRIERS; ++kq) xcd_barrier(bar);
#endif
    if (IN(4)) {
        for (int ch = C.bid; ch < NB * HB * 2; ch += C.G) gdn_chain_chunked(A, C, ch);
        for (int pr = C.bid; pr < NB * HA; pr += C.G) rwkv_pair_chunked(A, C, pr);
    } SEAM(4);
    if (IN(5)) _Pragma("unroll") for (int rep = 0; rep < REPS(5); ++rep) { phase_p4(A, C); } SEAM(5);
    if (IN(6)) _Pragma("unroll") for (int rep = 0; rep < REPS(6); ++rep) {
        pg8::Gemm g{WSP(bf16_t, WS_YMIX), D}; pg8::StaticOrder S; S.init(NLAT, D, C.G, C.bid, WSP(bf16_t, WS_BTOUT), D);
        pg8::EpiResGate E{A.in[I_X], A.out, WSP(float, WS_MOD), 2 * D};
        pg8::gemm_phase<pg8::EpiResGate, pg8::StaticOrder, false>(C.lds, g, S, E);
    } SEAM(6);
    if (IN(7)) _Pragma("unroll") for (int rep = 0; rep < REPS(7); ++rep) { phase_p6(A, C); __syncthreads(); convert_experts(A, C); __syncthreads(); } SEAM(7);
    if (IN(8)) _Pragma("unroll") for (int rep = 0; rep < REPS(8); ++rep) {
        pg8::Gemm g{WSP(bf16_t, WS_H2N), D}; pg8::StaticOrder S; S.init(NLAT, NE, C.G, C.bid, WSP(bf16_t, WS_BTR), D);
        pg8::EpiF32 E{WSP(float, WS_LOGIT), NE};
        pg8::gemm_phase<pg8::EpiF32, pg8::StaticOrder, false>(C.lds, g, S, E);
    } SEAM(8);
    if (IN(9)) { phase_p8(A, C); } SEAM(9);
    if (IN(10)) _Pragma("unroll") for (int rep = 0; rep < REPS(10); ++rep) { phase_p9(A, C); } SEAM(10);
    if (IN(11)) { phase_moe(A, C, 0); if (REPS(11) > 1) { __syncthreads(); phase_moe(A, C, 1); } } SEAM(11);
    if (IN(12)) { if (REPS(12) > 1) { phase_final(A, C, (float*)(A.ws + WS_WEXP)); __syncthreads(); } phase_final(A, C, A.out); }
#undef IN
#undef SEAM
}

extern "C" void kernel_launch(void* const* d_in, const int* in_sizes, int n_in, void* d_out, int out_size, void* d_ws, size_t ws_size, hipStream_t stream) {
    static int grid = 0;
    if (grid == 0) {
        if (n_in != 34 || out_size != NLAT * D || ws_size < WS_END) { fprintf(stderr, "kernel_launch: unexpected shapes (n_in %d out %d ws %zu need %zu)\n", n_in, out_size, ws_size, (size_t)WS_END); grid = -1; return; }
        int dev = 0, cus = 0;
        if (hipGetDevice(&dev) != hipSuccess || hipDeviceGetAttribute(&cus, hipDeviceAttributeMultiprocessorCount, dev) != hipSuccess) { grid = -1; return; }
        if (hipFuncSetAttribute((const void*)fwd_kernel, hipFuncAttributeMaxDynamicSharedMemorySize, LDS_BYTES) != hipSuccess) { fprintf(stderr, "kernel_launch: hipFuncSetAttribute failed\n"); grid = -1; return; }
        int per_cu = 0;
        if (hipOccupancyMaxActiveBlocksPerMultiprocessor(&per_cu, (const void*)fwd_kernel, 512, LDS_BYTES) != hipSuccess || per_cu < 1) { fprintf(stderr, "kernel_launch: occupancy query says %d\n", per_cu); }
        (void)hipGetLastError();
        grid = cus;
    }
    if (grid < 0) return;
    (void)hipMemsetAsync((char*)d_ws + WS_CTL, 0, CTL_BYTES, stream);
    Args a{};
    for (int i = 0; i < 34; ++i) a.in[i] = (const float*)d_in[i];
    a.out = (float*)d_out; a.ws = (unsigned char*)d_ws;
#if MK_PER_PHASE
    for (int p = 0; p < NPHASE; ++p) { a.ph_lo = p; a.ph_hi = p + 1; hipLaunchKernelGGL(fwd_kernel, dim3(grid), dim3(512), LDS_BYTES, stream, a); }
#else
    a.ph_lo = 0; a.ph_hi = NPHASE; hipLaunchKernelGGL(fwd_kernel, dim3(grid), dim3(512), LDS_BYTES, stream, a);
#endif
}
```

```cpp
#include <hip/hip_runtime.h>
#include <cstdio>
#include <cstdint>

#ifndef MK_PER_PHASE
#define MK_PER_PHASE 0
#endif

#define LAS __attribute__((address_space(3)))
typedef unsigned short bf16_t;
typedef short bf16x8 __attribute__((ext_vector_type(8)));
typedef float f32x4 __attribute__((ext_vector_type(4)));
typedef float f32x2 __attribute__((ext_vector_type(2)));
typedef unsigned u32x4 __attribute__((ext_vector_type(4)));
typedef unsigned u32x2 __attribute__((ext_vector_type(2)));
typedef int i32x4 __attribute__((ext_vector_type(4)));
typedef int i32x8 __attribute__((ext_vector_type(8)));
typedef LAS float lfloat;
typedef LAS unsigned char lbyte;

constexpr int D = 1024, NB = 32, SEQ = 2048, CTX = 256, GW = 64;
constexpr int NLAT = NB * SEQ;
constexpr int NCTX = NB * CTX;
constexpr int NROWS = NLAT + NCTX;
constexpr int DA = 512, HA = 8, NA = 64;
constexpr int RW_COLS = 1920, GD_COLS = 2064, IN_COLS = 3984, PLD = 4096;
constexpr int DB = 512, HB = 4, KB = 128;
constexpr int NE = 256, TOPK = 8, DE = 256;
constexpr int MODW = 6 * D;
constexpr float NORM_EPS = 1e-6f, RWKV_EPS = 64e-5f;
constexpr int MAXTILES = (NLAT * TOPK + NE * 255) / 256 + 1;

constexpr size_t MiB = 1u << 20;
constexpr size_t WS_CTL = 0, CTL_BYTES = 1 * MiB;
constexpr size_t WS_MOD = 1 * MiB;
constexpr size_t WS_BTIN = 2 * MiB, WS_BTOUT = 10 * MiB, WS_BTR = 12 * MiB, WS_BON = 13 * MiB, WS_GUPT = 17 * MiB, WS_NRM = 978 * MiB;
constexpr size_t WS_P = 18 * MiB, WS_XN = 594 * MiB, WS_YDIR = 594 * MiB, WS_YMIX = 850 * MiB;
constexpr size_t WS_H2N8 = 900 * MiB;
constexpr size_t WS_H2N = 18 * MiB, WS_LOGIT = 146 * MiB, WS_TOPE = 210 * MiB, WS_TOPW = 212 * MiB, WS_POS = 214 * MiB, WS_Y = 146 * MiB;
constexpr size_t WS_ROWL = 658 * MiB, WS_ROWW = 661 * MiB, WS_TILEE = 664 * MiB, WS_HS = 672 * MiB, WS_WEXP = 704 * MiB;
constexpr size_t WEXP_STRIDE = (size_t)(512 * 1024 + 1024 * 256);
constexpr float SW13 = 64.f, SW2 = 32.f, SHS = 8.f;
constexpr size_t WS_END = 1090 * MiB;
static_assert(WS_WEXP + 257 * WEXP_STRIDE <= WS_END && WS_Y + (size_t)NLAT * 8 * D <= WS_ROWL, "ws map");
constexpr int CW_BAR = 4096;
constexpr int CW_CNT = 16384;

constexpr int LDS_BYTES = 159744;
constexpr int LDS_MISC = LDS_BYTES - 64;

__device__ __forceinline__ unsigned f2bf(float f) { unsigned u = __builtin_bit_cast(unsigned, f); return (u + 0x7fffu + ((u >> 16) & 1u)) >> 16; }
typedef __bf16 bf16x2_t __attribute__((ext_vector_type(2)));
__device__ __forceinline__ unsigned cvtpk(float lo, float hi) { f32x2 v = {lo, hi}; return __builtin_bit_cast(unsigned, __builtin_convertvector(v, bf16x2_t)); }
__device__ __forceinline__ unsigned pk2(float lo, float hi) { return cvtpk(lo, hi); }
__device__ __forceinline__ unsigned pk4_fp8(float a, float b, float c, float d) { unsigned w = 0u;
    w = __builtin_amdgcn_cvt_pk_fp8_f32(__builtin_amdgcn_fmed3f(a, -448.f, 448.f), __builtin_amdgcn_fmed3f(b, -448.f, 448.f), w, false);
    w = __builtin_amdgcn_cvt_pk_fp8_f32(__builtin_amdgcn_fmed3f(c, -448.f, 448.f), __builtin_amdgcn_fmed3f(d, -448.f, 448.f), w, true); return w; }
__device__ __forceinline__ float bf2f(unsigned short b) { return __builtin_bit_cast(float, ((unsigned)b) << 16); }
__device__ __forceinline__ float bflo(unsigned w) { return __builtin_bit_cast(float, w << 16); }
__device__ __forceinline__ float bfhi(unsigned w) { return __builtin_bit_cast(float, w & 0xffff0000u); }
template <int CTRL> __device__ __forceinline__ float dpp_f(float v) { return __builtin_bit_cast(float, __builtin_amdgcn_update_dpp(0, __builtin_bit_cast(int, v), CTRL, 0xf, 0xf, false)); }
__device__ __forceinline__ float wave_sum(float v) {
    v += dpp_f<0x128>(v);
    v += dpp_f<0x124>(v);
    v += dpp_f<0x122>(v);
    v += dpp_f<0x121>(v);
    const int vi = __builtin_bit_cast(int, v);
    const float r0 = __builtin_bit_cast(float, __builtin_amdgcn_readlane(vi, 0)), r1 = __builtin_bit_cast(float, __builtin_amdgcn_readlane(vi, 16)),
                r2 = __builtin_bit_cast(float, __builtin_amdgcn_readlane(vi, 32)), r3 = __builtin_bit_cast(float, __builtin_amdgcn_readlane(vi, 48));
    return (r0 + r1) + (r2 + r3);
}
__device__ __forceinline__ float sigmoidf_(float x) { return __builtin_amdgcn_rcpf(1.f + __expf(-x)); }
__device__ __forceinline__ float siluf_(float x) { return x * __builtin_amdgcn_rcpf(1.f + __expf(-x)); }
__device__ __forceinline__ float softplusf_(float x) { return fmaxf(x, 0.f) + __logf(1.f + __expf(-fabsf(x))); }
__device__ __forceinline__ float tanhf_(float x) { const float e = __expf(-2.f * fabsf(x)); const float t = (1.f - e) * __builtin_amdgcn_rcpf(1.f + e); return x < 0.f ? -t : t; }

#define XB_TMO      128
#define XB_XCNT(j)  (256  + 64 * (j))
#define XB_XSUB(j)  (1280 + 64 * (j))
#define XB_XGEN(j)  (2304 + 64 * (j))
#define XB_TOP      3328
#define XB_TOPGEN   3392
#define XCD_BAR_WORDS 3456
#define XB_SPIN_CAP (1u << 22)
__device__ __forceinline__ unsigned xb_ld(unsigned* p)              { return __hip_atomic_load(p, __ATOMIC_RELAXED, __HIP_MEMORY_SCOPE_AGENT); }
__device__ __forceinline__ unsigned xb_add(unsigned* p, unsigned v) { return __hip_atomic_fetch_add(p, v, __ATOMIC_RELAXED, __HIP_MEMORY_SCOPE_AGENT); }
__device__ __forceinline__ unsigned xb_xcc_id() { return (unsigned)__builtin_amdgcn_s_getreg((3 << 11) | 20) & 0xFu; }
#define XB_SPIN(cond, bar) do { unsigned _sp = 0; while (cond) { __builtin_amdgcn_s_sleep(1); \
    if ((++_sp & 255u) == 0u) { if (xb_ld(&(bar)[XB_TMO])) break; if (_sp > XB_SPIN_CAP) { atomicAdd(&(bar)[XB_TMO], 1u); break; } } } } while (0)
struct XcdBarrier { unsigned* bar; unsigned x; volatile LAS unsigned* st; };
__device__ __forceinline__ XcdBarrier xcd_barrier_post(unsigned* bar, volatile LAS unsigned* st) {
    XcdBarrier b; b.bar = bar; b.x = xb_xcc_id(); b.st = st;
    if (threadIdx.x == 0) (void)xb_add(&bar[XB_XCNT(b.x)], 1u);
    return b;
}
__device__ __forceinline__ void xcd_barrier_complete(unsigned* bar, unsigned x, unsigned& nloc, unsigned& nx) {
    const unsigned G = gridDim.x * gridDim.y * gridDim.z;
    unsigned sum, cnt, mine, sp = 0u;
    for (;;) {
        sum = 0u; cnt = 0u; mine = 0u;
#pragma unroll
        for (unsigned j = 0; j < 16; ++j) { const unsigned c = xb_ld(&bar[XB_XCNT(j)]); sum += c; cnt += (c > 0u) ? 1u : 0u; mine = (j == x) ? c : mine; }
        if (sum == G) break;
        __builtin_amdgcn_s_sleep(1);
        if ((++sp & 255u) == 0u) { if (xb_ld(&bar[XB_TMO])) break; if (sp > XB_SPIN_CAP) { atomicAdd(&bar[XB_TMO], 1u); break; } }
    }
    nloc = mine > 0u ? mine : 1u; nx = cnt > 0u ? cnt : 1u;
}
__device__ __forceinline__ void xcd_barrier(const XcdBarrier& b) {
    asm volatile("s_waitcnt vmcnt(0)" ::: "memory");
    __syncthreads();
    if (threadIdx.x == 0) {
        unsigned* bar = b.bar;
        __builtin_amdgcn_s_waitcnt(0);
        unsigned nloc = b.st[0], nx = b.st[1];
        if (nloc == 0u) { xcd_barrier_complete(bar, b.x, nloc, nx); b.st[0] = nloc; b.st[1] = nx; }
        const unsigned old = xb_add(&bar[XB_XSUB(b.x)], 1u);
        const unsigned gen = old / nloc;
        if (old + 1u == (gen + 1u) * nloc) {
            __builtin_amdgcn_fence(__ATOMIC_RELEASE, "agent");
            asm volatile("s_waitcnt vmcnt(0)" ::: "memory");
            const unsigned og = xb_add(&bar[XB_TOP], 1u);
            const unsigned tg = og / nx;
            if (og + 1u == (tg + 1u) * nx) xb_add(&bar[XB_TOPGEN], 1u);
            else XB_SPIN(xb_ld(&bar[XB_TOPGEN]) == tg, bar);
            __builtin_amdgcn_fence(__ATOMIC_ACQUIRE, "agent");
            xb_add(&bar[XB_XGEN(b.x)], 1u);
            asm volatile("s_waitcnt vmcnt(0)" ::: "memory");
        } else {
            XB_SPIN(xb_ld(&bar[XB_XGEN(b.x)]) == gen, bar);
            __builtin_amdgcn_fence(__ATOMIC_ACQUIRE, "agent");
            asm volatile("s_waitcnt vmcnt(0)" ::: "memory");
        }
    }
    __syncthreads();
}

struct Args {
    const float* in[34];
    float* out;
    unsigned char* ws;
    int ph_lo, ph_hi;
};
enum { I_X = 0, I_C, I_CTX, I_CCTX, I_WADA, I_BADA, I_N1G, I_WIN, I_MU, I_W0, I_WUP, I_A0, I_AUP, I_GUP, I_KK, I_KA, I_RK, I_LNW, I_LNB,
       I_CONVW, I_ALOG, I_DTB, I_ONG, I_WOUT, I_N2G, I_RW, I_RB, I_EW1, I_EW3, I_EW2, I_SW1, I_SW3, I_SW2, I_FG };

namespace pg8 {
constexpr int BM = 256, BK = 64, HALF = 128, HTB = HALF * BK * 2, STAGE_BYTES = 8 * HTB, NXCD = 8, WGM = 8;
__host__ __device__ __forceinline__ int lds_byte(int r, int c) { const int st = (r >> 4) * 2 + (c >> 5), rr = r & 15, cc = c & 31, ob = rr * 64 + cc * 2; return st * 1024 + (ob ^ (((ob >> 9) & 1) << 5)); }
__host__ __device__ __forceinline__ void stage_rc(int b, int& R, int& C) { const int st = b / 1024, sb = b % 1024, swz = sb ^ (((sb >> 9) & 1) << 5); R = (st >> 1) * 16 + swz / 64; C = (st & 1) * 32 + (swz % 64) / 2; }
__host__ __device__ __forceinline__ int perm32(int rho) { const int n = rho >> 4, i = rho & 15; return 8 * (i >> 2) + 4 * n + (i & 3); }
struct Unit { int pm, pn; };
struct Gemm { const bf16_t* A; int K; };
struct StaticOrder {
    int nM, nN, nwg, G, c; const char* Bt; size_t tstepB;
    __device__ void init(int M, int N, int G_, int c_, const void* Bt_, int K) { nM = M / BM; nN = N / BM; nwg = nM * nN; G = G_; c = c_; Bt = (const char*)Bt_; tstepB = (size_t)BM * K * 2; }
    __device__ bool next(int i, Unit& u) const {
        const long L = (long)i * G + c; if (L >= nwg) return false;
        int wgid = (int)L; { const int q = nwg / NXCD, r = nwg % NXCD, xcd = wgid % NXCD, off = wgid / NXCD; wgid = (xcd < r ? xcd * (q + 1) : r * (q + 1) + (xcd - r) * q) + off; }
        const int nig = WGM * nN, gid = wgid / nig, fm = gid * WGM, gsz = (nM - fm) < WGM ? (nM - fm) : WGM;
        u.pm = fm + ((wgid % nig) % gsz); u.pn = (wgid % nig) / gsz; return true;
    }
    __device__ __forceinline__ const char* bptr(const Unit& u) const { return Bt + (size_t)u.pn * tstepB; }
    __device__ __forceinline__ int rowsel(const Unit&, int) const { return 0; }
};
struct TileOrder {
    int nunits, npn, G, c; const int* tile_e; const char* wbase; size_t wstride, woff, tstepB; const int* rowl;
    __device__ bool next(int i, Unit& u) const { const int L = i * G + c; if (L >= nunits) return false; u.pm = L / npn; u.pn = L - u.pm * npn; return true; }
    __device__ __forceinline__ const char* bptr(const Unit& u) const { const int e = __builtin_amdgcn_readfirstlane(tile_e[u.pm]); return wbase + (size_t)e * wstride + woff + (size_t)u.pn * tstepB; }
    __device__ __forceinline__ int rowsel(const Unit& u, int r) const { const int t = rowl[(size_t)u.pm * 256 + r]; return t < 0 ? 0 : t; }
};
struct SeqOrder {
    int n; const char* Bt; size_t tstepB; const LAS int* rsel;
    __device__ bool next(int i, Unit& u) const { if (i >= n) return false; u.pm = 0; u.pn = i; return true; }
    __device__ __forceinline__ const char* bptr(const Unit& u) const { return Bt + (size_t)u.pn * tstepB; }
    __device__ __forceinline__ int rowsel(const Unit&, int r) const { return rsel[r]; }
};
__device__ __forceinline__ unsigned cvt_pk_bf16(float lo, float hi) { return cvtpk(lo, hi); }

template <class Epi, class Sched, bool GATHER, int A_AUX = 0, bool ALIGN = true>
__device__ __forceinline__ void gemm_phase(lbyte* lds, const Gemm g, const Sched& S, const Epi& E) {
    int tid_ = threadIdx.x; asm volatile("" : "+v"(tid_));
    const int tid = tid_, wid = __builtin_amdgcn_readfirstlane(tid >> 6), lane = tid & 63, wr = wid >> 2, wc = wid & 3, fr = lane & 15, fq = lane >> 4;
    const int K = g.K, nt = K / BK;
    Unit cur, nxt; int ui = 0;
    if (!S.next(0, cur)) return;
    int Rst[2], Cst[2];
    unsigned voffA[2], voffA1[2], voffB[2], nvA[2], nvA1[2];
#pragma unroll
    for (int i = 0; i < 2; ++i) { int R, C; stage_rc(tid * 16 + i * 8192, R, C); const int Rb = Epi::PERM ? ((R & ~31) + perm32(R & 31)) : R; Rst[i] = R; Cst[i] = C;
        if (GATHER) { voffA[i] = ((unsigned)S.rowsel(cur, R) * (unsigned)K + (unsigned)C) * 2u; voffA1[i] = ((unsigned)S.rowsel(cur, 128 + R) * (unsigned)K + (unsigned)C) * 2u; }
        else { voffA[i] = (unsigned)(R * K + C) * 2u; voffA1[i] = voffA[i]; }
        nvA[i] = voffA[i]; nvA1[i] = voffA1[i];
        voffB[i] = (unsigned)(Rb * K + C) * 2u; }
    const size_t kstep = (size_t)(BK * 2);
    const size_t hstep = (size_t)HALF * K * 2;
    const size_t hstepA = GATHER ? 0 : hstep;
    const size_t tstep = 2 * hstep;
    const unsigned ldsw = (unsigned)wid * 1024u;
    const int aoff = lds_byte(wr * 64 + fr, fq * 8), boff = lds_byte(wc * 32 + fr, fq * 8);
#define PG8_SA(b, h) (((b) * 2 + (h)) * HTB)
#define PG8_SB(b, h) ((4 + (b) * 2 + (h)) * HTB)
#define PG8_STAGE2(bufoff, gbase, v0, v1) do { \
        __builtin_amdgcn_global_load_lds((const unsigned*)((const char*)(gbase) + (v0)), (LAS unsigned*)(lds + (bufoff) + ldsw), 16, 0, 0); \
        __builtin_amdgcn_global_load_lds((const unsigned*)((const char*)(gbase) + (v1)), (LAS unsigned*)(lds + (bufoff) + ldsw + 8192), 16, 0, 0); } while (0)
#define PG8_STAGE2A(bufoff, gbase, v0, v1) do { if constexpr (A_AUX == 16) { \
        __builtin_amdgcn_global_load_lds((const unsigned*)((const char*)(gbase) + (v0)), (LAS unsigned*)(lds + (bufoff) + ldsw), 16, 0, 16); \
        __builtin_amdgcn_global_load_lds((const unsigned*)((const char*)(gbase) + (v1)), (LAS unsigned*)(lds + (bufoff) + ldsw + 8192), 16, 0, 16); } else { PG8_STAGE2(bufoff, gbase, v0, v1); } } while (0)
#define PG8_STAGE(bufoff, gbase, voff) PG8_STAGE2(bufoff, gbase, (voff)[0], (voff)[1])
#define PG8_STAGEA(bufoff, gbase, voff) PG8_STAGE2A(bufoff, gbase, (voff)[0], (voff)[1])
#define PG8_LDA(dst, b, h) do { _Pragma("unroll") for (int m = 0; m < 4; ++m) _Pragma("unroll") for (int k = 0; k < 2; ++k) dst[m][k] = *(const LAS bf16x8*)(lds + PG8_SA(b, h) + aoff + m * 2048 + k * 1024); } while (0)
#define PG8_LDB(dst, b, h) do { _Pragma("unroll") for (int n = 0; n < 2; ++n) _Pragma("unroll") for (int k = 0; k < 2; ++k) dst[n][k] = *(const LAS bf16x8*)(lds + PG8_SB(b, h) + boff + n * 2048 + k * 1024); } while (0)
#define PG8_MMA(ai, bj, At, Bt) do { __builtin_amdgcn_s_setprio(1); _Pragma("unroll") for (int m = 0; m < 4; ++m) _Pragma("unroll") for (int n = 0; n < 2; ++n) _Pragma("unroll") for (int k = 0; k < 2; ++k) \
        acc[ai][bj][m][n] = __builtin_amdgcn_mfma_f32_16x16x32_bf16(Bt[n][k], At[m][k], acc[ai][bj][m][n], 0, 0, 0); __builtin_amdgcn_s_setprio(0); } while (0)
#define PG8_WAIT_V(n) asm volatile("s_waitcnt vmcnt(" #n ")" ::: "memory")
#define PG8_WAIT_L(n) asm volatile("s_waitcnt lgkmcnt(" #n ")" ::: "memory")
#define PG8_BAR __builtin_amdgcn_s_barrier()
#define PG8_SCHED __builtin_amdgcn_sched_barrier(0)
    f32x4 acc[2][2][4][2];
#pragma unroll
    for (int a = 0; a < 2; ++a)
#pragma unroll
        for (int b = 0; b < 2; ++b)
#pragma unroll
            for (int m = 0; m < 4; ++m)
#pragma unroll
                for (int n = 0; n < 2; ++n) acc[a][b][m][n] = (f32x4){0.f, 0.f, 0.f, 0.f};
    bf16x8 At[4][2], B0[2][2], B1[2][2];
    const char* cA = (const char*)g.A + (GATHER ? (size_t)0 : (size_t)cur.pm * tstep); const char* cB = S.bptr(cur);
    PG8_STAGE(PG8_SB(0, 0), cB, voffB); PG8_STAGE(PG8_SB(0, 1), cB + hstep, voffB); PG8_STAGEA(PG8_SA(0, 0), cA, voffA); PG8_STAGEA(PG8_SA(0, 1), cA + hstepA, voffA1);
    if (wr == 1) PG8_BAR;
    PG8_WAIT_V(2); PG8_BAR;
    PG8_STAGE(PG8_SB(1, 0), cB + kstep, voffB); PG8_STAGEA(PG8_SA(1, 0), cA + kstep, voffA); PG8_STAGE(PG8_SB(1, 1), cB + hstep + kstep, voffB);
    PG8_WAIT_V(6); PG8_BAR;
    for (;;) {
        const bool has_next = S.next(ui + 1, nxt);
        const char* nA = has_next ? (const char*)g.A + (GATHER ? (size_t)0 : (size_t)nxt.pm * tstep) : cA; const char* nB = has_next ? S.bptr(nxt) : cB;
        for (int t = 0; t < nt; t += 2) {
            const bool last = (t == nt - 2);
            const char* a1 = cA + (size_t)(t + 1) * kstep;
            const char* a2 = last ? nA : cA + (size_t)(t + 2) * kstep; const char* b2 = last ? nB : cB + (size_t)(t + 2) * kstep;
            const char* a3 = a2 + kstep; const char* b3 = b2 + kstep;
            if (GATHER && last && has_next) {
#pragma unroll
                for (int i = 0; i < 2; ++i) { nvA[i] = ((unsigned)S.rowsel(nxt, Rst[i]) * (unsigned)K + (unsigned)Cst[i]) * 2u; nvA1[i] = ((unsigned)S.rowsel(nxt, 128 + Rst[i]) * (unsigned)K + (unsigned)Cst[i]) * 2u; }
            }
            const unsigned x0 = (GATHER && last) ? nvA[0] : voffA[0], x1 = (GATHER && last) ? nvA[1] : voffA[1];
            const unsigned y0 = (GATHER && last) ? nvA1[0] : voffA1[0], y1 = (GATHER && last) ? nvA1[1] : voffA1[1];
            PG8_LDB(B0, 0, 0); PG8_LDB(B1, 0, 1); PG8_SCHED; PG8_LDA(At, 0, 0); PG8_STAGEA(PG8_SA(1, 1), a1 + hstepA, voffA1);
            PG8_WAIT_V(8); PG8_WAIT_L(0); PG8_BAR; PG8_MMA(0, 0, At, B0); PG8_MMA(0, 1, At, B1); PG8_BAR; PG8_SCHED;
            PG8_LDA(At, 0, 1); PG8_STAGE(PG8_SB(0, 0), b2, voffB); PG8_STAGE(PG8_SB(0, 1), b2 + hstep, voffB); PG8_STAGE2A(PG8_SA(0, 0), a2, x0, x1);
            PG8_WAIT_V(8); PG8_WAIT_L(0); PG8_BAR; PG8_MMA(1, 0, At, B0); PG8_MMA(1, 1, At, B1); PG8_BAR; PG8_SCHED;
            PG8_LDB(B0, 1, 0); PG8_LDB(B1, 1, 1); PG8_SCHED; PG8_LDA(At, 1, 0); PG8_STAGE2A(PG8_SA(0, 1), a2 + hstepA, y0, y1);
            PG8_WAIT_V(8); PG8_WAIT_L(0); PG8_BAR; PG8_MMA(0, 0, At, B0); PG8_MMA(0, 1, At, B1); PG8_BAR; PG8_SCHED;
            PG8_LDA(At, 1, 1); PG8_STAGE(PG8_SB(1, 0), b3, voffB); PG8_STAGE(PG8_SB(1, 1), b3 + hstep, voffB); PG8_STAGE2A(PG8_SA(1, 0), a3, x0, x1);
            PG8_WAIT_V(8); PG8_WAIT_L(0); PG8_BAR; PG8_MMA(1, 0, At, B0); PG8_MMA(1, 1, At, B1); PG8_BAR; PG8_SCHED;
        }
        if (ALIGN && wr == 0) PG8_BAR;
        E(acc, cur, wr, wc, fr, fq);
        if (!has_next) break;
#pragma unroll
        for (int a = 0; a < 2; ++a)
#pragma unroll
            for (int b = 0; b < 2; ++b)
#pragma unroll
                for (int m = 0; m < 4; ++m)
#pragma unroll
                    for (int n = 0; n < 2; ++n) acc[a][b][m][n] = (f32x4){0.f, 0.f, 0.f, 0.f};
        cur = nxt; cA = nA; cB = nB; ++ui;
        if (GATHER) { voffA[0] = nvA[0]; voffA[1] = nvA[1]; voffA1[0] = nvA1[0]; voffA1[1] = nvA1[1]; }
        if (ALIGN && wr == 1) PG8_BAR;
    }
    PG8_WAIT_V(0);
    if (!ALIGN && wr == 0) PG8_BAR;
    PG8_BAR;
#undef PG8_SA
#undef PG8_SB
#undef PG8_STAGE
#undef PG8_STAGE2
#undef PG8_STAGE2A
#undef PG8_STAGEA
#undef PG8_LDA
#undef PG8_LDB
#undef PG8_MMA
#undef PG8_WAIT_V
#undef PG8_WAIT_L
#undef PG8_BAR
#undef PG8_SCHED
}

struct EpiBf16 {
    static constexpr bool PERM = true;
    bf16_t* O; int ldc;
    __device__ __forceinline__ void operator()(const f32x4 (&acc)[2][2][4][2], const Unit& u, int wr, int wc, int fr, int fq) const {
        const int row0 = u.pm * BM + wr * 64 + fr; const int col0 = u.pn * BM + wc * 32 + 8 * fq;
#pragma unroll
        for (int ai = 0; ai < 2; ++ai)
#pragma unroll
            for (int m = 0; m < 4; ++m) { bf16_t* rowp = O + (size_t)(row0 + ai * HALF + m * 16) * ldc + col0;
#pragma unroll
                for (int bj = 0; bj < 2; ++bj) { const f32x4 v0 = acc[ai][bj][m][0], v1 = acc[ai][bj][m][1];
                    u32x4 w; w.x = cvt_pk_bf16(v0[0], v0[1]); w.y = cvt_pk_bf16(v0[2], v0[3]); w.z = cvt_pk_bf16(v1[0], v1[1]); w.w = cvt_pk_bf16(v1[2], v1[3]);
                    *(u32x4*)(rowp + bj * HALF) = w; } }
    }
};
struct EpiF32 {
    static constexpr bool PERM = false;
    float* C; int ldc;
    __device__ __forceinline__ void operator()(const f32x4 (&acc)[2][2][4][2], const Unit& u, int wr, int wc, int fr, int fq) const {
        const int row0 = u.pm * BM + wr * 64 + fr, col0 = u.pn * BM + wc * 32 + 4 * fq;
#pragma unroll
        for (int ai = 0; ai < 2; ++ai)
#pragma unroll
            for (int m = 0; m < 4; ++m) { float* rowp = C + (size_t)(row0 + ai * HALF + m * 16) * ldc + col0;
#pragma unroll
                for (int bj = 0; bj < 2; ++bj)
#pragma unroll
                    for (int n = 0; n < 2; ++n) *(f32x4*)(rowp + bj * HALF + n * 16) = acc[ai][bj][m][n]; }
    }
};
struct EpiResGate {
    static constexpr bool PERM = false;
    const float* x; float* out; const float* mod; int gate_off;
    __device__ __forceinline__ void operator()(const f32x4 (&acc)[2][2][4][2], const Unit& u, int wr, int wc, int fr, int fq) const {
        const int row0 = u.pm * BM + wr * 64 + fr, col0 = u.pn * BM + wc * 32 + 4 * fq;
        const float* gp = mod + (size_t)((u.pm * BM) >> 11) * MODW + gate_off + col0;
        f32x4 gv[2][2];
#pragma unroll
        for (int bj = 0; bj < 2; ++bj)
#pragma unroll
            for (int n = 0; n < 2; ++n) gv[bj][n] = *(const f32x4*)(gp + bj * HALF + n * 16);
#pragma unroll
        for (int ai = 0; ai < 2; ++ai)
#pragma unroll
            for (int m = 0; m < 4; ++m) { const size_t off = (size_t)(row0 + ai * HALF + m * 16) * D + col0;
#pragma unroll
                for (int bj = 0; bj < 2; ++bj)
#pragma unroll
                    for (int n = 0; n < 2; ++n) { const f32x4 xv = *(const f32x4*)(x + off + bj * HALF + n * 16);
                        *(f32x4*)(out + off + bj * HALF + n * 16) = xv + gv[bj][n] * acc[ai][bj][m][n]; }
                asm volatile("" ::: "memory"); }
    }
};
struct EpiGLU {
    static constexpr bool PERM = true;
    bf16_t* H;
    __device__ __forceinline__ void operator()(const f32x4 (&acc)[2][2][4][2], const Unit& u, int wr, int wc, int fr, int fq) const {
        const int row0 = u.pm * BM + wr * 64 + fr; const int col0 = u.pn * 128 + wc * 32 + 8 * fq;
#pragma unroll
        for (int ai = 0; ai < 2; ++ai)
#pragma unroll
            for (int m = 0; m < 4; ++m) { bf16_t* rowp = H + (size_t)(row0 + ai * HALF + m * 16) * 256 + col0;
                f32x4 h0, h1;
#pragma unroll
                for (int j = 0; j < 4; ++j) { const float a0 = acc[ai][0][m][0][j], a1 = acc[ai][0][m][1][j];
                    h0[j] = siluf_(a0) * acc[ai][1][m][0][j]; h1[j] = siluf_(a1) * acc[ai][1][m][1][j]; }
                u32x4 w; w.x = cvt_pk_bf16(h0[0], h0[1]); w.y = cvt_pk_bf16(h0[2], h0[3]); w.z = cvt_pk_bf16(h1[0], h1[1]); w.w = cvt_pk_bf16(h1[2], h1[3]);
                *(u32x4*)rowp = w; }
    }
};
constexpr float YSCALE = 8.f;
struct EpiY {
    static constexpr bool PERM = true;
    unsigned char* Y; float* out; const float* mod; const LAS int* rtok; const LAS float* rw; int shared;
    __device__ __forceinline__ void operator()(const f32x4 (&acc)[2][2][4][2], const Unit& u, int wr, int wc, int fr, int fq) const {
        const int col0 = u.pn * BM + wc * 32 + 8 * fq;
#pragma unroll
        for (int ai = 0; ai < 2; ++ai)
#pragma unroll
            for (int m = 0; m < 4; ++m) { const int r = wr * 64 + fr + ai * HALF + m * 16; const int ts = rtok[r]; const float w = rw[r];
                if (ts >= 0) {
                    if (shared) { const unsigned goff = (unsigned)(ts >> 11) * MODW + 5 * D + col0; const unsigned ooff = (unsigned)ts * D + col0;
#pragma unroll
                        for (int bj = 0; bj < 2; ++bj)
#pragma unroll
                            for (int n = 0; n < 2; ++n) { const f32x4 gv = *(const f32x4*)(mod + goff + bj * HALF + n * 4); f32x4* op = (f32x4*)(out + ooff + bj * HALF + n * 4);
                                *op = *op + gv * acc[ai][bj][m][n]; }
                    } else { unsigned char* yp = Y + (size_t)(unsigned)ts * D + col0; const float ws_ = w * YSCALE;
#pragma unroll
                        for (int bj = 0; bj < 2; ++bj) { f32x4 v0 = acc[ai][bj][m][0] * ws_, v1 = acc[ai][bj][m][1] * ws_;
#pragma unroll
                                for (int j = 0; j < 4; ++j) { v0[j] = __builtin_amdgcn_fmed3f(v0[j], -448.f, 448.f); v1[j] = __builtin_amdgcn_fmed3f(v1[j], -448.f, 448.f); }
                            unsigned lo = 0u, hi = 0u;
                            lo = __builtin_amdgcn_cvt_pk_fp8_f32(v0[0], v0[1], lo, false); lo = __builtin_amdgcn_cvt_pk_fp8_f32(v0[2], v0[3], lo, true);
                            hi = __builtin_amdgcn_cvt_pk_fp8_f32(v1[0], v1[1], hi, false); hi = __builtin_amdgcn_cvt_pk_fp8_f32(v1[2], v1[3], hi, true);
                            u32x2 pk; pk.x = lo; pk.y = hi; *(u32x2*)(yp + bj * HALF) = pk; } } }
                asm volatile("" ::: "memory"); }
    }
};

struct MoeCtx {
    int ntiles, nrt, G, vc;
    const LAS int* tb; LAS int* tbl;
    const unsigned* cnt; const int* rowl; const float* roww;
    const char* wexp; const char* h2n; char* Hs; unsigned char* Y; float* out; const float* mod; int dry_shared;
};
__device__ __forceinline__ void gemm_moe(lbyte* lds, const MoeCtx& M) {
    int tid_ = threadIdx.x; asm volatile("" : "+v"(tid_));
    const int tid = tid_, wid = __builtin_amdgcn_readfirstlane(tid >> 6), lane = tid & 63, wr = wid >> 2, wc = wid & 3, fr = lane & 15, fq = lane >> 4;
    const int ntl = (M.ntiles - M.vc + M.G - 1) / M.G;
    if (M.vc >= M.ntiles) return;
    const int nunits = ntl * 6;
    const unsigned ldsw = (unsigned)wid * 1024u;
    const int aoff = lds_byte(wr * 64 + fr, fq * 16), boff = lds_byte(wc * 32 + fr, fq * 16);
    auto tile_expert = [&](int tile, int& e, int& k) { if (tile < M.nrt) { int lo = 0, hi = NE - 1; while (lo < hi) { const int mid = (lo + hi + 1) >> 1; if (M.tb[mid] <= tile) lo = mid; else hi = mid - 1; } e = lo; k = tile - M.tb[lo]; } else { e = NE; k = tile - M.nrt; } };
    auto fill = [&](int j) { if (j < ntl && tid < 256) { const int tile = M.vc + j * M.G; int e, k; tile_expert(tile, e, k); LAS int* T = M.tbl + (j % 3) * 768;
            int ts; float w;
            if (e < NE) { const int valid = (int)M.cnt[e] - 256 * k; if (tid < valid) { ts = M.rowl[(size_t)tile * 256 + tid]; w = M.roww[(size_t)tile * 256 + tid]; } else { ts = -1; w = 0.f; } T[tid] = ts < 0 ? 0 : (ts >> 3); }
            else { ts = k * 256 + tid; w = 1.f; T[tid] = ts; }
            T[256 + tid] = ts; ((LAS float*)T)[512 + tid] = w; } };
    struct UP { const char* aB; const char* bB; unsigned bh; int nt, kind, pn, slot, shared, e, hbuf, fillnext; };
    auto unit_params = [&](int ui, int prev_e, UP& u, unsigned (&oa)[4], unsigned (&ob)[2]) {
        int tq = threadIdx.x; asm volatile("" : "+v"(tq));
        int Rst[2], Cst[2], Rbp[2];
#pragma unroll
        for (int i = 0; i < 2; ++i) { int R, C; stage_rc(tq * 16 + i * 8192, R, C); Rst[i] = R; Cst[i] = C; Rbp[i] = (R & ~31) + perm32(R & 31); }
        int j, sub;
        if (ui < 2) { j = 0; sub = ui; }
        else { const int qq = ui - 2, g = qq / 6, r = qq - 6 * g; if (g < ntl - 1 && r < 2) { j = g + 1; sub = r; } else { j = g; sub = (g < ntl - 1) ? r : r + 2; } }
        const int tile = M.vc + j * M.G; int e, k;
        if (sub == 0 || sub == 2) tile_expert(tile, e, k); else e = prev_e;
        u.e = e;
        const char* w = M.wexp + (size_t)e * WEXP_STRIDE;
        u.slot = j % 3; u.hbuf = j & 1; u.fillnext = (sub == 1) ? j + 1 : -1; u.shared = (e == NE) ? 1 : 0;
        if (sub < 2) { u.kind = 0; u.pn = sub; u.nt = D / 128; u.aB = M.h2n; u.bB = w + (size_t)sub * 256 * D; u.bh = 128u * D;
            const LAS int* T = M.tbl + (j % 3) * 768;
#pragma unroll
            for (int i = 0; i < 2; ++i) { oa[i] = (unsigned)T[Rst[i]] * (unsigned)D + 2u * (unsigned)Cst[i]; oa[2 + i] = (unsigned)T[128 + Rst[i]] * (unsigned)D + 2u * (unsigned)Cst[i]; ob[i] = (unsigned)(Rbp[i] * D + 2 * Cst[i]); } }
        else { u.kind = 1; u.pn = sub - 2; u.nt = DE / 128; u.aB = M.Hs + (j & 1) * 65536; u.bB = w + (size_t)512 * 1024 + (size_t)(sub - 2) * 256 * DE; u.bh = 128u * DE;
#pragma unroll
            for (int i = 0; i < 2; ++i) { oa[i] = (unsigned)(Rst[i] * DE + 2 * Cst[i]); oa[2 + i] = (unsigned)((128 + Rst[i]) * DE + 2 * Cst[i]); ob[i] = (unsigned)(Rbp[i] * DE + 2 * Cst[i]); } }
    };
#define PG8_SA(b, h) (((b) * 2 + (h)) * HTB)
#define PG8_SB(b, h) ((4 + (b) * 2 + (h)) * HTB)
#define MOE_DMA(bufoff, ptr, aux) __builtin_amdgcn_global_load_lds((const unsigned*)(ptr), (LAS unsigned*)(lds + (bufoff)), 16, 0, aux)
#define MOE_STA(bufoff, base, o0, o1) do { MOE_DMA((bufoff) + ldsw, (base) + (o0), 16); MOE_DMA((bufoff) + ldsw + 8192, (base) + (o1), 16); } while (0)
#define MOE_STAK(kindv, bufoff, base, o0, o1) do { if ((kindv) == 0) { MOE_DMA((bufoff) + ldsw, (base) + (o0), 0); MOE_DMA((bufoff) + ldsw + 8192, (base) + (o1), 0); } else MOE_STA(bufoff, base, o0, o1); } while (0)
#define MOE_STB(bufoff, base, o0, o1) do { MOE_DMA((bufoff) + ldsw, (base) + (o0), 0); MOE_DMA((bufoff) + ldsw + 8192, (base) + (o1), 0); } while (0)
#define MOE_LD32(p) __builtin_shufflevector(*(const LAS i32x4*)(p), *(const LAS i32x4*)((p) + 16), 0, 1, 2, 3, 4, 5, 6, 7)
#define PG8_LDA(dst, b, h) do { _Pragma("unroll") for (int m = 0; m < 4; ++m) dst[m] = MOE_LD32(lds + PG8_SA(b, h) + aoff + m * 2048); } while (0)
#define PG8_LDB(dst, b, h) do { _Pragma("unroll") for (int n = 0; n < 2; ++n) dst[n] = MOE_LD32(lds + PG8_SB(b, h) + boff + n * 2048); } while (0)
#define MOE_MFMA(c, a, b) asm volatile("v_mfma_scale_f32_16x16x128_f8f6f4 %0, %1, %2, %0, %3, %3 op_sel_hi:[0,0,0]" : "+v"(c) : "v"(a), "v"(b), "v"(one_scale))
#define PG8_MMA(ai, bj, At, Bt) do { __builtin_amdgcn_s_setprio(1); _Pragma("unroll") for (int m = 0; m < 4; ++m) _Pragma("unroll") for (int n = 0; n < 2; ++n) \
        MOE_MFMA(acc[ai][bj][m][n], Bt[n], At[m]); __builtin_amdgcn_s_setprio(0); } while (0)
#define PG8_WAIT_V(n) asm volatile("s_waitcnt vmcnt(" #n ")" ::: "memory")
#define PG8_WAIT_L(n) asm volatile("s_waitcnt lgkmcnt(" #n ")" ::: "memory")
#define PG8_BAR __builtin_amdgcn_s_barrier()
#define PG8_SCHED __builtin_amdgcn_sched_barrier(0)
    fill(0);
    asm volatile("s_waitcnt vmcnt(0) lgkmcnt(0)" ::: "memory");
    __syncthreads();
    UP cu, nu; unsigned oa[4], ob[2], na[4], nb[2];
    unit_params(0, 0, cu, oa, ob);
    nu = cu;
#pragma unroll
    for (int i = 0; i < 4; ++i) na[i] = oa[i];
    nb[0] = ob[0]; nb[1] = ob[1];
    f32x4 acc[2][2][4][2];
#pragma unroll
    for (int a = 0; a < 2; ++a)
#pragma unroll
        for (int b = 0; b < 2; ++b)
#pragma unroll
            for (int m = 0; m < 4; ++m)
#pragma unroll
                for (int n = 0; n < 2; ++n) acc[a][b][m][n] = (f32x4){0.f, 0.f, 0.f, 0.f};
    i32x8 At[4], B0[2], B1[2];
    int one_scale = 0x7F7F7F7F; asm volatile("" : "+v"(one_scale));
    const size_t kstep = (size_t)128;
    {   const char* cA = cu.aB; const char* cB = cu.bB;
        MOE_STB(PG8_SB(0, 0), cB, ob[0], ob[1]); MOE_STB(PG8_SB(0, 1), cB + cu.bh, ob[0], ob[1]); MOE_STAK(cu.kind, PG8_SA(0, 0), cA, oa[0], oa[1]); MOE_STAK(cu.kind, PG8_SA(0, 1), cA, oa[2], oa[3]);
        if (wr == 1) PG8_BAR;
        PG8_WAIT_V(2); PG8_BAR;
        MOE_STB(PG8_SB(1, 0), cB + kstep, ob[0], ob[1]); MOE_STAK(cu.kind, PG8_SA(1, 0), cA + kstep, oa[0], oa[1]); MOE_STB(PG8_SB(1, 1), cB + cu.bh + kstep, ob[0], ob[1]);
        PG8_WAIT_V(6); PG8_BAR; }
    for (int ui = 0;; ++ui) {
        const bool has_next = (ui + 1 < nunits);
        if (cu.fillnext >= 0) fill(cu.fillnext);
        const char* cA = cu.aB; const char* cB = cu.bB; const int nt = cu.nt; const unsigned bh = cu.bh;
        for (int t = 0; t < nt; t += 2) {
            const bool last = (t == nt - 2);
            if (last && has_next) unit_params(ui + 1, cu.e, nu, na, nb);
            const char* a1 = cA + (size_t)(t + 1) * kstep;
            const char* a2 = last ? nu.aB : cA + (size_t)(t + 2) * kstep; const char* b2 = last ? nu.bB : cB + (size_t)(t + 2) * kstep;
            const char* a3 = a2 + kstep; const char* b3 = b2 + kstep;
            const unsigned bh2 = last ? nu.bh : bh;
            const unsigned x0 = last ? na[0] : oa[0], x1 = last ? na[1] : oa[1], y0 = last ? na[2] : oa[2], y1 = last ? na[3] : oa[3];
            const unsigned z0 = last ? nb[0] : ob[0], z1 = last ? nb[1] : ob[1];
            const int k2 = last ? nu.kind : cu.kind;
            PG8_LDB(B0, 0, 0); PG8_LDB(B1, 0, 1); PG8_SCHED; PG8_LDA(At, 0, 0); MOE_STAK(cu.kind, PG8_SA(1, 1), a1, oa[2], oa[3]);
            PG8_WAIT_V(8); PG8_WAIT_L(0); PG8_BAR; PG8_MMA(0, 0, At, B0); PG8_MMA(0, 1, At, B1); PG8_BAR; PG8_SCHED;
            PG8_LDA(At, 0, 1); MOE_STB(PG8_SB(0, 0), b2, z0, z1); MOE_STB(PG8_SB(0, 1), b2 + bh2, z0, z1); MOE_STAK(k2, PG8_SA(0, 0), a2, x0, x1);
            PG8_WAIT_V(8); PG8_WAIT_L(0); PG8_BAR; PG8_MMA(1, 0, At, B0); PG8_MMA(1, 1, At, B1); PG8_BAR; PG8_SCHED;
            PG8_LDB(B0, 1, 0); PG8_LDB(B1, 1, 1); PG8_SCHED; PG8_LDA(At, 1, 0); MOE_STAK(k2, PG8_SA(0, 1), a2, y0, y1);
            PG8_WAIT_V(8); PG8_WAIT_L(0); PG8_BAR; PG8_MMA(0, 0, At, B0); PG8_MMA(0, 1, At, B1); PG8_BAR; PG8_SCHED;
            PG8_LDA(At, 1, 1); MOE_STB(PG8_SB(1, 0), b3, z0, z1); MOE_STB(PG8_SB(1, 1), b3 + bh2, z0, z1); MOE_STAK(k2, PG8_SA(1, 0), a3, x0, x1);
            PG8_WAIT_V(8); PG8_WAIT_L(0); PG8_BAR; PG8_MMA(1, 0, At, B0); PG8_MMA(1, 1, At, B1); PG8_BAR; PG8_SCHED;
        }
        if (wr == 0) PG8_BAR;
        asm volatile("s_nop 15\n\ts_nop 15" ::: "memory");
        if (cu.kind == 0) {
            const int row0 = wr * 64 + fr; const int col0 = cu.pn * 128 + wc * 32 + 8 * fq;
            constexpr float is13 = 1.f / SW13;
#pragma unroll
            for (int ai = 0; ai < 2; ++ai)
#pragma unroll
                for (int m = 0; m < 4; ++m) { unsigned char* rowp = (unsigned char*)M.Hs + cu.hbuf * 65536 + (size_t)(row0 + ai * HALF + m * 16) * 256 + col0;
                    f32x4 h0, h1;
#pragma unroll
                    for (int j = 0; j < 4; ++j) { h0[j] = siluf_(acc[ai][0][m][0][j] * is13) * (acc[ai][1][m][0][j] * (is13 * SHS)); h1[j] = siluf_(acc[ai][0][m][1][j] * is13) * (acc[ai][1][m][1][j] * (is13 * SHS)); }
                    u32x2 w; w.x = pk4_fp8(h0[0], h0[1], h0[2], h0[3]); w.y = pk4_fp8(h1[0], h1[1], h1[2], h1[3]);
                    *(u32x2*)rowp = w; }
        } else {
            const LAS int* rtok = M.tbl + cu.slot * 768 + 256; const LAS float* rw = (const LAS float*)(M.tbl + cu.slot * 768 + 512);
            const int col0 = cu.pn * BM + wc * 32 + 8 * fq;
#pragma unroll
            for (int ai = 0; ai < 2; ++ai)
#pragma unroll
                for (int m = 0; m < 4; ++m) { const int r = wr * 64 + fr + ai * HALF + m * 16; const int ts = rtok[r]; const float w = rw[r];
                    if (ts >= 0) {
                        if (cu.shared) { const unsigned goff = (unsigned)(ts >> 11) * MODW + 5 * D + col0; const unsigned ooff = (unsigned)ts * D + col0;
#pragma unroll
                            for (int bj = 0; bj < 2; ++bj)
#pragma unroll
                                for (int n = 0; n < 2; ++n) { const f32x4 gv = *(const f32x4*)(M.mod + goff + bj * HALF + n * 4); f32x4* op = (f32x4*)(M.out + ooff + bj * HALF + n * 4);
                                    const f32x4 nv = *op + gv * acc[ai][bj][m][n] * (1.f / (SHS * SW2)); if (!M.dry_shared) *op = nv; else asm volatile("" :: "v"(nv)); }
                        } else { unsigned char* yp = M.Y + (size_t)(unsigned)ts * D + col0; const float ws_ = w * (YSCALE / (SHS * SW2));
#pragma unroll
                            for (int bj = 0; bj < 2; ++bj) { f32x4 v0 = acc[ai][bj][m][0] * ws_, v1 = acc[ai][bj][m][1] * ws_;
#pragma unroll
                                for (int j = 0; j < 4; ++j) { v0[j] = __builtin_amdgcn_fmed3f(v0[j], -448.f, 448.f); v1[j] = __builtin_amdgcn_fmed3f(v1[j], -448.f, 448.f); }
                                unsigned lo = 0u, hi = 0u;
                                lo = __builtin_amdgcn_cvt_pk_fp8_f32(v0[0], v0[1], lo, false); lo = __builtin_amdgcn_cvt_pk_fp8_f32(v0[2], v0[3], lo, true);
                                hi = __builtin_amdgcn_cvt_pk_fp8_f32(v1[0], v1[1], hi, false); hi = __builtin_amdgcn_cvt_pk_fp8_f32(v1[2], v1[3], hi, true);
                                u32x2 pk; pk.x = lo; pk.y = hi; *(u32x2*)(yp + bj * HALF) = pk; } } }
                    asm volatile("" ::: "memory"); }
        }
        if (!has_next) break;
#pragma unroll
        for (int a = 0; a < 2; ++a)
#pragma unroll
            for (int b = 0; b < 2; ++b)
#pragma unroll
                for (int m = 0; m < 4; ++m)
#pragma unroll
                    for (int n = 0; n < 2; ++n) acc[a][b][m][n] = (f32x4){0.f, 0.f, 0.f, 0.f};
        cu = nu;
#pragma unroll
        for (int i = 0; i < 4; ++i) oa[i] = na[i];
        ob[0] = nb[0]; ob[1] = nb[1];
        if (wr == 1) PG8_BAR;
    }
    PG8_WAIT_V(0);
    PG8_BAR;
#undef PG8_SA
#undef PG8_SB
#undef MOE_DMA
#undef MOE_STA
#undef MOE_STAK
#undef MOE_STB
#undef PG8_LDA
#undef PG8_LDB
#undef MOE_LD32
#undef MOE_MFMA
#undef PG8_MMA
#undef PG8_WAIT_V
#undef PG8_WAIT_L
#undef PG8_BAR
#undef PG8_SCHED
}
}

struct Ctx {
    lbyte* lds; int tid, lane, wave, G, bid;
    const Args* a;
};
#define WSP(T, off) ((T*)(A.ws + (off)))

template <class RowMap>
__device__ __forceinline__ void transpose_item(const float* W, int K, int N, bf16_t* WT, RowMap rowmap, lfloat* scr, int item, int lane) {
    const int nblk = N / 32, kb = item / nblk, nb = item % nblk, k0 = 64 * kb, n0 = 32 * nb;
#pragma unroll 8
    for (int i = 0; i < 32; ++i) { const int kk = 2 * i + (lane >> 5); scr[kk * 33 + (lane & 31)] = W[(size_t)(k0 + kk) * N + n0 + (lane & 31)]; }
    asm volatile("s_waitcnt lgkmcnt(0)" ::: "memory");
    const int c = lane & 7;
#pragma unroll
    for (int j = 0; j < 4; ++j) { const int n = (lane >> 3) + 8 * j; const lfloat* s = scr + (8 * c) * 33 + n;
        u32x4 o; o.x = pk2(s[0 * 33], s[1 * 33]); o.y = pk2(s[2 * 33], s[3 * 33]); o.z = pk2(s[4 * 33], s[5 * 33]); o.w = pk2(s[6 * 33], s[7 * 33]);
        *(u32x4*)(WT + (size_t)rowmap(n0 + n) * K + k0 + 8 * c) = o; }
    asm volatile("s_waitcnt lgkmcnt(0)" ::: "memory");
}
template <class RowMap>
__device__ __forceinline__ void transpose_item_fp8(const float* W, int K, int N, unsigned char* WT, RowMap rowmap, float sc, lfloat* scr, int item, int lane) {
    const int nblk = N / 32, kb = item / nblk, nb = item % nblk, k0 = 64 * kb, n0 = 32 * nb;
#pragma unroll 8
    for (int i = 0; i < 32; ++i) { const int kk = 2 * i + (lane >> 5); scr[kk * 33 + (lane & 31)] = W[(size_t)(k0 + kk) * N + n0 + (lane & 31)] * sc; }
    asm volatile("s_waitcnt lgkmcnt(0)" ::: "memory");
    const int c = lane & 7;
#pragma unroll
    for (int j = 0; j < 4; ++j) { const int n = (lane >> 3) + 8 * j; const lfloat* s = scr + (8 * c) * 33 + n;
        u32x2 o; o.x = pk4_fp8(s[0 * 33], s[1 * 33], s[2 * 33], s[3 * 33]); o.y = pk4_fp8(s[4 * 33], s[5 * 33], s[6 * 33], s[7 * 33]);
        *(u32x2*)(WT + (size_t)rowmap(n0 + n) * K + k0 + 8 * c) = o; }
    asm volatile("s_waitcnt lgkmcnt(0)" ::: "memory");
}
struct RowId { __device__ int operator()(int n) const { return n; } };
struct RowGLU { int base; __device__ int operator()(int n) const { return ((n >> 7) << 8) + base + (n & 127); } };

__device__ __forceinline__ void norm_mod_row(const float* xrow, const float* g, const float* sc, const float* sh, bf16_t* orow, int lane, unsigned* o8row = nullptr) {
    const f32x4* xr = (const f32x4*)xrow + lane;
    f32x4 v[4]; float s = 0.f;
#pragma unroll
    for (int j = 0; j < 4; ++j) { v[j] = xr[64 * j]; s += (v[j].x * v[j].x + v[j].y * v[j].y) + (v[j].z * v[j].z + v[j].w * v[j].w); }
    const float rstd = __builtin_amdgcn_rsqf(wave_sum(s) * (1.f / D) + NORM_EPS);
    u32x2* o8 = (u32x2*)orow + lane;
#pragma unroll
    for (int j = 0; j < 4; ++j) { const f32x4 gg = ((const f32x4*)g)[lane + 64 * j], ss = ((const f32x4*)sc)[lane + 64 * j], hh = ((const f32x4*)sh)[lane + 64 * j];
        const f32x4 y = v[j] * rstd * gg * (ss + 1.f) + hh;
        u32x2 w; w.x = pk2(y.x, y.y); w.y = pk2(y.z, y.w); o8[64 * j] = w;
        if (o8row) o8row[lane + 64 * j] = pk4_fp8(y.x, y.y, y.z, y.w); }
}

__device__ __forceinline__ void phase_p0(const Args& A, Ctx& C) {
    float* mod = WSP(float, WS_MOD);
    {
        lfloat* sc = (lfloat*)C.lds;
        lfloat* red = (lfloat*)(C.lds + 17 * 1024 * 4);
        const float* wada = A.in[I_WADA]; const float* bada = A.in[I_BADA];
        for (int it = C.bid; it < 96 * 2; it += C.G) {
            const int chunk = it >> 1, pass = it & 1, r0 = pass * 17, nr = pass ? 16 : 17, col0 = chunk * 64;
            __syncthreads();
            for (int i = C.tid; i < nr * 1024; i += 512) { const int r = i >> 10, k = i & 1023; const int rr = r0 + r;
                const float cv = rr < 32 ? A.in[I_C][rr * 1024 + k] : A.in[I_CCTX][k]; sc[r * 1024 + k] = siluf_(cv); }
            __syncthreads();
            const int col = C.tid & 63, kq = C.tid >> 6;
            float acc[17];
#pragma unroll
            for (int r = 0; r < 17; ++r) acc[r] = 0.f;
            for (int k = kq * 128; k < kq * 128 + 128; k += 4) {
                float w[4];
#pragma unroll
                for (int j = 0; j < 4; ++j) w[j] = wada[(size_t)(k + j) * MODW + col0 + col];
#pragma unroll
                for (int r = 0; r < 17; ++r) { const f32x4 s4 = *(const LAS f32x4*)(sc + r * 1024 + k); acc[r] += s4.x * w[0] + s4.y * w[1] + s4.z * w[2] + s4.w * w[3]; }
            }
#pragma unroll
            for (int r = 0; r < 17; ++r) red[(kq * 17 + r) * 64 + col] = acc[r];
            __syncthreads();
            for (int i = C.tid; i < nr * 64; i += 512) { const int r = i >> 6, cc = i & 63; float s = 0.f;
#pragma unroll
                for (int q = 0; q < 8; ++q) s += red[(q * 17 + r) * 64 + cc];
                mod[(size_t)(r0 + r) * MODW + col0 + cc] = s + bada[col0 + cc]; }
        }
        __syncthreads();
    }
    {
        lfloat* scr = (lfloat*)(C.lds + C.wave * 16384);
        const int gw = C.bid * 8 + C.wave, NGW = C.G * 8;
        bf16_t* btin = WSP(bf16_t, WS_BTIN); bf16_t* btout = WSP(bf16_t, WS_BTOUT); bf16_t* btr = WSP(bf16_t, WS_BTR);
        constexpr int I_IN = (D / 64) * 124, I_OUT = (D / 64) * (D / 32), I_R = (D / 64) * (NE / 32), I_G = (128 / 64) * (DA / 32);
        for (int it = gw; it < I_IN + I_OUT + I_R + I_G; it += NGW) {
            int r = it;
            if (r < I_IN) {
                const int kb = r / 124, nb = r % 124, k0 = 64 * kb, n0 = 32 * nb; const float* W = A.in[I_WIN];
#pragma unroll 8
                for (int i = 0; i < 32; ++i) { const int kk = 2 * i + (C.lane >> 5); scr[kk * 33 + (C.lane & 31)] = W[(size_t)(k0 + kk) * IN_COLS + n0 + (C.lane & 31)]; }
                asm volatile("s_waitcnt lgkmcnt(0)" ::: "memory");
                const int c = C.lane & 7;
#pragma unroll
                for (int j = 0; j < 4; ++j) { const int n = (C.lane >> 3) + 8 * j; const lfloat* s = scr + (8 * c) * 33 + n;
                    u32x4 o; o.x = pk2(s[0 * 33], s[1 * 33]); o.y = pk2(s[2 * 33], s[3 * 33]); o.z = pk2(s[4 * 33], s[5 * 33]); o.w = pk2(s[6 * 33], s[7 * 33]);
                    *(u32x4*)(btin + (size_t)(n0 + n) * D + k0 + 8 * c) = o; }
                asm volatile("s_waitcnt lgkmcnt(0)" ::: "memory");
                continue; }
            r -= I_IN;
            if (r < I_OUT) { transpose_item(A.in[I_WOUT], D, D, btout, RowId(), scr, r, C.lane); continue; } r -= I_OUT;
            if (r < I_R) { transpose_item(A.in[I_RW], D, NE, btr, RowId(), scr, r, C.lane); continue; } r -= I_R;
            transpose_item(A.in[I_GUP], 128, DA, WSP(bf16_t, WS_GUPT), RowId(), scr, r, C.lane);
        }
        for (int i = C.bid * 512 + C.tid; i < 16 * D; i += C.G * 512) { const int n = 3968 + (i >> 10), k = i & 1023; btin[(size_t)n * D + k] = (bf16_t)f2bf(A.in[I_WIN][(size_t)k * IN_COLS + n]); }
        for (int i = C.bid * 512 + C.tid; i < (PLD - IN_COLS) * D / 8; i += C.G * 512) ((u32x4*)(btin + (size_t)IN_COLS * D))[i] = (u32x4){0u, 0u, 0u, 0u};
    }
}

__device__ __forceinline__ void phase_p1(const Args& A, Ctx& C) {
    const float* mod = WSP(float, WS_MOD); bf16_t* xn = WSP(bf16_t, WS_XN);
    const int gw = C.bid * 8 + C.wave, NGW = C.G * 8;
    for (int row = gw; row < NROWS; row += NGW) {
        const float* xr; int mb;
        if (row < NLAT) { xr = A.in[I_X] + (size_t)row * D; mb = row >> 11; } else { xr = A.in[I_CTX] + (size_t)(row - NLAT) * D; mb = 32; }
        const float* m = mod + (size_t)mb * MODW;
        norm_mod_row(xr, A.in[I_N1G], m + D, m, xn + (size_t)row * D, C.lane);
    }
}

template <int NK>
__device__ __forceinline__ f32x4 mm_tile(const lbyte* Ap, int lda, const lbyte* Bp, int ldb, f32x4 acc, int lane) {
    const int r = lane & 15, g = lane >> 4;
#pragma unroll
    for (int ks = 0; ks < NK; ++ks) {
        const bf16x8 a = *(const LAS bf16x8*)(Ap + r * lda + ks * 64 + g * 16);
        const bf16x8 b = *(const LAS bf16x8*)(Bp + r * ldb + ks * 64 + g * 16);
        acc = __builtin_amdgcn_mfma_f32_16x16x32_bf16(a, b, acc, 0, 0, 0);
    }
    return acc;
}

__device__ __forceinline__ void st_bf16x4(lbyte* p, f32x4 v) { u32x2 w; w.x = cvtpk(v.x, v.y); w.y = cvtpk(v.z, v.w); *(LAS u32x2*)p = w; }
__device__ __forceinline__ void st_bf16(lbyte* p, float v) { *(LAS unsigned short*)p = (unsigned short)cvtpk(v, v); }
__device__ __forceinline__ float rdlane(float v, int l) { return __builtin_bit_cast(float, __builtin_amdgcn_readlane(__builtin_bit_cast(int, v), l)); }

__device__ __forceinline__ void tri_inv16(const f32x4 m, int lane, float (&X)[16]) {
#pragma unroll
    for (int i = 0; i < 16; ++i) {
        float x0 = (lane == i) ? 1.f : 0.f, x1 = 0.f;
#pragma unroll
        for (int k = 0; k < i; ++k) { const float t = rdlane(m[k & 3], i + 16 * (k >> 2)) * X[k]; if (k & 1) x1 -= t; else x0 -= t; }
        X[i] = x0 + x1;
    }
}

namespace rk {
constexpr int S64 = 160, S32 = 80, SW = 144;
constexpr int O_WUP = 0, O_AUP = O_WUP + 64 * SW, O_WLT = O_AUP + 64 * SW, O_ALT = O_WLT + 16 * S64, O_LW = O_ALT + 16 * S64, O_LA = O_LW + 4096,
              O_KKT = O_LA + 4096, O_RT = O_KKT + 16 * S64, O_BT = O_RT + 16 * S64, O_KDT = O_BT + 16 * S64,
              O_VT = O_KDT + 16 * S64, O_BHT = O_VT + 64 * S32, O_KHT = O_BHT + 64 * S32, O_UT = O_KHT + 64 * S32, O_UTT = O_WLT  ,
              O_TI = O_UT + 64 * S32, O_MK = O_TI + 16 * S32, O_NB = O_MK + 16 * S32, O_NK = O_NB + 16 * S32,
              O_SBF = O_NK + 16 * S32, O_WC = O_SBF + 64 * S64, TEAM_BYTES = O_WC + 256;
static_assert(2 * TEAM_BYTES <= LDS_MISC, "rwkv LDS");
}
__device__ __forceinline__ void rwkv_pair_chunked(const Args& A, Ctx& C, int pair) {
    using namespace rk;
    const int b = pair >> 3, h = pair & 7;
    const int dir = C.wave >> 2;
    const int t4 = C.tid & 255, q = C.wave & 3, lane = C.lane;
    lbyte* L = C.lds + dir * TEAM_BYTES;
    const bf16_t* P = WSP(bf16_t, WS_P);
    bf16_t* ydir = WSP(bf16_t, WS_YDIR) + (size_t)dir * NLAT * D;
    float* bon = WSP(float, WS_BON) + (size_t)dir * NLAT * 8;
    __syncthreads();
#pragma unroll 2
    for (int i = t4; i < 4096; i += 256) { const int l = i >> 6, c = i & 63;
        st_bf16(L + O_WUP + c * SW + l * 2, A.in[I_WUP][((size_t)dir * 64 + l) * DA + 64 * h + c]);
        st_bf16(L + O_AUP + c * SW + l * 2, A.in[I_AUP][((size_t)dir * 64 + l) * DA + 64 * h + c]); }
#pragma unroll 2
    for (int i = t4; i < (4 * 64 * S32 + 4 * 16 * S32 + 64 * S64) / 4; i += 256) ((LAS unsigned*)(L + O_VT))[i] = 0u;
    for (int i = t4; i < (2 * 16 * S64) / 4; i += 256) ((LAS unsigned*)(L + O_WLT))[i] = 0u;
    const int c = lane;
    int col5[5] = {64 * h + c, 512 + 64 * h + c, 1024 + 64 * h + c, 1536 + 64 * dir + c, 1664 + 64 * dir + c};
    float mu5[5]; int dl5[5], cl5[5], dc5[5], cc5[5];
#pragma unroll
    for (int e = 0; e < 5; ++e) { const int col = col5[e]; mu5[e] = A.in[I_MU][col];
        cl5[e] = col < 480 ? 0 : (col < 960 ? 1 : (col < 1440 ? 2 : 3)); dl5[e] = (cl5[e] == 0 ? -PLD : (cl5[e] == 1 ? PLD : (cl5[e] == 2 ? -64 * PLD : 64 * PLD)));
        cc5[e] = col < 960 ? 0 : 1; dc5[e] = col < 960 ? -PLD : PLD; }
    const float kkc = A.in[I_KK][64 * h + c], kac = A.in[I_KA][64 * h + c], rkc = A.in[I_RK][64 * h + c];
    const float w0c = A.in[I_W0][dir * DA + 64 * h + c], a0c = A.in[I_A0][dir * DA + 64 * h + c];
    f32x4 Sacc[4];
#pragma unroll
    for (int i = 0; i < 4; ++i) Sacc[i] = (f32x4){0.f, 0.f, 0.f, 0.f};
    const int fr = lane & 15, fg = lane >> 4;
    unsigned short rawp[4][5], raws[4][5];
    auto chunk_geom = [&](int ch, bool& isctx, int& sbase, int& T, size_t& rowbase) { isctx = ch < 16; sbase = isctx ? ch * 16 : (ch - 16) * 16; T = isctx ? CTX : SEQ; rowbase = isctx ? (size_t)NLAT + (size_t)b * CTX : (size_t)b * SEQ; };
    auto okmask = [&](bool isctx, int t) -> int { return isctx ? ((t >= 1 ? 1 : 0) | (t <= CTX - 2 ? 2 : 0)) : (((t & 63) >= 1 ? 1 : 0) | ((t & 63) <= 62 ? 2 : 0) | (t >= 64 ? 4 : 0) | (t < SEQ - 64 ? 8 : 0)); };
    auto issue_loads = [&](int ch) { bool isctx; int sbase, T; size_t rowbase; chunk_geom(ch, isctx, sbase, T, rowbase);
#pragma unroll
        for (int j = 0; j < 4; ++j) { const int i = q + 4 * j; const int t = __builtin_amdgcn_readfirstlane(dir ? (T - 1 - (sbase + i)) : (sbase + i));
            const bf16_t* pr = P + (rowbase + t) * PLD; const int okm = okmask(isctx, t);
#pragma unroll
            for (int e = 0; e < 5; ++e) { const int cls = isctx ? cc5[e] : cl5[e]; const bool ok = (okm >> cls) & 1; const int off = col5[e] + (ok ? (isctx ? dc5[e] : dl5[e]) : 0);
                rawp[j][e] = pr[col5[e]]; raws[j][e] = pr[off]; } } };
    issue_loads(0);
    for (int ch = 0; ch < 144; ++ch) {
        bool isctx; int sbase, T; size_t rowbase; chunk_geom(ch, isctx, sbase, T, rowbase);
        float vr[4], vk[4], vv[4], vkk[4], lw[4], av[4];
        __syncthreads();
        float mxa[4][5];
#pragma unroll
        for (int j = 0; j < 4; ++j) { const int i = q + 4 * j; const int t = __builtin_amdgcn_readfirstlane(dir ? (T - 1 - (sbase + i)) : (sbase + i)); const int okm = okmask(isctx, t);
#pragma unroll
            for (int e = 0; e < 5; ++e) { const int cls = isctx ? cc5[e] : cl5[e]; const bool ok = (okm >> cls) & 1;
                const float pv = bf2f(rawp[j][e]); const float sv = bf2f(raws[j][e]); mxa[j][e] = pv + mu5[e] * ((ok ? sv : 0.f) - pv); } }
        if (ch + 1 < 144) issue_loads(ch + 1);
#pragma unroll
        for (int j = 0; j < 4; ++j) {
            const int i = q + 4 * j;
            float mx[5];
#pragma unroll
            for (int e = 0; e < 5; ++e) mx[e] = mxa[j][e];
            vr[j] = mx[0]; vk[j] = mx[1]; vv[j] = mx[2];
            *(LAS unsigned short*)(L + O_WLT + i * S64 + c * 2) = (unsigned short)cvtpk(tanhf_(mx[3]), 0.f); *(LAS unsigned short*)(L + O_ALT + i * S64 + c * 2) = (unsigned short)cvtpk(mx[4], 0.f);
            const float kx = vk[j] * kkc; const float ss = wave_sum(kx * kx);
            vkk[j] = kx * __builtin_amdgcn_rsqf(ss + 1e-6f);
        }
        __syncthreads();
        {
            const f32x4 z = (f32x4){0.f, 0.f, 0.f, 0.f};
            const f32x4 tw = mm_tile<2>(L + O_WLT, S64, L + O_WUP + 16 * q * SW, SW, z, lane);
            const f32x4 ta = mm_tile<2>(L + O_ALT, S64, L + O_AUP + 16 * q * SW, SW, z, lane);
#pragma unroll
            for (int e = 0; e < 4; ++e) { ((LAS float*)(L + O_LW))[(4 * fg + e) * 64 + 16 * q + fr] = tw[e]; ((LAS float*)(L + O_LA))[(4 * fg + e) * 64 + 16 * q + fr] = ta[e]; }
        }
        __syncthreads();
#pragma unroll
        for (int j = 0; j < 4; ++j) { const int i = q + 4 * j;
            const float wlog = -softplusf_(-(w0c + ((LAS float*)(L + O_LW))[i * 64 + c])) - 0.5f;
            lw[j] = -__expf(wlog);
            av[j] = sigmoidf_(a0c + ((LAS float*)(L + O_LA))[i * 64 + c]);
            ((LAS float*)(L + O_LW))[i * 64 + c] = lw[j]; }
        __syncthreads();
        if (t4 < 64) { float cum = 0.f;
#pragma unroll
            for (int t = 0; t < 16; ++t) { cum += ((LAS float*)(L + O_LW))[t * 64 + c]; ((LAS float*)(L + O_LW))[t * 64 + c] = cum; } }
        __syncthreads();
        {
            const float cumC = ((LAS float*)(L + O_LW))[15 * 64 + c];
#pragma unroll
            for (int j = 0; j < 4; ++j) { const int i = q + 4 * j;
                const float cum = ((LAS float*)(L + O_LW))[i * 64 + c];
                const float Wt = __expf(cum), Wp = __expf(cum - lw[j]), Wi = __expf(-cum), Wc = __expf(cumC - cum);
                const float kd = vk[j] * (1.f + (av[j] - 1.f) * kac), bb = vkk[j] * av[j];
                const unsigned p0 = cvtpk(vkk[j] * Wp, vr[j] * Wt), p1 = cvtpk(bb * Wi, kd * Wi), p2 = cvtpk(vv[j], bb * Wc), p3 = cvtpk(kd * Wc, 0.f);
                *(LAS unsigned short*)(L + O_KKT + i * S64 + c * 2) = (unsigned short)p0; *(LAS unsigned short*)(L + O_RT + i * S64 + c * 2) = (unsigned short)(p0 >> 16);
                *(LAS unsigned short*)(L + O_BT + i * S64 + c * 2) = (unsigned short)p1; *(LAS unsigned short*)(L + O_KDT + i * S64 + c * 2) = (unsigned short)(p1 >> 16);
                *(LAS unsigned short*)(L + O_VT + c * S32 + i * 2) = (unsigned short)p2; *(LAS unsigned short*)(L + O_BHT + c * S32 + i * 2) = (unsigned short)(p2 >> 16);
                *(LAS unsigned short*)(L + O_KHT + c * S32 + i * 2) = (unsigned short)p3;
                const float bs = wave_sum(vr[j] * kd * rkc);
                if (!isctx && lane == 0) { const int t = dir ? (T - 1 - (sbase + i)) : (sbase + i); bon[((size_t)b * SEQ + t) * 8 + h] = bs; }
            }
            if (q == 3) ((LAS float*)(L + O_WC))[c] = __expf(cumC);
        }
        __syncthreads();
        {
            const lbyte* Aj = L + ((q & 1) ? O_KDT : O_BT);
            const lbyte* Bt = L + ((q & 2) ? O_RT : O_KKT);
            f32x4 g4 = mm_tile<2>(Aj, S64, Bt, S64, (f32x4){0.f, 0.f, 0.f, 0.f}, lane);
#pragma unroll
            for (int e = 0; e < 4; ++e) { const int j = 4 * fg + e; const bool keep = (q & 2) ? (j <= fr) : (j < fr); g4[e] = keep ? g4[e] : 0.f; }
            if (q == 0) { float X[16]; tri_inv16(g4, lane, X);
                if (lane < 16) {
#pragma unroll
                    for (int i = 0; i < 16; ++i) *(LAS unsigned short*)(L + O_TI + i * S32 + lane * 2) = (unsigned short)cvtpk(X[i], 0.f); } }
            else st_bf16x4(L + (q == 1 ? O_MK : (q == 2 ? O_NB : O_NK)) + fr * S32 + fg * 8, g4);
        }
        __syncthreads();
        f32x4 yacc;
        {
            f32x4 u4 = mm_tile<2>(L + O_KKT, S64, L + O_SBF + 16 * q * S64, S64, (f32x4){0.f, 0.f, 0.f, 0.f}, lane);
            u4 = mm_tile<1>(L + O_MK, S32, L + O_VT + 16 * q * S32, S32, u4, lane);
            st_bf16x4(L + O_UTT + (16 * q + fr) * S32 + fg * 8, u4);
            yacc = mm_tile<2>(L + O_SBF + 16 * q * S64, S64, L + O_RT, S64, (f32x4){0.f, 0.f, 0.f, 0.f}, lane);
            yacc = mm_tile<1>(L + O_VT + 16 * q * S32, S32, L + O_NK, S32, yacc, lane);
        }
        asm volatile("s_waitcnt lgkmcnt(0)" ::: "memory");
        {
            f32x4 u4 = mm_tile<1>(L + O_TI, S32, L + O_UTT + 16 * q * S32, S32, (f32x4){0.f, 0.f, 0.f, 0.f}, lane);
            st_bf16x4(L + O_UT + (16 * q + fr) * S32 + fg * 8, -u4);
        }
        __syncthreads();
        {
            yacc = mm_tile<1>(L + O_UT + 16 * q * S32, S32, L + O_NB, S32, yacc, lane);
            if (!isctx) { const int t = dir ? (T - 1 - (sbase + fr)) : (sbase + fr);
                u32x2 w; w.x = cvtpk(yacc[0], yacc[1]); w.y = cvtpk(yacc[2], yacc[3]);
                *(u32x2*)(ydir + ((size_t)b * SEQ + t) * D + 64 * h + 16 * q + 4 * fg) = w; }
            const f32x4 wc4 = *(LAS f32x4*)(L + O_WC + (16 * q + 4 * fg) * 4);
#pragma unroll
            for (int vi = 0; vi < 4; ++vi) {
                f32x4 s4 = Sacc[vi] * wc4;
                s4 = mm_tile<1>(L + O_KHT + 16 * q * S32, S32, L + O_VT + 16 * vi * S32, S32, s4, lane);
                s4 = mm_tile<1>(L + O_BHT + 16 * q * S32, S32, L + O_UT + 16 * vi * S32, S32, s4, lane);
                Sacc[vi] = s4;
                st_bf16x4(L + O_SBF + (16 * vi + fr) * S64 + (16 * q + 4 * fg) * 2, s4);
            }
        }
    }
    __syncthreads();
}

__device__ __forceinline__ void phase_gdn_prep(const Args& A, Ctx& C) {
    const bf16_t* P = WSP(bf16_t, WS_P);
    bf16_t* QKV = (bf16_t*)A.out; float* NRM = WSP(float, WS_NRM);
    lfloat* part = (lfloat*)C.lds;
    const int tid = C.tid, lane = C.lane, w = C.wave;
    float cw[3][5];
#pragma unroll
    for (int g = 0; g < 3; ++g)
#pragma unroll
        for (int e = 0; e < 5; ++e) cw[g][e] = A.in[I_CONVW][e * 1536 + g * 512 + tid];
    for (int tile = C.bid; tile < NROWS / 16; tile += C.G) {
        const int row0 = tile * 16;
        int T, ta; size_t rowbase;
        if (row0 < NLAT) { T = SEQ; rowbase = (size_t)(row0 >> 11) * SEQ; ta = row0 & (SEQ - 1); } else { T = CTX; const int r = row0 - NLAT; rowbase = (size_t)NLAT + (size_t)(r >> 8) * CTX; ta = r & (CTX - 1); }
        float x[3][20];
#pragma unroll
        for (int e = 0; e < 20; ++e) { const int t = ta - 2 + e; const bool ok = (t >= 0 && t < T); const bf16_t* pr = P + (rowbase + (ok ? t : ta)) * PLD + RW_COLS + tid;
#pragma unroll
            for (int g = 0; g < 3; ++g) { const float xv = bf2f(pr[g * 512]); x[g][e] = ok ? xv : 0.f; } }
        __syncthreads();
#pragma unroll
        for (int i = 0; i < 16; ++i) { float y[3];
#pragma unroll
            for (int g = 0; g < 3; ++g) { float sacc = 0.f;
#pragma unroll
                for (int f = 0; f < 5; ++f) sacc += cw[g][f] * x[g][i + f];
                y[g] = siluf_(sacc); }
            bf16_t* orow = QKV + (rowbase + ta + i) * 1536 + tid;
            orow[0] = (bf16_t)cvtpk(y[0], 0.f); orow[512] = (bf16_t)cvtpk(y[1], 0.f); orow[1024] = (bf16_t)cvtpk(y[2], 0.f);
            const float sq = wave_sum(y[0] * y[0]), sk = wave_sum(y[1] * y[1]);
            if (lane == 0) { part[(i * 8 + w) * 2] = sq; part[(i * 8 + w) * 2 + 1] = sk; } }
        __syncthreads();
        if (tid < 128) { const int i = tid >> 3, sidx = tid & 7, h = sidx & 3, sel = sidx >> 2;
            const float ss = part[(i * 8 + 2 * h) * 2 + sel] + part[(i * 8 + 2 * h + 1) * 2 + sel];
            NRM[(rowbase + ta + i) * 8 + sidx] = __builtin_amdgcn_rsqf(ss + 1e-6f) * (sel ? 1.f : 0.08838834764831845f); }
    }
    __syncthreads();
}

namespace gd {
constexpr int S128 = 288, S32 = 80;
constexpr int O_QR = 0, O_KR = O_QR + 8192, O_KT = O_KR + 8192, O_QT = O_KT + 16 * S128, O_KKT = O_QT + 16 * S128, O_RT = O_KKT + 16 * S128,
              O_VT = O_RT + 16 * S128, O_BHT = O_VT + 128 * S32, O_KHT = O_BHT + 128 * S32, O_UT = O_KHT + 128 * S32, O_UTT = O_UT + 128 * S32,
              O_TI = O_UTT + 128 * S32, O_MK = O_TI + 16 * S32, O_NB = O_MK + 16 * S32, O_NK = O_NB + 16 * S32,
              O_SBF = O_NK + 16 * S32, O_SC = O_SBF + 128 * S128, GD_BYTES = O_SC + 512;
static_assert(GD_BYTES <= LDS_MISC, "gdn LDS");
}
__device__ __forceinline__ void gdn_chain_chunked(const Args& A, Ctx& C, int chain) {
    using namespace gd;
    const int b = chain >> 3, h = (chain >> 1) & 3, dir = chain & 1;
    lbyte* L = C.lds;
    LAS float* SC = (LAS float*)(L + O_SC);
    const bf16_t* P = WSP(bf16_t, WS_P);
    bf16_t* ydir = WSP(bf16_t, WS_YDIR) + (size_t)dir * NLAT * D;
    const int tid = C.tid, lane = C.lane, w = C.wave, fr = lane & 15, fg = lane >> 4;
    const int grp = tid >> 7, idx = tid & 127;
    const int ccol = grp * 512 + 128 * h + idx;
    float cw[5];
#pragma unroll
    for (int e = 0; e < 5; ++e) cw[e] = grp < 3 ? A.in[I_CONVW][e * 1536 + ccol] : 0.f;
    const float Aexp = __expf(A.in[I_ALOG][dir * 4 + h]), dtb = A.in[I_DTB][dir * 4 + h];
    __syncthreads();
#pragma unroll 2
    for (int i = tid; i < (5 * 128 * S32 + 4 * 16 * S32 + 128 * S128) / 4; i += 512) ((LAS unsigned*)(L + O_VT))[i] = 0u;
    f32x4 Sacc[8];
#pragma unroll
    for (int i = 0; i < 8; ++i) Sacc[i] = (f32x4){0.f, 0.f, 0.f, 0.f};
    const bf16_t* QKV = (const bf16_t*)A.out; const float* NRM = WSP(const float, WS_NRM);
    unsigned short rq[4], rk[4], rv[4]; float nq[4], nk[4]; unsigned short raw_al = 0, raw_be = 0;
    auto chunk_geom = [&](int ch, bool& isctx, int& sbase, int& T, size_t& rowbase) { isctx = ch < 16; sbase = isctx ? ch * 16 : (ch - 16) * 16; T = isctx ? CTX : SEQ;
        rowbase = isctx ? (size_t)NLAT + (size_t)b * CTX : (size_t)b * SEQ; };
    auto issue_loads = [&](int ch) { bool isctx; int sbase, T; size_t rowbase; chunk_geom(ch, isctx, sbase, T, rowbase);
#pragma unroll
        for (int j = 0; j < 4; ++j) { const int i = grp + 4 * j; const int t = dir ? (T - 1 - (sbase + i)) : (sbase + i); const size_t row = rowbase + t;
            const bf16_t* qr = QKV + row * 1536 + 128 * h + idx; rq[j] = qr[0]; rk[j] = qr[512]; rv[j] = qr[1024]; nq[j] = NRM[row * 8 + h]; nk[j] = NRM[row * 8 + 4 + h]; }
        if (w == 7 && lane < 16) { const int t = dir ? (T - 1 - (sbase + lane)) : (sbase + lane); const bf16_t* pr = P + (rowbase + t) * PLD + RW_COLS + 2048; raw_al = pr[dir * 4 + h]; raw_be = pr[8 + dir * 4 + h]; } };
    issue_loads(0);
    for (int ch = 0; ch < 144; ++ch) {
        bool isctx; int sbase, T; size_t rowbase; chunk_geom(ch, isctx, sbase, T, rowbase);
        __syncthreads();
        float qv[4], kv[4], vv[4], nqv[4], nkv[4];
#pragma unroll
        for (int j = 0; j < 4; ++j) { qv[j] = bf2f(rq[j]); kv[j] = bf2f(rk[j]); vv[j] = bf2f(rv[j]); nqv[j] = nq[j]; nkv[j] = nk[j]; }
        if (w == 7) {
            const float gi = (lane < 16) ? -Aexp * softplusf_(bf2f(raw_al) + dtb) : 0.f;
            float cum = gi;
            cum += __builtin_bit_cast(float, __builtin_amdgcn_update_dpp(0, __builtin_bit_cast(int, cum), 0x111, 0xf, 0xf, true));
            cum += __builtin_bit_cast(float, __builtin_amdgcn_update_dpp(0, __builtin_bit_cast(int, cum), 0x112, 0xf, 0xf, true));
            cum += __builtin_bit_cast(float, __builtin_amdgcn_update_dpp(0, __builtin_bit_cast(int, cum), 0x114, 0xf, 0xf, true));
            cum += __builtin_bit_cast(float, __builtin_amdgcn_update_dpp(0, __builtin_bit_cast(int, cum), 0x118, 0xf, 0xf, true));
            if (lane < 16) { SC[16 + lane] = sigmoidf_(bf2f(raw_be)); SC[64 + lane + 1] = cum; if (lane == 0) SC[64] = 0.f; }
        }
        if (ch + 1 < 144) issue_loads(ch + 1);
        __syncthreads();
        {
            const int c = idx; const float gcC = SC[64 + 16];
#pragma unroll
            for (int j = 0; j < 4; ++j) { const int i = grp + 4 * j;
                const float kn = kv[j] * nkv[j], qn = qv[j] * nqv[j];
                const float gm = SC[64 + i], gi = SC[64 + i + 1], be = SC[16 + i];
                const unsigned p0 = cvtpk(kn, qn), p1 = cvtpk(kn * __expf(gm), qn * __expf(gi)), p2 = cvtpk(be * kn * __expf(gcC - gm), be * kn * __expf(gcC - gi));
                *(LAS unsigned short*)(L + O_KT + i * S128 + c * 2) = (unsigned short)p0; *(LAS unsigned short*)(L + O_QT + i * S128 + c * 2) = (unsigned short)(p0 >> 16);
                *(LAS unsigned short*)(L + O_KKT + i * S128 + c * 2) = (unsigned short)p1; *(LAS unsigned short*)(L + O_RT + i * S128 + c * 2) = (unsigned short)(p1 >> 16);
                *(LAS unsigned short*)(L + O_BHT + c * S32 + i * 2) = (unsigned short)p2; *(LAS unsigned short*)(L + O_KHT + c * S32 + i * 2) = (unsigned short)(p2 >> 16);
                *(LAS unsigned short*)(L + O_VT + c * S32 + i * 2) = (unsigned short)cvtpk(vv[j], 0.f); }
        }
        __syncthreads();
        if (w < 2) {
            const f32x4 g4 = mm_tile<4>(L + O_KT, S128, L + (w ? O_QT : O_KT), S128, (f32x4){0.f, 0.f, 0.f, 0.f}, lane);
            const float gt = w ? SC[64 + fr + 1] : SC[64 + fr];
            f32x4 m0, m1;
#pragma unroll
            for (int e = 0; e < 4; ++e) { const int j = 4 * fg + e; const bool keep = w ? (j <= fr) : (j < fr);
                const float bj = SC[16 + j] * g4[e];
                m0[e] = keep ? bj * __expf(gt - SC[64 + j]) : 0.f;
                m1[e] = keep ? bj * __expf(gt - SC[64 + j + 1]) : 0.f; }
            if (w == 0) { st_bf16x4(L + O_MK + fr * S32 + fg * 8, m1);
                float X[16]; tri_inv16(m0, lane, X);
                if (lane < 16) {
#pragma unroll
                    for (int i = 0; i < 16; ++i) *(LAS unsigned short*)(L + O_TI + i * S32 + lane * 2) = (unsigned short)cvtpk(X[i], 0.f); } }
            else { st_bf16x4(L + O_NB + fr * S32 + fg * 8, m0); st_bf16x4(L + O_NK + fr * S32 + fg * 8, m1); }
        }
        __syncthreads();
        f32x4 yacc;
        {
            f32x4 u4 = mm_tile<4>(L + O_KKT, S128, L + O_SBF + 16 * w * S128, S128, (f32x4){0.f, 0.f, 0.f, 0.f}, lane);
            u4 = mm_tile<1>(L + O_MK, S32, L + O_VT + 16 * w * S32, S32, u4, lane);
            st_bf16x4(L + O_UTT + (16 * w + fr) * S32 + fg * 8, u4);
            yacc = mm_tile<4>(L + O_SBF + 16 * w * S128, S128, L + O_RT, S128, (f32x4){0.f, 0.f, 0.f, 0.f}, lane);
            yacc = mm_tile<1>(L + O_VT + 16 * w * S32, S32, L + O_NK, S32, yacc, lane);
        }
        asm volatile("s_waitcnt lgkmcnt(0)" ::: "memory");
        {
            const f32x4 u4 = mm_tile<1>(L + O_TI, S32, L + O_UTT + 16 * w * S32, S32, (f32x4){0.f, 0.f, 0.f, 0.f}, lane);
            st_bf16x4(L + O_UT + (16 * w + fr) * S32 + fg * 8, -u4);
        }
        __syncthreads();
        {
            yacc = mm_tile<1>(L + O_UT + 16 * w * S32, S32, L + O_NB, S32, yacc, lane);
            if (!isctx) { const int t = dir ? (T - 1 - (sbase + fr)) : (sbase + fr);
                u32x2 pk; pk.x = cvtpk(yacc[0], yacc[1]); pk.y = cvtpk(yacc[2], yacc[3]);
                *(u32x2*)(ydir + ((size_t)b * SEQ + t) * D + 512 + 128 * h + 16 * w + 4 * fg) = pk; }
            const float wc = __expf(SC[64 + 16]);
#pragma unroll
            for (int vi = 0; vi < 8; ++vi) {
                f32x4 s4 = Sacc[vi] * wc;
                s4 = mm_tile<1>(L + O_KHT + 16 * w * S32, S32, L + O_VT + 16 * vi * S32, S32, s4, lane);
                s4 = mm_tile<1>(L + O_BHT + 16 * w * S32, S32, L + O_UT + 16 * vi * S32, S32, s4, lane);
                Sacc[vi] = s4;
                st_bf16x4(L + O_SBF + (16 * vi + fr) * S128 + (16 * w + 4 * fg) * 2, s4);
            }
        }
    }
    __syncthreads();
}

__device__ __forceinline__ void unpack8(const u32x4 w, float (&f)[8]) { f[0] = bflo(w.x); f[1] = bfhi(w.x); f[2] = bflo(w.y); f[3] = bfhi(w.y); f[4] = bflo(w.z); f[5] = bfhi(w.z); f[6] = bflo(w.w); f[7] = bfhi(w.w); }
__device__ __forceinline__ void phase_p4(const Args& A, Ctx& C) {
    const bf16_t* P = WSP(bf16_t, WS_P);
    const bf16_t* yf = WSP(bf16_t, WS_YDIR); const bf16_t* yb = yf + (size_t)NLAT * D;
    const float* bon = WSP(float, WS_BON);
    bf16_t* ymix = WSP(bf16_t, WS_YMIX);
    lbyte* SGb = C.lds;
    lfloat* GO = (lfloat*)(C.lds + 8192);
    const int tid = C.tid, lane = C.lane, w = C.wave;
    const bf16_t* gupt = WSP(const bf16_t, WS_GUPT);
    const int fr = lane & 15, fg = lane >> 4;
    const int c8 = 8 * lane;
    float lnw[8], lnb[8], ong[8], muv[8];
#pragma unroll
    for (int e = 0; e < 8; ++e) { lnw[e] = A.in[I_LNW][c8 + e]; lnb[e] = A.in[I_LNB][c8 + e]; ong[e] = A.in[I_ONG][(c8 + e) & 127]; muv[e] = A.in[I_MU][1024 + c8 + e]; }
    const int tkA = tid >> 5, lA = 4 * (tid & 31);
    float muA[4];
#pragma unroll
    for (int e = 0; e < 4; ++e) muA[e] = A.in[I_MU][1792 + lA + e];
    const bool vup = (1024 + c8) < 1440;
    for (int tile = C.bid; tile < NLAT / 16; tile += C.G) {
        const int row0 = tile * 16;
        __syncthreads();
        {
            const int row = row0 + tkA, t = row & (SEQ - 1); const bool ok = t < SEQ - 64;
            const u32x2 pw = *(const u32x2*)(P + (size_t)row * PLD + 1792 + lA); const u32x2 sw = *(const u32x2*)(P + (size_t)(row + (ok ? 64 : 0)) * PLD + 1792 + lA);
            const float pv[4] = {bflo(pw.x), bfhi(pw.x), bflo(pw.y), bfhi(pw.y)}; const float sv[4] = {bflo(sw.x), bfhi(sw.x), bflo(sw.y), bfhi(sw.y)};
            float o[4];
#pragma unroll
            for (int e = 0; e < 4; ++e) o[e] = sigmoidf_(pv[e] + muA[e] * ((ok ? sv[e] : 0.f) - pv[e]));
            u32x2 ow; ow.x = cvtpk(o[0], o[1]); ow.y = cvtpk(o[2], o[3]); *(LAS u32x2*)(SGb + tkA * 288 + lA * 2) = ow;
        }
        __syncthreads();
#pragma unroll
        for (int i = 0; i < 4; ++i) { const int c0 = 64 * w + 16 * i; f32x4 acc = (f32x4){0.f, 0.f, 0.f, 0.f};
#pragma unroll
            for (int ks = 0; ks < 4; ++ks) { const bf16x8 a = *(const LAS bf16x8*)(SGb + fr * 288 + ks * 64 + fg * 16);
                const bf16x8 bq = *(const bf16x8*)(gupt + (size_t)(c0 + fr) * 128 + ks * 32 + fg * 8);
                acc = __builtin_amdgcn_mfma_f32_16x16x32_bf16(a, bq, acc, 0, 0, 0); }
#pragma unroll
            for (int e = 0; e < 4; ++e) GO[(4 * fg + e) * 512 + c0 + fr] = acc[e]; }
        __syncthreads();
#pragma unroll
        for (int tt = 0; tt < 2; ++tt) {
            const int tk = 2 * w + tt, row = row0 + tk, t = row & (SEQ - 1);
            const bool okv = vup ? (t >= 64) : (t < SEQ - 64);
            const u32x4 wyf = *(const u32x4*)(yf + (size_t)row * D + c8), wyb = *(const u32x4*)(yb + (size_t)row * D + c8);
            const u32x4 wpv = *(const u32x4*)(P + (size_t)row * PLD + 1024 + c8), wsv = *(const u32x4*)(P + (size_t)(row + (okv ? (vup ? -64 : 64) : 0)) * PLD + 1024 + c8);
            const u32x4 wof = *(const u32x4*)(yf + (size_t)row * D + 512 + c8), wob = *(const u32x4*)(yb + (size_t)row * D + 512 + c8);
            const u32x4 wz = *(const u32x4*)(P + (size_t)row * PLD + RW_COLS + 1536 + c8);
            const float bs = bon[(size_t)row * 8 + (lane >> 3)] + bon[((size_t)NLAT + row) * 8 + (lane >> 3)];
            const f32x4 g0 = *(const LAS f32x4*)(GO + tk * 512 + c8), g1 = *(const LAS f32x4*)(GO + tk * 512 + c8 + 4);
            const float gg[8] = {g0.x, g0.y, g0.z, g0.w, g1.x, g1.y, g1.z, g1.w};
            float a[8], bq[8], pv[8], sv[8], y[8];
            unpack8(wyf, a); unpack8(wyb, bq); unpack8(wpv, pv); unpack8(wsv, sv);
            float s1 = 0.f;
#pragma unroll
            for (int e = 0; e < 8; ++e) { y[e] = a[e] + bq[e]; s1 += y[e]; }
            s1 += __shfl_xor(s1, 1); s1 += __shfl_xor(s1, 2); s1 += __shfl_xor(s1, 4);
            const float m = s1 * (1.f / 64.f);
            float s2 = 0.f;
#pragma unroll
            for (int e = 0; e < 8; ++e) { y[e] -= m; s2 += y[e] * y[e]; }
            s2 += __shfl_xor(s2, 1); s2 += __shfl_xor(s2, 2); s2 += __shfl_xor(s2, 4);
            const float rs = __builtin_amdgcn_rsqf(s2 * (1.f / 64.f) + RWKV_EPS);
            float o[8];
#pragma unroll
            for (int e = 0; e < 8; ++e) { const float vv = pv[e] + muv[e] * ((okv ? sv[e] : 0.f) - pv[e]); o[e] = (y[e] * rs * lnw[e] + lnb[e] + bs * vv) * gg[e]; }
            u32x4 ow; ow.x = cvtpk(o[0], o[1]); ow.y = cvtpk(o[2], o[3]); ow.z = cvtpk(o[4], o[5]); ow.w = cvtpk(o[6], o[7]);
            *(u32x4*)(ymix + (size_t)row * D + c8) = ow;
            float of[8], ob[8], z[8];
            unpack8(wof, of); unpack8(wob, ob); unpack8(wz, z);
            float s3 = 0.f;
#pragma unroll
            for (int e = 0; e < 8; ++e) { of[e] += ob[e]; s3 += of[e] * of[e]; }
            s3 += __shfl_xor(s3, 1); s3 += __shfl_xor(s3, 2); s3 += __shfl_xor(s3, 4); s3 += __shfl_xor(s3, 8);
            const float rg = __builtin_amdgcn_rsqf(s3 * (1.f / 128.f) + NORM_EPS);
#pragma unroll
            for (int e = 0; e < 8; ++e) o[e] = of[e] * rg * ong[e] * siluf_(z[e]);
            ow.x = cvtpk(o[0], o[1]); ow.y = cvtpk(o[2], o[3]); ow.z = cvtpk(o[4], o[5]); ow.w = cvtpk(o[6], o[7]);
            *(u32x4*)(ymix + (size_t)row * D + 512 + c8) = ow;
        }
    }
}

__device__ __forceinline__ void convert_experts(const Args& A, Ctx& C) {
    lfloat* scr = (lfloat*)(C.lds + C.wave * 16384);
    const int gw = C.bid * 8 + C.wave, NGW = C.G * 8;
    constexpr int I13 = (D / 64) * (DE / 32);
    constexpr int I2 = (DE / 64) * (D / 32);
    constexpr int PER = 2 * I13 + I2;
    for (int it = gw; it < 257 * PER; it += NGW) {
        const int e = it / PER; int r = it % PER;
        unsigned char* bt13 = A.ws + WS_WEXP + (size_t)e * WEXP_STRIDE; unsigned char* bt2 = bt13 + 512 * 1024;
        const float* w1 = e < NE ? A.in[I_EW1] + (size_t)e * D * DE : A.in[I_SW1];
        const float* w3 = e < NE ? A.in[I_EW3] + (size_t)e * D * DE : A.in[I_SW3];
        const float* w2 = e < NE ? A.in[I_EW2] + (size_t)e * DE * D : A.in[I_SW2];
        if (r < I13) { transpose_item_fp8(w1, D, DE, bt13, RowGLU{0}, SW13, scr, r, C.lane); continue; } r -= I13;
        if (r < I13) { transpose_item_fp8(w3, D, DE, bt13, RowGLU{128}, SW13, scr, r, C.lane); continue; } r -= I13;
        transpose_item_fp8(w2, DE, D, bt2, RowId(), SW2, scr, r, C.lane);
    }
}

__device__ __forceinline__ void phase_p6(const Args& A, Ctx& C) {
    const float* mod = WSP(float, WS_MOD); bf16_t* h2n = WSP(bf16_t, WS_H2N);
    const int gw = C.bid * 8 + C.wave, NGW = C.G * 8;
    for (int row = gw; row < NLAT; row += NGW) {
        const float* m = mod + (size_t)(row >> 11) * MODW;
        norm_mod_row(A.out + (size_t)row * D, A.in[I_N2G], m + 4 * D, m + 3 * D, h2n + (size_t)row * D, C.lane, (unsigned*)(A.ws + WS_H2N8) + (size_t)row * (D / 4));
    }
}

__device__ __forceinline__ void phase_p8(const Args& A, Ctx& C) {
    const float* logit = WSP(float, WS_LOGIT);
    int* tope = WSP(int, WS_TOPE); float* topw = WSP(float, WS_TOPW); int* pos = WSP(int, WS_POS);
    unsigned* cnt = WSP(unsigned, WS_CTL) + CW_CNT;
    const int gw = C.bid * 8 + C.wave, NGW = C.G * 8, lane = C.lane;
    const f32x4 rb = ((const f32x4*)A.in[I_RB])[lane];
    for (int tok = gw; tok < NLAT; tok += NGW) {
        const f32x4 lg = ((const f32x4*)(logit + (size_t)tok * NE))[lane];
        float s[4], sel[4];
#pragma unroll
        for (int i = 0; i < 4; ++i) { s[i] = sigmoidf_(lg[i]); sel[i] = s[i] + rb[i]; }
        float m1 = fmaxf(fmaxf(sel[0], sel[1]), fmaxf(sel[2], sel[3]));
        float m2;
        {
            float a = fmaxf(sel[0], sel[1]), bq = fminf(sel[0], sel[1]), cq = fmaxf(sel[2], sel[3]), dq = fminf(sel[2], sel[3]);
            m2 = fmaxf(fminf(a, cq), fmaxf(bq, dq)); }
#pragma unroll
        for (int o = 1; o < 8; o <<= 1) { const float o1 = __shfl_xor(m1, o), o2 = __shfl_xor(m2, o);
            const float n1 = fmaxf(m1, o1); const float n2 = fmaxf(fminf(m1, o1), fmaxf(m2, o2)); m1 = n1; m2 = n2; }
        const float gs = m1 + m2;
        const int grp = lane >> 3;
        int rank = 0;
#pragma unroll
        for (int gq = 0; gq < 8; ++gq) { const float og = __shfl(gs, gq * 8); rank += (og > gs || (og == gs && gq < grp)) ? 1 : 0; }
        const bool gsel = rank < 4;
        float cand[4];
#pragma unroll
        for (int i = 0; i < 4; ++i) cand[i] = gsel ? sel[i] : -INFINITY;
        int my_e = 0; float my_w = 0.f; float wsum = 0.f;
#pragma unroll
        for (int r = 0; r < 8; ++r) {
            float bv = cand[0]; int bi = 0;
#pragma unroll
            for (int i = 1; i < 4; ++i) if (cand[i] > bv) { bv = cand[i]; bi = i; }
            int be = lane * 4 + bi;
#define P8_STEP(CTRL) { const float ov = dpp_f<CTRL>(bv); const int oe = __builtin_amdgcn_update_dpp(0, be, CTRL, 0xf, 0xf, false); if (ov > bv || (ov == bv && oe < be)) { bv = ov; be = oe; } }
            P8_STEP(0x128) P8_STEP(0x124) P8_STEP(0x122) P8_STEP(0x121)
#undef P8_STEP
            float gv = rdlane(bv, 0); int ge = __builtin_amdgcn_readlane(be, 0);
#pragma unroll
            for (int rr = 1; rr < 4; ++rr) { const float ov = rdlane(bv, 16 * rr); const int oe = __builtin_amdgcn_readlane(be, 16 * rr); if (ov > gv || (ov == gv && oe < ge)) { gv = ov; ge = oe; } }
            be = ge;
            const int ol = be >> 2, oi = be & 3;
            const float mys = oi == 0 ? s[0] : (oi == 1 ? s[1] : (oi == 2 ? s[2] : s[3]));
            const float ws_ = __shfl(mys, ol);
            if (lane == ol) { if (oi == 0) cand[0] = -INFINITY; else if (oi == 1) cand[1] = -INFINITY; else if (oi == 2) cand[2] = -INFINITY; else cand[3] = -INFINITY; }
            wsum += ws_;
            if (lane == r) { my_e = be; my_w = ws_; }
        }
        if (lane < 8) {
            const float w = my_w / wsum * 2.5f;
            const unsigned p = atomicAdd(cnt + my_e, 1u);
            tope[(size_t)tok * 8 + lane] = my_e; topw[(size_t)tok * 8 + lane] = w; pos[(size_t)tok * 8 + lane] = (int)p;
        }
    }
}

__device__ __forceinline__ void tile_prefix(const Args& A, Ctx& C, LAS int* tb) {
    const unsigned* cnt = WSP(unsigned, WS_CTL) + CW_CNT;
    if (C.tid == 0) { int acc = 0; for (int e = 0; e < NE; ++e) { tb[e] = acc; acc += ((int)cnt[e] + 255) >> 8; } tb[NE] = acc; }
    __syncthreads();
}
__device__ __forceinline__ void phase_p9(const Args& A, Ctx& C) {
    LAS int* tb = (LAS int*)C.lds;
    tile_prefix(A, C, tb);
    const unsigned* cnt = WSP(unsigned, WS_CTL) + CW_CNT;
    const int* tope = WSP(int, WS_TOPE); const float* topw = WSP(float, WS_TOPW); const int* pos = WSP(int, WS_POS);
    int* rowl = WSP(int, WS_ROWL); float* roww = WSP(float, WS_ROWW); int* tile_e = WSP(int, WS_TILEE);
    const int nrt = tb[NE];
    for (int i = C.bid * 512 + C.tid; i < NLAT * 8; i += C.G * 512) { const int e = tope[i]; const int pr = tb[e] * 256 + pos[i]; rowl[pr] = i; roww[pr] = topw[i]; }
    for (int e = C.bid; e < NE; e += C.G) { const int n = (int)cnt[e], nt = tb[e + 1] - tb[e];
        for (int j = n + C.tid; j < nt * 256; j += 512) { rowl[tb[e] * 256 + j] = -1; roww[tb[e] * 256 + j] = 0.f; }
        for (int k = C.tid; k < nt; k += 512) tile_e[tb[e] + k] = e; }
    for (int i = C.bid * 512 + C.tid; i < NLAT; i += C.G * 512) { rowl[nrt * 256 + i] = i; roww[nrt * 256 + i] = 1.f; }
    for (int k = C.bid * 512 + C.tid; k < NLAT / 256; k += C.G * 512) tile_e[nrt + k] = NE;
    __syncthreads();
}

__device__ __forceinline__ void phase_moe(const Args& A, Ctx& C, int dry_shared) {
    LAS int* tb = (LAS int*)(C.lds + 131072);
    LAS int* tbl = tb + 320;
    tile_prefix(A, C, tb);
    pg8::MoeCtx M;
    M.nrt = tb[NE]; M.ntiles = M.nrt + NLAT / 256; M.G = C.G; M.vc = (C.G % 8 == 0) ? (C.bid % 8) * (C.G / 8) + C.bid / 8 : C.bid;
    M.tb = tb; M.tbl = tbl; M.cnt = WSP(unsigned, WS_CTL) + CW_CNT; M.rowl = WSP(int, WS_ROWL); M.roww = WSP(float, WS_ROWW);
    M.wexp = (const char*)(A.ws + WS_WEXP); M.h2n = (const char*)(A.ws + WS_H2N8); M.Hs = (char*)(A.ws + WS_HS) + (size_t)C.bid * 2 * 65536;
    M.Y = (unsigned char*)(A.ws + WS_Y); M.out = A.out; M.mod = WSP(const float, WS_MOD); M.dry_shared = dry_shared;
    pg8::gemm_moe(C.lds, M);
    __syncthreads();
}

__device__ __forceinline__ void phase_final(const Args& A, Ctx& C, float* dst) {
    const int gw = C.bid * 8 + C.wave, NGW = C.G * 8;
    const float* fg = A.in[I_FG]; const float* mod = WSP(const float, WS_MOD);
    const unsigned* Y = (const unsigned*)(A.ws + WS_Y);
    for (int row = gw; row < NLAT; row += NGW) {
        f32x4* xr = (f32x4*)(A.out + (size_t)row * D) + C.lane;
        const f32x4* gt = (const f32x4*)(mod + (size_t)(row >> 11) * MODW + 5 * D) + C.lane;
        const unsigned* yr = Y + (size_t)row * 8 * (D / 4) + C.lane;
        f32x4 v[4]; float s = 0.f;
#pragma unroll
        for (int j = 0; j < 4; ++j) {
            f32x4 a = (f32x4){0.f, 0.f, 0.f, 0.f};
#pragma unroll
            for (int sl = 0; sl < 8; ++sl) { const unsigned w = yr[sl * (D / 4) + 64 * j];
                const f32x2 lo = __builtin_amdgcn_cvt_pk_f32_fp8(w, false), hi = __builtin_amdgcn_cvt_pk_f32_fp8(w, true);
                a.x += lo.x; a.y += lo.y; a.z += hi.x; a.w += hi.y; }
            v[j] = xr[64 * j] + gt[64 * j] * a * (1.f / pg8::YSCALE);
            s += (v[j].x * v[j].x + v[j].y * v[j].y) + (v[j].z * v[j].z + v[j].w * v[j].w); }
        const float rstd = __builtin_amdgcn_rsqf(wave_sum(s) * (1.f / D) + NORM_EPS);
        f32x4* orow = (f32x4*)(dst + (size_t)row * D) + C.lane;
#pragma unroll
        for (int j = 0; j < 4; ++j) orow[64 * j] = v[j] * rstd * ((const f32x4*)fg)[C.lane + 64 * j];
    }
}

constexpr int NPHASE = 13;
__global__ void __launch_bounds__(512, 2) fwd_kernel(Args A) {
    extern __shared__ __attribute__((aligned(16))) unsigned char lds_raw[];
    Ctx C; C.lds = (lbyte*)lds_raw; C.tid = threadIdx.x; C.lane = C.tid & 63; C.wave = __builtin_amdgcn_readfirstlane(C.tid >> 6);
    C.G = gridDim.x; C.bid = blockIdx.x; C.a = &A;
    volatile LAS unsigned* misc = (volatile LAS unsigned*)(C.lds + LDS_MISC);
    if (C.tid < 16) misc[C.tid] = 0u;
    __syncthreads();
    XcdBarrier bar; bar.bar = WSP(unsigned, WS_CTL) + CW_BAR; bar.x = 0; bar.st = nullptr;
    const int lo = A.ph_lo, hi = A.ph_hi;
    const bool multi = (hi - lo) > 1;
    if (multi) bar = xcd_barrier_post(WSP(unsigned, WS_CTL) + CW_BAR, misc);
#ifndef PHASE_MASK
#define PHASE_MASK 0x1FFF
#endif
#define IN(k) (((PHASE_MASK >> (k)) & 1) && lo <= (k) && (k) < hi)
#define SEAM(k) do { if (IN(k) && IN((k) + 1)) xcd_barrier(bar); } while (0)
#ifndef REP_MASK
#define REP_MASK 0
#endif
#define REPS(k) (((REP_MASK >> (k)) & 1) ? 2 : 1)

    if (IN(0)) _Pragma("unroll") for (int rep = 0; rep < REPS(0); ++rep) { phase_p0(A, C); __syncthreads(); } SEAM(0);
    if (IN(1)) _Pragma("unroll") for (int rep = 0; rep < REPS(1); ++rep) { phase_p1(A, C); } SEAM(1);
    if (IN(2)) _Pragma("unroll") for (int rep = 0; rep < REPS(2); ++rep) {
        pg8::Gemm g{WSP(bf16_t, WS_XN), D}; pg8::StaticOrder S; S.init(NROWS, PLD, C.G, C.bid, WSP(bf16_t, WS_BTIN), D);
        pg8::EpiBf16 E{WSP(bf16_t, WS_P), PLD};
        pg8::gemm_phase<pg8::EpiBf16, pg8::StaticOrder, false, 0, false>(C.lds, g, S, E);
    } SEAM(2);
    if (IN(3)) _Pragma("unroll") for (int rep = 0; rep < REPS(3); ++rep) { phase_gdn_prep(A, C); } SEAM(3);
#ifdef PROBE_BARRIERS
    if (multi) for (int kq = 0; kq < PROBE_BARRIERS; ++kq) xcd_barrier(bar);
#endif
    if (IN(4)) {
        for (int ch = C.bid; ch < NB * HB * 2; ch += C.G) gdn_chain_chunked(A, C, ch);
        for (int pr = C.bid; pr < NB * HA; pr += C.G) rwkv_pair_chunked(A, C, pr);
    } SEAM(4);
    if (IN(5)) _Pragma("unroll") for (int rep = 0; rep < REPS(5); ++rep) { phase_p4(A, C); } SEAM(5);
    if (IN(6)) _Pragma("unroll") for (int rep = 0; rep < REPS(6); ++rep) {
        pg8::Gemm g{WSP(bf16_t, WS_YMIX), D}; pg8::StaticOrder S; S.init(NLAT, D, C.G, C.bid, WSP(bf16_t, WS_BTOUT), D);
        pg8::EpiResGate E{A.in[I_X], A.out, WSP(float, WS_MOD), 2 * D};
        pg8::gemm_phase<pg8::EpiResGate, pg8::StaticOrder, false>(C.lds, g, S, E);
    } SEAM(6);
    if (IN(7)) _Pragma("unroll") for (int rep = 0; rep < REPS(7); ++rep) { phase_p6(A, C); __syncthreads(); convert_experts(A, C); __syncthreads(); } SEAM(7);
    if (IN(8)) _Pragma("unroll") for (int rep = 0; rep < REPS(8); ++rep) {
        pg8::Gemm g{WSP(bf16_t, WS_H2N), D}; pg8::StaticOrder S; S.init(NLAT, NE, C.G, C.bid, WSP(bf16_t, WS_BTR), D);
        pg8::EpiF32 E{WSP(float, WS_LOGIT), NE};
        pg8::gemm_phase<pg8::EpiF32, pg8::StaticOrder, false>(C.lds, g, S, E);
    } SEAM(8);
    if (IN(9)) { phase_p8(A, C); } SEAM(9);
    if (IN(10)) _Pragma("unroll") for (int rep = 0; rep < REPS(10); ++rep) { phase_p9(A, C); } SEAM(10);
    if (IN(11)) { phase_moe(A, C, 0); if (REPS(11) > 1) { __syncthreads(); phase_moe(A, C, 1); } } SEAM(11);
    if (IN(12)) { if (REPS(12) > 1) { phase_final(A, C, (float*)(A.ws + WS_WEXP)); __syncthreads(); } phase_final(A, C, A.out); }
#undef IN
#undef SEAM
}

extern "C" void kernel_launch(void* const* d_in, const int* in_sizes, int n_in, void* d_out, int out_size, void* d_ws, size_t ws_size, hipStream_t stream) {
    static int grid = 0;
    if (grid == 0) {
        if (n_in != 34 || out_size != NLAT * D || ws_size < WS_END) { fprintf(stderr, "kernel_launch: unexpected shapes (n_in %d out %d ws %zu need %zu)\n", n_in, out_size, ws_size, (size_t)WS_END); grid = -1; return; }
        int dev = 0, cus = 0;
        if (hipGetDevice(&dev) != hipSuccess || hipDeviceGetAttribute(&cus, hipDeviceAttributeMultiprocessorCount, dev) != hipSuccess) { grid = -1; return; }
        if (hipFuncSetAttribute((const void*)fwd_kernel, hipFuncAttributeMaxDynamicSharedMemorySize, LDS_BYTES) != hipSuccess) { fprintf(stderr, "kernel_launch: hipFuncSetAttribute failed\n"); grid = -1; return; }
        int per_cu = 0;
        if (hipOccupancyMaxActiveBlocksPerMultiprocessor(&per_cu, (const void*)fwd_kernel, 512, LDS_BYTES) != hipSuccess || per_cu < 1) { fprintf(stderr, "kernel_launch: occupancy query says %d\n", per_cu); }
        (void)hipGetLastError();
        grid = cus;
    }
    if (grid < 0) return;
    (void)hipMemsetAsync((char*)d_ws + WS_CTL, 0, CTL_BYTES, stream);
    Args a{};
    for (int i = 0; i < 34; ++i) a.in[i] = (const float*)d_in[i];
    a.out = (float*)d_out; a.ws = (unsigned char*)d_ws;
#if MK_PER_PHASE
    for (int p = 0; p < NPHASE; ++p) { a.ph_lo = p; a.ph_hi = p + 1; hipLaunchKernelGGL(fwd_kernel, dim3(grid), dim3(512), LDS_BYTES, stream, a); }
#else
    a.ph_lo = 0; a.ph_hi = NPHASE; hipLaunchKernelGGL(fwd_kernel, dim3(grid), dim3(512), LDS_BYTES, stream, a);
#endif
}
```

```cpp
#include <hip/hip_runtime.h>
#include <cstdio>
#include <cstdint>

#ifndef MK_PER_PHASE
#define MK_PER_PHASE 0
#endif

#define LAS __attribute__((address_space(3)))
typedef unsigned short bf16_t;
typedef short bf16x8 __attribute__((ext_vector_type(8)));
typedef float f32x4 __attribute__((ext_vector_type(4)));
typedef float f32x2 __attribute__((ext_vector_type(2)));
typedef unsigned u32x4 __attribute__((ext_vector_type(4)));
typedef unsigned u32x2 __attribute__((ext_vector_type(2)));
typedef int i32x4 __attribute__((ext_vector_type(4)));
typedef int i32x8 __attribute__((ext_vector_type(8)));
typedef LAS float lfloat;
typedef LAS unsigned char lbyte;

constexpr int D = 1024, NB = 32, SEQ = 2048, CTX = 256, GW = 64;
constexpr int NLAT = NB * SEQ;
constexpr int NCTX = NB * CTX;
constexpr int NROWS = NLAT + NCTX;
constexpr int DA = 512, HA = 8, NA = 64;
constexpr int RW_COLS = 1920, GD_COLS = 2064, IN_COLS = 3984, PLD = 4096;
constexpr int DB = 512, HB = 4, KB = 128;
constexpr int NE = 256, TOPK = 8, DE = 256;
constexpr int MODW = 6 * D;
constexpr float NORM_EPS = 1e-6f, RWKV_EPS = 64e-5f;
constexpr int MAXTILES = (NLAT * TOPK + NE * 255) / 256 + 1;

constexpr size_t MiB = 1u << 20;
constexpr size_t WS_CTL = 0, CTL_BYTES = 1 * MiB;
constexpr size_t WS_MOD = 1 * MiB;
constexpr size_t WS_BTIN = 2 * MiB, WS_BTOUT = 10 * MiB, WS_BTR = 12 * MiB, WS_BON = 13 * MiB, WS_GUPT = 17 * MiB, WS_NRM = 978 * MiB;
constexpr size_t WS_P = 18 * MiB, WS_XN = 594 * MiB, WS_YDIR = 594 * MiB, WS_YMIX = 850 * MiB;
constexpr size_t WS_H2N8 = 900 * MiB;
constexpr size_t WS_H2N = 18 * MiB, WS_LOGIT = 146 * MiB, WS_TOPE = 210 * MiB, WS_TOPW = 212 * MiB, WS_POS = 214 * MiB, WS_Y = 146 * MiB;
constexpr size_t WS_ROWL = 658 * MiB, WS_ROWW = 661 * MiB, WS_TILEE = 664 * MiB, WS_HS = 672 * MiB, WS_WEXP = 704 * MiB;
constexpr size_t WEXP_STRIDE = (size_t)(512 * 1024 + 1024 * 256);
constexpr float SW13 = 64.f, SW2 = 32.f, SHS = 8.f, SWIN = 32.f;
constexpr size_t WS_END = 1090 * MiB;
static_assert(WS_WEXP + 257 * WEXP_STRIDE <= WS_END && WS_Y + (size_t)NLAT * 8 * D <= WS_ROWL, "ws map");
constexpr int CW_BAR = 4096;
constexpr int CW_CNT = 16384;

constexpr int LDS_BYTES = 159744;
constexpr int LDS_MISC = LDS_BYTES - 64;

__device__ __forceinline__ unsigned f2bf(float f) { unsigned u = __builtin_bit_cast(unsigned, f); return (u + 0x7fffu + ((u >> 16) & 1u)) >> 16; }
typedef __bf16 bf16x2_t __attribute__((ext_vector_type(2)));
__device__ __forceinline__ unsigned cvtpk(float lo, float hi) { f32x2 v = {lo, hi}; return __builtin_bit_cast(unsigned, __builtin_convertvector(v, bf16x2_t)); }
__device__ __forceinline__ unsigned pk2(float lo, float hi) { return cvtpk(lo, hi); }
__device__ __forceinline__ unsigned pk4_fp8(float a, float b, float c, float d) { unsigned w = 0u;
    w = __builtin_amdgcn_cvt_pk_fp8_f32(__builtin_amdgcn_fmed3f(a, -448.f, 448.f), __builtin_amdgcn_fmed3f(b, -448.f, 448.f), w, false);
    w = __builtin_amdgcn_cvt_pk_fp8_f32(__builtin_amdgcn_fmed3f(c, -448.f, 448.f), __builtin_amdgcn_fmed3f(d, -448.f, 448.f), w, true); return w; }
__device__ __forceinline__ float bf2f(unsigned short b) { return __builtin_bit_cast(float, ((unsigned)b) << 16); }
__device__ __forceinline__ float bflo(unsigned w) { return __builtin_bit_cast(float, w << 16); }
__device__ __forceinline__ float bfhi(unsigned w) { return __builtin_bit_cast(float, w & 0xffff0000u); }
template <int CTRL> __device__ __forceinline__ float dpp_f(float v) { return __builtin_bit_cast(float, __builtin_amdgcn_update_dpp(0, __builtin_bit_cast(int, v), CTRL, 0xf, 0xf, false)); }
__device__ __forceinline__ float wave_sum(float v) {
    v += dpp_f<0x128>(v);
    v += dpp_f<0x124>(v);
    v += dpp_f<0x122>(v);
    v += dpp_f<0x121>(v);
    const int vi = __builtin_bit_cast(int, v);
    const float r0 = __builtin_bit_cast(float, __builtin_amdgcn_readlane(vi, 0)), r1 = __builtin_bit_cast(float, __builtin_amdgcn_readlane(vi, 16)),
                r2 = __builtin_bit_cast(float, __builtin_amdgcn_readlane(vi, 32)), r3 = __builtin_bit_cast(float, __builtin_amdgcn_readlane(vi, 48));
    return (r0 + r1) + (r2 + r3);
}
__device__ __forceinline__ float sigmoidf_(float x) { return __builtin_amdgcn_rcpf(1.f + __expf(-x)); }
__device__ __forceinline__ float siluf_(float x) { return x * __builtin_amdgcn_rcpf(1.f + __expf(-x)); }
__device__ __forceinline__ float softplusf_(float x) { return fmaxf(x, 0.f) + __logf(1.f + __expf(-fabsf(x))); }
__device__ __forceinline__ float tanhf_(float x) { const float e = __expf(-2.f * fabsf(x)); const float t = (1.f - e) * __builtin_amdgcn_rcpf(1.f + e); return x < 0.f ? -t : t; }

#define XB_TMO      128
#define XB_XCNT(j)  (256  + 64 * (j))
#define XB_XSUB(j)  (1280 + 64 * (j))
#define XB_XGEN(j)  (2304 + 64 * (j))
#define XB_TOP      3328
#define XB_TOPGEN   3392
#define XCD_BAR_WORDS 3456
#define XB_SPIN_CAP (1u << 22)
__device__ __forceinline__ unsigned xb_ld(unsigned* p)              { return __hip_atomic_load(p, __ATOMIC_RELAXED, __HIP_MEMORY_SCOPE_AGENT); }
__device__ __forceinline__ unsigned xb_add(unsigned* p, unsigned v) { return __hip_atomic_fetch_add(p, v, __ATOMIC_RELAXED, __HIP_MEMORY_SCOPE_AGENT); }
__device__ __forceinline__ unsigned xb_xcc_id() { return (unsigned)__builtin_amdgcn_s_getreg((3 << 11) | 20) & 0xFu; }
#define XB_SPIN(cond, bar) do { unsigned _sp = 0; while (cond) { __builtin_amdgcn_s_sleep(1); \
    if ((++_sp & 255u) == 0u) { if (xb_ld(&(bar)[XB_TMO])) break; if (_sp > XB_SPIN_CAP) { atomicAdd(&(bar)[XB_TMO], 1u); break; } } } } while (0)
struct XcdBarrier { unsigned* bar; unsigned x; volatile LAS unsigned* st; };
__device__ __forceinline__ XcdBarrier xcd_barrier_post(unsigned* bar, volatile LAS unsigned* st) {
    XcdBarrier b; b.bar = bar; b.x = xb_xcc_id(); b.st = st;
    if (threadIdx.x == 0) (void)xb_add(&bar[XB_XCNT(b.x)], 1u);
    return b;
}
__device__ __forceinline__ void xcd_barrier_complete(unsigned* bar, unsigned x, unsigned& nloc, unsigned& nx) {
    const unsigned G = gridDim.x * gridDim.y * gridDim.z;
    unsigned sum, cnt, mine, sp = 0u;
    for (;;) {
        sum = 0u; cnt = 0u; mine = 0u;
#pragma unroll
        for (unsigned j = 0; j < 16; ++j) { const unsigned c = xb_ld(&bar[XB_XCNT(j)]); sum += c; cnt += (c > 0u) ? 1u : 0u; mine = (j == x) ? c : mine; }
        if (sum == G) break;
        __builtin_amdgcn_s_sleep(1);
        if ((++sp & 255u) == 0u) { if (xb_ld(&bar[XB_TMO])) break; if (sp > XB_SPIN_CAP) { atomicAdd(&bar[XB_TMO], 1u); break; } }
    }
    nloc = mine > 0u ? mine : 1u; nx = cnt > 0u ? cnt : 1u;
}
__device__ __forceinline__ void xcd_barrier(const XcdBarrier& b) {
    asm volatile("s_waitcnt vmcnt(0)" ::: "memory");
    __syncthreads();
    if (threadIdx.x == 0) {
        unsigned* bar = b.bar;
        __builtin_amdgcn_s_waitcnt(0);
        unsigned nloc = b.st[0], nx = b.st[1];
        if (nloc == 0u) { xcd_barrier_complete(bar, b.x, nloc, nx); b.st[0] = nloc; b.st[1] = nx; }
        const unsigned old = xb_add(&bar[XB_XSUB(b.x)], 1u);
        const unsigned gen = old / nloc;
        if (old + 1u == (gen + 1u) * nloc) {
            __builtin_amdgcn_fence(__ATOMIC_RELEASE, "agent");
            asm volatile("s_waitcnt vmcnt(0)" ::: "memory");
            const unsigned og = xb_add(&bar[XB_TOP], 1u);
            const unsigned tg = og / nx;
            if (og + 1u == (tg + 1u) * nx) xb_add(&bar[XB_TOPGEN], 1u);
            else XB_SPIN(xb_ld(&bar[XB_TOPGEN]) == tg, bar);
            __builtin_amdgcn_fence(__ATOMIC_ACQUIRE, "agent");
            xb_add(&bar[XB_XGEN(b.x)], 1u);
            asm volatile("s_waitcnt vmcnt(0)" ::: "memory");
        } else {
            XB_SPIN(xb_ld(&bar[XB_XGEN(b.x)]) == gen, bar);
            __builtin_amdgcn_fence(__ATOMIC_ACQUIRE, "agent");
            asm volatile("s_waitcnt vmcnt(0)" ::: "memory");
        }
    }
    __syncthreads();
}

struct Args {
    const float* in[34];
    float* out;
    unsigned char* ws;
    int ph_lo, ph_hi;
};
enum { I_X = 0, I_C, I_CTX, I_CCTX, I_WADA, I_BADA, I_N1G, I_WIN, I_MU, I_W0, I_WUP, I_A0, I_AUP, I_GUP, I_KK, I_KA, I_RK, I_LNW, I_LNB,
       I_CONVW, I_ALOG, I_DTB, I_ONG, I_WOUT, I_N2G, I_RW, I_RB, I_EW1, I_EW3, I_EW2, I_SW1, I_SW3, I_SW2, I_FG };

namespace pg8 {
constexpr int BM = 256, BK = 64, HALF = 128, HTB = HALF * BK * 2, STAGE_BYTES = 8 * HTB, NXCD = 8, WGM = 8;
__host__ __device__ __forceinline__ int lds_byte(int r, int c) { const int st = (r >> 4) * 2 + (c >> 5), rr = r & 15, cc = c & 31, ob = rr * 64 + cc * 2; return st * 1024 + (ob ^ (((ob >> 9) & 1) << 5)); }
__host__ __device__ __forceinline__ void stage_rc(int b, int& R, int& C) { const int st = b / 1024, sb = b % 1024, swz = sb ^ (((sb >> 9) & 1) << 5); R = (st >> 1) * 16 + swz / 64; C = (st & 1) * 32 + (swz % 64) / 2; }
__host__ __device__ __forceinline__ int perm32(int rho) { const int n = rho >> 4, i = rho & 15; return 8 * (i >> 2) + 4 * n + (i & 3); }
struct Unit { int pm, pn; };
struct Gemm { const bf16_t* A; int K; };
struct StaticOrder {
    int nM, nN, nwg, G, c; const char* Bt; size_t tstepB;
    __device__ void init(int M, int N, int G_, int c_, const void* Bt_, int K, int es = 2) { nM = M / BM; nN = N / BM; nwg = nM * nN; G = G_; c = c_; Bt = (const char*)Bt_; tstepB = (size_t)BM * K * es; }
    __device__ bool next(int i, Unit& u) const {
        const long L = (long)i * G + c; if (L >= nwg) return false;
        int wgid = (int)L; { const int q = nwg / NXCD, r = nwg % NXCD, xcd = wgid % NXCD, off = wgid / NXCD; wgid = (xcd < r ? xcd * (q + 1) : r * (q + 1) + (xcd - r) * q) + off; }
        const int nig = WGM * nN, gid = wgid / nig, fm = gid * WGM, gsz = (nM - fm) < WGM ? (nM - fm) : WGM;
        u.pm = fm + ((wgid % nig) % gsz); u.pn = (wgid % nig) / gsz; return true;
    }
    __device__ __forceinline__ const char* bptr(const Unit& u) const { return Bt + (size_t)u.pn * tstepB; }
    __device__ __forceinline__ int rowsel(const Unit&, int) const { return 0; }
};
struct TileOrder {
    int nunits, npn, G, c; const int* tile_e; const char* wbase; size_t wstride, woff, tstepB; const int* rowl;
    __device__ bool next(int i, Unit& u) const { const int L = i * G + c; if (L >= nunits) return false; u.pm = L / npn; u.pn = L - u.pm * npn; return true; }
    __device__ __forceinline__ const char* bptr(const Unit& u) const { const int e = __builtin_amdgcn_readfirstlane(tile_e[u.pm]); return wbase + (size_t)e * wstride + woff + (size_t)u.pn * tstepB; }
    __device__ __forceinline__ int rowsel(const Unit& u, int r) const { const int t = rowl[(size_t)u.pm * 256 + r]; return t < 0 ? 0 : t; }
};
struct SeqOrder {
    int n; const char* Bt; size_t tstepB; const LAS int* rsel;
    __device__ bool next(int i, Unit& u) const { if (i >= n) return false; u.pm = 0; u.pn = i; return true; }
    __device__ __forceinline__ const char* bptr(const Unit& u) const { return Bt + (size_t)u.pn * tstepB; }
    __device__ __forceinline__ int rowsel(const Unit&, int r) const { return rsel[r]; }
};
__device__ __forceinline__ unsigned cvt_pk_bf16(float lo, float hi) { return cvtpk(lo, hi); }

template <class Epi, class Sched, bool GATHER, int A_AUX = 0, bool ALIGN = true, bool FP8 = false>
__device__ __forceinline__ void gemm_phase(lbyte* lds, const Gemm g, const Sched& S, const Epi& E) {
    int tid_ = threadIdx.x; asm volatile("" : "+v"(tid_));
    const int tid = tid_, wid = __builtin_amdgcn_readfirstlane(tid >> 6), lane = tid & 63, wr = wid >> 2, wc = wid & 3, fr = lane & 15, fq = lane >> 4;
    constexpr unsigned ES = FP8 ? 1u : 2u;
    const int K = g.K, nt = FP8 ? K / 128 : K / BK;
    Unit cur, nxt; int ui = 0;
    if (!S.next(0, cur)) return;
    int Rst[2], Cst[2];
    unsigned voffA[2], voffA1[2], voffB[2], nvA[2], nvA1[2];
#pragma unroll
    for (int i = 0; i < 2; ++i) { int R, C; stage_rc(tid * 16 + i * 8192, R, C); const int Rb = Epi::PERM ? ((R & ~31) + perm32(R & 31)) : R; Rst[i] = R; Cst[i] = C;
        if (GATHER) { voffA[i] = (unsigned)S.rowsel(cur, R) * (unsigned)K * ES + (unsigned)C * 2u; voffA1[i] = (unsigned)S.rowsel(cur, 128 + R) * (unsigned)K * ES + (unsigned)C * 2u; }
        else { voffA[i] = (unsigned)(R * K) * ES + (unsigned)C * 2u; voffA1[i] = voffA[i]; }
        nvA[i] = voffA[i]; nvA1[i] = voffA1[i];
        voffB[i] = (unsigned)(Rb * K) * ES + (unsigned)C * 2u; }
    const size_t kstep = (size_t)(BK * 2);
    const size_t hstep = (size_t)HALF * K * ES;
    const size_t hstepA = GATHER ? 0 : hstep;
    const size_t tstep = 2 * hstep;
    const unsigned ldsw = (unsigned)wid * 1024u;
    const int aoff = lds_byte(wr * 64 + fr, FP8 ? fq * 16 : fq * 8), boff = lds_byte(wc * 32 + fr, FP8 ? fq * 16 : fq * 8);
#define PG8_SA(b, h) (((b) * 2 + (h)) * HTB)
#define PG8_SB(b, h) ((4 + (b) * 2 + (h)) * HTB)
#define PG8_STAGE2(bufoff, gbase, v0, v1) do { \
        __builtin_amdgcn_global_load_lds((const unsigned*)((const char*)(gbase) + (v0)), (LAS unsigned*)(lds + (bufoff) + ldsw), 16, 0, 0); \
        __builtin_amdgcn_global_load_lds((const unsigned*)((const char*)(gbase) + (v1)), (LAS unsigned*)(lds + (bufoff) + ldsw + 8192), 16, 0, 0); } while (0)
#define PG8_STAGE2A(bufoff, gbase, v0, v1) do { if constexpr (A_AUX == 16) { \
        __builtin_amdgcn_global_load_lds((const unsigned*)((const char*)(gbase) + (v0)), (LAS unsigned*)(lds + (bufoff) + ldsw), 16, 0, 16); \
        __builtin_amdgcn_global_load_lds((const unsigned*)((const char*)(gbase) + (v1)), (LAS unsigned*)(lds + (bufoff) + ldsw + 8192), 16, 0, 16); } else { PG8_STAGE2(bufoff, gbase, v0, v1); } } while (0)
#define PG8_STAGE(bufoff, gbase, voff) PG8_STAGE2(bufoff, gbase, (voff)[0], (voff)[1])
#define PG8_STAGEA(bufoff, gbase, voff) PG8_STAGE2A(bufoff, gbase, (voff)[0], (voff)[1])
#define G_LD32(p) __builtin_shufflevector(*(const LAS i32x4*)(p), *(const LAS i32x4*)((p) + 16), 0, 1, 2, 3, 4, 5, 6, 7)
#define G_MFMA8(c, a, b) asm volatile("v_mfma_scale_f32_16x16x128_f8f6f4 %0, %1, %2, %0, %3, %3 op_sel_hi:[0,0,0]" : "+v"(c) : "v"(a), "v"(b), "v"(one_scale))
#define PG8_LDA(dst, b, h) do { if constexpr (FP8) { _Pragma("unroll") for (int m = 0; m < 4; ++m) dst##8[m] = G_LD32(lds + PG8_SA(b, h) + aoff + m * 2048); } else { \
        _Pragma("unroll") for (int m = 0; m < 4; ++m) _Pragma("unroll") for (int k = 0; k < 2; ++k) dst[m][k] = *(const LAS bf16x8*)(lds + PG8_SA(b, h) + aoff + m * 2048 + k * 1024); } } while (0)
#define PG8_LDB(dst, b, h) do { if constexpr (FP8) { _Pragma("unroll") for (int n = 0; n < 2; ++n) dst##8[n] = G_LD32(lds + PG8_SB(b, h) + boff + n * 2048); } else { \
        _Pragma("unroll") for (int n = 0; n < 2; ++n) _Pragma("unroll") for (int k = 0; k < 2; ++k) dst[n][k] = *(const LAS bf16x8*)(lds + PG8_SB(b, h) + boff + n * 2048 + k * 1024); } } while (0)
#define PG8_MMA(ai, bj, At, Bt) do { __builtin_amdgcn_s_setprio(1); if constexpr (FP8) { _Pragma("unroll") for (int m = 0; m < 4; ++m) _Pragma("unroll") for (int n = 0; n < 2; ++n) G_MFMA8(acc[ai][bj][m][n], Bt##8[n], At##8[m]); } else { \
        _Pragma("unroll") for (int m = 0; m < 4; ++m) _Pragma("unroll") for (int n = 0; n < 2; ++n) _Pragma("unroll") for (int k = 0; k < 2; ++k) \
        acc[ai][bj][m][n] = __builtin_amdgcn_mfma_f32_16x16x32_bf16(Bt[n][k], At[m][k], acc[ai][bj][m][n], 0, 0, 0); } __builtin_amdgcn_s_setprio(0); } while (0)
#define PG8_WAIT_V(n) asm volatile("s_waitcnt vmcnt(" #n ")" ::: "memory")
#define PG8_WAIT_L(n) asm volatile("s_waitcnt lgkmcnt(" #n ")" ::: "memory")
#define PG8_BAR __builtin_amdgcn_s_barrier()
#define PG8_SCHED __builtin_amdgcn_sched_barrier(0)
    f32x4 acc[2][2][4][2];
#pragma unroll
    for (int a = 0; a < 2; ++a)
#pragma unroll
        for (int b = 0; b < 2; ++b)
#pragma unroll
            for (int m = 0; m < 4; ++m)
#pragma unroll
                for (int n = 0; n < 2; ++n) acc[a][b][m][n] = (f32x4){0.f, 0.f, 0.f, 0.f};
    bf16x8 At[4][2], B0[2][2], B1[2][2]; i32x8 At8[4], B08[2], B18[2];
    int one_scale = 0x7F7F7F7F; asm volatile("" : "+v"(one_scale));
    const char* cA = (const char*)g.A + (GATHER ? (size_t)0 : (size_t)cur.pm * tstep); const char* cB = S.bptr(cur);
    PG8_STAGE(PG8_SB(0, 0), cB, voffB); PG8_STAGE(PG8_SB(0, 1), cB + hstep, voffB); PG8_STAGEA(PG8_SA(0, 0), cA, voffA); PG8_STAGEA(PG8_SA(0, 1), cA + hstepA, voffA1);
    if (wr == 1) PG8_BAR;
    PG8_WAIT_V(2); PG8_BAR;
    PG8_STAGE(PG8_SB(1, 0), cB + kstep, voffB); PG8_STAGEA(PG8_SA(1, 0), cA + kstep, voffA); PG8_STAGE(PG8_SB(1, 1), cB + hstep + kstep, voffB);
    PG8_WAIT_V(6); PG8_BAR;
    for (;;) {
        const bool has_next = S.next(ui + 1, nxt);
        const char* nA = has_next ? (const char*)g.A + (GATHER ? (size_t)0 : (size_t)nxt.pm * tstep) : cA; const char* nB = has_next ? S.bptr(nxt) : cB;
        for (int t = 0; t < nt; t += 2) {
            const bool last = (t == nt - 2);
            const char* a1 = cA + (size_t)(t + 1) * kstep;
            const char* a2 = last ? nA : cA + (size_t)(t + 2) * kstep; const char* b2 = last ? nB : cB + (size_t)(t + 2) * kstep;
            const char* a3 = a2 + kstep; const char* b3 = b2 + kstep;
            if (GATHER && last && has_next) {
#pragma unroll
                for (int i = 0; i < 2; ++i) { nvA[i] = (unsigned)S.rowsel(nxt, Rst[i]) * (unsigned)K * ES + (unsigned)Cst[i] * 2u; nvA1[i] = (unsigned)S.rowsel(nxt, 128 + Rst[i]) * (unsigned)K * ES + (unsigned)Cst[i] * 2u; }
            }
            const unsigned x0 = (GATHER && last) ? nvA[0] : voffA[0], x1 = (GATHER && last) ? nvA[1] : voffA[1];
            const unsigned y0 = (GATHER && last) ? nvA1[0] : voffA1[0], y1 = (GATHER && last) ? nvA1[1] : voffA1[1];
            PG8_LDB(B0, 0, 0); PG8_LDB(B1, 0, 1); PG8_SCHED; PG8_LDA(At, 0, 0); PG8_STAGEA(PG8_SA(1, 1), a1 + hstepA, voffA1);
            PG8_WAIT_V(8); PG8_WAIT_L(0); PG8_BAR; PG8_MMA(0, 0, At, B0); PG8_MMA(0, 1, At, B1); PG8_BAR; PG8_SCHED;
            PG8_LDA(At, 0, 1); PG8_STAGE(PG8_SB(0, 0), b2, voffB); PG8_STAGE(PG8_SB(0, 1), b2 + hstep, voffB); PG8_STAGE2A(PG8_SA(0, 0), a2, x0, x1);
            PG8_WAIT_V(8); PG8_WAIT_L(0); PG8_BAR; PG8_MMA(1, 0, At, B0); PG8_MMA(1, 1, At, B1); PG8_BAR; PG8_SCHED;
            PG8_LDB(B0, 1, 0); PG8_LDB(B1, 1, 1); PG8_SCHED; PG8_LDA(At, 1, 0); PG8_STAGE2A(PG8_SA(0, 1), a2 + hstepA, y0, y1);
            PG8_WAIT_V(8); PG8_WAIT_L(0); PG8_BAR; PG8_MMA(0, 0, At, B0); PG8_MMA(0, 1, At, B1); PG8_BAR; PG8_SCHED;
            PG8_LDA(At, 1, 1); PG8_STAGE(PG8_SB(1, 0), b3, voffB); PG8_STAGE(PG8_SB(1, 1), b3 + hstep, voffB); PG8_STAGE2A(PG8_SA(1, 0), a3, x0, x1);
            PG8_WAIT_V(8); PG8_WAIT_L(0); PG8_BAR; PG8_MMA(1, 0, At, B0); PG8_MMA(1, 1, At, B1); PG8_BAR; PG8_SCHED;
        }
        if (ALIGN && wr == 0) PG8_BAR;
        if constexpr (FP8) asm volatile("s_nop 15\n\ts_nop 15" ::: "memory");
        E(acc, cur, wr, wc, fr, fq);
        if (!has_next) break;
#pragma unroll
        for (int a = 0; a < 2; ++a)
#pragma unroll
            for (int b = 0; b < 2; ++b)
#pragma unroll
                for (int m = 0; m < 4; ++m)
#pragma unroll
                    for (int n = 0; n < 2; ++n) acc[a][b][m][n] = (f32x4){0.f, 0.f, 0.f, 0.f};
        cur = nxt; cA = nA; cB = nB; ++ui;
        if (GATHER) { voffA[0] = nvA[0]; voffA[1] = nvA[1]; voffA1[0] = nvA1[0]; voffA1[1] = nvA1[1]; }
        if (ALIGN && wr == 1) PG8_BAR;
    }
    PG8_WAIT_V(0);
    if (!ALIGN && wr == 0) PG8_BAR;
    PG8_BAR;
#undef PG8_SA
#undef PG8_SB
#undef PG8_STAGE
#undef PG8_STAGE2
#undef PG8_STAGE2A
#undef PG8_STAGEA
#undef G_LD32
#undef G_MFMA8
#undef PG8_LDA
#undef PG8_LDB
#undef PG8_MMA
#undef PG8_WAIT_V
#undef PG8_WAIT_L
#undef PG8_BAR
#undef PG8_SCHED
}

struct EpiBf16 {
    static constexpr bool PERM = true;
    bf16_t* O; int ldc; float scale;
    __device__ __forceinline__ void operator()(const f32x4 (&acc)[2][2][4][2], const Unit& u, int wr, int wc, int fr, int fq) const {
        const int row0 = u.pm * BM + wr * 64 + fr; const int col0 = u.pn * BM + wc * 32 + 8 * fq;
#pragma unroll
        for (int ai = 0; ai < 2; ++ai)
#pragma unroll
            for (int m = 0; m < 4; ++m) { bf16_t* rowp = O + (size_t)(row0 + ai * HALF + m * 16) * ldc + col0;
#pragma unroll
                for (int bj = 0; bj < 2; ++bj) { const f32x4 v0 = acc[ai][bj][m][0] * scale, v1 = acc[ai][bj][m][1] * scale;
                    u32x4 w; w.x = cvt_pk_bf16(v0[0], v0[1]); w.y = cvt_pk_bf16(v0[2], v0[3]); w.z = cvt_pk_bf16(v1[0], v1[1]); w.w = cvt_pk_bf16(v1[2], v1[3]);
                    *(u32x4*)(rowp + bj * HALF) = w; } }
    }
};
struct EpiF32 {
    static constexpr bool PERM = false;
    float* C; int ldc;
    __device__ __forceinline__ void operator()(const f32x4 (&acc)[2][2][4][2], const Unit& u, int wr, int wc, int fr, int fq) const {
        const int row0 = u.pm * BM + wr * 64 + fr, col0 = u.pn * BM + wc * 32 + 4 * fq;
#pragma unroll
        for (int ai = 0; ai < 2; ++ai)
#pragma unroll
            for (int m = 0; m < 4; ++m) { float* rowp = C + (size_t)(row0 + ai * HALF + m * 16) * ldc + col0;
#pragma unroll
                for (int bj = 0; bj < 2; ++bj)
#pragma unroll
                    for (int n = 0; n < 2; ++n) *(f32x4*)(rowp + bj * HALF + n * 16) = acc[ai][bj][m][n]; }
    }
};
struct EpiResGate {
    static constexpr bool PERM = false;
    const float* x; float* out; const float* mod; int gate_off;
    __device__ __forceinline__ void operator()(const f32x4 (&acc)[2][2][4][2], const Unit& u, int wr, int wc, int fr, int fq) const {
        const int row0 = u.pm * BM + wr * 64 + fr, col0 = u.pn * BM + wc * 32 + 4 * fq;
        const float* gp = mod + (size_t)((u.pm * BM) >> 11) * MODW + gate_off + col0;
        f32x4 gv[2][2];
#pragma unroll
        for (int bj = 0; bj < 2; ++bj)
#pragma unroll
            for (int n = 0; n < 2; ++n) gv[bj][n] = *(const f32x4*)(gp + bj * HALF + n * 16);
#pragma unroll
        for (int ai = 0; ai < 2; ++ai)
#pragma unroll
            for (int m = 0; m < 4; ++m) { const size_t off = (size_t)(row0 + ai * HALF + m * 16) * D + col0;
#pragma unroll
                for (int bj = 0; bj < 2; ++bj)
#pragma unroll
                    for (int n = 0; n < 2; ++n) { const f32x4 xv = *(const f32x4*)(x + off + bj * HALF + n * 16);
                        *(f32x4*)(out + off + bj * HALF + n * 16) = xv + gv[bj][n] * acc[ai][bj][m][n]; }
                asm volatile("" ::: "memory"); }
    }
};
struct EpiGLU {
    static constexpr bool PERM = true;
    bf16_t* H;
    __device__ __forceinline__ void operator()(const f32x4 (&acc)[2][2][4][2], const Unit& u, int wr, int wc, int fr, int fq) const {
        const int row0 = u.pm * BM + wr * 64 + fr; const int col0 = u.pn * 128 + wc * 32 + 8 * fq;
#pragma unroll
        for (int ai = 0; ai < 2; ++ai)
#pragma unroll
            for (int m = 0; m < 4; ++m) { bf16_t* rowp = H + (size_t)(row0 + ai * HALF + m * 16) * 256 + col0;
                f32x4 h0, h1;
#pragma unroll
                for (int j = 0; j < 4; ++j) { const float a0 = acc[ai][0][m][0][j], a1 = acc[ai][0][m][1][j];
                    h0[j] = siluf_(a0) * acc[ai][1][m][0][j]; h1[j] = siluf_(a1) * acc[ai][1][m][1][j]; }
                u32x4 w; w.x = cvt_pk_bf16(h0[0], h0[1]); w.y = cvt_pk_bf16(h0[2], h0[3]); w.z = cvt_pk_bf16(h1[0], h1[1]); w.w = cvt_pk_bf16(h1[2], h1[3]);
                *(u32x4*)rowp = w; }
    }
};
constexpr float YSCALE = 8.f;
struct EpiY {
    static constexpr bool PERM = true;
    unsigned char* Y; float* out; const float* mod; const LAS int* rtok; const LAS float* rw; int shared;
    __device__ __forceinline__ void operator()(const f32x4 (&acc)[2][2][4][2], const Unit& u, int wr, int wc, int fr, int fq) const {
        const int col0 = u.pn * BM + wc * 32 + 8 * fq;
#pragma unroll
        for (int ai = 0; ai < 2; ++ai)
#pragma unroll
            for (int m = 0; m < 4; ++m) { const int r = wr * 64 + fr + ai * HALF + m * 16; const int ts = rtok[r]; const float w = rw[r];
                if (ts >= 0) {
                    if (shared) { const unsigned goff = (unsigned)(ts >> 11) * MODW + 5 * D + col0; const unsigned ooff = (unsigned)ts * D + col0;
#pragma unroll
                        for (int bj = 0; bj < 2; ++bj)
#pragma unroll
                            for (int n = 0; n < 2; ++n) { const f32x4 gv = *(const f32x4*)(mod + goff + bj * HALF + n * 4); f32x4* op = (f32x4*)(out + ooff + bj * HALF + n * 4);
                                *op = *op + gv * acc[ai][bj][m][n]; }
                    } else { unsigned char* yp = Y + (size_t)(unsigned)ts * D + col0; const float ws_ = w * YSCALE;
#pragma unroll
                        for (int bj = 0; bj < 2; ++bj) { f32x4 v0 = acc[ai][bj][m][0] * ws_, v1 = acc[ai][bj][m][1] * ws_;
#pragma unroll
                                for (int j = 0; j < 4; ++j) { v0[j] = __builtin_amdgcn_fmed3f(v0[j], -448.f, 448.f); v1[j] = __builtin_amdgcn_fmed3f(v1[j], -448.f, 448.f); }
                            unsigned lo = 0u, hi = 0u;
                            lo = __builtin_amdgcn_cvt_pk_fp8_f32(v0[0], v0[1], lo, false); lo = __builtin_amdgcn_cvt_pk_fp8_f32(v0[2], v0[3], lo, true);
                            hi = __builtin_amdgcn_cvt_pk_fp8_f32(v1[0], v1[1], hi, false); hi = __builtin_amdgcn_cvt_pk_fp8_f32(v1[2], v1[3], hi, true);
                            u32x2 pk; pk.x = lo; pk.y = hi; *(u32x2*)(yp + bj * HALF) = pk; } } }
                asm volatile("" ::: "memory"); }
    }
};

struct MoeCtx {
    int ntiles, nrt, G, vc;
    const LAS int* tb; LAS int* tbl;
    const unsigned* cnt; const int* rowl; const float* roww;
    const char* wexp; const char* h2n; char* Hs; unsigned char* Y; float* out; const float* mod; int dry_shared;
};
__device__ __forceinline__ void gemm_moe(lbyte* lds, const MoeCtx& M) {
    int tid_ = threadIdx.x; asm volatile("" : "+v"(tid_));
    const int tid = tid_, wid = __builtin_amdgcn_readfirstlane(tid >> 6), lane = tid & 63, wr = wid >> 2, wc = wid & 3, fr = lane & 15, fq = lane >> 4;
    const int ntl = (M.ntiles - M.vc + M.G - 1) / M.G;
    if (M.vc >= M.ntiles) return;
    const int nunits = ntl * 6;
    const unsigned ldsw = (unsigned)wid * 1024u;
    const int aoff = lds_byte(wr * 64 + fr, fq * 16), boff = lds_byte(wc * 32 + fr, fq * 16);
    auto tile_expert = [&](int tile, int& e, int& k) { if (tile < M.nrt) { int lo = 0, hi = NE - 1; while (lo < hi) { const int mid = (lo + hi + 1) >> 1; if (M.tb[mid] <= tile) lo = mid; else hi = mid - 1; } e = lo; k = tile - M.tb[lo]; } else { e = NE; k = tile - M.nrt; } };
    auto fill = [&](int j) { if (j < ntl && tid < 256) { const int tile = M.vc + j * M.G; int e, k; tile_expert(tile, e, k); LAS int* T = M.tbl + (j % 3) * 768;
            int ts; float w;
            if (e < NE) { const int valid = (int)M.cnt[e] - 256 * k; if (tid < valid) { ts = M.rowl[(size_t)tile * 256 + tid]; w = M.roww[(size_t)tile * 256 + tid]; } else { ts = -1; w = 0.f; } T[tid] = ts < 0 ? 0 : (ts >> 3); }
            else { ts = k * 256 + tid; w = 1.f; T[tid] = ts; }
            T[256 + tid] = ts; ((LAS float*)T)[512 + tid] = w; } };
    struct UP { const char* aB; const char* bB; unsigned bh; int nt, kind, pn, slot, shared, e, hbuf, fillnext; };
    auto unit_params = [&](int ui, int prev_e, UP& u, unsigned (&oa)[4], unsigned (&ob)[2]) {
        int tq = threadIdx.x; asm volatile("" : "+v"(tq));
        int Rst[2], Cst[2], Rbp[2];
#pragma unroll
        for (int i = 0; i < 2; ++i) { int R, C; stage_rc(tq * 16 + i * 8192, R, C); Rst[i] = R; Cst[i] = C; Rbp[i] = (R & ~31) + perm32(R & 31); }
        int j, sub;
        if (ui < 2) { j = 0; sub = ui; }
        else { const int qq = ui - 2, g = qq / 6, r = qq - 6 * g; if (g < ntl - 1 && r < 2) { j = g + 1; sub = r; } else { j = g; sub = (g < ntl - 1) ? r : r + 2; } }
        const int tile = M.vc + j * M.G; int e, k;
        if (sub == 0 || sub == 2) tile_expert(tile, e, k); else e = prev_e;
        u.e = e;
        const char* w = M.wexp + (size_t)e * WEXP_STRIDE;
        u.slot = j % 3; u.hbuf = j & 1; u.fillnext = (sub == 1) ? j + 1 : -1; u.shared = (e == NE) ? 1 : 0;
        if (sub < 2) { u.kind = 0; u.pn = sub; u.nt = D / 128; u.aB = M.h2n; u.bB = w + (size_t)sub * 256 * D; u.bh = 128u * D;
            const LAS int* T = M.tbl + (j % 3) * 768;
#pragma unroll
            for (int i = 0; i < 2; ++i) { oa[i] = (unsigned)T[Rst[i]] * (unsigned)D + 2u * (unsigned)Cst[i]; oa[2 + i] = (unsigned)T[128 + Rst[i]] * (unsigned)D + 2u * (unsigned)Cst[i]; ob[i] = (unsigned)(Rbp[i] * D + 2 * Cst[i]); } }
        else { u.kind = 1; u.pn = sub - 2; u.nt = DE / 128; u.aB = M.Hs + (j & 1) * 65536; u.bB = w + (size_t)512 * 1024 + (size_t)(sub - 2) * 256 * DE; u.bh = 128u * DE;
#pragma unroll
            for (int i = 0; i < 2; ++i) { oa[i] = (unsigned)(Rst[i] * DE + 2 * Cst[i]); oa[2 + i] = (unsigned)((128 + Rst[i]) * DE + 2 * Cst[i]); ob[i] = (unsigned)(Rbp[i] * DE + 2 * Cst[i]); } }
    };
#define PG8_SA(b, h) (((b) * 2 + (h)) * HTB)
#define PG8_SB(b, h) ((4 + (b) * 2 + (h)) * HTB)
#define MOE_DMA(bufoff, ptr, aux) __builtin_amdgcn_global_load_lds((const unsigned*)(ptr), (LAS unsigned*)(lds + (bufoff)), 16, 0, aux)
#define MOE_STA(bufoff, base, o0, o1) do { MOE_DMA((bufoff) + ldsw, (base) + (o0), 16); MOE_DMA((bufoff) + ldsw + 8192, (base) + (o1), 16); } while (0)
#define MOE_STAK(kindv, bufoff, base, o0, o1) do { if ((kindv) == 0) { MOE_DMA((bufoff) + ldsw, (base) + (o0), 0); MOE_DMA((bufoff) + ldsw + 8192, (base) + (o1), 0); } else MOE_STA(bufoff, base, o0, o1); } while (0)
#define MOE_STB(bufoff, base, o0, o1) do { MOE_DMA((bufoff) + ldsw, (base) + (o0), 0); MOE_DMA((bufoff) + ldsw + 8192, (base) + (o1), 0); } while (0)
#define MOE_LD32(p) __builtin_shufflevector(*(const LAS i32x4*)(p), *(const LAS i32x4*)((p) + 16), 0, 1, 2, 3, 4, 5, 6, 7)
#define PG8_LDA(dst, b, h) do { _Pragma("unroll") for (int m = 0; m < 4; ++m) dst[m] = MOE_LD32(lds + PG8_SA(b, h) + aoff + m * 2048); } while (0)
#define PG8_LDB(dst, b, h) do { _Pragma("unroll") for (int n = 0; n < 2; ++n) dst[n] = MOE_LD32(lds + PG8_SB(b, h) + boff + n * 2048); } while (0)
#define MOE_MFMA(c, a, b) asm volatile("v_mfma_scale_f32_16x16x128_f8f6f4 %0, %1, %2, %0, %3, %3 op_sel_hi:[0,0,0]" : "+v"(c) : "v"(a), "v"(b), "v"(one_scale))
#define PG8_MMA(ai, bj, At, Bt) do { __builtin_amdgcn_s_setprio(1); _Pragma("unroll") for (int m = 0; m < 4; ++m) _Pragma("unroll") for (int n = 0; n < 2; ++n) \
        MOE_MFMA(acc[ai][bj][m][n], Bt[n], At[m]); __builtin_amdgcn_s_setprio(0); } while (0)
#define PG8_WAIT_V(n) asm volatile("s_waitcnt vmcnt(" #n ")" ::: "memory")
#define PG8_WAIT_L(n) asm volatile("s_waitcnt lgkmcnt(" #n ")" ::: "memory")
#define PG8_BAR __builtin_amdgcn_s_barrier()
#define PG8_SCHED __builtin_amdgcn_sched_barrier(0)
    fill(0);
    asm volatile("s_waitcnt vmcnt(0) lgkmcnt(0)" ::: "memory");
    __syncthreads();
    UP cu, nu; unsigned oa[4], ob[2], na[4], nb[2];
    unit_params(0, 0, cu, oa, ob);
    nu = cu;
#pragma unroll
    for (int i = 0; i < 4; ++i) na[i] = oa[i];
    nb[0] = ob[0]; nb[1] = ob[1];
    f32x4 acc[2][2][4][2];
#pragma unroll
    for (int a = 0; a < 2; ++a)
#pragma unroll
        for (int b = 0; b < 2; ++b)
#pragma unroll
            for (int m = 0; m < 4; ++m)
#pragma unroll
                for (int n = 0; n < 2; ++n) acc[a][b][m][n] = (f32x4){0.f, 0.f, 0.f, 0.f};
    i32x8 At[4], B0[2], B1[2];
    int one_scale = 0x7F7F7F7F; asm volatile("" : "+v"(one_scale));
    const size_t kstep = (size_t)128;
    {   const char* cA = cu.aB; const char* cB = cu.bB;
        MOE_STB(PG8_SB(0, 0), cB, ob[0], ob[1]); MOE_STB(PG8_SB(0, 1), cB + cu.bh, ob[0], ob[1]); MOE_STAK(cu.kind, PG8_SA(0, 0), cA, oa[0], oa[1]); MOE_STAK(cu.kind, PG8_SA(0, 1), cA, oa[2], oa[3]);
        if (wr == 1) PG8_BAR;
        PG8_WAIT_V(2); PG8_BAR;
        MOE_STB(PG8_SB(1, 0), cB + kstep, ob[0], ob[1]); MOE_STAK(cu.kind, PG8_SA(1, 0), cA + kstep, oa[0], oa[1]); MOE_STB(PG8_SB(1, 1), cB + cu.bh + kstep, ob[0], ob[1]);
        PG8_WAIT_V(6); PG8_BAR; }
    for (int ui = 0;; ++ui) {
        const bool has_next = (ui + 1 < nunits);
        if (cu.fillnext >= 0) fill(cu.fillnext);
        const char* cA = cu.aB; const char* cB = cu.bB; const int nt = cu.nt; const unsigned bh = cu.bh;
        for (int t = 0; t < nt; t += 2) {
            const bool last = (t == nt - 2);
            if (last && has_next) unit_params(ui + 1, cu.e, nu, na, nb);
            const char* a1 = cA + (size_t)(t + 1) * kstep;
            const char* a2 = last ? nu.aB : cA + (size_t)(t + 2) * kstep; const char* b2 = last ? nu.bB : cB + (size_t)(t + 2) * kstep;
            const char* a3 = a2 + kstep; const char* b3 = b2 + kstep;
            const unsigned bh2 = last ? nu.bh : bh;
            const unsigned x0 = last ? na[0] : oa[0], x1 = last ? na[1] : oa[1], y0 = last ? na[2] : oa[2], y1 = last ? na[3] : oa[3];
            const unsigned z0 = last ? nb[0] : ob[0], z1 = last ? nb[1] : ob[1];
            const int k2 = last ? nu.kind : cu.kind;
            PG8_LDB(B0, 0, 0); PG8_LDB(B1, 0, 1); PG8_SCHED; PG8_LDA(At, 0, 0); MOE_STAK(cu.kind, PG8_SA(1, 1), a1, oa[2], oa[3]);
            PG8_WAIT_V(8); PG8_WAIT_L(0); PG8_BAR; PG8_MMA(0, 0, At, B0); PG8_MMA(0, 1, At, B1); PG8_BAR; PG8_SCHED;
            PG8_LDA(At, 0, 1); MOE_STB(PG8_SB(0, 0), b2, z0, z1); MOE_STB(PG8_SB(0, 1), b2 + bh2, z0, z1); MOE_STAK(k2, PG8_SA(0, 0), a2, x0, x1);
            PG8_WAIT_V(8); PG8_WAIT_L(0); PG8_BAR; PG8_MMA(1, 0, At, B0); PG8_MMA(1, 1, At, B1); PG8_BAR; PG8_SCHED;
            PG8_LDB(B0, 1, 0); PG8_LDB(B1, 1, 1); PG8_SCHED; PG8_LDA(At, 1, 0); MOE_STAK(k2, PG8_SA(0, 1), a2, y0, y1);
            PG8_WAIT_V(8); PG8_WAIT_L(0); PG8_BAR; PG8_MMA(0, 0, At, B0); PG8_MMA(0, 1, At, B1); PG8_BAR; PG8_SCHED;
            PG8_LDA(At, 1, 1); MOE_STB(PG8_SB(1, 0), b3, z0, z1); MOE_STB(PG8_SB(1, 1), b3 + bh2, z0, z1); MOE_STAK(k2, PG8_SA(1, 0), a3, x0, x1);
            PG8_WAIT_V(8); PG8_WAIT_L(0); PG8_BAR; PG8_MMA(1, 0, At, B0); PG8_MMA(1, 1, At, B1); PG8_BAR; PG8_SCHED;
        }
        if (wr == 0) PG8_BAR;
        asm volatile("s_nop 15\n\ts_nop 15" ::: "memory");
        if (cu.kind == 0) {
            const int row0 = wr * 64 + fr; const int col0 = cu.pn * 128 + wc * 32 + 8 * fq;
            constexpr float is13 = 1.f / SW13;
#pragma unroll
            for (int ai = 0; ai < 2; ++ai)
#pragma unroll
                for (int m = 0; m < 4; ++m) { unsigned char* rowp = (unsigned char*)M.Hs + cu.hbuf * 65536 + (size_t)(row0 + ai * HALF + m * 16) * 256 + col0;
                    f32x4 h0, h1;
#pragma unroll
                    for (int j = 0; j < 4; ++j) { h0[j] = siluf_(acc[ai][0][m][0][j] * is13) * (acc[ai][1][m][0][j] * (is13 * SHS)); h1[j] = siluf_(acc[ai][0][m][1][j] * is13) * (acc[ai][1][m][1][j] * (is13 * SHS)); }
                    u32x2 w; w.x = pk4_fp8(h0[0], h0[1], h0[2], h0[3]); w.y = pk4_fp8(h1[0], h1[1], h1[2], h1[3]);
                    *(u32x2*)rowp = w; }
        } else {
            const LAS int* rtok = M.tbl + cu.slot * 768 + 256; const LAS float* rw = (const LAS float*)(M.tbl + cu.slot * 768 + 512);
            const int col0 = cu.pn * BM + wc * 32 + 8 * fq;
#pragma unroll
            for (int ai = 0; ai < 2; ++ai)
#pragma unroll
                for (int m = 0; m < 4; ++m) { const int r = wr * 64 + fr + ai * HALF + m * 16; const int ts = rtok[r]; const float w = rw[r];
                    if (ts >= 0) {
                        if (cu.shared) { const unsigned goff = (unsigned)(ts >> 11) * MODW + 5 * D + col0; const unsigned ooff = (unsigned)ts * D + col0;
#pragma unroll
                            for (int bj = 0; bj < 2; ++bj)
#pragma unroll
                                for (int n = 0; n < 2; ++n) { const f32x4 gv = *(const f32x4*)(M.mod + goff + bj * HALF + n * 4); f32x4* op = (f32x4*)(M.out + ooff + bj * HALF + n * 4);
                                    const f32x4 nv = *op + gv * acc[ai][bj][m][n] * (1.f / (SHS * SW2)); if (!M.dry_shared) *op = nv; else asm volatile("" :: "v"(nv)); }
                        } else { unsigned char* yp = M.Y + (size_t)(unsigned)ts * D + col0; const float ws_ = w * (YSCALE / (SHS * SW2));
#pragma unroll
                            for (int bj = 0; bj < 2; ++bj) { f32x4 v0 = acc[ai][bj][m][0] * ws_, v1 = acc[ai][bj][m][1] * ws_;
#pragma unroll
                                for (int j = 0; j < 4; ++j) { v0[j] = __builtin_amdgcn_fmed3f(v0[j], -448.f, 448.f); v1[j] = __builtin_amdgcn_fmed3f(v1[j], -448.f, 448.f); }
                                unsigned lo = 0u, hi = 0u;
                                lo = __builtin_amdgcn_cvt_pk_fp8_f32(v0[0], v0[1], lo, false); lo = __builtin_amdgcn_cvt_pk_fp8_f32(v0[2], v0[3], lo, true);
                                hi = __builtin_amdgcn_cvt_pk_fp8_f32(v1[0], v1[1], hi, false); hi = __builtin_amdgcn_cvt_pk_fp8_f32(v1[2], v1[3], hi, true);
                                u32x2 pk; pk.x = lo; pk.y = hi; *(u32x2*)(yp + bj * HALF) = pk; } } }
                    asm volatile("" ::: "memory"); }
        }
        if (!has_next) break;
#pragma unroll
        for (int a = 0; a < 2; ++a)
#pragma unroll
            for (int b = 0; b < 2; ++b)
#pragma unroll
                for (int m = 0; m < 4; ++m)
#pragma unroll
                    for (int n = 0; n < 2; ++n) acc[a][b][m][n] = (f32x4){0.f, 0.f, 0.f, 0.f};
        cu = nu;
#pragma unroll
        for (int i = 0; i < 4; ++i) oa[i] = na[i];
        ob[0] = nb[0]; ob[1] = nb[1];
        if (wr == 1) PG8_BAR;
    }
    PG8_WAIT_V(0);
    PG8_BAR;
#undef PG8_SA
#undef PG8_SB
#undef MOE_DMA
#undef MOE_STA
#undef MOE_STAK
#undef MOE_STB
#undef PG8_LDA
#undef PG8_LDB
#undef MOE_LD32
#undef MOE_MFMA
#undef PG8_MMA
#undef PG8_WAIT_V
#undef PG8_WAIT_L
#undef PG8_BAR
#undef PG8_SCHED
}
}

struct Ctx {
    lbyte* lds; int tid, lane, wave, G, bid;
    const Args* a;
};
#define WSP(T, off) ((T*)(A.ws + (off)))

template <class RowMap>
__device__ __forceinline__ void transpose_item(const float* W, int K, int N, bf16_t* WT, RowMap rowmap, lfloat* scr, int item, int lane) {
    const int nblk = N / 32, kb = item / nblk, nb = item % nblk, k0 = 64 * kb, n0 = 32 * nb;
#pragma unroll 8
    for (int i = 0; i < 32; ++i) { const int kk = 2 * i + (lane >> 5); scr[kk * 33 + (lane & 31)] = W[(size_t)(k0 + kk) * N + n0 + (lane & 31)]; }
    asm volatile("s_waitcnt lgkmcnt(0)" ::: "memory");
    const int c = lane & 7;
#pragma unroll
    for (int j = 0; j < 4; ++j) { const int n = (lane >> 3) + 8 * j; const lfloat* s = scr + (8 * c) * 33 + n;
        u32x4 o; o.x = pk2(s[0 * 33], s[1 * 33]); o.y = pk2(s[2 * 33], s[3 * 33]); o.z = pk2(s[4 * 33], s[5 * 33]); o.w = pk2(s[6 * 33], s[7 * 33]);
        *(u32x4*)(WT + (size_t)rowmap(n0 + n) * K + k0 + 8 * c) = o; }
    asm volatile("s_waitcnt lgkmcnt(0)" ::: "memory");
}
template <class RowMap>
__device__ __forceinline__ void transpose_item_fp8(const float* W, int K, int N, unsigned char* WT, RowMap rowmap, float sc, lfloat* scr, int item, int lane) {
    const int nblk = N / 32, kb = item / nblk, nb = item % nblk, k0 = 64 * kb, n0 = 32 * nb;
#pragma unroll 8
    for (int i = 0; i < 32; ++i) { const int kk = 2 * i + (lane >> 5); scr[kk * 33 + (lane & 31)] = W[(size_t)(k0 + kk) * N + n0 + (lane & 31)] * sc; }
    asm volatile("s_waitcnt lgkmcnt(0)" ::: "memory");
    const int c = lane & 7;
#pragma unroll
    for (int j = 0; j < 4; ++j) { const int n = (lane >> 3) + 8 * j; const lfloat* s = scr + (8 * c) * 33 + n;
        u32x2 o; o.x = pk4_fp8(s[0 * 33], s[1 * 33], s[2 * 33], s[3 * 33]); o.y = pk4_fp8(s[4 * 33], s[5 * 33], s[6 * 33], s[7 * 33]);
        *(u32x2*)(WT + (size_t)rowmap(n0 + n) * K + k0 + 8 * c) = o; }
    asm volatile("s_waitcnt lgkmcnt(0)" ::: "memory");
}
struct RowId { __device__ int operator()(int n) const { return n; } };
struct RowGLU { int base; __device__ int operator()(int n) const { return ((n >> 7) << 8) + base + (n & 127); } };

__device__ __forceinline__ void norm_mod_row(const float* xrow, const float* g, const float* sc, const float* sh, bf16_t* orow, int lane, unsigned* o8row = nullptr) {
    const f32x4* xr = (const f32x4*)xrow + lane;
    f32x4 v[4]; float s = 0.f;
#pragma unroll
    for (int j = 0; j < 4; ++j) { v[j] = xr[64 * j]; s += (v[j].x * v[j].x + v[j].y * v[j].y) + (v[j].z * v[j].z + v[j].w * v[j].w); }
    const float rstd = __builtin_amdgcn_rsqf(wave_sum(s) * (1.f / D) + NORM_EPS);
    u32x2* o8 = (u32x2*)orow + lane;
#pragma unroll
    for (int j = 0; j < 4; ++j) { const f32x4 gg = ((const f32x4*)g)[lane + 64 * j], ss = ((const f32x4*)sc)[lane + 64 * j], hh = ((const f32x4*)sh)[lane + 64 * j];
        const f32x4 y = v[j] * rstd * gg * (ss + 1.f) + hh;
        if (orow) { u32x2 w; w.x = pk2(y.x, y.y); w.y = pk2(y.z, y.w); o8[64 * j] = w; }
        if (o8row) o8row[lane + 64 * j] = pk4_fp8(y.x, y.y, y.z, y.w); }
}

__device__ __forceinline__ void phase_p0(const Args& A, Ctx& C) {
    float* mod = WSP(float, WS_MOD);
    {
        lfloat* sc = (lfloat*)C.lds;
        lfloat* red = (lfloat*)(C.lds + 17 * 1024 * 4);
        const float* wada = A.in[I_WADA]; const float* bada = A.in[I_BADA];
        for (int it = C.bid; it < 96 * 2; it += C.G) {
            const int chunk = it >> 1, pass = it & 1, r0 = pass * 17, nr = pass ? 16 : 17, col0 = chunk * 64;
            __syncthreads();
            for (int i = C.tid; i < nr * 1024; i += 512) { const int r = i >> 10, k = i & 1023; const int rr = r0 + r;
                const float cv = rr < 32 ? A.in[I_C][rr * 1024 + k] : A.in[I_CCTX][k]; sc[r * 1024 + k] = siluf_(cv); }
            __syncthreads();
            const int col = C.tid & 63, kq = C.tid >> 6;
            float acc[17];
#pragma unroll
            for (int r = 0; r < 17; ++r) acc[r] = 0.f;
            for (int k = kq * 128; k < kq * 128 + 128; k += 4) {
                float w[4];
#pragma unroll
                for (int j = 0; j < 4; ++j) w[j] = wada[(size_t)(k + j) * MODW + col0 + col];
#pragma unroll
                for (int r = 0; r < 17; ++r) { const f32x4 s4 = *(const LAS f32x4*)(sc + r * 1024 + k); acc[r] += s4.x * w[0] + s4.y * w[1] + s4.z * w[2] + s4.w * w[3]; }
            }
#pragma unroll
            for (int r = 0; r < 17; ++r) red[(kq * 17 + r) * 64 + col] = acc[r];
            __syncthreads();
            for (int i = C.tid; i < nr * 64; i += 512) { const int r = i >> 6, cc = i & 63; float s = 0.f;
#pragma unroll
                for (int q = 0; q < 8; ++q) s += red[(q * 17 + r) * 64 + cc];
                mod[(size_t)(r0 + r) * MODW + col0 + cc] = s + bada[col0 + cc]; }
        }
        __syncthreads();
    }
    {
        lfloat* scr = (lfloat*)(C.lds + C.wave * 16384);
        const int gw = C.bid * 8 + C.wave, NGW = C.G * 8;
        unsigned char* btin8 = A.ws + WS_BTIN; bf16_t* btout = WSP(bf16_t, WS_BTOUT); bf16_t* btr = WSP(bf16_t, WS_BTR);
        constexpr int I_IN = (D / 64) * 124, I_OUT = (D / 64) * (D / 32), I_R = (D / 64) * (NE / 32), I_G = (128 / 64) * (DA / 32);
        for (int it = gw; it < I_IN + I_OUT + I_R + I_G; it += NGW) {
            int r = it;
            if (r < I_IN) {
                const int kb = r / 124, nb = r % 124, k0 = 64 * kb, n0 = 32 * nb; const float* W = A.in[I_WIN];
#pragma unroll 8
                for (int i = 0; i < 32; ++i) { const int kk = 2 * i + (C.lane >> 5); scr[kk * 33 + (C.lane & 31)] = W[(size_t)(k0 + kk) * IN_COLS + n0 + (C.lane & 31)] * SWIN; }
                asm volatile("s_waitcnt lgkmcnt(0)" ::: "memory");
                const int c = C.lane & 7;
#pragma unroll
                for (int j = 0; j < 4; ++j) { const int n = (C.lane >> 3) + 8 * j; const lfloat* s = scr + (8 * c) * 33 + n;
                    u32x2 o; o.x = pk4_fp8(s[0 * 33], s[1 * 33], s[2 * 33], s[3 * 33]); o.y = pk4_fp8(s[4 * 33], s[5 * 33], s[6 * 33], s[7 * 33]);
                    *(u32x2*)(btin8 + (size_t)(n0 + n) * D + k0 + 8 * c) = o; }
                asm volatile("s_waitcnt lgkmcnt(0)" ::: "memory");
                continue; }
            r -= I_IN;
            if (r < I_OUT) { transpose_item(A.in[I_WOUT], D, D, btout, RowId(), scr, r, C.lane); continue; } r -= I_OUT;
            if (r < I_R) { transpose_item(A.in[I_RW], D, NE, btr, RowId(), scr, r, C.lane); continue; } r -= I_R;
            transpose_item(A.in[I_GUP], 128, DA, WSP(bf16_t, WS_GUPT), RowId(), scr, r, C.lane);
        }
        for (int i = C.bid * 512 + C.tid; i < 16 * D / 4; i += C.G * 512) { const int n = 3968 + (i >> 8), k = (i & 255) * 4; const float* W = A.in[I_WIN];
            *(unsigned*)(btin8 + (size_t)n * D + k) = pk4_fp8(W[(size_t)k * IN_COLS + n] * SWIN, W[(size_t)(k + 1) * IN_COLS + n] * SWIN, W[(size_t)(k + 2) * IN_COLS + n] * SWIN, W[(size_t)(k + 3) * IN_COLS + n] * SWIN); }
        for (int i = C.bid * 512 + C.tid; i < (PLD - IN_COLS) * D / 16; i += C.G * 512) ((u32x4*)(btin8 + (size_t)IN_COLS * D))[i] = (u32x4){0u, 0u, 0u, 0u};
    }
}

__device__ __forceinline__ void phase_p1(const Args& A, Ctx& C) {
    const float* mod = WSP(float, WS_MOD); bf16_t* xn = WSP(bf16_t, WS_XN);
    const int gw = C.bid * 8 + C.wave, NGW = C.G * 8;
    for (int row = gw; row < NROWS; row += NGW) {
        const float* xr; int mb;
        if (row < NLAT) { xr = A.in[I_X] + (size_t)row * D; mb = row >> 11; } else { xr = A.in[I_CTX] + (size_t)(row - NLAT) * D; mb = 32; }
        const float* m = mod + (size_t)mb * MODW;
        norm_mod_row(xr, A.in[I_N1G], m + D, m, nullptr, C.lane, (unsigned*)(A.ws + WS_XN) + (size_t)row * (D / 4));
    }
}

template <int NK>
__device__ __forceinline__ f32x4 mm_tile(const lbyte* Ap, int lda, const lbyte* Bp, int ldb, f32x4 acc, int lane) {
    const int r = lane & 15, g = lane >> 4;
#pragma unroll
    for (int ks = 0; ks < NK; ++ks) {
        const bf16x8 a = *(const LAS bf16x8*)(Ap + r * lda + ks * 64 + g * 16);
        const bf16x8 b = *(const LAS bf16x8*)(Bp + r * ldb + ks * 64 + g * 16);
        acc = __builtin_amdgcn_mfma_f32_16x16x32_bf16(a, b, acc, 0, 0, 0);
    }
    return acc;
}

__device__ __forceinline__ void st_bf16x4(lbyte* p, f32x4 v) { u32x2 w; w.x = cvtpk(v.x, v.y); w.y = cvtpk(v.z, v.w); *(LAS u32x2*)p = w; }
__device__ __forceinline__ void st_bf16(lbyte* p, float v) { *(LAS unsigned short*)p = (unsigned short)cvtpk(v, v); }
__device__ __forceinline__ float rdlane(float v, int l) { return __builtin_bit_cast(float, __builtin_amdgcn_readlane(__builtin_bit_cast(int, v), l)); }

__device__ __forceinline__ void tri_inv16(const f32x4 m, int lane, float (&X)[16]) {
#pragma unroll
    for (int i = 0; i < 16; ++i) {
        float x0 = (lane == i) ? 1.f : 0.f, x1 = 0.f;
#pragma unroll
        for (int k = 0; k < i; ++k) { const float t = rdlane(m[k & 3], i + 16 * (k >> 2)) * X[k]; if (k & 1) x1 -= t; else x0 -= t; }
        X[i] = x0 + x1;
    }
}

namespace rk {
constexpr int S64 = 160, S32 = 80, SW = 144;
constexpr int O_WUP = 0, O_AUP = O_WUP + 64 * SW, O_WLT = O_AUP + 64 * SW, O_ALT = O_WLT + 16 * S64, O_LW = O_ALT + 16 * S64, O_LA = O_LW + 4096,
              O_KKT = O_LA + 4096, O_RT = O_KKT + 16 * S64, O_BT = O_RT + 16 * S64, O_KDT = O_BT + 16 * S64,
              O_VT = O_KDT + 16 * S64, O_BHT = O_VT + 64 * S32, O_KHT = O_BHT + 64 * S32, O_UT = O_KHT + 64 * S32, O_UTT = O_WLT  ,
              O_TI = O_UT + 64 * S32, O_MK = O_TI + 16 * S32, O_NB = O_MK + 16 * S32, O_NK = O_NB + 16 * S32,
              O_SBF = O_NK + 16 * S32, O_WC = O_SBF + 64 * S64, TEAM_BYTES = O_WC + 256;
static_assert(2 * TEAM_BYTES <= LDS_MISC, "rwkv LDS");
}
__device__ __forceinline__ void rwkv_pair_chunked(const Args& A, Ctx& C, int pair) {
    using namespace rk;
    const int b = pair >> 3, h = pair & 7;
    const int dir = C.wave >> 2;
    const int t4 = C.tid & 255, q = C.wave & 3, lane = C.lane;
    lbyte* L = C.lds + dir * TEAM_BYTES;
    const bf16_t* P = WSP(bf16_t, WS_P);
    bf16_t* ydir = WSP(bf16_t, WS_YDIR) + (size_t)dir * NLAT * D;
    float* bon = WSP(float, WS_BON) + (size_t)dir * NLAT * 8;
    __syncthreads();
#pragma unroll 2
    for (int i = t4; i < 4096; i += 256) { const int l = i >> 6, c = i & 63;
        st_bf16(L + O_WUP + c * SW + l * 2, A.in[I_WUP][((size_t)dir * 64 + l) * DA + 64 * h + c]);
        st_bf16(L + O_AUP + c * SW + l * 2, A.in[I_AUP][((size_t)dir * 64 + l) * DA + 64 * h + c]); }
#pragma unroll 2
    for (int i = t4; i < (4 * 64 * S32 + 4 * 16 * S32 + 64 * S64) / 4; i += 256) ((LAS unsigned*)(L + O_VT))[i] = 0u;
    for (int i = t4; i < (2 * 16 * S64) / 4; i += 256) ((LAS unsigned*)(L + O_WLT))[i] = 0u;
    const int c = lane;
    int col5[5] = {64 * h + c, 512 + 64 * h + c, 1024 + 64 * h + c, 1536 + 64 * dir + c, 1664 + 64 * dir + c};
    float mu5[5]; int dl5[5], cl5[5], dc5[5], cc5[5];
#pragma unroll
    for (int e = 0; e < 5; ++e) { const int col = col5[e]; mu5[e] = A.in[I_MU][col];
        cl5[e] = col < 480 ? 0 : (col < 960 ? 1 : (col < 1440 ? 2 : 3)); dl5[e] = (cl5[e] == 0 ? -PLD : (cl5[e] == 1 ? PLD : (cl5[e] == 2 ? -64 * PLD : 64 * PLD)));
        cc5[e] = col < 960 ? 0 : 1; dc5[e] = col < 960 ? -PLD : PLD; }
    const float kkc = A.in[I_KK][64 * h + c], kac = A.in[I_KA][64 * h + c], rkc = A.in[I_RK][64 * h + c];
    const float w0c = A.in[I_W0][dir * DA + 64 * h + c], a0c = A.in[I_A0][dir * DA + 64 * h + c];
    f32x4 Sacc[4];
#pragma unroll
    for (int i = 0; i < 4; ++i) Sacc[i] = (f32x4){0.f, 0.f, 0.f, 0.f};
    const int fr = lane & 15, fg = lane >> 4;
    unsigned short rawp[4][5], raws[4][5];
    auto chunk_geom = [&](int ch, bool& isctx, int& sbase, int& T, size_t& rowbase) { isctx = ch < 16; sbase = isctx ? ch * 16 : (ch - 16) * 16; T = isctx ? CTX : SEQ; rowbase = isctx ? (size_t)NLAT + (size_t)b * CTX : (size_t)b * SEQ; };
    auto okmask = [&](bool isctx, int t) -> int { return isctx ? ((t >= 1 ? 1 : 0) | (t <= CTX - 2 ? 2 : 0)) : (((t & 63) >= 1 ? 1 : 0) | ((t & 63) <= 62 ? 2 : 0) | (t >= 64 ? 4 : 0) | (t < SEQ - 64 ? 8 : 0)); };
    auto issue_loads = [&](int ch) { bool isctx; int sbase, T; size_t rowbase; chunk_geom(ch, isctx, sbase, T, rowbase);
#pragma unroll
        for (int j = 0; j < 4; ++j) { const int i = q + 4 * j; const int t = __builtin_amdgcn_readfirstlane(dir ? (T - 1 - (sbase + i)) : (sbase + i));
            const bf16_t* pr = P + (rowbase + t) * PLD; const int okm = okmask(isctx, t);
#pragma unroll
            for (int e = 0; e < 5; ++e) { const int cls = isctx ? cc5[e] : cl5[e]; const bool ok = (okm >> cls) & 1; const int off = col5[e] + (ok ? (isctx ? dc5[e] : dl5[e]) : 0);
                rawp[j][e] = pr[col5[e]]; raws[j][e] = pr[off]; } } };
    issue_loads(0);
    for (int ch = 0; ch < 144; ++ch) {
        bool isctx; int sbase, T; size_t rowbase; chunk_geom(ch, isctx, sbase, T, rowbase);
        float vr[4], vk[4], vv[4], vkk[4], lw[4], av[4];
        __syncthreads();
        float mxa[4][5];
#pragma unroll
        for (int j = 0; j < 4; ++j) { const int i = q + 4 * j; const int t = __builtin_amdgcn_readfirstlane(dir ? (T - 1 - (sbase + i)) : (sbase + i)); const int okm = okmask(isctx, t);
#pragma unroll
            for (int e = 0; e < 5; ++e) { const int cls = isctx ? cc5[e] : cl5[e]; const bool ok = (okm >> cls) & 1;
                const float pv = bf2f(rawp[j][e]); const float sv = bf2f(raws[j][e]); mxa[j][e] = pv + mu5[e] * ((ok ? sv : 0.f) - pv); } }
        if (ch + 1 < 144) issue_loads(ch + 1);
#pragma unroll
        for (int j = 0; j < 4; ++j) {
            const int i = q + 4 * j;
            float mx[5];
#pragma unroll
            for (int e = 0; e < 5; ++e) mx[e] = mxa[j][e];
            vr[j] = mx[0]; vk[j] = mx[1]; vv[j] = mx[2];
            *(LAS unsigned short*)(L + O_WLT + i * S64 + c * 2) = (unsigned short)cvtpk(tanhf_(mx[3]), 0.f); *(LAS unsigned short*)(L + O_ALT + i * S64 + c * 2) = (unsigned short)cvtpk(mx[4], 0.f);
            const float kx = vk[j] * kkc; const float ss = wave_sum(kx * kx);
            vkk[j] = kx * __builtin_amdgcn_rsqf(ss + 1e-6f);
        }
        __syncthreads();
        {
            const f32x4 z = (f32x4){0.f, 0.f, 0.f, 0.f};
            const f32x4 tw = mm_tile<2>(L + O_WLT, S64, L + O_WUP + 16 * q * SW, SW, z, lane);
            const f32x4 ta = mm_tile<2>(L + O_ALT, S64, L + O_AUP + 16 * q * SW, SW, z, lane);
#pragma unroll
            for (int e = 0; e < 4; ++e) { ((LAS float*)(L + O_LW))[(4 * fg + e) * 64 + 16 * q + fr] = tw[e]; ((LAS float*)(L + O_LA))[(4 * fg + e) * 64 + 16 * q + fr] = ta[e]; }
        }
        __syncthreads();
#pragma unroll
        for (int j = 0; j < 4; ++j) { const int i = q + 4 * j;
            const float wlog = -softplusf_(-(w0c + ((LAS float*)(L + O_LW))[i * 64 + c])) - 0.5f;
            lw[j] = -__expf(wlog);
            av[j] = sigmoidf_(a0c + ((LAS float*)(L + O_LA))[i * 64 + c]);
            ((LAS float*)(L + O_LW))[i * 64 + c] = lw[j]; }
        __syncthreads();
        if (t4 < 64) { float cum = 0.f;
#pragma unroll
            for (int t = 0; t < 16; ++t) { cum += ((LAS float*)(L + O_LW))[t * 64 + c]; ((LAS float*)(L + O_LW))[t * 64 + c] = cum; } }
        __syncthreads();
        {
            const float cumC = ((LAS float*)(L + O_LW))[15 * 64 + c];
#pragma unroll
            for (int j = 0; j < 4; ++j) { const int i = q + 4 * j;
                const float cum = ((LAS float*)(L + O_LW))[i * 64 + c];
                const float Wt = __expf(cum), Wp = __expf(cum - lw[j]), Wi = __expf(-cum), Wc = __expf(cumC - cum);
                const float kd = vk[j] * (1.f + (av[j] - 1.f) * kac), bb = vkk[j] * av[j];
                const unsigned p0 = cvtpk(vkk[j] * Wp, vr[j] * Wt), p1 = cvtpk(bb * Wi, kd * Wi), p2 = cvtpk(vv[j], bb * Wc), p3 = cvtpk(kd * Wc, 0.f);
                *(LAS unsigned short*)(L + O_KKT + i * S64 + c * 2) = (unsigned short)p0; *(LAS unsigned short*)(L + O_RT + i * S64 + c * 2) = (unsigned short)(p0 >> 16);
                *(LAS unsigned short*)(L + O_BT + i * S64 + c * 2) = (unsigned short)p1; *(LAS unsigned short*)(L + O_KDT + i * S64 + c * 2) = (unsigned short)(p1 >> 16);
                *(LAS unsigned short*)(L + O_VT + c * S32 + i * 2) = (unsigned short)p2; *(LAS unsigned short*)(L + O_BHT + c * S32 + i * 2) = (unsigned short)(p2 >> 16);
                *(LAS unsigned short*)(L + O_KHT + c * S32 + i * 2) = (unsigned short)p3;
                const float bs = wave_sum(vr[j] * kd * rkc);
                if (!isctx && lane == 0) { const int t = dir ? (T - 1 - (sbase + i)) : (sbase + i); bon[((size_t)b * SEQ + t) * 8 + h] = bs; }
            }
            if (q == 3) ((LAS float*)(L + O_WC))[c] = __expf(cumC);
        }
        __syncthreads();
        {
            const lbyte* Aj = L + ((q & 1) ? O_KDT : O_BT);
            const lbyte* Bt = L + ((q & 2) ? O_RT : O_KKT);
            f32x4 g4 = mm_tile<2>(Aj, S64, Bt, S64, (f32x4){0.f, 0.f, 0.f, 0.f}, lane);
#pragma unroll
            for (int e = 0; e < 4; ++e) { const int j = 4 * fg + e; const bool keep = (q & 2) ? (j <= fr) : (j < fr); g4[e] = keep ? g4[e] : 0.f; }
            if (q == 0) { float X[16]; tri_inv16(g4, lane, X);
                if (lane < 16) {
#pragma unroll
                    for (int i = 0; i < 16; ++i) *(LAS unsigned short*)(L + O_TI + i * S32 + lane * 2) = (unsigned short)cvtpk(X[i], 0.f); } }
            else st_bf16x4(L + (q == 1 ? O_MK : (q == 2 ? O_NB : O_NK)) + fr * S32 + fg * 8, g4);
        }
        __syncthreads();
        f32x4 yacc;
        {
            f32x4 u4 = mm_tile<2>(L + O_KKT, S64, L + O_SBF + 16 * q * S64, S64, (f32x4){0.f, 0.f, 0.f, 0.f}, lane);
            u4 = mm_tile<1>(L + O_MK, S32, L + O_VT + 16 * q * S32, S32, u4, lane);
            st_bf16x4(L + O_UTT + (16 * q + fr) * S32 + fg * 8, u4);
            yacc = mm_tile<2>(L + O_SBF + 16 * q * S64, S64, L + O_RT, S64, (f32x4){0.f, 0.f, 0.f, 0.f}, lane);
            yacc = mm_tile<1>(L + O_VT + 16 * q * S32, S32, L + O_NK, S32, yacc, lane);
        }
        asm volatile("s_waitcnt lgkmcnt(0)" ::: "memory");
        {
            f32x4 u4 = mm_tile<1>(L + O_TI, S32, L + O_UTT + 16 * q * S32, S32, (f32x4){0.f, 0.f, 0.f, 0.f}, lane);
            st_bf16x4(L + O_UT + (16 * q + fr) * S32 + fg * 8, -u4);
        }
        __syncthreads();
        {
            yacc = mm_tile<1>(L + O_UT + 16 * q * S32, S32, L + O_NB, S32, yacc, lane);
            if (!isctx) { const int t = dir ? (T - 1 - (sbase + fr)) : (sbase + fr);
                u32x2 w; w.x = cvtpk(yacc[0], yacc[1]); w.y = cvtpk(yacc[2], yacc[3]);
                *(u32x2*)(ydir + ((size_t)b * SEQ + t) * D + 64 * h + 16 * q + 4 * fg) = w; }
            const f32x4 wc4 = *(LAS f32x4*)(L + O_WC + (16 * q + 4 * fg) * 4);
#pragma unroll
            for (int vi = 0; vi < 4; ++vi) {
                f32x4 s4 = Sacc[vi] * wc4;
                s4 = mm_tile<1>(L + O_KHT + 16 * q * S32, S32, L + O_VT + 16 * vi * S32, S32, s4, lane);
                s4 = mm_tile<1>(L + O_BHT + 16 * q * S32, S32, L + O_UT + 16 * vi * S32, S32, s4, lane);
                Sacc[vi] = s4;
                st_bf16x4(L + O_SBF + (16 * vi + fr) * S64 + (16 * q + 4 * fg) * 2, s4);
            }
        }
    }
    __syncthreads();
}

__device__ __forceinline__ void phase_gdn_prep(const Args& A, Ctx& C) {
    const bf16_t* P = WSP(bf16_t, WS_P);
    bf16_t* QKV = (bf16_t*)A.out; float* NRM = WSP(float, WS_NRM);
    lfloat* part = (lfloat*)C.lds;
    const int tid = C.tid, lane = C.lane, w = C.wave;
    float cw[3][5];
#pragma unroll
    for (int g = 0; g < 3; ++g)
#pragma unroll
        for (int e = 0; e < 5; ++e) cw[g][e] = A.in[I_CONVW][e * 1536 + g * 512 + tid];
    for (int tile = C.bid; tile < NROWS / 16; tile += C.G) {
        const int row0 = tile * 16;
        int T, ta; size_t rowbase;
        if (row0 < NLAT) { T = SEQ; rowbase = (size_t)(row0 >> 11) * SEQ; ta = row0 & (SEQ - 1); } else { T = CTX; const int r = row0 - NLAT; rowbase = (size_t)NLAT + (size_t)(r >> 8) * CTX; ta = r & (CTX - 1); }
        float x[3][20];
#pragma unroll
        for (int e = 0; e < 20; ++e) { const int t = ta - 2 + e; const bool ok = (t >= 0 && t < T); const bf16_t* pr = P + (rowbase + (ok ? t : ta)) * PLD + RW_COLS + tid;
#pragma unroll
            for (int g = 0; g < 3; ++g) { const float xv = bf2f(pr[g * 512]); x[g][e] = ok ? xv : 0.f; } }
        __syncthreads();
#pragma unroll
        for (int i = 0; i < 16; ++i) { float y[3];
#pragma unroll
            for (int g = 0; g < 3; ++g) { float sacc = 0.f;
#pragma unroll
                for (int f = 0; f < 5; ++f) sacc += cw[g][f] * x[g][i + f];
                y[g] = siluf_(sacc); }
            bf16_t* orow = QKV + (rowbase + ta + i) * 1536 + tid;
            orow[0] = (bf16_t)cvtpk(y[0], 0.f); orow[512] = (bf16_t)cvtpk(y[1], 0.f); orow[1024] = (bf16_t)cvtpk(y[2], 0.f);
            const float sq = wave_sum(y[0] * y[0]), sk = wave_sum(y[1] * y[1]);
            if (lane == 0) { part[(i * 8 + w) * 2] = sq; part[(i * 8 + w) * 2 + 1] = sk; } }
        __syncthreads();
        if (tid < 128) { const int i = tid >> 3, sidx = tid & 7, h = sidx & 3, sel = sidx >> 2;
            const float ss = part[(i * 8 + 2 * h) * 2 + sel] + part[(i * 8 + 2 * h + 1) * 2 + sel];
            NRM[(rowbase + ta + i) * 8 + sidx] = __builtin_amdgcn_rsqf(ss + 1e-6f) * (sel ? 1.f : 0.08838834764831845f); }
    }
    __syncthreads();
}

namespace gd {
constexpr int S128 = 288, S32 = 80;
constexpr int O_QR = 0, O_KR = O_QR + 8192, O_KT = O_KR + 8192, O_QT = O_KT + 16 * S128, O_KKT = O_QT + 16 * S128, O_RT = O_KKT + 16 * S128,
              O_VT = O_RT + 16 * S128, O_BHT = O_VT + 128 * S32, O_KHT = O_BHT + 128 * S32, O_UT = O_KHT + 128 * S32, O_UTT = O_UT + 128 * S32,
              O_TI = O_UTT + 128 * S32, O_MK = O_TI + 16 * S32, O_NB = O_MK + 16 * S32, O_NK = O_NB + 16 * S32,
              O_SBF = O_NK + 16 * S32, O_SC = O_SBF + 128 * S128, GD_BYTES = O_SC + 512;
static_assert(GD_BYTES <= LDS_MISC, "gdn LDS");
}
__device__ __forceinline__ void gdn_chain_chunked(const Args& A, Ctx& C, int chain) {
    using namespace gd;
    const int b = chain >> 3, h = (chain >> 1) & 3, dir = chain & 1;
    lbyte* L = C.lds;
    LAS float* SC = (LAS float*)(L + O_SC);
    const bf16_t* P = WSP(bf16_t, WS_P);
    bf16_t* ydir = WSP(bf16_t, WS_YDIR) + (size_t)dir * NLAT * D;
    const int tid = C.tid, lane = C.lane, w = C.wave, fr = lane & 15, fg = lane >> 4;
    const int grp = tid >> 7, idx = tid & 127;
    const int ccol = grp * 512 + 128 * h + idx;
    float cw[5];
#pragma unroll
    for (int e = 0; e < 5; ++e) cw[e] = grp < 3 ? A.in[I_CONVW][e * 1536 + ccol] : 0.f;
    const float Aexp = __expf(A.in[I_ALOG][dir * 4 + h]), dtb = A.in[I_DTB][dir * 4 + h];
    __syncthreads();
#pragma unroll 2
    for (int i = tid; i < (5 * 128 * S32 + 4 * 16 * S32 + 128 * S128) / 4; i += 512) ((LAS unsigned*)(L + O_VT))[i] = 0u;
    f32x4 Sacc[8];
#pragma unroll
    for (int i = 0; i < 8; ++i) Sacc[i] = (f32x4){0.f, 0.f, 0.f, 0.f};
    const bf16_t* QKV = (const bf16_t*)A.out; const float* NRM = WSP(const float, WS_NRM);
    unsigned short rq[4], rk[4], rv[4]; float nq[4], nk[4]; unsigned short raw_al = 0, raw_be = 0;
    auto chunk_geom = [&](int ch, bool& isctx, int& sbase, int& T, size_t& rowbase) { isctx = ch < 16; sbase = isctx ? ch * 16 : (ch - 16) * 16; T = isctx ? CTX : SEQ;
        rowbase = isctx ? (size_t)NLAT + (size_t)b * CTX : (size_t)b * SEQ; };
    auto issue_loads = [&](int ch) { bool isctx; int sbase, T; size_t rowbase; chunk_geom(ch, isctx, sbase, T, rowbase);
#pragma unroll
        for (int j = 0; j < 4; ++j) { const int i = grp + 4 * j; const int t = dir ? (T - 1 - (sbase + i)) : (sbase + i); const size_t row = rowbase + t;
            const bf16_t* qr = QKV + row * 1536 + 128 * h + idx; rq[j] = qr[0]; rk[j] = qr[512]; rv[j] = qr[1024]; nq[j] = NRM[row * 8 + h]; nk[j] = NRM[row * 8 + 4 + h]; }
        if (w == 7 && lane < 16) { const int t = dir ? (T - 1 - (sbase + lane)) : (sbase + lane); const bf16_t* pr = P + (rowbase + t) * PLD + RW_COLS + 2048; raw_al = pr[dir * 4 + h]; raw_be = pr[8 + dir * 4 + h]; } };
    issue_loads(0);
    for (int ch = 0; ch < 144; ++ch) {
        bool isctx; int sbase, T; size_t rowbase; chunk_geom(ch, isctx, sbase, T, rowbase);
        __syncthreads();
        float qv[4], kv[4], vv[4], nqv[4], nkv[4];
#pragma unroll
        for (int j = 0; j < 4; ++j) { qv[j] = bf2f(rq[j]); kv[j] = bf2f(rk[j]); vv[j] = bf2f(rv[j]); nqv[j] = nq[j]; nkv[j] = nk[j]; }
        if (w == 7) {
            const float gi = (lane < 16) ? -Aexp * softplusf_(bf2f(raw_al) + dtb) : 0.f;
            float cum = gi;
            cum += __builtin_bit_cast(float, __builtin_amdgcn_update_dpp(0, __builtin_bit_cast(int, cum), 0x111, 0xf, 0xf, true));
            cum += __builtin_bit_cast(float, __builtin_amdgcn_update_dpp(0, __builtin_bit_cast(int, cum), 0x112, 0xf, 0xf, true));
            cum += __builtin_bit_cast(float, __builtin_amdgcn_update_dpp(0, __builtin_bit_cast(int, cum), 0x114, 0xf, 0xf, true));
            cum += __builtin_bit_cast(float, __builtin_amdgcn_update_dpp(0, __builtin_bit_cast(int, cum), 0x118, 0xf, 0xf, true));
            if (lane < 16) { SC[16 + lane] = sigmoidf_(bf2f(raw_be)); SC[64 + lane + 1] = cum; if (lane == 0) SC[64] = 0.f; }
        }
        if (ch + 1 < 144) issue_loads(ch + 1);
        __syncthreads();
        {
            const int c = idx; const float gcC = SC[64 + 16];
#pragma unroll
            for (int j = 0; j < 4; ++j) { const int i = grp + 4 * j;
                const float kn = kv[j] * nkv[j], qn = qv[j] * nqv[j];
                const float gm = SC[64 + i], gi = SC[64 + i + 1], be = SC[16 + i];
                const unsigned p0 = cvtpk(kn, qn), p1 = cvtpk(kn * __expf(gm), qn * __expf(gi)), p2 = cvtpk(be * kn * __expf(gcC - gm), be * kn * __expf(gcC - gi));
                *(LAS unsigned short*)(L + O_KT + i * S128 + c * 2) = (unsigned short)p0; *(LAS unsigned short*)(L + O_QT + i * S128 + c * 2) = (unsigned short)(p0 >> 16);
                *(LAS unsigned short*)(L + O_KKT + i * S128 + c * 2) = (unsigned short)p1; *(LAS unsigned short*)(L + O_RT + i * S128 + c * 2) = (unsigned short)(p1 >> 16);
                *(LAS unsigned short*)(L + O_BHT + c * S32 + i * 2) = (unsigned short)p2; *(LAS unsigned short*)(L + O_KHT + c * S32 + i * 2) = (unsigned short)(p2 >> 16);
                *(LAS unsigned short*)(L + O_VT + c * S32 + i * 2) = (unsigned short)cvtpk(vv[j], 0.f); }
        }
        __syncthreads();
        if (w < 2) {
            const f32x4 g4 = mm_tile<4>(L + O_KT, S128, L + (w ? O_QT : O_KT), S128, (f32x4){0.f, 0.f, 0.f, 0.f}, lane);
            const float gt = w ? SC[64 + fr + 1] : SC[64 + fr];
            f32x4 m0, m1;
#pragma unroll
            for (int e = 0; e < 4; ++e) { const int j = 4 * fg + e; const bool keep = w ? (j <= fr) : (j < fr);
                const float bj = SC[16 + j] * g4[e];
                m0[e] = keep ? bj * __expf(gt - SC[64 + j]) : 0.f;
                m1[e] = keep ? bj * __expf(gt - SC[64 + j + 1]) : 0.f; }
            if (w == 0) { st_bf16x4(L + O_MK + fr * S32 + fg * 8, m1);
                float X[16]; tri_inv16(m0, lane, X);
                if (lane < 16) {
#pragma unroll
                    for (int i = 0; i < 16; ++i) *(LAS unsigned short*)(L + O_TI + i * S32 + lane * 2) = (unsigned short)cvtpk(X[i], 0.f); } }
            else { st_bf16x4(L + O_NB + fr * S32 + fg * 8, m0); st_bf16x4(L + O_NK + fr * S32 + fg * 8, m1); }
        }
        __syncthreads();
        f32x4 yacc;
        {
            f32x4 u4 = mm_tile<4>(L + O_KKT, S128, L + O_SBF + 16 * w * S128, S128, (f32x4){0.f, 0.f, 0.f, 0.f}, lane);
            u4 = mm_tile<1>(L + O_MK, S32, L + O_VT + 16 * w * S32, S32, u4, lane);
            st_bf16x4(L + O_UTT + (16 * w + fr) * S32 + fg * 8, u4);
            yacc = mm_tile<4>(L + O_SBF + 16 * w * S128, S128, L + O_RT, S128, (f32x4){0.f, 0.f, 0.f, 0.f}, lane);
            yacc = mm_tile<1>(L + O_VT + 16 * w * S32, S32, L + O_NK, S32, yacc, lane);
        }
        asm volatile("s_waitcnt lgkmcnt(0)" ::: "memory");
        {
            const f32x4 u4 = mm_tile<1>(L + O_TI, S32, L + O_UTT + 16 * w * S32, S32, (f32x4){0.f, 0.f, 0.f, 0.f}, lane);
            st_bf16x4(L + O_UT + (16 * w + fr) * S32 + fg * 8, -u4);
        }
        __syncthreads();
        {
            yacc = mm_tile<1>(L + O_UT + 16 * w * S32, S32, L + O_NB, S32, yacc, lane);
            if (!isctx) { const int t = dir ? (T - 1 - (sbase + fr)) : (sbase + fr);
                u32x2 pk; pk.x = cvtpk(yacc[0], yacc[1]); pk.y = cvtpk(yacc[2], yacc[3]);
                *(u32x2*)(ydir + ((size_t)b * SEQ + t) * D + 512 + 128 * h + 16 * w + 4 * fg) = pk; }
            const float wc = __expf(SC[64 + 16]);
#pragma unroll
            for (int vi = 0; vi < 8; ++vi) {
                f32x4 s4 = Sacc[vi] * wc;
                s4 = mm_tile<1>(L + O_KHT + 16 * w * S32, S32, L + O_VT + 16 * vi * S32, S32, s4, lane);
                s4 = mm_tile<1>(L + O_BHT + 16 * w * S32, S32, L + O_UT + 16 * vi * S32, S32, s4, lane);
                Sacc[vi] = s4;
                st_bf16x4(L + O_SBF + (16 * vi + fr) * S128 + (16 * w + 4 * fg) * 2, s4);
            }
        }
    }
    __syncthreads();
}

__device__ __forceinline__ void unpack8(const u32x4 w, float (&f)[8]) { f[0] = bflo(w.x); f[1] = bfhi(w.x); f[2] = bflo(w.y); f[3] = bfhi(w.y); f[4] = bflo(w.z); f[5] = bfhi(w.z); f[6] = bflo(w.w); f[7] = bfhi(w.w); }
__device__ __forceinline__ void phase_p4(const Args& A, Ctx& C) {
    const bf16_t* P = WSP(bf16_t, WS_P);
    const bf16_t* yf = WSP(bf16_t, WS_YDIR); const bf16_t* yb = yf + (size_t)NLAT * D;
    const float* bon = WSP(float, WS_BON);
    bf16_t* ymix = WSP(bf16_t, WS_YMIX);
    lbyte* SGb = C.lds;
    lfloat* GO = (lfloat*)(C.lds + 8192);
    const int tid = C.tid, lane = C.lane, w = C.wave;
    const bf16_t* gupt = WSP(const bf16_t, WS_GUPT);
    const int fr = lane & 15, fg = lane >> 4;
    const int c8 = 8 * lane;
    float lnw[8], lnb[8], ong[8], muv[8];
#pragma unroll
    for (int e = 0; e < 8; ++e) { lnw[e] = A.in[I_LNW][c8 + e]; lnb[e] = A.in[I_LNB][c8 + e]; ong[e] = A.in[I_ONG][(c8 + e) & 127]; muv[e] = A.in[I_MU][1024 + c8 + e]; }
    const int tkA = tid >> 5, lA = 4 * (tid & 31);
    float muA[4];
#pragma unroll
    for (int e = 0; e < 4; ++e) muA[e] = A.in[I_MU][1792 + lA + e];
    const bool vup = (1024 + c8) < 1440;
    for (int tile = C.bid; tile < NLAT / 16; tile += C.G) {
        const int row0 = tile * 16;
        __syncthreads();
        {
            const int row = row0 + tkA, t = row & (SEQ - 1); const bool ok = t < SEQ - 64;
            const u32x2 pw = *(const u32x2*)(P + (size_t)row * PLD + 1792 + lA); const u32x2 sw = *(const u32x2*)(P + (size_t)(row + (ok ? 64 : 0)) * PLD + 1792 + lA);
            const float pv[4] = {bflo(pw.x), bfhi(pw.x), bflo(pw.y), bfhi(pw.y)}; const float sv[4] = {bflo(sw.x), bfhi(sw.x), bflo(sw.y), bfhi(sw.y)};
            float o[4];
#pragma unroll
            for (int e = 0; e < 4; ++e) o[e] = sigmoidf_(pv[e] + muA[e] * ((ok ? sv[e] : 0.f) - pv[e]));
            u32x2 ow; ow.x = cvtpk(o[0], o[1]); ow.y = cvtpk(o[2], o[3]); *(LAS u32x2*)(SGb + tkA * 288 + lA * 2) = ow;
        }
        __syncthreads();
#pragma unroll
        for (int i = 0; i < 4; ++i) { const int c0 = 64 * w + 16 * i; f32x4 acc = (f32x4){0.f, 0.f, 0.f, 0.f};
#pragma unroll
            for (int ks = 0; ks < 4; ++ks) { const bf16x8 a = *(const LAS bf16x8*)(SGb + fr * 288 + ks * 64 + fg * 16);
                const bf16x8 bq = *(const bf16x8*)(gupt + (size_t)(c0 + fr) * 128 + ks * 32 + fg * 8);
                acc = __builtin_amdgcn_mfma_f32_16x16x32_bf16(a, bq, acc, 0, 0, 0); }
#pragma unroll
            for (int e = 0; e < 4; ++e) GO[(4 * fg + e) * 512 + c0 + fr] = acc[e]; }
        __syncthreads();
#pragma unroll
        for (int tt = 0; tt < 2; ++tt) {
            const int tk = 2 * w + tt, row = row0 + tk, t = row & (SEQ - 1);
            const bool okv = vup ? (t >= 64) : (t < SEQ - 64);
            const u32x4 wyf = *(const u32x4*)(yf + (size_t)row * D + c8), wyb = *(const u32x4*)(yb + (size_t)row * D + c8);
            const u32x4 wpv = *(const u32x4*)(P + (size_t)row * PLD + 1024 + c8), wsv = *(const u32x4*)(P + (size_t)(row + (okv ? (vup ? -64 : 64) : 0)) * PLD + 1024 + c8);
            const u32x4 wof = *(const u32x4*)(yf + (size_t)row * D + 512 + c8), wob = *(const u32x4*)(yb + (size_t)row * D + 512 + c8);
            const u32x4 wz = *(const u32x4*)(P + (size_t)row * PLD + RW_COLS + 1536 + c8);
            const float bs = bon[(size_t)row * 8 + (lane >> 3)] + bon[((size_t)NLAT + row) * 8 + (lane >> 3)];
            const f32x4 g0 = *(const LAS f32x4*)(GO + tk * 512 + c8), g1 = *(const LAS f32x4*)(GO + tk * 512 + c8 + 4);
            const float gg[8] = {g0.x, g0.y, g0.z, g0.w, g1.x, g1.y, g1.z, g1.w};
            float a[8], bq[8], pv[8], sv[8], y[8];
            unpack8(wyf, a); unpack8(wyb, bq); unpack8(wpv, pv); unpack8(wsv, sv);
            float s1 = 0.f;
#pragma unroll
            for (int e = 0; e < 8; ++e) { y[e] = a[e] + bq[e]; s1 += y[e]; }
            s1 += __shfl_xor(s1, 1); s1 += __shfl_xor(s1, 2); s1 += __shfl_xor(s1, 4);
            const float m = s1 * (1.f / 64.f);
            float s2 = 0.f;
#pragma unroll
            for (int e = 0; e < 8; ++e) { y[e] -= m; s2 += y[e] * y[e]; }
            s2 += __shfl_xor(s2, 1); s2 += __shfl_xor(s2, 2); s2 += __shfl_xor(s2, 4);
            const float rs = __builtin_amdgcn_rsqf(s2 * (1.f / 64.f) + RWKV_EPS);
            float o[8];
#pragma unroll
            for (int e = 0; e < 8; ++e) { const float vv = pv[e] + muv[e] * ((okv ? sv[e] : 0.f) - pv[e]); o[e] = (y[e] * rs * lnw[e] + lnb[e] + bs * vv) * gg[e]; }
            u32x4 ow; ow.x = cvtpk(o[0], o[1]); ow.y = cvtpk(o[2], o[3]); ow.z = cvtpk(o[4], o[5]); ow.w = cvtpk(o[6], o[7]);
            *(u32x4*)(ymix + (size_t)row * D + c8) = ow;
            float of[8], ob[8], z[8];
            unpack8(wof, of); unpack8(wob, ob); unpack8(wz, z);
            float s3 = 0.f;
#pragma unroll
            for (int e = 0; e < 8; ++e) { of[e] += ob[e]; s3 += of[e] * of[e]; }
            s3 += __shfl_xor(s3, 1); s3 += __shfl_xor(s3, 2); s3 += __shfl_xor(s3, 4); s3 += __shfl_xor(s3, 8);
            const float rg = __builtin_amdgcn_rsqf(s3 * (1.f / 128.f) + NORM_EPS);
#pragma unroll
            for (int e = 0; e < 8; ++e) o[e] = of[e] * rg * ong[e] * siluf_(z[e]);
            ow.x = cvtpk(o[0], o[1]); ow.y = cvtpk(o[2], o[3]); ow.z = cvtpk(o[4], o[5]); ow.w = cvtpk(o[6], o[7]);
            *(u32x4*)(ymix + (size_t)row * D + 512 + c8) = ow;
        }
    }
}

__device__ __forceinline__ void convert_experts(const Args& A, Ctx& C) {
    lfloat* scr = (lfloat*)(C.lds + C.wave * 16384);
    const int gw = C.bid * 8 + C.wave, NGW = C.G * 8;
    constexpr int I13 = (D / 64) * (DE / 32);
    constexpr int I2 = (DE / 64) * (D / 32);
    constexpr int PER = 2 * I13 + I2;
    for (int it = gw; it < 257 * PER; it += NGW) {
        const int e = it / PER; int r = it % PER;
        unsigned char* bt13 = A.ws + WS_WEXP + (size_t)e * WEXP_STRIDE; unsigned char* bt2 = bt13 + 512 * 1024;
        const float* w1 = e < NE ? A.in[I_EW1] + (size_t)e * D * DE : A.in[I_SW1];
        const float* w3 = e < NE ? A.in[I_EW3] + (size_t)e * D * DE : A.in[I_SW3];
        const float* w2 = e < NE ? A.in[I_EW2] + (size_t)e * DE * D : A.in[I_SW2];
        if (r < I13) { transpose_item_fp8(w1, D, DE, bt13, RowGLU{0}, SW13, scr, r, C.lane); continue; } r -= I13;
        if (r < I13) { transpose_item_fp8(w3, D, DE, bt13, RowGLU{128}, SW13, scr, r, C.lane); continue; } r -= I13;
        transpose_item_fp8(w2, DE, D, bt2, RowId(), SW2, scr, r, C.lane);
    }
}

__device__ __forceinline__ void phase_p6(const Args& A, Ctx& C) {
    const float* mod = WSP(float, WS_MOD); bf16_t* h2n = WSP(bf16_t, WS_H2N);
    const int gw = C.bid * 8 + C.wave, NGW = C.G * 8;
    for (int row = gw; row < NLAT; row += NGW) {
        const float* m = mod + (size_t)(row >> 11) * MODW;
        norm_mod_row(A.out + (size_t)row * D, A.in[I_N2G], m + 4 * D, m + 3 * D, h2n + (size_t)row * D, C.lane, (unsigned*)(A.ws + WS_H2N8) + (size_t)row * (D / 4));
    }
}

__device__ __forceinline__ void phase_p8(const Args& A, Ctx& C) {
    const float* logit = WSP(float, WS_LOGIT);
    int* tope = WSP(int, WS_TOPE); float* topw = WSP(float, WS_TOPW); int* pos = WSP(int, WS_POS);
    unsigned* cnt = WSP(unsigned, WS_CTL) + CW_CNT;
    const int gw = C.bid * 8 + C.wave, NGW = C.G * 8, lane = C.lane;
    const f32x4 rb = ((const f32x4*)A.in[I_RB])[lane];
    for (int tok = gw; tok < NLAT; tok += NGW) {
        const f32x4 lg = ((const f32x4*)(logit + (size_t)tok * NE))[lane];
        float s[4], sel[4];
#pragma unroll
        for (int i = 0; i < 4; ++i) { s[i] = sigmoidf_(lg[i]); sel[i] = s[i] + rb[i]; }
        float m1 = fmaxf(fmaxf(sel[0], sel[1]), fmaxf(sel[2], sel[3]));
        float m2;
        {
            float a = fmaxf(sel[0], sel[1]), bq = fminf(sel[0], sel[1]), cq = fmaxf(sel[2], sel[3]), dq = fminf(sel[2], sel[3]);
            m2 = fmaxf(fminf(a, cq), fmaxf(bq, dq)); }
#pragma unroll
        for (int o = 1; o < 8; o <<= 1) { const float o1 = __shfl_xor(m1, o), o2 = __shfl_xor(m2, o);
            const float n1 = fmaxf(m1, o1); const float n2 = fmaxf(fminf(m1, o1), fmaxf(m2, o2)); m1 = n1; m2 = n2; }
        const float gs = m1 + m2;
        const int grp = lane >> 3;
        int rank = 0;
#pragma unroll
        for (int gq = 0; gq < 8; ++gq) { const float og = __shfl(gs, gq * 8); rank += (og > gs || (og == gs && gq < grp)) ? 1 : 0; }
        const bool gsel = rank < 4;
        float cand[4];
#pragma unroll
        for (int i = 0; i < 4; ++i) cand[i] = gsel ? sel[i] : -INFINITY;
        int my_e = 0; float my_w = 0.f; float wsum = 0.f;
#pragma unroll
        for (int r = 0; r < 8; ++r) {
            float bv = cand[0]; int bi = 0;
#pragma unroll
            for (int i = 1; i < 4; ++i) if (cand[i] > bv) { bv = cand[i]; bi = i; }
            int be = lane * 4 + bi;
#define P8_STEP(CTRL) { const float ov = dpp_f<CTRL>(bv); const int oe = __builtin_amdgcn_update_dpp(0, be, CTRL, 0xf, 0xf, false); if (ov > bv || (ov == bv && oe < be)) { bv = ov; be = oe; } }
            P8_STEP(0x128) P8_STEP(0x124) P8_STEP(0x122) P8_STEP(0x121)
#undef P8_STEP
            float gv = rdlane(bv, 0); int ge = __builtin_amdgcn_readlane(be, 0);
#pragma unroll
            for (int rr = 1; rr < 4; ++rr) { const float ov = rdlane(bv, 16 * rr); const int oe = __builtin_amdgcn_readlane(be, 16 * rr); if (ov > gv || (ov == gv && oe < ge)) { gv = ov; ge = oe; } }
            be = ge;
            const int ol = be >> 2, oi = be & 3;
            const float mys = oi == 0 ? s[0] : (oi == 1 ? s[1] : (oi == 2 ? s[2] : s[3]));
            const float ws_ = __shfl(mys, ol);
            if (lane == ol) { if (oi == 0) cand[0] = -INFINITY; else if (oi == 1) cand[1] = -INFINITY; else if (oi == 2) cand[2] = -INFINITY; else cand[3] = -INFINITY; }
            wsum += ws_;
            if (lane == r) { my_e = be; my_w = ws_; }
        }
        if (lane < 8) {
            const float w = my_w / wsum * 2.5f;
            const unsigned p = atomicAdd(cnt + my_e, 1u);
            tope[(size_t)tok * 8 + lane] = my_e; topw[(size_t)tok * 8 + lane] = w; pos[(size_t)tok * 8 + lane] = (int)p;
        }
    }
}

__device__ __forceinline__ void tile_prefix(const Args& A, Ctx& C, LAS int* tb) {
    const unsigned* cnt = WSP(unsigned, WS_CTL) + CW_CNT;
    if (C.tid == 0) { int acc = 0; for (int e = 0; e < NE; ++e) { tb[e] = acc; acc += ((int)cnt[e] + 255) >> 8; } tb[NE] = acc; }
    __syncthreads();
}
__device__ __forceinline__ void phase_p9(const Args& A, Ctx& C) {
    LAS int* tb = (LAS int*)C.lds;
    tile_prefix(A, C, tb);
    const unsigned* cnt = WSP(unsigned, WS_CTL) + CW_CNT;
    const int* tope = WSP(int, WS_TOPE); const float* topw = WSP(float, WS_TOPW); const int* pos = WSP(int, WS_POS);
    int* rowl = WSP(int, WS_ROWL); float* roww = WSP(float, WS_ROWW); int* tile_e = WSP(int, WS_TILEE);
    const int nrt = tb[NE];
    for (int i = C.bid * 512 + C.tid; i < NLAT * 8; i += C.G * 512) { const int e = tope[i]; const int pr = tb[e] * 256 + pos[i]; rowl[pr] = i; roww[pr] = topw[i]; }
    for (int e = C.bid; e < NE; e += C.G) { const int n = (int)cnt[e], nt = tb[e + 1] - tb[e];
        for (int j = n + C.tid; j < nt * 256; j += 512) { rowl[tb[e] * 256 + j] = -1; roww[tb[e] * 256 + j] = 0.f; }
        for (int k = C.tid; k < nt; k += 512) tile_e[tb[e] + k] = e; }
    for (int i = C.bid * 512 + C.tid; i < NLAT; i += C.G * 512) { rowl[nrt * 256 + i] = i; roww[nrt * 256 + i] = 1.f; }
    for (int k = C.bid * 512 + C.tid; k < NLAT / 256; k += C.G * 512) tile_e[nrt + k] = NE;
    __syncthreads();
}

__device__ __forceinline__ void phase_moe(const Args& A, Ctx& C, int dry_shared) {
    LAS int* tb = (LAS int*)(C.lds + 131072);
    LAS int* tbl = tb + 320;
    tile_prefix(A, C, tb);
    pg8::MoeCtx M;
    M.nrt = tb[NE]; M.ntiles = M.nrt + NLAT / 256; M.G = C.G; M.vc = (C.G % 8 == 0) ? (C.bid % 8) * (C.G / 8) + C.bid / 8 : C.bid;
    M.tb = tb; M.tbl = tbl; M.cnt = WSP(unsigned, WS_CTL) + CW_CNT; M.rowl = WSP(int, WS_ROWL); M.roww = WSP(float, WS_ROWW);
    M.wexp = (const char*)(A.ws + WS_WEXP); M.h2n = (const char*)(A.ws + WS_H2N8); M.Hs = (char*)(A.ws + WS_HS) + (size_t)C.bid * 2 * 65536;
    M.Y = (unsigned char*)(A.ws + WS_Y); M.out = A.out; M.mod = WSP(const float, WS_MOD); M.dry_shared = dry_shared;
    pg8::gemm_moe(C.lds, M);
    __syncthreads();
}

__device__ __forceinline__ void phase_final(const Args& A, Ctx& C, float* dst) {
    const int gw = C.bid * 8 + C.wave, NGW = C.G * 8;
    const float* fg = A.in[I_FG]; const float* mod = WSP(const float, WS_MOD);
    const unsigned* Y = (const unsigned*)(A.ws + WS_Y);
    for (int row = gw; row < NLAT; row += NGW) {
        f32x4* xr = (f32x4*)(A.out + (size_t)row * D) + C.lane;
        const f32x4* gt = (const f32x4*)(mod + (size_t)(row >> 11) * MODW + 5 * D) + C.lane;
        const unsigned* yr = Y + (size_t)row * 8 * (D / 4) + C.lane;
        f32x4 v[4]; float s = 0.f;
#pragma unroll
        for (int j = 0; j < 4; ++j) {
            f32x4 a = (f32x4){0.f, 0.f, 0.f, 0.f};
#pragma unroll
            for (int sl = 0; sl < 8; ++sl) { const unsigned w = yr[sl * (D / 4) + 64 * j];
                const f32x2 lo = __builtin_amdgcn_cvt_pk_f32_fp8(w, false), hi = __builtin_amdgcn_cvt_pk_f32_fp8(w, true);
                a.x += lo.x; a.y += lo.y; a.z += hi.x; a.w += hi.y; }
            v[j] = xr[64 * j] + gt[64 * j] * a * (1.f / pg8::YSCALE);
            s += (v[j].x * v[j].x + v[j].y * v[j].y) + (v[j].z * v[j].z + v[j].w * v[j].w); }
        const float rstd = __builtin_amdgcn_rsqf(wave_sum(s) * (1.f / D) + NORM_EPS);
        f32x4* orow = (f32x4*)(dst + (size_t)row * D) + C.lane;
#pragma unroll
        for (int j = 0; j < 4; ++j) orow[64 * j] = v[j] * rstd * ((const f32x4*)fg)[C.lane + 64 * j];
    }
}

constexpr int NPHASE = 13;
__global__ void __launch_bounds__(512, 2) fwd_kernel(Args A) {
    extern __shared__ __attribute__((aligned(16))) unsigned char lds_raw[];
    Ctx C; C.lds = (lbyte*)lds_raw; C.tid = threadIdx.x; C.lane = C.tid & 63; C.wave = __builtin_amdgcn_readfirstlane(C.tid >> 6);
    C.G = gridDim.x; C.bid = blockIdx.x; C.a = &A;
    volatile LAS unsigned* misc = (volatile LAS unsigned*)(C.lds + LDS_MISC);
    if (C.tid < 16) misc[C.tid] = 0u;
    __syncthreads();
    XcdBarrier bar; bar.bar = WSP(unsigned, WS_CTL) + CW_BAR; bar.x = 0; bar.st = nullptr;
    const int lo = A.ph_lo, hi = A.ph_hi;
    const bool multi = (hi - lo) > 1;
    if (multi) bar = xcd_barrier_post(WSP(unsigned, WS_CTL) + CW_BAR, misc);
#ifndef PHASE_MASK
#define PHASE_MASK 0x1FFF
#endif
#define IN(k) (((PHASE_MASK >> (k)) & 1) && lo <= (k) && (k) < hi)
#define SEAM(k) do { if (IN(k) && IN((k) + 1)) xcd_barrier(bar); } while (0)
#ifndef REP_MASK
#define REP_MASK 0
#endif
#define REPS(k) (((REP_MASK >> (k)) & 1) ? 2 : 1)

    if (IN(0)) _Pragma("unroll") for (int rep = 0; rep < REPS(0); ++rep) { phase_p0(A, C); __syncthreads(); } SEAM(0);
    if (IN(1)) _Pragma("unroll") for (int rep = 0; rep < REPS(1); ++rep) { phase_p1(A, C); } SEAM(1);
    if (IN(2)) _Pragma("unroll") for (int rep = 0; rep < REPS(2); ++rep) {
        pg8::Gemm g{WSP(bf16_t, WS_XN), D}; pg8::StaticOrder S; S.init(NROWS, PLD, C.G, C.bid, WSP(bf16_t, WS_BTIN), D, 1);
        pg8::EpiBf16 E{WSP(bf16_t, WS_P), PLD, 1.f / SWIN};
        pg8::gemm_phase<pg8::EpiBf16, pg8::StaticOrder, false, 0, false, true>(C.lds, g, S, E);
    } SEAM(2);
    if (IN(3)) _Pragma("unroll") for (int rep = 0; rep < REPS(3); ++rep) { phase_gdn_prep(A, C); } SEAM(3);
#ifdef PROBE_BARRIERS
    if (multi) for (int kq = 0; kq < PROBE_BARRIERS; ++kq) xcd_barrier(bar);
#endif
    if (IN(4)) {
        for (int ch = C.bid; ch < NB * HB * 2; ch += C.G) gdn_chain_chunked(A, C, ch);
        for (int pr = C.bid; pr < NB * HA; pr += C.G) rwkv_pair_chunked(A, C, pr);
    } SEAM(4);
    if (IN(5)) _Pragma("unroll") for (int rep = 0; rep < REPS(5); ++rep) { phase_p4(A, C); } SEAM(5);
    if (IN(6)) _Pragma("unroll") for (int rep = 0; rep < REPS(6); ++rep) {
        pg8::Gemm g{WSP(bf16_t, WS_YMIX), D}; pg8::StaticOrder S; S.init(NLAT, D, C.G, C.bid, WSP(bf16_t, WS_BTOUT), D);
        pg8::EpiResGate E{A.in[I_X], A.out, WSP(float, WS_MOD), 2 * D};
        pg8::gemm_phase<pg8::EpiResGate, pg8::StaticOrder, false>(C.lds, g, S, E);
    } SEAM(6);
    if (IN(7)) _Pragma("unroll") for (int rep = 0; rep < REPS(7); ++rep) { phase_p6(A, C); __syncthreads(); convert_experts(A, C); __syncthreads(); } SEAM(7);
    if (IN(8)) _Pragma("unroll") for (int rep = 0; rep < REPS(8); ++rep) {
        pg8::Gemm g{WSP(bf16_t, WS_H2N), D}; pg8::StaticOrder S; S.init(NLAT, NE, C.G, C.bid, WSP(bf16_t, WS_BTR), D);
        pg8::EpiF32 E{WSP(float, WS_LOGIT), NE};
        pg8::gemm_phase<pg8::EpiF32, pg8::StaticOrder, false>(C.lds, g, S, E);
    } SEAM(8);
    if (IN(9)) { phase_p8(A, C); } SEAM(9);
    if (IN(10)) _Pragma("unroll") for (int rep = 0; rep < REPS(10); ++rep) { phase_p9(A, C); } SEAM(10);
    if (IN(11)) { phase_moe(A, C, 0); if (REPS(11) > 1) { __syncthreads(); phase_moe(A, C, 1); } } SEAM(11);
    if (IN(12)) { if (REPS(12) > 1) { phase_final(A, C, (float*)(A.ws + WS_WEXP)); __syncthreads(); } phase_final(A, C, A.out); }
#undef IN
#undef SEAM
}

extern "C" void kernel_launch(void* const* d_in, const int* in_sizes, int n_in, void* d_out, int out_size, void* d_ws, size_t ws_size, hipStream_t stream) {
    static int grid = 0;
    if (grid == 0) {
        if (n_in != 34 || out_size != NLAT * D || ws_size < WS_END) { fprintf(stderr, "kernel_launch: unexpected shapes (n_in %d out %d ws %zu need %zu)\n", n_in, out_size, ws_size, (size_t)WS_END); grid = -1; return; }
        int dev = 0, cus = 0;
        if (hipGetDevice(&dev) != hipSuccess || hipDeviceGetAttribute(&cus, hipDeviceAttributeMultiprocessorCount, dev) != hipSuccess) { grid = -1; return; }
        if (hipFuncSetAttribute((const void*)fwd_kernel, hipFuncAttributeMaxDynamicSharedMemorySize, LDS_BYTES) != hipSuccess) { fprintf(stderr, "kernel_launch: hipFuncSetAttribute failed\n"); grid = -1; return; }
        int per_cu = 0;
        if (hipOccupancyMaxActiveBlocksPerMultiprocessor(&per_cu, (const void*)fwd_kernel, 512, LDS_BYTES) != hipSuccess || per_cu < 1) { fprintf(stderr, "kernel_launch: occupancy query says %d\n", per_cu); }
        (void)hipGetLastError();
        grid = cus;
    }
    if (grid < 0) return;
    (void)hipMemsetAsync((char*)d_ws + WS_CTL, 0, CTL_BYTES, stream);
    Args a{};
    for (int i = 0; i < 34; ++i) a.in[i] = (const float*)d_in[i];
    a.out = (float*)d_out; a.ws = (unsigned char*)d_ws;
#if MK_PER_PHASE
    for (int p = 0; p < NPHASE; ++p) { a.ph_lo = p; a.ph_hi = p + 1; hipLaunchKernelGGL(fwd_kernel, dim3(grid), dim3(512), LDS_BYTES, stream, a); }
#else
    a.ph_lo = 0; a.ph_hi = NPHASE; hipLaunchKernelGGL(fwd_kernel, dim3(grid), dim3(512), LDS_BYTES, stream, a);
#endif
}
```

```cpp
#include <hip/hip_runtime.h>
#include <cstdio>
#include <cstdint>

#ifndef MK_PER_PHASE
#define MK_PER_PHASE 0
#endif

#define LAS __attribute__((address_space(3)))
typedef unsigned short bf16_t;
typedef short bf16x8 __attribute__((ext_vector_type(8)));
typedef float f32x4 __attribute__((ext_vector_type(4)));
typedef float f32x2 __attribute__((ext_vector_type(2)));
typedef unsigned u32x4 __attribute__((ext_vector_type(4)));
typedef unsigned u32x2 __attribute__((ext_vector_type(2)));
typedef int i32x4 __attribute__((ext_vector_type(4)));
typedef int i32x8 __attribute__((ext_vector_type(8)));
typedef LAS float lfloat;
typedef LAS unsigned char lbyte;

constexpr int D = 1024, NB = 32, SEQ = 2048, CTX = 256, GW = 64;
constexpr int NLAT = NB * SEQ;
constexpr int NCTX = NB * CTX;
constexpr int NROWS = NLAT + NCTX;
constexpr int DA = 512, HA = 8, NA = 64;
constexpr int RW_COLS = 1920, GD_COLS = 2064, IN_COLS = 3984, PLD = 4096;
constexpr int DB = 512, HB = 4, KB = 128;
constexpr int NE = 256, TOPK = 8, DE = 256;
constexpr int MODW = 6 * D;
constexpr float NORM_EPS = 1e-6f, RWKV_EPS = 64e-5f;
constexpr int MAXTILES = (NLAT * TOPK + NE * 255) / 256 + 1;

constexpr size_t MiB = 1u << 20;
constexpr size_t WS_CTL = 0, CTL_BYTES = 1 * MiB;
constexpr size_t WS_MOD = 1 * MiB;
constexpr size_t WS_BTIN = 2 * MiB, WS_BTOUT = 10 * MiB, WS_BTR = 12 * MiB, WS_BON = 13 * MiB, WS_GUPT = 17 * MiB, WS_NRM = 978 * MiB;
constexpr size_t WS_P = 18 * MiB, WS_XN = 594 * MiB, WS_YDIR = 594 * MiB, WS_YMIX = 850 * MiB;
constexpr size_t WS_H2N8 = 900 * MiB;
constexpr size_t WS_H2N = 18 * MiB, WS_LOGIT = 146 * MiB, WS_TOPE = 210 * MiB, WS_TOPW = 212 * MiB, WS_POS = 214 * MiB, WS_Y = 146 * MiB;
constexpr size_t WS_ROWL = 658 * MiB, WS_ROWW = 661 * MiB, WS_TILEE = 664 * MiB, WS_HS = 672 * MiB, WS_WEXP = 704 * MiB;
constexpr size_t WEXP_STRIDE = (size_t)(512 * 1024 + 1024 * 256);
constexpr float SW13 = 64.f, SW2 = 32.f, SHS = 8.f, SWIN = 32.f;
constexpr size_t WS_END = 1090 * MiB;
static_assert(WS_WEXP + 257 * WEXP_STRIDE <= WS_END && WS_Y + (size_t)NLAT * 8 * D <= WS_ROWL, "ws map");
constexpr int CW_BAR = 4096;
constexpr int CW_CNT = 16384;

constexpr int LDS_BYTES = 159744;
constexpr int LDS_MISC = LDS_BYTES - 64;

__device__ __forceinline__ unsigned f2bf(float f) { unsigned u = __builtin_bit_cast(unsigned, f); return (u + 0x7fffu + ((u >> 16) & 1u)) >> 16; }
typedef __bf16 bf16x2_t __attribute__((ext_vector_type(2)));
__device__ __forceinline__ unsigned cvtpk(float lo, float hi) { f32x2 v = {lo, hi}; return __builtin_bit_cast(unsigned, __builtin_convertvector(v, bf16x2_t)); }
__device__ __forceinline__ unsigned pk2(float lo, float hi) { return cvtpk(lo, hi); }
__device__ __forceinline__ unsigned pk4_fp8(float a, float b, float c, float d) { unsigned w = 0u;
    w = __builtin_amdgcn_cvt_pk_fp8_f32(__builtin_amdgcn_fmed3f(a, -448.f, 448.f), __builtin_amdgcn_fmed3f(b, -448.f, 448.f), w, false);
    w = __builtin_amdgcn_cvt_pk_fp8_f32(__builtin_amdgcn_fmed3f(c, -448.f, 448.f), __builtin_amdgcn_fmed3f(d, -448.f, 448.f), w, true); return w; }
__device__ __forceinline__ float bf2f(unsigned short b) { return __builtin_bit_cast(float, ((unsigned)b) << 16); }
__device__ __forceinline__ float bflo(unsigned w) { return __builtin_bit_cast(float, w << 16); }
__device__ __forceinline__ float bfhi(unsigned w) { return __builtin_bit_cast(float, w & 0xffff0000u); }
template <int CTRL> __device__ __forceinline__ float dpp_f(float v) { return __builtin_bit_cast(float, __builtin_amdgcn_update_dpp(0, __builtin_bit_cast(int, v), CTRL, 0xf, 0xf, false)); }
__device__ __forceinline__ float wave_sum(float v) {
    v += dpp_f<0x128>(v);
    v += dpp_f<0x124>(v);
    v += dpp_f<0x122>(v);
    v += dpp_f<0x121>(v);
    const int vi = __builtin_bit_cast(int, v);
    const float r0 = __builtin_bit_cast(float, __builtin_amdgcn_readlane(vi, 0)), r1 = __builtin_bit_cast(float, __builtin_amdgcn_readlane(vi, 16)),
                r2 = __builtin_bit_cast(float, __builtin_amdgcn_readlane(vi, 32)), r3 = __builtin_bit_cast(float, __builtin_amdgcn_readlane(vi, 48));
    return (r0 + r1) + (r2 + r3);
}
__device__ __forceinline__ float sigmoidf_(float x) { return __builtin_amdgcn_rcpf(1.f + __expf(-x)); }
__device__ __forceinline__ float siluf_(float x) { return x * __builtin_amdgcn_rcpf(1.f + __expf(-x)); }
__device__ __forceinline__ float softplusf_(float x) { return fmaxf(x, 0.f) + __logf(1.f + __expf(-fabsf(x))); }
__device__ __forceinline__ float tanhf_(float x) { const float e = __expf(-2.f * fabsf(x)); const float t = (1.f - e) * __builtin_amdgcn_rcpf(1.f + e); return x < 0.f ? -t : t; }

#define XB_TMO      128
#define XB_XCNT(j)  (256  + 64 * (j))
#define XB_XSUB(j)  (1280 + 64 * (j))
#define XB_XGEN(j)  (2304 + 64 * (j))
#define XB_TOP      3328
#define XB_TOPGEN   3392
#define XCD_BAR_WORDS 3456
#define XB_SPIN_CAP (1u << 22)
__device__ __forceinline__ unsigned xb_ld(unsigned* p)              { return __hip_atomic_load(p, __ATOMIC_RELAXED, __HIP_MEMORY_SCOPE_AGENT); }
__device__ __forceinline__ unsigned xb_add(unsigned* p, unsigned v) { return __hip_atomic_fetch_add(p, v, __ATOMIC_RELAXED, __HIP_MEMORY_SCOPE_AGENT); }
__device__ __forceinline__ unsigned xb_xcc_id() { return (unsigned)__builtin_amdgcn_s_getreg((3 << 11) | 20) & 0xFu; }
#define XB_SPIN(cond, bar) do { unsigned _sp = 0; while (cond) { __builtin_amdgcn_s_sleep(1); \
    if ((++_sp & 255u) == 0u) { if (xb_ld(&(bar)[XB_TMO])) break; if (_sp > XB_SPIN_CAP) { atomicAdd(&(bar)[XB_TMO], 1u); break; } } } } while (0)
struct XcdBarrier { unsigned* bar; unsigned x; volatile LAS unsigned* st; };
__device__ __forceinline__ XcdBarrier xcd_barrier_post(unsigned* bar, volatile LAS unsigned* st) {
    XcdBarrier b; b.bar = bar; b.x = xb_xcc_id(); b.st = st;
    if (threadIdx.x == 0) (void)xb_add(&bar[XB_XCNT(b.x)], 1u);
    return b;
}
__device__ __forceinline__ void xcd_barrier_complete(unsigned* bar, unsigned x, unsigned& nloc, unsigned& nx) {
    const unsigned G = gridDim.x * gridDim.y * gridDim.z;
    unsigned sum, cnt, mine, sp = 0u;
    for (;;) {
        sum = 0u; cnt = 0u; mine = 0u;
#pragma unroll
        for (unsigned j = 0; j < 16; ++j) { const unsigned c = xb_ld(&bar[XB_XCNT(j)]); sum += c; cnt += (c > 0u) ? 1u : 0u; mine = (j == x) ? c : mine; }
        if (sum == G) break;
        __builtin_amdgcn_s_sleep(1);
        if ((++sp & 255u) == 0u) { if (xb_ld(&bar[XB_TMO])) break; if (sp > XB_SPIN_CAP) { atomicAdd(&bar[XB_TMO], 1u); break; } }
    }
    nloc = mine > 0u ? mine : 1u; nx = cnt > 0u ? cnt : 1u;
}
__device__ __forceinline__ void xcd_barrier(const XcdBarrier& b) {
    asm volatile("s_waitcnt vmcnt(0)" ::: "memory");
    __syncthreads();
    if (threadIdx.x == 0) {
        unsigned* bar = b.bar;
        __builtin_amdgcn_s_waitcnt(0);
        unsigned nloc = b.st[0], nx = b.st[1];
        if (nloc == 0u) { xcd_barrier_complete(bar, b.x, nloc, nx); b.st[0] = nloc; b.st[1] = nx; }
        const unsigned old = xb_add(&bar[XB_XSUB(b.x)], 1u);
        const unsigned gen = old / nloc;
        if (old + 1u == (gen + 1u) * nloc) {
            __builtin_amdgcn_fence(__ATOMIC_RELEASE, "agent");
            asm volatile("s_waitcnt vmcnt(0)" ::: "memory");
            const unsigned og = xb_add(&bar[XB_TOP], 1u);
            const unsigned tg = og / nx;
            if (og + 1u == (tg + 1u) * nx) xb_add(&bar[XB_TOPGEN], 1u);
            else XB_SPIN(xb_ld(&bar[XB_TOPGEN]) == tg, bar);
            __builtin_amdgcn_fence(__ATOMIC_ACQUIRE, "agent");
            xb_add(&bar[XB_XGEN(b.x)], 1u);
            asm volatile("s_waitcnt vmcnt(0)" ::: "memory");
        } else {
            XB_SPIN(xb_ld(&bar[XB_XGEN(b.x)]) == gen, bar);
            __builtin_amdgcn_fence(__ATOMIC_ACQUIRE, "agent");
            asm volatile("s_waitcnt vmcnt(0)" ::: "memory");
        }
    }
    __syncthreads();
}

struct Args {
    const float* in[34];
    float* out;
    unsigned char* ws;
    int ph_lo, ph_hi;
};
enum { I_X = 0, I_C, I_CTX, I_CCTX, I_WADA, I_BADA, I_N1G, I_WIN, I_MU, I_W0, I_WUP, I_A0, I_AUP, I_GUP, I_KK, I_KA, I_RK, I_LNW, I_LNB,
       I_CONVW, I_ALOG, I_DTB, I_ONG, I_WOUT, I_N2G, I_RW, I_RB, I_EW1, I_EW3, I_EW2, I_SW1, I_SW3, I_SW2, I_FG };

namespace pg8 {
constexpr int BM = 256, BK = 64, HALF = 128, HTB = HALF * BK * 2, STAGE_BYTES = 8 * HTB, NXCD = 8, WGM = 8;
__host__ __device__ __forceinline__ int lds_byte(int r, int c) { const int st = (r >> 4) * 2 + (c >> 5), rr = r & 15, cc = c & 31, ob = rr * 64 + cc * 2; return st * 1024 + (ob ^ (((ob >> 9) & 1) << 5)); }
__host__ __device__ __forceinline__ void stage_rc(int b, int& R, int& C) { const int st = b / 1024, sb = b % 1024, swz = sb ^ (((sb >> 9) & 1) << 5); R = (st >> 1) * 16 + swz / 64; C = (st & 1) * 32 + (swz % 64) / 2; }
__host__ __device__ __forceinline__ int perm32(int rho) { const int n = rho >> 4, i = rho & 15; return 8 * (i >> 2) + 4 * n + (i & 3); }
struct Unit { int pm, pn; };
struct Gemm { const bf16_t* A; int K; };
struct StaticOrder {
    int nM, nN, nwg, G, c; const char* Bt; size_t tstepB;
    __device__ void init(int M, int N, int G_, int c_, const void* Bt_, int K, int es = 2) { nM = M / BM; nN = N / BM; nwg = nM * nN; G = G_; c = c_; Bt = (const char*)Bt_; tstepB = (size_t)BM * K * es; }
    __device__ bool next(int i, Unit& u) const {
        const long L = (long)i * G + c; if (L >= nwg) return false;
        int wgid = (int)L; { const int q = nwg / NXCD, r = nwg % NXCD, xcd = wgid % NXCD, off = wgid / NXCD; wgid = (xcd < r ? xcd * (q + 1) : r * (q + 1) + (xcd - r) * q) + off; }
        const int nig = WGM * nN, gid = wgid / nig, fm = gid * WGM, gsz = (nM - fm) < WGM ? (nM - fm) : WGM;
        u.pm = fm + ((wgid % nig) % gsz); u.pn = (wgid % nig) / gsz; return true;
    }
    __device__ __forceinline__ const char* bptr(const Unit& u) const { return Bt + (size_t)u.pn * tstepB; }
    __device__ __forceinline__ int rowsel(const Unit&, int) const { return 0; }
};
struct TileOrder {
    int nunits, npn, G, c; const int* tile_e; const char* wbase; size_t wstride, woff, tstepB; const int* rowl;
    __device__ bool next(int i, Unit& u) const { const int L = i * G + c; if (L >= nunits) return false; u.pm = L / npn; u.pn = L - u.pm * npn; return true; }
    __device__ __forceinline__ const char* bptr(const Unit& u) const { const int e = __builtin_amdgcn_readfirstlane(tile_e[u.pm]); return wbase + (size_t)e * wstride + woff + (size_t)u.pn * tstepB; }
    __device__ __forceinline__ int rowsel(const Unit& u, int r) const { const int t = rowl[(size_t)u.pm * 256 + r]; return t < 0 ? 0 : t; }
};
struct SeqOrder {
    int n; const char* Bt; size_t tstepB; const LAS int* rsel;
    __device__ bool next(int i, Unit& u) const { if (i >= n) return false; u.pm = 0; u.pn = i; return true; }
    __device__ __forceinline__ const char* bptr(const Unit& u) const { return Bt + (size_t)u.pn * tstepB; }
    __device__ __forceinline__ int rowsel(const Unit&, int r) const { return rsel[r]; }
};
__device__ __forceinline__ unsigned cvt_pk_bf16(float lo, float hi) { return cvtpk(lo, hi); }

template <class Epi, class Sched, bool GATHER, int A_AUX = 0, bool ALIGN = true, bool FP8 = false>
__device__ __forceinline__ void gemm_phase(lbyte* lds, const Gemm g, const Sched& S, const Epi& E) {
    int tid_ = threadIdx.x; asm volatile("" : "+v"(tid_));
    const int tid = tid_, wid = __builtin_amdgcn_readfirstlane(tid >> 6), lane = tid & 63, wr = wid >> 2, wc = wid & 3, fr = lane & 15, fq = lane >> 4;
    constexpr unsigned ES = FP8 ? 1u : 2u;
    const int K = g.K, nt = FP8 ? K / 128 : K / BK;
    Unit cur, nxt; int ui = 0;
    if (!S.next(0, cur)) return;
    int Rst[2], Cst[2];
    unsigned voffA[2], voffA1[2], voffB[2], nvA[2], nvA1[2];
#pragma unroll
    for (int i = 0; i < 2; ++i) { int R, C; stage_rc(tid * 16 + i * 8192, R, C); const int Rb = Epi::PERM ? ((R & ~31) + perm32(R & 31)) : R; Rst[i] = R; Cst[i] = C;
        if (GATHER) { voffA[i] = (unsigned)S.rowsel(cur, R) * (unsigned)K * ES + (unsigned)C * 2u; voffA1[i] = (unsigned)S.rowsel(cur, 128 + R) * (unsigned)K * ES + (unsigned)C * 2u; }
        else { voffA[i] = (unsigned)(R * K) * ES + (unsigned)C * 2u; voffA1[i] = voffA[i]; }
        nvA[i] = voffA[i]; nvA1[i] = voffA1[i];
        voffB[i] = (unsigned)(Rb * K) * ES + (unsigned)C * 2u; }
    const size_t kstep = (size_t)(BK * 2);
    const size_t hstep = (size_t)HALF * K * ES;
    const size_t hstepA = GATHER ? 0 : hstep;
    const size_t tstep = 2 * hstep;
    const unsigned ldsw = (unsigned)wid * 1024u;
    const int aoff = lds_byte(wr * 64 + fr, FP8 ? fq * 16 : fq * 8), boff = lds_byte(wc * 32 + fr, FP8 ? fq * 16 : fq * 8);
#define PG8_SA(b, h) (((b) * 2 + (h)) * HTB)
#define PG8_SB(b, h) ((4 + (b) * 2 + (h)) * HTB)
#define PG8_STAGE2(bufoff, gbase, v0, v1) do { \
        __builtin_amdgcn_global_load_lds((const unsigned*)((const char*)(gbase) + (v0)), (LAS unsigned*)(lds + (bufoff) + ldsw), 16, 0, 0); \
        __builtin_amdgcn_global_load_lds((const unsigned*)((const char*)(gbase) + (v1)), (LAS unsigned*)(lds + (bufoff) + ldsw + 8192), 16, 0, 0); } while (0)
#define PG8_STAGE2A(bufoff, gbase, v0, v1) do { if constexpr (A_AUX == 16) { \
        __builtin_amdgcn_global_load_lds((const unsigned*)((const char*)(gbase) + (v0)), (LAS unsigned*)(lds + (bufoff) + ldsw), 16, 0, 16); \
        __builtin_amdgcn_global_load_lds((const unsigned*)((const char*)(gbase) + (v1)), (LAS unsigned*)(lds + (bufoff) + ldsw + 8192), 16, 0, 16); } else { PG8_STAGE2(bufoff, gbase, v0, v1); } } while (0)
#define PG8_STAGE(bufoff, gbase, voff) PG8_STAGE2(bufoff, gbase, (voff)[0], (voff)[1])
#define PG8_STAGEA(bufoff, gbase, voff) PG8_STAGE2A(bufoff, gbase, (voff)[0], (voff)[1])
#define G_LD32(p) __builtin_shufflevector(*(const LAS i32x4*)(p), *(const LAS i32x4*)((p) + 16), 0, 1, 2, 3, 4, 5, 6, 7)
#define G_MFMA8(c, a, b) asm volatile("v_mfma_scale_f32_16x16x128_f8f6f4 %0, %1, %2, %0, %3, %3 op_sel_hi:[0,0,0]" : "+v"(c) : "v"(a), "v"(b), "v"(one_scale))
#define PG8_LDA(dst, b, h) do { if constexpr (FP8) { _Pragma("unroll") for (int m = 0; m < 4; ++m) dst##8[m] = G_LD32(lds + PG8_SA(b, h) + aoff + m * 2048); } else { \
        _Pragma("unroll") for (int m = 0; m < 4; ++m) _Pragma("unroll") for (int k = 0; k < 2; ++k) dst[m][k] = *(const LAS bf16x8*)(lds + PG8_SA(b, h) + aoff + m * 2048 + k * 1024); } } while (0)
#define PG8_LDB(dst, b, h) do { if constexpr (FP8) { _Pragma("unroll") for (int n = 0; n < 2; ++n) dst##8[n] = G_LD32(lds + PG8_SB(b, h) + boff + n * 2048); } else { \
        _Pragma("unroll") for (int n = 0; n < 2; ++n) _Pragma("unroll") for (int k = 0; k < 2; ++k) dst[n][k] = *(const LAS bf16x8*)(lds + PG8_SB(b, h) + boff + n * 2048 + k * 1024); } } while (0)
#define PG8_MMA(ai, bj, At, Bt) do { __builtin_amdgcn_s_setprio(1); if constexpr (FP8) { _Pragma("unroll") for (int m = 0; m < 4; ++m) _Pragma("unroll") for (int n = 0; n < 2; ++n) G_MFMA8(acc[ai][bj][m][n], Bt##8[n], At##8[m]); } else { \
        _Pragma("unroll") for (int m = 0; m < 4; ++m) _Pragma("unroll") for (int n = 0; n < 2; ++n) _Pragma("unroll") for (int k = 0; k < 2; ++k) \
        acc[ai][bj][m][n] = __builtin_amdgcn_mfma_f32_16x16x32_bf16(Bt[n][k], At[m][k], acc[ai][bj][m][n], 0, 0, 0); } __builtin_amdgcn_s_setprio(0); } while (0)
#define PG8_WAIT_V(n) asm volatile("s_waitcnt vmcnt(" #n ")" ::: "memory")
#define PG8_WAIT_L(n) asm volatile("s_waitcnt lgkmcnt(" #n ")" ::: "memory")
#define PG8_BAR __builtin_amdgcn_s_barrier()
#define PG8_SCHED __builtin_amdgcn_sched_barrier(0)
    f32x4 acc[2][2][4][2];
#pragma unroll
    for (int a = 0; a < 2; ++a)
#pragma unroll
        for (int b = 0; b < 2; ++b)
#pragma unroll
            for (int m = 0; m < 4; ++m)
#pragma unroll
                for (int n = 0; n < 2; ++n) acc[a][b][m][n] = (f32x4){0.f, 0.f, 0.f, 0.f};
    bf16x8 At[4][2], B0[2][2], B1[2][2]; i32x8 At8[4], B08[2], B18[2];
    int one_scale = 0x7F7F7F7F; asm volatile("" : "+v"(one_scale));
    const char* cA = (const char*)g.A + (GATHER ? (size_t)0 : (size_t)cur.pm * tstep); const char* cB = S.bptr(cur);
    PG8_STAGE(PG8_SB(0, 0), cB, voffB); PG8_STAGE(PG8_SB(0, 1), cB + hstep, voffB); PG8_STAGEA(PG8_SA(0, 0), cA, voffA); PG8_STAGEA(PG8_SA(0, 1), cA + hstepA, voffA1);
    if (wr == 1) PG8_BAR;
    PG8_WAIT_V(2); PG8_BAR;
    PG8_STAGE(PG8_SB(1, 0), cB + kstep, voffB); PG8_STAGEA(PG8_SA(1, 0), cA + kstep, voffA); PG8_STAGE(PG8_SB(1, 1), cB + hstep + kstep, voffB);
    PG8_WAIT_V(6); PG8_BAR;
    for (;;) {
        const bool has_next = S.next(ui + 1, nxt);
        const char* nA = has_next ? (const char*)g.A + (GATHER ? (size_t)0 : (size_t)nxt.pm * tstep) : cA; const char* nB = has_next ? S.bptr(nxt) : cB;
        for (int t = 0; t < nt; t += 2) {
            const bool last = (t == nt - 2);
            const char* a1 = cA + (size_t)(t + 1) * kstep;
            const char* a2 = last ? nA : cA + (size_t)(t + 2) * kstep; const char* b2 = last ? nB : cB + (size_t)(t + 2) * kstep;
            const char* a3 = a2 + kstep; const char* b3 = b2 + kstep;
            if (GATHER && last && has_next) {
#pragma unroll
                for (int i = 0; i < 2; ++i) { nvA[i] = (unsigned)S.rowsel(nxt, Rst[i]) * (unsigned)K * ES + (unsigned)Cst[i] * 2u; nvA1[i] = (unsigned)S.rowsel(nxt, 128 + Rst[i]) * (unsigned)K * ES + (unsigned)Cst[i] * 2u; }
            }
            const unsigned x0 = (GATHER && last) ? nvA[0] : voffA[0], x1 = (GATHER && last) ? nvA[1] : voffA[1];
            const unsigned y0 = (GATHER && last) ? nvA1[0] : voffA1[0], y1 = (GATHER && last) ? nvA1[1] : voffA1[1];
            PG8_LDB(B0, 0, 0); PG8_LDB(B1, 0, 1); PG8_SCHED; PG8_LDA(At, 0, 0); PG8_STAGEA(PG8_SA(1, 1), a1 + hstepA, voffA1);
            PG8_WAIT_V(8); PG8_WAIT_L(0); PG8_BAR; PG8_MMA(0, 0, At, B0); PG8_MMA(0, 1, At, B1); PG8_BAR; PG8_SCHED;
            PG8_LDA(At, 0, 1); PG8_STAGE(PG8_SB(0, 0), b2, voffB); PG8_STAGE(PG8_SB(0, 1), b2 + hstep, voffB); PG8_STAGE2A(PG8_SA(0, 0), a2, x0, x1);
            PG8_WAIT_V(8); PG8_WAIT_L(0); PG8_BAR; PG8_MMA(1, 0, At, B0); PG8_MMA(1, 1, At, B1); PG8_BAR; PG8_SCHED;
            PG8_LDB(B0, 1, 0); PG8_LDB(B1, 1, 1); PG8_SCHED; PG8_LDA(At, 1, 0); PG8_STAGE2A(PG8_SA(0, 1), a2 + hstepA, y0, y1);
            PG8_WAIT_V(8); PG8_WAIT_L(0); PG8_BAR; PG8_MMA(0, 0, At, B0); PG8_MMA(0, 1, At, B1); PG8_BAR; PG8_SCHED;
            PG8_LDA(At, 1, 1); PG8_STAGE(PG8_SB(1, 0), b3, voffB); PG8_STAGE(PG8_SB(1, 1), b3 + hstep, voffB); PG8_STAGE2A(PG8_SA(1, 0), a3, x0, x1);
            PG8_WAIT_V(8); PG8_WAIT_L(0); PG8_BAR; PG8_MMA(1, 0, At, B0); PG8_MMA(1, 1, At, B1); PG8_BAR; PG8_SCHED;
        }
        if (ALIGN && wr == 0) PG8_BAR;
        if constexpr (FP8) asm volatile("s_nop 15\n\ts_nop 15" ::: "memory");
        E(acc, cur, wr, wc, fr, fq);
        if (!has_next) break;
#pragma unroll
        for (int a = 0; a < 2; ++a)
#pragma unroll
            for (int b = 0; b < 2; ++b)
#pragma unroll
                for (int m = 0; m < 4; ++m)
#pragma unroll
                    for (int n = 0; n < 2; ++n) acc[a][b][m][n] = (f32x4){0.f, 0.f, 0.f, 0.f};
        cur = nxt; cA = nA; cB = nB; ++ui;
        if (GATHER) { voffA[0] = nvA[0]; voffA[1] = nvA[1]; voffA1[0] = nvA1[0]; voffA1[1] = nvA1[1]; }
        if (ALIGN && wr == 1) PG8_BAR;
    }
    PG8_WAIT_V(0);
    if (!ALIGN && wr == 0) PG8_BAR;
    PG8_BAR;
#undef PG8_SA
#undef PG8_SB
#undef PG8_STAGE
#undef PG8_STAGE2
#undef PG8_STAGE2A
#undef PG8_STAGEA
#undef G_LD32
#undef G_MFMA8
#undef PG8_LDA
#undef PG8_LDB
#undef PG8_MMA
#undef PG8_WAIT_V
#undef PG8_WAIT_L
#undef PG8_BAR
#undef PG8_SCHED
}

struct EpiBf16 {
    static constexpr bool PERM = true;
    bf16_t* O; int ldc; float scale;
    __device__ __forceinline__ void operator()(const f32x4 (&acc)[2][2][4][2], const Unit& u, int wr, int wc, int fr, int fq) const {
        const int row0 = u.pm * BM + wr * 64 + fr; const int col0 = u.pn * BM + wc * 32 + 8 * fq;
#pragma unroll
        for (int ai = 0; ai < 2; ++ai)
#pragma unroll
            for (int m = 0; m < 4; ++m) { bf16_t* rowp = O + (size_t)(row0 + ai * HALF + m * 16) * ldc + col0;
#pragma unroll
                for (int bj = 0; bj < 2; ++bj) { const f32x4 v0 = acc[ai][bj][m][0] * scale, v1 = acc[ai][bj][m][1] * scale;
                    u32x4 w; w.x = cvt_pk_bf16(v0[0], v0[1]); w.y = cvt_pk_bf16(v0[2], v0[3]); w.z = cvt_pk_bf16(v1[0], v1[1]); w.w = cvt_pk_bf16(v1[2], v1[3]);
                    *(u32x4*)(rowp + bj * HALF) = w; } }
    }
};
struct EpiF32 {
    static constexpr bool PERM = false;
    float* C; int ldc;
    __device__ __forceinline__ void operator()(const f32x4 (&acc)[2][2][4][2], const Unit& u, int wr, int wc, int fr, int fq) const {
        const int row0 = u.pm * BM + wr * 64 + fr, col0 = u.pn * BM + wc * 32 + 4 * fq;
#pragma unroll
        for (int ai = 0; ai < 2; ++ai)
#pragma unroll
            for (int m = 0; m < 4; ++m) { float* rowp = C + (size_t)(row0 + ai * HALF + m * 16) * ldc + col0;
#pragma unroll
                for (int bj = 0; bj < 2; ++bj)
#pragma unroll
                    for (int n = 0; n < 2; ++n) *(f32x4*)(rowp + bj * HALF + n * 16) = acc[ai][bj][m][n]; }
    }
};
struct EpiResGate {
    static constexpr bool PERM = false;
    const float* x; float* out; const float* mod; int gate_off;
    __device__ __forceinline__ void operator()(const f32x4 (&acc)[2][2][4][2], const Unit& u, int wr, int wc, int fr, int fq) const {
        const int row0 = u.pm * BM + wr * 64 + fr, col0 = u.pn * BM + wc * 32 + 4 * fq;
        const float* gp = mod + (size_t)((u.pm * BM) >> 11) * MODW + gate_off + col0;
        f32x4 gv[2][2];
#pragma unroll
        for (int bj = 0; bj < 2; ++bj)
#pragma unroll
            for (int n = 0; n < 2; ++n) gv[bj][n] = *(const f32x4*)(gp + bj * HALF + n * 16);
#pragma unroll
        for (int ai = 0; ai < 2; ++ai)
#pragma unroll
            for (int m = 0; m < 4; ++m) { const size_t off = (size_t)(row0 + ai * HALF + m * 16) * D + col0;
#pragma unroll
                for (int bj = 0; bj < 2; ++bj)
#pragma unroll
                    for (int n = 0; n < 2; ++n) { const f32x4 xv = *(const f32x4*)(x + off + bj * HALF + n * 16);
                        *(f32x4*)(out + off + bj * HALF + n * 16) = xv + gv[bj][n] * acc[ai][bj][m][n]; }
                asm volatile("" ::: "memory"); }
    }
};
struct EpiGLU {
    static constexpr bool PERM = true;
    bf16_t* H;
    __device__ __forceinline__ void operator()(const f32x4 (&acc)[2][2][4][2], const Unit& u, int wr, int wc, int fr, int fq) const {
        const int row0 = u.pm * BM + wr * 64 + fr; const int col0 = u.pn * 128 + wc * 32 + 8 * fq;
#pragma unroll
        for (int ai = 0; ai < 2; ++ai)
#pragma unroll
            for (int m = 0; m < 4; ++m) { bf16_t* rowp = H + (size_t)(row0 + ai * HALF + m * 16) * 256 + col0;
                f32x4 h0, h1;
#pragma unroll
                for (int j = 0; j < 4; ++j) { const float a0 = acc[ai][0][m][0][j], a1 = acc[ai][0][m][1][j];
                    h0[j] = siluf_(a0) * acc[ai][1][m][0][j]; h1[j] = siluf_(a1) * acc[ai][1][m][1][j]; }
                u32x4 w; w.x = cvt_pk_bf16(h0[0], h0[1]); w.y = cvt_pk_bf16(h0[2], h0[3]); w.z = cvt_pk_bf16(h1[0], h1[1]); w.w = cvt_pk_bf16(h1[2], h1[3]);
                *(u32x4*)rowp = w; }
    }
};
constexpr float YSCALE = 8.f;
struct EpiY {
    static constexpr bool PERM = true;
    unsigned char* Y; float* out; const float* mod; const LAS int* rtok; const LAS float* rw; int shared;
    __device__ __forceinline__ void operator()(const f32x4 (&acc)[2][2][4][2], const Unit& u, int wr, int wc, int fr, int fq) const {
        const int col0 = u.pn * BM + wc * 32 + 8 * fq;
#pragma unroll
        for (int ai = 0; ai < 2; ++ai)
#pragma unroll
            for (int m = 0; m < 4; ++m) { const int r = wr * 64 + fr + ai * HALF + m * 16; const int ts = rtok[r]; const float w = rw[r];
                if (ts >= 0) {
                    if (shared) { const unsigned goff = (unsigned)(ts >> 11) * MODW + 5 * D + col0; const unsigned ooff = (unsigned)ts * D + col0;
#pragma unroll
                        for (int bj = 0; bj < 2; ++bj)
#pragma unroll
                            for (int n = 0; n < 2; ++n) { const f32x4 gv = *(const f32x4*)(mod + goff + bj * HALF + n * 4); f32x4* op = (f32x4*)(out + ooff + bj * HALF + n * 4);
                                *op = *op + gv * acc[ai][bj][m][n]; }
                    } else { unsigned char* yp = Y + (size_t)(unsigned)ts * D + col0; const float ws_ = w * YSCALE;
#pragma unroll
                        for (int bj = 0; bj < 2; ++bj) { f32x4 v0 = acc[ai][bj][m][0] * ws_, v1 = acc[ai][bj][m][1] * ws_;
#pragma unroll
                                for (int j = 0; j < 4; ++j) { v0[j] = __builtin_amdgcn_fmed3f(v0[j], -448.f, 448.f); v1[j] = __builtin_amdgcn_fmed3f(v1[j], -448.f, 448.f); }
                            unsigned lo = 0u, hi = 0u;
                            lo = __builtin_amdgcn_cvt_pk_fp8_f32(v0[0], v0[1], lo, false); lo = __builtin_amdgcn_cvt_pk_fp8_f32(v0[2], v0[3], lo, true);
                            hi = __builtin_amdgcn_cvt_pk_fp8_f32(v1[0], v1[1], hi, false); hi = __builtin_amdgcn_cvt_pk_fp8_f32(v1[2], v1[3], hi, true);
                            u32x2 pk; pk.x = lo; pk.y = hi; *(u32x2*)(yp + bj * HALF) = pk; } } }
                asm volatile("" ::: "memory"); }
    }
};

struct MoeCtx {
    int ntiles, nrt, G, vc;
    const LAS int* tb; LAS int* tbl;
    const unsigned* cnt; const int* rowl; const float* roww;
    const char* wexp; const char* h2n; char* Hs; unsigned char* Y; float* out; const float* mod; int dry_shared;
};
__device__ __forceinline__ void gemm_moe(lbyte* lds, const MoeCtx& M) {
    int tid_ = threadIdx.x; asm volatile("" : "+v"(tid_));
    const int tid = tid_, wid = __builtin_amdgcn_readfirstlane(tid >> 6), lane = tid & 63, wr = wid >> 2, wc = wid & 3, fr = lane & 15, fq = lane >> 4;
    const int ntl = (M.ntiles - M.vc + M.G - 1) / M.G;
    if (M.vc >= M.ntiles) return;
    const int nunits = ntl * 6;
    const unsigned ldsw = (unsigned)wid * 1024u;
    const int aoff = lds_byte(wr * 64 + fr, fq * 16), boff = lds_byte(wc * 32 + fr, fq * 16);
    auto tile_expert = [&](int tile, int& e, int& k) { if (tile < M.nrt) { int lo = 0, hi = NE - 1; while (lo < hi) { const int mid = (lo + hi + 1) >> 1; if (M.tb[mid] <= tile) lo = mid; else hi = mid - 1; } e = lo; k = tile - M.tb[lo]; } else { e = NE; k = tile - M.nrt; } };
    auto fill = [&](int j) { if (j < ntl && tid < 256) { const int tile = M.vc + j * M.G; int e, k; tile_expert(tile, e, k); LAS int* T = M.tbl + (j % 3) * 768;
            int ts; float w;
            if (e < NE) { const int valid = (int)M.cnt[e] - 256 * k; if (tid < valid) { ts = M.rowl[(size_t)tile * 256 + tid]; w = M.roww[(size_t)tile * 256 + tid]; } else { ts = -1; w = 0.f; } T[tid] = ts < 0 ? 0 : (ts >> 3); }
            else { ts = k * 256 + tid; w = 1.f; T[tid] = ts; }
            T[256 + tid] = ts; ((LAS float*)T)[512 + tid] = w; } };
    struct UP { const char* aB; const char* bB; unsigned bh; int nt, kind, pn, slot, shared, e, hbuf, fillnext; };
    auto unit_params = [&](int ui, int prev_e, UP& u, unsigned (&oa)[4], unsigned (&ob)[2]) {
        int tq = threadIdx.x; asm volatile("" : "+v"(tq));
        int Rst[2], Cst[2], Rbp[2];
#pragma unroll
        for (int i = 0; i < 2; ++i) { int R, C; stage_rc(tq * 16 + i * 8192, R, C); Rst[i] = R; Cst[i] = C; Rbp[i] = (R & ~31) + perm32(R & 31); }
        int j, sub;
        if (ui < 2) { j = 0; sub = ui; }
        else { const int qq = ui - 2, g = qq / 6, r = qq - 6 * g; if (g < ntl - 1 && r < 2) { j = g + 1; sub = r; } else { j = g; sub = (g < ntl - 1) ? r : r + 2; } }
        const int tile = M.vc + j * M.G; int e, k;
        if (sub == 0 || sub == 2) tile_expert(tile, e, k); else e = prev_e;
        u.e = e;
        const char* w = M.wexp + (size_t)e * WEXP_STRIDE;
        u.slot = j % 3; u.hbuf = j & 1; u.fillnext = (sub == 1) ? j + 1 : -1; u.shared = (e == NE) ? 1 : 0;
        if (sub < 2) { u.kind = 0; u.pn = sub; u.nt = D / 128; u.aB = M.h2n; u.bB = w + (size_t)sub * 256 * D; u.bh = 128u * D;
            const LAS int* T = M.tbl + (j % 3) * 768;
#pragma unroll
            for (int i = 0; i < 2; ++i) { oa[i] = (unsigned)T[Rst[i]] * (unsigned)D + 2u * (unsigned)Cst[i]; oa[2 + i] = (unsigned)T[128 + Rst[i]] * (unsigned)D + 2u * (unsigned)Cst[i]; ob[i] = (unsigned)(Rbp[i] * D + 2 * Cst[i]); } }
        else { u.kind = 1; u.pn = sub - 2; u.nt = DE / 128; u.aB = M.Hs + (j & 1) * 65536; u.bB = w + (size_t)512 * 1024 + (size_t)(sub - 2) * 256 * DE; u.bh = 128u * DE;
#pragma unroll
            for (int i = 0; i < 2; ++i) { oa[i] = (unsigned)(Rst[i] * DE + 2 * Cst[i]); oa[2 + i] = (unsigned)((128 + Rst[i]) * DE + 2 * Cst[i]); ob[i] = (unsigned)(Rbp[i] * DE + 2 * Cst[i]); } }
    };
#define PG8_SA(b, h) (((b) * 2 + (h)) * HTB)
#define PG8_SB(b, h) ((4 + (b) * 2 + (h)) * HTB)
#define MOE_DMA(bufoff, ptr, aux) __builtin_amdgcn_global_load_lds((const unsigned*)(ptr), (LAS unsigned*)(lds + (bufoff)), 16, 0, aux)
#define MOE_STA(bufoff, base, o0, o1) do { MOE_DMA((bufoff) + ldsw, (base) + (o0), 16); MOE_DMA((bufoff) + ldsw + 8192, (base) + (o1), 16); } while (0)
#define MOE_STAK(kindv, bufoff, base, o0, o1) do { if ((kindv) == 0) { MOE_DMA((bufoff) + ldsw, (base) + (o0), 0); MOE_DMA((bufoff) + ldsw + 8192, (base) + (o1), 0); } else MOE_STA(bufoff, base, o0, o1); } while (0)
#define MOE_STB(bufoff, base, o0, o1) do { MOE_DMA((bufoff) + ldsw, (base) + (o0), 0); MOE_DMA((bufoff) + ldsw + 8192, (base) + (o1), 0); } while (0)
#define MOE_LD32(p) __builtin_shufflevector(*(const LAS i32x4*)(p), *(const LAS i32x4*)((p) + 16), 0, 1, 2, 3, 4, 5, 6, 7)
#define PG8_LDA(dst, b, h) do { _Pragma("unroll") for (int m = 0; m < 4; ++m) dst[m] = MOE_LD32(lds + PG8_SA(b, h) + aoff + m * 2048); } while (0)
#define PG8_LDB(dst, b, h) do { _Pragma("unroll") for (int n = 0; n < 2; ++n) dst[n] = MOE_LD32(lds + PG8_SB(b, h) + boff + n * 2048); } while (0)
#define MOE_MFMA(c, a, b) asm volatile("v_mfma_scale_f32_16x16x128_f8f6f4 %0, %1, %2, %0, %3, %3 op_sel_hi:[0,0,0]" : "+v"(c) : "v"(a), "v"(b), "v"(one_scale))
#define PG8_MMA(ai, bj, At, Bt) do { __builtin_amdgcn_s_setprio(1); _Pragma("unroll") for (int m = 0; m < 4; ++m) _Pragma("unroll") for (int n = 0; n < 2; ++n) \
        MOE_MFMA(acc[ai][bj][m][n], Bt[n], At[m]); __builtin_amdgcn_s_setprio(0); } while (0)
#define PG8_WAIT_V(n) asm volatile("s_waitcnt vmcnt(" #n ")" ::: "memory")
#define PG8_WAIT_L(n) asm volatile("s_waitcnt lgkmcnt(" #n ")" ::: "memory")
#define PG8_BAR __builtin_amdgcn_s_barrier()
#define PG8_SCHED __builtin_amdgcn_sched_barrier(0)
    fill(0);
    asm volatile("s_waitcnt vmcnt(0) lgkmcnt(0)" ::: "memory");
    __syncthreads();
    UP cu, nu; unsigned oa[4], ob[2], na[4], nb[2];
    unit_params(0, 0, cu, oa, ob);
    nu = cu;
#pragma unroll
    for (int i = 0; i < 4; ++i) na[i] = oa[i];
    nb[0] = ob[0]; nb[1] = ob[1];
    f32x4 acc[2][2][4][2];
#pragma unroll
    for (int a = 0; a < 2; ++a)
#pragma unroll
        for (int b = 0; b < 2; ++b)
#pragma unroll
            for (int m = 0; m < 4; ++m)
#pragma unroll
                for (int n = 0; n < 2; ++n) acc[a][b][m][n] = (f32x4){0.f, 0.f, 0.f, 0.f};
    i32x8 At[4], B0[2], B1[2];
    int one_scale = 0x7F7F7F7F; asm volatile("" : "+v"(one_scale));
    const size_t kstep = (size_t)128;
    {   const char* cA = cu.aB; const char* cB = cu.bB;
        MOE_STB(PG8_SB(0, 0), cB, ob[0], ob[1]); MOE_STB(PG8_SB(0, 1), cB + cu.bh, ob[0], ob[1]); MOE_STAK(cu.kind, PG8_SA(0, 0), cA, oa[0], oa[1]); MOE_STAK(cu.kind, PG8_SA(0, 1), cA, oa[2], oa[3]);
        if (wr == 1) PG8_BAR;
        PG8_WAIT_V(2); PG8_BAR;
        MOE_STB(PG8_SB(1, 0), cB + kstep, ob[0], ob[1]); MOE_STAK(cu.kind, PG8_SA(1, 0), cA + kstep, oa[0], oa[1]); MOE_STB(PG8_SB(1, 1), cB + cu.bh + kstep, ob[0], ob[1]);
        PG8_WAIT_V(6); PG8_BAR; }
    for (int ui = 0;; ++ui) {
        const bool has_next = (ui + 1 < nunits);
        if (cu.fillnext >= 0) fill(cu.fillnext);
        const char* cA = cu.aB; const char* cB = cu.bB; const int nt = cu.nt; const unsigned bh = cu.bh;
        for (int t = 0; t < nt; t += 2) {
            const bool last = (t == nt - 2);
            if (last && has_next) unit_params(ui + 1, cu.e, nu, na, nb);
            const char* a1 = cA + (size_t)(t + 1) * kstep;
            const char* a2 = last ? nu.aB : cA + (size_t)(t + 2) * kstep; const char* b2 = last ? nu.bB : cB + (size_t)(t + 2) * kstep;
            const char* a3 = a2 + kstep; const char* b3 = b2 + kstep;
            const unsigned bh2 = last ? nu.bh : bh;
            const unsigned x0 = last ? na[0] : oa[0], x1 = last ? na[1] : oa[1], y0 = last ? na[2] : oa[2], y1 = last ? na[3] : oa[3];
            const unsigned z0 = last ? nb[0] : ob[0], z1 = last ? nb[1] : ob[1];
            const int k2 = last ? nu.kind : cu.kind;
            PG8_LDB(B0, 0, 0); PG8_LDB(B1, 0, 1); PG8_SCHED; PG8_LDA(At, 0, 0); MOE_STAK(cu.kind, PG8_SA(1, 1), a1, oa[2], oa[3]);
            PG8_WAIT_V(8); PG8_WAIT_L(0); PG8_BAR; PG8_MMA(0, 0, At, B0); PG8_MMA(0, 1, At, B1); PG8_BAR; PG8_SCHED;
            PG8_LDA(At, 0, 1); MOE_STB(PG8_SB(0, 0), b2, z0, z1); MOE_STB(PG8_SB(0, 1), b2 + bh2, z0, z1); MOE_STAK(k2, PG8_SA(0, 0), a2, x0, x1);
            PG8_WAIT_V(8); PG8_WAIT_L(0); PG8_BAR; PG8_MMA(1, 0, At, B0); PG8_MMA(1, 1, At, B1); PG8_BAR; PG8_SCHED;
            PG8_LDB(B0, 1, 0); PG8_LDB(B1, 1, 1); PG8_SCHED; PG8_LDA(At, 1, 0); MOE_STAK(k2, PG8_SA(0, 1), a2, y0, y1);
            PG8_WAIT_V(8); PG8_WAIT_L(0); PG8_BAR; PG8_MMA(0, 0, At, B0); PG8_MMA(0, 1, At, B1); PG8_BAR; PG8_SCHED;
            PG8_LDA(At, 1, 1); MOE_STB(PG8_SB(1, 0), b3, z0, z1); MOE_STB(PG8_SB(1, 1), b3 + bh2, z0, z1); MOE_STAK(k2, PG8_SA(1, 0), a3, x0, x1);
            PG8_WAIT_V(8); PG8_WAIT_L(0); PG8_BAR; PG8_MMA(1, 0, At, B0); PG8_MMA(1, 1, At, B1); PG8_BAR; PG8_SCHED;
        }
        if (wr == 0) PG8_BAR;
        asm volatile("s_nop 15\n\ts_nop 15" ::: "memory");
        if (cu.kind == 0) {
            const int row0 = wr * 64 + fr; const int col0 = cu.pn * 128 + wc * 32 + 8 * fq;
            constexpr float is13 = 1.f / SW13;
#pragma unroll
            for (int ai = 0; ai < 2; ++ai)
#pragma unroll
                for (int m = 0; m < 4; ++m) { unsigned char* rowp = (unsigned char*)M.Hs + cu.hbuf * 65536 + (size_t)(row0 + ai * HALF + m * 16) * 256 + col0;
                    f32x4 h0, h1;
#pragma unroll
                    for (int j = 0; j < 4; ++j) { h0[j] = siluf_(acc[ai][0][m][0][j] * is13) * (acc[ai][1][m][0][j] * (is13 * SHS)); h1[j] = siluf_(acc[ai][0][m][1][j] * is13) * (acc[ai][1][m][1][j] * (is13 * SHS)); }
                    u32x2 w; w.x = pk4_fp8(h0[0], h0[1], h0[2], h0[3]); w.y = pk4_fp8(h1[0], h1[1], h1[2], h1[3]);
                    *(u32x2*)rowp = w; }
        } else {
            const LAS int* rtok = M.tbl + cu.slot * 768 + 256; const LAS float* rw = (const LAS float*)(M.tbl + cu.slot * 768 + 512);
            const int col0 = cu.pn * BM + wc * 32 + 8 * fq;
#pragma unroll
            for (int ai = 0; ai < 2; ++ai)
#pragma unroll
                for (int m = 0; m < 4; ++m) { const int r = wr * 64 + fr + ai * HALF + m * 16; const int ts = rtok[r]; const float w = rw[r];
                    if (ts >= 0) {
                        if (cu.shared) { const unsigned goff = (unsigned)(ts >> 11) * MODW + 5 * D + col0; const unsigned ooff = (unsigned)ts * D + col0;
#pragma unroll
                            for (int bj = 0; bj < 2; ++bj)
#pragma unroll
                                for (int n = 0; n < 2; ++n) { const f32x4 gv = *(const f32x4*)(M.mod + goff + bj * HALF + n * 4); f32x4* op = (f32x4*)(M.out + ooff + bj * HALF + n * 4);
                                    const f32x4 nv = *op + gv * acc[ai][bj][m][n] * (1.f / (SHS * SW2)); if (!M.dry_shared) *op = nv; else asm volatile("" :: "v"(nv)); }
                        } else { unsigned char* yp = M.Y + (size_t)(unsigned)ts * D + col0; const float ws_ = w * (YSCALE / (SHS * SW2));
#pragma unroll
                            for (int bj = 0; bj < 2; ++bj) { f32x4 v0 = acc[ai][bj][m][0] * ws_, v1 = acc[ai][bj][m][1] * ws_;
#pragma unroll
                                for (int j = 0; j < 4; ++j) { v0[j] = __builtin_amdgcn_fmed3f(v0[j], -448.f, 448.f); v1[j] = __builtin_amdgcn_fmed3f(v1[j], -448.f, 448.f); }
                                unsigned lo = 0u, hi = 0u;
                                lo = __builtin_amdgcn_cvt_pk_fp8_f32(v0[0], v0[1], lo, false); lo = __builtin_amdgcn_cvt_pk_fp8_f32(v0[2], v0[3], lo, true);
                                hi = __builtin_amdgcn_cvt_pk_fp8_f32(v1[0], v1[1], hi, false); hi = __builtin_amdgcn_cvt_pk_fp8_f32(v1[2], v1[3], hi, true);
                                u32x2 pk; pk.x = lo; pk.y = hi; *(u32x2*)(yp + bj * HALF) = pk; } } }
                    asm volatile("" ::: "memory"); }
        }
        if (!has_next) break;
#pragma unroll
        for (int a = 0; a < 2; ++a)
#pragma unroll
            for (int b = 0; b < 2; ++b)
#pragma unroll
                for (int m = 0; m < 4; ++m)
#pragma unroll
                    for (int n = 0; n < 2; ++n) acc[a][b][m][n] = (f32x4){0.f, 0.f, 0.f, 0.f};
        cu = nu;
#pragma unroll
        for (int i = 0; i < 4; ++i) oa[i] = na[i];
        ob[0] = nb[0]; ob[1] = nb[1];
        if (wr == 1) PG8_BAR;
    }
    PG8_WAIT_V(0);
    PG8_BAR;
#undef PG8_SA
#undef PG8_SB
#undef MOE_DMA
#undef MOE_STA
#undef MOE_STAK
#undef MOE_STB
#undef PG8_LDA
#undef PG8_LDB
#undef MOE_LD32
#undef MOE_MFMA
#undef PG8_MMA
#undef PG8_WAIT_V
#undef PG8_WAIT_L
#undef PG8_BAR
#undef PG8_SCHED
}
}

struct Ctx {
    lbyte* lds; int tid, lane, wave, G, bid;
    const Args* a;
};
#define WSP(T, off) ((T*)(A.ws + (off)))

template <class RowMap>
__device__ __forceinline__ void transpose_item(const float* W, int K, int N, bf16_t* WT, RowMap rowmap, lfloat* scr, int item, int lane) {
    const int nblk = N / 32, kb = item / nblk, nb = item % nblk, k0 = 64 * kb, n0 = 32 * nb;
#pragma unroll 8
    for (int i = 0; i < 32; ++i) { const int kk = 2 * i + (lane >> 5); scr[kk * 33 + (lane & 31)] = W[(size_t)(k0 + kk) * N + n0 + (lane & 31)]; }
    asm volatile("s_waitcnt lgkmcnt(0)" ::: "memory");
    const int c = lane & 7;
#pragma unroll
    for (int j = 0; j < 4; ++j) { const int n = (lane >> 3) + 8 * j; const lfloat* s = scr + (8 * c) * 33 + n;
        u32x4 o; o.x = pk2(s[0 * 33], s[1 * 33]); o.y = pk2(s[2 * 33], s[3 * 33]); o.z = pk2(s[4 * 33], s[5 * 33]); o.w = pk2(s[6 * 33], s[7 * 33]);
        *(u32x4*)(WT + (size_t)rowmap(n0 + n) * K + k0 + 8 * c) = o; }
    asm volatile("s_waitcnt lgkmcnt(0)" ::: "memory");
}
template <class RowMap>
__device__ __forceinline__ void transpose_item_fp8(const float* W, int K, int N, unsigned char* WT, RowMap rowmap, float sc, lfloat* scr, int item, int lane) {
    const int nblk = N / 32, kb = item / nblk, nb = item % nblk, k0 = 64 * kb, n0 = 32 * nb;
#pragma unroll 8
    for (int i = 0; i < 32; ++i) { const int kk = 2 * i + (lane >> 5); scr[kk * 33 + (lane & 31)] = W[(size_t)(k0 + kk) * N + n0 + (lane & 31)] * sc; }
    asm volatile("s_waitcnt lgkmcnt(0)" ::: "memory");
    const int c = lane & 7;
#pragma unroll
    for (int j = 0; j < 4; ++j) { const int n = (lane >> 3) + 8 * j; const lfloat* s = scr + (8 * c) * 33 + n;
        u32x2 o; o.x = pk4_fp8(s[0 * 33], s[1 * 33], s[2 * 33], s[3 * 33]); o.y = pk4_fp8(s[4 * 33], s[5 * 33], s[6 * 33], s[7 * 33]);
        *(u32x2*)(WT + (size_t)rowmap(n0 + n) * K + k0 + 8 * c) = o; }
    asm volatile("s_waitcnt lgkmcnt(0)" ::: "memory");
}
struct RowId { __device__ int operator()(int n) const { return n; } };
struct RowGLU { int base; __device__ int operator()(int n) const { return ((n >> 7) << 8) + base + (n & 127); } };

__device__ __forceinline__ void norm_mod_row(const float* xrow, const float* g, const float* sc, const float* sh, bf16_t* orow, int lane, unsigned* o8row = nullptr) {
    const f32x4* xr = (const f32x4*)xrow + lane;
    f32x4 v[4]; float s = 0.f;
#pragma unroll
    for (int j = 0; j < 4; ++j) { v[j] = xr[64 * j]; s += (v[j].x * v[j].x + v[j].y * v[j].y) + (v[j].z * v[j].z + v[j].w * v[j].w); }
    const float rstd = __builtin_amdgcn_rsqf(wave_sum(s) * (1.f / D) + NORM_EPS);
    u32x2* o8 = (u32x2*)orow + lane;
#pragma unroll
    for (int j = 0; j < 4; ++j) { const f32x4 gg = ((const f32x4*)g)[lane + 64 * j], ss = ((const f32x4*)sc)[lane + 64 * j], hh = ((const f32x4*)sh)[lane + 64 * j];
        const f32x4 y = v[j] * rstd * gg * (ss + 1.f) + hh;
        if (orow) { u32x2 w; w.x = pk2(y.x, y.y); w.y = pk2(y.z, y.w); o8[64 * j] = w; }
        if (o8row) o8row[lane + 64 * j] = pk4_fp8(y.x, y.y, y.z, y.w); }
}

__device__ __forceinline__ void phase_p0(const Args& A, Ctx& C) {
    float* mod = WSP(float, WS_MOD);
    {
        lfloat* sc = (lfloat*)C.lds;
        lfloat* red = (lfloat*)(C.lds + 17 * 1024 * 4);
        const float* wada = A.in[I_WADA]; const float* bada = A.in[I_BADA];
        for (int it = C.bid; it < 96 * 2; it += C.G) {
            const int chunk = it >> 1, pass = it & 1, r0 = pass * 17, nr = pass ? 16 : 17, col0 = chunk * 64;
            __syncthreads();
            for (int i = C.tid; i < nr * 1024; i += 512) { const int r = i >> 10, k = i & 1023; const int rr = r0 + r;
                const float cv = rr < 32 ? A.in[I_C][rr * 1024 + k] : A.in[I_CCTX][k]; sc[r * 1024 + k] = siluf_(cv); }
            __syncthreads();
            const int col = C.tid & 63, kq = C.tid >> 6;
            float acc[17];
#pragma unroll
            for (int r = 0; r < 17; ++r) acc[r] = 0.f;
            for (int k = kq * 128; k < kq * 128 + 128; k += 4) {
                float w[4];
#pragma unroll
                for (int j = 0; j < 4; ++j) w[j] = wada[(size_t)(k + j) * MODW + col0 + col];
#pragma unroll
                for (int r = 0; r < 17; ++r) { const f32x4 s4 = *(const LAS f32x4*)(sc + r * 1024 + k); acc[r] += s4.x * w[0] + s4.y * w[1] + s4.z * w[2] + s4.w * w[3]; }
            }
#pragma unroll
            for (int r = 0; r < 17; ++r) red[(kq * 17 + r) * 64 + col] = acc[r];
            __syncthreads();
            for (int i = C.tid; i < nr * 64; i += 512) { const int r = i >> 6, cc = i & 63; float s = 0.f;
#pragma unroll
                for (int q = 0; q < 8; ++q) s += red[(q * 17 + r) * 64 + cc];
                mod[(size_t)(r0 + r) * MODW + col0 + cc] = s + bada[col0 + cc]; }
        }
        __syncthreads();
    }
    {
        lfloat* scr = (lfloat*)(C.lds + C.wave * 16384);
        const int gw = C.bid * 8 + C.wave, NGW = C.G * 8;
        unsigned char* btin8 = A.ws + WS_BTIN; bf16_t* btout = WSP(bf16_t, WS_BTOUT); bf16_t* btr = WSP(bf16_t, WS_BTR);
        constexpr int I_IN = (D / 64) * 124, I_OUT = (D / 64) * (D / 32), I_R = (D / 64) * (NE / 32), I_G = (128 / 64) * (DA / 32);
        for (int it = gw; it < I_IN + I_OUT + I_R + I_G; it += NGW) {
            int r = it;
            if (r < I_IN) {
                const int kb = r / 124, nb = r % 124, k0 = 64 * kb, n0 = 32 * nb; const float* W = A.in[I_WIN];
#pragma unroll 8
                for (int i = 0; i < 32; ++i) { const int kk = 2 * i + (C.lane >> 5); scr[kk * 33 + (C.lane & 31)] = W[(size_t)(k0 + kk) * IN_COLS + n0 + (C.lane & 31)] * SWIN; }
                asm volatile("s_waitcnt lgkmcnt(0)" ::: "memory");
                const int c = C.lane & 7;
#pragma unroll
                for (int j = 0; j < 4; ++j) { const int n = (C.lane >> 3) + 8 * j; const lfloat* s = scr + (8 * c) * 33 + n;
                    u32x2 o; o.x = pk4_fp8(s[0 * 33], s[1 * 33], s[2 * 33], s[3 * 33]); o.y = pk4_fp8(s[4 * 33], s[5 * 33], s[6 * 33], s[7 * 33]);
                    *(u32x2*)(btin8 + (size_t)(n0 + n) * D + k0 + 8 * c) = o; }
                asm volatile("s_waitcnt lgkmcnt(0)" ::: "memory");
                continue; }
            r -= I_IN;
            if (r < I_OUT) { transpose_item(A.in[I_WOUT], D, D, btout, RowId(), scr, r, C.lane); continue; } r -= I_OUT;
            if (r < I_R) { transpose_item(A.in[I_RW], D, NE, btr, RowId(), scr, r, C.lane); continue; } r -= I_R;
            transpose_item(A.in[I_GUP], 128, DA, WSP(bf16_t, WS_GUPT), RowId(), scr, r, C.lane);
        }
        for (int i = C.bid * 512 + C.tid; i < 16 * D / 4; i += C.G * 512) { const int n = 3968 + (i >> 8), k = (i & 255) * 4; const float* W = A.in[I_WIN];
            *(unsigned*)(btin8 + (size_t)n * D + k) = pk4_fp8(W[(size_t)k * IN_COLS + n] * SWIN, W[(size_t)(k + 1) * IN_COLS + n] * SWIN, W[(size_t)(k + 2) * IN_COLS + n] * SWIN, W[(size_t)(k + 3) * IN_COLS + n] * SWIN); }
        for (int i = C.bid * 512 + C.tid; i < (PLD - IN_COLS) * D / 16; i += C.G * 512) ((u32x4*)(btin8 + (size_t)IN_COLS * D))[i] = (u32x4){0u, 0u, 0u, 0u};
    }
}

__device__ __forceinline__ void phase_p1(const Args& A, Ctx& C) {
    const float* mod = WSP(float, WS_MOD); bf16_t* xn = WSP(bf16_t, WS_XN);
    const int gw = C.bid * 8 + C.wave, NGW = C.G * 8;
    for (int row = gw; row < NROWS; row += NGW) {
        const float* xr; int mb;
        if (row < NLAT) { xr = A.in[I_X] + (size_t)row * D; mb = row >> 11; } else { xr = A.in[I_CTX] + (size_t)(row - NLAT) * D; mb = 32; }
        const float* m = mod + (size_t)mb * MODW;
        norm_mod_row(xr, A.in[I_N1G], m + D, m, nullptr, C.lane, (unsigned*)(A.ws + WS_XN) + (size_t)row * (D / 4));
    }
}

template <int NK>
__device__ __forceinline__ f32x4 mm_tile(const lbyte* Ap, int lda, const lbyte* Bp, int ldb, f32x4 acc, int lane) {
    const int r = lane & 15, g = lane >> 4;
#pragma unroll
    for (int ks = 0; ks < NK; ++ks) {
        const bf16x8 a = *(const LAS bf16x8*)(Ap + r * lda + ks * 64 + g * 16);
        const bf16x8 b = *(const LAS bf16x8*)(Bp + r * ldb + ks * 64 + g * 16);
        acc = __builtin_amdgcn_mfma_f32_16x16x32_bf16(a, b, acc, 0, 0, 0);
    }
    return acc;
}

__device__ __forceinline__ void st_bf16x4(lbyte* p, f32x4 v) { u32x2 w; w.x = cvtpk(v.x, v.y); w.y = cvtpk(v.z, v.w); *(LAS u32x2*)p = w; }
__device__ __forceinline__ void st_bf16(lbyte* p, float v) { *(LAS unsigned short*)p = (unsigned short)cvtpk(v, v); }
__device__ __forceinline__ float rdlane(float v, int l) { return __builtin_bit_cast(float, __builtin_amdgcn_readlane(__builtin_bit_cast(int, v), l)); }

__device__ __forceinline__ void tri_inv16(const f32x4 m, int lane, float (&X)[16]) {
#pragma unroll
    for (int i = 0; i < 16; ++i) {
        float x0 = (lane == i) ? 1.f : 0.f, x1 = 0.f;
#pragma unroll
        for (int k = 0; k < i; ++k) { const float t = rdlane(m[k & 3], i + 16 * (k >> 2)) * X[k]; if (k & 1) x1 -= t; else x0 -= t; }
        X[i] = x0 + x1;
    }
}

namespace rk {
constexpr int S64 = 160, S32 = 80, SW = 144;
constexpr int O_WUP = 0, O_AUP = O_WUP + 64 * SW, O_WLT = O_AUP + 64 * SW, O_ALT = O_WLT + 16 * S64, O_LW = O_ALT + 16 * S64, O_LA = O_LW + 4096,
              O_KKT = O_LA + 4096, O_RT = O_KKT + 16 * S64, O_BT = O_RT + 16 * S64, O_KDT = O_BT + 16 * S64,
              O_VT = O_KDT + 16 * S64, O_BHT = O_VT + 64 * S32, O_KHT = O_BHT + 64 * S32, O_UT = O_KHT + 64 * S32, O_UTT = O_WLT  ,
              O_TI = O_UT + 64 * S32, O_MK = O_TI + 16 * S32, O_NB = O_MK + 16 * S32, O_NK = O_NB + 16 * S32,
              O_SBF = O_NK + 16 * S32, O_WC = O_SBF + 64 * S64, TEAM_BYTES = O_WC + 256;
static_assert(2 * TEAM_BYTES <= LDS_MISC, "rwkv LDS");
}
__device__ __forceinline__ void rwkv_pair_chunked(const Args& A, Ctx& C, int pair) {
    using namespace rk;
    const int b = pair >> 3, h = pair & 7;
    const int dir = C.wave >> 2;
    const int t4 = C.tid & 255, q = C.wave & 3, lane = C.lane;
    lbyte* L = C.lds + dir * TEAM_BYTES;
    const bf16_t* P = WSP(bf16_t, WS_P);
    bf16_t* ydir = WSP(bf16_t, WS_YDIR) + (size_t)dir * NLAT * D;
    float* bon = WSP(float, WS_BON) + (size_t)dir * NLAT * 8;
    __syncthreads();
#pragma unroll 2
    for (int i = t4; i < 4096; i += 256) { const int l = i >> 6, c = i & 63;
        st_bf16(L + O_WUP + c * SW + l * 2, A.in[I_WUP][((size_t)dir * 64 + l) * DA + 64 * h + c]);
        st_bf16(L + O_AUP + c * SW + l * 2, A.in[I_AUP][((size_t)dir * 64 + l) * DA + 64 * h + c]); }
#pragma unroll 2
    for (int i = t4; i < (4 * 64 * S32 + 4 * 16 * S32 + 64 * S64) / 4; i += 256) ((LAS unsigned*)(L + O_VT))[i] = 0u;
    for (int i = t4; i < (2 * 16 * S64) / 4; i += 256) ((LAS unsigned*)(L + O_WLT))[i] = 0u;
    const int c = lane;
    int col5[5] = {64 * h + c, 512 + 64 * h + c, 1024 + 64 * h + c, 1536 + 64 * dir + c, 1664 + 64 * dir + c};
    float mu5[5]; int dl5[5], cl5[5], dc5[5], cc5[5];
#pragma unroll
    for (int e = 0; e < 5; ++e) { const int col = col5[e]; mu5[e] = A.in[I_MU][col];
        cl5[e] = col < 480 ? 0 : (col < 960 ? 1 : (col < 1440 ? 2 : 3)); dl5[e] = (cl5[e] == 0 ? -PLD : (cl5[e] == 1 ? PLD : (cl5[e] == 2 ? -64 * PLD : 64 * PLD)));
        cc5[e] = col < 960 ? 0 : 1; dc5[e] = col < 960 ? -PLD : PLD; }
    const float kkc = A.in[I_KK][64 * h + c], kac = A.in[I_KA][64 * h + c], rkc = A.in[I_RK][64 * h + c];
    const float w0c = A.in[I_W0][dir * DA + 64 * h + c], a0c = A.in[I_A0][dir * DA + 64 * h + c];
    f32x4 Sacc[4];
#pragma unroll
    for (int i = 0; i < 4; ++i) Sacc[i] = (f32x4){0.f, 0.f, 0.f, 0.f};
    const int fr = lane & 15, fg = lane >> 4;
    unsigned short rawp[4][5], raws[4][5];
    auto chunk_geom = [&](int ch, bool& isctx, int& sbase, int& T, size_t& rowbase) { isctx = ch < 16; sbase = isctx ? ch * 16 : (ch - 16) * 16; T = isctx ? CTX : SEQ; rowbase = isctx ? (size_t)NLAT + (size_t)b * CTX : (size_t)b * SEQ; };
    auto okmask = [&](bool isctx, int t) -> int { return isctx ? ((t >= 1 ? 1 : 0) | (t <= CTX - 2 ? 2 : 0)) : (((t & 63) >= 1 ? 1 : 0) | ((t & 63) <= 62 ? 2 : 0) | (t >= 64 ? 4 : 0) | (t < SEQ - 64 ? 8 : 0)); };
    auto issue_loads = [&](int ch) { bool isctx; int sbase, T; size_t rowbase; chunk_geom(ch, isctx, sbase, T, rowbase);
#pragma unroll
        for (int j = 0; j < 4; ++j) { const int i = q + 4 * j; const int t = __builtin_amdgcn_readfirstlane(dir ? (T - 1 - (sbase + i)) : (sbase + i));
            const bf16_t* pr = P + (rowbase + t) * PLD; const int okm = okmask(isctx, t);
#pragma unroll
            for (int e = 0; e < 5; ++e) { const int cls = isctx ? cc5[e] : cl5[e]; const bool ok = (okm >> cls) & 1; const int off = col5[e] + (ok ? (isctx ? dc5[e] : dl5[e]) : 0);
                rawp[j][e] = pr[col5[e]]; raws[j][e] = pr[off]; } } };
    issue_loads(0);
    for (int ch = 0; ch < 144; ++ch) {
        bool isctx; int sbase, T; size_t rowbase; chunk_geom(ch, isctx, sbase, T, rowbase);
        float vr[4], vk[4], vv[4], vkk[4], lw[4], av[4];
        __syncthreads();
        float mxa[4][5];
#pragma unroll
        for (int j = 0; j < 4; ++j) { const int i = q + 4 * j; const int t = __builtin_amdgcn_readfirstlane(dir ? (T - 1 - (sbase + i)) : (sbase + i)); const int okm = okmask(isctx, t);
#pragma unroll
            for (int e = 0; e < 5; ++e) { const int cls = isctx ? cc5[e] : cl5[e]; const bool ok = (okm >> cls) & 1;
                const float pv = bf2f(rawp[j][e]); const float sv = bf2f(raws[j][e]); mxa[j][e] = pv + mu5[e] * ((ok ? sv : 0.f) - pv); } }
        if (ch + 1 < 144) issue_loads(ch + 1);
#pragma unroll
        for (int j = 0; j < 4; ++j) {
            const int i = q + 4 * j;
            float mx[5];
#pragma unroll
            for (int e = 0; e < 5; ++e) mx[e] = mxa[j][e];
            vr[j] = mx[0]; vk[j] = mx[1]; vv[j] = mx[2];
            *(LAS unsigned short*)(L + O_WLT + i * S64 + c * 2) = (unsigned short)cvtpk(tanhf_(mx[3]), 0.f); *(LAS unsigned short*)(L + O_ALT + i * S64 + c * 2) = (unsigned short)cvtpk(mx[4], 0.f);
            const float kx = vk[j] * kkc; const float ss = wave_sum(kx * kx);
            vkk[j] = kx * __builtin_amdgcn_rsqf(ss + 1e-6f);
        }
        __syncthreads();
        {
            const f32x4 z = (f32x4){0.f, 0.f, 0.f, 0.f};
            const f32x4 tw = mm_tile<2>(L + O_WLT, S64, L + O_WUP + 16 * q * SW, SW, z, lane);
            const f32x4 ta = mm_tile<2>(L + O_ALT, S64, L + O_AUP + 16 * q * SW, SW, z, lane);
#pragma unroll
            for (int e = 0; e < 4; ++e) { ((LAS float*)(L + O_LW))[(4 * fg + e) * 64 + 16 * q + fr] = tw[e]; ((LAS float*)(L + O_LA))[(4 * fg + e) * 64 + 16 * q + fr] = ta[e]; }
        }
        __syncthreads();
#pragma unroll
        for (int j = 0; j < 4; ++j) { const int i = q + 4 * j;
            const float wlog = -softplusf_(-(w0c + ((LAS float*)(L + O_LW))[i * 64 + c])) - 0.5f;
            lw[j] = -__expf(wlog);
            av[j] = sigmoidf_(a0c + ((LAS float*)(L + O_LA))[i * 64 + c]);
            ((LAS float*)(L + O_LW))[i * 64 + c] = lw[j]; }
        __syncthreads();
        if (t4 < 64) { float cum = 0.f;
#pragma unroll
            for (int t = 0; t < 16; ++t) { cum += ((LAS float*)(L + O_LW))[t * 64 + c]; ((LAS float*)(L + O_LW))[t * 64 + c] = cum; } }
        __syncthreads();
        {
            const float cumC = ((LAS float*)(L + O_LW))[15 * 64 + c];
#pragma unroll
            for (int j = 0; j < 4; ++j) { const int i = q + 4 * j;
                const float cum = ((LAS float*)(L + O_LW))[i * 64 + c];
                const float Wt = __expf(cum), Wp = __expf(cum - lw[j]), Wi = __expf(-cum), Wc = __expf(cumC - cum);
                const float kd = vk[j] * (1.f + (av[j] - 1.f) * kac), bb = vkk[j] * av[j];
                const unsigned p0 = cvtpk(vkk[j] * Wp, vr[j] * Wt), p1 = cvtpk(bb * Wi, kd * Wi), p2 = cvtpk(vv[j], bb * Wc), p3 = cvtpk(kd * Wc, 0.f);
                *(LAS unsigned short*)(L + O_KKT + i * S64 + c * 2) = (unsigned short)p0; *(LAS unsigned short*)(L + O_RT + i * S64 + c * 2) = (unsigned short)(p0 >> 16);
                *(LAS unsigned short*)(L + O_BT + i * S64 + c * 2) = (unsigned short)p1; *(LAS unsigned short*)(L + O_KDT + i * S64 + c * 2) = (unsigned short)(p1 >> 16);
                *(LAS unsigned short*)(L + O_VT + c * S32 + i * 2) = (unsigned short)p2; *(LAS unsigned short*)(L + O_BHT + c * S32 + i * 2) = (unsigned short)(p2 >> 16);
                *(LAS unsigned short*)(L + O_KHT + c * S32 + i * 2) = (unsigned short)p3;
                const float bs = wave_sum(vr[j] * kd * rkc);
                if (!isctx && lane == 0) { const int t = dir ? (T - 1 - (sbase + i)) : (sbase + i); bon[((size_t)b * SEQ + t) * 8 + h] = bs; }
            }
            if (q == 3) ((LAS float*)(L + O_WC))[c] = __expf(cumC);
        }
        __syncthreads();
        {
            const lbyte* Aj = L + ((q & 1) ? O_KDT : O_BT);
            const lbyte* Bt = L + ((q & 2) ? O_RT : O_KKT);
            f32x4 g4 = mm_tile<2>(Aj, S64, Bt, S64, (f32x4){0.f, 0.f, 0.f, 0.f}, lane);
#pragma unroll
            for (int e = 0; e < 4; ++e) { const int j = 4 * fg + e; const bool keep = (q & 2) ? (j <= fr) : (j < fr); g4[e] = keep ? g4[e] : 0.f; }
            if (q == 0) { float X[16]; tri_inv16(g4, lane, X);
                if (lane < 16) {
#pragma unroll
                    for (int i = 0; i < 16; ++i) *(LAS unsigned short*)(L + O_TI + i * S32 + lane * 2) = (unsigned short)cvtpk(X[i], 0.f); } }
            else st_bf16x4(L + (q == 1 ? O_MK : (q == 2 ? O_NB : O_NK)) + fr * S32 + fg * 8, g4);
        }
        __syncthreads();
        f32x4 yacc;
        {
            f32x4 u4 = mm_tile<2>(L + O_KKT, S64, L + O_SBF + 16 * q * S64, S64, (f32x4){0.f, 0.f, 0.f, 0.f}, lane);
            u4 = mm_tile<1>(L + O_MK, S32, L + O_VT + 16 * q * S32, S32, u4, lane);
            st_bf16x4(L + O_UTT + (16 * q + fr) * S32 + fg * 8, u4);
            yacc = mm_tile<2>(L + O_SBF + 16 * q * S64, S64, L + O_RT, S64, (f32x4){0.f, 0.f, 0.f, 0.f}, lane);
            yacc = mm_tile<1>(L + O_VT + 16 * q * S32, S32, L + O_NK, S32, yacc, lane);
        }
        asm volatile("s_waitcnt lgkmcnt(0)" ::: "memory");
        {
            f32x4 u4 = mm_tile<1>(L + O_TI, S32, L + O_UTT + 16 * q * S32, S32, (f32x4){0.f, 0.f, 0.f, 0.f}, lane);
            st_bf16x4(L + O_UT + (16 * q + fr) * S32 + fg * 8, -u4);
        }
        __syncthreads();
        {
            yacc = mm_tile<1>(L + O_UT + 16 * q * S32, S32, L + O_NB, S32, yacc, lane);
            if (!isctx) { const int t = dir ? (T - 1 - (sbase + fr)) : (sbase + fr);
                u32x2 w; w.x = cvtpk(yacc[0], yacc[1]); w.y = cvtpk(yacc[2], yacc[3]);
                *(u32x2*)(ydir + ((size_t)b * SEQ + t) * D + 64 * h + 16 * q + 4 * fg) = w; }
            const f32x4 wc4 = *(LAS f32x4*)(L + O_WC + (16 * q + 4 * fg) * 4);
#pragma unroll
            for (int vi = 0; vi < 4; ++vi) {
                f32x4 s4 = Sacc[vi] * wc4;
                s4 = mm_tile<1>(L + O_KHT + 16 * q * S32, S32, L + O_VT + 16 * vi * S32, S32, s4, lane);
                s4 = mm_tile<1>(L + O_BHT + 16 * q * S32, S32, L + O_UT + 16 * vi * S32, S32, s4, lane);
                Sacc[vi] = s4;
                st_bf16x4(L + O_SBF + (16 * vi + fr) * S64 + (16 * q + 4 * fg) * 2, s4);
            }
        }
    }
    __syncthreads();
}

__device__ __forceinline__ void phase_gdn_prep(const Args& A, Ctx& C) {
    const bf16_t* P = WSP(bf16_t, WS_P);
    bf16_t* QKV = (bf16_t*)A.out; float* NRM = WSP(float, WS_NRM);
    lfloat* part = (lfloat*)C.lds;
    const int tid = C.tid, lane = C.lane, w = C.wave;
    float cw[3][5];
#pragma unroll
    for (int g = 0; g < 3; ++g)
#pragma unroll
        for (int e = 0; e < 5; ++e) cw[g][e] = A.in[I_CONVW][e * 1536 + g * 512 + tid];
    for (int tile = C.bid; tile < NROWS / 16; tile += C.G) {
        const int row0 = tile * 16;
        int T, ta; size_t rowbase;
        if (row0 < NLAT) { T = SEQ; rowbase = (size_t)(row0 >> 11) * SEQ; ta = row0 & (SEQ - 1); } else { T = CTX; const int r = row0 - NLAT; rowbase = (size_t)NLAT + (size_t)(r >> 8) * CTX; ta = r & (CTX - 1); }
        float x[3][20];
#pragma unroll
        for (int e = 0; e < 20; ++e) { const int t = ta - 2 + e; const bool ok = (t >= 0 && t < T); const bf16_t* pr = P + (rowbase + (ok ? t : ta)) * PLD + RW_COLS + tid;
#pragma unroll
            for (int g = 0; g < 3; ++g) { const float xv = bf2f(pr[g * 512]); x[g][e] = ok ? xv : 0.f; } }
        __syncthreads();
#pragma unroll
        for (int i = 0; i < 16; ++i) { float y[3];
#pragma unroll
            for (int g = 0; g < 3; ++g) { float sacc = 0.f;
#pragma unroll
                for (int f = 0; f < 5; ++f) sacc += cw[g][f] * x[g][i + f];
                y[g] = siluf_(sacc); }
            bf16_t* orow = QKV + (rowbase + ta + i) * 1536 + tid;
            orow[0] = (bf16_t)cvtpk(y[0], 0.f); orow[512] = (bf16_t)cvtpk(y[1], 0.f); orow[1024] = (bf16_t)cvtpk(y[2], 0.f);
            const float sq = wave_sum(y[0] * y[0]), sk = wave_sum(y[1] * y[1]);
            if (lane == 0) { part[(i * 8 + w) * 2] = sq; part[(i * 8 + w) * 2 + 1] = sk; } }
        __syncthreads();
        if (tid < 128) { const int i = tid >> 3, sidx = tid & 7, h = sidx & 3, sel = sidx >> 2;
            const float ss = part[(i * 8 + 2 * h) * 2 + sel] + part[(i * 8 + 2 * h + 1) * 2 + sel];
            NRM[(rowbase + ta + i) * 8 + sidx] = __builtin_amdgcn_rsqf(ss + 1e-6f) * (sel ? 1.f : 0.08838834764831845f); }
    }
    __syncthreads();
}

namespace gd {
constexpr int S128 = 288, S32 = 80;
constexpr int O_KT = 0, O_QT = O_KT + 32 * S128, O_KKT = O_QT + 32 * S128, O_RT = O_KKT + 32 * S128,
              O_VT = O_RT + 32 * S128, O_BHT = O_VT + 128 * S32, O_KHT = O_BHT + 128 * S32, O_UT = O_KHT + 128 * S32, O_UTT = O_UT + 128 * S32,
              O_TI = O_UTT + 128 * S32, O_MK = O_TI + 32 * S32, O_NB = O_MK + 32 * S32, O_NK = O_NB + 32 * S32,
              O_M21 = O_NK + 32 * S32, O_T11T = O_M21 + 16 * S32, O_T22 = O_T11T + 16 * S32, O_XT = O_T22 + 16 * S32,
              O_SBF = O_XT + 16 * S32, O_SC = O_SBF + 128 * S128, GD_BYTES = O_SC + 512;
static_assert(GD_BYTES <= LDS_MISC, "gdn LDS");
}
__device__ __forceinline__ void gdn_chain_chunked(const Args& A, Ctx& C, int chain) {
    using namespace gd;
    const int b = chain >> 3, h = (chain >> 1) & 3, dir = chain & 1;
    lbyte* L = C.lds;
    LAS float* SC = (LAS float*)(L + O_SC);
    const bf16_t* P = WSP(bf16_t, WS_P);
    bf16_t* ydir = WSP(bf16_t, WS_YDIR) + (size_t)dir * NLAT * D;
    const int tid = C.tid, lane = C.lane, w = C.wave, fr = lane & 15, fg = lane >> 4;
    const int grp = tid >> 7, idx = tid & 127;
    const float Aexp = __expf(A.in[I_ALOG][dir * 4 + h]), dtb = A.in[I_DTB][dir * 4 + h];
    const f32x4 z4 = (f32x4){0.f, 0.f, 0.f, 0.f};
    __syncthreads();
#pragma unroll 2
    for (int i = tid; i < (O_SC - O_VT) / 4; i += 512) ((LAS unsigned*)(L + O_VT))[i] = 0u;
    f32x4 Sacc[8];
#pragma unroll
    for (int i = 0; i < 8; ++i) Sacc[i] = z4;
    const bf16_t* QKV = (const bf16_t*)A.out; const float* NRM = WSP(const float, WS_NRM);
    unsigned short rq[8], rk[8], rv[8]; float nq[8], nk[8]; unsigned short raw_al = 0, raw_be = 0;
    auto chunk_geom = [&](int ch, bool& isctx, int& sbase, int& T, size_t& rowbase) { isctx = ch < 8; sbase = isctx ? ch * 32 : (ch - 8) * 32; T = isctx ? CTX : SEQ;
        rowbase = isctx ? (size_t)NLAT + (size_t)b * CTX : (size_t)b * SEQ; };
    auto issue_loads = [&](int ch) { bool isctx; int sbase, T; size_t rowbase; chunk_geom(ch, isctx, sbase, T, rowbase);
#pragma unroll
        for (int j = 0; j < 8; ++j) { const int i = grp + 4 * j; const int t = dir ? (T - 1 - (sbase + i)) : (sbase + i); const size_t row = rowbase + t;
            const bf16_t* qr = QKV + row * 1536 + 128 * h + idx; rq[j] = qr[0]; rk[j] = qr[512]; rv[j] = qr[1024]; nq[j] = NRM[row * 8 + h]; nk[j] = NRM[row * 8 + 4 + h]; }
        if (w == 7 && lane < 32) { const int t = dir ? (T - 1 - (sbase + lane)) : (sbase + lane); const bf16_t* pr = P + (rowbase + t) * PLD + RW_COLS + 2048; raw_al = pr[dir * 4 + h]; raw_be = pr[8 + dir * 4 + h]; } };
    issue_loads(0);
    for (int ch = 0; ch < 72; ++ch) {
        bool isctx; int sbase, T; size_t rowbase; chunk_geom(ch, isctx, sbase, T, rowbase);
        __syncthreads();
        float qv[8], kv[8], vv[8], nqv[8], nkv[8];
#pragma unroll
        for (int j = 0; j < 8; ++j) { qv[j] = bf2f(rq[j]); kv[j] = bf2f(rk[j]); vv[j] = bf2f(rv[j]); nqv[j] = nq[j]; nkv[j] = nk[j]; }
        if (w == 7) {
            const float gi = (lane < 32) ? -Aexp * softplusf_(bf2f(raw_al) + dtb) : 0.f;
            float cum = gi;
            cum += __builtin_bit_cast(float, __builtin_amdgcn_update_dpp(0, __builtin_bit_cast(int, cum), 0x111, 0xf, 0xf, true));
            cum += __builtin_bit_cast(float, __builtin_amdgcn_update_dpp(0, __builtin_bit_cast(int, cum), 0x112, 0xf, 0xf, true));
            cum += __builtin_bit_cast(float, __builtin_amdgcn_update_dpp(0, __builtin_bit_cast(int, cum), 0x114, 0xf, 0xf, true));
            cum += __builtin_bit_cast(float, __builtin_amdgcn_update_dpp(0, __builtin_bit_cast(int, cum), 0x118, 0xf, 0xf, true));
            const float r0 = rdlane(cum, 15);
            cum += (lane >= 16) ? r0 : 0.f;
            if (lane < 32) { SC[lane] = sigmoidf_(bf2f(raw_be)); SC[32 + lane + 1] = cum; if (lane == 0) SC[32] = 0.f; }
        }
        if (ch + 1 < 72) issue_loads(ch + 1);
        __syncthreads();
        {
            const int c = idx; const float gcC = SC[32 + 32];
#pragma unroll
            for (int j = 0; j < 8; ++j) { const int i = grp + 4 * j;
                const float kn = kv[j] * nkv[j], qn = qv[j] * nqv[j];
                const float gm = SC[32 + i], gi = SC[32 + i + 1], be = SC[i];
                const unsigned p0 = cvtpk(kn, qn), p1 = cvtpk(kn * __expf(gm), qn * __expf(gi)), p2 = cvtpk(be * kn * __expf(gcC - gm), be * kn * __expf(gcC - gi));
                *(LAS unsigned short*)(L + O_KT + i * S128 + c * 2) = (unsigned short)p0; *(LAS unsigned short*)(L + O_QT + i * S128 + c * 2) = (unsigned short)(p0 >> 16);
                *(LAS unsigned short*)(L + O_KKT + i * S128 + c * 2) = (unsigned short)p1; *(LAS unsigned short*)(L + O_RT + i * S128 + c * 2) = (unsigned short)(p1 >> 16);
                *(LAS unsigned short*)(L + O_BHT + c * S32 + i * 2) = (unsigned short)p2; *(LAS unsigned short*)(L + O_KHT + c * S32 + i * 2) = (unsigned short)(p2 >> 16);
                *(LAS unsigned short*)(L + O_VT + c * S32 + i * 2) = (unsigned short)cvtpk(vv[j], 0.f); }
        }
        __syncthreads();
        {
            const int isq = w >> 2, tb = (w >> 1) & 1, jb = w & 1;
            if (jb <= tb) {
                const f32x4 g4 = mm_tile<4>(L + O_KT + jb * 16 * S128, S128, L + (isq ? O_QT : O_KT) + tb * 16 * S128, S128, z4, lane);
                const int t = tb * 16 + fr;
                const float gt = SC[32 + t + isq];
                f32x4 m0, m1;
#pragma unroll
                for (int e = 0; e < 4; ++e) { const int j = jb * 16 + 4 * fg + e; const bool keep = isq ? (j <= t) : (j < t);
                    const float bj = SC[j] * g4[e];
                    m0[e] = keep ? bj * __expf(gt - SC[32 + j]) : 0.f;
                    m1[e] = keep ? bj * __expf(gt - SC[32 + j + 1]) : 0.f; }
                const int off = t * S32 + (jb * 16 + 4 * fg) * 2;
                if (isq) { st_bf16x4(L + O_NB + off, m0); st_bf16x4(L + O_NK + off, m1); }
                else {
                    st_bf16x4(L + O_MK + off, m1);
                    if (tb != jb) st_bf16x4(L + O_M21 + fr * S32 + fg * 8, m0);
                    else { float X[16]; tri_inv16(m0, lane, X);
                        if (lane < 16) {
#pragma unroll
                            for (int i = 0; i < 16; ++i) *(LAS unsigned short*)(L + O_TI + (tb * 16 + i) * S32 + (tb * 16 + lane) * 2) = (unsigned short)cvtpk(X[i], 0.f);
                            if (tb == 0) { u32x4 a0, a1;
                                a0.x = cvtpk(X[0], X[1]); a0.y = cvtpk(X[2], X[3]); a0.z = cvtpk(X[4], X[5]); a0.w = cvtpk(X[6], X[7]);
                                a1.x = cvtpk(X[8], X[9]); a1.y = cvtpk(X[10], X[11]); a1.z = cvtpk(X[12], X[13]); a1.w = cvtpk(X[14], X[15]);
                                *(LAS u32x4*)(L + O_T11T + lane * S32) = a0; *(LAS u32x4*)(L + O_T11T + lane * S32 + 16) = a1; }
                            else {
#pragma unroll
                                for (int i = 0; i < 16; ++i) *(LAS unsigned short*)(L + O_T22 + i * S32 + lane * 2) = (unsigned short)cvtpk(X[i], 0.f); }
                        } }
                }
            }
        }
        __syncthreads();
        if (w == 1) {
            const f32x4 x4 = mm_tile<1>(L + O_M21, S32, L + O_T11T, S32, z4, lane);
            st_bf16x4(L + O_XT + fr * S32 + fg * 8, x4);
            asm volatile("s_waitcnt lgkmcnt(0)" ::: "memory");
            const f32x4 t4 = mm_tile<1>(L + O_XT, S32, L + O_T22, S32, z4, lane);
            st_bf16x4(L + O_TI + (16 + fr) * S32 + fg * 8, -t4);
        }
        f32x4 yacc[2];
#pragma unroll
        for (int tb = 0; tb < 2; ++tb) {
            f32x4 u4 = mm_tile<4>(L + O_KKT + tb * 16 * S128, S128, L + O_SBF + 16 * w * S128, S128, z4, lane);
            u4 = mm_tile<1>(L + O_MK + tb * 16 * S32, S32, L + O_VT + 16 * w * S32, S32, u4, lane);
            st_bf16x4(L + O_UTT + (16 * w + fr) * S32 + tb * 32 + fg * 8, u4);
            yacc[tb] = mm_tile<4>(L + O_SBF + 16 * w * S128, S128, L + O_RT + tb * 16 * S128, S128, z4, lane);
            yacc[tb] = mm_tile<1>(L + O_VT + 16 * w * S32, S32, L + O_NK + tb * 16 * S32, S32, yacc[tb], lane);
        }
        __syncthreads();
#pragma unroll
        for (int tb = 0; tb < 2; ++tb) {
            const f32x4 u4 = mm_tile<1>(L + O_TI + tb * 16 * S32, S32, L + O_UTT + 16 * w * S32, S32, z4, lane);
            st_bf16x4(L + O_UT + (16 * w + fr) * S32 + tb * 32 + fg * 8, -u4);
        }
        __syncthreads();
        {
#pragma unroll
            for (int tb = 0; tb < 2; ++tb) {
                yacc[tb] = mm_tile<1>(L + O_UT + 16 * w * S32, S32, L + O_NB + tb * 16 * S32, S32, yacc[tb], lane);
                if (!isctx) { const int tl = sbase + tb * 16 + fr; const int t = dir ? (T - 1 - tl) : tl;
                    u32x2 pk; pk.x = cvtpk(yacc[tb][0], yacc[tb][1]); pk.y = cvtpk(yacc[tb][2], yacc[tb][3]);
                    *(u32x2*)(ydir + ((size_t)b * SEQ + t) * D + 512 + 128 * h + 16 * w + 4 * fg) = pk; }
            }
            const float wc = __expf(SC[32 + 32]);
#pragma unroll
            for (int vi = 0; vi < 8; ++vi) {
                f32x4 s4 = Sacc[vi] * wc;
                s4 = mm_tile<1>(L + O_KHT + 16 * w * S32, S32, L + O_VT + 16 * vi * S32, S32, s4, lane);
                s4 = mm_tile<1>(L + O_BHT + 16 * w * S32, S32, L + O_UT + 16 * vi * S32, S32, s4, lane);
                Sacc[vi] = s4;
                st_bf16x4(L + O_SBF + (16 * vi + fr) * S128 + (16 * w + 4 * fg) * 2, s4);
            }
        }
    }
    __syncthreads();
}

__device__ __forceinline__ void unpack8(const u32x4 w, float (&f)[8]) { f[0] = bflo(w.x); f[1] = bfhi(w.x); f[2] = bflo(w.y); f[3] = bfhi(w.y); f[4] = bflo(w.z); f[5] = bfhi(w.z); f[6] = bflo(w.w); f[7] = bfhi(w.w); }
__device__ __forceinline__ void phase_p4(const Args& A, Ctx& C) {
    const bf16_t* P = WSP(bf16_t, WS_P);
    const bf16_t* yf = WSP(bf16_t, WS_YDIR); const bf16_t* yb = yf + (size_t)NLAT * D;
    const float* bon = WSP(float, WS_BON);
    bf16_t* ymix = WSP(bf16_t, WS_YMIX);
    lbyte* SGb = C.lds;
    lfloat* GO = (lfloat*)(C.lds + 8192);
    const int tid = C.tid, lane = C.lane, w = C.wave;
    const bf16_t* gupt = WSP(const bf16_t, WS_GUPT);
    const int fr = lane & 15, fg = lane >> 4;
    const int c8 = 8 * lane;
    float lnw[8], lnb[8], ong[8], muv[8];
#pragma unroll
    for (int e = 0; e < 8; ++e) { lnw[e] = A.in[I_LNW][c8 + e]; lnb[e] = A.in[I_LNB][c8 + e]; ong[e] = A.in[I_ONG][(c8 + e) & 127]; muv[e] = A.in[I_MU][1024 + c8 + e]; }
    const int tkA = tid >> 5, lA = 4 * (tid & 31);
    float muA[4];
#pragma unroll
    for (int e = 0; e < 4; ++e) muA[e] = A.in[I_MU][1792 + lA + e];
    const bool vup = (1024 + c8) < 1440;
    for (int tile = C.bid; tile < NLAT / 16; tile += C.G) {
        const int row0 = tile * 16;
        __syncthreads();
        {
            const int row = row0 + tkA, t = row & (SEQ - 1); const bool ok = t < SEQ - 64;
            const u32x2 pw = *(const u32x2*)(P + (size_t)row * PLD + 1792 + lA); const u32x2 sw = *(const u32x2*)(P + (size_t)(row + (ok ? 64 : 0)) * PLD + 1792 + lA);
            const float pv[4] = {bflo(pw.x), bfhi(pw.x), bflo(pw.y), bfhi(pw.y)}; const float sv[4] = {bflo(sw.x), bfhi(sw.x), bflo(sw.y), bfhi(sw.y)};
            float o[4];
#pragma unroll
            for (int e = 0; e < 4; ++e) o[e] = sigmoidf_(pv[e] + muA[e] * ((ok ? sv[e] : 0.f) - pv[e]));
            u32x2 ow; ow.x = cvtpk(o[0], o[1]); ow.y = cvtpk(o[2], o[3]); *(LAS u32x2*)(SGb + tkA * 288 + lA * 2) = ow;
        }
        __syncthreads();
#pragma unroll
        for (int i = 0; i < 4; ++i) { const int c0 = 64 * w + 16 * i; f32x4 acc = (f32x4){0.f, 0.f, 0.f, 0.f};
#pragma unroll
            for (int ks = 0; ks < 4; ++ks) { const bf16x8 a = *(const LAS bf16x8*)(SGb + fr * 288 + ks * 64 + fg * 16);
                const bf16x8 bq = *(const bf16x8*)(gupt + (size_t)(c0 + fr) * 128 + ks * 32 + fg * 8);
                acc = __builtin_amdgcn_mfma_f32_16x16x32_bf16(a, bq, acc, 0, 0, 0); }
#pragma unroll
            for (int e = 0; e < 4; ++e) GO[(4 * fg + e) * 512 + c0 + fr] = acc[e]; }
        __syncthreads();
#pragma unroll
        for (int tt = 0; tt < 2; ++tt) {
            const int tk = 2 * w + tt, row = row0 + tk, t = row & (SEQ - 1);
            const bool okv = vup ? (t >= 64) : (t < SEQ - 64);
            const u32x4 wyf = *(const u32x4*)(yf + (size_t)row * D + c8), wyb = *(const u32x4*)(yb + (size_t)row * D + c8);
            const u32x4 wpv = *(const u32x4*)(P + (size_t)row * PLD + 1024 + c8), wsv = *(const u32x4*)(P + (size_t)(row + (okv ? (vup ? -64 : 64) : 0)) * PLD + 1024 + c8);
            const u32x4 wof = *(const u32x4*)(yf + (size_t)row * D + 512 + c8), wob = *(const u32x4*)(yb + (size_t)row * D + 512 + c8);
            const u32x4 wz = *(const u32x4*)(P + (size_t)row * PLD + RW_COLS + 1536 + c8);
            const float bs = bon[(size_t)row * 8 + (lane >> 3)] + bon[((size_t)NLAT + row) * 8 + (lane >> 3)];
            const f32x4 g0 = *(const LAS f32x4*)(GO + tk * 512 + c8), g1 = *(const LAS f32x4*)(GO + tk * 512 + c8 + 4);
            const float gg[8] = {g0.x, g0.y, g0.z, g0.w, g1.x, g1.y, g1.z, g1.w};
            float a[8], bq[8], pv[8], sv[8], y[8];
            unpack8(wyf, a); unpack8(wyb, bq); unpack8(wpv, pv); unpack8(wsv, sv);
            float s1 = 0.f;
#pragma unroll
            for (int e = 0; e < 8; ++e) { y[e] = a[e] + bq[e]; s1 += y[e]; }
            s1 += __shfl_xor(s1, 1); s1 += __shfl_xor(s1, 2); s1 += __shfl_xor(s1, 4);
            const float m = s1 * (1.f / 64.f);
            float s2 = 0.f;
#pragma unroll
            for (int e = 0; e < 8; ++e) { y[e] -= m; s2 += y[e] * y[e]; }
            s2 += __shfl_xor(s2, 1); s2 += __shfl_xor(s2, 2); s2 += __shfl_xor(s2, 4);
            const float rs = __builtin_amdgcn_rsqf(s2 * (1.f / 64.f) + RWKV_EPS);
            float o[8];
#pragma unroll
            for (int e = 0; e < 8; ++e) { const float vv = pv[e] + muv[e] * ((okv ? sv[e] : 0.f) - pv[e]); o[e] = (y[e] * rs * lnw[e] + lnb[e] + bs * vv) * gg[e]; }
            u32x4 ow; ow.x = cvtpk(o[0], o[1]); ow.y = cvtpk(o[2], o[3]); ow.z = cvtpk(o[4], o[5]); ow.w = cvtpk(o[6], o[7]);
            *(u32x4*)(ymix + (size_t)row * D + c8) = ow;
            float of[8], ob[8], z[8];
            unpack8(wof, of); unpack8(wob, ob); unpack8(wz, z);
            float s3 = 0.f;
#pragma unroll
            for (int e = 0; e < 8; ++e) { of[e] += ob[e]; s3 += of[e] * of[e]; }
            s3 += __shfl_xor(s3, 1); s3 += __shfl_xor(s3, 2); s3 += __shfl_xor(s3, 4); s3 += __shfl_xor(s3, 8);
            const float rg = __builtin_amdgcn_rsqf(s3 * (1.f / 128.f) + NORM_EPS);
#pragma unroll
            for (int e = 0; e < 8; ++e) o[e] = of[e] * rg * ong[e] * siluf_(z[e]);
            ow.x = cvtpk(o[0], o[1]); ow.y = cvtpk(o[2], o[3]); ow.z = cvtpk(o[4], o[5]); ow.w = cvtpk(o[6], o[7]);
            *(u32x4*)(ymix + (size_t)row * D + 512 + c8) = ow;
        }
    }
}

__device__ __forceinline__ void convert_experts(const Args& A, Ctx& C) {
    lfloat* scr = (lfloat*)(C.lds + C.wave * 16384);
    const int gw = C.bid * 8 + C.wave, NGW = C.G * 8;
    constexpr int I13 = (D / 64) * (DE / 32);
    constexpr int I2 = (DE / 64) * (D / 32);
    constexpr int PER = 2 * I13 + I2;
    for (int it = gw; it < 257 * PER; it += NGW) {
        const int e = it / PER; int r = it % PER;
        unsigned char* bt13 = A.ws + WS_WEXP + (size_t)e * WEXP_STRIDE; unsigned char* bt2 = bt13 + 512 * 1024;
        const float* w1 = e < NE ? A.in[I_EW1] + (size_t)e * D * DE : A.in[I_SW1];
        const float* w3 = e < NE ? A.in[I_EW3] + (size_t)e * D * DE : A.in[I_SW3];
        const float* w2 = e < NE ? A.in[I_EW2] + (size_t)e * DE * D : A.in[I_SW2];
        if (r < I13) { transpose_item_fp8(w1, D, DE, bt13, RowGLU{0}, SW13, scr, r, C.lane); continue; } r -= I13;
        if (r < I13) { transpose_item_fp8(w3, D, DE, bt13, RowGLU{128}, SW13, scr, r, C.lane); continue; } r -= I13;
        transpose_item_fp8(w2, DE, D, bt2, RowId(), SW2, scr, r, C.lane);
    }
}

__device__ __forceinline__ void phase_p6(const Args& A, Ctx& C) {
    const float* mod = WSP(float, WS_MOD); bf16_t* h2n = WSP(bf16_t, WS_H2N);
    const int gw = C.bid * 8 + C.wave, NGW = C.G * 8;
    for (int row = gw; row < NLAT; row += NGW) {
        const float* m = mod + (size_t)(row >> 11) * MODW;
        norm_mod_row(A.out + (size_t)row * D, A.in[I_N2G], m + 4 * D, m + 3 * D, h2n + (size_t)row * D, C.lane, (unsigned*)(A.ws + WS_H2N8) + (size_t)row * (D / 4));
    }
}

__device__ __forceinline__ void phase_p8(const Args& A, Ctx& C) {
    const float* logit = WSP(float, WS_LOGIT);
    int* tope = WSP(int, WS_TOPE); float* topw = WSP(float, WS_TOPW); int* pos = WSP(int, WS_POS);
    unsigned* cnt = WSP(unsigned, WS_CTL) + CW_CNT;
    const int gw = C.bid * 8 + C.wave, NGW = C.G * 8, lane = C.lane;
    const f32x4 rb = ((const f32x4*)A.in[I_RB])[lane];
    for (int tok = gw; tok < NLAT; tok += NGW) {
        const f32x4 lg = ((const f32x4*)(logit + (size_t)tok * NE))[lane];
        float s[4], sel[4];
#pragma unroll
        for (int i = 0; i < 4; ++i) { s[i] = sigmoidf_(lg[i]); sel[i] = s[i] + rb[i]; }
        float m1 = fmaxf(fmaxf(sel[0], sel[1]), fmaxf(sel[2], sel[3]));
        float m2;
        {
            float a = fmaxf(sel[0], sel[1]), bq = fminf(sel[0], sel[1]), cq = fmaxf(sel[2], sel[3]), dq = fminf(sel[2], sel[3]);
            m2 = fmaxf(fminf(a, cq), fmaxf(bq, dq)); }
#pragma unroll
        for (int o = 1; o < 8; o <<= 1) { const float o1 = __shfl_xor(m1, o), o2 = __shfl_xor(m2, o);
            const float n1 = fmaxf(m1, o1); const float n2 = fmaxf(fminf(m1, o1), fmaxf(m2, o2)); m1 = n1; m2 = n2; }
        const float gs = m1 + m2;
        const int grp = lane >> 3;
        int rank = 0;
#pragma unroll
        for (int gq = 0; gq < 8; ++gq) { const float og = __shfl(gs, gq * 8); rank += (og > gs || (og == gs && gq < grp)) ? 1 : 0; }
        const bool gsel = rank < 4;
        float cand[4];
#pragma unroll
        for (int i = 0; i < 4; ++i) cand[i] = gsel ? sel[i] : -INFINITY;
        int my_e = 0; float my_w = 0.f; float wsum = 0.f;
#pragma unroll
        for (int r = 0; r < 8; ++r) {
            float bv = cand[0]; int bi = 0;
#pragma unroll
            for (int i = 1; i < 4; ++i) if (cand[i] > bv) { bv = cand[i]; bi = i; }
            int be = lane * 4 + bi;
#define P8_STEP(CTRL) { const float ov = dpp_f<CTRL>(bv); const int oe = __builtin_amdgcn_update_dpp(0, be, CTRL, 0xf, 0xf, false); if (ov > bv || (ov == bv && oe < be)) { bv = ov; be = oe; } }
            P8_STEP(0x128) P8_STEP(0x124) P8_STEP(0x122) P8_STEP(0x121)
#undef P8_STEP
            float gv = rdlane(bv, 0); int ge = __builtin_amdgcn_readlane(be, 0);
#pragma unroll
            for (int rr = 1; rr < 4; ++rr) { const float ov = rdlane(bv, 16 * rr); const int oe = __builtin_amdgcn_readlane(be, 16 * rr); if (ov > gv || (ov == gv && oe < ge)) { gv = ov; ge = oe; } }
            be = ge;
            const int ol = be >> 2, oi = be & 3;
            const float mys = oi == 0 ? s[0] : (oi == 1 ? s[1] : (oi == 2 ? s[2] : s[3]));
            const float ws_ = __shfl(mys, ol);
            if (lane == ol) { if (oi == 0) cand[0] = -INFINITY; else if (oi == 1) cand[1] = -INFINITY; else if (oi == 2) cand[2] = -INFINITY; else cand[3] = -INFINITY; }
            wsum += ws_;
            if (lane == r) { my_e = be; my_w = ws_; }
        }
        if (lane < 8) {
            const float w = my_w / wsum * 2.5f;
            const unsigned p = atomicAdd(cnt + my_e, 1u);
            tope[(size_t)tok * 8 + lane] = my_e; topw[(size_t)tok * 8 + lane] = w; pos[(size_t)tok * 8 + lane] = (int)p;
        }
    }
}

__device__ __forceinline__ void tile_prefix(const Args& A, Ctx& C, LAS int* tb) {
    const unsigned* cnt = WSP(unsigned, WS_CTL) + CW_CNT;
    if (C.tid == 0) { int acc = 0; for (int e = 0; e < NE; ++e) { tb[e] = acc; acc += ((int)cnt[e] + 255) >> 8; } tb[NE] = acc; }
    __syncthreads();
}
__device__ __forceinline__ void phase_p9(const Args& A, Ctx& C) {
    LAS int* tb = (LAS int*)C.lds;
    tile_prefix(A, C, tb);
    const unsigned* cnt = WSP(unsigned, WS_CTL) + CW_CNT;
    const int* tope = WSP(int, WS_TOPE); const float* topw = WSP(float, WS_TOPW); const int* pos = WSP(int, WS_POS);
    int* rowl = WSP(int, WS_ROWL); float* roww = WSP(float, WS_ROWW); int* tile_e = WSP(int, WS_TILEE);
    const int nrt = tb[NE];
    for (int i = C.bid * 512 + C.tid; i < NLAT * 8; i += C.G * 512) { const int e = tope[i]; const int pr = tb[e] * 256 + pos[i]; rowl[pr] = i; roww[pr] = topw[i]; }
    for (int e = C.bid; e < NE; e += C.G) { const int n = (int)cnt[e], nt = tb[e + 1] - tb[e];
        for (int j = n + C.tid; j < nt * 256; j += 512) { rowl[tb[e] * 256 + j] = -1; roww[tb[e] * 256 + j] = 0.f; }
        for (int k = C.tid; k < nt; k += 512) tile_e[tb[e] + k] = e; }
    for (int i = C.bid * 512 + C.tid; i < NLAT; i += C.G * 512) { rowl[nrt * 256 + i] = i; roww[nrt * 256 + i] = 1.f; }
    for (int k = C.bid * 512 + C.tid; k < NLAT / 256; k += C.G * 512) tile_e[nrt + k] = NE;
    __syncthreads();
}

__device__ __forceinline__ void phase_moe(const Args& A, Ctx& C, int dry_shared) {
    LAS int* tb = (LAS int*)(C.lds + 131072);
    LAS int* tbl = tb + 320;
    tile_prefix(A, C, tb);
    pg8::MoeCtx M;
    M.nrt = tb[NE]; M.ntiles = M.nrt + NLAT / 256; M.G = C.G; M.vc = (C.G % 8 == 0) ? (C.bid % 8) * (C.G / 8) + C.bid / 8 : C.bid;
    M.tb = tb; M.tbl = tbl; M.cnt = WSP(unsigned, WS_CTL) + CW_CNT; M.rowl = WSP(int, WS_ROWL); M.roww = WSP(float, WS_ROWW);
    M.wexp = (const char*)(A.ws + WS_WEXP); M.h2n = (const char*)(A.ws + WS_H2N8); M.Hs = (char*)(A.ws + WS_HS) + (size_t)C.bid * 2 * 65536;
    M.Y = (unsigned char*)(A.ws + WS_Y); M.out = A.out; M.mod = WSP(const float, WS_MOD); M.dry_shared = dry_shared;
    pg8::gemm_moe(C.lds, M);
    __syncthreads();
}

__device__ __forceinline__ void phase_final(const Args& A, Ctx& C, float* dst) {
    const int gw = C.bid * 8 + C.wave, NGW = C.G * 8;
    const float* fg = A.in[I_FG]; const float* mod = WSP(const float, WS_MOD);
    const unsigned* Y = (const unsigned*)(A.ws + WS_Y);
    for (int row = gw; row < NLAT; row += NGW) {
        f32x4* xr = (f32x4*)(A.out + (size_t)row * D) + C.lane;
        const f32x4* gt = (const f32x4*)(mod + (size_t)(row >> 11) * MODW + 5 * D) + C.lane;
        const unsigned* yr = Y + (size_t)row * 8 * (D / 4) + C.lane;
        f32x4 v[4]; float s = 0.f;
#pragma unroll
        for (int j = 0; j < 4; ++j) {
            f32x4 a = (f32x4){0.f, 0.f, 0.f, 0.f};
#pragma unroll
            for (int sl = 0; sl < 8; ++sl) { const unsigned w = yr[sl * (D / 4) + 64 * j];
                const f32x2 lo = __builtin_amdgcn_cvt_pk_f32_fp8(w, false), hi = __builtin_amdgcn_cvt_pk_f32_fp8(w, true);
                a.x += lo.x; a.y += lo.y; a.z += hi.x; a.w += hi.y; }
            v[j] = xr[64 * j] + gt[64 * j] * a * (1.f / pg8::YSCALE);
            s += (v[j].x * v[j].x + v[j].y * v[j].y) + (v[j].z * v[j].z + v[j].w * v[j].w); }
        const float rstd = __builtin_amdgcn_rsqf(wave_sum(s) * (1.f / D) + NORM_EPS);
        f32x4* orow = (f32x4*)(dst + (size_t)row * D) + C.lane;
#pragma unroll
        for (int j = 0; j < 4; ++j) orow[64 * j] = v[j] * rstd * ((const f32x4*)fg)[C.lane + 64 * j];
    }
}

constexpr int NPHASE = 13;
__global__ void __launch_bounds__(512, 2) fwd_kernel(Args A) {
    extern __shared__ __attribute__((aligned(16))) unsigned char lds_raw[];
    Ctx C; C.lds = (lbyte*)lds_raw; C.tid = threadIdx.x; C.lane = C.tid & 63; C.wave = __builtin_amdgcn_readfirstlane(C.tid >> 6);
    C.G = gridDim.x; C.bid = blockIdx.x; C.a = &A;
    volatile LAS unsigned* misc = (volatile LAS unsigned*)(C.lds + LDS_MISC);
    if (C.tid < 16) misc[C.tid] = 0u;
    __syncthreads();
    XcdBarrier bar; bar.bar = WSP(unsigned, WS_CTL) + CW_BAR; bar.x = 0; bar.st = nullptr;
    const int lo = A.ph_lo, hi = A.ph_hi;
    const bool multi = (hi - lo) > 1;
    if (multi) bar = xcd_barrier_post(WSP(unsigned, WS_CTL) + CW_BAR, misc);
#ifndef PHASE_MASK
#define PHASE_MASK 0x1FFF
#endif
#define IN(k) (((PHASE_MASK >> (k)) & 1) && lo <= (k) && (k) < hi)
#define SEAM(k) do { if (IN(k) && IN((k) + 1)) xcd_barrier(bar); } while (0)
#ifndef REP_MASK
#define REP_MASK 0
#endif
#define REPS(k) (((REP_MASK >> (k)) & 1) ? 2 : 1)

    if (IN(0)) _Pragma("unroll") for (int rep = 0; rep < REPS(0); ++rep) { phase_p0(A, C); __syncthreads(); } SEAM(0);
    if (IN(1)) _Pragma("unroll") for (int rep = 0; rep < REPS(1); ++rep) { phase_p1(A, C); } SEAM(1);
    if (IN(2)) _Pragma("unroll") for (int rep = 0; rep < REPS(2); ++rep) {
        pg8::Gemm g{WSP(bf16_t, WS_XN), D}; pg8::StaticOrder S; S.init(NROWS, PLD, C.G, C.bid, WSP(bf16_t, WS_BTIN), D, 1);
        pg8::EpiBf16 E{WSP(bf16_t, WS_P), PLD, 1.f / SWIN};
        pg8::gemm_phase<pg8::EpiBf16, pg8::StaticOrder, false, 0, false, true>(C.lds, g, S, E);
    } SEAM(2);
    if (IN(3)) _Pragma("unroll") for (int rep = 0; rep < REPS(3); ++rep) { phase_gdn_prep(A, C); } SEAM(3);
#ifdef PROBE_BARRIERS
    if (multi) for (int kq = 0; kq < PROBE_BARRIERS; ++kq) xcd_barrier(bar);
#endif
    if (IN(4)) {
        for (int ch = C.bid; ch < NB * HB * 2; ch += C.G) gdn_chain_chunked(A, C, ch);
        for (int pr = C.bid; pr < NB * HA; pr += C.G) rwkv_pair_chunked(A, C, pr);
    } SEAM(4);
    if (IN(5)) _Pragma("unroll") for (int rep = 0; rep < REPS(5); ++rep) { phase_p4(A, C); } SEAM(5);
    if (IN(6)) _Pragma("unroll") for (int rep = 0; rep < REPS(6); ++rep) {
        pg8::Gemm g{WSP(bf16_t, WS_YMIX), D}; pg8::StaticOrder S; S.init(NLAT, D, C.G, C.bid, WSP(bf16_t, WS_BTOUT), D);
        pg8::EpiResGate E{A.in[I_X], A.out, WSP(float, WS_MOD), 2 * D};
        pg8::gemm_phase<pg8::EpiResGate, pg8::StaticOrder, false>(C.lds, g, S, E);
    } SEAM(6);
    if (IN(7)) _Pragma("unroll") for (int rep = 0; rep < REPS(7); ++rep) { phase_p6(A, C); __syncthreads(); convert_experts(A, C); __syncthreads(); } SEAM(7);
    if (IN(8)) _Pragma("unroll") for (int rep = 0; rep < REPS(8); ++rep) {
        pg8::Gemm g{WSP(bf16_t, WS_H2N), D}; pg8::StaticOrder S; S.init(NLAT, NE, C.G, C.bid, WSP(bf16_t, WS_BTR), D);
        pg8::EpiF32 E{WSP(float, WS_LOGIT), NE};
        pg8::gemm_phase<pg8::EpiF32, pg8::StaticOrder, false>(C.lds, g, S, E);
    } SEAM(8);
    if (IN(9)) { phase_p8(A, C); } SEAM(9);
    if (IN(10)) _Pragma("unroll") for (int rep = 0; rep < REPS(10); ++rep) { phase_p9(A, C); } SEAM(10);
    if (IN(11)) { phase_moe(A, C, 0); if (REPS(11) > 1) { __syncthreads(); phase_moe(A, C, 1); } } SEAM(11);
    if (IN(12)) { if (REPS(12) > 1) { phase_final(A, C, (float*)(A.ws + WS_WEXP)); __syncthreads(); } phase_final(A, C, A.out); }
#undef IN
#undef SEAM
}

extern "C" void kernel_launch(void* const* d_in, const int* in_sizes, int n_in, void* d_out, int out_size, void* d_ws, size_t ws_size, hipStream_t stream) {
    static int grid = 0;
    if (grid == 0) {
        if (n_in != 34 || out_size != NLAT * D || ws_size < WS_END) { fprintf(stderr, "kernel_launch: unexpected shapes (n_in %d out %d ws %zu need %zu)\n", n_in, out_size, ws_size, (size_t)WS_END); grid = -1; return; }
        int dev = 0, cus = 0;
        if (hipGetDevice(&dev) != hipSuccess || hipDeviceGetAttribute(&cus, hipDeviceAttributeMultiprocessorCount, dev) != hipSuccess) { grid = -1; return; }
        if (hipFuncSetAttribute((const void*)fwd_kernel, hipFuncAttributeMaxDynamicSharedMemorySize, LDS_BYTES) != hipSuccess) { fprintf(stderr, "kernel_launch: hipFuncSetAttribute failed\n"); grid = -1; return; }
        int per_cu = 0;
        if (hipOccupancyMaxActiveBlocksPerMultiprocessor(&per_cu, (const void*)fwd_kernel, 512, LDS_BYTES) != hipSuccess || per_cu < 1) { fprintf(stderr, "kernel_launch: occupancy query says %d\n", per_cu); }
        (void)hipGetLastError();
        grid = cus;
    }
    if (grid < 0) return;
    (void)hipMemsetAsync((char*)d_ws + WS_CTL, 0, CTL_BYTES, stream);
    Args a{};
    for (int i = 0; i < 34; ++i) a.in[i] = (const float*)d_in[i];
    a.out = (float*)d_out; a.ws = (unsigned char*)d_ws;
#if MK_PER_PHASE
    for (int p = 0; p < NPHASE; ++p) { a.ph_lo = p; a.ph_hi = p + 1; hipLaunchKernelGGL(fwd_kernel, dim3(grid), dim3(512), LDS_BYTES, stream, a); }
#else
    a.ph_lo = 0; a.ph_hi = NPHASE; hipLaunchKernelGGL(fwd_kernel, dim3(grid), dim3(512), LDS_BYTES, stream, a);
#endif
}
```

```cpp
#include <hip/hip_runtime.h>
#include <cstdio>
#include <cstdint>

#ifndef MK_PER_PHASE
#define MK_PER_PHASE 0
#endif

#define LAS __attribute__((address_space(3)))
typedef unsigned short bf16_t;
typedef short bf16x8 __attribute__((ext_vector_type(8)));
typedef float f32x4 __attribute__((ext_vector_type(4)));
typedef float f32x2 __attribute__((ext_vector_type(2)));
typedef unsigned u32x4 __attribute__((ext_vector_type(4)));
typedef unsigned u32x2 __attribute__((ext_vector_type(2)));
typedef int i32x4 __attribute__((ext_vector_type(4)));
typedef int i32x8 __attribute__((ext_vector_type(8)));
typedef LAS float lfloat;
typedef LAS unsigned char lbyte;

constexpr int D = 1024, NB = 32, SEQ = 2048, CTX = 256, GW = 64;
constexpr int NLAT = NB * SEQ;
constexpr int NCTX = NB * CTX;
constexpr int NROWS = NLAT + NCTX;
constexpr int DA = 512, HA = 8, NA = 64;
constexpr int RW_COLS = 1920, GD_COLS = 2064, IN_COLS = 3984, PLD = 4096;
constexpr int DB = 512, HB = 4, KB = 128;
constexpr int NE = 256, TOPK = 8, DE = 256;
constexpr int MODW = 6 * D;
constexpr float NORM_EPS = 1e-6f, RWKV_EPS = 64e-5f;
constexpr int MAXTILES = (NLAT * TOPK + NE * 255) / 256 + 1;

constexpr size_t MiB = 1u << 20;
constexpr size_t WS_CTL = 0, CTL_BYTES = 1 * MiB;
constexpr size_t WS_MOD = 1 * MiB;
constexpr size_t WS_BTIN = 2 * MiB, WS_BTOUT = 10 * MiB, WS_BTR = 12 * MiB, WS_BON = 13 * MiB, WS_GUPT = 17 * MiB, WS_NRM = 978 * MiB;
constexpr size_t WS_P = 18 * MiB, WS_XN = 594 * MiB, WS_YDIR = 594 * MiB, WS_YMIX = 850 * MiB;
constexpr size_t WS_H2N8 = 900 * MiB;
constexpr size_t WS_H2N = 18 * MiB, WS_LOGIT = 146 * MiB, WS_TOPE = 210 * MiB, WS_TOPW = 212 * MiB, WS_POS = 214 * MiB, WS_Y = 146 * MiB;
constexpr size_t WS_ROWL = 658 * MiB, WS_ROWW = 661 * MiB, WS_TILEE = 664 * MiB, WS_HS = 672 * MiB, WS_WEXP = 704 * MiB;
constexpr size_t WEXP_STRIDE = (size_t)(512 * 1024 + 1024 * 256);
constexpr float SW13 = 64.f, SW2 = 32.f, SHS = 8.f, SWIN = 32.f;
constexpr size_t WS_END = 1090 * MiB;
static_assert(WS_WEXP + 257 * WEXP_STRIDE <= WS_END && WS_Y + (size_t)NLAT * 8 * D <= WS_ROWL, "ws map");
constexpr int CW_BAR = 4096;
constexpr int CW_CNT = 16384;

constexpr int LDS_BYTES = 159744;
constexpr int LDS_MISC = LDS_BYTES - 64;

__device__ __forceinline__ unsigned f2bf(float f) { unsigned u = __builtin_bit_cast(unsigned, f); return (u + 0x7fffu + ((u >> 16) & 1u)) >> 16; }
typedef __bf16 bf16x2_t __attribute__((ext_vector_type(2)));
__device__ __forceinline__ unsigned cvtpk(float lo, float hi) { f32x2 v = {lo, hi}; return __builtin_bit_cast(unsigned, __builtin_convertvector(v, bf16x2_t)); }
__device__ __forceinline__ unsigned pk2(float lo, float hi) { return cvtpk(lo, hi); }
__device__ __forceinline__ unsigned pk4_fp8(float a, float b, float c, float d) { unsigned w = 0u;
    w = __builtin_amdgcn_cvt_pk_fp8_f32(__builtin_amdgcn_fmed3f(a, -448.f, 448.f), __builtin_amdgcn_fmed3f(b, -448.f, 448.f), w, false);
    w = __builtin_amdgcn_cvt_pk_fp8_f32(__builtin_amdgcn_fmed3f(c, -448.f, 448.f), __builtin_amdgcn_fmed3f(d, -448.f, 448.f), w, true); return w; }
__device__ __forceinline__ float bf2f(unsigned short b) { return __builtin_bit_cast(float, ((unsigned)b) << 16); }
__device__ __forceinline__ float bflo(unsigned w) { return __builtin_bit_cast(float, w << 16); }
__device__ __forceinline__ float bfhi(unsigned w) { return __builtin_bit_cast(float, w & 0xffff0000u); }
template <int CTRL> __device__ __forceinline__ float dpp_f(float v) { return __builtin_bit_cast(float, __builtin_amdgcn_update_dpp(0, __builtin_bit_cast(int, v), CTRL, 0xf, 0xf, false)); }
__device__ __forceinline__ float wave_sum(float v) {
    v += dpp_f<0x128>(v);
    v += dpp_f<0x124>(v);
    v += dpp_f<0x122>(v);
    v += dpp_f<0x121>(v);
    const int vi = __builtin_bit_cast(int, v);
    const float r0 = __builtin_bit_cast(float, __builtin_amdgcn_readlane(vi, 0)), r1 = __builtin_bit_cast(float, __builtin_amdgcn_readlane(vi, 16)),
                r2 = __builtin_bit_cast(float, __builtin_amdgcn_readlane(vi, 32)), r3 = __builtin_bit_cast(float, __builtin_amdgcn_readlane(vi, 48));
    return (r0 + r1) + (r2 + r3);
}
__device__ __forceinline__ float sigmoidf_(float x) { return __builtin_amdgcn_rcpf(1.f + __expf(-x)); }
__device__ __forceinline__ float siluf_(float x) { return x * __builtin_amdgcn_rcpf(1.f + __expf(-x)); }
__device__ __forceinline__ float softplusf_(float x) { return fmaxf(x, 0.f) + __logf(1.f + __expf(-fabsf(x))); }
__device__ __forceinline__ float tanhf_(float x) { const float e = __expf(-2.f * fabsf(x)); const float t = (1.f - e) * __builtin_amdgcn_rcpf(1.f + e); return x < 0.f ? -t : t; }

#define XB_TMO      128
#define XB_XCNT(j)  (256  + 64 * (j))
#define XB_XSUB(j)  (1280 + 64 * (j))
#define XB_XGEN(j)  (2304 + 64 * (j))
#define XB_TOP      3328
#define XB_TOPGEN   3392
#define XCD_BAR_WORDS 3456
#define XB_SPIN_CAP (1u << 22)
__device__ __forceinline__ unsigned xb_ld(unsigned* p)              { return __hip_atomic_load(p, __ATOMIC_RELAXED, __HIP_MEMORY_SCOPE_AGENT); }
__device__ __forceinline__ unsigned xb_add(unsigned* p, unsigned v) { return __hip_atomic_fetch_add(p, v, __ATOMIC_RELAXED, __HIP_MEMORY_SCOPE_AGENT); }
__device__ __forceinline__ unsigned xb_xcc_id() { return (unsigned)__builtin_amdgcn_s_getreg((3 << 11) | 20) & 0xFu; }
#define XB_SPIN(cond, bar) do { unsigned _sp = 0; while (cond) { __builtin_amdgcn_s_sleep(1); \
    if ((++_sp & 255u) == 0u) { if (xb_ld(&(bar)[XB_TMO])) break; if (_sp > XB_SPIN_CAP) { atomicAdd(&(bar)[XB_TMO], 1u); break; } } } } while (0)
struct XcdBarrier { unsigned* bar; unsigned x; volatile LAS unsigned* st; };
__device__ __forceinline__ XcdBarrier xcd_barrier_post(unsigned* bar, volatile LAS unsigned* st) {
    XcdBarrier b; b.bar = bar; b.x = xb_xcc_id(); b.st = st;
    if (threadIdx.x == 0) (void)xb_add(&bar[XB_XCNT(b.x)], 1u);
    return b;
}
__device__ __forceinline__ void xcd_barrier_complete(unsigned* bar, unsigned x, unsigned& nloc, unsigned& nx) {
    const unsigned G = gridDim.x * gridDim.y * gridDim.z;
    unsigned sum, cnt, mine, sp = 0u;
    for (;;) {
        sum = 0u; cnt = 0u; mine = 0u;
#pragma unroll
        for (unsigned j = 0; j < 16; ++j) { const unsigned c = xb_ld(&bar[XB_XCNT(j)]); sum += c; cnt += (c > 0u) ? 1u : 0u; mine = (j == x) ? c : mine; }
        if (sum == G) break;
        __builtin_amdgcn_s_sleep(1);
        if ((++sp & 255u) == 0u) { if (xb_ld(&bar[XB_TMO])) break; if (sp > XB_SPIN_CAP) { atomicAdd(&bar[XB_TMO], 1u); break; } }
    }
    nloc = mine > 0u ? mine : 1u; nx = cnt > 0u ? cnt : 1u;
}
__device__ __forceinline__ void xcd_barrier(const XcdBarrier& b) {
    asm volatile("s_waitcnt vmcnt(0)" ::: "memory");
    __syncthreads();
    if (threadIdx.x == 0) {
        unsigned* bar = b.bar;
        __builtin_amdgcn_s_waitcnt(0);
        unsigned nloc = b.st[0], nx = b.st[1];
        if (nloc == 0u) { xcd_barrier_complete(bar, b.x, nloc, nx); b.st[0] = nloc; b.st[1] = nx; }
        const unsigned old = xb_add(&bar[XB_XSUB(b.x)], 1u);
        const unsigned gen = old / nloc;
        if (old + 1u == (gen + 1u) * nloc) {
            __builtin_amdgcn_fence(__ATOMIC_RELEASE, "agent");
            asm volatile("s_waitcnt vmcnt(0)" ::: "memory");
            const unsigned og = xb_add(&bar[XB_TOP], 1u);
            const unsigned tg = og / nx;
            if (og + 1u == (tg + 1u) * nx) xb_add(&bar[XB_TOPGEN], 1u);
            else XB_SPIN(xb_ld(&bar[XB_TOPGEN]) == tg, bar);
            __builtin_amdgcn_fence(__ATOMIC_ACQUIRE, "agent");
            xb_add(&bar[XB_XGEN(b.x)], 1u);
            asm volatile("s_waitcnt vmcnt(0)" ::: "memory");
        } else {
            XB_SPIN(xb_ld(&bar[XB_XGEN(b.x)]) == gen, bar);
            __builtin_amdgcn_fence(__ATOMIC_ACQUIRE, "agent");
            asm volatile("s_waitcnt vmcnt(0)" ::: "memory");
        }
    }
    __syncthreads();
}

struct Args {
    const float* in[34];
    float* out;
    unsigned char* ws;
    int ph_lo, ph_hi;
};
enum { I_X = 0, I_C, I_CTX, I_CCTX, I_WADA, I_BADA, I_N1G, I_WIN, I_MU, I_W0, I_WUP, I_A0, I_AUP, I_GUP, I_KK, I_KA, I_RK, I_LNW, I_LNB,
       I_CONVW, I_ALOG, I_DTB, I_ONG, I_WOUT, I_N2G, I_RW, I_RB, I_EW1, I_EW3, I_EW2, I_SW1, I_SW3, I_SW2, I_FG };

namespace pg8 {
constexpr int BM = 256, BK = 64, HALF = 128, HTB = HALF * BK * 2, STAGE_BYTES = 8 * HTB, NXCD = 8, WGM = 8;
__host__ __device__ __forceinline__ int lds_byte(int r, int c) { const int st = (r >> 4) * 2 + (c >> 5), rr = r & 15, cc = c & 31, ob = rr * 64 + cc * 2; return st * 1024 + (ob ^ (((ob >> 9) & 1) << 5)); }
__host__ __device__ __forceinline__ void stage_rc(int b, int& R, int& C) { const int st = b / 1024, sb = b % 1024, swz = sb ^ (((sb >> 9) & 1) << 5); R = (st >> 1) * 16 + swz / 64; C = (st & 1) * 32 + (swz % 64) / 2; }
__host__ __device__ __forceinline__ int perm32(int rho) { const int n = rho >> 4, i = rho & 15; return 8 * (i >> 2) + 4 * n + (i & 3); }
struct Unit { int pm, pn; };
struct Gemm { const bf16_t* A; int K; };
struct StaticOrder {
    int nM, nN, nwg, G, c; const char* Bt; size_t tstepB;
    __device__ void init(int M, int N, int G_, int c_, const void* Bt_, int K, int es = 2) { nM = M / BM; nN = N / BM; nwg = nM * nN; G = G_; c = c_; Bt = (const char*)Bt_; tstepB = (size_t)BM * K * es; }
    __device__ bool next(int i, Unit& u) const {
        const long L = (long)i * G + c; if (L >= nwg) return false;
        int wgid = (int)L; { const int q = nwg / NXCD, r = nwg % NXCD, xcd = wgid % NXCD, off = wgid / NXCD; wgid = (xcd < r ? xcd * (q + 1) : r * (q + 1) + (xcd - r) * q) + off; }
        const int nig = WGM * nN, gid = wgid / nig, fm = gid * WGM, gsz = (nM - fm) < WGM ? (nM - fm) : WGM;
        u.pm = fm + ((wgid % nig) % gsz); u.pn = (wgid % nig) / gsz; return true;
    }
    __device__ __forceinline__ const char* bptr(const Unit& u) const { return Bt + (size_t)u.pn * tstepB; }
    __device__ __forceinline__ int rowsel(const Unit&, int) const { return 0; }
};
struct TileOrder {
    int nunits, npn, G, c; const int* tile_e; const char* wbase; size_t wstride, woff, tstepB; const int* rowl;
    __device__ bool next(int i, Unit& u) const { const int L = i * G + c; if (L >= nunits) return false; u.pm = L / npn; u.pn = L - u.pm * npn; return true; }
    __device__ __forceinline__ const char* bptr(const Unit& u) const { const int e = __builtin_amdgcn_readfirstlane(tile_e[u.pm]); return wbase + (size_t)e * wstride + woff + (size_t)u.pn * tstepB; }
    __device__ __forceinline__ int rowsel(const Unit& u, int r) const { const int t = rowl[(size_t)u.pm * 256 + r]; return t < 0 ? 0 : t; }
};
struct SeqOrder {
    int n; const char* Bt; size_t tstepB; const LAS int* rsel;
    __device__ bool next(int i, Unit& u) const { if (i >= n) return false; u.pm = 0; u.pn = i; return true; }
    __device__ __forceinline__ const char* bptr(const Unit& u) const { return Bt + (size_t)u.pn * tstepB; }
    __device__ __forceinline__ int rowsel(const Unit&, int r) const { return rsel[r]; }
};
__device__ __forceinline__ unsigned cvt_pk_bf16(float lo, float hi) { return cvtpk(lo, hi); }

template <class Epi, class Sched, bool GATHER, int A_AUX = 0, bool ALIGN = true, bool FP8 = false>
__device__ __forceinline__ void gemm_phase(lbyte* lds, const Gemm g, const Sched& S, const Epi& E) {
    int tid_ = threadIdx.x; asm volatile("" : "+v"(tid_));
    const int tid = tid_, wid = __builtin_amdgcn_readfirstlane(tid >> 6), lane = tid & 63, wr = wid >> 2, wc = wid & 3, fr = lane & 15, fq = lane >> 4;
    constexpr unsigned ES = FP8 ? 1u : 2u;
    const int K = g.K, nt = FP8 ? K / 128 : K / BK;
    Unit cur, nxt; int ui = 0;
    if (!S.next(0, cur)) return;
    int Rst[2], Cst[2];
    unsigned voffA[2], voffA1[2], voffB[2], nvA[2], nvA1[2];
#pragma unroll
    for (int i = 0; i < 2; ++i) { int R, C; stage_rc(tid * 16 + i * 8192, R, C); const int Rb = Epi::PERM ? ((R & ~31) + perm32(R & 31)) : R; Rst[i] = R; Cst[i] = C;
        if (GATHER) { voffA[i] = (unsigned)S.rowsel(cur, R) * (unsigned)K * ES + (unsigned)C * 2u; voffA1[i] = (unsigned)S.rowsel(cur, 128 + R) * (unsigned)K * ES + (unsigned)C * 2u; }
        else { voffA[i] = (unsigned)(R * K) * ES + (unsigned)C * 2u; voffA1[i] = voffA[i]; }
        nvA[i] = voffA[i]; nvA1[i] = voffA1[i];
        voffB[i] = (unsigned)(Rb * K) * ES + (unsigned)C * 2u; }
    const size_t kstep = (size_t)(BK * 2);
    const size_t hstep = (size_t)HALF * K * ES;
    const size_t hstepA = GATHER ? 0 : hstep;
    const size_t tstep = 2 * hstep;
    const unsigned ldsw = (unsigned)wid * 1024u;
    const int aoff = lds_byte(wr * 64 + fr, FP8 ? fq * 16 : fq * 8), boff = lds_byte(wc * 32 + fr, FP8 ? fq * 16 : fq * 8);
#define PG8_SA(b, h) (((b) * 2 + (h)) * HTB)
#define PG8_SB(b, h) ((4 + (b) * 2 + (h)) * HTB)
#define PG8_STAGE2(bufoff, gbase, v0, v1) do { \
        __builtin_amdgcn_global_load_lds((const unsigned*)((const char*)(gbase) + (v0)), (LAS unsigned*)(lds + (bufoff) + ldsw), 16, 0, 0); \
        __builtin_amdgcn_global_load_lds((const unsigned*)((const char*)(gbase) + (v1)), (LAS unsigned*)(lds + (bufoff) + ldsw + 8192), 16, 0, 0); } while (0)
#define PG8_STAGE2A(bufoff, gbase, v0, v1) do { if constexpr (A_AUX == 16) { \
        __builtin_amdgcn_global_load_lds((const unsigned*)((const char*)(gbase) + (v0)), (LAS unsigned*)(lds + (bufoff) + ldsw), 16, 0, 16); \
        __builtin_amdgcn_global_load_lds((const unsigned*)((const char*)(gbase) + (v1)), (LAS unsigned*)(lds + (bufoff) + ldsw + 8192), 16, 0, 16); } else { PG8_STAGE2(bufoff, gbase, v0, v1); } } while (0)
#define PG8_STAGE(bufoff, gbase, voff) PG8_STAGE2(bufoff, gbase, (voff)[0], (voff)[1])
#define PG8_STAGEA(bufoff, gbase, voff) PG8_STAGE2A(bufoff, gbase, (voff)[0], (voff)[1])
#define G_LD32(p) __builtin_shufflevector(*(const LAS i32x4*)(p), *(const LAS i32x4*)((p) + 16), 0, 1, 2, 3, 4, 5, 6, 7)
#define G_MFMA8(c, a, b) asm volatile("v_mfma_scale_f32_16x16x128_f8f6f4 %0, %1, %2, %0, %3, %3 op_sel_hi:[0,0,0]" : "+v"(c) : "v"(a), "v"(b), "v"(one_scale))
#define PG8_LDA(dst, b, h) do { if constexpr (FP8) { _Pragma("unroll") for (int m = 0; m < 4; ++m) dst##8[m] = G_LD32(lds + PG8_SA(b, h) + aoff + m * 2048); } else { \
        _Pragma("unroll") for (int m = 0; m < 4; ++m) _Pragma("unroll") for (int k = 0; k < 2; ++k) dst[m][k] = *(const LAS bf16x8*)(lds + PG8_SA(b, h) + aoff + m * 2048 + k * 1024); } } while (0)
#define PG8_LDB(dst, b, h) do { if constexpr (FP8) { _Pragma("unroll") for (int n = 0; n < 2; ++n) dst##8[n] = G_LD32(lds + PG8_SB(b, h) + boff + n * 2048); } else { \
        _Pragma("unroll") for (int n = 0; n < 2; ++n) _Pragma("unroll") for (int k = 0; k < 2; ++k) dst[n][k] = *(const LAS bf16x8*)(lds + PG8_SB(b, h) + boff + n * 2048 + k * 1024); } } while (0)
#define PG8_MMA(ai, bj, At, Bt) do { __builtin_amdgcn_s_setprio(1); if constexpr (FP8) { _Pragma("unroll") for (int m = 0; m < 4; ++m) _Pragma("unroll") for (int n = 0; n < 2; ++n) G_MFMA8(acc[ai][bj][m][n], Bt##8[n], At##8[m]); } else { \
        _Pragma("unroll") for (int m = 0; m < 4; ++m) _Pragma("unroll") for (int n = 0; n < 2; ++n) _Pragma("unroll") for (int k = 0; k < 2; ++k) \
        acc[ai][bj][m][n] = __builtin_amdgcn_mfma_f32_16x16x32_bf16(Bt[n][k], At[m][k], acc[ai][bj][m][n], 0, 0, 0); } __builtin_amdgcn_s_setprio(0); } while (0)
#define PG8_WAIT_V(n) asm volatile("s_waitcnt vmcnt(" #n ")" ::: "memory")
#define PG8_WAIT_L(n) asm volatile("s_waitcnt lgkmcnt(" #n ")" ::: "memory")
#define PG8_BAR __builtin_amdgcn_s_barrier()
#define PG8_SCHED __builtin_amdgcn_sched_barrier(0)
    f32x4 acc[2][2][4][2];
#pragma unroll
    for (int a = 0; a < 2; ++a)
#pragma unroll
        for (int b = 0; b < 2; ++b)
#pragma unroll
            for (int m = 0; m < 4; ++m)
#pragma unroll
                for (int n = 0; n < 2; ++n) acc[a][b][m][n] = (f32x4){0.f, 0.f, 0.f, 0.f};
    bf16x8 At[4][2], B0[2][2], B1[2][2]; i32x8 At8[4], B08[2], B18[2];
    int one_scale = 0x7F7F7F7F; asm volatile("" : "+v"(one_scale));
    const char* cA = (const char*)g.A + (GATHER ? (size_t)0 : (size_t)cur.pm * tstep); const char* cB = S.bptr(cur);
    PG8_STAGE(PG8_SB(0, 0), cB, voffB); PG8_STAGE(PG8_SB(0, 1), cB + hstep, voffB); PG8_STAGEA(PG8_SA(0, 0), cA, voffA); PG8_STAGEA(PG8_SA(0, 1), cA + hstepA, voffA1);
    if (wr == 1) PG8_BAR;
    PG8_WAIT_V(2); PG8_BAR;
    PG8_STAGE(PG8_SB(1, 0), cB + kstep, voffB); PG8_STAGEA(PG8_SA(1, 0), cA + kstep, voffA); PG8_STAGE(PG8_SB(1, 1), cB + hstep + kstep, voffB);
    PG8_WAIT_V(6); PG8_BAR;
    for (;;) {
        const bool has_next = S.next(ui + 1, nxt);
        const char* nA = has_next ? (const char*)g.A + (GATHER ? (size_t)0 : (size_t)nxt.pm * tstep) : cA; const char* nB = has_next ? S.bptr(nxt) : cB;
        for (int t = 0; t < nt; t += 2) {
            const bool last = (t == nt - 2);
            const char* a1 = cA + (size_t)(t + 1) * kstep;
            const char* a2 = last ? nA : cA + (size_t)(t + 2) * kstep; const char* b2 = last ? nB : cB + (size_t)(t + 2) * kstep;
            const char* a3 = a2 + kstep; const char* b3 = b2 + kstep;
            if (GATHER && last && has_next) {
#pragma unroll
                for (int i = 0; i < 2; ++i) { nvA[i] = (unsigned)S.rowsel(nxt, Rst[i]) * (unsigned)K * ES + (unsigned)Cst[i] * 2u; nvA1[i] = (unsigned)S.rowsel(nxt, 128 + Rst[i]) * (unsigned)K * ES + (unsigned)Cst[i] * 2u; }
            }
            const unsigned x0 = (GATHER && last) ? nvA[0] : voffA[0], x1 = (GATHER && last) ? nvA[1] : voffA[1];
            const unsigned y0 = (GATHER && last) ? nvA1[0] : voffA1[0], y1 = (GATHER && last) ? nvA1[1] : voffA1[1];
            PG8_LDB(B0, 0, 0); PG8_LDB(B1, 0, 1); PG8_SCHED; PG8_LDA(At, 0, 0); PG8_STAGEA(PG8_SA(1, 1), a1 + hstepA, voffA1);
            PG8_WAIT_V(8); PG8_WAIT_L(0); PG8_BAR; PG8_MMA(0, 0, At, B0); PG8_MMA(0, 1, At, B1); PG8_BAR; PG8_SCHED;
            PG8_LDA(At, 0, 1); PG8_STAGE(PG8_SB(0, 0), b2, voffB); PG8_STAGE(PG8_SB(0, 1), b2 + hstep, voffB); PG8_STAGE2A(PG8_SA(0, 0), a2, x0, x1);
            PG8_WAIT_V(8); PG8_WAIT_L(0); PG8_BAR; PG8_MMA(1, 0, At, B0); PG8_MMA(1, 1, At, B1); PG8_BAR; PG8_SCHED;
            PG8_LDB(B0, 1, 0); PG8_LDB(B1, 1, 1); PG8_SCHED; PG8_LDA(At, 1, 0); PG8_STAGE2A(PG8_SA(0, 1), a2 + hstepA, y0, y1);
            PG8_WAIT_V(8); PG8_WAIT_L(0); PG8_BAR; PG8_MMA(0, 0, At, B0); PG8_MMA(0, 1, At, B1); PG8_BAR; PG8_SCHED;
            PG8_LDA(At, 1, 1); PG8_STAGE(PG8_SB(1, 0), b3, voffB); PG8_STAGE(PG8_SB(1, 1), b3 + hstep, voffB); PG8_STAGE2A(PG8_SA(1, 0), a3, x0, x1);
            PG8_WAIT_V(8); PG8_WAIT_L(0); PG8_BAR; PG8_MMA(1, 0, At, B0); PG8_MMA(1, 1, At, B1); PG8_BAR; PG8_SCHED;
        }
        if (ALIGN && wr == 0) PG8_BAR;
        if constexpr (FP8) asm volatile("s_nop 15\n\ts_nop 15" ::: "memory");
        E(acc, cur, wr, wc, fr, fq);
        if (!has_next) break;
#pragma unroll
        for (int a = 0; a < 2; ++a)
#pragma unroll
            for (int b = 0; b < 2; ++b)
#pragma unroll
                for (int m = 0; m < 4; ++m)
#pragma unroll
                    for (int n = 0; n < 2; ++n) acc[a][b][m][n] = (f32x4){0.f, 0.f, 0.f, 0.f};
        cur = nxt; cA = nA; cB = nB; ++ui;
        if (GATHER) { voffA[0] = nvA[0]; voffA[1] = nvA[1]; voffA1[0] = nvA1[0]; voffA1[1] = nvA1[1]; }
        if (ALIGN && wr == 1) PG8_BAR;
    }
    PG8_WAIT_V(0);
    if (!ALIGN && wr == 0) PG8_BAR;
    PG8_BAR;
#undef PG8_SA
#undef PG8_SB
#undef PG8_STAGE
#undef PG8_STAGE2
#undef PG8_STAGE2A
#undef PG8_STAGEA
#undef G_LD32
#undef G_MFMA8
#undef PG8_LDA
#undef PG8_LDB
#undef PG8_MMA
#undef PG8_WAIT_V
#undef PG8_WAIT_L
#undef PG8_BAR
#undef PG8_SCHED
}

struct EpiBf16 {
    static constexpr bool PERM = true;
    bf16_t* O; int ldc; float scale;
    __device__ __forceinline__ void operator()(const f32x4 (&acc)[2][2][4][2], const Unit& u, int wr, int wc, int fr, int fq) const {
        const int row0 = u.pm * BM + wr * 64 + fr; const int col0 = u.pn * BM + wc * 32 + 8 * fq;
#pragma unroll
        for (int ai = 0; ai < 2; ++ai)
#pragma unroll
            for (int m = 0; m < 4; ++m) { bf16_t* rowp = O + (size_t)(row0 + ai * HALF + m * 16) * ldc + col0;
#pragma unroll
                for (int bj = 0; bj < 2; ++bj) { const f32x4 v0 = acc[ai][bj][m][0] * scale, v1 = acc[ai][bj][m][1] * scale;
                    u32x4 w; w.x = cvt_pk_bf16(v0[0], v0[1]); w.y = cvt_pk_bf16(v0[2], v0[3]); w.z = cvt_pk_bf16(v1[0], v1[1]); w.w = cvt_pk_bf16(v1[2], v1[3]);
                    *(u32x4*)(rowp + bj * HALF) = w; } }
    }
};
struct EpiF32 {
    static constexpr bool PERM = false;
    float* C; int ldc;
    __device__ __forceinline__ void operator()(const f32x4 (&acc)[2][2][4][2], const Unit& u, int wr, int wc, int fr, int fq) const {
        const int row0 = u.pm * BM + wr * 64 + fr, col0 = u.pn * BM + wc * 32 + 4 * fq;
#pragma unroll
        for (int ai = 0; ai < 2; ++ai)
#pragma unroll
            for (int m = 0; m < 4; ++m) { float* rowp = C + (size_t)(row0 + ai * HALF + m * 16) * ldc + col0;
#pragma unroll
                for (int bj = 0; bj < 2; ++bj)
#pragma unroll
                    for (int n = 0; n < 2; ++n) *(f32x4*)(rowp + bj * HALF + n * 16) = acc[ai][bj][m][n]; }
    }
};
struct EpiResGate {
    static constexpr bool PERM = false;
    const float* x; float* out; const float* mod; int gate_off;
    __device__ __forceinline__ void operator()(const f32x4 (&acc)[2][2][4][2], const Unit& u, int wr, int wc, int fr, int fq) const {
        const int row0 = u.pm * BM + wr * 64 + fr, col0 = u.pn * BM + wc * 32 + 4 * fq;
        const float* gp = mod + (size_t)((u.pm * BM) >> 11) * MODW + gate_off + col0;
        f32x4 gv[2][2];
#pragma unroll
        for (int bj = 0; bj < 2; ++bj)
#pragma unroll
            for (int n = 0; n < 2; ++n) gv[bj][n] = *(const f32x4*)(gp + bj * HALF + n * 16);
#pragma unroll
        for (int ai = 0; ai < 2; ++ai)
#pragma unroll
            for (int m = 0; m < 4; ++m) { const size_t off = (size_t)(row0 + ai * HALF + m * 16) * D + col0;
#pragma unroll
                for (int bj = 0; bj < 2; ++bj)
#pragma unroll
                    for (int n = 0; n < 2; ++n) { const f32x4 xv = *(const f32x4*)(x + off + bj * HALF + n * 16);
                        *(f32x4*)(out + off + bj * HALF + n * 16) = xv + gv[bj][n] * acc[ai][bj][m][n]; }
                asm volatile("" ::: "memory"); }
    }
};
struct EpiGLU {
    static constexpr bool PERM = true;
    bf16_t* H;
    __device__ __forceinline__ void operator()(const f32x4 (&acc)[2][2][4][2], const Unit& u, int wr, int wc, int fr, int fq) const {
        const int row0 = u.pm * BM + wr * 64 + fr; const int col0 = u.pn * 128 + wc * 32 + 8 * fq;
#pragma unroll
        for (int ai = 0; ai < 2; ++ai)
#pragma unroll
            for (int m = 0; m < 4; ++m) { bf16_t* rowp = H + (size_t)(row0 + ai * HALF + m * 16) * 256 + col0;
                f32x4 h0, h1;
#pragma unroll
                for (int j = 0; j < 4; ++j) { const float a0 = acc[ai][0][m][0][j], a1 = acc[ai][0][m][1][j];
                    h0[j] = siluf_(a0) * acc[ai][1][m][0][j]; h1[j] = siluf_(a1) * acc[ai][1][m][1][j]; }
                u32x4 w; w.x = cvt_pk_bf16(h0[0], h0[1]); w.y = cvt_pk_bf16(h0[2], h0[3]); w.z = cvt_pk_bf16(h1[0], h1[1]); w.w = cvt_pk_bf16(h1[2], h1[3]);
                *(u32x4*)rowp = w; }
    }
};
constexpr float YSCALE = 8.f;
struct EpiY {
    static constexpr bool PERM = true;
    unsigned char* Y; float* out; const float* mod; const LAS int* rtok; const LAS float* rw; int shared;
    __device__ __forceinline__ void operator()(const f32x4 (&acc)[2][2][4][2], const Unit& u, int wr, int wc, int fr, int fq) const {
        const int col0 = u.pn * BM + wc * 32 + 8 * fq;
#pragma unroll
        for (int ai = 0; ai < 2; ++ai)
#pragma unroll
            for (int m = 0; m < 4; ++m) { const int r = wr * 64 + fr + ai * HALF + m * 16; const int ts = rtok[r]; const float w = rw[r];
                if (ts >= 0) {
                    if (shared) { const unsigned goff = (unsigned)(ts >> 11) * MODW + 5 * D + col0; const unsigned ooff = (unsigned)ts * D + col0;
#pragma unroll
                        for (int bj = 0; bj < 2; ++bj)
#pragma unroll
                            for (int n = 0; n < 2; ++n) { const f32x4 gv = *(const f32x4*)(mod + goff + bj * HALF + n * 4); f32x4* op = (f32x4*)(out + ooff + bj * HALF + n * 4);
                                *op = *op + gv * acc[ai][bj][m][n]; }
                    } else { unsigned char* yp = Y + (size_t)(unsigned)ts * D + col0; const float ws_ = w * YSCALE;
#pragma unroll
                        for (int bj = 0; bj < 2; ++bj) { f32x4 v0 = acc[ai][bj][m][0] * ws_, v1 = acc[ai][bj][m][1] * ws_;
#pragma unroll
                                for (int j = 0; j < 4; ++j) { v0[j] = __builtin_amdgcn_fmed3f(v0[j], -448.f, 448.f); v1[j] = __builtin_amdgcn_fmed3f(v1[j], -448.f, 448.f); }
                            unsigned lo = 0u, hi = 0u;
                            lo = __builtin_amdgcn_cvt_pk_fp8_f32(v0[0], v0[1], lo, false); lo = __builtin_amdgcn_cvt_pk_fp8_f32(v0[2], v0[3], lo, true);
                            hi = __builtin_amdgcn_cvt_pk_fp8_f32(v1[0], v1[1], hi, false); hi = __builtin_amdgcn_cvt_pk_fp8_f32(v1[2], v1[3], hi, true);
                            u32x2 pk; pk.x = lo; pk.y = hi; *(u32x2*)(yp + bj * HALF) = pk; } } }
                asm volatile("" ::: "memory"); }
    }
};

struct MoeCtx {
    int ntiles, nrt, G, vc;
    const LAS int* tb; LAS int* tbl;
    const unsigned* cnt; const int* rowl; const float* roww;
    const char* wexp; const char* h2n; char* Hs; unsigned char* Y; float* out; const float* mod; int dry_shared;
};
__device__ __forceinline__ void gemm_moe(lbyte* lds, const MoeCtx& M) {
    int tid_ = threadIdx.x; asm volatile("" : "+v"(tid_));
    const int tid = tid_, wid = __builtin_amdgcn_readfirstlane(tid >> 6), lane = tid & 63, wr = wid >> 2, wc = wid & 3, fr = lane & 15, fq = lane >> 4;
    const int ntl = (M.ntiles - M.vc + M.G - 1) / M.G;
    if (M.vc >= M.ntiles) return;
    const int nunits = ntl * 6;
    const unsigned ldsw = (unsigned)wid * 1024u;
    const int aoff = lds_byte(wr * 64 + fr, fq * 16), boff = lds_byte(wc * 32 + fr, fq * 16);
    auto tile_expert = [&](int tile, int& e, int& k) { if (tile < M.nrt) { int lo = 0, hi = NE - 1; while (lo < hi) { const int mid = (lo + hi + 1) >> 1; if (M.tb[mid] <= tile) lo = mid; else hi = mid - 1; } e = lo; k = tile - M.tb[lo]; } else { e = NE; k = tile - M.nrt; } };
    auto fill = [&](int j) { if (j < ntl && tid < 256) { const int tile = M.vc + j * M.G; int e, k; tile_expert(tile, e, k); LAS int* T = M.tbl + (j % 3) * 768;
            int ts; float w;
            if (e < NE) { const int valid = (int)M.cnt[e] - 256 * k; if (tid < valid) { ts = M.rowl[(size_t)tile * 256 + tid]; w = M.roww[(size_t)tile * 256 + tid]; } else { ts = -1; w = 0.f; } T[tid] = ts < 0 ? 0 : (ts >> 3); }
            else { ts = k * 256 + tid; w = 1.f; T[tid] = ts; }
            T[256 + tid] = ts; ((LAS float*)T)[512 + tid] = w; } };
    struct UP { const char* aB; const char* bB; unsigned bh; int nt, kind, pn, slot, shared, e, hbuf, fillnext; };
    auto unit_params = [&](int ui, int prev_e, UP& u, unsigned (&oa)[4], unsigned (&ob)[2]) {
        int tq = threadIdx.x; asm volatile("" : "+v"(tq));
        int Rst[2], Cst[2], Rbp[2];
#pragma unroll
        for (int i = 0; i < 2; ++i) { int R, C; stage_rc(tq * 16 + i * 8192, R, C); Rst[i] = R; Cst[i] = C; Rbp[i] = (R & ~31) + perm32(R & 31); }
        int j, sub;
        if (ui < 2) { j = 0; sub = ui; }
        else { const int qq = ui - 2, g = qq / 6, r = qq - 6 * g; if (g < ntl - 1 && r < 2) { j = g + 1; sub = r; } else { j = g; sub = (g < ntl - 1) ? r : r + 2; } }
        const int tile = M.vc + j * M.G; int e, k;
        if (sub == 0 || sub == 2) tile_expert(tile, e, k); else e = prev_e;
        u.e = e;
        const char* w = M.wexp + (size_t)e * WEXP_STRIDE;
        u.slot = j % 3; u.hbuf = j & 1; u.fillnext = (sub == 1) ? j + 1 : -1; u.shared = (e == NE) ? 1 : 0;
        if (sub < 2) { u.kind = 0; u.pn = sub; u.nt = D / 128; u.aB = M.h2n; u.bB = w + (size_t)sub * 256 * D; u.bh = 128u * D;
            const LAS int* T = M.tbl + (j % 3) * 768;
#pragma unroll
            for (int i = 0; i < 2; ++i) { oa[i] = (unsigned)T[Rst[i]] * (unsigned)D + 2u * (unsigned)Cst[i]; oa[2 + i] = (unsigned)T[128 + Rst[i]] * (unsigned)D + 2u * (unsigned)Cst[i]; ob[i] = (unsigned)(Rbp[i] * D + 2 * Cst[i]); } }
        else { u.kind = 1; u.pn = sub - 2; u.nt = DE / 128; u.aB = M.Hs + (j & 1) * 65536; u.bB = w + (size_t)512 * 1024 + (size_t)(sub - 2) * 256 * DE; u.bh = 128u * DE;
#pragma unroll
            for (int i = 0; i < 2; ++i) { oa[i] = (unsigned)(Rst[i] * DE + 2 * Cst[i]); oa[2 + i] = (unsigned)((128 + Rst[i]) * DE + 2 * Cst[i]); ob[i] = (unsigned)(Rbp[i] * DE + 2 * Cst[i]); } }
    };
#define PG8_SA(b, h) (((b) * 2 + (h)) * HTB)
#define PG8_SB(b, h) ((4 + (b) * 2 + (h)) * HTB)
#define MOE_DMA(bufoff, ptr, aux) __builtin_amdgcn_global_load_lds((const unsigned*)(ptr), (LAS unsigned*)(lds + (bufoff)), 16, 0, aux)
#define MOE_STA(bufoff, base, o0, o1) do { MOE_DMA((bufoff) + ldsw, (base) + (o0), 16); MOE_DMA((bufoff) + ldsw + 8192, (base) + (o1), 16); } while (0)
#define MOE_STAK(kindv, bufoff, base, o0, o1) do { if ((kindv) == 0) { MOE_DMA((bufoff) + ldsw, (base) + (o0), 0); MOE_DMA((bufoff) + ldsw + 8192, (base) + (o1), 0); } else MOE_STA(bufoff, base, o0, o1); } while (0)
#define MOE_STB(bufoff, base, o0, o1) do { MOE_DMA((bufoff) + ldsw, (base) + (o0), 0); MOE_DMA((bufoff) + ldsw + 8192, (base) + (o1), 0); } while (0)
#define MOE_LD32(p) __builtin_shufflevector(*(const LAS i32x4*)(p), *(const LAS i32x4*)((p) + 16), 0, 1, 2, 3, 4, 5, 6, 7)
#define PG8_LDA(dst, b, h) do { _Pragma("unroll") for (int m = 0; m < 4; ++m) dst[m] = MOE_LD32(lds + PG8_SA(b, h) + aoff + m * 2048); } while (0)
#define PG8_LDB(dst, b, h) do { _Pragma("unroll") for (int n = 0; n < 2; ++n) dst[n] = MOE_LD32(lds + PG8_SB(b, h) + boff + n * 2048); } while (0)
#define MOE_MFMA(c, a, b) asm volatile("v_mfma_scale_f32_16x16x128_f8f6f4 %0, %1, %2, %0, %3, %3 op_sel_hi:[0,0,0]" : "+v"(c) : "v"(a), "v"(b), "v"(one_scale))
#define PG8_MMA(ai, bj, At, Bt) do { __builtin_amdgcn_s_setprio(1); _Pragma("unroll") for (int m = 0; m < 4; ++m) _Pragma("unroll") for (int n = 0; n < 2; ++n) \
        MOE_MFMA(acc[ai][bj][m][n], Bt[n], At[m]); __builtin_amdgcn_s_setprio(0); } while (0)
#define PG8_WAIT_V(n) asm volatile("s_waitcnt vmcnt(" #n ")" ::: "memory")
#define PG8_WAIT_L(n) asm volatile("s_waitcnt lgkmcnt(" #n ")" ::: "memory")
#define PG8_BAR __builtin_amdgcn_s_barrier()
#define PG8_SCHED __builtin_amdgcn_sched_barrier(0)
    fill(0);
    asm volatile("s_waitcnt vmcnt(0) lgkmcnt(0)" ::: "memory");
    __syncthreads();
    UP cu, nu; unsigned oa[4], ob[2], na[4], nb[2];
    unit_params(0, 0, cu, oa, ob);
    nu = cu;
#pragma unroll
    for (int i = 0; i < 4; ++i) na[i] = oa[i];
    nb[0] = ob[0]; nb[1] = ob[1];
    f32x4 acc[2][2][4][2];
#pragma unroll
    for (int a = 0; a < 2; ++a)
#pragma unroll
        for (int b = 0; b < 2; ++b)
#pragma unroll
            for (int m = 0; m < 4; ++m)
#pragma unroll
                for (int n = 0; n < 2; ++n) acc[a][b][m][n] = (f32x4){0.f, 0.f, 0.f, 0.f};
    i32x8 At[4], B0[2], B1[2];
    int one_scale = 0x7F7F7F7F; asm volatile("" : "+v"(one_scale));
    const size_t kstep = (size_t)128;
    {   const char* cA = cu.aB; const char* cB = cu.bB;
        MOE_STB(PG8_SB(0, 0), cB, ob[0], ob[1]); MOE_STB(PG8_SB(0, 1), cB + cu.bh, ob[0], ob[1]); MOE_STAK(cu.kind, PG8_SA(0, 0), cA, oa[0], oa[1]); MOE_STAK(cu.kind, PG8_SA(0, 1), cA, oa[2], oa[3]);
        if (wr == 1) PG8_BAR;
        PG8_WAIT_V(2); PG8_BAR;
        MOE_STB(PG8_SB(1, 0), cB + kstep, ob[0], ob[1]); MOE_STAK(cu.kind, PG8_SA(1, 0), cA + kstep, oa[0], oa[1]); MOE_STB(PG8_SB(1, 1), cB + cu.bh + kstep, ob[0], ob[1]);
        PG8_WAIT_V(6); PG8_BAR; }
    for (int ui = 0;; ++ui) {
        const bool has_next = (ui + 1 < nunits);
        if (cu.fillnext >= 0) fill(cu.fillnext);
        const char* cA = cu.aB; const char* cB = cu.bB; const int nt = cu.nt; const unsigned bh = cu.bh;
        for (int t = 0; t < nt; t += 2) {
            const bool last = (t == nt - 2);
            if (last && has_next) unit_params(ui + 1, cu.e, nu, na, nb);
            const char* a1 = cA + (size_t)(t + 1) * kstep;
            const char* a2 = last ? nu.aB : cA + (size_t)(t + 2) * kstep; const char* b2 = last ? nu.bB : cB + (size_t)(t + 2) * kstep;
            const char* a3 = a2 + kstep; const char* b3 = b2 + kstep;
            const unsigned bh2 = last ? nu.bh : bh;
            const unsigned x0 = last ? na[0] : oa[0], x1 = last ? na[1] : oa[1], y0 = last ? na[2] : oa[2], y1 = last ? na[3] : oa[3];
            const unsigned z0 = last ? nb[0] : ob[0], z1 = last ? nb[1] : ob[1];
            const int k2 = last ? nu.kind : cu.kind;
            PG8_LDB(B0, 0, 0); PG8_LDB(B1, 0, 1); PG8_SCHED; PG8_LDA(At, 0, 0); MOE_STAK(cu.kind, PG8_SA(1, 1), a1, oa[2], oa[3]);
            PG8_WAIT_V(8); PG8_WAIT_L(0); PG8_BAR; PG8_MMA(0, 0, At, B0); PG8_MMA(0, 1, At, B1); PG8_BAR; PG8_SCHED;
            PG8_LDA(At, 0, 1); MOE_STB(PG8_SB(0, 0), b2, z0, z1); MOE_STB(PG8_SB(0, 1), b2 + bh2, z0, z1); MOE_STAK(k2, PG8_SA(0, 0), a2, x0, x1);
            PG8_WAIT_V(8); PG8_WAIT_L(0); PG8_BAR; PG8_MMA(1, 0, At, B0); PG8_MMA(1, 1, At, B1); PG8_BAR; PG8_SCHED;
            PG8_LDB(B0, 1, 0); PG8_LDB(B1, 1, 1); PG8_SCHED; PG8_LDA(At, 1, 0); MOE_STAK(k2, PG8_SA(0, 1), a2, y0, y1);
            PG8_WAIT_V(8); PG8_WAIT_L(0); PG8_BAR; PG8_MMA(0, 0, At, B0); PG8_MMA(0, 1, At, B1); PG8_BAR; PG8_SCHED;
            PG8_LDA(At, 1, 1); MOE_STB(PG8_SB(1, 0), b3, z0, z1); MOE_STB(PG8_SB(1, 1), b3 + bh2, z0, z1); MOE_STAK(k2, PG8_SA(1, 0), a3, x0, x1);
            PG8_WAIT_V(8); PG8_WAIT_L(0); PG8_BAR; PG8_MMA(1, 0, At, B0); PG8_MMA(1, 1, At, B1); PG8_BAR; PG8_SCHED;
        }
        if (wr == 0) PG8_BAR;
        asm volatile("s_nop 15\n\ts_nop 15" ::: "memory");
        if (cu.kind == 0) {
            const int row0 = wr * 64 + fr; const int col0 = cu.pn * 128 + wc * 32 + 8 * fq;
            constexpr float is13 = 1.f / SW13;
#pragma unroll
            for (int ai = 0; ai < 2; ++ai)
#pragma unroll
                for (int m = 0; m < 4; ++m) { unsigned char* rowp = (unsigned char*)M.Hs + cu.hbuf * 65536 + (size_t)(row0 + ai * HALF + m * 16) * 256 + col0;
                    f32x4 h0, h1;
#pragma unroll
                    for (int j = 0; j < 4; ++j) { h0[j] = siluf_(acc[ai][0][m][0][j] * is13) * (acc[ai][1][m][0][j] * (is13 * SHS)); h1[j] = siluf_(acc[ai][0][m][1][j] * is13) * (acc[ai][1][m][1][j] * (is13 * SHS)); }
                    u32x2 w; w.x = pk4_fp8(h0[0], h0[1], h0[2], h0[3]); w.y = pk4_fp8(h1[0], h1[1], h1[2], h1[3]);
                    *(u32x2*)rowp = w; }
        } else {
            const LAS int* rtok = M.tbl + cu.slot * 768 + 256; const LAS float* rw = (const LAS float*)(M.tbl + cu.slot * 768 + 512);
            const int col0 = cu.pn * BM + wc * 32 + 8 * fq;
#pragma unroll
            for (int ai = 0; ai < 2; ++ai)
#pragma unroll
                for (int m = 0; m < 4; ++m) { const int r = wr * 64 + fr + ai * HALF + m * 16; const int ts = rtok[r]; const float w = rw[r];
                    if (ts >= 0) {
                        if (cu.shared) { const unsigned goff = (unsigned)(ts >> 11) * MODW + 5 * D + col0; const unsigned ooff = (unsigned)ts * D + col0;
#pragma unroll
                            for (int bj = 0; bj < 2; ++bj)
#pragma unroll
                                for (int n = 0; n < 2; ++n) { const f32x4 gv = *(const f32x4*)(M.mod + goff + bj * HALF + n * 4); f32x4* op = (f32x4*)(M.out + ooff + bj * HALF + n * 4);
                                    const f32x4 nv = *op + gv * acc[ai][bj][m][n] * (1.f / (SHS * SW2)); if (!M.dry_shared) *op = nv; else asm volatile("" :: "v"(nv)); }
                        } else { unsigned char* yp = M.Y + (size_t)(unsigned)ts * D + col0; const float ws_ = w * (YSCALE / (SHS * SW2));
#pragma unroll
                            for (int bj = 0; bj < 2; ++bj) { f32x4 v0 = acc[ai][bj][m][0] * ws_, v1 = acc[ai][bj][m][1] * ws_;
#pragma unroll
                                for (int j = 0; j < 4; ++j) { v0[j] = __builtin_amdgcn_fmed3f(v0[j], -448.f, 448.f); v1[j] = __builtin_amdgcn_fmed3f(v1[j], -448.f, 448.f); }
                                unsigned lo = 0u, hi = 0u;
                                lo = __builtin_amdgcn_cvt_pk_fp8_f32(v0[0], v0[1], lo, false); lo = __builtin_amdgcn_cvt_pk_fp8_f32(v0[2], v0[3], lo, true);
                                hi = __builtin_amdgcn_cvt_pk_fp8_f32(v1[0], v1[1], hi, false); hi = __builtin_amdgcn_cvt_pk_fp8_f32(v1[2], v1[3], hi, true);
                                u32x2 pk; pk.x = lo; pk.y = hi; *(u32x2*)(yp + bj * HALF) = pk; } } }
                    asm volatile("" ::: "memory"); }
        }
        if (!has_next) break;
#pragma unroll
        for (int a = 0; a < 2; ++a)
#pragma unroll
            for (int b = 0; b < 2; ++b)
#pragma unroll
                for (int m = 0; m < 4; ++m)
#pragma unroll
                    for (int n = 0; n < 2; ++n) acc[a][b][m][n] = (f32x4){0.f, 0.f, 0.f, 0.f};
        cu = nu;
#pragma unroll
        for (int i = 0; i < 4; ++i) oa[i] = na[i];
        ob[0] = nb[0]; ob[1] = nb[1];
        if (wr == 1) PG8_BAR;
    }
    PG8_WAIT_V(0);
    PG8_BAR;
#undef PG8_SA
#undef PG8_SB
#undef MOE_DMA
#undef MOE_STA
#undef MOE_STAK
#undef MOE_STB
#undef PG8_LDA
#undef PG8_LDB
#undef MOE_LD32
#undef MOE_MFMA
#undef PG8_MMA
#undef PG8_WAIT_V
#undef PG8_WAIT_L
#undef PG8_BAR
#undef PG8_SCHED
}
}

struct Ctx {
    lbyte* lds; int tid, lane, wave, G, bid;
    const Args* a;
};
#define WSP(T, off) ((T*)(A.ws + (off)))

template <class RowMap>
__device__ __forceinline__ void transpose_item(const float* W, int K, int N, bf16_t* WT, RowMap rowmap, lfloat* scr, int item, int lane) {
    const int nblk = N / 32, kb = item / nblk, nb = item % nblk, k0 = 64 * kb, n0 = 32 * nb;
#pragma unroll 8
    for (int i = 0; i < 32; ++i) { const int kk = 2 * i + (lane >> 5); scr[kk * 33 + (lane & 31)] = W[(size_t)(k0 + kk) * N + n0 + (lane & 31)]; }
    asm volatile("s_waitcnt lgkmcnt(0)" ::: "memory");
    const int c = lane & 7;
#pragma unroll
    for (int j = 0; j < 4; ++j) { const int n = (lane >> 3) + 8 * j; const lfloat* s = scr + (8 * c) * 33 + n;
        u32x4 o; o.x = pk2(s[0 * 33], s[1 * 33]); o.y = pk2(s[2 * 33], s[3 * 33]); o.z = pk2(s[4 * 33], s[5 * 33]); o.w = pk2(s[6 * 33], s[7 * 33]);
        *(u32x4*)(WT + (size_t)rowmap(n0 + n) * K + k0 + 8 * c) = o; }
    asm volatile("s_waitcnt lgkmcnt(0)" ::: "memory");
}
template <class RowMap>
__device__ __forceinline__ void transpose_item_fp8(const float* W, int K, int N, unsigned char* WT, RowMap rowmap, float sc, lfloat* scr, int item, int lane) {
    const int nblk = N / 32, kb = item / nblk, nb = item % nblk, k0 = 64 * kb, n0 = 32 * nb;
#pragma unroll 8
    for (int i = 0; i < 32; ++i) { const int kk = 2 * i + (lane >> 5); scr[kk * 33 + (lane & 31)] = W[(size_t)(k0 + kk) * N + n0 + (lane & 31)] * sc; }
    asm volatile("s_waitcnt lgkmcnt(0)" ::: "memory");
    const int c = lane & 7;
#pragma unroll
    for (int j = 0; j < 4; ++j) { const int n = (lane >> 3) + 8 * j; const lfloat* s = scr + (8 * c) * 33 + n;
        u32x2 o; o.x = pk4_fp8(s[0 * 33], s[1 * 33], s[2 * 33], s[3 * 33]); o.y = pk4_fp8(s[4 * 33], s[5 * 33], s[6 * 33], s[7 * 33]);
        *(u32x2*)(WT + (size_t)rowmap(n0 + n) * K + k0 + 8 * c) = o; }
    asm volatile("s_waitcnt lgkmcnt(0)" ::: "memory");
}
struct RowId { __device__ int operator()(int n) const { return n; } };
struct RowGLU { int base; __device__ int operator()(int n) const { return ((n >> 7) << 8) + base + (n & 127); } };

__device__ __forceinline__ void norm_mod_row(const float* xrow, const float* g, const float* sc, const float* sh, bf16_t* orow, int lane, unsigned* o8row = nullptr) {
    const f32x4* xr = (const f32x4*)xrow + lane;
    f32x4 v[4]; float s = 0.f;
#pragma unroll
    for (int j = 0; j < 4; ++j) { v[j] = xr[64 * j]; s += (v[j].x * v[j].x + v[j].y * v[j].y) + (v[j].z * v[j].z + v[j].w * v[j].w); }
    const float rstd = __builtin_amdgcn_rsqf(wave_sum(s) * (1.f / D) + NORM_EPS);
    u32x2* o8 = (u32x2*)orow + lane;
#pragma unroll
    for (int j = 0; j < 4; ++j) { const f32x4 gg = ((const f32x4*)g)[lane + 64 * j], ss = ((const f32x4*)sc)[lane + 64 * j], hh = ((const f32x4*)sh)[lane + 64 * j];
        const f32x4 y = v[j] * rstd * gg * (ss + 1.f) + hh;
        if (orow) { u32x2 w; w.x = pk2(y.x, y.y); w.y = pk2(y.z, y.w); o8[64 * j] = w; }
        if (o8row) o8row[lane + 64 * j] = pk4_fp8(y.x, y.y, y.z, y.w); }
}

__device__ __forceinline__ void phase_p0(const Args& A, Ctx& C) {
    float* mod = WSP(float, WS_MOD);
    {
        lfloat* sc = (lfloat*)C.lds;
        lfloat* red = (lfloat*)(C.lds + 17 * 1024 * 4);
        const float* wada = A.in[I_WADA]; const float* bada = A.in[I_BADA];
        for (int it = C.bid; it < 96 * 2; it += C.G) {
            const int chunk = it >> 1, pass = it & 1, r0 = pass * 17, nr = pass ? 16 : 17, col0 = chunk * 64;
            __syncthreads();
            for (int i = C.tid; i < nr * 1024; i += 512) { const int r = i >> 10, k = i & 1023; const int rr = r0 + r;
                const float cv = rr < 32 ? A.in[I_C][rr * 1024 + k] : A.in[I_CCTX][k]; sc[r * 1024 + k] = siluf_(cv); }
            __syncthreads();
            const int col = C.tid & 63, kq = C.tid >> 6;
            float acc[17];
#pragma unroll
            for (int r = 0; r < 17; ++r) acc[r] = 0.f;
            for (int k = kq * 128; k < kq * 128 + 128; k += 4) {
                float w[4];
#pragma unroll
                for (int j = 0; j < 4; ++j) w[j] = wada[(size_t)(k + j) * MODW + col0 + col];
#pragma unroll
                for (int r = 0; r < 17; ++r) { const f32x4 s4 = *(const LAS f32x4*)(sc + r * 1024 + k); acc[r] += s4.x * w[0] + s4.y * w[1] + s4.z * w[2] + s4.w * w[3]; }
            }
#pragma unroll
            for (int r = 0; r < 17; ++r) red[(kq * 17 + r) * 64 + col] = acc[r];
            __syncthreads();
            for (int i = C.tid; i < nr * 64; i += 512) { const int r = i >> 6, cc = i & 63; float s = 0.f;
#pragma unroll
                for (int q = 0; q < 8; ++q) s += red[(q * 17 + r) * 64 + cc];
                mod[(size_t)(r0 + r) * MODW + col0 + cc] = s + bada[col0 + cc]; }
        }
        __syncthreads();
    }
    {
        lfloat* scr = (lfloat*)(C.lds + C.wave * 16384);
        const int gw = C.bid * 8 + C.wave, NGW = C.G * 8;
        unsigned char* btin8 = A.ws + WS_BTIN; bf16_t* btout = WSP(bf16_t, WS_BTOUT); bf16_t* btr = WSP(bf16_t, WS_BTR);
        constexpr int I_IN = (D / 64) * 124, I_OUT = (D / 64) * (D / 32), I_R = (D / 64) * (NE / 32), I_G = (128 / 64) * (DA / 32);
        for (int it = gw; it < I_IN + I_OUT + I_R + I_G; it += NGW) {
            int r = it;
            if (r < I_IN) {
                const int kb = r / 124, nb = r % 124, k0 = 64 * kb, n0 = 32 * nb; const float* W = A.in[I_WIN];
#pragma unroll 8
                for (int i = 0; i < 32; ++i) { const int kk = 2 * i + (C.lane >> 5); scr[kk * 33 + (C.lane & 31)] = W[(size_t)(k0 + kk) * IN_COLS + n0 + (C.lane & 31)] * SWIN; }
                asm volatile("s_waitcnt lgkmcnt(0)" ::: "memory");
                const int c = C.lane & 7;
#pragma unroll
                for (int j = 0; j < 4; ++j) { const int n = (C.lane >> 3) + 8 * j; const lfloat* s = scr + (8 * c) * 33 + n;
                    u32x2 o; o.x = pk4_fp8(s[0 * 33], s[1 * 33], s[2 * 33], s[3 * 33]); o.y = pk4_fp8(s[4 * 33], s[5 * 33], s[6 * 33], s[7 * 33]);
                    *(u32x2*)(btin8 + (size_t)(n0 + n) * D + k0 + 8 * c) = o; }
                asm volatile("s_waitcnt lgkmcnt(0)" ::: "memory");
                continue; }
            r -= I_IN;
            if (r < I_OUT) { transpose_item(A.in[I_WOUT], D, D, btout, RowId(), scr, r, C.lane); continue; } r -= I_OUT;
            if (r < I_R) { transpose_item(A.in[I_RW], D, NE, btr, RowId(), scr, r, C.lane); continue; } r -= I_R;
            transpose_item(A.in[I_GUP], 128, DA, WSP(bf16_t, WS_GUPT), RowId(), scr, r, C.lane);
        }
        for (int i = C.bid * 512 + C.tid; i < 16 * D / 4; i += C.G * 512) { const int n = 3968 + (i >> 8), k = (i & 255) * 4; const float* W = A.in[I_WIN];
            *(unsigned*)(btin8 + (size_t)n * D + k) = pk4_fp8(W[(size_t)k * IN_COLS + n] * SWIN, W[(size_t)(k + 1) * IN_COLS + n] * SWIN, W[(size_t)(k + 2) * IN_COLS + n] * SWIN, W[(size_t)(k + 3) * IN_COLS + n] * SWIN); }
        for (int i = C.bid * 512 + C.tid; i < (PLD - IN_COLS) * D / 16; i += C.G * 512) ((u32x4*)(btin8 + (size_t)IN_COLS * D))[i] = (u32x4){0u, 0u, 0u, 0u};
    }
}

__device__ __forceinline__ void phase_p1(const Args& A, Ctx& C) {
    const float* mod = WSP(float, WS_MOD); bf16_t* xn = WSP(bf16_t, WS_XN);
    const int gw = C.bid * 8 + C.wave, NGW = C.G * 8;
    for (int row = gw; row < NROWS; row += NGW) {
        const float* xr; int mb;
        if (row < NLAT) { xr = A.in[I_X] + (size_t)row * D; mb = row >> 11; } else { xr = A.in[I_CTX] + (size_t)(row - NLAT) * D; mb = 32; }
        const float* m = mod + (size_t)mb * MODW;
        norm_mod_row(xr, A.in[I_N1G], m + D, m, nullptr, C.lane, (unsigned*)(A.ws + WS_XN) + (size_t)row * (D / 4));
    }
}

template <int NK>
__device__ __forceinline__ f32x4 mm_tile(const lbyte* Ap, int lda, const lbyte* Bp, int ldb, f32x4 acc, int lane) {
    const int r = lane & 15, g = lane >> 4;
#pragma unroll
    for (int ks = 0; ks < NK; ++ks) {
        const bf16x8 a = *(const LAS bf16x8*)(Ap + r * lda + ks * 64 + g * 16);
        const bf16x8 b = *(const LAS bf16x8*)(Bp + r * ldb + ks * 64 + g * 16);
        acc = __builtin_amdgcn_mfma_f32_16x16x32_bf16(a, b, acc, 0, 0, 0);
    }
    return acc;
}

__device__ __forceinline__ void st_bf16x4(lbyte* p, f32x4 v) { u32x2 w; w.x = cvtpk(v.x, v.y); w.y = cvtpk(v.z, v.w); *(LAS u32x2*)p = w; }
__device__ __forceinline__ void st_bf16(lbyte* p, float v) { *(LAS unsigned short*)p = (unsigned short)cvtpk(v, v); }
__device__ __forceinline__ float rdlane(float v, int l) { return __builtin_bit_cast(float, __builtin_amdgcn_readlane(__builtin_bit_cast(int, v), l)); }

__device__ __forceinline__ void tri_inv16(const f32x4 m, int lane, float (&X)[16]) {
#pragma unroll
    for (int i = 0; i < 16; ++i) {
        float x0 = (lane == i) ? 1.f : 0.f, x1 = 0.f;
#pragma unroll
        for (int k = 0; k < i; ++k) { const float t = rdlane(m[k & 3], i + 16 * (k >> 2)) * X[k]; if (k & 1) x1 -= t; else x0 -= t; }
        X[i] = x0 + x1;
    }
}

namespace rk {
constexpr int S64 = 160, S32 = 80, SW = 144;
constexpr int O_WUP = 0, O_AUP = O_WUP + 64 * SW, O_WLT = O_AUP + 64 * SW, O_ALT = O_WLT + 16 * S64, O_LW = O_ALT + 16 * S64, O_LA = O_LW + 4096,
              O_KKT = O_LA + 4096, O_RT = O_KKT + 16 * S64, O_BT = O_RT + 16 * S64, O_KDT = O_BT + 16 * S64,
              O_VT = O_KDT + 16 * S64, O_BHT = O_VT + 64 * S32, O_KHT = O_BHT + 64 * S32, O_UT = O_KHT + 64 * S32, O_UTT = O_WLT  ,
              O_TI = O_UT + 64 * S32, O_MK = O_TI + 16 * S32, O_NB = O_MK + 16 * S32, O_NK = O_NB + 16 * S32,
              O_SBF = O_NK + 16 * S32, O_WC = O_SBF + 64 * S64, O_WT = O_WC + 256, TEAM_BYTES = O_WT + 1024;
static_assert(2 * TEAM_BYTES <= LDS_MISC, "rwkv LDS");
}
__device__ __forceinline__ void rwkv_pair_chunked(const Args& A, Ctx& C, int pair) {
    using namespace rk;
    const int b = pair >> 3, h = pair & 7;
    const int dir = C.wave >> 2;
    const int t4 = C.tid & 255, q = C.wave & 3, lane = C.lane;
    lbyte* L = C.lds + dir * TEAM_BYTES;
    const bf16_t* P = WSP(bf16_t, WS_P);
    bf16_t* ydir = WSP(bf16_t, WS_YDIR) + (size_t)dir * NLAT * D;
    float* bon = WSP(float, WS_BON) + (size_t)dir * NLAT * 8;
    __syncthreads();
#pragma unroll 2
    for (int i = t4; i < 4096; i += 256) { const int l = i >> 6, c = i & 63;
        st_bf16(L + O_WUP + c * SW + l * 2, A.in[I_WUP][((size_t)dir * 64 + l) * DA + 64 * h + c]);
        st_bf16(L + O_AUP + c * SW + l * 2, A.in[I_AUP][((size_t)dir * 64 + l) * DA + 64 * h + c]); }
#pragma unroll 2
    for (int i = t4; i < (4 * 64 * S32 + 4 * 16 * S32 + 64 * S64) / 4; i += 256) ((LAS unsigned*)(L + O_VT))[i] = 0u;
    for (int i = t4; i < (2 * 16 * S64) / 4; i += 256) ((LAS unsigned*)(L + O_WLT))[i] = 0u;
    const int c = lane;
    int col5[5] = {64 * h + c, 512 + 64 * h + c, 1024 + 64 * h + c, 1536 + 64 * dir + c, 1664 + 64 * dir + c};
    float mu5[5]; int dl5[5], cl5[5], dc5[5], cc5[5];
#pragma unroll
    for (int e = 0; e < 5; ++e) { const int col = col5[e]; mu5[e] = A.in[I_MU][col];
        cl5[e] = col < 480 ? 0 : (col < 960 ? 1 : (col < 1440 ? 2 : 3)); dl5[e] = (cl5[e] == 0 ? -PLD : (cl5[e] == 1 ? PLD : (cl5[e] == 2 ? -64 * PLD : 64 * PLD)));
        cc5[e] = col < 960 ? 0 : 1; dc5[e] = col < 960 ? -PLD : PLD; }
    const float kkc = A.in[I_KK][64 * h + c], kac = A.in[I_KA][64 * h + c], rkc = A.in[I_RK][64 * h + c];
    const float w0c = A.in[I_W0][dir * DA + 64 * h + c], a0c = A.in[I_A0][dir * DA + 64 * h + c];
    f32x4 Sacc[4];
#pragma unroll
    for (int i = 0; i < 4; ++i) Sacc[i] = (f32x4){0.f, 0.f, 0.f, 0.f};
    const int fr = lane & 15, fg = lane >> 4;
    unsigned short rawp[4][5], raws[4][5];
    auto chunk_geom = [&](int ch, bool& isctx, int& sbase, int& T, size_t& rowbase) { isctx = ch < 16; sbase = isctx ? ch * 16 : (ch - 16) * 16; T = isctx ? CTX : SEQ; rowbase = isctx ? (size_t)NLAT + (size_t)b * CTX : (size_t)b * SEQ; };
    auto okmask = [&](bool isctx, int t) -> int { return isctx ? ((t >= 1 ? 1 : 0) | (t <= CTX - 2 ? 2 : 0)) : (((t & 63) >= 1 ? 1 : 0) | ((t & 63) <= 62 ? 2 : 0) | (t >= 64 ? 4 : 0) | (t < SEQ - 64 ? 8 : 0)); };
    auto issue_loads = [&](int ch) { bool isctx; int sbase, T; size_t rowbase; chunk_geom(ch, isctx, sbase, T, rowbase);
#pragma unroll
        for (int j = 0; j < 4; ++j) { const int i = 4 * q + j; const int t = __builtin_amdgcn_readfirstlane(dir ? (T - 1 - (sbase + i)) : (sbase + i));
            const bf16_t* pr = P + (rowbase + t) * PLD; const int okm = okmask(isctx, t);
#pragma unroll
            for (int e = 0; e < 5; ++e) { const int cls = isctx ? cc5[e] : cl5[e]; const bool ok = (okm >> cls) & 1; const int off = col5[e] + (ok ? (isctx ? dc5[e] : dl5[e]) : 0);
                rawp[j][e] = pr[col5[e]]; raws[j][e] = pr[off]; } } };
    issue_loads(0);
    for (int ch = 0; ch < 144; ++ch) {
        bool isctx; int sbase, T; size_t rowbase; chunk_geom(ch, isctx, sbase, T, rowbase);
        float vr[4], vk[4], vv[4], vkk[4], lw[4], av[4];
        __syncthreads();
        float mxa[4][5];
#pragma unroll
        for (int j = 0; j < 4; ++j) { const int i = 4 * q + j; const int t = __builtin_amdgcn_readfirstlane(dir ? (T - 1 - (sbase + i)) : (sbase + i)); const int okm = okmask(isctx, t);
#pragma unroll
            for (int e = 0; e < 5; ++e) { const int cls = isctx ? cc5[e] : cl5[e]; const bool ok = (okm >> cls) & 1;
                const float pv = bf2f(rawp[j][e]); const float sv = bf2f(raws[j][e]); mxa[j][e] = pv + mu5[e] * ((ok ? sv : 0.f) - pv); } }
        if (ch + 1 < 144) issue_loads(ch + 1);
#pragma unroll
        for (int j = 0; j < 4; ++j) {
            const int i = 4 * q + j;
            float mx[5];
#pragma unroll
            for (int e = 0; e < 5; ++e) mx[e] = mxa[j][e];
            vr[j] = mx[0]; vk[j] = mx[1]; vv[j] = mx[2];
            *(LAS unsigned short*)(L + O_WLT + i * S64 + c * 2) = (unsigned short)cvtpk(tanhf_(mx[3]), 0.f); *(LAS unsigned short*)(L + O_ALT + i * S64 + c * 2) = (unsigned short)cvtpk(mx[4], 0.f);
            const float kx = vk[j] * kkc; const float ss = wave_sum(kx * kx);
            vkk[j] = kx * __builtin_amdgcn_rsqf(ss + 1e-6f);
        }
        __syncthreads();
        {
            const f32x4 z = (f32x4){0.f, 0.f, 0.f, 0.f};
            const f32x4 tw = mm_tile<2>(L + O_WLT, S64, L + O_WUP + 16 * q * SW, SW, z, lane);
            const f32x4 ta = mm_tile<2>(L + O_ALT, S64, L + O_AUP + 16 * q * SW, SW, z, lane);
#pragma unroll
            for (int e = 0; e < 4; ++e) { ((LAS float*)(L + O_LW))[(4 * fg + e) * 64 + 16 * q + fr] = tw[e]; ((LAS float*)(L + O_LA))[(4 * fg + e) * 64 + 16 * q + fr] = ta[e]; }
        }
        __syncthreads();
        float cl[4];
        { float run = 0.f;
#pragma unroll
        for (int j = 0; j < 4; ++j) { const int i = 4 * q + j;
            const float wlog = -softplusf_(-(w0c + ((LAS float*)(L + O_LW))[i * 64 + c])) - 0.5f;
            lw[j] = -__expf(wlog);
            av[j] = sigmoidf_(a0c + ((LAS float*)(L + O_LA))[i * 64 + c]);
            run += lw[j]; cl[j] = run; }
        ((LAS float*)(L + O_WT))[q * 64 + c] = run; }
        __syncthreads();
        {
            float off = 0.f, cumC = 0.f;
#pragma unroll
            for (int qq = 0; qq < 4; ++qq) { const float tv = ((LAS float*)(L + O_WT))[qq * 64 + c]; cumC += tv; off += (qq < q) ? tv : 0.f; }
#pragma unroll
            for (int j = 0; j < 4; ++j) { const int i = 4 * q + j;
                const float cum = off + cl[j];
                const float Wt = __expf(cum), Wp = __expf(cum - lw[j]), Wi = __expf(-cum), Wc = __expf(cumC - cum);
                const float kd = vk[j] * (1.f + (av[j] - 1.f) * kac), bb = vkk[j] * av[j];
                const unsigned p0 = cvtpk(vkk[j] * Wp, vr[j] * Wt), p1 = cvtpk(bb * Wi, kd * Wi), p2 = cvtpk(vv[j], bb * Wc), p3 = cvtpk(kd * Wc, 0.f);
                *(LAS unsigned short*)(L + O_KKT + i * S64 + c * 2) = (unsigned short)p0; *(LAS unsigned short*)(L + O_RT + i * S64 + c * 2) = (unsigned short)(p0 >> 16);
                *(LAS unsigned short*)(L + O_BT + i * S64 + c * 2) = (unsigned short)p1; *(LAS unsigned short*)(L + O_KDT + i * S64 + c * 2) = (unsigned short)(p1 >> 16);
                *(LAS unsigned short*)(L + O_VT + c * S32 + i * 2) = (unsigned short)p2; *(LAS unsigned short*)(L + O_BHT + c * S32 + i * 2) = (unsigned short)(p2 >> 16);
                *(LAS unsigned short*)(L + O_KHT + c * S32 + i * 2) = (unsigned short)p3;
                const float bs = wave_sum(vr[j] * kd * rkc);
                if (!isctx && lane == 0) { const int t = dir ? (T - 1 - (sbase + i)) : (sbase + i); bon[((size_t)b * SEQ + t) * 8 + h] = bs; }
            }
            if (q == 3) ((LAS float*)(L + O_WC))[c] = __expf(cumC);
        }
        __syncthreads();
        {
            const lbyte* Aj = L + ((q & 1) ? O_KDT : O_BT);
            const lbyte* Bt = L + ((q & 2) ? O_RT : O_KKT);
            f32x4 g4 = mm_tile<2>(Aj, S64, Bt, S64, (f32x4){0.f, 0.f, 0.f, 0.f}, lane);
#pragma unroll
            for (int e = 0; e < 4; ++e) { const int j = 4 * fg + e; const bool keep = (q & 2) ? (j <= fr) : (j < fr); g4[e] = keep ? g4[e] : 0.f; }
            if (q == 0) { float X[16]; tri_inv16(g4, lane, X);
                if (lane < 16) {
#pragma unroll
                    for (int i = 0; i < 16; ++i) *(LAS unsigned short*)(L + O_TI + i * S32 + lane * 2) = (unsigned short)cvtpk(X[i], 0.f); } }
            else st_bf16x4(L + (q == 1 ? O_MK : (q == 2 ? O_NB : O_NK)) + fr * S32 + fg * 8, g4);
        }
        __syncthreads();
        f32x4 yacc;
        {
            f32x4 u4 = mm_tile<2>(L + O_KKT, S64, L + O_SBF + 16 * q * S64, S64, (f32x4){0.f, 0.f, 0.f, 0.f}, lane);
            u4 = mm_tile<1>(L + O_MK, S32, L + O_VT + 16 * q * S32, S32, u4, lane);
            st_bf16x4(L + O_UTT + (16 * q + fr) * S32 + fg * 8, u4);
            yacc = mm_tile<2>(L + O_SBF + 16 * q * S64, S64, L + O_RT, S64, (f32x4){0.f, 0.f, 0.f, 0.f}, lane);
            yacc = mm_tile<1>(L + O_VT + 16 * q * S32, S32, L + O_NK, S32, yacc, lane);
        }
        asm volatile("s_waitcnt lgkmcnt(0)" ::: "memory");
        {
            f32x4 u4 = mm_tile<1>(L + O_TI, S32, L + O_UTT + 16 * q * S32, S32, (f32x4){0.f, 0.f, 0.f, 0.f}, lane);
            st_bf16x4(L + O_UT + (16 * q + fr) * S32 + fg * 8, -u4);
        }
        __syncthreads();
        {
            yacc = mm_tile<1>(L + O_UT + 16 * q * S32, S32, L + O_NB, S32, yacc, lane);
            if (!isctx) { const int t = dir ? (T - 1 - (sbase + fr)) : (sbase + fr);
                u32x2 w; w.x = cvtpk(yacc[0], yacc[1]); w.y = cvtpk(yacc[2], yacc[3]);
                *(u32x2*)(ydir + ((size_t)b * SEQ + t) * D + 64 * h + 16 * q + 4 * fg) = w; }
            const f32x4 wc4 = *(LAS f32x4*)(L + O_WC + (16 * q + 4 * fg) * 4);
#pragma unroll
            for (int vi = 0; vi < 4; ++vi) {
                f32x4 s4 = Sacc[vi] * wc4;
                s4 = mm_tile<1>(L + O_KHT + 16 * q * S32, S32, L + O_VT + 16 * vi * S32, S32, s4, lane);
                s4 = mm_tile<1>(L + O_BHT + 16 * q * S32, S32, L + O_UT + 16 * vi * S32, S32, s4, lane);
                Sacc[vi] = s4;
                st_bf16x4(L + O_SBF + (16 * vi + fr) * S64 + (16 * q + 4 * fg) * 2, s4);
            }
        }
    }
    __syncthreads();
}

__device__ __forceinline__ void phase_gdn_prep(const Args& A, Ctx& C) {
    const bf16_t* P = WSP(bf16_t, WS_P);
    bf16_t* QKV = (bf16_t*)A.out; float* NRM = WSP(float, WS_NRM);
    lfloat* part = (lfloat*)C.lds;
    const int tid = C.tid, lane = C.lane, w = C.wave;
    float cw[3][5];
#pragma unroll
    for (int g = 0; g < 3; ++g)
#pragma unroll
        for (int e = 0; e < 5; ++e) cw[g][e] = A.in[I_CONVW][e * 1536 + g * 512 + tid];
    for (int tile = C.bid; tile < NROWS / 16; tile += C.G) {
        const int row0 = tile * 16;
        int T, ta; size_t rowbase;
        if (row0 < NLAT) { T = SEQ; rowbase = (size_t)(row0 >> 11) * SEQ; ta = row0 & (SEQ - 1); } else { T = CTX; const int r = row0 - NLAT; rowbase = (size_t)NLAT + (size_t)(r >> 8) * CTX; ta = r & (CTX - 1); }
        float x[3][20];
#pragma unroll
        for (int e = 0; e < 20; ++e) { const int t = ta - 2 + e; const bool ok = (t >= 0 && t < T); const bf16_t* pr = P + (rowbase + (ok ? t : ta)) * PLD + RW_COLS + tid;
#pragma unroll
            for (int g = 0; g < 3; ++g) { const float xv = bf2f(pr[g * 512]); x[g][e] = ok ? xv : 0.f; } }
        __syncthreads();
#pragma unroll
        for (int i = 0; i < 16; ++i) { float y[3];
#pragma unroll
            for (int g = 0; g < 3; ++g) { float sacc = 0.f;
#pragma unroll
                for (int f = 0; f < 5; ++f) sacc += cw[g][f] * x[g][i + f];
                y[g] = siluf_(sacc); }
            bf16_t* orow = QKV + (rowbase + ta + i) * 1536 + tid;
            orow[0] = (bf16_t)cvtpk(y[0], 0.f); orow[512] = (bf16_t)cvtpk(y[1], 0.f); orow[1024] = (bf16_t)cvtpk(y[2], 0.f);
            const float sq = wave_sum(y[0] * y[0]), sk = wave_sum(y[1] * y[1]);
            if (lane == 0) { part[(i * 8 + w) * 2] = sq; part[(i * 8 + w) * 2 + 1] = sk; } }
        __syncthreads();
        if (tid < 128) { const int i = tid >> 3, sidx = tid & 7, h = sidx & 3, sel = sidx >> 2;
            const float ss = part[(i * 8 + 2 * h) * 2 + sel] + part[(i * 8 + 2 * h + 1) * 2 + sel];
            NRM[(rowbase + ta + i) * 8 + sidx] = __builtin_amdgcn_rsqf(ss + 1e-6f) * (sel ? 1.f : 0.08838834764831845f); }
    }
    __syncthreads();
}

namespace gd {
constexpr int S128 = 288, S32 = 80;
constexpr int O_KT = 0, O_QT = O_KT + 32 * S128, O_KKT = O_QT + 32 * S128, O_RT = O_KKT + 32 * S128,
              O_VT = O_RT + 32 * S128, O_BHT = O_VT + 128 * S32, O_KHT = O_BHT + 128 * S32, O_UT = O_KHT + 128 * S32, O_UTT = O_UT + 128 * S32,
              O_TI = O_UTT + 128 * S32, O_MK = O_TI + 32 * S32, O_NB = O_MK + 32 * S32, O_NK = O_NB + 32 * S32,
              O_M21 = O_NK + 32 * S32, O_T11T = O_M21 + 16 * S32, O_T22 = O_T11T + 16 * S32, O_XT = O_T22 + 16 * S32,
              O_SBF = O_XT + 16 * S32, O_SC = O_SBF + 128 * S128, GD_BYTES = O_SC + 512;
static_assert(GD_BYTES <= LDS_MISC, "gdn LDS");
}
__device__ __forceinline__ void gdn_chain_chunked(const Args& A, Ctx& C, int chain) {
    using namespace gd;
    const int b = chain >> 3, h = (chain >> 1) & 3, dir = chain & 1;
    lbyte* L = C.lds;
    LAS float* SC = (LAS float*)(L + O_SC);
    const bf16_t* P = WSP(bf16_t, WS_P);
    bf16_t* ydir = WSP(bf16_t, WS_YDIR) + (size_t)dir * NLAT * D;
    const int tid = C.tid, lane = C.lane, w = C.wave, fr = lane & 15, fg = lane >> 4;
    const int grp = tid >> 7, idx = tid & 127;
    const float Aexp = __expf(A.in[I_ALOG][dir * 4 + h]), dtb = A.in[I_DTB][dir * 4 + h];
    const f32x4 z4 = (f32x4){0.f, 0.f, 0.f, 0.f};
    __syncthreads();
#pragma unroll 2
    for (int i = tid; i < (O_SC - O_VT) / 4; i += 512) ((LAS unsigned*)(L + O_VT))[i] = 0u;
    f32x4 Sacc[8];
#pragma unroll
    for (int i = 0; i < 8; ++i) Sacc[i] = z4;
    const bf16_t* QKV = (const bf16_t*)A.out; const float* NRM = WSP(const float, WS_NRM);
    unsigned short rq[8], rk[8], rv[8]; float nq[8], nk[8]; unsigned short raw_al = 0, raw_be = 0;
    auto chunk_geom = [&](int ch, bool& isctx, int& sbase, int& T, size_t& rowbase) { isctx = ch < 8; sbase = isctx ? ch * 32 : (ch - 8) * 32; T = isctx ? CTX : SEQ;
        rowbase = isctx ? (size_t)NLAT + (size_t)b * CTX : (size_t)b * SEQ; };
    auto issue_loads = [&](int ch) { bool isctx; int sbase, T; size_t rowbase; chunk_geom(ch, isctx, sbase, T, rowbase);
#pragma unroll
        for (int j = 0; j < 8; ++j) { const int i = grp + 4 * j; const int t = dir ? (T - 1 - (sbase + i)) : (sbase + i); const size_t row = rowbase + t;
            const bf16_t* qr = QKV + row * 1536 + 128 * h + idx; rq[j] = qr[0]; rk[j] = qr[512]; rv[j] = qr[1024]; nq[j] = NRM[row * 8 + h]; nk[j] = NRM[row * 8 + 4 + h]; }
        if (w == 7 && lane < 32) { const int t = dir ? (T - 1 - (sbase + lane)) : (sbase + lane); const bf16_t* pr = P + (rowbase + t) * PLD + RW_COLS + 2048; raw_al = pr[dir * 4 + h]; raw_be = pr[8 + dir * 4 + h]; } };
    issue_loads(0);
    for (int ch = 0; ch < 72; ++ch) {
        bool isctx; int sbase, T; size_t rowbase; chunk_geom(ch, isctx, sbase, T, rowbase);
        __syncthreads();
        float qv[8], kv[8], vv[8], nqv[8], nkv[8];
#pragma unroll
        for (int j = 0; j < 8; ++j) { qv[j] = bf2f(rq[j]); kv[j] = bf2f(rk[j]); vv[j] = bf2f(rv[j]); nqv[j] = nq[j]; nkv[j] = nk[j]; }
        if (w == 7) {
            const float gi = (lane < 32) ? -Aexp * softplusf_(bf2f(raw_al) + dtb) : 0.f;
            float cum = gi;
            cum += __builtin_bit_cast(float, __builtin_amdgcn_update_dpp(0, __builtin_bit_cast(int, cum), 0x111, 0xf, 0xf, true));
            cum += __builtin_bit_cast(float, __builtin_amdgcn_update_dpp(0, __builtin_bit_cast(int, cum), 0x112, 0xf, 0xf, true));
            cum += __builtin_bit_cast(float, __builtin_amdgcn_update_dpp(0, __builtin_bit_cast(int, cum), 0x114, 0xf, 0xf, true));
            cum += __builtin_bit_cast(float, __builtin_amdgcn_update_dpp(0, __builtin_bit_cast(int, cum), 0x118, 0xf, 0xf, true));
            const float r0 = rdlane(cum, 15);
            cum += (lane >= 16) ? r0 : 0.f;
            if (lane < 32) { SC[lane] = sigmoidf_(bf2f(raw_be)); SC[32 + lane + 1] = cum; if (lane == 0) SC[32] = 0.f; }
        }
        if (ch + 1 < 72) issue_loads(ch + 1);
        __syncthreads();
        {
            const int c = idx; const float gcC = SC[32 + 32];
#pragma unroll
            for (int j = 0; j < 8; ++j) { const int i = grp + 4 * j;
                const float kn = kv[j] * nkv[j], qn = qv[j] * nqv[j];
                const float gm = SC[32 + i], gi = SC[32 + i + 1], be = SC[i];
                const unsigned p0 = cvtpk(kn, qn), p1 = cvtpk(kn * __expf(gm), qn * __expf(gi)), p2 = cvtpk(be * kn * __expf(gcC - gm), be * kn * __expf(gcC - gi));
                *(LAS unsigned short*)(L + O_KT + i * S128 + c * 2) = (unsigned short)p0; *(LAS unsigned short*)(L + O_QT + i * S128 + c * 2) = (unsigned short)(p0 >> 16);
                *(LAS unsigned short*)(L + O_KKT + i * S128 + c * 2) = (unsigned short)p1; *(LAS unsigned short*)(L + O_RT + i * S128 + c * 2) = (unsigned short)(p1 >> 16);
                *(LAS unsigned short*)(L + O_BHT + c * S32 + i * 2) = (unsigned short)p2; *(LAS unsigned short*)(L + O_KHT + c * S32 + i * 2) = (unsigned short)(p2 >> 16);
                *(LAS unsigned short*)(L + O_VT + c * S32 + i * 2) = (unsigned short)cvtpk(vv[j], 0.f); }
        }
        __syncthreads();
        {
            const int isq = w >> 2, tb = (w >> 1) & 1, jb = w & 1;
            if (jb <= tb) {
                const f32x4 g4 = mm_tile<4>(L + O_KT + jb * 16 * S128, S128, L + (isq ? O_QT : O_KT) + tb * 16 * S128, S128, z4, lane);
                const int t = tb * 16 + fr;
                const float gt = SC[32 + t + isq];
                f32x4 m0, m1;
#pragma unroll
                for (int e = 0; e < 4; ++e) { const int j = jb * 16 + 4 * fg + e; const bool keep = isq ? (j <= t) : (j < t);
                    const float bj = SC[j] * g4[e];
                    m0[e] = keep ? bj * __expf(gt - SC[32 + j]) : 0.f;
                    m1[e] = keep ? bj * __expf(gt - SC[32 + j + 1]) : 0.f; }
                const int off = t * S32 + (jb * 16 + 4 * fg) * 2;
                if (isq) { st_bf16x4(L + O_NB + off, m0); st_bf16x4(L + O_NK + off, m1); }
                else {
                    st_bf16x4(L + O_MK + off, m1);
                    if (tb != jb) st_bf16x4(L + O_M21 + fr * S32 + fg * 8, m0);
                    else { float X[16]; tri_inv16(m0, lane, X);
                        if (lane < 16) {
#pragma unroll
                            for (int i = 0; i < 16; ++i) *(LAS unsigned short*)(L + O_TI + (tb * 16 + i) * S32 + (tb * 16 + lane) * 2) = (unsigned short)cvtpk(X[i], 0.f);
                            if (tb == 0) { u32x4 a0, a1;
                                a0.x = cvtpk(X[0], X[1]); a0.y = cvtpk(X[2], X[3]); a0.z = cvtpk(X[4], X[5]); a0.w = cvtpk(X[6], X[7]);
                                a1.x = cvtpk(X[8], X[9]); a1.y = cvtpk(X[10], X[11]); a1.z = cvtpk(X[12], X[13]); a1.w = cvtpk(X[14], X[15]);
                                *(LAS u32x4*)(L + O_T11T + lane * S32) = a0; *(LAS u32x4*)(L + O_T11T + lane * S32 + 16) = a1; }
                            else {
#pragma unroll
                                for (int i = 0; i < 16; ++i) *(LAS unsigned short*)(L + O_T22 + i * S32 + lane * 2) = (unsigned short)cvtpk(X[i], 0.f); }
                        } }
                }
            }
        }
        __syncthreads();
        if (w == 1) {
            const f32x4 x4 = mm_tile<1>(L + O_M21, S32, L + O_T11T, S32, z4, lane);
            st_bf16x4(L + O_XT + fr * S32 + fg * 8, x4);
            asm volatile("s_waitcnt lgkmcnt(0)" ::: "memory");
            const f32x4 t4 = mm_tile<1>(L + O_XT, S32, L + O_T22, S32, z4, lane);
            st_bf16x4(L + O_TI + (16 + fr) * S32 + fg * 8, -t4);
        }
        f32x4 yacc[2];
#pragma unroll
        for (int tb = 0; tb < 2; ++tb) {
            f32x4 u4 = mm_tile<4>(L + O_KKT + tb * 16 * S128, S128, L + O_SBF + 16 * w * S128, S128, z4, lane);
            u4 = mm_tile<1>(L + O_MK + tb * 16 * S32, S32, L + O_VT + 16 * w * S32, S32, u4, lane);
            st_bf16x4(L + O_UTT + (16 * w + fr) * S32 + tb * 32 + fg * 8, u4);
            yacc[tb] = mm_tile<4>(L + O_SBF + 16 * w * S128, S128, L + O_RT + tb * 16 * S128, S128, z4, lane);
            yacc[tb] = mm_tile<1>(L + O_VT + 16 * w * S32, S32, L + O_NK + tb * 16 * S32, S32, yacc[tb], lane);
        }
        __syncthreads();
#pragma unroll
        for (int tb = 0; tb < 2; ++tb) {
            const f32x4 u4 = mm_tile<1>(L + O_TI + tb * 16 * S32, S32, L + O_UTT + 16 * w * S32, S32, z4, lane);
            st_bf16x4(L + O_UT + (16 * w + fr) * S32 + tb * 32 + fg * 8, -u4);
        }
        __syncthreads();
        {
#pragma unroll
            for (int tb = 0; tb < 2; ++tb) {
                yacc[tb] = mm_tile<1>(L + O_UT + 16 * w * S32, S32, L + O_NB + tb * 16 * S32, S32, yacc[tb], lane);
                if (!isctx) { const int tl = sbase + tb * 16 + fr; const int t = dir ? (T - 1 - tl) : tl;
                    u32x2 pk; pk.x = cvtpk(yacc[tb][0], yacc[tb][1]); pk.y = cvtpk(yacc[tb][2], yacc[tb][3]);
                    *(u32x2*)(ydir + ((size_t)b * SEQ + t) * D + 512 + 128 * h + 16 * w + 4 * fg) = pk; }
            }
            const float wc = __expf(SC[32 + 32]);
#pragma unroll
            for (int vi = 0; vi < 8; ++vi) {
                f32x4 s4 = Sacc[vi] * wc;
                s4 = mm_tile<1>(L + O_KHT + 16 * w * S32, S32, L + O_VT + 16 * vi * S32, S32, s4, lane);
                s4 = mm_tile<1>(L + O_BHT + 16 * w * S32, S32, L + O_UT + 16 * vi * S32, S32, s4, lane);
                Sacc[vi] = s4;
                st_bf16x4(L + O_SBF + (16 * vi + fr) * S128 + (16 * w + 4 * fg) * 2, s4);
            }
        }
    }
    __syncthreads();
}

__device__ __forceinline__ void unpack8(const u32x4 w, float (&f)[8]) { f[0] = bflo(w.x); f[1] = bfhi(w.x); f[2] = bflo(w.y); f[3] = bfhi(w.y); f[4] = bflo(w.z); f[5] = bfhi(w.z); f[6] = bflo(w.w); f[7] = bfhi(w.w); }
__device__ __forceinline__ void phase_p4(const Args& A, Ctx& C) {
    const bf16_t* P = WSP(bf16_t, WS_P);
    const bf16_t* yf = WSP(bf16_t, WS_YDIR); const bf16_t* yb = yf + (size_t)NLAT * D;
    const float* bon = WSP(float, WS_BON);
    bf16_t* ymix = WSP(bf16_t, WS_YMIX);
    lbyte* SGb = C.lds;
    lfloat* GO = (lfloat*)(C.lds + 8192);
    const int tid = C.tid, lane = C.lane, w = C.wave;
    const bf16_t* gupt = WSP(const bf16_t, WS_GUPT);
    const int fr = lane & 15, fg = lane >> 4;
    const int c8 = 8 * lane;
    float lnw[8], lnb[8], ong[8], muv[8];
#pragma unroll
    for (int e = 0; e < 8; ++e) { lnw[e] = A.in[I_LNW][c8 + e]; lnb[e] = A.in[I_LNB][c8 + e]; ong[e] = A.in[I_ONG][(c8 + e) & 127]; muv[e] = A.in[I_MU][1024 + c8 + e]; }
    const int tkA = tid >> 5, lA = 4 * (tid & 31);
    float muA[4];
#pragma unroll
    for (int e = 0; e < 4; ++e) muA[e] = A.in[I_MU][1792 + lA + e];
    const bool vup = (1024 + c8) < 1440;
    for (int tile = C.bid; tile < NLAT / 16; tile += C.G) {
        const int row0 = tile * 16;
        __syncthreads();
        {
            const int row = row0 + tkA, t = row & (SEQ - 1); const bool ok = t < SEQ - 64;
            const u32x2 pw = *(const u32x2*)(P + (size_t)row * PLD + 1792 + lA); const u32x2 sw = *(const u32x2*)(P + (size_t)(row + (ok ? 64 : 0)) * PLD + 1792 + lA);
            const float pv[4] = {bflo(pw.x), bfhi(pw.x), bflo(pw.y), bfhi(pw.y)}; const float sv[4] = {bflo(sw.x), bfhi(sw.x), bflo(sw.y), bfhi(sw.y)};
            float o[4];
#pragma unroll
            for (int e = 0; e < 4; ++e) o[e] = sigmoidf_(pv[e] + muA[e] * ((ok ? sv[e] : 0.f) - pv[e]));
            u32x2 ow; ow.x = cvtpk(o[0], o[1]); ow.y = cvtpk(o[2], o[3]); *(LAS u32x2*)(SGb + tkA * 288 + lA * 2) = ow;
        }
        __syncthreads();
#pragma unroll
        for (int i = 0; i < 4; ++i) { const int c0 = 64 * w + 16 * i; f32x4 acc = (f32x4){0.f, 0.f, 0.f, 0.f};
#pragma unroll
            for (int ks = 0; ks < 4; ++ks) { const bf16x8 a = *(const LAS bf16x8*)(SGb + fr * 288 + ks * 64 + fg * 16);
                const bf16x8 bq = *(const bf16x8*)(gupt + (size_t)(c0 + fr) * 128 + ks * 32 + fg * 8);
                acc = __builtin_amdgcn_mfma_f32_16x16x32_bf16(a, bq, acc, 0, 0, 0); }
#pragma unroll
            for (int e = 0; e < 4; ++e) GO[(4 * fg + e) * 512 + c0 + fr] = acc[e]; }
        __syncthreads();
#pragma unroll
        for (int tt = 0; tt < 2; ++tt) {
            const int tk = 2 * w + tt, row = row0 + tk, t = row & (SEQ - 1);
            const bool okv = vup ? (t >= 64) : (t < SEQ - 64);
            const u32x4 wyf = *(const u32x4*)(yf + (size_t)row * D + c8), wyb = *(const u32x4*)(yb + (size_t)row * D + c8);
            const u32x4 wpv = *(const u32x4*)(P + (size_t)row * PLD + 1024 + c8), wsv = *(const u32x4*)(P + (size_t)(row + (okv ? (vup ? -64 : 64) : 0)) * PLD + 1024 + c8);
            const u32x4 wof = *(const u32x4*)(yf + (size_t)row * D + 512 + c8), wob = *(const u32x4*)(yb + (size_t)row * D + 512 + c8);
            const u32x4 wz = *(const u32x4*)(P + (size_t)row * PLD + RW_COLS + 1536 + c8);
            const float bs = bon[(size_t)row * 8 + (lane >> 3)] + bon[((size_t)NLAT + row) * 8 + (lane >> 3)];
            const f32x4 g0 = *(const LAS f32x4*)(GO + tk * 512 + c8), g1 = *(const LAS f32x4*)(GO + tk * 512 + c8 + 4);
            const float gg[8] = {g0.x, g0.y, g0.z, g0.w, g1.x, g1.y, g1.z, g1.w};
            float a[8], bq[8], pv[8], sv[8], y[8];
            unpack8(wyf, a); unpack8(wyb, bq); unpack8(wpv, pv); unpack8(wsv, sv);
            float s1 = 0.f;
#pragma unroll
            for (int e = 0; e < 8; ++e) { y[e] = a[e] + bq[e]; s1 += y[e]; }
            s1 += __shfl_xor(s1, 1); s1 += __shfl_xor(s1, 2); s1 += __shfl_xor(s1, 4);
            const float m = s1 * (1.f / 64.f);
            float s2 = 0.f;
#pragma unroll
            for (int e = 0; e < 8; ++e) { y[e] -= m; s2 += y[e] * y[e]; }
            s2 += __shfl_xor(s2, 1); s2 += __shfl_xor(s2, 2); s2 += __shfl_xor(s2, 4);
            const float rs = __builtin_amdgcn_rsqf(s2 * (1.f / 64.f) + RWKV_EPS);
            float o[8];
#pragma unroll
            for (int e = 0; e < 8; ++e) { const float vv = pv[e] + muv[e] * ((okv ? sv[e] : 0.f) - pv[e]); o[e] = (y[e] * rs * lnw[e] + lnb[e] + bs * vv) * gg[e]; }
            u32x4 ow; ow.x = cvtpk(o[0], o[1]); ow.y = cvtpk(o[2], o[3]); ow.z = cvtpk(o[4], o[5]); ow.w = cvtpk(o[6], o[7]);
            *(u32x4*)(ymix + (size_t)row * D + c8) = ow;
            float of[8], ob[8], z[8];
            unpack8(wof, of); unpack8(wob, ob); unpack8(wz, z);
            float s3 = 0.f;
#pragma unroll
            for (int e = 0; e < 8; ++e) { of[e] += ob[e]; s3 += of[e] * of[e]; }
            s3 += __shfl_xor(s3, 1); s3 += __shfl_xor(s3, 2); s3 += __shfl_xor(s3, 4); s3 += __shfl_xor(s3, 8);
            const float rg = __builtin_amdgcn_rsqf(s3 * (1.f / 128.f) + NORM_EPS);
#pragma unroll
            for (int e = 0; e < 8; ++e) o[e] = of[e] * rg * ong[e] * siluf_(z[e]);
            ow.x = cvtpk(o[0], o[1]); ow.y = cvtpk(o[2], o[3]); ow.z = cvtpk(o[4], o[5]); ow.w = cvtpk(o[6], o[7]);
            *(u32x4*)(ymix + (size_t)row * D + 512 + c8) = ow;
        }
    }
}

__device__ __forceinline__ void convert_experts(const Args& A, Ctx& C) {
    lfloat* scr = (lfloat*)(C.lds + C.wave * 16384);
    const int gw = C.bid * 8 + C.wave, NGW = C.G * 8;
    constexpr int I13 = (D / 64) * (DE / 32);
    constexpr int I2 = (DE / 64) * (D / 32);
    constexpr int PER = 2 * I13 + I2;
    for (int it = gw; it < 257 * PER; it += NGW) {
        const int e = it / PER; int r = it % PER;
        unsigned char* bt13 = A.ws + WS_WEXP + (size_t)e * WEXP_STRIDE; unsigned char* bt2 = bt13 + 512 * 1024;
        const float* w1 = e < NE ? A.in[I_EW1] + (size_t)e * D * DE : A.in[I_SW1];
        const float* w3 = e < NE ? A.in[I_EW3] + (size_t)e * D * DE : A.in[I_SW3];
        const float* w2 = e < NE ? A.in[I_EW2] + (size_t)e * DE * D : A.in[I_SW2];
        if (r < I13) { transpose_item_fp8(w1, D, DE, bt13, RowGLU{0}, SW13, scr, r, C.lane); continue; } r -= I13;
        if (r < I13) { transpose_item_fp8(w3, D, DE, bt13, RowGLU{128}, SW13, scr, r, C.lane); continue; } r -= I13;
        transpose_item_fp8(w2, DE, D, bt2, RowId(), SW2, scr, r, C.lane);
    }
}

__device__ __forceinline__ void phase_p6(const Args& A, Ctx& C) {
    const float* mod = WSP(float, WS_MOD); bf16_t* h2n = WSP(bf16_t, WS_H2N);
    const int gw = C.bid * 8 + C.wave, NGW = C.G * 8;
    for (int row = gw; row < NLAT; row += NGW) {
        const float* m = mod + (size_t)(row >> 11) * MODW;
        norm_mod_row(A.out + (size_t)row * D, A.in[I_N2G], m + 4 * D, m + 3 * D, h2n + (size_t)row * D, C.lane, (unsigned*)(A.ws + WS_H2N8) + (size_t)row * (D / 4));
    }
}

__device__ __forceinline__ void phase_p8(const Args& A, Ctx& C) {
    const float* logit = WSP(float, WS_LOGIT);
    int* tope = WSP(int, WS_TOPE); float* topw = WSP(float, WS_TOPW); int* pos = WSP(int, WS_POS);
    unsigned* cnt = WSP(unsigned, WS_CTL) + CW_CNT;
    const int gw = C.bid * 8 + C.wave, NGW = C.G * 8, lane = C.lane;
    const f32x4 rb = ((const f32x4*)A.in[I_RB])[lane];
    for (int tok = gw; tok < NLAT; tok += NGW) {
        const f32x4 lg = ((const f32x4*)(logit + (size_t)tok * NE))[lane];
        float s[4], sel[4];
#pragma unroll
        for (int i = 0; i < 4; ++i) { s[i] = sigmoidf_(lg[i]); sel[i] = s[i] + rb[i]; }
        float m1 = fmaxf(fmaxf(sel[0], sel[1]), fmaxf(sel[2], sel[3]));
        float m2;
        {
            float a = fmaxf(sel[0], sel[1]), bq = fminf(sel[0], sel[1]), cq = fmaxf(sel[2], sel[3]), dq = fminf(sel[2], sel[3]);
            m2 = fmaxf(fminf(a, cq), fmaxf(bq, dq)); }
#pragma unroll
        for (int o = 1; o < 8; o <<= 1) { const float o1 = __shfl_xor(m1, o), o2 = __shfl_xor(m2, o);
            const float n1 = fmaxf(m1, o1); const float n2 = fmaxf(fminf(m1, o1), fmaxf(m2, o2)); m1 = n1; m2 = n2; }
        const float gs = m1 + m2;
        const int grp = lane >> 3;
        int rank = 0;
#pragma unroll
        for (int gq = 0; gq < 8; ++gq) { const float og = __shfl(gs, gq * 8); rank += (og > gs || (og == gs && gq < grp)) ? 1 : 0; }
        const bool gsel = rank < 4;
        float cand[4];
#pragma unroll
        for (int i = 0; i < 4; ++i) cand[i] = gsel ? sel[i] : -INFINITY;
        int my_e = 0; float my_w = 0.f; float wsum = 0.f;
#pragma unroll
        for (int r = 0; r < 8; ++r) {
            float bv = cand[0]; int bi = 0;
#pragma unroll
            for (int i = 1; i < 4; ++i) if (cand[i] > bv) { bv = cand[i]; bi = i; }
            int be = lane * 4 + bi;
#define P8_STEP(CTRL) { const float ov = dpp_f<CTRL>(bv); const int oe = __builtin_amdgcn_update_dpp(0, be, CTRL, 0xf, 0xf, false); if (ov > bv || (ov == bv && oe < be)) { bv = ov; be = oe; } }
            P8_STEP(0x128) P8_STEP(0x124) P8_STEP(0x122) P8_STEP(0x121)
#undef P8_STEP
            float gv = rdlane(bv, 0); int ge = __builtin_amdgcn_readlane(be, 0);
#pragma unroll
            for (int rr = 1; rr < 4; ++rr) { const float ov = rdlane(bv, 16 * rr); const int oe = __builtin_amdgcn_readlane(be, 16 * rr); if (ov > gv || (ov == gv && oe < ge)) { gv = ov; ge = oe; } }
            be = ge;
            const int ol = be >> 2, oi = be & 3;
            const float mys = oi == 0 ? s[0] : (oi == 1 ? s[1] : (oi == 2 ? s[2] : s[3]));
            const float ws_ = __shfl(mys, ol);
            if (lane == ol) { if (oi == 0) cand[0] = -INFINITY; else if (oi == 1) cand[1] = -INFINITY; else if (oi == 2) cand[2] = -INFINITY; else cand[3] = -INFINITY; }
            wsum += ws_;
            if (lane == r) { my_e = be; my_w = ws_; }
        }
        if (lane < 8) {
            const float w = my_w / wsum * 2.5f;
            const unsigned p = atomicAdd(cnt + my_e, 1u);
            tope[(size_t)tok * 8 + lane] = my_e; topw[(size_t)tok * 8 + lane] = w; pos[(size_t)tok * 8 + lane] = (int)p;
        }
    }
}

__device__ __forceinline__ void tile_prefix(const Args& A, Ctx& C, LAS int* tb) {
    const unsigned* cnt = WSP(unsigned, WS_CTL) + CW_CNT;
    if (C.tid == 0) { int acc = 0; for (int e = 0; e < NE; ++e) { tb[e] = acc; acc += ((int)cnt[e] + 255) >> 8; } tb[NE] = acc; }
    __syncthreads();
}
__device__ __forceinline__ void phase_p9(const Args& A, Ctx& C) {
    LAS int* tb = (LAS int*)C.lds;
    tile_prefix(A, C, tb);
    const unsigned* cnt = WSP(unsigned, WS_CTL) + CW_CNT;
    const int* tope = WSP(int, WS_TOPE); const float* topw = WSP(float, WS_TOPW); const int* pos = WSP(int, WS_POS);
    int* rowl = WSP(int, WS_ROWL); float* roww = WSP(float, WS_ROWW); int* tile_e = WSP(int, WS_TILEE);
    const int nrt = tb[NE];
    for (int i = C.bid * 512 + C.tid; i < NLAT * 8; i += C.G * 512) { const int e = tope[i]; const int pr = tb[e] * 256 + pos[i]; rowl[pr] = i; roww[pr] = topw[i]; }
    for (int e = C.bid; e < NE; e += C.G) { const int n = (int)cnt[e], nt = tb[e + 1] - tb[e];
        for (int j = n + C.tid; j < nt * 256; j += 512) { rowl[tb[e] * 256 + j] = -1; roww[tb[e] * 256 + j] = 0.f; }
        for (int k = C.tid; k < nt; k += 512) tile_e[tb[e] + k] = e; }
    for (int i = C.bid * 512 + C.tid; i < NLAT; i += C.G * 512) { rowl[nrt * 256 + i] = i; roww[nrt * 256 + i] = 1.f; }
    for (int k = C.bid * 512 + C.tid; k < NLAT / 256; k += C.G * 512) tile_e[nrt + k] = NE;
    __syncthreads();
}

__device__ __forceinline__ void phase_moe(const Args& A, Ctx& C, int dry_shared) {
    LAS int* tb = (LAS int*)(C.lds + 131072);
    LAS int* tbl = tb + 320;
    tile_prefix(A, C, tb);
    pg8::MoeCtx M;
    M.nrt = tb[NE]; M.ntiles = M.nrt + NLAT / 256; M.G = C.G; M.vc = (C.G % 8 == 0) ? (C.bid % 8) * (C.G / 8) + C.bid / 8 : C.bid;
    M.tb = tb; M.tbl = tbl; M.cnt = WSP(unsigned, WS_CTL) + CW_CNT; M.rowl = WSP(int, WS_ROWL); M.roww = WSP(float, WS_ROWW);
    M.wexp = (const char*)(A.ws + WS_WEXP); M.h2n = (const char*)(A.ws + WS_H2N8); M.Hs = (char*)(A.ws + WS_HS) + (size_t)C.bid * 2 * 65536;
    M.Y = (unsigned char*)(A.ws + WS_Y); M.out = A.out; M.mod = WSP(const float, WS_MOD); M.dry_shared = dry_shared;
    pg8::gemm_moe(C.lds, M);
    __syncthreads();
}

__device__ __forceinline__ void phase_final(const Args& A, Ctx& C, float* dst) {
    const int gw = C.bid * 8 + C.wave, NGW = C.G * 8;
    const float* fg = A.in[I_FG]; const float* mod = WSP(const float, WS_MOD);
    const unsigned* Y = (const unsigned*)(A.ws + WS_Y);
    for (int row = gw; row < NLAT; row += NGW) {
        f32x4* xr = (f32x4*)(A.out + (size_t)row * D) + C.lane;
        const f32x4* gt = (const f32x4*)(mod + (size_t)(row >> 11) * MODW + 5 * D) + C.lane;
        const unsigned* yr = Y + (size_t)row * 8 * (D / 4) + C.lane;
        f32x4 v[4]; float s = 0.f;
#pragma unroll
        for (int j = 0; j < 4; ++j) {
            f32x4 a = (f32x4){0.f, 0.f, 0.f, 0.f};
#pragma unroll
            for (int sl = 0; sl < 8; ++sl) { const unsigned w = yr[sl * (D / 4) + 64 * j];
                const f32x2 lo = __builtin_amdgcn_cvt_pk_f32_fp8(w, false), hi = __builtin_amdgcn_cvt_pk_f32_fp8(w, true);
                a.x += lo.x; a.y += lo.y; a.z += hi.x; a.w += hi.y; }
            v[j] = xr[64 * j] + gt[64 * j] * a * (1.f / pg8::YSCALE);
            s += (v[j].x * v[j].x + v[j].y * v[j].y) + (v[j].z * v[j].z + v[j].w * v[j].w); }
        const float rstd = __builtin_amdgcn_rsqf(wave_sum(s) * (1.f / D) + NORM_EPS);
        f32x4* orow = (f32x4*)(dst + (size_t)row * D) + C.lane;
#pragma unroll
        for (int j = 0; j < 4; ++j) orow[64 * j] = v[j] * rstd * ((const f32x4*)fg)[C.lane + 64 * j];
    }
}

constexpr int NPHASE = 13;
__global__ void __launch_bounds__(512, 2) fwd_kernel(Args A) {
    extern __shared__ __attribute__((aligned(16))) unsigned char lds_raw[];
    Ctx C; C.lds = (lbyte*)lds_raw; C.tid = threadIdx.x; C.lane = C.tid & 63; C.wave = __builtin_amdgcn_readfirstlane(C.tid >> 6);
    C.G = gridDim.x; C.bid = blockIdx.x; C.a = &A;
    volatile LAS unsigned* misc = (volatile LAS unsigned*)(C.lds + LDS_MISC);
    if (C.tid < 16) misc[C.tid] = 0u;
    __syncthreads();
    XcdBarrier bar; bar.bar = WSP(unsigned, WS_CTL) + CW_BAR; bar.x = 0; bar.st = nullptr;
    const int lo = A.ph_lo, hi = A.ph_hi;
    const bool multi = (hi - lo) > 1;
    if (multi) bar = xcd_barrier_post(WSP(unsigned, WS_CTL) + CW_BAR, misc);
#ifndef PHASE_MASK
#define PHASE_MASK 0x1FFF
#endif
#define IN(k) (((PHASE_MASK >> (k)) & 1) && lo <= (k) && (k) < hi)
#define SEAM(k) do { if (IN(k) && IN((k) + 1)) xcd_barrier(bar); } while (0)
#ifndef REP_MASK
#define REP_MASK 0
#endif
#define REPS(k) (((REP_MASK >> (k)) & 1) ? 2 : 1)

    if (IN(0)) _Pragma("unroll") for (int rep = 0; rep < REPS(0); ++rep) { phase_p0(A, C); __syncthreads(); } SEAM(0);
    if (IN(1)) _Pragma("unroll") for (int rep = 0; rep < REPS(1); ++rep) { phase_p1(A, C); } SEAM(1);
    if (IN(2)) _Pragma("unroll") for (int rep = 0; rep < REPS(2); ++rep) {
        pg8::Gemm g{WSP(bf16_t, WS_XN), D}; pg8::StaticOrder S; S.init(NROWS, PLD, C.G, C.bid, WSP(bf16_t, WS_BTIN), D, 1);
        pg8::EpiBf16 E{WSP(bf16_t, WS_P), PLD, 1.f / SWIN};
        pg8::gemm_phase<pg8::EpiBf16, pg8::StaticOrder, false, 0, false, true>(C.lds, g, S, E);
    } SEAM(2);
    if (IN(3)) _Pragma("unroll") for (int rep = 0; rep < REPS(3); ++rep) { phase_gdn_prep(A, C); } SEAM(3);
#ifdef PROBE_BARRIERS
    if (multi) for (int kq = 0; kq < PROBE_BARRIERS; ++kq) xcd_barrier(bar);
#endif
    if (IN(4)) {
        for (int ch = C.bid; ch < NB * HB * 2; ch += C.G) gdn_chain_chunked(A, C, ch);
        for (int pr = C.bid; pr < NB * HA; pr += C.G) rwkv_pair_chunked(A, C, pr);
    } SEAM(4);
    if (IN(5)) _Pragma("unroll") for (int rep = 0; rep < REPS(5); ++rep) { phase_p4(A, C); } SEAM(5);
    if (IN(6)) _Pragma("unroll") for (int rep = 0; rep < REPS(6); ++rep) {
        pg8::Gemm g{WSP(bf16_t, WS_YMIX), D}; pg8::StaticOrder S; S.init(NLAT, D, C.G, C.bid, WSP(bf16_t, WS_BTOUT), D);
        pg8::EpiResGate E{A.in[I_X], A.out, WSP(float, WS_MOD), 2 * D};
        pg8::gemm_phase<pg8::EpiResGate, pg8::StaticOrder, false>(C.lds, g, S, E);
    } SEAM(6);
    if (IN(7)) _Pragma("unroll") for (int rep = 0; rep < REPS(7); ++rep) { phase_p6(A, C); __syncthreads(); convert_experts(A, C); __syncthreads(); } SEAM(7);
    if (IN(8)) _Pragma("unroll") for (int rep = 0; rep < REPS(8); ++rep) {
        pg8::Gemm g{WSP(bf16_t, WS_H2N), D}; pg8::StaticOrder S; S.init(NLAT, NE, C.G, C.bid, WSP(bf16_t, WS_BTR), D);
        pg8::EpiF32 E{WSP(float, WS_LOGIT), NE};
        pg8::gemm_phase<pg8::EpiF32, pg8::StaticOrder, false>(C.lds, g, S, E);
    } SEAM(8);
    if (IN(9)) { phase_p8(A, C); } SEAM(9);
    if (IN(10)) _Pragma("unroll") for (int rep = 0; rep < REPS(10); ++rep) { phase_p9(A, C); } SEAM(10);
    if (IN(11)) { phase_moe(A, C, 0); if (REPS(11) > 1) { __syncthreads(); phase_moe(A, C, 1); } } SEAM(11);
    if (IN(12)) { if (REPS(12) > 1) { phase_final(A, C, (float*)(A.ws + WS_WEXP)); __syncthreads(); } phase_final(A, C, A.out); }
#undef IN
#undef SEAM
}

extern "C" void kernel_launch(void* const* d_in, const int* in_sizes, int n_in, void* d_out, int out_size, void* d_ws, size_t ws_size, hipStream_t stream) {
    static int grid = 0;
    if (grid == 0) {
        if (n_in != 34 || out_size != NLAT * D || ws_size < WS_END) { fprintf(stderr, "kernel_launch: unexpected shapes (n_in %d out %d ws %zu need %zu)\n", n_in, out_size, ws_size, (size_t)WS_END); grid = -1; return; }
        int dev = 0, cus = 0;
        if (hipGetDevice(&dev) != hipSuccess || hipDeviceGetAttribute(&cus, hipDeviceAttributeMultiprocessorCount, dev) != hipSuccess) { grid = -1; return; }
        if (hipFuncSetAttribute((const void*)fwd_kernel, hipFuncAttributeMaxDynamicSharedMemorySize, LDS_BYTES) != hipSuccess) { fprintf(stderr, "kernel_launch: hipFuncSetAttribute failed\n"); grid = -1; return; }
        int per_cu = 0;
        if (hipOccupancyMaxActiveBlocksPerMultiprocessor(&per_cu, (const void*)fwd_kernel, 512, LDS_BYTES) != hipSuccess || per_cu < 1) { fprintf(stderr, "kernel_launch: occupancy query says %d\n", per_cu); }
        (void)hipGetLastError();
        grid = cus;
    }
    if (grid < 0) return;
    (void)hipMemsetAsync((char*)d_ws + WS_CTL, 0, CTL_BYTES, stream);
    Args a{};
    for (int i = 0; i < 34; ++i) a.in[i] = (const float*)d_in[i];
    a.out = (float*)d_out; a.ws = (unsigned char*)d_ws;
#if MK_PER_PHASE
    for (int p = 0; p < NPHASE; ++p) { a.ph_lo = p; a.ph_hi = p + 1; hipLaunchKernelGGL(fwd_kernel, dim3(grid), dim3(512), LDS_BYTES, stream, a); }
#else
    a.ph_lo = 0; a.ph_hi = NPHASE; hipLaunchKernelGGL(fwd_kernel, dim3(grid), dim3(512), LDS_BYTES, stream, a);
#endif
}
```

```cpp
#include <hip/hip_runtime.h>
#include <cstdio>
#include <cstdint>

#ifndef MK_PER_PHASE
#define MK_PER_PHASE 0
#endif

#define LAS __attribute__((address_space(3)))
typedef unsigned short bf16_t;
typedef short bf16x8 __attribute__((ext_vector_type(8)));
typedef float f32x4 __attribute__((ext_vector_type(4)));
typedef float f32x2 __attribute__((ext_vector_type(2)));
typedef unsigned u32x4 __attribute__((ext_vector_type(4)));
typedef unsigned u32x2 __attribute__((ext_vector_type(2)));
typedef int i32x4 __attribute__((ext_vector_type(4)));
typedef int i32x8 __attribute__((ext_vector_type(8)));
typedef LAS float lfloat;
typedef LAS unsigned char lbyte;

constexpr int D = 1024, NB = 32, SEQ = 2048, CTX = 256, GW = 64;
constexpr int NLAT = NB * SEQ;
constexpr int NCTX = NB * CTX;
constexpr int NROWS = NLAT + NCTX;
constexpr int DA = 512, HA = 8, NA = 64;
constexpr int RW_COLS = 1920, GD_COLS = 2064, IN_COLS = 3984, PLD = 4096;
constexpr int DB = 512, HB = 4, KB = 128;
constexpr int NE = 256, TOPK = 8, DE = 256;
constexpr int MODW = 6 * D;
constexpr float NORM_EPS = 1e-6f, RWKV_EPS = 64e-5f;
constexpr int MAXTILES = (NLAT * TOPK + NE * 255) / 256 + 1;

constexpr size_t MiB = 1u << 20;
constexpr size_t WS_CTL = 0, CTL_BYTES = 1 * MiB;
constexpr size_t WS_MOD = 1 * MiB;
constexpr size_t WS_BTIN = 2 * MiB, WS_BTOUT = 10 * MiB, WS_BTR = 12 * MiB, WS_BON = 13 * MiB, WS_GUPT = 17 * MiB, WS_NRM = 978 * MiB;
constexpr size_t WS_P = 18 * MiB, WS_XN = 594 * MiB, WS_YDIR = 594 * MiB, WS_YMIX = 850 * MiB;
constexpr size_t WS_H2N8 = 900 * MiB;
constexpr size_t WS_H2N = 18 * MiB, WS_LOGIT = 146 * MiB, WS_TOPE = 210 * MiB, WS_TOPW = 212 * MiB, WS_POS = 214 * MiB, WS_Y = 146 * MiB;
constexpr size_t WS_ROWL = 658 * MiB, WS_ROWW = 661 * MiB, WS_TILEE = 664 * MiB, WS_HS = 672 * MiB, WS_WEXP = 704 * MiB;
constexpr size_t WEXP_STRIDE = (size_t)(512 * 1024 + 1024 * 256);
constexpr float SW13 = 64.f, SW2 = 32.f, SHS = 8.f, SWIN = 32.f;
constexpr size_t WS_END = 1090 * MiB;
static_assert(WS_WEXP + 257 * WEXP_STRIDE <= WS_END && WS_Y + (size_t)NLAT * 8 * D <= WS_ROWL, "ws map");
constexpr int CW_BAR = 4096;
constexpr int CW_CNT = 16384;

constexpr int LDS_BYTES = 159744;
constexpr int LDS_MISC = LDS_BYTES - 64;

__device__ __forceinline__ unsigned f2bf(float f) { unsigned u = __builtin_bit_cast(unsigned, f); return (u + 0x7fffu + ((u >> 16) & 1u)) >> 16; }
typedef __bf16 bf16x2_t __attribute__((ext_vector_type(2)));
__device__ __forceinline__ unsigned cvtpk(float lo, float hi) { f32x2 v = {lo, hi}; return __builtin_bit_cast(unsigned, __builtin_convertvector(v, bf16x2_t)); }
__device__ __forceinline__ unsigned pk2(float lo, float hi) { return cvtpk(lo, hi); }
__device__ __forceinline__ unsigned pk4_fp8(float a, float b, float c, float d) { unsigned w = 0u;
    w = __builtin_amdgcn_cvt_pk_fp8_f32(__builtin_amdgcn_fmed3f(a, -448.f, 448.f), __builtin_amdgcn_fmed3f(b, -448.f, 448.f), w, false);
    w = __builtin_amdgcn_cvt_pk_fp8_f32(__builtin_amdgcn_fmed3f(c, -448.f, 448.f), __builtin_amdgcn_fmed3f(d, -448.f, 448.f), w, true); return w; }
__device__ __forceinline__ float bf2f(unsigned short b) { return __builtin_bit_cast(float, ((unsigned)b) << 16); }
__device__ __forceinline__ float bflo(unsigned w) { return __builtin_bit_cast(float, w << 16); }
__device__ __forceinline__ float bfhi(unsigned w) { return __builtin_bit_cast(float, w & 0xffff0000u); }
template <int CTRL> __device__ __forceinline__ float dpp_f(float v) { return __builtin_bit_cast(float, __builtin_amdgcn_update_dpp(0, __builtin_bit_cast(int, v), CTRL, 0xf, 0xf, false)); }
__device__ __forceinline__ float wave_sum(float v) {
    v += dpp_f<0x128>(v);
    v += dpp_f<0x124>(v);
    v += dpp_f<0x122>(v);
    v += dpp_f<0x121>(v);
    const int vi = __builtin_bit_cast(int, v);
    const float r0 = __builtin_bit_cast(float, __builtin_amdgcn_readlane(vi, 0)), r1 = __builtin_bit_cast(float, __builtin_amdgcn_readlane(vi, 16)),
                r2 = __builtin_bit_cast(float, __builtin_amdgcn_readlane(vi, 32)), r3 = __builtin_bit_cast(float, __builtin_amdgcn_readlane(vi, 48));
    return (r0 + r1) + (r2 + r3);
}
__device__ __forceinline__ float sigmoidf_(float x) { return __builtin_amdgcn_rcpf(1.f + __expf(-x)); }
__device__ __forceinline__ float siluf_(float x) { return x * __builtin_amdgcn_rcpf(1.f + __expf(-x)); }
__device__ __forceinline__ float softplusf_(float x) { return fmaxf(x, 0.f) + __logf(1.f + __expf(-fabsf(x))); }
__device__ __forceinline__ float tanhf_(float x) { const float e = __expf(-2.f * fabsf(x)); const float t = (1.f - e) * __builtin_amdgcn_rcpf(1.f + e); return x < 0.f ? -t : t; }

#define XB_TMO      128
#define XB_XCNT(j)  (256  + 64 * (j))
#define XB_XSUB(j)  (1280 + 64 * (j))
#define XB_XGEN(j)  (2304 + 64 * (j))
#define XB_TOP      3328
#define XB_TOPGEN   3392
#define XCD_BAR_WORDS 3456
#define XB_SPIN_CAP (1u << 22)
__device__ __forceinline__ unsigned xb_ld(unsigned* p)              { return __hip_atomic_load(p, __ATOMIC_RELAXED, __HIP_MEMORY_SCOPE_AGENT); }
__device__ __forceinline__ unsigned xb_add(unsigned* p, unsigned v) { return __hip_atomic_fetch_add(p, v, __ATOMIC_RELAXED, __HIP_MEMORY_SCOPE_AGENT); }
__device__ __forceinline__ unsigned xb_xcc_id() { return (unsigned)__builtin_amdgcn_s_getreg((3 << 11) | 20) & 0xFu; }
#define XB_SPIN(cond, bar) do { unsigned _sp = 0; while (cond) { __builtin_amdgcn_s_sleep(1); \
    if ((++_sp & 255u) == 0u) { if (xb_ld(&(bar)[XB_TMO])) break; if (_sp > XB_SPIN_CAP) { atomicAdd(&(bar)[XB_TMO], 1u); break; } } } } while (0)
struct XcdBarrier { unsigned* bar; unsigned x; volatile LAS unsigned* st; };
__device__ __forceinline__ XcdBarrier xcd_barrier_post(unsigned* bar, volatile LAS unsigned* st) {
    XcdBarrier b; b.bar = bar; b.x = xb_xcc_id(); b.st = st;
    if (threadIdx.x == 0) (void)xb_add(&bar[XB_XCNT(b.x)], 1u);
    return b;
}
__device__ __forceinline__ void xcd_barrier_complete(unsigned* bar, unsigned x, unsigned& nloc, unsigned& nx) {
    const unsigned G = gridDim.x * gridDim.y * gridDim.z;
    unsigned sum, cnt, mine, sp = 0u;
    for (;;) {
        sum = 0u; cnt = 0u; mine = 0u;
#pragma unroll
        for (unsigned j = 0; j < 16; ++j) { const unsigned c = xb_ld(&bar[XB_XCNT(j)]); sum += c; cnt += (c > 0u) ? 1u : 0u; mine = (j == x) ? c : mine; }
        if (sum == G) break;
        __builtin_amdgcn_s_sleep(1);
        if ((++sp & 255u) == 0u) { if (xb_ld(&bar[XB_TMO])) break; if (sp > XB_SPIN_CAP) { atomicAdd(&bar[XB_TMO], 1u); break; } }
    }
    nloc = mine > 0u ? mine : 1u; nx = cnt > 0u ? cnt : 1u;
}
__device__ __forceinline__ void xcd_barrier(const XcdBarrier& b) {
    asm volatile("s_waitcnt vmcnt(0)" ::: "memory");
    __syncthreads();
    if (threadIdx.x == 0) {
        unsigned* bar = b.bar;
        __builtin_amdgcn_s_waitcnt(0);
        unsigned nloc = b.st[0], nx = b.st[1];
        if (nloc == 0u) { xcd_barrier_complete(bar, b.x, nloc, nx); b.st[0] = nloc; b.st[1] = nx; }
        const unsigned old = xb_add(&bar[XB_XSUB(b.x)], 1u);
        const unsigned gen = old / nloc;
        if (old + 1u == (gen + 1u) * nloc) {
            __builtin_amdgcn_fence(__ATOMIC_RELEASE, "agent");
            asm volatile("s_waitcnt vmcnt(0)" ::: "memory");
            const unsigned og = xb_add(&bar[XB_TOP], 1u);
            const unsigned tg = og / nx;
            if (og + 1u == (tg + 1u) * nx) xb_add(&bar[XB_TOPGEN], 1u);
            else XB_SPIN(xb_ld(&bar[XB_TOPGEN]) == tg, bar);
            __builtin_amdgcn_fence(__ATOMIC_ACQUIRE, "agent");
            xb_add(&bar[XB_XGEN(b.x)], 1u);
            asm volatile("s_waitcnt vmcnt(0)" ::: "memory");
        } else {
            XB_SPIN(xb_ld(&bar[XB_XGEN(b.x)]) == gen, bar);
            __builtin_amdgcn_fence(__ATOMIC_ACQUIRE, "agent");
            asm volatile("s_waitcnt vmcnt(0)" ::: "memory");
        }
    }
    __syncthreads();
}

struct Args {
    const float* in[34];
    float* out;
    unsigned char* ws;
    int ph_lo, ph_hi;
};
enum { I_X = 0, I_C, I_CTX, I_CCTX, I_WADA, I_BADA, I_N1G, I_WIN, I_MU, I_W0, I_WUP, I_A0, I_AUP, I_GUP, I_KK, I_KA, I_RK, I_LNW, I_LNB,
       I_CONVW, I_ALOG, I_DTB, I_ONG, I_WOUT, I_N2G, I_RW, I_RB, I_EW1, I_EW3, I_EW2, I_SW1, I_SW3, I_SW2, I_FG };

namespace pg8 {
constexpr int BM = 256, BK = 64, HALF = 128, HTB = HALF * BK * 2, STAGE_BYTES = 8 * HTB, NXCD = 8, WGM = 8;
__host__ __device__ __forceinline__ int lds_byte(int r, int c) { const int st = (r >> 4) * 2 + (c >> 5), rr = r & 15, cc = c & 31, ob = rr * 64 + cc * 2; return st * 1024 + (ob ^ (((ob >> 9) & 1) << 5)); }
__host__ __device__ __forceinline__ void stage_rc(int b, int& R, int& C) { const int st = b / 1024, sb = b % 1024, swz = sb ^ (((sb >> 9) & 1) << 5); R = (st >> 1) * 16 + swz / 64; C = (st & 1) * 32 + (swz % 64) / 2; }
__host__ __device__ __forceinline__ int perm32(int rho) { const int n = rho >> 4, i = rho & 15; return 8 * (i >> 2) + 4 * n + (i & 3); }
struct Unit { int pm, pn; };
struct Gemm { const bf16_t* A; int K; };
struct StaticOrder {
    int nM, nN, nwg, G, c; const char* Bt; size_t tstepB;
    __device__ void init(int M, int N, int G_, int c_, const void* Bt_, int K, int es = 2) { nM = M / BM; nN = N / BM; nwg = nM * nN; G = G_; c = c_; Bt = (const char*)Bt_; tstepB = (size_t)BM * K * es; }
    __device__ bool next(int i, Unit& u) const {
        const long L = (long)i * G + c; if (L >= nwg) return false;
        int wgid = (int)L; { const int q = nwg / NXCD, r = nwg % NXCD, xcd = wgid % NXCD, off = wgid / NXCD; wgid = (xcd < r ? xcd * (q + 1) : r * (q + 1) + (xcd - r) * q) + off; }
        const int nig = WGM * nN, gid = wgid / nig, fm = gid * WGM, gsz = (nM - fm) < WGM ? (nM - fm) : WGM;
        u.pm = fm + ((wgid % nig) % gsz); u.pn = (wgid % nig) / gsz; return true;
    }
    __device__ __forceinline__ const char* bptr(const Unit& u) const { return Bt + (size_t)u.pn * tstepB; }
    __device__ __forceinline__ int rowsel(const Unit&, int) const { return 0; }
};
struct TileOrder {
    int nunits, npn, G, c; const int* tile_e; const char* wbase; size_t wstride, woff, tstepB; const int* rowl;
    __device__ bool next(int i, Unit& u) const { const int L = i * G + c; if (L >= nunits) return false; u.pm = L / npn; u.pn = L - u.pm * npn; return true; }
    __device__ __forceinline__ const char* bptr(const Unit& u) const { const int e = __builtin_amdgcn_readfirstlane(tile_e[u.pm]); return wbase + (size_t)e * wstride + woff + (size_t)u.pn * tstepB; }
    __device__ __forceinline__ int rowsel(const Unit& u, int r) const { const int t = rowl[(size_t)u.pm * 256 + r]; return t < 0 ? 0 : t; }
};
struct SeqOrder {
    int n; const char* Bt; size_t tstepB; const LAS int* rsel;
    __device__ bool next(int i, Unit& u) const { if (i >= n) return false; u.pm = 0; u.pn = i; return true; }
    __device__ __forceinline__ const char* bptr(const Unit& u) const { return Bt + (size_t)u.pn * tstepB; }
    __device__ __forceinline__ int rowsel(const Unit&, int r) const { return rsel[r]; }
};
__device__ __forceinline__ unsigned cvt_pk_bf16(float lo, float hi) { return cvtpk(lo, hi); }

template <class Epi, class Sched, bool GATHER, int A_AUX = 0, bool ALIGN = true, bool FP8 = false>
__device__ __forceinline__ void gemm_phase(lbyte* lds, const Gemm g, const Sched& S, const Epi& E) {
    int tid_ = threadIdx.x; asm volatile("" : "+v"(tid_));
    const int tid = tid_, wid = __builtin_amdgcn_readfirstlane(tid >> 6), lane = tid & 63, wr = wid >> 2, wc = wid & 3, fr = lane & 15, fq = lane >> 4;
    constexpr unsigned ES = FP8 ? 1u : 2u;
    const int K = g.K, nt = FP8 ? K / 128 : K / BK;
    Unit cur, nxt; int ui = 0;
    if (!S.next(0, cur)) return;
    int Rst[2], Cst[2];
    unsigned voffA[2], voffA1[2], voffB[2], nvA[2], nvA1[2];
#pragma unroll
    for (int i = 0; i < 2; ++i) { int R, C; stage_rc(tid * 16 + i * 8192, R, C); const int Rb = Epi::PERM ? ((R & ~31) + perm32(R & 31)) : R; Rst[i] = R; Cst[i] = C;
        if (GATHER) { voffA[i] = (unsigned)S.rowsel(cur, R) * (unsigned)K * ES + (unsigned)C * 2u; voffA1[i] = (unsigned)S.rowsel(cur, 128 + R) * (unsigned)K * ES + (unsigned)C * 2u; }
        else { voffA[i] = (unsigned)(R * K) * ES + (unsigned)C * 2u; voffA1[i] = voffA[i]; }
        nvA[i] = voffA[i]; nvA1[i] = voffA1[i];
        voffB[i] = (unsigned)(Rb * K) * ES + (unsigned)C * 2u; }
    const size_t kstep = (size_t)(BK * 2);
    const size_t hstep = (size_t)HALF * K * ES;
    const size_t hstepA = GATHER ? 0 : hstep;
    const size_t tstep = 2 * hstep;
    const unsigned ldsw = (unsigned)wid * 1024u;
    const int aoff = lds_byte(wr * 64 + fr, FP8 ? fq * 16 : fq * 8), boff = lds_byte(wc * 32 + fr, FP8 ? fq * 16 : fq * 8);
#define PG8_SA(b, h) (((b) * 2 + (h)) * HTB)
#define PG8_SB(b, h) ((4 + (b) * 2 + (h)) * HTB)
#define PG8_STAGE2(bufoff, gbase, v0, v1) do { \
        __builtin_amdgcn_global_load_lds((const unsigned*)((const char*)(gbase) + (v0)), (LAS unsigned*)(lds + (bufoff) + ldsw), 16, 0, 0); \
        __builtin_amdgcn_global_load_lds((const unsigned*)((const char*)(gbase) + (v1)), (LAS unsigned*)(lds + (bufoff) + ldsw + 8192), 16, 0, 0); } while (0)
#define PG8_STAGE2A(bufoff, gbase, v0, v1) do { if constexpr (A_AUX == 16) { \
        __builtin_amdgcn_global_load_lds((const unsigned*)((const char*)(gbase) + (v0)), (LAS unsigned*)(lds + (bufoff) + ldsw), 16, 0, 16); \
        __builtin_amdgcn_global_load_lds((const unsigned*)((const char*)(gbase) + (v1)), (LAS unsigned*)(lds + (bufoff) + ldsw + 8192), 16, 0, 16); } else { PG8_STAGE2(bufoff, gbase, v0, v1); } } while (0)
#define PG8_STAGE(bufoff, gbase, voff) PG8_STAGE2(bufoff, gbase, (voff)[0], (voff)[1])
#define PG8_STAGEA(bufoff, gbase, voff) PG8_STAGE2A(bufoff, gbase, (voff)[0], (voff)[1])
#define G_LD32(p) __builtin_shufflevector(*(const LAS i32x4*)(p), *(const LAS i32x4*)((p) + 16), 0, 1, 2, 3, 4, 5, 6, 7)
#define G_MFMA8(c, a, b) asm volatile("v_mfma_scale_f32_16x16x128_f8f6f4 %0, %1, %2, %0, %3, %3 op_sel_hi:[0,0,0]" : "+v"(c) : "v"(a), "v"(b), "v"(one_scale))
#define PG8_LDA(dst, b, h) do { if constexpr (FP8) { _Pragma("unroll") for (int m = 0; m < 4; ++m) dst##8[m] = G_LD32(lds + PG8_SA(b, h) + aoff + m * 2048); } else { \
        _Pragma("unroll") for (int m = 0; m < 4; ++m) _Pragma("unroll") for (int k = 0; k < 2; ++k) dst[m][k] = *(const LAS bf16x8*)(lds + PG8_SA(b, h) + aoff + m * 2048 + k * 1024); } } while (0)
#define PG8_LDB(dst, b, h) do { if constexpr (FP8) { _Pragma("unroll") for (int n = 0; n < 2; ++n) dst##8[n] = G_LD32(lds + PG8_SB(b, h) + boff + n * 2048); } else { \
        _Pragma("unroll") for (int n = 0; n < 2; ++n) _Pragma("unroll") for (int k = 0; k < 2; ++k) dst[n][k] = *(const LAS bf16x8*)(lds + PG8_SB(b, h) + boff + n * 2048 + k * 1024); } } while (0)
#define PG8_MMA(ai, bj, At, Bt) do { __builtin_amdgcn_s_setprio(1); if constexpr (FP8) { _Pragma("unroll") for (int m = 0; m < 4; ++m) _Pragma("unroll") for (int n = 0; n < 2; ++n) G_MFMA8(acc[ai][bj][m][n], Bt##8[n], At##8[m]); } else { \
        _Pragma("unroll") for (int m = 0; m < 4; ++m) _Pragma("unroll") for (int n = 0; n < 2; ++n) _Pragma("unroll") for (int k = 0; k < 2; ++k) \
        acc[ai][bj][m][n] = __builtin_amdgcn_mfma_f32_16x16x32_bf16(Bt[n][k], At[m][k], acc[ai][bj][m][n], 0, 0, 0); } __builtin_amdgcn_s_setprio(0); } while (0)
#define PG8_WAIT_V(n) asm volatile("s_waitcnt vmcnt(" #n ")" ::: "memory")
#define PG8_WAIT_L(n) asm volatile("s_waitcnt lgkmcnt(" #n ")" ::: "memory")
#define PG8_BAR __builtin_amdgcn_s_barrier()
#define PG8_SCHED __builtin_amdgcn_sched_barrier(0)
    f32x4 acc[2][2][4][2];
#pragma unroll
    for (int a = 0; a < 2; ++a)
#pragma unroll
        for (int b = 0; b < 2; ++b)
#pragma unroll
            for (int m = 0; m < 4; ++m)
#pragma unroll
                for (int n = 0; n < 2; ++n) acc[a][b][m][n] = (f32x4){0.f, 0.f, 0.f, 0.f};
    bf16x8 At[4][2], B0[2][2], B1[2][2]; i32x8 At8[4], B08[2], B18[2];
    int one_scale = 0x7F7F7F7F; asm volatile("" : "+v"(one_scale));
    const char* cA = (const char*)g.A + (GATHER ? (size_t)0 : (size_t)cur.pm * tstep); const char* cB = S.bptr(cur);
    PG8_STAGE(PG8_SB(0, 0), cB, voffB); PG8_STAGE(PG8_SB(0, 1), cB + hstep, voffB); PG8_STAGEA(PG8_SA(0, 0), cA, voffA); PG8_STAGEA(PG8_SA(0, 1), cA + hstepA, voffA1);
    if (wr == 1) PG8_BAR;
    PG8_WAIT_V(2); PG8_BAR;
    PG8_STAGE(PG8_SB(1, 0), cB + kstep, voffB); PG8_STAGEA(PG8_SA(1, 0), cA + kstep, voffA); PG8_STAGE(PG8_SB(1, 1), cB + hstep + kstep, voffB);
    PG8_WAIT_V(6); PG8_BAR;
    for (;;) {
        const bool has_next = S.next(ui + 1, nxt);
        const char* nA = has_next ? (const char*)g.A + (GATHER ? (size_t)0 : (size_t)nxt.pm * tstep) : cA; const char* nB = has_next ? S.bptr(nxt) : cB;
        for (int t = 0; t < nt; t += 2) {
            const bool last = (t == nt - 2);
            const char* a1 = cA + (size_t)(t + 1) * kstep;
            const char* a2 = last ? nA : cA + (size_t)(t + 2) * kstep; const char* b2 = last ? nB : cB + (size_t)(t + 2) * kstep;
            const char* a3 = a2 + kstep; const char* b3 = b2 + kstep;
            if (GATHER && last && has_next) {
#pragma unroll
                for (int i = 0; i < 2; ++i) { nvA[i] = (unsigned)S.rowsel(nxt, Rst[i]) * (unsigned)K * ES + (unsigned)Cst[i] * 2u; nvA1[i] = (unsigned)S.rowsel(nxt, 128 + Rst[i]) * (unsigned)K * ES + (unsigned)Cst[i] * 2u; }
            }
            const unsigned x0 = (GATHER && last) ? nvA[0] : voffA[0], x1 = (GATHER && last) ? nvA[1] : voffA[1];
            const unsigned y0 = (GATHER && last) ? nvA1[0] : voffA1[0], y1 = (GATHER && last) ? nvA1[1] : voffA1[1];
            PG8_LDB(B0, 0, 0); PG8_LDB(B1, 0, 1); PG8_SCHED; PG8_LDA(At, 0, 0); PG8_STAGEA(PG8_SA(1, 1), a1 + hstepA, voffA1);
            PG8_WAIT_V(8); PG8_WAIT_L(0); PG8_BAR; PG8_MMA(0, 0, At, B0); PG8_MMA(0, 1, At, B1); PG8_BAR; PG8_SCHED;
            PG8_LDA(At, 0, 1); PG8_STAGE(PG8_SB(0, 0), b2, voffB); PG8_STAGE(PG8_SB(0, 1), b2 + hstep, voffB); PG8_STAGE2A(PG8_SA(0, 0), a2, x0, x1);
            PG8_WAIT_V(8); PG8_WAIT_L(0); PG8_BAR; PG8_MMA(1, 0, At, B0); PG8_MMA(1, 1, At, B1); PG8_BAR; PG8_SCHED;
            PG8_LDB(B0, 1, 0); PG8_LDB(B1, 1, 1); PG8_SCHED; PG8_LDA(At, 1, 0); PG8_STAGE2A(PG8_SA(0, 1), a2 + hstepA, y0, y1);
            PG8_WAIT_V(8); PG8_WAIT_L(0); PG8_BAR; PG8_MMA(0, 0, At, B0); PG8_MMA(0, 1, At, B1); PG8_BAR; PG8_SCHED;
            PG8_LDA(At, 1, 1); PG8_STAGE(PG8_SB(1, 0), b3, voffB); PG8_STAGE(PG8_SB(1, 1), b3 + hstep, voffB); PG8_STAGE2A(PG8_SA(1, 0), a3, x0, x1);
            PG8_WAIT_V(8); PG8_WAIT_L(0); PG8_BAR; PG8_MMA(1, 0, At, B0); PG8_MMA(1, 1, At, B1); PG8_BAR; PG8_SCHED;
        }
        if (ALIGN && wr == 0) PG8_BAR;
        if constexpr (FP8) asm volatile("s_nop 15\n\ts_nop 15" ::: "memory");
        E(acc, cur, wr, wc, fr, fq);
        if (!has_next) break;
#pragma unroll
        for (int a = 0; a < 2; ++a)
#pragma unroll
            for (int b = 0; b < 2; ++b)
#pragma unroll
                for (int m = 0; m < 4; ++m)
#pragma unroll
                    for (int n = 0; n < 2; ++n) acc[a][b][m][n] = (f32x4){0.f, 0.f, 0.f, 0.f};
        cur = nxt; cA = nA; cB = nB; ++ui;
        if (GATHER) { voffA[0] = nvA[0]; voffA[1] = nvA[1]; voffA1[0] = nvA1[0]; voffA1[1] = nvA1[1]; }
        if (ALIGN && wr == 1) PG8_BAR;
    }
    PG8_WAIT_V(0);
    if (!ALIGN && wr == 0) PG8_BAR;
    PG8_BAR;
#undef PG8_SA
#undef PG8_SB
#undef PG8_STAGE
#undef PG8_STAGE2
#undef PG8_STAGE2A
#undef PG8_STAGEA
#undef G_LD32
#undef G_MFMA8
#undef PG8_LDA
#undef PG8_LDB
#undef PG8_MMA
#undef PG8_WAIT_V
#undef PG8_WAIT_L
#undef PG8_BAR
#undef PG8_SCHED
}

struct EpiBf16 {
    static constexpr bool PERM = true;
    bf16_t* O; int ldc; float scale;
    __device__ __forceinline__ void operator()(const f32x4 (&acc)[2][2][4][2], const Unit& u, int wr, int wc, int fr, int fq) const {
        const int row0 = u.pm * BM + wr * 64 + fr; const int col0 = u.pn * BM + wc * 32 + 8 * fq;
#pragma unroll
        for (int ai = 0; ai < 2; ++ai)
#pragma unroll
            for (int m = 0; m < 4; ++m) { bf16_t* rowp = O + (size_t)(row0 + ai * HALF + m * 16) * ldc + col0;
#pragma unroll
                for (int bj = 0; bj < 2; ++bj) { const f32x4 v0 = acc[ai][bj][m][0] * scale, v1 = acc[ai][bj][m][1] * scale;
                    u32x4 w; w.x = cvt_pk_bf16(v0[0], v0[1]); w.y = cvt_pk_bf16(v0[2], v0[3]); w.z = cvt_pk_bf16(v1[0], v1[1]); w.w = cvt_pk_bf16(v1[2], v1[3]);
                    *(u32x4*)(rowp + bj * HALF) = w; } }
    }
};
struct EpiF32 {
    static constexpr bool PERM = false;
    float* C; int ldc;
    __device__ __forceinline__ void operator()(const f32x4 (&acc)[2][2][4][2], const Unit& u, int wr, int wc, int fr, int fq) const {
        const int row0 = u.pm * BM + wr * 64 + fr, col0 = u.pn * BM + wc * 32 + 4 * fq;
#pragma unroll
        for (int ai = 0; ai < 2; ++ai)
#pragma unroll
            for (int m = 0; m < 4; ++m) { float* rowp = C + (size_t)(row0 + ai * HALF + m * 16) * ldc + col0;
#pragma unroll
                for (int bj = 0; bj < 2; ++bj)
#pragma unroll
                    for (int n = 0; n < 2; ++n) *(f32x4*)(rowp + bj * HALF + n * 16) = acc[ai][bj][m][n]; }
    }
};
struct EpiResGate {
    static constexpr bool PERM = false;
    const float* x; float* out; const float* mod; int gate_off;
    __device__ __forceinline__ void operator()(const f32x4 (&acc)[2][2][4][2], const Unit& u, int wr, int wc, int fr, int fq) const {
        const int row0 = u.pm * BM + wr * 64 + fr, col0 = u.pn * BM + wc * 32 + 4 * fq;
        const float* gp = mod + (size_t)((u.pm * BM) >> 11) * MODW + gate_off + col0;
        f32x4 gv[2][2];
#pragma unroll
        for (int bj = 0; bj < 2; ++bj)
#pragma unroll
            for (int n = 0; n < 2; ++n) gv[bj][n] = *(const f32x4*)(gp + bj * HALF + n * 16);
#pragma unroll
        for (int ai = 0; ai < 2; ++ai)
#pragma unroll
            for (int m = 0; m < 4; ++m) { const size_t off = (size_t)(row0 + ai * HALF + m * 16) * D + col0;
#pragma unroll
                for (int bj = 0; bj < 2; ++bj)
#pragma unroll
                    for (int n = 0; n < 2; ++n) { const f32x4 xv = *(const f32x4*)(x + off + bj * HALF + n * 16);
                        *(f32x4*)(out + off + bj * HALF + n * 16) = xv + gv[bj][n] * acc[ai][bj][m][n]; }
                asm volatile("" ::: "memory"); }
    }
};
struct EpiGLU {
    static constexpr bool PERM = true;
    bf16_t* H;
    __device__ __forceinline__ void operator()(const f32x4 (&acc)[2][2][4][2], const Unit& u, int wr, int wc, int fr, int fq) const {
        const int row0 = u.pm * BM + wr * 64 + fr; const int col0 = u.pn * 128 + wc * 32 + 8 * fq;
#pragma unroll
        for (int ai = 0; ai < 2; ++ai)
#pragma unroll
            for (int m = 0; m < 4; ++m) { bf16_t* rowp = H + (size_t)(row0 + ai * HALF + m * 16) * 256 + col0;
                f32x4 h0, h1;
#pragma unroll
                for (int j = 0; j < 4; ++j) { const float a0 = acc[ai][0][m][0][j], a1 = acc[ai][0][m][1][j];
                    h0[j] = siluf_(a0) * acc[ai][1][m][0][j]; h1[j] = siluf_(a1) * acc[ai][1][m][1][j]; }
                u32x4 w; w.x = cvt_pk_bf16(h0[0], h0[1]); w.y = cvt_pk_bf16(h0[2], h0[3]); w.z = cvt_pk_bf16(h1[0], h1[1]); w.w = cvt_pk_bf16(h1[2], h1[3]);
                *(u32x4*)rowp = w; }
    }
};
constexpr float YSCALE = 8.f;
struct EpiY {
    static constexpr bool PERM = true;
    unsigned char* Y; float* out; const float* mod; const LAS int* rtok; const LAS float* rw; int shared;
    __device__ __forceinline__ void operator()(const f32x4 (&acc)[2][2][4][2], const Unit& u, int wr, int wc, int fr, int fq) const {
        const int col0 = u.pn * BM + wc * 32 + 8 * fq;
#pragma unroll
        for (int ai = 0; ai < 2; ++ai)
#pragma unroll
            for (int m = 0; m < 4; ++m) { const int r = wr * 64 + fr + ai * HALF + m * 16; const int ts = rtok[r]; const float w = rw[r];
                if (ts >= 0) {
                    if (shared) { const unsigned goff = (unsigned)(ts >> 11) * MODW + 5 * D + col0; const unsigned ooff = (unsigned)ts * D + col0;
#pragma unroll
                        for (int bj = 0; bj < 2; ++bj)
#pragma unroll
                            for (int n = 0; n < 2; ++n) { const f32x4 gv = *(const f32x4*)(mod + goff + bj * HALF + n * 4); f32x4* op = (f32x4*)(out + ooff + bj * HALF + n * 4);
                                *op = *op + gv * acc[ai][bj][m][n]; }
                    } else { unsigned char* yp = Y + (size_t)(unsigned)ts * D + col0; const float ws_ = w * YSCALE;
#pragma unroll
                        for (int bj = 0; bj < 2; ++bj) { f32x4 v0 = acc[ai][bj][m][0] * ws_, v1 = acc[ai][bj][m][1] * ws_;
#pragma unroll
                                for (int j = 0; j < 4; ++j) { v0[j] = __builtin_amdgcn_fmed3f(v0[j], -448.f, 448.f); v1[j] = __builtin_amdgcn_fmed3f(v1[j], -448.f, 448.f); }
                            unsigned lo = 0u, hi = 0u;
                            lo = __builtin_amdgcn_cvt_pk_fp8_f32(v0[0], v0[1], lo, false); lo = __builtin_amdgcn_cvt_pk_fp8_f32(v0[2], v0[3], lo, true);
                            hi = __builtin_amdgcn_cvt_pk_fp8_f32(v1[0], v1[1], hi, false); hi = __builtin_amdgcn_cvt_pk_fp8_f32(v1[2], v1[3], hi, true);
                            u32x2 pk; pk.x = lo; pk.y = hi; *(u32x2*)(yp + bj * HALF) = pk; } } }
                asm volatile("" ::: "memory"); }
    }
};

struct MoeCtx {
    int ntiles, nrt, G, vc;
    const LAS int* tb; LAS int* tbl;
    const unsigned* cnt; const int* rowl; const float* roww;
    const char* wexp; const char* h2n; char* Hs; unsigned char* Y; float* out; const float* mod; int dry_shared;
};
__device__ __forceinline__ void gemm_moe(lbyte* lds, const MoeCtx& M) {
    int tid_ = threadIdx.x; asm volatile("" : "+v"(tid_));
    const int tid = tid_, wid = __builtin_amdgcn_readfirstlane(tid >> 6), lane = tid & 63, wr = wid >> 2, wc = wid & 3, fr = lane & 15, fq = lane >> 4;
    const int ntl = (M.ntiles - M.vc + M.G - 1) / M.G;
    if (M.vc >= M.ntiles) return;
    const int nunits = ntl * 6;
    const unsigned ldsw = (unsigned)wid * 1024u;
    const int aoff = lds_byte(wr * 64 + fr, fq * 16), boff = lds_byte(wc * 32 + fr, fq * 16);
    auto tile_expert = [&](int tile, int& e, int& k) { if (tile < M.nrt) { int lo = 0, hi = NE - 1; while (lo < hi) { const int mid = (lo + hi + 1) >> 1; if (M.tb[mid] <= tile) lo = mid; else hi = mid - 1; } e = lo; k = tile - M.tb[lo]; } else { e = NE; k = tile - M.nrt; } };
    auto fill = [&](int j) { if (j < ntl && tid < 256) { const int tile = M.vc + j * M.G; int e, k; tile_expert(tile, e, k); LAS int* T = M.tbl + (j % 3) * 768;
            int ts; float w;
            if (e < NE) { const int valid = (int)M.cnt[e] - 256 * k; if (tid < valid) { ts = M.rowl[(size_t)tile * 256 + tid]; w = M.roww[(size_t)tile * 256 + tid]; } else { ts = -1; w = 0.f; } T[tid] = ts < 0 ? 0 : (ts >> 3); }
            else { ts = k * 256 + tid; w = 1.f; T[tid] = ts; }
            T[256 + tid] = ts; ((LAS float*)T)[512 + tid] = w; } };
    struct UP { const char* aB; const char* bB; unsigned bh; int nt, kind, pn, slot, shared, e, hbuf, fillnext; };
    auto unit_params = [&](int ui, int prev_e, UP& u, unsigned (&oa)[4], unsigned (&ob)[2]) {
        int tq = threadIdx.x; asm volatile("" : "+v"(tq));
        int Rst[2], Cst[2], Rbp[2];
#pragma unroll
        for (int i = 0; i < 2; ++i) { int R, C; stage_rc(tq * 16 + i * 8192, R, C); Rst[i] = R; Cst[i] = C; Rbp[i] = (R & ~31) + perm32(R & 31); }
        int j, sub;
        if (ui < 2) { j = 0; sub = ui; }
        else { const int qq = ui - 2, g = qq / 6, r = qq - 6 * g; if (g < ntl - 1 && r < 2) { j = g + 1; sub = r; } else { j = g; sub = (g < ntl - 1) ? r : r + 2; } }
        const int tile = M.vc + j * M.G; int e, k;
        if (sub == 0 || sub == 2) tile_expert(tile, e, k); else e = prev_e;
        u.e = e;
        const char* w = M.wexp + (size_t)e * WEXP_STRIDE;
        u.slot = j % 3; u.hbuf = j & 1; u.fillnext = (sub == 1) ? j + 1 : -1; u.shared = (e == NE) ? 1 : 0;
        if (sub < 2) { u.kind = 0; u.pn = sub; u.nt = D / 128; u.aB = M.h2n; u.bB = w + (size_t)sub * 256 * D; u.bh = 128u * D;
            const LAS int* T = M.tbl + (j % 3) * 768;
#pragma unroll
            for (int i = 0; i < 2; ++i) { oa[i] = (unsigned)T[Rst[i]] * (unsigned)D + 2u * (unsigned)Cst[i]; oa[2 + i] = (unsigned)T[128 + Rst[i]] * (unsigned)D + 2u * (unsigned)Cst[i]; ob[i] = (unsigned)(Rbp[i] * D + 2 * Cst[i]); } }
        else { u.kind = 1; u.pn = sub - 2; u.nt = DE / 128; u.aB = M.Hs + (j & 1) * 65536; u.bB = w + (size_t)512 * 1024 + (size_t)(sub - 2) * 256 * DE; u.bh = 128u * DE;
#pragma unroll
            for (int i = 0; i < 2; ++i) { oa[i] = (unsigned)(Rst[i] * DE + 2 * Cst[i]); oa[2 + i] = (unsigned)((128 + Rst[i]) * DE + 2 * Cst[i]); ob[i] = (unsigned)(Rbp[i] * DE + 2 * Cst[i]); } }
    };
#define PG8_SA(b, h) (((b) * 2 + (h)) * HTB)
#define PG8_SB(b, h) ((4 + (b) * 2 + (h)) * HTB)
#define MOE_DMA(bufoff, ptr, aux) __builtin_amdgcn_global_load_lds((const unsigned*)(ptr), (LAS unsigned*)(lds + (bufoff)), 16, 0, aux)
#define MOE_STA(bufoff, base, o0, o1) do { MOE_DMA((bufoff) + ldsw, (base) + (o0), 16); MOE_DMA((bufoff) + ldsw + 8192, (base) + (o1), 16); } while (0)
#define MOE_STAK(kindv, bufoff, base, o0, o1) do { if ((kindv) == 0) { MOE_DMA((bufoff) + ldsw, (base) + (o0), 0); MOE_DMA((bufoff) + ldsw + 8192, (base) + (o1), 0); } else MOE_STA(bufoff, base, o0, o1); } while (0)
#define MOE_STB(bufoff, base, o0, o1) do { MOE_DMA((bufoff) + ldsw, (base) + (o0), 0); MOE_DMA((bufoff) + ldsw + 8192, (base) + (o1), 0); } while (0)
#define MOE_LD32(p) __builtin_shufflevector(*(const LAS i32x4*)(p), *(const LAS i32x4*)((p) + 16), 0, 1, 2, 3, 4, 5, 6, 7)
#define PG8_LDA(dst, b, h) do { _Pragma("unroll") for (int m = 0; m < 4; ++m) dst[m] = MOE_LD32(lds + PG8_SA(b, h) + aoff + m * 2048); } while (0)
#define PG8_LDB(dst, b, h) do { _Pragma("unroll") for (int n = 0; n < 2; ++n) dst[n] = MOE_LD32(lds + PG8_SB(b, h) + boff + n * 2048); } while (0)
#define MOE_MFMA(c, a, b) asm volatile("v_mfma_scale_f32_16x16x128_f8f6f4 %0, %1, %2, %0, %3, %3 op_sel_hi:[0,0,0]" : "+v"(c) : "v"(a), "v"(b), "v"(one_scale))
#define PG8_MMA(ai, bj, At, Bt) do { __builtin_amdgcn_s_setprio(1); _Pragma("unroll") for (int m = 0; m < 4; ++m) _Pragma("unroll") for (int n = 0; n < 2; ++n) \
        MOE_MFMA(acc[ai][bj][m][n], Bt[n], At[m]); __builtin_amdgcn_s_setprio(0); } while (0)
#define PG8_WAIT_V(n) asm volatile("s_waitcnt vmcnt(" #n ")" ::: "memory")
#define PG8_WAIT_L(n) asm volatile("s_waitcnt lgkmcnt(" #n ")" ::: "memory")
#define PG8_BAR __builtin_amdgcn_s_barrier()
#define PG8_SCHED __builtin_amdgcn_sched_barrier(0)
    fill(0);
    asm volatile("s_waitcnt vmcnt(0) lgkmcnt(0)" ::: "memory");
    __syncthreads();
    UP cu, nu; unsigned oa[4], ob[2], na[4], nb[2];
    unit_params(0, 0, cu, oa, ob);
    nu = cu;
#pragma unroll
    for (int i = 0; i < 4; ++i) na[i] = oa[i];
    nb[0] = ob[0]; nb[1] = ob[1];
    f32x4 acc[2][2][4][2];
#pragma unroll
    for (int a = 0; a < 2; ++a)
#pragma unroll
        for (int b = 0; b < 2; ++b)
#pragma unroll
            for (int m = 0; m < 4; ++m)
#pragma unroll
                for (int n = 0; n < 2; ++n) acc[a][b][m][n] = (f32x4){0.f, 0.f, 0.f, 0.f};
    i32x8 At[4], B0[2], B1[2];
    int one_scale = 0x7F7F7F7F; asm volatile("" : "+v"(one_scale));
    const size_t kstep = (size_t)128;
    {   const char* cA = cu.aB; const char* cB = cu.bB;
        MOE_STB(PG8_SB(0, 0), cB, ob[0], ob[1]); MOE_STB(PG8_SB(0, 1), cB + cu.bh, ob[0], ob[1]); MOE_STAK(cu.kind, PG8_SA(0, 0), cA, oa[0], oa[1]); MOE_STAK(cu.kind, PG8_SA(0, 1), cA, oa[2], oa[3]);
        if (wr == 1) PG8_BAR;
        PG8_WAIT_V(2); PG8_BAR;
        MOE_STB(PG8_SB(1, 0), cB + kstep, ob[0], ob[1]); MOE_STAK(cu.kind, PG8_SA(1, 0), cA + kstep, oa[0], oa[1]); MOE_STB(PG8_SB(1, 1), cB + cu.bh + kstep, ob[0], ob[1]);
        PG8_WAIT_V(6); PG8_BAR; }
    for (int ui = 0;; ++ui) {
        const bool has_next = (ui + 1 < nunits);
        if (cu.fillnext >= 0) fill(cu.fillnext);
        const char* cA = cu.aB; const char* cB = cu.bB; const int nt = cu.nt; const unsigned bh = cu.bh;
        for (int t = 0; t < nt; t += 2) {
            const bool last = (t == nt - 2);
            if (last && has_next) unit_params(ui + 1, cu.e, nu, na, nb);
            const char* a1 = cA + (size_t)(t + 1) * kstep;
            const char* a2 = last ? nu.aB : cA + (size_t)(t + 2) * kstep; const char* b2 = last ? nu.bB : cB + (size_t)(t + 2) * kstep;
            const char* a3 = a2 + kstep; const char* b3 = b2 + kstep;
            const unsigned bh2 = last ? nu.bh : bh;
            const unsigned x0 = last ? na[0] : oa[0], x1 = last ? na[1] : oa[1], y0 = last ? na[2] : oa[2], y1 = last ? na[3] : oa[3];
            const unsigned z0 = last ? nb[0] : ob[0], z1 = last ? nb[1] : ob[1];
            const int k2 = last ? nu.kind : cu.kind;
            PG8_LDB(B0, 0, 0); PG8_LDB(B1, 0, 1); PG8_SCHED; PG8_LDA(At, 0, 0); MOE_STAK(cu.kind, PG8_SA(1, 1), a1, oa[2], oa[3]);
            PG8_WAIT_V(8); PG8_WAIT_L(0); PG8_BAR; PG8_MMA(0, 0, At, B0); PG8_MMA(0, 1, At, B1); PG8_BAR; PG8_SCHED;
            PG8_LDA(At, 0, 1); MOE_STB(PG8_SB(0, 0), b2, z0, z1); MOE_STB(PG8_SB(0, 1), b2 + bh2, z0, z1); MOE_STAK(k2, PG8_SA(0, 0), a2, x0, x1);
            PG8_WAIT_V(8); PG8_WAIT_L(0); PG8_BAR; PG8_MMA(1, 0, At, B0); PG8_MMA(1, 1, At, B1); PG8_BAR; PG8_SCHED;
            PG8_LDB(B0, 1, 0); PG8_LDB(B1, 1, 1); PG8_SCHED; PG8_LDA(At, 1, 0); MOE_STAK(k2, PG8_SA(0, 1), a2, y0, y1);
            PG8_WAIT_V(8); PG8_WAIT_L(0); PG8_BAR; PG8_MMA(0, 0, At, B0); PG8_MMA(0, 1, At, B1); PG8_BAR; PG8_SCHED;
            PG8_LDA(At, 1, 1); MOE_STB(PG8_SB(1, 0), b3, z0, z1); MOE_STB(PG8_SB(1, 1), b3 + bh2, z0, z1); MOE_STAK(k2, PG8_SA(1, 0), a3, x0, x1);
            PG8_WAIT_V(8); PG8_WAIT_L(0); PG8_BAR; PG8_MMA(1, 0, At, B0); PG8_MMA(1, 1, At, B1); PG8_BAR; PG8_SCHED;
        }
        if (wr == 0) PG8_BAR;
        asm volatile("s_nop 15\n\ts_nop 15" ::: "memory");
        if (cu.kind == 0) {
            const int row0 = wr * 64 + fr; const int col0 = cu.pn * 128 + wc * 32 + 8 * fq;
            constexpr float is13 = 1.f / SW13;
#pragma unroll
            for (int ai = 0; ai < 2; ++ai)
#pragma unroll
                for (int m = 0; m < 4; ++m) { unsigned char* rowp = (unsigned char*)M.Hs + cu.hbuf * 65536 + (size_t)(row0 + ai * HALF + m * 16) * 256 + col0;
                    f32x4 h0, h1;
#pragma unroll
                    for (int j = 0; j < 4; ++j) { h0[j] = siluf_(acc[ai][0][m][0][j] * is13) * (acc[ai][1][m][0][j] * (is13 * SHS)); h1[j] = siluf_(acc[ai][0][m][1][j] * is13) * (acc[ai][1][m][1][j] * (is13 * SHS)); }
                    u32x2 w; w.x = pk4_fp8(h0[0], h0[1], h0[2], h0[3]); w.y = pk4_fp8(h1[0], h1[1], h1[2], h1[3]);
                    *(u32x2*)rowp = w; }
        } else {
            const LAS int* rtok = M.tbl + cu.slot * 768 + 256; const LAS float* rw = (const LAS float*)(M.tbl + cu.slot * 768 + 512);
            const int col0 = cu.pn * BM + wc * 32 + 8 * fq;
#pragma unroll
            for (int ai = 0; ai < 2; ++ai)
#pragma unroll
                for (int m = 0; m < 4; ++m) { const int r = wr * 64 + fr + ai * HALF + m * 16; const int ts = rtok[r]; const float w = rw[r];
                    if (ts >= 0) {
                        if (cu.shared) { const unsigned goff = (unsigned)(ts >> 11) * MODW + 5 * D + col0; const unsigned ooff = (unsigned)ts * D + col0;
#pragma unroll
                            for (int bj = 0; bj < 2; ++bj)
#pragma unroll
                                for (int n = 0; n < 2; ++n) { const f32x4 gv = *(const f32x4*)(M.mod + goff + bj * HALF + n * 4); f32x4* op = (f32x4*)(M.out + ooff + bj * HALF + n * 4);
                                    const f32x4 nv = *op + gv * acc[ai][bj][m][n] * (1.f / (SHS * SW2)); if (!M.dry_shared) *op = nv; else asm volatile("" :: "v"(nv)); }
                        } else { unsigned char* yp = M.Y + (size_t)(unsigned)ts * D + col0; const float ws_ = w * (YSCALE / (SHS * SW2));
#pragma unroll
                            for (int bj = 0; bj < 2; ++bj) { f32x4 v0 = acc[ai][bj][m][0] * ws_, v1 = acc[ai][bj][m][1] * ws_;
#pragma unroll
                                for (int j = 0; j < 4; ++j) { v0[j] = __builtin_amdgcn_fmed3f(v0[j], -448.f, 448.f); v1[j] = __builtin_amdgcn_fmed3f(v1[j], -448.f, 448.f); }
                                unsigned lo = 0u, hi = 0u;
                                lo = __builtin_amdgcn_cvt_pk_fp8_f32(v0[0], v0[1], lo, false); lo = __builtin_amdgcn_cvt_pk_fp8_f32(v0[2], v0[3], lo, true);
                                hi = __builtin_amdgcn_cvt_pk_fp8_f32(v1[0], v1[1], hi, false); hi = __builtin_amdgcn_cvt_pk_fp8_f32(v1[2], v1[3], hi, true);
                                u32x2 pk; pk.x = lo; pk.y = hi; *(u32x2*)(yp + bj * HALF) = pk; } } }
                    asm volatile("" ::: "memory"); }
        }
        if (!has_next) break;
#pragma unroll
        for (int a = 0; a < 2; ++a)
#pragma unroll
            for (int b = 0; b < 2; ++b)
#pragma unroll
                for (int m = 0; m < 4; ++m)
#pragma unroll
                    for (int n = 0; n < 2; ++n) acc[a][b][m][n] = (f32x4){0.f, 0.f, 0.f, 0.f};
        cu = nu;
#pragma unroll
        for (int i = 0; i < 4; ++i) oa[i] = na[i];
        ob[0] = nb[0]; ob[1] = nb[1];
        if (wr == 1) PG8_BAR;
    }
    PG8_WAIT_V(0);
    PG8_BAR;
#undef PG8_SA
#undef PG8_SB
#undef MOE_DMA
#undef MOE_STA
#undef MOE_STAK
#undef MOE_STB
#undef PG8_LDA
#undef PG8_LDB
#undef MOE_LD32
#undef MOE_MFMA
#undef PG8_MMA
#undef PG8_WAIT_V
#undef PG8_WAIT_L
#undef PG8_BAR
#undef PG8_SCHED
}
}

struct Ctx {
    lbyte* lds; int tid, lane, wave, G, bid;
    const Args* a;
};
#define WSP(T, off) ((T*)(A.ws + (off)))

template <class RowMap>
__device__ __forceinline__ void transpose_item(const float* W, int K, int N, bf16_t* WT, RowMap rowmap, lfloat* scr, int item, int lane) {
    const int nblk = N / 32, kb = item / nblk, nb = item % nblk, k0 = 64 * kb, n0 = 32 * nb;
#pragma unroll 8
    for (int i = 0; i < 32; ++i) { const int kk = 2 * i + (lane >> 5); scr[kk * 33 + (lane & 31)] = W[(size_t)(k0 + kk) * N + n0 + (lane & 31)]; }
    asm volatile("s_waitcnt lgkmcnt(0)" ::: "memory");
    const int c = lane & 7;
#pragma unroll
    for (int j = 0; j < 4; ++j) { const int n = (lane >> 3) + 8 * j; const lfloat* s = scr + (8 * c) * 33 + n;
        u32x4 o; o.x = pk2(s[0 * 33], s[1 * 33]); o.y = pk2(s[2 * 33], s[3 * 33]); o.z = pk2(s[4 * 33], s[5 * 33]); o.w = pk2(s[6 * 33], s[7 * 33]);
        *(u32x4*)(WT + (size_t)rowmap(n0 + n) * K + k0 + 8 * c) = o; }
    asm volatile("s_waitcnt lgkmcnt(0)" ::: "memory");
}
template <class RowMap>
__device__ __forceinline__ void transpose_item_fp8(const float* W, int K, int N, unsigned char* WT, RowMap rowmap, float sc, lfloat* scr, int item, int lane) {
    const int nblk = N / 32, kb = item / nblk, nb = item % nblk, k0 = 64 * kb, n0 = 32 * nb;
#pragma unroll 8
    for (int i = 0; i < 32; ++i) { const int kk = 2 * i + (lane >> 5); scr[kk * 33 + (lane & 31)] = W[(size_t)(k0 + kk) * N + n0 + (lane & 31)] * sc; }
    asm volatile("s_waitcnt lgkmcnt(0)" ::: "memory");
    const int c = lane & 7;
#pragma unroll
    for (int j = 0; j < 4; ++j) { const int n = (lane >> 3) + 8 * j; const lfloat* s = scr + (8 * c) * 33 + n;
        u32x2 o; o.x = pk4_fp8(s[0 * 33], s[1 * 33], s[2 * 33], s[3 * 33]); o.y = pk4_fp8(s[4 * 33], s[5 * 33], s[6 * 33], s[7 * 33]);
        *(u32x2*)(WT + (size_t)rowmap(n0 + n) * K + k0 + 8 * c) = o; }
    asm volatile("s_waitcnt lgkmcnt(0)" ::: "memory");
}
struct RowId { __device__ int operator()(int n) const { return n; } };
struct RowGLU { int base; __device__ int operator()(int n) const { return ((n >> 7) << 8) + base + (n & 127); } };

__device__ __forceinline__ void norm_mod_row(const float* xrow, const float* g, const float* sc, const float* sh, bf16_t* orow, int lane, unsigned* o8row = nullptr) {
    const f32x4* xr = (const f32x4*)xrow + lane;
    f32x4 v[4]; float s = 0.f;
#pragma unroll
    for (int j = 0; j < 4; ++j) { v[j] = xr[64 * j]; s += (v[j].x * v[j].x + v[j].y * v[j].y) + (v[j].z * v[j].z + v[j].w * v[j].w); }
    const float rstd = __builtin_amdgcn_rsqf(wave_sum(s) * (1.f / D) + NORM_EPS);
    u32x2* o8 = (u32x2*)orow + lane;
#pragma unroll
    for (int j = 0; j < 4; ++j) { const f32x4 gg = ((const f32x4*)g)[lane + 64 * j], ss = ((const f32x4*)sc)[lane + 64 * j], hh = ((const f32x4*)sh)[lane + 64 * j];
        const f32x4 y = v[j] * rstd * gg * (ss + 1.f) + hh;
        if (orow) { u32x2 w; w.x = pk2(y.x, y.y); w.y = pk2(y.z, y.w); o8[64 * j] = w; }
        if (o8row) o8row[lane + 64 * j] = pk4_fp8(y.x, y.y, y.z, y.w); }
}

__device__ __forceinline__ void phase_p0(const Args& A, Ctx& C) {
    float* mod = WSP(float, WS_MOD);
    {
        lfloat* sc = (lfloat*)C.lds;
        lfloat* red = (lfloat*)(C.lds + 17 * 1024 * 4);
        const float* wada = A.in[I_WADA]; const float* bada = A.in[I_BADA];
        for (int it = C.bid; it < 96 * 2; it += C.G) {
            const int chunk = it >> 1, pass = it & 1, r0 = pass * 17, nr = pass ? 16 : 17, col0 = chunk * 64;
            __syncthreads();
            for (int i = C.tid; i < nr * 1024; i += 512) { const int r = i >> 10, k = i & 1023; const int rr = r0 + r;
                const float cv = rr < 32 ? A.in[I_C][rr * 1024 + k] : A.in[I_CCTX][k]; sc[r * 1024 + k] = siluf_(cv); }
            __syncthreads();
            const int col = C.tid & 63, kq = C.tid >> 6;
            float acc[17];
#pragma unroll
            for (int r = 0; r < 17; ++r) acc[r] = 0.f;
            for (int k = kq * 128; k < kq * 128 + 128; k += 4) {
                float w[4];
#pragma unroll
                for (int j = 0; j < 4; ++j) w[j] = wada[(size_t)(k + j) * MODW + col0 + col];
#pragma unroll
                for (int r = 0; r < 17; ++r) { const f32x4 s4 = *(const LAS f32x4*)(sc + r * 1024 + k); acc[r] += s4.x * w[0] + s4.y * w[1] + s4.z * w[2] + s4.w * w[3]; }
            }
#pragma unroll
            for (int r = 0; r < 17; ++r) red[(kq * 17 + r) * 64 + col] = acc[r];
            __syncthreads();
            for (int i = C.tid; i < nr * 64; i += 512) { const int r = i >> 6, cc = i & 63; float s = 0.f;
#pragma unroll
                for (int q = 0; q < 8; ++q) s += red[(q * 17 + r) * 64 + cc];
                mod[(size_t)(r0 + r) * MODW + col0 + cc] = s + bada[col0 + cc]; }
        }
        __syncthreads();
    }
    {
        lfloat* scr = (lfloat*)(C.lds + C.wave * 16384);
        const int gw = C.bid * 8 + C.wave, NGW = C.G * 8;
        unsigned char* btin8 = A.ws + WS_BTIN; bf16_t* btout = WSP(bf16_t, WS_BTOUT); bf16_t* btr = WSP(bf16_t, WS_BTR);
        constexpr int I_IN = (D / 64) * 124, I_OUT = (D / 64) * (D / 32), I_R = (D / 64) * (NE / 32), I_G = (128 / 64) * (DA / 32);
        for (int it = gw; it < I_IN + I_OUT + I_R + I_G; it += NGW) {
            int r = it;
            if (r < I_IN) {
                const int kb = r / 124, nb = r % 124, k0 = 64 * kb, n0 = 32 * nb; const float* W = A.in[I_WIN];
#pragma unroll 8
                for (int i = 0; i < 32; ++i) { const int kk = 2 * i + (C.lane >> 5); scr[kk * 33 + (C.lane & 31)] = W[(size_t)(k0 + kk) * IN_COLS + n0 + (C.lane & 31)] * SWIN; }
                asm volatile("s_waitcnt lgkmcnt(0)" ::: "memory");
                const int c = C.lane & 7;
#pragma unroll
                for (int j = 0; j < 4; ++j) { const int n = (C.lane >> 3) + 8 * j; const lfloat* s = scr + (8 * c) * 33 + n;
                    u32x2 o; o.x = pk4_fp8(s[0 * 33], s[1 * 33], s[2 * 33], s[3 * 33]); o.y = pk4_fp8(s[4 * 33], s[5 * 33], s[6 * 33], s[7 * 33]);
                    *(u32x2*)(btin8 + (size_t)(n0 + n) * D + k0 + 8 * c) = o; }
                asm volatile("s_waitcnt lgkmcnt(0)" ::: "memory");
                continue; }
            r -= I_IN;
            if (r < I_OUT) { transpose_item(A.in[I_WOUT], D, D, btout, RowId(), scr, r, C.lane); continue; } r -= I_OUT;
            if (r < I_R) { transpose_item(A.in[I_RW], D, NE, btr, RowId(), scr, r, C.lane); continue; } r -= I_R;
            transpose_item(A.in[I_GUP], 128, DA, WSP(bf16_t, WS_GUPT), RowId(), scr, r, C.lane);
        }
        for (int i = C.bid * 512 + C.tid; i < 16 * D / 4; i += C.G * 512) { const int n = 3968 + (i >> 8), k = (i & 255) * 4; const float* W = A.in[I_WIN];
            *(unsigned*)(btin8 + (size_t)n * D + k) = pk4_fp8(W[(size_t)k * IN_COLS + n] * SWIN, W[(size_t)(k + 1) * IN_COLS + n] * SWIN, W[(size_t)(k + 2) * IN_COLS + n] * SWIN, W[(size_t)(k + 3) * IN_COLS + n] * SWIN); }
        for (int i = C.bid * 512 + C.tid; i < (PLD - IN_COLS) * D / 16; i += C.G * 512) ((u32x4*)(btin8 + (size_t)IN_COLS * D))[i] = (u32x4){0u, 0u, 0u, 0u};
    }
}

__device__ __forceinline__ void phase_p1(const Args& A, Ctx& C) {
    const float* mod = WSP(float, WS_MOD); bf16_t* xn = WSP(bf16_t, WS_XN);
    const int gw = C.bid * 8 + C.wave, NGW = C.G * 8;
    for (int row = gw; row < NROWS; row += NGW) {
        const float* xr; int mb;
        if (row < NLAT) { xr = A.in[I_X] + (size_t)row * D; mb = row >> 11; } else { xr = A.in[I_CTX] + (size_t)(row - NLAT) * D; mb = 32; }
        const float* m = mod + (size_t)mb * MODW;
        norm_mod_row(xr, A.in[I_N1G], m + D, m, nullptr, C.lane, (unsigned*)(A.ws + WS_XN) + (size_t)row * (D / 4));
    }
}

template <int NK>
__device__ __forceinline__ f32x4 mm_tile(const lbyte* Ap, int lda, const lbyte* Bp, int ldb, f32x4 acc, int lane) {
    const int r = lane & 15, g = lane >> 4;
#pragma unroll
    for (int ks = 0; ks < NK; ++ks) {
        const bf16x8 a = *(const LAS bf16x8*)(Ap + r * lda + ks * 64 + g * 16);
        const bf16x8 b = *(const LAS bf16x8*)(Bp + r * ldb + ks * 64 + g * 16);
        acc = __builtin_amdgcn_mfma_f32_16x16x32_bf16(a, b, acc, 0, 0, 0);
    }
    return acc;
}

__device__ __forceinline__ void st_bf16x4(lbyte* p, f32x4 v) { u32x2 w; w.x = cvtpk(v.x, v.y); w.y = cvtpk(v.z, v.w); *(LAS u32x2*)p = w; }
__device__ __forceinline__ void st_bf16(lbyte* p, float v) { *(LAS unsigned short*)p = (unsigned short)cvtpk(v, v); }
__device__ __forceinline__ float rdlane(float v, int l) { return __builtin_bit_cast(float, __builtin_amdgcn_readlane(__builtin_bit_cast(int, v), l)); }

__device__ __forceinline__ void tri_inv16(const f32x4 m, int lane, float (&X)[16]) {
#pragma unroll
    for (int i = 0; i < 16; ++i) {
        float x0 = (lane == i) ? 1.f : 0.f, x1 = 0.f;
#pragma unroll
        for (int k = 0; k < i; ++k) { const float t = rdlane(m[k & 3], i + 16 * (k >> 2)) * X[k]; if (k & 1) x1 -= t; else x0 -= t; }
        X[i] = x0 + x1;
    }
}

#ifndef RWKV_REP
#define RWKV_REP 1
#endif
namespace rk {
constexpr int S64 = 160, S32 = 80, SW = 144;
constexpr int O_WUP = 0, O_AUP = O_WUP + 64 * SW, O_WLT = O_AUP + 64 * SW, O_ALT = O_WLT + 16 * S64, O_LW = O_ALT + 16 * S64, O_LA = O_LW + 4096,
              O_KKT = O_LA + 4096, O_RT = O_KKT + 16 * S64, O_BT = O_RT + 16 * S64, O_KDT = O_BT + 16 * S64,
              O_VT = O_KDT + 16 * S64, O_BHT = O_VT + 64 * S32, O_KHT = O_BHT + 64 * S32, O_UT = O_KHT + 64 * S32, O_UTT = O_WLT  ,
              O_TI = O_UT + 64 * S32, O_MK = O_TI + 16 * S32, O_NB = O_MK + 16 * S32, O_NK = O_NB + 16 * S32,
              O_SBF = O_NK + 16 * S32, O_WC = O_SBF + 64 * S64, O_WT = O_WC + 256, TEAM_BYTES = O_WT + 1024;
static_assert(2 * TEAM_BYTES <= LDS_MISC, "rwkv LDS");
}
__device__ __forceinline__ void rwkv_pair_chunked(const Args& A, Ctx& C, int pair) {
    using namespace rk;
    const int b = pair >> 3, h = pair & 7;
    const int dir = C.wave >> 2;
    const int t4 = C.tid & 255, q = C.wave & 3, lane = C.lane;
    lbyte* L = C.lds + dir * TEAM_BYTES;
    const bf16_t* P = WSP(bf16_t, WS_P);
    bf16_t* ydir = WSP(bf16_t, WS_YDIR) + (size_t)dir * NLAT * D;
    float* bon = WSP(float, WS_BON) + (size_t)dir * NLAT * 8;
    __syncthreads();
#pragma unroll 2
    for (int i = t4; i < 4096; i += 256) { const int l = i >> 6, c = i & 63;
        st_bf16(L + O_WUP + c * SW + l * 2, A.in[I_WUP][((size_t)dir * 64 + l) * DA + 64 * h + c]);
        st_bf16(L + O_AUP + c * SW + l * 2, A.in[I_AUP][((size_t)dir * 64 + l) * DA + 64 * h + c]); }
#pragma unroll 2
    for (int i = t4; i < (4 * 64 * S32 + 4 * 16 * S32 + 64 * S64) / 4; i += 256) ((LAS unsigned*)(L + O_VT))[i] = 0u;
    for (int i = t4; i < (2 * 16 * S64) / 4; i += 256) ((LAS unsigned*)(L + O_WLT))[i] = 0u;
    const int c = lane;
    int col5[5] = {64 * h + c, 512 + 64 * h + c, 1024 + 64 * h + c, 1536 + 64 * dir + c, 1664 + 64 * dir + c};
    float mu5[5]; int dl5[5], cl5[5], dc5[5], cc5[5];
#pragma unroll
    for (int e = 0; e < 5; ++e) { const int col = col5[e]; mu5[e] = A.in[I_MU][col];
        cl5[e] = col < 480 ? 0 : (col < 960 ? 1 : (col < 1440 ? 2 : 3)); dl5[e] = (cl5[e] == 0 ? -PLD : (cl5[e] == 1 ? PLD : (cl5[e] == 2 ? -64 * PLD : 64 * PLD)));
        cc5[e] = col < 960 ? 0 : 1; dc5[e] = col < 960 ? -PLD : PLD; }
    const float kkc = A.in[I_KK][64 * h + c], kac = A.in[I_KA][64 * h + c], rkc = A.in[I_RK][64 * h + c];
    const float w0c = A.in[I_W0][dir * DA + 64 * h + c], a0c = A.in[I_A0][dir * DA + 64 * h + c];
    f32x4 Sacc[4];
#pragma unroll
    for (int i = 0; i < 4; ++i) Sacc[i] = (f32x4){0.f, 0.f, 0.f, 0.f};
    const int fr = lane & 15, fg = lane >> 4;
    unsigned short rawp[4][5], raws[4][5];
    auto chunk_geom = [&](int ch, bool& isctx, int& sbase, int& T, size_t& rowbase) { isctx = ch < 16; sbase = isctx ? ch * 16 : (ch - 16) * 16; T = isctx ? CTX : SEQ; rowbase = isctx ? (size_t)NLAT + (size_t)b * CTX : (size_t)b * SEQ; };
    auto okmask = [&](bool isctx, int t) -> int { return isctx ? ((t >= 1 ? 1 : 0) | (t <= CTX - 2 ? 2 : 0)) : (((t & 63) >= 1 ? 1 : 0) | ((t & 63) <= 62 ? 2 : 0) | (t >= 64 ? 4 : 0) | (t < SEQ - 64 ? 8 : 0)); };
    auto issue_loads = [&](int ch) { bool isctx; int sbase, T; size_t rowbase; chunk_geom(ch, isctx, sbase, T, rowbase);
#pragma unroll
        for (int j = 0; j < 4; ++j) { const int i = 4 * q + j; const int t = __builtin_amdgcn_readfirstlane(dir ? (T - 1 - (sbase + i)) : (sbase + i));
            const bf16_t* pr = P + (rowbase + t) * PLD; const int okm = okmask(isctx, t);
#pragma unroll
            for (int e = 0; e < 5; ++e) { const int cls = isctx ? cc5[e] : cl5[e]; const bool ok = (okm >> cls) & 1; const int off = col5[e] + (ok ? (isctx ? dc5[e] : dl5[e]) : 0);
                rawp[j][e] = pr[col5[e]]; raws[j][e] = pr[off]; } } };
    issue_loads(0);
    for (int ch = 0; ch < 144; ++ch) {
        bool isctx; int sbase, T; size_t rowbase; chunk_geom(ch, isctx, sbase, T, rowbase);
        float vr[4], vk[4], vv[4], vkk[4], lw[4], av[4];
        __syncthreads();
        float mxa[4][5];
#pragma unroll
        for (int j = 0; j < 4; ++j) { const int i = 4 * q + j; const int t = __builtin_amdgcn_readfirstlane(dir ? (T - 1 - (sbase + i)) : (sbase + i)); const int okm = okmask(isctx, t);
#pragma unroll
            for (int e = 0; e < 5; ++e) { const int cls = isctx ? cc5[e] : cl5[e]; const bool ok = (okm >> cls) & 1;
                const float pv = bf2f(rawp[j][e]); const float sv = bf2f(raws[j][e]); mxa[j][e] = pv + mu5[e] * ((ok ? sv : 0.f) - pv); } }
        if (ch + 1 < 144) issue_loads(ch + 1);
        float cl[4];
        _Pragma("unroll") for (int rrep = 0; rrep < RWKV_REP; ++rrep) {
#pragma unroll
        for (int j = 0; j < 4; ++j) {
            const int i = 4 * q + j;
            float mx[5];
#pragma unroll
            for (int e = 0; e < 5; ++e) mx[e] = mxa[j][e];
            vr[j] = mx[0]; vk[j] = mx[1]; vv[j] = mx[2];
            *(LAS unsigned short*)(L + O_WLT + i * S64 + c * 2) = (unsigned short)cvtpk(tanhf_(mx[3]), 0.f); *(LAS unsigned short*)(L + O_ALT + i * S64 + c * 2) = (unsigned short)cvtpk(mx[4], 0.f);
            const float kx = vk[j] * kkc; const float ss = wave_sum(kx * kx);
            vkk[j] = kx * __builtin_amdgcn_rsqf(ss + 1e-6f);
        }
        __syncthreads();
        {
            const f32x4 z = (f32x4){0.f, 0.f, 0.f, 0.f};
            const f32x4 tw = mm_tile<2>(L + O_WLT, S64, L + O_WUP + 16 * q * SW, SW, z, lane);
            const f32x4 ta = mm_tile<2>(L + O_ALT, S64, L + O_AUP + 16 * q * SW, SW, z, lane);
#pragma unroll
            for (int e = 0; e < 4; ++e) { ((LAS float*)(L + O_LW))[(4 * fg + e) * 64 + 16 * q + fr] = tw[e]; ((LAS float*)(L + O_LA))[(4 * fg + e) * 64 + 16 * q + fr] = ta[e]; }
        }
        __syncthreads();
        { float run = 0.f;
#pragma unroll
        for (int j = 0; j < 4; ++j) { const int i = 4 * q + j;
            const float wlog = -softplusf_(-(w0c + ((LAS float*)(L + O_LW))[i * 64 + c])) - 0.5f;
            lw[j] = -__expf(wlog);
            av[j] = sigmoidf_(a0c + ((LAS float*)(L + O_LA))[i * 64 + c]);
            run += lw[j]; cl[j] = run; }
        ((LAS float*)(L + O_WT))[q * 64 + c] = run; }
        __syncthreads();
        }
        {
            float off = 0.f, cumC = 0.f;
#pragma unroll
            for (int qq = 0; qq < 4; ++qq) { const float tv = ((LAS float*)(L + O_WT))[qq * 64 + c]; cumC += tv; off += (qq < q) ? tv : 0.f; }
            float tv_[4], tb_[4], tk_[4];
#pragma unroll
            for (int j = 0; j < 4; ++j) { const int i = 4 * q + j;
                const float cum = off + cl[j];
                const float Wt = __expf(cum), Wp = __expf(cum - lw[j]), Wi = __expf(-cum), Wc = __expf(cumC - cum);
                const float kd = vk[j] * (1.f + (av[j] - 1.f) * kac), bb = vkk[j] * av[j];
                const unsigned p0 = cvtpk(vkk[j] * Wp, vr[j] * Wt), p1 = cvtpk(bb * Wi, kd * Wi);
                *(LAS unsigned short*)(L + O_KKT + i * S64 + c * 2) = (unsigned short)p0; *(LAS unsigned short*)(L + O_RT + i * S64 + c * 2) = (unsigned short)(p0 >> 16);
                *(LAS unsigned short*)(L + O_BT + i * S64 + c * 2) = (unsigned short)p1; *(LAS unsigned short*)(L + O_KDT + i * S64 + c * 2) = (unsigned short)(p1 >> 16);
                tv_[j] = vv[j]; tb_[j] = bb * Wc; tk_[j] = kd * Wc;
                const float bs = wave_sum(vr[j] * kd * rkc);
                if (!isctx && lane == 0) { const int t = dir ? (T - 1 - (sbase + i)) : (sbase + i); bon[((size_t)b * SEQ + t) * 8 + h] = bs; }
            }
#pragma unroll
            for (int jp = 0; jp < 2; ++jp) { const int i = 4 * q + 2 * jp;
                *(LAS unsigned*)(L + O_VT + c * S32 + i * 2) = cvtpk(tv_[2 * jp], tv_[2 * jp + 1]);
                *(LAS unsigned*)(L + O_BHT + c * S32 + i * 2) = cvtpk(tb_[2 * jp], tb_[2 * jp + 1]);
                *(LAS unsigned*)(L + O_KHT + c * S32 + i * 2) = cvtpk(tk_[2 * jp], tk_[2 * jp + 1]); }
            if (q == 3) ((LAS float*)(L + O_WC))[c] = __expf(cumC);
        }
        __syncthreads();
        {
            const int role = (q + dir) & 3;
            const lbyte* Aj = L + ((role & 1) ? O_KDT : O_BT);
            const lbyte* Bt = L + ((role & 2) ? O_RT : O_KKT);
            f32x4 g4 = mm_tile<2>(Aj, S64, Bt, S64, (f32x4){0.f, 0.f, 0.f, 0.f}, lane);
#pragma unroll
            for (int e = 0; e < 4; ++e) { const int j = 4 * fg + e; const bool keep = (role & 2) ? (j <= fr) : (j < fr); g4[e] = keep ? g4[e] : 0.f; }
            if (role == 0) { float X[16]; tri_inv16(g4, lane, X);
                if (lane < 16) {
#pragma unroll
                    for (int i = 0; i < 16; ++i) *(LAS unsigned short*)(L + O_TI + i * S32 + lane * 2) = (unsigned short)cvtpk(X[i], 0.f); } }
            else st_bf16x4(L + (role == 1 ? O_MK : (role == 2 ? O_NB : O_NK)) + fr * S32 + fg * 8, g4);
        }
        __syncthreads();
        f32x4 yacc;
        {
            f32x4 u4 = mm_tile<2>(L + O_KKT, S64, L + O_SBF + 16 * q * S64, S64, (f32x4){0.f, 0.f, 0.f, 0.f}, lane);
            u4 = mm_tile<1>(L + O_MK, S32, L + O_VT + 16 * q * S32, S32, u4, lane);
            st_bf16x4(L + O_UTT + (16 * q + fr) * S32 + fg * 8, u4);
            yacc = mm_tile<2>(L + O_SBF + 16 * q * S64, S64, L + O_RT, S64, (f32x4){0.f, 0.f, 0.f, 0.f}, lane);
            yacc = mm_tile<1>(L + O_VT + 16 * q * S32, S32, L + O_NK, S32, yacc, lane);
        }
        asm volatile("s_waitcnt lgkmcnt(0)" ::: "memory");
        {
            f32x4 u4 = mm_tile<1>(L + O_TI, S32, L + O_UTT + 16 * q * S32, S32, (f32x4){0.f, 0.f, 0.f, 0.f}, lane);
            st_bf16x4(L + O_UT + (16 * q + fr) * S32 + fg * 8, -u4);
        }
        __syncthreads();
        {
            yacc = mm_tile<1>(L + O_UT + 16 * q * S32, S32, L + O_NB, S32, yacc, lane);
            if (!isctx) { const int t = dir ? (T - 1 - (sbase + fr)) : (sbase + fr);
                u32x2 w; w.x = cvtpk(yacc[0], yacc[1]); w.y = cvtpk(yacc[2], yacc[3]);
                *(u32x2*)(ydir + ((size_t)b * SEQ + t) * D + 64 * h + 16 * q + 4 * fg) = w; }
            const f32x4 wc4 = *(LAS f32x4*)(L + O_WC + (16 * q + 4 * fg) * 4);
#pragma unroll
            for (int vi = 0; vi < 4; ++vi) {
                f32x4 s4 = Sacc[vi] * wc4;
                s4 = mm_tile<1>(L + O_KHT + 16 * q * S32, S32, L + O_VT + 16 * vi * S32, S32, s4, lane);
                s4 = mm_tile<1>(L + O_BHT + 16 * q * S32, S32, L + O_UT + 16 * vi * S32, S32, s4, lane);
                Sacc[vi] = s4;
                st_bf16x4(L + O_SBF + (16 * vi + fr) * S64 + (16 * q + 4 * fg) * 2, s4);
            }
        }
    }
    __syncthreads();
}

__device__ __forceinline__ void phase_gdn_prep(const Args& A, Ctx& C) {
    const bf16_t* P = WSP(bf16_t, WS_P);
    bf16_t* QKV = (bf16_t*)A.out; float* NRM = WSP(float, WS_NRM);
    lfloat* part = (lfloat*)C.lds;
    const int tid = C.tid, lane = C.lane, w = C.wave;
    float cw[3][5];
#pragma unroll
    for (int g = 0; g < 3; ++g)
#pragma unroll
        for (int e = 0; e < 5; ++e) cw[g][e] = A.in[I_CONVW][e * 1536 + g * 512 + tid];
    for (int tile = C.bid; tile < NROWS / 16; tile += C.G) {
        const int row0 = tile * 16;
        int T, ta; size_t rowbase;
        if (row0 < NLAT) { T = SEQ; rowbase = (size_t)(row0 >> 11) * SEQ; ta = row0 & (SEQ - 1); } else { T = CTX; const int r = row0 - NLAT; rowbase = (size_t)NLAT + (size_t)(r >> 8) * CTX; ta = r & (CTX - 1); }
        float x[3][20];
#pragma unroll
        for (int e = 0; e < 20; ++e) { const int t = ta - 2 + e; const bool ok = (t >= 0 && t < T); const bf16_t* pr = P + (rowbase + (ok ? t : ta)) * PLD + RW_COLS + tid;
#pragma unroll
            for (int g = 0; g < 3; ++g) { const float xv = bf2f(pr[g * 512]); x[g][e] = ok ? xv : 0.f; } }
        __syncthreads();
#pragma unroll
        for (int i = 0; i < 16; ++i) { float y[3];
#pragma unroll
            for (int g = 0; g < 3; ++g) { float sacc = 0.f;
#pragma unroll
                for (int f = 0; f < 5; ++f) sacc += cw[g][f] * x[g][i + f];
                y[g] = siluf_(sacc); }
            bf16_t* orow = QKV + (rowbase + ta + i) * 1536 + tid;
            orow[0] = (bf16_t)cvtpk(y[0], 0.f); orow[512] = (bf16_t)cvtpk(y[1], 0.f); orow[1024] = (bf16_t)cvtpk(y[2], 0.f);
            const float sq = wave_sum(y[0] * y[0]), sk = wave_sum(y[1] * y[1]);
            if (lane == 0) { part[(i * 8 + w) * 2] = sq; part[(i * 8 + w) * 2 + 1] = sk; } }
        __syncthreads();
        if (tid < 128) { const int i = tid >> 3, sidx = tid & 7, h = sidx & 3, sel = sidx >> 2;
            const float ss = part[(i * 8 + 2 * h) * 2 + sel] + part[(i * 8 + 2 * h + 1) * 2 + sel];
            NRM[(rowbase + ta + i) * 8 + sidx] = __builtin_amdgcn_rsqf(ss + 1e-6f) * (sel ? 1.f : 0.08838834764831845f); }
    }
    __syncthreads();
}

namespace gd {
constexpr int S128 = 288, S32 = 80;
constexpr int O_KT = 0, O_QT = O_KT + 32 * S128, O_KKT = O_QT + 32 * S128, O_RT = O_KKT + 32 * S128,
              O_VT = O_RT + 32 * S128, O_BHT = O_VT + 128 * S32, O_KHT = O_BHT + 128 * S32, O_UT = O_KHT + 128 * S32, O_UTT = O_UT + 128 * S32,
              O_TI = O_UTT + 128 * S32, O_MK = O_TI + 32 * S32, O_NB = O_MK + 32 * S32, O_NK = O_NB + 32 * S32,
              O_M21 = O_NK + 32 * S32, O_T11T = O_M21 + 16 * S32, O_T22 = O_T11T + 16 * S32, O_XT = O_T22 + 16 * S32,
              O_SBF = O_XT + 16 * S32, O_SC = O_SBF + 128 * S128, GD_BYTES = O_SC + 512;
static_assert(GD_BYTES <= LDS_MISC, "gdn LDS");
}
__device__ __forceinline__ void gdn_chain_chunked(const Args& A, Ctx& C, int chain) {
    using namespace gd;
    const int b = chain >> 3, h = (chain >> 1) & 3, dir = chain & 1;
    lbyte* L = C.lds;
    LAS float* SC = (LAS float*)(L + O_SC);
    const bf16_t* P = WSP(bf16_t, WS_P);
    bf16_t* ydir = WSP(bf16_t, WS_YDIR) + (size_t)dir * NLAT * D;
    const int tid = C.tid, lane = C.lane, w = C.wave, fr = lane & 15, fg = lane >> 4;
    const int grp = tid >> 7, idx = tid & 127;
    const float Aexp = __expf(A.in[I_ALOG][dir * 4 + h]), dtb = A.in[I_DTB][dir * 4 + h];
    const f32x4 z4 = (f32x4){0.f, 0.f, 0.f, 0.f};
    __syncthreads();
#pragma unroll 2
    for (int i = tid; i < (O_SC - O_VT) / 4; i += 512) ((LAS unsigned*)(L + O_VT))[i] = 0u;
    f32x4 Sacc[8];
#pragma unroll
    for (int i = 0; i < 8; ++i) Sacc[i] = z4;
    const bf16_t* QKV = (const bf16_t*)A.out; const float* NRM = WSP(const float, WS_NRM);
    unsigned short rq[8], rk[8], rv[8]; float nq[8], nk[8]; unsigned short raw_al = 0, raw_be = 0;
    auto chunk_geom = [&](int ch, bool& isctx, int& sbase, int& T, size_t& rowbase) { isctx = ch < 8; sbase = isctx ? ch * 32 : (ch - 8) * 32; T = isctx ? CTX : SEQ;
        rowbase = isctx ? (size_t)NLAT + (size_t)b * CTX : (size_t)b * SEQ; };
    auto issue_loads = [&](int ch) { bool isctx; int sbase, T; size_t rowbase; chunk_geom(ch, isctx, sbase, T, rowbase);
#pragma unroll
        for (int j = 0; j < 8; ++j) { const int i = 2 * grp + 8 * (j >> 1) + (j & 1); const int t = dir ? (T - 1 - (sbase + i)) : (sbase + i); const size_t row = rowbase + t;
            const bf16_t* qr = QKV + row * 1536 + 128 * h + idx; rq[j] = qr[0]; rk[j] = qr[512]; rv[j] = qr[1024]; nq[j] = NRM[row * 8 + h]; nk[j] = NRM[row * 8 + 4 + h]; }
        if (w == 7 && lane < 32) { const int t = dir ? (T - 1 - (sbase + lane)) : (sbase + lane); const bf16_t* pr = P + (rowbase + t) * PLD + RW_COLS + 2048; raw_al = pr[dir * 4 + h]; raw_be = pr[8 + dir * 4 + h]; } };
    issue_loads(0);
    for (int ch = 0; ch < 72; ++ch) {
        bool isctx; int sbase, T; size_t rowbase; chunk_geom(ch, isctx, sbase, T, rowbase);
        __syncthreads();
        float qv[8], kv[8], vv[8], nqv[8], nkv[8];
#pragma unroll
        for (int j = 0; j < 8; ++j) { qv[j] = bf2f(rq[j]); kv[j] = bf2f(rk[j]); vv[j] = bf2f(rv[j]); nqv[j] = nq[j]; nkv[j] = nk[j]; }
        if (w == 7) {
            const float gi = (lane < 32) ? -Aexp * softplusf_(bf2f(raw_al) + dtb) : 0.f;
            float cum = gi;
            cum += __builtin_bit_cast(float, __builtin_amdgcn_update_dpp(0, __builtin_bit_cast(int, cum), 0x111, 0xf, 0xf, true));
            cum += __builtin_bit_cast(float, __builtin_amdgcn_update_dpp(0, __builtin_bit_cast(int, cum), 0x112, 0xf, 0xf, true));
            cum += __builtin_bit_cast(float, __builtin_amdgcn_update_dpp(0, __builtin_bit_cast(int, cum), 0x114, 0xf, 0xf, true));
            cum += __builtin_bit_cast(float, __builtin_amdgcn_update_dpp(0, __builtin_bit_cast(int, cum), 0x118, 0xf, 0xf, true));
            const float r0 = rdlane(cum, 15);
            cum += (lane >= 16) ? r0 : 0.f;
            if (lane < 32) { SC[lane] = sigmoidf_(bf2f(raw_be)); SC[32 + lane + 1] = cum; if (lane == 0) SC[32] = 0.f; }
        }
        if (ch + 1 < 72) issue_loads(ch + 1);
        __syncthreads();
        {
            const int c = idx; const float gcC = SC[32 + 32];
#pragma unroll
            for (int jj = 0; jj < 4; ++jj) { const int i0 = 2 * grp + 8 * jj;
                float bh[2], kh[2];
#pragma unroll
                for (int e = 0; e < 2; ++e) { const int j = 2 * jj + e, i = i0 + e;
                    const float kn = kv[j] * nkv[j], qn = qv[j] * nqv[j];
                    const float gm = SC[32 + i], gi = SC[32 + i + 1], be = SC[i];
                    const unsigned p0 = cvtpk(kn, qn), p1 = cvtpk(kn * __expf(gm), qn * __expf(gi));
                    *(LAS unsigned short*)(L + O_KT + i * S128 + c * 2) = (unsigned short)p0; *(LAS unsigned short*)(L + O_QT + i * S128 + c * 2) = (unsigned short)(p0 >> 16);
                    *(LAS unsigned short*)(L + O_KKT + i * S128 + c * 2) = (unsigned short)p1; *(LAS unsigned short*)(L + O_RT + i * S128 + c * 2) = (unsigned short)(p1 >> 16);
                    bh[e] = be * kn * __expf(gcC - gm); kh[e] = be * kn * __expf(gcC - gi); }
                *(LAS unsigned*)(L + O_BHT + c * S32 + i0 * 2) = cvtpk(bh[0], bh[1]); *(LAS unsigned*)(L + O_KHT + c * S32 + i0 * 2) = cvtpk(kh[0], kh[1]);
                *(LAS unsigned*)(L + O_VT + c * S32 + i0 * 2) = cvtpk(vv[2 * jj], vv[2 * jj + 1]); }
        }
        __syncthreads();
        {
            const int isq = w >> 2, tb = (w >> 1) & 1, jb = w & 1;
            if (jb <= tb) {
                const f32x4 g4 = mm_tile<4>(L + O_KT + jb * 16 * S128, S128, L + (isq ? O_QT : O_KT) + tb * 16 * S128, S128, z4, lane);
                const int t = tb * 16 + fr;
                const float gt = SC[32 + t + isq];
                f32x4 m0, m1;
#pragma unroll
                for (int e = 0; e < 4; ++e) { const int j = jb * 16 + 4 * fg + e; const bool keep = isq ? (j <= t) : (j < t);
                    const float bj = SC[j] * g4[e];
                    m0[e] = keep ? bj * __expf(gt - SC[32 + j]) : 0.f;
                    m1[e] = keep ? bj * __expf(gt - SC[32 + j + 1]) : 0.f; }
                const int off = t * S32 + (jb * 16 + 4 * fg) * 2;
                if (isq) { st_bf16x4(L + O_NB + off, m0); st_bf16x4(L + O_NK + off, m1); }
                else {
                    st_bf16x4(L + O_MK + off, m1);
                    if (tb != jb) st_bf16x4(L + O_M21 + fr * S32 + fg * 8, m0);
                    else { float X[16]; tri_inv16(m0, lane, X);
                        if (lane < 16) {
#pragma unroll
                            for (int i = 0; i < 16; ++i) *(LAS unsigned short*)(L + O_TI + (tb * 16 + i) * S32 + (tb * 16 + lane) * 2) = (unsigned short)cvtpk(X[i], 0.f);
                            if (tb == 0) { u32x4 a0, a1;
                                a0.x = cvtpk(X[0], X[1]); a0.y = cvtpk(X[2], X[3]); a0.z = cvtpk(X[4], X[5]); a0.w = cvtpk(X[6], X[7]);
                                a1.x = cvtpk(X[8], X[9]); a1.y = cvtpk(X[10], X[11]); a1.z = cvtpk(X[12], X[13]); a1.w = cvtpk(X[14], X[15]);
                                *(LAS u32x4*)(L + O_T11T + lane * S32) = a0; *(LAS u32x4*)(L + O_T11T + lane * S32 + 16) = a1; }
                            else {
#pragma unroll
                                for (int i = 0; i < 16; ++i) *(LAS unsigned short*)(L + O_T22 + i * S32 + lane * 2) = (unsigned short)cvtpk(X[i], 0.f); }
                        } }
                }
            }
        }
        __syncthreads();
        if (w == 1) {
            const f32x4 x4 = mm_tile<1>(L + O_M21, S32, L + O_T11T, S32, z4, lane);
            st_bf16x4(L + O_XT + fr * S32 + fg * 8, x4);
            asm volatile("s_waitcnt lgkmcnt(0)" ::: "memory");
            const f32x4 t4 = mm_tile<1>(L + O_XT, S32, L + O_T22, S32, z4, lane);
            st_bf16x4(L + O_TI + (16 + fr) * S32 + fg * 8, -t4);
        }
        f32x4 yacc[2];
#pragma unroll
        for (int tb = 0; tb < 2; ++tb) {
            f32x4 u4 = mm_tile<4>(L + O_KKT + tb * 16 * S128, S128, L + O_SBF + 16 * w * S128, S128, z4, lane);
            u4 = mm_tile<1>(L + O_MK + tb * 16 * S32, S32, L + O_VT + 16 * w * S32, S32, u4, lane);
            st_bf16x4(L + O_UTT + (16 * w + fr) * S32 + tb * 32 + fg * 8, u4);
            yacc[tb] = mm_tile<4>(L + O_SBF + 16 * w * S128, S128, L + O_RT + tb * 16 * S128, S128, z4, lane);
            yacc[tb] = mm_tile<1>(L + O_VT + 16 * w * S32, S32, L + O_NK + tb * 16 * S32, S32, yacc[tb], lane);
        }
        __syncthreads();
#pragma unroll
        for (int tb = 0; tb < 2; ++tb) {
            const f32x4 u4 = mm_tile<1>(L + O_TI + tb * 16 * S32, S32, L + O_UTT + 16 * w * S32, S32, z4, lane);
            st_bf16x4(L + O_UT + (16 * w + fr) * S32 + tb * 32 + fg * 8, -u4);
        }
        __syncthreads();
        {
#pragma unroll
            for (int tb = 0; tb < 2; ++tb) {
                yacc[tb] = mm_tile<1>(L + O_UT + 16 * w * S32, S32, L + O_NB + tb * 16 * S32, S32, yacc[tb], lane);
                if (!isctx) { const int tl = sbase + tb * 16 + fr; const int t = dir ? (T - 1 - tl) : tl;
                    u32x2 pk; pk.x = cvtpk(yacc[tb][0], yacc[tb][1]); pk.y = cvtpk(yacc[tb][2], yacc[tb][3]);
                    *(u32x2*)(ydir + ((size_t)b * SEQ + t) * D + 512 + 128 * h + 16 * w + 4 * fg) = pk; }
            }
            const float wc = __expf(SC[32 + 32]);
#pragma unroll
            for (int vi = 0; vi < 8; ++vi) {
                f32x4 s4 = Sacc[vi] * wc;
                s4 = mm_tile<1>(L + O_KHT + 16 * w * S32, S32, L + O_VT + 16 * vi * S32, S32, s4, lane);
                s4 = mm_tile<1>(L + O_BHT + 16 * w * S32, S32, L + O_UT + 16 * vi * S32, S32, s4, lane);
                Sacc[vi] = s4;
                st_bf16x4(L + O_SBF + (16 * vi + fr) * S128 + (16 * w + 4 * fg) * 2, s4);
            }
        }
    }
    __syncthreads();
}

__device__ __forceinline__ void unpack8(const u32x4 w, float (&f)[8]) { f[0] = bflo(w.x); f[1] = bfhi(w.x); f[2] = bflo(w.y); f[3] = bfhi(w.y); f[4] = bflo(w.z); f[5] = bfhi(w.z); f[6] = bflo(w.w); f[7] = bfhi(w.w); }
__device__ __forceinline__ void phase_p4(const Args& A, Ctx& C) {
    const bf16_t* P = WSP(bf16_t, WS_P);
    const bf16_t* yf = WSP(bf16_t, WS_YDIR); const bf16_t* yb = yf + (size_t)NLAT * D;
    const float* bon = WSP(float, WS_BON);
    bf16_t* ymix = WSP(bf16_t, WS_YMIX);
    lbyte* SGb = C.lds;
    lfloat* GO = (lfloat*)(C.lds + 8192);
    const int tid = C.tid, lane = C.lane, w = C.wave;
    const bf16_t* gupt = WSP(const bf16_t, WS_GUPT);
    const int fr = lane & 15, fg = lane >> 4;
    const int c8 = 8 * lane;
    float lnw[8], lnb[8], ong[8], muv[8];
#pragma unroll
    for (int e = 0; e < 8; ++e) { lnw[e] = A.in[I_LNW][c8 + e]; lnb[e] = A.in[I_LNB][c8 + e]; ong[e] = A.in[I_ONG][(c8 + e) & 127]; muv[e] = A.in[I_MU][1024 + c8 + e]; }
    const int tkA = tid >> 5, lA = 4 * (tid & 31);
    float muA[4];
#pragma unroll
    for (int e = 0; e < 4; ++e) muA[e] = A.in[I_MU][1792 + lA + e];
    const bool vup = (1024 + c8) < 1440;
    for (int tile = C.bid; tile < NLAT / 16; tile += C.G) {
        const int row0 = tile * 16;
        __syncthreads();
        {
            const int row = row0 + tkA, t = row & (SEQ - 1); const bool ok = t < SEQ - 64;
            const u32x2 pw = *(const u32x2*)(P + (size_t)row * PLD + 1792 + lA); const u32x2 sw = *(const u32x2*)(P + (size_t)(row + (ok ? 64 : 0)) * PLD + 1792 + lA);
            const float pv[4] = {bflo(pw.x), bfhi(pw.x), bflo(pw.y), bfhi(pw.y)}; const float sv[4] = {bflo(sw.x), bfhi(sw.x), bflo(sw.y), bfhi(sw.y)};
            float o[4];
#pragma unroll
            for (int e = 0; e < 4; ++e) o[e] = sigmoidf_(pv[e] + muA[e] * ((ok ? sv[e] : 0.f) - pv[e]));
            u32x2 ow; ow.x = cvtpk(o[0], o[1]); ow.y = cvtpk(o[2], o[3]); *(LAS u32x2*)(SGb + tkA * 288 + lA * 2) = ow;
        }
        __syncthreads();
#pragma unroll
        for (int i = 0; i < 4; ++i) { const int c0 = 64 * w + 16 * i; f32x4 acc = (f32x4){0.f, 0.f, 0.f, 0.f};
#pragma unroll
            for (int ks = 0; ks < 4; ++ks) { const bf16x8 a = *(const LAS bf16x8*)(SGb + fr * 288 + ks * 64 + fg * 16);
                const bf16x8 bq = *(const bf16x8*)(gupt + (size_t)(c0 + fr) * 128 + ks * 32 + fg * 8);
                acc = __builtin_amdgcn_mfma_f32_16x16x32_bf16(a, bq, acc, 0, 0, 0); }
#pragma unroll
            for (int e = 0; e < 4; ++e) GO[(4 * fg + e) * 512 + c0 + fr] = acc[e]; }
        __syncthreads();
#pragma unroll
        for (int tt = 0; tt < 2; ++tt) {
            const int tk = 2 * w + tt, row = row0 + tk, t = row & (SEQ - 1);
            const bool okv = vup ? (t >= 64) : (t < SEQ - 64);
            const u32x4 wyf = *(const u32x4*)(yf + (size_t)row * D + c8), wyb = *(const u32x4*)(yb + (size_t)row * D + c8);
            const u32x4 wpv = *(const u32x4*)(P + (size_t)row * PLD + 1024 + c8), wsv = *(const u32x4*)(P + (size_t)(row + (okv ? (vup ? -64 : 64) : 0)) * PLD + 1024 + c8);
            const u32x4 wof = *(const u32x4*)(yf + (size_t)row * D + 512 + c8), wob = *(const u32x4*)(yb + (size_t)row * D + 512 + c8);
            const u32x4 wz = *(const u32x4*)(P + (size_t)row * PLD + RW_COLS + 1536 + c8);
            const float bs = bon[(size_t)row * 8 + (lane >> 3)] + bon[((size_t)NLAT + row) * 8 + (lane >> 3)];
            const f32x4 g0 = *(const LAS f32x4*)(GO + tk * 512 + c8), g1 = *(const LAS f32x4*)(GO + tk * 512 + c8 + 4);
            const float gg[8] = {g0.x, g0.y, g0.z, g0.w, g1.x, g1.y, g1.z, g1.w};
            float a[8], bq[8], pv[8], sv[8], y[8];
            unpack8(wyf, a); unpack8(wyb, bq); unpack8(wpv, pv); unpack8(wsv, sv);
            float s1 = 0.f;
#pragma unroll
            for (int e = 0; e < 8; ++e) { y[e] = a[e] + bq[e]; s1 += y[e]; }
            s1 += __shfl_xor(s1, 1); s1 += __shfl_xor(s1, 2); s1 += __shfl_xor(s1, 4);
            const float m = s1 * (1.f / 64.f);
            float s2 = 0.f;
#pragma unroll
            for (int e = 0; e < 8; ++e) { y[e] -= m; s2 += y[e] * y[e]; }
            s2 += __shfl_xor(s2, 1); s2 += __shfl_xor(s2, 2); s2 += __shfl_xor(s2, 4);
            const float rs = __builtin_amdgcn_rsqf(s2 * (1.f / 64.f) + RWKV_EPS);
            float o[8];
#pragma unroll
            for (int e = 0; e < 8; ++e) { const float vv = pv[e] + muv[e] * ((okv ? sv[e] : 0.f) - pv[e]); o[e] = (y[e] * rs * lnw[e] + lnb[e] + bs * vv) * gg[e]; }
            u32x4 ow; ow.x = cvtpk(o[0], o[1]); ow.y = cvtpk(o[2], o[3]); ow.z = cvtpk(o[4], o[5]); ow.w = cvtpk(o[6], o[7]);
            *(u32x4*)(ymix + (size_t)row * D + c8) = ow;
            float of[8], ob[8], z[8];
            unpack8(wof, of); unpack8(wob, ob); unpack8(wz, z);
            float s3 = 0.f;
#pragma unroll
            for (int e = 0; e < 8; ++e) { of[e] += ob[e]; s3 += of[e] * of[e]; }
            s3 += __shfl_xor(s3, 1); s3 += __shfl_xor(s3, 2); s3 += __shfl_xor(s3, 4); s3 += __shfl_xor(s3, 8);
            const float rg = __builtin_amdgcn_rsqf(s3 * (1.f / 128.f) + NORM_EPS);
#pragma unroll
            for (int e = 0; e < 8; ++e) o[e] = of[e] * rg * ong[e] * siluf_(z[e]);
            ow.x = cvtpk(o[0], o[1]); ow.y = cvtpk(o[2], o[3]); ow.z = cvtpk(o[4], o[5]); ow.w = cvtpk(o[6], o[7]);
            *(u32x4*)(ymix + (size_t)row * D + 512 + c8) = ow;
        }
    }
}

__device__ __forceinline__ void convert_experts(const Args& A, Ctx& C) {
    lfloat* scr = (lfloat*)(C.lds + C.wave * 16384);
    const int gw = C.bid * 8 + C.wave, NGW = C.G * 8;
    constexpr int I13 = (D / 64) * (DE / 32);
    constexpr int I2 = (DE / 64) * (D / 32);
    constexpr int PER = 2 * I13 + I2;
    for (int it = gw; it < 257 * PER; it += NGW) {
        const int e = it / PER; int r = it % PER;
        unsigned char* bt13 = A.ws + WS_WEXP + (size_t)e * WEXP_STRIDE; unsigned char* bt2 = bt13 + 512 * 1024;
        const float* w1 = e < NE ? A.in[I_EW1] + (size_t)e * D * DE : A.in[I_SW1];
        const float* w3 = e < NE ? A.in[I_EW3] + (size_t)e * D * DE : A.in[I_SW3];
        const float* w2 = e < NE ? A.in[I_EW2] + (size_t)e * DE * D : A.in[I_SW2];
        if (r < I13) { transpose_item_fp8(w1, D, DE, bt13, RowGLU{0}, SW13, scr, r, C.lane); continue; } r -= I13;
        if (r < I13) { transpose_item_fp8(w3, D, DE, bt13, RowGLU{128}, SW13, scr, r, C.lane); continue; } r -= I13;
        transpose_item_fp8(w2, DE, D, bt2, RowId(), SW2, scr, r, C.lane);
    }
}

__device__ __forceinline__ void phase_p6(const Args& A, Ctx& C) {
    const float* mod = WSP(float, WS_MOD); bf16_t* h2n = WSP(bf16_t, WS_H2N);
    const int gw = C.bid * 8 + C.wave, NGW = C.G * 8;
    for (int row = gw; row < NLAT; row += NGW) {
        const float* m = mod + (size_t)(row >> 11) * MODW;
        norm_mod_row(A.out + (size_t)row * D, A.in[I_N2G], m + 4 * D, m + 3 * D, h2n + (size_t)row * D, C.lane, (unsigned*)(A.ws + WS_H2N8) + (size_t)row * (D / 4));
    }
}

__device__ __forceinline__ void phase_p8(const Args& A, Ctx& C) {
    const float* logit = WSP(float, WS_LOGIT);
    int* tope = WSP(int, WS_TOPE); float* topw = WSP(float, WS_TOPW); int* pos = WSP(int, WS_POS);
    unsigned* cnt = WSP(unsigned, WS_CTL) + CW_CNT;
    const int gw = C.bid * 8 + C.wave, NGW = C.G * 8, lane = C.lane;
    const f32x4 rb = ((const f32x4*)A.in[I_RB])[lane];
    for (int tok = gw; tok < NLAT; tok += NGW) {
        const f32x4 lg = ((const f32x4*)(logit + (size_t)tok * NE))[lane];
        float s[4], sel[4];
#pragma unroll
        for (int i = 0; i < 4; ++i) { s[i] = sigmoidf_(lg[i]); sel[i] = s[i] + rb[i]; }
        float m1 = fmaxf(fmaxf(sel[0], sel[1]), fmaxf(sel[2], sel[3]));
        float m2;
        {
            float a = fmaxf(sel[0], sel[1]), bq = fminf(sel[0], sel[1]), cq = fmaxf(sel[2], sel[3]), dq = fminf(sel[2], sel[3]);
            m2 = fmaxf(fminf(a, cq), fmaxf(bq, dq)); }
#pragma unroll
        for (int o = 1; o < 8; o <<= 1) { const float o1 = __shfl_xor(m1, o), o2 = __shfl_xor(m2, o);
            const float n1 = fmaxf(m1, o1); const float n2 = fmaxf(fminf(m1, o1), fmaxf(m2, o2)); m1 = n1; m2 = n2; }
        const float gs = m1 + m2;
        const int grp = lane >> 3;
        int rank = 0;
#pragma unroll
        for (int gq = 0; gq < 8; ++gq) { const float og = __shfl(gs, gq * 8); rank += (og > gs || (og == gs && gq < grp)) ? 1 : 0; }
        const bool gsel = rank < 4;
        float cand[4];
#pragma unroll
        for (int i = 0; i < 4; ++i) cand[i] = gsel ? sel[i] : -INFINITY;
        int my_e = 0; float my_w = 0.f; float wsum = 0.f;
#pragma unroll
        for (int r = 0; r < 8; ++r) {
            float bv = cand[0]; int bi = 0;
#pragma unroll
            for (int i = 1; i < 4; ++i) if (cand[i] > bv) { bv = cand[i]; bi = i; }
            int be = lane * 4 + bi;
#define P8_STEP(CTRL) { const float ov = dpp_f<CTRL>(bv); const int oe = __builtin_amdgcn_update_dpp(0, be, CTRL, 0xf, 0xf, false); if (ov > bv || (ov == bv && oe < be)) { bv = ov; be = oe; } }
            P8_STEP(0x128) P8_STEP(0x124) P8_STEP(0x122) P8_STEP(0x121)
#undef P8_STEP
            float gv = rdlane(bv, 0); int ge = __builtin_amdgcn_readlane(be, 0);
#pragma unroll
            for (int rr = 1; rr < 4; ++rr) { const float ov = rdlane(bv, 16 * rr); const int oe = __builtin_amdgcn_readlane(be, 16 * rr); if (ov > gv || (ov == gv && oe < ge)) { gv = ov; ge = oe; } }
            be = ge;
            const int ol = be >> 2, oi = be & 3;
            const float mys = oi == 0 ? s[0] : (oi == 1 ? s[1] : (oi == 2 ? s[2] : s[3]));
            const float ws_ = __shfl(mys, ol);
            if (lane == ol) { if (oi == 0) cand[0] = -INFINITY; else if (oi == 1) cand[1] = -INFINITY; else if (oi == 2) cand[2] = -INFINITY; else cand[3] = -INFINITY; }
            wsum += ws_;
            if (lane == r) { my_e = be; my_w = ws_; }
        }
        if (lane < 8) {
            const float w = my_w / wsum * 2.5f;
            const unsigned p = atomicAdd(cnt + my_e, 1u);
            tope[(size_t)tok * 8 + lane] = my_e; topw[(size_t)tok * 8 + lane] = w; pos[(size_t)tok * 8 + lane] = (int)p;
        }
    }
}

__device__ __forceinline__ void tile_prefix(const Args& A, Ctx& C, LAS int* tb) {
    const unsigned* cnt = WSP(unsigned, WS_CTL) + CW_CNT;
    if (C.tid == 0) { int acc = 0; for (int e = 0; e < NE; ++e) { tb[e] = acc; acc += ((int)cnt[e] + 255) >> 8; } tb[NE] = acc; }
    __syncthreads();
}
__device__ __forceinline__ void phase_p9(const Args& A, Ctx& C) {
    LAS int* tb = (LAS int*)C.lds;
    tile_prefix(A, C, tb);
    const unsigned* cnt = WSP(unsigned, WS_CTL) + CW_CNT;
    const int* tope = WSP(int, WS_TOPE); const float* topw = WSP(float, WS_TOPW); const int* pos = WSP(int, WS_POS);
    int* rowl = WSP(int, WS_ROWL); float* roww = WSP(float, WS_ROWW); int* tile_e = WSP(int, WS_TILEE);
    const int nrt = tb[NE];
    for (int i = C.bid * 512 + C.tid; i < NLAT * 8; i += C.G * 512) { const int e = tope[i]; const int pr = tb[e] * 256 + pos[i]; rowl[pr] = i; roww[pr] = topw[i]; }
    for (int e = C.bid; e < NE; e += C.G) { const int n = (int)cnt[e], nt = tb[e + 1] - tb[e];
        for (int j = n + C.tid; j < nt * 256; j += 512) { rowl[tb[e] * 256 + j] = -1; roww[tb[e] * 256 + j] = 0.f; }
        for (int k = C.tid; k < nt; k += 512) tile_e[tb[e] + k] = e; }
    for (int i = C.bid * 512 + C.tid; i < NLAT; i += C.G * 512) { rowl[nrt * 256 + i] = i; roww[nrt * 256 + i] = 1.f; }
    for (int k = C.bid * 512 + C.tid; k < NLAT / 256; k += C.G * 512) tile_e[nrt + k] = NE;
    __syncthreads();
}

__device__ __forceinline__ void phase_moe(const Args& A, Ctx& C, int dry_shared) {
    LAS int* tb = (LAS int*)(C.lds + 131072);
    LAS int* tbl = tb + 320;
    tile_prefix(A, C, tb);
    pg8::MoeCtx M;
    M.nrt = tb[NE]; M.ntiles = M.nrt + NLAT / 256; M.G = C.G; M.vc = (C.G % 8 == 0) ? (C.bid % 8) * (C.G / 8) + C.bid / 8 : C.bid;
    M.tb = tb; M.tbl = tbl; M.cnt = WSP(unsigned, WS_CTL) + CW_CNT; M.rowl = WSP(int, WS_ROWL); M.roww = WSP(float, WS_ROWW);
    M.wexp = (const char*)(A.ws + WS_WEXP); M.h2n = (const char*)(A.ws + WS_H2N8); M.Hs = (char*)(A.ws + WS_HS) + (size_t)C.bid * 2 * 65536;
    M.Y = (unsigned char*)(A.ws + WS_Y); M.out = A.out; M.mod = WSP(const float, WS_MOD); M.dry_shared = dry_shared;
    pg8::gemm_moe(C.lds, M);
    __syncthreads();
}

__device__ __forceinline__ void phase_final(const Args& A, Ctx& C, float* dst) {
    const int gw = C.bid * 8 + C.wave, NGW = C.G * 8;
    const float* fg = A.in[I_FG]; const float* mod = WSP(const float, WS_MOD);
    const unsigned* Y = (const unsigned*)(A.ws + WS_Y);
    for (int row = gw; row < NLAT; row += NGW) {
        f32x4* xr = (f32x4*)(A.out + (size_t)row * D) + C.lane;
        const f32x4* gt = (const f32x4*)(mod + (size_t)(row >> 11) * MODW + 5 * D) + C.lane;
        const unsigned* yr = Y + (size_t)row * 8 * (D / 4) + C.lane;
        f32x4 v[4]; float s = 0.f;
#pragma unroll
        for (int j = 0; j < 4; ++j) {
            f32x4 a = (f32x4){0.f, 0.f, 0.f, 0.f};
#pragma unroll
            for (int sl = 0; sl < 8; ++sl) { const unsigned w = yr[sl * (D / 4) + 64 * j];
                const f32x2 lo = __builtin_amdgcn_cvt_pk_f32_fp8(w, false), hi = __builtin_amdgcn_cvt_pk_f32_fp8(w, true);
                a.x += lo.x; a.y += lo.y; a.z += hi.x; a.w += hi.y; }
            v[j] = xr[64 * j] + gt[64 * j] * a * (1.f / pg8::YSCALE);
            s += (v[j].x * v[j].x + v[j].y * v[j].y) + (v[j].z * v[j].z + v[j].w * v[j].w); }
        const float rstd = __builtin_amdgcn_rsqf(wave_sum(s) * (1.f / D) + NORM_EPS);
        f32x4* orow = (f32x4*)(dst + (size_t)row * D) + C.lane;
#pragma unroll
        for (int j = 0; j < 4; ++j) orow[64 * j] = v[j] * rstd * ((const f32x4*)fg)[C.lane + 64 * j];
    }
}

constexpr int NPHASE = 13;
__global__ void __launch_bounds__(512, 2) fwd_kernel(Args A) {
    extern __shared__ __attribute__((aligned(16))) unsigned char lds_raw[];
    Ctx C; C.lds = (lbyte*)lds_raw; C.tid = threadIdx.x; C.lane = C.tid & 63; C.wave = __builtin_amdgcn_readfirstlane(C.tid >> 6);
    C.G = gridDim.x; C.bid = blockIdx.x; C.a = &A;
    volatile LAS unsigned* misc = (volatile LAS unsigned*)(C.lds + LDS_MISC);
    if (C.tid < 16) misc[C.tid] = 0u;
    __syncthreads();
    XcdBarrier bar; bar.bar = WSP(unsigned, WS_CTL) + CW_BAR; bar.x = 0; bar.st = nullptr;
    const int lo = A.ph_lo, hi = A.ph_hi;
    const bool multi = (hi - lo) > 1;
    if (multi) bar = xcd_barrier_post(WSP(unsigned, WS_CTL) + CW_BAR, misc);
#ifndef PHASE_MASK
#define PHASE_MASK 0x1FFF
#endif
#define IN(k) (((PHASE_MASK >> (k)) & 1) && lo <= (k) && (k) < hi)
#define SEAM(k) do { if (IN(k) && IN((k) + 1)) xcd_barrier(bar); } while (0)
#ifndef REP_MASK
#define REP_MASK 0
#endif
#define REPS(k) (((REP_MASK >> (k)) & 1) ? 2 : 1)

    if (IN(0)) _Pragma("unroll") for (int rep = 0; rep < REPS(0); ++rep) { phase_p0(A, C); __syncthreads(); } SEAM(0);
    if (IN(1)) _Pragma("unroll") for (int rep = 0; rep < REPS(1); ++rep) { phase_p1(A, C); } SEAM(1);
    if (IN(2)) _Pragma("unroll") for (int rep = 0; rep < REPS(2); ++rep) {
        pg8::Gemm g{WSP(bf16_t, WS_XN), D}; pg8::StaticOrder S; S.init(NROWS, PLD, C.G, C.bid, WSP(bf16_t, WS_BTIN), D, 1);
        pg8::EpiBf16 E{WSP(bf16_t, WS_P), PLD, 1.f / SWIN};
        pg8::gemm_phase<pg8::EpiBf16, pg8::StaticOrder, false, 0, false, true>(C.lds, g, S, E);
    } SEAM(2);
    if (IN(3)) _Pragma("unroll") for (int rep = 0; rep < REPS(3); ++rep) { phase_gdn_prep(A, C); } SEAM(3);
#ifdef PROBE_BARRIERS
    if (multi) for (int kq = 0; kq < PROBE_BARRIERS; ++kq) xcd_barrier(bar);
#endif
    if (IN(4)) {
        for (int ch = C.bid; ch < NB * HB * 2; ch += C.G) gdn_chain_chunked(A, C, ch);
        for (int pr = C.bid; pr < NB * HA; pr += C.G) rwkv_pair_chunked(A, C, pr);
    } SEAM(4);
    if (IN(5)) _Pragma("unroll") for (int rep = 0; rep < REPS(5); ++rep) { phase_p4(A, C); } SEAM(5);
    if (IN(6)) _Pragma("unroll") for (int rep = 0; rep < REPS(6); ++rep) {
        pg8::Gemm g{WSP(bf16_t, WS_YMIX), D}; pg8::StaticOrder S; S.init(NLAT, D, C.G, C.bid, WSP(bf16_t, WS_BTOUT), D);
        pg8::EpiResGate E{A.in[I_X], A.out, WSP(float, WS_MOD), 2 * D};
        pg8::gemm_phase<pg8::EpiResGate, pg8::StaticOrder, false>(C.lds, g, S, E);
    } SEAM(6);
    if (IN(7)) _Pragma("unroll") for (int rep = 0; rep < REPS(7); ++rep) { phase_p6(A, C); __syncthreads(); convert_experts(A, C); __syncthreads(); } SEAM(7);
    if (IN(8)) _Pragma("unroll") for (int rep = 0; rep < REPS(8); ++rep) {
        pg8::Gemm g{WSP(bf16_t, WS_H2N), D}; pg8::StaticOrder S; S.init(NLAT, NE, C.G, C.bid, WSP(bf16_t, WS_BTR), D);
        pg8::EpiF32 E{WSP(float, WS_LOGIT), NE};
        pg8::gemm_phase<pg8::EpiF32, pg8::StaticOrder, false>(C.lds, g, S, E);
    } SEAM(8);
    if (IN(9)) { phase_p8(A, C); } SEAM(9);
    if (IN(10)) _Pragma("unroll") for (int rep = 0; rep < REPS(10); ++rep) { phase_p9(A, C); } SEAM(10);
    if (IN(11)) { phase_moe(A, C, 0); if (REPS(11) > 1) { __syncthreads(); phase_moe(A, C, 1); } } SEAM(11);
    if (IN(12)) { if (REPS(12) > 1) { phase_final(A, C, (float*)(A.ws + WS_WEXP)); __syncthreads(); } phase_final(A, C, A.out); }
#undef IN
#undef SEAM
}

extern "C" void kernel_launch(void* const* d_in, const int* in_sizes, int n_in, void* d_out, int out_size, void* d_ws, size_t ws_size, hipStream_t stream) {
    static int grid = 0;
    if (grid == 0) {
        if (n_in != 34 || out_size != NLAT * D || ws_size < WS_END) { fprintf(stderr, "kernel_launch: unexpected shapes (n_in %d out %d ws %zu need %zu)\n", n_in, out_size, ws_size, (size_t)WS_END); grid = -1; return; }
        int dev = 0, cus = 0;
        if (hipGetDevice(&dev) != hipSuccess || hipDeviceGetAttribute(&cus, hipDeviceAttributeMultiprocessorCount, dev) != hipSuccess) { grid = -1; return; }
        if (hipFuncSetAttribute((const void*)fwd_kernel, hipFuncAttributeMaxDynamicSharedMemorySize, LDS_BYTES) != hipSuccess) { fprintf(stderr, "kernel_launch: hipFuncSetAttribute failed\n"); grid = -1; return; }
        int per_cu = 0;
        if (hipOccupancyMaxActiveBlocksPerMultiprocessor(&per_cu, (const void*)fwd_kernel, 512, LDS_BYTES) != hipSuccess || per_cu < 1) { fprintf(stderr, "kernel_launch: occupancy query says %d\n", per_cu); }
        (void)hipGetLastError();
        grid = cus;
    }
    if (grid < 0) return;
    (void)hipMemsetAsync((char*)d_ws + WS_CTL, 0, CTL_BYTES, stream);
    Args a{};
    for (int i = 0; i < 34; ++i) a.in[i] = (const float*)d_in[i];
    a.out = (float*)d_out; a.ws = (unsigned char*)d_ws;
#if MK_PER_PHASE
    for (int p = 0; p < NPHASE; ++p) { a.ph_lo = p; a.ph_hi = p + 1; hipLaunchKernelGGL(fwd_kernel, dim3(grid), dim3(512), LDS_BYTES, stream, a); }
#else
    a.ph_lo = 0; a.ph_hi = NPHASE; hipLaunchKernelGGL(fwd_kernel, dim3(grid), dim3(512), LDS_BYTES, stream, a);
#endif
}
```

```cpp
#include <hip/hip_runtime.h>
#include <cstdio>
#include <cstdint>

#ifndef MK_PER_PHASE
#define MK_PER_PHASE 0
#endif

#define LAS __attribute__((address_space(3)))
typedef unsigned short bf16_t;
typedef short bf16x8 __attribute__((ext_vector_type(8)));
typedef float f32x4 __attribute__((ext_vector_type(4)));
typedef float f32x2 __attribute__((ext_vector_type(2)));
typedef unsigned u32x4 __attribute__((ext_vector_type(4)));
typedef unsigned u32x2 __attribute__((ext_vector_type(2)));
typedef int i32x4 __attribute__((ext_vector_type(4)));
typedef int i32x8 __attribute__((ext_vector_type(8)));
typedef LAS float lfloat;
typedef LAS unsigned char lbyte;

constexpr int D = 1024, NB = 32, SEQ = 2048, CTX = 256, GW = 64;
constexpr int NLAT = NB * SEQ;
constexpr int NCTX = NB * CTX;
constexpr int NROWS = NLAT + NCTX;
constexpr int DA = 512, HA = 8, NA = 64;
constexpr int RW_COLS = 1920, GD_COLS = 2064, IN_COLS = 3984, PLD = 4096;
constexpr int DB = 512, HB = 4, KB = 128;
constexpr int NE = 256, TOPK = 8, DE = 256;
constexpr int MODW = 6 * D;
constexpr float NORM_EPS = 1e-6f, RWKV_EPS = 64e-5f;
constexpr int MAXTILES = (NLAT * TOPK + NE * 255) / 256 + 1;

constexpr size_t MiB = 1u << 20;
constexpr size_t WS_CTL = 0, CTL_BYTES = 1 * MiB;
constexpr size_t WS_MOD = 1 * MiB;
constexpr size_t WS_BTIN = 2 * MiB, WS_BTOUT = 10 * MiB, WS_BTR = 12 * MiB, WS_BON = 13 * MiB, WS_GUPT = 17 * MiB, WS_NRM = 978 * MiB;
constexpr size_t WS_P = 18 * MiB, WS_XN = 594 * MiB, WS_YDIR = 594 * MiB, WS_YMIX = 850 * MiB;
constexpr size_t WS_H2N8 = 900 * MiB;
constexpr size_t WS_H2N = 18 * MiB, WS_LOGIT = 146 * MiB, WS_TOPE = 210 * MiB, WS_TOPW = 212 * MiB, WS_POS = 214 * MiB, WS_Y = 146 * MiB;
constexpr size_t WS_ROWL = 658 * MiB, WS_ROWW = 661 * MiB, WS_TILEE = 664 * MiB, WS_HS = 672 * MiB, WS_WEXP = 704 * MiB;
constexpr size_t WEXP_STRIDE = (size_t)(512 * 1024 + 1024 * 256);
constexpr float SW13 = 64.f, SW2 = 32.f, SHS = 8.f, SWIN = 32.f;
constexpr size_t WS_END = 1090 * MiB;
static_assert(WS_WEXP + 257 * WEXP_STRIDE <= WS_END && WS_Y + (size_t)NLAT * 8 * D <= WS_ROWL, "ws map");
constexpr int CW_BAR = 4096;
constexpr int CW_CNT = 16384;

constexpr int LDS_BYTES = 159744;
constexpr int LDS_MISC = LDS_BYTES - 64;

__device__ __forceinline__ unsigned f2bf(float f) { unsigned u = __builtin_bit_cast(unsigned, f); return (u + 0x7fffu + ((u >> 16) & 1u)) >> 16; }
typedef __bf16 bf16x2_t __attribute__((ext_vector_type(2)));
__device__ __forceinline__ unsigned cvtpk(float lo, float hi) { f32x2 v = {lo, hi}; return __builtin_bit_cast(unsigned, __builtin_convertvector(v, bf16x2_t)); }
__device__ __forceinline__ unsigned pk2(float lo, float hi) { return cvtpk(lo, hi); }
__device__ __forceinline__ unsigned pk4_fp8(float a, float b, float c, float d) { unsigned w = 0u;
    w = __builtin_amdgcn_cvt_pk_fp8_f32(__builtin_amdgcn_fmed3f(a, -448.f, 448.f), __builtin_amdgcn_fmed3f(b, -448.f, 448.f), w, false);
    w = __builtin_amdgcn_cvt_pk_fp8_f32(__builtin_amdgcn_fmed3f(c, -448.f, 448.f), __builtin_amdgcn_fmed3f(d, -448.f, 448.f), w, true); return w; }
__device__ __forceinline__ float bf2f(unsigned short b) { return __builtin_bit_cast(float, ((unsigned)b) << 16); }
__device__ __forceinline__ float bflo(unsigned w) { return __builtin_bit_cast(float, w << 16); }
__device__ __forceinline__ float bfhi(unsigned w) { return __builtin_bit_cast(float, w & 0xffff0000u); }
template <int CTRL> __device__ __forceinline__ float dpp_f(float v) { return __builtin_bit_cast(float, __builtin_amdgcn_update_dpp(0, __builtin_bit_cast(int, v), CTRL, 0xf, 0xf, false)); }
__device__ __forceinline__ float wave_sum(float v) {
    v += dpp_f<0x128>(v);
    v += dpp_f<0x124>(v);
    v += dpp_f<0x122>(v);
    v += dpp_f<0x121>(v);
    const int vi = __builtin_bit_cast(int, v);
    const float r0 = __builtin_bit_cast(float, __builtin_amdgcn_readlane(vi, 0)), r1 = __builtin_bit_cast(float, __builtin_amdgcn_readlane(vi, 16)),
                r2 = __builtin_bit_cast(float, __builtin_amdgcn_readlane(vi, 32)), r3 = __builtin_bit_cast(float, __builtin_amdgcn_readlane(vi, 48));
    return (r0 + r1) + (r2 + r3);
}
__device__ __forceinline__ float sigmoidf_(float x) { return __builtin_amdgcn_rcpf(1.f + __expf(-x)); }
__device__ __forceinline__ float siluf_(float x) { return x * __builtin_amdgcn_rcpf(1.f + __expf(-x)); }
__device__ __forceinline__ float softplusf_(float x) { return fmaxf(x, 0.f) + __logf(1.f + __expf(-fabsf(x))); }
__device__ __forceinline__ float tanhf_(float x) { const float e = __expf(-2.f * fabsf(x)); const float t = (1.f - e) * __builtin_amdgcn_rcpf(1.f + e); return x < 0.f ? -t : t; }

#define XB_TMO      128
#define XB_XCNT(j)  (256  + 64 * (j))
#define XB_XSUB(j)  (1280 + 64 * (j))
#define XB_XGEN(j)  (2304 + 64 * (j))
#define XB_TOP      3328
#define XB_TOPGEN   3392
#define XCD_BAR_WORDS 3456
#define XB_SPIN_CAP (1u << 22)
__device__ __forceinline__ unsigned xb_ld(unsigned* p)              { return __hip_atomic_load(p, __ATOMIC_RELAXED, __HIP_MEMORY_SCOPE_AGENT); }
__device__ __forceinline__ unsigned xb_add(unsigned* p, unsigned v) { return __hip_atomic_fetch_add(p, v, __ATOMIC_RELAXED, __HIP_MEMORY_SCOPE_AGENT); }
__device__ __forceinline__ unsigned xb_xcc_id() { return (unsigned)__builtin_amdgcn_s_getreg((3 << 11) | 20) & 0xFu; }
#define XB_SPIN(cond, bar) do { unsigned _sp = 0; while (cond) { __builtin_amdgcn_s_sleep(1); \
    if ((++_sp & 255u) == 0u) { if (xb_ld(&(bar)[XB_TMO])) break; if (_sp > XB_SPIN_CAP) { atomicAdd(&(bar)[XB_TMO], 1u); break; } } } } while (0)
struct XcdBarrier { unsigned* bar; unsigned x; volatile LAS unsigned* st; };
__device__ __forceinline__ XcdBarrier xcd_barrier_post(unsigned* bar, volatile LAS unsigned* st) {
    XcdBarrier b; b.bar = bar; b.x = xb_xcc_id(); b.st = st;
    if (threadIdx.x == 0) (void)xb_add(&bar[XB_XCNT(b.x)], 1u);
    return b;
}
__device__ __forceinline__ void xcd_barrier_complete(unsigned* bar, unsigned x, unsigned& nloc, unsigned& nx) {
    const unsigned G = gridDim.x * gridDim.y * gridDim.z;
    unsigned sum, cnt, mine, sp = 0u;
    for (;;) {
        sum = 0u; cnt = 0u; mine = 0u;
#pragma unroll
        for (unsigned j = 0; j < 16; ++j) { const unsigned c = xb_ld(&bar[XB_XCNT(j)]); sum += c; cnt += (c > 0u) ? 1u : 0u; mine = (j == x) ? c : mine; }
        if (sum == G) break;
        __builtin_amdgcn_s_sleep(1);
        if ((++sp & 255u) == 0u) { if (xb_ld(&bar[XB_TMO])) break; if (sp > XB_SPIN_CAP) { atomicAdd(&bar[XB_TMO], 1u); break; } }
    }
    nloc = mine > 0u ? mine : 1u; nx = cnt > 0u ? cnt : 1u;
}
__device__ __forceinline__ void xcd_barrier(const XcdBarrier& b) {
    asm volatile("s_waitcnt vmcnt(0)" ::: "memory");
    __syncthreads();
    if (threadIdx.x == 0) {
        unsigned* bar = b.bar;
        __builtin_amdgcn_s_waitcnt(0);
        unsigned nloc = b.st[0], nx = b.st[1];
        if (nloc == 0u) { xcd_barrier_complete(bar, b.x, nloc, nx); b.st[0] = nloc; b.st[1] = nx; }
        const unsigned old = xb_add(&bar[XB_XSUB(b.x)], 1u);
        const unsigned gen = old / nloc;
        if (old + 1u == (gen + 1u) * nloc) {
            __builtin_amdgcn_fence(__ATOMIC_RELEASE, "agent");
            asm volatile("s_waitcnt vmcnt(0)" ::: "memory");
            const unsigned og = xb_add(&bar[XB_TOP], 1u);
            const unsigned tg = og / nx;
            if (og + 1u == (tg + 1u) * nx) xb_add(&bar[XB_TOPGEN], 1u);
            else XB_SPIN(xb_ld(&bar[XB_TOPGEN]) == tg, bar);
            __builtin_amdgcn_fence(__ATOMIC_ACQUIRE, "agent");
            xb_add(&bar[XB_XGEN(b.x)], 1u);
            asm volatile("s_waitcnt vmcnt(0)" ::: "memory");
        } else {
            XB_SPIN(xb_ld(&bar[XB_XGEN(b.x)]) == gen, bar);
            __builtin_amdgcn_fence(__ATOMIC_ACQUIRE, "agent");
            asm volatile("s_waitcnt vmcnt(0)" ::: "memory");
        }
    }
    __syncthreads();
}

struct Args {
    const float* in[34];
    float* out;
    unsigned char* ws;
    int ph_lo, ph_hi;
};
enum { I_X = 0, I_C, I_CTX, I_CCTX, I_WADA, I_BADA, I_N1G, I_WIN, I_MU, I_W0, I_WUP, I_A0, I_AUP, I_GUP, I_KK, I_KA, I_RK, I_LNW, I_LNB,
       I_CONVW, I_ALOG, I_DTB, I_ONG, I_WOUT, I_N2G, I_RW, I_RB, I_EW1, I_EW3, I_EW2, I_SW1, I_SW3, I_SW2, I_FG };

namespace pg8 {
constexpr int BM = 256, BK = 64, HALF = 128, HTB = HALF * BK * 2, STAGE_BYTES = 8 * HTB, NXCD = 8, WGM = 8;
__host__ __device__ __forceinline__ int lds_byte(int r, int c) { const int st = (r >> 4) * 2 + (c >> 5), rr = r & 15, cc = c & 31, ob = rr * 64 + cc * 2; return st * 1024 + (ob ^ (((ob >> 9) & 1) << 5)); }
__host__ __device__ __forceinline__ void stage_rc(int b, int& R, int& C) { const int st = b / 1024, sb = b % 1024, swz = sb ^ (((sb >> 9) & 1) << 5); R = (st >> 1) * 16 + swz / 64; C = (st & 1) * 32 + (swz % 64) / 2; }
__host__ __device__ __forceinline__ int perm32(int rho) { const int n = rho >> 4, i = rho & 15; return 8 * (i >> 2) + 4 * n + (i & 3); }
struct Unit { int pm, pn; };
struct Gemm { const bf16_t* A; int K; };
struct StaticOrder {
    int nM, nN, nwg, G, c; const char* Bt; size_t tstepB;
    __device__ void init(int M, int N, int G_, int c_, const void* Bt_, int K, int es = 2) { nM = M / BM; nN = N / BM; nwg = nM * nN; G = G_; c = c_; Bt = (const char*)Bt_; tstepB = (size_t)BM * K * es; }
    __device__ bool next(int i, Unit& u) const {
        const long L = (long)i * G + c; if (L >= nwg) return false;
        int wgid = (int)L; { const int q = nwg / NXCD, r = nwg % NXCD, xcd = wgid % NXCD, off = wgid / NXCD; wgid = (xcd < r ? xcd * (q + 1) : r * (q + 1) + (xcd - r) * q) + off; }
        const int nig = WGM * nN, gid = wgid / nig, fm = gid * WGM, gsz = (nM - fm) < WGM ? (nM - fm) : WGM;
        u.pm = fm + ((wgid % nig) % gsz); u.pn = (wgid % nig) / gsz; return true;
    }
    __device__ __forceinline__ const char* bptr(const Unit& u) const { return Bt + (size_t)u.pn * tstepB; }
    __device__ __forceinline__ int rowsel(const Unit&, int) const { return 0; }
};
struct TileOrder {
    int nunits, npn, G, c; const int* tile_e; const char* wbase; size_t wstride, woff, tstepB; const int* rowl;
    __device__ bool next(int i, Unit& u) const { const int L = i * G + c; if (L >= nunits) return false; u.pm = L / npn; u.pn = L - u.pm * npn; return true; }
    __device__ __forceinline__ const char* bptr(const Unit& u) const { const int e = __builtin_amdgcn_readfirstlane(tile_e[u.pm]); return wbase + (size_t)e * wstride + woff + (size_t)u.pn * tstepB; }
    __device__ __forceinline__ int rowsel(const Unit& u, int r) const { const int t = rowl[(size_t)u.pm * 256 + r]; return t < 0 ? 0 : t; }
};
struct SeqOrder {
    int n; const char* Bt; size_t tstepB; const LAS int* rsel;
    __device__ bool next(int i, Unit& u) const { if (i >= n) return false; u.pm = 0; u.pn = i; return true; }
    __device__ __forceinline__ const char* bptr(const Unit& u) const { return Bt + (size_t)u.pn * tstepB; }
    __device__ __forceinline__ int rowsel(const Unit&, int r) const { return rsel[r]; }
};
__device__ __forceinline__ unsigned cvt_pk_bf16(float lo, float hi) { return cvtpk(lo, hi); }

template <class Epi, class Sched, bool GATHER, int A_AUX = 0, bool ALIGN = true, bool FP8 = false>
__device__ __forceinline__ void gemm_phase(lbyte* lds, const Gemm g, const Sched& S, const Epi& E) {
    int tid_ = threadIdx.x; asm volatile("" : "+v"(tid_));
    const int tid = tid_, wid = __builtin_amdgcn_readfirstlane(tid >> 6), lane = tid & 63, wr = wid >> 2, wc = wid & 3, fr = lane & 15, fq = lane >> 4;
    constexpr unsigned ES = FP8 ? 1u : 2u;
    const int K = g.K, nt = FP8 ? K / 128 : K / BK;
    Unit cur, nxt; int ui = 0;
    if (!S.next(0, cur)) return;
    int Rst[2], Cst[2];
    unsigned voffA[2], voffA1[2], voffB[2], nvA[2], nvA1[2];
#pragma unroll
    for (int i = 0; i < 2; ++i) { int R, C; stage_rc(tid * 16 + i * 8192, R, C); const int Rb = Epi::PERM ? ((R & ~31) + perm32(R & 31)) : R; Rst[i] = R; Cst[i] = C;
        if (GATHER) { voffA[i] = (unsigned)S.rowsel(cur, R) * (unsigned)K * ES + (unsigned)C * 2u; voffA1[i] = (unsigned)S.rowsel(cur, 128 + R) * (unsigned)K * ES + (unsigned)C * 2u; }
        else { voffA[i] = (unsigned)(R * K) * ES + (unsigned)C * 2u; voffA1[i] = voffA[i]; }
        nvA[i] = voffA[i]; nvA1[i] = voffA1[i];
        voffB[i] = (unsigned)(Rb * K) * ES + (unsigned)C * 2u; }
    const size_t kstep = (size_t)(BK * 2);
    const size_t hstep = (size_t)HALF * K * ES;
    const size_t hstepA = GATHER ? 0 : hstep;
    const size_t tstep = 2 * hstep;
    const unsigned ldsw = (unsigned)wid * 1024u;
    const int aoff = lds_byte(wr * 64 + fr, FP8 ? fq * 16 : fq * 8), boff = lds_byte(wc * 32 + fr, FP8 ? fq * 16 : fq * 8);
#define PG8_SA(b, h) (((b) * 2 + (h)) * HTB)
#define PG8_SB(b, h) ((4 + (b) * 2 + (h)) * HTB)
#define PG8_STAGE2(bufoff, gbase, v0, v1) do { \
        __builtin_amdgcn_global_load_lds((const unsigned*)((const char*)(gbase) + (v0)), (LAS unsigned*)(lds + (bufoff) + ldsw), 16, 0, 0); \
        __builtin_amdgcn_global_load_lds((const unsigned*)((const char*)(gbase) + (v1)), (LAS unsigned*)(lds + (bufoff) + ldsw + 8192), 16, 0, 0); } while (0)
#define PG8_STAGE2A(bufoff, gbase, v0, v1) do { if constexpr (A_AUX == 16) { \
        __builtin_amdgcn_global_load_lds((const unsigned*)((const char*)(gbase) + (v0)), (LAS unsigned*)(lds + (bufoff) + ldsw), 16, 0, 16); \
        __builtin_amdgcn_global_load_lds((const unsigned*)((const char*)(gbase) + (v1)), (LAS unsigned*)(lds + (bufoff) + ldsw + 8192), 16, 0, 16); } else { PG8_STAGE2(bufoff, gbase, v0, v1); } } while (0)
#define PG8_STAGE(bufoff, gbase, voff) PG8_STAGE2(bufoff, gbase, (voff)[0], (voff)[1])
#define PG8_STAGEA(bufoff, gbase, voff) PG8_STAGE2A(bufoff, gbase, (voff)[0], (voff)[1])
#define G_LD32(p) __builtin_shufflevector(*(const LAS i32x4*)(p), *(const LAS i32x4*)((p) + 16), 0, 1, 2, 3, 4, 5, 6, 7)
#define G_MFMA8(c, a, b) asm volatile("v_mfma_scale_f32_16x16x128_f8f6f4 %0, %1, %2, %0, %3, %3 op_sel_hi:[0,0,0]" : "+v"(c) : "v"(a), "v"(b), "v"(one_scale))
#define PG8_LDA(dst, b, h) do { if constexpr (FP8) { _Pragma("unroll") for (int m = 0; m < 4; ++m) dst##8[m] = G_LD32(lds + PG8_SA(b, h) + aoff + m * 2048); } else { \
        _Pragma("unroll") for (int m = 0; m < 4; ++m) _Pragma("unroll") for (int k = 0; k < 2; ++k) dst[m][k] = *(const LAS bf16x8*)(lds + PG8_SA(b, h) + aoff + m * 2048 + k * 1024); } } while (0)
#define PG8_LDB(dst, b, h) do { if constexpr (FP8) { _Pragma("unroll") for (int n = 0; n < 2; ++n) dst##8[n] = G_LD32(lds + PG8_SB(b, h) + boff + n * 2048); } else { \
        _Pragma("unroll") for (int n = 0; n < 2; ++n) _Pragma("unroll") for (int k = 0; k < 2; ++k) dst[n][k] = *(const LAS bf16x8*)(lds + PG8_SB(b, h) + boff + n * 2048 + k * 1024); } } while (0)
#define PG8_MMA(ai, bj, At, Bt) do { __builtin_amdgcn_s_setprio(1); if constexpr (FP8) { _Pragma("unroll") for (int m = 0; m < 4; ++m) _Pragma("unroll") for (int n = 0; n < 2; ++n) G_MFMA8(acc[ai][bj][m][n], Bt##8[n], At##8[m]); } else { \
        _Pragma("unroll") for (int m = 0; m < 4; ++m) _Pragma("unroll") for (int n = 0; n < 2; ++n) _Pragma("unroll") for (int k = 0; k < 2; ++k) \
        acc[ai][bj][m][n] = __builtin_amdgcn_mfma_f32_16x16x32_bf16(Bt[n][k], At[m][k], acc[ai][bj][m][n], 0, 0, 0); } __builtin_amdgcn_s_setprio(0); } while (0)
#define PG8_WAIT_V(n) asm volatile("s_waitcnt vmcnt(" #n ")" ::: "memory")
#define PG8_WAIT_L(n) asm volatile("s_waitcnt lgkmcnt(" #n ")" ::: "memory")
#define PG8_BAR __builtin_amdgcn_s_barrier()
#define PG8_SCHED __builtin_amdgcn_sched_barrier(0)
    f32x4 acc[2][2][4][2];
#pragma unroll
    for (int a = 0; a < 2; ++a)
#pragma unroll
        for (int b = 0; b < 2; ++b)
#pragma unroll
            for (int m = 0; m < 4; ++m)
#pragma unroll
                for (int n = 0; n < 2; ++n) acc[a][b][m][n] = (f32x4){0.f, 0.f, 0.f, 0.f};
    bf16x8 At[4][2], B0[2][2], B1[2][2]; i32x8 At8[4], B08[2], B18[2];
    int one_scale = 0x7F7F7F7F; asm volatile("" : "+v"(one_scale));
    const char* cA = (const char*)g.A + (GATHER ? (size_t)0 : (size_t)cur.pm * tstep); const char* cB = S.bptr(cur);
    PG8_STAGE(PG8_SB(0, 0), cB, voffB); PG8_STAGE(PG8_SB(0, 1), cB + hstep, voffB); PG8_STAGEA(PG8_SA(0, 0), cA, voffA); PG8_STAGEA(PG8_SA(0, 1), cA + hstepA, voffA1);
    if (wr == 1) PG8_BAR;
    PG8_WAIT_V(2); PG8_BAR;
    PG8_STAGE(PG8_SB(1, 0), cB + kstep, voffB); PG8_STAGEA(PG8_SA(1, 0), cA + kstep, voffA); PG8_STAGE(PG8_SB(1, 1), cB + hstep + kstep, voffB);
    PG8_WAIT_V(6); PG8_BAR;
    for (;;) {
        const bool has_next = S.next(ui + 1, nxt);
        const char* nA = has_next ? (const char*)g.A + (GATHER ? (size_t)0 : (size_t)nxt.pm * tstep) : cA; const char* nB = has_next ? S.bptr(nxt) : cB;
        for (int t = 0; t < nt; t += 2) {
            const bool last = (t == nt - 2);
            const char* a1 = cA + (size_t)(t + 1) * kstep;
            const char* a2 = last ? nA : cA + (size_t)(t + 2) * kstep; const char* b2 = last ? nB : cB + (size_t)(t + 2) * kstep;
            const char* a3 = a2 + kstep; const char* b3 = b2 + kstep;
            if (GATHER && last && has_next) {
#pragma unroll
                for (int i = 0; i < 2; ++i) { nvA[i] = (unsigned)S.rowsel(nxt, Rst[i]) * (unsigned)K * ES + (unsigned)Cst[i] * 2u; nvA1[i] = (unsigned)S.rowsel(nxt, 128 + Rst[i]) * (unsigned)K * ES + (unsigned)Cst[i] * 2u; }
            }
            const unsigned x0 = (GATHER && last) ? nvA[0] : voffA[0], x1 = (GATHER && last) ? nvA[1] : voffA[1];
            const unsigned y0 = (GATHER && last) ? nvA1[0] : voffA1[0], y1 = (GATHER && last) ? nvA1[1] : voffA1[1];
            PG8_LDB(B0, 0, 0); PG8_LDB(B1, 0, 1); PG8_SCHED; PG8_LDA(At, 0, 0); PG8_STAGEA(PG8_SA(1, 1), a1 + hstepA, voffA1);
            PG8_WAIT_V(8); PG8_WAIT_L(0); PG8_BAR; PG8_MMA(0, 0, At, B0); PG8_MMA(0, 1, At, B1); PG8_BAR; PG8_SCHED;
            PG8_LDA(At, 0, 1); PG8_STAGE(PG8_SB(0, 0), b2, voffB); PG8_STAGE(PG8_SB(0, 1), b2 + hstep, voffB); PG8_STAGE2A(PG8_SA(0, 0), a2, x0, x1);
            PG8_WAIT_V(8); PG8_WAIT_L(0); PG8_BAR; PG8_MMA(1, 0, At, B0); PG8_MMA(1, 1, At, B1); PG8_BAR; PG8_SCHED;
            PG8_LDB(B0, 1, 0); PG8_LDB(B1, 1, 1); PG8_SCHED; PG8_LDA(At, 1, 0); PG8_STAGE2A(PG8_SA(0, 1), a2 + hstepA, y0, y1);
            PG8_WAIT_V(8); PG8_WAIT_L(0); PG8_BAR; PG8_MMA(0, 0, At, B0); PG8_MMA(0, 1, At, B1); PG8_BAR; PG8_SCHED;
            PG8_LDA(At, 1, 1); PG8_STAGE(PG8_SB(1, 0), b3, voffB); PG8_STAGE(PG8_SB(1, 1), b3 + hstep, voffB); PG8_STAGE2A(PG8_SA(1, 0), a3, x0, x1);
            PG8_WAIT_V(8); PG8_WAIT_L(0); PG8_BAR; PG8_MMA(1, 0, At, B0); PG8_MMA(1, 1, At, B1); PG8_BAR; PG8_SCHED;
        }
        if (ALIGN && wr == 0) PG8_BAR;
        if constexpr (FP8) asm volatile("s_nop 15\n\ts_nop 15" ::: "memory");
        E(acc, cur, wr, wc, fr, fq);
        if (!has_next) break;
#pragma unroll
        for (int a = 0; a < 2; ++a)
#pragma unroll
            for (int b = 0; b < 2; ++b)
#pragma unroll
                for (int m = 0; m < 4; ++m)
#pragma unroll
                    for (int n = 0; n < 2; ++n) acc[a][b][m][n] = (f32x4){0.f, 0.f, 0.f, 0.f};
        cur = nxt; cA = nA; cB = nB; ++ui;
        if (GATHER) { voffA[0] = nvA[0]; voffA[1] = nvA[1]; voffA1[0] = nvA1[0]; voffA1[1] = nvA1[1]; }
        if (ALIGN && wr == 1) PG8_BAR;
    }
    PG8_WAIT_V(0);
    if (!ALIGN && wr == 0) PG8_BAR;
    PG8_BAR;
#undef PG8_SA
#undef PG8_SB
#undef PG8_STAGE
#undef PG8_STAGE2
#undef PG8_STAGE2A
#undef PG8_STAGEA
#undef G_LD32
#undef G_MFMA8
#undef PG8_LDA
#undef PG8_LDB
#undef PG8_MMA
#undef PG8_WAIT_V
#undef PG8_WAIT_L
#undef PG8_BAR
#undef PG8_SCHED
}

struct EpiBf16 {
    static constexpr bool PERM = true;
    bf16_t* O; int ldc; float scale;
    __device__ __forceinline__ void operator()(const f32x4 (&acc)[2][2][4][2], const Unit& u, int wr, int wc, int fr, int fq) const {
        const int row0 = u.pm * BM + wr * 64 + fr; const int col0 = u.pn * BM + wc * 32 + 8 * fq;
#pragma unroll
        for (int ai = 0; ai < 2; ++ai)
#pragma unroll
            for (int m = 0; m < 4; ++m) { bf16_t* rowp = O + (size_t)(row0 + ai * HALF + m * 16) * ldc + col0;
#pragma unroll
                for (int bj = 0; bj < 2; ++bj) { const f32x4 v0 = acc[ai][bj][m][0] * scale, v1 = acc[ai][bj][m][1] * scale;
                    u32x4 w; w.x = cvt_pk_bf16(v0[0], v0[1]); w.y = cvt_pk_bf16(v0[2], v0[3]); w.z = cvt_pk_bf16(v1[0], v1[1]); w.w = cvt_pk_bf16(v1[2], v1[3]);
                    *(u32x4*)(rowp + bj * HALF) = w; } }
    }
};
struct EpiF32 {
    static constexpr bool PERM = false;
    float* C; int ldc;
    __device__ __forceinline__ void operator()(const f32x4 (&acc)[2][2][4][2], const Unit& u, int wr, int wc, int fr, int fq) const {
        const int row0 = u.pm * BM + wr * 64 + fr, col0 = u.pn * BM + wc * 32 + 4 * fq;
#pragma unroll
        for (int ai = 0; ai < 2; ++ai)
#pragma unroll
            for (int m = 0; m < 4; ++m) { float* rowp = C + (size_t)(row0 + ai * HALF + m * 16) * ldc + col0;
#pragma unroll
                for (int bj = 0; bj < 2; ++bj)
#pragma unroll
                    for (int n = 0; n < 2; ++n) *(f32x4*)(rowp + bj * HALF + n * 16) = acc[ai][bj][m][n]; }
    }
};
struct EpiResGate {
    static constexpr bool PERM = false;
    const float* x; float* out; const float* mod; int gate_off;
    __device__ __forceinline__ void operator()(const f32x4 (&acc)[2][2][4][2], const Unit& u, int wr, int wc, int fr, int fq) const {
        const int row0 = u.pm * BM + wr * 64 + fr, col0 = u.pn * BM + wc * 32 + 4 * fq;
        const float* gp = mod + (size_t)((u.pm * BM) >> 11) * MODW + gate_off + col0;
        f32x4 gv[2][2];
#pragma unroll
        for (int bj = 0; bj < 2; ++bj)
#pragma unroll
            for (int n = 0; n < 2; ++n) gv[bj][n] = *(const f32x4*)(gp + bj * HALF + n * 16);
#pragma unroll
        for (int ai = 0; ai < 2; ++ai)
#pragma unroll
            for (int m = 0; m < 4; ++m) { const size_t off = (size_t)(row0 + ai * HALF + m * 16) * D + col0;
#pragma unroll
                for (int bj = 0; bj < 2; ++bj)
#pragma unroll
                    for (int n = 0; n < 2; ++n) { const f32x4 xv = *(const f32x4*)(x + off + bj * HALF + n * 16);
                        *(f32x4*)(out + off + bj * HALF + n * 16) = xv + gv[bj][n] * acc[ai][bj][m][n]; }
                asm volatile("" ::: "memory"); }
    }
};
struct EpiGLU {
    static constexpr bool PERM = true;
    bf16_t* H;
    __device__ __forceinline__ void operator()(const f32x4 (&acc)[2][2][4][2], const Unit& u, int wr, int wc, int fr, int fq) const {
        const int row0 = u.pm * BM + wr * 64 + fr; const int col0 = u.pn * 128 + wc * 32 + 8 * fq;
#pragma unroll
        for (int ai = 0; ai < 2; ++ai)
#pragma unroll
            for (int m = 0; m < 4; ++m) { bf16_t* rowp = H + (size_t)(row0 + ai * HALF + m * 16) * 256 + col0;
                f32x4 h0, h1;
#pragma unroll
                for (int j = 0; j < 4; ++j) { const float a0 = acc[ai][0][m][0][j], a1 = acc[ai][0][m][1][j];
                    h0[j] = siluf_(a0) * acc[ai][1][m][0][j]; h1[j] = siluf_(a1) * acc[ai][1][m][1][j]; }
                u32x4 w; w.x = cvt_pk_bf16(h0[0], h0[1]); w.y = cvt_pk_bf16(h0[2], h0[3]); w.z = cvt_pk_bf16(h1[0], h1[1]); w.w = cvt_pk_bf16(h1[2], h1[3]);
                *(u32x4*)rowp = w; }
    }
};
constexpr float YSCALE = 8.f;
struct EpiY {
    static constexpr bool PERM = true;
    unsigned char* Y; float* out; const float* mod; const LAS int* rtok; const LAS float* rw; int shared;
    __device__ __forceinline__ void operator()(const f32x4 (&acc)[2][2][4][2], const Unit& u, int wr, int wc, int fr, int fq) const {
        const int col0 = u.pn * BM + wc * 32 + 8 * fq;
#pragma unroll
        for (int ai = 0; ai < 2; ++ai)
#pragma unroll
            for (int m = 0; m < 4; ++m) { const int r = wr * 64 + fr + ai * HALF + m * 16; const int ts = rtok[r]; const float w = rw[r];
                if (ts >= 0) {
                    if (shared) { const unsigned goff = (unsigned)(ts >> 11) * MODW + 5 * D + col0; const unsigned ooff = (unsigned)ts * D + col0;
#pragma unroll
                        for (int bj = 0; bj < 2; ++bj)
#pragma unroll
                            for (int n = 0; n < 2; ++n) { const f32x4 gv = *(const f32x4*)(mod + goff + bj * HALF + n * 4); f32x4* op = (f32x4*)(out + ooff + bj * HALF + n * 4);
                                *op = *op + gv * acc[ai][bj][m][n]; }
                    } else { unsigned char* yp = Y + (size_t)(unsigned)ts * D + col0; const float ws_ = w * YSCALE;
#pragma unroll
                        for (int bj = 0; bj < 2; ++bj) { f32x4 v0 = acc[ai][bj][m][0] * ws_, v1 = acc[ai][bj][m][1] * ws_;
#pragma unroll
                                for (int j = 0; j < 4; ++j) { v0[j] = __builtin_amdgcn_fmed3f(v0[j], -448.f, 448.f); v1[j] = __builtin_amdgcn_fmed3f(v1[j], -448.f, 448.f); }
                            unsigned lo = 0u, hi = 0u;
                            lo = __builtin_amdgcn_cvt_pk_fp8_f32(v0[0], v0[1], lo, false); lo = __builtin_amdgcn_cvt_pk_fp8_f32(v0[2], v0[3], lo, true);
                            hi = __builtin_amdgcn_cvt_pk_fp8_f32(v1[0], v1[1], hi, false); hi = __builtin_amdgcn_cvt_pk_fp8_f32(v1[2], v1[3], hi, true);
                            u32x2 pk; pk.x = lo; pk.y = hi; *(u32x2*)(yp + bj * HALF) = pk; } } }
                asm volatile("" ::: "memory"); }
    }
};

struct MoeCtx {
    int ntiles, nrt, G, vc;
    const LAS int* tb; LAS int* tbl;
    const unsigned* cnt; const int* rowl; const float* roww;
    const char* wexp; const char* h2n; char* Hs; unsigned char* Y; float* out; const float* mod; int dry_shared;
};
__device__ __forceinline__ void gemm_moe(lbyte* lds, const MoeCtx& M) {
    int tid_ = threadIdx.x; asm volatile("" : "+v"(tid_));
    const int tid = tid_, wid = __builtin_amdgcn_readfirstlane(tid >> 6), lane = tid & 63, wr = wid >> 2, wc = wid & 3, fr = lane & 15, fq = lane >> 4;
    const int ntl = (M.ntiles - M.vc + M.G - 1) / M.G;
    if (M.vc >= M.ntiles) return;
    const int nunits = ntl * 6;
    const unsigned ldsw = (unsigned)wid * 1024u;
    const int aoff = lds_byte(wr * 64 + fr, fq * 16), boff = lds_byte(wc * 32 + fr, fq * 16);
    auto tile_expert = [&](int tile, int& e, int& k) { if (tile < M.nrt) { int lo = 0, hi = NE - 1; while (lo < hi) { const int mid = (lo + hi + 1) >> 1; if (M.tb[mid] <= tile) lo = mid; else hi = mid - 1; } e = lo; k = tile - M.tb[lo]; } else { e = NE; k = tile - M.nrt; } };
    auto fill = [&](int j) { if (j < ntl && tid < 256) { const int tile = M.vc + j * M.G; int e, k; tile_expert(tile, e, k); LAS int* T = M.tbl + (j % 3) * 768;
            int ts; float w;
            if (e < NE) { const int valid = (int)M.cnt[e] - 256 * k; if (tid < valid) { ts = M.rowl[(size_t)tile * 256 + tid]; w = M.roww[(size_t)tile * 256 + tid]; } else { ts = -1; w = 0.f; } T[tid] = ts < 0 ? 0 : (ts >> 3); }
            else { ts = k * 256 + tid; w = 1.f; T[tid] = ts; }
            T[256 + tid] = ts; ((LAS float*)T)[512 + tid] = w; } };
    struct UP { const char* aB; const char* bB; unsigned bh; int nt, kind, pn, slot, shared, e, hbuf, fillnext; };
    auto unit_params = [&](int ui, int prev_e, UP& u, unsigned (&oa)[4], unsigned (&ob)[2]) {
        int tq = threadIdx.x; asm volatile("" : "+v"(tq));
        int Rst[2], Cst[2], Rbp[2];
#pragma unroll
        for (int i = 0; i < 2; ++i) { int R, C; stage_rc(tq * 16 + i * 8192, R, C); Rst[i] = R; Cst[i] = C; Rbp[i] = (R & ~31) + perm32(R & 31); }
        int j, sub;
        if (ui < 2) { j = 0; sub = ui; }
        else { const int qq = ui - 2, g = qq / 6, r = qq - 6 * g; if (g < ntl - 1 && r < 2) { j = g + 1; sub = r; } else { j = g; sub = (g < ntl - 1) ? r : r + 2; } }
        const int tile = M.vc + j * M.G; int e, k;
        if (sub == 0 || sub == 2) tile_expert(tile, e, k); else e = prev_e;
        u.e = e;
        const char* w = M.wexp + (size_t)e * WEXP_STRIDE;
        u.slot = j % 3; u.hbuf = j & 1; u.fillnext = (sub == 1) ? j + 1 : -1; u.shared = (e == NE) ? 1 : 0;
        if (sub < 2) { u.kind = 0; u.pn = sub; u.nt = D / 128; u.aB = M.h2n; u.bB = w + (size_t)sub * 256 * D; u.bh = 128u * D;
            const LAS int* T = M.tbl + (j % 3) * 768;
#pragma unroll
            for (int i = 0; i < 2; ++i) { oa[i] = (unsigned)T[Rst[i]] * (unsigned)D + 2u * (unsigned)Cst[i]; oa[2 + i] = (unsigned)T[128 + Rst[i]] * (unsigned)D + 2u * (unsigned)Cst[i]; ob[i] = (unsigned)(Rbp[i] * D + 2 * Cst[i]); } }
        else { u.kind = 1; u.pn = sub - 2; u.nt = DE / 128; u.aB = M.Hs + (j & 1) * 65536; u.bB = w + (size_t)512 * 1024 + (size_t)(sub - 2) * 256 * DE; u.bh = 128u * DE;
#pragma unroll
            for (int i = 0; i < 2; ++i) { oa[i] = (unsigned)(Rst[i] * DE + 2 * Cst[i]); oa[2 + i] = (unsigned)((128 + Rst[i]) * DE + 2 * Cst[i]); ob[i] = (unsigned)(Rbp[i] * DE + 2 * Cst[i]); } }
    };
#define PG8_SA(b, h) (((b) * 2 + (h)) * HTB)
#define PG8_SB(b, h) ((4 + (b) * 2 + (h)) * HTB)
#define MOE_DMA(bufoff, ptr, aux) __builtin_amdgcn_global_load_lds((const unsigned*)(ptr), (LAS unsigned*)(lds + (bufoff)), 16, 0, aux)
#define MOE_STA(bufoff, base, o0, o1) do { MOE_DMA((bufoff) + ldsw, (base) + (o0), 16); MOE_DMA((bufoff) + ldsw + 8192, (base) + (o1), 16); } while (0)
#define MOE_STAK(kindv, bufoff, base, o0, o1) do { if ((kindv) == 0) { MOE_DMA((bufoff) + ldsw, (base) + (o0), 0); MOE_DMA((bufoff) + ldsw + 8192, (base) + (o1), 0); } else MOE_STA(bufoff, base, o0, o1); } while (0)
#define MOE_STB(bufoff, base, o0, o1) do { MOE_DMA((bufoff) + ldsw, (base) + (o0), 0); MOE_DMA((bufoff) + ldsw + 8192, (base) + (o1), 0); } while (0)
#define MOE_LD32(p) __builtin_shufflevector(*(const LAS i32x4*)(p), *(const LAS i32x4*)((p) + 16), 0, 1, 2, 3, 4, 5, 6, 7)
#define PG8_LDA(dst, b, h) do { _Pragma("unroll") for (int m = 0; m < 4; ++m) dst[m] = MOE_LD32(lds + PG8_SA(b, h) + aoff + m * 2048); } while (0)
#define PG8_LDB(dst, b, h) do { _Pragma("unroll") for (int n = 0; n < 2; ++n) dst[n] = MOE_LD32(lds + PG8_SB(b, h) + boff + n * 2048); } while (0)
#define MOE_MFMA(c, a, b) asm volatile("v_mfma_scale_f32_16x16x128_f8f6f4 %0, %1, %2, %0, %3, %3 op_sel_hi:[0,0,0]" : "+v"(c) : "v"(a), "v"(b), "v"(one_scale))
#define PG8_MMA(ai, bj, At, Bt) do { __builtin_amdgcn_s_setprio(1); _Pragma("unroll") for (int m = 0; m < 4; ++m) _Pragma("unroll") for (int n = 0; n < 2; ++n) \
        MOE_MFMA(acc[ai][bj][m][n], Bt[n], At[m]); __builtin_amdgcn_s_setprio(0); } while (0)
#define PG8_WAIT_V(n) asm volatile("s_waitcnt vmcnt(" #n ")" ::: "memory")
#define PG8_WAIT_L(n) asm volatile("s_waitcnt lgkmcnt(" #n ")" ::: "memory")
#define PG8_BAR __builtin_amdgcn_s_barrier()
#define PG8_SCHED __builtin_amdgcn_sched_barrier(0)
    fill(0);
    asm volatile("s_waitcnt vmcnt(0) lgkmcnt(0)" ::: "memory");
    __syncthreads();
    UP cu, nu; unsigned oa[4], ob[2], na[4], nb[2];
    unit_params(0, 0, cu, oa, ob);
    nu = cu;
#pragma unroll
    for (int i = 0; i < 4; ++i) na[i] = oa[i];
    nb[0] = ob[0]; nb[1] = ob[1];
    f32x4 acc[2][2][4][2];
#pragma unroll
    for (int a = 0; a < 2; ++a)
#pragma unroll
        for (int b = 0; b < 2; ++b)
#pragma unroll
            for (int m = 0; m < 4; ++m)
#pragma unroll
                for (int n = 0; n < 2; ++n) acc[a][b][m][n] = (f32x4){0.f, 0.f, 0.f, 0.f};
    i32x8 At[4], B0[2], B1[2];
    int one_scale = 0x7F7F7F7F; asm volatile("" : "+v"(one_scale));
    const size_t kstep = (size_t)128;
    {   const char* cA = cu.aB; const char* cB = cu.bB;
        MOE_STB(PG8_SB(0, 0), cB, ob[0], ob[1]); MOE_STB(PG8_SB(0, 1), cB + cu.bh, ob[0], ob[1]); MOE_STAK(cu.kind, PG8_SA(0, 0), cA, oa[0], oa[1]); MOE_STAK(cu.kind, PG8_SA(0, 1), cA, oa[2], oa[3]);
        if (wr == 1) PG8_BAR;
        PG8_WAIT_V(2); PG8_BAR;
        MOE_STB(PG8_SB(1, 0), cB + kstep, ob[0], ob[1]); MOE_STAK(cu.kind, PG8_SA(1, 0), cA + kstep, oa[0], oa[1]); MOE_STB(PG8_SB(1, 1), cB + cu.bh + kstep, ob[0], ob[1]);
        PG8_WAIT_V(6); PG8_BAR; }
    for (int ui = 0;; ++ui) {
        const bool has_next = (ui + 1 < nunits);
        if (cu.fillnext >= 0) fill(cu.fillnext);
        const char* cA = cu.aB; const char* cB = cu.bB; const int nt = cu.nt; const unsigned bh = cu.bh;
        for (int t = 0; t < nt; t += 2) {
            const bool last = (t == nt - 2);
            if (last && has_next) unit_params(ui + 1, cu.e, nu, na, nb);
            const char* a1 = cA + (size_t)(t + 1) * kstep;
            const char* a2 = last ? nu.aB : cA + (size_t)(t + 2) * kstep; const char* b2 = last ? nu.bB : cB + (size_t)(t + 2) * kstep;
            const char* a3 = a2 + kstep; const char* b3 = b2 + kstep;
            const unsigned bh2 = last ? nu.bh : bh;
            const unsigned x0 = last ? na[0] : oa[0], x1 = last ? na[1] : oa[1], y0 = last ? na[2] : oa[2], y1 = last ? na[3] : oa[3];
            const unsigned z0 = last ? nb[0] : ob[0], z1 = last ? nb[1] : ob[1];
            const int k2 = last ? nu.kind : cu.kind;
            PG8_LDB(B0, 0, 0); PG8_LDB(B1, 0, 1); PG8_SCHED; PG8_LDA(At, 0, 0); MOE_STAK(cu.kind, PG8_SA(1, 1), a1, oa[2], oa[3]);
            PG8_WAIT_V(8); PG8_WAIT_L(0); PG8_BAR; PG8_MMA(0, 0, At, B0); PG8_MMA(0, 1, At, B1); PG8_BAR; PG8_SCHED;
            PG8_LDA(At, 0, 1); MOE_STB(PG8_SB(0, 0), b2, z0, z1); MOE_STB(PG8_SB(0, 1), b2 + bh2, z0, z1); MOE_STAK(k2, PG8_SA(0, 0), a2, x0, x1);
            PG8_WAIT_V(8); PG8_WAIT_L(0); PG8_BAR; PG8_MMA(1, 0, At, B0); PG8_MMA(1, 1, At, B1); PG8_BAR; PG8_SCHED;
            PG8_LDB(B0, 1, 0); PG8_LDB(B1, 1, 1); PG8_SCHED; PG8_LDA(At, 1, 0); MOE_STAK(k2, PG8_SA(0, 1), a2, y0, y1);
            PG8_WAIT_V(8); PG8_WAIT_L(0); PG8_BAR; PG8_MMA(0, 0, At, B0); PG8_MMA(0, 1, At, B1); PG8_BAR; PG8_SCHED;
            PG8_LDA(At, 1, 1); MOE_STB(PG8_SB(1, 0), b3, z0, z1); MOE_STB(PG8_SB(1, 1), b3 + bh2, z0, z1); MOE_STAK(k2, PG8_SA(1, 0), a3, x0, x1);
            PG8_WAIT_V(8); PG8_WAIT_L(0); PG8_BAR; PG8_MMA(1, 0, At, B0); PG8_MMA(1, 1, At, B1); PG8_BAR; PG8_SCHED;
        }
        if (wr == 0) PG8_BAR;
        asm volatile("s_nop 15\n\ts_nop 15" ::: "memory");
        if (cu.kind == 0) {
            const int row0 = wr * 64 + fr; const int col0 = cu.pn * 128 + wc * 32 + 8 * fq;
            constexpr float is13 = 1.f / SW13;
#pragma unroll
            for (int ai = 0; ai < 2; ++ai)
#pragma unroll
                for (int m = 0; m < 4; ++m) { unsigned char* rowp = (unsigned char*)M.Hs + cu.hbuf * 65536 + (size_t)(row0 + ai * HALF + m * 16) * 256 + col0;
                    f32x4 h0, h1;
#pragma unroll
                    for (int j = 0; j < 4; ++j) { h0[j] = siluf_(acc[ai][0][m][0][j] * is13) * (acc[ai][1][m][0][j] * (is13 * SHS)); h1[j] = siluf_(acc[ai][0][m][1][j] * is13) * (acc[ai][1][m][1][j] * (is13 * SHS)); }
                    u32x2 w; w.x = pk4_fp8(h0[0], h0[1], h0[2], h0[3]); w.y = pk4_fp8(h1[0], h1[1], h1[2], h1[3]);
                    *(u32x2*)rowp = w; }
        } else {
            const LAS int* rtok = M.tbl + cu.slot * 768 + 256; const LAS float* rw = (const LAS float*)(M.tbl + cu.slot * 768 + 512);
            const int col0 = cu.pn * BM + wc * 32 + 8 * fq;
#pragma unroll
            for (int ai = 0; ai < 2; ++ai)
#pragma unroll
                for (int m = 0; m < 4; ++m) { const int r = wr * 64 + fr + ai * HALF + m * 16; const int ts = rtok[r]; const float w = rw[r];
                    if (ts >= 0) {
                        if (cu.shared) { const unsigned goff = (unsigned)(ts >> 11) * MODW + 5 * D + col0; const unsigned ooff = (unsigned)ts * D + col0;
#pragma unroll
                            for (int bj = 0; bj < 2; ++bj)
#pragma unroll
                                for (int n = 0; n < 2; ++n) { const f32x4 gv = *(const f32x4*)(M.mod + goff + bj * HALF + n * 4); f32x4* op = (f32x4*)(M.out + ooff + bj * HALF + n * 4);
                                    const f32x4 nv = *op + gv * acc[ai][bj][m][n] * (1.f / (SHS * SW2)); if (!M.dry_shared) *op = nv; else asm volatile("" :: "v"(nv)); }
                        } else { unsigned char* yp = M.Y + (size_t)(unsigned)ts * D + col0; const float ws_ = w * (YSCALE / (SHS * SW2));
#pragma unroll
                            for (int bj = 0; bj < 2; ++bj) { f32x4 v0 = acc[ai][bj][m][0] * ws_, v1 = acc[ai][bj][m][1] * ws_;
#pragma unroll
                                for (int j = 0; j < 4; ++j) { v0[j] = __builtin_amdgcn_fmed3f(v0[j], -448.f, 448.f); v1[j] = __builtin_amdgcn_fmed3f(v1[j], -448.f, 448.f); }
                                unsigned lo = 0u, hi = 0u;
                                lo = __builtin_amdgcn_cvt_pk_fp8_f32(v0[0], v0[1], lo, false); lo = __builtin_amdgcn_cvt_pk_fp8_f32(v0[2], v0[3], lo, true);
                                hi = __builtin_amdgcn_cvt_pk_fp8_f32(v1[0], v1[1], hi, false); hi = __builtin_amdgcn_cvt_pk_fp8_f32(v1[2], v1[3], hi, true);
                                u32x2 pk; pk.x = lo; pk.y = hi; *(u32x2*)(yp + bj * HALF) = pk; } } }
                    asm volatile("" ::: "memory"); }
        }
        if (!has_next) break;
#pragma unroll
        for (int a = 0; a < 2; ++a)
#pragma unroll
            for (int b = 0; b < 2; ++b)
#pragma unroll
                for (int m = 0; m < 4; ++m)
#pragma unroll
                    for (int n = 0; n < 2; ++n) acc[a][b][m][n] = (f32x4){0.f, 0.f, 0.f, 0.f};
        cu = nu;
#pragma unroll
        for (int i = 0; i < 4; ++i) oa[i] = na[i];
        ob[0] = nb[0]; ob[1] = nb[1];
        if (wr == 1) PG8_BAR;
    }
    PG8_WAIT_V(0);
    PG8_BAR;
#undef PG8_SA
#undef PG8_SB
#undef MOE_DMA
#undef MOE_STA
#undef MOE_STAK
#undef MOE_STB
#undef PG8_LDA
#undef PG8_LDB
#undef MOE_LD32
#undef MOE_MFMA
#undef PG8_MMA
#undef PG8_WAIT_V
#undef PG8_WAIT_L
#undef PG8_BAR
#undef PG8_SCHED
}
}

struct Ctx {
    lbyte* lds; int tid, lane, wave, G, bid;
    const Args* a;
};
#define WSP(T, off) ((T*)(A.ws + (off)))

template <class RowMap>
__device__ __forceinline__ void transpose_item(const float* W, int K, int N, bf16_t* WT, RowMap rowmap, lfloat* scr, int item, int lane) {
    const int nblk = N / 32, kb = item / nblk, nb = item % nblk, k0 = 64 * kb, n0 = 32 * nb;
#pragma unroll 8
    for (int i = 0; i < 32; ++i) { const int kk = 2 * i + (lane >> 5); scr[kk * 33 + (lane & 31)] = W[(size_t)(k0 + kk) * N + n0 + (lane & 31)]; }
    asm volatile("s_waitcnt lgkmcnt(0)" ::: "memory");
    const int c = lane & 7;
#pragma unroll
    for (int j = 0; j < 4; ++j) { const int n = (lane >> 3) + 8 * j; const lfloat* s = scr + (8 * c) * 33 + n;
        u32x4 o; o.x = pk2(s[0 * 33], s[1 * 33]); o.y = pk2(s[2 * 33], s[3 * 33]); o.z = pk2(s[4 * 33], s[5 * 33]); o.w = pk2(s[6 * 33], s[7 * 33]);
        *(u32x4*)(WT + (size_t)rowmap(n0 + n) * K + k0 + 8 * c) = o; }
    asm volatile("s_waitcnt lgkmcnt(0)" ::: "memory");
}
template <class RowMap>
__device__ __forceinline__ void transpose_item_fp8(const float* W, int K, int N, unsigned char* WT, RowMap rowmap, float sc, lfloat* scr, int item, int lane) {
    const int nblk = N / 32, kb = item / nblk, nb = item % nblk, k0 = 64 * kb, n0 = 32 * nb;
#pragma unroll 8
    for (int i = 0; i < 32; ++i) { const int kk = 2 * i + (lane >> 5); scr[kk * 33 + (lane & 31)] = W[(size_t)(k0 + kk) * N + n0 + (lane & 31)] * sc; }
    asm volatile("s_waitcnt lgkmcnt(0)" ::: "memory");
    const int c = lane & 7;
#pragma unroll
    for (int j = 0; j < 4; ++j) { const int n = (lane >> 3) + 8 * j; const lfloat* s = scr + (8 * c) * 33 + n;
        u32x2 o; o.x = pk4_fp8(s[0 * 33], s[1 * 33], s[2 * 33], s[3 * 33]); o.y = pk4_fp8(s[4 * 33], s[5 * 33], s[6 * 33], s[7 * 33]);
        *(u32x2*)(WT + (size_t)rowmap(n0 + n) * K + k0 + 8 * c) = o; }
    asm volatile("s_waitcnt lgkmcnt(0)" ::: "memory");
}
struct RowId { __device__ int operator()(int n) const { return n; } };
struct RowGLU { int base; __device__ int operator()(int n) const { return ((n >> 7) << 8) + base + (n & 127); } };

__device__ __forceinline__ void norm_mod_row(const float* xrow, const float* g, const float* sc, const float* sh, bf16_t* orow, int lane, unsigned* o8row = nullptr) {
    const f32x4* xr = (const f32x4*)xrow + lane;
    f32x4 v[4]; float s = 0.f;
#pragma unroll
    for (int j = 0; j < 4; ++j) { v[j] = xr[64 * j]; s += (v[j].x * v[j].x + v[j].y * v[j].y) + (v[j].z * v[j].z + v[j].w * v[j].w); }
    const float rstd = __builtin_amdgcn_rsqf(wave_sum(s) * (1.f / D) + NORM_EPS);
    u32x2* o8 = (u32x2*)orow + lane;
#pragma unroll
    for (int j = 0; j < 4; ++j) { const f32x4 gg = ((const f32x4*)g)[lane + 64 * j], ss = ((const f32x4*)sc)[lane + 64 * j], hh = ((const f32x4*)sh)[lane + 64 * j];
        const f32x4 y = v[j] * rstd * gg * (ss + 1.f) + hh;
        if (orow) { u32x2 w; w.x = pk2(y.x, y.y); w.y = pk2(y.z, y.w); o8[64 * j] = w; }
        if (o8row) o8row[lane + 64 * j] = pk4_fp8(y.x, y.y, y.z, y.w); }
}

__device__ __forceinline__ void phase_p0(const Args& A, Ctx& C) {
    float* mod = WSP(float, WS_MOD);
    {
        lfloat* sc = (lfloat*)C.lds;
        lfloat* red = (lfloat*)(C.lds + 17 * 1024 * 4);
        const float* wada = A.in[I_WADA]; const float* bada = A.in[I_BADA];
        for (int it = C.bid; it < 96 * 2; it += C.G) {
            const int chunk = it >> 1, pass = it & 1, r0 = pass * 17, nr = pass ? 16 : 17, col0 = chunk * 64;
            __syncthreads();
            for (int i = C.tid; i < nr * 1024; i += 512) { const int r = i >> 10, k = i & 1023; const int rr = r0 + r;
                const float cv = rr < 32 ? A.in[I_C][rr * 1024 + k] : A.in[I_CCTX][k]; sc[r * 1024 + k] = siluf_(cv); }
            __syncthreads();
            const int col = C.tid & 63, kq = C.tid >> 6;
            float acc[17];
#pragma unroll
            for (int r = 0; r < 17; ++r) acc[r] = 0.f;
            for (int k = kq * 128; k < kq * 128 + 128; k += 4) {
                float w[4];
#pragma unroll
                for (int j = 0; j < 4; ++j) w[j] = wada[(size_t)(k + j) * MODW + col0 + col];
#pragma unroll
                for (int r = 0; r < 17; ++r) { const f32x4 s4 = *(const LAS f32x4*)(sc + r * 1024 + k); acc[r] += s4.x * w[0] + s4.y * w[1] + s4.z * w[2] + s4.w * w[3]; }
            }
#pragma unroll
            for (int r = 0; r < 17; ++r) red[(kq * 17 + r) * 64 + col] = acc[r];
            __syncthreads();
            for (int i = C.tid; i < nr * 64; i += 512) { const int r = i >> 6, cc = i & 63; float s = 0.f;
#pragma unroll
                for (int q = 0; q < 8; ++q) s += red[(q * 17 + r) * 64 + cc];
                mod[(size_t)(r0 + r) * MODW + col0 + cc] = s + bada[col0 + cc]; }
        }
        __syncthreads();
    }
    {
        lfloat* scr = (lfloat*)(C.lds + C.wave * 16384);
        const int gw = C.bid * 8 + C.wave, NGW = C.G * 8;
        unsigned char* btin8 = A.ws + WS_BTIN; bf16_t* btout = WSP(bf16_t, WS_BTOUT); bf16_t* btr = WSP(bf16_t, WS_BTR);
        constexpr int I_IN = (D / 64) * 124, I_OUT = (D / 64) * (D / 32), I_R = (D / 64) * (NE / 32), I_G = (128 / 64) * (DA / 32);
        for (int it = gw; it < I_IN + I_OUT + I_R + I_G; it += NGW) {
            int r = it;
            if (r < I_IN) {
                const int kb = r / 124, nb = r % 124, k0 = 64 * kb, n0 = 32 * nb; const float* W = A.in[I_WIN];
#pragma unroll 8
                for (int i = 0; i < 32; ++i) { const int kk = 2 * i + (C.lane >> 5); scr[kk * 33 + (C.lane & 31)] = W[(size_t)(k0 + kk) * IN_COLS + n0 + (C.lane & 31)] * SWIN; }
                asm volatile("s_waitcnt lgkmcnt(0)" ::: "memory");
                const int c = C.lane & 7;
#pragma unroll
                for (int j = 0; j < 4; ++j) { const int n = (C.lane >> 3) + 8 * j; const lfloat* s = scr + (8 * c) * 33 + n;
                    u32x2 o; o.x = pk4_fp8(s[0 * 33], s[1 * 33], s[2 * 33], s[3 * 33]); o.y = pk4_fp8(s[4 * 33], s[5 * 33], s[6 * 33], s[7 * 33]);
                    *(u32x2*)(btin8 + (size_t)(n0 + n) * D + k0 + 8 * c) = o; }
                asm volatile("s_waitcnt lgkmcnt(0)" ::: "memory");
                continue; }
            r -= I_IN;
            if (r < I_OUT) { transpose_item(A.in[I_WOUT], D, D, btout, RowId(), scr, r, C.lane); continue; } r -= I_OUT;
            if (r < I_R) { transpose_item(A.in[I_RW], D, NE, btr, RowId(), scr, r, C.lane); continue; } r -= I_R;
            transpose_item(A.in[I_GUP], 128, DA, WSP(bf16_t, WS_GUPT), RowId(), scr, r, C.lane);
        }
        for (int i = C.bid * 512 + C.tid; i < 16 * D / 4; i += C.G * 512) { const int n = 3968 + (i >> 8), k = (i & 255) * 4; const float* W = A.in[I_WIN];
            *(unsigned*)(btin8 + (size_t)n * D + k) = pk4_fp8(W[(size_t)k * IN_COLS + n] * SWIN, W[(size_t)(k + 1) * IN_COLS + n] * SWIN, W[(size_t)(k + 2) * IN_COLS + n] * SWIN, W[(size_t)(k + 3) * IN_COLS + n] * SWIN); }
        for (int i = C.bid * 512 + C.tid; i < (PLD - IN_COLS) * D / 16; i += C.G * 512) ((u32x4*)(btin8 + (size_t)IN_COLS * D))[i] = (u32x4){0u, 0u, 0u, 0u};
    }
}

__device__ __forceinline__ void phase_p1(const Args& A, Ctx& C) {
    const float* mod = WSP(float, WS_MOD); bf16_t* xn = WSP(bf16_t, WS_XN);
    const int gw = C.bid * 8 + C.wave, NGW = C.G * 8;
    for (int row = gw; row < NROWS; row += NGW) {
        const float* xr; int mb;
        if (row < NLAT) { xr = A.in[I_X] + (size_t)row * D; mb = row >> 11; } else { xr = A.in[I_CTX] + (size_t)(row - NLAT) * D; mb = 32; }
        const float* m = mod + (size_t)mb * MODW;
        norm_mod_row(xr, A.in[I_N1G], m + D, m, nullptr, C.lane, (unsigned*)(A.ws + WS_XN) + (size_t)row * (D / 4));
    }
}

__device__ __forceinline__ float bfsel(unsigned w, bool odd) { return __builtin_bit_cast(float, odd ? (w & 0xffff0000u) : (w << 16)); }
template <int NK>
__device__ __forceinline__ f32x4 mm_tile(const lbyte* Ap, int lda, const lbyte* Bp, int ldb, f32x4 acc, int lane) {
    const int r = lane & 15, g = lane >> 4;
#pragma unroll
    for (int ks = 0; ks < NK; ++ks) {
        const bf16x8 a = *(const LAS bf16x8*)(Ap + r * lda + ks * 64 + g * 16);
        const bf16x8 b = *(const LAS bf16x8*)(Bp + r * ldb + ks * 64 + g * 16);
        acc = __builtin_amdgcn_mfma_f32_16x16x32_bf16(a, b, acc, 0, 0, 0);
    }
    return acc;
}

__device__ __forceinline__ void st_bf16x4(lbyte* p, f32x4 v) { u32x2 w; w.x = cvtpk(v.x, v.y); w.y = cvtpk(v.z, v.w); *(LAS u32x2*)p = w; }
__device__ __forceinline__ void st_bf16(lbyte* p, float v) { *(LAS unsigned short*)p = (unsigned short)cvtpk(v, v); }
__device__ __forceinline__ float rdlane(float v, int l) { return __builtin_bit_cast(float, __builtin_amdgcn_readlane(__builtin_bit_cast(int, v), l)); }

__device__ __forceinline__ void tri_inv16(const f32x4 m, int lane, lbyte* scr, float (&X)[16]) {
    *(LAS f32x4*)(scr + (lane & 15) * 64 + (lane >> 4) * 16) = m;
    asm volatile("s_waitcnt lgkmcnt(0)" ::: "memory");
    float Mr[16];
#pragma unroll
    for (int kq = 0; kq < 4; ++kq) { const f32x4 r = *(const LAS f32x4*)(scr + (lane & 15) * 64 + kq * 16); Mr[4 * kq] = r.x; Mr[4 * kq + 1] = r.y; Mr[4 * kq + 2] = r.z; Mr[4 * kq + 3] = r.w; }
    const int l16 = lane & 15;
    X[0] = (l16 == 0) ? 1.f : 0.f;
    { float x0 = (l16 == 1) ? 1.f : 0.f, x1 = 0.f;
      asm("s_nop 1\n\t" "v_fmac_f32_dpp %0, -%1, %2 row_newbcast:1 row_mask:0xf bank_mask:0xf\n\t" : "+v"(x0) : "v"(Mr[0]), "v"(X[0]));
      X[1] = x0 + x1; }
    { float x0 = (l16 == 2) ? 1.f : 0.f, x1 = 0.f;
      asm("s_nop 1\n\t" "v_fmac_f32_dpp %0, -%1, %2 row_newbcast:2 row_mask:0xf bank_mask:0xf\n\t" : "+v"(x0) : "v"(Mr[0]), "v"(X[0]));
      asm("s_nop 1\n\t" "v_fmac_f32_dpp %0, -%1, %2 row_newbcast:2 row_mask:0xf bank_mask:0xf\n\t" : "+v"(x1) : "v"(Mr[1]), "v"(X[1]));
      X[2] = x0 + x1; }
    { float x0 = (l16 == 3) ? 1.f : 0.f, x1 = 0.f;
      asm("s_nop 1\n\t" "v_fmac_f32_dpp %0, -%1, %2 row_newbcast:3 row_mask:0xf bank_mask:0xf\n\t" "v_fmac_f32_dpp %0, -%3, %4 row_newbcast:3 row_mask:0xf bank_mask:0xf\n\t" : "+v"(x0) : "v"(Mr[0]), "v"(X[0]), "v"(Mr[2]), "v"(X[2]));
      asm("s_nop 1\n\t" "v_fmac_f32_dpp %0, -%1, %2 row_newbcast:3 row_mask:0xf bank_mask:0xf\n\t" : "+v"(x1) : "v"(Mr[1]), "v"(X[1]));
      X[3] = x0 + x1; }
    { float x0 = (l16 == 4) ? 1.f : 0.f, x1 = 0.f;
      asm("s_nop 1\n\t" "v_fmac_f32_dpp %0, -%1, %2 row_newbcast:4 row_mask:0xf bank_mask:0xf\n\t" "v_fmac_f32_dpp %0, -%3, %4 row_newbcast:4 row_mask:0xf bank_mask:0xf\n\t" : "+v"(x0) : "v"(Mr[0]), "v"(X[0]), "v"(Mr[2]), "v"(X[2]));
      asm("s_nop 1\n\t" "v_fmac_f32_dpp %0, -%1, %2 row_newbcast:4 row_mask:0xf bank_mask:0xf\n\t" "v_fmac_f32_dpp %0, -%3, %4 row_newbcast:4 row_mask:0xf bank_mask:0xf\n\t" : "+v"(x1) : "v"(Mr[1]), "v"(X[1]), "v"(Mr[3]), "v"(X[3]));
      X[4] = x0 + x1; }
    { float x0 = (l16 == 5) ? 1.f : 0.f, x1 = 0.f;
      asm("s_nop 1\n\t" "v_fmac_f32_dpp %0, -%1, %2 row_newbcast:5 row_mask:0xf bank_mask:0xf\n\t" "v_fmac_f32_dpp %0, -%3, %4 row_newbcast:5 row_mask:0xf bank_mask:0xf\n\t" "v_fmac_f32_dpp %0, -%5, %6 row_newbcast:5 row_mask:0xf bank_mask:0xf\n\t" : "+v"(x0) : "v"(Mr[0]), "v"(X[0]), "v"(Mr[2]), "v"(X[2]), "v"(Mr[4]), "v"(X[4]));
      asm("s_nop 1\n\t" "v_fmac_f32_dpp %0, -%1, %2 row_newbcast:5 row_mask:0xf bank_mask:0xf\n\t" "v_fmac_f32_dpp %0, -%3, %4 row_newbcast:5 row_mask:0xf bank_mask:0xf\n\t" : "+v"(x1) : "v"(Mr[1]), "v"(X[1]), "v"(Mr[3]), "v"(X[3]));
      X[5] = x0 + x1; }
    { float x0 = (l16 == 6) ? 1.f : 0.f, x1 = 0.f;
      asm("s_nop 1\n\t" "v_fmac_f32_dpp %0, -%1, %2 row_newbcast:6 row_mask:0xf bank_mask:0xf\n\t" "v_fmac_f32_dpp %0, -%3, %4 row_newbcast:6 row_mask:0xf bank_mask:0xf\n\t" "v_fmac_f32_dpp %0, -%5, %6 row_newbcast:6 row_mask:0xf bank_mask:0xf\n\t" : "+v"(x0) : "v"(Mr[0]), "v"(X[0]), "v"(Mr[2]), "v"(X[2]), "v"(Mr[4]), "v"(X[4]));
      asm("s_nop 1\n\t" "v_fmac_f32_dpp %0, -%1, %2 row_newbcast:6 row_mask:0xf bank_mask:0xf\n\t" "v_fmac_f32_dpp %0, -%3, %4 row_newbcast:6 row_mask:0xf bank_mask:0xf\n\t" "v_fmac_f32_dpp %0, -%5, %6 row_newbcast:6 row_mask:0xf bank_mask:0xf\n\t" : "+v"(x1) : "v"(Mr[1]), "v"(X[1]), "v"(Mr[3]), "v"(X[3]), "v"(Mr[5]), "v"(X[5]));
      X[6] = x0 + x1; }
    { float x0 = (l16 == 7) ? 1.f : 0.f, x1 = 0.f;
      asm("s_nop 1\n\t" "v_fmac_f32_dpp %0, -%1, %2 row_newbcast:7 row_mask:0xf bank_mask:0xf\n\t" "v_fmac_f32_dpp %0, -%3, %4 row_newbcast:7 row_mask:0xf bank_mask:0xf\n\t" "v_fmac_f32_dpp %0, -%5, %6 row_newbcast:7 row_mask:0xf bank_mask:0xf\n\t" "v_fmac_f32_dpp %0, -%7, %8 row_newbcast:7 row_mask:0xf bank_mask:0xf\n\t" : "+v"(x0) : "v"(Mr[0]), "v"(X[0]), "v"(Mr[2]), "v"(X[2]), "v"(Mr[4]), "v"(X[4]), "v"(Mr[6]), "v"(X[6]));
      asm("s_nop 1\n\t" "v_fmac_f32_dpp %0, -%1, %2 row_newbcast:7 row_mask:0xf bank_mask:0xf\n\t" "v_fmac_f32_dpp %0, -%3, %4 row_newbcast:7 row_mask:0xf bank_mask:0xf\n\t" "v_fmac_f32_dpp %0, -%5, %6 row_newbcast:7 row_mask:0xf bank_mask:0xf\n\t" : "+v"(x1) : "v"(Mr[1]), "v"(X[1]), "v"(Mr[3]), "v"(X[3]), "v"(Mr[5]), "v"(X[5]));
      X[7] = x0 + x1; }
    { float x0 = (l16 == 8) ? 1.f : 0.f, x1 = 0.f;
      asm("s_nop 1\n\t" "v_fmac_f32_dpp %0, -%1, %2 row_newbcast:8 row_mask:0xf bank_mask:0xf\n\t" "v_fmac_f32_dpp %0, -%3, %4 row_newbcast:8 row_mask:0xf bank_mask:0xf\n\t" "v_fmac_f32_dpp %0, -%5, %6 row_newbcast:8 row_mask:0xf bank_mask:0xf\n\t" "v_fmac_f32_dpp %0, -%7, %8 row_newbcast:8 row_mask:0xf bank_mask:0xf\n\t" : "+v"(x0) : "v"(Mr[0]), "v"(X[0]), "v"(Mr[2]), "v"(X[2]), "v"(Mr[4]), "v"(X[4]), "v"(Mr[6]), "v"(X[6]));
      asm("s_nop 1\n\t" "v_fmac_f32_dpp %0, -%1, %2 row_newbcast:8 row_mask:0xf bank_mask:0xf\n\t" "v_fmac_f32_dpp %0, -%3, %4 row_newbcast:8 row_mask:0xf bank_mask:0xf\n\t" "v_fmac_f32_dpp %0, -%5, %6 row_newbcast:8 row_mask:0xf bank_mask:0xf\n\t" "v_fmac_f32_dpp %0, -%7, %8 row_newbcast:8 row_mask:0xf bank_mask:0xf\n\t" : "+v"(x1) : "v"(Mr[1]), "v"(X[1]), "v"(Mr[3]), "v"(X[3]), "v"(Mr[5]), "v"(X[5]), "v"(Mr[7]), "v"(X[7]));
      X[8] = x0 + x1; }
    { float x0 = (l16 == 9) ? 1.f : 0.f, x1 = 0.f;
      asm("s_nop 1\n\t" "v_fmac_f32_dpp %0, -%1, %2 row_newbcast:9 row_mask:0xf bank_mask:0xf\n\t" "v_fmac_f32_dpp %0, -%3, %4 row_newbcast:9 row_mask:0xf bank_mask:0xf\n\t" "v_fmac_f32_dpp %0, -%5, %6 row_newbcast:9 row_mask:0xf bank_mask:0xf\n\t" "v_fmac_f32_dpp %0, -%7, %8 row_newbcast:9 row_mask:0xf bank_mask:0xf\n\t" "v_fmac_f32_dpp %0, -%9, %10 row_newbcast:9 row_mask:0xf bank_mask:0xf\n\t" : "+v"(x0) : "v"(Mr[0]), "v"(X[0]), "v"(Mr[2]), "v"(X[2]), "v"(Mr[4]), "v"(X[4]), "v"(Mr[6]), "v"(X[6]), "v"(Mr[8]), "v"(X[8]));
      asm("s_nop 1\n\t" "v_fmac_f32_dpp %0, -%1, %2 row_newbcast:9 row_mask:0xf bank_mask:0xf\n\t" "v_fmac_f32_dpp %0, -%3, %4 row_newbcast:9 row_mask:0xf bank_mask:0xf\n\t" "v_fmac_f32_dpp %0, -%5, %6 row_newbcast:9 row_mask:0xf bank_mask:0xf\n\t" "v_fmac_f32_dpp %0, -%7, %8 row_newbcast:9 row_mask:0xf bank_mask:0xf\n\t" : "+v"(x1) : "v"(Mr[1]), "v"(X[1]), "v"(Mr[3]), "v"(X[3]), "v"(Mr[5]), "v"(X[5]), "v"(Mr[7]), "v"(X[7]));
      X[9] = x0 + x1; }
    { float x0 = (l16 == 10) ? 1.f : 0.f, x1 = 0.f;
      asm("s_nop 1\n\t" "v_fmac_f32_dpp %0, -%1, %2 row_newbcast:10 row_mask:0xf bank_mask:0xf\n\t" "v_fmac_f32_dpp %0, -%3, %4 row_newbcast:10 row_mask:0xf bank_mask:0xf\n\t" "v_fmac_f32_dpp %0, -%5, %6 row_newbcast:10 row_mask:0xf bank_mask:0xf\n\t" "v_fmac_f32_dpp %0, -%7, %8 row_newbcast:10 row_mask:0xf bank_mask:0xf\n\t" "v_fmac_f32_dpp %0, -%9, %10 row_newbcast:10 row_mask:0xf bank_mask:0xf\n\t" : "+v"(x0) : "v"(Mr[0]), "v"(X[0]), "v"(Mr[2]), "v"(X[2]), "v"(Mr[4]), "v"(X[4]), "v"(Mr[6]), "v"(X[6]), "v"(Mr[8]), "v"(X[8]));
      asm("s_nop 1\n\t" "v_fmac_f32_dpp %0, -%1, %2 row_newbcast:10 row_mask:0xf bank_mask:0xf\n\t" "v_fmac_f32_dpp %0, -%3, %4 row_newbcast:10 row_mask:0xf bank_mask:0xf\n\t" "v_fmac_f32_dpp %0, -%5, %6 row_newbcast:10 row_mask:0xf bank_mask:0xf\n\t" "v_fmac_f32_dpp %0, -%7, %8 row_newbcast:10 row_mask:0xf bank_mask:0xf\n\t" "v_fmac_f32_dpp %0, -%9, %10 row_newbcast:10 row_mask:0xf bank_mask:0xf\n\t" : "+v"(x1) : "v"(Mr[1]), "v"(X[1]), "v"(Mr[3]), "v"(X[3]), "v"(Mr[5]), "v"(X[5]), "v"(Mr[7]), "v"(X[7]), "v"(Mr[9]), "v"(X[9]));
      X[10] = x0 + x1; }
    { float x0 = (l16 == 11) ? 1.f : 0.f, x1 = 0.f;
      asm("s_nop 1\n\t" "v_fmac_f32_dpp %0, -%1, %2 row_newbcast:11 row_mask:0xf bank_mask:0xf\n\t" "v_fmac_f32_dpp %0, -%3, %4 row_newbcast:11 row_mask:0xf bank_mask:0xf\n\t" "v_fmac_f32_dpp %0, -%5, %6 row_newbcast:11 row_mask:0xf bank_mask:0xf\n\t" "v_fmac_f32_dpp %0, -%7, %8 row_newbcast:11 row_mask:0xf bank_mask:0xf\n\t" "v_fmac_f32_dpp %0, -%9, %10 row_newbcast:11 row_mask:0xf bank_mask:0xf\n\t" "v_fmac_f32_dpp %0, -%11, %12 row_newbcast:11 row_mask:0xf bank_mask:0xf\n\t" : "+v"(x0) : "v"(Mr[0]), "v"(X[0]), "v"(Mr[2]), "v"(X[2]), "v"(Mr[4]), "v"(X[4]), "v"(Mr[6]), "v"(X[6]), "v"(Mr[8]), "v"(X[8]), "v"(Mr[10]), "v"(X[10]));
      asm("s_nop 1\n\t" "v_fmac_f32_dpp %0, -%1, %2 row_newbcast:11 row_mask:0xf bank_mask:0xf\n\t" "v_fmac_f32_dpp %0, -%3, %4 row_newbcast:11 row_mask:0xf bank_mask:0xf\n\t" "v_fmac_f32_dpp %0, -%5, %6 row_newbcast:11 row_mask:0xf bank_mask:0xf\n\t" "v_fmac_f32_dpp %0, -%7, %8 row_newbcast:11 row_mask:0xf bank_mask:0xf\n\t" "v_fmac_f32_dpp %0, -%9, %10 row_newbcast:11 row_mask:0xf bank_mask:0xf\n\t" : "+v"(x1) : "v"(Mr[1]), "v"(X[1]), "v"(Mr[3]), "v"(X[3]), "v"(Mr[5]), "v"(X[5]), "v"(Mr[7]), "v"(X[7]), "v"(Mr[9]), "v"(X[9]));
      X[11] = x0 + x1; }
    { float x0 = (l16 == 12) ? 1.f : 0.f, x1 = 0.f;
      asm("s_nop 1\n\t" "v_fmac_f32_dpp %0, -%1, %2 row_newbcast:12 row_mask:0xf bank_mask:0xf\n\t" "v_fmac_f32_dpp %0, -%3, %4 row_newbcast:12 row_mask:0xf bank_mask:0xf\n\t" "v_fmac_f32_dpp %0, -%5, %6 row_newbcast:12 row_mask:0xf bank_mask:0xf\n\t" "v_fmac_f32_dpp %0, -%7, %8 row_newbcast:12 row_mask:0xf bank_mask:0xf\n\t" "v_fmac_f32_dpp %0, -%9, %10 row_newbcast:12 row_mask:0xf bank_mask:0xf\n\t" "v_fmac_f32_dpp %0, -%11, %12 row_newbcast:12 row_mask:0xf bank_mask:0xf\n\t" : "+v"(x0) : "v"(Mr[0]), "v"(X[0]), "v"(Mr[2]), "v"(X[2]), "v"(Mr[4]), "v"(X[4]), "v"(Mr[6]), "v"(X[6]), "v"(Mr[8]), "v"(X[8]), "v"(Mr[10]), "v"(X[10]));
      asm("s_nop 1\n\t" "v_fmac_f32_dpp %0, -%1, %2 row_newbcast:12 row_mask:0xf bank_mask:0xf\n\t" "v_fmac_f32_dpp %0, -%3, %4 row_newbcast:12 row_mask:0xf bank_mask:0xf\n\t" "v_fmac_f32_dpp %0, -%5, %6 row_newbcast:12 row_mask:0xf bank_mask:0xf\n\t" "v_fmac_f32_dpp %0, -%7, %8 row_newbcast:12 row_mask:0xf bank_mask:0xf\n\t" "v_fmac_f32_dpp %0, -%9, %10 row_newbcast:12 row_mask:0xf bank_mask:0xf\n\t" "v_fmac_f32_dpp %0, -%11, %12 row_newbcast:12 row_mask:0xf bank_mask:0xf\n\t" : "+v"(x1) : "v"(Mr[1]), "v"(X[1]), "v"(Mr[3]), "v"(X[3]), "v"(Mr[5]), "v"(X[5]), "v"(Mr[7]), "v"(X[7]), "v"(Mr[9]), "v"(X[9]), "v"(Mr[11]), "v"(X[11]));
      X[12] = x0 + x1; }
    { float x0 = (l16 == 13) ? 1.f : 0.f, x1 = 0.f;
      asm("s_nop 1\n\t" "v_fmac_f32_dpp %0, -%1, %2 row_newbcast:13 row_mask:0xf bank_mask:0xf\n\t" "v_fmac_f32_dpp %0, -%3, %4 row_newbcast:13 row_mask:0xf bank_mask:0xf\n\t" "v_fmac_f32_dpp %0, -%5, %6 row_newbcast:13 row_mask:0xf bank_mask:0xf\n\t" "v_fmac_f32_dpp %0, -%7, %8 row_newbcast:13 row_mask:0xf bank_mask:0xf\n\t" "v_fmac_f32_dpp %0, -%9, %10 row_newbcast:13 row_mask:0xf bank_mask:0xf\n\t" "v_fmac_f32_dpp %0, -%11, %12 row_newbcast:13 row_mask:0xf bank_mask:0xf\n\t" "v_fmac_f32_dpp %0, -%13, %14 row_newbcast:13 row_mask:0xf bank_mask:0xf\n\t" : "+v"(x0) : "v"(Mr[0]), "v"(X[0]), "v"(Mr[2]), "v"(X[2]), "v"(Mr[4]), "v"(X[4]), "v"(Mr[6]), "v"(X[6]), "v"(Mr[8]), "v"(X[8]), "v"(Mr[10]), "v"(X[10]), "v"(Mr[12]), "v"(X[12]));
      asm("s_nop 1\n\t" "v_fmac_f32_dpp %0, -%1, %2 row_newbcast:13 row_mask:0xf bank_mask:0xf\n\t" "v_fmac_f32_dpp %0, -%3, %4 row_newbcast:13 row_mask:0xf bank_mask:0xf\n\t" "v_fmac_f32_dpp %0, -%5, %6 row_newbcast:13 row_mask:0xf bank_mask:0xf\n\t" "v_fmac_f32_dpp %0, -%7, %8 row_newbcast:13 row_mask:0xf bank_mask:0xf\n\t" "v_fmac_f32_dpp %0, -%9, %10 row_newbcast:13 row_mask:0xf bank_mask:0xf\n\t" "v_fmac_f32_dpp %0, -%11, %12 row_newbcast:13 row_mask:0xf bank_mask:0xf\n\t" : "+v"(x1) : "v"(Mr[1]), "v"(X[1]), "v"(Mr[3]), "v"(X[3]), "v"(Mr[5]), "v"(X[5]), "v"(Mr[7]), "v"(X[7]), "v"(Mr[9]), "v"(X[9]), "v"(Mr[11]), "v"(X[11]));
      X[13] = x0 + x1; }
    { float x0 = (l16 == 14) ? 1.f : 0.f, x1 = 0.f;
      asm("s_nop 1\n\t" "v_fmac_f32_dpp %0, -%1, %2 row_newbcast:14 row_mask:0xf bank_mask:0xf\n\t" "v_fmac_f32_dpp %0, -%3, %4 row_newbcast:14 row_mask:0xf bank_mask:0xf\n\t" "v_fmac_f32_dpp %0, -%5, %6 row_newbcast:14 row_mask:0xf bank_mask:0xf\n\t" "v_fmac_f32_dpp %0, -%7, %8 row_newbcast:14 row_mask:0xf bank_mask:0xf\n\t" "v_fmac_f32_dpp %0, -%9, %10 row_newbcast:14 row_mask:0xf bank_mask:0xf\n\t" "v_fmac_f32_dpp %0, -%11, %12 row_newbcast:14 row_mask:0xf bank_mask:0xf\n\t" "v_fmac_f32_dpp %0, -%13, %14 row_newbcast:14 row_mask:0xf bank_mask:0xf\n\t" : "+v"(x0) : "v"(Mr[0]), "v"(X[0]), "v"(Mr[2]), "v"(X[2]), "v"(Mr[4]), "v"(X[4]), "v"(Mr[6]), "v"(X[6]), "v"(Mr[8]), "v"(X[8]), "v"(Mr[10]), "v"(X[10]), "v"(Mr[12]), "v"(X[12]));
      asm("s_nop 1\n\t" "v_fmac_f32_dpp %0, -%1, %2 row_newbcast:14 row_mask:0xf bank_mask:0xf\n\t" "v_fmac_f32_dpp %0, -%3, %4 row_newbcast:14 row_mask:0xf bank_mask:0xf\n\t" "v_fmac_f32_dpp %0, -%5, %6 row_newbcast:14 row_mask:0xf bank_mask:0xf\n\t" "v_fmac_f32_dpp %0, -%7, %8 row_newbcast:14 row_mask:0xf bank_mask:0xf\n\t" "v_fmac_f32_dpp %0, -%9, %10 row_newbcast:14 row_mask:0xf bank_mask:0xf\n\t" "v_fmac_f32_dpp %0, -%11, %12 row_newbcast:14 row_mask:0xf bank_mask:0xf\n\t" "v_fmac_f32_dpp %0, -%13, %14 row_newbcast:14 row_mask:0xf bank_mask:0xf\n\t" : "+v"(x1) : "v"(Mr[1]), "v"(X[1]), "v"(Mr[3]), "v"(X[3]), "v"(Mr[5]), "v"(X[5]), "v"(Mr[7]), "v"(X[7]), "v"(Mr[9]), "v"(X[9]), "v"(Mr[11]), "v"(X[11]), "v"(Mr[13]), "v"(X[13]));
      X[14] = x0 + x1; }
    { float x0 = (l16 == 15) ? 1.f : 0.f, x1 = 0.f;
      asm("s_nop 1\n\t" "v_fmac_f32_dpp %0, -%1, %2 row_newbcast:15 row_mask:0xf bank_mask:0xf\n\t" "v_fmac_f32_dpp %0, -%3, %4 row_newbcast:15 row_mask:0xf bank_mask:0xf\n\t" "v_fmac_f32_dpp %0, -%5, %6 row_newbcast:15 row_mask:0xf bank_mask:0xf\n\t" "v_fmac_f32_dpp %0, -%7, %8 row_newbcast:15 row_mask:0xf bank_mask:0xf\n\t" "v_fmac_f32_dpp %0, -%9, %10 row_newbcast:15 row_mask:0xf bank_mask:0xf\n\t" "v_fmac_f32_dpp %0, -%11, %12 row_newbcast:15 row_mask:0xf bank_mask:0xf\n\t" "v_fmac_f32_dpp %0, -%13, %14 row_newbcast:15 row_mask:0xf bank_mask:0xf\n\t" "v_fmac_f32_dpp %0, -%15, %16 row_newbcast:15 row_mask:0xf bank_mask:0xf\n\t" : "+v"(x0) : "v"(Mr[0]), "v"(X[0]), "v"(Mr[2]), "v"(X[2]), "v"(Mr[4]), "v"(X[4]), "v"(Mr[6]), "v"(X[6]), "v"(Mr[8]), "v"(X[8]), "v"(Mr[10]), "v"(X[10]), "v"(Mr[12]), "v"(X[12]), "v"(Mr[14]), "v"(X[14]));
      asm("s_nop 1\n\t" "v_fmac_f32_dpp %0, -%1, %2 row_newbcast:15 row_mask:0xf bank_mask:0xf\n\t" "v_fmac_f32_dpp %0, -%3, %4 row_newbcast:15 row_mask:0xf bank_mask:0xf\n\t" "v_fmac_f32_dpp %0, -%5, %6 row_newbcast:15 row_mask:0xf bank_mask:0xf\n\t" "v_fmac_f32_dpp %0, -%7, %8 row_newbcast:15 row_mask:0xf bank_mask:0xf\n\t" "v_fmac_f32_dpp %0, -%9, %10 row_newbcast:15 row_mask:0xf bank_mask:0xf\n\t" "v_fmac_f32_dpp %0, -%11, %12 row_newbcast:15 row_mask:0xf bank_mask:0xf\n\t" "v_fmac_f32_dpp %0, -%13, %14 row_newbcast:15 row_mask:0xf bank_mask:0xf\n\t" : "+v"(x1) : "v"(Mr[1]), "v"(X[1]), "v"(Mr[3]), "v"(X[3]), "v"(Mr[5]), "v"(X[5]), "v"(Mr[7]), "v"(X[7]), "v"(Mr[9]), "v"(X[9]), "v"(Mr[11]), "v"(X[11]), "v"(Mr[13]), "v"(X[13]));
      X[15] = x0 + x1; }
}

#ifndef RWKV_REP
#define RWKV_REP 1
#endif
namespace rk {
constexpr int S64 = 160, S32 = 80, SW = 144;
constexpr int O_WUP = 0, O_AUP = O_WUP + 64 * SW, O_WLT = O_AUP + 64 * SW, O_ALT = O_WLT + 16 * S64, O_LW = O_ALT + 16 * S64, O_LA = O_LW + 4096,
              O_KKT = O_LA + 4096, O_RT = O_KKT + 16 * S64, O_BT = O_RT + 16 * S64, O_KDT = O_BT + 16 * S64,
              O_VT = O_KDT + 16 * S64, O_BHT = O_VT + 64 * S32, O_KHT = O_BHT + 64 * S32, O_UT = O_KHT + 64 * S32, O_UTT = O_WLT  ,
              O_TI = O_UT + 64 * S32, O_MK = O_TI + 16 * S32, O_NB = O_MK + 16 * S32, O_NK = O_NB + 16 * S32,
              O_SBF = O_NK + 16 * S32, O_WC = O_SBF + 64 * S64, O_WT = O_WC + 256, TEAM_BYTES = O_WT + 1024;
static_assert(2 * TEAM_BYTES <= LDS_MISC, "rwkv LDS");
}
__device__ __forceinline__ void rwkv_pair_chunked(const Args& A, Ctx& C, int pair) {
    using namespace rk;
    const int b = pair >> 3, h = pair & 7;
    const int dir = C.wave >> 2;
    const int t4 = C.tid & 255, q = C.wave & 3, lane = C.lane;
    lbyte* L = C.lds + dir * TEAM_BYTES;
    const bf16_t* P = WSP(bf16_t, WS_P);
    bf16_t* ydir = WSP(bf16_t, WS_YDIR) + (size_t)dir * NLAT * D;
    float* bon = WSP(float, WS_BON) + (size_t)dir * NLAT * 8;
    __syncthreads();
#pragma unroll 2
    for (int i = t4; i < 4096; i += 256) { const int l = i >> 6, c = i & 63;
        st_bf16(L + O_WUP + c * SW + l * 2, A.in[I_WUP][((size_t)dir * 64 + l) * DA + 64 * h + c]);
        st_bf16(L + O_AUP + c * SW + l * 2, A.in[I_AUP][((size_t)dir * 64 + l) * DA + 64 * h + c]); }
#pragma unroll 2
    for (int i = t4; i < (4 * 64 * S32 + 4 * 16 * S32 + 64 * S64) / 4; i += 256) ((LAS unsigned*)(L + O_VT))[i] = 0u;
    for (int i = t4; i < (2 * 16 * S64) / 4; i += 256) ((LAS unsigned*)(L + O_WLT))[i] = 0u;
    const int c = lane;
    int col5[5] = {64 * h + c, 512 + 64 * h + c, 1024 + 64 * h + c, 1536 + 64 * dir + c, 1664 + 64 * dir + c};
    float mu5[5]; int dl5[5], cl5[5], dc5[5], cc5[5];
#pragma unroll
    for (int e = 0; e < 5; ++e) { const int col = col5[e]; mu5[e] = A.in[I_MU][col];
        cl5[e] = col < 480 ? 0 : (col < 960 ? 1 : (col < 1440 ? 2 : 3)); dl5[e] = (cl5[e] == 0 ? -PLD : (cl5[e] == 1 ? PLD : (cl5[e] == 2 ? -64 * PLD : 64 * PLD)));
        cc5[e] = col < 960 ? 0 : 1; dc5[e] = col < 960 ? -PLD : PLD; }
    const float kkc = A.in[I_KK][64 * h + c], kac = A.in[I_KA][64 * h + c], rkc = A.in[I_RK][64 * h + c];
    const float w0c = A.in[I_W0][dir * DA + 64 * h + c], a0c = A.in[I_A0][dir * DA + 64 * h + c];
    f32x4 Sacc[4];
#pragma unroll
    for (int i = 0; i < 4; ++i) Sacc[i] = (f32x4){0.f, 0.f, 0.f, 0.f};
    const int fr = lane & 15, fg = lane >> 4;
    unsigned short rawp[4][5], raws[4][5];
    auto chunk_geom = [&](int ch, bool& isctx, int& sbase, int& T, size_t& rowbase) { isctx = ch < 16; sbase = isctx ? ch * 16 : (ch - 16) * 16; T = isctx ? CTX : SEQ; rowbase = isctx ? (size_t)NLAT + (size_t)b * CTX : (size_t)b * SEQ; };
    auto okmask = [&](bool isctx, int t) -> int { return isctx ? ((t >= 1 ? 1 : 0) | (t <= CTX - 2 ? 2 : 0)) : (((t & 63) >= 1 ? 1 : 0) | ((t & 63) <= 62 ? 2 : 0) | (t >= 64 ? 4 : 0) | (t < SEQ - 64 ? 8 : 0)); };
    auto issue_loads = [&](int ch) { bool isctx; int sbase, T; size_t rowbase; chunk_geom(ch, isctx, sbase, T, rowbase);
#pragma unroll
        for (int j = 0; j < 4; ++j) { const int i = 4 * q + j; const int t = __builtin_amdgcn_readfirstlane(dir ? (T - 1 - (sbase + i)) : (sbase + i));
            const bf16_t* pr = P + (rowbase + t) * PLD; const int okm = okmask(isctx, t);
#pragma unroll
            for (int e = 0; e < 5; ++e) { const int cls = isctx ? cc5[e] : cl5[e]; const bool ok = (okm >> cls) & 1; const int off = col5[e] + (ok ? (isctx ? dc5[e] : dl5[e]) : 0);
                rawp[j][e] = pr[col5[e]]; raws[j][e] = pr[off]; } } };
    u32x2 ypend; ypend.x = 0u; ypend.y = 0u; float bpend[4] = {0.f, 0.f, 0.f, 0.f};
    auto flush = [&](int pch) { bool pisctx; int psb, pT; size_t prb; chunk_geom(pch, pisctx, psb, pT, prb);
        if (!pisctx) { const int t = dir ? (pT - 1 - (psb + fr)) : (psb + fr);
            *(u32x2*)(ydir + ((size_t)b * SEQ + t) * D + 64 * h + 16 * q + 4 * fg) = ypend;
            if (lane == 0) {
#pragma unroll
                for (int j = 0; j < 4; ++j) { const int i = 4 * q + j; const int tj = dir ? (pT - 1 - (psb + i)) : (psb + i); bon[((size_t)b * SEQ + tj) * 8 + h] = bpend[j]; } } } };
    issue_loads(0);
    for (int ch = 0; ch < 144; ++ch) {
        bool isctx; int sbase, T; size_t rowbase; chunk_geom(ch, isctx, sbase, T, rowbase);
        float vr[4], vk[4], vv[4], vkk[4], lw[4], av[4];
        __syncthreads();
        float mxa[4][5];
#pragma unroll
        for (int j = 0; j < 4; ++j) { const int i = 4 * q + j; const int t = __builtin_amdgcn_readfirstlane(dir ? (T - 1 - (sbase + i)) : (sbase + i)); const int okm = okmask(isctx, t);
#pragma unroll
            for (int e = 0; e < 5; ++e) { const int cls = isctx ? cc5[e] : cl5[e]; const bool ok = (okm >> cls) & 1;
                const float pv = bf2f(rawp[j][e]); const float sv = bf2f(raws[j][e]); mxa[j][e] = pv + mu5[e] * ((ok ? sv : 0.f) - pv); } }
        asm volatile("" :: "v"(mxa[0][0]), "v"(mxa[0][1]), "v"(mxa[0][2]), "v"(mxa[0][3]), "v"(mxa[0][4]), "v"(mxa[1][0]), "v"(mxa[1][1]), "v"(mxa[1][2]), "v"(mxa[1][3]), "v"(mxa[1][4]),
                        "v"(mxa[2][0]), "v"(mxa[2][1]), "v"(mxa[2][2]), "v"(mxa[2][3]), "v"(mxa[2][4]), "v"(mxa[3][0]), "v"(mxa[3][1]), "v"(mxa[3][2]), "v"(mxa[3][3]), "v"(mxa[3][4]) : "memory");
        if (ch > 0) flush(ch - 1);
        if (ch + 1 < 144) issue_loads(ch + 1);
        float cl[4];
        _Pragma("unroll") for (int rrep = 0; rrep < RWKV_REP; ++rrep) {
#pragma unroll
        for (int j = 0; j < 4; ++j) {
            const int i = 4 * q + j;
            float mx[5];
#pragma unroll
            for (int e = 0; e < 5; ++e) mx[e] = mxa[j][e];
            vr[j] = mx[0]; vk[j] = mx[1]; vv[j] = mx[2];
            *(LAS unsigned short*)(L + O_WLT + i * S64 + c * 2) = (unsigned short)cvtpk(tanhf_(mx[3]), 0.f); *(LAS unsigned short*)(L + O_ALT + i * S64 + c * 2) = (unsigned short)cvtpk(mx[4], 0.f);
            const float kx = vk[j] * kkc; const float ss = wave_sum(kx * kx);
            vkk[j] = kx * __builtin_amdgcn_rsqf(ss + 1e-6f);
        }
        __syncthreads();
        {
            const f32x4 z = (f32x4){0.f, 0.f, 0.f, 0.f};
            const f32x4 tw = mm_tile<2>(L + O_WLT, S64, L + O_WUP + 16 * q * SW, SW, z, lane);
            const f32x4 ta = mm_tile<2>(L + O_ALT, S64, L + O_AUP + 16 * q * SW, SW, z, lane);
#pragma unroll
            for (int e = 0; e < 4; ++e) { ((LAS float*)(L + O_LW))[(4 * fg + e) * 64 + 16 * q + fr] = tw[e]; ((LAS float*)(L + O_LA))[(4 * fg + e) * 64 + 16 * q + fr] = ta[e]; }
        }
        __syncthreads();
        { float run = 0.f;
#pragma unroll
        for (int j = 0; j < 4; ++j) { const int i = 4 * q + j;
            const float wlog = -softplusf_(-(w0c + ((LAS float*)(L + O_LW))[i * 64 + c])) - 0.5f;
            lw[j] = -__expf(wlog);
            av[j] = sigmoidf_(a0c + ((LAS float*)(L + O_LA))[i * 64 + c]);
            run += lw[j]; cl[j] = run; }
        ((LAS float*)(L + O_WT))[q * 64 + c] = run; }
        __syncthreads();
        }
        {
            float off = 0.f, cumC = 0.f;
#pragma unroll
            for (int qq = 0; qq < 4; ++qq) { const float tv = ((LAS float*)(L + O_WT))[qq * 64 + c]; cumC += tv; off += (qq < q) ? tv : 0.f; }
            float tv_[4], tb_[4], tk_[4];
#pragma unroll
            for (int j = 0; j < 4; ++j) { const int i = 4 * q + j;
                const float cum = off + cl[j];
                const float Wt = __expf(cum), Wp = __expf(cum - lw[j]), Wi = __expf(-cum), Wc = __expf(cumC - cum);
                const float kd = vk[j] * (1.f + (av[j] - 1.f) * kac), bb = vkk[j] * av[j];
                const unsigned p0 = cvtpk(vkk[j] * Wp, vr[j] * Wt), p1 = cvtpk(bb * Wi, kd * Wi);
                *(LAS unsigned short*)(L + O_KKT + i * S64 + c * 2) = (unsigned short)p0; *(LAS unsigned short*)(L + O_RT + i * S64 + c * 2) = (unsigned short)(p0 >> 16);
                *(LAS unsigned short*)(L + O_BT + i * S64 + c * 2) = (unsigned short)p1; *(LAS unsigned short*)(L + O_KDT + i * S64 + c * 2) = (unsigned short)(p1 >> 16);
                tv_[j] = vv[j]; tb_[j] = bb * Wc; tk_[j] = kd * Wc;
                const float bs = wave_sum(vr[j] * kd * rkc);
                bpend[j] = bs;
            }
#pragma unroll
            for (int jp = 0; jp < 2; ++jp) { const int i = 4 * q + 2 * jp;
                *(LAS unsigned*)(L + O_VT + c * S32 + i * 2) = cvtpk(tv_[2 * jp], tv_[2 * jp + 1]);
                *(LAS unsigned*)(L + O_BHT + c * S32 + i * 2) = cvtpk(tb_[2 * jp], tb_[2 * jp + 1]);
                *(LAS unsigned*)(L + O_KHT + c * S32 + i * 2) = cvtpk(tk_[2 * jp], tk_[2 * jp + 1]); }
            if (q == 3) ((LAS float*)(L + O_WC))[c] = __expf(cumC);
        }
        __syncthreads();
        {
            const int role = (q + dir) & 3;
            const lbyte* Aj = L + ((role & 1) ? O_KDT : O_BT);
            const lbyte* Bt = L + ((role & 2) ? O_RT : O_KKT);
            f32x4 g4 = mm_tile<2>(Aj, S64, Bt, S64, (f32x4){0.f, 0.f, 0.f, 0.f}, lane);
#pragma unroll
            for (int e = 0; e < 4; ++e) { const int j = 4 * fg + e; const bool keep = (role & 2) ? (j <= fr) : (j < fr); g4[e] = keep ? g4[e] : 0.f; }
            if (role == 0) { float X[16]; tri_inv16(g4, lane, L + O_LW, X);
                if (lane < 16) {
#pragma unroll
                    for (int i = 0; i < 16; ++i) *(LAS unsigned short*)(L + O_TI + i * S32 + lane * 2) = (unsigned short)cvtpk(X[i], 0.f); } }
            else st_bf16x4(L + (role == 1 ? O_MK : (role == 2 ? O_NB : O_NK)) + fr * S32 + fg * 8, g4);
        }
        __syncthreads();
        f32x4 yacc;
        {
            f32x4 u4 = mm_tile<2>(L + O_KKT, S64, L + O_SBF + 16 * q * S64, S64, (f32x4){0.f, 0.f, 0.f, 0.f}, lane);
            u4 = mm_tile<1>(L + O_MK, S32, L + O_VT + 16 * q * S32, S32, u4, lane);
            st_bf16x4(L + O_UTT + (16 * q + fr) * S32 + fg * 8, u4);
            yacc = mm_tile<2>(L + O_SBF + 16 * q * S64, S64, L + O_RT, S64, (f32x4){0.f, 0.f, 0.f, 0.f}, lane);
            yacc = mm_tile<1>(L + O_VT + 16 * q * S32, S32, L + O_NK, S32, yacc, lane);
        }
        asm volatile("s_waitcnt lgkmcnt(0)" ::: "memory");
        {
            f32x4 u4 = mm_tile<1>(L + O_TI, S32, L + O_UTT + 16 * q * S32, S32, (f32x4){0.f, 0.f, 0.f, 0.f}, lane);
            st_bf16x4(L + O_UT + (16 * q + fr) * S32 + fg * 8, -u4);
        }
        __syncthreads();
        {
            yacc = mm_tile<1>(L + O_UT + 16 * q * S32, S32, L + O_NB, S32, yacc, lane);
            ypend.x = cvtpk(yacc[0], yacc[1]); ypend.y = cvtpk(yacc[2], yacc[3]);
            const f32x4 wc4 = *(LAS f32x4*)(L + O_WC + (16 * q + 4 * fg) * 4);
#pragma unroll
            for (int vi = 0; vi < 4; ++vi) {
                f32x4 s4 = Sacc[vi] * wc4;
                s4 = mm_tile<1>(L + O_KHT + 16 * q * S32, S32, L + O_VT + 16 * vi * S32, S32, s4, lane);
                s4 = mm_tile<1>(L + O_BHT + 16 * q * S32, S32, L + O_UT + 16 * vi * S32, S32, s4, lane);
                Sacc[vi] = s4;
                st_bf16x4(L + O_SBF + (16 * vi + fr) * S64 + (16 * q + 4 * fg) * 2, s4);
            }
        }
    }
    flush(143);
    __syncthreads();
}

__device__ __forceinline__ void phase_gdn_prep(const Args& A, Ctx& C) {
    const bf16_t* P = WSP(bf16_t, WS_P);
    bf16_t* QKV = (bf16_t*)A.out; float* NRM = WSP(float, WS_NRM);
    lfloat* part = (lfloat*)C.lds;
    const int tid = C.tid, lane = C.lane, w = C.wave;
    float cw[3][5];
#pragma unroll
    for (int g = 0; g < 3; ++g)
#pragma unroll
        for (int e = 0; e < 5; ++e) cw[g][e] = A.in[I_CONVW][e * 1536 + g * 512 + tid];
    for (int tile = C.bid; tile < NROWS / 16; tile += C.G) {
        const int row0 = tile * 16;
        int T, ta; size_t rowbase;
        if (row0 < NLAT) { T = SEQ; rowbase = (size_t)(row0 >> 11) * SEQ; ta = row0 & (SEQ - 1); } else { T = CTX; const int r = row0 - NLAT; rowbase = (size_t)NLAT + (size_t)(r >> 8) * CTX; ta = r & (CTX - 1); }
        float x[3][20];
#pragma unroll
        for (int e = 0; e < 20; ++e) { const int t = ta - 2 + e; const bool ok = (t >= 0 && t < T); const bf16_t* pr = P + (rowbase + (ok ? t : ta)) * PLD + RW_COLS + tid;
#pragma unroll
            for (int g = 0; g < 3; ++g) { const float xv = bf2f(pr[g * 512]); x[g][e] = ok ? xv : 0.f; } }
        __syncthreads();
#pragma unroll
        for (int i = 0; i < 16; ++i) { float y[3];
#pragma unroll
            for (int g = 0; g < 3; ++g) { float sacc = 0.f;
#pragma unroll
                for (int f = 0; f < 5; ++f) sacc += cw[g][f] * x[g][i + f];
                y[g] = siluf_(sacc); }
            bf16_t* orow = QKV + (rowbase + ta + i) * 1536 + tid;
            orow[0] = (bf16_t)cvtpk(y[0], 0.f); orow[512] = (bf16_t)cvtpk(y[1], 0.f); orow[1024] = (bf16_t)cvtpk(y[2], 0.f);
            const float sq = wave_sum(y[0] * y[0]), sk = wave_sum(y[1] * y[1]);
            if (lane == 0) { part[(i * 8 + w) * 2] = sq; part[(i * 8 + w) * 2 + 1] = sk; } }
        __syncthreads();
        if (tid < 128) { const int i = tid >> 3, sidx = tid & 7, h = sidx & 3, sel = sidx >> 2;
            const float ss = part[(i * 8 + 2 * h) * 2 + sel] + part[(i * 8 + 2 * h + 1) * 2 + sel];
            NRM[(rowbase + ta + i) * 8 + sidx] = __builtin_amdgcn_rsqf(ss + 1e-6f) * (sel ? 1.f : 0.08838834764831845f); }
    }
    __syncthreads();
}

namespace gd {
constexpr int S128 = 288, S32 = 80;
constexpr int O_KT = 0, O_QT = O_KT + 32 * S128, O_KKT = O_QT + 32 * S128, O_RT = O_KKT + 32 * S128,
              O_VT = O_RT + 32 * S128, O_BHT = O_VT + 128 * S32, O_KHT = O_BHT + 128 * S32, O_UT = O_KHT + 128 * S32, O_UTT = O_UT + 128 * S32,
              O_TI = O_UTT + 128 * S32, O_MK = O_TI + 32 * S32, O_NB = O_MK + 32 * S32, O_NK = O_NB + 32 * S32,
              O_M21 = O_NK + 32 * S32, O_T11T = O_M21 + 16 * S32, O_T22 = O_T11T + 16 * S32, O_XT = O_T22 + 16 * S32,
              O_SBF = O_XT + 16 * S32, O_SC = O_SBF + 128 * S128, O_MS = O_SC + 512, GD_BYTES = O_MS + 2048;
static_assert(GD_BYTES <= LDS_MISC, "gdn LDS");
}
__device__ __forceinline__ void gdn_chain_chunked(const Args& A, Ctx& C, int chain) {
    using namespace gd;
    const int b = chain >> 3, h = (chain >> 1) & 3, dir = chain & 1;
    lbyte* L = C.lds;
    LAS float* SC = (LAS float*)(L + O_SC);
    const bf16_t* P = WSP(bf16_t, WS_P);
    bf16_t* ydir = WSP(bf16_t, WS_YDIR) + (size_t)dir * NLAT * D;
    const int tid = C.tid, lane = C.lane, w = C.wave, fr = lane & 15, fg = lane >> 4;
    const int grp = tid >> 7, idx = tid & 127;
    const float Aexp = __expf(A.in[I_ALOG][dir * 4 + h]), dtb = A.in[I_DTB][dir * 4 + h];
    const f32x4 z4 = (f32x4){0.f, 0.f, 0.f, 0.f};
    __syncthreads();
#pragma unroll 2
    for (int i = tid; i < (O_SC - O_VT) / 4; i += 512) ((LAS unsigned*)(L + O_VT))[i] = 0u;
    f32x4 Sacc[8];
#pragma unroll
    for (int i = 0; i < 8; ++i) Sacc[i] = z4;
    const bf16_t* QKV = (const bf16_t*)A.out; const float* NRM = WSP(const float, WS_NRM);
    unsigned rq[8], rk[8], rv[8]; float nq[8], nk[8]; unsigned raw_al = 0, raw_be = 0;
    const bool codd = idx & 1, godd = h & 1;
    auto chunk_geom = [&](int ch, bool& isctx, int& sbase, int& T, size_t& rowbase) { isctx = ch < 8; sbase = isctx ? ch * 32 : (ch - 8) * 32; T = isctx ? CTX : SEQ;
        rowbase = isctx ? (size_t)NLAT + (size_t)b * CTX : (size_t)b * SEQ; };
    auto issue_loads = [&](int ch) { bool isctx; int sbase, T; size_t rowbase; chunk_geom(ch, isctx, sbase, T, rowbase);
#pragma unroll
        for (int j = 0; j < 8; ++j) { const int i = 2 * grp + 8 * (j >> 1) + (j & 1); const int t = dir ? (T - 1 - (sbase + i)) : (sbase + i); const size_t row = rowbase + t;
            const unsigned* qr = (const unsigned*)(QKV + row * 1536 + 128 * h + (idx & ~1)); rq[j] = qr[0]; rk[j] = qr[256]; rv[j] = qr[512]; nq[j] = NRM[row * 8 + h]; nk[j] = NRM[row * 8 + 4 + h]; }
        if (w == 7 && lane < 32) { const int t = dir ? (T - 1 - (sbase + lane)) : (sbase + lane); const unsigned* pr = (const unsigned*)(P + (rowbase + t) * PLD + RW_COLS + 2048 + ((dir * 4 + h) & ~1)); raw_al = pr[0]; raw_be = pr[4]; } };
    u32x2 ypend[2]; ypend[0].x = ypend[0].y = ypend[1].x = ypend[1].y = 0u;
    auto flush = [&](int pch) { bool pisctx; int psb, pT; size_t prb; chunk_geom(pch, pisctx, psb, pT, prb);
        if (!pisctx) {
#pragma unroll
            for (int tb = 0; tb < 2; ++tb) { const int tl = psb + tb * 16 + fr; const int t = dir ? (pT - 1 - tl) : tl;
                *(u32x2*)(ydir + ((size_t)b * SEQ + t) * D + 512 + 128 * h + 16 * w + 4 * fg) = ypend[tb]; } } };
    issue_loads(0);
    for (int ch = 0; ch < 72; ++ch) {
        bool isctx; int sbase, T; size_t rowbase; chunk_geom(ch, isctx, sbase, T, rowbase);
        __syncthreads();
        float qv[8], kv[8], vv[8], nqv[8], nkv[8];
#pragma unroll
        for (int j = 0; j < 8; ++j) { qv[j] = bfsel(rq[j], codd); kv[j] = bfsel(rk[j], codd); vv[j] = bfsel(rv[j], codd); nqv[j] = nq[j]; nkv[j] = nk[j]; }
        if (w == 7) {
            const float gi = (lane < 32) ? -Aexp * softplusf_(bfsel(raw_al, godd) + dtb) : 0.f;
            float cum = gi;
            cum += __builtin_bit_cast(float, __builtin_amdgcn_update_dpp(0, __builtin_bit_cast(int, cum), 0x111, 0xf, 0xf, true));
            cum += __builtin_bit_cast(float, __builtin_amdgcn_update_dpp(0, __builtin_bit_cast(int, cum), 0x112, 0xf, 0xf, true));
            cum += __builtin_bit_cast(float, __builtin_amdgcn_update_dpp(0, __builtin_bit_cast(int, cum), 0x114, 0xf, 0xf, true));
            cum += __builtin_bit_cast(float, __builtin_amdgcn_update_dpp(0, __builtin_bit_cast(int, cum), 0x118, 0xf, 0xf, true));
            const float r0 = rdlane(cum, 15);
            cum += (lane >= 16) ? r0 : 0.f;
            if (lane < 32) { SC[lane] = sigmoidf_(bfsel(raw_be, godd)); SC[32 + lane + 1] = cum; if (lane == 0) SC[32] = 0.f; }
        }
        asm volatile("" :: "v"(qv[0]), "v"(qv[1]), "v"(qv[2]), "v"(qv[3]), "v"(qv[4]), "v"(qv[5]), "v"(qv[6]), "v"(qv[7]), "v"(kv[0]), "v"(kv[1]), "v"(kv[2]), "v"(kv[3]), "v"(kv[4]), "v"(kv[5]), "v"(kv[6]), "v"(kv[7]),
                        "v"(vv[0]), "v"(vv[1]), "v"(vv[2]), "v"(vv[3]), "v"(vv[4]), "v"(vv[5]), "v"(vv[6]), "v"(vv[7]) : "memory");
        asm volatile("" :: "v"(nqv[0]), "v"(nqv[1]), "v"(nqv[2]), "v"(nqv[3]), "v"(nqv[4]), "v"(nqv[5]), "v"(nqv[6]), "v"(nqv[7]), "v"(nkv[0]), "v"(nkv[1]), "v"(nkv[2]), "v"(nkv[3]), "v"(nkv[4]), "v"(nkv[5]), "v"(nkv[6]), "v"(nkv[7]),
                        "v"(raw_al), "v"(raw_be) : "memory");
        if (ch > 0) flush(ch - 1);
        if (ch + 1 < 72) issue_loads(ch + 1);
        __syncthreads();
        {
            const int c = idx; const float gcC = SC[32 + 32];
#pragma unroll
            for (int jj = 0; jj < 4; ++jj) { const int i0 = 2 * grp + 8 * jj;
                float bh[2], kh[2];
#pragma unroll
                for (int e = 0; e < 2; ++e) { const int j = 2 * jj + e, i = i0 + e;
                    const float kn = kv[j] * nkv[j], qn = qv[j] * nqv[j];
                    const float gm = SC[32 + i], gi = SC[32 + i + 1], be = SC[i];
                    const unsigned p0 = cvtpk(kn, qn), p1 = cvtpk(kn * __expf(gm), qn * __expf(gi));
                    *(LAS unsigned short*)(L + O_KT + i * S128 + c * 2) = (unsigned short)p0; *(LAS unsigned short*)(L + O_QT + i * S128 + c * 2) = (unsigned short)(p0 >> 16);
                    *(LAS unsigned short*)(L + O_KKT + i * S128 + c * 2) = (unsigned short)p1; *(LAS unsigned short*)(L + O_RT + i * S128 + c * 2) = (unsigned short)(p1 >> 16);
                    bh[e] = be * kn * __expf(gcC - gm); kh[e] = be * kn * __expf(gcC - gi); }
                *(LAS unsigned*)(L + O_BHT + c * S32 + i0 * 2) = cvtpk(bh[0], bh[1]); *(LAS unsigned*)(L + O_KHT + c * S32 + i0 * 2) = cvtpk(kh[0], kh[1]);
                *(LAS unsigned*)(L + O_VT + c * S32 + i0 * 2) = cvtpk(vv[2 * jj], vv[2 * jj + 1]); }
        }
        __syncthreads();
        {
            const int isq = w >> 2, tb = (w >> 1) & 1, jb = w & 1;
            if (jb <= tb) {
                const f32x4 g4 = mm_tile<4>(L + O_KT + jb * 16 * S128, S128, L + (isq ? O_QT : O_KT) + tb * 16 * S128, S128, z4, lane);
                const int t = tb * 16 + fr;
                const float gt = SC[32 + t + isq];
                f32x4 m0, m1;
#pragma unroll
                for (int e = 0; e < 4; ++e) { const int j = jb * 16 + 4 * fg + e; const bool keep = isq ? (j <= t) : (j < t);
                    const float bj = SC[j] * g4[e];
                    m0[e] = keep ? bj * __expf(gt - SC[32 + j]) : 0.f;
                    m1[e] = keep ? bj * __expf(gt - SC[32 + j + 1]) : 0.f; }
                const int off = t * S32 + (jb * 16 + 4 * fg) * 2;
                if (isq) { st_bf16x4(L + O_NB + off, m0); st_bf16x4(L + O_NK + off, m1); }
                else {
                    st_bf16x4(L + O_MK + off, m1);
                    if (tb != jb) st_bf16x4(L + O_M21 + fr * S32 + fg * 8, m0);
                    else { float X[16]; tri_inv16(m0, lane, L + O_MS + tb * 1024, X);
                        if (lane < 16) {
#pragma unroll
                            for (int i = 0; i < 16; ++i) *(LAS unsigned short*)(L + O_TI + (tb * 16 + i) * S32 + (tb * 16 + lane) * 2) = (unsigned short)cvtpk(X[i], 0.f);
                            if (tb == 0) { u32x4 a0, a1;
                                a0.x = cvtpk(X[0], X[1]); a0.y = cvtpk(X[2], X[3]); a0.z = cvtpk(X[4], X[5]); a0.w = cvtpk(X[6], X[7]);
                                a1.x = cvtpk(X[8], X[9]); a1.y = cvtpk(X[10], X[11]); a1.z = cvtpk(X[12], X[13]); a1.w = cvtpk(X[14], X[15]);
                                *(LAS u32x4*)(L + O_T11T + lane * S32) = a0; *(LAS u32x4*)(L + O_T11T + lane * S32 + 16) = a1; }
                            else {
#pragma unroll
                                for (int i = 0; i < 16; ++i) *(LAS unsigned short*)(L + O_T22 + i * S32 + lane * 2) = (unsigned short)cvtpk(X[i], 0.f); }
                        } }
                }
            }
        }
        __syncthreads();
        if (w == 1) {
            const f32x4 x4 = mm_tile<1>(L + O_M21, S32, L + O_T11T, S32, z4, lane);
            st_bf16x4(L + O_XT + fr * S32 + fg * 8, x4);
            asm volatile("s_waitcnt lgkmcnt(0)" ::: "memory");
            const f32x4 t4 = mm_tile<1>(L + O_XT, S32, L + O_T22, S32, z4, lane);
            st_bf16x4(L + O_TI + (16 + fr) * S32 + fg * 8, -t4);
        }
        f32x4 yacc[2];
#pragma unroll
        for (int tb = 0; tb < 2; ++tb) {
            f32x4 u4 = mm_tile<4>(L + O_KKT + tb * 16 * S128, S128, L + O_SBF + 16 * w * S128, S128, z4, lane);
            u4 = mm_tile<1>(L + O_MK + tb * 16 * S32, S32, L + O_VT + 16 * w * S32, S32, u4, lane);
            st_bf16x4(L + O_UTT + (16 * w + fr) * S32 + tb * 32 + fg * 8, u4);
            yacc[tb] = mm_tile<4>(L + O_SBF + 16 * w * S128, S128, L + O_RT + tb * 16 * S128, S128, z4, lane);
            yacc[tb] = mm_tile<1>(L + O_VT + 16 * w * S32, S32, L + O_NK + tb * 16 * S32, S32, yacc[tb], lane);
        }
        __syncthreads();
#pragma unroll
        for (int tb = 0; tb < 2; ++tb) {
            const f32x4 u4 = mm_tile<1>(L + O_TI + tb * 16 * S32, S32, L + O_UTT + 16 * w * S32, S32, z4, lane);
            st_bf16x4(L + O_UT + (16 * w + fr) * S32 + tb * 32 + fg * 8, -u4);
        }
        __syncthreads();
        {
#pragma unroll
            for (int tb = 0; tb < 2; ++tb) {
                yacc[tb] = mm_tile<1>(L + O_UT + 16 * w * S32, S32, L + O_NB + tb * 16 * S32, S32, yacc[tb], lane);
                ypend[tb].x = cvtpk(yacc[tb][0], yacc[tb][1]); ypend[tb].y = cvtpk(yacc[tb][2], yacc[tb][3]);
            }
            const float wc = __expf(SC[32 + 32]);
#pragma unroll
            for (int vi = 0; vi < 8; ++vi) {
                f32x4 s4 = Sacc[vi] * wc;
                s4 = mm_tile<1>(L + O_KHT + 16 * w * S32, S32, L + O_VT + 16 * vi * S32, S32, s4, lane);
                s4 = mm_tile<1>(L + O_BHT + 16 * w * S32, S32, L + O_UT + 16 * vi * S32, S32, s4, lane);
                Sacc[vi] = s4;
                st_bf16x4(L + O_SBF + (16 * vi + fr) * S128 + (16 * w + 4 * fg) * 2, s4);
            }
        }
    }
    flush(71);
    __syncthreads();
}

__device__ __forceinline__ void unpack8(const u32x4 w, float (&f)[8]) { f[0] = bflo(w.x); f[1] = bfhi(w.x); f[2] = bflo(w.y); f[3] = bfhi(w.y); f[4] = bflo(w.z); f[5] = bfhi(w.z); f[6] = bflo(w.w); f[7] = bfhi(w.w); }
__device__ __forceinline__ void phase_p4(const Args& A, Ctx& C) {
    const bf16_t* P = WSP(bf16_t, WS_P);
    const bf16_t* yf = WSP(bf16_t, WS_YDIR); const bf16_t* yb = yf + (size_t)NLAT * D;
    const float* bon = WSP(float, WS_BON);
    bf16_t* ymix = WSP(bf16_t, WS_YMIX);
    lbyte* SGb = C.lds;
    lfloat* GO = (lfloat*)(C.lds + 8192);
    const int tid = C.tid, lane = C.lane, w = C.wave;
    const bf16_t* gupt = WSP(const bf16_t, WS_GUPT);
    const int fr = lane & 15, fg = lane >> 4;
    const int c8 = 8 * lane;
    float lnw[8], lnb[8], ong[8], muv[8];
#pragma unroll
    for (int e = 0; e < 8; ++e) { lnw[e] = A.in[I_LNW][c8 + e]; lnb[e] = A.in[I_LNB][c8 + e]; ong[e] = A.in[I_ONG][(c8 + e) & 127]; muv[e] = A.in[I_MU][1024 + c8 + e]; }
    const int tkA = tid >> 5, lA = 4 * (tid & 31);
    float muA[4];
#pragma unroll
    for (int e = 0; e < 4; ++e) muA[e] = A.in[I_MU][1792 + lA + e];
    const bool vup = (1024 + c8) < 1440;
    for (int tile = C.bid; tile < NLAT / 16; tile += C.G) {
        const int row0 = tile * 16;
        __syncthreads();
        {
            const int row = row0 + tkA, t = row & (SEQ - 1); const bool ok = t < SEQ - 64;
            const u32x2 pw = *(const u32x2*)(P + (size_t)row * PLD + 1792 + lA); const u32x2 sw = *(const u32x2*)(P + (size_t)(row + (ok ? 64 : 0)) * PLD + 1792 + lA);
            const float pv[4] = {bflo(pw.x), bfhi(pw.x), bflo(pw.y), bfhi(pw.y)}; const float sv[4] = {bflo(sw.x), bfhi(sw.x), bflo(sw.y), bfhi(sw.y)};
            float o[4];
#pragma unroll
            for (int e = 0; e < 4; ++e) o[e] = sigmoidf_(pv[e] + muA[e] * ((ok ? sv[e] : 0.f) - pv[e]));
            u32x2 ow; ow.x = cvtpk(o[0], o[1]); ow.y = cvtpk(o[2], o[3]); *(LAS u32x2*)(SGb + tkA * 288 + lA * 2) = ow;
        }
        __syncthreads();
#pragma unroll
        for (int i = 0; i < 4; ++i) { const int c0 = 64 * w + 16 * i; f32x4 acc = (f32x4){0.f, 0.f, 0.f, 0.f};
#pragma unroll
            for (int ks = 0; ks < 4; ++ks) { const bf16x8 a = *(const LAS bf16x8*)(SGb + fr * 288 + ks * 64 + fg * 16);
                const bf16x8 bq = *(const bf16x8*)(gupt + (size_t)(c0 + fr) * 128 + ks * 32 + fg * 8);
                acc = __builtin_amdgcn_mfma_f32_16x16x32_bf16(a, bq, acc, 0, 0, 0); }
#pragma unroll
            for (int e = 0; e < 4; ++e) GO[(4 * fg + e) * 512 + c0 + fr] = acc[e]; }
        __syncthreads();
#pragma unroll
        for (int tt = 0; tt < 2; ++tt) {
            const int tk = 2 * w + tt, row = row0 + tk, t = row & (SEQ - 1);
            const bool okv = vup ? (t >= 64) : (t < SEQ - 64);
            const u32x4 wyf = *(const u32x4*)(yf + (size_t)row * D + c8), wyb = *(const u32x4*)(yb + (size_t)row * D + c8);
            const u32x4 wpv = *(const u32x4*)(P + (size_t)row * PLD + 1024 + c8), wsv = *(const u32x4*)(P + (size_t)(row + (okv ? (vup ? -64 : 64) : 0)) * PLD + 1024 + c8);
            const u32x4 wof = *(const u32x4*)(yf + (size_t)row * D + 512 + c8), wob = *(const u32x4*)(yb + (size_t)row * D + 512 + c8);
            const u32x4 wz = *(const u32x4*)(P + (size_t)row * PLD + RW_COLS + 1536 + c8);
            const float bs = bon[(size_t)row * 8 + (lane >> 3)] + bon[((size_t)NLAT + row) * 8 + (lane >> 3)];
            const f32x4 g0 = *(const LAS f32x4*)(GO + tk * 512 + c8), g1 = *(const LAS f32x4*)(GO + tk * 512 + c8 + 4);
            const float gg[8] = {g0.x, g0.y, g0.z, g0.w, g1.x, g1.y, g1.z, g1.w};
            float a[8], bq[8], pv[8], sv[8], y[8];
            unpack8(wyf, a); unpack8(wyb, bq); unpack8(wpv, pv); unpack8(wsv, sv);
            float s1 = 0.f;
#pragma unroll
            for (int e = 0; e < 8; ++e) { y[e] = a[e] + bq[e]; s1 += y[e]; }
            s1 += __shfl_xor(s1, 1); s1 += __shfl_xor(s1, 2); s1 += __shfl_xor(s1, 4);
            const float m = s1 * (1.f / 64.f);
            float s2 = 0.f;
#pragma unroll
            for (int e = 0; e < 8; ++e) { y[e] -= m; s2 += y[e] * y[e]; }
            s2 += __shfl_xor(s2, 1); s2 += __shfl_xor(s2, 2); s2 += __shfl_xor(s2, 4);
            const float rs = __builtin_amdgcn_rsqf(s2 * (1.f / 64.f) + RWKV_EPS);
            float o[8];
#pragma unroll
            for (int e = 0; e < 8; ++e) { const float vv = pv[e] + muv[e] * ((okv ? sv[e] : 0.f) - pv[e]); o[e] = (y[e] * rs * lnw[e] + lnb[e] + bs * vv) * gg[e]; }
            u32x4 ow; ow.x = cvtpk(o[0], o[1]); ow.y = cvtpk(o[2], o[3]); ow.z = cvtpk(o[4], o[5]); ow.w = cvtpk(o[6], o[7]);
            *(u32x4*)(ymix + (size_t)row * D + c8) = ow;
            float of[8], ob[8], z[8];
            unpack8(wof, of); unpack8(wob, ob); unpack8(wz, z);
            float s3 = 0.f;
#pragma unroll
            for (int e = 0; e < 8; ++e) { of[e] += ob[e]; s3 += of[e] * of[e]; }
            s3 += __shfl_xor(s3, 1); s3 += __shfl_xor(s3, 2); s3 += __shfl_xor(s3, 4); s3 += __shfl_xor(s3, 8);
            const float rg = __builtin_amdgcn_rsqf(s3 * (1.f / 128.f) + NORM_EPS);
#pragma unroll
            for (int e = 0; e < 8; ++e) o[e] = of[e] * rg * ong[e] * siluf_(z[e]);
            ow.x = cvtpk(o[0], o[1]); ow.y = cvtpk(o[2], o[3]); ow.z = cvtpk(o[4], o[5]); ow.w = cvtpk(o[6], o[7]);
            *(u32x4*)(ymix + (size_t)row * D + 512 + c8) = ow;
        }
    }
}

__device__ __forceinline__ void convert_experts(const Args& A, Ctx& C) {
    lfloat* scr = (lfloat*)(C.lds + C.wave * 16384);
    const int gw = C.bid * 8 + C.wave, NGW = C.G * 8;
    constexpr int I13 = (D / 64) * (DE / 32);
    constexpr int I2 = (DE / 64) * (D / 32);
    constexpr int PER = 2 * I13 + I2;
    for (int it = gw; it < 257 * PER; it += NGW) {
        const int e = it / PER; int r = it % PER;
        unsigned char* bt13 = A.ws + WS_WEXP + (size_t)e * WEXP_STRIDE; unsigned char* bt2 = bt13 + 512 * 1024;
        const float* w1 = e < NE ? A.in[I_EW1] + (size_t)e * D * DE : A.in[I_SW1];
        const float* w3 = e < NE ? A.in[I_EW3] + (size_t)e * D * DE : A.in[I_SW3];
        const float* w2 = e < NE ? A.in[I_EW2] + (size_t)e * DE * D : A.in[I_SW2];
        if (r < I13) { transpose_item_fp8(w1, D, DE, bt13, RowGLU{0}, SW13, scr, r, C.lane); continue; } r -= I13;
        if (r < I13) { transpose_item_fp8(w3, D, DE, bt13, RowGLU{128}, SW13, scr, r, C.lane); continue; } r -= I13;
        transpose_item_fp8(w2, DE, D, bt2, RowId(), SW2, scr, r, C.lane);
    }
}

__device__ __forceinline__ void phase_p6(const Args& A, Ctx& C) {
    const float* mod = WSP(float, WS_MOD); bf16_t* h2n = WSP(bf16_t, WS_H2N);
    const int gw = C.bid * 8 + C.wave, NGW = C.G * 8;
    for (int row = gw; row < NLAT; row += NGW) {
        const float* m = mod + (size_t)(row >> 11) * MODW;
        norm_mod_row(A.out + (size_t)row * D, A.in[I_N2G], m + 4 * D, m + 3 * D, h2n + (size_t)row * D, C.lane, (unsigned*)(A.ws + WS_H2N8) + (size_t)row * (D / 4));
    }
}

__device__ __forceinline__ void phase_p8(const Args& A, Ctx& C) {
    const float* logit = WSP(float, WS_LOGIT);
    int* tope = WSP(int, WS_TOPE); float* topw = WSP(float, WS_TOPW); int* pos = WSP(int, WS_POS);
    unsigned* cnt = WSP(unsigned, WS_CTL) + CW_CNT;
    const int gw = C.bid * 8 + C.wave, NGW = C.G * 8, lane = C.lane;
    const f32x4 rb = ((const f32x4*)A.in[I_RB])[lane];
    for (int tok = gw; tok < NLAT; tok += NGW) {
        const f32x4 lg = ((const f32x4*)(logit + (size_t)tok * NE))[lane];
        float s[4], sel[4];
#pragma unroll
        for (int i = 0; i < 4; ++i) { s[i] = sigmoidf_(lg[i]); sel[i] = s[i] + rb[i]; }
        float m1 = fmaxf(fmaxf(sel[0], sel[1]), fmaxf(sel[2], sel[3]));
        float m2;
        {
            float a = fmaxf(sel[0], sel[1]), bq = fminf(sel[0], sel[1]), cq = fmaxf(sel[2], sel[3]), dq = fminf(sel[2], sel[3]);
            m2 = fmaxf(fminf(a, cq), fmaxf(bq, dq)); }
#pragma unroll
        for (int o = 1; o < 8; o <<= 1) { const float o1 = __shfl_xor(m1, o), o2 = __shfl_xor(m2, o);
            const float n1 = fmaxf(m1, o1); const float n2 = fmaxf(fminf(m1, o1), fmaxf(m2, o2)); m1 = n1; m2 = n2; }
        const float gs = m1 + m2;
        const int grp = lane >> 3;
        int rank = 0;
#pragma unroll
        for (int gq = 0; gq < 8; ++gq) { const float og = __shfl(gs, gq * 8); rank += (og > gs || (og == gs && gq < grp)) ? 1 : 0; }
        const bool gsel = rank < 4;
        float cand[4];
#pragma unroll
        for (int i = 0; i < 4; ++i) cand[i] = gsel ? sel[i] : -INFINITY;
        int my_e = 0; float my_w = 0.f; float wsum = 0.f;
#pragma unroll
        for (int r = 0; r < 8; ++r) {
            float bv = cand[0]; int bi = 0;
#pragma unroll
            for (int i = 1; i < 4; ++i) if (cand[i] > bv) { bv = cand[i]; bi = i; }
            int be = lane * 4 + bi;
#define P8_STEP(CTRL) { const float ov = dpp_f<CTRL>(bv); const int oe = __builtin_amdgcn_update_dpp(0, be, CTRL, 0xf, 0xf, false); if (ov > bv || (ov == bv && oe < be)) { bv = ov; be = oe; } }
            P8_STEP(0x128) P8_STEP(0x124) P8_STEP(0x122) P8_STEP(0x121)
#undef P8_STEP
            float gv = rdlane(bv, 0); int ge = __builtin_amdgcn_readlane(be, 0);
#pragma unroll
            for (int rr = 1; rr < 4; ++rr) { const float ov = rdlane(bv, 16 * rr); const int oe = __builtin_amdgcn_readlane(be, 16 * rr); if (ov > gv || (ov == gv && oe < ge)) { gv = ov; ge = oe; } }
            be = ge;
            const int ol = be >> 2, oi = be & 3;
            const float mys = oi == 0 ? s[0] : (oi == 1 ? s[1] : (oi == 2 ? s[2] : s[3]));
            const float ws_ = __shfl(mys, ol);
            if (lane == ol) { if (oi == 0) cand[0] = -INFINITY; else if (oi == 1) cand[1] = -INFINITY; else if (oi == 2) cand[2] = -INFINITY; else cand[3] = -INFINITY; }
            wsum += ws_;
            if (lane == r) { my_e = be; my_w = ws_; }
        }
        if (lane < 8) {
            const float w = my_w / wsum * 2.5f;
            const unsigned p = atomicAdd(cnt + my_e, 1u);
            tope[(size_t)tok * 8 + lane] = my_e; topw[(size_t)tok * 8 + lane] = w; pos[(size_t)tok * 8 + lane] = (int)p;
        }
    }
}

__device__ __forceinline__ void tile_prefix(const Args& A, Ctx& C, LAS int* tb) {
    const unsigned* cnt = WSP(unsigned, WS_CTL) + CW_CNT;
    if (C.tid == 0) { int acc = 0; for (int e = 0; e < NE; ++e) { tb[e] = acc; acc += ((int)cnt[e] + 255) >> 8; } tb[NE] = acc; }
    __syncthreads();
}
__device__ __forceinline__ void phase_p9(const Args& A, Ctx& C) {
    LAS int* tb = (LAS int*)C.lds;
    tile_prefix(A, C, tb);
    const unsigned* cnt = WSP(unsigned, WS_CTL) + CW_CNT;
    const int* tope = WSP(int, WS_TOPE); const float* topw = WSP(float, WS_TOPW); const int* pos = WSP(int, WS_POS);
    int* rowl = WSP(int, WS_ROWL); float* roww = WSP(float, WS_ROWW); int* tile_e = WSP(int, WS_TILEE);
    const int nrt = tb[NE];
    for (int i = C.bid * 512 + C.tid; i < NLAT * 8; i += C.G * 512) { const int e = tope[i]; const int pr = tb[e] * 256 + pos[i]; rowl[pr] = i; roww[pr] = topw[i]; }
    for (int e = C.bid; e < NE; e += C.G) { const int n = (int)cnt[e], nt = tb[e + 1] - tb[e];
        for (int j = n + C.tid; j < nt * 256; j += 512) { rowl[tb[e] * 256 + j] = -1; roww[tb[e] * 256 + j] = 0.f; }
        for (int k = C.tid; k < nt; k += 512) tile_e[tb[e] + k] = e; }
    for (int i = C.bid * 512 + C.tid; i < NLAT; i += C.G * 512) { rowl[nrt * 256 + i] = i; roww[nrt * 256 + i] = 1.f; }
    for (int k = C.bid * 512 + C.tid; k < NLAT / 256; k += C.G * 512) tile_e[nrt + k] = NE;
    __syncthreads();
}

__device__ __forceinline__ void phase_moe(const Args& A, Ctx& C, int dry_shared) {
    LAS int* tb = (LAS int*)(C.lds + 131072);
    LAS int* tbl = tb + 320;
    tile_prefix(A, C, tb);
    pg8::MoeCtx M;
    M.nrt = tb[NE]; M.ntiles = M.nrt + NLAT / 256; M.G = C.G; M.vc = (C.G % 8 == 0) ? (C.bid % 8) * (C.G / 8) + C.bid / 8 : C.bid;
    M.tb = tb; M.tbl = tbl; M.cnt = WSP(unsigned, WS_CTL) + CW_CNT; M.rowl = WSP(int, WS_ROWL); M.roww = WSP(float, WS_ROWW);
    M.wexp = (const char*)(A.ws + WS_WEXP); M.h2n = (const char*)(A.ws + WS_H2N8); M.Hs = (char*)(A.ws + WS_HS) + (size_t)C.bid * 2 * 65536;
    M.Y = (unsigned char*)(A.ws + WS_Y); M.out = A.out; M.mod = WSP(const float, WS_MOD); M.dry_shared = dry_shared;
    pg8::gemm_moe(C.lds, M);
    __syncthreads();
}

__device__ __forceinline__ void phase_final(const Args& A, Ctx& C, float* dst) {
    const int gw = C.bid * 8 + C.wave, NGW = C.G * 8;
    const float* fg = A.in[I_FG]; const float* mod = WSP(const float, WS_MOD);
    const unsigned* Y = (const unsigned*)(A.ws + WS_Y);
    for (int row = gw; row < NLAT; row += NGW) {
        f32x4* xr = (f32x4*)(A.out + (size_t)row * D) + C.lane;
        const f32x4* gt = (const f32x4*)(mod + (size_t)(row >> 11) * MODW + 5 * D) + C.lane;
        const unsigned* yr = Y + (size_t)row * 8 * (D / 4) + C.lane;
        f32x4 v[4]; float s = 0.f;
#pragma unroll
        for (int j = 0; j < 4; ++j) {
            f32x4 a = (f32x4){0.f, 0.f, 0.f, 0.f};
#pragma unroll
            for (int sl = 0; sl < 8; ++sl) { const unsigned w = yr[sl * (D / 4) + 64 * j];
                const f32x2 lo = __builtin_amdgcn_cvt_pk_f32_fp8(w, false), hi = __builtin_amdgcn_cvt_pk_f32_fp8(w, true);
                a.x += lo.x; a.y += lo.y; a.z += hi.x; a.w += hi.y; }
            v[j] = xr[64 * j] + gt[64 * j] * a * (1.f / pg8::YSCALE);
            s += (v[j].x * v[j].x + v[j].y * v[j].y) + (v[j].z * v[j].z + v[j].w * v[j].w); }
        const float rstd = __builtin_amdgcn_rsqf(wave_sum(s) * (1.f / D) + NORM_EPS);
        f32x4* orow = (f32x4*)(dst + (size_t)row * D) + C.lane;
#pragma unroll
        for (int j = 0; j < 4; ++j) orow[64 * j] = v[j] * rstd * ((const f32x4*)fg)[C.lane + 64 * j];
    }
}

constexpr int NPHASE = 13;
__global__ void __launch_bounds__(512, 2) fwd_kernel(Args A) {
    extern __shared__ __attribute__((aligned(16))) unsigned char lds_raw[];
    Ctx C; C.lds = (lbyte*)lds_raw; C.tid = threadIdx.x; C.lane = C.tid & 63; C.wave = __builtin_amdgcn_readfirstlane(C.tid >> 6);
    C.G = gridDim.x; C.bid = blockIdx.x; C.a = &A;
    volatile LAS unsigned* misc = (volatile LAS unsigned*)(C.lds + LDS_MISC);
    if (C.tid < 16) misc[C.tid] = 0u;
    __syncthreads();
    XcdBarrier bar; bar.bar = WSP(unsigned, WS_CTL) + CW_BAR; bar.x = 0; bar.st = nullptr;
    const int lo = A.ph_lo, hi = A.ph_hi;
    const bool multi = (hi - lo) > 1;
    if (multi) bar = xcd_barrier_post(WSP(unsigned, WS_CTL) + CW_BAR, misc);
#ifndef PHASE_MASK
#define PHASE_MASK 0x1FFF
#endif
#define IN(k) (((PHASE_MASK >> (k)) & 1) && lo <= (k) && (k) < hi)
#define SEAM(k) do { if (IN(k) && IN((k) + 1)) xcd_barrier(bar); } while (0)
#ifndef REP_MASK
#define REP_MASK 0
#endif
#define REPS(k) (((REP_MASK >> (k)) & 1) ? 2 : 1)

    if (IN(0)) _Pragma("unroll") for (int rep = 0; rep < REPS(0); ++rep) { phase_p0(A, C); __syncthreads(); } SEAM(0);
    if (IN(1)) _Pragma("unroll") for (int rep = 0; rep < REPS(1); ++rep) { phase_p1(A, C); } SEAM(1);
    if (IN(2)) _Pragma("unroll") for (int rep = 0; rep < REPS(2); ++rep) {
        pg8::Gemm g{WSP(bf16_t, WS_XN), D}; pg8::StaticOrder S; S.init(NROWS, PLD, C.G, C.bid, WSP(bf16_t, WS_BTIN), D, 1);
        pg8::EpiBf16 E{WSP(bf16_t, WS_P), PLD, 1.f / SWIN};
        pg8::gemm_phase<pg8::EpiBf16, pg8::StaticOrder, false, 0, false, true>(C.lds, g, S, E);
    } SEAM(2);
    if (IN(3)) _Pragma("unroll") for (int rep = 0; rep < REPS(3); ++rep) { phase_gdn_prep(A, C); } SEAM(3);
#ifdef PROBE_BARRIERS
    if (multi) for (int kq = 0; kq < PROBE_BARRIERS; ++kq) xcd_barrier(bar);
#endif
    if (IN(4)) {
        for (int ch = C.bid; ch < NB * HB * 2; ch += C.G) gdn_chain_chunked(A, C, ch);
        for (int pr = C.bid; pr < NB * HA; pr += C.G) rwkv_pair_chunked(A, C, pr);
    } SEAM(4);
    if (IN(5)) _Pragma("unroll") for (int rep = 0; rep < REPS(5); ++rep) { phase_p4(A, C); } SEAM(5);
    if (IN(6)) _Pragma("unroll") for (int rep = 0; rep < REPS(6); ++rep) {
        pg8::Gemm g{WSP(bf16_t, WS_YMIX), D}; pg8::StaticOrder S; S.init(NLAT, D, C.G, C.bid, WSP(bf16_t, WS_BTOUT), D);
        pg8::EpiResGate E{A.in[I_X], A.out, WSP(float, WS_MOD), 2 * D};
        pg8::gemm_phase<pg8::EpiResGate, pg8::StaticOrder, false>(C.lds, g, S, E);
    } SEAM(6);
    if (IN(7)) _Pragma("unroll") for (int rep = 0; rep < REPS(7); ++rep) { phase_p6(A, C); __syncthreads(); convert_experts(A, C); __syncthreads(); } SEAM(7);
    if (IN(8)) _Pragma("unroll") for (int rep = 0; rep < REPS(8); ++rep) {
        pg8::Gemm g{WSP(bf16_t, WS_H2N), D}; pg8::StaticOrder S; S.init(NLAT, NE, C.G, C.bid, WSP(bf16_t, WS_BTR), D);
        pg8::EpiF32 E{WSP(float, WS_LOGIT), NE};
        pg8::gemm_phase<pg8::EpiF32, pg8::StaticOrder, false>(C.lds, g, S, E);
    } SEAM(8);
    if (IN(9)) { phase_p8(A, C); } SEAM(9);
    if (IN(10)) _Pragma("unroll") for (int rep = 0; rep < REPS(10); ++rep) { phase_p9(A, C); } SEAM(10);
    if (IN(11)) { phase_moe(A, C, 0); if (REPS(11) > 1) { __syncthreads(); phase_moe(A, C, 1); } } SEAM(11);
    if (IN(12)) { if (REPS(12) > 1) { phase_final(A, C, (float*)(A.ws + WS_WEXP)); __syncthreads(); } phase_final(A, C, A.out); }
#undef IN
#undef SEAM
}

extern "C" void kernel_launch(void* const* d_in, const int* in_sizes, int n_in, void* d_out, int out_size, void* d_ws, size_t ws_size, hipStream_t stream) {
    static int grid = 0;
    if (grid == 0) {
        if (n_in != 34 || out_size != NLAT * D || ws_size < WS_END) { fprintf(stderr, "kernel_launch: unexpected shapes (n_in %d out %d ws %zu need %zu)\n", n_in, out_size, ws_size, (size_t)WS_END); grid = -1; return; }
        int dev = 0, cus = 0;
        if (hipGetDevice(&dev) != hipSuccess || hipDeviceGetAttribute(&cus, hipDeviceAttributeMultiprocessorCount, dev) != hipSuccess) { grid = -1; return; }
        if (hipFuncSetAttribute((const void*)fwd_kernel, hipFuncAttributeMaxDynamicSharedMemorySize, LDS_BYTES) != hipSuccess) { fprintf(stderr, "kernel_launch: hipFuncSetAttribute failed\n"); grid = -1; return; }
        int per_cu = 0;
        if (hipOccupancyMaxActiveBlocksPerMultiprocessor(&per_cu, (const void*)fwd_kernel, 512, LDS_BYTES) != hipSuccess || per_cu < 1) { fprintf(stderr, "kernel_launch: occupancy query says %d\n", per_cu); }
        (void)hipGetLastError();
        grid = cus;
    }
    if (grid < 0) return;
    (void)hipMemsetAsync((char*)d_ws + WS_CTL, 0, CTL_BYTES, stream);
    Args a{};
    for (int i = 0; i < 34; ++i) a.in[i] = (const float*)d_in[i];
    a.out = (float*)d_out; a.ws = (unsigned char*)d_ws;
#if MK_PER_PHASE
    for (int p = 0; p < NPHASE; ++p) { a.ph_lo = p; a.ph_hi = p + 1; hipLaunchKernelGGL(fwd_kernel, dim3(grid), dim3(512), LDS_BYTES, stream, a); }
#else
    a.ph_lo = 0; a.ph_hi = NPHASE; hipLaunchKernelGGL(fwd_kernel, dim3(grid), dim3(512), LDS_BYTES, stream, a);
#endif
}
```

```cpp
#include <hip/hip_runtime.h>
#include <cstdio>
#include <cstdint>

#ifndef MK_PER_PHASE
#define MK_PER_PHASE 0
#endif

#define LAS __attribute__((address_space(3)))
typedef unsigned short bf16_t;
typedef short bf16x8 __attribute__((ext_vector_type(8)));
typedef float f32x4 __attribute__((ext_vector_type(4)));
typedef float f32x2 __attribute__((ext_vector_type(2)));
typedef unsigned u32x4 __attribute__((ext_vector_type(4)));
typedef unsigned u32x2 __attribute__((ext_vector_type(2)));
typedef int i32x4 __attribute__((ext_vector_type(4)));
typedef int i32x8 __attribute__((ext_vector_type(8)));
typedef LAS float lfloat;
typedef LAS unsigned char lbyte;

constexpr int D = 1024, NB = 32, SEQ = 2048, CTX = 256, GW = 64;
constexpr int NLAT = NB * SEQ;
constexpr int NCTX = NB * CTX;
constexpr int NROWS = NLAT + NCTX;
constexpr int DA = 512, HA = 8, NA = 64;
constexpr int RW_COLS = 1920, GD_COLS = 2064, IN_COLS = 3984, PLD = 4096;
constexpr int DB = 512, HB = 4, KB = 128;
constexpr int NE = 256, TOPK = 8, DE = 256;
constexpr int MODW = 6 * D;
constexpr float NORM_EPS = 1e-6f, RWKV_EPS = 64e-5f;
constexpr int MAXTILES = (NLAT * TOPK + NE * 255) / 256 + 1;

constexpr size_t MiB = 1u << 20;
constexpr size_t WS_CTL = 0, CTL_BYTES = 1 * MiB;
constexpr size_t WS_MOD = 1 * MiB;
constexpr size_t WS_BTIN = 2 * MiB, WS_BTOUT = 10 * MiB, WS_BTR = 12 * MiB, WS_BON = 13 * MiB, WS_GUPT = 17 * MiB, WS_NRM = 978 * MiB;
constexpr size_t WS_P = 18 * MiB, WS_XN = 594 * MiB, WS_YDIR = 594 * MiB, WS_YMIX = 850 * MiB;
constexpr size_t WS_H2N8 = 900 * MiB;
constexpr size_t WS_H2N = 18 * MiB, WS_LOGIT = 146 * MiB, WS_TOPE = 210 * MiB, WS_TOPW = 212 * MiB, WS_POS = 214 * MiB, WS_Y = 146 * MiB;
constexpr size_t WS_ROWL = 658 * MiB, WS_ROWW = 661 * MiB, WS_TILEE = 664 * MiB, WS_HS = 672 * MiB, WS_WEXP = 704 * MiB;
constexpr size_t WEXP_STRIDE = (size_t)(512 * 1024 + 1024 * 256);
constexpr float SW13 = 64.f, SW2 = 32.f, SHS = 8.f, SWIN = 32.f;
constexpr size_t WS_END = 1090 * MiB;
static_assert(WS_WEXP + 257 * WEXP_STRIDE <= WS_END && WS_Y + (size_t)NLAT * 8 * D <= WS_ROWL, "ws map");
constexpr int CW_BAR = 4096;
constexpr int CW_CNT = 16384;

constexpr int LDS_BYTES = 159744;
constexpr int LDS_MISC = LDS_BYTES - 64;

__device__ __forceinline__ unsigned f2bf(float f) { unsigned u = __builtin_bit_cast(unsigned, f); return (u + 0x7fffu + ((u >> 16) & 1u)) >> 16; }
typedef __bf16 bf16x2_t __attribute__((ext_vector_type(2)));
__device__ __forceinline__ unsigned cvtpk(float lo, float hi) { f32x2 v = {lo, hi}; return __builtin_bit_cast(unsigned, __builtin_convertvector(v, bf16x2_t)); }
__device__ __forceinline__ unsigned pk2(float lo, float hi) { return cvtpk(lo, hi); }
__device__ __forceinline__ unsigned pk4_fp8(float a, float b, float c, float d) { unsigned w = 0u;
    w = __builtin_amdgcn_cvt_pk_fp8_f32(__builtin_amdgcn_fmed3f(a, -448.f, 448.f), __builtin_amdgcn_fmed3f(b, -448.f, 448.f), w, false);
    w = __builtin_amdgcn_cvt_pk_fp8_f32(__builtin_amdgcn_fmed3f(c, -448.f, 448.f), __builtin_amdgcn_fmed3f(d, -448.f, 448.f), w, true); return w; }
__device__ __forceinline__ float bf2f(unsigned short b) { return __builtin_bit_cast(float, ((unsigned)b) << 16); }
__device__ __forceinline__ float bflo(unsigned w) { return __builtin_bit_cast(float, w << 16); }
__device__ __forceinline__ float bfhi(unsigned w) { return __builtin_bit_cast(float, w & 0xffff0000u); }
template <int CTRL> __device__ __forceinline__ float dpp_f(float v) { return __builtin_bit_cast(float, __builtin_amdgcn_update_dpp(0, __builtin_bit_cast(int, v), CTRL, 0xf, 0xf, false)); }
__device__ __forceinline__ float wave_sum(float v) {
    v += dpp_f<0x128>(v);
    v += dpp_f<0x124>(v);
    v += dpp_f<0x122>(v);
    v += dpp_f<0x121>(v);
    const int vi = __builtin_bit_cast(int, v);
    const float r0 = __builtin_bit_cast(float, __builtin_amdgcn_readlane(vi, 0)), r1 = __builtin_bit_cast(float, __builtin_amdgcn_readlane(vi, 16)),
                r2 = __builtin_bit_cast(float, __builtin_amdgcn_readlane(vi, 32)), r3 = __builtin_bit_cast(float, __builtin_amdgcn_readlane(vi, 48));
    return (r0 + r1) + (r2 + r3);
}
__device__ __forceinline__ float sigmoidf_(float x) { return __builtin_amdgcn_rcpf(1.f + __expf(-x)); }
__device__ __forceinline__ float siluf_(float x) { return x * __builtin_amdgcn_rcpf(1.f + __expf(-x)); }
__device__ __forceinline__ float softplusf_(float x) { return fmaxf(x, 0.f) + __logf(1.f + __expf(-fabsf(x))); }
__device__ __forceinline__ float tanhf_(float x) { const float e = __expf(-2.f * fabsf(x)); const float t = (1.f - e) * __builtin_amdgcn_rcpf(1.f + e); return x < 0.f ? -t : t; }

#define XB_TMO      128
#define XB_XCNT(j)  (256  + 64 * (j))
#define XB_XSUB(j)  (1280 + 64 * (j))
#define XB_XGEN(j)  (2304 + 64 * (j))
#define XB_TOP      3328
#define XB_TOPGEN   3392
#define XCD_BAR_WORDS 3456
#define XB_SPIN_CAP (1u << 22)
__device__ __forceinline__ unsigned xb_ld(unsigned* p)              { return __hip_atomic_load(p, __ATOMIC_RELAXED, __HIP_MEMORY_SCOPE_AGENT); }
__device__ __forceinline__ unsigned xb_add(unsigned* p, unsigned v) { return __hip_atomic_fetch_add(p, v, __ATOMIC_RELAXED, __HIP_MEMORY_SCOPE_AGENT); }
__device__ __forceinline__ unsigned xb_xcc_id() { return (unsigned)__builtin_amdgcn_s_getreg((3 << 11) | 20) & 0xFu; }
#define XB_SPIN(cond, bar) do { unsigned _sp = 0; while (cond) { __builtin_amdgcn_s_sleep(1); \
    if ((++_sp & 255u) == 0u) { if (xb_ld(&(bar)[XB_TMO])) break; if (_sp > XB_SPIN_CAP) { atomicAdd(&(bar)[XB_TMO], 1u); break; } } } } while (0)
struct XcdBarrier { unsigned* bar; unsigned x; volatile LAS unsigned* st; };
__device__ __forceinline__ XcdBarrier xcd_barrier_post(unsigned* bar, volatile LAS unsigned* st) {
    XcdBarrier b; b.bar = bar; b.x = xb_xcc_id(); b.st = st;
    if (threadIdx.x == 0) (void)xb_add(&bar[XB_XCNT(b.x)], 1u);
    return b;
}
__device__ __forceinline__ void xcd_barrier_complete(unsigned* bar, unsigned x, unsigned& nloc, unsigned& nx) {
    const unsigned G = gridDim.x * gridDim.y * gridDim.z;
    unsigned sum, cnt, mine, sp = 0u;
    for (;;) {
        sum = 0u; cnt = 0u; mine = 0u;
#pragma unroll
        for (unsigned j = 0; j < 16; ++j) { const unsigned c = xb_ld(&bar[XB_XCNT(j)]); sum += c; cnt += (c > 0u) ? 1u : 0u; mine = (j == x) ? c : mine; }
        if (sum == G) break;
        __builtin_amdgcn_s_sleep(1);
        if ((++sp & 255u) == 0u) { if (xb_ld(&bar[XB_TMO])) break; if (sp > XB_SPIN_CAP) { atomicAdd(&bar[XB_TMO], 1u); break; } }
    }
    nloc = mine > 0u ? mine : 1u; nx = cnt > 0u ? cnt : 1u;
}
__device__ __forceinline__ void xcd_barrier(const XcdBarrier& b) {
    asm volatile("s_waitcnt vmcnt(0)" ::: "memory");
    __syncthreads();
    if (threadIdx.x == 0) {
        unsigned* bar = b.bar;
        __builtin_amdgcn_s_waitcnt(0);
        unsigned nloc = b.st[0], nx = b.st[1];
        if (nloc == 0u) { xcd_barrier_complete(bar, b.x, nloc, nx); b.st[0] = nloc; b.st[1] = nx; }
        const unsigned old = xb_add(&bar[XB_XSUB(b.x)], 1u);
        const unsigned gen = old / nloc;
        if (old + 1u == (gen + 1u) * nloc) {
            __builtin_amdgcn_fence(__ATOMIC_RELEASE, "agent");
            asm volatile("s_waitcnt vmcnt(0)" ::: "memory");
            const unsigned og = xb_add(&bar[XB_TOP], 1u);
            const unsigned tg = og / nx;
            if (og + 1u == (tg + 1u) * nx) xb_add(&bar[XB_TOPGEN], 1u);
            else XB_SPIN(xb_ld(&bar[XB_TOPGEN]) == tg, bar);
            __builtin_amdgcn_fence(__ATOMIC_ACQUIRE, "agent");
            xb_add(&bar[XB_XGEN(b.x)], 1u);
            asm volatile("s_waitcnt vmcnt(0)" ::: "memory");
        } else {
            XB_SPIN(xb_ld(&bar[XB_XGEN(b.x)]) == gen, bar);
            __builtin_amdgcn_fence(__ATOMIC_ACQUIRE, "agent");
            asm volatile("s_waitcnt vmcnt(0)" ::: "memory");
        }
    }
    __syncthreads();
}

struct Args {
    const float* in[34];
    float* out;
    unsigned char* ws;
    int ph_lo, ph_hi;
};
enum { I_X = 0, I_C, I_CTX, I_CCTX, I_WADA, I_BADA, I_N1G, I_WIN, I_MU, I_W0, I_WUP, I_A0, I_AUP, I_GUP, I_KK, I_KA, I_RK, I_LNW, I_LNB,
       I_CONVW, I_ALOG, I_DTB, I_ONG, I_WOUT, I_N2G, I_RW, I_RB, I_EW1, I_EW3, I_EW2, I_SW1, I_SW3, I_SW2, I_FG };

namespace pg8 {
constexpr int BM = 256, BK = 64, HALF = 128, HTB = HALF * BK * 2, STAGE_BYTES = 8 * HTB, NXCD = 8, WGM = 8;
__host__ __device__ __forceinline__ int lds_byte(int r, int c) { const int st = (r >> 4) * 2 + (c >> 5), rr = r & 15, cc = c & 31, ob = rr * 64 + cc * 2; return st * 1024 + (ob ^ (((ob >> 9) & 1) << 5)); }
__host__ __device__ __forceinline__ void stage_rc(int b, int& R, int& C) { const int st = b / 1024, sb = b % 1024, swz = sb ^ (((sb >> 9) & 1) << 5); R = (st >> 1) * 16 + swz / 64; C = (st & 1) * 32 + (swz % 64) / 2; }
__host__ __device__ __forceinline__ int perm32(int rho) { const int n = rho >> 4, i = rho & 15; return 8 * (i >> 2) + 4 * n + (i & 3); }
struct Unit { int pm, pn; };
struct Gemm { const bf16_t* A; int K; };
struct StaticOrder {
    int nM, nN, nwg, G, c; const char* Bt; size_t tstepB;
    __device__ void init(int M, int N, int G_, int c_, const void* Bt_, int K, int es = 2) { nM = M / BM; nN = N / BM; nwg = nM * nN; G = G_; c = c_; Bt = (const char*)Bt_; tstepB = (size_t)BM * K * es; }
    __device__ bool next(int i, Unit& u) const {
        const long L = (long)i * G + c; if (L >= nwg) return false;
        int wgid = (int)L; { const int q = nwg / NXCD, r = nwg % NXCD, xcd = wgid % NXCD, off = wgid / NXCD; wgid = (xcd < r ? xcd * (q + 1) : r * (q + 1) + (xcd - r) * q) + off; }
        const int nig = WGM * nN, gid = wgid / nig, fm = gid * WGM, gsz = (nM - fm) < WGM ? (nM - fm) : WGM;
        u.pm = fm + ((wgid % nig) % gsz); u.pn = (wgid % nig) / gsz; return true;
    }
    __device__ __forceinline__ const char* bptr(const Unit& u) const { return Bt + (size_t)u.pn * tstepB; }
    __device__ __forceinline__ int rowsel(const Unit&, int) const { return 0; }
};
struct TileOrder {
    int nunits, npn, G, c; const int* tile_e; const char* wbase; size_t wstride, woff, tstepB; const int* rowl;
    __device__ bool next(int i, Unit& u) const { const int L = i * G + c; if (L >= nunits) return false; u.pm = L / npn; u.pn = L - u.pm * npn; return true; }
    __device__ __forceinline__ const char* bptr(const Unit& u) const { const int e = __builtin_amdgcn_readfirstlane(tile_e[u.pm]); return wbase + (size_t)e * wstride + woff + (size_t)u.pn * tstepB; }
    __device__ __forceinline__ int rowsel(const Unit& u, int r) const { const int t = rowl[(size_t)u.pm * 256 + r]; return t < 0 ? 0 : t; }
};
struct SeqOrder {
    int n; const char* Bt; size_t tstepB; const LAS int* rsel;
    __device__ bool next(int i, Unit& u) const { if (i >= n) return false; u.pm = 0; u.pn = i; return true; }
    __device__ __forceinline__ const char* bptr(const Unit& u) const { return Bt + (size_t)u.pn * tstepB; }
    __device__ __forceinline__ int rowsel(const Unit&, int r) const { return rsel[r]; }
};
__device__ __forceinline__ unsigned cvt_pk_bf16(float lo, float hi) { return cvtpk(lo, hi); }

template <class Epi, class Sched, bool GATHER, int A_AUX = 0, bool ALIGN = true, bool FP8 = false>
__device__ __forceinline__ void gemm_phase(lbyte* lds, const Gemm g, const Sched& S, const Epi& E) {
    int tid_ = threadIdx.x; asm volatile("" : "+v"(tid_));
    const int tid = tid_, wid = __builtin_amdgcn_readfirstlane(tid >> 6), lane = tid & 63, wr = wid >> 2, wc = wid & 3, fr = lane & 15, fq = lane >> 4;
    constexpr unsigned ES = FP8 ? 1u : 2u;
    const int K = g.K, nt = FP8 ? K / 128 : K / BK;
    Unit cur, nxt; int ui = 0;
    if (!S.next(0, cur)) return;
    int Rst[2], Cst[2];
    unsigned voffA[2], voffA1[2], voffB[2], nvA[2], nvA1[2];
#pragma unroll
    for (int i = 0; i < 2; ++i) { int R, C; stage_rc(tid * 16 + i * 8192, R, C); const int Rb = Epi::PERM ? ((R & ~31) + perm32(R & 31)) : R; Rst[i] = R; Cst[i] = C;
        if (GATHER) { voffA[i] = (unsigned)S.rowsel(cur, R) * (unsigned)K * ES + (unsigned)C * 2u; voffA1[i] = (unsigned)S.rowsel(cur, 128 + R) * (unsigned)K * ES + (unsigned)C * 2u; }
        else { voffA[i] = (unsigned)(R * K) * ES + (unsigned)C * 2u; voffA1[i] = voffA[i]; }
        nvA[i] = voffA[i]; nvA1[i] = voffA1[i];
        voffB[i] = (unsigned)(Rb * K) * ES + (unsigned)C * 2u; }
    const size_t kstep = (size_t)(BK * 2);
    const size_t hstep = (size_t)HALF * K * ES;
    const size_t hstepA = GATHER ? 0 : hstep;
    const size_t tstep = 2 * hstep;
    const unsigned ldsw = (unsigned)wid * 1024u;
    const int aoff = lds_byte(wr * 64 + fr, FP8 ? fq * 16 : fq * 8), boff = lds_byte(wc * 32 + fr, FP8 ? fq * 16 : fq * 8);
#define PG8_SA(b, h) (((b) * 2 + (h)) * HTB)
#define PG8_SB(b, h) ((4 + (b) * 2 + (h)) * HTB)
#define PG8_STAGE2(bufoff, gbase, v0, v1) do { \
        __builtin_amdgcn_global_load_lds((const unsigned*)((const char*)(gbase) + (v0)), (LAS unsigned*)(lds + (bufoff) + ldsw), 16, 0, 0); \
        __builtin_amdgcn_global_load_lds((const unsigned*)((const char*)(gbase) + (v1)), (LAS unsigned*)(lds + (bufoff) + ldsw + 8192), 16, 0, 0); } while (0)
#define PG8_STAGE2A(bufoff, gbase, v0, v1) do { if constexpr (A_AUX == 16) { \
        __builtin_amdgcn_global_load_lds((const unsigned*)((const char*)(gbase) + (v0)), (LAS unsigned*)(lds + (bufoff) + ldsw), 16, 0, 16); \
        __builtin_amdgcn_global_load_lds((const unsigned*)((const char*)(gbase) + (v1)), (LAS unsigned*)(lds + (bufoff) + ldsw + 8192), 16, 0, 16); } else { PG8_STAGE2(bufoff, gbase, v0, v1); } } while (0)
#define PG8_STAGE(bufoff, gbase, voff) PG8_STAGE2(bufoff, gbase, (voff)[0], (voff)[1])
#define PG8_STAGEA(bufoff, gbase, voff) PG8_STAGE2A(bufoff, gbase, (voff)[0], (voff)[1])
#define G_LD32(p) __builtin_shufflevector(*(const LAS i32x4*)(p), *(const LAS i32x4*)((p) + 16), 0, 1, 2, 3, 4, 5, 6, 7)
#define G_MFMA8(c, a, b) asm volatile("v_mfma_scale_f32_16x16x128_f8f6f4 %0, %1, %2, %0, %3, %3 op_sel_hi:[0,0,0]" : "+v"(c) : "v"(a), "v"(b), "v"(one_scale))
#define PG8_LDA(dst, b, h) do { if constexpr (FP8) { _Pragma("unroll") for (int m = 0; m < 4; ++m) dst##8[m] = G_LD32(lds + PG8_SA(b, h) + aoff + m * 2048); } else { \
        _Pragma("unroll") for (int m = 0; m < 4; ++m) _Pragma("unroll") for (int k = 0; k < 2; ++k) dst[m][k] = *(const LAS bf16x8*)(lds + PG8_SA(b, h) + aoff + m * 2048 + k * 1024); } } while (0)
#define PG8_LDB(dst, b, h) do { if constexpr (FP8) { _Pragma("unroll") for (int n = 0; n < 2; ++n) dst##8[n] = G_LD32(lds + PG8_SB(b, h) + boff + n * 2048); } else { \
        _Pragma("unroll") for (int n = 0; n < 2; ++n) _Pragma("unroll") for (int k = 0; k < 2; ++k) dst[n][k] = *(const LAS bf16x8*)(lds + PG8_SB(b, h) + boff + n * 2048 + k * 1024); } } while (0)
#define PG8_MMA(ai, bj, At, Bt) do { __builtin_amdgcn_s_setprio(1); if constexpr (FP8) { _Pragma("unroll") for (int m = 0; m < 4; ++m) _Pragma("unroll") for (int n = 0; n < 2; ++n) G_MFMA8(acc[ai][bj][m][n], Bt##8[n], At##8[m]); } else { \
        _Pragma("unroll") for (int m = 0; m < 4; ++m) _Pragma("unroll") for (int n = 0; n < 2; ++n) _Pragma("unroll") for (int k = 0; k < 2; ++k) \
        acc[ai][bj][m][n] = __builtin_amdgcn_mfma_f32_16x16x32_bf16(Bt[n][k], At[m][k], acc[ai][bj][m][n], 0, 0, 0); } __builtin_amdgcn_s_setprio(0); } while (0)
#define PG8_WAIT_V(n) asm volatile("s_waitcnt vmcnt(" #n ")" ::: "memory")
#define PG8_WAIT_L(n) asm volatile("s_waitcnt lgkmcnt(" #n ")" ::: "memory")
#define PG8_BAR __builtin_amdgcn_s_barrier()
#define PG8_SCHED __builtin_amdgcn_sched_barrier(0)
    f32x4 acc[2][2][4][2];
#pragma unroll
    for (int a = 0; a < 2; ++a)
#pragma unroll
        for (int b = 0; b < 2; ++b)
#pragma unroll
            for (int m = 0; m < 4; ++m)
#pragma unroll
                for (int n = 0; n < 2; ++n) acc[a][b][m][n] = (f32x4){0.f, 0.f, 0.f, 0.f};
    bf16x8 At[4][2], B0[2][2], B1[2][2]; i32x8 At8[4], B08[2], B18[2];
    int one_scale = 0x7F7F7F7F; asm volatile("" : "+v"(one_scale));
    const char* cA = (const char*)g.A + (GATHER ? (size_t)0 : (size_t)cur.pm * tstep); const char* cB = S.bptr(cur);
    PG8_STAGE(PG8_SB(0, 0), cB, voffB); PG8_STAGE(PG8_SB(0, 1), cB + hstep, voffB); PG8_STAGEA(PG8_SA(0, 0), cA, voffA); PG8_STAGEA(PG8_SA(0, 1), cA + hstepA, voffA1);
    if (wr == 1) PG8_BAR;
    PG8_WAIT_V(2); PG8_BAR;
    PG8_STAGE(PG8_SB(1, 0), cB + kstep, voffB); PG8_STAGEA(PG8_SA(1, 0), cA + kstep, voffA); PG8_STAGE(PG8_SB(1, 1), cB + hstep + kstep, voffB);
    PG8_WAIT_V(6); PG8_BAR;
    for (;;) {
        const bool has_next = S.next(ui + 1, nxt);
        const char* nA = has_next ? (const char*)g.A + (GATHER ? (size_t)0 : (size_t)nxt.pm * tstep) : cA; const char* nB = has_next ? S.bptr(nxt) : cB;
        for (int t = 0; t < nt; t += 2) {
            const bool last = (t == nt - 2);
            const char* a1 = cA + (size_t)(t + 1) * kstep;
            const char* a2 = last ? nA : cA + (size_t)(t + 2) * kstep; const char* b2 = last ? nB : cB + (size_t)(t + 2) * kstep;
            const char* a3 = a2 + kstep; const char* b3 = b2 + kstep;
            if (GATHER && last && has_next) {
#pragma unroll
                for (int i = 0; i < 2; ++i) { nvA[i] = (unsigned)S.rowsel(nxt, Rst[i]) * (unsigned)K * ES + (unsigned)Cst[i] * 2u; nvA1[i] = (unsigned)S.rowsel(nxt, 128 + Rst[i]) * (unsigned)K * ES + (unsigned)Cst[i] * 2u; }
            }
            const unsigned x0 = (GATHER && last) ? nvA[0] : voffA[0], x1 = (GATHER && last) ? nvA[1] : voffA[1];
            const unsigned y0 = (GATHER && last) ? nvA1[0] : voffA1[0], y1 = (GATHER && last) ? nvA1[1] : voffA1[1];
            PG8_LDB(B0, 0, 0); PG8_LDB(B1, 0, 1); PG8_SCHED; PG8_LDA(At, 0, 0); PG8_STAGEA(PG8_SA(1, 1), a1 + hstepA, voffA1);
            PG8_WAIT_V(8); PG8_WAIT_L(0); PG8_BAR; PG8_MMA(0, 0, At, B0); PG8_MMA(0, 1, At, B1); PG8_BAR; PG8_SCHED;
            PG8_LDA(At, 0, 1); PG8_STAGE(PG8_SB(0, 0), b2, voffB); PG8_STAGE(PG8_SB(0, 1), b2 + hstep, voffB); PG8_STAGE2A(PG8_SA(0, 0), a2, x0, x1);
            PG8_WAIT_V(8); PG8_WAIT_L(0); PG8_BAR; PG8_MMA(1, 0, At, B0); PG8_MMA(1, 1, At, B1); PG8_BAR; PG8_SCHED;
            PG8_LDB(B0, 1, 0); PG8_LDB(B1, 1, 1); PG8_SCHED; PG8_LDA(At, 1, 0); PG8_STAGE2A(PG8_SA(0, 1), a2 + hstepA, y0, y1);
            PG8_WAIT_V(8); PG8_WAIT_L(0); PG8_BAR; PG8_MMA(0, 0, At, B0); PG8_MMA(0, 1, At, B1); PG8_BAR; PG8_SCHED;
            PG8_LDA(At, 1, 1); PG8_STAGE(PG8_SB(1, 0), b3, voffB); PG8_STAGE(PG8_SB(1, 1), b3 + hstep, voffB); PG8_STAGE2A(PG8_SA(1, 0), a3, x0, x1);
            PG8_WAIT_V(8); PG8_WAIT_L(0); PG8_BAR; PG8_MMA(1, 0, At, B0); PG8_MMA(1, 1, At, B1); PG8_BAR; PG8_SCHED;
        }
        if (ALIGN && wr == 0) PG8_BAR;
        if constexpr (FP8) asm volatile("s_nop 15\n\ts_nop 15" ::: "memory");
        E(acc, cur, wr, wc, fr, fq);
        if (!has_next) break;
#pragma unroll
        for (int a = 0; a < 2; ++a)
#pragma unroll
            for (int b = 0; b < 2; ++b)
#pragma unroll
                for (int m = 0; m < 4; ++m)
#pragma unroll
                    for (int n = 0; n < 2; ++n) acc[a][b][m][n] = (f32x4){0.f, 0.f, 0.f, 0.f};
        cur = nxt; cA = nA; cB = nB; ++ui;
        if (GATHER) { voffA[0] = nvA[0]; voffA[1] = nvA[1]; voffA1[0] = nvA1[0]; voffA1[1] = nvA1[1]; }
        if (ALIGN && wr == 1) PG8_BAR;
    }
    PG8_WAIT_V(0);
    if (!ALIGN && wr == 0) PG8_BAR;
    PG8_BAR;
#undef PG8_SA
#undef PG8_SB
#undef PG8_STAGE
#undef PG8_STAGE2
#undef PG8_STAGE2A
#undef PG8_STAGEA
#undef G_LD32
#undef G_MFMA8
#undef PG8_LDA
#undef PG8_LDB
#undef PG8_MMA
#undef PG8_WAIT_V
#undef PG8_WAIT_L
#undef PG8_BAR
#undef PG8_SCHED
}

struct EpiBf16 {
    static constexpr bool PERM = true;
    bf16_t* O; int ldc; float scale;
    __device__ __forceinline__ void operator()(const f32x4 (&acc)[2][2][4][2], const Unit& u, int wr, int wc, int fr, int fq) const {
        const int row0 = u.pm * BM + wr * 64 + fr; const int col0 = u.pn * BM + wc * 32 + 8 * fq;
#pragma unroll
        for (int ai = 0; ai < 2; ++ai)
#pragma unroll
            for (int m = 0; m < 4; ++m) { bf16_t* rowp = O + (size_t)(row0 + ai * HALF + m * 16) * ldc + col0;
#pragma unroll
                for (int bj = 0; bj < 2; ++bj) { const f32x4 v0 = acc[ai][bj][m][0] * scale, v1 = acc[ai][bj][m][1] * scale;
                    u32x4 w; w.x = cvt_pk_bf16(v0[0], v0[1]); w.y = cvt_pk_bf16(v0[2], v0[3]); w.z = cvt_pk_bf16(v1[0], v1[1]); w.w = cvt_pk_bf16(v1[2], v1[3]);
                    *(u32x4*)(rowp + bj * HALF) = w; } }
    }
};
struct EpiF32 {
    static constexpr bool PERM = false;
    float* C; int ldc;
    __device__ __forceinline__ void operator()(const f32x4 (&acc)[2][2][4][2], const Unit& u, int wr, int wc, int fr, int fq) const {
        const int row0 = u.pm * BM + wr * 64 + fr, col0 = u.pn * BM + wc * 32 + 4 * fq;
#pragma unroll
        for (int ai = 0; ai < 2; ++ai)
#pragma unroll
            for (int m = 0; m < 4; ++m) { float* rowp = C + (size_t)(row0 + ai * HALF + m * 16) * ldc + col0;
#pragma unroll
                for (int bj = 0; bj < 2; ++bj)
#pragma unroll
                    for (int n = 0; n < 2; ++n) *(f32x4*)(rowp + bj * HALF + n * 16) = acc[ai][bj][m][n]; }
    }
};
struct EpiResGate {
    static constexpr bool PERM = false;
    const float* x; float* out; const float* mod; int gate_off;
    __device__ __forceinline__ void operator()(const f32x4 (&acc)[2][2][4][2], const Unit& u, int wr, int wc, int fr, int fq) const {
        const int row0 = u.pm * BM + wr * 64 + fr, col0 = u.pn * BM + wc * 32 + 4 * fq;
        const float* gp = mod + (size_t)((u.pm * BM) >> 11) * MODW + gate_off + col0;
        f32x4 gv[2][2];
#pragma unroll
        for (int bj = 0; bj < 2; ++bj)
#pragma unroll
            for (int n = 0; n < 2; ++n) gv[bj][n] = *(const f32x4*)(gp + bj * HALF + n * 16);
#pragma unroll
        for (int ai = 0; ai < 2; ++ai)
#pragma unroll
            for (int m = 0; m < 4; ++m) { const size_t off = (size_t)(row0 + ai * HALF + m * 16) * D + col0;
#pragma unroll
                for (int bj = 0; bj < 2; ++bj)
#pragma unroll
                    for (int n = 0; n < 2; ++n) { const f32x4 xv = *(const f32x4*)(x + off + bj * HALF + n * 16);
                        *(f32x4*)(out + off + bj * HALF + n * 16) = xv + gv[bj][n] * acc[ai][bj][m][n]; }
                asm volatile("" ::: "memory"); }
    }
};
struct EpiGLU {
    static constexpr bool PERM = true;
    bf16_t* H;
    __device__ __forceinline__ void operator()(const f32x4 (&acc)[2][2][4][2], const Unit& u, int wr, int wc, int fr, int fq) const {
        const int row0 = u.pm * BM + wr * 64 + fr; const int col0 = u.pn * 128 + wc * 32 + 8 * fq;
#pragma unroll
        for (int ai = 0; ai < 2; ++ai)
#pragma unroll
            for (int m = 0; m < 4; ++m) { bf16_t* rowp = H + (size_t)(row0 + ai * HALF + m * 16) * 256 + col0;
                f32x4 h0, h1;
#pragma unroll
                for (int j = 0; j < 4; ++j) { const float a0 = acc[ai][0][m][0][j], a1 = acc[ai][0][m][1][j];
                    h0[j] = siluf_(a0) * acc[ai][1][m][0][j]; h1[j] = siluf_(a1) * acc[ai][1][m][1][j]; }
                u32x4 w; w.x = cvt_pk_bf16(h0[0], h0[1]); w.y = cvt_pk_bf16(h0[2], h0[3]); w.z = cvt_pk_bf16(h1[0], h1[1]); w.w = cvt_pk_bf16(h1[2], h1[3]);
                *(u32x4*)rowp = w; }
    }
};
constexpr float YSCALE = 8.f;
struct EpiY {
    static constexpr bool PERM = true;
    unsigned char* Y; float* out; const float* mod; const LAS int* rtok; const LAS float* rw; int shared;
    __device__ __forceinline__ void operator()(const f32x4 (&acc)[2][2][4][2], const Unit& u, int wr, int wc, int fr, int fq) const {
        const int col0 = u.pn * BM + wc * 32 + 8 * fq;
#pragma unroll
        for (int ai = 0; ai < 2; ++ai)
#pragma unroll
            for (int m = 0; m < 4; ++m) { const int r = wr * 64 + fr + ai * HALF + m * 16; const int ts = rtok[r]; const float w = rw[r];
                if (ts >= 0) {
                    if (shared) { const unsigned goff = (unsigned)(ts >> 11) * MODW + 5 * D + col0; const unsigned ooff = (unsigned)ts * D + col0;
#pragma unroll
                        for (int bj = 0; bj < 2; ++bj)
#pragma unroll
                            for (int n = 0; n < 2; ++n) { const f32x4 gv = *(const f32x4*)(mod + goff + bj * HALF + n * 4); f32x4* op = (f32x4*)(out + ooff + bj * HALF + n * 4);
                                *op = *op + gv * acc[ai][bj][m][n]; }
                    } else { unsigned char* yp = Y + (size_t)(unsigned)ts * D + col0; const float ws_ = w * YSCALE;
#pragma unroll
                        for (int bj = 0; bj < 2; ++bj) { f32x4 v0 = acc[ai][bj][m][0] * ws_, v1 = acc[ai][bj][m][1] * ws_;
#pragma unroll
                                for (int j = 0; j < 4; ++j) { v0[j] = __builtin_amdgcn_fmed3f(v0[j], -448.f, 448.f); v1[j] = __builtin_amdgcn_fmed3f(v1[j], -448.f, 448.f); }
                            unsigned lo = 0u, hi = 0u;
                            lo = __builtin_amdgcn_cvt_pk_fp8_f32(v0[0], v0[1], lo, false); lo = __builtin_amdgcn_cvt_pk_fp8_f32(v0[2], v0[3], lo, true);
                            hi = __builtin_amdgcn_cvt_pk_fp8_f32(v1[0], v1[1], hi, false); hi = __builtin_amdgcn_cvt_pk_fp8_f32(v1[2], v1[3], hi, true);
                            u32x2 pk; pk.x = lo; pk.y = hi; *(u32x2*)(yp + bj * HALF) = pk; } } }
                asm volatile("" ::: "memory"); }
    }
};

struct MoeCtx {
    int ntiles, nrt, G, vc;
    const LAS int* tb; LAS int* tbl;
    const unsigned* cnt; const int* rowl; const float* roww;
    const char* wexp; const char* h2n; char* Hs; unsigned char* Y; float* out; const float* mod; int dry_shared;
};
__device__ __forceinline__ void gemm_moe(lbyte* lds, const MoeCtx& M) {
    int tid_ = threadIdx.x; asm volatile("" : "+v"(tid_));
    const int tid = tid_, wid = __builtin_amdgcn_readfirstlane(tid >> 6), lane = tid & 63, wr = wid >> 2, wc = wid & 3, fr = lane & 15, fq = lane >> 4;
    const int ntl = (M.ntiles - M.vc + M.G - 1) / M.G;
    if (M.vc >= M.ntiles) return;
    const int nunits = ntl * 6;
    const unsigned ldsw = (unsigned)wid * 1024u;
    const int aoff = lds_byte(wr * 64 + fr, fq * 16), boff = lds_byte(wc * 32 + fr, fq * 16);
    auto tile_expert = [&](int tile, int& e, int& k) { if (tile < M.nrt) { int lo = 0, hi = NE - 1; while (lo < hi) { const int mid = (lo + hi + 1) >> 1; if (M.tb[mid] <= tile) lo = mid; else hi = mid - 1; } e = lo; k = tile - M.tb[lo]; } else { e = NE; k = tile - M.nrt; } };
    auto fill = [&](int j) { if (j < ntl && tid < 256) { const int tile = M.vc + j * M.G; int e, k; tile_expert(tile, e, k); LAS int* T = M.tbl + (j % 3) * 768;
            int ts; float w;
            if (e < NE) { const int valid = (int)M.cnt[e] - 256 * k; if (tid < valid) { ts = M.rowl[(size_t)tile * 256 + tid]; w = M.roww[(size_t)tile * 256 + tid]; } else { ts = -1; w = 0.f; } T[tid] = ts < 0 ? 0 : (ts >> 3); }
            else { ts = k * 256 + tid; w = 1.f; T[tid] = ts; }
            T[256 + tid] = ts; ((LAS float*)T)[512 + tid] = w; } };
    struct UP { const char* aB; const char* bB; unsigned bh; int nt, kind, pn, slot, shared, e, hbuf, fillnext; };
    auto unit_params = [&](int ui, int prev_e, UP& u, unsigned (&oa)[4], unsigned (&ob)[2]) {
        int tq = threadIdx.x; asm volatile("" : "+v"(tq));
        int Rst[2], Cst[2], Rbp[2];
#pragma unroll
        for (int i = 0; i < 2; ++i) { int R, C; stage_rc(tq * 16 + i * 8192, R, C); Rst[i] = R; Cst[i] = C; Rbp[i] = (R & ~31) + perm32(R & 31); }
        int j, sub;
        if (ui < 2) { j = 0; sub = ui; }
        else { const int qq = ui - 2, g = qq / 6, r = qq - 6 * g; if (g < ntl - 1 && r < 2) { j = g + 1; sub = r; } else { j = g; sub = (g < ntl - 1) ? r : r + 2; } }
        const int tile = M.vc + j * M.G; int e, k;
        if (sub == 0 || sub == 2) tile_expert(tile, e, k); else e = prev_e;
        u.e = e;
        const char* w = M.wexp + (size_t)e * WEXP_STRIDE;
        u.slot = j % 3; u.hbuf = j & 1; u.fillnext = (sub == 1) ? j + 1 : -1; u.shared = (e == NE) ? 1 : 0;
        if (sub < 2) { u.kind = 0; u.pn = sub; u.nt = D / 128; u.aB = M.h2n; u.bB = w + (size_t)sub * 256 * D; u.bh = 128u * D;
            const LAS int* T = M.tbl + (j % 3) * 768;
#pragma unroll
            for (int i = 0; i < 2; ++i) { oa[i] = (unsigned)T[Rst[i]] * (unsigned)D + 2u * (unsigned)Cst[i]; oa[2 + i] = (unsigned)T[128 + Rst[i]] * (unsigned)D + 2u * (unsigned)Cst[i]; ob[i] = (unsigned)(Rbp[i] * D + 2 * Cst[i]); } }
        else { u.kind = 1; u.pn = sub - 2; u.nt = DE / 128; u.aB = M.Hs + (j & 1) * 65536; u.bB = w + (size_t)512 * 1024 + (size_t)(sub - 2) * 256 * DE; u.bh = 128u * DE;
#pragma unroll
            for (int i = 0; i < 2; ++i) { oa[i] = (unsigned)(Rst[i] * DE + 2 * Cst[i]); oa[2 + i] = (unsigned)((128 + Rst[i]) * DE + 2 * Cst[i]); ob[i] = (unsigned)(Rbp[i] * DE + 2 * Cst[i]); } }
    };
#define PG8_SA(b, h) (((b) * 2 + (h)) * HTB)
#define PG8_SB(b, h) ((4 + (b) * 2 + (h)) * HTB)
#define MOE_DMA(bufoff, ptr, aux) __builtin_amdgcn_global_load_lds((const unsigned*)(ptr), (LAS unsigned*)(lds + (bufoff)), 16, 0, aux)
#define MOE_STA(bufoff, base, o0, o1) do { MOE_DMA((bufoff) + ldsw, (base) + (o0), 16); MOE_DMA((bufoff) + ldsw + 8192, (base) + (o1), 16); } while (0)
#define MOE_STAK(kindv, bufoff, base, o0, o1) do { if ((kindv) == 0) { MOE_DMA((bufoff) + ldsw, (base) + (o0), 0); MOE_DMA((bufoff) + ldsw + 8192, (base) + (o1), 0); } else MOE_STA(bufoff, base, o0, o1); } while (0)
#define MOE_STB(bufoff, base, o0, o1) do { MOE_DMA((bufoff) + ldsw, (base) + (o0), 0); MOE_DMA((bufoff) + ldsw + 8192, (base) + (o1), 0); } while (0)
#define MOE_LD32(p) __builtin_shufflevector(*(const LAS i32x4*)(p), *(const LAS i32x4*)((p) + 16), 0, 1, 2, 3, 4, 5, 6, 7)
#define PG8_LDA(dst, b, h) do { _Pragma("unroll") for (int m = 0; m < 4; ++m) dst[m] = MOE_LD32(lds + PG8_SA(b, h) + aoff + m * 2048); } while (0)
#define PG8_LDB(dst, b, h) do { _Pragma("unroll") for (int n = 0; n < 2; ++n) dst[n] = MOE_LD32(lds + PG8_SB(b, h) + boff + n * 2048); } while (0)
#define MOE_MFMA(c, a, b) asm volatile("v_mfma_scale_f32_16x16x128_f8f6f4 %0, %1, %2, %0, %3, %3 op_sel_hi:[0,0,0]" : "+v"(c) : "v"(a), "v"(b), "v"(one_scale))
#define PG8_MMA(ai, bj, At, Bt) do { __builtin_amdgcn_s_setprio(1); _Pragma("unroll") for (int m = 0; m < 4; ++m) _Pragma("unroll") for (int n = 0; n < 2; ++n) \
        MOE_MFMA(acc[ai][bj][m][n], Bt[n], At[m]); __builtin_amdgcn_s_setprio(0); } while (0)
#define PG8_WAIT_V(n) asm volatile("s_waitcnt vmcnt(" #n ")" ::: "memory")
#define PG8_WAIT_L(n) asm volatile("s_waitcnt lgkmcnt(" #n ")" ::: "memory")
#define PG8_BAR __builtin_amdgcn_s_barrier()
#define PG8_SCHED __builtin_amdgcn_sched_barrier(0)
    fill(0);
    asm volatile("s_waitcnt vmcnt(0) lgkmcnt(0)" ::: "memory");
    __syncthreads();
    UP cu, nu; unsigned oa[4], ob[2], na[4], nb[2];
    unit_params(0, 0, cu, oa, ob);
    nu = cu;
#pragma unroll
    for (int i = 0; i < 4; ++i) na[i] = oa[i];
    nb[0] = ob[0]; nb[1] = ob[1];
    f32x4 acc[2][2][4][2];
#pragma unroll
    for (int a = 0; a < 2; ++a)
#pragma unroll
        for (int b = 0; b < 2; ++b)
#pragma unroll
            for (int m = 0; m < 4; ++m)
#pragma unroll
                for (int n = 0; n < 2; ++n) acc[a][b][m][n] = (f32x4){0.f, 0.f, 0.f, 0.f};
    i32x8 At[4], B0[2], B1[2];
    int one_scale = 0x7F7F7F7F; asm volatile("" : "+v"(one_scale));
    const size_t kstep = (size_t)128;
    {   const char* cA = cu.aB; const char* cB = cu.bB;
        MOE_STB(PG8_SB(0, 0), cB, ob[0], ob[1]); MOE_STB(PG8_SB(0, 1), cB + cu.bh, ob[0], ob[1]); MOE_STAK(cu.kind, PG8_SA(0, 0), cA, oa[0], oa[1]); MOE_STAK(cu.kind, PG8_SA(0, 1), cA, oa[2], oa[3]);
        if (wr == 1) PG8_BAR;
        PG8_WAIT_V(2); PG8_BAR;
        MOE_STB(PG8_SB(1, 0), cB + kstep, ob[0], ob[1]); MOE_STAK(cu.kind, PG8_SA(1, 0), cA + kstep, oa[0], oa[1]); MOE_STB(PG8_SB(1, 1), cB + cu.bh + kstep, ob[0], ob[1]);
        PG8_WAIT_V(6); PG8_BAR; }
    for (int ui = 0;; ++ui) {
        const bool has_next = (ui + 1 < nunits);
        if (cu.fillnext >= 0) fill(cu.fillnext);
        const char* cA = cu.aB; const char* cB = cu.bB; const int nt = cu.nt; const unsigned bh = cu.bh;
        for (int t = 0; t < nt; t += 2) {
            const bool last = (t == nt - 2);
            if (last && has_next) unit_params(ui + 1, cu.e, nu, na, nb);
            const char* a1 = cA + (size_t)(t + 1) * kstep;
            const char* a2 = last ? nu.aB : cA + (size_t)(t + 2) * kstep; const char* b2 = last ? nu.bB : cB + (size_t)(t + 2) * kstep;
            const char* a3 = a2 + kstep; const char* b3 = b2 + kstep;
            const unsigned bh2 = last ? nu.bh : bh;
            const unsigned x0 = last ? na[0] : oa[0], x1 = last ? na[1] : oa[1], y0 = last ? na[2] : oa[2], y1 = last ? na[3] : oa[3];
            const unsigned z0 = last ? nb[0] : ob[0], z1 = last ? nb[1] : ob[1];
            const int k2 = last ? nu.kind : cu.kind;
            PG8_LDB(B0, 0, 0); PG8_LDB(B1, 0, 1); PG8_SCHED; PG8_LDA(At, 0, 0); MOE_STAK(cu.kind, PG8_SA(1, 1), a1, oa[2], oa[3]);
            PG8_WAIT_V(8); PG8_WAIT_L(0); PG8_BAR; PG8_MMA(0, 0, At, B0); PG8_MMA(0, 1, At, B1); PG8_BAR; PG8_SCHED;
            PG8_LDA(At, 0, 1); MOE_STB(PG8_SB(0, 0), b2, z0, z1); MOE_STB(PG8_SB(0, 1), b2 + bh2, z0, z1); MOE_STAK(k2, PG8_SA(0, 0), a2, x0, x1);
            PG8_WAIT_V(8); PG8_WAIT_L(0); PG8_BAR; PG8_MMA(1, 0, At, B0); PG8_MMA(1, 1, At, B1); PG8_BAR; PG8_SCHED;
            PG8_LDB(B0, 1, 0); PG8_LDB(B1, 1, 1); PG8_SCHED; PG8_LDA(At, 1, 0); MOE_STAK(k2, PG8_SA(0, 1), a2, y0, y1);
            PG8_WAIT_V(8); PG8_WAIT_L(0); PG8_BAR; PG8_MMA(0, 0, At, B0); PG8_MMA(0, 1, At, B1); PG8_BAR; PG8_SCHED;
            PG8_LDA(At, 1, 1); MOE_STB(PG8_SB(1, 0), b3, z0, z1); MOE_STB(PG8_SB(1, 1), b3 + bh2, z0, z1); MOE_STAK(k2, PG8_SA(1, 0), a3, x0, x1);
            PG8_WAIT_V(8); PG8_WAIT_L(0); PG8_BAR; PG8_MMA(1, 0, At, B0); PG8_MMA(1, 1, At, B1); PG8_BAR; PG8_SCHED;
        }
        if (wr == 0) PG8_BAR;
        asm volatile("s_nop 15\n\ts_nop 15" ::: "memory");
        if (cu.kind == 0) {
            const int row0 = wr * 64 + fr; const int col0 = cu.pn * 128 + wc * 32 + 8 * fq;
            constexpr float is13 = 1.f / SW13;
#pragma unroll
            for (int ai = 0; ai < 2; ++ai)
#pragma unroll
                for (int m = 0; m < 4; ++m) { unsigned char* rowp = (unsigned char*)M.Hs + cu.hbuf * 65536 + (size_t)(row0 + ai * HALF + m * 16) * 256 + col0;
                    f32x4 h0, h1;
#pragma unroll
                    for (int j = 0; j < 4; ++j) { h0[j] = siluf_(acc[ai][0][m][0][j] * is13) * (acc[ai][1][m][0][j] * (is13 * SHS)); h1[j] = siluf_(acc[ai][0][m][1][j] * is13) * (acc[ai][1][m][1][j] * (is13 * SHS)); }
                    u32x2 w; w.x = pk4_fp8(h0[0], h0[1], h0[2], h0[3]); w.y = pk4_fp8(h1[0], h1[1], h1[2], h1[3]);
                    *(u32x2*)rowp = w; }
        } else {
            const LAS int* rtok = M.tbl + cu.slot * 768 + 256; const LAS float* rw = (const LAS float*)(M.tbl + cu.slot * 768 + 512);
            const int col0 = cu.pn * BM + wc * 32 + 8 * fq;
#pragma unroll
            for (int ai = 0; ai < 2; ++ai)
#pragma unroll
                for (int m = 0; m < 4; ++m) { const int r = wr * 64 + fr + ai * HALF + m * 16; const int ts = rtok[r]; const float w = rw[r];
                    if (ts >= 0) {
                        if (cu.shared) { const unsigned goff = (unsigned)(ts >> 11) * MODW + 5 * D + col0; const unsigned ooff = (unsigned)ts * D + col0;
#pragma unroll
                            for (int bj = 0; bj < 2; ++bj)
#pragma unroll
                                for (int n = 0; n < 2; ++n) { const f32x4 gv = *(const f32x4*)(M.mod + goff + bj * HALF + n * 4); f32x4* op = (f32x4*)(M.out + ooff + bj * HALF + n * 4);
                                    const f32x4 nv = *op + gv * acc[ai][bj][m][n] * (1.f / (SHS * SW2)); if (!M.dry_shared) *op = nv; else asm volatile("" :: "v"(nv)); }
                        } else { unsigned char* yp = M.Y + (size_t)(unsigned)ts * D + col0; const float ws_ = w * (YSCALE / (SHS * SW2));
#pragma unroll
                            for (int bj = 0; bj < 2; ++bj) { f32x4 v0 = acc[ai][bj][m][0] * ws_, v1 = acc[ai][bj][m][1] * ws_;
#pragma unroll
                                for (int j = 0; j < 4; ++j) { v0[j] = __builtin_amdgcn_fmed3f(v0[j], -448.f, 448.f); v1[j] = __builtin_amdgcn_fmed3f(v1[j], -448.f, 448.f); }
                                unsigned lo = 0u, hi = 0u;
                                lo = __builtin_amdgcn_cvt_pk_fp8_f32(v0[0], v0[1], lo, false); lo = __builtin_amdgcn_cvt_pk_fp8_f32(v0[2], v0[3], lo, true);
                                hi = __builtin_amdgcn_cvt_pk_fp8_f32(v1[0], v1[1], hi, false); hi = __builtin_amdgcn_cvt_pk_fp8_f32(v1[2], v1[3], hi, true);
                                u32x2 pk; pk.x = lo; pk.y = hi; *(u32x2*)(yp + bj * HALF) = pk; } } }
                    asm volatile("" ::: "memory"); }
        }
        if (!has_next) break;
#pragma unroll
        for (int a = 0; a < 2; ++a)
#pragma unroll
            for (int b = 0; b < 2; ++b)
#pragma unroll
                for (int m = 0; m < 4; ++m)
#pragma unroll
                    for (int n = 0; n < 2; ++n) acc[a][b][m][n] = (f32x4){0.f, 0.f, 0.f, 0.f};
        cu = nu;
#pragma unroll
        for (int i = 0; i < 4; ++i) oa[i] = na[i];
        ob[0] = nb[0]; ob[1] = nb[1];
        if (wr == 1) PG8_BAR;
    }
    PG8_WAIT_V(0);
    PG8_BAR;
#undef PG8_SA
#undef PG8_SB
#undef MOE_DMA
#undef MOE_STA
#undef MOE_STAK
#undef MOE_STB
#undef PG8_LDA
#undef PG8_LDB
#undef MOE_LD32
#undef MOE_MFMA
#undef PG8_MMA
#undef PG8_WAIT_V
#undef PG8_WAIT_L
#undef PG8_BAR
#undef PG8_SCHED
}
}

struct Ctx {
    lbyte* lds; int tid, lane, wave, G, bid;
    const Args* a;
};
#define WSP(T, off) ((T*)(A.ws + (off)))

template <class RowMap>
__device__ __forceinline__ void transpose_item(const float* W, int K, int N, bf16_t* WT, RowMap rowmap, lfloat* scr, int item, int lane) {
    const int nblk = N / 32, kb = item / nblk, nb = item % nblk, k0 = 64 * kb, n0 = 32 * nb;
#pragma unroll 8
    for (int i = 0; i < 32; ++i) { const int kk = 2 * i + (lane >> 5); scr[kk * 33 + (lane & 31)] = W[(size_t)(k0 + kk) * N + n0 + (lane & 31)]; }
    asm volatile("s_waitcnt lgkmcnt(0)" ::: "memory");
    const int c = lane & 7;
#pragma unroll
    for (int j = 0; j < 4; ++j) { const int n = (lane >> 3) + 8 * j; const lfloat* s = scr + (8 * c) * 33 + n;
        u32x4 o; o.x = pk2(s[0 * 33], s[1 * 33]); o.y = pk2(s[2 * 33], s[3 * 33]); o.z = pk2(s[4 * 33], s[5 * 33]); o.w = pk2(s[6 * 33], s[7 * 33]);
        *(u32x4*)(WT + (size_t)rowmap(n0 + n) * K + k0 + 8 * c) = o; }
    asm volatile("s_waitcnt lgkmcnt(0)" ::: "memory");
}
template <class RowMap>
__device__ __forceinline__ void transpose_item_fp8(const float* W, int K, int N, unsigned char* WT, RowMap rowmap, float sc, lfloat* scr, int item, int lane) {
    const int nblk = N / 32, kb = item / nblk, nb = item % nblk, k0 = 64 * kb, n0 = 32 * nb;
#pragma unroll 8
    for (int i = 0; i < 32; ++i) { const int kk = 2 * i + (lane >> 5); scr[kk * 33 + (lane & 31)] = W[(size_t)(k0 + kk) * N + n0 + (lane & 31)] * sc; }
    asm volatile("s_waitcnt lgkmcnt(0)" ::: "memory");
    const int c = lane & 7;
#pragma unroll
    for (int j = 0; j < 4; ++j) { const int n = (lane >> 3) + 8 * j; const lfloat* s = scr + (8 * c) * 33 + n;
        u32x2 o; o.x = pk4_fp8(s[0 * 33], s[1 * 33], s[2 * 33], s[3 * 33]); o.y = pk4_fp8(s[4 * 33], s[5 * 33], s[6 * 33], s[7 * 33]);
        *(u32x2*)(WT + (size_t)rowmap(n0 + n) * K + k0 + 8 * c) = o; }
    asm volatile("s_waitcnt lgkmcnt(0)" ::: "memory");
}
struct RowId { __device__ int operator()(int n) const { return n; } };
struct RowGLU { int base; __device__ int operator()(int n) const { return ((n >> 7) << 8) + base + (n & 127); } };

__device__ __forceinline__ void norm_mod_row(const float* xrow, const float* g, const float* sc, const float* sh, bf16_t* orow, int lane, unsigned* o8row = nullptr) {
    const f32x4* xr = (const f32x4*)xrow + lane;
    f32x4 v[4]; float s = 0.f;
#pragma unroll
    for (int j = 0; j < 4; ++j) { v[j] = xr[64 * j]; s += (v[j].x * v[j].x + v[j].y * v[j].y) + (v[j].z * v[j].z + v[j].w * v[j].w); }
    const float rstd = __builtin_amdgcn_rsqf(wave_sum(s) * (1.f / D) + NORM_EPS);
    u32x2* o8 = (u32x2*)orow + lane;
#pragma unroll
    for (int j = 0; j < 4; ++j) { const f32x4 gg = ((const f32x4*)g)[lane + 64 * j], ss = ((const f32x4*)sc)[lane + 64 * j], hh = ((const f32x4*)sh)[lane + 64 * j];
        const f32x4 y = v[j] * rstd * gg * (ss + 1.f) + hh;
        if (orow) { u32x2 w; w.x = pk2(y.x, y.y); w.y = pk2(y.z, y.w); o8[64 * j] = w; }
        if (o8row) o8row[lane + 64 * j] = pk4_fp8(y.x, y.y, y.z, y.w); }
}

__device__ __forceinline__ void phase_p0(const Args& A, Ctx& C) {
    float* mod = WSP(float, WS_MOD);
    {
        lfloat* sc = (lfloat*)C.lds;
        lfloat* red = (lfloat*)(C.lds + 17 * 1024 * 4);
        const float* wada = A.in[I_WADA]; const float* bada = A.in[I_BADA];
        for (int it = C.bid; it < 96 * 2; it += C.G) {
            const int chunk = it >> 1, pass = it & 1, r0 = pass * 17, nr = pass ? 16 : 17, col0 = chunk * 64;
            __syncthreads();
            for (int i = C.tid; i < nr * 1024; i += 512) { const int r = i >> 10, k = i & 1023; const int rr = r0 + r;
                const float cv = rr < 32 ? A.in[I_C][rr * 1024 + k] : A.in[I_CCTX][k]; sc[r * 1024 + k] = siluf_(cv); }
            __syncthreads();
            const int col = C.tid & 63, kq = C.tid >> 6;
            float acc[17];
#pragma unroll
            for (int r = 0; r < 17; ++r) acc[r] = 0.f;
            for (int k = kq * 128; k < kq * 128 + 128; k += 4) {
                float w[4];
#pragma unroll
                for (int j = 0; j < 4; ++j) w[j] = wada[(size_t)(k + j) * MODW + col0 + col];
#pragma unroll
                for (int r = 0; r < 17; ++r) { const f32x4 s4 = *(const LAS f32x4*)(sc + r * 1024 + k); acc[r] += s4.x * w[0] + s4.y * w[1] + s4.z * w[2] + s4.w * w[3]; }
            }
#pragma unroll
            for (int r = 0; r < 17; ++r) red[(kq * 17 + r) * 64 + col] = acc[r];
            __syncthreads();
            for (int i = C.tid; i < nr * 64; i += 512) { const int r = i >> 6, cc = i & 63; float s = 0.f;
#pragma unroll
                for (int q = 0; q < 8; ++q) s += red[(q * 17 + r) * 64 + cc];
                mod[(size_t)(r0 + r) * MODW + col0 + cc] = s + bada[col0 + cc]; }
        }
        __syncthreads();
    }
    {
        lfloat* scr = (lfloat*)(C.lds + C.wave * 16384);
        const int gw = C.bid * 8 + C.wave, NGW = C.G * 8;
        unsigned char* btin8 = A.ws + WS_BTIN; bf16_t* btout = WSP(bf16_t, WS_BTOUT); bf16_t* btr = WSP(bf16_t, WS_BTR);
        constexpr int I_IN = (D / 64) * 124, I_OUT = (D / 64) * (D / 32), I_R = (D / 64) * (NE / 32), I_G = (128 / 64) * (DA / 32);
        for (int it = gw; it < I_IN + I_OUT + I_R + I_G; it += NGW) {
            int r = it;
            if (r < I_IN) {
                const int kb = r / 124, nb = r % 124, k0 = 64 * kb, n0 = 32 * nb; const float* W = A.in[I_WIN];
#pragma unroll 8
                for (int i = 0; i < 32; ++i) { const int kk = 2 * i + (C.lane >> 5); scr[kk * 33 + (C.lane & 31)] = W[(size_t)(k0 + kk) * IN_COLS + n0 + (C.lane & 31)] * SWIN; }
                asm volatile("s_waitcnt lgkmcnt(0)" ::: "memory");
                const int c = C.lane & 7;
#pragma unroll
                for (int j = 0; j < 4; ++j) { const int n = (C.lane >> 3) + 8 * j; const lfloat* s = scr + (8 * c) * 33 + n;
                    u32x2 o; o.x = pk4_fp8(s[0 * 33], s[1 * 33], s[2 * 33], s[3 * 33]); o.y = pk4_fp8(s[4 * 33], s[5 * 33], s[6 * 33], s[7 * 33]);
                    *(u32x2*)(btin8 + (size_t)(n0 + n) * D + k0 + 8 * c) = o; }
                asm volatile("s_waitcnt lgkmcnt(0)" ::: "memory");
                continue; }
            r -= I_IN;
            if (r < I_OUT) { transpose_item(A.in[I_WOUT], D, D, btout, RowId(), scr, r, C.lane); continue; } r -= I_OUT;
            if (r < I_R) { transpose_item(A.in[I_RW], D, NE, btr, RowId(), scr, r, C.lane); continue; } r -= I_R;
            transpose_item(A.in[I_GUP], 128, DA, WSP(bf16_t, WS_GUPT), RowId(), scr, r, C.lane);
        }
        for (int i = C.bid * 512 + C.tid; i < 16 * D / 4; i += C.G * 512) { const int n = 3968 + (i >> 8), k = (i & 255) * 4; const float* W = A.in[I_WIN];
            *(unsigned*)(btin8 + (size_t)n * D + k) = pk4_fp8(W[(size_t)k * IN_COLS + n] * SWIN, W[(size_t)(k + 1) * IN_COLS + n] * SWIN, W[(size_t)(k + 2) * IN_COLS + n] * SWIN, W[(size_t)(k + 3) * IN_COLS + n] * SWIN); }
        for (int i = C.bid * 512 + C.tid; i < (PLD - IN_COLS) * D / 16; i += C.G * 512) ((u32x4*)(btin8 + (size_t)IN_COLS * D))[i] = (u32x4){0u, 0u, 0u, 0u};
    }
}

__device__ __forceinline__ void phase_p1(const Args& A, Ctx& C) {
    const float* mod = WSP(float, WS_MOD); bf16_t* xn = WSP(bf16_t, WS_XN);
    const int gw = C.bid * 8 + C.wave, NGW = C.G * 8;
    for (int row = gw; row < NROWS; row += NGW) {
        const float* xr; int mb;
        if (row < NLAT) { xr = A.in[I_X] + (size_t)row * D; mb = row >> 11; } else { xr = A.in[I_CTX] + (size_t)(row - NLAT) * D; mb = 32; }
        const float* m = mod + (size_t)mb * MODW;
        norm_mod_row(xr, A.in[I_N1G], m + D, m, nullptr, C.lane, (unsigned*)(A.ws + WS_XN) + (size_t)row * (D / 4));
    }
}

__device__ __forceinline__ float bfsel(unsigned w, bool odd) { return __builtin_bit_cast(float, odd ? (w & 0xffff0000u) : (w << 16)); }
template <int NK>
__device__ __forceinline__ f32x4 mm_tile(const lbyte* Ap, int lda, const lbyte* Bp, int ldb, f32x4 acc, int lane) {
    const int r = lane & 15, g = lane >> 4;
#pragma unroll
    for (int ks = 0; ks < NK; ++ks) {
        const bf16x8 a = *(const LAS bf16x8*)(Ap + r * lda + ks * 64 + g * 16);
        const bf16x8 b = *(const LAS bf16x8*)(Bp + r * ldb + ks * 64 + g * 16);
        acc = __builtin_amdgcn_mfma_f32_16x16x32_bf16(a, b, acc, 0, 0, 0);
    }
    return acc;
}

__device__ __forceinline__ void st_bf16x4(lbyte* p, f32x4 v) { u32x2 w; w.x = cvtpk(v.x, v.y); w.y = cvtpk(v.z, v.w); *(LAS u32x2*)p = w; }
__device__ __forceinline__ void st_bf16(lbyte* p, float v) { *(LAS unsigned short*)p = (unsigned short)cvtpk(v, v); }
__device__ __forceinline__ float rdlane(float v, int l) { return __builtin_bit_cast(float, __builtin_amdgcn_readlane(__builtin_bit_cast(int, v), l)); }

__device__ __forceinline__ void tri_inv16(const f32x4 m, int lane, lbyte* scr, float (&X)[16]) {
    *(LAS f32x4*)(scr + (lane & 15) * 64 + (lane >> 4) * 16) = m;
    asm volatile("s_waitcnt lgkmcnt(0)" ::: "memory");
    float Mr[16];
#pragma unroll
    for (int kq = 0; kq < 4; ++kq) { const f32x4 r = *(const LAS f32x4*)(scr + (lane & 15) * 64 + kq * 16); Mr[4 * kq] = r.x; Mr[4 * kq + 1] = r.y; Mr[4 * kq + 2] = r.z; Mr[4 * kq + 3] = r.w; }
    const int l16 = lane & 15;
    X[0] = (l16 == 0) ? 1.f : 0.f;
    { float x0 = (l16 == 1) ? 1.f : 0.f, x1 = 0.f;
      asm("s_nop 1\n\t" "v_fmac_f32_dpp %0, -%1, %2 row_newbcast:1 row_mask:0xf bank_mask:0xf\n\t" : "+v"(x0) : "v"(Mr[0]), "v"(X[0]));
      X[1] = x0 + x1; }
    { float x0 = (l16 == 2) ? 1.f : 0.f, x1 = 0.f;
      asm("s_nop 1\n\t" "v_fmac_f32_dpp %0, -%1, %2 row_newbcast:2 row_mask:0xf bank_mask:0xf\n\t" : "+v"(x0) : "v"(Mr[0]), "v"(X[0]));
      asm("s_nop 1\n\t" "v_fmac_f32_dpp %0, -%1, %2 row_newbcast:2 row_mask:0xf bank_mask:0xf\n\t" : "+v"(x1) : "v"(Mr[1]), "v"(X[1]));
      X[2] = x0 + x1; }
    { float x0 = (l16 == 3) ? 1.f : 0.f, x1 = 0.f;
      asm("s_nop 1\n\t" "v_fmac_f32_dpp %0, -%1, %2 row_newbcast:3 row_mask:0xf bank_mask:0xf\n\t" "v_fmac_f32_dpp %0, -%3, %4 row_newbcast:3 row_mask:0xf bank_mask:0xf\n\t" : "+v"(x0) : "v"(Mr[0]), "v"(X[0]), "v"(Mr[2]), "v"(X[2]));
      asm("s_nop 1\n\t" "v_fmac_f32_dpp %0, -%1, %2 row_newbcast:3 row_mask:0xf bank_mask:0xf\n\t" : "+v"(x1) : "v"(Mr[1]), "v"(X[1]));
      X[3] = x0 + x1; }
    { float x0 = (l16 == 4) ? 1.f : 0.f, x1 = 0.f;
      asm("s_nop 1\n\t" "v_fmac_f32_dpp %0, -%1, %2 row_newbcast:4 row_mask:0xf bank_mask:0xf\n\t" "v_fmac_f32_dpp %0, -%3, %4 row_newbcast:4 row_mask:0xf bank_mask:0xf\n\t" : "+v"(x0) : "v"(Mr[0]), "v"(X[0]), "v"(Mr[2]), "v"(X[2]));
      asm("s_nop 1\n\t" "v_fmac_f32_dpp %0, -%1, %2 row_newbcast:4 row_mask:0xf bank_mask:0xf\n\t" "v_fmac_f32_dpp %0, -%3, %4 row_newbcast:4 row_mask:0xf bank_mask:0xf\n\t" : "+v"(x1) : "v"(Mr[1]), "v"(X[1]), "v"(Mr[3]), "v"(X[3]));
      X[4] = x0 + x1; }
    { float x0 = (l16 == 5) ? 1.f : 0.f, x1 = 0.f;
      asm("s_nop 1\n\t" "v_fmac_f32_dpp %0, -%1, %2 row_newbcast:5 row_mask:0xf bank_mask:0xf\n\t" "v_fmac_f32_dpp %0, -%3, %4 row_newbcast:5 row_mask:0xf bank_mask:0xf\n\t" "v_fmac_f32_dpp %0, -%5, %6 row_newbcast:5 row_mask:0xf bank_mask:0xf\n\t" : "+v"(x0) : "v"(Mr[0]), "v"(X[0]), "v"(Mr[2]), "v"(X[2]), "v"(Mr[4]), "v"(X[4]));
      asm("s_nop 1\n\t" "v_fmac_f32_dpp %0, -%1, %2 row_newbcast:5 row_mask:0xf bank_mask:0xf\n\t" "v_fmac_f32_dpp %0, -%3, %4 row_newbcast:5 row_mask:0xf bank_mask:0xf\n\t" : "+v"(x1) : "v"(Mr[1]), "v"(X[1]), "v"(Mr[3]), "v"(X[3]));
      X[5] = x0 + x1; }
    { float x0 = (l16 == 6) ? 1.f : 0.f, x1 = 0.f;
      asm("s_nop 1\n\t" "v_fmac_f32_dpp %0, -%1, %2 row_newbcast:6 row_mask:0xf bank_mask:0xf\n\t" "v_fmac_f32_dpp %0, -%3, %4 row_newbcast:6 row_mask:0xf bank_mask:0xf\n\t" "v_fmac_f32_dpp %0, -%5, %6 row_newbcast:6 row_mask:0xf bank_mask:0xf\n\t" : "+v"(x0) : "v"(Mr[0]), "v"(X[0]), "v"(Mr[2]), "v"(X[2]), "v"(Mr[4]), "v"(X[4]));
      asm("s_nop 1\n\t" "v_fmac_f32_dpp %0, -%1, %2 row_newbcast:6 row_mask:0xf bank_mask:0xf\n\t" "v_fmac_f32_dpp %0, -%3, %4 row_newbcast:6 row_mask:0xf bank_mask:0xf\n\t" "v_fmac_f32_dpp %0, -%5, %6 row_newbcast:6 row_mask:0xf bank_mask:0xf\n\t" : "+v"(x1) : "v"(Mr[1]), "v"(X[1]), "v"(Mr[3]), "v"(X[3]), "v"(Mr[5]), "v"(X[5]));
      X[6] = x0 + x1; }
    { float x0 = (l16 == 7) ? 1.f : 0.f, x1 = 0.f;
      asm("s_nop 1\n\t" "v_fmac_f32_dpp %0, -%1, %2 row_newbcast:7 row_mask:0xf bank_mask:0xf\n\t" "v_fmac_f32_dpp %0, -%3, %4 row_newbcast:7 row_mask:0xf bank_mask:0xf\n\t" "v_fmac_f32_dpp %0, -%5, %6 row_newbcast:7 row_mask:0xf bank_mask:0xf\n\t" "v_fmac_f32_dpp %0, -%7, %8 row_newbcast:7 row_mask:0xf bank_mask:0xf\n\t" : "+v"(x0) : "v"(Mr[0]), "v"(X[0]), "v"(Mr[2]), "v"(X[2]), "v"(Mr[4]), "v"(X[4]), "v"(Mr[6]), "v"(X[6]));
      asm("s_nop 1\n\t" "v_fmac_f32_dpp %0, -%1, %2 row_newbcast:7 row_mask:0xf bank_mask:0xf\n\t" "v_fmac_f32_dpp %0, -%3, %4 row_newbcast:7 row_mask:0xf bank_mask:0xf\n\t" "v_fmac_f32_dpp %0, -%5, %6 row_newbcast:7 row_mask:0xf bank_mask:0xf\n\t" : "+v"(x1) : "v"(Mr[1]), "v"(X[1]), "v"(Mr[3]), "v"(X[3]), "v"(Mr[5]), "v"(X[5]));
      X[7] = x0 + x1; }
    { float x0 = (l16 == 8) ? 1.f : 0.f, x1 = 0.f;
      asm("s_nop 1\n\t" "v_fmac_f32_dpp %0, -%1, %2 row_newbcast:8 row_mask:0xf bank_mask:0xf\n\t" "v_fmac_f32_dpp %0, -%3, %4 row_newbcast:8 row_mask:0xf bank_mask:0xf\n\t" "v_fmac_f32_dpp %0, -%5, %6 row_newbcast:8 row_mask:0xf bank_mask:0xf\n\t" "v_fmac_f32_dpp %0, -%7, %8 row_newbcast:8 row_mask:0xf bank_mask:0xf\n\t" : "+v"(x0) : "v"(Mr[0]), "v"(X[0]), "v"(Mr[2]), "v"(X[2]), "v"(Mr[4]), "v"(X[4]), "v"(Mr[6]), "v"(X[6]));
      asm("s_nop 1\n\t" "v_fmac_f32_dpp %0, -%1, %2 row_newbcast:8 row_mask:0xf bank_mask:0xf\n\t" "v_fmac_f32_dpp %0, -%3, %4 row_newbcast:8 row_mask:0xf bank_mask:0xf\n\t" "v_fmac_f32_dpp %0, -%5, %6 row_newbcast:8 row_mask:0xf bank_mask:0xf\n\t" "v_fmac_f32_dpp %0, -%7, %8 row_newbcast:8 row_mask:0xf bank_mask:0xf\n\t" : "+v"(x1) : "v"(Mr[1]), "v"(X[1]), "v"(Mr[3]), "v"(X[3]), "v"(Mr[5]), "v"(X[5]), "v"(Mr[7]), "v"(X[7]));
      X[8] = x0 + x1; }
    { float x0 = (l16 == 9) ? 1.f : 0.f, x1 = 0.f;
      asm("s_nop 1\n\t" "v_fmac_f32_dpp %0, -%1, %2 row_newbcast:9 row_mask:0xf bank_mask:0xf\n\t" "v_fmac_f32_dpp %0, -%3, %4 row_newbcast:9 row_mask:0xf bank_mask:0xf\n\t" "v_fmac_f32_dpp %0, -%5, %6 row_newbcast:9 row_mask:0xf bank_mask:0xf\n\t" "v_fmac_f32_dpp %0, -%7, %8 row_newbcast:9 row_mask:0xf bank_mask:0xf\n\t" "v_fmac_f32_dpp %0, -%9, %10 row_newbcast:9 row_mask:0xf bank_mask:0xf\n\t" : "+v"(x0) : "v"(Mr[0]), "v"(X[0]), "v"(Mr[2]), "v"(X[2]), "v"(Mr[4]), "v"(X[4]), "v"(Mr[6]), "v"(X[6]), "v"(Mr[8]), "v"(X[8]));
      asm("s_nop 1\n\t" "v_fmac_f32_dpp %0, -%1, %2 row_newbcast:9 row_mask:0xf bank_mask:0xf\n\t" "v_fmac_f32_dpp %0, -%3, %4 row_newbcast:9 row_mask:0xf bank_mask:0xf\n\t" "v_fmac_f32_dpp %0, -%5, %6 row_newbcast:9 row_mask:0xf bank_mask:0xf\n\t" "v_fmac_f32_dpp %0, -%7, %8 row_newbcast:9 row_mask:0xf bank_mask:0xf\n\t" : "+v"(x1) : "v"(Mr[1]), "v"(X[1]), "v"(Mr[3]), "v"(X[3]), "v"(Mr[5]), "v"(X[5]), "v"(Mr[7]), "v"(X[7]));
      X[9] = x0 + x1; }
    { float x0 = (l16 == 10) ? 1.f : 0.f, x1 = 0.f;
      asm("s_nop 1\n\t" "v_fmac_f32_dpp %0, -%1, %2 row_newbcast:10 row_mask:0xf bank_mask:0xf\n\t" "v_fmac_f32_dpp %0, -%3, %4 row_newbcast:10 row_mask:0xf bank_mask:0xf\n\t" "v_fmac_f32_dpp %0, -%5, %6 row_newbcast:10 row_mask:0xf bank_mask:0xf\n\t" "v_fmac_f32_dpp %0, -%7, %8 row_newbcast:10 row_mask:0xf bank_mask:0xf\n\t" "v_fmac_f32_dpp %0, -%9, %10 row_newbcast:10 row_mask:0xf bank_mask:0xf\n\t" : "+v"(x0) : "v"(Mr[0]), "v"(X[0]), "v"(Mr[2]), "v"(X[2]), "v"(Mr[4]), "v"(X[4]), "v"(Mr[6]), "v"(X[6]), "v"(Mr[8]), "v"(X[8]));
      asm("s_nop 1\n\t" "v_fmac_f32_dpp %0, -%1, %2 row_newbcast:10 row_mask:0xf bank_mask:0xf\n\t" "v_fmac_f32_dpp %0, -%3, %4 row_newbcast:10 row_mask:0xf bank_mask:0xf\n\t" "v_fmac_f32_dpp %0, -%5, %6 row_newbcast:10 row_mask:0xf bank_mask:0xf\n\t" "v_fmac_f32_dpp %0, -%7, %8 row_newbcast:10 row_mask:0xf bank_mask:0xf\n\t" "v_fmac_f32_dpp %0, -%9, %10 row_newbcast:10 row_mask:0xf bank_mask:0xf\n\t" : "+v"(x1) : "v"(Mr[1]), "v"(X[1]), "v"(Mr[3]), "v"(X[3]), "v"(Mr[5]), "v"(X[5]), "v"(Mr[7]), "v"(X[7]), "v"(Mr[9]), "v"(X[9]));
      X[10] = x0 + x1; }
    { float x0 = (l16 == 11) ? 1.f : 0.f, x1 = 0.f;
      asm("s_nop 1\n\t" "v_fmac_f32_dpp %0, -%1, %2 row_newbcast:11 row_mask:0xf bank_mask:0xf\n\t" "v_fmac_f32_dpp %0, -%3, %4 row_newbcast:11 row_mask:0xf bank_mask:0xf\n\t" "v_fmac_f32_dpp %0, -%5, %6 row_newbcast:11 row_mask:0xf bank_mask:0xf\n\t" "v_fmac_f32_dpp %0, -%7, %8 row_newbcast:11 row_mask:0xf bank_mask:0xf\n\t" "v_fmac_f32_dpp %0, -%9, %10 row_newbcast:11 row_mask:0xf bank_mask:0xf\n\t" "v_fmac_f32_dpp %0, -%11, %12 row_newbcast:11 row_mask:0xf bank_mask:0xf\n\t" : "+v"(x0) : "v"(Mr[0]), "v"(X[0]), "v"(Mr[2]), "v"(X[2]), "v"(Mr[4]), "v"(X[4]), "v"(Mr[6]), "v"(X[6]), "v"(Mr[8]), "v"(X[8]), "v"(Mr[10]), "v"(X[10]));
      asm("s_nop 1\n\t" "v_fmac_f32_dpp %0, -%1, %2 row_newbcast:11 row_mask:0xf bank_mask:0xf\n\t" "v_fmac_f32_dpp %0, -%3, %4 row_newbcast:11 row_mask:0xf bank_mask:0xf\n\t" "v_fmac_f32_dpp %0, -%5, %6 row_newbcast:11 row_mask:0xf bank_mask:0xf\n\t" "v_fmac_f32_dpp %0, -%7, %8 row_newbcast:11 row_mask:0xf bank_mask:0xf\n\t" "v_fmac_f32_dpp %0, -%9, %10 row_newbcast:11 row_mask:0xf bank_mask:0xf\n\t" : "+v"(x1) : "v"(Mr[1]), "v"(X[1]), "v"(Mr[3]), "v"(X[3]), "v"(Mr[5]), "v"(X[5]), "v"(Mr[7]), "v"(X[7]), "v"(Mr[9]), "v"(X[9]));
      X[11] = x0 + x1; }
    { float x0 = (l16 == 12) ? 1.f : 0.f, x1 = 0.f;
      asm("s_nop 1\n\t" "v_fmac_f32_dpp %0, -%1, %2 row_newbcast:12 row_mask:0xf bank_mask:0xf\n\t" "v_fmac_f32_dpp %0, -%3, %4 row_newbcast:12 row_mask:0xf bank_mask:0xf\n\t" "v_fmac_f32_dpp %0, -%5, %6 row_newbcast:12 row_mask:0xf bank_mask:0xf\n\t" "v_fmac_f32_dpp %0, -%7, %8 row_newbcast:12 row_mask:0xf bank_mask:0xf\n\t" "v_fmac_f32_dpp %0, -%9, %10 row_newbcast:12 row_mask:0xf bank_mask:0xf\n\t" "v_fmac_f32_dpp %0, -%11, %12 row_newbcast:12 row_mask:0xf bank_mask:0xf\n\t" : "+v"(x0) : "v"(Mr[0]), "v"(X[0]), "v"(Mr[2]), "v"(X[2]), "v"(Mr[4]), "v"(X[4]), "v"(Mr[6]), "v"(X[6]), "v"(Mr[8]), "v"(X[8]), "v"(Mr[10]), "v"(X[10]));
      asm("s_nop 1\n\t" "v_fmac_f32_dpp %0, -%1, %2 row_newbcast:12 row_mask:0xf bank_mask:0xf\n\t" "v_fmac_f32_dpp %0, -%3, %4 row_newbcast:12 row_mask:0xf bank_mask:0xf\n\t" "v_fmac_f32_dpp %0, -%5, %6 row_newbcast:12 row_mask:0xf bank_mask:0xf\n\t" "v_fmac_f32_dpp %0, -%7, %8 row_newbcast:12 row_mask:0xf bank_mask:0xf\n\t" "v_fmac_f32_dpp %0, -%9, %10 row_newbcast:12 row_mask:0xf bank_mask:0xf\n\t" "v_fmac_f32_dpp %0, -%11, %12 row_newbcast:12 row_mask:0xf bank_mask:0xf\n\t" : "+v"(x1) : "v"(Mr[1]), "v"(X[1]), "v"(Mr[3]), "v"(X[3]), "v"(Mr[5]), "v"(X[5]), "v"(Mr[7]), "v"(X[7]), "v"(Mr[9]), "v"(X[9]), "v"(Mr[11]), "v"(X[11]));
      X[12] = x0 + x1; }
    { float x0 = (l16 == 13) ? 1.f : 0.f, x1 = 0.f;
      asm("s_nop 1\n\t" "v_fmac_f32_dpp %0, -%1, %2 row_newbcast:13 row_mask:0xf bank_mask:0xf\n\t" "v_fmac_f32_dpp %0, -%3, %4 row_newbcast:13 row_mask:0xf bank_mask:0xf\n\t" "v_fmac_f32_dpp %0, -%5, %6 row_newbcast:13 row_mask:0xf bank_mask:0xf\n\t" "v_fmac_f32_dpp %0, -%7, %8 row_newbcast:13 row_mask:0xf bank_mask:0xf\n\t" "v_fmac_f32_dpp %0, -%9, %10 row_newbcast:13 row_mask:0xf bank_mask:0xf\n\t" "v_fmac_f32_dpp %0, -%11, %12 row_newbcast:13 row_mask:0xf bank_mask:0xf\n\t" "v_fmac_f32_dpp %0, -%13, %14 row_newbcast:13 row_mask:0xf bank_mask:0xf\n\t" : "+v"(x0) : "v"(Mr[0]), "v"(X[0]), "v"(Mr[2]), "v"(X[2]), "v"(Mr[4]), "v"(X[4]), "v"(Mr[6]), "v"(X[6]), "v"(Mr[8]), "v"(X[8]), "v"(Mr[10]), "v"(X[10]), "v"(Mr[12]), "v"(X[12]));
      asm("s_nop 1\n\t" "v_fmac_f32_dpp %0, -%1, %2 row_newbcast:13 row_mask:0xf bank_mask:0xf\n\t" "v_fmac_f32_dpp %0, -%3, %4 row_newbcast:13 row_mask:0xf bank_mask:0xf\n\t" "v_fmac_f32_dpp %0, -%5, %6 row_newbcast:13 row_mask:0xf bank_mask:0xf\n\t" "v_fmac_f32_dpp %0, -%7, %8 row_newbcast:13 row_mask:0xf bank_mask:0xf\n\t" "v_fmac_f32_dpp %0, -%9, %10 row_newbcast:13 row_mask:0xf bank_mask:0xf\n\t" "v_fmac_f32_dpp %0, -%11, %12 row_newbcast:13 row_mask:0xf bank_mask:0xf\n\t" : "+v"(x1) : "v"(Mr[1]), "v"(X[1]), "v"(Mr[3]), "v"(X[3]), "v"(Mr[5]), "v"(X[5]), "v"(Mr[7]), "v"(X[7]), "v"(Mr[9]), "v"(X[9]), "v"(Mr[11]), "v"(X[11]));
      X[13] = x0 + x1; }
    { float x0 = (l16 == 14) ? 1.f : 0.f, x1 = 0.f;
      asm("s_nop 1\n\t" "v_fmac_f32_dpp %0, -%1, %2 row_newbcast:14 row_mask:0xf bank_mask:0xf\n\t" "v_fmac_f32_dpp %0, -%3, %4 row_newbcast:14 row_mask:0xf bank_mask:0xf\n\t" "v_fmac_f32_dpp %0, -%5, %6 row_newbcast:14 row_mask:0xf bank_mask:0xf\n\t" "v_fmac_f32_dpp %0, -%7, %8 row_newbcast:14 row_mask:0xf bank_mask:0xf\n\t" "v_fmac_f32_dpp %0, -%9, %10 row_newbcast:14 row_mask:0xf bank_mask:0xf\n\t" "v_fmac_f32_dpp %0, -%11, %12 row_newbcast:14 row_mask:0xf bank_mask:0xf\n\t" "v_fmac_f32_dpp %0, -%13, %14 row_newbcast:14 row_mask:0xf bank_mask:0xf\n\t" : "+v"(x0) : "v"(Mr[0]), "v"(X[0]), "v"(Mr[2]), "v"(X[2]), "v"(Mr[4]), "v"(X[4]), "v"(Mr[6]), "v"(X[6]), "v"(Mr[8]), "v"(X[8]), "v"(Mr[10]), "v"(X[10]), "v"(Mr[12]), "v"(X[12]));
      asm("s_nop 1\n\t" "v_fmac_f32_dpp %0, -%1, %2 row_newbcast:14 row_mask:0xf bank_mask:0xf\n\t" "v_fmac_f32_dpp %0, -%3, %4 row_newbcast:14 row_mask:0xf bank_mask:0xf\n\t" "v_fmac_f32_dpp %0, -%5, %6 row_newbcast:14 row_mask:0xf bank_mask:0xf\n\t" "v_fmac_f32_dpp %0, -%7, %8 row_newbcast:14 row_mask:0xf bank_mask:0xf\n\t" "v_fmac_f32_dpp %0, -%9, %10 row_newbcast:14 row_mask:0xf bank_mask:0xf\n\t" "v_fmac_f32_dpp %0, -%11, %12 row_newbcast:14 row_mask:0xf bank_mask:0xf\n\t" "v_fmac_f32_dpp %0, -%13, %14 row_newbcast:14 row_mask:0xf bank_mask:0xf\n\t" : "+v"(x1) : "v"(Mr[1]), "v"(X[1]), "v"(Mr[3]), "v"(X[3]), "v"(Mr[5]), "v"(X[5]), "v"(Mr[7]), "v"(X[7]), "v"(Mr[9]), "v"(X[9]), "v"(Mr[11]), "v"(X[11]), "v"(Mr[13]), "v"(X[13]));
      X[14] = x0 + x1; }
    { float x0 = (l16 == 15) ? 1.f : 0.f, x1 = 0.f;
      asm("s_nop 1\n\t" "v_fmac_f32_dpp %0, -%1, %2 row_newbcast:15 row_mask:0xf bank_mask:0xf\n\t" "v_fmac_f32_dpp %0, -%3, %4 row_newbcast:15 row_mask:0xf bank_mask:0xf\n\t" "v_fmac_f32_dpp %0, -%5, %6 row_newbcast:15 row_mask:0xf bank_mask:0xf\n\t" "v_fmac_f32_dpp %0, -%7, %8 row_newbcast:15 row_mask:0xf bank_mask:0xf\n\t" "v_fmac_f32_dpp %0, -%9, %10 row_newbcast:15 row_mask:0xf bank_mask:0xf\n\t" "v_fmac_f32_dpp %0, -%11, %12 row_newbcast:15 row_mask:0xf bank_mask:0xf\n\t" "v_fmac_f32_dpp %0, -%13, %14 row_newbcast:15 row_mask:0xf bank_mask:0xf\n\t" "v_fmac_f32_dpp %0, -%15, %16 row_newbcast:15 row_mask:0xf bank_mask:0xf\n\t" : "+v"(x0) : "v"(Mr[0]), "v"(X[0]), "v"(Mr[2]), "v"(X[2]), "v"(Mr[4]), "v"(X[4]), "v"(Mr[6]), "v"(X[6]), "v"(Mr[8]), "v"(X[8]), "v"(Mr[10]), "v"(X[10]), "v"(Mr[12]), "v"(X[12]), "v"(Mr[14]), "v"(X[14]));
      asm("s_nop 1\n\t" "v_fmac_f32_dpp %0, -%1, %2 row_newbcast:15 row_mask:0xf bank_mask:0xf\n\t" "v_fmac_f32_dpp %0, -%3, %4 row_newbcast:15 row_mask:0xf bank_mask:0xf\n\t" "v_fmac_f32_dpp %0, -%5, %6 row_newbcast:15 row_mask:0xf bank_mask:0xf\n\t" "v_fmac_f32_dpp %0, -%7, %8 row_newbcast:15 row_mask:0xf bank_mask:0xf\n\t" "v_fmac_f32_dpp %0, -%9, %10 row_newbcast:15 row_mask:0xf bank_mask:0xf\n\t" "v_fmac_f32_dpp %0, -%11, %12 row_newbcast:15 row_mask:0xf bank_mask:0xf\n\t" "v_fmac_f32_dpp %0, -%13, %14 row_newbcast:15 row_mask:0xf bank_mask:0xf\n\t" : "+v"(x1) : "v"(Mr[1]), "v"(X[1]), "v"(Mr[3]), "v"(X[3]), "v"(Mr[5]), "v"(X[5]), "v"(Mr[7]), "v"(X[7]), "v"(Mr[9]), "v"(X[9]), "v"(Mr[11]), "v"(X[11]), "v"(Mr[13]), "v"(X[13]));
      X[15] = x0 + x1; }
}

#ifndef RWKV_REP
#define RWKV_REP 1
#endif
namespace rk {
constexpr int S64 = 160, S32 = 80, SW = 144;
constexpr int O_WUP = 0, O_AUP = O_WUP + 64 * SW, O_WLT = O_AUP + 64 * SW, O_ALT = O_WLT + 16 * S64, O_LW = O_ALT + 16 * S64, O_LA = O_LW + 4096,
              O_KKT = O_LA + 4096, O_RT = O_KKT + 16 * S64, O_BT = O_RT + 16 * S64, O_KDT = O_BT + 16 * S64,
              O_VT = O_KDT + 16 * S64, O_BHT = O_VT + 64 * S32, O_KHT = O_BHT + 64 * S32, O_UT = O_KHT + 64 * S32, O_UTT = O_WLT  ,
              O_TI = O_UT + 64 * S32, O_MK = O_TI + 16 * S32, O_NB = O_MK + 16 * S32, O_NK = O_NB + 16 * S32,
              O_SBF = O_NK + 16 * S32, O_WC = O_SBF + 64 * S64, O_WT = O_WC + 256, TEAM_BYTES = O_WT + 1024;
static_assert(2 * TEAM_BYTES <= LDS_MISC, "rwkv LDS");
}
__device__ __forceinline__ void rwkv_pair_chunked(const Args& A, Ctx& C, int pair) {
    using namespace rk;
    const int b = pair >> 3, h = pair & 7;
    const int dir = C.wave >> 2;
    const int t4 = C.tid & 255, q = C.wave & 3, lane = C.lane;
    lbyte* L = C.lds + dir * TEAM_BYTES;
    const bf16_t* P = WSP(bf16_t, WS_P);
    bf16_t* ydir = WSP(bf16_t, WS_YDIR) + (size_t)dir * NLAT * D;
    float* bon = WSP(float, WS_BON) + (size_t)dir * NLAT * 8;
    __syncthreads();
#pragma unroll 2
    for (int i = t4; i < 4096; i += 256) { const int l = i >> 6, c = i & 63;
        st_bf16(L + O_WUP + c * SW + l * 2, A.in[I_WUP][((size_t)dir * 64 + l) * DA + 64 * h + c]);
        st_bf16(L + O_AUP + c * SW + l * 2, A.in[I_AUP][((size_t)dir * 64 + l) * DA + 64 * h + c]); }
#pragma unroll 2
    for (int i = t4; i < (4 * 64 * S32 + 4 * 16 * S32 + 64 * S64) / 4; i += 256) ((LAS unsigned*)(L + O_VT))[i] = 0u;
    for (int i = t4; i < (2 * 16 * S64) / 4; i += 256) ((LAS unsigned*)(L + O_WLT))[i] = 0u;
    const int c = lane;
    const int col5[5] = {64 * h + c, 512 + 64 * h + c, 1024 + 64 * h + c, 1536 + 64 * dir + c, 1664 + 64 * dir + c};
    float mu5[5]; unsigned coff[5], nm[5], nlo[5], nrg[5]; int ndb[5];
#pragma unroll
    for (int e = 0; e < 5; ++e) { mu5[e] = A.in[I_MU][col5[e]]; coff[e] = (unsigned)col5[e] * 2u; }
    auto set_rules = [&](bool ctx) {
#pragma unroll
        for (int e = 0; e < 5; ++e) { const int col = col5[e];
            if (ctx) { nm[e] = 0xffffffffu; nlo[e] = col < 960 ? 1u : 0u; nrg[e] = (unsigned)(CTX - 2); ndb[e] = (col < 960 ? -PLD : PLD) * 2; }
            else { const int cls = col < 480 ? 0 : (col < 960 ? 1 : (col < 1440 ? 2 : 3));
                nm[e] = cls < 2 ? 63u : 0xffffffffu; nlo[e] = cls == 0 ? 1u : (cls == 2 ? 64u : 0u); nrg[e] = cls < 2 ? 62u : (unsigned)(SEQ - 65);
                ndb[e] = (cls == 0 ? -PLD : (cls == 1 ? PLD : (cls == 2 ? -64 * PLD : 64 * PLD))) * 2; } } };
    set_rules(true);
    const char* wsb = (const char*)A.ws;
    const float kkc = A.in[I_KK][64 * h + c], kac = A.in[I_KA][64 * h + c], rkc = A.in[I_RK][64 * h + c];
    const float w0c = A.in[I_W0][dir * DA + 64 * h + c], a0c = A.in[I_A0][dir * DA + 64 * h + c];
    f32x4 Sacc[4];
#pragma unroll
    for (int i = 0; i < 4; ++i) Sacc[i] = (f32x4){0.f, 0.f, 0.f, 0.f};
    const int fr = lane & 15, fg = lane >> 4;
    unsigned short rawp[4][5], raws[4][5];
    auto chunk_geom = [&](int ch, bool& isctx, int& sbase, int& T, size_t& rowbase) { isctx = ch < 16; sbase = isctx ? ch * 16 : (ch - 16) * 16; T = isctx ? CTX : SEQ; rowbase = isctx ? (size_t)NLAT + (size_t)b * CTX : (size_t)b * SEQ; };
    auto issue_loads = [&](int ch) { bool isctx; int sbase, T; size_t rowbase; chunk_geom(ch, isctx, sbase, T, rowbase);
#pragma unroll
        for (int j = 0; j < 4; ++j) { const int i = 4 * q + j; const int t = __builtin_amdgcn_readfirstlane(dir ? (T - 1 - (sbase + i)) : (sbase + i));
            const unsigned rowoff = (unsigned)WS_P + (unsigned)(rowbase + t) * (unsigned)(PLD * 2);
#pragma unroll
            for (int e = 0; e < 5; ++e) { const unsigned vs = rowoff + coff[e]; const bool ok = (((unsigned)t & nm[e]) - nlo[e]) <= nrg[e]; const unsigned vn = ok ? vs + (unsigned)ndb[e] : 8u;
                rawp[j][e] = *(const bf16_t*)(wsb + vs); raws[j][e] = *(const bf16_t*)(wsb + vn); } } };
    u32x2 ypend; ypend.x = 0u; ypend.y = 0u; float bpend[4] = {0.f, 0.f, 0.f, 0.f};
    auto flush = [&](int pch) { bool pisctx; int psb, pT; size_t prb; chunk_geom(pch, pisctx, psb, pT, prb);
        if (!pisctx) { const int t = dir ? (pT - 1 - (psb + fr)) : (psb + fr);
            *(u32x2*)(ydir + ((size_t)b * SEQ + t) * D + 64 * h + 16 * q + 4 * fg) = ypend;
            if (lane == 0) {
#pragma unroll
                for (int j = 0; j < 4; ++j) { const int i = 4 * q + j; const int tj = dir ? (pT - 1 - (psb + i)) : (psb + i); bon[((size_t)b * SEQ + tj) * 8 + h] = bpend[j]; } } } };
    issue_loads(0);
    for (int ch = 0; ch < 144; ++ch) {
        bool isctx; int sbase, T; size_t rowbase; chunk_geom(ch, isctx, sbase, T, rowbase);
        float vr[4], vk[4], vv[4], vkk[4], lw[4], av[4];
        __syncthreads();
        float mxa[4][5];
#pragma unroll
        for (int j = 0; j < 4; ++j) {
#pragma unroll
            for (int e = 0; e < 5; ++e) { const float pv = bf2f(rawp[j][e]); const float sv = bf2f(raws[j][e]); mxa[j][e] = pv + mu5[e] * (sv - pv); } }
        asm volatile("" :: "v"(mxa[0][0]), "v"(mxa[0][1]), "v"(mxa[0][2]), "v"(mxa[0][3]), "v"(mxa[0][4]), "v"(mxa[1][0]), "v"(mxa[1][1]), "v"(mxa[1][2]), "v"(mxa[1][3]), "v"(mxa[1][4]),
                        "v"(mxa[2][0]), "v"(mxa[2][1]), "v"(mxa[2][2]), "v"(mxa[2][3]), "v"(mxa[2][4]), "v"(mxa[3][0]), "v"(mxa[3][1]), "v"(mxa[3][2]), "v"(mxa[3][3]), "v"(mxa[3][4]) : "memory");
        if (ch > 0) flush(ch - 1);
        if (ch == 15) set_rules(false);
        if (ch + 1 < 144) issue_loads(ch + 1);
        float cl[4];
        _Pragma("unroll") for (int rrep = 0; rrep < RWKV_REP; ++rrep) {
#pragma unroll
        for (int j = 0; j < 4; ++j) {
            const int i = 4 * q + j;
            float mx[5];
#pragma unroll
            for (int e = 0; e < 5; ++e) mx[e] = mxa[j][e];
            vr[j] = mx[0]; vk[j] = mx[1]; vv[j] = mx[2];
            *(LAS unsigned short*)(L + O_WLT + i * S64 + c * 2) = (unsigned short)cvtpk(tanhf_(mx[3]), 0.f); *(LAS unsigned short*)(L + O_ALT + i * S64 + c * 2) = (unsigned short)cvtpk(mx[4], 0.f);
            const float kx = vk[j] * kkc; const float ss = wave_sum(kx * kx);
            vkk[j] = kx * __builtin_amdgcn_rsqf(ss + 1e-6f);
        }
        __syncthreads();
        {
            const f32x4 z = (f32x4){0.f, 0.f, 0.f, 0.f};
            const f32x4 tw = mm_tile<2>(L + O_WLT, S64, L + O_WUP + 16 * q * SW, SW, z, lane);
            const f32x4 ta = mm_tile<2>(L + O_ALT, S64, L + O_AUP + 16 * q * SW, SW, z, lane);
#pragma unroll
            for (int e = 0; e < 4; ++e) { ((LAS float*)(L + O_LW))[(4 * fg + e) * 64 + 16 * q + fr] = tw[e]; ((LAS float*)(L + O_LA))[(4 * fg + e) * 64 + 16 * q + fr] = ta[e]; }
        }
        __syncthreads();
        { float run = 0.f;
#pragma unroll
        for (int j = 0; j < 4; ++j) { const int i = 4 * q + j;
            const float wlog = -softplusf_(-(w0c + ((LAS float*)(L + O_LW))[i * 64 + c])) - 0.5f;
            lw[j] = -__expf(wlog);
            av[j] = sigmoidf_(a0c + ((LAS float*)(L + O_LA))[i * 64 + c]);
            run += lw[j]; cl[j] = run; }
        ((LAS float*)(L + O_WT))[q * 64 + c] = run; }
        __syncthreads();
        }
        {
            float off = 0.f, cumC = 0.f;
#pragma unroll
            for (int qq = 0; qq < 4; ++qq) { const float tv = ((LAS float*)(L + O_WT))[qq * 64 + c]; cumC += tv; off += (qq < q) ? tv : 0.f; }
            float tv_[4], tb_[4], tk_[4];
#pragma unroll
            for (int j = 0; j < 4; ++j) { const int i = 4 * q + j;
                const float cum = off + cl[j];
                const float Wt = __expf(cum), Wp = __expf(cum - lw[j]), Wi = __expf(-cum), Wc = __expf(cumC - cum);
                const float kd = vk[j] * (1.f + (av[j] - 1.f) * kac), bb = vkk[j] * av[j];
                const unsigned p0 = cvtpk(vkk[j] * Wp, vr[j] * Wt), p1 = cvtpk(bb * Wi, kd * Wi);
                *(LAS unsigned short*)(L + O_KKT + i * S64 + c * 2) = (unsigned short)p0; *(LAS unsigned short*)(L + O_RT + i * S64 + c * 2) = (unsigned short)(p0 >> 16);
                *(LAS unsigned short*)(L + O_BT + i * S64 + c * 2) = (unsigned short)p1; *(LAS unsigned short*)(L + O_KDT + i * S64 + c * 2) = (unsigned short)(p1 >> 16);
                tv_[j] = vv[j]; tb_[j] = bb * Wc; tk_[j] = kd * Wc;
                const float bs = wave_sum(vr[j] * kd * rkc);
                bpend[j] = bs;
            }
#pragma unroll
            for (int jp = 0; jp < 2; ++jp) { const int i = 4 * q + 2 * jp;
                *(LAS unsigned*)(L + O_VT + c * S32 + i * 2) = cvtpk(tv_[2 * jp], tv_[2 * jp + 1]);
                *(LAS unsigned*)(L + O_BHT + c * S32 + i * 2) = cvtpk(tb_[2 * jp], tb_[2 * jp + 1]);
                *(LAS unsigned*)(L + O_KHT + c * S32 + i * 2) = cvtpk(tk_[2 * jp], tk_[2 * jp + 1]); }
            if (q == 3) ((LAS float*)(L + O_WC))[c] = __expf(cumC);
        }
        __syncthreads();
        {
            const int role = (q + dir) & 3;
            const lbyte* Aj = L + ((role & 1) ? O_KDT : O_BT);
            const lbyte* Bt = L + ((role & 2) ? O_RT : O_KKT);
            f32x4 g4 = mm_tile<2>(Aj, S64, Bt, S64, (f32x4){0.f, 0.f, 0.f, 0.f}, lane);
#pragma unroll
            for (int e = 0; e < 4; ++e) { const int j = 4 * fg + e; const bool keep = (role & 2) ? (j <= fr) : (j < fr); g4[e] = keep ? g4[e] : 0.f; }
            if (role == 0) { float X[16]; tri_inv16(g4, lane, L + O_LW, X);
                if (lane < 16) {
#pragma unroll
                    for (int i = 0; i < 16; ++i) *(LAS unsigned short*)(L + O_TI + i * S32 + lane * 2) = (unsigned short)cvtpk(X[i], 0.f); } }
            else st_bf16x4(L + (role == 1 ? O_MK : (role == 2 ? O_NB : O_NK)) + fr * S32 + fg * 8, g4);
        }
        __syncthreads();
        f32x4 yacc;
        {
            f32x4 u4 = mm_tile<2>(L + O_KKT, S64, L + O_SBF + 16 * q * S64, S64, (f32x4){0.f, 0.f, 0.f, 0.f}, lane);
            u4 = mm_tile<1>(L + O_MK, S32, L + O_VT + 16 * q * S32, S32, u4, lane);
            st_bf16x4(L + O_UTT + (16 * q + fr) * S32 + fg * 8, u4);
            yacc = mm_tile<2>(L + O_SBF + 16 * q * S64, S64, L + O_RT, S64, (f32x4){0.f, 0.f, 0.f, 0.f}, lane);
            yacc = mm_tile<1>(L + O_VT + 16 * q * S32, S32, L + O_NK, S32, yacc, lane);
        }
        asm volatile("s_waitcnt lgkmcnt(0)" ::: "memory");
        {
            f32x4 u4 = mm_tile<1>(L + O_TI, S32, L + O_UTT + 16 * q * S32, S32, (f32x4){0.f, 0.f, 0.f, 0.f}, lane);
            st_bf16x4(L + O_UT + (16 * q + fr) * S32 + fg * 8, -u4);
        }
        __syncthreads();
        {
            yacc = mm_tile<1>(L + O_UT + 16 * q * S32, S32, L + O_NB, S32, yacc, lane);
            ypend.x = cvtpk(yacc[0], yacc[1]); ypend.y = cvtpk(yacc[2], yacc[3]);
            const f32x4 wc4 = *(LAS f32x4*)(L + O_WC + (16 * q + 4 * fg) * 4);
#pragma unroll
            for (int vi = 0; vi < 4; ++vi) {
                f32x4 s4 = Sacc[vi] * wc4;
                s4 = mm_tile<1>(L + O_KHT + 16 * q * S32, S32, L + O_VT + 16 * vi * S32, S32, s4, lane);
                s4 = mm_tile<1>(L + O_BHT + 16 * q * S32, S32, L + O_UT + 16 * vi * S32, S32, s4, lane);
                Sacc[vi] = s4;
                st_bf16x4(L + O_SBF + (16 * vi + fr) * S64 + (16 * q + 4 * fg) * 2, s4);
            }
        }
    }
    flush(143);
    __syncthreads();
}

__device__ __forceinline__ void phase_gdn_prep(const Args& A, Ctx& C) {
    const bf16_t* P = WSP(bf16_t, WS_P);
    bf16_t* QKV = (bf16_t*)A.out; float* NRM = WSP(float, WS_NRM);
    lfloat* part = (lfloat*)C.lds;
    const int tid = C.tid, lane = C.lane, w = C.wave;
    float cw[3][5];
#pragma unroll
    for (int g = 0; g < 3; ++g)
#pragma unroll
        for (int e = 0; e < 5; ++e) cw[g][e] = A.in[I_CONVW][e * 1536 + g * 512 + tid];
    for (int tile = C.bid; tile < NROWS / 16; tile += C.G) {
        const int row0 = tile * 16;
        int T, ta; size_t rowbase;
        if (row0 < NLAT) { T = SEQ; rowbase = (size_t)(row0 >> 11) * SEQ; ta = row0 & (SEQ - 1); } else { T = CTX; const int r = row0 - NLAT; rowbase = (size_t)NLAT + (size_t)(r >> 8) * CTX; ta = r & (CTX - 1); }
        float x[3][20];
#pragma unroll
        for (int e = 0; e < 20; ++e) { const int t = ta - 2 + e; const bool ok = (t >= 0 && t < T); const bf16_t* pr = P + (rowbase + (ok ? t : ta)) * PLD + RW_COLS + tid;
#pragma unroll
            for (int g = 0; g < 3; ++g) { const float xv = bf2f(pr[g * 512]); x[g][e] = ok ? xv : 0.f; } }
        __syncthreads();
#pragma unroll
        for (int i = 0; i < 16; ++i) { float y[3];
#pragma unroll
            for (int g = 0; g < 3; ++g) { float sacc = 0.f;
#pragma unroll
                for (int f = 0; f < 5; ++f) sacc += cw[g][f] * x[g][i + f];
                y[g] = siluf_(sacc); }
            bf16_t* orow = QKV + (rowbase + ta + i) * 1536 + tid;
            orow[0] = (bf16_t)cvtpk(y[0], 0.f); orow[512] = (bf16_t)cvtpk(y[1], 0.f); orow[1024] = (bf16_t)cvtpk(y[2], 0.f);
            const float sq = wave_sum(y[0] * y[0]), sk = wave_sum(y[1] * y[1]);
            if (lane == 0) { part[(i * 8 + w) * 2] = sq; part[(i * 8 + w) * 2 + 1] = sk; } }
        __syncthreads();
        if (tid < 128) { const int i = tid >> 3, sidx = tid & 7, h = sidx & 3, sel = sidx >> 2;
            const float ss = part[(i * 8 + 2 * h) * 2 + sel] + part[(i * 8 + 2 * h + 1) * 2 + sel];
            NRM[(rowbase + ta + i) * 8 + sidx] = __builtin_amdgcn_rsqf(ss + 1e-6f) * (sel ? 1.f : 0.08838834764831845f); }
    }
    __syncthreads();
}

namespace gd {
constexpr int S128 = 288, S32 = 80;
constexpr int O_KT = 0, O_QT = O_KT + 32 * S128, O_KKT = O_QT + 32 * S128, O_RT = O_KKT + 32 * S128,
              O_VT = O_RT + 32 * S128, O_BHT = O_VT + 128 * S32, O_KHT = O_BHT + 128 * S32, O_UT = O_KHT + 128 * S32, O_UTT = O_UT + 128 * S32,
              O_TI = O_UTT + 128 * S32, O_MK = O_TI + 32 * S32, O_NB = O_MK + 32 * S32, O_NK = O_NB + 32 * S32,
              O_M21 = O_NK + 32 * S32, O_T11T = O_M21 + 16 * S32, O_T22 = O_T11T + 16 * S32, O_XT = O_T22 + 16 * S32,
              O_SBF = O_XT + 16 * S32, O_SC = O_SBF + 128 * S128, O_MS = O_SC + 512, GD_BYTES = O_MS + 2048;
static_assert(GD_BYTES <= LDS_MISC, "gdn LDS");
}
__device__ __forceinline__ void gdn_chain_chunked(const Args& A, Ctx& C, int chain) {
    using namespace gd;
    const int b = chain >> 3, h = (chain >> 1) & 3, dir = chain & 1;
    lbyte* L = C.lds;
    LAS float* SC = (LAS float*)(L + O_SC);
    const bf16_t* P = WSP(bf16_t, WS_P);
    bf16_t* ydir = WSP(bf16_t, WS_YDIR) + (size_t)dir * NLAT * D;
    const int tid = C.tid, lane = C.lane, w = C.wave, fr = lane & 15, fg = lane >> 4;
    const int grp = tid >> 7, idx = tid & 127;
    const float Aexp = __expf(A.in[I_ALOG][dir * 4 + h]), dtb = A.in[I_DTB][dir * 4 + h];
    const f32x4 z4 = (f32x4){0.f, 0.f, 0.f, 0.f};
    __syncthreads();
#pragma unroll 2
    for (int i = tid; i < (O_SC - O_VT) / 4; i += 512) ((LAS unsigned*)(L + O_VT))[i] = 0u;
    f32x4 Sacc[8];
#pragma unroll
    for (int i = 0; i < 8; ++i) Sacc[i] = z4;
    const bf16_t* QKV = (const bf16_t*)A.out; const float* NRM = WSP(const float, WS_NRM);
    unsigned rq[8], rk[8], rv[8]; float nq[8], nk[8]; unsigned raw_al = 0, raw_be = 0;
    const bool codd = idx & 1, godd = h & 1;
    auto chunk_geom = [&](int ch, bool& isctx, int& sbase, int& T, size_t& rowbase) { isctx = ch < 8; sbase = isctx ? ch * 32 : (ch - 8) * 32; T = isctx ? CTX : SEQ;
        rowbase = isctx ? (size_t)NLAT + (size_t)b * CTX : (size_t)b * SEQ; };
    auto issue_loads = [&](int ch) { bool isctx; int sbase, T; size_t rowbase; chunk_geom(ch, isctx, sbase, T, rowbase);
#pragma unroll
        for (int j = 0; j < 8; ++j) { const int i = 2 * grp + 8 * (j >> 1) + (j & 1); const int t = dir ? (T - 1 - (sbase + i)) : (sbase + i); const size_t row = rowbase + t;
            const unsigned* qr = (const unsigned*)(QKV + row * 1536 + 128 * h + (idx & ~1)); rq[j] = qr[0]; rk[j] = qr[256]; rv[j] = qr[512]; nq[j] = NRM[row * 8 + h]; nk[j] = NRM[row * 8 + 4 + h]; }
        if (w == 7 && lane < 32) { const int t = dir ? (T - 1 - (sbase + lane)) : (sbase + lane); const unsigned* pr = (const unsigned*)(P + (rowbase + t) * PLD + RW_COLS + 2048 + ((dir * 4 + h) & ~1)); raw_al = pr[0]; raw_be = pr[4]; } };
    u32x2 ypend[2]; ypend[0].x = ypend[0].y = ypend[1].x = ypend[1].y = 0u;
    auto flush = [&](int pch) { bool pisctx; int psb, pT; size_t prb; chunk_geom(pch, pisctx, psb, pT, prb);
        if (!pisctx) {
#pragma unroll
            for (int tb = 0; tb < 2; ++tb) { const int tl = psb + tb * 16 + fr; const int t = dir ? (pT - 1 - tl) : tl;
                *(u32x2*)(ydir + ((size_t)b * SEQ + t) * D + 512 + 128 * h + 16 * w + 4 * fg) = ypend[tb]; } } };
    issue_loads(0);
    for (int ch = 0; ch < 72; ++ch) {
        bool isctx; int sbase, T; size_t rowbase; chunk_geom(ch, isctx, sbase, T, rowbase);
        __syncthreads();
        float qv[8], kv[8], vv[8], nqv[8], nkv[8];
#pragma unroll
        for (int j = 0; j < 8; ++j) { qv[j] = bfsel(rq[j], codd); kv[j] = bfsel(rk[j], codd); vv[j] = bfsel(rv[j], codd); nqv[j] = nq[j]; nkv[j] = nk[j]; }
        if (w == 7) {
            const float gi = (lane < 32) ? -Aexp * softplusf_(bfsel(raw_al, godd) + dtb) : 0.f;
            float cum = gi;
            cum += __builtin_bit_cast(float, __builtin_amdgcn_update_dpp(0, __builtin_bit_cast(int, cum), 0x111, 0xf, 0xf, true));
            cum += __builtin_bit_cast(float, __builtin_amdgcn_update_dpp(0, __builtin_bit_cast(int, cum), 0x112, 0xf, 0xf, true));
            cum += __builtin_bit_cast(float, __builtin_amdgcn_update_dpp(0, __builtin_bit_cast(int, cum), 0x114, 0xf, 0xf, true));
            cum += __builtin_bit_cast(float, __builtin_amdgcn_update_dpp(0, __builtin_bit_cast(int, cum), 0x118, 0xf, 0xf, true));
            const float r0 = rdlane(cum, 15);
            cum += (lane >= 16) ? r0 : 0.f;
            if (lane < 32) { SC[lane] = sigmoidf_(bfsel(raw_be, godd)); SC[32 + lane + 1] = cum; if (lane == 0) SC[32] = 0.f; }
        }
        asm volatile("" :: "v"(qv[0]), "v"(qv[1]), "v"(qv[2]), "v"(qv[3]), "v"(qv[4]), "v"(qv[5]), "v"(qv[6]), "v"(qv[7]), "v"(kv[0]), "v"(kv[1]), "v"(kv[2]), "v"(kv[3]), "v"(kv[4]), "v"(kv[5]), "v"(kv[6]), "v"(kv[7]),
                        "v"(vv[0]), "v"(vv[1]), "v"(vv[2]), "v"(vv[3]), "v"(vv[4]), "v"(vv[5]), "v"(vv[6]), "v"(vv[7]) : "memory");
        asm volatile("" :: "v"(nqv[0]), "v"(nqv[1]), "v"(nqv[2]), "v"(nqv[3]), "v"(nqv[4]), "v"(nqv[5]), "v"(nqv[6]), "v"(nqv[7]), "v"(nkv[0]), "v"(nkv[1]), "v"(nkv[2]), "v"(nkv[3]), "v"(nkv[4]), "v"(nkv[5]), "v"(nkv[6]), "v"(nkv[7]),
                        "v"(raw_al), "v"(raw_be) : "memory");
        if (ch > 0) flush(ch - 1);
        if (ch + 1 < 72) issue_loads(ch + 1);
        __syncthreads();
        {
            const int c = idx; const float gcC = SC[32 + 32];
#pragma unroll
            for (int jj = 0; jj < 4; ++jj) { const int i0 = 2 * grp + 8 * jj;
                float bh[2], kh[2];
#pragma unroll
                for (int e = 0; e < 2; ++e) { const int j = 2 * jj + e, i = i0 + e;
                    const float kn = kv[j] * nkv[j], qn = qv[j] * nqv[j];
                    const float gm = SC[32 + i], gi = SC[32 + i + 1], be = SC[i];
                    const unsigned p0 = cvtpk(kn, qn), p1 = cvtpk(kn * __expf(gm), qn * __expf(gi));
                    *(LAS unsigned short*)(L + O_KT + i * S128 + c * 2) = (unsigned short)p0; *(LAS unsigned short*)(L + O_QT + i * S128 + c * 2) = (unsigned short)(p0 >> 16);
                    *(LAS unsigned short*)(L + O_KKT + i * S128 + c * 2) = (unsigned short)p1; *(LAS unsigned short*)(L + O_RT + i * S128 + c * 2) = (unsigned short)(p1 >> 16);
                    bh[e] = be * kn * __expf(gcC - gm); kh[e] = be * kn * __expf(gcC - gi); }
                *(LAS unsigned*)(L + O_BHT + c * S32 + i0 * 2) = cvtpk(bh[0], bh[1]); *(LAS unsigned*)(L + O_KHT + c * S32 + i0 * 2) = cvtpk(kh[0], kh[1]);
                *(LAS unsigned*)(L + O_VT + c * S32 + i0 * 2) = cvtpk(vv[2 * jj], vv[2 * jj + 1]); }
        }
        __syncthreads();
        {
            const int isq = w >> 2, tb = (w >> 1) & 1, jb = w & 1;
            if (jb <= tb) {
                const f32x4 g4 = mm_tile<4>(L + O_KT + jb * 16 * S128, S128, L + (isq ? O_QT : O_KT) + tb * 16 * S128, S128, z4, lane);
                const int t = tb * 16 + fr;
                const float gt = SC[32 + t + isq];
                f32x4 m0, m1;
#pragma unroll
                for (int e = 0; e < 4; ++e) { const int j = jb * 16 + 4 * fg + e; const bool keep = isq ? (j <= t) : (j < t);
                    const float bj = SC[j] * g4[e];
                    m0[e] = keep ? bj * __expf(gt - SC[32 + j]) : 0.f;
                    m1[e] = keep ? bj * __expf(gt - SC[32 + j + 1]) : 0.f; }
                const int off = t * S32 + (jb * 16 + 4 * fg) * 2;
                if (isq) { st_bf16x4(L + O_NB + off, m0); st_bf16x4(L + O_NK + off, m1); }
                else {
                    st_bf16x4(L + O_MK + off, m1);
                    if (tb != jb) st_bf16x4(L + O_M21 + fr * S32 + fg * 8, m0);
                    else { float X[16]; tri_inv16(m0, lane, L + O_MS + tb * 1024, X);
                        if (lane < 16) {
#pragma unroll
                            for (int i = 0; i < 16; ++i) *(LAS unsigned short*)(L + O_TI + (tb * 16 + i) * S32 + (tb * 16 + lane) * 2) = (unsigned short)cvtpk(X[i], 0.f);
                            if (tb == 0) { u32x4 a0, a1;
                                a0.x = cvtpk(X[0], X[1]); a0.y = cvtpk(X[2], X[3]); a0.z = cvtpk(X[4], X[5]); a0.w = cvtpk(X[6], X[7]);
                                a1.x = cvtpk(X[8], X[9]); a1.y = cvtpk(X[10], X[11]); a1.z = cvtpk(X[12], X[13]); a1.w = cvtpk(X[14], X[15]);
                                *(LAS u32x4*)(L + O_T11T + lane * S32) = a0; *(LAS u32x4*)(L + O_T11T + lane * S32 + 16) = a1; }
                            else {
#pragma unroll
                                for (int i = 0; i < 16; ++i) *(LAS unsigned short*)(L + O_T22 + i * S32 + lane * 2) = (unsigned short)cvtpk(X[i], 0.f); }
                        } }
                }
            }
        }
        __syncthreads();
        if (w == 1) {
            const f32x4 x4 = mm_tile<1>(L + O_M21, S32, L + O_T11T, S32, z4, lane);
            st_bf16x4(L + O_XT + fr * S32 + fg * 8, x4);
            asm volatile("s_waitcnt lgkmcnt(0)" ::: "memory");
            const f32x4 t4 = mm_tile<1>(L + O_XT, S32, L + O_T22, S32, z4, lane);
            st_bf16x4(L + O_TI + (16 + fr) * S32 + fg * 8, -t4);
        }
        f32x4 yacc[2];
#pragma unroll
        for (int tb = 0; tb < 2; ++tb) {
            f32x4 u4 = mm_tile<4>(L + O_KKT + tb * 16 * S128, S128, L + O_SBF + 16 * w * S128, S128, z4, lane);
            u4 = mm_tile<1>(L + O_MK + tb * 16 * S32, S32, L + O_VT + 16 * w * S32, S32, u4, lane);
            st_bf16x4(L + O_UTT + (16 * w + fr) * S32 + tb * 32 + fg * 8, u4);
            yacc[tb] = mm_tile<4>(L + O_SBF + 16 * w * S128, S128, L + O_RT + tb * 16 * S128, S128, z4, lane);
            yacc[tb] = mm_tile<1>(L + O_VT + 16 * w * S32, S32, L + O_NK + tb * 16 * S32, S32, yacc[tb], lane);
        }
        __syncthreads();
#pragma unroll
        for (int tb = 0; tb < 2; ++tb) {
            const f32x4 u4 = mm_tile<1>(L + O_TI + tb * 16 * S32, S32, L + O_UTT + 16 * w * S32, S32, z4, lane);
            st_bf16x4(L + O_UT + (16 * w + fr) * S32 + tb * 32 + fg * 8, -u4);
        }
        __syncthreads();
        {
#pragma unroll
            for (int tb = 0; tb < 2; ++tb) {
                yacc[tb] = mm_tile<1>(L + O_UT + 16 * w * S32, S32, L + O_NB + tb * 16 * S32, S32, yacc[tb], lane);
                ypend[tb].x = cvtpk(yacc[tb][0], yacc[tb][1]); ypend[tb].y = cvtpk(yacc[tb][2], yacc[tb][3]);
            }
            const float wc = __expf(SC[32 + 32]);
#pragma unroll
            for (int vi = 0; vi < 8; ++vi) {
                f32x4 s4 = Sacc[vi] * wc;
                s4 = mm_tile<1>(L + O_KHT + 16 * w * S32, S32, L + O_VT + 16 * vi * S32, S32, s4, lane);
                s4 = mm_tile<1>(L + O_BHT + 16 * w * S32, S32, L + O_UT + 16 * vi * S32, S32, s4, lane);
                Sacc[vi] = s4;
                st_bf16x4(L + O_SBF + (16 * vi + fr) * S128 + (16 * w + 4 * fg) * 2, s4);
            }
        }
    }
    flush(71);
    __syncthreads();
}

__device__ __forceinline__ void unpack8(const u32x4 w, float (&f)[8]) { f[0] = bflo(w.x); f[1] = bfhi(w.x); f[2] = bflo(w.y); f[3] = bfhi(w.y); f[4] = bflo(w.z); f[5] = bfhi(w.z); f[6] = bflo(w.w); f[7] = bfhi(w.w); }
__device__ __forceinline__ void phase_p4(const Args& A, Ctx& C) {
    const bf16_t* P = WSP(bf16_t, WS_P);
    const bf16_t* yf = WSP(bf16_t, WS_YDIR); const bf16_t* yb = yf + (size_t)NLAT * D;
    const float* bon = WSP(float, WS_BON);
    bf16_t* ymix = WSP(bf16_t, WS_YMIX);
    lbyte* SGb = C.lds;
    lfloat* GO = (lfloat*)(C.lds + 8192);
    const int tid = C.tid, lane = C.lane, w = C.wave;
    const bf16_t* gupt = WSP(const bf16_t, WS_GUPT);
    const int fr = lane & 15, fg = lane >> 4;
    const int c8 = 8 * lane;
    float lnw[8], lnb[8], ong[8], muv[8];
#pragma unroll
    for (int e = 0; e < 8; ++e) { lnw[e] = A.in[I_LNW][c8 + e]; lnb[e] = A.in[I_LNB][c8 + e]; ong[e] = A.in[I_ONG][(c8 + e) & 127]; muv[e] = A.in[I_MU][1024 + c8 + e]; }
    const int tkA = tid >> 5, lA = 4 * (tid & 31);
    float muA[4];
#pragma unroll
    for (int e = 0; e < 4; ++e) muA[e] = A.in[I_MU][1792 + lA + e];
    const bool vup = (1024 + c8) < 1440;
    for (int tile = C.bid; tile < NLAT / 16; tile += C.G) {
        const int row0 = tile * 16;
        __syncthreads();
        {
            const int row = row0 + tkA, t = row & (SEQ - 1); const bool ok = t < SEQ - 64;
            const u32x2 pw = *(const u32x2*)(P + (size_t)row * PLD + 1792 + lA); const u32x2 sw = *(const u32x2*)(P + (size_t)(row + (ok ? 64 : 0)) * PLD + 1792 + lA);
            const float pv[4] = {bflo(pw.x), bfhi(pw.x), bflo(pw.y), bfhi(pw.y)}; const float sv[4] = {bflo(sw.x), bfhi(sw.x), bflo(sw.y), bfhi(sw.y)};
            float o[4];
#pragma unroll
            for (int e = 0; e < 4; ++e) o[e] = sigmoidf_(pv[e] + muA[e] * ((ok ? sv[e] : 0.f) - pv[e]));
            u32x2 ow; ow.x = cvtpk(o[0], o[1]); ow.y = cvtpk(o[2], o[3]); *(LAS u32x2*)(SGb + tkA * 288 + lA * 2) = ow;
        }
        __syncthreads();
#pragma unroll
        for (int i = 0; i < 4; ++i) { const int c0 = 64 * w + 16 * i; f32x4 acc = (f32x4){0.f, 0.f, 0.f, 0.f};
#pragma unroll
            for (int ks = 0; ks < 4; ++ks) { const bf16x8 a = *(const LAS bf16x8*)(SGb + fr * 288 + ks * 64 + fg * 16);
                const bf16x8 bq = *(const bf16x8*)(gupt + (size_t)(c0 + fr) * 128 + ks * 32 + fg * 8);
                acc = __builtin_amdgcn_mfma_f32_16x16x32_bf16(a, bq, acc, 0, 0, 0); }
#pragma unroll
            for (int e = 0; e < 4; ++e) GO[(4 * fg + e) * 512 + c0 + fr] = acc[e]; }
        __syncthreads();
#pragma unroll
        for (int tt = 0; tt < 2; ++tt) {
            const int tk = 2 * w + tt, row = row0 + tk, t = row & (SEQ - 1);
            const bool okv = vup ? (t >= 64) : (t < SEQ - 64);
            const u32x4 wyf = *(const u32x4*)(yf + (size_t)row * D + c8), wyb = *(const u32x4*)(yb + (size_t)row * D + c8);
            const u32x4 wpv = *(const u32x4*)(P + (size_t)row * PLD + 1024 + c8), wsv = *(const u32x4*)(P + (size_t)(row + (okv ? (vup ? -64 : 64) : 0)) * PLD + 1024 + c8);
            const u32x4 wof = *(const u32x4*)(yf + (size_t)row * D + 512 + c8), wob = *(const u32x4*)(yb + (size_t)row * D + 512 + c8);
            const u32x4 wz = *(const u32x4*)(P + (size_t)row * PLD + RW_COLS + 1536 + c8);
            const float bs = bon[(size_t)row * 8 + (lane >> 3)] + bon[((size_t)NLAT + row) * 8 + (lane >> 3)];
            const f32x4 g0 = *(const LAS f32x4*)(GO + tk * 512 + c8), g1 = *(const LAS f32x4*)(GO + tk * 512 + c8 + 4);
            const float gg[8] = {g0.x, g0.y, g0.z, g0.w, g1.x, g1.y, g1.z, g1.w};
            float a[8], bq[8], pv[8], sv[8], y[8];
            unpack8(wyf, a); unpack8(wyb, bq); unpack8(wpv, pv); unpack8(wsv, sv);
            float s1 = 0.f;
#pragma unroll
            for (int e = 0; e < 8; ++e) { y[e] = a[e] + bq[e]; s1 += y[e]; }
            s1 += __shfl_xor(s1, 1); s1 += __shfl_xor(s1, 2); s1 += __shfl_xor(s1, 4);
            const float m = s1 * (1.f / 64.f);
            float s2 = 0.f;
#pragma unroll
            for (int e = 0; e < 8; ++e) { y[e] -= m; s2 += y[e] * y[e]; }
            s2 += __shfl_xor(s2, 1); s2 += __shfl_xor(s2, 2); s2 += __shfl_xor(s2, 4);
            const float rs = __builtin_amdgcn_rsqf(s2 * (1.f / 64.f) + RWKV_EPS);
            float o[8];
#pragma unroll
            for (int e = 0; e < 8; ++e) { const float vv = pv[e] + muv[e] * ((okv ? sv[e] : 0.f) - pv[e]); o[e] = (y[e] * rs * lnw[e] + lnb[e] + bs * vv) * gg[e]; }
            u32x4 ow; ow.x = cvtpk(o[0], o[1]); ow.y = cvtpk(o[2], o[3]); ow.z = cvtpk(o[4], o[5]); ow.w = cvtpk(o[6], o[7]);
            *(u32x4*)(ymix + (size_t)row * D + c8) = ow;
            float of[8], ob[8], z[8];
            unpack8(wof, of); unpack8(wob, ob); unpack8(wz, z);
            float s3 = 0.f;
#pragma unroll
            for (int e = 0; e < 8; ++e) { of[e] += ob[e]; s3 += of[e] * of[e]; }
            s3 += __shfl_xor(s3, 1); s3 += __shfl_xor(s3, 2); s3 += __shfl_xor(s3, 4); s3 += __shfl_xor(s3, 8);
            const float rg = __builtin_amdgcn_rsqf(s3 * (1.f / 128.f) + NORM_EPS);
#pragma unroll
            for (int e = 0; e < 8; ++e) o[e] = of[e] * rg * ong[e] * siluf_(z[e]);
            ow.x = cvtpk(o[0], o[1]); ow.y = cvtpk(o[2], o[3]); ow.z = cvtpk(o[4], o[5]); ow.w = cvtpk(o[6], o[7]);
            *(u32x4*)(ymix + (size_t)row * D + 512 + c8) = ow;
        }
    }
}

__device__ __forceinline__ void convert_experts(const Args& A, Ctx& C) {
    lfloat* scr = (lfloat*)(C.lds + C.wave * 16384);
    const int gw = C.bid * 8 + C.wave, NGW = C.G * 8;
    constexpr int I13 = (D / 64) * (DE / 32);
    constexpr int I2 = (DE / 64) * (D / 32);
    constexpr int PER = 2 * I13 + I2;
    for (int it = gw; it < 257 * PER; it += NGW) {
        const int e = it / PER; int r = it % PER;
        unsigned char* bt13 = A.ws + WS_WEXP + (size_t)e * WEXP_STRIDE; unsigned char* bt2 = bt13 + 512 * 1024;
        const float* w1 = e < NE ? A.in[I_EW1] + (size_t)e * D * DE : A.in[I_SW1];
        const float* w3 = e < NE ? A.in[I_EW3] + (size_t)e * D * DE : A.in[I_SW3];
        const float* w2 = e < NE ? A.in[I_EW2] + (size_t)e * DE * D : A.in[I_SW2];
        if (r < I13) { transpose_item_fp8(w1, D, DE, bt13, RowGLU{0}, SW13, scr, r, C.lane); continue; } r -= I13;
        if (r < I13) { transpose_item_fp8(w3, D, DE, bt13, RowGLU{128}, SW13, scr, r, C.lane); continue; } r -= I13;
        transpose_item_fp8(w2, DE, D, bt2, RowId(), SW2, scr, r, C.lane);
    }
}

__device__ __forceinline__ void phase_p6(const Args& A, Ctx& C) {
    const float* mod = WSP(float, WS_MOD); bf16_t* h2n = WSP(bf16_t, WS_H2N);
    const int gw = C.bid * 8 + C.wave, NGW = C.G * 8;
    for (int row = gw; row < NLAT; row += NGW) {
        const float* m = mod + (size_t)(row >> 11) * MODW;
        norm_mod_row(A.out + (size_t)row * D, A.in[I_N2G], m + 4 * D, m + 3 * D, h2n + (size_t)row * D, C.lane, (unsigned*)(A.ws + WS_H2N8) + (size_t)row * (D / 4));
    }
}

__device__ __forceinline__ void phase_p8(const Args& A, Ctx& C) {
    const float* logit = WSP(float, WS_LOGIT);
    int* tope = WSP(int, WS_TOPE); float* topw = WSP(float, WS_TOPW); int* pos = WSP(int, WS_POS);
    unsigned* cnt = WSP(unsigned, WS_CTL) + CW_CNT;
    const int gw = C.bid * 8 + C.wave, NGW = C.G * 8, lane = C.lane;
    const f32x4 rb = ((const f32x4*)A.in[I_RB])[lane];
    for (int tok = gw; tok < NLAT; tok += NGW) {
        const f32x4 lg = ((const f32x4*)(logit + (size_t)tok * NE))[lane];
        float s[4], sel[4];
#pragma unroll
        for (int i = 0; i < 4; ++i) { s[i] = sigmoidf_(lg[i]); sel[i] = s[i] + rb[i]; }
        float m1 = fmaxf(fmaxf(sel[0], sel[1]), fmaxf(sel[2], sel[3]));
        float m2;
        {
            float a = fmaxf(sel[0], sel[1]), bq = fminf(sel[0], sel[1]), cq = fmaxf(sel[2], sel[3]), dq = fminf(sel[2], sel[3]);
            m2 = fmaxf(fminf(a, cq), fmaxf(bq, dq)); }
#pragma unroll
        for (int o = 1; o < 8; o <<= 1) { const float o1 = __shfl_xor(m1, o), o2 = __shfl_xor(m2, o);
            const float n1 = fmaxf(m1, o1); const float n2 = fmaxf(fminf(m1, o1), fmaxf(m2, o2)); m1 = n1; m2 = n2; }
        const float gs = m1 + m2;
        const int grp = lane >> 3;
        int rank = 0;
#pragma unroll
        for (int gq = 0; gq < 8; ++gq) { const float og = __shfl(gs, gq * 8); rank += (og > gs || (og == gs && gq < grp)) ? 1 : 0; }
        const bool gsel = rank < 4;
        float cand[4];
#pragma unroll
        for (int i = 0; i < 4; ++i) cand[i] = gsel ? sel[i] : -INFINITY;
        int my_e = 0; float my_w = 0.f; float wsum = 0.f;
#pragma unroll
        for (int r = 0; r < 8; ++r) {
            float bv = cand[0]; int bi = 0;
#pragma unroll
            for (int i = 1; i < 4; ++i) if (cand[i] > bv) { bv = cand[i]; bi = i; }
            int be = lane * 4 + bi;
#define P8_STEP(CTRL) { const float ov = dpp_f<CTRL>(bv); const int oe = __builtin_amdgcn_update_dpp(0, be, CTRL, 0xf, 0xf, false); if (ov > bv || (ov == bv && oe < be)) { bv = ov; be = oe; } }
            P8_STEP(0x128) P8_STEP(0x124) P8_STEP(0x122) P8_STEP(0x121)
#undef P8_STEP
            float gv = rdlane(bv, 0); int ge = __builtin_amdgcn_readlane(be, 0);
#pragma unroll
            for (int rr = 1; rr < 4; ++rr) { const float ov = rdlane(bv, 16 * rr); const int oe = __builtin_amdgcn_readlane(be, 16 * rr); if (ov > gv || (ov == gv && oe < ge)) { gv = ov; ge = oe; } }
            be = ge;
            const int ol = be >> 2, oi = be & 3;
            const float mys = oi == 0 ? s[0] : (oi == 1 ? s[1] : (oi == 2 ? s[2] : s[3]));
            const float ws_ = __shfl(mys, ol);
            if (lane == ol) { if (oi == 0) cand[0] = -INFINITY; else if (oi == 1) cand[1] = -INFINITY; else if (oi == 2) cand[2] = -INFINITY; else cand[3] = -INFINITY; }
            wsum += ws_;
            if (lane == r) { my_e = be; my_w = ws_; }
        }
        if (lane < 8) {
            const float w = my_w / wsum * 2.5f;
            const unsigned p = atomicAdd(cnt + my_e, 1u);
            tope[(size_t)tok * 8 + lane] = my_e; topw[(size_t)tok * 8 + lane] = w; pos[(size_t)tok * 8 + lane] = (int)p;
        }
    }
}

__device__ __forceinline__ void tile_prefix(const Args& A, Ctx& C, LAS int* tb) {
    const unsigned* cnt = WSP(unsigned, WS_CTL) + CW_CNT;
    if (C.tid == 0) { int acc = 0; for (int e = 0; e < NE; ++e) { tb[e] = acc; acc += ((int)cnt[e] + 255) >> 8; } tb[NE] = acc; }
    __syncthreads();
}
__device__ __forceinline__ void phase_p9(const Args& A, Ctx& C) {
    LAS int* tb = (LAS int*)C.lds;
    tile_prefix(A, C, tb);
    const unsigned* cnt = WSP(unsigned, WS_CTL) + CW_CNT;
    const int* tope = WSP(int, WS_TOPE); const float* topw = WSP(float, WS_TOPW); const int* pos = WSP(int, WS_POS);
    int* rowl = WSP(int, WS_ROWL); float* roww = WSP(float, WS_ROWW); int* tile_e = WSP(int, WS_TILEE);
    const int nrt = tb[NE];
    for (int i = C.bid * 512 + C.tid; i < NLAT * 8; i += C.G * 512) { const int e = tope[i]; const int pr = tb[e] * 256 + pos[i]; rowl[pr] = i; roww[pr] = topw[i]; }
    for (int e = C.bid; e < NE; e += C.G) { const int n = (int)cnt[e], nt = tb[e + 1] - tb[e];
        for (int j = n + C.tid; j < nt * 256; j += 512) { rowl[tb[e] * 256 + j] = -1; roww[tb[e] * 256 + j] = 0.f; }
        for (int k = C.tid; k < nt; k += 512) tile_e[tb[e] + k] = e; }
    for (int i = C.bid * 512 + C.tid; i < NLAT; i += C.G * 512) { rowl[nrt * 256 + i] = i; roww[nrt * 256 + i] = 1.f; }
    for (int k = C.bid * 512 + C.tid; k < NLAT / 256; k += C.G * 512) tile_e[nrt + k] = NE;
    __syncthreads();
}

__device__ __forceinline__ void phase_moe(const Args& A, Ctx& C, int dry_shared) {
    LAS int* tb = (LAS int*)(C.lds + 131072);
    LAS int* tbl = tb + 320;
    tile_prefix(A, C, tb);
    pg8::MoeCtx M;
    M.nrt = tb[NE]; M.ntiles = M.nrt + NLAT / 256; M.G = C.G; M.vc = (C.G % 8 == 0) ? (C.bid % 8) * (C.G / 8) + C.bid / 8 : C.bid;
    M.tb = tb; M.tbl = tbl; M.cnt = WSP(unsigned, WS_CTL) + CW_CNT; M.rowl = WSP(int, WS_ROWL); M.roww = WSP(float, WS_ROWW);
    M.wexp = (const char*)(A.ws + WS_WEXP); M.h2n = (const char*)(A.ws + WS_H2N8); M.Hs = (char*)(A.ws + WS_HS) + (size_t)C.bid * 2 * 65536;
    M.Y = (unsigned char*)(A.ws + WS_Y); M.out = A.out; M.mod = WSP(const float, WS_MOD); M.dry_shared = dry_shared;
    pg8::gemm_moe(C.lds, M);
    __syncthreads();
}

__device__ __forceinline__ void phase_final(const Args& A, Ctx& C, float* dst) {
    const int gw = C.bid * 8 + C.wave, NGW = C.G * 8;
    const float* fg = A.in[I_FG]; const float* mod = WSP(const float, WS_MOD);
    const unsigned* Y = (const unsigned*)(A.ws + WS_Y);
    for (int row = gw; row < NLAT; row += NGW) {
        f32x4* xr = (f32x4*)(A.out + (size_t)row * D) + C.lane;
        const f32x4* gt = (const f32x4*)(mod + (size_t)(row >> 11) * MODW + 5 * D) + C.lane;
        const unsigned* yr = Y + (size_t)row * 8 * (D / 4) + C.lane;
        f32x4 v[4]; float s = 0.f;
#pragma unroll
        for (int j = 0; j < 4; ++j) {
            f32x4 a = (f32x4){0.f, 0.f, 0.f, 0.f};
#pragma unroll
            for (int sl = 0; sl < 8; ++sl) { const unsigned w = yr[sl * (D / 4) + 64 * j];
                const f32x2 lo = __builtin_amdgcn_cvt_pk_f32_fp8(w, false), hi = __builtin_amdgcn_cvt_pk_f32_fp8(w, true);
                a.x += lo.x; a.y += lo.y; a.z += hi.x; a.w += hi.y; }
            v[j] = xr[64 * j] + gt[64 * j] * a * (1.f / pg8::YSCALE);
            s += (v[j].x * v[j].x + v[j].y * v[j].y) + (v[j].z * v[j].z + v[j].w * v[j].w); }
        const float rstd = __builtin_amdgcn_rsqf(wave_sum(s) * (1.f / D) + NORM_EPS);
        f32x4* orow = (f32x4*)(dst + (size_t)row * D) + C.lane;
#pragma unroll
        for (int j = 0; j < 4; ++j) orow[64 * j] = v[j] * rstd * ((const f32x4*)fg)[C.lane + 64 * j];
    }
}

constexpr int NPHASE = 13;
__global__ void __launch_bounds__(512, 2) fwd_kernel(Args A) {
    extern __shared__ __attribute__((aligned(16))) unsigned char lds_raw[];
    Ctx C; C.lds = (lbyte*)lds_raw; C.tid = threadIdx.x; C.lane = C.tid & 63; C.wave = __builtin_amdgcn_readfirstlane(C.tid >> 6);
    C.G = gridDim.x; C.bid = blockIdx.x; C.a = &A;
    volatile LAS unsigned* misc = (volatile LAS unsigned*)(C.lds + LDS_MISC);
    if (C.tid < 16) misc[C.tid] = 0u;
    __syncthreads();
    XcdBarrier bar; bar.bar = WSP(unsigned, WS_CTL) + CW_BAR; bar.x = 0; bar.st = nullptr;
    const int lo = A.ph_lo, hi = A.ph_hi;
    const bool multi = (hi - lo) > 1;
    if (multi) bar = xcd_barrier_post(WSP(unsigned, WS_CTL) + CW_BAR, misc);
#ifndef PHASE_MASK
#define PHASE_MASK 0x1FFF
#endif
#define IN(k) (((PHASE_MASK >> (k)) & 1) && lo <= (k) && (k) < hi)
#define SEAM(k) do { if (IN(k) && IN((k) + 1)) xcd_barrier(bar); } while (0)
#ifndef REP_MASK
#define REP_MASK 0
#endif
#define REPS(k) (((REP_MASK >> (k)) & 1) ? 2 : 1)

    if (IN(0)) _Pragma("unroll") for (int rep = 0; rep < REPS(0); ++rep) { phase_p0(A, C); __syncthreads(); } SEAM(0);
    if (IN(1)) _Pragma("unroll") for (int rep = 0; rep < REPS(1); ++rep) { phase_p1(A, C); } SEAM(1);
    if (IN(2)) _Pragma("unroll") for (int rep = 0; rep < REPS(2); ++rep) {
        pg8::Gemm g{WSP(bf16_t, WS_XN), D}; pg8::StaticOrder S; S.init(NROWS, PLD, C.G, C.bid, WSP(bf16_t, WS_BTIN), D, 1);
        pg8::EpiBf16 E{WSP(bf16_t, WS_P), PLD, 1.f / SWIN};
        pg8::gemm_phase<pg8::EpiBf16, pg8::StaticOrder, false, 0, false, true>(C.lds, g, S, E);
    } SEAM(2);
    if (IN(3)) _Pragma("unroll") for (int rep = 0; rep < REPS(3); ++rep) { phase_gdn_prep(A, C); } SEAM(3);
#ifdef PROBE_BARRIERS
    if (multi) for (int kq = 0; kq < PROBE_BARRIERS; ++kq) xcd_barrier(bar);
#endif
    if (IN(4)) {
        for (int ch = C.bid; ch < NB * HB * 2; ch += C.G) gdn_chain_chunked(A, C, ch);
        for (int pr = C.bid; pr < NB * HA; pr += C.G) rwkv_pair_chunked(A, C, pr);
    } SEAM(4);
    if (IN(5)) _Pragma("unroll") for (int rep = 0; rep < REPS(5); ++rep) { phase_p4(A, C); } SEAM(5);
    if (IN(6)) _Pragma("unroll") for (int rep = 0; rep < REPS(6); ++rep) {
        pg8::Gemm g{WSP(bf16_t, WS_YMIX), D}; pg8::StaticOrder S; S.init(NLAT, D, C.G, C.bid, WSP(bf16_t, WS_BTOUT), D);
        pg8::EpiResGate E{A.in[I_X], A.out, WSP(float, WS_MOD), 2 * D};
        pg8::gemm_phase<pg8::EpiResGate, pg8::StaticOrder, false>(C.lds, g, S, E);
    } SEAM(6);
    if (IN(7)) _Pragma("unroll") for (int rep = 0; rep < REPS(7); ++rep) { phase_p6(A, C); __syncthreads(); convert_experts(A, C); __syncthreads(); } SEAM(7);
    if (IN(8)) _Pragma("unroll") for (int rep = 0; rep < REPS(8); ++rep) {
        pg8::Gemm g{WSP(bf16_t, WS_H2N), D}; pg8::StaticOrder S; S.init(NLAT, NE, C.G, C.bid, WSP(bf16_t, WS_BTR), D);
        pg8::EpiF32 E{WSP(float, WS_LOGIT), NE};
        pg8::gemm_phase<pg8::EpiF32, pg8::StaticOrder, false>(C.lds, g, S, E);
    } SEAM(8);
    if (IN(9)) { phase_p8(A, C); } SEAM(9);
    if (IN(10)) _Pragma("unroll") for (int rep = 0; rep < REPS(10); ++rep) { phase_p9(A, C); } SEAM(10);
    if (IN(11)) { phase_moe(A, C, 0); if (REPS(11) > 1) { __syncthreads(); phase_moe(A, C, 1); } } SEAM(11);
    if (IN(12)) { if (REPS(12) > 1) { phase_final(A, C, (float*)(A.ws + WS_WEXP)); __syncthreads(); } phase_final(A, C, A.out); }
#undef IN
#undef SEAM
}

extern "C" void kernel_launch(void* const* d_in, const int* in_sizes, int n_in, void* d_out, int out_size, void* d_ws, size_t ws_size, hipStream_t stream) {
    static int grid = 0;
    if (grid == 0) {
        if (n_in != 34 || out_size != NLAT * D || ws_size < WS_END) { fprintf(stderr, "kernel_launch: unexpected shapes (n_in %d out %d ws %zu need %zu)\n", n_in, out_size, ws_size, (size_t)WS_END); grid = -1; return; }
        int dev = 0, cus = 0;
        if (hipGetDevice(&dev) != hipSuccess || hipDeviceGetAttribute(&cus, hipDeviceAttributeMultiprocessorCount, dev) != hipSuccess) { grid = -1; return; }
        if (hipFuncSetAttribute((const void*)fwd_kernel, hipFuncAttributeMaxDynamicSharedMemorySize, LDS_BYTES) != hipSuccess) { fprintf(stderr, "kernel_launch: hipFuncSetAttribute failed\n"); grid = -1; return; }
        int per_cu = 0;
        if (hipOccupancyMaxActiveBlocksPerMultiprocessor(&per_cu, (const void*)fwd_kernel, 512, LDS_BYTES) != hipSuccess || per_cu < 1) { fprintf(stderr, "kernel_launch: occupancy query says %d\n", per_cu); }
        (void)hipGetLastError();
        grid = cus;
    }
    if (grid < 0) return;
    (void)hipMemsetAsync((char*)d_ws + WS_CTL, 0, CTL_BYTES, stream);
    Args a{};
    for (int i = 0; i < 34; ++i) a.in[i] = (const float*)d_in[i];
    a.out = (float*)d_out; a.ws = (unsigned char*)d_ws;
#if MK_PER_PHASE
    for (int p = 0; p < NPHASE; ++p) { a.ph_lo = p; a.ph_hi = p + 1; hipLaunchKernelGGL(fwd_kernel, dim3(grid), dim3(512), LDS_BYTES, stream, a); }
#else
    a.ph_lo = 0; a.ph_hi = NPHASE; hipLaunchKernelGGL(fwd_kernel, dim3(grid), dim3(512), LDS_BYTES, stream, a);
#endif
}
```

```cpp
#include <hip/hip_runtime.h>
#include <cstdio>
#include <cstdint>

#ifndef MK_PER_PHASE
#define MK_PER_PHASE 0
#endif

#define LAS __attribute__((address_space(3)))
typedef unsigned short bf16_t;
typedef short bf16x8 __attribute__((ext_vector_type(8)));
typedef float f32x4 __attribute__((ext_vector_type(4)));
typedef float f32x2 __attribute__((ext_vector_type(2)));
typedef unsigned u32x4 __attribute__((ext_vector_type(4)));
typedef unsigned u32x2 __attribute__((ext_vector_type(2)));
typedef int i32x4 __attribute__((ext_vector_type(4)));
typedef int i32x8 __attribute__((ext_vector_type(8)));
typedef LAS float lfloat;
typedef LAS unsigned char lbyte;

constexpr int D = 1024, NB = 32, SEQ = 2048, CTX = 256, GW = 64;
constexpr int NLAT = NB * SEQ;
constexpr int NCTX = NB * CTX;
constexpr int NROWS = NLAT + NCTX;
constexpr int DA = 512, HA = 8, NA = 64;
constexpr int RW_COLS = 1920, GD_COLS = 2064, IN_COLS = 3984, PLD = 4096;
constexpr int DB = 512, HB = 4, KB = 128;
constexpr int NE = 256, TOPK = 8, DE = 256;
constexpr int MODW = 6 * D;
constexpr float NORM_EPS = 1e-6f, RWKV_EPS = 64e-5f;
constexpr int MAXTILES = (NLAT * TOPK + NE * 255) / 256 + 1;

constexpr size_t MiB = 1u << 20;
constexpr size_t WS_CTL = 0, CTL_BYTES = 1 * MiB;
constexpr size_t WS_MOD = 1 * MiB;
constexpr size_t WS_BTIN = 2 * MiB, WS_BTOUT = 10 * MiB, WS_BTR = 12 * MiB, WS_BON = 13 * MiB, WS_GUPT = 17 * MiB, WS_NRM = 978 * MiB;
constexpr size_t WS_P = 18 * MiB, WS_XN = 594 * MiB, WS_YDIR = 594 * MiB, WS_YMIX = 850 * MiB;
constexpr size_t WS_H2N8 = 900 * MiB;
constexpr size_t WS_H2N = 18 * MiB, WS_LOGIT = 146 * MiB, WS_TOPE = 210 * MiB, WS_TOPW = 212 * MiB, WS_POS = 214 * MiB, WS_Y = 146 * MiB;
constexpr size_t WS_ROWL = 658 * MiB, WS_ROWW = 661 * MiB, WS_TILEE = 664 * MiB, WS_HS = 672 * MiB, WS_WEXP = 704 * MiB;
constexpr size_t WEXP_STRIDE = (size_t)(512 * 1024 + 1024 * 256);
constexpr float SW13 = 64.f, SW2 = 32.f, SHS = 8.f, SWIN = 32.f;
constexpr size_t WS_END = 1090 * MiB;
static_assert(WS_WEXP + 257 * WEXP_STRIDE <= WS_END && WS_Y + (size_t)NLAT * 8 * D <= WS_ROWL, "ws map");
constexpr int CW_BAR = 4096;
constexpr int CW_CNT = 16384;

constexpr int LDS_BYTES = 159744;
constexpr int LDS_MISC = LDS_BYTES - 64;

__device__ __forceinline__ unsigned f2bf(float f) { unsigned u = __builtin_bit_cast(unsigned, f); return (u + 0x7fffu + ((u >> 16) & 1u)) >> 16; }
typedef __bf16 bf16x2_t __attribute__((ext_vector_type(2)));
__device__ __forceinline__ unsigned cvtpk(float lo, float hi) { f32x2 v = {lo, hi}; return __builtin_bit_cast(unsigned, __builtin_convertvector(v, bf16x2_t)); }
__device__ __forceinline__ unsigned pk2(float lo, float hi) { return cvtpk(lo, hi); }
__device__ __forceinline__ unsigned pk4_fp8(float a, float b, float c, float d) { unsigned w = 0u;
    w = __builtin_amdgcn_cvt_pk_fp8_f32(__builtin_amdgcn_fmed3f(a, -448.f, 448.f), __builtin_amdgcn_fmed3f(b, -448.f, 448.f), w, false);
    w = __builtin_amdgcn_cvt_pk_fp8_f32(__builtin_amdgcn_fmed3f(c, -448.f, 448.f), __builtin_amdgcn_fmed3f(d, -448.f, 448.f), w, true); return w; }
__device__ __forceinline__ float bf2f(unsigned short b) { return __builtin_bit_cast(float, ((unsigned)b) << 16); }
__device__ __forceinline__ float bflo(unsigned w) { return __builtin_bit_cast(float, w << 16); }
__device__ __forceinline__ float bfhi(unsigned w) { return __builtin_bit_cast(float, w & 0xffff0000u); }
template <int CTRL> __device__ __forceinline__ float dpp_f(float v) { return __builtin_bit_cast(float, __builtin_amdgcn_update_dpp(0, __builtin_bit_cast(int, v), CTRL, 0xf, 0xf, false)); }
__device__ __forceinline__ float wave_sum(float v) {
    v += dpp_f<0x128>(v);
    v += dpp_f<0x124>(v);
    v += dpp_f<0x122>(v);
    v += dpp_f<0x121>(v);
    const int vi = __builtin_bit_cast(int, v);
    const float r0 = __builtin_bit_cast(float, __builtin_amdgcn_readlane(vi, 0)), r1 = __builtin_bit_cast(float, __builtin_amdgcn_readlane(vi, 16)),
                r2 = __builtin_bit_cast(float, __builtin_amdgcn_readlane(vi, 32)), r3 = __builtin_bit_cast(float, __builtin_amdgcn_readlane(vi, 48));
    return (r0 + r1) + (r2 + r3);
}
__device__ __forceinline__ float sigmoidf_(float x) { return __builtin_amdgcn_rcpf(1.f + __expf(-x)); }
__device__ __forceinline__ float siluf_(float x) { return x * __builtin_amdgcn_rcpf(1.f + __expf(-x)); }
__device__ __forceinline__ float softplusf_(float x) { return fmaxf(x, 0.f) + __logf(1.f + __expf(-fabsf(x))); }
__device__ __forceinline__ float tanhf_(float x) { const float e = __expf(-2.f * fabsf(x)); const float t = (1.f - e) * __builtin_amdgcn_rcpf(1.f + e); return x < 0.f ? -t : t; }

#define XB_TMO      128
#define XB_XCNT(j)  (256  + 64 * (j))
#define XB_XSUB(j)  (1280 + 64 * (j))
#define XB_XGEN(j)  (2304 + 64 * (j))
#define XB_TOP      3328
#define XB_TOPGEN   3392
#define XCD_BAR_WORDS 3456
#define XB_SPIN_CAP (1u << 22)
__device__ __forceinline__ unsigned xb_ld(unsigned* p)              { return __hip_atomic_load(p, __ATOMIC_RELAXED, __HIP_MEMORY_SCOPE_AGENT); }
__device__ __forceinline__ unsigned xb_add(unsigned* p, unsigned v) { return __hip_atomic_fetch_add(p, v, __ATOMIC_RELAXED, __HIP_MEMORY_SCOPE_AGENT); }
__device__ __forceinline__ unsigned xb_xcc_id() { return (unsigned)__builtin_amdgcn_s_getreg((3 << 11) | 20) & 0xFu; }
#define XB_SPIN(cond, bar) do { unsigned _sp = 0; while (cond) { __builtin_amdgcn_s_sleep(1); \
    if ((++_sp & 255u) == 0u) { if (xb_ld(&(bar)[XB_TMO])) break; if (_sp > XB_SPIN_CAP) { atomicAdd(&(bar)[XB_TMO], 1u); break; } } } } while (0)
struct XcdBarrier { unsigned* bar; unsigned x; volatile LAS unsigned* st; };
__device__ __forceinline__ XcdBarrier xcd_barrier_post(unsigned* bar, volatile LAS unsigned* st) {
    XcdBarrier b; b.bar = bar; b.x = xb_xcc_id(); b.st = st;
    if (threadIdx.x == 0) (void)xb_add(&bar[XB_XCNT(b.x)], 1u);
    return b;
}
__device__ __forceinline__ void xcd_barrier_complete(unsigned* bar, unsigned x, unsigned& nloc, unsigned& nx) {
    const unsigned G = gridDim.x * gridDim.y * gridDim.z;
    unsigned sum, cnt, mine, sp = 0u;
    for (;;) {
        sum = 0u; cnt = 0u; mine = 0u;
#pragma unroll
        for (unsigned j = 0; j < 16; ++j) { const unsigned c = xb_ld(&bar[XB_XCNT(j)]); sum += c; cnt += (c > 0u) ? 1u : 0u; mine = (j == x) ? c : mine; }
        if (sum == G) break;
        __builtin_amdgcn_s_sleep(1);
        if ((++sp & 255u) == 0u) { if (xb_ld(&bar[XB_TMO])) break; if (sp > XB_SPIN_CAP) { atomicAdd(&bar[XB_TMO], 1u); break; } }
    }
    nloc = mine > 0u ? mine : 1u; nx = cnt > 0u ? cnt : 1u;
}
__device__ __forceinline__ void xcd_barrier(const XcdBarrier& b) {
    asm volatile("s_waitcnt vmcnt(0)" ::: "memory");
    __syncthreads();
    if (threadIdx.x == 0) {
        unsigned* bar = b.bar;
        __builtin_amdgcn_s_waitcnt(0);
        unsigned nloc = b.st[0], nx = b.st[1];
        if (nloc == 0u) { xcd_barrier_complete(bar, b.x, nloc, nx); b.st[0] = nloc; b.st[1] = nx; }
        const unsigned old = xb_add(&bar[XB_XSUB(b.x)], 1u);
        const unsigned gen = old / nloc;
        if (old + 1u == (gen + 1u) * nloc) {
            __builtin_amdgcn_fence(__ATOMIC_RELEASE, "agent");
            asm volatile("s_waitcnt vmcnt(0)" ::: "memory");
            const unsigned og = xb_add(&bar[XB_TOP], 1u);
            const unsigned tg = og / nx;
            if (og + 1u == (tg + 1u) * nx) xb_add(&bar[XB_TOPGEN], 1u);
            else XB_SPIN(xb_ld(&bar[XB_TOPGEN]) == tg, bar);
            __builtin_amdgcn_fence(__ATOMIC_ACQUIRE, "agent");
            xb_add(&bar[XB_XGEN(b.x)], 1u);
            asm volatile("s_waitcnt vmcnt(0)" ::: "memory");
        } else {
            XB_SPIN(xb_ld(&bar[XB_XGEN(b.x)]) == gen, bar);
            __builtin_amdgcn_fence(__ATOMIC_ACQUIRE, "agent");
            asm volatile("s_waitcnt vmcnt(0)" ::: "memory");
        }
    }
    __syncthreads();
}

struct Args {
    const float* in[34];
    float* out;
    unsigned char* ws;
    int ph_lo, ph_hi;
};
enum { I_X = 0, I_C, I_CTX, I_CCTX, I_WADA, I_BADA, I_N1G, I_WIN, I_MU, I_W0, I_WUP, I_A0, I_AUP, I_GUP, I_KK, I_KA, I_RK, I_LNW, I_LNB,
       I_CONVW, I_ALOG, I_DTB, I_ONG, I_WOUT, I_N2G, I_RW, I_RB, I_EW1, I_EW3, I_EW2, I_SW1, I_SW3, I_SW2, I_FG };

namespace pg8 {
constexpr int BM = 256, BK = 64, HALF = 128, HTB = HALF * BK * 2, STAGE_BYTES = 8 * HTB, NXCD = 8, WGM = 8;
__host__ __device__ __forceinline__ int lds_byte(int r, int c) { const int st = (r >> 4) * 2 + (c >> 5), rr = r & 15, cc = c & 31, ob = rr * 64 + cc * 2; return st * 1024 + (ob ^ (((ob >> 9) & 1) << 5)); }
__host__ __device__ __forceinline__ void stage_rc(int b, int& R, int& C) { const int st = b / 1024, sb = b % 1024, swz = sb ^ (((sb >> 9) & 1) << 5); R = (st >> 1) * 16 + swz / 64; C = (st & 1) * 32 + (swz % 64) / 2; }
__host__ __device__ __forceinline__ int perm32(int rho) { const int n = rho >> 4, i = rho & 15; return 8 * (i >> 2) + 4 * n + (i & 3); }
struct Unit { int pm, pn; };
struct Gemm { const bf16_t* A; int K; };
struct StaticOrder {
    int nM, nN, nwg, G, c; const char* Bt; size_t tstepB;
    __device__ void init(int M, int N, int G_, int c_, const void* Bt_, int K, int es = 2) { nM = M / BM; nN = N / BM; nwg = nM * nN; G = G_; c = c_; Bt = (const char*)Bt_; tstepB = (size_t)BM * K * es; }
    __device__ bool next(int i, Unit& u) const {
        const long L = (long)i * G + c; if (L >= nwg) return false;
        int wgid = (int)L; { const int q = nwg / NXCD, r = nwg % NXCD, xcd = wgid % NXCD, off = wgid / NXCD; wgid = (xcd < r ? xcd * (q + 1) : r * (q + 1) + (xcd - r) * q) + off; }
        const int nig = WGM * nN, gid = wgid / nig, fm = gid * WGM, gsz = (nM - fm) < WGM ? (nM - fm) : WGM;
        u.pm = fm + ((wgid % nig) % gsz); u.pn = (wgid % nig) / gsz; return true;
    }
    __device__ __forceinline__ const char* bptr(const Unit& u) const { return Bt + (size_t)u.pn * tstepB; }
    __device__ __forceinline__ int rowsel(const Unit&, int) const { return 0; }
};
struct TileOrder {
    int nunits, npn, G, c; const int* tile_e; const char* wbase; size_t wstride, woff, tstepB; const int* rowl;
    __device__ bool next(int i, Unit& u) const { const int L = i * G + c; if (L >= nunits) return false; u.pm = L / npn; u.pn = L - u.pm * npn; return true; }
    __device__ __forceinline__ const char* bptr(const Unit& u) const { const int e = __builtin_amdgcn_readfirstlane(tile_e[u.pm]); return wbase + (size_t)e * wstride + woff + (size_t)u.pn * tstepB; }
    __device__ __forceinline__ int rowsel(const Unit& u, int r) const { const int t = rowl[(size_t)u.pm * 256 + r]; return t < 0 ? 0 : t; }
};
struct SeqOrder {
    int n; const char* Bt; size_t tstepB; const LAS int* rsel;
    __device__ bool next(int i, Unit& u) const { if (i >= n) return false; u.pm = 0; u.pn = i; return true; }
    __device__ __forceinline__ const char* bptr(const Unit& u) const { return Bt + (size_t)u.pn * tstepB; }
    __device__ __forceinline__ int rowsel(const Unit&, int r) const { return rsel[r]; }
};
__device__ __forceinline__ unsigned cvt_pk_bf16(float lo, float hi) { return cvtpk(lo, hi); }

template <class Epi, class Sched, bool GATHER, int A_AUX = 0, bool ALIGN = true, bool FP8 = false>
__device__ __forceinline__ void gemm_phase(lbyte* lds, const Gemm g, const Sched& S, const Epi& E) {
    int tid_ = threadIdx.x; asm volatile("" : "+v"(tid_));
    const int tid = tid_, wid = __builtin_amdgcn_readfirstlane(tid >> 6), lane = tid & 63, wr = wid >> 2, wc = wid & 3, fr = lane & 15, fq = lane >> 4;
    constexpr unsigned ES = FP8 ? 1u : 2u;
    const int K = g.K, nt = FP8 ? K / 128 : K / BK;
    Unit cur, nxt; int ui = 0;
    if (!S.next(0, cur)) return;
    int Rst[2], Cst[2];
    unsigned voffA[2], voffA1[2], voffB[2], nvA[2], nvA1[2];
#pragma unroll
    for (int i = 0; i < 2; ++i) { int R, C; stage_rc(tid * 16 + i * 8192, R, C); const int Rb = Epi::PERM ? ((R & ~31) + perm32(R & 31)) : R; Rst[i] = R; Cst[i] = C;
        if (GATHER) { voffA[i] = (unsigned)S.rowsel(cur, R) * (unsigned)K * ES + (unsigned)C * 2u; voffA1[i] = (unsigned)S.rowsel(cur, 128 + R) * (unsigned)K * ES + (unsigned)C * 2u; }
        else { voffA[i] = (unsigned)(R * K) * ES + (unsigned)C * 2u; voffA1[i] = voffA[i]; }
        nvA[i] = voffA[i]; nvA1[i] = voffA1[i];
        voffB[i] = (unsigned)(Rb * K) * ES + (unsigned)C * 2u; }
    const size_t kstep = (size_t)(BK * 2);
    const size_t hstep = (size_t)HALF * K * ES;
    const size_t hstepA = GATHER ? 0 : hstep;
    const size_t tstep = 2 * hstep;
    const unsigned ldsw = (unsigned)wid * 1024u;
    const int aoff = lds_byte(wr * 64 + fr, FP8 ? fq * 16 : fq * 8), boff = lds_byte(wc * 32 + fr, FP8 ? fq * 16 : fq * 8);
#define PG8_SA(b, h) (((b) * 2 + (h)) * HTB)
#define PG8_SB(b, h) ((4 + (b) * 2 + (h)) * HTB)
#define PG8_STAGE2(bufoff, gbase, v0, v1) do { \
        __builtin_amdgcn_global_load_lds((const unsigned*)((const char*)(gbase) + (v0)), (LAS unsigned*)(lds + (bufoff) + ldsw), 16, 0, 0); \
        __builtin_amdgcn_global_load_lds((const unsigned*)((const char*)(gbase) + (v1)), (LAS unsigned*)(lds + (bufoff) + ldsw + 8192), 16, 0, 0); } while (0)
#define PG8_STAGE2A(bufoff, gbase, v0, v1) do { if constexpr (A_AUX == 16) { \
        __builtin_amdgcn_global_load_lds((const unsigned*)((const char*)(gbase) + (v0)), (LAS unsigned*)(lds + (bufoff) + ldsw), 16, 0, 16); \
        __builtin_amdgcn_global_load_lds((const unsigned*)((const char*)(gbase) + (v1)), (LAS unsigned*)(lds + (bufoff) + ldsw + 8192), 16, 0, 16); } else { PG8_STAGE2(bufoff, gbase, v0, v1); } } while (0)
#define PG8_STAGE(bufoff, gbase, voff) PG8_STAGE2(bufoff, gbase, (voff)[0], (voff)[1])
#define PG8_STAGEA(bufoff, gbase, voff) PG8_STAGE2A(bufoff, gbase, (voff)[0], (voff)[1])
#define G_LD32(p) __builtin_shufflevector(*(const LAS i32x4*)(p), *(const LAS i32x4*)((p) + 16), 0, 1, 2, 3, 4, 5, 6, 7)
#define G_MFMA8(c, a, b) asm volatile("v_mfma_scale_f32_16x16x128_f8f6f4 %0, %1, %2, %0, %3, %3 op_sel_hi:[0,0,0]" : "+v"(c) : "v"(a), "v"(b), "v"(one_scale))
#define PG8_LDA(dst, b, h) do { if constexpr (FP8) { _Pragma("unroll") for (int m = 0; m < 4; ++m) dst##8[m] = G_LD32(lds + PG8_SA(b, h) + aoff + m * 2048); } else { \
        _Pragma("unroll") for (int m = 0; m < 4; ++m) _Pragma("unroll") for (int k = 0; k < 2; ++k) dst[m][k] = *(const LAS bf16x8*)(lds + PG8_SA(b, h) + aoff + m * 2048 + k * 1024); } } while (0)
#define PG8_LDB(dst, b, h) do { if constexpr (FP8) { _Pragma("unroll") for (int n = 0; n < 2; ++n) dst##8[n] = G_LD32(lds + PG8_SB(b, h) + boff + n * 2048); } else { \
        _Pragma("unroll") for (int n = 0; n < 2; ++n) _Pragma("unroll") for (int k = 0; k < 2; ++k) dst[n][k] = *(const LAS bf16x8*)(lds + PG8_SB(b, h) + boff + n * 2048 + k * 1024); } } while (0)
#define PG8_MMA(ai, bj, At, Bt) do { __builtin_amdgcn_s_setprio(1); if constexpr (FP8) { _Pragma("unroll") for (int m = 0; m < 4; ++m) _Pragma("unroll") for (int n = 0; n < 2; ++n) G_MFMA8(acc[ai][bj][m][n], Bt##8[n], At##8[m]); } else { \
        _Pragma("unroll") for (int m = 0; m < 4; ++m) _Pragma("unroll") for (int n = 0; n < 2; ++n) _Pragma("unroll") for (int k = 0; k < 2; ++k) \
        acc[ai][bj][m][n] = __builtin_amdgcn_mfma_f32_16x16x32_bf16(Bt[n][k], At[m][k], acc[ai][bj][m][n], 0, 0, 0); } __builtin_amdgcn_s_setprio(0); } while (0)
#define PG8_WAIT_V(n) asm volatile("s_waitcnt vmcnt(" #n ")" ::: "memory")
#define PG8_WAIT_L(n) asm volatile("s_waitcnt lgkmcnt(" #n ")" ::: "memory")
#define PG8_BAR __builtin_amdgcn_s_barrier()
#define PG8_SCHED __builtin_amdgcn_sched_barrier(0)
    f32x4 acc[2][2][4][2];
#pragma unroll
    for (int a = 0; a < 2; ++a)
#pragma unroll
        for (int b = 0; b < 2; ++b)
#pragma unroll
            for (int m = 0; m < 4; ++m)
#pragma unroll
                for (int n = 0; n < 2; ++n) acc[a][b][m][n] = (f32x4){0.f, 0.f, 0.f, 0.f};
    bf16x8 At[4][2], B0[2][2], B1[2][2]; i32x8 At8[4], B08[2], B18[2];
    int one_scale = 0x7F7F7F7F; asm volatile("" : "+v"(one_scale));
    const char* cA = (const char*)g.A + (GATHER ? (size_t)0 : (size_t)cur.pm * tstep); const char* cB = S.bptr(cur);
    PG8_STAGE(PG8_SB(0, 0), cB, voffB); PG8_STAGE(PG8_SB(0, 1), cB + hstep, voffB); PG8_STAGEA(PG8_SA(0, 0), cA, voffA); PG8_STAGEA(PG8_SA(0, 1), cA + hstepA, voffA1);
    if (wr == 1) PG8_BAR;
    PG8_WAIT_V(2); PG8_BAR;
    PG8_STAGE(PG8_SB(1, 0), cB + kstep, voffB); PG8_STAGEA(PG8_SA(1, 0), cA + kstep, voffA); PG8_STAGE(PG8_SB(1, 1), cB + hstep + kstep, voffB);
    PG8_WAIT_V(6); PG8_BAR;
    for (;;) {
        const bool has_next = S.next(ui + 1, nxt);
        const char* nA = has_next ? (const char*)g.A + (GATHER ? (size_t)0 : (size_t)nxt.pm * tstep) : cA; const char* nB = has_next ? S.bptr(nxt) : cB;
        for (int t = 0; t < nt; t += 2) {
            const bool last = (t == nt - 2);
            const char* a1 = cA + (size_t)(t + 1) * kstep;
            const char* a2 = last ? nA : cA + (size_t)(t + 2) * kstep; const char* b2 = last ? nB : cB + (size_t)(t + 2) * kstep;
            const char* a3 = a2 + kstep; const char* b3 = b2 + kstep;
            if (GATHER && last && has_next) {
#pragma unroll
                for (int i = 0; i < 2; ++i) { nvA[i] = (unsigned)S.rowsel(nxt, Rst[i]) * (unsigned)K * ES + (unsigned)Cst[i] * 2u; nvA1[i] = (unsigned)S.rowsel(nxt, 128 + Rst[i]) * (unsigned)K * ES + (unsigned)Cst[i] * 2u; }
            }
            const unsigned x0 = (GATHER && last) ? nvA[0] : voffA[0], x1 = (GATHER && last) ? nvA[1] : voffA[1];
            const unsigned y0 = (GATHER && last) ? nvA1[0] : voffA1[0], y1 = (GATHER && last) ? nvA1[1] : voffA1[1];
            PG8_LDB(B0, 0, 0); PG8_LDB(B1, 0, 1); PG8_SCHED; PG8_LDA(At, 0, 0); PG8_STAGEA(PG8_SA(1, 1), a1 + hstepA, voffA1);
            PG8_WAIT_V(8); PG8_WAIT_L(0); PG8_BAR; PG8_MMA(0, 0, At, B0); PG8_MMA(0, 1, At, B1); PG8_BAR; PG8_SCHED;
            PG8_LDA(At, 0, 1); PG8_STAGE(PG8_SB(0, 0), b2, voffB); PG8_STAGE(PG8_SB(0, 1), b2 + hstep, voffB); PG8_STAGE2A(PG8_SA(0, 0), a2, x0, x1);
            PG8_WAIT_V(8); PG8_WAIT_L(0); PG8_BAR; PG8_MMA(1, 0, At, B0); PG8_MMA(1, 1, At, B1); PG8_BAR; PG8_SCHED;
            PG8_LDB(B0, 1, 0); PG8_LDB(B1, 1, 1); PG8_SCHED; PG8_LDA(At, 1, 0); PG8_STAGE2A(PG8_SA(0, 1), a2 + hstepA, y0, y1);
            PG8_WAIT_V(8); PG8_WAIT_L(0); PG8_BAR; PG8_MMA(0, 0, At, B0); PG8_MMA(0, 1, At, B1); PG8_BAR; PG8_SCHED;
            PG8_LDA(At, 1, 1); PG8_STAGE(PG8_SB(1, 0), b3, voffB); PG8_STAGE(PG8_SB(1, 1), b3 + hstep, voffB); PG8_STAGE2A(PG8_SA(1, 0), a3, x0, x1);
            PG8_WAIT_V(8); PG8_WAIT_L(0); PG8_BAR; PG8_MMA(1, 0, At, B0); PG8_MMA(1, 1, At, B1); PG8_BAR; PG8_SCHED;
        }
        if (ALIGN && wr == 0) PG8_BAR;
        if constexpr (FP8) asm volatile("s_nop 15\n\ts_nop 15" ::: "memory");
        E(acc, cur, wr, wc, fr, fq);
        if (!has_next) break;
#pragma unroll
        for (int a = 0; a < 2; ++a)
#pragma unroll
            for (int b = 0; b < 2; ++b)
#pragma unroll
                for (int m = 0; m < 4; ++m)
#pragma unroll
                    for (int n = 0; n < 2; ++n) acc[a][b][m][n] = (f32x4){0.f, 0.f, 0.f, 0.f};
        cur = nxt; cA = nA; cB = nB; ++ui;
        if (GATHER) { voffA[0] = nvA[0]; voffA[1] = nvA[1]; voffA1[0] = nvA1[0]; voffA1[1] = nvA1[1]; }
        if (ALIGN && wr == 1) PG8_BAR;
    }
    PG8_WAIT_V(0);
    if (!ALIGN && wr == 0) PG8_BAR;
    PG8_BAR;
#undef PG8_SA
#undef PG8_SB
#undef PG8_STAGE
#undef PG8_STAGE2
#undef PG8_STAGE2A
#undef PG8_STAGEA
#undef G_LD32
#undef G_MFMA8
#undef PG8_LDA
#undef PG8_LDB
#undef PG8_MMA
#undef PG8_WAIT_V
#undef PG8_WAIT_L
#undef PG8_BAR
#undef PG8_SCHED
}

struct EpiBf16 {
    static constexpr bool PERM = true;
    bf16_t* O; int ldc; float scale;
    __device__ __forceinline__ void operator()(const f32x4 (&acc)[2][2][4][2], const Unit& u, int wr, int wc, int fr, int fq) const {
        const int row0 = u.pm * BM + wr * 64 + fr; const int col0 = u.pn * BM + wc * 32 + 8 * fq;
#pragma unroll
        for (int ai = 0; ai < 2; ++ai)
#pragma unroll
            for (int m = 0; m < 4; ++m) { bf16_t* rowp = O + (size_t)(row0 + ai * HALF + m * 16) * ldc + col0;
#pragma unroll
                for (int bj = 0; bj < 2; ++bj) { const f32x4 v0 = acc[ai][bj][m][0] * scale, v1 = acc[ai][bj][m][1] * scale;
                    u32x4 w; w.x = cvt_pk_bf16(v0[0], v0[1]); w.y = cvt_pk_bf16(v0[2], v0[3]); w.z = cvt_pk_bf16(v1[0], v1[1]); w.w = cvt_pk_bf16(v1[2], v1[3]);
                    *(u32x4*)(rowp + bj * HALF) = w; } }
    }
};
struct EpiF32 {
    static constexpr bool PERM = false;
    float* C; int ldc;
    __device__ __forceinline__ void operator()(const f32x4 (&acc)[2][2][4][2], const Unit& u, int wr, int wc, int fr, int fq) const {
        const int row0 = u.pm * BM + wr * 64 + fr, col0 = u.pn * BM + wc * 32 + 4 * fq;
#pragma unroll
        for (int ai = 0; ai < 2; ++ai)
#pragma unroll
            for (int m = 0; m < 4; ++m) { float* rowp = C + (size_t)(row0 + ai * HALF + m * 16) * ldc + col0;
#pragma unroll
                for (int bj = 0; bj < 2; ++bj)
#pragma unroll
                    for (int n = 0; n < 2; ++n) *(f32x4*)(rowp + bj * HALF + n * 16) = acc[ai][bj][m][n]; }
    }
};
struct EpiResGate {
    static constexpr bool PERM = false;
    const float* x; float* out; const float* mod; int gate_off;
    __device__ __forceinline__ void operator()(const f32x4 (&acc)[2][2][4][2], const Unit& u, int wr, int wc, int fr, int fq) const {
        const int row0 = u.pm * BM + wr * 64 + fr, col0 = u.pn * BM + wc * 32 + 4 * fq;
        const float* gp = mod + (size_t)((u.pm * BM) >> 11) * MODW + gate_off + col0;
        f32x4 gv[2][2];
#pragma unroll
        for (int bj = 0; bj < 2; ++bj)
#pragma unroll
            for (int n = 0; n < 2; ++n) gv[bj][n] = *(const f32x4*)(gp + bj * HALF + n * 16);
#pragma unroll
        for (int ai = 0; ai < 2; ++ai)
#pragma unroll
            for (int m = 0; m < 4; ++m) { const size_t off = (size_t)(row0 + ai * HALF + m * 16) * D + col0;
#pragma unroll
                for (int bj = 0; bj < 2; ++bj)
#pragma unroll
                    for (int n = 0; n < 2; ++n) { const f32x4 xv = *(const f32x4*)(x + off + bj * HALF + n * 16);
                        *(f32x4*)(out + off + bj * HALF + n * 16) = xv + gv[bj][n] * acc[ai][bj][m][n]; }
                asm volatile("" ::: "memory"); }
    }
};
struct EpiGLU {
    static constexpr bool PERM = true;
    bf16_t* H;
    __device__ __forceinline__ void operator()(const f32x4 (&acc)[2][2][4][2], const Unit& u, int wr, int wc, int fr, int fq) const {
        const int row0 = u.pm * BM + wr * 64 + fr; const int col0 = u.pn * 128 + wc * 32 + 8 * fq;
#pragma unroll
        for (int ai = 0; ai < 2; ++ai)
#pragma unroll
            for (int m = 0; m < 4; ++m) { bf16_t* rowp = H + (size_t)(row0 + ai * HALF + m * 16) * 256 + col0;
                f32x4 h0, h1;
#pragma unroll
                for (int j = 0; j < 4; ++j) { const float a0 = acc[ai][0][m][0][j], a1 = acc[ai][0][m][1][j];
                    h0[j] = siluf_(a0) * acc[ai][1][m][0][j]; h1[j] = siluf_(a1) * acc[ai][1][m][1][j]; }
                u32x4 w; w.x = cvt_pk_bf16(h0[0], h0[1]); w.y = cvt_pk_bf16(h0[2], h0[3]); w.z = cvt_pk_bf16(h1[0], h1[1]); w.w = cvt_pk_bf16(h1[2], h1[3]);
                *(u32x4*)rowp = w; }
    }
};
constexpr float YSCALE = 8.f;
struct EpiY {
    static constexpr bool PERM = true;
    unsigned char* Y; float* out; const float* mod; const LAS int* rtok; const LAS float* rw; int shared;
    __device__ __forceinline__ void operator()(const f32x4 (&acc)[2][2][4][2], const Unit& u, int wr, int wc, int fr, int fq) const {
        const int col0 = u.pn * BM + wc * 32 + 8 * fq;
#pragma unroll
        for (int ai = 0; ai < 2; ++ai)
#pragma unroll
            for (int m = 0; m < 4; ++m) { const int r = wr * 64 + fr + ai * HALF + m * 16; const int ts = rtok[r]; const float w = rw[r];
                if (ts >= 0) {
                    if (shared) { const unsigned goff = (unsigned)(ts >> 11) * MODW + 5 * D + col0; const unsigned ooff = (unsigned)ts * D + col0;
#pragma unroll
                        for (int bj = 0; bj < 2; ++bj)
#pragma unroll
                            for (int n = 0; n < 2; ++n) { const f32x4 gv = *(const f32x4*)(mod + goff + bj * HALF + n * 4); f32x4* op = (f32x4*)(out + ooff + bj * HALF + n * 4);
                                *op = *op + gv * acc[ai][bj][m][n]; }
                    } else { unsigned char* yp = Y + (size_t)(unsigned)ts * D + col0; const float ws_ = w * YSCALE;
#pragma unroll
                        for (int bj = 0; bj < 2; ++bj) { f32x4 v0 = acc[ai][bj][m][0] * ws_, v1 = acc[ai][bj][m][1] * ws_;
#pragma unroll
                                for (int j = 0; j < 4; ++j) { v0[j] = __builtin_amdgcn_fmed3f(v0[j], -448.f, 448.f); v1[j] = __builtin_amdgcn_fmed3f(v1[j], -448.f, 448.f); }
                            unsigned lo = 0u, hi = 0u;
                            lo = __builtin_amdgcn_cvt_pk_fp8_f32(v0[0], v0[1], lo, false); lo = __builtin_amdgcn_cvt_pk_fp8_f32(v0[2], v0[3], lo, true);
                            hi = __builtin_amdgcn_cvt_pk_fp8_f32(v1[0], v1[1], hi, false); hi = __builtin_amdgcn_cvt_pk_fp8_f32(v1[2], v1[3], hi, true);
                            u32x2 pk; pk.x = lo; pk.y = hi; *(u32x2*)(yp + bj * HALF) = pk; } } }
                asm volatile("" ::: "memory"); }
    }
};

struct MoeCtx {
    int ntiles, nrt, G, vc;
    const LAS int* tb; LAS int* tbl;
    const unsigned* cnt; const int* rowl; const float* roww;
    const char* wexp; const char* h2n; char* Hs; unsigned char* Y; float* out; const float* mod; int dry_shared;
};
__device__ __forceinline__ void gemm_moe(lbyte* lds, const MoeCtx& M) {
    int tid_ = threadIdx.x; asm volatile("" : "+v"(tid_));
    const int tid = tid_, wid = __builtin_amdgcn_readfirstlane(tid >> 6), lane = tid & 63, wr = wid >> 2, wc = wid & 3, fr = lane & 15, fq = lane >> 4;
    const int ntl = (M.ntiles - M.vc + M.G - 1) / M.G;
    if (M.vc >= M.ntiles) return;
    const int nunits = ntl * 6;
    const unsigned ldsw = (unsigned)wid * 1024u;
    const int aoff = lds_byte(wr * 64 + fr, fq * 16), boff = lds_byte(wc * 32 + fr, fq * 16);
    auto tile_expert = [&](int tile, int& e, int& k) { if (tile < M.nrt) { int lo = 0, hi = NE - 1; while (lo < hi) { const int mid = (lo + hi + 1) >> 1; if (M.tb[mid] <= tile) lo = mid; else hi = mid - 1; } e = lo; k = tile - M.tb[lo]; } else { e = NE; k = tile - M.nrt; } };
    auto fill = [&](int j) { if (j < ntl && tid < 256) { const int tile = M.vc + j * M.G; int e, k; tile_expert(tile, e, k); LAS int* T = M.tbl + (j % 3) * 768;
            int ts; float w;
            if (e < NE) { const int valid = (int)M.cnt[e] - 256 * k; if (tid < valid) { ts = M.rowl[(size_t)tile * 256 + tid]; w = M.roww[(size_t)tile * 256 + tid]; } else { ts = -1; w = 0.f; } T[tid] = ts < 0 ? 0 : (ts >> 3); }
            else { ts = k * 256 + tid; w = 1.f; T[tid] = ts; }
            T[256 + tid] = ts; ((LAS float*)T)[512 + tid] = w; } };
    struct UP { const char* aB; const char* bB; unsigned bh; int nt, kind, pn, slot, shared, e, hbuf, fillnext; };
    auto unit_params = [&](int ui, int prev_e, UP& u, unsigned (&oa)[4], unsigned (&ob)[2]) {
        int tq = threadIdx.x; asm volatile("" : "+v"(tq));
        int Rst[2], Cst[2], Rbp[2];
#pragma unroll
        for (int i = 0; i < 2; ++i) { int R, C; stage_rc(tq * 16 + i * 8192, R, C); Rst[i] = R; Cst[i] = C; Rbp[i] = (R & ~31) + perm32(R & 31); }
        int j, sub;
        if (ui < 2) { j = 0; sub = ui; }
        else { const int qq = ui - 2, g = qq / 6, r = qq - 6 * g; if (g < ntl - 1 && r < 2) { j = g + 1; sub = r; } else { j = g; sub = (g < ntl - 1) ? r : r + 2; } }
        const int tile = M.vc + j * M.G; int e, k;
        if (sub == 0 || sub == 2) tile_expert(tile, e, k); else e = prev_e;
        u.e = e;
        const char* w = M.wexp + (size_t)e * WEXP_STRIDE;
        u.slot = j % 3; u.hbuf = j & 1; u.fillnext = (sub == 1) ? j + 1 : -1; u.shared = (e == NE) ? 1 : 0;
        if (sub < 2) { u.kind = 0; u.pn = sub; u.nt = D / 128; u.aB = M.h2n; u.bB = w + (size_t)sub * 256 * D; u.bh = 128u * D;
            const LAS int* T = M.tbl + (j % 3) * 768;
#pragma unroll
            for (int i = 0; i < 2; ++i) { oa[i] = (unsigned)T[Rst[i]] * (unsigned)D + 2u * (unsigned)Cst[i]; oa[2 + i] = (unsigned)T[128 + Rst[i]] * (unsigned)D + 2u * (unsigned)Cst[i]; ob[i] = (unsigned)(Rbp[i] * D + 2 * Cst[i]); } }
        else { u.kind = 1; u.pn = sub - 2; u.nt = DE / 128; u.aB = M.Hs + (j & 1) * 65536; u.bB = w + (size_t)512 * 1024 + (size_t)(sub - 2) * 256 * DE; u.bh = 128u * DE;
#pragma unroll
            for (int i = 0; i < 2; ++i) { oa[i] = (unsigned)(Rst[i] * DE + 2 * Cst[i]); oa[2 + i] = (unsigned)((128 + Rst[i]) * DE + 2 * Cst[i]); ob[i] = (unsigned)(Rbp[i] * DE + 2 * Cst[i]); } }
    };
#define PG8_SA(b, h) (((b) * 2 + (h)) * HTB)
#define PG8_SB(b, h) ((4 + (b) * 2 + (h)) * HTB)
#define MOE_DMA(bufoff, ptr, aux) __builtin_amdgcn_global_load_lds((const unsigned*)(ptr), (LAS unsigned*)(lds + (bufoff)), 16, 0, aux)
#define MOE_STA(bufoff, base, o0, o1) do { MOE_DMA((bufoff) + ldsw, (base) + (o0), 16); MOE_DMA((bufoff) + ldsw + 8192, (base) + (o1), 16); } while (0)
#define MOE_STAK(kindv, bufoff, base, o0, o1) do { if ((kindv) == 0) { MOE_DMA((bufoff) + ldsw, (base) + (o0), 0); MOE_DMA((bufoff) + ldsw + 8192, (base) + (o1), 0); } else MOE_STA(bufoff, base, o0, o1); } while (0)
#define MOE_STB(bufoff, base, o0, o1) do { MOE_DMA((bufoff) + ldsw, (base) + (o0), 0); MOE_DMA((bufoff) + ldsw + 8192, (base) + (o1), 0); } while (0)
#define MOE_LD32(p) __builtin_shufflevector(*(const LAS i32x4*)(p), *(const LAS i32x4*)((p) + 16), 0, 1, 2, 3, 4, 5, 6, 7)
#define PG8_LDA(dst, b, h) do { _Pragma("unroll") for (int m = 0; m < 4; ++m) dst[m] = MOE_LD32(lds + PG8_SA(b, h) + aoff + m * 2048); } while (0)
#define PG8_LDB(dst, b, h) do { _Pragma("unroll") for (int n = 0; n < 2; ++n) dst[n] = MOE_LD32(lds + PG8_SB(b, h) + boff + n * 2048); } while (0)
#define MOE_MFMA(c, a, b) asm volatile("v_mfma_scale_f32_16x16x128_f8f6f4 %0, %1, %2, %0, %3, %3 op_sel_hi:[0,0,0]" : "+v"(c) : "v"(a), "v"(b), "v"(one_scale))
#define PG8_MMA(ai, bj, At, Bt) do { __builtin_amdgcn_s_setprio(1); _Pragma("unroll") for (int m = 0; m < 4; ++m) _Pragma("unroll") for (int n = 0; n < 2; ++n) \
        MOE_MFMA(acc[ai][bj][m][n], Bt[n], At[m]); __builtin_amdgcn_s_setprio(0); } while (0)
#define PG8_WAIT_V(n) asm volatile("s_waitcnt vmcnt(" #n ")" ::: "memory")
#define PG8_WAIT_L(n) asm volatile("s_waitcnt lgkmcnt(" #n ")" ::: "memory")
#define PG8_BAR __builtin_amdgcn_s_barrier()
#define PG8_SCHED __builtin_amdgcn_sched_barrier(0)
    fill(0);
    asm volatile("s_waitcnt vmcnt(0) lgkmcnt(0)" ::: "memory");
    __syncthreads();
    UP cu, nu; unsigned oa[4], ob[2], na[4], nb[2];
    unit_params(0, 0, cu, oa, ob);
    nu = cu;
#pragma unroll
    for (int i = 0; i < 4; ++i) na[i] = oa[i];
    nb[0] = ob[0]; nb[1] = ob[1];
    f32x4 acc[2][2][4][2];
#pragma unroll
    for (int a = 0; a < 2; ++a)
#pragma unroll
        for (int b = 0; b < 2; ++b)
#pragma unroll
            for (int m = 0; m < 4; ++m)
#pragma unroll
                for (int n = 0; n < 2; ++n) acc[a][b][m][n] = (f32x4){0.f, 0.f, 0.f, 0.f};
    i32x8 At[4], B0[2], B1[2];
    int one_scale = 0x7F7F7F7F; asm volatile("" : "+v"(one_scale));
    const size_t kstep = (size_t)128;
    {   const char* cA = cu.aB; const char* cB = cu.bB;
        MOE_STB(PG8_SB(0, 0), cB, ob[0], ob[1]); MOE_STB(PG8_SB(0, 1), cB + cu.bh, ob[0], ob[1]); MOE_STAK(cu.kind, PG8_SA(0, 0), cA, oa[0], oa[1]); MOE_STAK(cu.kind, PG8_SA(0, 1), cA, oa[2], oa[3]);
        if (wr == 1) PG8_BAR;
        PG8_WAIT_V(2); PG8_BAR;
        MOE_STB(PG8_SB(1, 0), cB + kstep, ob[0], ob[1]); MOE_STAK(cu.kind, PG8_SA(1, 0), cA + kstep, oa[0], oa[1]); MOE_STB(PG8_SB(1, 1), cB + cu.bh + kstep, ob[0], ob[1]);
        PG8_WAIT_V(6); PG8_BAR; }
    for (int ui = 0;; ++ui) {
        const bool has_next = (ui + 1 < nunits);
        if (cu.fillnext >= 0) fill(cu.fillnext);
        const char* cA = cu.aB; const char* cB = cu.bB; const int nt = cu.nt; const unsigned bh = cu.bh;
        for (int t = 0; t < nt; t += 2) {
            const bool last = (t == nt - 2);
            if (last && has_next) unit_params(ui + 1, cu.e, nu, na, nb);
            const char* a1 = cA + (size_t)(t + 1) * kstep;
            const char* a2 = last ? nu.aB : cA + (size_t)(t + 2) * kstep; const char* b2 = last ? nu.bB : cB + (size_t)(t + 2) * kstep;
            const char* a3 = a2 + kstep; const char* b3 = b2 + kstep;
            const unsigned bh2 = last ? nu.bh : bh;
            const unsigned x0 = last ? na[0] : oa[0], x1 = last ? na[1] : oa[1], y0 = last ? na[2] : oa[2], y1 = last ? na[3] : oa[3];
            const unsigned z0 = last ? nb[0] : ob[0], z1 = last ? nb[1] : ob[1];
            const int k2 = last ? nu.kind : cu.kind;
            PG8_LDB(B0, 0, 0); PG8_LDB(B1, 0, 1); PG8_SCHED; PG8_LDA(At, 0, 0); MOE_STAK(cu.kind, PG8_SA(1, 1), a1, oa[2], oa[3]);
            PG8_WAIT_V(8); PG8_WAIT_L(0); PG8_BAR; PG8_MMA(0, 0, At, B0); PG8_MMA(0, 1, At, B1); PG8_BAR; PG8_SCHED;
            PG8_LDA(At, 0, 1); MOE_STB(PG8_SB(0, 0), b2, z0, z1); MOE_STB(PG8_SB(0, 1), b2 + bh2, z0, z1); MOE_STAK(k2, PG8_SA(0, 0), a2, x0, x1);
            PG8_WAIT_V(8); PG8_WAIT_L(0); PG8_BAR; PG8_MMA(1, 0, At, B0); PG8_MMA(1, 1, At, B1); PG8_BAR; PG8_SCHED;
            PG8_LDB(B0, 1, 0); PG8_LDB(B1, 1, 1); PG8_SCHED; PG8_LDA(At, 1, 0); MOE_STAK(k2, PG8_SA(0, 1), a2, y0, y1);
            PG8_WAIT_V(8); PG8_WAIT_L(0); PG8_BAR; PG8_MMA(0, 0, At, B0); PG8_MMA(0, 1, At, B1); PG8_BAR; PG8_SCHED;
            PG8_LDA(At, 1, 1); MOE_STB(PG8_SB(1, 0), b3, z0, z1); MOE_STB(PG8_SB(1, 1), b3 + bh2, z0, z1); MOE_STAK(k2, PG8_SA(1, 0), a3, x0, x1);
            PG8_WAIT_V(8); PG8_WAIT_L(0); PG8_BAR; PG8_MMA(1, 0, At, B0); PG8_MMA(1, 1, At, B1); PG8_BAR; PG8_SCHED;
        }
        if (wr == 0) PG8_BAR;
        asm volatile("s_nop 15\n\ts_nop 15" ::: "memory");
        if (cu.kind == 0) {
            const int row0 = wr * 64 + fr; const int col0 = cu.pn * 128 + wc * 32 + 8 * fq;
            constexpr float is13 = 1.f / SW13;
#pragma unroll
            for (int ai = 0; ai < 2; ++ai)
#pragma unroll
                for (int m = 0; m < 4; ++m) { unsigned char* rowp = (unsigned char*)M.Hs + cu.hbuf * 65536 + (size_t)(row0 + ai * HALF + m * 16) * 256 + col0;
                    f32x4 h0, h1;
#pragma unroll
                    for (int j = 0; j < 4; ++j) { h0[j] = siluf_(acc[ai][0][m][0][j] * is13) * (acc[ai][1][m][0][j] * (is13 * SHS)); h1[j] = siluf_(acc[ai][0][m][1][j] * is13) * (acc[ai][1][m][1][j] * (is13 * SHS)); }
                    u32x2 w; w.x = pk4_fp8(h0[0], h0[1], h0[2], h0[3]); w.y = pk4_fp8(h1[0], h1[1], h1[2], h1[3]);
                    *(u32x2*)rowp = w; }
        } else {
            const LAS int* rtok = M.tbl + cu.slot * 768 + 256; const LAS float* rw = (const LAS float*)(M.tbl + cu.slot * 768 + 512);
            const int col0 = cu.pn * BM + wc * 32 + 8 * fq;
#pragma unroll
            for (int ai = 0; ai < 2; ++ai)
#pragma unroll
                for (int m = 0; m < 4; ++m) { const int r = wr * 64 + fr + ai * HALF + m * 16; const int ts = rtok[r]; const float w = rw[r];
                    if (ts >= 0) {
                        if (cu.shared) { const unsigned goff = (unsigned)(ts >> 11) * MODW + 5 * D + col0; const unsigned ooff = (unsigned)ts * D + col0;
#pragma unroll
                            for (int bj = 0; bj < 2; ++bj)
#pragma unroll
                                for (int n = 0; n < 2; ++n) { const f32x4 gv = *(const f32x4*)(M.mod + goff + bj * HALF + n * 4); f32x4* op = (f32x4*)(M.out + ooff + bj * HALF + n * 4);
                                    const f32x4 nv = *op + gv * acc[ai][bj][m][n] * (1.f / (SHS * SW2)); if (!M.dry_shared) *op = nv; else asm volatile("" :: "v"(nv)); }
                        } else { unsigned char* yp = M.Y + (size_t)(unsigned)ts * D + col0; const float ws_ = w * (YSCALE / (SHS * SW2));
#pragma unroll
                            for (int bj = 0; bj < 2; ++bj) { f32x4 v0 = acc[ai][bj][m][0] * ws_, v1 = acc[ai][bj][m][1] * ws_;
#pragma unroll
                                for (int j = 0; j < 4; ++j) { v0[j] = __builtin_amdgcn_fmed3f(v0[j], -448.f, 448.f); v1[j] = __builtin_amdgcn_fmed3f(v1[j], -448.f, 448.f); }
                                unsigned lo = 0u, hi = 0u;
                                lo = __builtin_amdgcn_cvt_pk_fp8_f32(v0[0], v0[1], lo, false); lo = __builtin_amdgcn_cvt_pk_fp8_f32(v0[2], v0[3], lo, true);
                                hi = __builtin_amdgcn_cvt_pk_fp8_f32(v1[0], v1[1], hi, false); hi = __builtin_amdgcn_cvt_pk_fp8_f32(v1[2], v1[3], hi, true);
                                u32x2 pk; pk.x = lo; pk.y = hi; *(u32x2*)(yp + bj * HALF) = pk; } } }
                    asm volatile("" ::: "memory"); }
        }
        if (!has_next) break;
#pragma unroll
        for (int a = 0; a < 2; ++a)
#pragma unroll
            for (int b = 0; b < 2; ++b)
#pragma unroll
                for (int m = 0; m < 4; ++m)
#pragma unroll
                    for (int n = 0; n < 2; ++n) acc[a][b][m][n] = (f32x4){0.f, 0.f, 0.f, 0.f};
        cu = nu;
#pragma unroll
        for (int i = 0; i < 4; ++i) oa[i] = na[i];
        ob[0] = nb[0]; ob[1] = nb[1];
        if (wr == 1) PG8_BAR;
    }
    PG8_WAIT_V(0);
    PG8_BAR;
#undef PG8_SA
#undef PG8_SB
#undef MOE_DMA
#undef MOE_STA
#undef MOE_STAK
#undef MOE_STB
#undef PG8_LDA
#undef PG8_LDB
#undef MOE_LD32
#undef MOE_MFMA
#undef PG8_MMA
#undef PG8_WAIT_V
#undef PG8_WAIT_L
#undef PG8_BAR
#undef PG8_SCHED
}
}

struct Ctx {
    lbyte* lds; int tid, lane, wave, G, bid;
    const Args* a;
};
#define WSP(T, off) ((T*)(A.ws + (off)))

template <class RowMap>
__device__ __forceinline__ void transpose_item(const float* W, int K, int N, bf16_t* WT, RowMap rowmap, lfloat* scr, int item, int lane) {
    const int nblk = N / 32, kb = item / nblk, nb = item % nblk, k0 = 64 * kb, n0 = 32 * nb;
#pragma unroll 8
    for (int i = 0; i < 32; ++i) { const int kk = 2 * i + (lane >> 5); scr[kk * 33 + (lane & 31)] = W[(size_t)(k0 + kk) * N + n0 + (lane & 31)]; }
    asm volatile("s_waitcnt lgkmcnt(0)" ::: "memory");
    const int c = lane & 7;
#pragma unroll
    for (int j = 0; j < 4; ++j) { const int n = (lane >> 3) + 8 * j; const lfloat* s = scr + (8 * c) * 33 + n;
        u32x4 o; o.x = pk2(s[0 * 33], s[1 * 33]); o.y = pk2(s[2 * 33], s[3 * 33]); o.z = pk2(s[4 * 33], s[5 * 33]); o.w = pk2(s[6 * 33], s[7 * 33]);
        *(u32x4*)(WT + (size_t)rowmap(n0 + n) * K + k0 + 8 * c) = o; }
    asm volatile("s_waitcnt lgkmcnt(0)" ::: "memory");
}
template <class RowMap>
__device__ __forceinline__ void transpose_item_fp8(const float* W, int K, int N, unsigned char* WT, RowMap rowmap, float sc, lfloat* scr, int item, int lane) {
    const int nblk = N / 32, kb = item / nblk, nb = item % nblk, k0 = 64 * kb, n0 = 32 * nb;
#pragma unroll 8
    for (int i = 0; i < 32; ++i) { const int kk = 2 * i + (lane >> 5); scr[kk * 33 + (lane & 31)] = W[(size_t)(k0 + kk) * N + n0 + (lane & 31)] * sc; }
    asm volatile("s_waitcnt lgkmcnt(0)" ::: "memory");
    const int c = lane & 7;
#pragma unroll
    for (int j = 0; j < 4; ++j) { const int n = (lane >> 3) + 8 * j; const lfloat* s = scr + (8 * c) * 33 + n;
        u32x2 o; o.x = pk4_fp8(s[0 * 33], s[1 * 33], s[2 * 33], s[3 * 33]); o.y = pk4_fp8(s[4 * 33], s[5 * 33], s[6 * 33], s[7 * 33]);
        *(u32x2*)(WT + (size_t)rowmap(n0 + n) * K + k0 + 8 * c) = o; }
    asm volatile("s_waitcnt lgkmcnt(0)" ::: "memory");
}
struct RowId { __device__ int operator()(int n) const { return n; } };
struct RowGLU { int base; __device__ int operator()(int n) const { return ((n >> 7) << 8) + base + (n & 127); } };

__device__ __forceinline__ void norm_mod_row(const float* xrow, const float* g, const float* sc, const float* sh, bf16_t* orow, int lane, unsigned* o8row = nullptr) {
    const f32x4* xr = (const f32x4*)xrow + lane;
    f32x4 v[4]; float s = 0.f;
#pragma unroll
    for (int j = 0; j < 4; ++j) { v[j] = xr[64 * j]; s += (v[j].x * v[j].x + v[j].y * v[j].y) + (v[j].z * v[j].z + v[j].w * v[j].w); }
    const float rstd = __builtin_amdgcn_rsqf(wave_sum(s) * (1.f / D) + NORM_EPS);
    u32x2* o8 = (u32x2*)orow + lane;
#pragma unroll
    for (int j = 0; j < 4; ++j) { const f32x4 gg = ((const f32x4*)g)[lane + 64 * j], ss = ((const f32x4*)sc)[lane + 64 * j], hh = ((const f32x4*)sh)[lane + 64 * j];
        const f32x4 y = v[j] * rstd * gg * (ss + 1.f) + hh;
        if (orow) { u32x2 w; w.x = pk2(y.x, y.y); w.y = pk2(y.z, y.w); o8[64 * j] = w; }
        if (o8row) o8row[lane + 64 * j] = pk4_fp8(y.x, y.y, y.z, y.w); }
}

__device__ __forceinline__ void phase_p0(const Args& A, Ctx& C) {
    float* mod = WSP(float, WS_MOD);
    {
        lfloat* sc = (lfloat*)C.lds;
        lfloat* red = (lfloat*)(C.lds + 17 * 1024 * 4);
        const float* wada = A.in[I_WADA]; const float* bada = A.in[I_BADA];
        for (int it = C.bid; it < 96 * 2; it += C.G) {
            const int chunk = it >> 1, pass = it & 1, r0 = pass * 17, nr = pass ? 16 : 17, col0 = chunk * 64;
            __syncthreads();
            for (int i = C.tid; i < nr * 1024; i += 512) { const int r = i >> 10, k = i & 1023; const int rr = r0 + r;
                const float cv = rr < 32 ? A.in[I_C][rr * 1024 + k] : A.in[I_CCTX][k]; sc[r * 1024 + k] = siluf_(cv); }
            __syncthreads();
            const int col = C.tid & 63, kq = C.tid >> 6;
            float acc[17];
#pragma unroll
            for (int r = 0; r < 17; ++r) acc[r] = 0.f;
            for (int k = kq * 128; k < kq * 128 + 128; k += 4) {
                float w[4];
#pragma unroll
                for (int j = 0; j < 4; ++j) w[j] = wada[(size_t)(k + j) * MODW + col0 + col];
#pragma unroll
                for (int r = 0; r < 17; ++r) { const f32x4 s4 = *(const LAS f32x4*)(sc + r * 1024 + k); acc[r] += s4.x * w[0] + s4.y * w[1] + s4.z * w[2] + s4.w * w[3]; }
            }
#pragma unroll
            for (int r = 0; r < 17; ++r) red[(kq * 17 + r) * 64 + col] = acc[r];
            __syncthreads();
            for (int i = C.tid; i < nr * 64; i += 512) { const int r = i >> 6, cc = i & 63; float s = 0.f;
#pragma unroll
                for (int q = 0; q < 8; ++q) s += red[(q * 17 + r) * 64 + cc];
                mod[(size_t)(r0 + r) * MODW + col0 + cc] = s + bada[col0 + cc]; }
        }
        __syncthreads();
    }
    {
        lfloat* scr = (lfloat*)(C.lds + C.wave * 16384);
        const int gw = C.bid * 8 + C.wave, NGW = C.G * 8;
        unsigned char* btin8 = A.ws + WS_BTIN; bf16_t* btout = WSP(bf16_t, WS_BTOUT); bf16_t* btr = WSP(bf16_t, WS_BTR);
        constexpr int I_IN = (D / 64) * 124, I_OUT = (D / 64) * (D / 32), I_R = (D / 64) * (NE / 32), I_G = (128 / 64) * (DA / 32);
        for (int it = gw; it < I_IN + I_OUT + I_R + I_G; it += NGW) {
            int r = it;
            if (r < I_IN) {
                const int kb = r / 124, nb = r % 124, k0 = 64 * kb, n0 = 32 * nb; const float* W = A.in[I_WIN];
#pragma unroll 8
                for (int i = 0; i < 32; ++i) { const int kk = 2 * i + (C.lane >> 5); scr[kk * 33 + (C.lane & 31)] = W[(size_t)(k0 + kk) * IN_COLS + n0 + (C.lane & 31)] * SWIN; }
                asm volatile("s_waitcnt lgkmcnt(0)" ::: "memory");
                const int c = C.lane & 7;
#pragma unroll
                for (int j = 0; j < 4; ++j) { const int n = (C.lane >> 3) + 8 * j; const lfloat* s = scr + (8 * c) * 33 + n;
                    u32x2 o; o.x = pk4_fp8(s[0 * 33], s[1 * 33], s[2 * 33], s[3 * 33]); o.y = pk4_fp8(s[4 * 33], s[5 * 33], s[6 * 33], s[7 * 33]);
                    *(u32x2*)(btin8 + (size_t)(n0 + n) * D + k0 + 8 * c) = o; }
                asm volatile("s_waitcnt lgkmcnt(0)" ::: "memory");
                continue; }
            r -= I_IN;
            if (r < I_OUT) { transpose_item(A.in[I_WOUT], D, D, btout, RowId(), scr, r, C.lane); continue; } r -= I_OUT;
            if (r < I_R) { transpose_item(A.in[I_RW], D, NE, btr, RowId(), scr, r, C.lane); continue; } r -= I_R;
            transpose_item(A.in[I_GUP], 128, DA, WSP(bf16_t, WS_GUPT), RowId(), scr, r, C.lane);
        }
        for (int i = C.bid * 512 + C.tid; i < 16 * D / 4; i += C.G * 512) { const int n = 3968 + (i >> 8), k = (i & 255) * 4; const float* W = A.in[I_WIN];
            *(unsigned*)(btin8 + (size_t)n * D + k) = pk4_fp8(W[(size_t)k * IN_COLS + n] * SWIN, W[(size_t)(k + 1) * IN_COLS + n] * SWIN, W[(size_t)(k + 2) * IN_COLS + n] * SWIN, W[(size_t)(k + 3) * IN_COLS + n] * SWIN); }
        for (int i = C.bid * 512 + C.tid; i < (PLD - IN_COLS) * D / 16; i += C.G * 512) ((u32x4*)(btin8 + (size_t)IN_COLS * D))[i] = (u32x4){0u, 0u, 0u, 0u};
    }
}

__device__ __forceinline__ void phase_p1(const Args& A, Ctx& C) {
    const float* mod = WSP(float, WS_MOD); bf16_t* xn = WSP(bf16_t, WS_XN);
    const int gw = C.bid * 8 + C.wave, NGW = C.G * 8;
    for (int row = gw; row < NROWS; row += NGW) {
        const float* xr; int mb;
        if (row < NLAT) { xr = A.in[I_X] + (size_t)row * D; mb = row >> 11; } else { xr = A.in[I_CTX] + (size_t)(row - NLAT) * D; mb = 32; }
        const float* m = mod + (size_t)mb * MODW;
        norm_mod_row(xr, A.in[I_N1G], m + D, m, nullptr, C.lane, (unsigned*)(A.ws + WS_XN) + (size_t)row * (D / 4));
    }
}

__device__ __forceinline__ float bfsel(unsigned w, unsigned sh) { return __builtin_bit_cast(float, (w << sh) & 0xffff0000u); }
template <int NK>
__device__ __forceinline__ f32x4 mm_tile(const lbyte* Ap, int lda, const lbyte* Bp, int ldb, f32x4 acc, int lane) {
    const int r = lane & 15, g = lane >> 4;
#pragma unroll
    for (int ks = 0; ks < NK; ++ks) {
        const bf16x8 a = *(const LAS bf16x8*)(Ap + r * lda + ks * 64 + g * 16);
        const bf16x8 b = *(const LAS bf16x8*)(Bp + r * ldb + ks * 64 + g * 16);
        acc = __builtin_amdgcn_mfma_f32_16x16x32_bf16(a, b, acc, 0, 0, 0);
    }
    return acc;
}

__device__ __forceinline__ void st_bf16x4(lbyte* p, f32x4 v) { u32x2 w; w.x = cvtpk(v.x, v.y); w.y = cvtpk(v.z, v.w); *(LAS u32x2*)p = w; }
__device__ __forceinline__ void st_bf16(lbyte* p, float v) { *(LAS unsigned short*)p = (unsigned short)cvtpk(v, v); }
__device__ __forceinline__ float rdlane(float v, int l) { return __builtin_bit_cast(float, __builtin_amdgcn_readlane(__builtin_bit_cast(int, v), l)); }

__device__ __forceinline__ void tri_inv16(const f32x4 m, int lane, lbyte* scr, float (&X)[16]) {
    *(LAS f32x4*)(scr + (lane & 15) * 64 + (lane >> 4) * 16) = m;
    asm volatile("s_waitcnt lgkmcnt(0)" ::: "memory");
    float Mr[16];
#pragma unroll
    for (int kq = 0; kq < 4; ++kq) { const f32x4 r = *(const LAS f32x4*)(scr + (lane & 15) * 64 + kq * 16); Mr[4 * kq] = r.x; Mr[4 * kq + 1] = r.y; Mr[4 * kq + 2] = r.z; Mr[4 * kq + 3] = r.w; }
    const int l16 = lane & 15;
    X[0] = (l16 == 0) ? 1.f : 0.f;
    { float a0 = (l16 == 1) ? 1.f : 0.f, a1 = 0.f, a2 = 0.f, a3 = 0.f;
      asm("s_nop 1\n\t" "v_fmac_f32_dpp %0, -%2, %3 row_newbcast:1 row_mask:0xf bank_mask:0xf\n\t" : "+v"(a0), "+v"(a1) : "v"(Mr[0]), "v"(X[0]));
      X[1] = (a0 + a1) + (a2 + a3); }
    { float a0 = (l16 == 2) ? 1.f : 0.f, a1 = 0.f, a2 = 0.f, a3 = 0.f;
      asm("s_nop 1\n\t" "v_fmac_f32_dpp %0, -%2, %3 row_newbcast:2 row_mask:0xf bank_mask:0xf\n\t" "v_fmac_f32_dpp %1, -%4, %5 row_newbcast:2 row_mask:0xf bank_mask:0xf\n\t" : "+v"(a0), "+v"(a1) : "v"(Mr[0]), "v"(X[0]), "v"(Mr[1]), "v"(X[1]));
      X[2] = (a0 + a1) + (a2 + a3); }
    { float a0 = (l16 == 3) ? 1.f : 0.f, a1 = 0.f, a2 = 0.f, a3 = 0.f;
      asm("s_nop 1\n\t" "v_fmac_f32_dpp %0, -%2, %3 row_newbcast:3 row_mask:0xf bank_mask:0xf\n\t" "v_fmac_f32_dpp %1, -%4, %5 row_newbcast:3 row_mask:0xf bank_mask:0xf\n\t" : "+v"(a0), "+v"(a1) : "v"(Mr[0]), "v"(X[0]), "v"(Mr[1]), "v"(X[1]));
      asm("s_nop 1\n\t" "v_fmac_f32_dpp %0, -%2, %3 row_newbcast:3 row_mask:0xf bank_mask:0xf\n\t" : "+v"(a2), "+v"(a3) : "v"(Mr[2]), "v"(X[2]));
      X[3] = (a0 + a1) + (a2 + a3); }
    { float a0 = (l16 == 4) ? 1.f : 0.f, a1 = 0.f, a2 = 0.f, a3 = 0.f;
      asm("s_nop 1\n\t" "v_fmac_f32_dpp %0, -%2, %3 row_newbcast:4 row_mask:0xf bank_mask:0xf\n\t" "v_fmac_f32_dpp %1, -%4, %5 row_newbcast:4 row_mask:0xf bank_mask:0xf\n\t" : "+v"(a0), "+v"(a1) : "v"(Mr[0]), "v"(X[0]), "v"(Mr[1]), "v"(X[1]));
      asm("s_nop 1\n\t" "v_fmac_f32_dpp %0, -%2, %3 row_newbcast:4 row_mask:0xf bank_mask:0xf\n\t" "v_fmac_f32_dpp %1, -%4, %5 row_newbcast:4 row_mask:0xf bank_mask:0xf\n\t" : "+v"(a2), "+v"(a3) : "v"(Mr[2]), "v"(X[2]), "v"(Mr[3]), "v"(X[3]));
      X[4] = (a0 + a1) + (a2 + a3); }
    { float a0 = (l16 == 5) ? 1.f : 0.f, a1 = 0.f, a2 = 0.f, a3 = 0.f;
      asm("s_nop 1\n\t" "v_fmac_f32_dpp %0, -%2, %3 row_newbcast:5 row_mask:0xf bank_mask:0xf\n\t" "v_fmac_f32_dpp %1, -%4, %5 row_newbcast:5 row_mask:0xf bank_mask:0xf\n\t" "v_fmac_f32_dpp %0, -%6, %7 row_newbcast:5 row_mask:0xf bank_mask:0xf\n\t" : "+v"(a0), "+v"(a1) : "v"(Mr[0]), "v"(X[0]), "v"(Mr[1]), "v"(X[1]), "v"(Mr[4]), "v"(X[4]));
      asm("s_nop 1\n\t" "v_fmac_f32_dpp %0, -%2, %3 row_newbcast:5 row_mask:0xf bank_mask:0xf\n\t" "v_fmac_f32_dpp %1, -%4, %5 row_newbcast:5 row_mask:0xf bank_mask:0xf\n\t" : "+v"(a2), "+v"(a3) : "v"(Mr[2]), "v"(X[2]), "v"(Mr[3]), "v"(X[3]));
      X[5] = (a0 + a1) + (a2 + a3); }
    { float a0 = (l16 == 6) ? 1.f : 0.f, a1 = 0.f, a2 = 0.f, a3 = 0.f;
      asm("s_nop 1\n\t" "v_fmac_f32_dpp %0, -%2, %3 row_newbcast:6 row_mask:0xf bank_mask:0xf\n\t" "v_fmac_f32_dpp %1, -%4, %5 row_newbcast:6 row_mask:0xf bank_mask:0xf\n\t" "v_fmac_f32_dpp %0, -%6, %7 row_newbcast:6 row_mask:0xf bank_mask:0xf\n\t" "v_fmac_f32_dpp %1, -%8, %9 row_newbcast:6 row_mask:0xf bank_mask:0xf\n\t" : "+v"(a0), "+v"(a1) : "v"(Mr[0]), "v"(X[0]), "v"(Mr[1]), "v"(X[1]), "v"(Mr[4]), "v"(X[4]), "v"(Mr[5]), "v"(X[5]));
      asm("s_nop 1\n\t" "v_fmac_f32_dpp %0, -%2, %3 row_newbcast:6 row_mask:0xf bank_mask:0xf\n\t" "v_fmac_f32_dpp %1, -%4, %5 row_newbcast:6 row_mask:0xf bank_mask:0xf\n\t" : "+v"(a2), "+v"(a3) : "v"(Mr[2]), "v"(X[2]), "v"(Mr[3]), "v"(X[3]));
      X[6] = (a0 + a1) + (a2 + a3); }
    { float a0 = (l16 == 7) ? 1.f : 0.f, a1 = 0.f, a2 = 0.f, a3 = 0.f;
      asm("s_nop 1\n\t" "v_fmac_f32_dpp %0, -%2, %3 row_newbcast:7 row_mask:0xf bank_mask:0xf\n\t" "v_fmac_f32_dpp %1, -%4, %5 row_newbcast:7 row_mask:0xf bank_mask:0xf\n\t" "v_fmac_f32_dpp %0, -%6, %7 row_newbcast:7 row_mask:0xf bank_mask:0xf\n\t" "v_fmac_f32_dpp %1, -%8, %9 row_newbcast:7 row_mask:0xf bank_mask:0xf\n\t" : "+v"(a0), "+v"(a1) : "v"(Mr[0]), "v"(X[0]), "v"(Mr[1]), "v"(X[1]), "v"(Mr[4]), "v"(X[4]), "v"(Mr[5]), "v"(X[5]));
      asm("s_nop 1\n\t" "v_fmac_f32_dpp %0, -%2, %3 row_newbcast:7 row_mask:0xf bank_mask:0xf\n\t" "v_fmac_f32_dpp %1, -%4, %5 row_newbcast:7 row_mask:0xf bank_mask:0xf\n\t" "v_fmac_f32_dpp %0, -%6, %7 row_newbcast:7 row_mask:0xf bank_mask:0xf\n\t" : "+v"(a2), "+v"(a3) : "v"(Mr[2]), "v"(X[2]), "v"(Mr[3]), "v"(X[3]), "v"(Mr[6]), "v"(X[6]));
      X[7] = (a0 + a1) + (a2 + a3); }
    { float a0 = (l16 == 8) ? 1.f : 0.f, a1 = 0.f, a2 = 0.f, a3 = 0.f;
      asm("s_nop 1\n\t" "v_fmac_f32_dpp %0, -%2, %3 row_newbcast:8 row_mask:0xf bank_mask:0xf\n\t" "v_fmac_f32_dpp %1, -%4, %5 row_newbcast:8 row_mask:0xf bank_mask:0xf\n\t" "v_fmac_f32_dpp %0, -%6, %7 row_newbcast:8 row_mask:0xf bank_mask:0xf\n\t" "v_fmac_f32_dpp %1, -%8, %9 row_newbcast:8 row_mask:0xf bank_mask:0xf\n\t" : "+v"(a0), "+v"(a1) : "v"(Mr[0]), "v"(X[0]), "v"(Mr[1]), "v"(X[1]), "v"(Mr[4]), "v"(X[4]), "v"(Mr[5]), "v"(X[5]));
      asm("s_nop 1\n\t" "v_fmac_f32_dpp %0, -%2, %3 row_newbcast:8 row_mask:0xf bank_mask:0xf\n\t" "v_fmac_f32_dpp %1, -%4, %5 row_newbcast:8 row_mask:0xf bank_mask:0xf\n\t" "v_fmac_f32_dpp %0, -%6, %7 row_newbcast:8 row_mask:0xf bank_mask:0xf\n\t" "v_fmac_f32_dpp %1, -%8, %9 row_newbcast:8 row_mask:0xf bank_mask:0xf\n\t" : "+v"(a2), "+v"(a3) : "v"(Mr[2]), "v"(X[2]), "v"(Mr[3]), "v"(X[3]), "v"(Mr[6]), "v"(X[6]), "v"(Mr[7]), "v"(X[7]));
      X[8] = (a0 + a1) + (a2 + a3); }
    { float a0 = (l16 == 9) ? 1.f : 0.f, a1 = 0.f, a2 = 0.f, a3 = 0.f;
      asm("s_nop 1\n\t" "v_fmac_f32_dpp %0, -%2, %3 row_newbcast:9 row_mask:0xf bank_mask:0xf\n\t" "v_fmac_f32_dpp %1, -%4, %5 row_newbcast:9 row_mask:0xf bank_mask:0xf\n\t" "v_fmac_f32_dpp %0, -%6, %7 row_newbcast:9 row_mask:0xf bank_mask:0xf\n\t" "v_fmac_f32_dpp %1, -%8, %9 row_newbcast:9 row_mask:0xf bank_mask:0xf\n\t" "v_fmac_f32_dpp %0, -%10, %11 row_newbcast:9 row_mask:0xf bank_mask:0xf\n\t" : "+v"(a0), "+v"(a1) : "v"(Mr[0]), "v"(X[0]), "v"(Mr[1]), "v"(X[1]), "v"(Mr[4]), "v"(X[4]), "v"(Mr[5]), "v"(X[5]), "v"(Mr[8]), "v"(X[8]));
      asm("s_nop 1\n\t" "v_fmac_f32_dpp %0, -%2, %3 row_newbcast:9 row_mask:0xf bank_mask:0xf\n\t" "v_fmac_f32_dpp %1, -%4, %5 row_newbcast:9 row_mask:0xf bank_mask:0xf\n\t" "v_fmac_f32_dpp %0, -%6, %7 row_newbcast:9 row_mask:0xf bank_mask:0xf\n\t" "v_fmac_f32_dpp %1, -%8, %9 row_newbcast:9 row_mask:0xf bank_mask:0xf\n\t" : "+v"(a2), "+v"(a3) : "v"(Mr[2]), "v"(X[2]), "v"(Mr[3]), "v"(X[3]), "v"(Mr[6]), "v"(X[6]), "v"(Mr[7]), "v"(X[7]));
      X[9] = (a0 + a1) + (a2 + a3); }
    { float a0 = (l16 == 10) ? 1.f : 0.f, a1 = 0.f, a2 = 0.f, a3 = 0.f;
      asm("s_nop 1\n\t" "v_fmac_f32_dpp %0, -%2, %3 row_newbcast:10 row_mask:0xf bank_mask:0xf\n\t" "v_fmac_f32_dpp %1, -%4, %5 row_newbcast:10 row_mask:0xf bank_mask:0xf\n\t" "v_fmac_f32_dpp %0, -%6, %7 row_newbcast:10 row_mask:0xf bank_mask:0xf\n\t" "v_fmac_f32_dpp %1, -%8, %9 row_newbcast:10 row_mask:0xf bank_mask:0xf\n\t" "v_fmac_f32_dpp %0, -%10, %11 row_newbcast:10 row_mask:0xf bank_mask:0xf\n\t" "v_fmac_f32_dpp %1, -%12, %13 row_newbcast:10 row_mask:0xf bank_mask:0xf\n\t" : "+v"(a0), "+v"(a1) : "v"(Mr[0]), "v"(X[0]), "v"(Mr[1]), "v"(X[1]), "v"(Mr[4]), "v"(X[4]), "v"(Mr[5]), "v"(X[5]), "v"(Mr[8]), "v"(X[8]), "v"(Mr[9]), "v"(X[9]));
      asm("s_nop 1\n\t" "v_fmac_f32_dpp %0, -%2, %3 row_newbcast:10 row_mask:0xf bank_mask:0xf\n\t" "v_fmac_f32_dpp %1, -%4, %5 row_newbcast:10 row_mask:0xf bank_mask:0xf\n\t" "v_fmac_f32_dpp %0, -%6, %7 row_newbcast:10 row_mask:0xf bank_mask:0xf\n\t" "v_fmac_f32_dpp %1, -%8, %9 row_newbcast:10 row_mask:0xf bank_mask:0xf\n\t" : "+v"(a2), "+v"(a3) : "v"(Mr[2]), "v"(X[2]), "v"(Mr[3]), "v"(X[3]), "v"(Mr[6]), "v"(X[6]), "v"(Mr[7]), "v"(X[7]));
      X[10] = (a0 + a1) + (a2 + a3); }
    { float a0 = (l16 == 11) ? 1.f : 0.f, a1 = 0.f, a2 = 0.f, a3 = 0.f;
      asm("s_nop 1\n\t" "v_fmac_f32_dpp %0, -%2, %3 row_newbcast:11 row_mask:0xf bank_mask:0xf\n\t" "v_fmac_f32_dpp %1, -%4, %5 row_newbcast:11 row_mask:0xf bank_mask:0xf\n\t" "v_fmac_f32_dpp %0, -%6, %7 row_newbcast:11 row_mask:0xf bank_mask:0xf\n\t" "v_fmac_f32_dpp %1, -%8, %9 row_newbcast:11 row_mask:0xf bank_mask:0xf\n\t" "v_fmac_f32_dpp %0, -%10, %11 row_newbcast:11 row_mask:0xf bank_mask:0xf\n\t" "v_fmac_f32_dpp %1, -%12, %13 row_newbcast:11 row_mask:0xf bank_mask:0xf\n\t" : "+v"(a0), "+v"(a1) : "v"(Mr[0]), "v"(X[0]), "v"(Mr[1]), "v"(X[1]), "v"(Mr[4]), "v"(X[4]), "v"(Mr[5]), "v"(X[5]), "v"(Mr[8]), "v"(X[8]), "v"(Mr[9]), "v"(X[9]));
      asm("s_nop 1\n\t" "v_fmac_f32_dpp %0, -%2, %3 row_newbcast:11 row_mask:0xf bank_mask:0xf\n\t" "v_fmac_f32_dpp %1, -%4, %5 row_newbcast:11 row_mask:0xf bank_mask:0xf\n\t" "v_fmac_f32_dpp %0, -%6, %7 row_newbcast:11 row_mask:0xf bank_mask:0xf\n\t" "v_fmac_f32_dpp %1, -%8, %9 row_newbcast:11 row_mask:0xf bank_mask:0xf\n\t" "v_fmac_f32_dpp %0, -%10, %11 row_newbcast:11 row_mask:0xf bank_mask:0xf\n\t" : "+v"(a2), "+v"(a3) : "v"(Mr[2]), "v"(X[2]), "v"(Mr[3]), "v"(X[3]), "v"(Mr[6]), "v"(X[6]), "v"(Mr[7]), "v"(X[7]), "v"(Mr[10]), "v"(X[10]));
      X[11] = (a0 + a1) + (a2 + a3); }
    { float a0 = (l16 == 12) ? 1.f : 0.f, a1 = 0.f, a2 = 0.f, a3 = 0.f;
      asm("s_nop 1\n\t" "v_fmac_f32_dpp %0, -%2, %3 row_newbcast:12 row_mask:0xf bank_mask:0xf\n\t" "v_fmac_f32_dpp %1, -%4, %5 row_newbcast:12 row_mask:0xf bank_mask:0xf\n\t" "v_fmac_f32_dpp %0, -%6, %7 row_newbcast:12 row_mask:0xf bank_mask:0xf\n\t" "v_fmac_f32_dpp %1, -%8, %9 row_newbcast:12 row_mask:0xf bank_mask:0xf\n\t" "v_fmac_f32_dpp %0, -%10, %11 row_newbcast:12 row_mask:0xf bank_mask:0xf\n\t" "v_fmac_f32_dpp %1, -%12, %13 row_newbcast:12 row_mask:0xf bank_mask:0xf\n\t" : "+v"(a0), "+v"(a1) : "v"(Mr[0]), "v"(X[0]), "v"(Mr[1]), "v"(X[1]), "v"(Mr[4]), "v"(X[4]), "v"(Mr[5]), "v"(X[5]), "v"(Mr[8]), "v"(X[8]), "v"(Mr[9]), "v"(X[9]));
      asm("s_nop 1\n\t" "v_fmac_f32_dpp %0, -%2, %3 row_newbcast:12 row_mask:0xf bank_mask:0xf\n\t" "v_fmac_f32_dpp %1, -%4, %5 row_newbcast:12 row_mask:0xf bank_mask:0xf\n\t" "v_fmac_f32_dpp %0, -%6, %7 row_newbcast:12 row_mask:0xf bank_mask:0xf\n\t" "v_fmac_f32_dpp %1, -%8, %9 row_newbcast:12 row_mask:0xf bank_mask:0xf\n\t" "v_fmac_f32_dpp %0, -%10, %11 row_newbcast:12 row_mask:0xf bank_mask:0xf\n\t" "v_fmac_f32_dpp %1, -%12, %13 row_newbcast:12 row_mask:0xf bank_mask:0xf\n\t" : "+v"(a2), "+v"(a3) : "v"(Mr[2]), "v"(X[2]), "v"(Mr[3]), "v"(X[3]), "v"(Mr[6]), "v"(X[6]), "v"(Mr[7]), "v"(X[7]), "v"(Mr[10]), "v"(X[10]), "v"(Mr[11]), "v"(X[11]));
      X[12] = (a0 + a1) + (a2 + a3); }
    { float a0 = (l16 == 13) ? 1.f : 0.f, a1 = 0.f, a2 = 0.f, a3 = 0.f;
      asm("s_nop 1\n\t" "v_fmac_f32_dpp %0, -%2, %3 row_newbcast:13 row_mask:0xf bank_mask:0xf\n\t" "v_fmac_f32_dpp %1, -%4, %5 row_newbcast:13 row_mask:0xf bank_mask:0xf\n\t" "v_fmac_f32_dpp %0, -%6, %7 row_newbcast:13 row_mask:0xf bank_mask:0xf\n\t" "v_fmac_f32_dpp %1, -%8, %9 row_newbcast:13 row_mask:0xf bank_mask:0xf\n\t" "v_fmac_f32_dpp %0, -%10, %11 row_newbcast:13 row_mask:0xf bank_mask:0xf\n\t" "v_fmac_f32_dpp %1, -%12, %13 row_newbcast:13 row_mask:0xf bank_mask:0xf\n\t" "v_fmac_f32_dpp %0, -%14, %15 row_newbcast:13 row_mask:0xf bank_mask:0xf\n\t" : "+v"(a0), "+v"(a1) : "v"(Mr[0]), "v"(X[0]), "v"(Mr[1]), "v"(X[1]), "v"(Mr[4]), "v"(X[4]), "v"(Mr[5]), "v"(X[5]), "v"(Mr[8]), "v"(X[8]), "v"(Mr[9]), "v"(X[9]), "v"(Mr[12]), "v"(X[12]));
      asm("s_nop 1\n\t" "v_fmac_f32_dpp %0, -%2, %3 row_newbcast:13 row_mask:0xf bank_mask:0xf\n\t" "v_fmac_f32_dpp %1, -%4, %5 row_newbcast:13 row_mask:0xf bank_mask:0xf\n\t" "v_fmac_f32_dpp %0, -%6, %7 row_newbcast:13 row_mask:0xf bank_mask:0xf\n\t" "v_fmac_f32_dpp %1, -%8, %9 row_newbcast:13 row_mask:0xf bank_mask:0xf\n\t" "v_fmac_f32_dpp %0, -%10, %11 row_newbcast:13 row_mask:0xf bank_mask:0xf\n\t" "v_fmac_f32_dpp %1, -%12, %13 row_newbcast:13 row_mask:0xf bank_mask:0xf\n\t" : "+v"(a2), "+v"(a3) : "v"(Mr[2]), "v"(X[2]), "v"(Mr[3]), "v"(X[3]), "v"(Mr[6]), "v"(X[6]), "v"(Mr[7]), "v"(X[7]), "v"(Mr[10]), "v"(X[10]), "v"(Mr[11]), "v"(X[11]));
      X[13] = (a0 + a1) + (a2 + a3); }
    { float a0 = (l16 == 14) ? 1.f : 0.f, a1 = 0.f, a2 = 0.f, a3 = 0.f;
      asm("s_nop 1\n\t" "v_fmac_f32_dpp %0, -%2, %3 row_newbcast:14 row_mask:0xf bank_mask:0xf\n\t" "v_fmac_f32_dpp %1, -%4, %5 row_newbcast:14 row_mask:0xf bank_mask:0xf\n\t" "v_fmac_f32_dpp %0, -%6, %7 row_newbcast:14 row_mask:0xf bank_mask:0xf\n\t" "v_fmac_f32_dpp %1, -%8, %9 row_newbcast:14 row_mask:0xf bank_mask:0xf\n\t" "v_fmac_f32_dpp %0, -%10, %11 row_newbcast:14 row_mask:0xf bank_mask:0xf\n\t" "v_fmac_f32_dpp %1, -%12, %13 row_newbcast:14 row_mask:0xf bank_mask:0xf\n\t" "v_fmac_f32_dpp %0, -%14, %15 row_newbcast:14 row_mask:0xf bank_mask:0xf\n\t" "v_fmac_f32_dpp %1, -%16, %17 row_newbcast:14 row_mask:0xf bank_mask:0xf\n\t" : "+v"(a0), "+v"(a1) : "v"(Mr[0]), "v"(X[0]), "v"(Mr[1]), "v"(X[1]), "v"(Mr[4]), "v"(X[4]), "v"(Mr[5]), "v"(X[5]), "v"(Mr[8]), "v"(X[8]), "v"(Mr[9]), "v"(X[9]), "v"(Mr[12]), "v"(X[12]), "v"(Mr[13]), "v"(X[13]));
      asm("s_nop 1\n\t" "v_fmac_f32_dpp %0, -%2, %3 row_newbcast:14 row_mask:0xf bank_mask:0xf\n\t" "v_fmac_f32_dpp %1, -%4, %5 row_newbcast:14 row_mask:0xf bank_mask:0xf\n\t" "v_fmac_f32_dpp %0, -%6, %7 row_newbcast:14 row_mask:0xf bank_mask:0xf\n\t" "v_fmac_f32_dpp %1, -%8, %9 row_newbcast:14 row_mask:0xf bank_mask:0xf\n\t" "v_fmac_f32_dpp %0, -%10, %11 row_newbcast:14 row_mask:0xf bank_mask:0xf\n\t" "v_fmac_f32_dpp %1, -%12, %13 row_newbcast:14 row_mask:0xf bank_mask:0xf\n\t" : "+v"(a2), "+v"(a3) : "v"(Mr[2]), "v"(X[2]), "v"(Mr[3]), "v"(X[3]), "v"(Mr[6]), "v"(X[6]), "v"(Mr[7]), "v"(X[7]), "v"(Mr[10]), "v"(X[10]), "v"(Mr[11]), "v"(X[11]));
      X[14] = (a0 + a1) + (a2 + a3); }
    { float a0 = (l16 == 15) ? 1.f : 0.f, a1 = 0.f, a2 = 0.f, a3 = 0.f;
      asm("s_nop 1\n\t" "v_fmac_f32_dpp %0, -%2, %3 row_newbcast:15 row_mask:0xf bank_mask:0xf\n\t" "v_fmac_f32_dpp %1, -%4, %5 row_newbcast:15 row_mask:0xf bank_mask:0xf\n\t" "v_fmac_f32_dpp %0, -%6, %7 row_newbcast:15 row_mask:0xf bank_mask:0xf\n\t" "v_fmac_f32_dpp %1, -%8, %9 row_newbcast:15 row_mask:0xf bank_mask:0xf\n\t" "v_fmac_f32_dpp %0, -%10, %11 row_newbcast:15 row_mask:0xf bank_mask:0xf\n\t" "v_fmac_f32_dpp %1, -%12, %13 row_newbcast:15 row_mask:0xf bank_mask:0xf\n\t" "v_fmac_f32_dpp %0, -%14, %15 row_newbcast:15 row_mask:0xf bank_mask:0xf\n\t" "v_fmac_f32_dpp %1, -%16, %17 row_newbcast:15 row_mask:0xf bank_mask:0xf\n\t" : "+v"(a0), "+v"(a1) : "v"(Mr[0]), "v"(X[0]), "v"(Mr[1]), "v"(X[1]), "v"(Mr[4]), "v"(X[4]), "v"(Mr[5]), "v"(X[5]), "v"(Mr[8]), "v"(X[8]), "v"(Mr[9]), "v"(X[9]), "v"(Mr[12]), "v"(X[12]), "v"(Mr[13]), "v"(X[13]));
      asm("s_nop 1\n\t" "v_fmac_f32_dpp %0, -%2, %3 row_newbcast:15 row_mask:0xf bank_mask:0xf\n\t" "v_fmac_f32_dpp %1, -%4, %5 row_newbcast:15 row_mask:0xf bank_mask:0xf\n\t" "v_fmac_f32_dpp %0, -%6, %7 row_newbcast:15 row_mask:0xf bank_mask:0xf\n\t" "v_fmac_f32_dpp %1, -%8, %9 row_newbcast:15 row_mask:0xf bank_mask:0xf\n\t" "v_fmac_f32_dpp %0, -%10, %11 row_newbcast:15 row_mask:0xf bank_mask:0xf\n\t" "v_fmac_f32_dpp %1, -%12, %13 row_newbcast:15 row_mask:0xf bank_mask:0xf\n\t" "v_fmac_f32_dpp %0, -%14, %15 row_newbcast:15 row_mask:0xf bank_mask:0xf\n\t" : "+v"(a2), "+v"(a3) : "v"(Mr[2]), "v"(X[2]), "v"(Mr[3]), "v"(X[3]), "v"(Mr[6]), "v"(X[6]), "v"(Mr[7]), "v"(X[7]), "v"(Mr[10]), "v"(X[10]), "v"(Mr[11]), "v"(X[11]), "v"(Mr[14]), "v"(X[14]));
      X[15] = (a0 + a1) + (a2 + a3); }
}

#ifndef RWKV_REP
#define RWKV_REP 1
#endif
namespace rk {
constexpr int S64 = 160, S32 = 80, SW = 144;
constexpr int O_WUP = 0, O_AUP = O_WUP + 64 * SW, O_WLT = O_AUP + 64 * SW, O_ALT = O_WLT + 16 * S64, O_LW = O_ALT + 16 * S64, O_LA = O_LW + 4096,
              O_KKT = O_LA + 4096, O_RT = O_KKT + 16 * S64, O_BT = O_RT + 16 * S64, O_KDT = O_BT + 16 * S64,
              O_VT = O_KDT + 16 * S64, O_BHT = O_VT + 64 * S32, O_KHT = O_BHT + 64 * S32, O_UT = O_KHT + 64 * S32, O_UTT = O_WLT  ,
              O_TI = O_UT + 64 * S32, O_MK = O_TI + 16 * S32, O_NB = O_MK + 16 * S32, O_NK = O_NB + 16 * S32,
              O_SBF = O_NK + 16 * S32, O_WC = O_SBF + 64 * S64, O_WT = O_WC + 256, TEAM_BYTES = O_WT + 1024;
static_assert(2 * TEAM_BYTES <= LDS_MISC, "rwkv LDS");
}
__device__ __forceinline__ void rwkv_pair_chunked(const Args& A, Ctx& C, int pair) {
    using namespace rk;
    const int b = pair >> 3, h = pair & 7;
    const int dir = C.wave >> 2;
    const int t4 = C.tid & 255, q = C.wave & 3, lane = C.lane;
    lbyte* L = C.lds + dir * TEAM_BYTES;
    const bf16_t* P = WSP(bf16_t, WS_P);
    bf16_t* ydir = WSP(bf16_t, WS_YDIR) + (size_t)dir * NLAT * D;
    float* bon = WSP(float, WS_BON) + (size_t)dir * NLAT * 8;
    __syncthreads();
#pragma unroll 2
    for (int i = t4; i < 4096; i += 256) { const int l = i >> 6, c = i & 63;
        st_bf16(L + O_WUP + c * SW + l * 2, A.in[I_WUP][((size_t)dir * 64 + l) * DA + 64 * h + c]);
        st_bf16(L + O_AUP + c * SW + l * 2, A.in[I_AUP][((size_t)dir * 64 + l) * DA + 64 * h + c]); }
#pragma unroll 2
    for (int i = t4; i < (4 * 64 * S32 + 4 * 16 * S32 + 64 * S64) / 4; i += 256) ((LAS unsigned*)(L + O_VT))[i] = 0u;
    for (int i = t4; i < (2 * 16 * S64) / 4; i += 256) ((LAS unsigned*)(L + O_WLT))[i] = 0u;
    const int c = lane;
    const int col5[5] = {64 * h + c, 512 + 64 * h + c, 1024 + 64 * h + c, 1536 + 64 * dir + c, 1664 + 64 * dir + c};
    float mu5[5]; unsigned coff[5], nm[5], nlo[5], nrg[5]; int ndb[5];
#pragma unroll
    for (int e = 0; e < 5; ++e) { mu5[e] = A.in[I_MU][col5[e]]; coff[e] = (unsigned)col5[e] * 2u; }
    auto set_rules = [&](bool ctx) {
#pragma unroll
        for (int e = 0; e < 5; ++e) { const int col = col5[e];
            if (ctx) { nm[e] = 0xffffffffu; nlo[e] = col < 960 ? 1u : 0u; nrg[e] = (unsigned)(CTX - 2); ndb[e] = (col < 960 ? -PLD : PLD) * 2; }
            else { const int cls = col < 480 ? 0 : (col < 960 ? 1 : (col < 1440 ? 2 : 3));
                nm[e] = cls < 2 ? 63u : 0xffffffffu; nlo[e] = cls == 0 ? 1u : (cls == 2 ? 64u : 0u); nrg[e] = cls < 2 ? 62u : (unsigned)(SEQ - 65);
                ndb[e] = (cls == 0 ? -PLD : (cls == 1 ? PLD : (cls == 2 ? -64 * PLD : 64 * PLD))) * 2; } } };
    set_rules(true);
    const char* wsb = (const char*)A.ws;
    const float kkc = A.in[I_KK][64 * h + c], kac = A.in[I_KA][64 * h + c], rkc = A.in[I_RK][64 * h + c];
    const float w0c = A.in[I_W0][dir * DA + 64 * h + c], a0c = A.in[I_A0][dir * DA + 64 * h + c];
    f32x4 Sacc[4];
#pragma unroll
    for (int i = 0; i < 4; ++i) Sacc[i] = (f32x4){0.f, 0.f, 0.f, 0.f};
    const int fr = lane & 15, fg = lane >> 4;
    unsigned short rawp[4][5], raws[4][5];
    auto chunk_geom = [&](int ch, bool& isctx, int& sbase, int& T, size_t& rowbase) { isctx = ch < 16; sbase = isctx ? ch * 16 : (ch - 16) * 16; T = isctx ? CTX : SEQ; rowbase = isctx ? (size_t)NLAT + (size_t)b * CTX : (size_t)b * SEQ; };
    auto issue_loads = [&](int ch) { bool isctx; int sbase, T; size_t rowbase; chunk_geom(ch, isctx, sbase, T, rowbase);
#pragma unroll
        for (int j = 0; j < 4; ++j) { const int i = 4 * q + j; const int t = __builtin_amdgcn_readfirstlane(dir ? (T - 1 - (sbase + i)) : (sbase + i));
            const unsigned rowoff = (unsigned)WS_P + (unsigned)(rowbase + t) * (unsigned)(PLD * 2);
#pragma unroll
            for (int e = 0; e < 5; ++e) { const unsigned vs = rowoff + coff[e]; const bool ok = (((unsigned)t & nm[e]) - nlo[e]) <= nrg[e]; const unsigned vn = ok ? vs + (unsigned)ndb[e] : 8u;
                rawp[j][e] = *(const bf16_t*)(wsb + vs); raws[j][e] = *(const bf16_t*)(wsb + vn); } } };
    u32x2 ypend; ypend.x = 0u; ypend.y = 0u; float bpend[4] = {0.f, 0.f, 0.f, 0.f};
    auto flush = [&](int pch) { bool pisctx; int psb, pT; size_t prb; chunk_geom(pch, pisctx, psb, pT, prb);
        if (!pisctx) { const int t = dir ? (pT - 1 - (psb + fr)) : (psb + fr);
            *(u32x2*)(ydir + ((size_t)b * SEQ + t) * D + 64 * h + 16 * q + 4 * fg) = ypend;
            if (lane == 0) {
#pragma unroll
                for (int j = 0; j < 4; ++j) { const int i = 4 * q + j; const int tj = dir ? (pT - 1 - (psb + i)) : (psb + i); bon[((size_t)b * SEQ + tj) * 8 + h] = bpend[j]; } } } };
    issue_loads(0);
    for (int ch = 0; ch < 144; ++ch) {
        bool isctx; int sbase, T; size_t rowbase; chunk_geom(ch, isctx, sbase, T, rowbase);
        float vr[4], vk[4], vv[4], vkk[4], lw[4], av[4];
        __syncthreads();
        float mxa[4][5];
#pragma unroll
        for (int j = 0; j < 4; ++j) {
#pragma unroll
            for (int e = 0; e < 5; ++e) { const float pv = bf2f(rawp[j][e]); const float sv = bf2f(raws[j][e]); mxa[j][e] = pv + mu5[e] * (sv - pv); } }
        asm volatile("" :: "v"(mxa[0][0]), "v"(mxa[0][1]), "v"(mxa[0][2]), "v"(mxa[0][3]), "v"(mxa[0][4]), "v"(mxa[1][0]), "v"(mxa[1][1]), "v"(mxa[1][2]), "v"(mxa[1][3]), "v"(mxa[1][4]),
                        "v"(mxa[2][0]), "v"(mxa[2][1]), "v"(mxa[2][2]), "v"(mxa[2][3]), "v"(mxa[2][4]), "v"(mxa[3][0]), "v"(mxa[3][1]), "v"(mxa[3][2]), "v"(mxa[3][3]), "v"(mxa[3][4]) : "memory");
        if (ch > 0) flush(ch - 1);
        if (ch == 15) set_rules(false);
        if (ch + 1 < 144) issue_loads(ch + 1);
        float cl[4];
        _Pragma("unroll") for (int rrep = 0; rrep < RWKV_REP; ++rrep) {
#pragma unroll
        for (int j = 0; j < 4; ++j) {
            const int i = 4 * q + j;
            float mx[5];
#pragma unroll
            for (int e = 0; e < 5; ++e) mx[e] = mxa[j][e];
            vr[j] = mx[0]; vk[j] = mx[1]; vv[j] = mx[2];
            *(LAS unsigned short*)(L + O_WLT + i * S64 + c * 2) = (unsigned short)cvtpk(tanhf_(mx[3]), 0.f); *(LAS unsigned short*)(L + O_ALT + i * S64 + c * 2) = (unsigned short)cvtpk(mx[4], 0.f);
            const float kx = vk[j] * kkc; const float ss = wave_sum(kx * kx);
            vkk[j] = kx * __builtin_amdgcn_rsqf(ss + 1e-6f);
        }
        __syncthreads();
        {
            const f32x4 z = (f32x4){0.f, 0.f, 0.f, 0.f};
            const f32x4 tw = mm_tile<2>(L + O_WLT, S64, L + O_WUP + 16 * q * SW, SW, z, lane);
            const f32x4 ta = mm_tile<2>(L + O_ALT, S64, L + O_AUP + 16 * q * SW, SW, z, lane);
#pragma unroll
            for (int e = 0; e < 4; ++e) { ((LAS float*)(L + O_LW))[(4 * fg + e) * 64 + 16 * q + fr] = tw[e]; ((LAS float*)(L + O_LA))[(4 * fg + e) * 64 + 16 * q + fr] = ta[e]; }
        }
        __syncthreads();
        { float run = 0.f;
#pragma unroll
        for (int j = 0; j < 4; ++j) { const int i = 4 * q + j;
            const float wlog = -softplusf_(-(w0c + ((LAS float*)(L + O_LW))[i * 64 + c])) - 0.5f;
            lw[j] = -__expf(wlog);
            av[j] = sigmoidf_(a0c + ((LAS float*)(L + O_LA))[i * 64 + c]);
            run += lw[j]; cl[j] = run; }
        ((LAS float*)(L + O_WT))[q * 64 + c] = run; }
        __syncthreads();
        }
        {
            float off = 0.f, cumC = 0.f;
#pragma unroll
            for (int qq = 0; qq < 4; ++qq) { const float tv = ((LAS float*)(L + O_WT))[qq * 64 + c]; cumC += tv; off += (qq < q) ? tv : 0.f; }
            float tv_[4], tb_[4], tk_[4];
            float Wprev = __expf(off); const float eC = __expf(cumC);
#pragma unroll
            for (int j = 0; j < 4; ++j) { const int i = 4 * q + j;
                const float cum = off + cl[j];
                const float Wt = __expf(cum), Wp = Wprev, Wi = __builtin_amdgcn_rcpf(Wt), Wc = eC * Wi; Wprev = Wt;
                const float kd = vk[j] * (1.f + (av[j] - 1.f) * kac), bb = vkk[j] * av[j];
                const unsigned p0 = cvtpk(vkk[j] * Wp, vr[j] * Wt), p1 = cvtpk(bb * Wi, kd * Wi);
                *(LAS unsigned short*)(L + O_KKT + i * S64 + c * 2) = (unsigned short)p0; *(LAS unsigned short*)(L + O_RT + i * S64 + c * 2) = (unsigned short)(p0 >> 16);
                *(LAS unsigned short*)(L + O_BT + i * S64 + c * 2) = (unsigned short)p1; *(LAS unsigned short*)(L + O_KDT + i * S64 + c * 2) = (unsigned short)(p1 >> 16);
                tv_[j] = vv[j]; tb_[j] = bb * Wc; tk_[j] = kd * Wc;
                const float bs = wave_sum(vr[j] * kd * rkc);
                bpend[j] = bs;
            }
#pragma unroll
            for (int jp = 0; jp < 2; ++jp) { const int i = 4 * q + 2 * jp;
                *(LAS unsigned*)(L + O_VT + c * S32 + i * 2) = cvtpk(tv_[2 * jp], tv_[2 * jp + 1]);
                *(LAS unsigned*)(L + O_BHT + c * S32 + i * 2) = cvtpk(tb_[2 * jp], tb_[2 * jp + 1]);
                *(LAS unsigned*)(L + O_KHT + c * S32 + i * 2) = cvtpk(tk_[2 * jp], tk_[2 * jp + 1]); }
            if (q == 3) ((LAS float*)(L + O_WC))[c] = eC;
        }
        __syncthreads();
        {
            const int role = (q + dir) & 3;
            const lbyte* Aj = L + ((role & 1) ? O_KDT : O_BT);
            const lbyte* Bt = L + ((role & 2) ? O_RT : O_KKT);
            f32x4 g4 = mm_tile<2>(Aj, S64, Bt, S64, (f32x4){0.f, 0.f, 0.f, 0.f}, lane);
#pragma unroll
            for (int e = 0; e < 4; ++e) { const int j = 4 * fg + e; const bool keep = (role & 2) ? (j <= fr) : (j < fr); g4[e] = keep ? g4[e] : 0.f; }
            if (role == 0) { float X[16]; tri_inv16(g4, lane, L + O_LW, X);
                if (lane < 16) {
#pragma unroll
                    for (int i = 0; i < 16; ++i) *(LAS unsigned short*)(L + O_TI + i * S32 + lane * 2) = (unsigned short)cvtpk(X[i], 0.f); } }
            else st_bf16x4(L + (role == 1 ? O_MK : (role == 2 ? O_NB : O_NK)) + fr * S32 + fg * 8, g4);
        }
        __syncthreads();
        f32x4 yacc;
        {
            f32x4 u4 = mm_tile<2>(L + O_KKT, S64, L + O_SBF + 16 * q * S64, S64, (f32x4){0.f, 0.f, 0.f, 0.f}, lane);
            u4 = mm_tile<1>(L + O_MK, S32, L + O_VT + 16 * q * S32, S32, u4, lane);
            st_bf16x4(L + O_UTT + (16 * q + fr) * S32 + fg * 8, u4);
            yacc = mm_tile<2>(L + O_SBF + 16 * q * S64, S64, L + O_RT, S64, (f32x4){0.f, 0.f, 0.f, 0.f}, lane);
            yacc = mm_tile<1>(L + O_VT + 16 * q * S32, S32, L + O_NK, S32, yacc, lane);
        }
        asm volatile("s_waitcnt lgkmcnt(0)" ::: "memory");
        {
            f32x4 u4 = mm_tile<1>(L + O_TI, S32, L + O_UTT + 16 * q * S32, S32, (f32x4){0.f, 0.f, 0.f, 0.f}, lane);
            st_bf16x4(L + O_UT + (16 * q + fr) * S32 + fg * 8, -u4);
        }
        __syncthreads();
        {
            yacc = mm_tile<1>(L + O_UT + 16 * q * S32, S32, L + O_NB, S32, yacc, lane);
            ypend.x = cvtpk(yacc[0], yacc[1]); ypend.y = cvtpk(yacc[2], yacc[3]);
            const f32x4 wc4 = *(LAS f32x4*)(L + O_WC + (16 * q + 4 * fg) * 4);
#pragma unroll
            for (int vi = 0; vi < 4; ++vi) {
                f32x4 s4 = Sacc[vi] * wc4;
                s4 = mm_tile<1>(L + O_KHT + 16 * q * S32, S32, L + O_VT + 16 * vi * S32, S32, s4, lane);
                s4 = mm_tile<1>(L + O_BHT + 16 * q * S32, S32, L + O_UT + 16 * vi * S32, S32, s4, lane);
                Sacc[vi] = s4;
                st_bf16x4(L + O_SBF + (16 * vi + fr) * S64 + (16 * q + 4 * fg) * 2, s4);
            }
        }
    }
    flush(143);
    __syncthreads();
}

__device__ __forceinline__ void phase_gdn_prep(const Args& A, Ctx& C) {
    const bf16_t* P = WSP(bf16_t, WS_P);
    bf16_t* QKV = (bf16_t*)A.out; float* NRM = WSP(float, WS_NRM);
    lfloat* part = (lfloat*)C.lds;
    const int tid = C.tid, lane = C.lane, w = C.wave;
    float cw[3][5];
#pragma unroll
    for (int g = 0; g < 3; ++g)
#pragma unroll
        for (int e = 0; e < 5; ++e) cw[g][e] = A.in[I_CONVW][e * 1536 + g * 512 + tid];
    for (int tile = C.bid; tile < NROWS / 16; tile += C.G) {
        const int row0 = tile * 16;
        int T, ta; size_t rowbase;
        if (row0 < NLAT) { T = SEQ; rowbase = (size_t)(row0 >> 11) * SEQ; ta = row0 & (SEQ - 1); } else { T = CTX; const int r = row0 - NLAT; rowbase = (size_t)NLAT + (size_t)(r >> 8) * CTX; ta = r & (CTX - 1); }
        float x[3][20];
#pragma unroll
        for (int e = 0; e < 20; ++e) { const int t = ta - 2 + e; const bool ok = (t >= 0 && t < T); const bf16_t* pr = P + (rowbase + (ok ? t : ta)) * PLD + RW_COLS + tid;
#pragma unroll
            for (int g = 0; g < 3; ++g) { const float xv = bf2f(pr[g * 512]); x[g][e] = ok ? xv : 0.f; } }
        __syncthreads();
#pragma unroll
        for (int i = 0; i < 16; ++i) { float y[3];
#pragma unroll
            for (int g = 0; g < 3; ++g) { float sacc = 0.f;
#pragma unroll
                for (int f = 0; f < 5; ++f) sacc += cw[g][f] * x[g][i + f];
                y[g] = siluf_(sacc); }
            bf16_t* orow = QKV + (rowbase + ta + i) * 1536 + tid;
            orow[0] = (bf16_t)cvtpk(y[0], 0.f); orow[512] = (bf16_t)cvtpk(y[1], 0.f); orow[1024] = (bf16_t)cvtpk(y[2], 0.f);
            const float sq = wave_sum(y[0] * y[0]), sk = wave_sum(y[1] * y[1]);
            if (lane == 0) { part[(i * 8 + w) * 2] = sq; part[(i * 8 + w) * 2 + 1] = sk; } }
        __syncthreads();
        if (tid < 128) { const int i = tid >> 3, sidx = tid & 7, h = sidx & 3, sel = sidx >> 2;
            const float ss = part[(i * 8 + 2 * h) * 2 + sel] + part[(i * 8 + 2 * h + 1) * 2 + sel];
            NRM[(rowbase + ta + i) * 8 + sidx] = __builtin_amdgcn_rsqf(ss + 1e-6f) * (sel ? 1.f : 0.08838834764831845f); }
    }
    __syncthreads();
}

namespace gd {
constexpr int S128 = 288, S32 = 80;
constexpr int O_KT = 0, O_QT = O_KT + 32 * S128, O_KKT = O_QT + 32 * S128, O_RT = O_KKT + 32 * S128,
              O_VT = O_RT + 32 * S128, O_BHT = O_VT + 128 * S32, O_KHT = O_BHT + 128 * S32, O_UT = O_KHT + 128 * S32, O_UTT = O_UT + 128 * S32,
              O_TI = O_UTT + 128 * S32, O_MK = O_TI + 32 * S32, O_NB = O_MK + 32 * S32, O_NK = O_NB + 32 * S32,
              O_M21 = O_NK + 32 * S32, O_T11T = O_M21 + 16 * S32, O_T22 = O_T11T + 16 * S32, O_XT = O_T22 + 16 * S32,
              O_SBF = O_XT + 16 * S32, O_SC = O_SBF + 128 * S128, O_MS = O_SC + 512, GD_BYTES = O_MS + 2048;
static_assert(GD_BYTES <= LDS_MISC, "gdn LDS");
}
__device__ __forceinline__ void gdn_chain_chunked(const Args& A, Ctx& C, int chain) {
    using namespace gd;
    const int b = chain >> 3, h = (chain >> 1) & 3, dir = chain & 1;
    lbyte* L = C.lds;
    LAS float* SC = (LAS float*)(L + O_SC);
    const bf16_t* P = WSP(bf16_t, WS_P);
    bf16_t* ydir = WSP(bf16_t, WS_YDIR) + (size_t)dir * NLAT * D;
    const int tid = C.tid, lane = C.lane, w = C.wave, fr = lane & 15, fg = lane >> 4;
    const int grp = w >> 1, idx = tid & 127;
    const float Aexp = __expf(A.in[I_ALOG][dir * 4 + h]), dtb = A.in[I_DTB][dir * 4 + h];
    const f32x4 z4 = (f32x4){0.f, 0.f, 0.f, 0.f};
    __syncthreads();
#pragma unroll 2
    for (int i = tid; i < (O_SC - O_VT) / 4; i += 512) ((LAS unsigned*)(L + O_VT))[i] = 0u;
    f32x4 Sacc[8];
#pragma unroll
    for (int i = 0; i < 8; ++i) Sacc[i] = z4;
    const bf16_t* QKV = (const bf16_t*)A.out; const float* NRM = WSP(const float, WS_NRM);
    unsigned rq[8], rk[8], rv[8]; float nq[8], nk[8]; unsigned raw_al = 0, raw_be = 0;
    const unsigned codd = (idx & 1) ? 0u : 16u, godd = (h & 1) ? 0u : 16u;
    auto chunk_geom = [&](int ch, bool& isctx, int& sbase, int& T, size_t& rowbase) { isctx = ch < 8; sbase = isctx ? ch * 32 : (ch - 8) * 32; T = isctx ? CTX : SEQ;
        rowbase = isctx ? (size_t)NLAT + (size_t)b * CTX : (size_t)b * SEQ; };
    auto issue_loads = [&](int ch) { bool isctx; int sbase, T; size_t rowbase; chunk_geom(ch, isctx, sbase, T, rowbase);
#pragma unroll
        for (int j = 0; j < 8; ++j) { const int i = 2 * grp + 8 * (j >> 1) + (j & 1); const int t = dir ? (T - 1 - (sbase + i)) : (sbase + i); const size_t row = rowbase + t;
            const unsigned* qr = (const unsigned*)(QKV + row * 1536 + 128 * h + (idx & ~1)); rq[j] = qr[0]; rk[j] = qr[256]; rv[j] = qr[512]; nq[j] = NRM[row * 8 + h]; nk[j] = NRM[row * 8 + 4 + h]; }
        if (w == 7 && lane < 32) { const int t = dir ? (T - 1 - (sbase + lane)) : (sbase + lane); const unsigned* pr = (const unsigned*)(P + (rowbase + t) * PLD + RW_COLS + 2048 + ((dir * 4 + h) & ~1)); raw_al = pr[0]; raw_be = pr[4]; } };
    u32x2 ypend[2]; ypend[0].x = ypend[0].y = ypend[1].x = ypend[1].y = 0u;
    auto flush = [&](int pch) { bool pisctx; int psb, pT; size_t prb; chunk_geom(pch, pisctx, psb, pT, prb);
        if (!pisctx) {
#pragma unroll
            for (int tb = 0; tb < 2; ++tb) { const int tl = psb + tb * 16 + fr; const int t = dir ? (pT - 1 - tl) : tl;
                *(u32x2*)(ydir + ((size_t)b * SEQ + t) * D + 512 + 128 * h + 16 * w + 4 * fg) = ypend[tb]; } } };
    issue_loads(0);
    for (int ch = 0; ch < 72; ++ch) {
        bool isctx; int sbase, T; size_t rowbase; chunk_geom(ch, isctx, sbase, T, rowbase);
        __syncthreads();
        float qv[8], kv[8], vv[8], nqv[8], nkv[8];
#pragma unroll
        for (int j = 0; j < 8; ++j) { qv[j] = bfsel(rq[j], codd); kv[j] = bfsel(rk[j], codd); vv[j] = bfsel(rv[j], codd); nqv[j] = nq[j]; nkv[j] = nk[j]; }
        if (w == 7) {
            const float gi = (lane < 32) ? -Aexp * softplusf_(bfsel(raw_al, godd) + dtb) : 0.f;
            float cum = gi;
            cum += __builtin_bit_cast(float, __builtin_amdgcn_update_dpp(0, __builtin_bit_cast(int, cum), 0x111, 0xf, 0xf, true));
            cum += __builtin_bit_cast(float, __builtin_amdgcn_update_dpp(0, __builtin_bit_cast(int, cum), 0x112, 0xf, 0xf, true));
            cum += __builtin_bit_cast(float, __builtin_amdgcn_update_dpp(0, __builtin_bit_cast(int, cum), 0x114, 0xf, 0xf, true));
            cum += __builtin_bit_cast(float, __builtin_amdgcn_update_dpp(0, __builtin_bit_cast(int, cum), 0x118, 0xf, 0xf, true));
            const float r0 = rdlane(cum, 15);
            cum += (lane >= 16) ? r0 : 0.f;
            if (lane < 32) { SC[lane] = sigmoidf_(bfsel(raw_be, godd)); SC[32 + lane + 1] = cum; if (lane == 0) SC[32] = 0.f; }
        }
        asm volatile("" :: "v"(qv[0]), "v"(qv[1]), "v"(qv[2]), "v"(qv[3]), "v"(qv[4]), "v"(qv[5]), "v"(qv[6]), "v"(qv[7]), "v"(kv[0]), "v"(kv[1]), "v"(kv[2]), "v"(kv[3]), "v"(kv[4]), "v"(kv[5]), "v"(kv[6]), "v"(kv[7]),
                        "v"(vv[0]), "v"(vv[1]), "v"(vv[2]), "v"(vv[3]), "v"(vv[4]), "v"(vv[5]), "v"(vv[6]), "v"(vv[7]) : "memory");
        asm volatile("" :: "v"(nqv[0]), "v"(nqv[1]), "v"(nqv[2]), "v"(nqv[3]), "v"(nqv[4]), "v"(nqv[5]), "v"(nqv[6]), "v"(nqv[7]), "v"(nkv[0]), "v"(nkv[1]), "v"(nkv[2]), "v"(nkv[3]), "v"(nkv[4]), "v"(nkv[5]), "v"(nkv[6]), "v"(nkv[7]),
                        "v"(raw_al), "v"(raw_be) : "memory");
        if (ch > 0) flush(ch - 1);
        if (ch + 1 < 72) issue_loads(ch + 1);
        __syncthreads();
        {
            const int c = idx; const float gcC = SC[32 + 32];
#pragma unroll
            for (int jj = 0; jj < 4; ++jj) { const int i0 = 2 * grp + 8 * jj;
                float bh[2], kh[2];
#pragma unroll
                for (int e = 0; e < 2; ++e) { const int j = 2 * jj + e, i = i0 + e;
                    const float kn = kv[j] * nkv[j], qn = qv[j] * nqv[j];
                    const float gm = SC[32 + i], gi = SC[32 + i + 1], be = SC[i];
                    const unsigned p0 = cvtpk(kn, qn), p1 = cvtpk(kn * __expf(gm), qn * __expf(gi));
                    *(LAS unsigned short*)(L + O_KT + i * S128 + c * 2) = (unsigned short)p0; *(LAS unsigned short*)(L + O_QT + i * S128 + c * 2) = (unsigned short)(p0 >> 16);
                    *(LAS unsigned short*)(L + O_KKT + i * S128 + c * 2) = (unsigned short)p1; *(LAS unsigned short*)(L + O_RT + i * S128 + c * 2) = (unsigned short)(p1 >> 16);
                    bh[e] = be * kn * __expf(gcC - gm); kh[e] = be * kn * __expf(gcC - gi); }
                *(LAS unsigned*)(L + O_BHT + c * S32 + i0 * 2) = cvtpk(bh[0], bh[1]); *(LAS unsigned*)(L + O_KHT + c * S32 + i0 * 2) = cvtpk(kh[0], kh[1]);
                *(LAS unsigned*)(L + O_VT + c * S32 + i0 * 2) = cvtpk(vv[2 * jj], vv[2 * jj + 1]); }
        }
        __syncthreads();
        {
            const int isq = w >> 2, tb = (w >> 1) & 1, jb = w & 1;
            if (jb <= tb) {
                const f32x4 g4 = mm_tile<4>(L + O_KT + jb * 16 * S128, S128, L + (isq ? O_QT : O_KT) + tb * 16 * S128, S128, z4, lane);
                const int t = tb * 16 + fr;
                const float gt = SC[32 + t + isq];
                f32x4 m0, m1;
#pragma unroll
                for (int e = 0; e < 4; ++e) { const int j = jb * 16 + 4 * fg + e; const bool keep = isq ? (j <= t) : (j < t);
                    const float bj = SC[j] * g4[e];
                    m0[e] = keep ? bj * __expf(gt - SC[32 + j]) : 0.f;
                    m1[e] = keep ? bj * __expf(gt - SC[32 + j + 1]) : 0.f; }
                const int off = t * S32 + (jb * 16 + 4 * fg) * 2;
                if (isq) { st_bf16x4(L + O_NB + off, m0); st_bf16x4(L + O_NK + off, m1); }
                else {
                    st_bf16x4(L + O_MK + off, m1);
                    if (tb != jb) st_bf16x4(L + O_M21 + fr * S32 + fg * 8, m0);
                    else { float X[16]; tri_inv16(m0, lane, L + O_MS + tb * 1024, X);
                        if (lane < 16) {
#pragma unroll
                            for (int i = 0; i < 16; ++i) *(LAS unsigned short*)(L + O_TI + (tb * 16 + i) * S32 + (tb * 16 + lane) * 2) = (unsigned short)cvtpk(X[i], 0.f);
                            if (tb == 0) { u32x4 a0, a1;
                                a0.x = cvtpk(X[0], X[1]); a0.y = cvtpk(X[2], X[3]); a0.z = cvtpk(X[4], X[5]); a0.w = cvtpk(X[6], X[7]);
                                a1.x = cvtpk(X[8], X[9]); a1.y = cvtpk(X[10], X[11]); a1.z = cvtpk(X[12], X[13]); a1.w = cvtpk(X[14], X[15]);
                                *(LAS u32x4*)(L + O_T11T + lane * S32) = a0; *(LAS u32x4*)(L + O_T11T + lane * S32 + 16) = a1; }
                            else {
#pragma unroll
                                for (int i = 0; i < 16; ++i) *(LAS unsigned short*)(L + O_T22 + i * S32 + lane * 2) = (unsigned short)cvtpk(X[i], 0.f); }
                        } }
                }
            }
        }
        __syncthreads();
        if (w == 1) {
            const f32x4 x4 = mm_tile<1>(L + O_M21, S32, L + O_T11T, S32, z4, lane);
            st_bf16x4(L + O_XT + fr * S32 + fg * 8, x4);
            asm volatile("s_waitcnt lgkmcnt(0)" ::: "memory");
            const f32x4 t4 = mm_tile<1>(L + O_XT, S32, L + O_T22, S32, z4, lane);
            st_bf16x4(L + O_TI + (16 + fr) * S32 + fg * 8, -t4);
        }
        f32x4 yacc[2];
#pragma unroll
        for (int tb = 0; tb < 2; ++tb) {
            f32x4 u4 = mm_tile<4>(L + O_KKT + tb * 16 * S128, S128, L + O_SBF + 16 * w * S128, S128, z4, lane);
            u4 = mm_tile<1>(L + O_MK + tb * 16 * S32, S32, L + O_VT + 16 * w * S32, S32, u4, lane);
            st_bf16x4(L + O_UTT + (16 * w + fr) * S32 + tb * 32 + fg * 8, u4);
            yacc[tb] = mm_tile<4>(L + O_SBF + 16 * w * S128, S128, L + O_RT + tb * 16 * S128, S128, z4, lane);
            yacc[tb] = mm_tile<1>(L + O_VT + 16 * w * S32, S32, L + O_NK + tb * 16 * S32, S32, yacc[tb], lane);
        }
        __syncthreads();
#pragma unroll
        for (int tb = 0; tb < 2; ++tb) {
            const f32x4 u4 = mm_tile<1>(L + O_TI + tb * 16 * S32, S32, L + O_UTT + 16 * w * S32, S32, z4, lane);
            st_bf16x4(L + O_UT + (16 * w + fr) * S32 + tb * 32 + fg * 8, -u4);
        }
        __syncthreads();
        {
#pragma unroll
            for (int tb = 0; tb < 2; ++tb) {
                yacc[tb] = mm_tile<1>(L + O_UT + 16 * w * S32, S32, L + O_NB + tb * 16 * S32, S32, yacc[tb], lane);
                ypend[tb].x = cvtpk(yacc[tb][0], yacc[tb][1]); ypend[tb].y = cvtpk(yacc[tb][2], yacc[tb][3]);
            }
            const float wc = __expf(SC[32 + 32]);
#pragma unroll
            for (int vi = 0; vi < 8; ++vi) {
                f32x4 s4 = Sacc[vi] * wc;
                s4 = mm_tile<1>(L + O_KHT + 16 * w * S32, S32, L + O_VT + 16 * vi * S32, S32, s4, lane);
                s4 = mm_tile<1>(L + O_BHT + 16 * w * S32, S32, L + O_UT + 16 * vi * S32, S32, s4, lane);
                Sacc[vi] = s4;
                st_bf16x4(L + O_SBF + (16 * vi + fr) * S128 + (16 * w + 4 * fg) * 2, s4);
            }
        }
    }
    flush(71);
    __syncthreads();
}

__device__ __forceinline__ void unpack8(const u32x4 w, float (&f)[8]) { f[0] = bflo(w.x); f[1] = bfhi(w.x); f[2] = bflo(w.y); f[3] = bfhi(w.y); f[4] = bflo(w.z); f[5] = bfhi(w.z); f[6] = bflo(w.w); f[7] = bfhi(w.w); }
__device__ __forceinline__ void phase_p4(const Args& A, Ctx& C) {
    const bf16_t* P = WSP(bf16_t, WS_P);
    const bf16_t* yf = WSP(bf16_t, WS_YDIR); const bf16_t* yb = yf + (size_t)NLAT * D;
    const float* bon = WSP(float, WS_BON);
    bf16_t* ymix = WSP(bf16_t, WS_YMIX);
    lbyte* SGb = C.lds;
    lfloat* GO = (lfloat*)(C.lds + 8192);
    const int tid = C.tid, lane = C.lane, w = C.wave;
    const bf16_t* gupt = WSP(const bf16_t, WS_GUPT);
    const int fr = lane & 15, fg = lane >> 4;
    const int c8 = 8 * lane;
    float lnw[8], lnb[8], ong[8], muv[8];
#pragma unroll
    for (int e = 0; e < 8; ++e) { lnw[e] = A.in[I_LNW][c8 + e]; lnb[e] = A.in[I_LNB][c8 + e]; ong[e] = A.in[I_ONG][(c8 + e) & 127]; muv[e] = A.in[I_MU][1024 + c8 + e]; }
    const int tkA = tid >> 5, lA = 4 * (tid & 31);
    float muA[4];
#pragma unroll
    for (int e = 0; e < 4; ++e) muA[e] = A.in[I_MU][1792 + lA + e];
    const bool vup = (1024 + c8) < 1440;
    for (int tile = C.bid; tile < NLAT / 16; tile += C.G) {
        const int row0 = tile * 16;
        __syncthreads();
        {
            const int row = row0 + tkA, t = row & (SEQ - 1); const bool ok = t < SEQ - 64;
            const u32x2 pw = *(const u32x2*)(P + (size_t)row * PLD + 1792 + lA); const u32x2 sw = *(const u32x2*)(P + (size_t)(row + (ok ? 64 : 0)) * PLD + 1792 + lA);
            const float pv[4] = {bflo(pw.x), bfhi(pw.x), bflo(pw.y), bfhi(pw.y)}; const float sv[4] = {bflo(sw.x), bfhi(sw.x), bflo(sw.y), bfhi(sw.y)};
            float o[4];
#pragma unroll
            for (int e = 0; e < 4; ++e) o[e] = sigmoidf_(pv[e] + muA[e] * ((ok ? sv[e] : 0.f) - pv[e]));
            u32x2 ow; ow.x = cvtpk(o[0], o[1]); ow.y = cvtpk(o[2], o[3]); *(LAS u32x2*)(SGb + tkA * 288 + lA * 2) = ow;
        }
        __syncthreads();
#pragma unroll
        for (int i = 0; i < 4; ++i) { const int c0 = 64 * w + 16 * i; f32x4 acc = (f32x4){0.f, 0.f, 0.f, 0.f};
#pragma unroll
            for (int ks = 0; ks < 4; ++ks) { const bf16x8 a = *(const LAS bf16x8*)(SGb + fr * 288 + ks * 64 + fg * 16);
                const bf16x8 bq = *(const bf16x8*)(gupt + (size_t)(c0 + fr) * 128 + ks * 32 + fg * 8);
                acc = __builtin_amdgcn_mfma_f32_16x16x32_bf16(a, bq, acc, 0, 0, 0); }
#pragma unroll
            for (int e = 0; e < 4; ++e) GO[(4 * fg + e) * 512 + c0 + fr] = acc[e]; }
        __syncthreads();
#pragma unroll
        for (int tt = 0; tt < 2; ++tt) {
            const int tk = 2 * w + tt, row = row0 + tk, t = row & (SEQ - 1);
            const bool okv = vup ? (t >= 64) : (t < SEQ - 64);
            const u32x4 wyf = *(const u32x4*)(yf + (size_t)row * D + c8), wyb = *(const u32x4*)(yb + (size_t)row * D + c8);
            const u32x4 wpv = *(const u32x4*)(P + (size_t)row * PLD + 1024 + c8), wsv = *(const u32x4*)(P + (size_t)(row + (okv ? (vup ? -64 : 64) : 0)) * PLD + 1024 + c8);
            const u32x4 wof = *(const u32x4*)(yf + (size_t)row * D + 512 + c8), wob = *(const u32x4*)(yb + (size_t)row * D + 512 + c8);
            const u32x4 wz = *(const u32x4*)(P + (size_t)row * PLD + RW_COLS + 1536 + c8);
            const float bs = bon[(size_t)row * 8 + (lane >> 3)] + bon[((size_t)NLAT + row) * 8 + (lane >> 3)];
            const f32x4 g0 = *(const LAS f32x4*)(GO + tk * 512 + c8), g1 = *(const LAS f32x4*)(GO + tk * 512 + c8 + 4);
            const float gg[8] = {g0.x, g0.y, g0.z, g0.w, g1.x, g1.y, g1.z, g1.w};
            float a[8], bq[8], pv[8], sv[8], y[8];
            unpack8(wyf, a); unpack8(wyb, bq); unpack8(wpv, pv); unpack8(wsv, sv);
            float s1 = 0.f;
#pragma unroll
            for (int e = 0; e < 8; ++e) { y[e] = a[e] + bq[e]; s1 += y[e]; }
            s1 += __shfl_xor(s1, 1); s1 += __shfl_xor(s1, 2); s1 += __shfl_xor(s1, 4);
            const float m = s1 * (1.f / 64.f);
            float s2 = 0.f;
#pragma unroll
            for (int e = 0; e < 8; ++e) { y[e] -= m; s2 += y[e] * y[e]; }
            s2 += __shfl_xor(s2, 1); s2 += __shfl_xor(s2, 2); s2 += __shfl_xor(s2, 4);
            const float rs = __builtin_amdgcn_rsqf(s2 * (1.f / 64.f) + RWKV_EPS);
            float o[8];
#pragma unroll
            for (int e = 0; e < 8; ++e) { const float vv = pv[e] + muv[e] * ((okv ? sv[e] : 0.f) - pv[e]); o[e] = (y[e] * rs * lnw[e] + lnb[e] + bs * vv) * gg[e]; }
            u32x4 ow; ow.x = cvtpk(o[0], o[1]); ow.y = cvtpk(o[2], o[3]); ow.z = cvtpk(o[4], o[5]); ow.w = cvtpk(o[6], o[7]);
            *(u32x4*)(ymix + (size_t)row * D + c8) = ow;
            float of[8], ob[8], z[8];
            unpack8(wof, of); unpack8(wob, ob); unpack8(wz, z);
            float s3 = 0.f;
#pragma unroll
            for (int e = 0; e < 8; ++e) { of[e] += ob[e]; s3 += of[e] * of[e]; }
            s3 += __shfl_xor(s3, 1); s3 += __shfl_xor(s3, 2); s3 += __shfl_xor(s3, 4); s3 += __shfl_xor(s3, 8);
            const float rg = __builtin_amdgcn_rsqf(s3 * (1.f / 128.f) + NORM_EPS);
#pragma unroll
            for (int e = 0; e < 8; ++e) o[e] = of[e] * rg * ong[e] * siluf_(z[e]);
            ow.x = cvtpk(o[0], o[1]); ow.y = cvtpk(o[2], o[3]); ow.z = cvtpk(o[4], o[5]); ow.w = cvtpk(o[6], o[7]);
            *(u32x4*)(ymix + (size_t)row * D + 512 + c8) = ow;
        }
    }
}

__device__ __forceinline__ void convert_experts(const Args& A, Ctx& C) {
    lfloat* scr = (lfloat*)(C.lds + C.wave * 16384);
    const int gw = C.bid * 8 + C.wave, NGW = C.G * 8;
    constexpr int I13 = (D / 64) * (DE / 32);
    constexpr int I2 = (DE / 64) * (D / 32);
    constexpr int PER = 2 * I13 + I2;
    for (int it = gw; it < 257 * PER; it += NGW) {
        const int e = it / PER; int r = it % PER;
        unsigned char* bt13 = A.ws + WS_WEXP + (size_t)e * WEXP_STRIDE; unsigned char* bt2 = bt13 + 512 * 1024;
        const float* w1 = e < NE ? A.in[I_EW1] + (size_t)e * D * DE : A.in[I_SW1];
        const float* w3 = e < NE ? A.in[I_EW3] + (size_t)e * D * DE : A.in[I_SW3];
        const float* w2 = e < NE ? A.in[I_EW2] + (size_t)e * DE * D : A.in[I_SW2];
        if (r < I13) { transpose_item_fp8(w1, D, DE, bt13, RowGLU{0}, SW13, scr, r, C.lane); continue; } r -= I13;
        if (r < I13) { transpose_item_fp8(w3, D, DE, bt13, RowGLU{128}, SW13, scr, r, C.lane); continue; } r -= I13;
        transpose_item_fp8(w2, DE, D, bt2, RowId(), SW2, scr, r, C.lane);
    }
}

__device__ __forceinline__ void phase_p6(const Args& A, Ctx& C) {
    const float* mod = WSP(float, WS_MOD); bf16_t* h2n = WSP(bf16_t, WS_H2N);
    const int gw = C.bid * 8 + C.wave, NGW = C.G * 8;
    for (int row = gw; row < NLAT; row += NGW) {
        const float* m = mod + (size_t)(row >> 11) * MODW;
        norm_mod_row(A.out + (size_t)row * D, A.in[I_N2G], m + 4 * D, m + 3 * D, h2n + (size_t)row * D, C.lane, (unsigned*)(A.ws + WS_H2N8) + (size_t)row * (D / 4));
    }
}

__device__ __forceinline__ void phase_p8(const Args& A, Ctx& C) {
    const float* logit = WSP(float, WS_LOGIT);
    int* tope = WSP(int, WS_TOPE); float* topw = WSP(float, WS_TOPW); int* pos = WSP(int, WS_POS);
    unsigned* cnt = WSP(unsigned, WS_CTL) + CW_CNT;
    const int gw = C.bid * 8 + C.wave, NGW = C.G * 8, lane = C.lane;
    const f32x4 rb = ((const f32x4*)A.in[I_RB])[lane];
    for (int tok = gw; tok < NLAT; tok += NGW) {
        const f32x4 lg = ((const f32x4*)(logit + (size_t)tok * NE))[lane];
        float s[4], sel[4];
#pragma unroll
        for (int i = 0; i < 4; ++i) { s[i] = sigmoidf_(lg[i]); sel[i] = s[i] + rb[i]; }
        float m1 = fmaxf(fmaxf(sel[0], sel[1]), fmaxf(sel[2], sel[3]));
        float m2;
        {
            float a = fmaxf(sel[0], sel[1]), bq = fminf(sel[0], sel[1]), cq = fmaxf(sel[2], sel[3]), dq = fminf(sel[2], sel[3]);
            m2 = fmaxf(fminf(a, cq), fmaxf(bq, dq)); }
#pragma unroll
        for (int o = 1; o < 8; o <<= 1) { const float o1 = __shfl_xor(m1, o), o2 = __shfl_xor(m2, o);
            const float n1 = fmaxf(m1, o1); const float n2 = fmaxf(fminf(m1, o1), fmaxf(m2, o2)); m1 = n1; m2 = n2; }
        const float gs = m1 + m2;
        const int grp = lane >> 3;
        int rank = 0;
#pragma unroll
        for (int gq = 0; gq < 8; ++gq) { const float og = __shfl(gs, gq * 8); rank += (og > gs || (og == gs && gq < grp)) ? 1 : 0; }
        const bool gsel = rank < 4;
        float cand[4];
#pragma unroll
        for (int i = 0; i < 4; ++i) cand[i] = gsel ? sel[i] : -INFINITY;
        int my_e = 0; float my_w = 0.f; float wsum = 0.f;
#pragma unroll
        for (int r = 0; r < 8; ++r) {
            float bv = cand[0]; int bi = 0;
#pragma unroll
            for (int i = 1; i < 4; ++i) if (cand[i] > bv) { bv = cand[i]; bi = i; }
            int be = lane * 4 + bi;
#define P8_STEP(CTRL) { const float ov = dpp_f<CTRL>(bv); const int oe = __builtin_amdgcn_update_dpp(0, be, CTRL, 0xf, 0xf, false); if (ov > bv || (ov == bv && oe < be)) { bv = ov; be = oe; } }
            P8_STEP(0x128) P8_STEP(0x124) P8_STEP(0x122) P8_STEP(0x121)
#undef P8_STEP
            float gv = rdlane(bv, 0); int ge = __builtin_amdgcn_readlane(be, 0);
#pragma unroll
            for (int rr = 1; rr < 4; ++rr) { const float ov = rdlane(bv, 16 * rr); const int oe = __builtin_amdgcn_readlane(be, 16 * rr); if (ov > gv || (ov == gv && oe < ge)) { gv = ov; ge = oe; } }
            be = ge;
            const int ol = be >> 2, oi = be & 3;
            const float mys = oi == 0 ? s[0] : (oi == 1 ? s[1] : (oi == 2 ? s[2] : s[3]));
            const float ws_ = __shfl(mys, ol);
            if (lane == ol) { if (oi == 0) cand[0] = -INFINITY; else if (oi == 1) cand[1] = -INFINITY; else if (oi == 2) cand[2] = -INFINITY; else cand[3] = -INFINITY; }
            wsum += ws_;
            if (lane == r) { my_e = be; my_w = ws_; }
        }
        if (lane < 8) {
            const float w = my_w / wsum * 2.5f;
            const unsigned p = atomicAdd(cnt + my_e, 1u);
            tope[(size_t)tok * 8 + lane] = my_e; topw[(size_t)tok * 8 + lane] = w; pos[(size_t)tok * 8 + lane] = (int)p;
        }
    }
}

__device__ __forceinline__ void tile_prefix(const Args& A, Ctx& C, LAS int* tb) {
    const unsigned* cnt = WSP(unsigned, WS_CTL) + CW_CNT;
    if (C.tid == 0) { int acc = 0; for (int e = 0; e < NE; ++e) { tb[e] = acc; acc += ((int)cnt[e] + 255) >> 8; } tb[NE] = acc; }
    __syncthreads();
}
__device__ __forceinline__ void phase_p9(const Args& A, Ctx& C) {
    LAS int* tb = (LAS int*)C.lds;
    tile_prefix(A, C, tb);
    const unsigned* cnt = WSP(unsigned, WS_CTL) + CW_CNT;
    const int* tope = WSP(int, WS_TOPE); const float* topw = WSP(float, WS_TOPW); const int* pos = WSP(int, WS_POS);
    int* rowl = WSP(int, WS_ROWL); float* roww = WSP(float, WS_ROWW); int* tile_e = WSP(int, WS_TILEE);
    const int nrt = tb[NE];
    for (int i = C.bid * 512 + C.tid; i < NLAT * 8; i += C.G * 512) { const int e = tope[i]; const int pr = tb[e] * 256 + pos[i]; rowl[pr] = i; roww[pr] = topw[i]; }
    for (int e = C.bid; e < NE; e += C.G) { const int n = (int)cnt[e], nt = tb[e + 1] - tb[e];
        for (int j = n + C.tid; j < nt * 256; j += 512) { rowl[tb[e] * 256 + j] = -1; roww[tb[e] * 256 + j] = 0.f; }
        for (int k = C.tid; k < nt; k += 512) tile_e[tb[e] + k] = e; }
    for (int i = C.bid * 512 + C.tid; i < NLAT; i += C.G * 512) { rowl[nrt * 256 + i] = i; roww[nrt * 256 + i] = 1.f; }
    for (int k = C.bid * 512 + C.tid; k < NLAT / 256; k += C.G * 512) tile_e[nrt + k] = NE;
    __syncthreads();
}

__device__ __forceinline__ void phase_moe(const Args& A, Ctx& C, int dry_shared) {
    LAS int* tb = (LAS int*)(C.lds + 131072);
    LAS int* tbl = tb + 320;
    tile_prefix(A, C, tb);
    pg8::MoeCtx M;
    M.nrt = tb[NE]; M.ntiles = M.nrt + NLAT / 256; M.G = C.G; M.vc = (C.G % 8 == 0) ? (C.bid % 8) * (C.G / 8) + C.bid / 8 : C.bid;
    M.tb = tb; M.tbl = tbl; M.cnt = WSP(unsigned, WS_CTL) + CW_CNT; M.rowl = WSP(int, WS_ROWL); M.roww = WSP(float, WS_ROWW);
    M.wexp = (const char*)(A.ws + WS_WEXP); M.h2n = (const char*)(A.ws + WS_H2N8); M.Hs = (char*)(A.ws + WS_HS) + (size_t)C.bid * 2 * 65536;
    M.Y = (unsigned char*)(A.ws + WS_Y); M.out = A.out; M.mod = WSP(const float, WS_MOD); M.dry_shared = dry_shared;
    pg8::gemm_moe(C.lds, M);
    __syncthreads();
}

__device__ __forceinline__ void phase_final(const Args& A, Ctx& C, float* dst) {
    const int gw = C.bid * 8 + C.wave, NGW = C.G * 8;
    const float* fg = A.in[I_FG]; const float* mod = WSP(const float, WS_MOD);
    const unsigned* Y = (const unsigned*)(A.ws + WS_Y);
    for (int row = gw; row < NLAT; row += NGW) {
        f32x4* xr = (f32x4*)(A.out + (size_t)row * D) + C.lane;
        const f32x4* gt = (const f32x4*)(mod + (size_t)(row >> 11) * MODW + 5 * D) + C.lane;
        const unsigned* yr = Y + (size_t)row * 8 * (D / 4) + C.lane;
        f32x4 v[4]; float s = 0.f;
#pragma unroll
        for (int j = 0; j < 4; ++j) {
            f32x4 a = (f32x4){0.f, 0.f, 0.f, 0.f};
#pragma unroll
            for (int sl = 0; sl < 8; ++sl) { const unsigned w = yr[sl * (D / 4) + 64 * j];
                const f32x2 lo = __builtin_amdgcn_cvt_pk_f32_fp8(w, false), hi = __builtin_amdgcn_cvt_pk_f32_fp8(w, true);
                a.x += lo.x; a.y += lo.y; a.z += hi.x; a.w += hi.y; }
            v[j] = xr[64 * j] + gt[64 * j] * a * (1.f / pg8::YSCALE);
            s += (v[j].x * v[j].x + v[j].y * v[j].y) + (v[j].z * v[j].z + v[j].w * v[j].w); }
        const float rstd = __builtin_amdgcn_rsqf(wave_sum(s) * (1.f / D) + NORM_EPS);
        f32x4* orow = (f32x4*)(dst + (size_t)row * D) + C.lane;
#pragma unroll
        for (int j = 0; j < 4; ++j) orow[64 * j] = v[j] * rstd * ((const f32x4*)fg)[C.lane + 64 * j];
    }
}

constexpr int NPHASE = 13;
__global__ void __launch_bounds__(512, 2) fwd_kernel(Args A) {
    extern __shared__ __attribute__((aligned(16))) unsigned char lds_raw[];
    Ctx C; C.lds = (lbyte*)lds_raw; C.tid = threadIdx.x; C.lane = C.tid & 63; C.wave = __builtin_amdgcn_readfirstlane(C.tid >> 6);
    C.G = gridDim.x; C.bid = blockIdx.x; C.a = &A;
    volatile LAS unsigned* misc = (volatile LAS unsigned*)(C.lds + LDS_MISC);
    if (C.tid < 16) misc[C.tid] = 0u;
    __syncthreads();
    XcdBarrier bar; bar.bar = WSP(unsigned, WS_CTL) + CW_BAR; bar.x = 0; bar.st = nullptr;
    const int lo = A.ph_lo, hi = A.ph_hi;
    const bool multi = (hi - lo) > 1;
    if (multi) bar = xcd_barrier_post(WSP(unsigned, WS_CTL) + CW_BAR, misc);
#ifndef PHASE_MASK
#define PHASE_MASK 0x1FFF
#endif
#define IN(k) (((PHASE_MASK >> (k)) & 1) && lo <= (k) && (k) < hi)
#define SEAM(k) do { if (IN(k) && IN((k) + 1)) xcd_barrier(bar); } while (0)
#ifndef REP_MASK
#define REP_MASK 0
#endif
#define REPS(k) (((REP_MASK >> (k)) & 1) ? 2 : 1)

    if (IN(0)) _Pragma("unroll") for (int rep = 0; rep < REPS(0); ++rep) { phase_p0(A, C); __syncthreads(); } SEAM(0);
    if (IN(1)) _Pragma("unroll") for (int rep = 0; rep < REPS(1); ++rep) { phase_p1(A, C); } SEAM(1);
    if (IN(2)) _Pragma("unroll") for (int rep = 0; rep < REPS(2); ++rep) {
        pg8::Gemm g{WSP(bf16_t, WS_XN), D}; pg8::StaticOrder S; S.init(NROWS, PLD, C.G, C.bid, WSP(bf16_t, WS_BTIN), D, 1);
        pg8::EpiBf16 E{WSP(bf16_t, WS_P), PLD, 1.f / SWIN};
        pg8::gemm_phase<pg8::EpiBf16, pg8::StaticOrder, false, 0, false, true>(C.lds, g, S, E);
    } SEAM(2);
    if (IN(3)) _Pragma("unroll") for (int rep = 0; rep < REPS(3); ++rep) { phase_gdn_prep(A, C); } SEAM(3);
#ifdef PROBE_BARRIERS
    if (multi) for (int kq = 0; kq < PROBE_BARRIERS; ++kq) xcd_barrier(bar);
#endif
    if (IN(4)) {
        for (int ch = C.bid; ch < NB * HB * 2; ch += C.G) gdn_chain_chunked(A, C, ch);
        for (int pr = C.bid; pr < NB * HA; pr += C.G) rwkv_pair_chunked(A, C, pr);
    } SEAM(4);
    if (IN(5)) _Pragma("unroll") for (int rep = 0; rep < REPS(5); ++rep) { phase_p4(A, C); } SEAM(5);
    if (IN(6)) _Pragma("unroll") for (int rep = 0; rep < REPS(6); ++rep) {
        pg8::Gemm g{WSP(bf16_t, WS_YMIX), D}; pg8::StaticOrder S; S.init(NLAT, D, C.G, C.bid, WSP(bf16_t, WS_BTOUT), D);
        pg8::EpiResGate E{A.in[I_X], A.out, WSP(float, WS_MOD), 2 * D};
        pg8::gemm_phase<pg8::EpiResGate, pg8::StaticOrder, false>(C.lds, g, S, E);
    } SEAM(6);
    if (IN(7)) _Pragma("unroll") for (int rep = 0; rep < REPS(7); ++rep) { phase_p6(A, C); __syncthreads(); convert_experts(A, C); __syncthreads(); } SEAM(7);
    if (IN(8)) _Pragma("unroll") for (int rep = 0; rep < REPS(8); ++rep) {
        pg8::Gemm g{WSP(bf16_t, WS_H2N), D}; pg8::StaticOrder S; S.init(NLAT, NE, C.G, C.bid, WSP(bf16_t, WS_BTR), D);
        pg8::EpiF32 E{WSP(float, WS_LOGIT), NE};
        pg8::gemm_phase<pg8::EpiF32, pg8::StaticOrder, false>(C.lds, g, S, E);
    } SEAM(8);
    if (IN(9)) { phase_p8(A, C); } SEAM(9);
    if (IN(10)) _Pragma("unroll") for (int rep = 0; rep < REPS(10); ++rep) { phase_p9(A, C); } SEAM(10);
    if (IN(11)) { phase_moe(A, C, 0); if (REPS(11) > 1) { __syncthreads(); phase_moe(A, C, 1); } } SEAM(11);
    if (IN(12)) { if (REPS(12) > 1) { phase_final(A, C, (float*)(A.ws + WS_WEXP)); __syncthreads(); } phase_final(A, C, A.out); }
#undef IN
#undef SEAM
}

extern "C" void kernel_launch(void* const* d_in, const int* in_sizes, int n_in, void* d_out, int out_size, void* d_ws, size_t ws_size, hipStream_t stream) {
    static int grid = 0;
    if (grid == 0) {
        if (n_in != 34 || out_size != NLAT * D || ws_size < WS_END) { fprintf(stderr, "kernel_launch: unexpected shapes (n_in %d out %d ws %zu need %zu)\n", n_in, out_size, ws_size, (size_t)WS_END); grid = -1; return; }
        int dev = 0, cus = 0;
        if (hipGetDevice(&dev) != hipSuccess || hipDeviceGetAttribute(&cus, hipDeviceAttributeMultiprocessorCount, dev) != hipSuccess) { grid = -1; return; }
        if (hipFuncSetAttribute((const void*)fwd_kernel, hipFuncAttributeMaxDynamicSharedMemorySize, LDS_BYTES) != hipSuccess) { fprintf(stderr, "kernel_launch: hipFuncSetAttribute failed\n"); grid = -1; return; }
        int per_cu = 0;
        if (hipOccupancyMaxActiveBlocksPerMultiprocessor(&per_cu, (const void*)fwd_kernel, 512, LDS_BYTES) != hipSuccess || per_cu < 1) { fprintf(stderr, "kernel_launch: occupancy query says %d\n", per_cu); }
        (void)hipGetLastError();
        grid = cus;
    }
    if (grid < 0) return;
    (void)hipMemsetAsync((char*)d_ws + WS_CTL, 0, CTL_BYTES, stream);
    Args a{};
    for (int i = 0; i < 34; ++i) a.in[i] = (const float*)d_in[i];
    a.out = (float*)d_out; a.ws = (unsigned char*)d_ws;
#if MK_PER_PHASE
    for (int p = 0; p < NPHASE; ++p) { a.ph_lo = p; a.ph_hi = p + 1; hipLaunchKernelGGL(fwd_kernel, dim3(grid), dim3(512), LDS_BYTES, stream, a); }
#else
    a.ph_lo = 0; a.ph_hi = NPHASE; hipLaunchKernelGGL(fwd_kernel, dim3(grid), dim3(512), LDS_BYTES, stream, a);
#endif
}
```

```cpp
#include <hip/hip_runtime.h>
#include <cstdio>
#include <cstdint>

#ifndef MK_PER_PHASE
#define MK_PER_PHASE 0
#endif

#define LAS __attribute__((address_space(3)))
typedef unsigned short bf16_t;
typedef short bf16x8 __attribute__((ext_vector_type(8)));
typedef float f32x4 __attribute__((ext_vector_type(4)));
typedef float f32x2 __attribute__((ext_vector_type(2)));
typedef unsigned u32x4 __attribute__((ext_vector_type(4)));
typedef unsigned u32x2 __attribute__((ext_vector_type(2)));
typedef int i32x4 __attribute__((ext_vector_type(4)));
typedef int i32x8 __attribute__((ext_vector_type(8)));
typedef LAS float lfloat;
typedef LAS unsigned char lbyte;

constexpr int D = 1024, NB = 32, SEQ = 2048, CTX = 256, GW = 64;
constexpr int NLAT = NB * SEQ;
constexpr int NCTX = NB * CTX;
constexpr int NROWS = NLAT + NCTX;
constexpr int DA = 512, HA = 8, NA = 64;
constexpr int RW_COLS = 1920, GD_COLS = 2064, IN_COLS = 3984, PLD = 4096;
constexpr int DB = 512, HB = 4, KB = 128;
constexpr int NE = 256, TOPK = 8, DE = 256;
constexpr int MODW = 6 * D;
constexpr float NORM_EPS = 1e-6f, RWKV_EPS = 64e-5f;
constexpr int MAXTILES = (NLAT * TOPK + NE * 255) / 256 + 1;

constexpr size_t MiB = 1u << 20;
constexpr size_t WS_CTL = 0, CTL_BYTES = 1 * MiB;
constexpr size_t WS_MOD = 1 * MiB;
constexpr size_t WS_BTIN = 2 * MiB, WS_BTOUT = 10 * MiB, WS_BTR = 12 * MiB, WS_BON = 13 * MiB, WS_GUPT = 17 * MiB, WS_NRM = 978 * MiB;
constexpr size_t WS_P = 18 * MiB, WS_XN = 594 * MiB, WS_YDIR = 594 * MiB, WS_YMIX = 850 * MiB;
constexpr size_t WS_H2N8 = 900 * MiB;
constexpr size_t WS_H2N = 18 * MiB, WS_LOGIT = 146 * MiB, WS_TOPE = 210 * MiB, WS_TOPW = 212 * MiB, WS_POS = 214 * MiB, WS_Y = 146 * MiB;
constexpr size_t WS_ROWL = 658 * MiB, WS_ROWW = 661 * MiB, WS_TILEE = 664 * MiB, WS_HS = 672 * MiB, WS_WEXP = 704 * MiB;
constexpr size_t WEXP_STRIDE = (size_t)(512 * 1024 + 1024 * 256);
constexpr float SW13 = 64.f, SW2 = 32.f, SHS = 8.f, SWIN = 32.f;
constexpr size_t WS_END = 1090 * MiB;
static_assert(WS_WEXP + 257 * WEXP_STRIDE <= WS_END && WS_Y + (size_t)NLAT * 8 * D <= WS_ROWL, "ws map");
constexpr int CW_BAR = 4096;
constexpr int CW_CNT = 16384;

constexpr int LDS_BYTES = 159744;
constexpr int LDS_MISC = LDS_BYTES - 64;

__device__ __forceinline__ unsigned f2bf(float f) { unsigned u = __builtin_bit_cast(unsigned, f); return (u + 0x7fffu + ((u >> 16) & 1u)) >> 16; }
typedef __bf16 bf16x2_t __attribute__((ext_vector_type(2)));
__device__ __forceinline__ unsigned cvtpk(float lo, float hi) { f32x2 v = {lo, hi}; return __builtin_bit_cast(unsigned, __builtin_convertvector(v, bf16x2_t)); }
__device__ __forceinline__ unsigned pk2(float lo, float hi) { return cvtpk(lo, hi); }
__device__ __forceinline__ unsigned pk4_fp8(float a, float b, float c, float d) { unsigned w = 0u;
    w = __builtin_amdgcn_cvt_pk_fp8_f32(__builtin_amdgcn_fmed3f(a, -448.f, 448.f), __builtin_amdgcn_fmed3f(b, -448.f, 448.f), w, false);
    w = __builtin_amdgcn_cvt_pk_fp8_f32(__builtin_amdgcn_fmed3f(c, -448.f, 448.f), __builtin_amdgcn_fmed3f(d, -448.f, 448.f), w, true); return w; }
__device__ __forceinline__ float bf2f(unsigned short b) { return __builtin_bit_cast(float, ((unsigned)b) << 16); }
__device__ __forceinline__ float bflo(unsigned w) { return __builtin_bit_cast(float, w << 16); }
__device__ __forceinline__ float bfhi(unsigned w) { return __builtin_bit_cast(float, w & 0xffff0000u); }
template <int CTRL> __device__ __forceinline__ float dpp_f(float v) { return __builtin_bit_cast(float, __builtin_amdgcn_update_dpp(0, __builtin_bit_cast(int, v), CTRL, 0xf, 0xf, false)); }
__device__ __forceinline__ float wave_sum(float v) {
    v += dpp_f<0x128>(v);
    v += dpp_f<0x124>(v);
    v += dpp_f<0x122>(v);
    v += dpp_f<0x121>(v);
    const int vi = __builtin_bit_cast(int, v);
    const float r0 = __builtin_bit_cast(float, __builtin_amdgcn_readlane(vi, 0)), r1 = __builtin_bit_cast(float, __builtin_amdgcn_readlane(vi, 16)),
                r2 = __builtin_bit_cast(float, __builtin_amdgcn_readlane(vi, 32)), r3 = __builtin_bit_cast(float, __builtin_amdgcn_readlane(vi, 48));
    return (r0 + r1) + (r2 + r3);
}
__device__ __forceinline__ float sigmoidf_(float x) { return __builtin_amdgcn_rcpf(1.f + __expf(-x)); }
__device__ __forceinline__ float siluf_(float x) { return x * __builtin_amdgcn_rcpf(1.f + __expf(-x)); }
__device__ __forceinline__ float softplusf_(float x) { return fmaxf(x, 0.f) + __logf(1.f + __expf(-fabsf(x))); }
__device__ __forceinline__ float tanhf_(float x) { const float e = __expf(-2.f * fabsf(x)); const float t = (1.f - e) * __builtin_amdgcn_rcpf(1.f + e); return x < 0.f ? -t : t; }

#define XB_TMO      128
#define XB_XCNT(j)  (256  + 64 * (j))
#define XB_XSUB(j)  (1280 + 64 * (j))
#define XB_XGEN(j)  (2304 + 64 * (j))
#define XB_TOP      3328
#define XB_TOPGEN   3392
#define XCD_BAR_WORDS 3456
#define XB_SPIN_CAP (1u << 22)
__device__ __forceinline__ unsigned xb_ld(unsigned* p)              { return __hip_atomic_load(p, __ATOMIC_RELAXED, __HIP_MEMORY_SCOPE_AGENT); }
__device__ __forceinline__ unsigned xb_add(unsigned* p, unsigned v) { return __hip_atomic_fetch_add(p, v, __ATOMIC_RELAXED, __HIP_MEMORY_SCOPE_AGENT); }
__device__ __forceinline__ unsigned xb_xcc_id() { return (unsigned)__builtin_amdgcn_s_getreg((3 << 11) | 20) & 0xFu; }
#define XB_SPIN(cond, bar) do { unsigned _sp = 0; while (cond) { __builtin_amdgcn_s_sleep(1); \
    if ((++_sp & 255u) == 0u) { if (xb_ld(&(bar)[XB_TMO])) break; if (_sp > XB_SPIN_CAP) { atomicAdd(&(bar)[XB_TMO], 1u); break; } } } } while (0)
struct XcdBarrier { unsigned* bar; unsigned x; volatile LAS unsigned* st; };
__device__ __forceinline__ XcdBarrier xcd_barrier_post(unsigned* bar, volatile LAS unsigned* st) {
    XcdBarrier b; b.bar = bar; b.x = xb_xcc_id(); b.st = st;
    if (threadIdx.x == 0) (void)xb_add(&bar[XB_XCNT(b.x)], 1u);
    return b;
}
__device__ __forceinline__ void xcd_barrier_complete(unsigned* bar, unsigned x, unsigned& nloc, unsigned& nx) {
    const unsigned G = gridDim.x * gridDim.y * gridDim.z;
    unsigned sum, cnt, mine, sp = 0u;
    for (;;) {
        sum = 0u; cnt = 0u; mine = 0u;
#pragma unroll
        for (unsigned j = 0; j < 16; ++j) { const unsigned c = xb_ld(&bar[XB_XCNT(j)]); sum += c; cnt += (c > 0u) ? 1u : 0u; mine = (j == x) ? c : mine; }
        if (sum == G) break;
        __builtin_amdgcn_s_sleep(1);
        if ((++sp & 255u) == 0u) { if (xb_ld(&bar[XB_TMO])) break; if (sp > XB_SPIN_CAP) { atomicAdd(&bar[XB_TMO], 1u); break; } }
    }
    nloc = mine > 0u ? mine : 1u; nx = cnt > 0u ? cnt : 1u;
}
__device__ __forceinline__ void xcd_barrier(const XcdBarrier& b) {
    asm volatile("s_waitcnt vmcnt(0)" ::: "memory");
    __syncthreads();
    if (threadIdx.x == 0) {
        unsigned* bar = b.bar;
        __builtin_amdgcn_s_waitcnt(0);
        unsigned nloc = b.st[0], nx = b.st[1];
        if (nloc == 0u) { xcd_barrier_complete(bar, b.x, nloc, nx); b.st[0] = nloc; b.st[1] = nx; }
        const unsigned old = xb_add(&bar[XB_XSUB(b.x)], 1u);
        const unsigned gen = old / nloc;
        if (old + 1u == (gen + 1u) * nloc) {
            __builtin_amdgcn_fence(__ATOMIC_RELEASE, "agent");
            asm volatile("s_waitcnt vmcnt(0)" ::: "memory");
            const unsigned og = xb_add(&bar[XB_TOP], 1u);
            const unsigned tg = og / nx;
            if (og + 1u == (tg + 1u) * nx) xb_add(&bar[XB_TOPGEN], 1u);
            else XB_SPIN(xb_ld(&bar[XB_TOPGEN]) == tg, bar);
            __builtin_amdgcn_fence(__ATOMIC_ACQUIRE, "agent");
            xb_add(&bar[XB_XGEN(b.x)], 1u);
            asm volatile("s_waitcnt vmcnt(0)" ::: "memory");
        } else {
            XB_SPIN(xb_ld(&bar[XB_XGEN(b.x)]) == gen, bar);
            __builtin_amdgcn_fence(__ATOMIC_ACQUIRE, "agent");
            asm volatile("s_waitcnt vmcnt(0)" ::: "memory");
        }
    }
    __syncthreads();
}

struct Args {
    const float* in[34];
    float* out;
    unsigned char* ws;
    int ph_lo, ph_hi;
};
enum { I_X = 0, I_C, I_CTX, I_CCTX, I_WADA, I_BADA, I_N1G, I_WIN, I_MU, I_W0, I_WUP, I_A0, I_AUP, I_GUP, I_KK, I_KA, I_RK, I_LNW, I_LNB,
       I_CONVW, I_ALOG, I_DTB, I_ONG, I_WOUT, I_N2G, I_RW, I_RB, I_EW1, I_EW3, I_EW2, I_SW1, I_SW3, I_SW2, I_FG };

namespace pg8 {
constexpr int BM = 256, BK = 64, HALF = 128, HTB = HALF * BK * 2, STAGE_BYTES = 8 * HTB, NXCD = 8, WGM = 8;
__host__ __device__ __forceinline__ int lds_byte(int r, int c) { const int st = (r >> 4) * 2 + (c >> 5), rr = r & 15, cc = c & 31, ob = rr * 64 + cc * 2; return st * 1024 + (ob ^ (((ob >> 9) & 1) << 5)); }
__host__ __device__ __forceinline__ void stage_rc(int b, int& R, int& C) { const int st = b / 1024, sb = b % 1024, swz = sb ^ (((sb >> 9) & 1) << 5); R = (st >> 1) * 16 + swz / 64; C = (st & 1) * 32 + (swz % 64) / 2; }
__host__ __device__ __forceinline__ int perm32(int rho) { const int n = rho >> 4, i = rho & 15; return 8 * (i >> 2) + 4 * n + (i & 3); }
struct Unit { int pm, pn; };
struct Gemm { const bf16_t* A; int K; };
struct StaticOrder {
    int nM, nN, nwg, G, c; const char* Bt; size_t tstepB;
    __device__ void init(int M, int N, int G_, int c_, const void* Bt_, int K, int es = 2) { nM = M / BM; nN = N / BM; nwg = nM * nN; G = G_; c = c_; Bt = (const char*)Bt_; tstepB = (size_t)BM * K * es; }
    __device__ bool next(int i, Unit& u) const {
        const long L = (long)i * G + c; if (L >= nwg) return false;
        int wgid = (int)L; { const int q = nwg / NXCD, r = nwg % NXCD, xcd = wgid % NXCD, off = wgid / NXCD; wgid = (xcd < r ? xcd * (q + 1) : r * (q + 1) + (xcd - r) * q) + off; }
        const int nig = WGM * nN, gid = wgid / nig, fm = gid * WGM, gsz = (nM - fm) < WGM ? (nM - fm) : WGM;
        u.pm = fm + ((wgid % nig) % gsz); u.pn = (wgid % nig) / gsz; return true;
    }
    __device__ __forceinline__ const char* bptr(const Unit& u) const { return Bt + (size_t)u.pn * tstepB; }
    __device__ __forceinline__ int rowsel(const Unit&, int) const { return 0; }
};
struct TileOrder {
    int nunits, npn, G, c; const int* tile_e; const char* wbase; size_t wstride, woff, tstepB; const int* rowl;
    __device__ bool next(int i, Unit& u) const { const int L = i * G + c; if (L >= nunits) return false; u.pm = L / npn; u.pn = L - u.pm * npn; return true; }
    __device__ __forceinline__ const char* bptr(const Unit& u) const { const int e = __builtin_amdgcn_readfirstlane(tile_e[u.pm]); return wbase + (size_t)e * wstride + woff + (size_t)u.pn * tstepB; }
    __device__ __forceinline__ int rowsel(const Unit& u, int r) const { const int t = rowl[(size_t)u.pm * 256 + r]; return t < 0 ? 0 : t; }
};
struct SeqOrder {
    int n; const char* Bt; size_t tstepB; const LAS int* rsel;
    __device__ bool next(int i, Unit& u) const { if (i >= n) return false; u.pm = 0; u.pn = i; return true; }
    __device__ __forceinline__ const char* bptr(const Unit& u) const { return Bt + (size_t)u.pn * tstepB; }
    __device__ __forceinline__ int rowsel(const Unit&, int r) const { return rsel[r]; }
};
__device__ __forceinline__ unsigned cvt_pk_bf16(float lo, float hi) { return cvtpk(lo, hi); }

template <class Epi, class Sched, bool GATHER, int A_AUX = 0, bool ALIGN = true, bool FP8 = false>
__device__ __forceinline__ void gemm_phase(lbyte* lds, const Gemm g, const Sched& S, const Epi& E) {
    int tid_ = threadIdx.x; asm volatile("" : "+v"(tid_));
    const int tid = tid_, wid = __builtin_amdgcn_readfirstlane(tid >> 6), lane = tid & 63, wr = wid >> 2, wc = wid & 3, fr = lane & 15, fq = lane >> 4;
    constexpr unsigned ES = FP8 ? 1u : 2u;
    const int K = g.K, nt = FP8 ? K / 128 : K / BK;
    Unit cur, nxt; int ui = 0;
    if (!S.next(0, cur)) return;
    int Rst[2], Cst[2];
    unsigned voffA[2], voffA1[2], voffB[2], nvA[2], nvA1[2];
#pragma unroll
    for (int i = 0; i < 2; ++i) { int R, C; stage_rc(tid * 16 + i * 8192, R, C); const int Rb = Epi::PERM ? ((R & ~31) + perm32(R & 31)) : R; Rst[i] = R; Cst[i] = C;
        if (GATHER) { voffA[i] = (unsigned)S.rowsel(cur, R) * (unsigned)K * ES + (unsigned)C * 2u; voffA1[i] = (unsigned)S.rowsel(cur, 128 + R) * (unsigned)K * ES + (unsigned)C * 2u; }
        else { voffA[i] = (unsigned)(R * K) * ES + (unsigned)C * 2u; voffA1[i] = voffA[i]; }
        nvA[i] = voffA[i]; nvA1[i] = voffA1[i];
        voffB[i] = (unsigned)(Rb * K) * ES + (unsigned)C * 2u; }
    const size_t kstep = (size_t)(BK * 2);
    const size_t hstep = (size_t)HALF * K * ES;
    const size_t hstepA = GATHER ? 0 : hstep;
    const size_t tstep = 2 * hstep;
    const unsigned ldsw = (unsigned)wid * 1024u;
    const int aoff = lds_byte(wr * 64 + fr, FP8 ? fq * 16 : fq * 8), boff = lds_byte(wc * 32 + fr, FP8 ? fq * 16 : fq * 8);
#define PG8_SA(b, h) (((b) * 2 + (h)) * HTB)
#define PG8_SB(b, h) ((4 + (b) * 2 + (h)) * HTB)
#define PG8_STAGE2(bufoff, gbase, v0, v1) do { \
        __builtin_amdgcn_global_load_lds((const unsigned*)((const char*)(gbase) + (v0)), (LAS unsigned*)(lds + (bufoff) + ldsw), 16, 0, 0); \
        __builtin_amdgcn_global_load_lds((const unsigned*)((const char*)(gbase) + (v1)), (LAS unsigned*)(lds + (bufoff) + ldsw + 8192), 16, 0, 0); } while (0)
#define PG8_STAGE2A(bufoff, gbase, v0, v1) do { if constexpr (A_AUX == 16) { \
        __builtin_amdgcn_global_load_lds((const unsigned*)((const char*)(gbase) + (v0)), (LAS unsigned*)(lds + (bufoff) + ldsw), 16, 0, 16); \
        __builtin_amdgcn_global_load_lds((const unsigned*)((const char*)(gbase) + (v1)), (LAS unsigned*)(lds + (bufoff) + ldsw + 8192), 16, 0, 16); } else { PG8_STAGE2(bufoff, gbase, v0, v1); } } while (0)
#define PG8_STAGE(bufoff, gbase, voff) PG8_STAGE2(bufoff, gbase, (voff)[0], (voff)[1])
#define PG8_STAGEA(bufoff, gbase, voff) PG8_STAGE2A(bufoff, gbase, (voff)[0], (voff)[1])
#define G_LD32(p) __builtin_shufflevector(*(const LAS i32x4*)(p), *(const LAS i32x4*)((p) + 16), 0, 1, 2, 3, 4, 5, 6, 7)
#define G_MFMA8(c, a, b) asm volatile("v_mfma_scale_f32_16x16x128_f8f6f4 %0, %1, %2, %0, %3, %3 op_sel_hi:[0,0,0]" : "+v"(c) : "v"(a), "v"(b), "v"(one_scale))
#define PG8_LDA(dst, b, h) do { if constexpr (FP8) { _Pragma("unroll") for (int m = 0; m < 4; ++m) dst##8[m] = G_LD32(lds + PG8_SA(b, h) + aoff + m * 2048); } else { \
        _Pragma("unroll") for (int m = 0; m < 4; ++m) _Pragma("unroll") for (int k = 0; k < 2; ++k) dst[m][k] = *(const LAS bf16x8*)(lds + PG8_SA(b, h) + aoff + m * 2048 + k * 1024); } } while (0)
#define PG8_LDB(dst, b, h) do { if constexpr (FP8) { _Pragma("unroll") for (int n = 0; n < 2; ++n) dst##8[n] = G_LD32(lds + PG8_SB(b, h) + boff + n * 2048); } else { \
        _Pragma("unroll") for (int n = 0; n < 2; ++n) _Pragma("unroll") for (int k = 0; k < 2; ++k) dst[n][k] = *(const LAS bf16x8*)(lds + PG8_SB(b, h) + boff + n * 2048 + k * 1024); } } while (0)
#define PG8_MMA(ai, bj, At, Bt) do { __builtin_amdgcn_s_setprio(1); if constexpr (FP8) { _Pragma("unroll") for (int m = 0; m < 4; ++m) _Pragma("unroll") for (int n = 0; n < 2; ++n) G_MFMA8(acc[ai][bj][m][n], Bt##8[n], At##8[m]); } else { \
        _Pragma("unroll") for (int m = 0; m < 4; ++m) _Pragma("unroll") for (int n = 0; n < 2; ++n) _Pragma("unroll") for (int k = 0; k < 2; ++k) \
        acc[ai][bj][m][n] = __builtin_amdgcn_mfma_f32_16x16x32_bf16(Bt[n][k], At[m][k], acc[ai][bj][m][n], 0, 0, 0); } __builtin_amdgcn_s_setprio(0); } while (0)
#define PG8_WAIT_V(n) asm volatile("s_waitcnt vmcnt(" #n ")" ::: "memory")
#define PG8_WAIT_L(n) asm volatile("s_waitcnt lgkmcnt(" #n ")" ::: "memory")
#define PG8_BAR __builtin_amdgcn_s_barrier()
#define PG8_SCHED __builtin_amdgcn_sched_barrier(0)
    f32x4 acc[2][2][4][2];
#pragma unroll
    for (int a = 0; a < 2; ++a)
#pragma unroll
        for (int b = 0; b < 2; ++b)
#pragma unroll
            for (int m = 0; m < 4; ++m)
#pragma unroll
                for (int n = 0; n < 2; ++n) acc[a][b][m][n] = (f32x4){0.f, 0.f, 0.f, 0.f};
    bf16x8 At[4][2], B0[2][2], B1[2][2]; i32x8 At8[4], B08[2], B18[2];
    int one_scale = 0x7F7F7F7F; asm volatile("" : "+v"(one_scale));
    const char* cA = (const char*)g.A + (GATHER ? (size_t)0 : (size_t)cur.pm * tstep); const char* cB = S.bptr(cur);
    PG8_STAGE(PG8_SB(0, 0), cB, voffB); PG8_STAGE(PG8_SB(0, 1), cB + hstep, voffB); PG8_STAGEA(PG8_SA(0, 0), cA, voffA); PG8_STAGEA(PG8_SA(0, 1), cA + hstepA, voffA1);
    if (wr == 1) PG8_BAR;
    PG8_WAIT_V(2); PG8_BAR;
    PG8_STAGE(PG8_SB(1, 0), cB + kstep, voffB); PG8_STAGEA(PG8_SA(1, 0), cA + kstep, voffA); PG8_STAGE(PG8_SB(1, 1), cB + hstep + kstep, voffB);
    PG8_WAIT_V(6); PG8_BAR;
    for (;;) {
        const bool has_next = S.next(ui + 1, nxt);
        const char* nA = has_next ? (const char*)g.A + (GATHER ? (size_t)0 : (size_t)nxt.pm * tstep) : cA; const char* nB = has_next ? S.bptr(nxt) : cB;
        for (int t = 0; t < nt; t += 2) {
            const bool last = (t == nt - 2);
            const char* a1 = cA + (size_t)(t + 1) * kstep;
            const char* a2 = last ? nA : cA + (size_t)(t + 2) * kstep; const char* b2 = last ? nB : cB + (size_t)(t + 2) * kstep;
            const char* a3 = a2 + kstep; const char* b3 = b2 + kstep;
            if (GATHER && last && has_next) {
#pragma unroll
                for (int i = 0; i < 2; ++i) { nvA[i] = (unsigned)S.rowsel(nxt, Rst[i]) * (unsigned)K * ES + (unsigned)Cst[i] * 2u; nvA1[i] = (unsigned)S.rowsel(nxt, 128 + Rst[i]) * (unsigned)K * ES + (unsigned)Cst[i] * 2u; }
            }
            const unsigned x0 = (GATHER && last) ? nvA[0] : voffA[0], x1 = (GATHER && last) ? nvA[1] : voffA[1];
            const unsigned y0 = (GATHER && last) ? nvA1[0] : voffA1[0], y1 = (GATHER && last) ? nvA1[1] : voffA1[1];
            PG8_LDB(B0, 0, 0); PG8_LDB(B1, 0, 1); PG8_SCHED; PG8_LDA(At, 0, 0); PG8_STAGEA(PG8_SA(1, 1), a1 + hstepA, voffA1);
            PG8_WAIT_V(8); PG8_WAIT_L(0); PG8_BAR; PG8_MMA(0, 0, At, B0); PG8_MMA(0, 1, At, B1); PG8_BAR; PG8_SCHED;
            PG8_LDA(At, 0, 1); PG8_STAGE(PG8_SB(0, 0), b2, voffB); PG8_STAGE(PG8_SB(0, 1), b2 + hstep, voffB); PG8_STAGE2A(PG8_SA(0, 0), a2, x0, x1);
            PG8_WAIT_V(8); PG8_WAIT_L(0); PG8_BAR; PG8_MMA(1, 0, At, B0); PG8_MMA(1, 1, At, B1); PG8_BAR; PG8_SCHED;
            PG8_LDB(B0, 1, 0); PG8_LDB(B1, 1, 1); PG8_SCHED; PG8_LDA(At, 1, 0); PG8_STAGE2A(PG8_SA(0, 1), a2 + hstepA, y0, y1);
            PG8_WAIT_V(8); PG8_WAIT_L(0); PG8_BAR; PG8_MMA(0, 0, At, B0); PG8_MMA(0, 1, At, B1); PG8_BAR; PG8_SCHED;
            PG8_LDA(At, 1, 1); PG8_STAGE(PG8_SB(1, 0), b3, voffB); PG8_STAGE(PG8_SB(1, 1), b3 + hstep, voffB); PG8_STAGE2A(PG8_SA(1, 0), a3, x0, x1);
            PG8_WAIT_V(8); PG8_WAIT_L(0); PG8_BAR; PG8_MMA(1, 0, At, B0); PG8_MMA(1, 1, At, B1); PG8_BAR; PG8_SCHED;
        }
        if (ALIGN && wr == 0) PG8_BAR;
        if constexpr (FP8) asm volatile("s_nop 15\n\ts_nop 15" ::: "memory");
        E(acc, cur, wr, wc, fr, fq);
        if (!has_next) break;
#pragma unroll
        for (int a = 0; a < 2; ++a)
#pragma unroll
            for (int b = 0; b < 2; ++b)
#pragma unroll
                for (int m = 0; m < 4; ++m)
#pragma unroll
                    for (int n = 0; n < 2; ++n) acc[a][b][m][n] = (f32x4){0.f, 0.f, 0.f, 0.f};
        cur = nxt; cA = nA; cB = nB; ++ui;
        if (GATHER) { voffA[0] = nvA[0]; voffA[1] = nvA[1]; voffA1[0] = nvA1[0]; voffA1[1] = nvA1[1]; }
        if (ALIGN && wr == 1) PG8_BAR;
    }
    PG8_WAIT_V(0);
    if (!ALIGN && wr == 0) PG8_BAR;
    PG8_BAR;
#undef PG8_SA
#undef PG8_SB
#undef PG8_STAGE
#undef PG8_STAGE2
#undef PG8_STAGE2A
#undef PG8_STAGEA
#undef G_LD32
#undef G_MFMA8
#undef PG8_LDA
#undef PG8_LDB
#undef PG8_MMA
#undef PG8_WAIT_V
#undef PG8_WAIT_L
#undef PG8_BAR
#undef PG8_SCHED
}

struct EpiBf16 {
    static constexpr bool PERM = true;
    bf16_t* O; int ldc; float scale;
    __device__ __forceinline__ void operator()(const f32x4 (&acc)[2][2][4][2], const Unit& u, int wr, int wc, int fr, int fq) const {
        const int row0 = u.pm * BM + wr * 64 + fr; const int col0 = u.pn * BM + wc * 32 + 8 * fq;
#pragma unroll
        for (int ai = 0; ai < 2; ++ai)
#pragma unroll
            for (int m = 0; m < 4; ++m) { bf16_t* rowp = O + (size_t)(row0 + ai * HALF + m * 16) * ldc + col0;
#pragma unroll
                for (int bj = 0; bj < 2; ++bj) { const f32x4 v0 = acc[ai][bj][m][0] * scale, v1 = acc[ai][bj][m][1] * scale;
                    u32x4 w; w.x = cvt_pk_bf16(v0[0], v0[1]); w.y = cvt_pk_bf16(v0[2], v0[3]); w.z = cvt_pk_bf16(v1[0], v1[1]); w.w = cvt_pk_bf16(v1[2], v1[3]);
                    *(u32x4*)(rowp + bj * HALF) = w; } }
    }
};
struct EpiF32 {
    static constexpr bool PERM = false;
    float* C; int ldc;
    __device__ __forceinline__ void operator()(const f32x4 (&acc)[2][2][4][2], const Unit& u, int wr, int wc, int fr, int fq) const {
        const int row0 = u.pm * BM + wr * 64 + fr, col0 = u.pn * BM + wc * 32 + 4 * fq;
#pragma unroll
        for (int ai = 0; ai < 2; ++ai)
#pragma unroll
            for (int m = 0; m < 4; ++m) { float* rowp = C + (size_t)(row0 + ai * HALF + m * 16) * ldc + col0;
#pragma unroll
                for (int bj = 0; bj < 2; ++bj)
#pragma unroll
                    for (int n = 0; n < 2; ++n) *(f32x4*)(rowp + bj * HALF + n * 16) = acc[ai][bj][m][n]; }
    }
};
struct EpiResGate {
    static constexpr bool PERM = false;
    const float* x; float* out; const float* mod; int gate_off;
    __device__ __forceinline__ void operator()(const f32x4 (&acc)[2][2][4][2], const Unit& u, int wr, int wc, int fr, int fq) const {
        const int row0 = u.pm * BM + wr * 64 + fr, col0 = u.pn * BM + wc * 32 + 4 * fq;
        const float* gp = mod + (size_t)((u.pm * BM) >> 11) * MODW + gate_off + col0;
        f32x4 gv[2][2];
#pragma unroll
        for (int bj = 0; bj < 2; ++bj)
#pragma unroll
            for (int n = 0; n < 2; ++n) gv[bj][n] = *(const f32x4*)(gp + bj * HALF + n * 16);
#pragma unroll
        for (int ai = 0; ai < 2; ++ai)
#pragma unroll
            for (int m = 0; m < 4; ++m) { const size_t off = (size_t)(row0 + ai * HALF + m * 16) * D + col0;
#pragma unroll
                for (int bj = 0; bj < 2; ++bj)
#pragma unroll
                    for (int n = 0; n < 2; ++n) { const f32x4 xv = *(const f32x4*)(x + off + bj * HALF + n * 16);
                        *(f32x4*)(out + off + bj * HALF + n * 16) = xv + gv[bj][n] * acc[ai][bj][m][n]; }
                asm volatile("" ::: "memory"); }
    }
};
struct EpiGLU {
    static constexpr bool PERM = true;
    bf16_t* H;
    __device__ __forceinline__ void operator()(const f32x4 (&acc)[2][2][4][2], const Unit& u, int wr, int wc, int fr, int fq) const {
        const int row0 = u.pm * BM + wr * 64 + fr; const int col0 = u.pn * 128 + wc * 32 + 8 * fq;
#pragma unroll
        for (int ai = 0; ai < 2; ++ai)
#pragma unroll
            for (int m = 0; m < 4; ++m) { bf16_t* rowp = H + (size_t)(row0 + ai * HALF + m * 16) * 256 + col0;
                f32x4 h0, h1;
#pragma unroll
                for (int j = 0; j < 4; ++j) { const float a0 = acc[ai][0][m][0][j], a1 = acc[ai][0][m][1][j];
                    h0[j] = siluf_(a0) * acc[ai][1][m][0][j]; h1[j] = siluf_(a1) * acc[ai][1][m][1][j]; }
                u32x4 w; w.x = cvt_pk_bf16(h0[0], h0[1]); w.y = cvt_pk_bf16(h0[2], h0[3]); w.z = cvt_pk_bf16(h1[0], h1[1]); w.w = cvt_pk_bf16(h1[2], h1[3]);
                *(u32x4*)rowp = w; }
    }
};
constexpr float YSCALE = 8.f;
struct EpiY {
    static constexpr bool PERM = true;
    unsigned char* Y; float* out; const float* mod; const LAS int* rtok; const LAS float* rw; int shared;
    __device__ __forceinline__ void operator()(const f32x4 (&acc)[2][2][4][2], const Unit& u, int wr, int wc, int fr, int fq) const {
        const int col0 = u.pn * BM + wc * 32 + 8 * fq;
#pragma unroll
        for (int ai = 0; ai < 2; ++ai)
#pragma unroll
            for (int m = 0; m < 4; ++m) { const int r = wr * 64 + fr + ai * HALF + m * 16; const int ts = rtok[r]; const float w = rw[r];
                if (ts >= 0) {
                    if (shared) { const unsigned goff = (unsigned)(ts >> 11) * MODW + 5 * D + col0; const unsigned ooff = (unsigned)ts * D + col0;
#pragma unroll
                        for (int bj = 0; bj < 2; ++bj)
#pragma unroll
                            for (int n = 0; n < 2; ++n) { const f32x4 gv = *(const f32x4*)(mod + goff + bj * HALF + n * 4); f32x4* op = (f32x4*)(out + ooff + bj * HALF + n * 4);
                                *op = *op + gv * acc[ai][bj][m][n]; }
                    } else { unsigned char* yp = Y + (size_t)(unsigned)ts * D + col0; const float ws_ = w * YSCALE;
#pragma unroll
                        for (int bj = 0; bj < 2; ++bj) { f32x4 v0 = acc[ai][bj][m][0] * ws_, v1 = acc[ai][bj][m][1] * ws_;
#pragma unroll
                                for (int j = 0; j < 4; ++j) { v0[j] = __builtin_amdgcn_fmed3f(v0[j], -448.f, 448.f); v1[j] = __builtin_amdgcn_fmed3f(v1[j], -448.f, 448.f); }
                            unsigned lo = 0u, hi = 0u;
                            lo = __builtin_amdgcn_cvt_pk_fp8_f32(v0[0], v0[1], lo, false); lo = __builtin_amdgcn_cvt_pk_fp8_f32(v0[2], v0[3], lo, true);
                            hi = __builtin_amdgcn_cvt_pk_fp8_f32(v1[0], v1[1], hi, false); hi = __builtin_amdgcn_cvt_pk_fp8_f32(v1[2], v1[3], hi, true);
                            u32x2 pk; pk.x = lo; pk.y = hi; *(u32x2*)(yp + bj * HALF) = pk; } } }
                asm volatile("" ::: "memory"); }
    }
};

struct MoeCtx {
    int ntiles, nrt, G, vc;
    const LAS int* tb; LAS int* tbl;
    const unsigned* cnt; const int* rowl; const float* roww;
    const char* wexp; const char* h2n; char* Hs; unsigned char* Y; float* out; const float* mod; int dry_shared;
};
__device__ __forceinline__ void gemm_moe(lbyte* lds, const MoeCtx& M) {
    int tid_ = threadIdx.x; asm volatile("" : "+v"(tid_));
    const int tid = tid_, wid = __builtin_amdgcn_readfirstlane(tid >> 6), lane = tid & 63, wr = wid >> 2, wc = wid & 3, fr = lane & 15, fq = lane >> 4;
    const int ntl = (M.ntiles - M.vc + M.G - 1) / M.G;
    if (M.vc >= M.ntiles) return;
    const int nunits = ntl * 6;
    const unsigned ldsw = (unsigned)wid * 1024u;
    const int aoff = lds_byte(wr * 64 + fr, fq * 16), boff = lds_byte(wc * 32 + fr, fq * 16);
    auto tile_expert = [&](int tile, int& e, int& k) { if (tile < M.nrt) { int lo = 0, hi = NE - 1; while (lo < hi) { const int mid = (lo + hi + 1) >> 1; if (M.tb[mid] <= tile) lo = mid; else hi = mid - 1; } e = lo; k = tile - M.tb[lo]; } else { e = NE; k = tile - M.nrt; } };
    auto fill = [&](int j) { if (j < ntl && tid < 256) { const int tile = M.vc + j * M.G; int e, k; tile_expert(tile, e, k); LAS int* T = M.tbl + (j % 3) * 768;
            int ts; float w;
            if (e < NE) { const int valid = (int)M.cnt[e] - 256 * k; if (tid < valid) { ts = M.rowl[(size_t)tile * 256 + tid]; w = M.roww[(size_t)tile * 256 + tid]; } else { ts = -1; w = 0.f; } T[tid] = ts < 0 ? 0 : (ts >> 3); }
            else { ts = k * 256 + tid; w = 1.f; T[tid] = ts; }
            T[256 + tid] = ts; ((LAS float*)T)[512 + tid] = w; } };
    struct UP { const char* aB; const char* bB; unsigned bh; int nt, kind, pn, slot, shared, e, hbuf, fillnext; };
    auto unit_params = [&](int ui, int prev_e, UP& u, unsigned (&oa)[4], unsigned (&ob)[2]) {
        int tq = threadIdx.x; asm volatile("" : "+v"(tq));
        int Rst[2], Cst[2], Rbp[2];
#pragma unroll
        for (int i = 0; i < 2; ++i) { int R, C; stage_rc(tq * 16 + i * 8192, R, C); Rst[i] = R; Cst[i] = C; Rbp[i] = (R & ~31) + perm32(R & 31); }
        int j, sub;
        if (ui < 2) { j = 0; sub = ui; }
        else { const int qq = ui - 2, g = qq / 6, r = qq - 6 * g; if (g < ntl - 1 && r < 2) { j = g + 1; sub = r; } else { j = g; sub = (g < ntl - 1) ? r : r + 2; } }
        const int tile = M.vc + j * M.G; int e, k;
        if (sub == 0 || sub == 2) tile_expert(tile, e, k); else e = prev_e;
        u.e = e;
        const char* w = M.wexp + (size_t)e * WEXP_STRIDE;
        u.slot = j % 3; u.hbuf = j & 1; u.fillnext = (sub == 1) ? j + 1 : -1; u.shared = (e == NE) ? 1 : 0;
        if (sub < 2) { u.kind = 0; u.pn = sub; u.nt = D / 128; u.aB = M.h2n; u.bB = w + (size_t)sub * 256 * D; u.bh = 128u * D;
            const LAS int* T = M.tbl + (j % 3) * 768;
#pragma unroll
            for (int i = 0; i < 2; ++i) { oa[i] = (unsigned)T[Rst[i]] * (unsigned)D + 2u * (unsigned)Cst[i]; oa[2 + i] = (unsigned)T[128 + Rst[i]] * (unsigned)D + 2u * (unsigned)Cst[i]; ob[i] = (unsigned)(Rbp[i] * D + 2 * Cst[i]); } }
        else { u.kind = 1; u.pn = sub - 2; u.nt = DE / 128; u.aB = M.Hs + (j & 1) * 65536; u.bB = w + (size_t)512 * 1024 + (size_t)(sub - 2) * 256 * DE; u.bh = 128u * DE;
#pragma unroll
            for (int i = 0; i < 2; ++i) { oa[i] = (unsigned)(Rst[i] * DE + 2 * Cst[i]); oa[2 + i] = (unsigned)((128 + Rst[i]) * DE + 2 * Cst[i]); ob[i] = (unsigned)(Rbp[i] * DE + 2 * Cst[i]); } }
    };
#define PG8_SA(b, h) (((b) * 2 + (h)) * HTB)
#define PG8_SB(b, h) ((4 + (b) * 2 + (h)) * HTB)
#define MOE_DMA(bufoff, ptr, aux) __builtin_amdgcn_global_load_lds((const unsigned*)(ptr), (LAS unsigned*)(lds + (bufoff)), 16, 0, aux)
#define MOE_STA(bufoff, base, o0, o1) do { MOE_DMA((bufoff) + ldsw, (base) + (o0), 16); MOE_DMA((bufoff) + ldsw + 8192, (base) + (o1), 16); } while (0)
#define MOE_STAK(kindv, bufoff, base, o0, o1) do { if ((kindv) == 0) { MOE_DMA((bufoff) + ldsw, (base) + (o0), 0); MOE_DMA((bufoff) + ldsw + 8192, (base) + (o1), 0); } else MOE_STA(bufoff, base, o0, o1); } while (0)
#define MOE_STB(bufoff, base, o0, o1) do { MOE_DMA((bufoff) + ldsw, (base) + (o0), 0); MOE_DMA((bufoff) + ldsw + 8192, (base) + (o1), 0); } while (0)
#define MOE_LD32(p) __builtin_shufflevector(*(const LAS i32x4*)(p), *(const LAS i32x4*)((p) + 16), 0, 1, 2, 3, 4, 5, 6, 7)
#define PG8_LDA(dst, b, h) do { _Pragma("unroll") for (int m = 0; m < 4; ++m) dst[m] = MOE_LD32(lds + PG8_SA(b, h) + aoff + m * 2048); } while (0)
#define PG8_LDB(dst, b, h) do { _Pragma("unroll") for (int n = 0; n < 2; ++n) dst[n] = MOE_LD32(lds + PG8_SB(b, h) + boff + n * 2048); } while (0)
#define MOE_MFMA(c, a, b) asm volatile("v_mfma_scale_f32_16x16x128_f8f6f4 %0, %1, %2, %0, %3, %3 op_sel_hi:[0,0,0]" : "+v"(c) : "v"(a), "v"(b), "v"(one_scale))
#define PG8_MMA(ai, bj, At, Bt) do { __builtin_amdgcn_s_setprio(1); _Pragma("unroll") for (int m = 0; m < 4; ++m) _Pragma("unroll") for (int n = 0; n < 2; ++n) \
        MOE_MFMA(acc[ai][bj][m][n], Bt[n], At[m]); __builtin_amdgcn_s_setprio(0); } while (0)
#define PG8_WAIT_V(n) asm volatile("s_waitcnt vmcnt(" #n ")" ::: "memory")
#define PG8_WAIT_L(n) asm volatile("s_waitcnt lgkmcnt(" #n ")" ::: "memory")
#define PG8_BAR __builtin_amdgcn_s_barrier()
#define PG8_SCHED __builtin_amdgcn_sched_barrier(0)
    fill(0);
    asm volatile("s_waitcnt vmcnt(0) lgkmcnt(0)" ::: "memory");
    __syncthreads();
    UP cu, nu; unsigned oa[4], ob[2], na[4], nb[2];
    unit_params(0, 0, cu, oa, ob);
    nu = cu;
#pragma unroll
    for (int i = 0; i < 4; ++i) na[i] = oa[i];
    nb[0] = ob[0]; nb[1] = ob[1];
    f32x4 acc[2][2][4][2];
#pragma unroll
    for (int a = 0; a < 2; ++a)
#pragma unroll
        for (int b = 0; b < 2; ++b)
#pragma unroll
            for (int m = 0; m < 4; ++m)
#pragma unroll
                for (int n = 0; n < 2; ++n) acc[a][b][m][n] = (f32x4){0.f, 0.f, 0.f, 0.f};
    i32x8 At[4], B0[2], B1[2];
    int one_scale = 0x7F7F7F7F; asm volatile("" : "+v"(one_scale));
    const size_t kstep = (size_t)128;
    {   const char* cA = cu.aB; const char* cB = cu.bB;
        MOE_STB(PG8_SB(0, 0), cB, ob[0], ob[1]); MOE_STB(PG8_SB(0, 1), cB + cu.bh, ob[0], ob[1]); MOE_STAK(cu.kind, PG8_SA(0, 0), cA, oa[0], oa[1]); MOE_STAK(cu.kind, PG8_SA(0, 1), cA, oa[2], oa[3]);
        if (wr == 1) PG8_BAR;
        PG8_WAIT_V(2); PG8_BAR;
        MOE_STB(PG8_SB(1, 0), cB + kstep, ob[0], ob[1]); MOE_STAK(cu.kind, PG8_SA(1, 0), cA + kstep, oa[0], oa[1]); MOE_STB(PG8_SB(1, 1), cB + cu.bh + kstep, ob[0], ob[1]);
        PG8_WAIT_V(6); PG8_BAR; }
    for (int ui = 0;; ++ui) {
        const bool has_next = (ui + 1 < nunits);
        if (cu.fillnext >= 0) fill(cu.fillnext);
        const char* cA = cu.aB; const char* cB = cu.bB; const int nt = cu.nt; const unsigned bh = cu.bh;
        for (int t = 0; t < nt; t += 2) {
            const bool last = (t == nt - 2);
            if (last && has_next) unit_params(ui + 1, cu.e, nu, na, nb);
            const char* a1 = cA + (size_t)(t + 1) * kstep;
            const char* a2 = last ? nu.aB : cA + (size_t)(t + 2) * kstep; const char* b2 = last ? nu.bB : cB + (size_t)(t + 2) * kstep;
            const char* a3 = a2 + kstep; const char* b3 = b2 + kstep;
            const unsigned bh2 = last ? nu.bh : bh;
            const unsigned x0 = last ? na[0] : oa[0], x1 = last ? na[1] : oa[1], y0 = last ? na[2] : oa[2], y1 = last ? na[3] : oa[3];
            const unsigned z0 = last ? nb[0] : ob[0], z1 = last ? nb[1] : ob[1];
            const int k2 = last ? nu.kind : cu.kind;
            PG8_LDB(B0, 0, 0); PG8_LDB(B1, 0, 1); PG8_SCHED; PG8_LDA(At, 0, 0); MOE_STAK(cu.kind, PG8_SA(1, 1), a1, oa[2], oa[3]);
            PG8_WAIT_V(8); PG8_WAIT_L(0); PG8_BAR; PG8_MMA(0, 0, At, B0); PG8_MMA(0, 1, At, B1); PG8_BAR; PG8_SCHED;
            PG8_LDA(At, 0, 1); MOE_STB(PG8_SB(0, 0), b2, z0, z1); MOE_STB(PG8_SB(0, 1), b2 + bh2, z0, z1); MOE_STAK(k2, PG8_SA(0, 0), a2, x0, x1);
            PG8_WAIT_V(8); PG8_WAIT_L(0); PG8_BAR; PG8_MMA(1, 0, At, B0); PG8_MMA(1, 1, At, B1); PG8_BAR; PG8_SCHED;
            PG8_LDB(B0, 1, 0); PG8_LDB(B1, 1, 1); PG8_SCHED; PG8_LDA(At, 1, 0); MOE_STAK(k2, PG8_SA(0, 1), a2, y0, y1);
            PG8_WAIT_V(8); PG8_WAIT_L(0); PG8_BAR; PG8_MMA(0, 0, At, B0); PG8_MMA(0, 1, At, B1); PG8_BAR; PG8_SCHED;
            PG8_LDA(At, 1, 1); MOE_STB(PG8_SB(1, 0), b3, z0, z1); MOE_STB(PG8_SB(1, 1), b3 + bh2, z0, z1); MOE_STAK(k2, PG8_SA(1, 0), a3, x0, x1);
            PG8_WAIT_V(8); PG8_WAIT_L(0); PG8_BAR; PG8_MMA(1, 0, At, B0); PG8_MMA(1, 1, At, B1); PG8_BAR; PG8_SCHED;
        }
        if (wr == 0) PG8_BAR;
        asm volatile("s_nop 15\n\ts_nop 15" ::: "memory");
        if (cu.kind == 0) {
            const int row0 = wr * 64 + fr; const int col0 = cu.pn * 128 + wc * 32 + 8 * fq;
            constexpr float is13 = 1.f / SW13;
#pragma unroll
            for (int ai = 0; ai < 2; ++ai)
#pragma unroll
                for (int m = 0; m < 4; ++m) { unsigned char* rowp = (unsigned char*)M.Hs + cu.hbuf * 65536 + (size_t)(row0 + ai * HALF + m * 16) * 256 + col0;
                    f32x4 h0, h1;
#pragma unroll
                    for (int j = 0; j < 4; ++j) { h0[j] = siluf_(acc[ai][0][m][0][j] * is13) * (acc[ai][1][m][0][j] * (is13 * SHS)); h1[j] = siluf_(acc[ai][0][m][1][j] * is13) * (acc[ai][1][m][1][j] * (is13 * SHS)); }
                    u32x2 w; w.x = pk4_fp8(h0[0], h0[1], h0[2], h0[3]); w.y = pk4_fp8(h1[0], h1[1], h1[2], h1[3]);
                    *(u32x2*)rowp = w; }
        } else {
            const LAS int* rtok = M.tbl + cu.slot * 768 + 256; const LAS float* rw = (const LAS float*)(M.tbl + cu.slot * 768 + 512);
            const int col0 = cu.pn * BM + wc * 32 + 8 * fq;
#pragma unroll
            for (int ai = 0; ai < 2; ++ai)
#pragma unroll
                for (int m = 0; m < 4; ++m) { const int r = wr * 64 + fr + ai * HALF + m * 16; const int ts = rtok[r]; const float w = rw[r];
                    if (ts >= 0) {
                        if (cu.shared) { const unsigned goff = (unsigned)(ts >> 11) * MODW + 5 * D + col0; const unsigned ooff = (unsigned)ts * D + col0;
#pragma unroll
                            for (int bj = 0; bj < 2; ++bj)
#pragma unroll
                                for (int n = 0; n < 2; ++n) { const f32x4 gv = *(const f32x4*)(M.mod + goff + bj * HALF + n * 4); f32x4* op = (f32x4*)(M.out + ooff + bj * HALF + n * 4);
                                    const f32x4 nv = *op + gv * acc[ai][bj][m][n] * (1.f / (SHS * SW2)); if (!M.dry_shared) *op = nv; else asm volatile("" :: "v"(nv)); }
                        } else { unsigned char* yp = M.Y + (size_t)(unsigned)ts * D + col0; const float ws_ = w * (YSCALE / (SHS * SW2));
#pragma unroll
                            for (int bj = 0; bj < 2; ++bj) { f32x4 v0 = acc[ai][bj][m][0] * ws_, v1 = acc[ai][bj][m][1] * ws_;
#pragma unroll
                                for (int j = 0; j < 4; ++j) { v0[j] = __builtin_amdgcn_fmed3f(v0[j], -448.f, 448.f); v1[j] = __builtin_amdgcn_fmed3f(v1[j], -448.f, 448.f); }
                                unsigned lo = 0u, hi = 0u;
                                lo = __builtin_amdgcn_cvt_pk_fp8_f32(v0[0], v0[1], lo, false); lo = __builtin_amdgcn_cvt_pk_fp8_f32(v0[2], v0[3], lo, true);
                                hi = __builtin_amdgcn_cvt_pk_fp8_f32(v1[0], v1[1], hi, false); hi = __builtin_amdgcn_cvt_pk_fp8_f32(v1[2], v1[3], hi, true);
                                u32x2 pk; pk.x = lo; pk.y = hi; *(u32x2*)(yp + bj * HALF) = pk; } } }
                    asm volatile("" ::: "memory"); }
        }
        if (!has_next) break;
#pragma unroll
        for (int a = 0; a < 2; ++a)
#pragma unroll
            for (int b = 0; b < 2; ++b)
#pragma unroll
                for (int m = 0; m < 4; ++m)
#pragma unroll
                    for (int n = 0; n < 2; ++n) acc[a][b][m][n] = (f32x4){0.f, 0.f, 0.f, 0.f};
        cu = nu;
#pragma unroll
        for (int i = 0; i < 4; ++i) oa[i] = na[i];
        ob[0] = nb[0]; ob[1] = nb[1];
        if (wr == 1) PG8_BAR;
    }
    PG8_WAIT_V(0);
    PG8_BAR;
#undef PG8_SA
#undef PG8_SB
#undef MOE_DMA
#undef MOE_STA
#undef MOE_STAK
#undef MOE_STB
#undef PG8_LDA
#undef PG8_LDB
#undef MOE_LD32
#undef MOE_MFMA
#undef PG8_MMA
#undef PG8_WAIT_V
#undef PG8_WAIT_L
#undef PG8_BAR
#undef PG8_SCHED
}
}

struct Ctx {
    lbyte* lds; int tid, lane, wave, G, bid;
    const Args* a;
};
#define WSP(T, off) ((T*)(A.ws + (off)))

template <class RowMap>
__device__ __forceinline__ void transpose_item(const float* W, int K, int N, bf16_t* WT, RowMap rowmap, lfloat* scr, int item, int lane) {
    const int nblk = N / 32, kb = item / nblk, nb = item % nblk, k0 = 64 * kb, n0 = 32 * nb;
#pragma unroll 8
    for (int i = 0; i < 32; ++i) { const int kk = 2 * i + (lane >> 5); scr[kk * 33 + (lane & 31)] = W[(size_t)(k0 + kk) * N + n0 + (lane & 31)]; }
    asm volatile("s_waitcnt lgkmcnt(0)" ::: "memory");
    const int c = lane & 7;
#pragma unroll
    for (int j = 0; j < 4; ++j) { const int n = (lane >> 3) + 8 * j; const lfloat* s = scr + (8 * c) * 33 + n;
        u32x4 o; o.x = pk2(s[0 * 33], s[1 * 33]); o.y = pk2(s[2 * 33], s[3 * 33]); o.z = pk2(s[4 * 33], s[5 * 33]); o.w = pk2(s[6 * 33], s[7 * 33]);
        *(u32x4*)(WT + (size_t)rowmap(n0 + n) * K + k0 + 8 * c) = o; }
    asm volatile("s_waitcnt lgkmcnt(0)" ::: "memory");
}
template <class RowMap>
__device__ __forceinline__ void transpose_item_fp8(const float* W, int K, int N, unsigned char* WT, RowMap rowmap, float sc, lfloat* scr, int item, int lane) {
    const int nblk = N / 32, kb = item / nblk, nb = item % nblk, k0 = 64 * kb, n0 = 32 * nb;
#pragma unroll 8
    for (int i = 0; i < 32; ++i) { const int kk = 2 * i + (lane >> 5); scr[kk * 33 + (lane & 31)] = W[(size_t)(k0 + kk) * N + n0 + (lane & 31)] * sc; }
    asm volatile("s_waitcnt lgkmcnt(0)" ::: "memory");
    const int c = lane & 7;
#pragma unroll
    for (int j = 0; j < 4; ++j) { const int n = (lane >> 3) + 8 * j; const lfloat* s = scr + (8 * c) * 33 + n;
        u32x2 o; o.x = pk4_fp8(s[0 * 33], s[1 * 33], s[2 * 33], s[3 * 33]); o.y = pk4_fp8(s[4 * 33], s[5 * 33], s[6 * 33], s[7 * 33]);
        *(u32x2*)(WT + (size_t)rowmap(n0 + n) * K + k0 + 8 * c) = o; }
    asm volatile("s_waitcnt lgkmcnt(0)" ::: "memory");
}
struct RowId { __device__ int operator()(int n) const { return n; } };
struct RowGLU { int base; __device__ int operator()(int n) const { return ((n >> 7) << 8) + base + (n & 127); } };

__device__ __forceinline__ void norm_mod_row(const float* xrow, const float* g, const float* sc, const float* sh, bf16_t* orow, int lane, unsigned* o8row = nullptr) {
    const f32x4* xr = (const f32x4*)xrow + lane;
    f32x4 v[4]; float s = 0.f;
#pragma unroll
    for (int j = 0; j < 4; ++j) { v[j] = xr[64 * j]; s += (v[j].x * v[j].x + v[j].y * v[j].y) + (v[j].z * v[j].z + v[j].w * v[j].w); }
    const float rstd = __builtin_amdgcn_rsqf(wave_sum(s) * (1.f / D) + NORM_EPS);
    u32x2* o8 = (u32x2*)orow + lane;
#pragma unroll
    for (int j = 0; j < 4; ++j) { const f32x4 gg = ((const f32x4*)g)[lane + 64 * j], ss = ((const f32x4*)sc)[lane + 64 * j], hh = ((const f32x4*)sh)[lane + 64 * j];
        const f32x4 y = v[j] * rstd * gg * (ss + 1.f) + hh;
        if (orow) { u32x2 w; w.x = pk2(y.x, y.y); w.y = pk2(y.z, y.w); o8[64 * j] = w; }
        if (o8row) o8row[lane + 64 * j] = pk4_fp8(y.x, y.y, y.z, y.w); }
}

__device__ __forceinline__ void phase_p0(const Args& A, Ctx& C) {
    float* mod = WSP(float, WS_MOD);
    {
        lfloat* sc = (lfloat*)C.lds;
        lfloat* red = (lfloat*)(C.lds + 17 * 1024 * 4);
        const float* wada = A.in[I_WADA]; const float* bada = A.in[I_BADA];
        for (int it = C.bid; it < 96 * 2; it += C.G) {
            const int chunk = it >> 1, pass = it & 1, r0 = pass * 17, nr = pass ? 16 : 17, col0 = chunk * 64;
            __syncthreads();
            for (int i = C.tid; i < nr * 1024; i += 512) { const int r = i >> 10, k = i & 1023; const int rr = r0 + r;
                const float cv = rr < 32 ? A.in[I_C][rr * 1024 + k] : A.in[I_CCTX][k]; sc[r * 1024 + k] = siluf_(cv); }
            __syncthreads();
            const int col = C.tid & 63, kq = C.tid >> 6;
            float acc[17];
#pragma unroll
            for (int r = 0; r < 17; ++r) acc[r] = 0.f;
            for (int k = kq * 128; k < kq * 128 + 128; k += 4) {
                float w[4];
#pragma unroll
                for (int j = 0; j < 4; ++j) w[j] = wada[(size_t)(k + j) * MODW + col0 + col];
#pragma unroll
                for (int r = 0; r < 17; ++r) { const f32x4 s4 = *(const LAS f32x4*)(sc + r * 1024 + k); acc[r] += s4.x * w[0] + s4.y * w[1] + s4.z * w[2] + s4.w * w[3]; }
            }
#pragma unroll
            for (int r = 0; r < 17; ++r) red[(kq * 17 + r) * 64 + col] = acc[r];
            __syncthreads();
            for (int i = C.tid; i < nr * 64; i += 512) { const int r = i >> 6, cc = i & 63; float s = 0.f;
#pragma unroll
                for (int q = 0; q < 8; ++q) s += red[(q * 17 + r) * 64 + cc];
                mod[(size_t)(r0 + r) * MODW + col0 + cc] = s + bada[col0 + cc]; }
        }
        __syncthreads();
    }
    {
        lfloat* scr = (lfloat*)(C.lds + C.wave * 16384);
        const int gw = C.bid * 8 + C.wave, NGW = C.G * 8;
        unsigned char* btin8 = A.ws + WS_BTIN; bf16_t* btout = WSP(bf16_t, WS_BTOUT); bf16_t* btr = WSP(bf16_t, WS_BTR);
        constexpr int I_IN = (D / 64) * 124, I_OUT = (D / 64) * (D / 32), I_R = (D / 64) * (NE / 32), I_G = (128 / 64) * (DA / 32);
        for (int it = gw; it < I_IN + I_OUT + I_R + I_G; it += NGW) {
            int r = it;
            if (r < I_IN) {
                const int kb = r / 124, nb = r % 124, k0 = 64 * kb, n0 = 32 * nb; const float* W = A.in[I_WIN];
#pragma unroll 8
                for (int i = 0; i < 32; ++i) { const int kk = 2 * i + (C.lane >> 5); scr[kk * 33 + (C.lane & 31)] = W[(size_t)(k0 + kk) * IN_COLS + n0 + (C.lane & 31)] * SWIN; }
                asm volatile("s_waitcnt lgkmcnt(0)" ::: "memory");
                const int c = C.lane & 7;
#pragma unroll
                for (int j = 0; j < 4; ++j) { const int n = (C.lane >> 3) + 8 * j; const lfloat* s = scr + (8 * c) * 33 + n;
                    u32x2 o; o.x = pk4_fp8(s[0 * 33], s[1 * 33], s[2 * 33], s[3 * 33]); o.y = pk4_fp8(s[4 * 33], s[5 * 33], s[6 * 33], s[7 * 33]);
                    *(u32x2*)(btin8 + (size_t)(n0 + n) * D + k0 + 8 * c) = o; }
                asm volatile("s_waitcnt lgkmcnt(0)" ::: "memory");
                continue; }
            r -= I_IN;
            if (r < I_OUT) { transpose_item(A.in[I_WOUT], D, D, btout, RowId(), scr, r, C.lane); continue; } r -= I_OUT;
            if (r < I_R) { transpose_item(A.in[I_RW], D, NE, btr, RowId(), scr, r, C.lane); continue; } r -= I_R;
            transpose_item(A.in[I_GUP], 128, DA, WSP(bf16_t, WS_GUPT), RowId(), scr, r, C.lane);
        }
        for (int i = C.bid * 512 + C.tid; i < 16 * D / 4; i += C.G * 512) { const int n = 3968 + (i >> 8), k = (i & 255) * 4; const float* W = A.in[I_WIN];
            *(unsigned*)(btin8 + (size_t)n * D + k) = pk4_fp8(W[(size_t)k * IN_COLS + n] * SWIN, W[(size_t)(k + 1) * IN_COLS + n] * SWIN, W[(size_t)(k + 2) * IN_COLS + n] * SWIN, W[(size_t)(k + 3) * IN_COLS + n] * SWIN); }
        for (int i = C.bid * 512 + C.tid; i < (PLD - IN_COLS) * D / 16; i += C.G * 512) ((u32x4*)(btin8 + (size_t)IN_COLS * D))[i] = (u32x4){0u, 0u, 0u, 0u};
    }
}

__device__ __forceinline__ void phase_p1(const Args& A, Ctx& C) {
    const float* mod = WSP(float, WS_MOD); bf16_t* xn = WSP(bf16_t, WS_XN);
    const int gw = C.bid * 8 + C.wave, NGW = C.G * 8;
    for (int row = gw; row < NROWS; row += NGW) {
        const float* xr; int mb;
        if (row < NLAT) { xr = A.in[I_X] + (size_t)row * D; mb = row >> 11; } else { xr = A.in[I_CTX] + (size_t)(row - NLAT) * D; mb = 32; }
        const float* m = mod + (size_t)mb * MODW;
        norm_mod_row(xr, A.in[I_N1G], m + D, m, nullptr, C.lane, (unsigned*)(A.ws + WS_XN) + (size_t)row * (D / 4));
    }
}

__device__ __forceinline__ float bfsel(unsigned w, unsigned sh) { return __builtin_bit_cast(float, (w << sh) & 0xffff0000u); }
template <int NK>
__device__ __forceinline__ f32x4 mm_tile(const lbyte* Ap, int lda, const lbyte* Bp, int ldb, f32x4 acc, int lane) {
    const int r = lane & 15, g = lane >> 4;
#pragma unroll
    for (int ks = 0; ks < NK; ++ks) {
        const bf16x8 a = *(const LAS bf16x8*)(Ap + r * lda + ks * 64 + g * 16);
        const bf16x8 b = *(const LAS bf16x8*)(Bp + r * ldb + ks * 64 + g * 16);
        acc = __builtin_amdgcn_mfma_f32_16x16x32_bf16(a, b, acc, 0, 0, 0);
    }
    return acc;
}

__device__ __forceinline__ void st_bf16x4(lbyte* p, f32x4 v) { u32x2 w; w.x = cvtpk(v.x, v.y); w.y = cvtpk(v.z, v.w); *(LAS u32x2*)p = w; }
__device__ __forceinline__ void st_bf16(lbyte* p, float v) { *(LAS unsigned short*)p = (unsigned short)cvtpk(v, v); }
__device__ __forceinline__ float rdlane(float v, int l) { return __builtin_bit_cast(float, __builtin_amdgcn_readlane(__builtin_bit_cast(int, v), l)); }

__device__ __forceinline__ void tri_inv16(const f32x4 m, int lane, lbyte* scr, float (&X)[16]) {
    *(LAS f32x4*)(scr + (lane & 15) * 64 + (lane >> 4) * 16) = m;
    asm volatile("s_waitcnt lgkmcnt(0)" ::: "memory");
    float Mr[16];
#pragma unroll
    for (int kq = 0; kq < 4; ++kq) { const f32x4 r = *(const LAS f32x4*)(scr + (lane & 15) * 64 + kq * 16); Mr[4 * kq] = r.x; Mr[4 * kq + 1] = r.y; Mr[4 * kq + 2] = r.z; Mr[4 * kq + 3] = r.w; }
    const int l16 = lane & 15;
    X[0] = (l16 == 0) ? 1.f : 0.f;
    { float a0 = (l16 == 1) ? 1.f : 0.f, a1 = 0.f, a2 = 0.f, a3 = 0.f;
      asm("s_nop 1\n\t" "v_fmac_f32_dpp %0, -%2, %3 row_newbcast:1 row_mask:0xf bank_mask:0xf\n\t" : "+v"(a0), "+v"(a1) : "v"(Mr[0]), "v"(X[0]));
      X[1] = (a0 + a1) + (a2 + a3); }
    { float a0 = (l16 == 2) ? 1.f : 0.f, a1 = 0.f, a2 = 0.f, a3 = 0.f;
      asm("s_nop 1\n\t" "v_fmac_f32_dpp %0, -%2, %3 row_newbcast:2 row_mask:0xf bank_mask:0xf\n\t" "v_fmac_f32_dpp %1, -%4, %5 row_newbcast:2 row_mask:0xf bank_mask:0xf\n\t" : "+v"(a0), "+v"(a1) : "v"(Mr[0]), "v"(X[0]), "v"(Mr[1]), "v"(X[1]));
      X[2] = (a0 + a1) + (a2 + a3); }
    { float a0 = (l16 == 3) ? 1.f : 0.f, a1 = 0.f, a2 = 0.f, a3 = 0.f;
      asm("s_nop 1\n\t" "v_fmac_f32_dpp %0, -%2, %3 row_newbcast:3 row_mask:0xf bank_mask:0xf\n\t" "v_fmac_f32_dpp %1, -%4, %5 row_newbcast:3 row_mask:0xf bank_mask:0xf\n\t" : "+v"(a0), "+v"(a1) : "v"(Mr[0]), "v"(X[0]), "v"(Mr[1]), "v"(X[1]));
      asm("s_nop 1\n\t" "v_fmac_f32_dpp %0, -%2, %3 row_newbcast:3 row_mask:0xf bank_mask:0xf\n\t" : "+v"(a2), "+v"(a3) : "v"(Mr[2]), "v"(X[2]));
      X[3] = (a0 + a1) + (a2 + a3); }
    { float a0 = (l16 == 4) ? 1.f : 0.f, a1 = 0.f, a2 = 0.f, a3 = 0.f;
      asm("s_nop 1\n\t" "v_fmac_f32_dpp %0, -%2, %3 row_newbcast:4 row_mask:0xf bank_mask:0xf\n\t" "v_fmac_f32_dpp %1, -%4, %5 row_newbcast:4 row_mask:0xf bank_mask:0xf\n\t" : "+v"(a0), "+v"(a1) : "v"(Mr[0]), "v"(X[0]), "v"(Mr[1]), "v"(X[1]));
      asm("s_nop 1\n\t" "v_fmac_f32_dpp %0, -%2, %3 row_newbcast:4 row_mask:0xf bank_mask:0xf\n\t" "v_fmac_f32_dpp %1, -%4, %5 row_newbcast:4 row_mask:0xf bank_mask:0xf\n\t" : "+v"(a2), "+v"(a3) : "v"(Mr[2]), "v"(X[2]), "v"(Mr[3]), "v"(X[3]));
      X[4] = (a0 + a1) + (a2 + a3); }
    { float a0 = (l16 == 5) ? 1.f : 0.f, a1 = 0.f, a2 = 0.f, a3 = 0.f;
      asm("s_nop 1\n\t" "v_fmac_f32_dpp %0, -%2, %3 row_newbcast:5 row_mask:0xf bank_mask:0xf\n\t" "v_fmac_f32_dpp %1, -%4, %5 row_newbcast:5 row_mask:0xf bank_mask:0xf\n\t" "v_fmac_f32_dpp %0, -%6, %7 row_newbcast:5 row_mask:0xf bank_mask:0xf\n\t" : "+v"(a0), "+v"(a1) : "v"(Mr[0]), "v"(X[0]), "v"(Mr[1]), "v"(X[1]), "v"(Mr[4]), "v"(X[4]));
      asm("s_nop 1\n\t" "v_fmac_f32_dpp %0, -%2, %3 row_newbcast:5 row_mask:0xf bank_mask:0xf\n\t" "v_fmac_f32_dpp %1, -%4, %5 row_newbcast:5 row_mask:0xf bank_mask:0xf\n\t" : "+v"(a2), "+v"(a3) : "v"(Mr[2]), "v"(X[2]), "v"(Mr[3]), "v"(X[3]));
      X[5] = (a0 + a1) + (a2 + a3); }
    { float a0 = (l16 == 6) ? 1.f : 0.f, a1 = 0.f, a2 = 0.f, a3 = 0.f;
      asm("s_nop 1\n\t" "v_fmac_f32_dpp %0, -%2, %3 row_newbcast:6 row_mask:0xf bank_mask:0xf\n\t" "v_fmac_f32_dpp %1, -%4, %5 row_newbcast:6 row_mask:0xf bank_mask:0xf\n\t" "v_fmac_f32_dpp %0, -%6, %7 row_newbcast:6 row_mask:0xf bank_mask:0xf\n\t" "v_fmac_f32_dpp %1, -%8, %9 row_newbcast:6 row_mask:0xf bank_mask:0xf\n\t" : "+v"(a0), "+v"(a1) : "v"(Mr[0]), "v"(X[0]), "v"(Mr[1]), "v"(X[1]), "v"(Mr[4]), "v"(X[4]), "v"(Mr[5]), "v"(X[5]));
      asm("s_nop 1\n\t" "v_fmac_f32_dpp %0, -%2, %3 row_newbcast:6 row_mask:0xf bank_mask:0xf\n\t" "v_fmac_f32_dpp %1, -%4, %5 row_newbcast:6 row_mask:0xf bank_mask:0xf\n\t" : "+v"(a2), "+v"(a3) : "v"(Mr[2]), "v"(X[2]), "v"(Mr[3]), "v"(X[3]));
      X[6] = (a0 + a1) + (a2 + a3); }
    { float a0 = (l16 == 7) ? 1.f : 0.f, a1 = 0.f, a2 = 0.f, a3 = 0.f;
      asm("s_nop 1\n\t" "v_fmac_f32_dpp %0, -%2, %3 row_newbcast:7 row_mask:0xf bank_mask:0xf\n\t" "v_fmac_f32_dpp %1, -%4, %5 row_newbcast:7 row_mask:0xf bank_mask:0xf\n\t" "v_fmac_f32_dpp %0, -%6, %7 row_newbcast:7 row_mask:0xf bank_mask:0xf\n\t" "v_fmac_f32_dpp %1, -%8, %9 row_newbcast:7 row_mask:0xf bank_mask:0xf\n\t" : "+v"(a0), "+v"(a1) : "v"(Mr[0]), "v"(X[0]), "v"(Mr[1]), "v"(X[1]), "v"(Mr[4]), "v"(X[4]), "v"(Mr[5]), "v"(X[5]));
      asm("s_nop 1\n\t" "v_fmac_f32_dpp %0, -%2, %3 row_newbcast:7 row_mask:0xf bank_mask:0xf\n\t" "v_fmac_f32_dpp %1, -%4, %5 row_newbcast:7 row_mask:0xf bank_mask:0xf\n\t" "v_fmac_f32_dpp %0, -%6, %7 row_newbcast:7 row_mask:0xf bank_mask:0xf\n\t" : "+v"(a2), "+v"(a3) : "v"(Mr[2]), "v"(X[2]), "v"(Mr[3]), "v"(X[3]), "v"(Mr[6]), "v"(X[6]));
      X[7] = (a0 + a1) + (a2 + a3); }
    { float a0 = (l16 == 8) ? 1.f : 0.f, a1 = 0.f, a2 = 0.f, a3 = 0.f;
      asm("s_nop 1\n\t" "v_fmac_f32_dpp %0, -%2, %3 row_newbcast:8 row_mask:0xf bank_mask:0xf\n\t" "v_fmac_f32_dpp %1, -%4, %5 row_newbcast:8 row_mask:0xf bank_mask:0xf\n\t" "v_fmac_f32_dpp %0, -%6, %7 row_newbcast:8 row_mask:0xf bank_mask:0xf\n\t" "v_fmac_f32_dpp %1, -%8, %9 row_newbcast:8 row_mask:0xf bank_mask:0xf\n\t" : "+v"(a0), "+v"(a1) : "v"(Mr[0]), "v"(X[0]), "v"(Mr[1]), "v"(X[1]), "v"(Mr[4]), "v"(X[4]), "v"(Mr[5]), "v"(X[5]));
      asm("s_nop 1\n\t" "v_fmac_f32_dpp %0, -%2, %3 row_newbcast:8 row_mask:0xf bank_mask:0xf\n\t" "v_fmac_f32_dpp %1, -%4, %5 row_newbcast:8 row_mask:0xf bank_mask:0xf\n\t" "v_fmac_f32_dpp %0, -%6, %7 row_newbcast:8 row_mask:0xf bank_mask:0xf\n\t" "v_fmac_f32_dpp %1, -%8, %9 row_newbcast:8 row_mask:0xf bank_mask:0xf\n\t" : "+v"(a2), "+v"(a3) : "v"(Mr[2]), "v"(X[2]), "v"(Mr[3]), "v"(X[3]), "v"(Mr[6]), "v"(X[6]), "v"(Mr[7]), "v"(X[7]));
      X[8] = (a0 + a1) + (a2 + a3); }
    { float a0 = (l16 == 9) ? 1.f : 0.f, a1 = 0.f, a2 = 0.f, a3 = 0.f;
      asm("s_nop 1\n\t" "v_fmac_f32_dpp %0, -%2, %3 row_newbcast:9 row_mask:0xf bank_mask:0xf\n\t" "v_fmac_f32_dpp %1, -%4, %5 row_newbcast:9 row_mask:0xf bank_mask:0xf\n\t" "v_fmac_f32_dpp %0, -%6, %7 row_newbcast:9 row_mask:0xf bank_mask:0xf\n\t" "v_fmac_f32_dpp %1, -%8, %9 row_newbcast:9 row_mask:0xf bank_mask:0xf\n\t" "v_fmac_f32_dpp %0, -%10, %11 row_newbcast:9 row_mask:0xf bank_mask:0xf\n\t" : "+v"(a0), "+v"(a1) : "v"(Mr[0]), "v"(X[0]), "v"(Mr[1]), "v"(X[1]), "v"(Mr[4]), "v"(X[4]), "v"(Mr[5]), "v"(X[5]), "v"(Mr[8]), "v"(X[8]));
      asm("s_nop 1\n\t" "v_fmac_f32_dpp %0, -%2, %3 row_newbcast:9 row_mask:0xf bank_mask:0xf\n\t" "v_fmac_f32_dpp %1, -%4, %5 row_newbcast:9 row_mask:0xf bank_mask:0xf\n\t" "v_fmac_f32_dpp %0, -%6, %7 row_newbcast:9 row_mask:0xf bank_mask:0xf\n\t" "v_fmac_f32_dpp %1, -%8, %9 row_newbcast:9 row_mask:0xf bank_mask:0xf\n\t" : "+v"(a2), "+v"(a3) : "v"(Mr[2]), "v"(X[2]), "v"(Mr[3]), "v"(X[3]), "v"(Mr[6]), "v"(X[6]), "v"(Mr[7]), "v"(X[7]));
      X[9] = (a0 + a1) + (a2 + a3); }
    { float a0 = (l16 == 10) ? 1.f : 0.f, a1 = 0.f, a2 = 0.f, a3 = 0.f;
      asm("s_nop 1\n\t" "v_fmac_f32_dpp %0, -%2, %3 row_newbcast:10 row_mask:0xf bank_mask:0xf\n\t" "v_fmac_f32_dpp %1, -%4, %5 row_newbcast:10 row_mask:0xf bank_mask:0xf\n\t" "v_fmac_f32_dpp %0, -%6, %7 row_newbcast:10 row_mask:0xf bank_mask:0xf\n\t" "v_fmac_f32_dpp %1, -%8, %9 row_newbcast:10 row_mask:0xf bank_mask:0xf\n\t" "v_fmac_f32_dpp %0, -%10, %11 row_newbcast:10 row_mask:0xf bank_mask:0xf\n\t" "v_fmac_f32_dpp %1, -%12, %13 row_newbcast:10 row_mask:0xf bank_mask:0xf\n\t" : "+v"(a0), "+v"(a1) : "v"(Mr[0]), "v"(X[0]), "v"(Mr[1]), "v"(X[1]), "v"(Mr[4]), "v"(X[4]), "v"(Mr[5]), "v"(X[5]), "v"(Mr[8]), "v"(X[8]), "v"(Mr[9]), "v"(X[9]));
      asm("s_nop 1\n\t" "v_fmac_f32_dpp %0, -%2, %3 row_newbcast:10 row_mask:0xf bank_mask:0xf\n\t" "v_fmac_f32_dpp %1, -%4, %5 row_newbcast:10 row_mask:0xf bank_mask:0xf\n\t" "v_fmac_f32_dpp %0, -%6, %7 row_newbcast:10 row_mask:0xf bank_mask:0xf\n\t" "v_fmac_f32_dpp %1, -%8, %9 row_newbcast:10 row_mask:0xf bank_mask:0xf\n\t" : "+v"(a2), "+v"(a3) : "v"(Mr[2]), "v"(X[2]), "v"(Mr[3]), "v"(X[3]), "v"(Mr[6]), "v"(X[6]), "v"(Mr[7]), "v"(X[7]));
      X[10] = (a0 + a1) + (a2 + a3); }
    { float a0 = (l16 == 11) ? 1.f : 0.f, a1 = 0.f, a2 = 0.f, a3 = 0.f;
      asm("s_nop 1\n\t" "v_fmac_f32_dpp %0, -%2, %3 row_newbcast:11 row_mask:0xf bank_mask:0xf\n\t" "v_fmac_f32_dpp %1, -%4, %5 row_newbcast:11 row_mask:0xf bank_mask:0xf\n\t" "v_fmac_f32_dpp %0, -%6, %7 row_newbcast:11 row_mask:0xf bank_mask:0xf\n\t" "v_fmac_f32_dpp %1, -%8, %9 row_newbcast:11 row_mask:0xf bank_mask:0xf\n\t" "v_fmac_f32_dpp %0, -%10, %11 row_newbcast:11 row_mask:0xf bank_mask:0xf\n\t" "v_fmac_f32_dpp %1, -%12, %13 row_newbcast:11 row_mask:0xf bank_mask:0xf\n\t" : "+v"(a0), "+v"(a1) : "v"(Mr[0]), "v"(X[0]), "v"(Mr[1]), "v"(X[1]), "v"(Mr[4]), "v"(X[4]), "v"(Mr[5]), "v"(X[5]), "v"(Mr[8]), "v"(X[8]), "v"(Mr[9]), "v"(X[9]));
      asm("s_nop 1\n\t" "v_fmac_f32_dpp %0, -%2, %3 row_newbcast:11 row_mask:0xf bank_mask:0xf\n\t" "v_fmac_f32_dpp %1, -%4, %5 row_newbcast:11 row_mask:0xf bank_mask:0xf\n\t" "v_fmac_f32_dpp %0, -%6, %7 row_newbcast:11 row_mask:0xf bank_mask:0xf\n\t" "v_fmac_f32_dpp %1, -%8, %9 row_newbcast:11 row_mask:0xf bank_mask:0xf\n\t" "v_fmac_f32_dpp %0, -%10, %11 row_newbcast:11 row_mask:0xf bank_mask:0xf\n\t" : "+v"(a2), "+v"(a3) : "v"(Mr[2]), "v"(X[2]), "v"(Mr[3]), "v"(X[3]), "v"(Mr[6]), "v"(X[6]), "v"(Mr[7]), "v"(X[7]), "v"(Mr[10]), "v"(X[10]));
      X[11] = (a0 + a1) + (a2 + a3); }
    { float a0 = (l16 == 12) ? 1.f : 0.f, a1 = 0.f, a2 = 0.f, a3 = 0.f;
      asm("s_nop 1\n\t" "v_fmac_f32_dpp %0, -%2, %3 row_newbcast:12 row_mask:0xf bank_mask:0xf\n\t" "v_fmac_f32_dpp %1, -%4, %5 row_newbcast:12 row_mask:0xf bank_mask:0xf\n\t" "v_fmac_f32_dpp %0, -%6, %7 row_newbcast:12 row_mask:0xf bank_mask:0xf\n\t" "v_fmac_f32_dpp %1, -%8, %9 row_newbcast:12 row_mask:0xf bank_mask:0xf\n\t" "v_fmac_f32_dpp %0, -%10, %11 row_newbcast:12 row_mask:0xf bank_mask:0xf\n\t" "v_fmac_f32_dpp %1, -%12, %13 row_newbcast:12 row_mask:0xf bank_mask:0xf\n\t" : "+v"(a0), "+v"(a1) : "v"(Mr[0]), "v"(X[0]), "v"(Mr[1]), "v"(X[1]), "v"(Mr[4]), "v"(X[4]), "v"(Mr[5]), "v"(X[5]), "v"(Mr[8]), "v"(X[8]), "v"(Mr[9]), "v"(X[9]));
      asm("s_nop 1\n\t" "v_fmac_f32_dpp %0, -%2, %3 row_newbcast:12 row_mask:0xf bank_mask:0xf\n\t" "v_fmac_f32_dpp %1, -%4, %5 row_newbcast:12 row_mask:0xf bank_mask:0xf\n\t" "v_fmac_f32_dpp %0, -%6, %7 row_newbcast:12 row_mask:0xf bank_mask:0xf\n\t" "v_fmac_f32_dpp %1, -%8, %9 row_newbcast:12 row_mask:0xf bank_mask:0xf\n\t" "v_fmac_f32_dpp %0, -%10, %11 row_newbcast:12 row_mask:0xf bank_mask:0xf\n\t" "v_fmac_f32_dpp %1, -%12, %13 row_newbcast:12 row_mask:0xf bank_mask:0xf\n\t" : "+v"(a2), "+v"(a3) : "v"(Mr[2]), "v"(X[2]), "v"(Mr[3]), "v"(X[3]), "v"(Mr[6]), "v"(X[6]), "v"(Mr[7]), "v"(X[7]), "v"(Mr[10]), "v"(X[10]), "v"(Mr[11]), "v"(X[11]));
      X[12] = (a0 + a1) + (a2 + a3); }
    { float a0 = (l16 == 13) ? 1.f : 0.f, a1 = 0.f, a2 = 0.f, a3 = 0.f;
      asm("s_nop 1\n\t" "v_fmac_f32_dpp %0, -%2, %3 row_newbcast:13 row_mask:0xf bank_mask:0xf\n\t" "v_fmac_f32_dpp %1, -%4, %5 row_newbcast:13 row_mask:0xf bank_mask:0xf\n\t" "v_fmac_f32_dpp %0, -%6, %7 row_newbcast:13 row_mask:0xf bank_mask:0xf\n\t" "v_fmac_f32_dpp %1, -%8, %9 row_newbcast:13 row_mask:0xf bank_mask:0xf\n\t" "v_fmac_f32_dpp %0, -%10, %11 row_newbcast:13 row_mask:0xf bank_mask:0xf\n\t" "v_fmac_f32_dpp %1, -%12, %13 row_newbcast:13 row_mask:0xf bank_mask:0xf\n\t" "v_fmac_f32_dpp %0, -%14, %15 row_newbcast:13 row_mask:0xf bank_mask:0xf\n\t" : "+v"(a0), "+v"(a1) : "v"(Mr[0]), "v"(X[0]), "v"(Mr[1]), "v"(X[1]), "v"(Mr[4]), "v"(X[4]), "v"(Mr[5]), "v"(X[5]), "v"(Mr[8]), "v"(X[8]), "v"(Mr[9]), "v"(X[9]), "v"(Mr[12]), "v"(X[12]));
      asm("s_nop 1\n\t" "v_fmac_f32_dpp %0, -%2, %3 row_newbcast:13 row_mask:0xf bank_mask:0xf\n\t" "v_fmac_f32_dpp %1, -%4, %5 row_newbcast:13 row_mask:0xf bank_mask:0xf\n\t" "v_fmac_f32_dpp %0, -%6, %7 row_newbcast:13 row_mask:0xf bank_mask:0xf\n\t" "v_fmac_f32_dpp %1, -%8, %9 row_newbcast:13 row_mask:0xf bank_mask:0xf\n\t" "v_fmac_f32_dpp %0, -%10, %11 row_newbcast:13 row_mask:0xf bank_mask:0xf\n\t" "v_fmac_f32_dpp %1, -%12, %13 row_newbcast:13 row_mask:0xf bank_mask:0xf\n\t" : "+v"(a2), "+v"(a3) : "v"(Mr[2]), "v"(X[2]), "v"(Mr[3]), "v"(X[3]), "v"(Mr[6]), "v"(X[6]), "v"(Mr[7]), "v"(X[7]), "v"(Mr[10]), "v"(X[10]), "v"(Mr[11]), "v"(X[11]));
      X[13] = (a0 + a1) + (a2 + a3); }
    { float a0 = (l16 == 14) ? 1.f : 0.f, a1 = 0.f, a2 = 0.f, a3 = 0.f;
      asm("s_nop 1\n\t" "v_fmac_f32_dpp %0, -%2, %3 row_newbcast:14 row_mask:0xf bank_mask:0xf\n\t" "v_fmac_f32_dpp %1, -%4, %5 row_newbcast:14 row_mask:0xf bank_mask:0xf\n\t" "v_fmac_f32_dpp %0, -%6, %7 row_newbcast:14 row_mask:0xf bank_mask:0xf\n\t" "v_fmac_f32_dpp %1, -%8, %9 row_newbcast:14 row_mask:0xf bank_mask:0xf\n\t" "v_fmac_f32_dpp %0, -%10, %11 row_newbcast:14 row_mask:0xf bank_mask:0xf\n\t" "v_fmac_f32_dpp %1, -%12, %13 row_newbcast:14 row_mask:0xf bank_mask:0xf\n\t" "v_fmac_f32_dpp %0, -%14, %15 row_newbcast:14 row_mask:0xf bank_mask:0xf\n\t" "v_fmac_f32_dpp %1, -%16, %17 row_newbcast:14 row_mask:0xf bank_mask:0xf\n\t" : "+v"(a0), "+v"(a1) : "v"(Mr[0]), "v"(X[0]), "v"(Mr[1]), "v"(X[1]), "v"(Mr[4]), "v"(X[4]), "v"(Mr[5]), "v"(X[5]), "v"(Mr[8]), "v"(X[8]), "v"(Mr[9]), "v"(X[9]), "v"(Mr[12]), "v"(X[12]), "v"(Mr[13]), "v"(X[13]));
      asm("s_nop 1\n\t" "v_fmac_f32_dpp %0, -%2, %3 row_newbcast:14 row_mask:0xf bank_mask:0xf\n\t" "v_fmac_f32_dpp %1, -%4, %5 row_newbcast:14 row_mask:0xf bank_mask:0xf\n\t" "v_fmac_f32_dpp %0, -%6, %7 row_newbcast:14 row_mask:0xf bank_mask:0xf\n\t" "v_fmac_f32_dpp %1, -%8, %9 row_newbcast:14 row_mask:0xf bank_mask:0xf\n\t" "v_fmac_f32_dpp %0, -%10, %11 row_newbcast:14 row_mask:0xf bank_mask:0xf\n\t" "v_fmac_f32_dpp %1, -%12, %13 row_newbcast:14 row_mask:0xf bank_mask:0xf\n\t" : "+v"(a2), "+v"(a3) : "v"(Mr[2]), "v"(X[2]), "v"(Mr[3]), "v"(X[3]), "v"(Mr[6]), "v"(X[6]), "v"(Mr[7]), "v"(X[7]), "v"(Mr[10]), "v"(X[10]), "v"(Mr[11]), "v"(X[11]));
      X[14] = (a0 + a1) + (a2 + a3); }
    { float a0 = (l16 == 15) ? 1.f : 0.f, a1 = 0.f, a2 = 0.f, a3 = 0.f;
      asm("s_nop 1\n\t" "v_fmac_f32_dpp %0, -%2, %3 row_newbcast:15 row_mask:0xf bank_mask:0xf\n\t" "v_fmac_f32_dpp %1, -%4, %5 row_newbcast:15 row_mask:0xf bank_mask:0xf\n\t" "v_fmac_f32_dpp %0, -%6, %7 row_newbcast:15 row_mask:0xf bank_mask:0xf\n\t" "v_fmac_f32_dpp %1, -%8, %9 row_newbcast:15 row_mask:0xf bank_mask:0xf\n\t" "v_fmac_f32_dpp %0, -%10, %11 row_newbcast:15 row_mask:0xf bank_mask:0xf\n\t" "v_fmac_f32_dpp %1, -%12, %13 row_newbcast:15 row_mask:0xf bank_mask:0xf\n\t" "v_fmac_f32_dpp %0, -%14, %15 row_newbcast:15 row_mask:0xf bank_mask:0xf\n\t" "v_fmac_f32_dpp %1, -%16, %17 row_newbcast:15 row_mask:0xf bank_mask:0xf\n\t" : "+v"(a0), "+v"(a1) : "v"(Mr[0]), "v"(X[0]), "v"(Mr[1]), "v"(X[1]), "v"(Mr[4]), "v"(X[4]), "v"(Mr[5]), "v"(X[5]), "v"(Mr[8]), "v"(X[8]), "v"(Mr[9]), "v"(X[9]), "v"(Mr[12]), "v"(X[12]), "v"(Mr[13]), "v"(X[13]));
      asm("s_nop 1\n\t" "v_fmac_f32_dpp %0, -%2, %3 row_newbcast:15 row_mask:0xf bank_mask:0xf\n\t" "v_fmac_f32_dpp %1, -%4, %5 row_newbcast:15 row_mask:0xf bank_mask:0xf\n\t" "v_fmac_f32_dpp %0, -%6, %7 row_newbcast:15 row_mask:0xf bank_mask:0xf\n\t" "v_fmac_f32_dpp %1, -%8, %9 row_newbcast:15 row_mask:0xf bank_mask:0xf\n\t" "v_fmac_f32_dpp %0, -%10, %11 row_newbcast:15 row_mask:0xf bank_mask:0xf\n\t" "v_fmac_f32_dpp %1, -%12, %13 row_newbcast:15 row_mask:0xf bank_mask:0xf\n\t" "v_fmac_f32_dpp %0, -%14, %15 row_newbcast:15 row_mask:0xf bank_mask:0xf\n\t" : "+v"(a2), "+v"(a3) : "v"(Mr[2]), "v"(X[2]), "v"(Mr[3]), "v"(X[3]), "v"(Mr[6]), "v"(X[6]), "v"(Mr[7]), "v"(X[7]), "v"(Mr[10]), "v"(X[10]), "v"(Mr[11]), "v"(X[11]), "v"(Mr[14]), "v"(X[14]));
      X[15] = (a0 + a1) + (a2 + a3); }
}

#ifndef RWKV_REP
#define RWKV_REP 1
#endif
namespace rk {
constexpr int S64 = 160, S32 = 80, SW = 144;
constexpr int O_WUP = 0, O_AUP = O_WUP + 64 * SW, O_WLT = O_AUP + 64 * SW, O_ALT = O_WLT + 16 * S64, O_LW = O_ALT + 16 * S64, O_LA = O_LW + 4096,
              O_KKT = O_LA + 4096, O_RT = O_KKT + 16 * S64, O_BT = O_RT + 16 * S64, O_KDT = O_BT + 16 * S64,
              O_VT = O_KDT + 16 * S64, O_BHT = O_VT + 64 * S32, O_KHT = O_BHT + 64 * S32, O_UT = O_KHT + 64 * S32, O_UTT = O_WLT  ,
              O_TI = O_UT + 64 * S32, O_MK = O_TI + 16 * S32, O_NB = O_MK + 16 * S32, O_NK = O_NB + 16 * S32,
              O_SBF = O_NK + 16 * S32, O_WC = O_SBF + 64 * S64, O_WT = O_WC + 256, TEAM_BYTES = O_WT + 1024;
static_assert(2 * TEAM_BYTES <= LDS_MISC, "rwkv LDS");
}
__device__ __forceinline__ void rwkv_pair_chunked(const Args& A, Ctx& C, int pair) {
    using namespace rk;
    const int b = pair >> 3, h = pair & 7;
    const int dir = C.wave >> 2;
    const int t4 = C.tid & 255, q = C.wave & 3, lane = C.lane;
    lbyte* L = C.lds + dir * TEAM_BYTES;
    const bf16_t* P = WSP(bf16_t, WS_P);
    bf16_t* ydir = WSP(bf16_t, WS_YDIR) + (size_t)dir * NLAT * D;
    float* bon = WSP(float, WS_BON) + (size_t)dir * NLAT * 8;
    __syncthreads();
#pragma unroll 2
    for (int i = t4; i < 4096; i += 256) { const int l = i >> 6, c = i & 63;
        st_bf16(L + O_WUP + c * SW + l * 2, A.in[I_WUP][((size_t)dir * 64 + l) * DA + 64 * h + c]);
        st_bf16(L + O_AUP + c * SW + l * 2, A.in[I_AUP][((size_t)dir * 64 + l) * DA + 64 * h + c]); }
#pragma unroll 2
    for (int i = t4; i < (4 * 64 * S32 + 4 * 16 * S32 + 64 * S64) / 4; i += 256) ((LAS unsigned*)(L + O_VT))[i] = 0u;
    for (int i = t4; i < (2 * 16 * S64) / 4; i += 256) ((LAS unsigned*)(L + O_WLT))[i] = 0u;
    const int c = lane;
    const int col5[5] = {64 * h + c, 512 + 64 * h + c, 1024 + 64 * h + c, 1536 + 64 * dir + c, 1664 + 64 * dir + c};
    float mu5[5]; unsigned coff[5], nm[5], nlo[5], nrg[5]; int ndb[5];
#pragma unroll
    for (int e = 0; e < 5; ++e) { mu5[e] = A.in[I_MU][col5[e]]; coff[e] = (unsigned)col5[e] * 2u; }
    auto set_rules = [&](bool ctx) {
#pragma unroll
        for (int e = 0; e < 5; ++e) { const int col = col5[e];
            if (ctx) { nm[e] = 0xffffffffu; nlo[e] = col < 960 ? 1u : 0u; nrg[e] = (unsigned)(CTX - 2); ndb[e] = (col < 960 ? -PLD : PLD) * 2; }
            else { const int cls = col < 480 ? 0 : (col < 960 ? 1 : (col < 1440 ? 2 : 3));
                nm[e] = cls < 2 ? 63u : 0xffffffffu; nlo[e] = cls == 0 ? 1u : (cls == 2 ? 64u : 0u); nrg[e] = cls < 2 ? 62u : (unsigned)(SEQ - 65);
                ndb[e] = (cls == 0 ? -PLD : (cls == 1 ? PLD : (cls == 2 ? -64 * PLD : 64 * PLD))) * 2; } } };
    set_rules(true);
    const char* wsb = (const char*)A.ws;
    const float kkc = A.in[I_KK][64 * h + c], kac = A.in[I_KA][64 * h + c], rkc = A.in[I_RK][64 * h + c];
    const float w0c = A.in[I_W0][dir * DA + 64 * h + c], a0c = A.in[I_A0][dir * DA + 64 * h + c];
    f32x4 Sacc[4];
#pragma unroll
    for (int i = 0; i < 4; ++i) Sacc[i] = (f32x4){0.f, 0.f, 0.f, 0.f};
    const int fr = lane & 15, fg = lane >> 4;
    unsigned short rawp[4][5], raws[4][5];
    auto chunk_geom = [&](int ch, bool& isctx, int& sbase, int& T, size_t& rowbase) { isctx = ch < 16; sbase = isctx ? ch * 16 : (ch - 16) * 16; T = isctx ? CTX : SEQ; rowbase = isctx ? (size_t)NLAT + (size_t)b * CTX : (size_t)b * SEQ; };
    auto issue_loads = [&](int ch) { bool isctx; int sbase, T; size_t rowbase; chunk_geom(ch, isctx, sbase, T, rowbase);
#pragma unroll
        for (int j = 0; j < 4; ++j) { const int i = 4 * q + j; const int t = __builtin_amdgcn_readfirstlane(dir ? (T - 1 - (sbase + i)) : (sbase + i));
            const unsigned rowoff = (unsigned)WS_P + (unsigned)(rowbase + t) * (unsigned)(PLD * 2);
#pragma unroll
            for (int e = 0; e < 5; ++e) { const unsigned vs = rowoff + coff[e]; const bool ok = (((unsigned)t & nm[e]) - nlo[e]) <= nrg[e]; const unsigned vn = ok ? vs + (unsigned)ndb[e] : 8u;
                rawp[j][e] = *(const bf16_t*)(wsb + vs); raws[j][e] = *(const bf16_t*)(wsb + vn); } } };
    u32x2 ypend; ypend.x = 0u; ypend.y = 0u; float bpend[4] = {0.f, 0.f, 0.f, 0.f};
    auto flush = [&](int pch) { bool pisctx; int psb, pT; size_t prb; chunk_geom(pch, pisctx, psb, pT, prb);
        if (!pisctx) { const int t = dir ? (pT - 1 - (psb + fr)) : (psb + fr);
            *(u32x2*)(ydir + ((size_t)b * SEQ + t) * D + 64 * h + 16 * q + 4 * fg) = ypend;
            if (lane == 0) {
#pragma unroll
                for (int j = 0; j < 4; ++j) { const int i = 4 * q + j; const int tj = dir ? (pT - 1 - (psb + i)) : (psb + i); bon[((size_t)b * SEQ + tj) * 8 + h] = bpend[j]; } } } };
    issue_loads(0);
    for (int ch = 0; ch < 144; ++ch) {
        bool isctx; int sbase, T; size_t rowbase; chunk_geom(ch, isctx, sbase, T, rowbase);
        float vr[4], vk[4], vv[4], vkk[4], lw[4], av[4];
        __syncthreads();
        float mxa[4][5];
#pragma unroll
        for (int j = 0; j < 4; ++j) {
#pragma unroll
            for (int e = 0; e < 5; ++e) { const float pv = bf2f(rawp[j][e]); const float sv = bf2f(raws[j][e]); mxa[j][e] = pv + mu5[e] * (sv - pv); } }
        asm volatile("" :: "v"(mxa[0][0]), "v"(mxa[0][1]), "v"(mxa[0][2]), "v"(mxa[0][3]), "v"(mxa[0][4]), "v"(mxa[1][0]), "v"(mxa[1][1]), "v"(mxa[1][2]), "v"(mxa[1][3]), "v"(mxa[1][4]),
                        "v"(mxa[2][0]), "v"(mxa[2][1]), "v"(mxa[2][2]), "v"(mxa[2][3]), "v"(mxa[2][4]), "v"(mxa[3][0]), "v"(mxa[3][1]), "v"(mxa[3][2]), "v"(mxa[3][3]), "v"(mxa[3][4]) : "memory");
        if (ch > 0) flush(ch - 1);
        if (ch == 15) set_rules(false);
        if (ch + 1 < 144) issue_loads(ch + 1);
        float cl[4];
        _Pragma("unroll") for (int rrep = 0; rrep < RWKV_REP; ++rrep) {
#pragma unroll
        for (int j = 0; j < 4; ++j) {
            const int i = 4 * q + j;
            float mx[5];
#pragma unroll
            for (int e = 0; e < 5; ++e) mx[e] = mxa[j][e];
            vr[j] = mx[0]; vk[j] = mx[1]; vv[j] = mx[2];
            *(LAS unsigned short*)(L + O_WLT + i * S64 + c * 2) = (unsigned short)cvtpk(tanhf_(mx[3]), 0.f); *(LAS unsigned short*)(L + O_ALT + i * S64 + c * 2) = (unsigned short)cvtpk(mx[4], 0.f);
            const float kx = vk[j] * kkc; const float ss = wave_sum(kx * kx);
            vkk[j] = kx * __builtin_amdgcn_rsqf(ss + 1e-6f);
        }
        __syncthreads();
        {
            const f32x4 z = (f32x4){0.f, 0.f, 0.f, 0.f};
            const f32x4 tw = mm_tile<2>(L + O_WLT, S64, L + O_WUP + 16 * q * SW, SW, z, lane);
            const f32x4 ta = mm_tile<2>(L + O_ALT, S64, L + O_AUP + 16 * q * SW, SW, z, lane);
#pragma unroll
            for (int e = 0; e < 4; ++e) { ((LAS float*)(L + O_LW))[(4 * fg + e) * 64 + 16 * q + fr] = tw[e]; ((LAS float*)(L + O_LA))[(4 * fg + e) * 64 + 16 * q + fr] = ta[e]; }
        }
        __syncthreads();
        { float run = 0.f;
#pragma unroll
        for (int j = 0; j < 4; ++j) { const int i = 4 * q + j;
            const float wlog = -softplusf_(-(w0c + ((LAS float*)(L + O_LW))[i * 64 + c])) - 0.5f;
            lw[j] = -__expf(wlog);
            av[j] = sigmoidf_(a0c + ((LAS float*)(L + O_LA))[i * 64 + c]);
            run += lw[j]; cl[j] = run; }
        ((LAS float*)(L + O_WT))[q * 64 + c] = run; }
        __syncthreads();
        }
        {
            float off = 0.f, cumC = 0.f;
#pragma unroll
            for (int qq = 0; qq < 4; ++qq) { const float tv = ((LAS float*)(L + O_WT))[qq * 64 + c]; cumC += tv; off += (qq < q) ? tv : 0.f; }
            float tv_[4], tb_[4], tk_[4];
            float Wprev = __expf(off); const float eC = __expf(cumC);
#pragma unroll
            for (int j = 0; j < 4; ++j) { const int i = 4 * q + j;
                const float cum = off + cl[j];
                const float Wt = __expf(cum), Wp = Wprev, Wi = __builtin_amdgcn_rcpf(Wt), Wc = eC * Wi; Wprev = Wt;
                const float kd = vk[j] * (1.f + (av[j] - 1.f) * kac), bb = vkk[j] * av[j];
                const unsigned p0 = cvtpk(vkk[j] * Wp, vr[j] * Wt), p1 = cvtpk(bb * Wi, kd * Wi);
                *(LAS unsigned short*)(L + O_KKT + i * S64 + c * 2) = (unsigned short)p0; *(LAS unsigned short*)(L + O_RT + i * S64 + c * 2) = (unsigned short)(p0 >> 16);
                *(LAS unsigned short*)(L + O_BT + i * S64 + c * 2) = (unsigned short)p1; *(LAS unsigned short*)(L + O_KDT + i * S64 + c * 2) = (unsigned short)(p1 >> 16);
                tv_[j] = vv[j]; tb_[j] = bb * Wc; tk_[j] = kd * Wc;
                const float bs = wave_sum(vr[j] * kd * rkc);
                bpend[j] = bs;
            }
            { u32x2 w2;
                w2.x = cvtpk(tv_[0], tv_[1]); w2.y = cvtpk(tv_[2], tv_[3]); *(LAS u32x2*)(L + O_VT + c * S32 + q * 8) = w2;
                w2.x = cvtpk(tb_[0], tb_[1]); w2.y = cvtpk(tb_[2], tb_[3]); *(LAS u32x2*)(L + O_BHT + c * S32 + q * 8) = w2;
                w2.x = cvtpk(tk_[0], tk_[1]); w2.y = cvtpk(tk_[2], tk_[3]); *(LAS u32x2*)(L + O_KHT + c * S32 + q * 8) = w2; }
            if (q == 3) ((LAS float*)(L + O_WC))[c] = eC;
        }
        __syncthreads();
        {
            const int role = (q + dir) & 3;
            const lbyte* Aj = L + ((role & 1) ? O_KDT : O_BT);
            const lbyte* Bt = L + ((role & 2) ? O_RT : O_KKT);
            f32x4 g4 = mm_tile<2>(Aj, S64, Bt, S64, (f32x4){0.f, 0.f, 0.f, 0.f}, lane);
#pragma unroll
            for (int e = 0; e < 4; ++e) { const int j = 4 * fg + e; const bool keep = (role & 2) ? (j <= fr) : (j < fr); g4[e] = keep ? g4[e] : 0.f; }
            if (role == 0) { float X[16]; tri_inv16(g4, lane, L + O_LW, X);
                if (lane < 16) {
#pragma unroll
                    for (int i = 0; i < 16; ++i) *(LAS unsigned short*)(L + O_TI + i * S32 + lane * 2) = (unsigned short)cvtpk(X[i], 0.f); } }
            else st_bf16x4(L + (role == 1 ? O_MK : (role == 2 ? O_NB : O_NK)) + fr * S32 + fg * 8, g4);
        }
        __syncthreads();
        f32x4 yacc;
        {
            f32x4 u4 = mm_tile<2>(L + O_KKT, S64, L + O_SBF + 16 * q * S64, S64, (f32x4){0.f, 0.f, 0.f, 0.f}, lane);
            u4 = mm_tile<1>(L + O_MK, S32, L + O_VT + 16 * q * S32, S32, u4, lane);
            st_bf16x4(L + O_UTT + (16 * q + fr) * S32 + fg * 8, u4);
            yacc = mm_tile<2>(L + O_SBF + 16 * q * S64, S64, L + O_RT, S64, (f32x4){0.f, 0.f, 0.f, 0.f}, lane);
            yacc = mm_tile<1>(L + O_VT + 16 * q * S32, S32, L + O_NK, S32, yacc, lane);
        }
        asm volatile("s_waitcnt lgkmcnt(0)" ::: "memory");
        {
            f32x4 u4 = mm_tile<1>(L + O_TI, S32, L + O_UTT + 16 * q * S32, S32, (f32x4){0.f, 0.f, 0.f, 0.f}, lane);
            st_bf16x4(L + O_UT + (16 * q + fr) * S32 + fg * 8, -u4);
        }
        __syncthreads();
        {
            yacc = mm_tile<1>(L + O_UT + 16 * q * S32, S32, L + O_NB, S32, yacc, lane);
            ypend.x = cvtpk(yacc[0], yacc[1]); ypend.y = cvtpk(yacc[2], yacc[3]);
            const f32x4 wc4 = *(LAS f32x4*)(L + O_WC + (16 * q + 4 * fg) * 4);
#pragma unroll
            for (int vi = 0; vi < 4; ++vi) {
                f32x4 s4 = Sacc[vi] * wc4;
                s4 = mm_tile<1>(L + O_KHT + 16 * q * S32, S32, L + O_VT + 16 * vi * S32, S32, s4, lane);
                s4 = mm_tile<1>(L + O_BHT + 16 * q * S32, S32, L + O_UT + 16 * vi * S32, S32, s4, lane);
                Sacc[vi] = s4;
                st_bf16x4(L + O_SBF + (16 * vi + fr) * S64 + (16 * q + 4 * fg) * 2, s4);
            }
        }
    }
    flush(143);
    __syncthreads();
}

__device__ __forceinline__ void phase_gdn_prep(const Args& A, Ctx& C) {
    const bf16_t* P = WSP(bf16_t, WS_P);
    bf16_t* QKV = (bf16_t*)A.out; float* NRM = WSP(float, WS_NRM);
    lfloat* part = (lfloat*)C.lds;
    const int tid = C.tid, lane = C.lane, w = C.wave;
    float cw[3][5];
#pragma unroll
    for (int g = 0; g < 3; ++g)
#pragma unroll
        for (int e = 0; e < 5; ++e) cw[g][e] = A.in[I_CONVW][e * 1536 + g * 512 + tid];
    for (int tile = C.bid; tile < NROWS / 16; tile += C.G) {
        const int row0 = tile * 16;
        int T, ta; size_t rowbase;
        if (row0 < NLAT) { T = SEQ; rowbase = (size_t)(row0 >> 11) * SEQ; ta = row0 & (SEQ - 1); } else { T = CTX; const int r = row0 - NLAT; rowbase = (size_t)NLAT + (size_t)(r >> 8) * CTX; ta = r & (CTX - 1); }
        float x[3][20];
#pragma unroll
        for (int e = 0; e < 20; ++e) { const int t = ta - 2 + e; const bool ok = (t >= 0 && t < T); const bf16_t* pr = P + (rowbase + (ok ? t : ta)) * PLD + RW_COLS + tid;
#pragma unroll
            for (int g = 0; g < 3; ++g) { const float xv = bf2f(pr[g * 512]); x[g][e] = ok ? xv : 0.f; } }
        __syncthreads();
#pragma unroll
        for (int i = 0; i < 16; ++i) { float y[3];
#pragma unroll
            for (int g = 0; g < 3; ++g) { float sacc = 0.f;
#pragma unroll
                for (int f = 0; f < 5; ++f) sacc += cw[g][f] * x[g][i + f];
                y[g] = siluf_(sacc); }
            bf16_t* orow = QKV + (rowbase + ta + i) * 1536 + tid;
            orow[0] = (bf16_t)cvtpk(y[0], 0.f); orow[512] = (bf16_t)cvtpk(y[1], 0.f); orow[1024] = (bf16_t)cvtpk(y[2], 0.f);
            const float sq = wave_sum(y[0] * y[0]), sk = wave_sum(y[1] * y[1]);
            if (lane == 0) { part[(i * 8 + w) * 2] = sq; part[(i * 8 + w) * 2 + 1] = sk; } }
        __syncthreads();
        if (tid < 128) { const int i = tid >> 3, sidx = tid & 7, h = sidx & 3, sel = sidx >> 2;
            const float ss = part[(i * 8 + 2 * h) * 2 + sel] + part[(i * 8 + 2 * h + 1) * 2 + sel];
            NRM[(rowbase + ta + i) * 8 + sidx] = __builtin_amdgcn_rsqf(ss + 1e-6f) * (sel ? 1.f : 0.08838834764831845f); }
    }
    __syncthreads();
}

namespace gd {
constexpr int S128 = 288, S32 = 80;
constexpr int O_KT = 0, O_QT = O_KT + 32 * S128, O_KKT = O_QT + 32 * S128, O_RT = O_KKT + 32 * S128,
              O_VT = O_RT + 32 * S128, O_BHT = O_VT + 128 * S32, O_KHT = O_BHT + 128 * S32, O_UT = O_KHT + 128 * S32, O_UTT = O_UT + 128 * S32,
              O_TI = O_UTT + 128 * S32, O_MK = O_TI + 32 * S32, O_NB = O_MK + 32 * S32, O_NK = O_NB + 32 * S32,
              O_M21 = O_NK + 32 * S32, O_T11T = O_M21 + 16 * S32, O_T22 = O_T11T + 16 * S32, O_XT = O_T22 + 16 * S32,
              O_SBF = O_XT + 16 * S32, O_SC = O_SBF + 128 * S128, O_MS = O_SC + 512, GD_BYTES = O_MS + 2048;
static_assert(GD_BYTES <= LDS_MISC, "gdn LDS");
}
__device__ __forceinline__ void gdn_chain_chunked(const Args& A, Ctx& C, int chain) {
    using namespace gd;
    const int b = chain >> 3, h = (chain >> 1) & 3, dir = chain & 1;
    lbyte* L = C.lds;
    LAS float* SC = (LAS float*)(L + O_SC);
    const bf16_t* P = WSP(bf16_t, WS_P);
    bf16_t* ydir = WSP(bf16_t, WS_YDIR) + (size_t)dir * NLAT * D;
    const int tid = C.tid, lane = C.lane, w = C.wave, fr = lane & 15, fg = lane >> 4;
    const int grp = w >> 1, idx = tid & 127;
    const float Aexp = __expf(A.in[I_ALOG][dir * 4 + h]), dtb = A.in[I_DTB][dir * 4 + h];
    const f32x4 z4 = (f32x4){0.f, 0.f, 0.f, 0.f};
    __syncthreads();
#pragma unroll 2
    for (int i = tid; i < (O_SC - O_VT) / 4; i += 512) ((LAS unsigned*)(L + O_VT))[i] = 0u;
    f32x4 Sacc[8];
#pragma unroll
    for (int i = 0; i < 8; ++i) Sacc[i] = z4;
    const bf16_t* QKV = (const bf16_t*)A.out; const float* NRM = WSP(const float, WS_NRM);
    unsigned rq[8], rk[8], rv[8]; float nq[8], nk[8]; unsigned raw_al = 0, raw_be = 0;
    const unsigned codd = (idx & 1) ? 0u : 16u, godd = (h & 1) ? 0u : 16u;
    auto chunk_geom = [&](int ch, bool& isctx, int& sbase, int& T, size_t& rowbase) { isctx = ch < 8; sbase = isctx ? ch * 32 : (ch - 8) * 32; T = isctx ? CTX : SEQ;
        rowbase = isctx ? (size_t)NLAT + (size_t)b * CTX : (size_t)b * SEQ; };
    auto issue_loads = [&](int ch) { bool isctx; int sbase, T; size_t rowbase; chunk_geom(ch, isctx, sbase, T, rowbase);
#pragma unroll
        for (int j = 0; j < 8; ++j) { const int i = 8 * grp + j; const int t = dir ? (T - 1 - (sbase + i)) : (sbase + i); const size_t row = rowbase + t;
            const unsigned* qr = (const unsigned*)(QKV + row * 1536 + 128 * h + (idx & ~1)); rq[j] = qr[0]; rk[j] = qr[256]; rv[j] = qr[512]; nq[j] = NRM[row * 8 + h]; nk[j] = NRM[row * 8 + 4 + h]; }
        if (w == 7 && lane < 32) { const int t = dir ? (T - 1 - (sbase + lane)) : (sbase + lane); const unsigned* pr = (const unsigned*)(P + (rowbase + t) * PLD + RW_COLS + 2048 + ((dir * 4 + h) & ~1)); raw_al = pr[0]; raw_be = pr[4]; } };
    u32x2 ypend[2]; ypend[0].x = ypend[0].y = ypend[1].x = ypend[1].y = 0u;
    auto flush = [&](int pch) { bool pisctx; int psb, pT; size_t prb; chunk_geom(pch, pisctx, psb, pT, prb);
        if (!pisctx) {
#pragma unroll
            for (int tb = 0; tb < 2; ++tb) { const int tl = psb + tb * 16 + fr; const int t = dir ? (pT - 1 - tl) : tl;
                *(u32x2*)(ydir + ((size_t)b * SEQ + t) * D + 512 + 128 * h + 16 * w + 4 * fg) = ypend[tb]; } } };
    issue_loads(0);
    for (int ch = 0; ch < 72; ++ch) {
        bool isctx; int sbase, T; size_t rowbase; chunk_geom(ch, isctx, sbase, T, rowbase);
        __syncthreads();
        float qv[8], kv[8], vv[8], nqv[8], nkv[8];
#pragma unroll
        for (int j = 0; j < 8; ++j) { qv[j] = bfsel(rq[j], codd); kv[j] = bfsel(rk[j], codd); vv[j] = bfsel(rv[j], codd); nqv[j] = nq[j]; nkv[j] = nk[j]; }
        if (w == 7) {
            const float gi = (lane < 32) ? -Aexp * softplusf_(bfsel(raw_al, godd) + dtb) : 0.f;
            float cum = gi;
            cum += __builtin_bit_cast(float, __builtin_amdgcn_update_dpp(0, __builtin_bit_cast(int, cum), 0x111, 0xf, 0xf, true));
            cum += __builtin_bit_cast(float, __builtin_amdgcn_update_dpp(0, __builtin_bit_cast(int, cum), 0x112, 0xf, 0xf, true));
            cum += __builtin_bit_cast(float, __builtin_amdgcn_update_dpp(0, __builtin_bit_cast(int, cum), 0x114, 0xf, 0xf, true));
            cum += __builtin_bit_cast(float, __builtin_amdgcn_update_dpp(0, __builtin_bit_cast(int, cum), 0x118, 0xf, 0xf, true));
            const float r0 = rdlane(cum, 15);
            cum += (lane >= 16) ? r0 : 0.f;
            if (lane < 32) { SC[lane] = sigmoidf_(bfsel(raw_be, godd)); SC[32 + lane + 1] = cum; if (lane == 0) SC[32] = 0.f; }
        }
        asm volatile("" :: "v"(qv[0]), "v"(qv[1]), "v"(qv[2]), "v"(qv[3]), "v"(qv[4]), "v"(qv[5]), "v"(qv[6]), "v"(qv[7]), "v"(kv[0]), "v"(kv[1]), "v"(kv[2]), "v"(kv[3]), "v"(kv[4]), "v"(kv[5]), "v"(kv[6]), "v"(kv[7]),
                        "v"(vv[0]), "v"(vv[1]), "v"(vv[2]), "v"(vv[3]), "v"(vv[4]), "v"(vv[5]), "v"(vv[6]), "v"(vv[7]) : "memory");
        asm volatile("" :: "v"(nqv[0]), "v"(nqv[1]), "v"(nqv[2]), "v"(nqv[3]), "v"(nqv[4]), "v"(nqv[5]), "v"(nqv[6]), "v"(nqv[7]), "v"(nkv[0]), "v"(nkv[1]), "v"(nkv[2]), "v"(nkv[3]), "v"(nkv[4]), "v"(nkv[5]), "v"(nkv[6]), "v"(nkv[7]),
                        "v"(raw_al), "v"(raw_be) : "memory");
        if (ch > 0) flush(ch - 1);
        if (ch + 1 < 72) issue_loads(ch + 1);
        __syncthreads();
        {
            const int c = idx; const float gcC = SC[32 + 32];
            float bh[8], kh[8];
#pragma unroll
            for (int j = 0; j < 8; ++j) { const int i = 8 * grp + j;
                const float kn = kv[j] * nkv[j], qn = qv[j] * nqv[j];
                const float gm = SC[32 + i], gi = SC[32 + i + 1], be = SC[i];
                const unsigned p0 = cvtpk(kn, qn), p1 = cvtpk(kn * __expf(gm), qn * __expf(gi));
                *(LAS unsigned short*)(L + O_KT + i * S128 + c * 2) = (unsigned short)p0; *(LAS unsigned short*)(L + O_QT + i * S128 + c * 2) = (unsigned short)(p0 >> 16);
                *(LAS unsigned short*)(L + O_KKT + i * S128 + c * 2) = (unsigned short)p1; *(LAS unsigned short*)(L + O_RT + i * S128 + c * 2) = (unsigned short)(p1 >> 16);
                bh[j] = be * kn * __expf(gcC - gm); kh[j] = be * kn * __expf(gcC - gi); }
            u32x4 w4;
            w4.x = cvtpk(bh[0], bh[1]); w4.y = cvtpk(bh[2], bh[3]); w4.z = cvtpk(bh[4], bh[5]); w4.w = cvtpk(bh[6], bh[7]); *(LAS u32x4*)(L + O_BHT + c * S32 + grp * 16) = w4;
            w4.x = cvtpk(kh[0], kh[1]); w4.y = cvtpk(kh[2], kh[3]); w4.z = cvtpk(kh[4], kh[5]); w4.w = cvtpk(kh[6], kh[7]); *(LAS u32x4*)(L + O_KHT + c * S32 + grp * 16) = w4;
            w4.x = cvtpk(vv[0], vv[1]); w4.y = cvtpk(vv[2], vv[3]); w4.z = cvtpk(vv[4], vv[5]); w4.w = cvtpk(vv[6], vv[7]); *(LAS u32x4*)(L + O_VT + c * S32 + grp * 16) = w4;
        }
        __syncthreads();
        {
            const int isq = w >> 2, tb = (w >> 1) & 1, jb = w & 1;
            if (jb <= tb) {
                const f32x4 g4 = mm_tile<4>(L + O_KT + jb * 16 * S128, S128, L + (isq ? O_QT : O_KT) + tb * 16 * S128, S128, z4, lane);
                const int t = tb * 16 + fr;
                const float gt = SC[32 + t + isq];
                f32x4 m0, m1;
#pragma unroll
                for (int e = 0; e < 4; ++e) { const int j = jb * 16 + 4 * fg + e; const bool keep = isq ? (j <= t) : (j < t);
                    const float bj = SC[j] * g4[e];
                    m0[e] = keep ? bj * __expf(gt - SC[32 + j]) : 0.f;
                    m1[e] = keep ? bj * __expf(gt - SC[32 + j + 1]) : 0.f; }
                const int off = t * S32 + (jb * 16 + 4 * fg) * 2;
                if (isq) { st_bf16x4(L + O_NB + off, m0); st_bf16x4(L + O_NK + off, m1); }
                else {
                    st_bf16x4(L + O_MK + off, m1);
                    if (tb != jb) st_bf16x4(L + O_M21 + fr * S32 + fg * 8, m0);
                    else { float X[16]; tri_inv16(m0, lane, L + O_MS + tb * 1024, X);
                        if (lane < 16) {
#pragma unroll
                            for (int i = 0; i < 16; ++i) *(LAS unsigned short*)(L + O_TI + (tb * 16 + i) * S32 + (tb * 16 + lane) * 2) = (unsigned short)cvtpk(X[i], 0.f);
                            if (tb == 0) { u32x4 a0, a1;
                                a0.x = cvtpk(X[0], X[1]); a0.y = cvtpk(X[2], X[3]); a0.z = cvtpk(X[4], X[5]); a0.w = cvtpk(X[6], X[7]);
                                a1.x = cvtpk(X[8], X[9]); a1.y = cvtpk(X[10], X[11]); a1.z = cvtpk(X[12], X[13]); a1.w = cvtpk(X[14], X[15]);
                                *(LAS u32x4*)(L + O_T11T + lane * S32) = a0; *(LAS u32x4*)(L + O_T11T + lane * S32 + 16) = a1; }
                            else {
#pragma unroll
                                for (int i = 0; i < 16; ++i) *(LAS unsigned short*)(L + O_T22 + i * S32 + lane * 2) = (unsigned short)cvtpk(X[i], 0.f); }
                        } }
                }
            }
        }
        __syncthreads();
        if (w == 1) {
            const f32x4 x4 = mm_tile<1>(L + O_M21, S32, L + O_T11T, S32, z4, lane);
            st_bf16x4(L + O_XT + fr * S32 + fg * 8, x4);
            asm volatile("s_waitcnt lgkmcnt(0)" ::: "memory");
            const f32x4 t4 = mm_tile<1>(L + O_XT, S32, L + O_T22, S32, z4, lane);
            st_bf16x4(L + O_TI + (16 + fr) * S32 + fg * 8, -t4);
        }
        f32x4 yacc[2];
#pragma unroll
        for (int tb = 0; tb < 2; ++tb) {
            f32x4 u4 = mm_tile<4>(L + O_KKT + tb * 16 * S128, S128, L + O_SBF + 16 * w * S128, S128, z4, lane);
            u4 = mm_tile<1>(L + O_MK + tb * 16 * S32, S32, L + O_VT + 16 * w * S32, S32, u4, lane);
            st_bf16x4(L + O_UTT + (16 * w + fr) * S32 + tb * 32 + fg * 8, u4);
            yacc[tb] = mm_tile<4>(L + O_SBF + 16 * w * S128, S128, L + O_RT + tb * 16 * S128, S128, z4, lane);
            yacc[tb] = mm_tile<1>(L + O_VT + 16 * w * S32, S32, L + O_NK + tb * 16 * S32, S32, yacc[tb], lane);
        }
        __syncthreads();
#pragma unroll
        for (int tb = 0; tb < 2; ++tb) {
            const f32x4 u4 = mm_tile<1>(L + O_TI + tb * 16 * S32, S32, L + O_UTT + 16 * w * S32, S32, z4, lane);
            st_bf16x4(L + O_UT + (16 * w + fr) * S32 + tb * 32 + fg * 8, -u4);
        }
        __syncthreads();
        {
#pragma unroll
            for (int tb = 0; tb < 2; ++tb) {
                yacc[tb] = mm_tile<1>(L + O_UT + 16 * w * S32, S32, L + O_NB + tb * 16 * S32, S32, yacc[tb], lane);
                ypend[tb].x = cvtpk(yacc[tb][0], yacc[tb][1]); ypend[tb].y = cvtpk(yacc[tb][2], yacc[tb][3]);
            }
            const float wc = __expf(SC[32 + 32]);
#pragma unroll
            for (int vi = 0; vi < 8; ++vi) {
                f32x4 s4 = Sacc[vi] * wc;
                s4 = mm_tile<1>(L + O_KHT + 16 * w * S32, S32, L + O_VT + 16 * vi * S32, S32, s4, lane);
                s4 = mm_tile<1>(L + O_BHT + 16 * w * S32, S32, L + O_UT + 16 * vi * S32, S32, s4, lane);
                Sacc[vi] = s4;
                st_bf16x4(L + O_SBF + (16 * vi + fr) * S128 + (16 * w + 4 * fg) * 2, s4);
            }
        }
    }
    flush(71);
    __syncthreads();
}

__device__ __forceinline__ void unpack8(const u32x4 w, float (&f)[8]) { f[0] = bflo(w.x); f[1] = bfhi(w.x); f[2] = bflo(w.y); f[3] = bfhi(w.y); f[4] = bflo(w.z); f[5] = bfhi(w.z); f[6] = bflo(w.w); f[7] = bfhi(w.w); }
__device__ __forceinline__ void phase_p4(const Args& A, Ctx& C) {
    const bf16_t* P = WSP(bf16_t, WS_P);
    const bf16_t* yf = WSP(bf16_t, WS_YDIR); const bf16_t* yb = yf + (size_t)NLAT * D;
    const float* bon = WSP(float, WS_BON);
    bf16_t* ymix = WSP(bf16_t, WS_YMIX);
    lbyte* SGb = C.lds;
    lfloat* GO = (lfloat*)(C.lds + 8192);
    const int tid = C.tid, lane = C.lane, w = C.wave;
    const bf16_t* gupt = WSP(const bf16_t, WS_GUPT);
    const int fr = lane & 15, fg = lane >> 4;
    const int c8 = 8 * lane;
    float lnw[8], lnb[8], ong[8], muv[8];
#pragma unroll
    for (int e = 0; e < 8; ++e) { lnw[e] = A.in[I_LNW][c8 + e]; lnb[e] = A.in[I_LNB][c8 + e]; ong[e] = A.in[I_ONG][(c8 + e) & 127]; muv[e] = A.in[I_MU][1024 + c8 + e]; }
    const int tkA = tid >> 5, lA = 4 * (tid & 31);
    float muA[4];
#pragma unroll
    for (int e = 0; e < 4; ++e) muA[e] = A.in[I_MU][1792 + lA + e];
    const bool vup = (1024 + c8) < 1440;
    for (int tile = C.bid; tile < NLAT / 16; tile += C.G) {
        const int row0 = tile * 16;
        __syncthreads();
        {
            const int row = row0 + tkA, t = row & (SEQ - 1); const bool ok = t < SEQ - 64;
            const u32x2 pw = *(const u32x2*)(P + (size_t)row * PLD + 1792 + lA); const u32x2 sw = *(const u32x2*)(P + (size_t)(row + (ok ? 64 : 0)) * PLD + 1792 + lA);
            const float pv[4] = {bflo(pw.x), bfhi(pw.x), bflo(pw.y), bfhi(pw.y)}; const float sv[4] = {bflo(sw.x), bfhi(sw.x), bflo(sw.y), bfhi(sw.y)};
            float o[4];
#pragma unroll
            for (int e = 0; e < 4; ++e) o[e] = sigmoidf_(pv[e] + muA[e] * ((ok ? sv[e] : 0.f) - pv[e]));
            u32x2 ow; ow.x = cvtpk(o[0], o[1]); ow.y = cvtpk(o[2], o[3]); *(LAS u32x2*)(SGb + tkA * 288 + lA * 2) = ow;
        }
        __syncthreads();
#pragma unroll
        for (int i = 0; i < 4; ++i) { const int c0 = 64 * w + 16 * i; f32x4 acc = (f32x4){0.f, 0.f, 0.f, 0.f};
#pragma unroll
            for (int ks = 0; ks < 4; ++ks) { const bf16x8 a = *(const LAS bf16x8*)(SGb + fr * 288 + ks * 64 + fg * 16);
                const bf16x8 bq = *(const bf16x8*)(gupt + (size_t)(c0 + fr) * 128 + ks * 32 + fg * 8);
                acc = __builtin_amdgcn_mfma_f32_16x16x32_bf16(a, bq, acc, 0, 0, 0); }
#pragma unroll
            for (int e = 0; e < 4; ++e) GO[(4 * fg + e) * 512 + c0 + fr] = acc[e]; }
        __syncthreads();
#pragma unroll
        for (int tt = 0; tt < 2; ++tt) {
            const int tk = 2 * w + tt, row = row0 + tk, t = row & (SEQ - 1);
            const bool okv = vup ? (t >= 64) : (t < SEQ - 64);
            const u32x4 wyf = *(const u32x4*)(yf + (size_t)row * D + c8), wyb = *(const u32x4*)(yb + (size_t)row * D + c8);
            const u32x4 wpv = *(const u32x4*)(P + (size_t)row * PLD + 1024 + c8), wsv = *(const u32x4*)(P + (size_t)(row + (okv ? (vup ? -64 : 64) : 0)) * PLD + 1024 + c8);
            const u32x4 wof = *(const u32x4*)(yf + (size_t)row * D + 512 + c8), wob = *(const u32x4*)(yb + (size_t)row * D + 512 + c8);
            const u32x4 wz = *(const u32x4*)(P + (size_t)row * PLD + RW_COLS + 1536 + c8);
            const float bs = bon[(size_t)row * 8 + (lane >> 3)] + bon[((size_t)NLAT + row) * 8 + (lane >> 3)];
            const f32x4 g0 = *(const LAS f32x4*)(GO + tk * 512 + c8), g1 = *(const LAS f32x4*)(GO + tk * 512 + c8 + 4);
            const float gg[8] = {g0.x, g0.y, g0.z, g0.w, g1.x, g1.y, g1.z, g1.w};
            float a[8], bq[8], pv[8], sv[8], y[8];
            unpack8(wyf, a); unpack8(wyb, bq); unpack8(wpv, pv); unpack8(wsv, sv);
            float s1 = 0.f;
#pragma unroll
            for (int e = 0; e < 8; ++e) { y[e] = a[e] + bq[e]; s1 += y[e]; }
            s1 += __shfl_xor(s1, 1); s1 += __shfl_xor(s1, 2); s1 += __shfl_xor(s1, 4);
            const float m = s1 * (1.f / 64.f);
            float s2 = 0.f;
#pragma unroll
            for (int e = 0; e < 8; ++e) { y[e] -= m; s2 += y[e] * y[e]; }
            s2 += __shfl_xor(s2, 1); s2 += __shfl_xor(s2, 2); s2 += __shfl_xor(s2, 4);
            const float rs = __builtin_amdgcn_rsqf(s2 * (1.f / 64.f) + RWKV_EPS);
            float o[8];
#pragma unroll
            for (int e = 0; e < 8; ++e) { const float vv = pv[e] + muv[e] * ((okv ? sv[e] : 0.f) - pv[e]); o[e] = (y[e] * rs * lnw[e] + lnb[e] + bs * vv) * gg[e]; }
            u32x4 ow; ow.x = cvtpk(o[0], o[1]); ow.y = cvtpk(o[2], o[3]); ow.z = cvtpk(o[4], o[5]); ow.w = cvtpk(o[6], o[7]);
            *(u32x4*)(ymix + (size_t)row * D + c8) = ow;
            float of[8], ob[8], z[8];
            unpack8(wof, of); unpack8(wob, ob); unpack8(wz, z);
            float s3 = 0.f;
#pragma unroll
            for (int e = 0; e < 8; ++e) { of[e] += ob[e]; s3 += of[e] * of[e]; }
            s3 += __shfl_xor(s3, 1); s3 += __shfl_xor(s3, 2); s3 += __shfl_xor(s3, 4); s3 += __shfl_xor(s3, 8);
            const float rg = __builtin_amdgcn_rsqf(s3 * (1.f / 128.f) + NORM_EPS);
#pragma unroll
            for (int e = 0; e < 8; ++e) o[e] = of[e] * rg * ong[e] * siluf_(z[e]);
            ow.x = cvtpk(o[0], o[1]); ow.y = cvtpk(o[2], o[3]); ow.z = cvtpk(o[4], o[5]); ow.w = cvtpk(o[6], o[7]);
            *(u32x4*)(ymix + (size_t)row * D + 512 + c8) = ow;
        }
    }
}

__device__ __forceinline__ void convert_experts(const Args& A, Ctx& C) {
    lfloat* scr = (lfloat*)(C.lds + C.wave * 16384);
    const int gw = C.bid * 8 + C.wave, NGW = C.G * 8;
    constexpr int I13 = (D / 64) * (DE / 32);
    constexpr int I2 = (DE / 64) * (D / 32);
    constexpr int PER = 2 * I13 + I2;
    for (int it = gw; it < 257 * PER; it += NGW) {
        const int e = it / PER; int r = it % PER;
        unsigned char* bt13 = A.ws + WS_WEXP + (size_t)e * WEXP_STRIDE; unsigned char* bt2 = bt13 + 512 * 1024;
        const float* w1 = e < NE ? A.in[I_EW1] + (size_t)e * D * DE : A.in[I_SW1];
        const float* w3 = e < NE ? A.in[I_EW3] + (size_t)e * D * DE : A.in[I_SW3];
        const float* w2 = e < NE ? A.in[I_EW2] + (size_t)e * DE * D : A.in[I_SW2];
        if (r < I13) { transpose_item_fp8(w1, D, DE, bt13, RowGLU{0}, SW13, scr, r, C.lane); continue; } r -= I13;
        if (r < I13) { transpose_item_fp8(w3, D, DE, bt13, RowGLU{128}, SW13, scr, r, C.lane); continue; } r -= I13;
        transpose_item_fp8(w2, DE, D, bt2, RowId(), SW2, scr, r, C.lane);
    }
}

__device__ __forceinline__ void phase_p6(const Args& A, Ctx& C) {
    const float* mod = WSP(float, WS_MOD); bf16_t* h2n = WSP(bf16_t, WS_H2N);
    const int gw = C.bid * 8 + C.wave, NGW = C.G * 8;
    for (int row = gw; row < NLAT; row += NGW) {
        const float* m = mod + (size_t)(row >> 11) * MODW;
        norm_mod_row(A.out + (size_t)row * D, A.in[I_N2G], m + 4 * D, m + 3 * D, h2n + (size_t)row * D, C.lane, (unsigned*)(A.ws + WS_H2N8) + (size_t)row * (D / 4));
    }
}

__device__ __forceinline__ void phase_p8(const Args& A, Ctx& C) {
    const float* logit = WSP(float, WS_LOGIT);
    int* tope = WSP(int, WS_TOPE); float* topw = WSP(float, WS_TOPW); int* pos = WSP(int, WS_POS);
    unsigned* cnt = WSP(unsigned, WS_CTL) + CW_CNT;
    const int gw = C.bid * 8 + C.wave, NGW = C.G * 8, lane = C.lane;
    const f32x4 rb = ((const f32x4*)A.in[I_RB])[lane];
    for (int tok = gw; tok < NLAT; tok += NGW) {
        const f32x4 lg = ((const f32x4*)(logit + (size_t)tok * NE))[lane];
        float s[4], sel[4];
#pragma unroll
        for (int i = 0; i < 4; ++i) { s[i] = sigmoidf_(lg[i]); sel[i] = s[i] + rb[i]; }
        float m1 = fmaxf(fmaxf(sel[0], sel[1]), fmaxf(sel[2], sel[3]));
        float m2;
        {
            float a = fmaxf(sel[0], sel[1]), bq = fminf(sel[0], sel[1]), cq = fmaxf(sel[2], sel[3]), dq = fminf(sel[2], sel[3]);
            m2 = fmaxf(fminf(a, cq), fmaxf(bq, dq)); }
#pragma unroll
        for (int o = 1; o < 8; o <<= 1) { const float o1 = __shfl_xor(m1, o), o2 = __shfl_xor(m2, o);
            const float n1 = fmaxf(m1, o1); const float n2 = fmaxf(fminf(m1, o1), fmaxf(m2, o2)); m1 = n1; m2 = n2; }
        const float gs = m1 + m2;
        const int grp = lane >> 3;
        int rank = 0;
#pragma unroll
        for (int gq = 0; gq < 8; ++gq) { const float og = __shfl(gs, gq * 8); rank += (og > gs || (og == gs && gq < grp)) ? 1 : 0; }
        const bool gsel = rank < 4;
        float cand[4];
#pragma unroll
        for (int i = 0; i < 4; ++i) cand[i] = gsel ? sel[i] : -INFINITY;
        int my_e = 0; float my_w = 0.f; float wsum = 0.f;
#pragma unroll
        for (int r = 0; r < 8; ++r) {
            float bv = cand[0]; int bi = 0;
#pragma unroll
            for (int i = 1; i < 4; ++i) if (cand[i] > bv) { bv = cand[i]; bi = i; }
            int be = lane * 4 + bi;
#define P8_STEP(CTRL) { const float ov = dpp_f<CTRL>(bv); const int oe = __builtin_amdgcn_update_dpp(0, be, CTRL, 0xf, 0xf, false); if (ov > bv || (ov == bv && oe < be)) { bv = ov; be = oe; } }
            P8_STEP(0x128) P8_STEP(0x124) P8_STEP(0x122) P8_STEP(0x121)
#undef P8_STEP
            float gv = rdlane(bv, 0); int ge = __builtin_amdgcn_readlane(be, 0);
#pragma unroll
            for (int rr = 1; rr < 4; ++rr) { const float ov = rdlane(bv, 16 * rr); const int oe = __builtin_amdgcn_readlane(be, 16 * rr); if (ov > gv || (ov == gv && oe < ge)) { gv = ov; ge = oe; } }
            be = ge;
            const int ol = be >> 2, oi = be & 3;
            const float mys = oi == 0 ? s[0] : (oi == 1 ? s[1] : (oi == 2 ? s[2] : s[3]));
            const float ws_ = __shfl(mys, ol);
            if (lane == ol) { if (oi == 0) cand[0] = -INFINITY; else if (oi == 1) cand[1] = -INFINITY; else if (oi == 2) cand[2] = -INFINITY; else cand[3] = -INFINITY; }
            wsum += ws_;
            if (lane == r) { my_e = be; my_w = ws_; }
        }
        if (lane < 8) {
            const float w = my_w / wsum * 2.5f;
            const unsigned p = atomicAdd(cnt + my_e, 1u);
            tope[(size_t)tok * 8 + lane] = my_e; topw[(size_t)tok * 8 + lane] = w; pos[(size_t)tok * 8 + lane] = (int)p;
        }
    }
}

__device__ __forceinline__ void tile_prefix(const Args& A, Ctx& C, LAS int* tb) {
    const unsigned* cnt = WSP(unsigned, WS_CTL) + CW_CNT;
    if (C.tid == 0) { int acc = 0; for (int e = 0; e < NE; ++e) { tb[e] = acc; acc += ((int)cnt[e] + 255) >> 8; } tb[NE] = acc; }
    __syncthreads();
}
__device__ __forceinline__ void phase_p9(const Args& A, Ctx& C) {
    LAS int* tb = (LAS int*)C.lds;
    tile_prefix(A, C, tb);
    const unsigned* cnt = WSP(unsigned, WS_CTL) + CW_CNT;
    const int* tope = WSP(int, WS_TOPE); const float* topw = WSP(float, WS_TOPW); const int* pos = WSP(int, WS_POS);
    int* rowl = WSP(int, WS_ROWL); float* roww = WSP(float, WS_ROWW); int* tile_e = WSP(int, WS_TILEE);
    const int nrt = tb[NE];
    for (int i = C.bid * 512 + C.tid; i < NLAT * 8; i += C.G * 512) { const int e = tope[i]; const int pr = tb[e] * 256 + pos[i]; rowl[pr] = i; roww[pr] = topw[i]; }
    for (int e = C.bid; e < NE; e += C.G) { const int n = (int)cnt[e], nt = tb[e + 1] - tb[e];
        for (int j = n + C.tid; j < nt * 256; j += 512) { rowl[tb[e] * 256 + j] = -1; roww[tb[e] * 256 + j] = 0.f; }
        for (int k = C.tid; k < nt; k += 512) tile_e[tb[e] + k] = e; }
    for (int i = C.bid * 512 + C.tid; i < NLAT; i += C.G * 512) { rowl[nrt * 256 + i] = i; roww[nrt * 256 + i] = 1.f; }
    for (int k = C.bid * 512 + C.tid; k < NLAT / 256; k += C.G * 512) tile_e[nrt + k] = NE;
    __syncthreads();
}

__device__ __forceinline__ void phase_moe(const Args& A, Ctx& C, int dry_shared) {
    LAS int* tb = (LAS int*)(C.lds + 131072);
    LAS int* tbl = tb + 320;
    tile_prefix(A, C, tb);
    pg8::MoeCtx M;
    M.nrt = tb[NE]; M.ntiles = M.nrt + NLAT / 256; M.G = C.G; M.vc = (C.G % 8 == 0) ? (C.bid % 8) * (C.G / 8) + C.bid / 8 : C.bid;
    M.tb = tb; M.tbl = tbl; M.cnt = WSP(unsigned, WS_CTL) + CW_CNT; M.rowl = WSP(int, WS_ROWL); M.roww = WSP(float, WS_ROWW);
    M.wexp = (const char*)(A.ws + WS_WEXP); M.h2n = (const char*)(A.ws + WS_H2N8); M.Hs = (char*)(A.ws + WS_HS) + (size_t)C.bid * 2 * 65536;
    M.Y = (unsigned char*)(A.ws + WS_Y); M.out = A.out; M.mod = WSP(const float, WS_MOD); M.dry_shared = dry_shared;
    pg8::gemm_moe(C.lds, M);
    __syncthreads();
}

__device__ __forceinline__ void phase_final(const Args& A, Ctx& C, float* dst) {
    const int gw = C.bid * 8 + C.wave, NGW = C.G * 8;
    const float* fg = A.in[I_FG]; const float* mod = WSP(const float, WS_MOD);
    const unsigned* Y = (const unsigned*)(A.ws + WS_Y);
    for (int row = gw; row < NLAT; row += NGW) {
        f32x4* xr = (f32x4*)(A.out + (size_t)row * D) + C.lane;
        const f32x4* gt = (const f32x4*)(mod + (size_t)(row >> 11) * MODW + 5 * D) + C.lane;
        const unsigned* yr = Y + (size_t)row * 8 * (D / 4) + C.lane;
        f32x4 v[4]; float s = 0.f;
#pragma unroll
        for (int j = 0; j < 4; ++j) {
            f32x4 a = (f32x4){0.f, 0.f, 0.f, 0.f};
#pragma unroll
            for (int sl = 0; sl < 8; ++sl) { const unsigned w = yr[sl * (D / 4) + 64 * j];
                const f32x2 lo = __builtin_amdgcn_cvt_pk_f32_fp8(w, false), hi = __builtin_amdgcn_cvt_pk_f32_fp8(w, true);
                a.x += lo.x; a.y += lo.y; a.z += hi.x; a.w += hi.y; }
            v[j] = xr[64 * j] + gt[64 * j] * a * (1.f / pg8::YSCALE);
            s += (v[j].x * v[j].x + v[j].y * v[j].y) + (v[j].z * v[j].z + v[j].w * v[j].w); }
        const float rstd = __builtin_amdgcn_rsqf(wave_sum(s) * (1.f / D) + NORM_EPS);
        f32x4* orow = (f32x4*)(dst + (size_t)row * D) + C.lane;
#pragma unroll
        for (int j = 0; j < 4; ++j) orow[64 * j] = v[j] * rstd * ((const f32x4*)fg)[C.lane + 64 * j];
    }
}

constexpr int NPHASE = 13;
__global__ void __launch_bounds__(512, 2) fwd_kernel(Args A) {
    extern __shared__ __attribute__((aligned(16))) unsigned char lds_raw[];
    Ctx C; C.lds = (lbyte*)lds_raw; C.tid = threadIdx.x; C.lane = C.tid & 63; C.wave = __builtin_amdgcn_readfirstlane(C.tid >> 6);
    C.G = gridDim.x; C.bid = blockIdx.x; C.a = &A;
    volatile LAS unsigned* misc = (volatile LAS unsigned*)(C.lds + LDS_MISC);
    if (C.tid < 16) misc[C.tid] = 0u;
    __syncthreads();
    XcdBarrier bar; bar.bar = WSP(unsigned, WS_CTL) + CW_BAR; bar.x = 0; bar.st = nullptr;
    const int lo = A.ph_lo, hi = A.ph_hi;
    const bool multi = (hi - lo) > 1;
    if (multi) bar = xcd_barrier_post(WSP(unsigned, WS_CTL) + CW_BAR, misc);
#ifndef PHASE_MASK
#define PHASE_MASK 0x1FFF
#endif
#define IN(k) (((PHASE_MASK >> (k)) & 1) && lo <= (k) && (k) < hi)
#define SEAM(k) do { if (IN(k) && IN((k) + 1)) xcd_barrier(bar); } while (0)
#ifndef REP_MASK
#define REP_MASK 0
#endif
#define REPS(k) (((REP_MASK >> (k)) & 1) ? 2 : 1)

    if (IN(0)) _Pragma("unroll") for (int rep = 0; rep < REPS(0); ++rep) { phase_p0(A, C); __syncthreads(); } SEAM(0);
    if (IN(1)) _Pragma("unroll") for (int rep = 0; rep < REPS(1); ++rep) { phase_p1(A, C); } SEAM(1);
    if (IN(2)) _Pragma("unroll") for (int rep = 0; rep < REPS(2); ++rep) {
        pg8::Gemm g{WSP(bf16_t, WS_XN), D}; pg8::StaticOrder S; S.init(NROWS, PLD, C.G, C.bid, WSP(bf16_t, WS_BTIN), D, 1);
        pg8::EpiBf16 E{WSP(bf16_t, WS_P), PLD, 1.f / SWIN};
        pg8::gemm_phase<pg8::EpiBf16, pg8::StaticOrder, false, 0, false, true>(C.lds, g, S, E);
    } SEAM(2);
    if (IN(3)) _Pragma("unroll") for (int rep = 0; rep < REPS(3); ++rep) { phase_gdn_prep(A, C); } SEAM(3);
#ifdef PROBE_BARRIERS
    if (multi) for (int kq = 0; kq < PROBE_BARRIERS; ++kq) xcd_barrier(bar);
#endif
    if (IN(4)) {
        for (int ch = C.bid; ch < NB * HB * 2; ch += C.G) gdn_chain_chunked(A, C, ch);
        for (int pr = C.bid; pr < NB * HA; pr += C.G) rwkv_pair_chunked(A, C, pr);
    } SEAM(4);
    if (IN(5)) _Pragma("unroll") for (int rep = 0; rep < REPS(5); ++rep) { phase_p4(A, C); } SEAM(5);
    if (IN(6)) _Pragma("unroll") for (int rep = 0; rep < REPS(6); ++rep) {
        pg8::Gemm g{WSP(bf16_t, WS_YMIX), D}; pg8::StaticOrder S; S.init(NLAT, D, C.G, C.bid, WSP(bf16_t, WS_BTOUT), D);
        pg8::EpiResGate E{A.in[I_X], A.out, WSP(float, WS_MOD), 2 * D};
        pg8::gemm_phase<pg8::EpiResGate, pg8::StaticOrder, false>(C.lds, g, S, E);
    } SEAM(6);
    if (IN(7)) _Pragma("unroll") for (int rep = 0; rep < REPS(7); ++rep) { phase_p6(A, C); __syncthreads(); convert_experts(A, C); __syncthreads(); } SEAM(7);
    if (IN(8)) _Pragma("unroll") for (int rep = 0; rep < REPS(8); ++rep) {
        pg8::Gemm g{WSP(bf16_t, WS_H2N), D}; pg8::StaticOrder S; S.init(NLAT, NE, C.G, C.bid, WSP(bf16_t, WS_BTR), D);
        pg8::EpiF32 E{WSP(float, WS_LOGIT), NE};
        pg8::gemm_phase<pg8::EpiF32, pg8::StaticOrder, false>(C.lds, g, S, E);
    } SEAM(8);
    if (IN(9)) { phase_p8(A, C); } SEAM(9);
    if (IN(10)) _Pragma("unroll") for (int rep = 0; rep < REPS(10); ++rep) { phase_p9(A, C); } SEAM(10);
    if (IN(11)) { phase_moe(A, C, 0); if (REPS(11) > 1) { __syncthreads(); phase_moe(A, C, 1); } } SEAM(11);
    if (IN(12)) { if (REPS(12) > 1) { phase_final(A, C, (float*)(A.ws + WS_WEXP)); __syncthreads(); } phase_final(A, C, A.out); }
#undef IN
#undef SEAM
}

extern "C" void kernel_launch(void* const* d_in, const int* in_sizes, int n_in, void* d_out, int out_size, void* d_ws, size_t ws_size, hipStream_t stream) {
    static int grid = 0;
    if (grid == 0) {
        if (n_in != 34 || out_size != NLAT * D || ws_size < WS_END) { fprintf(stderr, "kernel_launch: unexpected shapes (n_in %d out %d ws %zu need %zu)\n", n_in, out_size, ws_size, (size_t)WS_END); grid = -1; return; }
        int dev = 0, cus = 0;
        if (hipGetDevice(&dev) != hipSuccess || hipDeviceGetAttribute(&cus, hipDeviceAttributeMultiprocessorCount, dev) != hipSuccess) { grid = -1; return; }
        if (hipFuncSetAttribute((const void*)fwd_kernel, hipFuncAttributeMaxDynamicSharedMemorySize, LDS_BYTES) != hipSuccess) { fprintf(stderr, "kernel_launch: hipFuncSetAttribute failed\n"); grid = -1; return; }
        int per_cu = 0;
        if (hipOccupancyMaxActiveBlocksPerMultiprocessor(&per_cu, (const void*)fwd_kernel, 512, LDS_BYTES) != hipSuccess || per_cu < 1) { fprintf(stderr, "kernel_launch: occupancy query says %d\n", per_cu); }
        (void)hipGetLastError();
        grid = cus;
    }
    if (grid < 0) return;
    (void)hipMemsetAsync((char*)d_ws + WS_CTL, 0, CTL_BYTES, stream);
    Args a{};
    for (int i = 0; i < 34; ++i) a.in[i] = (const float*)d_in[i];
    a.out = (float*)d_out; a.ws = (unsigned char*)d_ws;
#if MK_PER_PHASE
    for (int p = 0; p < NPHASE; ++p) { a.ph_lo = p; a.ph_hi = p + 1; hipLaunchKernelGGL(fwd_kernel, dim3(grid), dim3(512), LDS_BYTES, stream, a); }
#else
    a.ph_lo = 0; a.ph_hi = NPHASE; hipLaunchKernelGGL(fwd_kernel, dim3(grid), dim3(512), LDS_BYTES, stream, a);
#endif
}
```

```cpp
#include <hip/hip_runtime.h>
#include <cstdio>
#include <cstdint>

#ifndef MK_PER_PHASE
#define MK_PER_PHASE 0
#endif

#define LAS __attribute__((address_space(3)))
typedef unsigned short bf16_t;
typedef short bf16x8 __attribute__((ext_vector_type(8)));
typedef float f32x4 __attribute__((ext_vector_type(4)));
typedef float f32x2 __attribute__((ext_vector_type(2)));
typedef unsigned u32x4 __attribute__((ext_vector_type(4)));
typedef unsigned u32x2 __attribute__((ext_vector_type(2)));
typedef int i32x4 __attribute__((ext_vector_type(4)));
typedef int i32x8 __attribute__((ext_vector_type(8)));
typedef LAS float lfloat;
typedef LAS unsigned char lbyte;

constexpr int D = 1024, NB = 32, SEQ = 2048, CTX = 256, GW = 64;
constexpr int NLAT = NB * SEQ;
constexpr int NCTX = NB * CTX;
constexpr int NROWS = NLAT + NCTX;
constexpr int DA = 512, HA = 8, NA = 64;
constexpr int RW_COLS = 1920, GD_COLS = 2064, IN_COLS = 3984, PLD = 4096;
constexpr int DB = 512, HB = 4, KB = 128;
constexpr int NE = 256, TOPK = 8, DE = 256;
constexpr int MODW = 6 * D;
constexpr float NORM_EPS = 1e-6f, RWKV_EPS = 64e-5f;
constexpr int MAXTILES = (NLAT * TOPK + NE * 255) / 256 + 1;

constexpr size_t MiB = 1u << 20;
constexpr size_t WS_CTL = 0, CTL_BYTES = 1 * MiB;
constexpr size_t WS_MOD = 1 * MiB;
constexpr size_t WS_BTIN = 2 * MiB, WS_BTOUT = 10 * MiB, WS_BTR = 12 * MiB, WS_BON = 13 * MiB, WS_GUPT = 17 * MiB, WS_NRM = 978 * MiB;
constexpr size_t WS_P = 18 * MiB, WS_XN = 594 * MiB, WS_YDIR = 594 * MiB, WS_YMIX = 850 * MiB;
constexpr size_t WS_H2N8 = 900 * MiB;
constexpr size_t WS_H2N = 18 * MiB, WS_LOGIT = 146 * MiB, WS_TOPE = 210 * MiB, WS_TOPW = 212 * MiB, WS_POS = 214 * MiB, WS_Y = 146 * MiB;
constexpr size_t WS_ROWL = 658 * MiB, WS_ROWW = 661 * MiB, WS_TILEE = 664 * MiB, WS_HS = 672 * MiB, WS_WEXP = 704 * MiB;
constexpr size_t WEXP_STRIDE = (size_t)(512 * 1024 + 1024 * 256);
constexpr float SW13 = 64.f, SW2 = 32.f, SHS = 8.f, SWIN = 32.f;
constexpr size_t WS_END = 1090 * MiB;
static_assert(WS_WEXP + 257 * WEXP_STRIDE <= WS_END && WS_Y + (size_t)NLAT * 8 * D <= WS_ROWL, "ws map");
constexpr int CW_BAR = 4096;
constexpr int CW_CNT = 16384;

constexpr int LDS_BYTES = 159744;
constexpr int LDS_MISC = LDS_BYTES - 64;

__device__ __forceinline__ unsigned f2bf(float f) { unsigned u = __builtin_bit_cast(unsigned, f); return (u + 0x7fffu + ((u >> 16) & 1u)) >> 16; }
typedef __bf16 bf16x2_t __attribute__((ext_vector_type(2)));
__device__ __forceinline__ unsigned cvtpk(float lo, float hi) { f32x2 v = {lo, hi}; return __builtin_bit_cast(unsigned, __builtin_convertvector(v, bf16x2_t)); }
__device__ __forceinline__ unsigned pk2(float lo, float hi) { return cvtpk(lo, hi); }
__device__ __forceinline__ unsigned pk4_fp8(float a, float b, float c, float d) { unsigned w = 0u;
    w = __builtin_amdgcn_cvt_pk_fp8_f32(__builtin_amdgcn_fmed3f(a, -448.f, 448.f), __builtin_amdgcn_fmed3f(b, -448.f, 448.f), w, false);
    w = __builtin_amdgcn_cvt_pk_fp8_f32(__builtin_amdgcn_fmed3f(c, -448.f, 448.f), __builtin_amdgcn_fmed3f(d, -448.f, 448.f), w, true); return w; }
__device__ __forceinline__ float bf2f(unsigned short b) { return __builtin_bit_cast(float, ((unsigned)b) << 16); }
__device__ __forceinline__ float bflo(unsigned w) { return __builtin_bit_cast(float, w << 16); }
__device__ __forceinline__ float bfhi(unsigned w) { return __builtin_bit_cast(float, w & 0xffff0000u); }
template <int CTRL> __device__ __forceinline__ float dpp_f(float v) { return __builtin_bit_cast(float, __builtin_amdgcn_update_dpp(0, __builtin_bit_cast(int, v), CTRL, 0xf, 0xf, false)); }
__device__ __forceinline__ float wave_sum(float v) {
    v += dpp_f<0x128>(v);
    v += dpp_f<0x124>(v);
    v += dpp_f<0x122>(v);
    v += dpp_f<0x121>(v);
    const int vi = __builtin_bit_cast(int, v);
    const float r0 = __builtin_bit_cast(float, __builtin_amdgcn_readlane(vi, 0)), r1 = __builtin_bit_cast(float, __builtin_amdgcn_readlane(vi, 16)),
                r2 = __builtin_bit_cast(float, __builtin_amdgcn_readlane(vi, 32)), r3 = __builtin_bit_cast(float, __builtin_amdgcn_readlane(vi, 48));
    return (r0 + r1) + (r2 + r3);
}
__device__ __forceinline__ float sigmoidf_(float x) { return __builtin_amdgcn_rcpf(1.f + __expf(-x)); }
__device__ __forceinline__ float siluf_(float x) { return x * __builtin_amdgcn_rcpf(1.f + __expf(-x)); }
__device__ __forceinline__ float softplusf_(float x) { return fmaxf(x, 0.f) + __logf(1.f + __expf(-fabsf(x))); }
__device__ __forceinline__ float tanhf_(float x) { const float e = __expf(-2.f * fabsf(x)); const float t = (1.f - e) * __builtin_amdgcn_rcpf(1.f + e); return x < 0.f ? -t : t; }

#define XB_TMO      128
#define XB_XCNT(j)  (256  + 64 * (j))
#define XB_XSUB(j)  (1280 + 64 * (j))
#define XB_XGEN(j)  (2304 + 64 * (j))
#define XB_TOP      3328
#define XB_TOPGEN   3392
#define XCD_BAR_WORDS 3456
#define XB_SPIN_CAP (1u << 22)
__device__ __forceinline__ unsigned xb_ld(unsigned* p)              { return __hip_atomic_load(p, __ATOMIC_RELAXED, __HIP_MEMORY_SCOPE_AGENT); }
__device__ __forceinline__ unsigned xb_add(unsigned* p, unsigned v) { return __hip_atomic_fetch_add(p, v, __ATOMIC_RELAXED, __HIP_MEMORY_SCOPE_AGENT); }
__device__ __forceinline__ unsigned xb_xcc_id() { return (unsigned)__builtin_amdgcn_s_getreg((3 << 11) | 20) & 0xFu; }
#define XB_SPIN(cond, bar) do { unsigned _sp = 0; while (cond) { __builtin_amdgcn_s_sleep(1); \
    if ((++_sp & 255u) == 0u) { if (xb_ld(&(bar)[XB_TMO])) break; if (_sp > XB_SPIN_CAP) { atomicAdd(&(bar)[XB_TMO], 1u); break; } } } } while (0)
struct XcdBarrier { unsigned* bar; unsigned x; volatile LAS unsigned* st; };
__device__ __forceinline__ XcdBarrier xcd_barrier_post(unsigned* bar, volatile LAS unsigned* st) {
    XcdBarrier b; b.bar = bar; b.x = xb_xcc_id(); b.st = st;
    if (threadIdx.x == 0) (void)xb_add(&bar[XB_XCNT(b.x)], 1u);
    return b;
}
__device__ __forceinline__ void xcd_barrier_complete(unsigned* bar, unsigned x, unsigned& nloc, unsigned& nx) {
    const unsigned G = gridDim.x * gridDim.y * gridDim.z;
    unsigned sum, cnt, mine, sp = 0u;
    for (;;) {
        sum = 0u; cnt = 0u; mine = 0u;
#pragma unroll
        for (unsigned j = 0; j < 16; ++j) { const unsigned c = xb_ld(&bar[XB_XCNT(j)]); sum += c; cnt += (c > 0u) ? 1u : 0u; mine = (j == x) ? c : mine; }
        if (sum == G) break;
        __builtin_amdgcn_s_sleep(1);
        if ((++sp & 255u) == 0u) { if (xb_ld(&bar[XB_TMO])) break; if (sp > XB_SPIN_CAP) { atomicAdd(&bar[XB_TMO], 1u); break; } }
    }
    nloc = mine > 0u ? mine : 1u; nx = cnt > 0u ? cnt : 1u;
}
__device__ __forceinline__ void xcd_barrier(const XcdBarrier& b) {
    asm volatile("s_waitcnt vmcnt(0)" ::: "memory");
    __syncthreads();
    if (threadIdx.x == 0) {
        unsigned* bar = b.bar;
        __builtin_amdgcn_s_waitcnt(0);
        unsigned nloc = b.st[0], nx = b.st[1];
        if (nloc == 0u) { xcd_barrier_complete(bar, b.x, nloc, nx); b.st[0] = nloc; b.st[1] = nx; }
        const unsigned old = xb_add(&bar[XB_XSUB(b.x)], 1u);
        const unsigned gen = old / nloc;
        if (old + 1u == (gen + 1u) * nloc) {
            __builtin_amdgcn_fence(__ATOMIC_RELEASE, "agent");
            asm volatile("s_waitcnt vmcnt(0)" ::: "memory");
            const unsigned og = xb_add(&bar[XB_TOP], 1u);
            const unsigned tg = og / nx;
            if (og + 1u == (tg + 1u) * nx) xb_add(&bar[XB_TOPGEN], 1u);
            else XB_SPIN(xb_ld(&bar[XB_TOPGEN]) == tg, bar);
            __builtin_amdgcn_fence(__ATOMIC_ACQUIRE, "agent");
            xb_add(&bar[XB_XGEN(b.x)], 1u);
            asm volatile("s_waitcnt vmcnt(0)" ::: "memory");
        } else {
            XB_SPIN(xb_ld(&bar[XB_XGEN(b.x)]) == gen, bar);
            __builtin_amdgcn_fence(__ATOMIC_ACQUIRE, "agent");
            asm volatile("s_waitcnt vmcnt(0)" ::: "memory");
        }
    }
    __syncthreads();
}

struct Args {
    const float* in[34];
    float* out;
    unsigned char* ws;
    int ph_lo, ph_hi;
};
enum { I_X = 0, I_C, I_CTX, I_CCTX, I_WADA, I_BADA, I_N1G, I_WIN, I_MU, I_W0, I_WUP, I_A0, I_AUP, I_GUP, I_KK, I_KA, I_RK, I_LNW, I_LNB,
       I_CONVW, I_ALOG, I_DTB, I_ONG, I_WOUT, I_N2G, I_RW, I_RB, I_EW1, I_EW3, I_EW2, I_SW1, I_SW3, I_SW2, I_FG };

namespace pg8 {
constexpr int BM = 256, BK = 64, HALF = 128, HTB = HALF * BK * 2, STAGE_BYTES = 8 * HTB, NXCD = 8, WGM = 8;
__host__ __device__ __forceinline__ int lds_byte(int r, int c) { const int st = (r >> 4) * 2 + (c >> 5), rr = r & 15, cc = c & 31, ob = rr * 64 + cc * 2; return st * 1024 + (ob ^ (((ob >> 9) & 1) << 5)); }
__host__ __device__ __forceinline__ void stage_rc(int b, int& R, int& C) { const int st = b / 1024, sb = b % 1024, swz = sb ^ (((sb >> 9) & 1) << 5); R = (st >> 1) * 16 + swz / 64; C = (st & 1) * 32 + (swz % 64) / 2; }
__host__ __device__ __forceinline__ int perm32(int rho) { const int n = rho >> 4, i = rho & 15; return 8 * (i >> 2) + 4 * n + (i & 3); }
struct Unit { int pm, pn; };
struct Gemm { const bf16_t* A; int K; };
struct StaticOrder {
    int nM, nN, nwg, G, c; const char* Bt; size_t tstepB;
    __device__ void init(int M, int N, int G_, int c_, const void* Bt_, int K, int es = 2) { nM = M / BM; nN = N / BM; nwg = nM * nN; G = G_; c = c_; Bt = (const char*)Bt_; tstepB = (size_t)BM * K * es; }
    __device__ bool next(int i, Unit& u) const {
        const long L = (long)i * G + c; if (L >= nwg) return false;
        int wgid = (int)L; { const int q = nwg / NXCD, r = nwg % NXCD, xcd = wgid % NXCD, off = wgid / NXCD; wgid = (xcd < r ? xcd * (q + 1) : r * (q + 1) + (xcd - r) * q) + off; }
        const int nig = WGM * nN, gid = wgid / nig, fm = gid * WGM, gsz = (nM - fm) < WGM ? (nM - fm) : WGM;
        u.pm = fm + ((wgid % nig) % gsz); u.pn = (wgid % nig) / gsz; return true;
    }
    __device__ __forceinline__ const char* bptr(const Unit& u) const { return Bt + (size_t)u.pn * tstepB; }
    __device__ __forceinline__ int rowsel(const Unit&, int) const { return 0; }
};
struct TileOrder {
    int nunits, npn, G, c; const int* tile_e; const char* wbase; size_t wstride, woff, tstepB; const int* rowl;
    __device__ bool next(int i, Unit& u) const { const int L = i * G + c; if (L >= nunits) return false; u.pm = L / npn; u.pn = L - u.pm * npn; return true; }
    __device__ __forceinline__ const char* bptr(const Unit& u) const { const int e = __builtin_amdgcn_readfirstlane(tile_e[u.pm]); return wbase + (size_t)e * wstride + woff + (size_t)u.pn * tstepB; }
    __device__ __forceinline__ int rowsel(const Unit& u, int r) const { const int t = rowl[(size_t)u.pm * 256 + r]; return t < 0 ? 0 : t; }
};
struct SeqOrder {
    int n; const char* Bt; size_t tstepB; const LAS int* rsel;
    __device__ bool next(int i, Unit& u) const { if (i >= n) return false; u.pm = 0; u.pn = i; return true; }
    __device__ __forceinline__ const char* bptr(const Unit& u) const { return Bt + (size_t)u.pn * tstepB; }
    __device__ __forceinline__ int rowsel(const Unit&, int r) const { return rsel[r]; }
};
__device__ __forceinline__ unsigned cvt_pk_bf16(float lo, float hi) { return cvtpk(lo, hi); }

template <class Epi, class Sched, bool GATHER, int A_AUX = 0, bool ALIGN = true, bool FP8 = false>
__device__ __forceinline__ void gemm_phase(lbyte* lds, const Gemm g, const Sched& S, const Epi& E) {
    int tid_ = threadIdx.x; asm volatile("" : "+v"(tid_));
    const int tid = tid_, wid = __builtin_amdgcn_readfirstlane(tid >> 6), lane = tid & 63, wr = wid >> 2, wc = wid & 3, fr = lane & 15, fq = lane >> 4;
    constexpr unsigned ES = FP8 ? 1u : 2u;
    const int K = g.K, nt = FP8 ? K / 128 : K / BK;
    Unit cur, nxt; int ui = 0;
    if (!S.next(0, cur)) return;
    int Rst[2], Cst[2];
    unsigned voffA[2], voffA1[2], voffB[2], nvA[2], nvA1[2];
#pragma unroll
    for (int i = 0; i < 2; ++i) { int R, C; stage_rc(tid * 16 + i * 8192, R, C); const int Rb = Epi::PERM ? ((R & ~31) + perm32(R & 31)) : R; Rst[i] = R; Cst[i] = C;
        if (GATHER) { voffA[i] = (unsigned)S.rowsel(cur, R) * (unsigned)K * ES + (unsigned)C * 2u; voffA1[i] = (unsigned)S.rowsel(cur, 128 + R) * (unsigned)K * ES + (unsigned)C * 2u; }
        else { voffA[i] = (unsigned)(R * K) * ES + (unsigned)C * 2u; voffA1[i] = voffA[i]; }
        nvA[i] = voffA[i]; nvA1[i] = voffA1[i];
        voffB[i] = (unsigned)(Rb * K) * ES + (unsigned)C * 2u; }
    const size_t kstep = (size_t)(BK * 2);
    const size_t hstep = (size_t)HALF * K * ES;
    const size_t hstepA = GATHER ? 0 : hstep;
    const size_t tstep = 2 * hstep;
    const unsigned ldsw = (unsigned)wid * 1024u;
    const int aoff = lds_byte(wr * 64 + fr, FP8 ? fq * 16 : fq * 8), boff = lds_byte(wc * 32 + fr, FP8 ? fq * 16 : fq * 8);
#define PG8_SA(b, h) (((b) * 2 + (h)) * HTB)
#define PG8_SB(b, h) ((4 + (b) * 2 + (h)) * HTB)
#define PG8_STAGE2(bufoff, gbase, v0, v1) do { \
        __builtin_amdgcn_global_load_lds((const unsigned*)((const char*)(gbase) + (v0)), (LAS unsigned*)(lds + (bufoff) + ldsw), 16, 0, 0); \
        __builtin_amdgcn_global_load_lds((const unsigned*)((const char*)(gbase) + (v1)), (LAS unsigned*)(lds + (bufoff) + ldsw + 8192), 16, 0, 0); } while (0)
#define PG8_STAGE2A(bufoff, gbase, v0, v1) do { if constexpr (A_AUX == 16) { \
        __builtin_amdgcn_global_load_lds((const unsigned*)((const char*)(gbase) + (v0)), (LAS unsigned*)(lds + (bufoff) + ldsw), 16, 0, 16); \
        __builtin_amdgcn_global_load_lds((const unsigned*)((const char*)(gbase) + (v1)), (LAS unsigned*)(lds + (bufoff) + ldsw + 8192), 16, 0, 16); } else { PG8_STAGE2(bufoff, gbase, v0, v1); } } while (0)
#define PG8_STAGE(bufoff, gbase, voff) PG8_STAGE2(bufoff, gbase, (voff)[0], (voff)[1])
#define PG8_STAGEA(bufoff, gbase, voff) PG8_STAGE2A(bufoff, gbase, (voff)[0], (voff)[1])
#define G_LD32(p) __builtin_shufflevector(*(const LAS i32x4*)(p), *(const LAS i32x4*)((p) + 16), 0, 1, 2, 3, 4, 5, 6, 7)
#define G_MFMA8(c, a, b) asm volatile("v_mfma_scale_f32_16x16x128_f8f6f4 %0, %1, %2, %0, %3, %3 op_sel_hi:[0,0,0]" : "+v"(c) : "v"(a), "v"(b), "v"(one_scale))
#define PG8_LDA(dst, b, h) do { if constexpr (FP8) { _Pragma("unroll") for (int m = 0; m < 4; ++m) dst##8[m] = G_LD32(lds + PG8_SA(b, h) + aoff + m * 2048); } else { \
        _Pragma("unroll") for (int m = 0; m < 4; ++m) _Pragma("unroll") for (int k = 0; k < 2; ++k) dst[m][k] = *(const LAS bf16x8*)(lds + PG8_SA(b, h) + aoff + m * 2048 + k * 1024); } } while (0)
#define PG8_LDB(dst, b, h) do { if constexpr (FP8) { _Pragma("unroll") for (int n = 0; n < 2; ++n) dst##8[n] = G_LD32(lds + PG8_SB(b, h) + boff + n * 2048); } else { \
        _Pragma("unroll") for (int n = 0; n < 2; ++n) _Pragma("unroll") for (int k = 0; k < 2; ++k) dst[n][k] = *(const LAS bf16x8*)(lds + PG8_SB(b, h) + boff + n * 2048 + k * 1024); } } while (0)
#define PG8_MMA(ai, bj, At, Bt) do { __builtin_amdgcn_s_setprio(1); if constexpr (FP8) { _Pragma("unroll") for (int m = 0; m < 4; ++m) _Pragma("unroll") for (int n = 0; n < 2; ++n) G_MFMA8(acc[ai][bj][m][n], Bt##8[n], At##8[m]); } else { \
        _Pragma("unroll") for (int m = 0; m < 4; ++m) _Pragma("unroll") for (int n = 0; n < 2; ++n) _Pragma("unroll") for (int k = 0; k < 2; ++k) \
        acc[ai][bj][m][n] = __builtin_amdgcn_mfma_f32_16x16x32_bf16(Bt[n][k], At[m][k], acc[ai][bj][m][n], 0, 0, 0); } __builtin_amdgcn_s_setprio(0); } while (0)
#define PG8_WAIT_V(n) asm volatile("s_waitcnt vmcnt(" #n ")" ::: "memory")
#define PG8_WAIT_L(n) asm volatile("s_waitcnt lgkmcnt(" #n ")" ::: "memory")
#define PG8_BAR __builtin_amdgcn_s_barrier()
#define PG8_SCHED __builtin_amdgcn_sched_barrier(0)
    f32x4 acc[2][2][4][2];
#pragma unroll
    for (int a = 0; a < 2; ++a)
#pragma unroll
        for (int b = 0; b < 2; ++b)
#pragma unroll
            for (int m = 0; m < 4; ++m)
#pragma unroll
                for (int n = 0; n < 2; ++n) acc[a][b][m][n] = (f32x4){0.f, 0.f, 0.f, 0.f};
    bf16x8 At[4][2], B0[2][2], B1[2][2]; i32x8 At8[4], B08[2], B18[2];
    int one_scale = 0x7F7F7F7F; asm volatile("" : "+v"(one_scale));
    const char* cA = (const char*)g.A + (GATHER ? (size_t)0 : (size_t)cur.pm * tstep); const char* cB = S.bptr(cur);
    PG8_STAGE(PG8_SB(0, 0), cB, voffB); PG8_STAGE(PG8_SB(0, 1), cB + hstep, voffB); PG8_STAGEA(PG8_SA(0, 0), cA, voffA); PG8_STAGEA(PG8_SA(0, 1), cA + hstepA, voffA1);
    if (wr == 1) PG8_BAR;
    PG8_WAIT_V(2); PG8_BAR;
    PG8_STAGE(PG8_SB(1, 0), cB + kstep, voffB); PG8_STAGEA(PG8_SA(1, 0), cA + kstep, voffA); PG8_STAGE(PG8_SB(1, 1), cB + hstep + kstep, voffB);
    PG8_WAIT_V(6); PG8_BAR;
    for (;;) {
        const bool has_next = S.next(ui + 1, nxt);
        const char* nA = has_next ? (const char*)g.A + (GATHER ? (size_t)0 : (size_t)nxt.pm * tstep) : cA; const char* nB = has_next ? S.bptr(nxt) : cB;
        for (int t = 0; t < nt; t += 2) {
            const bool last = (t == nt - 2);
            const char* a1 = cA + (size_t)(t + 1) * kstep;
            const char* a2 = last ? nA : cA + (size_t)(t + 2) * kstep; const char* b2 = last ? nB : cB + (size_t)(t + 2) * kstep;
            const char* a3 = a2 + kstep; const char* b3 = b2 + kstep;
            if (GATHER && last && has_next) {
#pragma unroll
                for (int i = 0; i < 2; ++i) { nvA[i] = (unsigned)S.rowsel(nxt, Rst[i]) * (unsigned)K * ES + (unsigned)Cst[i] * 2u; nvA1[i] = (unsigned)S.rowsel(nxt, 128 + Rst[i]) * (unsigned)K * ES + (unsigned)Cst[i] * 2u; }
            }
            const unsigned x0 = (GATHER && last) ? nvA[0] : voffA[0], x1 = (GATHER && last) ? nvA[1] : voffA[1];
            const unsigned y0 = (GATHER && last) ? nvA1[0] : voffA1[0], y1 = (GATHER && last) ? nvA1[1] : voffA1[1];
            PG8_LDB(B0, 0, 0); PG8_LDB(B1, 0, 1); PG8_SCHED; PG8_LDA(At, 0, 0); PG8_STAGEA(PG8_SA(1, 1), a1 + hstepA, voffA1);
            PG8_WAIT_V(8); PG8_WAIT_L(0); PG8_BAR; PG8_MMA(0, 0, At, B0); PG8_MMA(0, 1, At, B1); PG8_BAR; PG8_SCHED;
            PG8_LDA(At, 0, 1); PG8_STAGE(PG8_SB(0, 0), b2, voffB); PG8_STAGE(PG8_SB(0, 1), b2 + hstep, voffB); PG8_STAGE2A(PG8_SA(0, 0), a2, x0, x1);
            PG8_WAIT_V(8); PG8_WAIT_L(0); PG8_BAR; PG8_MMA(1, 0, At, B0); PG8_MMA(1, 1, At, B1); PG8_BAR; PG8_SCHED;
            PG8_LDB(B0, 1, 0); PG8_LDB(B1, 1, 1); PG8_SCHED; PG8_LDA(At, 1, 0); PG8_STAGE2A(PG8_SA(0, 1), a2 + hstepA, y0, y1);
            PG8_WAIT_V(8); PG8_WAIT_L(0); PG8_BAR; PG8_MMA(0, 0, At, B0); PG8_MMA(0, 1, At, B1); PG8_BAR; PG8_SCHED;
            PG8_LDA(At, 1, 1); PG8_STAGE(PG8_SB(1, 0), b3, voffB); PG8_STAGE(PG8_SB(1, 1), b3 + hstep, voffB); PG8_STAGE2A(PG8_SA(1, 0), a3, x0, x1);
            PG8_WAIT_V(8); PG8_WAIT_L(0); PG8_BAR; PG8_MMA(1, 0, At, B0); PG8_MMA(1, 1, At, B1); PG8_BAR; PG8_SCHED;
        }
        if (ALIGN && wr == 0) PG8_BAR;
        if constexpr (FP8) asm volatile("s_nop 15\n\ts_nop 15" ::: "memory");
        E(acc, cur, wr, wc, fr, fq);
        if (!has_next) break;
#pragma unroll
        for (int a = 0; a < 2; ++a)
#pragma unroll
            for (int b = 0; b < 2; ++b)
#pragma unroll
                for (int m = 0; m < 4; ++m)
#pragma unroll
                    for (int n = 0; n < 2; ++n) acc[a][b][m][n] = (f32x4){0.f, 0.f, 0.f, 0.f};
        cur = nxt; cA = nA; cB = nB; ++ui;
        if (GATHER) { voffA[0] = nvA[0]; voffA[1] = nvA[1]; voffA1[0] = nvA1[0]; voffA1[1] = nvA1[1]; }
        if (ALIGN && wr == 1) PG8_BAR;
    }
    PG8_WAIT_V(0);
    if (!ALIGN && wr == 0) PG8_BAR;
    PG8_BAR;
#undef PG8_SA
#undef PG8_SB
#undef PG8_STAGE
#undef PG8_STAGE2
#undef PG8_STAGE2A
#undef PG8_STAGEA
#undef G_LD32
#undef G_MFMA8
#undef PG8_LDA
#undef PG8_LDB
#undef PG8_MMA
#undef PG8_WAIT_V
#undef PG8_WAIT_L
#undef PG8_BAR
#undef PG8_SCHED
}

struct EpiBf16 {
    static constexpr bool PERM = true;
    bf16_t* O; int ldc; float scale;
    __device__ __forceinline__ void operator()(const f32x4 (&acc)[2][2][4][2], const Unit& u, int wr, int wc, int fr, int fq) const {
        const int row0 = u.pm * BM + wr * 64 + fr; const int col0 = u.pn * BM + wc * 32 + 8 * fq;
#pragma unroll
        for (int ai = 0; ai < 2; ++ai)
#pragma unroll
            for (int m = 0; m < 4; ++m) { bf16_t* rowp = O + (size_t)(row0 + ai * HALF + m * 16) * ldc + col0;
#pragma unroll
                for (int bj = 0; bj < 2; ++bj) { const f32x4 v0 = acc[ai][bj][m][0] * scale, v1 = acc[ai][bj][m][1] * scale;
                    u32x4 w; w.x = cvt_pk_bf16(v0[0], v0[1]); w.y = cvt_pk_bf16(v0[2], v0[3]); w.z = cvt_pk_bf16(v1[0], v1[1]); w.w = cvt_pk_bf16(v1[2], v1[3]);
                    *(u32x4*)(rowp + bj * HALF) = w; } }
    }
};
struct EpiF32 {
    static constexpr bool PERM = false;
    float* C; int ldc;
    __device__ __forceinline__ void operator()(const f32x4 (&acc)[2][2][4][2], const Unit& u, int wr, int wc, int fr, int fq) const {
        const int row0 = u.pm * BM + wr * 64 + fr, col0 = u.pn * BM + wc * 32 + 4 * fq;
#pragma unroll
        for (int ai = 0; ai < 2; ++ai)
#pragma unroll
            for (int m = 0; m < 4; ++m) { float* rowp = C + (size_t)(row0 + ai * HALF + m * 16) * ldc + col0;
#pragma unroll
                for (int bj = 0; bj < 2; ++bj)
#pragma unroll
                    for (int n = 0; n < 2; ++n) *(f32x4*)(rowp + bj * HALF + n * 16) = acc[ai][bj][m][n]; }
    }
};
struct EpiResGate {
    static constexpr bool PERM = false;
    const float* x; float* out; const float* mod; int gate_off;
    __device__ __forceinline__ void operator()(const f32x4 (&acc)[2][2][4][2], const Unit& u, int wr, int wc, int fr, int fq) const {
        const int row0 = u.pm * BM + wr * 64 + fr, col0 = u.pn * BM + wc * 32 + 4 * fq;
        const float* gp = mod + (size_t)((u.pm * BM) >> 11) * MODW + gate_off + col0;
        f32x4 gv[2][2];
#pragma unroll
        for (int bj = 0; bj < 2; ++bj)
#pragma unroll
            for (int n = 0; n < 2; ++n) gv[bj][n] = *(const f32x4*)(gp + bj * HALF + n * 16);
#pragma unroll
        for (int ai = 0; ai < 2; ++ai)
#pragma unroll
            for (int m = 0; m < 4; ++m) { const size_t off = (size_t)(row0 + ai * HALF + m * 16) * D + col0;
#pragma unroll
                for (int bj = 0; bj < 2; ++bj)
#pragma unroll
                    for (int n = 0; n < 2; ++n) { const f32x4 xv = *(const f32x4*)(x + off + bj * HALF + n * 16);
                        *(f32x4*)(out + off + bj * HALF + n * 16) = xv + gv[bj][n] * acc[ai][bj][m][n]; }
                asm volatile("" ::: "memory"); }
    }
};
struct EpiGLU {
    static constexpr bool PERM = true;
    bf16_t* H;
    __device__ __forceinline__ void operator()(const f32x4 (&acc)[2][2][4][2], const Unit& u, int wr, int wc, int fr, int fq) const {
        const int row0 = u.pm * BM + wr * 64 + fr; const int col0 = u.pn * 128 + wc * 32 + 8 * fq;
#pragma unroll
        for (int ai = 0; ai < 2; ++ai)
#pragma unroll
            for (int m = 0; m < 4; ++m) { bf16_t* rowp = H + (size_t)(row0 + ai * HALF + m * 16) * 256 + col0;
                f32x4 h0, h1;
#pragma unroll
                for (int j = 0; j < 4; ++j) { const float a0 = acc[ai][0][m][0][j], a1 = acc[ai][0][m][1][j];
                    h0[j] = siluf_(a0) * acc[ai][1][m][0][j]; h1[j] = siluf_(a1) * acc[ai][1][m][1][j]; }
                u32x4 w; w.x = cvt_pk_bf16(h0[0], h0[1]); w.y = cvt_pk_bf16(h0[2], h0[3]); w.z = cvt_pk_bf16(h1[0], h1[1]); w.w = cvt_pk_bf16(h1[2], h1[3]);
                *(u32x4*)rowp = w; }
    }
};
constexpr float YSCALE = 8.f;
struct EpiY {
    static constexpr bool PERM = true;
    unsigned char* Y; float* out; const float* mod; const LAS int* rtok; const LAS float* rw; int shared;
    __device__ __forceinline__ void operator()(const f32x4 (&acc)[2][2][4][2], const Unit& u, int wr, int wc, int fr, int fq) const {
        const int col0 = u.pn * BM + wc * 32 + 8 * fq;
#pragma unroll
        for (int ai = 0; ai < 2; ++ai)
#pragma unroll
            for (int m = 0; m < 4; ++m) { const int r = wr * 64 + fr + ai * HALF + m * 16; const int ts = rtok[r]; const float w = rw[r];
                if (ts >= 0) {
                    if (shared) { const unsigned goff = (unsigned)(ts >> 11) * MODW + 5 * D + col0; const unsigned ooff = (unsigned)ts * D + col0;
#pragma unroll
                        for (int bj = 0; bj < 2; ++bj)
#pragma unroll
                            for (int n = 0; n < 2; ++n) { const f32x4 gv = *(const f32x4*)(mod + goff + bj * HALF + n * 4); f32x4* op = (f32x4*)(out + ooff + bj * HALF + n * 4);
                                *op = *op + gv * acc[ai][bj][m][n]; }
                    } else { unsigned char* yp = Y + (size_t)(unsigned)ts * D + col0; const float ws_ = w * YSCALE;
#pragma unroll
                        for (int bj = 0; bj < 2; ++bj) { f32x4 v0 = acc[ai][bj][m][0] * ws_, v1 = acc[ai][bj][m][1] * ws_;
#pragma unroll
                                for (int j = 0; j < 4; ++j) { v0[j] = __builtin_amdgcn_fmed3f(v0[j], -448.f, 448.f); v1[j] = __builtin_amdgcn_fmed3f(v1[j], -448.f, 448.f); }
                            unsigned lo = 0u, hi = 0u;
                            lo = __builtin_amdgcn_cvt_pk_fp8_f32(v0[0], v0[1], lo, false); lo = __builtin_amdgcn_cvt_pk_fp8_f32(v0[2], v0[3], lo, true);
                            hi = __builtin_amdgcn_cvt_pk_fp8_f32(v1[0], v1[1], hi, false); hi = __builtin_amdgcn_cvt_pk_fp8_f32(v1[2], v1[3], hi, true);
                            u32x2 pk; pk.x = lo; pk.y = hi; *(u32x2*)(yp + bj * HALF) = pk; } } }
                asm volatile("" ::: "memory"); }
    }
};

struct MoeCtx {
    int ntiles, nrt, G, vc;
    const LAS int* tb; LAS int* tbl;
    const unsigned* cnt; const int* rowl; const float* roww;
    const char* wexp; const char* h2n; char* Hs; unsigned char* Y; float* out; const float* mod; int dry_shared;
};
__device__ __forceinline__ void gemm_moe(lbyte* lds, const MoeCtx& M) {
    int tid_ = threadIdx.x; asm volatile("" : "+v"(tid_));
    const int tid = tid_, wid = __builtin_amdgcn_readfirstlane(tid >> 6), lane = tid & 63, wr = wid >> 2, wc = wid & 3, fr = lane & 15, fq = lane >> 4;
    const int ntl = (M.ntiles - M.vc + M.G - 1) / M.G;
    if (M.vc >= M.ntiles) return;
    const int nunits = ntl * 6;
    const unsigned ldsw = (unsigned)wid * 1024u;
    const int aoff = lds_byte(wr * 64 + fr, fq * 16), boff = lds_byte(wc * 32 + fr, fq * 16);
    auto tile_expert = [&](int tile, int& e, int& k) { if (tile < M.nrt) { int lo = 0, hi = NE - 1; while (lo < hi) { const int mid = (lo + hi + 1) >> 1; if (M.tb[mid] <= tile) lo = mid; else hi = mid - 1; } e = lo; k = tile - M.tb[lo]; } else { e = NE; k = tile - M.nrt; } };
    auto fill = [&](int j) { if (j < ntl && tid < 256) { const int tile = M.vc + j * M.G; int e, k; tile_expert(tile, e, k); LAS int* T = M.tbl + (j % 3) * 768;
            int ts; float w;
            if (e < NE) { const int valid = (int)M.cnt[e] - 256 * k; if (tid < valid) { ts = M.rowl[(size_t)tile * 256 + tid]; w = M.roww[(size_t)tile * 256 + tid]; } else { ts = -1; w = 0.f; } T[tid] = ts < 0 ? 0 : (ts >> 3); }
            else { ts = k * 256 + tid; w = 1.f; T[tid] = ts; }
            T[256 + tid] = ts; ((LAS float*)T)[512 + tid] = w; } };
    struct UP { const char* aB; const char* bB; unsigned bh; int nt, kind, pn, slot, shared, e, hbuf, fillnext; };
    auto unit_params = [&](int ui, int prev_e, UP& u, unsigned (&oa)[4], unsigned (&ob)[2]) {
        int tq = threadIdx.x; asm volatile("" : "+v"(tq));
        int Rst[2], Cst[2], Rbp[2];
#pragma unroll
        for (int i = 0; i < 2; ++i) { int R, C; stage_rc(tq * 16 + i * 8192, R, C); Rst[i] = R; Cst[i] = C; Rbp[i] = (R & ~31) + perm32(R & 31); }
        int j, sub;
        if (ui < 2) { j = 0; sub = ui; }
        else { const int qq = ui - 2, g = qq / 6, r = qq - 6 * g; if (g < ntl - 1 && r < 2) { j = g + 1; sub = r; } else { j = g; sub = (g < ntl - 1) ? r : r + 2; } }
        const int tile = M.vc + j * M.G; int e, k;
        if (sub == 0 || sub == 2) tile_expert(tile, e, k); else e = prev_e;
        u.e = e;
        const char* w = M.wexp + (size_t)e * WEXP_STRIDE;
        u.slot = j % 3; u.hbuf = j & 1; u.fillnext = (sub == 1) ? j + 1 : -1; u.shared = (e == NE) ? 1 : 0;
        if (sub < 2) { u.kind = 0; u.pn = sub; u.nt = D / 128; u.aB = M.h2n; u.bB = w + (size_t)sub * 256 * D; u.bh = 128u * D;
            const LAS int* T = M.tbl + (j % 3) * 768;
#pragma unroll
            for (int i = 0; i < 2; ++i) { oa[i] = (unsigned)T[Rst[i]] * (unsigned)D + 2u * (unsigned)Cst[i]; oa[2 + i] = (unsigned)T[128 + Rst[i]] * (unsigned)D + 2u * (unsigned)Cst[i]; ob[i] = (unsigned)(Rbp[i] * D + 2 * Cst[i]); } }
        else { u.kind = 1; u.pn = sub - 2; u.nt = DE / 128; u.aB = M.Hs + (j & 1) * 65536; u.bB = w + (size_t)512 * 1024 + (size_t)(sub - 2) * 256 * DE; u.bh = 128u * DE;
#pragma unroll
            for (int i = 0; i < 2; ++i) { oa[i] = (unsigned)(Rst[i] * DE + 2 * Cst[i]); oa[2 + i] = (unsigned)((128 + Rst[i]) * DE + 2 * Cst[i]); ob[i] = (unsigned)(Rbp[i] * DE + 2 * Cst[i]); } }
    };
#define PG8_SA(b, h) (((b) * 2 + (h)) * HTB)
#define PG8_SB(b, h) ((4 + (b) * 2 + (h)) * HTB)
#define MOE_DMA(bufoff, ptr, aux) __builtin_amdgcn_global_load_lds((const unsigned*)(ptr), (LAS unsigned*)(lds + (bufoff)), 16, 0, aux)
#define MOE_STA(bufoff, base, o0, o1) do { MOE_DMA((bufoff) + ldsw, (base) + (o0), 16); MOE_DMA((bufoff) + ldsw + 8192, (base) + (o1), 16); } while (0)
#define MOE_STAK(kindv, bufoff, base, o0, o1) do { if ((kindv) == 0) { MOE_DMA((bufoff) + ldsw, (base) + (o0), 0); MOE_DMA((bufoff) + ldsw + 8192, (base) + (o1), 0); } else MOE_STA(bufoff, base, o0, o1); } while (0)
#define MOE_STB(bufoff, base, o0, o1) do { MOE_DMA((bufoff) + ldsw, (base) + (o0), 0); MOE_DMA((bufoff) + ldsw + 8192, (base) + (o1), 0); } while (0)
#define MOE_LD32(p) __builtin_shufflevector(*(const LAS i32x4*)(p), *(const LAS i32x4*)((p) + 16), 0, 1, 2, 3, 4, 5, 6, 7)
#define PG8_LDA(dst, b, h) do { _Pragma("unroll") for (int m = 0; m < 4; ++m) dst[m] = MOE_LD32(lds + PG8_SA(b, h) + aoff + m * 2048); } while (0)
#define PG8_LDB(dst, b, h) do { _Pragma("unroll") for (int n = 0; n < 2; ++n) dst[n] = MOE_LD32(lds + PG8_SB(b, h) + boff + n * 2048); } while (0)
#define MOE_MFMA(c, a, b) asm volatile("v_mfma_scale_f32_16x16x128_f8f6f4 %0, %1, %2, %0, %3, %3 op_sel_hi:[0,0,0]" : "+v"(c) : "v"(a), "v"(b), "v"(one_scale))
#define PG8_MMA(ai, bj, At, Bt) do { __builtin_amdgcn_s_setprio(1); _Pragma("unroll") for (int m = 0; m < 4; ++m) _Pragma("unroll") for (int n = 0; n < 2; ++n) \
        MOE_MFMA(acc[ai][bj][m][n], Bt[n], At[m]); __builtin_amdgcn_s_setprio(0); } while (0)
#define PG8_WAIT_V(n) asm volatile("s_waitcnt vmcnt(" #n ")" ::: "memory")
#define PG8_WAIT_L(n) asm volatile("s_waitcnt lgkmcnt(" #n ")" ::: "memory")
#define PG8_BAR __builtin_amdgcn_s_barrier()
#define PG8_SCHED __builtin_amdgcn_sched_barrier(0)
    fill(0);
    asm volatile("s_waitcnt vmcnt(0) lgkmcnt(0)" ::: "memory");
    __syncthreads();
    UP cu, nu; unsigned oa[4], ob[2], na[4], nb[2];
    unit_params(0, 0, cu, oa, ob);
    nu = cu;
#pragma unroll
    for (int i = 0; i < 4; ++i) na[i] = oa[i];
    nb[0] = ob[0]; nb[1] = ob[1];
    f32x4 acc[2][2][4][2];
#pragma unroll
    for (int a = 0; a < 2; ++a)
#pragma unroll
        for (int b = 0; b < 2; ++b)
#pragma unroll
            for (int m = 0; m < 4; ++m)
#pragma unroll
                for (int n = 0; n < 2; ++n) acc[a][b][m][n] = (f32x4){0.f, 0.f, 0.f, 0.f};
    i32x8 At[4], B0[2], B1[2];
    int one_scale = 0x7F7F7F7F; asm volatile("" : "+v"(one_scale));
    const size_t kstep = (size_t)128;
    {   const char* cA = cu.aB; const char* cB = cu.bB;
        MOE_STB(PG8_SB(0, 0), cB, ob[0], ob[1]); MOE_STB(PG8_SB(0, 1), cB + cu.bh, ob[0], ob[1]); MOE_STAK(cu.kind, PG8_SA(0, 0), cA, oa[0], oa[1]); MOE_STAK(cu.kind, PG8_SA(0, 1), cA, oa[2], oa[3]);
        if (wr == 1) PG8_BAR;
        PG8_WAIT_V(2); PG8_BAR;
        MOE_STB(PG8_SB(1, 0), cB + kstep, ob[0], ob[1]); MOE_STAK(cu.kind, PG8_SA(1, 0), cA + kstep, oa[0], oa[1]); MOE_STB(PG8_SB(1, 1), cB + cu.bh + kstep, ob[0], ob[1]);
        PG8_WAIT_V(6); PG8_BAR; }
    for (int ui = 0;; ++ui) {
        const bool has_next = (ui + 1 < nunits);
        if (cu.fillnext >= 0) fill(cu.fillnext);
        const char* cA = cu.aB; const char* cB = cu.bB; const int nt = cu.nt; const unsigned bh = cu.bh;
        for (int t = 0; t < nt; t += 2) {
            const bool last = (t == nt - 2);
            if (last && has_next) unit_params(ui + 1, cu.e, nu, na, nb);
            const char* a1 = cA + (size_t)(t + 1) * kstep;
            const char* a2 = last ? nu.aB : cA + (size_t)(t + 2) * kstep; const char* b2 = last ? nu.bB : cB + (size_t)(t + 2) * kstep;
            const char* a3 = a2 + kstep; const char* b3 = b2 + kstep;
            const unsigned bh2 = last ? nu.bh : bh;
            const unsigned x0 = last ? na[0] : oa[0], x1 = last ? na[1] : oa[1], y0 = last ? na[2] : oa[2], y1 = last ? na[3] : oa[3];
            const unsigned z0 = last ? nb[0] : ob[0], z1 = last ? nb[1] : ob[1];
            const int k2 = last ? nu.kind : cu.kind;
            PG8_LDB(B0, 0, 0); PG8_LDB(B1, 0, 1); PG8_SCHED; PG8_LDA(At, 0, 0); MOE_STAK(cu.kind, PG8_SA(1, 1), a1, oa[2], oa[3]);
            PG8_WAIT_V(8); PG8_WAIT_L(0); PG8_BAR; PG8_MMA(0, 0, At, B0); PG8_MMA(0, 1, At, B1); PG8_BAR; PG8_SCHED;
            PG8_LDA(At, 0, 1); MOE_STB(PG8_SB(0, 0), b2, z0, z1); MOE_STB(PG8_SB(0, 1), b2 + bh2, z0, z1); MOE_STAK(k2, PG8_SA(0, 0), a2, x0, x1);
            PG8_WAIT_V(8); PG8_WAIT_L(0); PG8_BAR; PG8_MMA(1, 0, At, B0); PG8_MMA(1, 1, At, B1); PG8_BAR; PG8_SCHED;
            PG8_LDB(B0, 1, 0); PG8_LDB(B1, 1, 1); PG8_SCHED; PG8_LDA(At, 1, 0); MOE_STAK(k2, PG8_SA(0, 1), a2, y0, y1);
            PG8_WAIT_V(8); PG8_WAIT_L(0); PG8_BAR; PG8_MMA(0, 0, At, B0); PG8_MMA(0, 1, At, B1); PG8_BAR; PG8_SCHED;
            PG8_LDA(At, 1, 1); MOE_STB(PG8_SB(1, 0), b3, z0, z1); MOE_STB(PG8_SB(1, 1), b3 + bh2, z0, z1); MOE_STAK(k2, PG8_SA(1, 0), a3, x0, x1);
            PG8_WAIT_V(8); PG8_WAIT_L(0); PG8_BAR; PG8_MMA(1, 0, At, B0); PG8_MMA(1, 1, At, B1); PG8_BAR; PG8_SCHED;
        }
        if (wr == 0) PG8_BAR;
        asm volatile("s_nop 15\n\ts_nop 15" ::: "memory");
        if (cu.kind == 0) {
            const int row0 = wr * 64 + fr; const int col0 = cu.pn * 128 + wc * 32 + 8 * fq;
            constexpr float is13 = 1.f / SW13;
#pragma unroll
            for (int ai = 0; ai < 2; ++ai)
#pragma unroll
                for (int m = 0; m < 4; ++m) { unsigned char* rowp = (unsigned char*)M.Hs + cu.hbuf * 65536 + (size_t)(row0 + ai * HALF + m * 16) * 256 + col0;
                    f32x4 h0, h1;
#pragma unroll
                    for (int j = 0; j < 4; ++j) { h0[j] = siluf_(acc[ai][0][m][0][j] * is13) * (acc[ai][1][m][0][j] * (is13 * SHS)); h1[j] = siluf_(acc[ai][0][m][1][j] * is13) * (acc[ai][1][m][1][j] * (is13 * SHS)); }
                    u32x2 w; w.x = pk4_fp8(h0[0], h0[1], h0[2], h0[3]); w.y = pk4_fp8(h1[0], h1[1], h1[2], h1[3]);
                    *(u32x2*)rowp = w; }
        } else {
            const LAS int* rtok = M.tbl + cu.slot * 768 + 256; const LAS float* rw = (const LAS float*)(M.tbl + cu.slot * 768 + 512);
            const int col0 = cu.pn * BM + wc * 32 + 8 * fq;
#pragma unroll
            for (int ai = 0; ai < 2; ++ai)
#pragma unroll
                for (int m = 0; m < 4; ++m) { const int r = wr * 64 + fr + ai * HALF + m * 16; const int ts = rtok[r]; const float w = rw[r];
                    if (ts >= 0) {
                        if (cu.shared) { const unsigned goff = (unsigned)(ts >> 11) * MODW + 5 * D + col0; const unsigned ooff = (unsigned)ts * D + col0;
#pragma unroll
                            for (int bj = 0; bj < 2; ++bj)
#pragma unroll
                                for (int n = 0; n < 2; ++n) { const f32x4 gv = *(const f32x4*)(M.mod + goff + bj * HALF + n * 4); f32x4* op = (f32x4*)(M.out + ooff + bj * HALF + n * 4);
                                    const f32x4 nv = *op + gv * acc[ai][bj][m][n] * (1.f / (SHS * SW2)); if (!M.dry_shared) *op = nv; else asm volatile("" :: "v"(nv)); }
                        } else { unsigned char* yp = M.Y + (size_t)(unsigned)ts * D + col0; const float ws_ = w * (YSCALE / (SHS * SW2));
#pragma unroll
                            for (int bj = 0; bj < 2; ++bj) { f32x4 v0 = acc[ai][bj][m][0] * ws_, v1 = acc[ai][bj][m][1] * ws_;
#pragma unroll
                                for (int j = 0; j < 4; ++j) { v0[j] = __builtin_amdgcn_fmed3f(v0[j], -448.f, 448.f); v1[j] = __builtin_amdgcn_fmed3f(v1[j], -448.f, 448.f); }
                                unsigned lo = 0u, hi = 0u;
                                lo = __builtin_amdgcn_cvt_pk_fp8_f32(v0[0], v0[1], lo, false); lo = __builtin_amdgcn_cvt_pk_fp8_f32(v0[2], v0[3], lo, true);
                                hi = __builtin_amdgcn_cvt_pk_fp8_f32(v1[0], v1[1], hi, false); hi = __builtin_amdgcn_cvt_pk_fp8_f32(v1[2], v1[3], hi, true);
                                u32x2 pk; pk.x = lo; pk.y = hi; *(u32x2*)(yp + bj * HALF) = pk; } } }
                    asm volatile("" ::: "memory"); }
        }
        if (!has_next) break;
#pragma unroll
        for (int a = 0; a < 2; ++a)
#pragma unroll
            for (int b = 0; b < 2; ++b)
#pragma unroll
                for (int m = 0; m < 4; ++m)
#pragma unroll
                    for (int n = 0; n < 2; ++n) acc[a][b][m][n] = (f32x4){0.f, 0.f, 0.f, 0.f};
        cu = nu;
#pragma unroll
        for (int i = 0; i < 4; ++i) oa[i] = na[i];
        ob[0] = nb[0]; ob[1] = nb[1];
        if (wr == 1) PG8_BAR;
    }
    PG8_WAIT_V(0);
    PG8_BAR;
#undef PG8_SA
#undef PG8_SB
#undef MOE_DMA
#undef MOE_STA
#undef MOE_STAK
#undef MOE_STB
#undef PG8_LDA
#undef PG8_LDB
#undef MOE_LD32
#undef MOE_MFMA
#undef PG8_MMA
#undef PG8_WAIT_V
#undef PG8_WAIT_L
#undef PG8_BAR
#undef PG8_SCHED
}
}

struct Ctx {
    lbyte* lds; int tid, lane, wave, G, bid;
    const Args* a;
};
#define WSP(T, off) ((T*)(A.ws + (off)))

template <class RowMap>
__device__ __forceinline__ void transpose_item(const float* W, int K, int N, bf16_t* WT, RowMap rowmap, lfloat* scr, int item, int lane) {
    const int nblk = N / 32, kb = item / nblk, nb = item % nblk, k0 = 64 * kb, n0 = 32 * nb;
#pragma unroll 8
    for (int i = 0; i < 32; ++i) { const int kk = 2 * i + (lane >> 5); scr[kk * 33 + (lane & 31)] = W[(size_t)(k0 + kk) * N + n0 + (lane & 31)]; }
    asm volatile("s_waitcnt lgkmcnt(0)" ::: "memory");
    const int c = lane & 7;
#pragma unroll
    for (int j = 0; j < 4; ++j) { const int n = (lane >> 3) + 8 * j; const lfloat* s = scr + (8 * c) * 33 + n;
        u32x4 o; o.x = pk2(s[0 * 33], s[1 * 33]); o.y = pk2(s[2 * 33], s[3 * 33]); o.z = pk2(s[4 * 33], s[5 * 33]); o.w = pk2(s[6 * 33], s[7 * 33]);
        *(u32x4*)(WT + (size_t)rowmap(n0 + n) * K + k0 + 8 * c) = o; }
    asm volatile("s_waitcnt lgkmcnt(0)" ::: "memory");
}
template <class RowMap>
__device__ __forceinline__ void transpose_item_fp8(const float* W, int K, int N, unsigned char* WT, RowMap rowmap, float sc, lfloat* scr, int item, int lane) {
    const int nblk = N / 32, kb = item / nblk, nb = item % nblk, k0 = 64 * kb, n0 = 32 * nb;
#pragma unroll 8
    for (int i = 0; i < 32; ++i) { const int kk = 2 * i + (lane >> 5); scr[kk * 33 + (lane & 31)] = W[(size_t)(k0 + kk) * N + n0 + (lane & 31)] * sc; }
    asm volatile("s_waitcnt lgkmcnt(0)" ::: "memory");
    const int c = lane & 7;
#pragma unroll
    for (int j = 0; j < 4; ++j) { const int n = (lane >> 3) + 8 * j; const lfloat* s = scr + (8 * c) * 33 + n;
        u32x2 o; o.x = pk4_fp8(s[0 * 33], s[1 * 33], s[2 * 33], s[3 * 33]); o.y = pk4_fp8(s[4 * 33], s[5 * 33], s[6 * 33], s[7 * 33]);
        *(u32x2*)(WT + (size_t)rowmap(n0 + n) * K + k0 + 8 * c) = o; }
    asm volatile("s_waitcnt lgkmcnt(0)" ::: "memory");
}
struct RowId { __device__ int operator()(int n) const { return n; } };
struct RowGLU { int base; __device__ int operator()(int n) const { return ((n >> 7) << 8) + base + (n & 127); } };

__device__ __forceinline__ void norm_mod_row(const float* xrow, const float* g, const float* sc, const float* sh, bf16_t* orow, int lane, unsigned* o8row = nullptr) {
    const f32x4* xr = (const f32x4*)xrow + lane;
    f32x4 v[4]; float s = 0.f;
#pragma unroll
    for (int j = 0; j < 4; ++j) { v[j] = xr[64 * j]; s += (v[j].x * v[j].x + v[j].y * v[j].y) + (v[j].z * v[j].z + v[j].w * v[j].w); }
    const float rstd = __builtin_amdgcn_rsqf(wave_sum(s) * (1.f / D) + NORM_EPS);
    u32x2* o8 = (u32x2*)orow + lane;
#pragma unroll
    for (int j = 0; j < 4; ++j) { const f32x4 gg = ((const f32x4*)g)[lane + 64 * j], ss = ((const f32x4*)sc)[lane + 64 * j], hh = ((const f32x4*)sh)[lane + 64 * j];
        const f32x4 y = v[j] * rstd * gg * (ss + 1.f) + hh;
        if (orow) { u32x2 w; w.x = pk2(y.x, y.y); w.y = pk2(y.z, y.w); o8[64 * j] = w; }
        if (o8row) o8row[lane + 64 * j] = pk4_fp8(y.x, y.y, y.z, y.w); }
}

__device__ __forceinline__ void phase_p0(const Args& A, Ctx& C) {
    float* mod = WSP(float, WS_MOD);
    {
        lfloat* sc = (lfloat*)C.lds;
        lfloat* red = (lfloat*)(C.lds + 17 * 1024 * 4);
        const float* wada = A.in[I_WADA]; const float* bada = A.in[I_BADA];
        for (int it = C.bid; it < 96 * 2; it += C.G) {
            const int chunk = it >> 1, pass = it & 1, r0 = pass * 17, nr = pass ? 16 : 17, col0 = chunk * 64;
            __syncthreads();
            for (int i = C.tid; i < nr * 1024; i += 512) { const int r = i >> 10, k = i & 1023; const int rr = r0 + r;
                const float cv = rr < 32 ? A.in[I_C][rr * 1024 + k] : A.in[I_CCTX][k]; sc[r * 1024 + k] = siluf_(cv); }
            __syncthreads();
            const int col = C.tid & 63, kq = C.tid >> 6;
            float acc[17];
#pragma unroll
            for (int r = 0; r < 17; ++r) acc[r] = 0.f;
            for (int k = kq * 128; k < kq * 128 + 128; k += 4) {
                float w[4];
#pragma unroll
                for (int j = 0; j < 4; ++j) w[j] = wada[(size_t)(k + j) * MODW + col0 + col];
#pragma unroll
                for (int r = 0; r < 17; ++r) { const f32x4 s4 = *(const LAS f32x4*)(sc + r * 1024 + k); acc[r] += s4.x * w[0] + s4.y * w[1] + s4.z * w[2] + s4.w * w[3]; }
            }
#pragma unroll
            for (int r = 0; r < 17; ++r) red[(kq * 17 + r) * 64 + col] = acc[r];
            __syncthreads();
            for (int i = C.tid; i < nr * 64; i += 512) { const int r = i >> 6, cc = i & 63; float s = 0.f;
#pragma unroll
                for (int q = 0; q < 8; ++q) s += red[(q * 17 + r) * 64 + cc];
                mod[(size_t)(r0 + r) * MODW + col0 + cc] = s + bada[col0 + cc]; }
        }
        __syncthreads();
    }
    {
        lfloat* scr = (lfloat*)(C.lds + C.wave * 16384);
        const int gw = C.bid * 8 + C.wave, NGW = C.G * 8;
        unsigned char* btin8 = A.ws + WS_BTIN; bf16_t* btout = WSP(bf16_t, WS_BTOUT); bf16_t* btr = WSP(bf16_t, WS_BTR);
        constexpr int I_IN = (D / 64) * 124, I_OUT = (D / 64) * (D / 32), I_R = (D / 64) * (NE / 32), I_G = (128 / 64) * (DA / 32);
        for (int it = gw; it < I_IN + I_OUT + I_R + I_G; it += NGW) {
            int r = it;
            if (r < I_IN) {
                const int kb = r / 124, nb = r % 124, k0 = 64 * kb, n0 = 32 * nb; const float* W = A.in[I_WIN];
#pragma unroll 8
                for (int i = 0; i < 32; ++i) { const int kk = 2 * i + (C.lane >> 5); scr[kk * 33 + (C.lane & 31)] = W[(size_t)(k0 + kk) * IN_COLS + n0 + (C.lane & 31)] * SWIN; }
                asm volatile("s_waitcnt lgkmcnt(0)" ::: "memory");
                const int c = C.lane & 7;
#pragma unroll
                for (int j = 0; j < 4; ++j) { const int n = (C.lane >> 3) + 8 * j; const lfloat* s = scr + (8 * c) * 33 + n;
                    u32x2 o; o.x = pk4_fp8(s[0 * 33], s[1 * 33], s[2 * 33], s[3 * 33]); o.y = pk4_fp8(s[4 * 33], s[5 * 33], s[6 * 33], s[7 * 33]);
                    *(u32x2*)(btin8 + (size_t)(n0 + n) * D + k0 + 8 * c) = o; }
                asm volatile("s_waitcnt lgkmcnt(0)" ::: "memory");
                continue; }
            r -= I_IN;
            if (r < I_OUT) { transpose_item(A.in[I_WOUT], D, D, btout, RowId(), scr, r, C.lane); continue; } r -= I_OUT;
            if (r < I_R) { transpose_item(A.in[I_RW], D, NE, btr, RowId(), scr, r, C.lane); continue; } r -= I_R;
            transpose_item(A.in[I_GUP], 128, DA, WSP(bf16_t, WS_GUPT), RowId(), scr, r, C.lane);
        }
        for (int i = C.bid * 512 + C.tid; i < 16 * D / 4; i += C.G * 512) { const int n = 3968 + (i >> 8), k = (i & 255) * 4; const float* W = A.in[I_WIN];
            *(unsigned*)(btin8 + (size_t)n * D + k) = pk4_fp8(W[(size_t)k * IN_COLS + n] * SWIN, W[(size_t)(k + 1) * IN_COLS + n] * SWIN, W[(size_t)(k + 2) * IN_COLS + n] * SWIN, W[(size_t)(k + 3) * IN_COLS + n] * SWIN); }
        for (int i = C.bid * 512 + C.tid; i < (PLD - IN_COLS) * D / 16; i += C.G * 512) ((u32x4*)(btin8 + (size_t)IN_COLS * D))[i] = (u32x4){0u, 0u, 0u, 0u};
    }
}

__device__ __forceinline__ void phase_p1(const Args& A, Ctx& C) {
    const float* mod = WSP(float, WS_MOD); bf16_t* xn = WSP(bf16_t, WS_XN);
    const int gw = C.bid * 8 + C.wave, NGW = C.G * 8;
    for (int row = gw; row < NROWS; row += NGW) {
        const float* xr; int mb;
        if (row < NLAT) { xr = A.in[I_X] + (size_t)row * D; mb = row >> 11; } else { xr = A.in[I_CTX] + (size_t)(row - NLAT) * D; mb = 32; }
        const float* m = mod + (size_t)mb * MODW;
        norm_mod_row(xr, A.in[I_N1G], m + D, m, nullptr, C.lane, (unsigned*)(A.ws + WS_XN) + (size_t)row * (D / 4));
    }
}

__device__ __forceinline__ float bfsel(unsigned w, unsigned sh) { return __builtin_bit_cast(float, (w << sh) & 0xffff0000u); }
template <int NK>
__device__ __forceinline__ f32x4 mm_tile(const lbyte* Ap, int lda, const lbyte* Bp, int ldb, f32x4 acc, int lane) {
    const int r = lane & 15, g = lane >> 4;
#pragma unroll
    for (int ks = 0; ks < NK; ++ks) {
        const bf16x8 a = *(const LAS bf16x8*)(Ap + r * lda + ks * 64 + g * 16);
        const bf16x8 b = *(const LAS bf16x8*)(Bp + r * ldb + ks * 64 + g * 16);
        acc = __builtin_amdgcn_mfma_f32_16x16x32_bf16(a, b, acc, 0, 0, 0);
    }
    return acc;
}

__device__ __forceinline__ void st_bf16x4(lbyte* p, f32x4 v) { u32x2 w; w.x = cvtpk(v.x, v.y); w.y = cvtpk(v.z, v.w); *(LAS u32x2*)p = w; }
__device__ __forceinline__ void st_bf16(lbyte* p, float v) { *(LAS unsigned short*)p = (unsigned short)cvtpk(v, v); }
__device__ __forceinline__ float rdlane(float v, int l) { return __builtin_bit_cast(float, __builtin_amdgcn_readlane(__builtin_bit_cast(int, v), l)); }

__device__ __forceinline__ void tri_inv16(const f32x4 m, int lane, lbyte* scr, float (&X)[16]) {
    *(LAS f32x4*)(scr + (lane & 15) * 64 + (lane >> 4) * 16) = m;
    asm volatile("s_waitcnt lgkmcnt(0)" ::: "memory");
    float Mr[16];
#pragma unroll
    for (int kq = 0; kq < 4; ++kq) { const f32x4 r = *(const LAS f32x4*)(scr + (lane & 15) * 64 + kq * 16); Mr[4 * kq] = r.x; Mr[4 * kq + 1] = r.y; Mr[4 * kq + 2] = r.z; Mr[4 * kq + 3] = r.w; }
    const int l16 = lane & 15;
    X[0] = (l16 == 0) ? 1.f : 0.f;
    { float a0 = (l16 == 1) ? 1.f : 0.f, a1 = 0.f, a2 = 0.f, a3 = 0.f;
      asm("s_nop 1\n\t" "v_fmac_f32_dpp %0, -%2, %3 row_newbcast:1 row_mask:0xf bank_mask:0xf\n\t" : "+v"(a0), "+v"(a1) : "v"(Mr[0]), "v"(X[0]));
      X[1] = (a0 + a1) + (a2 + a3); }
    { float a0 = (l16 == 2) ? 1.f : 0.f, a1 = 0.f, a2 = 0.f, a3 = 0.f;
      asm("s_nop 1\n\t" "v_fmac_f32_dpp %0, -%2, %3 row_newbcast:2 row_mask:0xf bank_mask:0xf\n\t" "v_fmac_f32_dpp %1, -%4, %5 row_newbcast:2 row_mask:0xf bank_mask:0xf\n\t" : "+v"(a0), "+v"(a1) : "v"(Mr[0]), "v"(X[0]), "v"(Mr[1]), "v"(X[1]));
      X[2] = (a0 + a1) + (a2 + a3); }
    { float a0 = (l16 == 3) ? 1.f : 0.f, a1 = 0.f, a2 = 0.f, a3 = 0.f;
      asm("s_nop 1\n\t" "v_fmac_f32_dpp %0, -%2, %3 row_newbcast:3 row_mask:0xf bank_mask:0xf\n\t" "v_fmac_f32_dpp %1, -%4, %5 row_newbcast:3 row_mask:0xf bank_mask:0xf\n\t" : "+v"(a0), "+v"(a1) : "v"(Mr[0]), "v"(X[0]), "v"(Mr[1]), "v"(X[1]));
      asm("s_nop 1\n\t" "v_fmac_f32_dpp %0, -%2, %3 row_newbcast:3 row_mask:0xf bank_mask:0xf\n\t" : "+v"(a2), "+v"(a3) : "v"(Mr[2]), "v"(X[2]));
      X[3] = (a0 + a1) + (a2 + a3); }
    { float a0 = (l16 == 4) ? 1.f : 0.f, a1 = 0.f, a2 = 0.f, a3 = 0.f;
      asm("s_nop 1\n\t" "v_fmac_f32_dpp %0, -%2, %3 row_newbcast:4 row_mask:0xf bank_mask:0xf\n\t" "v_fmac_f32_dpp %1, -%4, %5 row_newbcast:4 row_mask:0xf bank_mask:0xf\n\t" : "+v"(a0), "+v"(a1) : "v"(Mr[0]), "v"(X[0]), "v"(Mr[1]), "v"(X[1]));
      asm("s_nop 1\n\t" "v_fmac_f32_dpp %0, -%2, %3 row_newbcast:4 row_mask:0xf bank_mask:0xf\n\t" "v_fmac_f32_dpp %1, -%4, %5 row_newbcast:4 row_mask:0xf bank_mask:0xf\n\t" : "+v"(a2), "+v"(a3) : "v"(Mr[2]), "v"(X[2]), "v"(Mr[3]), "v"(X[3]));
      X[4] = (a0 + a1) + (a2 + a3); }
    { float a0 = (l16 == 5) ? 1.f : 0.f, a1 = 0.f, a2 = 0.f, a3 = 0.f;
      asm("s_nop 1\n\t" "v_fmac_f32_dpp %0, -%2, %3 row_newbcast:5 row_mask:0xf bank_mask:0xf\n\t" "v_fmac_f32_dpp %1, -%4, %5 row_newbcast:5 row_mask:0xf bank_mask:0xf\n\t" "v_fmac_f32_dpp %0, -%6, %7 row_newbcast:5 row_mask:0xf bank_mask:0xf\n\t" : "+v"(a0), "+v"(a1) : "v"(Mr[0]), "v"(X[0]), "v"(Mr[1]), "v"(X[1]), "v"(Mr[4]), "v"(X[4]));
      asm("s_nop 1\n\t" "v_fmac_f32_dpp %0, -%2, %3 row_newbcast:5 row_mask:0xf bank_mask:0xf\n\t" "v_fmac_f32_dpp %1, -%4, %5 row_newbcast:5 row_mask:0xf bank_mask:0xf\n\t" : "+v"(a2), "+v"(a3) : "v"(Mr[2]), "v"(X[2]), "v"(Mr[3]), "v"(X[3]));
      X[5] = (a0 + a1) + (a2 + a3); }
    { float a0 = (l16 == 6) ? 1.f : 0.f, a1 = 0.f, a2 = 0.f, a3 = 0.f;
      asm("s_nop 1\n\t" "v_fmac_f32_dpp %0, -%2, %3 row_newbcast:6 row_mask:0xf bank_mask:0xf\n\t" "v_fmac_f32_dpp %1, -%4, %5 row_newbcast:6 row_mask:0xf bank_mask:0xf\n\t" "v_fmac_f32_dpp %0, -%6, %7 row_newbcast:6 row_mask:0xf bank_mask:0xf\n\t" "v_fmac_f32_dpp %1, -%8, %9 row_newbcast:6 row_mask:0xf bank_mask:0xf\n\t" : "+v"(a0), "+v"(a1) : "v"(Mr[0]), "v"(X[0]), "v"(Mr[1]), "v"(X[1]), "v"(Mr[4]), "v"(X[4]), "v"(Mr[5]), "v"(X[5]));
      asm("s_nop 1\n\t" "v_fmac_f32_dpp %0, -%2, %3 row_newbcast:6 row_mask:0xf bank_mask:0xf\n\t" "v_fmac_f32_dpp %1, -%4, %5 row_newbcast:6 row_mask:0xf bank_mask:0xf\n\t" : "+v"(a2), "+v"(a3) : "v"(Mr[2]), "v"(X[2]), "v"(Mr[3]), "v"(X[3]));
      X[6] = (a0 + a1) + (a2 + a3); }
    { float a0 = (l16 == 7) ? 1.f : 0.f, a1 = 0.f, a2 = 0.f, a3 = 0.f;
      asm("s_nop 1\n\t" "v_fmac_f32_dpp %0, -%2, %3 row_newbcast:7 row_mask:0xf bank_mask:0xf\n\t" "v_fmac_f32_dpp %1, -%4, %5 row_newbcast:7 row_mask:0xf bank_mask:0xf\n\t" "v_fmac_f32_dpp %0, -%6, %7 row_newbcast:7 row_mask:0xf bank_mask:0xf\n\t" "v_fmac_f32_dpp %1, -%8, %9 row_newbcast:7 row_mask:0xf bank_mask:0xf\n\t" : "+v"(a0), "+v"(a1) : "v"(Mr[0]), "v"(X[0]), "v"(Mr[1]), "v"(X[1]), "v"(Mr[4]), "v"(X[4]), "v"(Mr[5]), "v"(X[5]));
      asm("s_nop 1\n\t" "v_fmac_f32_dpp %0, -%2, %3 row_newbcast:7 row_mask:0xf bank_mask:0xf\n\t" "v_fmac_f32_dpp %1, -%4, %5 row_newbcast:7 row_mask:0xf bank_mask:0xf\n\t" "v_fmac_f32_dpp %0, -%6, %7 row_newbcast:7 row_mask:0xf bank_mask:0xf\n\t" : "+v"(a2), "+v"(a3) : "v"(Mr[2]), "v"(X[2]), "v"(Mr[3]), "v"(X[3]), "v"(Mr[6]), "v"(X[6]));
      X[7] = (a0 + a1) + (a2 + a3); }
    { float a0 = (l16 == 8) ? 1.f : 0.f, a1 = 0.f, a2 = 0.f, a3 = 0.f;
      asm("s_nop 1\n\t" "v_fmac_f32_dpp %0, -%2, %3 row_newbcast:8 row_mask:0xf bank_mask:0xf\n\t" "v_fmac_f32_dpp %1, -%4, %5 row_newbcast:8 row_mask:0xf bank_mask:0xf\n\t" "v_fmac_f32_dpp %0, -%6, %7 row_newbcast:8 row_mask:0xf bank_mask:0xf\n\t" "v_fmac_f32_dpp %1, -%8, %9 row_newbcast:8 row_mask:0xf bank_mask:0xf\n\t" : "+v"(a0), "+v"(a1) : "v"(Mr[0]), "v"(X[0]), "v"(Mr[1]), "v"(X[1]), "v"(Mr[4]), "v"(X[4]), "v"(Mr[5]), "v"(X[5]));
      asm("s_nop 1\n\t" "v_fmac_f32_dpp %0, -%2, %3 row_newbcast:8 row_mask:0xf bank_mask:0xf\n\t" "v_fmac_f32_dpp %1, -%4, %5 row_newbcast:8 row_mask:0xf bank_mask:0xf\n\t" "v_fmac_f32_dpp %0, -%6, %7 row_newbcast:8 row_mask:0xf bank_mask:0xf\n\t" "v_fmac_f32_dpp %1, -%8, %9 row_newbcast:8 row_mask:0xf bank_mask:0xf\n\t" : "+v"(a2), "+v"(a3) : "v"(Mr[2]), "v"(X[2]), "v"(Mr[3]), "v"(X[3]), "v"(Mr[6]), "v"(X[6]), "v"(Mr[7]), "v"(X[7]));
      X[8] = (a0 + a1) + (a2 + a3); }
    { float a0 = (l16 == 9) ? 1.f : 0.f, a1 = 0.f, a2 = 0.f, a3 = 0.f;
      asm("s_nop 1\n\t" "v_fmac_f32_dpp %0, -%2, %3 row_newbcast:9 row_mask:0xf bank_mask:0xf\n\t" "v_fmac_f32_dpp %1, -%4, %5 row_newbcast:9 row_mask:0xf bank_mask:0xf\n\t" "v_fmac_f32_dpp %0, -%6, %7 row_newbcast:9 row_mask:0xf bank_mask:0xf\n\t" "v_fmac_f32_dpp %1, -%8, %9 row_newbcast:9 row_mask:0xf bank_mask:0xf\n\t" "v_fmac_f32_dpp %0, -%10, %11 row_newbcast:9 row_mask:0xf bank_mask:0xf\n\t" : "+v"(a0), "+v"(a1) : "v"(Mr[0]), "v"(X[0]), "v"(Mr[1]), "v"(X[1]), "v"(Mr[4]), "v"(X[4]), "v"(Mr[5]), "v"(X[5]), "v"(Mr[8]), "v"(X[8]));
      asm("s_nop 1\n\t" "v_fmac_f32_dpp %0, -%2, %3 row_newbcast:9 row_mask:0xf bank_mask:0xf\n\t" "v_fmac_f32_dpp %1, -%4, %5 row_newbcast:9 row_mask:0xf bank_mask:0xf\n\t" "v_fmac_f32_dpp %0, -%6, %7 row_newbcast:9 row_mask:0xf bank_mask:0xf\n\t" "v_fmac_f32_dpp %1, -%8, %9 row_newbcast:9 row_mask:0xf bank_mask:0xf\n\t" : "+v"(a2), "+v"(a3) : "v"(Mr[2]), "v"(X[2]), "v"(Mr[3]), "v"(X[3]), "v"(Mr[6]), "v"(X[6]), "v"(Mr[7]), "v"(X[7]));
      X[9] = (a0 + a1) + (a2 + a3); }
    { float a0 = (l16 == 10) ? 1.f : 0.f, a1 = 0.f, a2 = 0.f, a3 = 0.f;
      asm("s_nop 1\n\t" "v_fmac_f32_dpp %0, -%2, %3 row_newbcast:10 row_mask:0xf bank_mask:0xf\n\t" "v_fmac_f32_dpp %1, -%4, %5 row_newbcast:10 row_mask:0xf bank_mask:0xf\n\t" "v_fmac_f32_dpp %0, -%6, %7 row_newbcast:10 row_mask:0xf bank_mask:0xf\n\t" "v_fmac_f32_dpp %1, -%8, %9 row_newbcast:10 row_mask:0xf bank_mask:0xf\n\t" "v_fmac_f32_dpp %0, -%10, %11 row_newbcast:10 row_mask:0xf bank_mask:0xf\n\t" "v_fmac_f32_dpp %1, -%12, %13 row_newbcast:10 row_mask:0xf bank_mask:0xf\n\t" : "+v"(a0), "+v"(a1) : "v"(Mr[0]), "v"(X[0]), "v"(Mr[1]), "v"(X[1]), "v"(Mr[4]), "v"(X[4]), "v"(Mr[5]), "v"(X[5]), "v"(Mr[8]), "v"(X[8]), "v"(Mr[9]), "v"(X[9]));
      asm("s_nop 1\n\t" "v_fmac_f32_dpp %0, -%2, %3 row_newbcast:10 row_mask:0xf bank_mask:0xf\n\t" "v_fmac_f32_dpp %1, -%4, %5 row_newbcast:10 row_mask:0xf bank_mask:0xf\n\t" "v_fmac_f32_dpp %0, -%6, %7 row_newbcast:10 row_mask:0xf bank_mask:0xf\n\t" "v_fmac_f32_dpp %1, -%8, %9 row_newbcast:10 row_mask:0xf bank_mask:0xf\n\t" : "+v"(a2), "+v"(a3) : "v"(Mr[2]), "v"(X[2]), "v"(Mr[3]), "v"(X[3]), "v"(Mr[6]), "v"(X[6]), "v"(Mr[7]), "v"(X[7]));
      X[10] = (a0 + a1) + (a2 + a3); }
    { float a0 = (l16 == 11) ? 1.f : 0.f, a1 = 0.f, a2 = 0.f, a3 = 0.f;
      asm("s_nop 1\n\t" "v_fmac_f32_dpp %0, -%2, %3 row_newbcast:11 row_mask:0xf bank_mask:0xf\n\t" "v_fmac_f32_dpp %1, -%4, %5 row_newbcast:11 row_mask:0xf bank_mask:0xf\n\t" "v_fmac_f32_dpp %0, -%6, %7 row_newbcast:11 row_mask:0xf bank_mask:0xf\n\t" "v_fmac_f32_dpp %1, -%8, %9 row_newbcast:11 row_mask:0xf bank_mask:0xf\n\t" "v_fmac_f32_dpp %0, -%10, %11 row_newbcast:11 row_mask:0xf bank_mask:0xf\n\t" "v_fmac_f32_dpp %1, -%12, %13 row_newbcast:11 row_mask:0xf bank_mask:0xf\n\t" : "+v"(a0), "+v"(a1) : "v"(Mr[0]), "v"(X[0]), "v"(Mr[1]), "v"(X[1]), "v"(Mr[4]), "v"(X[4]), "v"(Mr[5]), "v"(X[5]), "v"(Mr[8]), "v"(X[8]), "v"(Mr[9]), "v"(X[9]));
      asm("s_nop 1\n\t" "v_fmac_f32_dpp %0, -%2, %3 row_newbcast:11 row_mask:0xf bank_mask:0xf\n\t" "v_fmac_f32_dpp %1, -%4, %5 row_newbcast:11 row_mask:0xf bank_mask:0xf\n\t" "v_fmac_f32_dpp %0, -%6, %7 row_newbcast:11 row_mask:0xf bank_mask:0xf\n\t" "v_fmac_f32_dpp %1, -%8, %9 row_newbcast:11 row_mask:0xf bank_mask:0xf\n\t" "v_fmac_f32_dpp %0, -%10, %11 row_newbcast:11 row_mask:0xf bank_mask:0xf\n\t" : "+v"(a2), "+v"(a3) : "v"(Mr[2]), "v"(X[2]), "v"(Mr[3]), "v"(X[3]), "v"(Mr[6]), "v"(X[6]), "v"(Mr[7]), "v"(X[7]), "v"(Mr[10]), "v"(X[10]));
      X[11] = (a0 + a1) + (a2 + a3); }
    { float a0 = (l16 == 12) ? 1.f : 0.f, a1 = 0.f, a2 = 0.f, a3 = 0.f;
      asm("s_nop 1\n\t" "v_fmac_f32_dpp %0, -%2, %3 row_newbcast:12 row_mask:0xf bank_mask:0xf\n\t" "v_fmac_f32_dpp %1, -%4, %5 row_newbcast:12 row_mask:0xf bank_mask:0xf\n\t" "v_fmac_f32_dpp %0, -%6, %7 row_newbcast:12 row_mask:0xf bank_mask:0xf\n\t" "v_fmac_f32_dpp %1, -%8, %9 row_newbcast:12 row_mask:0xf bank_mask:0xf\n\t" "v_fmac_f32_dpp %0, -%10, %11 row_newbcast:12 row_mask:0xf bank_mask:0xf\n\t" "v_fmac_f32_dpp %1, -%12, %13 row_newbcast:12 row_mask:0xf bank_mask:0xf\n\t" : "+v"(a0), "+v"(a1) : "v"(Mr[0]), "v"(X[0]), "v"(Mr[1]), "v"(X[1]), "v"(Mr[4]), "v"(X[4]), "v"(Mr[5]), "v"(X[5]), "v"(Mr[8]), "v"(X[8]), "v"(Mr[9]), "v"(X[9]));
      asm("s_nop 1\n\t" "v_fmac_f32_dpp %0, -%2, %3 row_newbcast:12 row_mask:0xf bank_mask:0xf\n\t" "v_fmac_f32_dpp %1, -%4, %5 row_newbcast:12 row_mask:0xf bank_mask:0xf\n\t" "v_fmac_f32_dpp %0, -%6, %7 row_newbcast:12 row_mask:0xf bank_mask:0xf\n\t" "v_fmac_f32_dpp %1, -%8, %9 row_newbcast:12 row_mask:0xf bank_mask:0xf\n\t" "v_fmac_f32_dpp %0, -%10, %11 row_newbcast:12 row_mask:0xf bank_mask:0xf\n\t" "v_fmac_f32_dpp %1, -%12, %13 row_newbcast:12 row_mask:0xf bank_mask:0xf\n\t" : "+v"(a2), "+v"(a3) : "v"(Mr[2]), "v"(X[2]), "v"(Mr[3]), "v"(X[3]), "v"(Mr[6]), "v"(X[6]), "v"(Mr[7]), "v"(X[7]), "v"(Mr[10]), "v"(X[10]), "v"(Mr[11]), "v"(X[11]));
      X[12] = (a0 + a1) + (a2 + a3); }
    { float a0 = (l16 == 13) ? 1.f : 0.f, a1 = 0.f, a2 = 0.f, a3 = 0.f;
      asm("s_nop 1\n\t" "v_fmac_f32_dpp %0, -%2, %3 row_newbcast:13 row_mask:0xf bank_mask:0xf\n\t" "v_fmac_f32_dpp %1, -%4, %5 row_newbcast:13 row_mask:0xf bank_mask:0xf\n\t" "v_fmac_f32_dpp %0, -%6, %7 row_newbcast:13 row_mask:0xf bank_mask:0xf\n\t" "v_fmac_f32_dpp %1, -%8, %9 row_newbcast:13 row_mask:0xf bank_mask:0xf\n\t" "v_fmac_f32_dpp %0, -%10, %11 row_newbcast:13 row_mask:0xf bank_mask:0xf\n\t" "v_fmac_f32_dpp %1, -%12, %13 row_newbcast:13 row_mask:0xf bank_mask:0xf\n\t" "v_fmac_f32_dpp %0, -%14, %15 row_newbcast:13 row_mask:0xf bank_mask:0xf\n\t" : "+v"(a0), "+v"(a1) : "v"(Mr[0]), "v"(X[0]), "v"(Mr[1]), "v"(X[1]), "v"(Mr[4]), "v"(X[4]), "v"(Mr[5]), "v"(X[5]), "v"(Mr[8]), "v"(X[8]), "v"(Mr[9]), "v"(X[9]), "v"(Mr[12]), "v"(X[12]));
      asm("s_nop 1\n\t" "v_fmac_f32_dpp %0, -%2, %3 row_newbcast:13 row_mask:0xf bank_mask:0xf\n\t" "v_fmac_f32_dpp %1, -%4, %5 row_newbcast:13 row_mask:0xf bank_mask:0xf\n\t" "v_fmac_f32_dpp %0, -%6, %7 row_newbcast:13 row_mask:0xf bank_mask:0xf\n\t" "v_fmac_f32_dpp %1, -%8, %9 row_newbcast:13 row_mask:0xf bank_mask:0xf\n\t" "v_fmac_f32_dpp %0, -%10, %11 row_newbcast:13 row_mask:0xf bank_mask:0xf\n\t" "v_fmac_f32_dpp %1, -%12, %13 row_newbcast:13 row_mask:0xf bank_mask:0xf\n\t" : "+v"(a2), "+v"(a3) : "v"(Mr[2]), "v"(X[2]), "v"(Mr[3]), "v"(X[3]), "v"(Mr[6]), "v"(X[6]), "v"(Mr[7]), "v"(X[7]), "v"(Mr[10]), "v"(X[10]), "v"(Mr[11]), "v"(X[11]));
      X[13] = (a0 + a1) + (a2 + a3); }
    { float a0 = (l16 == 14) ? 1.f : 0.f, a1 = 0.f, a2 = 0.f, a3 = 0.f;
      asm("s_nop 1\n\t" "v_fmac_f32_dpp %0, -%2, %3 row_newbcast:14 row_mask:0xf bank_mask:0xf\n\t" "v_fmac_f32_dpp %1, -%4, %5 row_newbcast:14 row_mask:0xf bank_mask:0xf\n\t" "v_fmac_f32_dpp %0, -%6, %7 row_newbcast:14 row_mask:0xf bank_mask:0xf\n\t" "v_fmac_f32_dpp %1, -%8, %9 row_newbcast:14 row_mask:0xf bank_mask:0xf\n\t" "v_fmac_f32_dpp %0, -%10, %11 row_newbcast:14 row_mask:0xf bank_mask:0xf\n\t" "v_fmac_f32_dpp %1, -%12, %13 row_newbcast:14 row_mask:0xf bank_mask:0xf\n\t" "v_fmac_f32_dpp %0, -%14, %15 row_newbcast:14 row_mask:0xf bank_mask:0xf\n\t" "v_fmac_f32_dpp %1, -%16, %17 row_newbcast:14 row_mask:0xf bank_mask:0xf\n\t" : "+v"(a0), "+v"(a1) : "v"(Mr[0]), "v"(X[0]), "v"(Mr[1]), "v"(X[1]), "v"(Mr[4]), "v"(X[4]), "v"(Mr[5]), "v"(X[5]), "v"(Mr[8]), "v"(X[8]), "v"(Mr[9]), "v"(X[9]), "v"(Mr[12]), "v"(X[12]), "v"(Mr[13]), "v"(X[13]));
      asm("s_nop 1\n\t" "v_fmac_f32_dpp %0, -%2, %3 row_newbcast:14 row_mask:0xf bank_mask:0xf\n\t" "v_fmac_f32_dpp %1, -%4, %5 row_newbcast:14 row_mask:0xf bank_mask:0xf\n\t" "v_fmac_f32_dpp %0, -%6, %7 row_newbcast:14 row_mask:0xf bank_mask:0xf\n\t" "v_fmac_f32_dpp %1, -%8, %9 row_newbcast:14 row_mask:0xf bank_mask:0xf\n\t" "v_fmac_f32_dpp %0, -%10, %11 row_newbcast:14 row_mask:0xf bank_mask:0xf\n\t" "v_fmac_f32_dpp %1, -%12, %13 row_newbcast:14 row_mask:0xf bank_mask:0xf\n\t" : "+v"(a2), "+v"(a3) : "v"(Mr[2]), "v"(X[2]), "v"(Mr[3]), "v"(X[3]), "v"(Mr[6]), "v"(X[6]), "v"(Mr[7]), "v"(X[7]), "v"(Mr[10]), "v"(X[10]), "v"(Mr[11]), "v"(X[11]));
      X[14] = (a0 + a1) + (a2 + a3); }
    { float a0 = (l16 == 15) ? 1.f : 0.f, a1 = 0.f, a2 = 0.f, a3 = 0.f;
      asm("s_nop 1\n\t" "v_fmac_f32_dpp %0, -%2, %3 row_newbcast:15 row_mask:0xf bank_mask:0xf\n\t" "v_fmac_f32_dpp %1, -%4, %5 row_newbcast:15 row_mask:0xf bank_mask:0xf\n\t" "v_fmac_f32_dpp %0, -%6, %7 row_newbcast:15 row_mask:0xf bank_mask:0xf\n\t" "v_fmac_f32_dpp %1, -%8, %9 row_newbcast:15 row_mask:0xf bank_mask:0xf\n\t" "v_fmac_f32_dpp %0, -%10, %11 row_newbcast:15 row_mask:0xf bank_mask:0xf\n\t" "v_fmac_f32_dpp %1, -%12, %13 row_newbcast:15 row_mask:0xf bank_mask:0xf\n\t" "v_fmac_f32_dpp %0, -%14, %15 row_newbcast:15 row_mask:0xf bank_mask:0xf\n\t" "v_fmac_f32_dpp %1, -%16, %17 row_newbcast:15 row_mask:0xf bank_mask:0xf\n\t" : "+v"(a0), "+v"(a1) : "v"(Mr[0]), "v"(X[0]), "v"(Mr[1]), "v"(X[1]), "v"(Mr[4]), "v"(X[4]), "v"(Mr[5]), "v"(X[5]), "v"(Mr[8]), "v"(X[8]), "v"(Mr[9]), "v"(X[9]), "v"(Mr[12]), "v"(X[12]), "v"(Mr[13]), "v"(X[13]));
      asm("s_nop 1\n\t" "v_fmac_f32_dpp %0, -%2, %3 row_newbcast:15 row_mask:0xf bank_mask:0xf\n\t" "v_fmac_f32_dpp %1, -%4, %5 row_newbcast:15 row_mask:0xf bank_mask:0xf\n\t" "v_fmac_f32_dpp %0, -%6, %7 row_newbcast:15 row_mask:0xf bank_mask:0xf\n\t" "v_fmac_f32_dpp %1, -%8, %9 row_newbcast:15 row_mask:0xf bank_mask:0xf\n\t" "v_fmac_f32_dpp %0, -%10, %11 row_newbcast:15 row_mask:0xf bank_mask:0xf\n\t" "v_fmac_f32_dpp %1, -%12, %13 row_newbcast:15 row_mask:0xf bank_mask:0xf\n\t" "v_fmac_f32_dpp %0, -%14, %15 row_newbcast:15 row_mask:0xf bank_mask:0xf\n\t" : "+v"(a2), "+v"(a3) : "v"(Mr[2]), "v"(X[2]), "v"(Mr[3]), "v"(X[3]), "v"(Mr[6]), "v"(X[6]), "v"(Mr[7]), "v"(X[7]), "v"(Mr[10]), "v"(X[10]), "v"(Mr[11]), "v"(X[11]), "v"(Mr[14]), "v"(X[14]));
      X[15] = (a0 + a1) + (a2 + a3); }
}

#ifndef RWKV_REP
#define RWKV_REP 1
#endif
namespace rk {
constexpr int S64 = 160, S32 = 80, SW = 144;
constexpr int O_WUP = 0, O_AUP = O_WUP + 64 * SW, O_WLT = O_AUP + 64 * SW, O_ALT = O_WLT + 16 * S64, O_LW = O_ALT + 16 * S64, O_LA = O_LW + 4096,
              O_KKT = O_LA + 4096, O_RT = O_KKT + 16 * S64, O_BT = O_RT + 16 * S64, O_KDT = O_BT + 16 * S64,
              O_VT = O_KDT + 16 * S64, O_BHT = O_VT + 64 * S32, O_KHT = O_BHT + 64 * S32, O_UT = O_KHT + 64 * S32, O_UTT = O_WLT  ,
              O_TI = O_UT + 64 * S32, O_MK = O_TI + 16 * S32, O_NB = O_MK + 16 * S32, O_NK = O_NB + 16 * S32,
              O_SBF = O_NK + 16 * S32, O_WC = O_SBF + 64 * S64, O_WT = O_WC + 256, TEAM_BYTES = O_WT + 1024;
static_assert(2 * TEAM_BYTES <= LDS_MISC, "rwkv LDS");
}
__device__ __forceinline__ void rwkv_pair_chunked(const Args& A, Ctx& C, int pair) {
    using namespace rk;
    const int b = pair >> 3, h = pair & 7;
    const int dir = C.wave >> 2;
    const int t4 = C.tid & 255, q = C.wave & 3, lane = C.lane;
    lbyte* L = C.lds + dir * TEAM_BYTES;
    const bf16_t* P = WSP(bf16_t, WS_P);
    bf16_t* ydir = WSP(bf16_t, WS_YDIR) + (size_t)dir * NLAT * D;
    float* bon = WSP(float, WS_BON) + (size_t)dir * NLAT * 8;
    __syncthreads();
#pragma unroll 2
    for (int i = t4; i < 4096; i += 256) { const int l = i >> 6, c = i & 63;
        st_bf16(L + O_WUP + c * SW + l * 2, A.in[I_WUP][((size_t)dir * 64 + l) * DA + 64 * h + c]);
        st_bf16(L + O_AUP + c * SW + l * 2, A.in[I_AUP][((size_t)dir * 64 + l) * DA + 64 * h + c]); }
#pragma unroll 2
    for (int i = t4; i < (4 * 64 * S32 + 4 * 16 * S32 + 64 * S64) / 4; i += 256) ((LAS unsigned*)(L + O_VT))[i] = 0u;
    for (int i = t4; i < (2 * 16 * S64) / 4; i += 256) ((LAS unsigned*)(L + O_WLT))[i] = 0u;
    const int c = lane;
    const int col5[5] = {64 * h + c, 512 + 64 * h + c, 1024 + 64 * h + c, 1536 + 64 * dir + c, 1664 + 64 * dir + c};
    float mu5[5]; unsigned coff[5], nm[5], nlo[5], nrg[5]; int ndb[5];
#pragma unroll
    for (int e = 0; e < 5; ++e) { mu5[e] = A.in[I_MU][col5[e]]; coff[e] = (unsigned)col5[e] * 2u; }
    auto set_rules = [&](bool ctx) {
#pragma unroll
        for (int e = 0; e < 5; ++e) { const int col = col5[e];
            if (ctx) { nm[e] = 0xffffffffu; nlo[e] = col < 960 ? 1u : 0u; nrg[e] = (unsigned)(CTX - 2); ndb[e] = (col < 960 ? -PLD : PLD) * 2; }
            else { const int cls = col < 480 ? 0 : (col < 960 ? 1 : (col < 1440 ? 2 : 3));
                nm[e] = cls < 2 ? 63u : 0xffffffffu; nlo[e] = cls == 0 ? 1u : (cls == 2 ? 64u : 0u); nrg[e] = cls < 2 ? 62u : (unsigned)(SEQ - 65);
                ndb[e] = (cls == 0 ? -PLD : (cls == 1 ? PLD : (cls == 2 ? -64 * PLD : 64 * PLD))) * 2; } } };
    set_rules(true);
    const char* wsb = (const char*)A.ws;
    const float kkc = A.in[I_KK][64 * h + c], kac = A.in[I_KA][64 * h + c], rkc = A.in[I_RK][64 * h + c];
    const float w0c = A.in[I_W0][dir * DA + 64 * h + c], a0c = A.in[I_A0][dir * DA + 64 * h + c];
    f32x4 Sacc[4];
#pragma unroll
    for (int i = 0; i < 4; ++i) Sacc[i] = (f32x4){0.f, 0.f, 0.f, 0.f};
    const int fr = lane & 15, fg = lane >> 4;
    unsigned short rawp[4][5], raws[4][5];
    auto chunk_geom = [&](int ch, bool& isctx, int& sbase, int& T, size_t& rowbase) { isctx = ch < 16; sbase = isctx ? ch * 16 : (ch - 16) * 16; T = isctx ? CTX : SEQ; rowbase = isctx ? (size_t)NLAT + (size_t)b * CTX : (size_t)b * SEQ; };
    auto issue_loads = [&](int ch) { bool isctx; int sbase, T; size_t rowbase; chunk_geom(ch, isctx, sbase, T, rowbase);
#pragma unroll
        for (int j = 0; j < 4; ++j) { const int i = 4 * q + j; const int t = __builtin_amdgcn_readfirstlane(dir ? (T - 1 - (sbase + i)) : (sbase + i));
            const unsigned rowoff = (unsigned)WS_P + (unsigned)(rowbase + t) * (unsigned)(PLD * 2);
#pragma unroll
            for (int e = 0; e < 5; ++e) { const unsigned vs = rowoff + coff[e]; const bool ok = (((unsigned)t & nm[e]) - nlo[e]) <= nrg[e]; const unsigned vn = ok ? vs + (unsigned)ndb[e] : 8u;
                rawp[j][e] = *(const bf16_t*)(wsb + vs); raws[j][e] = *(const bf16_t*)(wsb + vn); } } };
    u32x2 ypend; ypend.x = 0u; ypend.y = 0u; float bpend[4] = {0.f, 0.f, 0.f, 0.f};
    auto flush = [&](int pch) { bool pisctx; int psb, pT; size_t prb; chunk_geom(pch, pisctx, psb, pT, prb);
        if (!pisctx) { const int t = dir ? (pT - 1 - (psb + fr)) : (psb + fr);
            *(u32x2*)(ydir + ((size_t)b * SEQ + t) * D + 64 * h + 16 * q + 4 * fg) = ypend;
            if (lane == 0) {
#pragma unroll
                for (int j = 0; j < 4; ++j) { const int i = 4 * q + j; const int tj = dir ? (pT - 1 - (psb + i)) : (psb + i); bon[((size_t)b * SEQ + tj) * 8 + h] = bpend[j]; } } } };
    issue_loads(0);
    for (int ch = 0; ch < 144; ++ch) {
        bool isctx; int sbase, T; size_t rowbase; chunk_geom(ch, isctx, sbase, T, rowbase);
        float vr[4], vk[4], vv[4], vkk[4], lw[4], av[4];
        __syncthreads();
        float mxa[4][5];
#pragma unroll
        for (int j = 0; j < 4; ++j) {
#pragma unroll
            for (int e = 0; e < 5; ++e) { const float pv = bf2f(rawp[j][e]); const float sv = bf2f(raws[j][e]); mxa[j][e] = pv + mu5[e] * (sv - pv); } }
        asm volatile("" :: "v"(mxa[0][0]), "v"(mxa[0][1]), "v"(mxa[0][2]), "v"(mxa[0][3]), "v"(mxa[0][4]), "v"(mxa[1][0]), "v"(mxa[1][1]), "v"(mxa[1][2]), "v"(mxa[1][3]), "v"(mxa[1][4]),
                        "v"(mxa[2][0]), "v"(mxa[2][1]), "v"(mxa[2][2]), "v"(mxa[2][3]), "v"(mxa[2][4]), "v"(mxa[3][0]), "v"(mxa[3][1]), "v"(mxa[3][2]), "v"(mxa[3][3]), "v"(mxa[3][4]) : "memory");
        if (ch > 0) flush(ch - 1);
        if (ch == 15) set_rules(false);
        if (ch + 1 < 144) issue_loads(ch + 1);
        float cl[4];
        _Pragma("unroll") for (int rrep = 0; rrep < RWKV_REP; ++rrep) {
#pragma unroll
        for (int j = 0; j < 4; ++j) {
            const int i = 4 * q + j;
            float mx[5];
#pragma unroll
            for (int e = 0; e < 5; ++e) mx[e] = mxa[j][e];
            vr[j] = mx[0]; vk[j] = mx[1]; vv[j] = mx[2];
            *(LAS unsigned short*)(L + O_WLT + i * S64 + c * 2) = (unsigned short)cvtpk(tanhf_(mx[3]), 0.f); *(LAS unsigned short*)(L + O_ALT + i * S64 + c * 2) = (unsigned short)cvtpk(mx[4], 0.f);
            const float kx = vk[j] * kkc; const float ss = wave_sum(kx * kx);
            vkk[j] = kx * __builtin_amdgcn_rsqf(ss + 1e-6f);
        }
        __syncthreads();
        {
            const f32x4 z = (f32x4){0.f, 0.f, 0.f, 0.f};
            const f32x4 tw = mm_tile<2>(L + O_WLT, S64, L + O_WUP + 16 * q * SW, SW, z, lane);
            const f32x4 ta = mm_tile<2>(L + O_ALT, S64, L + O_AUP + 16 * q * SW, SW, z, lane);
#pragma unroll
            for (int e = 0; e < 4; ++e) { ((LAS float*)(L + O_LW))[(4 * fg + e) * 64 + 16 * q + fr] = tw[e]; ((LAS float*)(L + O_LA))[(4 * fg + e) * 64 + 16 * q + fr] = ta[e]; }
        }
        __syncthreads();
        { float run = 0.f;
#pragma unroll
        for (int j = 0; j < 4; ++j) { const int i = 4 * q + j;
            const float wlog = -softplusf_(-(w0c + ((LAS float*)(L + O_LW))[i * 64 + c])) - 0.5f;
            lw[j] = -__expf(wlog);
            av[j] = sigmoidf_(a0c + ((LAS float*)(L + O_LA))[i * 64 + c]);
            run += lw[j]; cl[j] = run; }
        ((LAS float*)(L + O_WT))[q * 64 + c] = run; }
        __syncthreads();
        }
        {
            float off = 0.f, cumC = 0.f;
#pragma unroll
            for (int qq = 0; qq < 4; ++qq) { const float tv = ((LAS float*)(L + O_WT))[qq * 64 + c]; cumC += tv; off += (qq < q) ? tv : 0.f; }
            float tv_[4], tb_[4], tk_[4];
            float Wprev = __expf(off); const float eC = __expf(cumC);
#pragma unroll
            for (int j = 0; j < 4; ++j) { const int i = 4 * q + j;
                const float cum = off + cl[j];
                const float Wt = __expf(cum), Wp = Wprev, Wi = __builtin_amdgcn_rcpf(Wt), Wc = eC * Wi; Wprev = Wt;
                const float kd = vk[j] * (1.f + (av[j] - 1.f) * kac), bb = vkk[j] * av[j];
                const unsigned p0 = cvtpk(vkk[j] * Wp, vr[j] * Wt), p1 = cvtpk(bb * Wi, kd * Wi);
                *(LAS unsigned short*)(L + O_KKT + i * S64 + c * 2) = (unsigned short)p0; *(LAS unsigned short*)(L + O_RT + i * S64 + c * 2) = (unsigned short)(p0 >> 16);
                *(LAS unsigned short*)(L + O_BT + i * S64 + c * 2) = (unsigned short)p1; *(LAS unsigned short*)(L + O_KDT + i * S64 + c * 2) = (unsigned short)(p1 >> 16);
                tv_[j] = vv[j]; tb_[j] = bb * Wc; tk_[j] = kd * Wc;
                const float bs = wave_sum(vr[j] * kd * rkc);
                bpend[j] = bs;
            }
            { u32x2 w2;
                w2.x = cvtpk(tv_[0], tv_[1]); w2.y = cvtpk(tv_[2], tv_[3]); *(LAS u32x2*)(L + O_VT + c * S32 + q * 8) = w2;
                w2.x = cvtpk(tb_[0], tb_[1]); w2.y = cvtpk(tb_[2], tb_[3]); *(LAS u32x2*)(L + O_BHT + c * S32 + q * 8) = w2;
                w2.x = cvtpk(tk_[0], tk_[1]); w2.y = cvtpk(tk_[2], tk_[3]); *(LAS u32x2*)(L + O_KHT + c * S32 + q * 8) = w2; }
            if (q == 3) ((LAS float*)(L + O_WC))[c] = eC;
        }
        __syncthreads();
        {
            const int role = (q + dir) & 3;
            const lbyte* Aj = L + ((role & 1) ? O_KDT : O_BT);
            const lbyte* Bt = L + ((role & 2) ? O_RT : O_KKT);
            f32x4 g4 = mm_tile<2>(Aj, S64, Bt, S64, (f32x4){0.f, 0.f, 0.f, 0.f}, lane);
#pragma unroll
            for (int e = 0; e < 4; ++e) { const int j = 4 * fg + e; const bool keep = (role & 2) ? (j <= fr) : (j < fr); g4[e] = keep ? g4[e] : 0.f; }
            if (role == 0) { float X[16]; tri_inv16(g4, lane, L + O_LW, X);
                if (lane < 16) {
#pragma unroll
                    for (int i = 0; i < 16; ++i) *(LAS unsigned short*)(L + O_TI + i * S32 + lane * 2) = (unsigned short)cvtpk(X[i], 0.f); } }
            else st_bf16x4(L + (role == 1 ? O_MK : (role == 2 ? O_NB : O_NK)) + fr * S32 + fg * 8, g4);
        }
        __syncthreads();
        f32x4 yacc;
        {
            f32x4 u4 = mm_tile<2>(L + O_KKT, S64, L + O_SBF + 16 * q * S64, S64, (f32x4){0.f, 0.f, 0.f, 0.f}, lane);
            u4 = mm_tile<1>(L + O_MK, S32, L + O_VT + 16 * q * S32, S32, u4, lane);
            st_bf16x4(L + O_UTT + (16 * q + fr) * S32 + fg * 8, u4);
            yacc = mm_tile<2>(L + O_SBF + 16 * q * S64, S64, L + O_RT, S64, (f32x4){0.f, 0.f, 0.f, 0.f}, lane);
            yacc = mm_tile<1>(L + O_VT + 16 * q * S32, S32, L + O_NK, S32, yacc, lane);
        }
        asm volatile("s_waitcnt lgkmcnt(0)" ::: "memory");
        {
            f32x4 u4 = mm_tile<1>(L + O_TI, S32, L + O_UTT + 16 * q * S32, S32, (f32x4){0.f, 0.f, 0.f, 0.f}, lane);
            st_bf16x4(L + O_UT + (16 * q + fr) * S32 + fg * 8, -u4);
        }
        __syncthreads();
        {
            yacc = mm_tile<1>(L + O_UT + 16 * q * S32, S32, L + O_NB, S32, yacc, lane);
            ypend.x = cvtpk(yacc[0], yacc[1]); ypend.y = cvtpk(yacc[2], yacc[3]);
            const f32x4 wc4 = *(LAS f32x4*)(L + O_WC + (16 * q + 4 * fg) * 4);
#pragma unroll
            for (int vi = 0; vi < 4; ++vi) {
                f32x4 s4 = Sacc[vi] * wc4;
                s4 = mm_tile<1>(L + O_KHT + 16 * q * S32, S32, L + O_VT + 16 * vi * S32, S32, s4, lane);
                s4 = mm_tile<1>(L + O_BHT + 16 * q * S32, S32, L + O_UT + 16 * vi * S32, S32, s4, lane);
                Sacc[vi] = s4;
                st_bf16x4(L + O_SBF + (16 * vi + fr) * S64 + (16 * q + 4 * fg) * 2, s4);
            }
        }
    }
    flush(143);
    __syncthreads();
}

__device__ __forceinline__ void phase_gdn_prep(const Args& A, Ctx& C) {
    const bf16_t* P = WSP(bf16_t, WS_P);
    bf16_t* QKV = (bf16_t*)A.out; float* NRM = WSP(float, WS_NRM);
    const int lane = C.lane, w = C.wave, hq = w >> 1, th = w & 1;
    const int ch0 = 128 * hq + 2 * lane;
    float cw[3][2][5];
#pragma unroll
    for (int g = 0; g < 3; ++g)
#pragma unroll
        for (int xx = 0; xx < 2; ++xx)
#pragma unroll
            for (int e = 0; e < 5; ++e) cw[g][xx][e] = A.in[I_CONVW][e * 1536 + g * 512 + ch0 + xx];
    auto geom = [&](int tile, int& T, int& tb, size_t& rowbase) { const int row0 = tile * 16; int ta;
        if (row0 < NLAT) { T = SEQ; rowbase = (size_t)(row0 >> 11) * SEQ; ta = row0 & (SEQ - 1); } else { T = CTX; const int r = row0 - NLAT; rowbase = (size_t)NLAT + (size_t)(r >> 8) * CTX; ta = r & (CTX - 1); }
        tb = ta + 8 * th; };
    unsigned raw[12][3];
    auto issue = [&](int tile) { int T, tb; size_t rowbase; geom(tile, T, tb, rowbase);
#pragma unroll
        for (int e = 0; e < 12; ++e) { const int t = tb - 2 + e; const bool ok = (t >= 0 && t < T); const unsigned* pr = (const unsigned*)(P + (rowbase + (ok ? t : tb)) * PLD + RW_COLS + ch0);
#pragma unroll
            for (int g = 0; g < 3; ++g) raw[e][g] = pr[g * 256]; } };
    if (C.bid < NROWS / 16) issue(C.bid);
    for (int tile = C.bid; tile < NROWS / 16; tile += C.G) {
        int T, tb; size_t rowbase; geom(tile, T, tb, rowbase);
        float x[3][2][12];
#pragma unroll
        for (int e = 0; e < 12; ++e) { const int t = tb - 2 + e; const bool ok = (t >= 0 && t < T);
#pragma unroll
            for (int g = 0; g < 3; ++g) { const unsigned wv = raw[e][g]; x[g][0][e] = ok ? bflo(wv) : 0.f; x[g][1][e] = ok ? bfhi(wv) : 0.f; } }
        if (tile + C.G < NROWS / 16) issue(tile + C.G);
#pragma unroll
        for (int i = 0; i < 8; ++i) { float y[3][2];
#pragma unroll
            for (int g = 0; g < 3; ++g)
#pragma unroll
                for (int xx = 0; xx < 2; ++xx) { float sacc = 0.f;
#pragma unroll
                    for (int f = 0; f < 5; ++f) sacc += cw[g][xx][f] * x[g][xx][i + f];
                    y[g][xx] = siluf_(sacc); }
            const size_t row = rowbase + tb + i;
            unsigned* orow = (unsigned*)(QKV + row * 1536 + ch0);
            orow[0] = cvtpk(y[0][0], y[0][1]); orow[256] = cvtpk(y[1][0], y[1][1]); orow[512] = cvtpk(y[2][0], y[2][1]);
            const float sq = wave_sum(y[0][0] * y[0][0] + y[0][1] * y[0][1]), sk = wave_sum(y[1][0] * y[1][0] + y[1][1] * y[1][1]);
            if (lane == 0) { NRM[row * 8 + hq] = __builtin_amdgcn_rsqf(sq + 1e-6f) * 0.08838834764831845f; NRM[row * 8 + 4 + hq] = __builtin_amdgcn_rsqf(sk + 1e-6f); } }
    }
    __syncthreads();
}

namespace gd {
constexpr int S128 = 288, S32 = 80;
constexpr int O_KT = 0, O_QT = O_KT + 32 * S128, O_KKT = O_QT + 32 * S128, O_RT = O_KKT + 32 * S128,
              O_VT = O_RT + 32 * S128, O_BHT = O_VT + 128 * S32, O_KHT = O_BHT + 128 * S32, O_UT = O_KHT + 128 * S32, O_UTT = O_UT + 128 * S32,
              O_TI = O_UTT + 128 * S32, O_MK = O_TI + 32 * S32, O_NB = O_MK + 32 * S32, O_NK = O_NB + 32 * S32,
              O_M21 = O_NK + 32 * S32, O_T11T = O_M21 + 16 * S32, O_T22 = O_T11T + 16 * S32, O_XT = O_T22 + 16 * S32,
              O_SBF = O_XT + 16 * S32, O_SC = O_SBF + 128 * S128, O_MS = O_SC + 512, GD_BYTES = O_MS + 2048;
static_assert(GD_BYTES <= LDS_MISC, "gdn LDS");
}
__device__ __forceinline__ void gdn_chain_chunked(const Args& A, Ctx& C, int chain) {
    using namespace gd;
    const int b = chain >> 3, h = (chain >> 1) & 3, dir = chain & 1;
    lbyte* L = C.lds;
    LAS float* SC = (LAS float*)(L + O_SC);
    const bf16_t* P = WSP(bf16_t, WS_P);
    bf16_t* ydir = WSP(bf16_t, WS_YDIR) + (size_t)dir * NLAT * D;
    const int tid = C.tid, lane = C.lane, w = C.wave, fr = lane & 15, fg = lane >> 4;
    const int grp = w >> 1, idx = tid & 127;
    const float Aexp = __expf(A.in[I_ALOG][dir * 4 + h]), dtb = A.in[I_DTB][dir * 4 + h];
    const f32x4 z4 = (f32x4){0.f, 0.f, 0.f, 0.f};
    __syncthreads();
#pragma unroll 2
    for (int i = tid; i < (O_SC - O_VT) / 4; i += 512) ((LAS unsigned*)(L + O_VT))[i] = 0u;
    f32x4 Sacc[8];
#pragma unroll
    for (int i = 0; i < 8; ++i) Sacc[i] = z4;
    const bf16_t* QKV = (const bf16_t*)A.out; const float* NRM = WSP(const float, WS_NRM);
    unsigned rq[8], rk[8], rv[8]; float nq[8], nk[8]; unsigned raw_al = 0, raw_be = 0;
    const unsigned codd = (idx & 1) ? 0u : 16u, godd = (h & 1) ? 0u : 16u;
    auto chunk_geom = [&](int ch, bool& isctx, int& sbase, int& T, size_t& rowbase) { isctx = ch < 8; sbase = isctx ? ch * 32 : (ch - 8) * 32; T = isctx ? CTX : SEQ;
        rowbase = isctx ? (size_t)NLAT + (size_t)b * CTX : (size_t)b * SEQ; };
    auto issue_loads = [&](int ch) { bool isctx; int sbase, T; size_t rowbase; chunk_geom(ch, isctx, sbase, T, rowbase);
#pragma unroll
        for (int j = 0; j < 8; ++j) { const int i = 8 * grp + j; const int t = dir ? (T - 1 - (sbase + i)) : (sbase + i); const size_t row = rowbase + t;
            const unsigned* qr = (const unsigned*)(QKV + row * 1536 + 128 * h + (idx & ~1)); rq[j] = qr[0]; rk[j] = qr[256]; rv[j] = qr[512]; nq[j] = NRM[row * 8 + h]; nk[j] = NRM[row * 8 + 4 + h]; }
        if (w == 7 && lane < 32) { const int t = dir ? (T - 1 - (sbase + lane)) : (sbase + lane); const unsigned* pr = (const unsigned*)(P + (rowbase + t) * PLD + RW_COLS + 2048 + ((dir * 4 + h) & ~1)); raw_al = pr[0]; raw_be = pr[4]; } };
    u32x2 ypend[2]; ypend[0].x = ypend[0].y = ypend[1].x = ypend[1].y = 0u;
    auto flush = [&](int pch) { bool pisctx; int psb, pT; size_t prb; chunk_geom(pch, pisctx, psb, pT, prb);
        if (!pisctx) {
#pragma unroll
            for (int tb = 0; tb < 2; ++tb) { const int tl = psb + tb * 16 + fr; const int t = dir ? (pT - 1 - tl) : tl;
                *(u32x2*)(ydir + ((size_t)b * SEQ + t) * D + 512 + 128 * h + 16 * w + 4 * fg) = ypend[tb]; } } };
    issue_loads(0);
    for (int ch = 0; ch < 72; ++ch) {
        bool isctx; int sbase, T; size_t rowbase; chunk_geom(ch, isctx, sbase, T, rowbase);
        __syncthreads();
        float qv[8], kv[8], vv[8], nqv[8], nkv[8];
#pragma unroll
        for (int j = 0; j < 8; ++j) { qv[j] = bfsel(rq[j], codd); kv[j] = bfsel(rk[j], codd); vv[j] = bfsel(rv[j], codd); nqv[j] = nq[j]; nkv[j] = nk[j]; }
        if (w == 7) {
            const float gi = (lane < 32) ? -Aexp * softplusf_(bfsel(raw_al, godd) + dtb) : 0.f;
            float cum = gi;
            cum += __builtin_bit_cast(float, __builtin_amdgcn_update_dpp(0, __builtin_bit_cast(int, cum), 0x111, 0xf, 0xf, true));
            cum += __builtin_bit_cast(float, __builtin_amdgcn_update_dpp(0, __builtin_bit_cast(int, cum), 0x112, 0xf, 0xf, true));
            cum += __builtin_bit_cast(float, __builtin_amdgcn_update_dpp(0, __builtin_bit_cast(int, cum), 0x114, 0xf, 0xf, true));
            cum += __builtin_bit_cast(float, __builtin_amdgcn_update_dpp(0, __builtin_bit_cast(int, cum), 0x118, 0xf, 0xf, true));
            const float r0 = rdlane(cum, 15);
            cum += (lane >= 16) ? r0 : 0.f;
            if (lane < 32) { SC[lane] = sigmoidf_(bfsel(raw_be, godd)); SC[32 + lane + 1] = cum; if (lane == 0) SC[32] = 0.f; }
        }
        asm volatile("" :: "v"(qv[0]), "v"(qv[1]), "v"(qv[2]), "v"(qv[3]), "v"(qv[4]), "v"(qv[5]), "v"(qv[6]), "v"(qv[7]), "v"(kv[0]), "v"(kv[1]), "v"(kv[2]), "v"(kv[3]), "v"(kv[4]), "v"(kv[5]), "v"(kv[6]), "v"(kv[7]),
                        "v"(vv[0]), "v"(vv[1]), "v"(vv[2]), "v"(vv[3]), "v"(vv[4]), "v"(vv[5]), "v"(vv[6]), "v"(vv[7]) : "memory");
        asm volatile("" :: "v"(nqv[0]), "v"(nqv[1]), "v"(nqv[2]), "v"(nqv[3]), "v"(nqv[4]), "v"(nqv[5]), "v"(nqv[6]), "v"(nqv[7]), "v"(nkv[0]), "v"(nkv[1]), "v"(nkv[2]), "v"(nkv[3]), "v"(nkv[4]), "v"(nkv[5]), "v"(nkv[6]), "v"(nkv[7]),
                        "v"(raw_al), "v"(raw_be) : "memory");
        if (ch > 0) flush(ch - 1);
        if (ch + 1 < 72) issue_loads(ch + 1);
        __syncthreads();
        {
            const int c = idx; const float gcC = SC[32 + 32];
            float bh[8], kh[8];
#pragma unroll
            for (int j = 0; j < 8; ++j) { const int i = 8 * grp + j;
                const float kn = kv[j] * nkv[j], qn = qv[j] * nqv[j];
                const float gm = SC[32 + i], gi = SC[32 + i + 1], be = SC[i];
                const unsigned p0 = cvtpk(kn, qn), p1 = cvtpk(kn * __expf(gm), qn * __expf(gi));
                *(LAS unsigned short*)(L + O_KT + i * S128 + c * 2) = (unsigned short)p0; *(LAS unsigned short*)(L + O_QT + i * S128 + c * 2) = (unsigned short)(p0 >> 16);
                *(LAS unsigned short*)(L + O_KKT + i * S128 + c * 2) = (unsigned short)p1; *(LAS unsigned short*)(L + O_RT + i * S128 + c * 2) = (unsigned short)(p1 >> 16);
                bh[j] = be * kn * __expf(gcC - gm); kh[j] = be * kn * __expf(gcC - gi); }
            u32x4 w4;
            w4.x = cvtpk(bh[0], bh[1]); w4.y = cvtpk(bh[2], bh[3]); w4.z = cvtpk(bh[4], bh[5]); w4.w = cvtpk(bh[6], bh[7]); *(LAS u32x4*)(L + O_BHT + c * S32 + grp * 16) = w4;
            w4.x = cvtpk(kh[0], kh[1]); w4.y = cvtpk(kh[2], kh[3]); w4.z = cvtpk(kh[4], kh[5]); w4.w = cvtpk(kh[6], kh[7]); *(LAS u32x4*)(L + O_KHT + c * S32 + grp * 16) = w4;
            w4.x = cvtpk(vv[0], vv[1]); w4.y = cvtpk(vv[2], vv[3]); w4.z = cvtpk(vv[4], vv[5]); w4.w = cvtpk(vv[6], vv[7]); *(LAS u32x4*)(L + O_VT + c * S32 + grp * 16) = w4;
        }
        __syncthreads();
        {
            const int isq = w >> 2, tb = (w >> 1) & 1, jb = w & 1;
            if (jb <= tb) {
                const f32x4 g4 = mm_tile<4>(L + O_KT + jb * 16 * S128, S128, L + (isq ? O_QT : O_KT) + tb * 16 * S128, S128, z4, lane);
                const int t = tb * 16 + fr;
                const float gt = SC[32 + t + isq];
                f32x4 m0, m1;
#pragma unroll
                for (int e = 0; e < 4; ++e) { const int j = jb * 16 + 4 * fg + e; const bool keep = isq ? (j <= t) : (j < t);
                    const float bj = SC[j] * g4[e];
                    m0[e] = keep ? bj * __expf(gt - SC[32 + j]) : 0.f;
                    m1[e] = keep ? bj * __expf(gt - SC[32 + j + 1]) : 0.f; }
                const int off = t * S32 + (jb * 16 + 4 * fg) * 2;
                if (isq) { st_bf16x4(L + O_NB + off, m0); st_bf16x4(L + O_NK + off, m1); }
                else {
                    st_bf16x4(L + O_MK + off, m1);
                    if (tb != jb) st_bf16x4(L + O_M21 + fr * S32 + fg * 8, m0);
                    else { float X[16]; tri_inv16(m0, lane, L + O_MS + tb * 1024, X);
                        if (lane < 16) {
#pragma unroll
                            for (int i = 0; i < 16; ++i) *(LAS unsigned short*)(L + O_TI + (tb * 16 + i) * S32 + (tb * 16 + lane) * 2) = (unsigned short)cvtpk(X[i], 0.f);
                            if (tb == 0) { u32x4 a0, a1;
                                a0.x = cvtpk(X[0], X[1]); a0.y = cvtpk(X[2], X[3]); a0.z = cvtpk(X[4], X[5]); a0.w = cvtpk(X[6], X[7]);
                                a1.x = cvtpk(X[8], X[9]); a1.y = cvtpk(X[10], X[11]); a1.z = cvtpk(X[12], X[13]); a1.w = cvtpk(X[14], X[15]);
                                *(LAS u32x4*)(L + O_T11T + lane * S32) = a0; *(LAS u32x4*)(L + O_T11T + lane * S32 + 16) = a1; }
                            else {
#pragma unroll
                                for (int i = 0; i < 16; ++i) *(LAS unsigned short*)(L + O_T22 + i * S32 + lane * 2) = (unsigned short)cvtpk(X[i], 0.f); }
                        } }
                }
            }
        }
        __syncthreads();
        if (w == 1) {
            const f32x4 x4 = mm_tile<1>(L + O_M21, S32, L + O_T11T, S32, z4, lane);
            st_bf16x4(L + O_XT + fr * S32 + fg * 8, x4);
            asm volatile("s_waitcnt lgkmcnt(0)" ::: "memory");
            const f32x4 t4 = mm_tile<1>(L + O_XT, S32, L + O_T22, S32, z4, lane);
            st_bf16x4(L + O_TI + (16 + fr) * S32 + fg * 8, -t4);
        }
        f32x4 yacc[2];
#pragma unroll
        for (int tb = 0; tb < 2; ++tb) {
            f32x4 u4 = mm_tile<4>(L + O_KKT + tb * 16 * S128, S128, L + O_SBF + 16 * w * S128, S128, z4, lane);
            u4 = mm_tile<1>(L + O_MK + tb * 16 * S32, S32, L + O_VT + 16 * w * S32, S32, u4, lane);
            st_bf16x4(L + O_UTT + (16 * w + fr) * S32 + tb * 32 + fg * 8, u4);
            yacc[tb] = mm_tile<4>(L + O_SBF + 16 * w * S128, S128, L + O_RT + tb * 16 * S128, S128, z4, lane);
            yacc[tb] = mm_tile<1>(L + O_VT + 16 * w * S32, S32, L + O_NK + tb * 16 * S32, S32, yacc[tb], lane);
        }
        __syncthreads();
#pragma unroll
        for (int tb = 0; tb < 2; ++tb) {
            const f32x4 u4 = mm_tile<1>(L + O_TI + tb * 16 * S32, S32, L + O_UTT + 16 * w * S32, S32, z4, lane);
            st_bf16x4(L + O_UT + (16 * w + fr) * S32 + tb * 32 + fg * 8, -u4);
        }
        __syncthreads();
        {
#pragma unroll
            for (int tb = 0; tb < 2; ++tb) {
                yacc[tb] = mm_tile<1>(L + O_UT + 16 * w * S32, S32, L + O_NB + tb * 16 * S32, S32, yacc[tb], lane);
                ypend[tb].x = cvtpk(yacc[tb][0], yacc[tb][1]); ypend[tb].y = cvtpk(yacc[tb][2], yacc[tb][3]);
            }
            const float wc = __expf(SC[32 + 32]);
#pragma unroll
            for (int vi = 0; vi < 8; ++vi) {
                f32x4 s4 = Sacc[vi] * wc;
                s4 = mm_tile<1>(L + O_KHT + 16 * w * S32, S32, L + O_VT + 16 * vi * S32, S32, s4, lane);
                s4 = mm_tile<1>(L + O_BHT + 16 * w * S32, S32, L + O_UT + 16 * vi * S32, S32, s4, lane);
                Sacc[vi] = s4;
                st_bf16x4(L + O_SBF + (16 * vi + fr) * S128 + (16 * w + 4 * fg) * 2, s4);
            }
        }
    }
    flush(71);
    __syncthreads();
}

__device__ __forceinline__ void unpack8(const u32x4 w, float (&f)[8]) { f[0] = bflo(w.x); f[1] = bfhi(w.x); f[2] = bflo(w.y); f[3] = bfhi(w.y); f[4] = bflo(w.z); f[5] = bfhi(w.z); f[6] = bflo(w.w); f[7] = bfhi(w.w); }
__device__ __forceinline__ void phase_p4(const Args& A, Ctx& C) {
    const bf16_t* P = WSP(bf16_t, WS_P);
    const bf16_t* yf = WSP(bf16_t, WS_YDIR); const bf16_t* yb = yf + (size_t)NLAT * D;
    const float* bon = WSP(float, WS_BON);
    bf16_t* ymix = WSP(bf16_t, WS_YMIX);
    lbyte* SGb = C.lds;
    lfloat* GO = (lfloat*)(C.lds + 8192);
    const int tid = C.tid, lane = C.lane, w = C.wave;
    const bf16_t* gupt = WSP(const bf16_t, WS_GUPT);
    const int fr = lane & 15, fg = lane >> 4;
    const int c8 = 8 * lane;
    float lnw[8], lnb[8], ong[8], muv[8];
#pragma unroll
    for (int e = 0; e < 8; ++e) { lnw[e] = A.in[I_LNW][c8 + e]; lnb[e] = A.in[I_LNB][c8 + e]; ong[e] = A.in[I_ONG][(c8 + e) & 127]; muv[e] = A.in[I_MU][1024 + c8 + e]; }
    const int tkA = tid >> 5, lA = 4 * (tid & 31);
    float muA[4];
#pragma unroll
    for (int e = 0; e < 4; ++e) muA[e] = A.in[I_MU][1792 + lA + e];
    const bool vup = (1024 + c8) < 1440;
    bf16x8 gq[4][4];
#pragma unroll
    for (int i = 0; i < 4; ++i)
#pragma unroll
        for (int ks = 0; ks < 4; ++ks) gq[i][ks] = *(const bf16x8*)(gupt + (size_t)(64 * w + 16 * i + fr) * 128 + ks * 32 + fg * 8);
    u32x2 pwA, swA;
    auto issueA = [&](int tile) { const int row = tile * 16 + tkA, t = row & (SEQ - 1); const bool ok = t < SEQ - 64;
        pwA = *(const u32x2*)(P + (size_t)row * PLD + 1792 + lA); swA = *(const u32x2*)(P + (size_t)(row + (ok ? 64 : 0)) * PLD + 1792 + lA); };
    if (C.bid < NLAT / 16) issueA(C.bid);
    for (int tile = C.bid; tile < NLAT / 16; tile += C.G) {
        const int row0 = tile * 16;
        u32x4 wyf[2], wyb[2], wpv[2], wsv[2], wof[2], wob[2], wz[2]; float bsv[2];
#pragma unroll
        for (int tt = 0; tt < 2; ++tt) {
            const int tk = 2 * w + tt, row = row0 + tk, t = row & (SEQ - 1);
            const bool okv = vup ? (t >= 64) : (t < SEQ - 64);
            wyf[tt] = *(const u32x4*)(yf + (size_t)row * D + c8); wyb[tt] = *(const u32x4*)(yb + (size_t)row * D + c8);
            wpv[tt] = *(const u32x4*)(P + (size_t)row * PLD + 1024 + c8); wsv[tt] = *(const u32x4*)(P + (size_t)(row + (okv ? (vup ? -64 : 64) : 0)) * PLD + 1024 + c8);
            wof[tt] = *(const u32x4*)(yf + (size_t)row * D + 512 + c8); wob[tt] = *(const u32x4*)(yb + (size_t)row * D + 512 + c8);
            wz[tt] = *(const u32x4*)(P + (size_t)row * PLD + RW_COLS + 1536 + c8);
            bsv[tt] = bon[(size_t)row * 8 + (lane >> 3)] + bon[((size_t)NLAT + row) * 8 + (lane >> 3)];
        }
        __syncthreads();
        {
            const int row = row0 + tkA, t = row & (SEQ - 1); const bool ok = t < SEQ - 64;
            const u32x2 pw = pwA, sw = swA;
            const float pv[4] = {bflo(pw.x), bfhi(pw.x), bflo(pw.y), bfhi(pw.y)}; const float sv[4] = {bflo(sw.x), bfhi(sw.x), bflo(sw.y), bfhi(sw.y)};
            float o[4];
#pragma unroll
            for (int e = 0; e < 4; ++e) o[e] = sigmoidf_(pv[e] + muA[e] * ((ok ? sv[e] : 0.f) - pv[e]));
            u32x2 ow; ow.x = cvtpk(o[0], o[1]); ow.y = cvtpk(o[2], o[3]); *(LAS u32x2*)(SGb + tkA * 288 + lA * 2) = ow;
        }
        if (tile + C.G < NLAT / 16) issueA(tile + C.G);
        __syncthreads();
#pragma unroll
        for (int i = 0; i < 4; ++i) { const int c0 = 64 * w + 16 * i; f32x4 acc = (f32x4){0.f, 0.f, 0.f, 0.f};
#pragma unroll
            for (int ks = 0; ks < 4; ++ks) { const bf16x8 a = *(const LAS bf16x8*)(SGb + fr * 288 + ks * 64 + fg * 16);
                acc = __builtin_amdgcn_mfma_f32_16x16x32_bf16(a, gq[i][ks], acc, 0, 0, 0); }
#pragma unroll
            for (int e = 0; e < 4; ++e) GO[(4 * fg + e) * 512 + c0 + fr] = acc[e]; }
        __syncthreads();
#pragma unroll
        for (int tt = 0; tt < 2; ++tt) {
            const int tk = 2 * w + tt, row = row0 + tk, t = row & (SEQ - 1);
            const bool okv = vup ? (t >= 64) : (t < SEQ - 64);
            const float bs = bsv[tt];
            const f32x4 g0 = *(const LAS f32x4*)(GO + tk * 512 + c8), g1 = *(const LAS f32x4*)(GO + tk * 512 + c8 + 4);
            const float gg[8] = {g0.x, g0.y, g0.z, g0.w, g1.x, g1.y, g1.z, g1.w};
            float a[8], bq[8], pv[8], sv[8], y[8];
            unpack8(wyf[tt], a); unpack8(wyb[tt], bq); unpack8(wpv[tt], pv); unpack8(wsv[tt], sv);
            float s1 = 0.f;
#pragma unroll
            for (int e = 0; e < 8; ++e) { y[e] = a[e] + bq[e]; s1 += y[e]; }
            s1 += __shfl_xor(s1, 1); s1 += __shfl_xor(s1, 2); s1 += __shfl_xor(s1, 4);
            const float m = s1 * (1.f / 64.f);
            float s2 = 0.f;
#pragma unroll
            for (int e = 0; e < 8; ++e) { y[e] -= m; s2 += y[e] * y[e]; }
            s2 += __shfl_xor(s2, 1); s2 += __shfl_xor(s2, 2); s2 += __shfl_xor(s2, 4);
            const float rs = __builtin_amdgcn_rsqf(s2 * (1.f / 64.f) + RWKV_EPS);
            float o[8];
#pragma unroll
            for (int e = 0; e < 8; ++e) { const float vv = pv[e] + muv[e] * ((okv ? sv[e] : 0.f) - pv[e]); o[e] = (y[e] * rs * lnw[e] + lnb[e] + bs * vv) * gg[e]; }
            u32x4 ow; ow.x = cvtpk(o[0], o[1]); ow.y = cvtpk(o[2], o[3]); ow.z = cvtpk(o[4], o[5]); ow.w = cvtpk(o[6], o[7]);
            *(u32x4*)(ymix + (size_t)row * D + c8) = ow;
            float of[8], ob[8], z[8];
            unpack8(wof[tt], of); unpack8(wob[tt], ob); unpack8(wz[tt], z);
            float s3 = 0.f;
#pragma unroll
            for (int e = 0; e < 8; ++e) { of[e] += ob[e]; s3 += of[e] * of[e]; }
            s3 += __shfl_xor(s3, 1); s3 += __shfl_xor(s3, 2); s3 += __shfl_xor(s3, 4); s3 += __shfl_xor(s3, 8);
            const float rg = __builtin_amdgcn_rsqf(s3 * (1.f / 128.f) + NORM_EPS);
#pragma unroll
            for (int e = 0; e < 8; ++e) o[e] = of[e] * rg * ong[e] * siluf_(z[e]);
            ow.x = cvtpk(o[0], o[1]); ow.y = cvtpk(o[2], o[3]); ow.z = cvtpk(o[4], o[5]); ow.w = cvtpk(o[6], o[7]);
            *(u32x4*)(ymix + (size_t)row * D + 512 + c8) = ow;
        }
    }
}

__device__ __forceinline__ void convert_experts(const Args& A, Ctx& C) {
    lfloat* scr = (lfloat*)(C.lds + C.wave * 16384);
    const int gw = C.bid * 8 + C.wave, NGW = C.G * 8;
    constexpr int I13 = (D / 64) * (DE / 32);
    constexpr int I2 = (DE / 64) * (D / 32);
    constexpr int PER = 2 * I13 + I2;
    for (int it = gw; it < 257 * PER; it += NGW) {
        const int e = it / PER; int r = it % PER;
        unsigned char* bt13 = A.ws + WS_WEXP + (size_t)e * WEXP_STRIDE; unsigned char* bt2 = bt13 + 512 * 1024;
        const float* w1 = e < NE ? A.in[I_EW1] + (size_t)e * D * DE : A.in[I_SW1];
        const float* w3 = e < NE ? A.in[I_EW3] + (size_t)e * D * DE : A.in[I_SW3];
        const float* w2 = e < NE ? A.in[I_EW2] + (size_t)e * DE * D : A.in[I_SW2];
        if (r < I13) { transpose_item_fp8(w1, D, DE, bt13, RowGLU{0}, SW13, scr, r, C.lane); continue; } r -= I13;
        if (r < I13) { transpose_item_fp8(w3, D, DE, bt13, RowGLU{128}, SW13, scr, r, C.lane); continue; } r -= I13;
        transpose_item_fp8(w2, DE, D, bt2, RowId(), SW2, scr, r, C.lane);
    }
}

__device__ __forceinline__ void phase_p6(const Args& A, Ctx& C) {
    const float* mod = WSP(float, WS_MOD); bf16_t* h2n = WSP(bf16_t, WS_H2N);
    const int gw = C.bid * 8 + C.wave, NGW = C.G * 8;
    for (int row = gw; row < NLAT; row += NGW) {
        const float* m = mod + (size_t)(row >> 11) * MODW;
        norm_mod_row(A.out + (size_t)row * D, A.in[I_N2G], m + 4 * D, m + 3 * D, h2n + (size_t)row * D, C.lane, (unsigned*)(A.ws + WS_H2N8) + (size_t)row * (D / 4));
    }
}

__device__ __forceinline__ void phase_p8(const Args& A, Ctx& C) {
    const float* logit = WSP(float, WS_LOGIT);
    int* tope = WSP(int, WS_TOPE); float* topw = WSP(float, WS_TOPW); int* pos = WSP(int, WS_POS);
    unsigned* cnt = WSP(unsigned, WS_CTL) + CW_CNT;
    const int gw = C.bid * 8 + C.wave, NGW = C.G * 8, lane = C.lane;
    const f32x4 rb = ((const f32x4*)A.in[I_RB])[lane];
    for (int tok = gw; tok < NLAT; tok += NGW) {
        const f32x4 lg = ((const f32x4*)(logit + (size_t)tok * NE))[lane];
        float s[4], sel[4];
#pragma unroll
        for (int i = 0; i < 4; ++i) { s[i] = sigmoidf_(lg[i]); sel[i] = s[i] + rb[i]; }
        float m1 = fmaxf(fmaxf(sel[0], sel[1]), fmaxf(sel[2], sel[3]));
        float m2;
        {
            float a = fmaxf(sel[0], sel[1]), bq = fminf(sel[0], sel[1]), cq = fmaxf(sel[2], sel[3]), dq = fminf(sel[2], sel[3]);
            m2 = fmaxf(fminf(a, cq), fmaxf(bq, dq)); }
#pragma unroll
        for (int o = 1; o < 8; o <<= 1) { const float o1 = __shfl_xor(m1, o), o2 = __shfl_xor(m2, o);
            const float n1 = fmaxf(m1, o1); const float n2 = fmaxf(fminf(m1, o1), fmaxf(m2, o2)); m1 = n1; m2 = n2; }
        const float gs = m1 + m2;
        const int grp = lane >> 3;
        int rank = 0;
#pragma unroll
        for (int gq = 0; gq < 8; ++gq) { const float og = __shfl(gs, gq * 8); rank += (og > gs || (og == gs && gq < grp)) ? 1 : 0; }
        const bool gsel = rank < 4;
        float cand[4];
#pragma unroll
        for (int i = 0; i < 4; ++i) cand[i] = gsel ? sel[i] : -INFINITY;
        int my_e = 0; float my_w = 0.f; float wsum = 0.f;
#pragma unroll
        for (int r = 0; r < 8; ++r) {
            float bv = cand[0]; int bi = 0;
#pragma unroll
            for (int i = 1; i < 4; ++i) if (cand[i] > bv) { bv = cand[i]; bi = i; }
            int be = lane * 4 + bi;
#define P8_STEP(CTRL) { const float ov = dpp_f<CTRL>(bv); const int oe = __builtin_amdgcn_update_dpp(0, be, CTRL, 0xf, 0xf, false); if (ov > bv || (ov == bv && oe < be)) { bv = ov; be = oe; } }
            P8_STEP(0x128) P8_STEP(0x124) P8_STEP(0x122) P8_STEP(0x121)
#undef P8_STEP
            float gv = rdlane(bv, 0); int ge = __builtin_amdgcn_readlane(be, 0);
#pragma unroll
            for (int rr = 1; rr < 4; ++rr) { const float ov = rdlane(bv, 16 * rr); const int oe = __builtin_amdgcn_readlane(be, 16 * rr); if (ov > gv || (ov == gv && oe < ge)) { gv = ov; ge = oe; } }
            be = ge;
            const int ol = be >> 2, oi = be & 3;
            const float mys = oi == 0 ? s[0] : (oi == 1 ? s[1] : (oi == 2 ? s[2] : s[3]));
            const float ws_ = __shfl(mys, ol);
            if (lane == ol) { if (oi == 0) cand[0] = -INFINITY; else if (oi == 1) cand[1] = -INFINITY; else if (oi == 2) cand[2] = -INFINITY; else cand[3] = -INFINITY; }
            wsum += ws_;
            if (lane == r) { my_e = be; my_w = ws_; }
        }
        if (lane < 8) {
            const float w = my_w / wsum * 2.5f;
            const unsigned p = atomicAdd(cnt + my_e, 1u);
            tope[(size_t)tok * 8 + lane] = my_e; topw[(size_t)tok * 8 + lane] = w; pos[(size_t)tok * 8 + lane] = (int)p;
        }
    }
}

__device__ __forceinline__ void tile_prefix(const Args& A, Ctx& C, LAS int* tb) {
    const unsigned* cnt = WSP(unsigned, WS_CTL) + CW_CNT;
    if (C.tid == 0) { int acc = 0; for (int e = 0; e < NE; ++e) { tb[e] = acc; acc += ((int)cnt[e] + 255) >> 8; } tb[NE] = acc; }
    __syncthreads();
}
__device__ __forceinline__ void phase_p9(const Args& A, Ctx& C) {
    LAS int* tb = (LAS int*)C.lds;
    tile_prefix(A, C, tb);
    const unsigned* cnt = WSP(unsigned, WS_CTL) + CW_CNT;
    const int* tope = WSP(int, WS_TOPE); const float* topw = WSP(float, WS_TOPW); const int* pos = WSP(int, WS_POS);
    int* rowl = WSP(int, WS_ROWL); float* roww = WSP(float, WS_ROWW); int* tile_e = WSP(int, WS_TILEE);
    const int nrt = tb[NE];
    for (int i = C.bid * 512 + C.tid; i < NLAT * 8; i += C.G * 512) { const int e = tope[i]; const int pr = tb[e] * 256 + pos[i]; rowl[pr] = i; roww[pr] = topw[i]; }
    for (int e = C.bid; e < NE; e += C.G) { const int n = (int)cnt[e], nt = tb[e + 1] - tb[e];
        for (int j = n + C.tid; j < nt * 256; j += 512) { rowl[tb[e] * 256 + j] = -1; roww[tb[e] * 256 + j] = 0.f; }
        for (int k = C.tid; k < nt; k += 512) tile_e[tb[e] + k] = e; }
    for (int i = C.bid * 512 + C.tid; i < NLAT; i += C.G * 512) { rowl[nrt * 256 + i] = i; roww[nrt * 256 + i] = 1.f; }
    for (int k = C.bid * 512 + C.tid; k < NLAT / 256; k += C.G * 512) tile_e[nrt + k] = NE;
    __syncthreads();
}

__device__ __forceinline__ void phase_moe(const Args& A, Ctx& C, int dry_shared) {
    LAS int* tb = (LAS int*)(C.lds + 131072);
    LAS int* tbl = tb + 320;
    tile_prefix(A, C, tb);
    pg8::MoeCtx M;
    M.nrt = tb[NE]; M.ntiles = M.nrt + NLAT / 256; M.G = C.G; M.vc = (C.G % 8 == 0) ? (C.bid % 8) * (C.G / 8) + C.bid / 8 : C.bid;
    M.tb = tb; M.tbl = tbl; M.cnt = WSP(unsigned, WS_CTL) + CW_CNT; M.rowl = WSP(int, WS_ROWL); M.roww = WSP(float, WS_ROWW);
    M.wexp = (const char*)(A.ws + WS_WEXP); M.h2n = (const char*)(A.ws + WS_H2N8); M.Hs = (char*)(A.ws + WS_HS) + (size_t)C.bid * 2 * 65536;
    M.Y = (unsigned char*)(A.ws + WS_Y); M.out = A.out; M.mod = WSP(const float, WS_MOD); M.dry_shared = dry_shared;
    pg8::gemm_moe(C.lds, M);
    __syncthreads();
}

__device__ __forceinline__ void phase_final(const Args& A, Ctx& C, float* dst) {
    const int gw = C.bid * 8 + C.wave, NGW = C.G * 8;
    const float* fg = A.in[I_FG]; const float* mod = WSP(const float, WS_MOD);
    const unsigned* Y = (const unsigned*)(A.ws + WS_Y);
    for (int row = gw; row < NLAT; row += NGW) {
        f32x4* xr = (f32x4*)(A.out + (size_t)row * D) + C.lane;
        const f32x4* gt = (const f32x4*)(mod + (size_t)(row >> 11) * MODW + 5 * D) + C.lane;
        const unsigned* yr = Y + (size_t)row * 8 * (D / 4) + C.lane;
        f32x4 v[4]; float s = 0.f;
#pragma unroll
        for (int j = 0; j < 4; ++j) {
            f32x4 a = (f32x4){0.f, 0.f, 0.f, 0.f};
#pragma unroll
            for (int sl = 0; sl < 8; ++sl) { const unsigned w = yr[sl * (D / 4) + 64 * j];
                const f32x2 lo = __builtin_amdgcn_cvt_pk_f32_fp8(w, false), hi = __builtin_amdgcn_cvt_pk_f32_fp8(w, true);
                a.x += lo.x; a.y += lo.y; a.z += hi.x; a.w += hi.y; }
            v[j] = xr[64 * j] + gt[64 * j] * a * (1.f / pg8::YSCALE);
            s += (v[j].x * v[j].x + v[j].y * v[j].y) + (v[j].z * v[j].z + v[j].w * v[j].w); }
        const float rstd = __builtin_amdgcn_rsqf(wave_sum(s) * (1.f / D) + NORM_EPS);
        f32x4* orow = (f32x4*)(dst + (size_t)row * D) + C.lane;
#pragma unroll
        for (int j = 0; j < 4; ++j) orow[64 * j] = v[j] * rstd * ((const f32x4*)fg)[C.lane + 64 * j];
    }
}

constexpr int NPHASE = 13;
__global__ void __launch_bounds__(512, 2) fwd_kernel(Args A) {
    extern __shared__ __attribute__((aligned(16))) unsigned char lds_raw[];
    Ctx C; C.lds = (lbyte*)lds_raw; C.tid = threadIdx.x; C.lane = C.tid & 63; C.wave = __builtin_amdgcn_readfirstlane(C.tid >> 6);
    C.G = gridDim.x; C.bid = blockIdx.x; C.a = &A;
    volatile LAS unsigned* misc = (volatile LAS unsigned*)(C.lds + LDS_MISC);
    if (C.tid < 16) misc[C.tid] = 0u;
    __syncthreads();
    XcdBarrier bar; bar.bar = WSP(unsigned, WS_CTL) + CW_BAR; bar.x = 0; bar.st = nullptr;
    const int lo = A.ph_lo, hi = A.ph_hi;
    const bool multi = (hi - lo) > 1;
    if (multi) bar = xcd_barrier_post(WSP(unsigned, WS_CTL) + CW_BAR, misc);
#ifndef PHASE_MASK
#define PHASE_MASK 0x1FFF
#endif
#define IN(k) (((PHASE_MASK >> (k)) & 1) && lo <= (k) && (k) < hi)
#define SEAM(k) do { if (IN(k) && IN((k) + 1)) xcd_barrier(bar); } while (0)
#ifndef REP_MASK
#define REP_MASK 0
#endif
#define REPS(k) (((REP_MASK >> (k)) & 1) ? 2 : 1)

    if (IN(0)) _Pragma("unroll") for (int rep = 0; rep < REPS(0); ++rep) { phase_p0(A, C); __syncthreads(); } SEAM(0);
    if (IN(1)) _Pragma("unroll") for (int rep = 0; rep < REPS(1); ++rep) { phase_p1(A, C); } SEAM(1);
    if (IN(2)) _Pragma("unroll") for (int rep = 0; rep < REPS(2); ++rep) {
        pg8::Gemm g{WSP(bf16_t, WS_XN), D}; pg8::StaticOrder S; S.init(NROWS, PLD, C.G, C.bid, WSP(bf16_t, WS_BTIN), D, 1);
        pg8::EpiBf16 E{WSP(bf16_t, WS_P), PLD, 1.f / SWIN};
        pg8::gemm_phase<pg8::EpiBf16, pg8::StaticOrder, false, 0, false, true>(C.lds, g, S, E);
    } SEAM(2);
    if (IN(3)) _Pragma("unroll") for (int rep = 0; rep < REPS(3); ++rep) { phase_gdn_prep(A, C); } SEAM(3);
#ifdef PROBE_BARRIERS
    if (multi) for (int kq = 0; kq < PROBE_BARRIERS; ++kq) xcd_barrier(bar);
#endif
    if (IN(4)) {
        for (int ch = C.bid; ch < NB * HB * 2; ch += C.G) gdn_chain_chunked(A, C, ch);
        for (int pr = C.bid; pr < NB * HA; pr += C.G) rwkv_pair_chunked(A, C, pr);
    } SEAM(4);
    if (IN(5)) _Pragma("unroll") for (int rep = 0; rep < REPS(5); ++rep) { phase_p4(A, C); } SEAM(5);
    if (IN(6)) _Pragma("unroll") for (int rep = 0; rep < REPS(6); ++rep) {
        pg8::Gemm g{WSP(bf16_t, WS_YMIX), D}; pg8::StaticOrder S; S.init(NLAT, D, C.G, C.bid, WSP(bf16_t, WS_BTOUT), D);
        pg8::EpiResGate E{A.in[I_X], A.out, WSP(float, WS_MOD), 2 * D};
        pg8::gemm_phase<pg8::EpiResGate, pg8::StaticOrder, false>(C.lds, g, S, E);
    } SEAM(6);
    if (IN(7)) _Pragma("unroll") for (int rep = 0; rep < REPS(7); ++rep) { phase_p6(A, C); __syncthreads(); convert_experts(A, C); __syncthreads(); } SEAM(7);
    if (IN(8)) _Pragma("unroll") for (int rep = 0; rep < REPS(8); ++rep) {
        pg8::Gemm g{WSP(bf16_t, WS_H2N), D}; pg8::StaticOrder S; S.init(NLAT, NE, C.G, C.bid, WSP(bf16_t, WS_BTR), D);
        pg8::EpiF32 E{WSP(float, WS_LOGIT), NE};
        pg8::gemm_phase<pg8::EpiF32, pg8::StaticOrder, false>(C.lds, g, S, E);
    } SEAM(8);
    if (IN(9)) { phase_p8(A, C); } SEAM(9);
    if (IN(10)) _Pragma("unroll") for (int rep = 0; rep < REPS(10); ++rep) { phase_p9(A, C); } SEAM(10);
    if (IN(11)) { phase_moe(A, C, 0); if (REPS(11) > 1) { __syncthreads(); phase_moe(A, C, 1); } } SEAM(11);
    if (IN(12)) { if (REPS(12) > 1) { phase_final(A, C, (float*)(A.ws + WS_WEXP)); __syncthreads(); } phase_final(A, C, A.out); }
#undef IN
#undef SEAM
}

extern "C" void kernel_launch(void* const* d_in, const int* in_sizes, int n_in, void* d_out, int out_size, void* d_ws, size_t ws_size, hipStream_t stream) {
    static int grid = 0;
    if (grid == 0) {
        if (n_in != 34 || out_size != NLAT * D || ws_size < WS_END) { fprintf(stderr, "kernel_launch: unexpected shapes (n_in %d out %d ws %zu need %zu)\n", n_in, out_size, ws_size, (size_t)WS_END); grid = -1; return; }
        int dev = 0, cus = 0;
        if (hipGetDevice(&dev) != hipSuccess || hipDeviceGetAttribute(&cus, hipDeviceAttributeMultiprocessorCount, dev) != hipSuccess) { grid = -1; return; }
        if (hipFuncSetAttribute((const void*)fwd_kernel, hipFuncAttributeMaxDynamicSharedMemorySize, LDS_BYTES) != hipSuccess) { fprintf(stderr, "kernel_launch: hipFuncSetAttribute failed\n"); grid = -1; return; }
        int per_cu = 0;
        if (hipOccupancyMaxActiveBlocksPerMultiprocessor(&per_cu, (const void*)fwd_kernel, 512, LDS_BYTES) != hipSuccess || per_cu < 1) { fprintf(stderr, "kernel_launch: occupancy query says %d\n", per_cu); }
        (void)hipGetLastError();
        grid = cus;
    }
    if (grid < 0) return;
    (void)hipMemsetAsync((char*)d_ws + WS_CTL, 0, CTL_BYTES, stream);
    Args a{};
    for (int i = 0; i < 34; ++i) a.in[i] = (const float*)d_in[i];
    a.out = (float*)d_out; a.ws = (unsigned char*)d_ws;
#if MK_PER_PHASE
    for (int p = 0; p < NPHASE; ++p) { a.ph_lo = p; a.ph_hi = p + 1; hipLaunchKernelGGL(fwd_kernel, dim3(grid), dim3(512), LDS_BYTES, stream, a); }
#else
    a.ph_lo = 0; a.ph_hi = NPHASE; hipLaunchKernelGGL(fwd_kernel, dim3(grid), dim3(512), LDS_BYTES, stream, a);
#endif
}
```

```cpp
#include <hip/hip_runtime.h>
#include <cstdio>
#include <cstdint>

#ifndef MK_PER_PHASE
#define MK_PER_PHASE 0
#endif

#define LAS __attribute__((address_space(3)))
typedef unsigned short bf16_t;
typedef short bf16x8 __attribute__((ext_vector_type(8)));
typedef float f32x4 __attribute__((ext_vector_type(4)));
typedef float f32x2 __attribute__((ext_vector_type(2)));
typedef unsigned u32x4 __attribute__((ext_vector_type(4)));
typedef unsigned u32x2 __attribute__((ext_vector_type(2)));
typedef int i32x4 __attribute__((ext_vector_type(4)));
typedef int i32x8 __attribute__((ext_vector_type(8)));
typedef LAS float lfloat;
typedef LAS unsigned char lbyte;

constexpr int D = 1024, NB = 32, SEQ = 2048, CTX = 256, GW = 64;
constexpr int NLAT = NB * SEQ;
constexpr int NCTX = NB * CTX;
constexpr int NROWS = NLAT + NCTX;
constexpr int DA = 512, HA = 8, NA = 64;
constexpr int RW_COLS = 1920, GD_COLS = 2064, IN_COLS = 3984, PLD = 4096;
constexpr int DB = 512, HB = 4, KB = 128;
constexpr int NE = 256, TOPK = 8, DE = 256;
constexpr int MODW = 6 * D;
constexpr float NORM_EPS = 1e-6f, RWKV_EPS = 64e-5f;
constexpr int MAXTILES = (NLAT * TOPK + NE * 255) / 256 + 1;

constexpr size_t MiB = 1u << 20;
constexpr size_t WS_CTL = 0, CTL_BYTES = 1 * MiB;
constexpr size_t WS_MOD = 1 * MiB;
constexpr size_t WS_BTIN = 2 * MiB, WS_BTOUT = 10 * MiB, WS_BTR = 12 * MiB, WS_BON = 13 * MiB, WS_GUPT = 17 * MiB, WS_NRM = 978 * MiB;
constexpr size_t WS_P = 18 * MiB, WS_XN = 594 * MiB, WS_YDIR = 594 * MiB, WS_YMIX = 850 * MiB;
constexpr size_t WS_H2N8 = 900 * MiB;
constexpr size_t WS_H2N = 18 * MiB, WS_LOGIT = 146 * MiB, WS_TOPE = 210 * MiB, WS_TOPW = 212 * MiB, WS_POS = 214 * MiB, WS_Y = 146 * MiB;
constexpr size_t WS_ROWL = 658 * MiB, WS_ROWW = 661 * MiB, WS_TILEE = 664 * MiB, WS_HS = 672 * MiB, WS_WEXP = 704 * MiB;
constexpr size_t WEXP_STRIDE = (size_t)(512 * 1024 + 1024 * 256);
constexpr float SW13 = 64.f, SW2 = 32.f, SHS = 8.f, SWIN = 32.f;
constexpr size_t WS_END = 1090 * MiB;
static_assert(WS_WEXP + 257 * WEXP_STRIDE <= WS_END && WS_Y + (size_t)NLAT * 8 * D <= WS_ROWL, "ws map");
constexpr int CW_BAR = 4096;
constexpr int CW_CNT = 16384;
constexpr int CNT_STRIDE = 32;

constexpr int LDS_BYTES = 159744;
constexpr int LDS_MISC = LDS_BYTES - 64;

__device__ __forceinline__ unsigned f2bf(float f) { unsigned u = __builtin_bit_cast(unsigned, f); return (u + 0x7fffu + ((u >> 16) & 1u)) >> 16; }
typedef __bf16 bf16x2_t __attribute__((ext_vector_type(2)));
__device__ __forceinline__ unsigned cvtpk(float lo, float hi) { f32x2 v = {lo, hi}; return __builtin_bit_cast(unsigned, __builtin_convertvector(v, bf16x2_t)); }
__device__ __forceinline__ unsigned pk2(float lo, float hi) { return cvtpk(lo, hi); }
__device__ __forceinline__ unsigned pk4_fp8(float a, float b, float c, float d) { unsigned w = 0u;
    w = __builtin_amdgcn_cvt_pk_fp8_f32(__builtin_amdgcn_fmed3f(a, -448.f, 448.f), __builtin_amdgcn_fmed3f(b, -448.f, 448.f), w, false);
    w = __builtin_amdgcn_cvt_pk_fp8_f32(__builtin_amdgcn_fmed3f(c, -448.f, 448.f), __builtin_amdgcn_fmed3f(d, -448.f, 448.f), w, true); return w; }
__device__ __forceinline__ float bf2f(unsigned short b) { return __builtin_bit_cast(float, ((unsigned)b) << 16); }
__device__ __forceinline__ float bflo(unsigned w) { return __builtin_bit_cast(float, w << 16); }
__device__ __forceinline__ float bfhi(unsigned w) { return __builtin_bit_cast(float, w & 0xffff0000u); }
template <int CTRL> __device__ __forceinline__ float dpp_f(float v) { return __builtin_bit_cast(float, __builtin_amdgcn_update_dpp(0, __builtin_bit_cast(int, v), CTRL, 0xf, 0xf, false)); }
__device__ __forceinline__ float wave_sum(float v) {
    v += dpp_f<0x128>(v);
    v += dpp_f<0x124>(v);
    v += dpp_f<0x122>(v);
    v += dpp_f<0x121>(v);
    const int vi = __builtin_bit_cast(int, v);
    const float r0 = __builtin_bit_cast(float, __builtin_amdgcn_readlane(vi, 0)), r1 = __builtin_bit_cast(float, __builtin_amdgcn_readlane(vi, 16)),
                r2 = __builtin_bit_cast(float, __builtin_amdgcn_readlane(vi, 32)), r3 = __builtin_bit_cast(float, __builtin_amdgcn_readlane(vi, 48));
    return (r0 + r1) + (r2 + r3);
}
__device__ __forceinline__ float sigmoidf_(float x) { return __builtin_amdgcn_rcpf(1.f + __expf(-x)); }
__device__ __forceinline__ float siluf_(float x) { return x * __builtin_amdgcn_rcpf(1.f + __expf(-x)); }
__device__ __forceinline__ float softplusf_(float x) { return fmaxf(x, 0.f) + __logf(1.f + __expf(-fabsf(x))); }
__device__ __forceinline__ float tanhf_(float x) { const float e = __expf(-2.f * fabsf(x)); const float t = (1.f - e) * __builtin_amdgcn_rcpf(1.f + e); return x < 0.f ? -t : t; }

#define XB_TMO      128
#define XB_XCNT(j)  (256  + 64 * (j))
#define XB_XSUB(j)  (1280 + 64 * (j))
#define XB_XGEN(j)  (2304 + 64 * (j))
#define XB_TOP      3328
#define XB_TOPGEN   3392
#define XCD_BAR_WORDS 3456
#define XB_SPIN_CAP (1u << 22)
__device__ __forceinline__ unsigned xb_ld(unsigned* p)              { return __hip_atomic_load(p, __ATOMIC_RELAXED, __HIP_MEMORY_SCOPE_AGENT); }
__device__ __forceinline__ unsigned xb_add(unsigned* p, unsigned v) { return __hip_atomic_fetch_add(p, v, __ATOMIC_RELAXED, __HIP_MEMORY_SCOPE_AGENT); }
__device__ __forceinline__ unsigned xb_xcc_id() { return (unsigned)__builtin_amdgcn_s_getreg((3 << 11) | 20) & 0xFu; }
#define XB_SPIN(cond, bar) do { unsigned _sp = 0; while (cond) { __builtin_amdgcn_s_sleep(1); \
    if ((++_sp & 255u) == 0u) { if (xb_ld(&(bar)[XB_TMO])) break; if (_sp > XB_SPIN_CAP) { atomicAdd(&(bar)[XB_TMO], 1u); break; } } } } while (0)
struct XcdBarrier { unsigned* bar; unsigned x; volatile LAS unsigned* st; };
__device__ __forceinline__ XcdBarrier xcd_barrier_post(unsigned* bar, volatile LAS unsigned* st) {
    XcdBarrier b; b.bar = bar; b.x = xb_xcc_id(); b.st = st;
    if (threadIdx.x == 0) (void)xb_add(&bar[XB_XCNT(b.x)], 1u);
    return b;
}
__device__ __forceinline__ void xcd_barrier_complete(unsigned* bar, unsigned x, unsigned& nloc, unsigned& nx) {
    const unsigned G = gridDim.x * gridDim.y * gridDim.z;
    unsigned sum, cnt, mine, sp = 0u;
    for (;;) {
        sum = 0u; cnt = 0u; mine = 0u;
#pragma unroll
        for (unsigned j = 0; j < 16; ++j) { const unsigned c = xb_ld(&bar[XB_XCNT(j)]); sum += c; cnt += (c > 0u) ? 1u : 0u; mine = (j == x) ? c : mine; }
        if (sum == G) break;
        __builtin_amdgcn_s_sleep(1);
        if ((++sp & 255u) == 0u) { if (xb_ld(&bar[XB_TMO])) break; if (sp > XB_SPIN_CAP) { atomicAdd(&bar[XB_TMO], 1u); break; } }
    }
    nloc = mine > 0u ? mine : 1u; nx = cnt > 0u ? cnt : 1u;
}
__device__ __forceinline__ void xcd_barrier(const XcdBarrier& b) {
    asm volatile("s_waitcnt vmcnt(0)" ::: "memory");
    __syncthreads();
    if (threadIdx.x == 0) {
        unsigned* bar = b.bar;
        __builtin_amdgcn_s_waitcnt(0);
        unsigned nloc = b.st[0], nx = b.st[1];
        if (nloc == 0u) { xcd_barrier_complete(bar, b.x, nloc, nx); b.st[0] = nloc; b.st[1] = nx; }
        const unsigned old = xb_add(&bar[XB_XSUB(b.x)], 1u);
        const unsigned gen = old / nloc;
        if (old + 1u == (gen + 1u) * nloc) {
            __builtin_amdgcn_fence(__ATOMIC_RELEASE, "agent");
            asm volatile("s_waitcnt vmcnt(0)" ::: "memory");
            const unsigned og = xb_add(&bar[XB_TOP], 1u);
            const unsigned tg = og / nx;
            if (og + 1u == (tg + 1u) * nx) xb_add(&bar[XB_TOPGEN], 1u);
            else XB_SPIN(xb_ld(&bar[XB_TOPGEN]) == tg, bar);
            __builtin_amdgcn_fence(__ATOMIC_ACQUIRE, "agent");
            xb_add(&bar[XB_XGEN(b.x)], 1u);
            asm volatile("s_waitcnt vmcnt(0)" ::: "memory");
        } else {
            XB_SPIN(xb_ld(&bar[XB_XGEN(b.x)]) == gen, bar);
            __builtin_amdgcn_fence(__ATOMIC_ACQUIRE, "agent");
            asm volatile("s_waitcnt vmcnt(0)" ::: "memory");
        }
    }
    __syncthreads();
}

struct Args {
    const float* in[34];
    float* out;
    unsigned char* ws;
    int ph_lo, ph_hi;
};
enum { I_X = 0, I_C, I_CTX, I_CCTX, I_WADA, I_BADA, I_N1G, I_WIN, I_MU, I_W0, I_WUP, I_A0, I_AUP, I_GUP, I_KK, I_KA, I_RK, I_LNW, I_LNB,
       I_CONVW, I_ALOG, I_DTB, I_ONG, I_WOUT, I_N2G, I_RW, I_RB, I_EW1, I_EW3, I_EW2, I_SW1, I_SW3, I_SW2, I_FG };

namespace pg8 {
constexpr int BM = 256, BK = 64, HALF = 128, HTB = HALF * BK * 2, STAGE_BYTES = 8 * HTB, NXCD = 8, WGM = 8;
__host__ __device__ __forceinline__ int lds_byte(int r, int c) { const int st = (r >> 4) * 2 + (c >> 5), rr = r & 15, cc = c & 31, ob = rr * 64 + cc * 2; return st * 1024 + (ob ^ (((ob >> 9) & 1) << 5)); }
__host__ __device__ __forceinline__ void stage_rc(int b, int& R, int& C) { const int st = b / 1024, sb = b % 1024, swz = sb ^ (((sb >> 9) & 1) << 5); R = (st >> 1) * 16 + swz / 64; C = (st & 1) * 32 + (swz % 64) / 2; }
__host__ __device__ __forceinline__ int perm32(int rho) { const int n = rho >> 4, i = rho & 15; return 8 * (i >> 2) + 4 * n + (i & 3); }
struct Unit { int pm, pn; };
struct Gemm { const bf16_t* A; int K; };
struct StaticOrder {
    int nM, nN, nwg, G, c; const char* Bt; size_t tstepB;
    __device__ void init(int M, int N, int G_, int c_, const void* Bt_, int K, int es = 2) { nM = M / BM; nN = N / BM; nwg = nM * nN; G = G_; c = c_; Bt = (const char*)Bt_; tstepB = (size_t)BM * K * es; }
    __device__ bool next(int i, Unit& u) const {
        const long L = (long)i * G + c; if (L >= nwg) return false;
        int wgid = (int)L; { const int q = nwg / NXCD, r = nwg % NXCD, xcd = wgid % NXCD, off = wgid / NXCD; wgid = (xcd < r ? xcd * (q + 1) : r * (q + 1) + (xcd - r) * q) + off; }
        const int nig = WGM * nN, gid = wgid / nig, fm = gid * WGM, gsz = (nM - fm) < WGM ? (nM - fm) : WGM;
        u.pm = fm + ((wgid % nig) % gsz); u.pn = (wgid % nig) / gsz; return true;
    }
    __device__ __forceinline__ const char* bptr(const Unit& u) const { return Bt + (size_t)u.pn * tstepB; }
    __device__ __forceinline__ int rowsel(const Unit&, int) const { return 0; }
};
struct TileOrder {
    int nunits, npn, G, c; const int* tile_e; const char* wbase; size_t wstride, woff, tstepB; const int* rowl;
    __device__ bool next(int i, Unit& u) const { const int L = i * G + c; if (L >= nunits) return false; u.pm = L / npn; u.pn = L - u.pm * npn; return true; }
    __device__ __forceinline__ const char* bptr(const Unit& u) const { const int e = __builtin_amdgcn_readfirstlane(tile_e[u.pm]); return wbase + (size_t)e * wstride + woff + (size_t)u.pn * tstepB; }
    __device__ __forceinline__ int rowsel(const Unit& u, int r) const { const int t = rowl[(size_t)u.pm * 256 + r]; return t < 0 ? 0 : t; }
};
struct SeqOrder {
    int n; const char* Bt; size_t tstepB; const LAS int* rsel;
    __device__ bool next(int i, Unit& u) const { if (i >= n) return false; u.pm = 0; u.pn = i; return true; }
    __device__ __forceinline__ const char* bptr(const Unit& u) const { return Bt + (size_t)u.pn * tstepB; }
    __device__ __forceinline__ int rowsel(const Unit&, int r) const { return rsel[r]; }
};
__device__ __forceinline__ unsigned cvt_pk_bf16(float lo, float hi) { return cvtpk(lo, hi); }

template <class Epi, class Sched, bool GATHER, int A_AUX = 0, bool ALIGN = true, bool FP8 = false>
__device__ __forceinline__ void gemm_phase(lbyte* lds, const Gemm g, const Sched& S, const Epi& E) {
    int tid_ = threadIdx.x; asm volatile("" : "+v"(tid_));
    const int tid = tid_, wid = __builtin_amdgcn_readfirstlane(tid >> 6), lane = tid & 63, wr = wid >> 2, wc = wid & 3, fr = lane & 15, fq = lane >> 4;
    constexpr unsigned ES = FP8 ? 1u : 2u;
    const int K = g.K, nt = FP8 ? K / 128 : K / BK;
    Unit cur, nxt; int ui = 0;
    if (!S.next(0, cur)) return;
    int Rst[2], Cst[2];
    unsigned voffA[2], voffA1[2], voffB[2], nvA[2], nvA1[2];
#pragma unroll
    for (int i = 0; i < 2; ++i) { int R, C; stage_rc(tid * 16 + i * 8192, R, C); const int Rb = Epi::PERM ? ((R & ~31) + perm32(R & 31)) : R; Rst[i] = R; Cst[i] = C;
        if (GATHER) { voffA[i] = (unsigned)S.rowsel(cur, R) * (unsigned)K * ES + (unsigned)C * 2u; voffA1[i] = (unsigned)S.rowsel(cur, 128 + R) * (unsigned)K * ES + (unsigned)C * 2u; }
        else { voffA[i] = (unsigned)(R * K) * ES + (unsigned)C * 2u; voffA1[i] = voffA[i]; }
        nvA[i] = voffA[i]; nvA1[i] = voffA1[i];
        voffB[i] = (unsigned)(Rb * K) * ES + (unsigned)C * 2u; }
    const size_t kstep = (size_t)(BK * 2);
    const size_t hstep = (size_t)HALF * K * ES;
    const size_t hstepA = GATHER ? 0 : hstep;
    const size_t tstep = 2 * hstep;
    const unsigned ldsw = (unsigned)wid * 1024u;
    const int aoff = lds_byte(wr * 64 + fr, FP8 ? fq * 16 : fq * 8), boff = lds_byte(wc * 32 + fr, FP8 ? fq * 16 : fq * 8);
#define PG8_SA(b, h) (((b) * 2 + (h)) * HTB)
#define PG8_SB(b, h) ((4 + (b) * 2 + (h)) * HTB)
#define PG8_STAGE2(bufoff, gbase, v0, v1) do { \
        __builtin_amdgcn_global_load_lds((const unsigned*)((const char*)(gbase) + (v0)), (LAS unsigned*)(lds + (bufoff) + ldsw), 16, 0, 0); \
        __builtin_amdgcn_global_load_lds((const unsigned*)((const char*)(gbase) + (v1)), (LAS unsigned*)(lds + (bufoff) + ldsw + 8192), 16, 0, 0); } while (0)
#define PG8_STAGE2A(bufoff, gbase, v0, v1) do { if constexpr (A_AUX == 16) { \
        __builtin_amdgcn_global_load_lds((const unsigned*)((const char*)(gbase) + (v0)), (LAS unsigned*)(lds + (bufoff) + ldsw), 16, 0, 16); \
        __builtin_amdgcn_global_load_lds((const unsigned*)((const char*)(gbase) + (v1)), (LAS unsigned*)(lds + (bufoff) + ldsw + 8192), 16, 0, 16); } else { PG8_STAGE2(bufoff, gbase, v0, v1); } } while (0)
#define PG8_STAGE(bufoff, gbase, voff) PG8_STAGE2(bufoff, gbase, (voff)[0], (voff)[1])
#define PG8_STAGEA(bufoff, gbase, voff) PG8_STAGE2A(bufoff, gbase, (voff)[0], (voff)[1])
#define G_LD32(p) __builtin_shufflevector(*(const LAS i32x4*)(p), *(const LAS i32x4*)((p) + 16), 0, 1, 2, 3, 4, 5, 6, 7)
#define G_MFMA8(c, a, b) asm volatile("v_mfma_scale_f32_16x16x128_f8f6f4 %0, %1, %2, %0, %3, %3 op_sel_hi:[0,0,0]" : "+v"(c) : "v"(a), "v"(b), "v"(one_scale))
#define PG8_LDA(dst, b, h) do { if constexpr (FP8) { _Pragma("unroll") for (int m = 0; m < 4; ++m) dst##8[m] = G_LD32(lds + PG8_SA(b, h) + aoff + m * 2048); } else { \
        _Pragma("unroll") for (int m = 0; m < 4; ++m) _Pragma("unroll") for (int k = 0; k < 2; ++k) dst[m][k] = *(const LAS bf16x8*)(lds + PG8_SA(b, h) + aoff + m * 2048 + k * 1024); } } while (0)
#define PG8_LDB(dst, b, h) do { if constexpr (FP8) { _Pragma("unroll") for (int n = 0; n < 2; ++n) dst##8[n] = G_LD32(lds + PG8_SB(b, h) + boff + n * 2048); } else { \
        _Pragma("unroll") for (int n = 0; n < 2; ++n) _Pragma("unroll") for (int k = 0; k < 2; ++k) dst[n][k] = *(const LAS bf16x8*)(lds + PG8_SB(b, h) + boff + n * 2048 + k * 1024); } } while (0)
#define PG8_MMA(ai, bj, At, Bt) do { __builtin_amdgcn_s_setprio(1); if constexpr (FP8) { _Pragma("unroll") for (int m = 0; m < 4; ++m) _Pragma("unroll") for (int n = 0; n < 2; ++n) G_MFMA8(acc[ai][bj][m][n], Bt##8[n], At##8[m]); } else { \
        _Pragma("unroll") for (int m = 0; m < 4; ++m) _Pragma("unroll") for (int n = 0; n < 2; ++n) _Pragma("unroll") for (int k = 0; k < 2; ++k) \
        acc[ai][bj][m][n] = __builtin_amdgcn_mfma_f32_16x16x32_bf16(Bt[n][k], At[m][k], acc[ai][bj][m][n], 0, 0, 0); } __builtin_amdgcn_s_setprio(0); } while (0)
#define PG8_WAIT_V(n) asm volatile("s_waitcnt vmcnt(" #n ")" ::: "memory")
#define PG8_WAIT_L(n) asm volatile("s_waitcnt lgkmcnt(" #n ")" ::: "memory")
#define PG8_BAR __builtin_amdgcn_s_barrier()
#define PG8_SCHED __builtin_amdgcn_sched_barrier(0)
    f32x4 acc[2][2][4][2];
#pragma unroll
    for (int a = 0; a < 2; ++a)
#pragma unroll
        for (int b = 0; b < 2; ++b)
#pragma unroll
            for (int m = 0; m < 4; ++m)
#pragma unroll
                for (int n = 0; n < 2; ++n) acc[a][b][m][n] = (f32x4){0.f, 0.f, 0.f, 0.f};
    bf16x8 At[4][2], B0[2][2], B1[2][2]; i32x8 At8[4], B08[2], B18[2];
    int one_scale = 0x7F7F7F7F; asm volatile("" : "+v"(one_scale));
    const char* cA = (const char*)g.A + (GATHER ? (size_t)0 : (size_t)cur.pm * tstep); const char* cB = S.bptr(cur);
    PG8_STAGE(PG8_SB(0, 0), cB, voffB); PG8_STAGE(PG8_SB(0, 1), cB + hstep, voffB); PG8_STAGEA(PG8_SA(0, 0), cA, voffA); PG8_STAGEA(PG8_SA(0, 1), cA + hstepA, voffA1);
    if (wr == 1) PG8_BAR;
    PG8_WAIT_V(2); PG8_BAR;
    PG8_STAGE(PG8_SB(1, 0), cB + kstep, voffB); PG8_STAGEA(PG8_SA(1, 0), cA + kstep, voffA); PG8_STAGE(PG8_SB(1, 1), cB + hstep + kstep, voffB);
    PG8_WAIT_V(6); PG8_BAR;
    for (;;) {
        const bool has_next = S.next(ui + 1, nxt);
        const char* nA = has_next ? (const char*)g.A + (GATHER ? (size_t)0 : (size_t)nxt.pm * tstep) : cA; const char* nB = has_next ? S.bptr(nxt) : cB;
        for (int t = 0; t < nt; t += 2) {
            const bool last = (t == nt - 2);
            const char* a1 = cA + (size_t)(t + 1) * kstep;
            const char* a2 = last ? nA : cA + (size_t)(t + 2) * kstep; const char* b2 = last ? nB : cB + (size_t)(t + 2) * kstep;
            const char* a3 = a2 + kstep; const char* b3 = b2 + kstep;
            if (GATHER && last && has_next) {
#pragma unroll
                for (int i = 0; i < 2; ++i) { nvA[i] = (unsigned)S.rowsel(nxt, Rst[i]) * (unsigned)K * ES + (unsigned)Cst[i] * 2u; nvA1[i] = (unsigned)S.rowsel(nxt, 128 + Rst[i]) * (unsigned)K * ES + (unsigned)Cst[i] * 2u; }
            }
            const unsigned x0 = (GATHER && last) ? nvA[0] : voffA[0], x1 = (GATHER && last) ? nvA[1] : voffA[1];
            const unsigned y0 = (GATHER && last) ? nvA1[0] : voffA1[0], y1 = (GATHER && last) ? nvA1[1] : voffA1[1];
            PG8_LDB(B0, 0, 0); PG8_LDB(B1, 0, 1); PG8_SCHED; PG8_LDA(At, 0, 0); PG8_STAGEA(PG8_SA(1, 1), a1 + hstepA, voffA1);
            PG8_WAIT_V(8); PG8_WAIT_L(0); PG8_BAR; PG8_MMA(0, 0, At, B0); PG8_MMA(0, 1, At, B1); PG8_BAR; PG8_SCHED;
            PG8_LDA(At, 0, 1); PG8_STAGE(PG8_SB(0, 0), b2, voffB); PG8_STAGE(PG8_SB(0, 1), b2 + hstep, voffB); PG8_STAGE2A(PG8_SA(0, 0), a2, x0, x1);
            PG8_WAIT_V(8); PG8_WAIT_L(0); PG8_BAR; PG8_MMA(1, 0, At, B0); PG8_MMA(1, 1, At, B1); PG8_BAR; PG8_SCHED;
            PG8_LDB(B0, 1, 0); PG8_LDB(B1, 1, 1); PG8_SCHED; PG8_LDA(At, 1, 0); PG8_STAGE2A(PG8_SA(0, 1), a2 + hstepA, y0, y1);
            PG8_WAIT_V(8); PG8_WAIT_L(0); PG8_BAR; PG8_MMA(0, 0, At, B0); PG8_MMA(0, 1, At, B1); PG8_BAR; PG8_SCHED;
            PG8_LDA(At, 1, 1); PG8_STAGE(PG8_SB(1, 0), b3, voffB); PG8_STAGE(PG8_SB(1, 1), b3 + hstep, voffB); PG8_STAGE2A(PG8_SA(1, 0), a3, x0, x1);
            PG8_WAIT_V(8); PG8_WAIT_L(0); PG8_BAR; PG8_MMA(1, 0, At, B0); PG8_MMA(1, 1, At, B1); PG8_BAR; PG8_SCHED;
        }
        if (ALIGN && wr == 0) PG8_BAR;
        if constexpr (FP8) asm volatile("s_nop 15\n\ts_nop 15" ::: "memory");
        E(acc, cur, wr, wc, fr, fq);
        if (!has_next) break;
#pragma unroll
        for (int a = 0; a < 2; ++a)
#pragma unroll
            for (int b = 0; b < 2; ++b)
#pragma unroll
                for (int m = 0; m < 4; ++m)
#pragma unroll
                    for (int n = 0; n < 2; ++n) acc[a][b][m][n] = (f32x4){0.f, 0.f, 0.f, 0.f};
        cur = nxt; cA = nA; cB = nB; ++ui;
        if (GATHER) { voffA[0] = nvA[0]; voffA[1] = nvA[1]; voffA1[0] = nvA1[0]; voffA1[1] = nvA1[1]; }
        if (ALIGN && wr == 1) PG8_BAR;
    }
    PG8_WAIT_V(0);
    if (!ALIGN && wr == 0) PG8_BAR;
    PG8_BAR;
#undef PG8_SA
#undef PG8_SB
#undef PG8_STAGE
#undef PG8_STAGE2
#undef PG8_STAGE2A
#undef PG8_STAGEA
#undef G_LD32
#undef G_MFMA8
#undef PG8_LDA
#undef PG8_LDB
#undef PG8_MMA
#undef PG8_WAIT_V
#undef PG8_WAIT_L
#undef PG8_BAR
#undef PG8_SCHED
}

struct EpiBf16 {
    static constexpr bool PERM = true;
    bf16_t* O; int ldc; float scale;
    __device__ __forceinline__ void operator()(const f32x4 (&acc)[2][2][4][2], const Unit& u, int wr, int wc, int fr, int fq) const {
        const int row0 = u.pm * BM + wr * 64 + fr; const int col0 = u.pn * BM + wc * 32 + 8 * fq;
#pragma unroll
        for (int ai = 0; ai < 2; ++ai)
#pragma unroll
            for (int m = 0; m < 4; ++m) { bf16_t* rowp = O + (size_t)(row0 + ai * HALF + m * 16) * ldc + col0;
#pragma unroll
                for (int bj = 0; bj < 2; ++bj) { const f32x4 v0 = acc[ai][bj][m][0] * scale, v1 = acc[ai][bj][m][1] * scale;
                    u32x4 w; w.x = cvt_pk_bf16(v0[0], v0[1]); w.y = cvt_pk_bf16(v0[2], v0[3]); w.z = cvt_pk_bf16(v1[0], v1[1]); w.w = cvt_pk_bf16(v1[2], v1[3]);
                    *(u32x4*)(rowp + bj * HALF) = w; } }
    }
};
struct EpiF32 {
    static constexpr bool PERM = false;
    float* C; int ldc;
    __device__ __forceinline__ void operator()(const f32x4 (&acc)[2][2][4][2], const Unit& u, int wr, int wc, int fr, int fq) const {
        const int row0 = u.pm * BM + wr * 64 + fr, col0 = u.pn * BM + wc * 32 + 4 * fq;
#pragma unroll
        for (int ai = 0; ai < 2; ++ai)
#pragma unroll
            for (int m = 0; m < 4; ++m) { float* rowp = C + (size_t)(row0 + ai * HALF + m * 16) * ldc + col0;
#pragma unroll
                for (int bj = 0; bj < 2; ++bj)
#pragma unroll
                    for (int n = 0; n < 2; ++n) *(f32x4*)(rowp + bj * HALF + n * 16) = acc[ai][bj][m][n]; }
    }
};
struct EpiResGate {
    static constexpr bool PERM = false;
    const float* x; float* out; const float* mod; int gate_off;
    __device__ __forceinline__ void operator()(const f32x4 (&acc)[2][2][4][2], const Unit& u, int wr, int wc, int fr, int fq) const {
        const int row0 = u.pm * BM + wr * 64 + fr, col0 = u.pn * BM + wc * 32 + 4 * fq;
        const float* gp = mod + (size_t)((u.pm * BM) >> 11) * MODW + gate_off + col0;
        f32x4 gv[2][2];
#pragma unroll
        for (int bj = 0; bj < 2; ++bj)
#pragma unroll
            for (int n = 0; n < 2; ++n) gv[bj][n] = *(const f32x4*)(gp + bj * HALF + n * 16);
#pragma unroll
        for (int ai = 0; ai < 2; ++ai)
#pragma unroll
            for (int m = 0; m < 4; ++m) { const size_t off = (size_t)(row0 + ai * HALF + m * 16) * D + col0;
#pragma unroll
                for (int bj = 0; bj < 2; ++bj)
#pragma unroll
                    for (int n = 0; n < 2; ++n) { const f32x4 xv = *(const f32x4*)(x + off + bj * HALF + n * 16);
                        *(f32x4*)(out + off + bj * HALF + n * 16) = xv + gv[bj][n] * acc[ai][bj][m][n]; }
                asm volatile("" ::: "memory"); }
    }
};
struct EpiGLU {
    static constexpr bool PERM = true;
    bf16_t* H;
    __device__ __forceinline__ void operator()(const f32x4 (&acc)[2][2][4][2], const Unit& u, int wr, int wc, int fr, int fq) const {
        const int row0 = u.pm * BM + wr * 64 + fr; const int col0 = u.pn * 128 + wc * 32 + 8 * fq;
#pragma unroll
        for (int ai = 0; ai < 2; ++ai)
#pragma unroll
            for (int m = 0; m < 4; ++m) { bf16_t* rowp = H + (size_t)(row0 + ai * HALF + m * 16) * 256 + col0;
                f32x4 h0, h1;
#pragma unroll
                for (int j = 0; j < 4; ++j) { const float a0 = acc[ai][0][m][0][j], a1 = acc[ai][0][m][1][j];
                    h0[j] = siluf_(a0) * acc[ai][1][m][0][j]; h1[j] = siluf_(a1) * acc[ai][1][m][1][j]; }
                u32x4 w; w.x = cvt_pk_bf16(h0[0], h0[1]); w.y = cvt_pk_bf16(h0[2], h0[3]); w.z = cvt_pk_bf16(h1[0], h1[1]); w.w = cvt_pk_bf16(h1[2], h1[3]);
                *(u32x4*)rowp = w; }
    }
};
constexpr float YSCALE = 8.f;
struct EpiY {
    static constexpr bool PERM = true;
    unsigned char* Y; float* out; const float* mod; const LAS int* rtok; const LAS float* rw; int shared;
    __device__ __forceinline__ void operator()(const f32x4 (&acc)[2][2][4][2], const Unit& u, int wr, int wc, int fr, int fq) const {
        const int col0 = u.pn * BM + wc * 32 + 8 * fq;
#pragma unroll
        for (int ai = 0; ai < 2; ++ai)
#pragma unroll
            for (int m = 0; m < 4; ++m) { const int r = wr * 64 + fr + ai * HALF + m * 16; const int ts = rtok[r]; const float w = rw[r];
                if (ts >= 0) {
                    if (shared) { const unsigned goff = (unsigned)(ts >> 11) * MODW + 5 * D + col0; const unsigned ooff = (unsigned)ts * D + col0;
#pragma unroll
                        for (int bj = 0; bj < 2; ++bj)
#pragma unroll
                            for (int n = 0; n < 2; ++n) { const f32x4 gv = *(const f32x4*)(mod + goff + bj * HALF + n * 4); f32x4* op = (f32x4*)(out + ooff + bj * HALF + n * 4);
                                *op = *op + gv * acc[ai][bj][m][n]; }
                    } else { unsigned char* yp = Y + (size_t)(unsigned)ts * D + col0; const float ws_ = w * YSCALE;
#pragma unroll
                        for (int bj = 0; bj < 2; ++bj) { f32x4 v0 = acc[ai][bj][m][0] * ws_, v1 = acc[ai][bj][m][1] * ws_;
#pragma unroll
                                for (int j = 0; j < 4; ++j) { v0[j] = __builtin_amdgcn_fmed3f(v0[j], -448.f, 448.f); v1[j] = __builtin_amdgcn_fmed3f(v1[j], -448.f, 448.f); }
                            unsigned lo = 0u, hi = 0u;
                            lo = __builtin_amdgcn_cvt_pk_fp8_f32(v0[0], v0[1], lo, false); lo = __builtin_amdgcn_cvt_pk_fp8_f32(v0[2], v0[3], lo, true);
                            hi = __builtin_amdgcn_cvt_pk_fp8_f32(v1[0], v1[1], hi, false); hi = __builtin_amdgcn_cvt_pk_fp8_f32(v1[2], v1[3], hi, true);
                            u32x2 pk; pk.x = lo; pk.y = hi; *(u32x2*)(yp + bj * HALF) = pk; } } }
                asm volatile("" ::: "memory"); }
    }
};

struct MoeCtx {
    int ntiles, nrt, G, vc;
    const LAS int* tb; LAS int* tbl;
    const unsigned* cnt; const int* rowl; const float* roww;
    const char* wexp; const char* h2n; char* Hs; unsigned char* Y; float* out; const float* mod; int dry_shared;
};
__device__ __forceinline__ void gemm_moe(lbyte* lds, const MoeCtx& M) {
    int tid_ = threadIdx.x; asm volatile("" : "+v"(tid_));
    const int tid = tid_, wid = __builtin_amdgcn_readfirstlane(tid >> 6), lane = tid & 63, wr = wid >> 2, wc = wid & 3, fr = lane & 15, fq = lane >> 4;
    const int ntl = (M.ntiles - M.vc + M.G - 1) / M.G;
    if (M.vc >= M.ntiles) return;
    const int nunits = ntl * 6;
    const unsigned ldsw = (unsigned)wid * 1024u;
    const int aoff = lds_byte(wr * 64 + fr, fq * 16), boff = lds_byte(wc * 32 + fr, fq * 16);
    auto tile_expert = [&](int tile, int& e, int& k) { if (tile < M.nrt) { int lo = 0, hi = NE - 1; while (lo < hi) { const int mid = (lo + hi + 1) >> 1; if (M.tb[mid] <= tile) lo = mid; else hi = mid - 1; } e = lo; k = tile - M.tb[lo]; } else { e = NE; k = tile - M.nrt; } };
    auto fill = [&](int j) { if (j < ntl && tid < 256) { const int tile = M.vc + j * M.G; int e, k; tile_expert(tile, e, k); LAS int* T = M.tbl + (j % 3) * 768;
            int ts; float w;
            if (e < NE) { const int valid = (int)M.cnt[e * CNT_STRIDE] - 256 * k; if (tid < valid) { ts = M.rowl[(size_t)tile * 256 + tid]; w = M.roww[(size_t)tile * 256 + tid]; } else { ts = -1; w = 0.f; } T[tid] = ts < 0 ? 0 : (ts >> 3); }
            else { ts = k * 256 + tid; w = 1.f; T[tid] = ts; }
            T[256 + tid] = ts; ((LAS float*)T)[512 + tid] = w; } };
    struct UP { const char* aB; const char* bB; unsigned bh; int nt, kind, pn, slot, shared, e, hbuf, fillnext; };
    auto unit_params = [&](int ui, int prev_e, UP& u, unsigned (&oa)[4], unsigned (&ob)[2]) {
        int tq = threadIdx.x; asm volatile("" : "+v"(tq));
        int Rst[2], Cst[2], Rbp[2];
#pragma unroll
        for (int i = 0; i < 2; ++i) { int R, C; stage_rc(tq * 16 + i * 8192, R, C); Rst[i] = R; Cst[i] = C; Rbp[i] = (R & ~31) + perm32(R & 31); }
        int j, sub;
        if (ui < 2) { j = 0; sub = ui; }
        else { const int qq = ui - 2, g = qq / 6, r = qq - 6 * g; if (g < ntl - 1 && r < 2) { j = g + 1; sub = r; } else { j = g; sub = (g < ntl - 1) ? r : r + 2; } }
        const int tile = M.vc + j * M.G; int e, k;
        if (sub == 0 || sub == 2) tile_expert(tile, e, k); else e = prev_e;
        u.e = e;
        const char* w = M.wexp + (size_t)e * WEXP_STRIDE;
        u.slot = j % 3; u.hbuf = j & 1; u.fillnext = (sub == 1) ? j + 1 : -1; u.shared = (e == NE) ? 1 : 0;
        if (sub < 2) { u.kind = 0; u.pn = sub; u.nt = D / 128; u.aB = M.h2n; u.bB = w + (size_t)sub * 256 * D; u.bh = 128u * D;
            const LAS int* T = M.tbl + (j % 3) * 768;
#pragma unroll
            for (int i = 0; i < 2; ++i) { oa[i] = (unsigned)T[Rst[i]] * (unsigned)D + 2u * (unsigned)Cst[i]; oa[2 + i] = (unsigned)T[128 + Rst[i]] * (unsigned)D + 2u * (unsigned)Cst[i]; ob[i] = (unsigned)(Rbp[i] * D + 2 * Cst[i]); } }
        else { u.kind = 1; u.pn = sub - 2; u.nt = DE / 128; u.aB = M.Hs + (j & 1) * 65536; u.bB = w + (size_t)512 * 1024 + (size_t)(sub - 2) * 256 * DE; u.bh = 128u * DE;
#pragma unroll
            for (int i = 0; i < 2; ++i) { oa[i] = (unsigned)(Rst[i] * DE + 2 * Cst[i]); oa[2 + i] = (unsigned)((128 + Rst[i]) * DE + 2 * Cst[i]); ob[i] = (unsigned)(Rbp[i] * DE + 2 * Cst[i]); } }
    };
#define PG8_SA(b, h) (((b) * 2 + (h)) * HTB)
#define PG8_SB(b, h) ((4 + (b) * 2 + (h)) * HTB)
#define MOE_DMA(bufoff, ptr, aux) __builtin_amdgcn_global_load_lds((const unsigned*)(ptr), (LAS unsigned*)(lds + (bufoff)), 16, 0, aux)
#define MOE_STA(bufoff, base, o0, o1) do { MOE_DMA((bufoff) + ldsw, (base) + (o0), 16); MOE_DMA((bufoff) + ldsw + 8192, (base) + (o1), 16); } while (0)
#define MOE_STAK(kindv, bufoff, base, o0, o1) do { if ((kindv) == 0) { MOE_DMA((bufoff) + ldsw, (base) + (o0), 0); MOE_DMA((bufoff) + ldsw + 8192, (base) + (o1), 0); } else MOE_STA(bufoff, base, o0, o1); } while (0)
#define MOE_STB(bufoff, base, o0, o1) do { MOE_DMA((bufoff) + ldsw, (base) + (o0), 0); MOE_DMA((bufoff) + ldsw + 8192, (base) + (o1), 0); } while (0)
#define MOE_LD32(p) __builtin_shufflevector(*(const LAS i32x4*)(p), *(const LAS i32x4*)((p) + 16), 0, 1, 2, 3, 4, 5, 6, 7)
#define PG8_LDA(dst, b, h) do { _Pragma("unroll") for (int m = 0; m < 4; ++m) dst[m] = MOE_LD32(lds + PG8_SA(b, h) + aoff + m * 2048); } while (0)
#define PG8_LDB(dst, b, h) do { _Pragma("unroll") for (int n = 0; n < 2; ++n) dst[n] = MOE_LD32(lds + PG8_SB(b, h) + boff + n * 2048); } while (0)
#define MOE_MFMA(c, a, b) asm volatile("v_mfma_scale_f32_16x16x128_f8f6f4 %0, %1, %2, %0, %3, %3 op_sel_hi:[0,0,0]" : "+v"(c) : "v"(a), "v"(b), "v"(one_scale))
#define PG8_MMA(ai, bj, At, Bt) do { __builtin_amdgcn_s_setprio(1); _Pragma("unroll") for (int m = 0; m < 4; ++m) _Pragma("unroll") for (int n = 0; n < 2; ++n) \
        MOE_MFMA(acc[ai][bj][m][n], Bt[n], At[m]); __builtin_amdgcn_s_setprio(0); } while (0)
#define PG8_WAIT_V(n) asm volatile("s_waitcnt vmcnt(" #n ")" ::: "memory")
#define PG8_WAIT_L(n) asm volatile("s_waitcnt lgkmcnt(" #n ")" ::: "memory")
#define PG8_BAR __builtin_amdgcn_s_barrier()
#define PG8_SCHED __builtin_amdgcn_sched_barrier(0)
    fill(0);
    asm volatile("s_waitcnt vmcnt(0) lgkmcnt(0)" ::: "memory");
    __syncthreads();
    UP cu, nu; unsigned oa[4], ob[2], na[4], nb[2];
    unit_params(0, 0, cu, oa, ob);
    nu = cu;
#pragma unroll
    for (int i = 0; i < 4; ++i) na[i] = oa[i];
    nb[0] = ob[0]; nb[1] = ob[1];
    f32x4 acc[2][2][4][2];
#pragma unroll
    for (int a = 0; a < 2; ++a)
#pragma unroll
        for (int b = 0; b < 2; ++b)
#pragma unroll
            for (int m = 0; m < 4; ++m)
#pragma unroll
                for (int n = 0; n < 2; ++n) acc[a][b][m][n] = (f32x4){0.f, 0.f, 0.f, 0.f};
    i32x8 At[4], B0[2], B1[2];
    int one_scale = 0x7F7F7F7F; asm volatile("" : "+v"(one_scale));
    const size_t kstep = (size_t)128;
    {   const char* cA = cu.aB; const char* cB = cu.bB;
        MOE_STB(PG8_SB(0, 0), cB, ob[0], ob[1]); MOE_STB(PG8_SB(0, 1), cB + cu.bh, ob[0], ob[1]); MOE_STAK(cu.kind, PG8_SA(0, 0), cA, oa[0], oa[1]); MOE_STAK(cu.kind, PG8_SA(0, 1), cA, oa[2], oa[3]);
        if (wr == 1) PG8_BAR;
        PG8_WAIT_V(2); PG8_BAR;
        MOE_STB(PG8_SB(1, 0), cB + kstep, ob[0], ob[1]); MOE_STAK(cu.kind, PG8_SA(1, 0), cA + kstep, oa[0], oa[1]); MOE_STB(PG8_SB(1, 1), cB + cu.bh + kstep, ob[0], ob[1]);
        PG8_WAIT_V(6); PG8_BAR; }
    for (int ui = 0;; ++ui) {
        const bool has_next = (ui + 1 < nunits);
        if (cu.fillnext >= 0) fill(cu.fillnext);
        const char* cA = cu.aB; const char* cB = cu.bB; const int nt = cu.nt; const unsigned bh = cu.bh;
        for (int t = 0; t < nt; t += 2) {
            const bool last = (t == nt - 2);
            if (last && has_next) unit_params(ui + 1, cu.e, nu, na, nb);
            const char* a1 = cA + (size_t)(t + 1) * kstep;
            const char* a2 = last ? nu.aB : cA + (size_t)(t + 2) * kstep; const char* b2 = last ? nu.bB : cB + (size_t)(t + 2) * kstep;
            const char* a3 = a2 + kstep; const char* b3 = b2 + kstep;
            const unsigned bh2 = last ? nu.bh : bh;
            const unsigned x0 = last ? na[0] : oa[0], x1 = last ? na[1] : oa[1], y0 = last ? na[2] : oa[2], y1 = last ? na[3] : oa[3];
            const unsigned z0 = last ? nb[0] : ob[0], z1 = last ? nb[1] : ob[1];
            const int k2 = last ? nu.kind : cu.kind;
            PG8_LDB(B0, 0, 0); PG8_LDB(B1, 0, 1); PG8_SCHED; PG8_LDA(At, 0, 0); MOE_STAK(cu.kind, PG8_SA(1, 1), a1, oa[2], oa[3]);
            PG8_WAIT_V(8); PG8_WAIT_L(0); PG8_BAR; PG8_MMA(0, 0, At, B0); PG8_MMA(0, 1, At, B1); PG8_BAR; PG8_SCHED;
            PG8_LDA(At, 0, 1); MOE_STB(PG8_SB(0, 0), b2, z0, z1); MOE_STB(PG8_SB(0, 1), b2 + bh2, z0, z1); MOE_STAK(k2, PG8_SA(0, 0), a2, x0, x1);
            PG8_WAIT_V(8); PG8_WAIT_L(0); PG8_BAR; PG8_MMA(1, 0, At, B0); PG8_MMA(1, 1, At, B1); PG8_BAR; PG8_SCHED;
            PG8_LDB(B0, 1, 0); PG8_LDB(B1, 1, 1); PG8_SCHED; PG8_LDA(At, 1, 0); MOE_STAK(k2, PG8_SA(0, 1), a2, y0, y1);
            PG8_WAIT_V(8); PG8_WAIT_L(0); PG8_BAR; PG8_MMA(0, 0, At, B0); PG8_MMA(0, 1, At, B1); PG8_BAR; PG8_SCHED;
            PG8_LDA(At, 1, 1); MOE_STB(PG8_SB(1, 0), b3, z0, z1); MOE_STB(PG8_SB(1, 1), b3 + bh2, z0, z1); MOE_STAK(k2, PG8_SA(1, 0), a3, x0, x1);
            PG8_WAIT_V(8); PG8_WAIT_L(0); PG8_BAR; PG8_MMA(1, 0, At, B0); PG8_MMA(1, 1, At, B1); PG8_BAR; PG8_SCHED;
        }
        if (wr == 0) PG8_BAR;
        asm volatile("s_nop 15\n\ts_nop 15" ::: "memory");
        if (cu.kind == 0) {
            const int row0 = wr * 64 + fr; const int col0 = cu.pn * 128 + wc * 32 + 8 * fq;
            constexpr float is13 = 1.f / SW13;
#pragma unroll
            for (int ai = 0; ai < 2; ++ai)
#pragma unroll
                for (int m = 0; m < 4; ++m) { unsigned char* rowp = (unsigned char*)M.Hs + cu.hbuf * 65536 + (size_t)(row0 + ai * HALF + m * 16) * 256 + col0;
                    f32x4 h0, h1;
#pragma unroll
                    for (int j = 0; j < 4; ++j) { h0[j] = siluf_(acc[ai][0][m][0][j] * is13) * (acc[ai][1][m][0][j] * (is13 * SHS)); h1[j] = siluf_(acc[ai][0][m][1][j] * is13) * (acc[ai][1][m][1][j] * (is13 * SHS)); }
                    u32x2 w; w.x = pk4_fp8(h0[0], h0[1], h0[2], h0[3]); w.y = pk4_fp8(h1[0], h1[1], h1[2], h1[3]);
                    *(u32x2*)rowp = w; }
        } else {
            const LAS int* rtok = M.tbl + cu.slot * 768 + 256; const LAS float* rw = (const LAS float*)(M.tbl + cu.slot * 768 + 512);
            const int col0 = cu.pn * BM + wc * 32 + 8 * fq;
#pragma unroll
            for (int ai = 0; ai < 2; ++ai)
#pragma unroll
                for (int m = 0; m < 4; ++m) { const int r = wr * 64 + fr + ai * HALF + m * 16; const int ts = rtok[r]; const float w = rw[r];
                    if (ts >= 0) {
                        if (cu.shared) { const unsigned goff = (unsigned)(ts >> 11) * MODW + 5 * D + col0; const unsigned ooff = (unsigned)ts * D + col0;
#pragma unroll
                            for (int bj = 0; bj < 2; ++bj)
#pragma unroll
                                for (int n = 0; n < 2; ++n) { const f32x4 gv = *(const f32x4*)(M.mod + goff + bj * HALF + n * 4); f32x4* op = (f32x4*)(M.out + ooff + bj * HALF + n * 4);
                                    const f32x4 nv = *op + gv * acc[ai][bj][m][n] * (1.f / (SHS * SW2)); if (!M.dry_shared) *op = nv; else asm volatile("" :: "v"(nv)); }
                        } else { unsigned char* yp = M.Y + (size_t)(unsigned)ts * D + col0; const float ws_ = w * (YSCALE / (SHS * SW2));
#pragma unroll
                            for (int bj = 0; bj < 2; ++bj) { f32x4 v0 = acc[ai][bj][m][0] * ws_, v1 = acc[ai][bj][m][1] * ws_;
#pragma unroll
                                for (int j = 0; j < 4; ++j) { v0[j] = __builtin_amdgcn_fmed3f(v0[j], -448.f, 448.f); v1[j] = __builtin_amdgcn_fmed3f(v1[j], -448.f, 448.f); }
                                unsigned lo = 0u, hi = 0u;
                                lo = __builtin_amdgcn_cvt_pk_fp8_f32(v0[0], v0[1], lo, false); lo = __builtin_amdgcn_cvt_pk_fp8_f32(v0[2], v0[3], lo, true);
                                hi = __builtin_amdgcn_cvt_pk_fp8_f32(v1[0], v1[1], hi, false); hi = __builtin_amdgcn_cvt_pk_fp8_f32(v1[2], v1[3], hi, true);
                                u32x2 pk; pk.x = lo; pk.y = hi; *(u32x2*)(yp + bj * HALF) = pk; } } }
                    asm volatile("" ::: "memory"); }
        }
        if (!has_next) break;
#pragma unroll
        for (int a = 0; a < 2; ++a)
#pragma unroll
            for (int b = 0; b < 2; ++b)
#pragma unroll
                for (int m = 0; m < 4; ++m)
#pragma unroll
                    for (int n = 0; n < 2; ++n) acc[a][b][m][n] = (f32x4){0.f, 0.f, 0.f, 0.f};
        cu = nu;
#pragma unroll
        for (int i = 0; i < 4; ++i) oa[i] = na[i];
        ob[0] = nb[0]; ob[1] = nb[1];
        if (wr == 1) PG8_BAR;
    }
    PG8_WAIT_V(0);
    PG8_BAR;
#undef PG8_SA
#undef PG8_SB
#undef MOE_DMA
#undef MOE_STA
#undef MOE_STAK
#undef MOE_STB
#undef PG8_LDA
#undef PG8_LDB
#undef MOE_LD32
#undef MOE_MFMA
#undef PG8_MMA
#undef PG8_WAIT_V
#undef PG8_WAIT_L
#undef PG8_BAR
#undef PG8_SCHED
}
}

struct Ctx {
    lbyte* lds; int tid, lane, wave, G, bid;
    const Args* a;
};
#define WSP(T, off) ((T*)(A.ws + (off)))

template <class RowMap>
__device__ __forceinline__ void transpose_item(const float* W, int K, int N, bf16_t* WT, RowMap rowmap, lfloat* scr, int item, int lane) {
    const int nblk = N / 32, kb = item / nblk, nb = item % nblk, k0 = 64 * kb, n0 = 32 * nb;
#pragma unroll 8
    for (int i = 0; i < 32; ++i) { const int kk = 2 * i + (lane >> 5); scr[kk * 33 + (lane & 31)] = W[(size_t)(k0 + kk) * N + n0 + (lane & 31)]; }
    asm volatile("s_waitcnt lgkmcnt(0)" ::: "memory");
    const int c = lane & 7;
#pragma unroll
    for (int j = 0; j < 4; ++j) { const int n = (lane >> 3) + 8 * j; const lfloat* s = scr + (8 * c) * 33 + n;
        u32x4 o; o.x = pk2(s[0 * 33], s[1 * 33]); o.y = pk2(s[2 * 33], s[3 * 33]); o.z = pk2(s[4 * 33], s[5 * 33]); o.w = pk2(s[6 * 33], s[7 * 33]);
        *(u32x4*)(WT + (size_t)rowmap(n0 + n) * K + k0 + 8 * c) = o; }
    asm volatile("s_waitcnt lgkmcnt(0)" ::: "memory");
}
template <class RowMap>
__device__ __forceinline__ void transpose_item_fp8(const float* W, int K, int N, unsigned char* WT, RowMap rowmap, float sc, lfloat* scr, int item, int lane) {
    const int nblk = N / 32, kb = item / nblk, nb = item % nblk, k0 = 64 * kb, n0 = 32 * nb;
#pragma unroll 8
    for (int i = 0; i < 32; ++i) { const int kk = 2 * i + (lane >> 5); scr[kk * 33 + (lane & 31)] = W[(size_t)(k0 + kk) * N + n0 + (lane & 31)] * sc; }
    asm volatile("s_waitcnt lgkmcnt(0)" ::: "memory");
    const int c = lane & 7;
#pragma unroll
    for (int j = 0; j < 4; ++j) { const int n = (lane >> 3) + 8 * j; const lfloat* s = scr + (8 * c) * 33 + n;
        u32x2 o; o.x = pk4_fp8(s[0 * 33], s[1 * 33], s[2 * 33], s[3 * 33]); o.y = pk4_fp8(s[4 * 33], s[5 * 33], s[6 * 33], s[7 * 33]);
        *(u32x2*)(WT + (size_t)rowmap(n0 + n) * K + k0 + 8 * c) = o; }
    asm volatile("s_waitcnt lgkmcnt(0)" ::: "memory");
}
struct RowId { __device__ int operator()(int n) const { return n; } };
struct RowGLU { int base; __device__ int operator()(int n) const { return ((n >> 7) << 8) + base + (n & 127); } };

__device__ __forceinline__ void norm_mod_row(const float* xrow, const float* g, const float* sc, const float* sh, bf16_t* orow, int lane, unsigned* o8row = nullptr) {
    const f32x4* xr = (const f32x4*)xrow + lane;
    f32x4 v[4]; float s = 0.f;
#pragma unroll
    for (int j = 0; j < 4; ++j) { v[j] = xr[64 * j]; s += (v[j].x * v[j].x + v[j].y * v[j].y) + (v[j].z * v[j].z + v[j].w * v[j].w); }
    const float rstd = __builtin_amdgcn_rsqf(wave_sum(s) * (1.f / D) + NORM_EPS);
    u32x2* o8 = (u32x2*)orow + lane;
#pragma unroll
    for (int j = 0; j < 4; ++j) { const f32x4 gg = ((const f32x4*)g)[lane + 64 * j], ss = ((const f32x4*)sc)[lane + 64 * j], hh = ((const f32x4*)sh)[lane + 64 * j];
        const f32x4 y = v[j] * rstd * gg * (ss + 1.f) + hh;
        if (orow) { u32x2 w; w.x = pk2(y.x, y.y); w.y = pk2(y.z, y.w); o8[64 * j] = w; }
        if (o8row) o8row[lane + 64 * j] = pk4_fp8(y.x, y.y, y.z, y.w); }
}

__device__ __forceinline__ void phase_p0(const Args& A, Ctx& C) {
    float* mod = WSP(float, WS_MOD);
    {
        lfloat* sc = (lfloat*)C.lds;
        lfloat* red = (lfloat*)(C.lds + 17 * 1024 * 4);
        const float* wada = A.in[I_WADA]; const float* bada = A.in[I_BADA];
        for (int it = C.bid; it < 96 * 2; it += C.G) {
            const int chunk = it >> 1, pass = it & 1, r0 = pass * 17, nr = pass ? 16 : 17, col0 = chunk * 64;
            __syncthreads();
            for (int i = C.tid; i < nr * 1024; i += 512) { const int r = i >> 10, k = i & 1023; const int rr = r0 + r;
                const float cv = rr < 32 ? A.in[I_C][rr * 1024 + k] : A.in[I_CCTX][k]; sc[r * 1024 + k] = siluf_(cv); }
            __syncthreads();
            const int col = C.tid & 63, kq = C.tid >> 6;
            float acc[17];
#pragma unroll
            for (int r = 0; r < 17; ++r) acc[r] = 0.f;
            for (int k = kq * 128; k < kq * 128 + 128; k += 4) {
                float w[4];
#pragma unroll
                for (int j = 0; j < 4; ++j) w[j] = wada[(size_t)(k + j) * MODW + col0 + col];
#pragma unroll
                for (int r = 0; r < 17; ++r) { const f32x4 s4 = *(const LAS f32x4*)(sc + r * 1024 + k); acc[r] += s4.x * w[0] + s4.y * w[1] + s4.z * w[2] + s4.w * w[3]; }
            }
#pragma unroll
            for (int r = 0; r < 17; ++r) red[(kq * 17 + r) * 64 + col] = acc[r];
            __syncthreads();
            for (int i = C.tid; i < nr * 64; i += 512) { const int r = i >> 6, cc = i & 63; float s = 0.f;
#pragma unroll
                for (int q = 0; q < 8; ++q) s += red[(q * 17 + r) * 64 + cc];
                mod[(size_t)(r0 + r) * MODW + col0 + cc] = s + bada[col0 + cc]; }
        }
        __syncthreads();
    }
    {
        lfloat* scr = (lfloat*)(C.lds + C.wave * 16384);
        const int gw = C.bid * 8 + C.wave, NGW = C.G * 8;
        unsigned char* btin8 = A.ws + WS_BTIN; bf16_t* btout = WSP(bf16_t, WS_BTOUT); bf16_t* btr = WSP(bf16_t, WS_BTR);
        constexpr int I_IN = (D / 64) * 124, I_OUT = (D / 64) * (D / 32), I_R = (D / 64) * (NE / 32), I_G = (128 / 64) * (DA / 32);
        for (int it = gw; it < I_IN + I_OUT + I_R + I_G; it += NGW) {
            int r = it;
            if (r < I_IN) {
                const int kb = r / 124, nb = r % 124, k0 = 64 * kb, n0 = 32 * nb; const float* W = A.in[I_WIN];
#pragma unroll 8
                for (int i = 0; i < 32; ++i) { const int kk = 2 * i + (C.lane >> 5); scr[kk * 33 + (C.lane & 31)] = W[(size_t)(k0 + kk) * IN_COLS + n0 + (C.lane & 31)] * SWIN; }
                asm volatile("s_waitcnt lgkmcnt(0)" ::: "memory");
                const int c = C.lane & 7;
#pragma unroll
                for (int j = 0; j < 4; ++j) { const int n = (C.lane >> 3) + 8 * j; const lfloat* s = scr + (8 * c) * 33 + n;
                    u32x2 o; o.x = pk4_fp8(s[0 * 33], s[1 * 33], s[2 * 33], s[3 * 33]); o.y = pk4_fp8(s[4 * 33], s[5 * 33], s[6 * 33], s[7 * 33]);
                    *(u32x2*)(btin8 + (size_t)(n0 + n) * D + k0 + 8 * c) = o; }
                asm volatile("s_waitcnt lgkmcnt(0)" ::: "memory");
                continue; }
            r -= I_IN;
            if (r < I_OUT) { transpose_item(A.in[I_WOUT], D, D, btout, RowId(), scr, r, C.lane); continue; } r -= I_OUT;
            if (r < I_R) { transpose_item(A.in[I_RW], D, NE, btr, RowId(), scr, r, C.lane); continue; } r -= I_R;
            transpose_item(A.in[I_GUP], 128, DA, WSP(bf16_t, WS_GUPT), RowId(), scr, r, C.lane);
        }
        for (int i = C.bid * 512 + C.tid; i < 16 * D / 4; i += C.G * 512) { const int n = 3968 + (i >> 8), k = (i & 255) * 4; const float* W = A.in[I_WIN];
            *(unsigned*)(btin8 + (size_t)n * D + k) = pk4_fp8(W[(size_t)k * IN_COLS + n] * SWIN, W[(size_t)(k + 1) * IN_COLS + n] * SWIN, W[(size_t)(k + 2) * IN_COLS + n] * SWIN, W[(size_t)(k + 3) * IN_COLS + n] * SWIN); }
        for (int i = C.bid * 512 + C.tid; i < (PLD - IN_COLS) * D / 16; i += C.G * 512) ((u32x4*)(btin8 + (size_t)IN_COLS * D))[i] = (u32x4){0u, 0u, 0u, 0u};
    }
}

__device__ __forceinline__ void phase_p1(const Args& A, Ctx& C) {
    const float* mod = WSP(float, WS_MOD); bf16_t* xn = WSP(bf16_t, WS_XN);
    const int gw = C.bid * 8 + C.wave, NGW = C.G * 8;
    for (int row = gw; row < NROWS; row += NGW) {
        const float* xr; int mb;
        if (row < NLAT) { xr = A.in[I_X] + (size_t)row * D; mb = row >> 11; } else { xr = A.in[I_CTX] + (size_t)(row - NLAT) * D; mb = 32; }
        const float* m = mod + (size_t)mb * MODW;
        norm_mod_row(xr, A.in[I_N1G], m + D, m, nullptr, C.lane, (unsigned*)(A.ws + WS_XN) + (size_t)row * (D / 4));
    }
}

__device__ __forceinline__ float bfsel(unsigned w, unsigned sh) { return __builtin_bit_cast(float, (w << sh) & 0xffff0000u); }
template <int NK>
__device__ __forceinline__ f32x4 mm_tile(const lbyte* Ap, int lda, const lbyte* Bp, int ldb, f32x4 acc, int lane) {
    const int r = lane & 15, g = lane >> 4;
#pragma unroll
    for (int ks = 0; ks < NK; ++ks) {
        const bf16x8 a = *(const LAS bf16x8*)(Ap + r * lda + ks * 64 + g * 16);
        const bf16x8 b = *(const LAS bf16x8*)(Bp + r * ldb + ks * 64 + g * 16);
        acc = __builtin_amdgcn_mfma_f32_16x16x32_bf16(a, b, acc, 0, 0, 0);
    }
    return acc;
}

__device__ __forceinline__ void st_bf16x4(lbyte* p, f32x4 v) { u32x2 w; w.x = cvtpk(v.x, v.y); w.y = cvtpk(v.z, v.w); *(LAS u32x2*)p = w; }
__device__ __forceinline__ void st_bf16(lbyte* p, float v) { *(LAS unsigned short*)p = (unsigned short)cvtpk(v, v); }
__device__ __forceinline__ float rdlane(float v, int l) { return __builtin_bit_cast(float, __builtin_amdgcn_readlane(__builtin_bit_cast(int, v), l)); }

__device__ __forceinline__ void tri_inv16(const f32x4 m, int lane, lbyte* scr, float (&X)[16]) {
    *(LAS f32x4*)(scr + (lane & 15) * 64 + (lane >> 4) * 16) = m;
    asm volatile("s_waitcnt lgkmcnt(0)" ::: "memory");
    float Mr[16];
#pragma unroll
    for (int kq = 0; kq < 4; ++kq) { const f32x4 r = *(const LAS f32x4*)(scr + (lane & 15) * 64 + kq * 16); Mr[4 * kq] = r.x; Mr[4 * kq + 1] = r.y; Mr[4 * kq + 2] = r.z; Mr[4 * kq + 3] = r.w; }
    const int l16 = lane & 15;
    X[0] = (l16 == 0) ? 1.f : 0.f;
    { float a0 = (l16 == 1) ? 1.f : 0.f, a1 = 0.f, a2 = 0.f, a3 = 0.f;
      asm("s_nop 1\n\t" "v_fmac_f32_dpp %0, -%2, %3 row_newbcast:1 row_mask:0xf bank_mask:0xf\n\t" : "+v"(a0), "+v"(a1) : "v"(Mr[0]), "v"(X[0]));
      X[1] = (a0 + a1) + (a2 + a3); }
    { float a0 = (l16 == 2) ? 1.f : 0.f, a1 = 0.f, a2 = 0.f, a3 = 0.f;
      asm("s_nop 1\n\t" "v_fmac_f32_dpp %0, -%2, %3 row_newbcast:2 row_mask:0xf bank_mask:0xf\n\t" "v_fmac_f32_dpp %1, -%4, %5 row_newbcast:2 row_mask:0xf bank_mask:0xf\n\t" : "+v"(a0), "+v"(a1) : "v"(Mr[0]), "v"(X[0]), "v"(Mr[1]), "v"(X[1]));
      X[2] = (a0 + a1) + (a2 + a3); }
    { float a0 = (l16 == 3) ? 1.f : 0.f, a1 = 0.f, a2 = 0.f, a3 = 0.f;
      asm("s_nop 1\n\t" "v_fmac_f32_dpp %0, -%2, %3 row_newbcast:3 row_mask:0xf bank_mask:0xf\n\t" "v_fmac_f32_dpp %1, -%4, %5 row_newbcast:3 row_mask:0xf bank_mask:0xf\n\t" : "+v"(a0), "+v"(a1) : "v"(Mr[0]), "v"(X[0]), "v"(Mr[1]), "v"(X[1]));
      asm("s_nop 1\n\t" "v_fmac_f32_dpp %0, -%2, %3 row_newbcast:3 row_mask:0xf bank_mask:0xf\n\t" : "+v"(a2), "+v"(a3) : "v"(Mr[2]), "v"(X[2]));
      X[3] = (a0 + a1) + (a2 + a3); }
    { float a0 = (l16 == 4) ? 1.f : 0.f, a1 = 0.f, a2 = 0.f, a3 = 0.f;
      asm("s_nop 1\n\t" "v_fmac_f32_dpp %0, -%2, %3 row_newbcast:4 row_mask:0xf bank_mask:0xf\n\t" "v_fmac_f32_dpp %1, -%4, %5 row_newbcast:4 row_mask:0xf bank_mask:0xf\n\t" : "+v"(a0), "+v"(a1) : "v"(Mr[0]), "v"(X[0]), "v"(Mr[1]), "v"(X[1]));
      asm("s_nop 1\n\t" "v_fmac_f32_dpp %0, -%2, %3 row_newbcast:4 row_mask:0xf bank_mask:0xf\n\t" "v_fmac_f32_dpp %1, -%4, %5 row_newbcast:4 row_mask:0xf bank_mask:0xf\n\t" : "+v"(a2), "+v"(a3) : "v"(Mr[2]), "v"(X[2]), "v"(Mr[3]), "v"(X[3]));
      X[4] = (a0 + a1) + (a2 + a3); }
    { float a0 = (l16 == 5) ? 1.f : 0.f, a1 = 0.f, a2 = 0.f, a3 = 0.f;
      asm("s_nop 1\n\t" "v_fmac_f32_dpp %0, -%2, %3 row_newbcast:5 row_mask:0xf bank_mask:0xf\n\t" "v_fmac_f32_dpp %1, -%4, %5 row_newbcast:5 row_mask:0xf bank_mask:0xf\n\t" "v_fmac_f32_dpp %0, -%6, %7 row_newbcast:5 row_mask:0xf bank_mask:0xf\n\t" : "+v"(a0), "+v"(a1) : "v"(Mr[0]), "v"(X[0]), "v"(Mr[1]), "v"(X[1]), "v"(Mr[4]), "v"(X[4]));
      asm("s_nop 1\n\t" "v_fmac_f32_dpp %0, -%2, %3 row_newbcast:5 row_mask:0xf bank_mask:0xf\n\t" "v_fmac_f32_dpp %1, -%4, %5 row_newbcast:5 row_mask:0xf bank_mask:0xf\n\t" : "+v"(a2), "+v"(a3) : "v"(Mr[2]), "v"(X[2]), "v"(Mr[3]), "v"(X[3]));
      X[5] = (a0 + a1) + (a2 + a3); }
    { float a0 = (l16 == 6) ? 1.f : 0.f, a1 = 0.f, a2 = 0.f, a3 = 0.f;
      asm("s_nop 1\n\t" "v_fmac_f32_dpp %0, -%2, %3 row_newbcast:6 row_mask:0xf bank_mask:0xf\n\t" "v_fmac_f32_dpp %1, -%4, %5 row_newbcast:6 row_mask:0xf bank_mask:0xf\n\t" "v_fmac_f32_dpp %0, -%6, %7 row_newbcast:6 row_mask:0xf bank_mask:0xf\n\t" "v_fmac_f32_dpp %1, -%8, %9 row_newbcast:6 row_mask:0xf bank_mask:0xf\n\t" : "+v"(a0), "+v"(a1) : "v"(Mr[0]), "v"(X[0]), "v"(Mr[1]), "v"(X[1]), "v"(Mr[4]), "v"(X[4]), "v"(Mr[5]), "v"(X[5]));
      asm("s_nop 1\n\t" "v_fmac_f32_dpp %0, -%2, %3 row_newbcast:6 row_mask:0xf bank_mask:0xf\n\t" "v_fmac_f32_dpp %1, -%4, %5 row_newbcast:6 row_mask:0xf bank_mask:0xf\n\t" : "+v"(a2), "+v"(a3) : "v"(Mr[2]), "v"(X[2]), "v"(Mr[3]), "v"(X[3]));
      X[6] = (a0 + a1) + (a2 + a3); }
    { float a0 = (l16 == 7) ? 1.f : 0.f, a1 = 0.f, a2 = 0.f, a3 = 0.f;
      asm("s_nop 1\n\t" "v_fmac_f32_dpp %0, -%2, %3 row_newbcast:7 row_mask:0xf bank_mask:0xf\n\t" "v_fmac_f32_dpp %1, -%4, %5 row_newbcast:7 row_mask:0xf bank_mask:0xf\n\t" "v_fmac_f32_dpp %0, -%6, %7 row_newbcast:7 row_mask:0xf bank_mask:0xf\n\t" "v_fmac_f32_dpp %1, -%8, %9 row_newbcast:7 row_mask:0xf bank_mask:0xf\n\t" : "+v"(a0), "+v"(a1) : "v"(Mr[0]), "v"(X[0]), "v"(Mr[1]), "v"(X[1]), "v"(Mr[4]), "v"(X[4]), "v"(Mr[5]), "v"(X[5]));
      asm("s_nop 1\n\t" "v_fmac_f32_dpp %0, -%2, %3 row_newbcast:7 row_mask:0xf bank_mask:0xf\n\t" "v_fmac_f32_dpp %1, -%4, %5 row_newbcast:7 row_mask:0xf bank_mask:0xf\n\t" "v_fmac_f32_dpp %0, -%6, %7 row_newbcast:7 row_mask:0xf bank_mask:0xf\n\t" : "+v"(a2), "+v"(a3) : "v"(Mr[2]), "v"(X[2]), "v"(Mr[3]), "v"(X[3]), "v"(Mr[6]), "v"(X[6]));
      X[7] = (a0 + a1) + (a2 + a3); }
    { float a0 = (l16 == 8) ? 1.f : 0.f, a1 = 0.f, a2 = 0.f, a3 = 0.f;
      asm("s_nop 1\n\t" "v_fmac_f32_dpp %0, -%2, %3 row_newbcast:8 row_mask:0xf bank_mask:0xf\n\t" "v_fmac_f32_dpp %1, -%4, %5 row_newbcast:8 row_mask:0xf bank_mask:0xf\n\t" "v_fmac_f32_dpp %0, -%6, %7 row_newbcast:8 row_mask:0xf bank_mask:0xf\n\t" "v_fmac_f32_dpp %1, -%8, %9 row_newbcast:8 row_mask:0xf bank_mask:0xf\n\t" : "+v"(a0), "+v"(a1) : "v"(Mr[0]), "v"(X[0]), "v"(Mr[1]), "v"(X[1]), "v"(Mr[4]), "v"(X[4]), "v"(Mr[5]), "v"(X[5]));
      asm("s_nop 1\n\t" "v_fmac_f32_dpp %0, -%2, %3 row_newbcast:8 row_mask:0xf bank_mask:0xf\n\t" "v_fmac_f32_dpp %1, -%4, %5 row_newbcast:8 row_mask:0xf bank_mask:0xf\n\t" "v_fmac_f32_dpp %0, -%6, %7 row_newbcast:8 row_mask:0xf bank_mask:0xf\n\t" "v_fmac_f32_dpp %1, -%8, %9 row_newbcast:8 row_mask:0xf bank_mask:0xf\n\t" : "+v"(a2), "+v"(a3) : "v"(Mr[2]), "v"(X[2]), "v"(Mr[3]), "v"(X[3]), "v"(Mr[6]), "v"(X[6]), "v"(Mr[7]), "v"(X[7]));
      X[8] = (a0 + a1) + (a2 + a3); }
    { float a0 = (l16 == 9) ? 1.f : 0.f, a1 = 0.f, a2 = 0.f, a3 = 0.f;
      asm("s_nop 1\n\t" "v_fmac_f32_dpp %0, -%2, %3 row_newbcast:9 row_mask:0xf bank_mask:0xf\n\t" "v_fmac_f32_dpp %1, -%4, %5 row_newbcast:9 row_mask:0xf bank_mask:0xf\n\t" "v_fmac_f32_dpp %0, -%6, %7 row_newbcast:9 row_mask:0xf bank_mask:0xf\n\t" "v_fmac_f32_dpp %1, -%8, %9 row_newbcast:9 row_mask:0xf bank_mask:0xf\n\t" "v_fmac_f32_dpp %0, -%10, %11 row_newbcast:9 row_mask:0xf bank_mask:0xf\n\t" : "+v"(a0), "+v"(a1) : "v"(Mr[0]), "v"(X[0]), "v"(Mr[1]), "v"(X[1]), "v"(Mr[4]), "v"(X[4]), "v"(Mr[5]), "v"(X[5]), "v"(Mr[8]), "v"(X[8]));
      asm("s_nop 1\n\t" "v_fmac_f32_dpp %0, -%2, %3 row_newbcast:9 row_mask:0xf bank_mask:0xf\n\t" "v_fmac_f32_dpp %1, -%4, %5 row_newbcast:9 row_mask:0xf bank_mask:0xf\n\t" "v_fmac_f32_dpp %0, -%6, %7 row_newbcast:9 row_mask:0xf bank_mask:0xf\n\t" "v_fmac_f32_dpp %1, -%8, %9 row_newbcast:9 row_mask:0xf bank_mask:0xf\n\t" : "+v"(a2), "+v"(a3) : "v"(Mr[2]), "v"(X[2]), "v"(Mr[3]), "v"(X[3]), "v"(Mr[6]), "v"(X[6]), "v"(Mr[7]), "v"(X[7]));
      X[9] = (a0 + a1) + (a2 + a3); }
    { float a0 = (l16 == 10) ? 1.f : 0.f, a1 = 0.f, a2 = 0.f, a3 = 0.f;
      asm("s_nop 1\n\t" "v_fmac_f32_dpp %0, -%2, %3 row_newbcast:10 row_mask:0xf bank_mask:0xf\n\t" "v_fmac_f32_dpp %1, -%4, %5 row_newbcast:10 row_mask:0xf bank_mask:0xf\n\t" "v_fmac_f32_dpp %0, -%6, %7 row_newbcast:10 row_mask:0xf bank_mask:0xf\n\t" "v_fmac_f32_dpp %1, -%8, %9 row_newbcast:10 row_mask:0xf bank_mask:0xf\n\t" "v_fmac_f32_dpp %0, -%10, %11 row_newbcast:10 row_mask:0xf bank_mask:0xf\n\t" "v_fmac_f32_dpp %1, -%12, %13 row_newbcast:10 row_mask:0xf bank_mask:0xf\n\t" : "+v"(a0), "+v"(a1) : "v"(Mr[0]), "v"(X[0]), "v"(Mr[1]), "v"(X[1]), "v"(Mr[4]), "v"(X[4]), "v"(Mr[5]), "v"(X[5]), "v"(Mr[8]), "v"(X[8]), "v"(Mr[9]), "v"(X[9]));
      asm("s_nop 1\n\t" "v_fmac_f32_dpp %0, -%2, %3 row_newbcast:10 row_mask:0xf bank_mask:0xf\n\t" "v_fmac_f32_dpp %1, -%4, %5 row_newbcast:10 row_mask:0xf bank_mask:0xf\n\t" "v_fmac_f32_dpp %0, -%6, %7 row_newbcast:10 row_mask:0xf bank_mask:0xf\n\t" "v_fmac_f32_dpp %1, -%8, %9 row_newbcast:10 row_mask:0xf bank_mask:0xf\n\t" : "+v"(a2), "+v"(a3) : "v"(Mr[2]), "v"(X[2]), "v"(Mr[3]), "v"(X[3]), "v"(Mr[6]), "v"(X[6]), "v"(Mr[7]), "v"(X[7]));
      X[10] = (a0 + a1) + (a2 + a3); }
    { float a0 = (l16 == 11) ? 1.f : 0.f, a1 = 0.f, a2 = 0.f, a3 = 0.f;
      asm("s_nop 1\n\t" "v_fmac_f32_dpp %0, -%2, %3 row_newbcast:11 row_mask:0xf bank_mask:0xf\n\t" "v_fmac_f32_dpp %1, -%4, %5 row_newbcast:11 row_mask:0xf bank_mask:0xf\n\t" "v_fmac_f32_dpp %0, -%6, %7 row_newbcast:11 row_mask:0xf bank_mask:0xf\n\t" "v_fmac_f32_dpp %1, -%8, %9 row_newbcast:11 row_mask:0xf bank_mask:0xf\n\t" "v_fmac_f32_dpp %0, -%10, %11 row_newbcast:11 row_mask:0xf bank_mask:0xf\n\t" "v_fmac_f32_dpp %1, -%12, %13 row_newbcast:11 row_mask:0xf bank_mask:0xf\n\t" : "+v"(a0), "+v"(a1) : "v"(Mr[0]), "v"(X[0]), "v"(Mr[1]), "v"(X[1]), "v"(Mr[4]), "v"(X[4]), "v"(Mr[5]), "v"(X[5]), "v"(Mr[8]), "v"(X[8]), "v"(Mr[9]), "v"(X[9]));
      asm("s_nop 1\n\t" "v_fmac_f32_dpp %0, -%2, %3 row_newbcast:11 row_mask:0xf bank_mask:0xf\n\t" "v_fmac_f32_dpp %1, -%4, %5 row_newbcast:11 row_mask:0xf bank_mask:0xf\n\t" "v_fmac_f32_dpp %0, -%6, %7 row_newbcast:11 row_mask:0xf bank_mask:0xf\n\t" "v_fmac_f32_dpp %1, -%8, %9 row_newbcast:11 row_mask:0xf bank_mask:0xf\n\t" "v_fmac_f32_dpp %0, -%10, %11 row_newbcast:11 row_mask:0xf bank_mask:0xf\n\t" : "+v"(a2), "+v"(a3) : "v"(Mr[2]), "v"(X[2]), "v"(Mr[3]), "v"(X[3]), "v"(Mr[6]), "v"(X[6]), "v"(Mr[7]), "v"(X[7]), "v"(Mr[10]), "v"(X[10]));
      X[11] = (a0 + a1) + (a2 + a3); }
    { float a0 = (l16 == 12) ? 1.f : 0.f, a1 = 0.f, a2 = 0.f, a3 = 0.f;
      asm("s_nop 1\n\t" "v_fmac_f32_dpp %0, -%2, %3 row_newbcast:12 row_mask:0xf bank_mask:0xf\n\t" "v_fmac_f32_dpp %1, -%4, %5 row_newbcast:12 row_mask:0xf bank_mask:0xf\n\t" "v_fmac_f32_dpp %0, -%6, %7 row_newbcast:12 row_mask:0xf bank_mask:0xf\n\t" "v_fmac_f32_dpp %1, -%8, %9 row_newbcast:12 row_mask:0xf bank_mask:0xf\n\t" "v_fmac_f32_dpp %0, -%10, %11 row_newbcast:12 row_mask:0xf bank_mask:0xf\n\t" "v_fmac_f32_dpp %1, -%12, %13 row_newbcast:12 row_mask:0xf bank_mask:0xf\n\t" : "+v"(a0), "+v"(a1) : "v"(Mr[0]), "v"(X[0]), "v"(Mr[1]), "v"(X[1]), "v"(Mr[4]), "v"(X[4]), "v"(Mr[5]), "v"(X[5]), "v"(Mr[8]), "v"(X[8]), "v"(Mr[9]), "v"(X[9]));
      asm("s_nop 1\n\t" "v_fmac_f32_dpp %0, -%2, %3 row_newbcast:12 row_mask:0xf bank_mask:0xf\n\t" "v_fmac_f32_dpp %1, -%4, %5 row_newbcast:12 row_mask:0xf bank_mask:0xf\n\t" "v_fmac_f32_dpp %0, -%6, %7 row_newbcast:12 row_mask:0xf bank_mask:0xf\n\t" "v_fmac_f32_dpp %1, -%8, %9 row_newbcast:12 row_mask:0xf bank_mask:0xf\n\t" "v_fmac_f32_dpp %0, -%10, %11 row_newbcast:12 row_mask:0xf bank_mask:0xf\n\t" "v_fmac_f32_dpp %1, -%12, %13 row_newbcast:12 row_mask:0xf bank_mask:0xf\n\t" : "+v"(a2), "+v"(a3) : "v"(Mr[2]), "v"(X[2]), "v"(Mr[3]), "v"(X[3]), "v"(Mr[6]), "v"(X[6]), "v"(Mr[7]), "v"(X[7]), "v"(Mr[10]), "v"(X[10]), "v"(Mr[11]), "v"(X[11]));
      X[12] = (a0 + a1) + (a2 + a3); }
    { float a0 = (l16 == 13) ? 1.f : 0.f, a1 = 0.f, a2 = 0.f, a3 = 0.f;
      asm("s_nop 1\n\t" "v_fmac_f32_dpp %0, -%2, %3 row_newbcast:13 row_mask:0xf bank_mask:0xf\n\t" "v_fmac_f32_dpp %1, -%4, %5 row_newbcast:13 row_mask:0xf bank_mask:0xf\n\t" "v_fmac_f32_dpp %0, -%6, %7 row_newbcast:13 row_mask:0xf bank_mask:0xf\n\t" "v_fmac_f32_dpp %1, -%8, %9 row_newbcast:13 row_mask:0xf bank_mask:0xf\n\t" "v_fmac_f32_dpp %0, -%10, %11 row_newbcast:13 row_mask:0xf bank_mask:0xf\n\t" "v_fmac_f32_dpp %1, -%12, %13 row_newbcast:13 row_mask:0xf bank_mask:0xf\n\t" "v_fmac_f32_dpp %0, -%14, %15 row_newbcast:13 row_mask:0xf bank_mask:0xf\n\t" : "+v"(a0), "+v"(a1) : "v"(Mr[0]), "v"(X[0]), "v"(Mr[1]), "v"(X[1]), "v"(Mr[4]), "v"(X[4]), "v"(Mr[5]), "v"(X[5]), "v"(Mr[8]), "v"(X[8]), "v"(Mr[9]), "v"(X[9]), "v"(Mr[12]), "v"(X[12]));
      asm("s_nop 1\n\t" "v_fmac_f32_dpp %0, -%2, %3 row_newbcast:13 row_mask:0xf bank_mask:0xf\n\t" "v_fmac_f32_dpp %1, -%4, %5 row_newbcast:13 row_mask:0xf bank_mask:0xf\n\t" "v_fmac_f32_dpp %0, -%6, %7 row_newbcast:13 row_mask:0xf bank_mask:0xf\n\t" "v_fmac_f32_dpp %1, -%8, %9 row_newbcast:13 row_mask:0xf bank_mask:0xf\n\t" "v_fmac_f32_dpp %0, -%10, %11 row_newbcast:13 row_mask:0xf bank_mask:0xf\n\t" "v_fmac_f32_dpp %1, -%12, %13 row_newbcast:13 row_mask:0xf bank_mask:0xf\n\t" : "+v"(a2), "+v"(a3) : "v"(Mr[2]), "v"(X[2]), "v"(Mr[3]), "v"(X[3]), "v"(Mr[6]), "v"(X[6]), "v"(Mr[7]), "v"(X[7]), "v"(Mr[10]), "v"(X[10]), "v"(Mr[11]), "v"(X[11]));
      X[13] = (a0 + a1) + (a2 + a3); }
    { float a0 = (l16 == 14) ? 1.f : 0.f, a1 = 0.f, a2 = 0.f, a3 = 0.f;
      asm("s_nop 1\n\t" "v_fmac_f32_dpp %0, -%2, %3 row_newbcast:14 row_mask:0xf bank_mask:0xf\n\t" "v_fmac_f32_dpp %1, -%4, %5 row_newbcast:14 row_mask:0xf bank_mask:0xf\n\t" "v_fmac_f32_dpp %0, -%6, %7 row_newbcast:14 row_mask:0xf bank_mask:0xf\n\t" "v_fmac_f32_dpp %1, -%8, %9 row_newbcast:14 row_mask:0xf bank_mask:0xf\n\t" "v_fmac_f32_dpp %0, -%10, %11 row_newbcast:14 row_mask:0xf bank_mask:0xf\n\t" "v_fmac_f32_dpp %1, -%12, %13 row_newbcast:14 row_mask:0xf bank_mask:0xf\n\t" "v_fmac_f32_dpp %0, -%14, %15 row_newbcast:14 row_mask:0xf bank_mask:0xf\n\t" "v_fmac_f32_dpp %1, -%16, %17 row_newbcast:14 row_mask:0xf bank_mask:0xf\n\t" : "+v"(a0), "+v"(a1) : "v"(Mr[0]), "v"(X[0]), "v"(Mr[1]), "v"(X[1]), "v"(Mr[4]), "v"(X[4]), "v"(Mr[5]), "v"(X[5]), "v"(Mr[8]), "v"(X[8]), "v"(Mr[9]), "v"(X[9]), "v"(Mr[12]), "v"(X[12]), "v"(Mr[13]), "v"(X[13]));
      asm("s_nop 1\n\t" "v_fmac_f32_dpp %0, -%2, %3 row_newbcast:14 row_mask:0xf bank_mask:0xf\n\t" "v_fmac_f32_dpp %1, -%4, %5 row_newbcast:14 row_mask:0xf bank_mask:0xf\n\t" "v_fmac_f32_dpp %0, -%6, %7 row_newbcast:14 row_mask:0xf bank_mask:0xf\n\t" "v_fmac_f32_dpp %1, -%8, %9 row_newbcast:14 row_mask:0xf bank_mask:0xf\n\t" "v_fmac_f32_dpp %0, -%10, %11 row_newbcast:14 row_mask:0xf bank_mask:0xf\n\t" "v_fmac_f32_dpp %1, -%12, %13 row_newbcast:14 row_mask:0xf bank_mask:0xf\n\t" : "+v"(a2), "+v"(a3) : "v"(Mr[2]), "v"(X[2]), "v"(Mr[3]), "v"(X[3]), "v"(Mr[6]), "v"(X[6]), "v"(Mr[7]), "v"(X[7]), "v"(Mr[10]), "v"(X[10]), "v"(Mr[11]), "v"(X[11]));
      X[14] = (a0 + a1) + (a2 + a3); }
    { float a0 = (l16 == 15) ? 1.f : 0.f, a1 = 0.f, a2 = 0.f, a3 = 0.f;
      asm("s_nop 1\n\t" "v_fmac_f32_dpp %0, -%2, %3 row_newbcast:15 row_mask:0xf bank_mask:0xf\n\t" "v_fmac_f32_dpp %1, -%4, %5 row_newbcast:15 row_mask:0xf bank_mask:0xf\n\t" "v_fmac_f32_dpp %0, -%6, %7 row_newbcast:15 row_mask:0xf bank_mask:0xf\n\t" "v_fmac_f32_dpp %1, -%8, %9 row_newbcast:15 row_mask:0xf bank_mask:0xf\n\t" "v_fmac_f32_dpp %0, -%10, %11 row_newbcast:15 row_mask:0xf bank_mask:0xf\n\t" "v_fmac_f32_dpp %1, -%12, %13 row_newbcast:15 row_mask:0xf bank_mask:0xf\n\t" "v_fmac_f32_dpp %0, -%14, %15 row_newbcast:15 row_mask:0xf bank_mask:0xf\n\t" "v_fmac_f32_dpp %1, -%16, %17 row_newbcast:15 row_mask:0xf bank_mask:0xf\n\t" : "+v"(a0), "+v"(a1) : "v"(Mr[0]), "v"(X[0]), "v"(Mr[1]), "v"(X[1]), "v"(Mr[4]), "v"(X[4]), "v"(Mr[5]), "v"(X[5]), "v"(Mr[8]), "v"(X[8]), "v"(Mr[9]), "v"(X[9]), "v"(Mr[12]), "v"(X[12]), "v"(Mr[13]), "v"(X[13]));
      asm("s_nop 1\n\t" "v_fmac_f32_dpp %0, -%2, %3 row_newbcast:15 row_mask:0xf bank_mask:0xf\n\t" "v_fmac_f32_dpp %1, -%4, %5 row_newbcast:15 row_mask:0xf bank_mask:0xf\n\t" "v_fmac_f32_dpp %0, -%6, %7 row_newbcast:15 row_mask:0xf bank_mask:0xf\n\t" "v_fmac_f32_dpp %1, -%8, %9 row_newbcast:15 row_mask:0xf bank_mask:0xf\n\t" "v_fmac_f32_dpp %0, -%10, %11 row_newbcast:15 row_mask:0xf bank_mask:0xf\n\t" "v_fmac_f32_dpp %1, -%12, %13 row_newbcast:15 row_mask:0xf bank_mask:0xf\n\t" "v_fmac_f32_dpp %0, -%14, %15 row_newbcast:15 row_mask:0xf bank_mask:0xf\n\t" : "+v"(a2), "+v"(a3) : "v"(Mr[2]), "v"(X[2]), "v"(Mr[3]), "v"(X[3]), "v"(Mr[6]), "v"(X[6]), "v"(Mr[7]), "v"(X[7]), "v"(Mr[10]), "v"(X[10]), "v"(Mr[11]), "v"(X[11]), "v"(Mr[14]), "v"(X[14]));
      X[15] = (a0 + a1) + (a2 + a3); }
}

#ifndef RWKV_REP
#define RWKV_REP 1
#endif
namespace rk {
constexpr int S64 = 160, S32 = 80, SW = 144;
constexpr int O_WUP = 0, O_AUP = O_WUP + 64 * SW, O_WLT = O_AUP + 64 * SW, O_ALT = O_WLT + 16 * S64, O_LW = O_ALT + 16 * S64, O_LA = O_LW + 4096,
              O_KKT = O_LA + 4096, O_RT = O_KKT + 16 * S64, O_BT = O_RT + 16 * S64, O_KDT = O_BT + 16 * S64,
              O_VT = O_KDT + 16 * S64, O_BHT = O_VT + 64 * S32, O_KHT = O_BHT + 64 * S32, O_UT = O_KHT + 64 * S32, O_UTT = O_WLT  ,
              O_TI = O_UT + 64 * S32, O_MK = O_TI + 16 * S32, O_NB = O_MK + 16 * S32, O_NK = O_NB + 16 * S32,
              O_SBF = O_NK + 16 * S32, O_WC = O_SBF + 64 * S64, O_WT = O_WC + 256, TEAM_BYTES = O_WT + 1024;
static_assert(2 * TEAM_BYTES <= LDS_MISC, "rwkv LDS");
}
__device__ __forceinline__ void rwkv_pair_chunked(const Args& A, Ctx& C, int pair) {
    using namespace rk;
    const int b = pair >> 3, h = pair & 7;
    const int dir = C.wave >> 2;
    const int t4 = C.tid & 255, q = C.wave & 3, lane = C.lane;
    lbyte* L = C.lds + dir * TEAM_BYTES;
    const bf16_t* P = WSP(bf16_t, WS_P);
    bf16_t* ydir = WSP(bf16_t, WS_YDIR) + (size_t)dir * NLAT * D;
    float* bon = WSP(float, WS_BON) + (size_t)dir * NLAT * 8;
    __syncthreads();
#pragma unroll 2
    for (int i = t4; i < 4096; i += 256) { const int l = i >> 6, c = i & 63;
        st_bf16(L + O_WUP + c * SW + l * 2, A.in[I_WUP][((size_t)dir * 64 + l) * DA + 64 * h + c]);
        st_bf16(L + O_AUP + c * SW + l * 2, A.in[I_AUP][((size_t)dir * 64 + l) * DA + 64 * h + c]); }
#pragma unroll 2
    for (int i = t4; i < (4 * 64 * S32 + 4 * 16 * S32 + 64 * S64) / 4; i += 256) ((LAS unsigned*)(L + O_VT))[i] = 0u;
    for (int i = t4; i < (2 * 16 * S64) / 4; i += 256) ((LAS unsigned*)(L + O_WLT))[i] = 0u;
    const int c = lane;
    const int col5[5] = {64 * h + c, 512 + 64 * h + c, 1024 + 64 * h + c, 1536 + 64 * dir + c, 1664 + 64 * dir + c};
    float mu5[5]; unsigned coff[5], nm[5], nlo[5], nrg[5]; int ndb[5];
#pragma unroll
    for (int e = 0; e < 5; ++e) { mu5[e] = A.in[I_MU][col5[e]]; coff[e] = (unsigned)col5[e] * 2u; }
    auto set_rules = [&](bool ctx) {
#pragma unroll
        for (int e = 0; e < 5; ++e) { const int col = col5[e];
            if (ctx) { nm[e] = 0xffffffffu; nlo[e] = col < 960 ? 1u : 0u; nrg[e] = (unsigned)(CTX - 2); ndb[e] = (col < 960 ? -PLD : PLD) * 2; }
            else { const int cls = col < 480 ? 0 : (col < 960 ? 1 : (col < 1440 ? 2 : 3));
                nm[e] = cls < 2 ? 63u : 0xffffffffu; nlo[e] = cls == 0 ? 1u : (cls == 2 ? 64u : 0u); nrg[e] = cls < 2 ? 62u : (unsigned)(SEQ - 65);
                ndb[e] = (cls == 0 ? -PLD : (cls == 1 ? PLD : (cls == 2 ? -64 * PLD : 64 * PLD))) * 2; } } };
    set_rules(true);
    const char* wsb = (const char*)A.ws;
    const float kkc = A.in[I_KK][64 * h + c], kac = A.in[I_KA][64 * h + c], rkc = A.in[I_RK][64 * h + c];
    const float w0c = A.in[I_W0][dir * DA + 64 * h + c], a0c = A.in[I_A0][dir * DA + 64 * h + c];
    f32x4 Sacc[4];
#pragma unroll
    for (int i = 0; i < 4; ++i) Sacc[i] = (f32x4){0.f, 0.f, 0.f, 0.f};
    const int fr = lane & 15, fg = lane >> 4;
    unsigned short rawp[4][5], raws[4][5];
    auto chunk_geom = [&](int ch, bool& isctx, int& sbase, int& T, size_t& rowbase) { isctx = ch < 16; sbase = isctx ? ch * 16 : (ch - 16) * 16; T = isctx ? CTX : SEQ; rowbase = isctx ? (size_t)NLAT + (size_t)b * CTX : (size_t)b * SEQ; };
    auto issue_loads = [&](int ch) { bool isctx; int sbase, T; size_t rowbase; chunk_geom(ch, isctx, sbase, T, rowbase);
#pragma unroll
        for (int j = 0; j < 4; ++j) { const int i = 4 * q + j; const int t = __builtin_amdgcn_readfirstlane(dir ? (T - 1 - (sbase + i)) : (sbase + i));
            const unsigned rowoff = (unsigned)WS_P + (unsigned)(rowbase + t) * (unsigned)(PLD * 2);
#pragma unroll
            for (int e = 0; e < 5; ++e) { const unsigned vs = rowoff + coff[e]; const bool ok = (((unsigned)t & nm[e]) - nlo[e]) <= nrg[e]; const unsigned vn = ok ? vs + (unsigned)ndb[e] : 8u;
                rawp[j][e] = *(const bf16_t*)(wsb + vs); raws[j][e] = *(const bf16_t*)(wsb + vn); } } };
    u32x2 ypend; ypend.x = 0u; ypend.y = 0u; float bpend[4] = {0.f, 0.f, 0.f, 0.f};
    auto flush = [&](int pch) { bool pisctx; int psb, pT; size_t prb; chunk_geom(pch, pisctx, psb, pT, prb);
        if (!pisctx) { const int t = dir ? (pT - 1 - (psb + fr)) : (psb + fr);
            *(u32x2*)(ydir + ((size_t)b * SEQ + t) * D + 64 * h + 16 * q + 4 * fg) = ypend;
            if (lane == 0) {
#pragma unroll
                for (int j = 0; j < 4; ++j) { const int i = 4 * q + j; const int tj = dir ? (pT - 1 - (psb + i)) : (psb + i); bon[((size_t)b * SEQ + tj) * 8 + h] = bpend[j]; } } } };
    issue_loads(0);
    for (int ch = 0; ch < 144; ++ch) {
        bool isctx; int sbase, T; size_t rowbase; chunk_geom(ch, isctx, sbase, T, rowbase);
        float vr[4], vk[4], vv[4], vkk[4], lw[4], av[4];
        __syncthreads();
        float mxa[4][5];
#pragma unroll
        for (int j = 0; j < 4; ++j) {
#pragma unroll
            for (int e = 0; e < 5; ++e) { const float pv = bf2f(rawp[j][e]); const float sv = bf2f(raws[j][e]); mxa[j][e] = pv + mu5[e] * (sv - pv); } }
        asm volatile("" :: "v"(mxa[0][0]), "v"(mxa[0][1]), "v"(mxa[0][2]), "v"(mxa[0][3]), "v"(mxa[0][4]), "v"(mxa[1][0]), "v"(mxa[1][1]), "v"(mxa[1][2]), "v"(mxa[1][3]), "v"(mxa[1][4]),
                        "v"(mxa[2][0]), "v"(mxa[2][1]), "v"(mxa[2][2]), "v"(mxa[2][3]), "v"(mxa[2][4]), "v"(mxa[3][0]), "v"(mxa[3][1]), "v"(mxa[3][2]), "v"(mxa[3][3]), "v"(mxa[3][4]) : "memory");
        if (ch > 0) flush(ch - 1);
        if (ch == 15) set_rules(false);
        if (ch + 1 < 144) issue_loads(ch + 1);
        float cl[4];
        _Pragma("unroll") for (int rrep = 0; rrep < RWKV_REP; ++rrep) {
#pragma unroll
        for (int j = 0; j < 4; ++j) {
            const int i = 4 * q + j;
            float mx[5];
#pragma unroll
            for (int e = 0; e < 5; ++e) mx[e] = mxa[j][e];
            vr[j] = mx[0]; vk[j] = mx[1]; vv[j] = mx[2];
            *(LAS unsigned short*)(L + O_WLT + i * S64 + c * 2) = (unsigned short)cvtpk(tanhf_(mx[3]), 0.f); *(LAS unsigned short*)(L + O_ALT + i * S64 + c * 2) = (unsigned short)cvtpk(mx[4], 0.f);
            const float kx = vk[j] * kkc; const float ss = wave_sum(kx * kx);
            vkk[j] = kx * __builtin_amdgcn_rsqf(ss + 1e-6f);
        }
        __syncthreads();
        {
            const f32x4 z = (f32x4){0.f, 0.f, 0.f, 0.f};
            const f32x4 tw = mm_tile<2>(L + O_WLT, S64, L + O_WUP + 16 * q * SW, SW, z, lane);
            const f32x4 ta = mm_tile<2>(L + O_ALT, S64, L + O_AUP + 16 * q * SW, SW, z, lane);
#pragma unroll
            for (int e = 0; e < 4; ++e) { ((LAS float*)(L + O_LW))[(4 * fg + e) * 64 + 16 * q + fr] = tw[e]; ((LAS float*)(L + O_LA))[(4 * fg + e) * 64 + 16 * q + fr] = ta[e]; }
        }
        __syncthreads();
        { float run = 0.f;
#pragma unroll
        for (int j = 0; j < 4; ++j) { const int i = 4 * q + j;
            const float wlog = -softplusf_(-(w0c + ((LAS float*)(L + O_LW))[i * 64 + c])) - 0.5f;
            lw[j] = -__expf(wlog);
            av[j] = sigmoidf_(a0c + ((LAS float*)(L + O_LA))[i * 64 + c]);
            run += lw[j]; cl[j] = run; }
        ((LAS float*)(L + O_WT))[q * 64 + c] = run; }
        __syncthreads();
        }
        {
            float off = 0.f, cumC = 0.f;
#pragma unroll
            for (int qq = 0; qq < 4; ++qq) { const float tv = ((LAS float*)(L + O_WT))[qq * 64 + c]; cumC += tv; off += (qq < q) ? tv : 0.f; }
            float tv_[4], tb_[4], tk_[4];
            float Wprev = __expf(off); const float eC = __expf(cumC);
#pragma unroll
            for (int j = 0; j < 4; ++j) { const int i = 4 * q + j;
                const float cum = off + cl[j];
                const float Wt = __expf(cum), Wp = Wprev, Wi = __builtin_amdgcn_rcpf(Wt), Wc = eC * Wi; Wprev = Wt;
                const float kd = vk[j] * (1.f + (av[j] - 1.f) * kac), bb = vkk[j] * av[j];
                const unsigned p0 = cvtpk(vkk[j] * Wp, vr[j] * Wt), p1 = cvtpk(bb * Wi, kd * Wi);
                *(LAS unsigned short*)(L + O_KKT + i * S64 + c * 2) = (unsigned short)p0; *(LAS unsigned short*)(L + O_RT + i * S64 + c * 2) = (unsigned short)(p0 >> 16);
                *(LAS unsigned short*)(L + O_BT + i * S64 + c * 2) = (unsigned short)p1; *(LAS unsigned short*)(L + O_KDT + i * S64 + c * 2) = (unsigned short)(p1 >> 16);
                tv_[j] = vv[j]; tb_[j] = bb * Wc; tk_[j] = kd * Wc;
                const float bs = wave_sum(vr[j] * kd * rkc);
                bpend[j] = bs;
            }
            { u32x2 w2;
                w2.x = cvtpk(tv_[0], tv_[1]); w2.y = cvtpk(tv_[2], tv_[3]); *(LAS u32x2*)(L + O_VT + c * S32 + q * 8) = w2;
                w2.x = cvtpk(tb_[0], tb_[1]); w2.y = cvtpk(tb_[2], tb_[3]); *(LAS u32x2*)(L + O_BHT + c * S32 + q * 8) = w2;
                w2.x = cvtpk(tk_[0], tk_[1]); w2.y = cvtpk(tk_[2], tk_[3]); *(LAS u32x2*)(L + O_KHT + c * S32 + q * 8) = w2; }
            if (q == 3) ((LAS float*)(L + O_WC))[c] = eC;
        }
        __syncthreads();
        {
            const int role = (q + dir) & 3;
            const lbyte* Aj = L + ((role & 1) ? O_KDT : O_BT);
            const lbyte* Bt = L + ((role & 2) ? O_RT : O_KKT);
            f32x4 g4 = mm_tile<2>(Aj, S64, Bt, S64, (f32x4){0.f, 0.f, 0.f, 0.f}, lane);
#pragma unroll
            for (int e = 0; e < 4; ++e) { const int j = 4 * fg + e; const bool keep = (role & 2) ? (j <= fr) : (j < fr); g4[e] = keep ? g4[e] : 0.f; }
            if (role == 0) { float X[16]; tri_inv16(g4, lane, L + O_LW, X);
                if (lane < 16) {
#pragma unroll
                    for (int i = 0; i < 16; ++i) *(LAS unsigned short*)(L + O_TI + i * S32 + lane * 2) = (unsigned short)cvtpk(X[i], 0.f); } }
            else st_bf16x4(L + (role == 1 ? O_MK : (role == 2 ? O_NB : O_NK)) + fr * S32 + fg * 8, g4);
        }
        __syncthreads();
        f32x4 yacc;
        {
            f32x4 u4 = mm_tile<2>(L + O_KKT, S64, L + O_SBF + 16 * q * S64, S64, (f32x4){0.f, 0.f, 0.f, 0.f}, lane);
            u4 = mm_tile<1>(L + O_MK, S32, L + O_VT + 16 * q * S32, S32, u4, lane);
            st_bf16x4(L + O_UTT + (16 * q + fr) * S32 + fg * 8, u4);
            yacc = mm_tile<2>(L + O_SBF + 16 * q * S64, S64, L + O_RT, S64, (f32x4){0.f, 0.f, 0.f, 0.f}, lane);
            yacc = mm_tile<1>(L + O_VT + 16 * q * S32, S32, L + O_NK, S32, yacc, lane);
        }
        asm volatile("s_waitcnt lgkmcnt(0)" ::: "memory");
        {
            f32x4 u4 = mm_tile<1>(L + O_TI, S32, L + O_UTT + 16 * q * S32, S32, (f32x4){0.f, 0.f, 0.f, 0.f}, lane);
            st_bf16x4(L + O_UT + (16 * q + fr) * S32 + fg * 8, -u4);
        }
        __syncthreads();
        {
            yacc = mm_tile<1>(L + O_UT + 16 * q * S32, S32, L + O_NB, S32, yacc, lane);
            ypend.x = cvtpk(yacc[0], yacc[1]); ypend.y = cvtpk(yacc[2], yacc[3]);
            const f32x4 wc4 = *(LAS f32x4*)(L + O_WC + (16 * q + 4 * fg) * 4);
#pragma unroll
            for (int vi = 0; vi < 4; ++vi) {
                f32x4 s4 = Sacc[vi] * wc4;
                s4 = mm_tile<1>(L + O_KHT + 16 * q * S32, S32, L + O_VT + 16 * vi * S32, S32, s4, lane);
                s4 = mm_tile<1>(L + O_BHT + 16 * q * S32, S32, L + O_UT + 16 * vi * S32, S32, s4, lane);
                Sacc[vi] = s4;
                st_bf16x4(L + O_SBF + (16 * vi + fr) * S64 + (16 * q + 4 * fg) * 2, s4);
            }
        }
    }
    flush(143);
    __syncthreads();
}

__device__ __forceinline__ void phase_gdn_prep(const Args& A, Ctx& C) {
    const bf16_t* P = WSP(bf16_t, WS_P);
    bf16_t* QKV = (bf16_t*)A.out; float* NRM = WSP(float, WS_NRM);
    const int lane = C.lane, w = C.wave, hq = w >> 1, th = w & 1;
    const int ch0 = 128 * hq + 2 * lane;
    float cw[3][2][5];
#pragma unroll
    for (int g = 0; g < 3; ++g)
#pragma unroll
        for (int xx = 0; xx < 2; ++xx)
#pragma unroll
            for (int e = 0; e < 5; ++e) cw[g][xx][e] = A.in[I_CONVW][e * 1536 + g * 512 + ch0 + xx];
    auto geom = [&](int tile, int& T, int& tb, size_t& rowbase) { const int row0 = tile * 16; int ta;
        if (row0 < NLAT) { T = SEQ; rowbase = (size_t)(row0 >> 11) * SEQ; ta = row0 & (SEQ - 1); } else { T = CTX; const int r = row0 - NLAT; rowbase = (size_t)NLAT + (size_t)(r >> 8) * CTX; ta = r & (CTX - 1); }
        tb = ta + 8 * th; };
    unsigned raw[12][3];
    auto issue = [&](int tile) { int T, tb; size_t rowbase; geom(tile, T, tb, rowbase);
#pragma unroll
        for (int e = 0; e < 12; ++e) { const int t = tb - 2 + e; const bool ok = (t >= 0 && t < T); const unsigned* pr = (const unsigned*)(P + (rowbase + (ok ? t : tb)) * PLD + RW_COLS + ch0);
#pragma unroll
            for (int g = 0; g < 3; ++g) raw[e][g] = pr[g * 256]; } };
    if (C.bid < NROWS / 16) issue(C.bid);
    for (int tile = C.bid; tile < NROWS / 16; tile += C.G) {
        int T, tb; size_t rowbase; geom(tile, T, tb, rowbase);
        float x[3][2][12];
#pragma unroll
        for (int e = 0; e < 12; ++e) { const int t = tb - 2 + e; const bool ok = (t >= 0 && t < T);
#pragma unroll
            for (int g = 0; g < 3; ++g) { const unsigned wv = raw[e][g]; x[g][0][e] = ok ? bflo(wv) : 0.f; x[g][1][e] = ok ? bfhi(wv) : 0.f; } }
        if (tile + C.G < NROWS / 16) issue(tile + C.G);
#pragma unroll
        for (int i = 0; i < 8; ++i) { float y[3][2];
#pragma unroll
            for (int g = 0; g < 3; ++g)
#pragma unroll
                for (int xx = 0; xx < 2; ++xx) { float sacc = 0.f;
#pragma unroll
                    for (int f = 0; f < 5; ++f) sacc += cw[g][xx][f] * x[g][xx][i + f];
                    y[g][xx] = siluf_(sacc); }
            const size_t row = rowbase + tb + i;
            unsigned* orow = (unsigned*)(QKV + row * 1536 + ch0);
            orow[0] = cvtpk(y[0][0], y[0][1]); orow[256] = cvtpk(y[1][0], y[1][1]); orow[512] = cvtpk(y[2][0], y[2][1]);
            const float sq = wave_sum(y[0][0] * y[0][0] + y[0][1] * y[0][1]), sk = wave_sum(y[1][0] * y[1][0] + y[1][1] * y[1][1]);
            if (lane == 0) { NRM[row * 8 + hq] = __builtin_amdgcn_rsqf(sq + 1e-6f) * 0.08838834764831845f; NRM[row * 8 + 4 + hq] = __builtin_amdgcn_rsqf(sk + 1e-6f); } }
    }
    __syncthreads();
}

namespace gd {
constexpr int S128 = 288, S32 = 80;
constexpr int O_KT = 0, O_QT = O_KT + 32 * S128, O_KKT = O_QT + 32 * S128, O_RT = O_KKT + 32 * S128,
              O_VT = O_RT + 32 * S128, O_BHT = O_VT + 128 * S32, O_KHT = O_BHT + 128 * S32, O_UT = O_KHT + 128 * S32, O_UTT = O_UT + 128 * S32,
              O_TI = O_UTT + 128 * S32, O_MK = O_TI + 32 * S32, O_NB = O_MK + 32 * S32, O_NK = O_NB + 32 * S32,
              O_M21 = O_NK + 32 * S32, O_T11T = O_M21 + 16 * S32, O_T22 = O_T11T + 16 * S32, O_XT = O_T22 + 16 * S32,
              O_SBF = O_XT + 16 * S32, O_SC = O_SBF + 128 * S128, O_MS = O_SC + 512, GD_BYTES = O_MS + 2048;
static_assert(GD_BYTES <= LDS_MISC, "gdn LDS");
}
__device__ __forceinline__ void gdn_chain_chunked(const Args& A, Ctx& C, int chain) {
    using namespace gd;
    const int b = chain >> 3, h = (chain >> 1) & 3, dir = chain & 1;
    lbyte* L = C.lds;
    LAS float* SC = (LAS float*)(L + O_SC);
    const bf16_t* P = WSP(bf16_t, WS_P);
    bf16_t* ydir = WSP(bf16_t, WS_YDIR) + (size_t)dir * NLAT * D;
    const int tid = C.tid, lane = C.lane, w = C.wave, fr = lane & 15, fg = lane >> 4;
    const int grp = w >> 1, idx = tid & 127;
    const float Aexp = __expf(A.in[I_ALOG][dir * 4 + h]), dtb = A.in[I_DTB][dir * 4 + h];
    const f32x4 z4 = (f32x4){0.f, 0.f, 0.f, 0.f};
    __syncthreads();
#pragma unroll 2
    for (int i = tid; i < (O_SC - O_VT) / 4; i += 512) ((LAS unsigned*)(L + O_VT))[i] = 0u;
    f32x4 Sacc[8];
#pragma unroll
    for (int i = 0; i < 8; ++i) Sacc[i] = z4;
    const bf16_t* QKV = (const bf16_t*)A.out; const float* NRM = WSP(const float, WS_NRM);
    unsigned rq[8], rk[8], rv[8]; float nq[8], nk[8]; unsigned raw_al = 0, raw_be = 0;
    const unsigned codd = (idx & 1) ? 0u : 16u, godd = (h & 1) ? 0u : 16u;
    auto chunk_geom = [&](int ch, bool& isctx, int& sbase, int& T, size_t& rowbase) { isctx = ch < 8; sbase = isctx ? ch * 32 : (ch - 8) * 32; T = isctx ? CTX : SEQ;
        rowbase = isctx ? (size_t)NLAT + (size_t)b * CTX : (size_t)b * SEQ; };
    auto issue_loads = [&](int ch) { bool isctx; int sbase, T; size_t rowbase; chunk_geom(ch, isctx, sbase, T, rowbase);
#pragma unroll
        for (int j = 0; j < 8; ++j) { const int i = 8 * grp + j; const int t = dir ? (T - 1 - (sbase + i)) : (sbase + i); const size_t row = rowbase + t;
            const unsigned* qr = (const unsigned*)(QKV + row * 1536 + 128 * h + (idx & ~1)); rq[j] = qr[0]; rk[j] = qr[256]; rv[j] = qr[512]; nq[j] = NRM[row * 8 + h]; nk[j] = NRM[row * 8 + 4 + h]; }
        if (w == 7 && lane < 32) { const int t = dir ? (T - 1 - (sbase + lane)) : (sbase + lane); const unsigned* pr = (const unsigned*)(P + (rowbase + t) * PLD + RW_COLS + 2048 + ((dir * 4 + h) & ~1)); raw_al = pr[0]; raw_be = pr[4]; } };
    u32x2 ypend[2]; ypend[0].x = ypend[0].y = ypend[1].x = ypend[1].y = 0u;
    auto flush = [&](int pch) { bool pisctx; int psb, pT; size_t prb; chunk_geom(pch, pisctx, psb, pT, prb);
        if (!pisctx) {
#pragma unroll
            for (int tb = 0; tb < 2; ++tb) { const int tl = psb + tb * 16 + fr; const int t = dir ? (pT - 1 - tl) : tl;
                *(u32x2*)(ydir + ((size_t)b * SEQ + t) * D + 512 + 128 * h + 16 * w + 4 * fg) = ypend[tb]; } } };
    issue_loads(0);
    for (int ch = 0; ch < 72; ++ch) {
        bool isctx; int sbase, T; size_t rowbase; chunk_geom(ch, isctx, sbase, T, rowbase);
        __syncthreads();
        float qv[8], kv[8], vv[8], nqv[8], nkv[8];
#pragma unroll
        for (int j = 0; j < 8; ++j) { qv[j] = bfsel(rq[j], codd); kv[j] = bfsel(rk[j], codd); vv[j] = bfsel(rv[j], codd); nqv[j] = nq[j]; nkv[j] = nk[j]; }
        if (w == 7) {
            const float gi = (lane < 32) ? -Aexp * softplusf_(bfsel(raw_al, godd) + dtb) : 0.f;
            float cum = gi;
            cum += __builtin_bit_cast(float, __builtin_amdgcn_update_dpp(0, __builtin_bit_cast(int, cum), 0x111, 0xf, 0xf, true));
            cum += __builtin_bit_cast(float, __builtin_amdgcn_update_dpp(0, __builtin_bit_cast(int, cum), 0x112, 0xf, 0xf, true));
            cum += __builtin_bit_cast(float, __builtin_amdgcn_update_dpp(0, __builtin_bit_cast(int, cum), 0x114, 0xf, 0xf, true));
            cum += __builtin_bit_cast(float, __builtin_amdgcn_update_dpp(0, __builtin_bit_cast(int, cum), 0x118, 0xf, 0xf, true));
            const float r0 = rdlane(cum, 15);
            cum += (lane >= 16) ? r0 : 0.f;
            if (lane < 32) { SC[lane] = sigmoidf_(bfsel(raw_be, godd)); SC[32 + lane + 1] = cum; if (lane == 0) SC[32] = 0.f; }
        }
        asm volatile("" :: "v"(qv[0]), "v"(qv[1]), "v"(qv[2]), "v"(qv[3]), "v"(qv[4]), "v"(qv[5]), "v"(qv[6]), "v"(qv[7]), "v"(kv[0]), "v"(kv[1]), "v"(kv[2]), "v"(kv[3]), "v"(kv[4]), "v"(kv[5]), "v"(kv[6]), "v"(kv[7]),
                        "v"(vv[0]), "v"(vv[1]), "v"(vv[2]), "v"(vv[3]), "v"(vv[4]), "v"(vv[5]), "v"(vv[6]), "v"(vv[7]) : "memory");
        asm volatile("" :: "v"(nqv[0]), "v"(nqv[1]), "v"(nqv[2]), "v"(nqv[3]), "v"(nqv[4]), "v"(nqv[5]), "v"(nqv[6]), "v"(nqv[7]), "v"(nkv[0]), "v"(nkv[1]), "v"(nkv[2]), "v"(nkv[3]), "v"(nkv[4]), "v"(nkv[5]), "v"(nkv[6]), "v"(nkv[7]),
                        "v"(raw_al), "v"(raw_be) : "memory");
        if (ch > 0) flush(ch - 1);
        if (ch + 1 < 72) issue_loads(ch + 1);
        __syncthreads();
        {
            const int c = idx; const float gcC = SC[32 + 32];
            float bh[8], kh[8];
#pragma unroll
            for (int j = 0; j < 8; ++j) { const int i = 8 * grp + j;
                const float kn = kv[j] * nkv[j], qn = qv[j] * nqv[j];
                const float gm = SC[32 + i], gi = SC[32 + i + 1], be = SC[i];
                const unsigned p0 = cvtpk(kn, qn), p1 = cvtpk(kn * __expf(gm), qn * __expf(gi));
                *(LAS unsigned short*)(L + O_KT + i * S128 + c * 2) = (unsigned short)p0; *(LAS unsigned short*)(L + O_QT + i * S128 + c * 2) = (unsigned short)(p0 >> 16);
                *(LAS unsigned short*)(L + O_KKT + i * S128 + c * 2) = (unsigned short)p1; *(LAS unsigned short*)(L + O_RT + i * S128 + c * 2) = (unsigned short)(p1 >> 16);
                bh[j] = be * kn * __expf(gcC - gm); kh[j] = be * kn * __expf(gcC - gi); }
            u32x4 w4;
            w4.x = cvtpk(bh[0], bh[1]); w4.y = cvtpk(bh[2], bh[3]); w4.z = cvtpk(bh[4], bh[5]); w4.w = cvtpk(bh[6], bh[7]); *(LAS u32x4*)(L + O_BHT + c * S32 + grp * 16) = w4;
            w4.x = cvtpk(kh[0], kh[1]); w4.y = cvtpk(kh[2], kh[3]); w4.z = cvtpk(kh[4], kh[5]); w4.w = cvtpk(kh[6], kh[7]); *(LAS u32x4*)(L + O_KHT + c * S32 + grp * 16) = w4;
            w4.x = cvtpk(vv[0], vv[1]); w4.y = cvtpk(vv[2], vv[3]); w4.z = cvtpk(vv[4], vv[5]); w4.w = cvtpk(vv[6], vv[7]); *(LAS u32x4*)(L + O_VT + c * S32 + grp * 16) = w4;
        }
        __syncthreads();
        {
            const int isq = w >> 2, tb = (w >> 1) & 1, jb = w & 1;
            if (jb <= tb) {
                const f32x4 g4 = mm_tile<4>(L + O_KT + jb * 16 * S128, S128, L + (isq ? O_QT : O_KT) + tb * 16 * S128, S128, z4, lane);
                const int t = tb * 16 + fr;
                const float gt = SC[32 + t + isq];
                f32x4 m0, m1;
#pragma unroll
                for (int e = 0; e < 4; ++e) { const int j = jb * 16 + 4 * fg + e; const bool keep = isq ? (j <= t) : (j < t);
                    const float bj = SC[j] * g4[e];
                    m0[e] = keep ? bj * __expf(gt - SC[32 + j]) : 0.f;
                    m1[e] = keep ? bj * __expf(gt - SC[32 + j + 1]) : 0.f; }
                const int off = t * S32 + (jb * 16 + 4 * fg) * 2;
                if (isq) { st_bf16x4(L + O_NB + off, m0); st_bf16x4(L + O_NK + off, m1); }
                else {
                    st_bf16x4(L + O_MK + off, m1);
                    if (tb != jb) st_bf16x4(L + O_M21 + fr * S32 + fg * 8, m0);
                    else { float X[16]; tri_inv16(m0, lane, L + O_MS + tb * 1024, X);
                        if (lane < 16) {
#pragma unroll
                            for (int i = 0; i < 16; ++i) *(LAS unsigned short*)(L + O_TI + (tb * 16 + i) * S32 + (tb * 16 + lane) * 2) = (unsigned short)cvtpk(X[i], 0.f);
                            if (tb == 0) { u32x4 a0, a1;
                                a0.x = cvtpk(X[0], X[1]); a0.y = cvtpk(X[2], X[3]); a0.z = cvtpk(X[4], X[5]); a0.w = cvtpk(X[6], X[7]);
                                a1.x = cvtpk(X[8], X[9]); a1.y = cvtpk(X[10], X[11]); a1.z = cvtpk(X[12], X[13]); a1.w = cvtpk(X[14], X[15]);
                                *(LAS u32x4*)(L + O_T11T + lane * S32) = a0; *(LAS u32x4*)(L + O_T11T + lane * S32 + 16) = a1; }
                            else {
#pragma unroll
                                for (int i = 0; i < 16; ++i) *(LAS unsigned short*)(L + O_T22 + i * S32 + lane * 2) = (unsigned short)cvtpk(X[i], 0.f); }
                        } }
                }
            }
        }
        __syncthreads();
        if (w == 1) {
            const f32x4 x4 = mm_tile<1>(L + O_M21, S32, L + O_T11T, S32, z4, lane);
            st_bf16x4(L + O_XT + fr * S32 + fg * 8, x4);
            asm volatile("s_waitcnt lgkmcnt(0)" ::: "memory");
            const f32x4 t4 = mm_tile<1>(L + O_XT, S32, L + O_T22, S32, z4, lane);
            st_bf16x4(L + O_TI + (16 + fr) * S32 + fg * 8, -t4);
        }
        f32x4 yacc[2];
#pragma unroll
        for (int tb = 0; tb < 2; ++tb) {
            f32x4 u4 = mm_tile<4>(L + O_KKT + tb * 16 * S128, S128, L + O_SBF + 16 * w * S128, S128, z4, lane);
            u4 = mm_tile<1>(L + O_MK + tb * 16 * S32, S32, L + O_VT + 16 * w * S32, S32, u4, lane);
            st_bf16x4(L + O_UTT + (16 * w + fr) * S32 + tb * 32 + fg * 8, u4);
            yacc[tb] = mm_tile<4>(L + O_SBF + 16 * w * S128, S128, L + O_RT + tb * 16 * S128, S128, z4, lane);
            yacc[tb] = mm_tile<1>(L + O_VT + 16 * w * S32, S32, L + O_NK + tb * 16 * S32, S32, yacc[tb], lane);
        }
        __syncthreads();
#pragma unroll
        for (int tb = 0; tb < 2; ++tb) {
            const f32x4 u4 = mm_tile<1>(L + O_TI + tb * 16 * S32, S32, L + O_UTT + 16 * w * S32, S32, z4, lane);
            st_bf16x4(L + O_UT + (16 * w + fr) * S32 + tb * 32 + fg * 8, -u4);
        }
        __syncthreads();
        {
#pragma unroll
            for (int tb = 0; tb < 2; ++tb) {
                yacc[tb] = mm_tile<1>(L + O_UT + 16 * w * S32, S32, L + O_NB + tb * 16 * S32, S32, yacc[tb], lane);
                ypend[tb].x = cvtpk(yacc[tb][0], yacc[tb][1]); ypend[tb].y = cvtpk(yacc[tb][2], yacc[tb][3]);
            }
            const float wc = __expf(SC[32 + 32]);
#pragma unroll
            for (int vi = 0; vi < 8; ++vi) {
                f32x4 s4 = Sacc[vi] * wc;
                s4 = mm_tile<1>(L + O_KHT + 16 * w * S32, S32, L + O_VT + 16 * vi * S32, S32, s4, lane);
                s4 = mm_tile<1>(L + O_BHT + 16 * w * S32, S32, L + O_UT + 16 * vi * S32, S32, s4, lane);
                Sacc[vi] = s4;
                st_bf16x4(L + O_SBF + (16 * vi + fr) * S128 + (16 * w + 4 * fg) * 2, s4);
            }
        }
    }
    flush(71);
    __syncthreads();
}

__device__ __forceinline__ void unpack8(const u32x4 w, float (&f)[8]) { f[0] = bflo(w.x); f[1] = bfhi(w.x); f[2] = bflo(w.y); f[3] = bfhi(w.y); f[4] = bflo(w.z); f[5] = bfhi(w.z); f[6] = bflo(w.w); f[7] = bfhi(w.w); }
__device__ __forceinline__ void phase_p4(const Args& A, Ctx& C) {
    const bf16_t* P = WSP(bf16_t, WS_P);
    const bf16_t* yf = WSP(bf16_t, WS_YDIR); const bf16_t* yb = yf + (size_t)NLAT * D;
    const float* bon = WSP(float, WS_BON);
    bf16_t* ymix = WSP(bf16_t, WS_YMIX);
    lbyte* SGb = C.lds;
    lfloat* GO = (lfloat*)(C.lds + 8192);
    const int tid = C.tid, lane = C.lane, w = C.wave;
    const bf16_t* gupt = WSP(const bf16_t, WS_GUPT);
    const int fr = lane & 15, fg = lane >> 4;
    const int c8 = 8 * lane;
    float lnw[8], lnb[8], ong[8], muv[8];
#pragma unroll
    for (int e = 0; e < 8; ++e) { lnw[e] = A.in[I_LNW][c8 + e]; lnb[e] = A.in[I_LNB][c8 + e]; ong[e] = A.in[I_ONG][(c8 + e) & 127]; muv[e] = A.in[I_MU][1024 + c8 + e]; }
    const int tkA = tid >> 5, lA = 4 * (tid & 31);
    float muA[4];
#pragma unroll
    for (int e = 0; e < 4; ++e) muA[e] = A.in[I_MU][1792 + lA + e];
    const bool vup = (1024 + c8) < 1440;
    bf16x8 gq[4][4];
#pragma unroll
    for (int i = 0; i < 4; ++i)
#pragma unroll
        for (int ks = 0; ks < 4; ++ks) gq[i][ks] = *(const bf16x8*)(gupt + (size_t)(64 * w + 16 * i + fr) * 128 + ks * 32 + fg * 8);
    u32x2 pwA, swA;
    auto issueA = [&](int tile) { const int row = tile * 16 + tkA, t = row & (SEQ - 1); const bool ok = t < SEQ - 64;
        pwA = *(const u32x2*)(P + (size_t)row * PLD + 1792 + lA); swA = *(const u32x2*)(P + (size_t)(row + (ok ? 64 : 0)) * PLD + 1792 + lA); };
    if (C.bid < NLAT / 16) issueA(C.bid);
    for (int tile = C.bid; tile < NLAT / 16; tile += C.G) {
        const int row0 = tile * 16;
        u32x4 wyf[2], wyb[2], wpv[2], wsv[2], wof[2], wob[2], wz[2]; float bsv[2];
#pragma unroll
        for (int tt = 0; tt < 2; ++tt) {
            const int tk = 2 * w + tt, row = row0 + tk, t = row & (SEQ - 1);
            const bool okv = vup ? (t >= 64) : (t < SEQ - 64);
            wyf[tt] = *(const u32x4*)(yf + (size_t)row * D + c8); wyb[tt] = *(const u32x4*)(yb + (size_t)row * D + c8);
            wpv[tt] = *(const u32x4*)(P + (size_t)row * PLD + 1024 + c8); wsv[tt] = *(const u32x4*)(P + (size_t)(row + (okv ? (vup ? -64 : 64) : 0)) * PLD + 1024 + c8);
            wof[tt] = *(const u32x4*)(yf + (size_t)row * D + 512 + c8); wob[tt] = *(const u32x4*)(yb + (size_t)row * D + 512 + c8);
            wz[tt] = *(const u32x4*)(P + (size_t)row * PLD + RW_COLS + 1536 + c8);
            bsv[tt] = bon[(size_t)row * 8 + (lane >> 3)] + bon[((size_t)NLAT + row) * 8 + (lane >> 3)];
        }
        __syncthreads();
        {
            const int row = row0 + tkA, t = row & (SEQ - 1); const bool ok = t < SEQ - 64;
            const u32x2 pw = pwA, sw = swA;
            const float pv[4] = {bflo(pw.x), bfhi(pw.x), bflo(pw.y), bfhi(pw.y)}; const float sv[4] = {bflo(sw.x), bfhi(sw.x), bflo(sw.y), bfhi(sw.y)};
            float o[4];
#pragma unroll
            for (int e = 0; e < 4; ++e) o[e] = sigmoidf_(pv[e] + muA[e] * ((ok ? sv[e] : 0.f) - pv[e]));
            u32x2 ow; ow.x = cvtpk(o[0], o[1]); ow.y = cvtpk(o[2], o[3]); *(LAS u32x2*)(SGb + tkA * 288 + lA * 2) = ow;
        }
        if (tile + C.G < NLAT / 16) issueA(tile + C.G);
        __syncthreads();
#pragma unroll
        for (int i = 0; i < 4; ++i) { const int c0 = 64 * w + 16 * i; f32x4 acc = (f32x4){0.f, 0.f, 0.f, 0.f};
#pragma unroll
            for (int ks = 0; ks < 4; ++ks) { const bf16x8 a = *(const LAS bf16x8*)(SGb + fr * 288 + ks * 64 + fg * 16);
                acc = __builtin_amdgcn_mfma_f32_16x16x32_bf16(a, gq[i][ks], acc, 0, 0, 0); }
#pragma unroll
            for (int e = 0; e < 4; ++e) GO[(4 * fg + e) * 512 + c0 + fr] = acc[e]; }
        __syncthreads();
#pragma unroll
        for (int tt = 0; tt < 2; ++tt) {
            const int tk = 2 * w + tt, row = row0 + tk, t = row & (SEQ - 1);
            const bool okv = vup ? (t >= 64) : (t < SEQ - 64);
            const float bs = bsv[tt];
            const f32x4 g0 = *(const LAS f32x4*)(GO + tk * 512 + c8), g1 = *(const LAS f32x4*)(GO + tk * 512 + c8 + 4);
            const float gg[8] = {g0.x, g0.y, g0.z, g0.w, g1.x, g1.y, g1.z, g1.w};
            float a[8], bq[8], pv[8], sv[8], y[8];
            unpack8(wyf[tt], a); unpack8(wyb[tt], bq); unpack8(wpv[tt], pv); unpack8(wsv[tt], sv);
            float s1 = 0.f;
#pragma unroll
            for (int e = 0; e < 8; ++e) { y[e] = a[e] + bq[e]; s1 += y[e]; }
            s1 += __shfl_xor(s1, 1); s1 += __shfl_xor(s1, 2); s1 += __shfl_xor(s1, 4);
            const float m = s1 * (1.f / 64.f);
            float s2 = 0.f;
#pragma unroll
            for (int e = 0; e < 8; ++e) { y[e] -= m; s2 += y[e] * y[e]; }
            s2 += __shfl_xor(s2, 1); s2 += __shfl_xor(s2, 2); s2 += __shfl_xor(s2, 4);
            const float rs = __builtin_amdgcn_rsqf(s2 * (1.f / 64.f) + RWKV_EPS);
            float o[8];
#pragma unroll
            for (int e = 0; e < 8; ++e) { const float vv = pv[e] + muv[e] * ((okv ? sv[e] : 0.f) - pv[e]); o[e] = (y[e] * rs * lnw[e] + lnb[e] + bs * vv) * gg[e]; }
            u32x4 ow; ow.x = cvtpk(o[0], o[1]); ow.y = cvtpk(o[2], o[3]); ow.z = cvtpk(o[4], o[5]); ow.w = cvtpk(o[6], o[7]);
            *(u32x4*)(ymix + (size_t)row * D + c8) = ow;
            float of[8], ob[8], z[8];
            unpack8(wof[tt], of); unpack8(wob[tt], ob); unpack8(wz[tt], z);
            float s3 = 0.f;
#pragma unroll
            for (int e = 0; e < 8; ++e) { of[e] += ob[e]; s3 += of[e] * of[e]; }
            s3 += __shfl_xor(s3, 1); s3 += __shfl_xor(s3, 2); s3 += __shfl_xor(s3, 4); s3 += __shfl_xor(s3, 8);
            const float rg = __builtin_amdgcn_rsqf(s3 * (1.f / 128.f) + NORM_EPS);
#pragma unroll
            for (int e = 0; e < 8; ++e) o[e] = of[e] * rg * ong[e] * siluf_(z[e]);
            ow.x = cvtpk(o[0], o[1]); ow.y = cvtpk(o[2], o[3]); ow.z = cvtpk(o[4], o[5]); ow.w = cvtpk(o[6], o[7]);
            *(u32x4*)(ymix + (size_t)row * D + 512 + c8) = ow;
        }
    }
}

__device__ __forceinline__ void convert_experts(const Args& A, Ctx& C) {
    lfloat* scr = (lfloat*)(C.lds + C.wave * 16384);
    const int gw = C.bid * 8 + C.wave, NGW = C.G * 8;
    constexpr int I13 = (D / 64) * (DE / 32);
    constexpr int I2 = (DE / 64) * (D / 32);
    constexpr int PER = 2 * I13 + I2;
    for (int it = gw; it < 257 * PER; it += NGW) {
        const int e = it / PER; int r = it % PER;
        unsigned char* bt13 = A.ws + WS_WEXP + (size_t)e * WEXP_STRIDE; unsigned char* bt2 = bt13 + 512 * 1024;
        const float* w1 = e < NE ? A.in[I_EW1] + (size_t)e * D * DE : A.in[I_SW1];
        const float* w3 = e < NE ? A.in[I_EW3] + (size_t)e * D * DE : A.in[I_SW3];
        const float* w2 = e < NE ? A.in[I_EW2] + (size_t)e * DE * D : A.in[I_SW2];
        if (r < I13) { transpose_item_fp8(w1, D, DE, bt13, RowGLU{0}, SW13, scr, r, C.lane); continue; } r -= I13;
        if (r < I13) { transpose_item_fp8(w3, D, DE, bt13, RowGLU{128}, SW13, scr, r, C.lane); continue; } r -= I13;
        transpose_item_fp8(w2, DE, D, bt2, RowId(), SW2, scr, r, C.lane);
    }
}

__device__ __forceinline__ void phase_p6(const Args& A, Ctx& C) {
    const float* mod = WSP(float, WS_MOD); bf16_t* h2n = WSP(bf16_t, WS_H2N);
    const int gw = C.bid * 8 + C.wave, NGW = C.G * 8;
    for (int row = gw; row < NLAT; row += NGW) {
        const float* m = mod + (size_t)(row >> 11) * MODW;
        norm_mod_row(A.out + (size_t)row * D, A.in[I_N2G], m + 4 * D, m + 3 * D, h2n + (size_t)row * D, C.lane, (unsigned*)(A.ws + WS_H2N8) + (size_t)row * (D / 4));
    }
}

__device__ __forceinline__ void phase_p8(const Args& A, Ctx& C) {
    const float* logit = WSP(float, WS_LOGIT);
    int* tope = WSP(int, WS_TOPE); float* topw = WSP(float, WS_TOPW); int* pos = WSP(int, WS_POS);
    unsigned* cnt = WSP(unsigned, WS_CTL) + CW_CNT;
    const int lane = C.lane;
    const f32x4 rb = ((const f32x4*)A.in[I_RB])[lane];
    LAS unsigned* hist = (LAS unsigned*)C.lds;
    LAS unsigned* base = hist + 256;
    LAS unsigned* lpe = base + 256;
    for (int blk = C.bid; blk < NLAT / 256; blk += C.G) {
    __syncthreads();
    if (C.tid < 256) hist[C.tid] = 0u;
    __syncthreads();
    f32x4 nlg = ((const f32x4*)(logit + (size_t)(blk * 256 + C.wave * 32) * NE))[lane];
    for (int ti = 0; ti < 32; ++ti) {
        const int tl = C.wave * 32 + ti, tok = blk * 256 + tl;
        const f32x4 lg = nlg;
        if (ti + 1 < 32) nlg = ((const f32x4*)(logit + (size_t)(tok + 1) * NE))[lane];
        float s[4], sel[4];
#pragma unroll
        for (int i = 0; i < 4; ++i) { s[i] = sigmoidf_(lg[i]); sel[i] = s[i] + rb[i]; }
        float m1 = fmaxf(fmaxf(sel[0], sel[1]), fmaxf(sel[2], sel[3]));
        float m2;
        {
            float a = fmaxf(sel[0], sel[1]), bq = fminf(sel[0], sel[1]), cq = fmaxf(sel[2], sel[3]), dq = fminf(sel[2], sel[3]);
            m2 = fmaxf(fminf(a, cq), fmaxf(bq, dq)); }
#pragma unroll
        for (int o = 1; o < 8; o <<= 1) { const float o1 = __shfl_xor(m1, o), o2 = __shfl_xor(m2, o);
            const float n1 = fmaxf(m1, o1); const float n2 = fmaxf(fminf(m1, o1), fmaxf(m2, o2)); m1 = n1; m2 = n2; }
        const float gs = m1 + m2;
        const int grp = lane >> 3;
        int rank = 0;
#pragma unroll
        for (int gq = 0; gq < 8; ++gq) { const float og = __shfl(gs, gq * 8); rank += (og > gs || (og == gs && gq < grp)) ? 1 : 0; }
        const bool gsel = rank < 4;
        float cand[4];
#pragma unroll
        for (int i = 0; i < 4; ++i) cand[i] = gsel ? sel[i] : -INFINITY;
        int my_e = 0; float my_w = 0.f; float wsum = 0.f;
#pragma unroll
        for (int r = 0; r < 8; ++r) {
            float bv = cand[0]; int bi = 0;
#pragma unroll
            for (int i = 1; i < 4; ++i) if (cand[i] > bv) { bv = cand[i]; bi = i; }
            int be = lane * 4 + bi;
#define P8_STEP(CTRL) { const float ov = dpp_f<CTRL>(bv); const int oe = __builtin_amdgcn_update_dpp(0, be, CTRL, 0xf, 0xf, false); if (ov > bv || (ov == bv && oe < be)) { bv = ov; be = oe; } }
            P8_STEP(0x128) P8_STEP(0x124) P8_STEP(0x122) P8_STEP(0x121)
#undef P8_STEP
            float gv = rdlane(bv, 0); int ge = __builtin_amdgcn_readlane(be, 0);
#pragma unroll
            for (int rr = 1; rr < 4; ++rr) { const float ov = rdlane(bv, 16 * rr); const int oe = __builtin_amdgcn_readlane(be, 16 * rr); if (ov > gv || (ov == gv && oe < ge)) { gv = ov; ge = oe; } }
            be = ge;
            const int ol = be >> 2, oi = be & 3;
            const float mys = oi == 0 ? s[0] : (oi == 1 ? s[1] : (oi == 2 ? s[2] : s[3]));
            const float ws_ = __shfl(mys, ol);
            if (lane == ol) { if (oi == 0) cand[0] = -INFINITY; else if (oi == 1) cand[1] = -INFINITY; else if (oi == 2) cand[2] = -INFINITY; else cand[3] = -INFINITY; }
            wsum += ws_;
            if (lane == r) { my_e = be; my_w = ws_; }
        }
        if (lane < 8) {
            const float w = my_w / wsum * 2.5f;
            const unsigned lp = __hip_atomic_fetch_add(hist + my_e, 1u, __ATOMIC_RELAXED, __HIP_MEMORY_SCOPE_WORKGROUP);
            tope[(size_t)tok * 8 + lane] = my_e; topw[(size_t)tok * 8 + lane] = w; lpe[tl * 8 + lane] = ((unsigned)my_e << 16) | lp;
        }
    }
    __syncthreads();
    if (C.tid < 256) { const unsigned c = hist[C.tid]; base[C.tid] = c ? atomicAdd(cnt + C.tid * CNT_STRIDE, c) : 0u; }
    __syncthreads();
    for (int i = C.tid; i < 2048; i += 512) { const unsigned v = lpe[i]; pos[(size_t)blk * 2048 + i] = (int)(base[v >> 16] + (v & 0xffffu)); }
    }
}

__device__ __forceinline__ void tile_prefix(const Args& A, Ctx& C, LAS int* tb) {
    const unsigned* cnt = WSP(unsigned, WS_CTL) + CW_CNT;
    int v = 0;
    if (C.tid < NE) v = ((int)cnt[C.tid * CNT_STRIDE] + 255) >> 8;
#pragma unroll
    for (int d = 1; d < 64; d <<= 1) { const int t = __shfl_up(v, d); if (C.lane >= d) v += t; }
    if (C.tid < NE && C.lane == 63) tb[260 + C.wave] = v;
    __syncthreads();
    if (C.tid < NE) { int off = 0;
#pragma unroll
        for (int q = 0; q < 3; ++q) off += (q < C.wave) ? tb[260 + q] : 0;
        tb[C.tid + 1] = off + v; if (C.tid == 0) tb[0] = 0; }
    __syncthreads();
}
__device__ __forceinline__ void phase_p9(const Args& A, Ctx& C) {
    LAS int* tb = (LAS int*)C.lds;
    tile_prefix(A, C, tb);
    const unsigned* cnt = WSP(unsigned, WS_CTL) + CW_CNT;
    const int* tope = WSP(int, WS_TOPE); const float* topw = WSP(float, WS_TOPW); const int* pos = WSP(int, WS_POS);
    int* rowl = WSP(int, WS_ROWL); float* roww = WSP(float, WS_ROWW); int* tile_e = WSP(int, WS_TILEE);
    const int nrt = tb[NE];
    for (int i = C.bid * 512 + C.tid; i < NLAT * 8; i += C.G * 512) { const int e = tope[i]; const int pr = tb[e] * 256 + pos[i]; rowl[pr] = i; roww[pr] = topw[i]; }
    for (int e = C.bid; e < NE; e += C.G) { const int n = (int)cnt[e * CNT_STRIDE], nt = tb[e + 1] - tb[e];
        for (int j = n + C.tid; j < nt * 256; j += 512) { rowl[tb[e] * 256 + j] = -1; roww[tb[e] * 256 + j] = 0.f; }
        for (int k = C.tid; k < nt; k += 512) tile_e[tb[e] + k] = e; }
    for (int i = C.bid * 512 + C.tid; i < NLAT; i += C.G * 512) { rowl[nrt * 256 + i] = i; roww[nrt * 256 + i] = 1.f; }
    for (int k = C.bid * 512 + C.tid; k < NLAT / 256; k += C.G * 512) tile_e[nrt + k] = NE;
    __syncthreads();
}

__device__ __forceinline__ void phase_moe(const Args& A, Ctx& C, int dry_shared) {
    LAS int* tb = (LAS int*)(C.lds + 131072);
    LAS int* tbl = tb + 320;
    tile_prefix(A, C, tb);
    pg8::MoeCtx M;
    M.nrt = tb[NE]; M.ntiles = M.nrt + NLAT / 256; M.G = C.G; M.vc = (C.G % 8 == 0) ? (C.bid % 8) * (C.G / 8) + C.bid / 8 : C.bid;
    M.tb = tb; M.tbl = tbl; M.cnt = WSP(unsigned, WS_CTL) + CW_CNT; M.rowl = WSP(int, WS_ROWL); M.roww = WSP(float, WS_ROWW);
    M.wexp = (const char*)(A.ws + WS_WEXP); M.h2n = (const char*)(A.ws + WS_H2N8); M.Hs = (char*)(A.ws + WS_HS) + (size_t)C.bid * 2 * 65536;
    M.Y = (unsigned char*)(A.ws + WS_Y); M.out = A.out; M.mod = WSP(const float, WS_MOD); M.dry_shared = dry_shared;
    pg8::gemm_moe(C.lds, M);
    __syncthreads();
}

__device__ __forceinline__ void phase_final(const Args& A, Ctx& C, float* dst) {
    const int gw = C.bid * 8 + C.wave, NGW = C.G * 8;
    const float* fg = A.in[I_FG]; const float* mod = WSP(const float, WS_MOD);
    const unsigned* Y = (const unsigned*)(A.ws + WS_Y);
    for (int row = gw; row < NLAT; row += NGW) {
        f32x4* xr = (f32x4*)(A.out + (size_t)row * D) + C.lane;
        const f32x4* gt = (const f32x4*)(mod + (size_t)(row >> 11) * MODW + 5 * D) + C.lane;
        const unsigned* yr = Y + (size_t)row * 8 * (D / 4) + C.lane;
        f32x4 v[4]; float s = 0.f;
#pragma unroll
        for (int j = 0; j < 4; ++j) {
            f32x4 a = (f32x4){0.f, 0.f, 0.f, 0.f};
#pragma unroll
            for (int sl = 0; sl < 8; ++sl) { const unsigned w = yr[sl * (D / 4) + 64 * j];
                const f32x2 lo = __builtin_amdgcn_cvt_pk_f32_fp8(w, false), hi = __builtin_amdgcn_cvt_pk_f32_fp8(w, true);
                a.x += lo.x; a.y += lo.y; a.z += hi.x; a.w += hi.y; }
            v[j] = xr[64 * j] + gt[64 * j] * a * (1.f / pg8::YSCALE);
            s += (v[j].x * v[j].x + v[j].y * v[j].y) + (v[j].z * v[j].z + v[j].w * v[j].w); }
        const float rstd = __builtin_amdgcn_rsqf(wave_sum(s) * (1.f / D) + NORM_EPS);
        f32x4* orow = (f32x4*)(dst + (size_t)row * D) + C.lane;
#pragma unroll
        for (int j = 0; j < 4; ++j) orow[64 * j] = v[j] * rstd * ((const f32x4*)fg)[C.lane + 64 * j];
    }
}

constexpr int NPHASE = 13;
__global__ void __launch_bounds__(512, 2) fwd_kernel(Args A) {
    extern __shared__ __attribute__((aligned(16))) unsigned char lds_raw[];
    Ctx C; C.lds = (lbyte*)lds_raw; C.tid = threadIdx.x; C.lane = C.tid & 63; C.wave = __builtin_amdgcn_readfirstlane(C.tid >> 6);
    C.G = gridDim.x; C.bid = blockIdx.x; C.a = &A;
    volatile LAS unsigned* misc = (volatile LAS unsigned*)(C.lds + LDS_MISC);
    if (C.tid < 16) misc[C.tid] = 0u;
    __syncthreads();
    XcdBarrier bar; bar.bar = WSP(unsigned, WS_CTL) + CW_BAR; bar.x = 0; bar.st = nullptr;
    const int lo = A.ph_lo, hi = A.ph_hi;
    const bool multi = (hi - lo) > 1;
    if (multi) bar = xcd_barrier_post(WSP(unsigned, WS_CTL) + CW_BAR, misc);
#ifndef PHASE_MASK
#define PHASE_MASK 0x1FFF
#endif
#define IN(k) (((PHASE_MASK >> (k)) & 1) && lo <= (k) && (k) < hi)
#define SEAM(k) do { if (IN(k) && IN((k) + 1)) xcd_barrier(bar); } while (0)
#ifndef REP_MASK
#define REP_MASK 0
#endif
#define REPS(k) (((REP_MASK >> (k)) & 1) ? 2 : 1)

    if (IN(0)) _Pragma("unroll") for (int rep = 0; rep < REPS(0); ++rep) { phase_p0(A, C); __syncthreads(); } SEAM(0);
    if (IN(1)) _Pragma("unroll") for (int rep = 0; rep < REPS(1); ++rep) { phase_p1(A, C); } SEAM(1);
    if (IN(2)) _Pragma("unroll") for (int rep = 0; rep < REPS(2); ++rep) {
        pg8::Gemm g{WSP(bf16_t, WS_XN), D}; pg8::StaticOrder S; S.init(NROWS, PLD, C.G, C.bid, WSP(bf16_t, WS_BTIN), D, 1);
        pg8::EpiBf16 E{WSP(bf16_t, WS_P), PLD, 1.f / SWIN};
        pg8::gemm_phase<pg8::EpiBf16, pg8::StaticOrder, false, 0, false, true>(C.lds, g, S, E);
    } SEAM(2);
    if (IN(3)) _Pragma("unroll") for (int rep = 0; rep < REPS(3); ++rep) { phase_gdn_prep(A, C); } SEAM(3);
#ifdef PROBE_BARRIERS
    if (multi) for (int kq = 0; kq < PROBE_BARRIERS; ++kq) xcd_barrier(bar);
#endif
    if (IN(4)) {
        for (int ch = C.bid; ch < NB * HB * 2; ch += C.G) gdn_chain_chunked(A, C, ch);
        for (int pr = C.bid; pr < NB * HA; pr += C.G) rwkv_pair_chunked(A, C, pr);
    } SEAM(4);
    if (IN(5)) _Pragma("unroll") for (int rep = 0; rep < REPS(5); ++rep) { phase_p4(A, C); } SEAM(5);
    if (IN(6)) _Pragma("unroll") for (int rep = 0; rep < REPS(6); ++rep) {
        pg8::Gemm g{WSP(bf16_t, WS_YMIX), D}; pg8::StaticOrder S; S.init(NLAT, D, C.G, C.bid, WSP(bf16_t, WS_BTOUT), D);
        pg8::EpiResGate E{A.in[I_X], A.out, WSP(float, WS_MOD), 2 * D};
        pg8::gemm_phase<pg8::EpiResGate, pg8::StaticOrder, false>(C.lds, g, S, E);
    } SEAM(6);
    if (IN(7)) _Pragma("unroll") for (int rep = 0; rep < REPS(7); ++rep) { phase_p6(A, C); __syncthreads(); convert_experts(A, C); __syncthreads(); } SEAM(7);
    if (IN(8)) _Pragma("unroll") for (int rep = 0; rep < REPS(8); ++rep) {
        pg8::Gemm g{WSP(bf16_t, WS_H2N), D}; pg8::StaticOrder S; S.init(NLAT, NE, C.G, C.bid, WSP(bf16_t, WS_BTR), D);
        pg8::EpiF32 E{WSP(float, WS_LOGIT), NE};
        pg8::gemm_phase<pg8::EpiF32, pg8::StaticOrder, false>(C.lds, g, S, E);
    } SEAM(8);
    if (IN(9)) { phase_p8(A, C); } SEAM(9);
    if (IN(10)) _Pragma("unroll") for (int rep = 0; rep < REPS(10); ++rep) { phase_p9(A, C); } SEAM(10);
    if (IN(11)) { phase_moe(A, C, 0); if (REPS(11) > 1) { __syncthreads(); phase_moe(A, C, 1); } } SEAM(11);
    if (IN(12)) { if (REPS(12) > 1) { phase_final(A, C, (float*)(A.ws + WS_WEXP)); __syncthreads(); } phase_final(A, C, A.out); }
#undef IN
#undef SEAM
}

extern "C" void kernel_launch(void* const* d_in, const int* in_sizes, int n_in, void* d_out, int out_size, void* d_ws, size_t ws_size, hipStream_t stream) {
    static int grid = 0;
    if (grid == 0) {
        if (n_in != 34 || out_size != NLAT * D || ws_size < WS_END) { fprintf(stderr, "kernel_launch: unexpected shapes (n_in %d out %d ws %zu need %zu)\n", n_in, out_size, ws_size, (size_t)WS_END); grid = -1; return; }
        int dev = 0, cus = 0;
        if (hipGetDevice(&dev) != hipSuccess || hipDeviceGetAttribute(&cus, hipDeviceAttributeMultiprocessorCount, dev) != hipSuccess) { grid = -1; return; }
        if (hipFuncSetAttribute((const void*)fwd_kernel, hipFuncAttributeMaxDynamicSharedMemorySize, LDS_BYTES) != hipSuccess) { fprintf(stderr, "kernel_launch: hipFuncSetAttribute failed\n"); grid = -1; return; }
        int per_cu = 0;
        if (hipOccupancyMaxActiveBlocksPerMultiprocessor(&per_cu, (const void*)fwd_kernel, 512, LDS_BYTES) != hipSuccess || per_cu < 1) { fprintf(stderr, "kernel_launch: occupancy query says %d\n", per_cu); }
        (void)hipGetLastError();
        grid = cus;
    }
    if (grid < 0) return;
    (void)hipMemsetAsync((char*)d_ws + WS_CTL, 0, CTL_BYTES, stream);
    Args a{};
    for (int i = 0; i < 34; ++i) a.in[i] = (const float*)d_in[i];
    a.out = (float*)d_out; a.ws = (unsigned char*)d_ws;
#if MK_PER_PHASE
    for (int p = 0; p < NPHASE; ++p) { a.ph_lo = p; a.ph_hi = p + 1; hipLaunchKernelGGL(fwd_kernel, dim3(grid), dim3(512), LDS_BYTES, stream, a); }
#else
    a.ph_lo = 0; a.ph_hi = NPHASE; hipLaunchKernelGGL(fwd_kernel, dim3(grid), dim3(512), LDS_BYTES, stream, a);
#endif
}
```

```cpp
#include <hip/hip_runtime.h>
#include <cstdio>
#include <cstdint>

#ifndef MK_PER_PHASE
#define MK_PER_PHASE 0
#endif

#define LAS __attribute__((address_space(3)))
typedef unsigned short bf16_t;
typedef short bf16x8 __attribute__((ext_vector_type(8)));
typedef float f32x4 __attribute__((ext_vector_type(4)));
typedef float f32x2 __attribute__((ext_vector_type(2)));
typedef unsigned u32x4 __attribute__((ext_vector_type(4)));
typedef unsigned u32x2 __attribute__((ext_vector_type(2)));
typedef int i32x4 __attribute__((ext_vector_type(4)));
typedef int i32x8 __attribute__((ext_vector_type(8)));
typedef LAS float lfloat;
typedef LAS unsigned char lbyte;

constexpr int D = 1024, NB = 32, SEQ = 2048, CTX = 256, GW = 64;
constexpr int NLAT = NB * SEQ;
constexpr int NCTX = NB * CTX;
constexpr int NROWS = NLAT + NCTX;
constexpr int DA = 512, HA = 8, NA = 64;
constexpr int RW_COLS = 1920, GD_COLS = 2064, IN_COLS = 3984, PLD = 4096;
constexpr int DB = 512, HB = 4, KB = 128;
constexpr int NE = 256, TOPK = 8, DE = 256;
constexpr int MODW = 6 * D;
constexpr float NORM_EPS = 1e-6f, RWKV_EPS = 64e-5f;
constexpr int MAXTILES = (NLAT * TOPK + NE * 255) / 256 + 1;

constexpr size_t MiB = 1u << 20;
constexpr size_t WS_CTL = 0, CTL_BYTES = 1 * MiB;
constexpr size_t WS_MOD = 1 * MiB;
constexpr size_t WS_BTIN = 2 * MiB, WS_BTOUT = 10 * MiB, WS_BTR = 12 * MiB, WS_BON = 13 * MiB, WS_GUPT = 17 * MiB, WS_NRM = 978 * MiB;
constexpr size_t WS_P = 18 * MiB, WS_XN = 594 * MiB, WS_YDIR = 594 * MiB, WS_YMIX = 850 * MiB;
constexpr size_t WS_H2N8 = 900 * MiB;
constexpr size_t WS_H2N = 18 * MiB, WS_LOGIT = 146 * MiB, WS_TOPE = 210 * MiB, WS_TOPW = 212 * MiB, WS_POS = 214 * MiB, WS_Y = 146 * MiB;
constexpr size_t WS_ROWL = 658 * MiB, WS_ROWW = 661 * MiB, WS_TILEE = 664 * MiB, WS_HS = 672 * MiB, WS_WEXP = 704 * MiB;
constexpr size_t WEXP_STRIDE = (size_t)(512 * 1024 + 1024 * 256);
constexpr float SW13 = 64.f, SW2 = 32.f, SHS = 8.f, SWIN = 32.f;
constexpr size_t WS_END = 1090 * MiB;
static_assert(WS_WEXP + 257 * WEXP_STRIDE <= WS_END && WS_Y + (size_t)NLAT * 8 * D <= WS_ROWL, "ws map");
constexpr int CW_BAR = 4096;
constexpr int CW_CNT = 16384;
constexpr int CNT_STRIDE = 32;

constexpr int LDS_BYTES = 159744;
constexpr int LDS_MISC = LDS_BYTES - 64;

__device__ __forceinline__ unsigned f2bf(float f) { unsigned u = __builtin_bit_cast(unsigned, f); return (u + 0x7fffu + ((u >> 16) & 1u)) >> 16; }
typedef __bf16 bf16x2_t __attribute__((ext_vector_type(2)));
__device__ __forceinline__ unsigned cvtpk(float lo, float hi) { f32x2 v = {lo, hi}; return __builtin_bit_cast(unsigned, __builtin_convertvector(v, bf16x2_t)); }
__device__ __forceinline__ unsigned pk2(float lo, float hi) { return cvtpk(lo, hi); }
__device__ __forceinline__ unsigned pk4_fp8(float a, float b, float c, float d) { unsigned w = 0u;
    w = __builtin_amdgcn_cvt_pk_fp8_f32(__builtin_amdgcn_fmed3f(a, -448.f, 448.f), __builtin_amdgcn_fmed3f(b, -448.f, 448.f), w, false);
    w = __builtin_amdgcn_cvt_pk_fp8_f32(__builtin_amdgcn_fmed3f(c, -448.f, 448.f), __builtin_amdgcn_fmed3f(d, -448.f, 448.f), w, true); return w; }
__device__ __forceinline__ float bf2f(unsigned short b) { return __builtin_bit_cast(float, ((unsigned)b) << 16); }
__device__ __forceinline__ float bflo(unsigned w) { return __builtin_bit_cast(float, w << 16); }
__device__ __forceinline__ float bfhi(unsigned w) { return __builtin_bit_cast(float, w & 0xffff0000u); }
template <int CTRL> __device__ __forceinline__ float dpp_f(float v) { return __builtin_bit_cast(float, __builtin_amdgcn_update_dpp(0, __builtin_bit_cast(int, v), CTRL, 0xf, 0xf, false)); }
__device__ __forceinline__ float wave_sum(float v) {
    v += dpp_f<0x128>(v);
    v += dpp_f<0x124>(v);
    v += dpp_f<0x122>(v);
    v += dpp_f<0x121>(v);
    const int vi = __builtin_bit_cast(int, v);
    const float r0 = __builtin_bit_cast(float, __builtin_amdgcn_readlane(vi, 0)), r1 = __builtin_bit_cast(float, __builtin_amdgcn_readlane(vi, 16)),
                r2 = __builtin_bit_cast(float, __builtin_amdgcn_readlane(vi, 32)), r3 = __builtin_bit_cast(float, __builtin_amdgcn_readlane(vi, 48));
    return (r0 + r1) + (r2 + r3);
}
__device__ __forceinline__ float sigmoidf_(float x) { return __builtin_amdgcn_rcpf(1.f + __expf(-x)); }
__device__ __forceinline__ float siluf_(float x) { return x * __builtin_amdgcn_rcpf(1.f + __expf(-x)); }
__device__ __forceinline__ float softplusf_(float x) { return fmaxf(x, 0.f) + __logf(1.f + __expf(-fabsf(x))); }
__device__ __forceinline__ float tanhf_(float x) { const float e = __expf(-2.f * fabsf(x)); const float t = (1.f - e) * __builtin_amdgcn_rcpf(1.f + e); return x < 0.f ? -t : t; }

#define XB_TMO      128
#define XB_XCNT(j)  (256  + 64 * (j))
#define XB_XSUB(j)  (1280 + 64 * (j))
#define XB_XGEN(j)  (2304 + 64 * (j))
#define XB_TOP      3328
#define XB_TOPGEN   3392
#define XCD_BAR_WORDS 3456
#define XB_SPIN_CAP (1u << 22)
__device__ __forceinline__ unsigned xb_ld(unsigned* p)              { return __hip_atomic_load(p, __ATOMIC_RELAXED, __HIP_MEMORY_SCOPE_AGENT); }
__device__ __forceinline__ unsigned xb_add(unsigned* p, unsigned v) { return __hip_atomic_fetch_add(p, v, __ATOMIC_RELAXED, __HIP_MEMORY_SCOPE_AGENT); }
__device__ __forceinline__ unsigned xb_xcc_id() { return (unsigned)__builtin_amdgcn_s_getreg((3 << 11) | 20) & 0xFu; }
#define XB_SPIN(cond, bar) do { unsigned _sp = 0; while (cond) { __builtin_amdgcn_s_sleep(1); \
    if ((++_sp & 255u) == 0u) { if (xb_ld(&(bar)[XB_TMO])) break; if (_sp > XB_SPIN_CAP) { atomicAdd(&(bar)[XB_TMO], 1u); break; } } } } while (0)
struct XcdBarrier { unsigned* bar; unsigned x; volatile LAS unsigned* st; };
__device__ __forceinline__ XcdBarrier xcd_barrier_post(unsigned* bar, volatile LAS unsigned* st) {
    XcdBarrier b; b.bar = bar; b.x = xb_xcc_id(); b.st = st;
    if (threadIdx.x == 0) (void)xb_add(&bar[XB_XCNT(b.x)], 1u);
    return b;
}
__device__ __forceinline__ void xcd_barrier_complete(unsigned* bar, unsigned x, unsigned& nloc, unsigned& nx) {
    const unsigned G = gridDim.x * gridDim.y * gridDim.z;
    unsigned sum, cnt, mine, sp = 0u;
    for (;;) {
        sum = 0u; cnt = 0u; mine = 0u;
#pragma unroll
        for (unsigned j = 0; j < 16; ++j) { const unsigned c = xb_ld(&bar[XB_XCNT(j)]); sum += c; cnt += (c > 0u) ? 1u : 0u; mine = (j == x) ? c : mine; }
        if (sum == G) break;
        __builtin_amdgcn_s_sleep(1);
        if ((++sp & 255u) == 0u) { if (xb_ld(&bar[XB_TMO])) break; if (sp > XB_SPIN_CAP) { atomicAdd(&bar[XB_TMO], 1u); break; } }
    }
    nloc = mine > 0u ? mine : 1u; nx = cnt > 0u ? cnt : 1u;
}
__device__ __forceinline__ void xcd_barrier(const XcdBarrier& b) {
    asm volatile("s_waitcnt vmcnt(0)" ::: "memory");
    __syncthreads();
    if (threadIdx.x == 0) {
        unsigned* bar = b.bar;
        __builtin_amdgcn_s_waitcnt(0);
        unsigned nloc = b.st[0], nx = b.st[1];
        if (nloc == 0u) { xcd_barrier_complete(bar, b.x, nloc, nx); b.st[0] = nloc; b.st[1] = nx; }
        const unsigned old = xb_add(&bar[XB_XSUB(b.x)], 1u);
        const unsigned gen = old / nloc;
        if (old + 1u == (gen + 1u) * nloc) {
            __builtin_amdgcn_fence(__ATOMIC_RELEASE, "agent");
            asm volatile("s_waitcnt vmcnt(0)" ::: "memory");
            const unsigned og = xb_add(&bar[XB_TOP], 1u);
            const unsigned tg = og / nx;
            if (og + 1u == (tg + 1u) * nx) xb_add(&bar[XB_TOPGEN], 1u);
            else XB_SPIN(xb_ld(&bar[XB_TOPGEN]) == tg, bar);
            __builtin_amdgcn_fence(__ATOMIC_ACQUIRE, "agent");
            xb_add(&bar[XB_XGEN(b.x)], 1u);
            asm volatile("s_waitcnt vmcnt(0)" ::: "memory");
        } else {
            XB_SPIN(xb_ld(&bar[XB_XGEN(b.x)]) == gen, bar);
            __builtin_amdgcn_fence(__ATOMIC_ACQUIRE, "agent");
            asm volatile("s_waitcnt vmcnt(0)" ::: "memory");
        }
    }
    __syncthreads();
}

struct Args {
    const float* in[34];
    float* out;
    unsigned char* ws;
    int ph_lo, ph_hi;
};
enum { I_X = 0, I_C, I_CTX, I_CCTX, I_WADA, I_BADA, I_N1G, I_WIN, I_MU, I_W0, I_WUP, I_A0, I_AUP, I_GUP, I_KK, I_KA, I_RK, I_LNW, I_LNB,
       I_CONVW, I_ALOG, I_DTB, I_ONG, I_WOUT, I_N2G, I_RW, I_RB, I_EW1, I_EW3, I_EW2, I_SW1, I_SW3, I_SW2, I_FG };

namespace pg8 {
constexpr int BM = 256, BK = 64, HALF = 128, HTB = HALF * BK * 2, STAGE_BYTES = 8 * HTB, NXCD = 8, WGM = 8;
__host__ __device__ __forceinline__ int lds_byte(int r, int c) { const int st = (r >> 4) * 2 + (c >> 5), rr = r & 15, cc = c & 31, ob = rr * 64 + cc * 2; return st * 1024 + (ob ^ (((ob >> 9) & 1) << 5)); }
__host__ __device__ __forceinline__ void stage_rc(int b, int& R, int& C) { const int st = b / 1024, sb = b % 1024, swz = sb ^ (((sb >> 9) & 1) << 5); R = (st >> 1) * 16 + swz / 64; C = (st & 1) * 32 + (swz % 64) / 2; }
__host__ __device__ __forceinline__ int perm32(int rho) { const int n = rho >> 4, i = rho & 15; return 8 * (i >> 2) + 4 * n + (i & 3); }
struct Unit { int pm, pn; };
struct Gemm { const bf16_t* A; int K; };
struct StaticOrder {
    int nM, nN, nwg, G, c; const char* Bt; size_t tstepB;
    __device__ void init(int M, int N, int G_, int c_, const void* Bt_, int K, int es = 2) { nM = M / BM; nN = N / BM; nwg = nM * nN; G = G_; c = c_; Bt = (const char*)Bt_; tstepB = (size_t)BM * K * es; }
    __device__ bool next(int i, Unit& u) const {
        const long L = (long)i * G + c; if (L >= nwg) return false;
        int wgid = (int)L; { const int q = nwg / NXCD, r = nwg % NXCD, xcd = wgid % NXCD, off = wgid / NXCD; wgid = (xcd < r ? xcd * (q + 1) : r * (q + 1) + (xcd - r) * q) + off; }
        const int nig = WGM * nN, gid = wgid / nig, fm = gid * WGM, gsz = (nM - fm) < WGM ? (nM - fm) : WGM;
        u.pm = fm + ((wgid % nig) % gsz); u.pn = (wgid % nig) / gsz; return true;
    }
    __device__ __forceinline__ const char* bptr(const Unit& u) const { return Bt + (size_t)u.pn * tstepB; }
    __device__ __forceinline__ int rowsel(const Unit&, int) const { return 0; }
};
struct TileOrder {
    int nunits, npn, G, c; const int* tile_e; const char* wbase; size_t wstride, woff, tstepB; const int* rowl;
    __device__ bool next(int i, Unit& u) const { const int L = i * G + c; if (L >= nunits) return false; u.pm = L / npn; u.pn = L - u.pm * npn; return true; }
    __device__ __forceinline__ const char* bptr(const Unit& u) const { const int e = __builtin_amdgcn_readfirstlane(tile_e[u.pm]); return wbase + (size_t)e * wstride + woff + (size_t)u.pn * tstepB; }
    __device__ __forceinline__ int rowsel(const Unit& u, int r) const { const int t = rowl[(size_t)u.pm * 256 + r]; return t < 0 ? 0 : t; }
};
struct SeqOrder {
    int n; const char* Bt; size_t tstepB; const LAS int* rsel;
    __device__ bool next(int i, Unit& u) const { if (i >= n) return false; u.pm = 0; u.pn = i; return true; }
    __device__ __forceinline__ const char* bptr(const Unit& u) const { return Bt + (size_t)u.pn * tstepB; }
    __device__ __forceinline__ int rowsel(const Unit&, int r) const { return rsel[r]; }
};
__device__ __forceinline__ unsigned cvt_pk_bf16(float lo, float hi) { return cvtpk(lo, hi); }

template <class Epi, class Sched, bool GATHER, int A_AUX = 0, bool ALIGN = true, bool FP8 = false>
__device__ __forceinline__ void gemm_phase(lbyte* lds, const Gemm g, const Sched& S, const Epi& E) {
    int tid_ = threadIdx.x; asm volatile("" : "+v"(tid_));
    const int tid = tid_, wid = __builtin_amdgcn_readfirstlane(tid >> 6), lane = tid & 63, wr = wid >> 2, wc = wid & 3, fr = lane & 15, fq = lane >> 4;
    constexpr unsigned ES = FP8 ? 1u : 2u;
    const int K = g.K, nt = FP8 ? K / 128 : K / BK;
    Unit cur, nxt; int ui = 0;
    if (!S.next(0, cur)) return;
    int Rst[2], Cst[2];
    unsigned voffA[2], voffA1[2], voffB[2], nvA[2], nvA1[2];
#pragma unroll
    for (int i = 0; i < 2; ++i) { int R, C; stage_rc(tid * 16 + i * 8192, R, C); const int Rb = Epi::PERM ? ((R & ~31) + perm32(R & 31)) : R; Rst[i] = R; Cst[i] = C;
        if (GATHER) { voffA[i] = (unsigned)S.rowsel(cur, R) * (unsigned)K * ES + (unsigned)C * 2u; voffA1[i] = (unsigned)S.rowsel(cur, 128 + R) * (unsigned)K * ES + (unsigned)C * 2u; }
        else { voffA[i] = (unsigned)(R * K) * ES + (unsigned)C * 2u; voffA1[i] = voffA[i]; }
        nvA[i] = voffA[i]; nvA1[i] = voffA1[i];
        voffB[i] = (unsigned)(Rb * K) * ES + (unsigned)C * 2u; }
    const size_t kstep = (size_t)(BK * 2);
    const size_t hstep = (size_t)HALF * K * ES;
    const size_t hstepA = GATHER ? 0 : hstep;
    const size_t tstep = 2 * hstep;
    const unsigned ldsw = (unsigned)wid * 1024u;
    const int aoff = lds_byte(wr * 64 + fr, FP8 ? fq * 16 : fq * 8), boff = lds_byte(wc * 32 + fr, FP8 ? fq * 16 : fq * 8);
#define PG8_SA(b, h) (((b) * 2 + (h)) * HTB)
#define PG8_SB(b, h) ((4 + (b) * 2 + (h)) * HTB)
#define PG8_STAGE2(bufoff, gbase, v0, v1) do { \
        __builtin_amdgcn_global_load_lds((const unsigned*)((const char*)(gbase) + (v0)), (LAS unsigned*)(lds + (bufoff) + ldsw), 16, 0, 0); \
        __builtin_amdgcn_global_load_lds((const unsigned*)((const char*)(gbase) + (v1)), (LAS unsigned*)(lds + (bufoff) + ldsw + 8192), 16, 0, 0); } while (0)
#define PG8_STAGE2A(bufoff, gbase, v0, v1) do { if constexpr (A_AUX == 16) { \
        __builtin_amdgcn_global_load_lds((const unsigned*)((const char*)(gbase) + (v0)), (LAS unsigned*)(lds + (bufoff) + ldsw), 16, 0, 16); \
        __builtin_amdgcn_global_load_lds((const unsigned*)((const char*)(gbase) + (v1)), (LAS unsigned*)(lds + (bufoff) + ldsw + 8192), 16, 0, 16); } else { PG8_STAGE2(bufoff, gbase, v0, v1); } } while (0)
#define PG8_STAGE(bufoff, gbase, voff) PG8_STAGE2(bufoff, gbase, (voff)[0], (voff)[1])
#define PG8_STAGEA(bufoff, gbase, voff) PG8_STAGE2A(bufoff, gbase, (voff)[0], (voff)[1])
#define G_LD32(p) __builtin_shufflevector(*(const LAS i32x4*)(p), *(const LAS i32x4*)((p) + 16), 0, 1, 2, 3, 4, 5, 6, 7)
#define G_MFMA8(c, a, b) asm volatile("v_mfma_scale_f32_16x16x128_f8f6f4 %0, %1, %2, %0, %3, %3 op_sel_hi:[0,0,0]" : "+v"(c) : "v"(a), "v"(b), "v"(one_scale))
#define PG8_LDA(dst, b, h) do { if constexpr (FP8) { _Pragma("unroll") for (int m = 0; m < 4; ++m) dst##8[m] = G_LD32(lds + PG8_SA(b, h) + aoff + m * 2048); } else { \
        _Pragma("unroll") for (int m = 0; m < 4; ++m) _Pragma("unroll") for (int k = 0; k < 2; ++k) dst[m][k] = *(const LAS bf16x8*)(lds + PG8_SA(b, h) + aoff + m * 2048 + k * 1024); } } while (0)
#define PG8_LDB(dst, b, h) do { if constexpr (FP8) { _Pragma("unroll") for (int n = 0; n < 2; ++n) dst##8[n] = G_LD32(lds + PG8_SB(b, h) + boff + n * 2048); } else { \
        _Pragma("unroll") for (int n = 0; n < 2; ++n) _Pragma("unroll") for (int k = 0; k < 2; ++k) dst[n][k] = *(const LAS bf16x8*)(lds + PG8_SB(b, h) + boff + n * 2048 + k * 1024); } } while (0)
#define PG8_MMA(ai, bj, At, Bt) do { __builtin_amdgcn_s_setprio(1); if constexpr (FP8) { _Pragma("unroll") for (int m = 0; m < 4; ++m) _Pragma("unroll") for (int n = 0; n < 2; ++n) G_MFMA8(acc[ai][bj][m][n], Bt##8[n], At##8[m]); } else { \
        _Pragma("unroll") for (int m = 0; m < 4; ++m) _Pragma("unroll") for (int n = 0; n < 2; ++n) _Pragma("unroll") for (int k = 0; k < 2; ++k) \
        acc[ai][bj][m][n] = __builtin_amdgcn_mfma_f32_16x16x32_bf16(Bt[n][k], At[m][k], acc[ai][bj][m][n], 0, 0, 0); } __builtin_amdgcn_s_setprio(0); } while (0)
#define PG8_WAIT_V(n) asm volatile("s_waitcnt vmcnt(" #n ")" ::: "memory")
#define PG8_WAIT_L(n) asm volatile("s_waitcnt lgkmcnt(" #n ")" ::: "memory")
#define PG8_BAR __builtin_amdgcn_s_barrier()
#define PG8_SCHED __builtin_amdgcn_sched_barrier(0)
    f32x4 acc[2][2][4][2];
#pragma unroll
    for (int a = 0; a < 2; ++a)
#pragma unroll
        for (int b = 0; b < 2; ++b)
#pragma unroll
            for (int m = 0; m < 4; ++m)
#pragma unroll
                for (int n = 0; n < 2; ++n) acc[a][b][m][n] = (f32x4){0.f, 0.f, 0.f, 0.f};
    bf16x8 At[4][2], B0[2][2], B1[2][2]; i32x8 At8[4], B08[2], B18[2];
    int one_scale = 0x7F7F7F7F; asm volatile("" : "+v"(one_scale));
    const char* cA = (const char*)g.A + (GATHER ? (size_t)0 : (size_t)cur.pm * tstep); const char* cB = S.bptr(cur);
    PG8_STAGE(PG8_SB(0, 0), cB, voffB); PG8_STAGE(PG8_SB(0, 1), cB + hstep, voffB); PG8_STAGEA(PG8_SA(0, 0), cA, voffA); PG8_STAGEA(PG8_SA(0, 1), cA + hstepA, voffA1);
    if (wr == 1) PG8_BAR;
    PG8_WAIT_V(2); PG8_BAR;
    PG8_STAGE(PG8_SB(1, 0), cB + kstep, voffB); PG8_STAGEA(PG8_SA(1, 0), cA + kstep, voffA); PG8_STAGE(PG8_SB(1, 1), cB + hstep + kstep, voffB);
    PG8_WAIT_V(6); PG8_BAR;
    for (;;) {
        const bool has_next = S.next(ui + 1, nxt);
        const char* nA = has_next ? (const char*)g.A + (GATHER ? (size_t)0 : (size_t)nxt.pm * tstep) : cA; const char* nB = has_next ? S.bptr(nxt) : cB;
        for (int t = 0; t < nt; t += 2) {
            const bool last = (t == nt - 2);
            const char* a1 = cA + (size_t)(t + 1) * kstep;
            const char* a2 = last ? nA : cA + (size_t)(t + 2) * kstep; const char* b2 = last ? nB : cB + (size_t)(t + 2) * kstep;
            const char* a3 = a2 + kstep; const char* b3 = b2 + kstep;
            if (GATHER && last && has_next) {
#pragma unroll
                for (int i = 0; i < 2; ++i) { nvA[i] = (unsigned)S.rowsel(nxt, Rst[i]) * (unsigned)K * ES + (unsigned)Cst[i] * 2u; nvA1[i] = (unsigned)S.rowsel(nxt, 128 + Rst[i]) * (unsigned)K * ES + (unsigned)Cst[i] * 2u; }
            }
            const unsigned x0 = (GATHER && last) ? nvA[0] : voffA[0], x1 = (GATHER && last) ? nvA[1] : voffA[1];
            const unsigned y0 = (GATHER && last) ? nvA1[0] : voffA1[0], y1 = (GATHER && last) ? nvA1[1] : voffA1[1];
            PG8_LDB(B0, 0, 0); PG8_LDB(B1, 0, 1); PG8_SCHED; PG8_LDA(At, 0, 0); PG8_STAGEA(PG8_SA(1, 1), a1 + hstepA, voffA1);
            PG8_WAIT_V(8); PG8_WAIT_L(0); PG8_BAR; PG8_MMA(0, 0, At, B0); PG8_MMA(0, 1, At, B1); PG8_BAR; PG8_SCHED;
            PG8_LDA(At, 0, 1); PG8_STAGE(PG8_SB(0, 0), b2, voffB); PG8_STAGE(PG8_SB(0, 1), b2 + hstep, voffB); PG8_STAGE2A(PG8_SA(0, 0), a2, x0, x1);
            PG8_WAIT_V(8); PG8_WAIT_L(0); PG8_BAR; PG8_MMA(1, 0, At, B0); PG8_MMA(1, 1, At, B1); PG8_BAR; PG8_SCHED;
            PG8_LDB(B0, 1, 0); PG8_LDB(B1, 1, 1); PG8_SCHED; PG8_LDA(At, 1, 0); PG8_STAGE2A(PG8_SA(0, 1), a2 + hstepA, y0, y1);
            PG8_WAIT_V(8); PG8_WAIT_L(0); PG8_BAR; PG8_MMA(0, 0, At, B0); PG8_MMA(0, 1, At, B1); PG8_BAR; PG8_SCHED;
            PG8_LDA(At, 1, 1); PG8_STAGE(PG8_SB(1, 0), b3, voffB); PG8_STAGE(PG8_SB(1, 1), b3 + hstep, voffB); PG8_STAGE2A(PG8_SA(1, 0), a3, x0, x1);
            PG8_WAIT_V(8); PG8_WAIT_L(0); PG8_BAR; PG8_MMA(1, 0, At, B0); PG8_MMA(1, 1, At, B1); PG8_BAR; PG8_SCHED;
        }
        if (ALIGN && wr == 0) PG8_BAR;
        if constexpr (FP8) asm volatile("s_nop 15\n\ts_nop 15" ::: "memory");
        E(acc, cur, wr, wc, fr, fq);
        if (!has_next) break;
#pragma unroll
        for (int a = 0; a < 2; ++a)
#pragma unroll
            for (int b = 0; b < 2; ++b)
#pragma unroll
                for (int m = 0; m < 4; ++m)
#pragma unroll
                    for (int n = 0; n < 2; ++n) acc[a][b][m][n] = (f32x4){0.f, 0.f, 0.f, 0.f};
        cur = nxt; cA = nA; cB = nB; ++ui;
        if (GATHER) { voffA[0] = nvA[0]; voffA[1] = nvA[1]; voffA1[0] = nvA1[0]; voffA1[1] = nvA1[1]; }
        if (ALIGN && wr == 1) PG8_BAR;
    }
    PG8_WAIT_V(0);
    if (!ALIGN && wr == 0) PG8_BAR;
    PG8_BAR;
#undef PG8_SA
#undef PG8_SB
#undef PG8_STAGE
#undef PG8_STAGE2
#undef PG8_STAGE2A
#undef PG8_STAGEA
#undef G_LD32
#undef G_MFMA8
#undef PG8_LDA
#undef PG8_LDB
#undef PG8_MMA
#undef PG8_WAIT_V
#undef PG8_WAIT_L
#undef PG8_BAR
#undef PG8_SCHED
}

struct EpiBf16 {
    static constexpr bool PERM = true;
    bf16_t* O; int ldc; float scale;
    __device__ __forceinline__ void operator()(const f32x4 (&acc)[2][2][4][2], const Unit& u, int wr, int wc, int fr, int fq) const {
        const int row0 = u.pm * BM + wr * 64 + fr; const int col0 = u.pn * BM + wc * 32 + 8 * fq;
#pragma unroll
        for (int ai = 0; ai < 2; ++ai)
#pragma unroll
            for (int m = 0; m < 4; ++m) { bf16_t* rowp = O + (size_t)(row0 + ai * HALF + m * 16) * ldc + col0;
#pragma unroll
                for (int bj = 0; bj < 2; ++bj) { const f32x4 v0 = acc[ai][bj][m][0] * scale, v1 = acc[ai][bj][m][1] * scale;
                    u32x4 w; w.x = cvt_pk_bf16(v0[0], v0[1]); w.y = cvt_pk_bf16(v0[2], v0[3]); w.z = cvt_pk_bf16(v1[0], v1[1]); w.w = cvt_pk_bf16(v1[2], v1[3]);
                    *(u32x4*)(rowp + bj * HALF) = w; } }
    }
};
struct EpiF32 {
    static constexpr bool PERM = false;
    float* C; int ldc;
    __device__ __forceinline__ void operator()(const f32x4 (&acc)[2][2][4][2], const Unit& u, int wr, int wc, int fr, int fq) const {
        const int row0 = u.pm * BM + wr * 64 + fr, col0 = u.pn * BM + wc * 32 + 4 * fq;
#pragma unroll
        for (int ai = 0; ai < 2; ++ai)
#pragma unroll
            for (int m = 0; m < 4; ++m) { float* rowp = C + (size_t)(row0 + ai * HALF + m * 16) * ldc + col0;
#pragma unroll
                for (int bj = 0; bj < 2; ++bj)
#pragma unroll
                    for (int n = 0; n < 2; ++n) *(f32x4*)(rowp + bj * HALF + n * 16) = acc[ai][bj][m][n]; }
    }
};
struct EpiResGate {
    static constexpr bool PERM = false;
    const float* x; float* out; const float* mod; int gate_off;
    __device__ __forceinline__ void operator()(const f32x4 (&acc)[2][2][4][2], const Unit& u, int wr, int wc, int fr, int fq) const {
        const int row0 = u.pm * BM + wr * 64 + fr, col0 = u.pn * BM + wc * 32 + 4 * fq;
        const float* gp = mod + (size_t)((u.pm * BM) >> 11) * MODW + gate_off + col0;
        f32x4 gv[2][2];
#pragma unroll
        for (int bj = 0; bj < 2; ++bj)
#pragma unroll
            for (int n = 0; n < 2; ++n) gv[bj][n] = *(const f32x4*)(gp + bj * HALF + n * 16);
#pragma unroll
        for (int ai = 0; ai < 2; ++ai)
#pragma unroll
            for (int m = 0; m < 4; ++m) { const size_t off = (size_t)(row0 + ai * HALF + m * 16) * D + col0;
#pragma unroll
                for (int bj = 0; bj < 2; ++bj)
#pragma unroll
                    for (int n = 0; n < 2; ++n) { const f32x4 xv = *(const f32x4*)(x + off + bj * HALF + n * 16);
                        *(f32x4*)(out + off + bj * HALF + n * 16) = xv + gv[bj][n] * acc[ai][bj][m][n]; }
                asm volatile("" ::: "memory"); }
    }
};
struct EpiGLU {
    static constexpr bool PERM = true;
    bf16_t* H;
    __device__ __forceinline__ void operator()(const f32x4 (&acc)[2][2][4][2], const Unit& u, int wr, int wc, int fr, int fq) const {
        const int row0 = u.pm * BM + wr * 64 + fr; const int col0 = u.pn * 128 + wc * 32 + 8 * fq;
#pragma unroll
        for (int ai = 0; ai < 2; ++ai)
#pragma unroll
            for (int m = 0; m < 4; ++m) { bf16_t* rowp = H + (size_t)(row0 + ai * HALF + m * 16) * 256 + col0;
                f32x4 h0, h1;
#pragma unroll
                for (int j = 0; j < 4; ++j) { const float a0 = acc[ai][0][m][0][j], a1 = acc[ai][0][m][1][j];
                    h0[j] = siluf_(a0) * acc[ai][1][m][0][j]; h1[j] = siluf_(a1) * acc[ai][1][m][1][j]; }
                u32x4 w; w.x = cvt_pk_bf16(h0[0], h0[1]); w.y = cvt_pk_bf16(h0[2], h0[3]); w.z = cvt_pk_bf16(h1[0], h1[1]); w.w = cvt_pk_bf16(h1[2], h1[3]);
                *(u32x4*)rowp = w; }
    }
};
constexpr float YSCALE = 8.f;
struct EpiY {
    static constexpr bool PERM = true;
    unsigned char* Y; float* out; const float* mod; const LAS int* rtok; const LAS float* rw; int shared;
    __device__ __forceinline__ void operator()(const f32x4 (&acc)[2][2][4][2], const Unit& u, int wr, int wc, int fr, int fq) const {
        const int col0 = u.pn * BM + wc * 32 + 8 * fq;
#pragma unroll
        for (int ai = 0; ai < 2; ++ai)
#pragma unroll
            for (int m = 0; m < 4; ++m) { const int r = wr * 64 + fr + ai * HALF + m * 16; const int ts = rtok[r]; const float w = rw[r];
                if (ts >= 0) {
                    if (shared) { const unsigned goff = (unsigned)(ts >> 11) * MODW + 5 * D + col0; const unsigned ooff = (unsigned)ts * D + col0;
#pragma unroll
                        for (int bj = 0; bj < 2; ++bj)
#pragma unroll
                            for (int n = 0; n < 2; ++n) { const f32x4 gv = *(const f32x4*)(mod + goff + bj * HALF + n * 4); f32x4* op = (f32x4*)(out + ooff + bj * HALF + n * 4);
                                *op = *op + gv * acc[ai][bj][m][n]; }
                    } else { unsigned char* yp = Y + (size_t)(unsigned)ts * D + col0; const float ws_ = w * YSCALE;
#pragma unroll
                        for (int bj = 0; bj < 2; ++bj) { f32x4 v0 = acc[ai][bj][m][0] * ws_, v1 = acc[ai][bj][m][1] * ws_;
#pragma unroll
                                for (int j = 0; j < 4; ++j) { v0[j] = __builtin_amdgcn_fmed3f(v0[j], -448.f, 448.f); v1[j] = __builtin_amdgcn_fmed3f(v1[j], -448.f, 448.f); }
                            unsigned lo = 0u, hi = 0u;
                            lo = __builtin_amdgcn_cvt_pk_fp8_f32(v0[0], v0[1], lo, false); lo = __builtin_amdgcn_cvt_pk_fp8_f32(v0[2], v0[3], lo, true);
                            hi = __builtin_amdgcn_cvt_pk_fp8_f32(v1[0], v1[1], hi, false); hi = __builtin_amdgcn_cvt_pk_fp8_f32(v1[2], v1[3], hi, true);
                            u32x2 pk; pk.x = lo; pk.y = hi; *(u32x2*)(yp + bj * HALF) = pk; } } }
                asm volatile("" ::: "memory"); }
    }
};

struct MoeCtx {
    int ntiles, nrt, G, vc;
    const LAS int* tb; LAS int* tbl;
    const unsigned* cnt; const int* rowl; const float* roww;
    const char* wexp; const char* h2n; char* Hs; unsigned char* Y; float* out; const float* mod; int dry_shared;
};
__device__ __forceinline__ void gemm_moe(lbyte* lds, const MoeCtx& M) {
    int tid_ = threadIdx.x; asm volatile("" : "+v"(tid_));
    const int tid = tid_, wid = __builtin_amdgcn_readfirstlane(tid >> 6), lane = tid & 63, wr = wid >> 2, wc = wid & 3, fr = lane & 15, fq = lane >> 4;
    const int ntl = (M.ntiles - M.vc + M.G - 1) / M.G;
    if (M.vc >= M.ntiles) return;
    const int nunits = ntl * 6;
    const unsigned ldsw = (unsigned)wid * 1024u;
    const int aoff = lds_byte(wr * 64 + fr, fq * 16), boff = lds_byte(wc * 32 + fr, fq * 16);
    auto tile_expert = [&](int tile, int& e, int& k) { if (tile < M.nrt) { int lo = 0, hi = NE - 1; while (lo < hi) { const int mid = (lo + hi + 1) >> 1; if (M.tb[mid] <= tile) lo = mid; else hi = mid - 1; } e = lo; k = tile - M.tb[lo]; } else { e = NE; k = tile - M.nrt; } };
    auto fill = [&](int j) { if (j < ntl && tid < 256) { const int tile = M.vc + j * M.G; int e, k; tile_expert(tile, e, k); LAS int* T = M.tbl + (j % 3) * 768;
            int ts; float w;
            if (e < NE) { const int valid = (int)M.cnt[e * CNT_STRIDE] - 256 * k; if (tid < valid) { ts = M.rowl[(size_t)tile * 256 + tid]; w = M.roww[(size_t)tile * 256 + tid]; } else { ts = -1; w = 0.f; } T[tid] = ts < 0 ? 0 : (ts >> 3); }
            else { ts = k * 256 + tid; w = 1.f; T[tid] = ts; }
            T[256 + tid] = ts; ((LAS float*)T)[512 + tid] = w; } };
    struct UP { const char* aB; const char* bB; unsigned bh; int nt, kind, pn, slot, shared, e, hbuf, fillnext; };
    auto unit_params = [&](int ui, int prev_e, UP& u, unsigned (&oa)[4], unsigned (&ob)[2]) {
        int tq = threadIdx.x; asm volatile("" : "+v"(tq));
        int Rst[2], Cst[2], Rbp[2];
#pragma unroll
        for (int i = 0; i < 2; ++i) { int R, C; stage_rc(tq * 16 + i * 8192, R, C); Rst[i] = R; Cst[i] = C; Rbp[i] = (R & ~31) + perm32(R & 31); }
        int j, sub;
        if (ui < 2) { j = 0; sub = ui; }
        else { const int qq = ui - 2, g = qq / 6, r = qq - 6 * g; if (g < ntl - 1 && r < 2) { j = g + 1; sub = r; } else { j = g; sub = (g < ntl - 1) ? r : r + 2; } }
        const int tile = M.vc + j * M.G; int e, k;
        if (sub == 0 || sub == 2) tile_expert(tile, e, k); else e = prev_e;
        u.e = e;
        const char* w = M.wexp + (size_t)e * WEXP_STRIDE;
        u.slot = j % 3; u.hbuf = j & 1; u.fillnext = (sub == 1) ? j + 1 : -1; u.shared = (e == NE) ? 1 : 0;
        if (sub < 2) { u.kind = 0; u.pn = sub; u.nt = D / 128; u.aB = M.h2n; u.bB = w + (size_t)sub * 256 * D; u.bh = 128u * D;
            const LAS int* T = M.tbl + (j % 3) * 768;
#pragma unroll
            for (int i = 0; i < 2; ++i) { oa[i] = (unsigned)T[Rst[i]] * (unsigned)D + 2u * (unsigned)Cst[i]; oa[2 + i] = (unsigned)T[128 + Rst[i]] * (unsigned)D + 2u * (unsigned)Cst[i]; ob[i] = (unsigned)(Rbp[i] * D + 2 * Cst[i]); } }
        else { u.kind = 1; u.pn = sub - 2; u.nt = DE / 128; u.aB = M.Hs + (j & 1) * 65536; u.bB = w + (size_t)512 * 1024 + (size_t)(sub - 2) * 256 * DE; u.bh = 128u * DE;
#pragma unroll
            for (int i = 0; i < 2; ++i) { oa[i] = (unsigned)(Rst[i] * DE + 2 * Cst[i]); oa[2 + i] = (unsigned)((128 + Rst[i]) * DE + 2 * Cst[i]); ob[i] = (unsigned)(Rbp[i] * DE + 2 * Cst[i]); } }
    };
#define PG8_SA(b, h) (((b) * 2 + (h)) * HTB)
#define PG8_SB(b, h) ((4 + (b) * 2 + (h)) * HTB)
#define MOE_DMA(bufoff, ptr, aux) __builtin_amdgcn_global_load_lds((const unsigned*)(ptr), (LAS unsigned*)(lds + (bufoff)), 16, 0, aux)
#define MOE_STA(bufoff, base, o0, o1) do { MOE_DMA((bufoff) + ldsw, (base) + (o0), 16); MOE_DMA((bufoff) + ldsw + 8192, (base) + (o1), 16); } while (0)
#define MOE_STAK(kindv, bufoff, base, o0, o1) do { if ((kindv) == 0) { MOE_DMA((bufoff) + ldsw, (base) + (o0), 0); MOE_DMA((bufoff) + ldsw + 8192, (base) + (o1), 0); } else MOE_STA(bufoff, base, o0, o1); } while (0)
#define MOE_STB(bufoff, base, o0, o1) do { MOE_DMA((bufoff) + ldsw, (base) + (o0), 0); MOE_DMA((bufoff) + ldsw + 8192, (base) + (o1), 0); } while (0)
#define MOE_LD32(p) __builtin_shufflevector(*(const LAS i32x4*)(p), *(const LAS i32x4*)((p) + 16), 0, 1, 2, 3, 4, 5, 6, 7)
#define PG8_LDA(dst, b, h) do { _Pragma("unroll") for (int m = 0; m < 4; ++m) dst[m] = MOE_LD32(lds + PG8_SA(b, h) + aoff + m * 2048); } while (0)
#define PG8_LDB(dst, b, h) do { _Pragma("unroll") for (int n = 0; n < 2; ++n) dst[n] = MOE_LD32(lds + PG8_SB(b, h) + boff + n * 2048); } while (0)
#define MOE_MFMA(c, a, b) asm volatile("v_mfma_scale_f32_16x16x128_f8f6f4 %0, %1, %2, %0, %3, %3 op_sel_hi:[0,0,0]" : "+v"(c) : "v"(a), "v"(b), "v"(one_scale))
#define PG8_MMA(ai, bj, At, Bt) do { __builtin_amdgcn_s_setprio(1); _Pragma("unroll") for (int m = 0; m < 4; ++m) _Pragma("unroll") for (int n = 0; n < 2; ++n) \
        MOE_MFMA(acc[ai][bj][m][n], Bt[n], At[m]); __builtin_amdgcn_s_setprio(0); } while (0)
#define PG8_WAIT_V(n) asm volatile("s_waitcnt vmcnt(" #n ")" ::: "memory")
#define PG8_WAIT_L(n) asm volatile("s_waitcnt lgkmcnt(" #n ")" ::: "memory")
#define PG8_BAR __builtin_amdgcn_s_barrier()
#define PG8_SCHED __builtin_amdgcn_sched_barrier(0)
    fill(0);
    asm volatile("s_waitcnt vmcnt(0) lgkmcnt(0)" ::: "memory");
    __syncthreads();
    UP cu, nu; unsigned oa[4], ob[2], na[4], nb[2];
    unit_params(0, 0, cu, oa, ob);
    nu = cu;
#pragma unroll
    for (int i = 0; i < 4; ++i) na[i] = oa[i];
    nb[0] = ob[0]; nb[1] = ob[1];
    f32x4 acc[2][2][4][2];
#pragma unroll
    for (int a = 0; a < 2; ++a)
#pragma unroll
        for (int b = 0; b < 2; ++b)
#pragma unroll
            for (int m = 0; m < 4; ++m)
#pragma unroll
                for (int n = 0; n < 2; ++n) acc[a][b][m][n] = (f32x4){0.f, 0.f, 0.f, 0.f};
    i32x8 At[4], B0[2], B1[2];
    int one_scale = 0x7F7F7F7F; asm volatile("" : "+v"(one_scale));
    const size_t kstep = (size_t)128;
    {   const char* cA = cu.aB; const char* cB = cu.bB;
        MOE_STB(PG8_SB(0, 0), cB, ob[0], ob[1]); MOE_STB(PG8_SB(0, 1), cB + cu.bh, ob[0], ob[1]); MOE_STAK(cu.kind, PG8_SA(0, 0), cA, oa[0], oa[1]); MOE_STAK(cu.kind, PG8_SA(0, 1), cA, oa[2], oa[3]);
        if (wr == 1) PG8_BAR;
        PG8_WAIT_V(2); PG8_BAR;
        MOE_STB(PG8_SB(1, 0), cB + kstep, ob[0], ob[1]); MOE_STAK(cu.kind, PG8_SA(1, 0), cA + kstep, oa[0], oa[1]); MOE_STB(PG8_SB(1, 1), cB + cu.bh + kstep, ob[0], ob[1]);
        PG8_WAIT_V(6); PG8_BAR; }
    for (int ui = 0;; ++ui) {
        const bool has_next = (ui + 1 < nunits);
        if (cu.fillnext >= 0) fill(cu.fillnext);
        const char* cA = cu.aB; const char* cB = cu.bB; const int nt = cu.nt; const unsigned bh = cu.bh;
        for (int t = 0; t < nt; t += 2) {
            const bool last = (t == nt - 2);
            if (last && has_next) unit_params(ui + 1, cu.e, nu, na, nb);
            const char* a1 = cA + (size_t)(t + 1) * kstep;
            const char* a2 = last ? nu.aB : cA + (size_t)(t + 2) * kstep; const char* b2 = last ? nu.bB : cB + (size_t)(t + 2) * kstep;
            const char* a3 = a2 + kstep; const char* b3 = b2 + kstep;
            const unsigned bh2 = last ? nu.bh : bh;
            const unsigned x0 = last ? na[0] : oa[0], x1 = last ? na[1] : oa[1], y0 = last ? na[2] : oa[2], y1 = last ? na[3] : oa[3];
            const unsigned z0 = last ? nb[0] : ob[0], z1 = last ? nb[1] : ob[1];
            const int k2 = last ? nu.kind : cu.kind;
            PG8_LDB(B0, 0, 0); PG8_LDB(B1, 0, 1); PG8_SCHED; PG8_LDA(At, 0, 0); MOE_STAK(cu.kind, PG8_SA(1, 1), a1, oa[2], oa[3]);
            PG8_WAIT_V(8); PG8_WAIT_L(0); PG8_BAR; PG8_MMA(0, 0, At, B0); PG8_MMA(0, 1, At, B1); PG8_BAR; PG8_SCHED;
            PG8_LDA(At, 0, 1); MOE_STB(PG8_SB(0, 0), b2, z0, z1); MOE_STB(PG8_SB(0, 1), b2 + bh2, z0, z1); MOE_STAK(k2, PG8_SA(0, 0), a2, x0, x1);
            PG8_WAIT_V(8); PG8_WAIT_L(0); PG8_BAR; PG8_MMA(1, 0, At, B0); PG8_MMA(1, 1, At, B1); PG8_BAR; PG8_SCHED;
            PG8_LDB(B0, 1, 0); PG8_LDB(B1, 1, 1); PG8_SCHED; PG8_LDA(At, 1, 0); MOE_STAK(k2, PG8_SA(0, 1), a2, y0, y1);
            PG8_WAIT_V(8); PG8_WAIT_L(0); PG8_BAR; PG8_MMA(0, 0, At, B0); PG8_MMA(0, 1, At, B1); PG8_BAR; PG8_SCHED;
            PG8_LDA(At, 1, 1); MOE_STB(PG8_SB(1, 0), b3, z0, z1); MOE_STB(PG8_SB(1, 1), b3 + bh2, z0, z1); MOE_STAK(k2, PG8_SA(1, 0), a3, x0, x1);
            PG8_WAIT_V(8); PG8_WAIT_L(0); PG8_BAR; PG8_MMA(1, 0, At, B0); PG8_MMA(1, 1, At, B1); PG8_BAR; PG8_SCHED;
        }
        if (wr == 0) PG8_BAR;
        asm volatile("s_nop 15\n\ts_nop 15" ::: "memory");
        if (cu.kind == 0) {
            const int row0 = wr * 64 + fr; const int col0 = cu.pn * 128 + wc * 32 + 8 * fq;
            constexpr float is13 = 1.f / SW13;
#pragma unroll
            for (int ai = 0; ai < 2; ++ai)
#pragma unroll
                for (int m = 0; m < 4; ++m) { unsigned char* rowp = (unsigned char*)M.Hs + cu.hbuf * 65536 + (size_t)(row0 + ai * HALF + m * 16) * 256 + col0;
                    f32x4 h0, h1;
#pragma unroll
                    for (int j = 0; j < 4; ++j) { h0[j] = siluf_(acc[ai][0][m][0][j] * is13) * (acc[ai][1][m][0][j] * (is13 * SHS)); h1[j] = siluf_(acc[ai][0][m][1][j] * is13) * (acc[ai][1][m][1][j] * (is13 * SHS)); }
                    u32x2 w; w.x = pk4_fp8(h0[0], h0[1], h0[2], h0[3]); w.y = pk4_fp8(h1[0], h1[1], h1[2], h1[3]);
                    *(u32x2*)rowp = w; }
        } else {
            const LAS int* rtok = M.tbl + cu.slot * 768 + 256; const LAS float* rw = (const LAS float*)(M.tbl + cu.slot * 768 + 512);
            const int col0 = cu.pn * BM + wc * 32 + 8 * fq;
#pragma unroll
            for (int ai = 0; ai < 2; ++ai)
#pragma unroll
                for (int m = 0; m < 4; ++m) { const int r = wr * 64 + fr + ai * HALF + m * 16; const int ts = rtok[r]; const float w = rw[r];
                    if (ts >= 0) {
                        if (cu.shared) { const unsigned goff = (unsigned)(ts >> 11) * MODW + 5 * D + col0; const unsigned ooff = (unsigned)ts * D + col0;
#pragma unroll
                            for (int bj = 0; bj < 2; ++bj)
#pragma unroll
                                for (int n = 0; n < 2; ++n) { const f32x4 gv = *(const f32x4*)(M.mod + goff + bj * HALF + n * 4); f32x4* op = (f32x4*)(M.out + ooff + bj * HALF + n * 4);
                                    const f32x4 nv = *op + gv * acc[ai][bj][m][n] * (1.f / (SHS * SW2)); if (!M.dry_shared) *op = nv; else asm volatile("" :: "v"(nv)); }
                        } else { unsigned char* yp = M.Y + (size_t)(unsigned)ts * D + col0; const float ws_ = w * (YSCALE / (SHS * SW2));
#pragma unroll
                            for (int bj = 0; bj < 2; ++bj) { f32x4 v0 = acc[ai][bj][m][0] * ws_, v1 = acc[ai][bj][m][1] * ws_;
#pragma unroll
                                for (int j = 0; j < 4; ++j) { v0[j] = __builtin_amdgcn_fmed3f(v0[j], -448.f, 448.f); v1[j] = __builtin_amdgcn_fmed3f(v1[j], -448.f, 448.f); }
                                unsigned lo = 0u, hi = 0u;
                                lo = __builtin_amdgcn_cvt_pk_fp8_f32(v0[0], v0[1], lo, false); lo = __builtin_amdgcn_cvt_pk_fp8_f32(v0[2], v0[3], lo, true);
                                hi = __builtin_amdgcn_cvt_pk_fp8_f32(v1[0], v1[1], hi, false); hi = __builtin_amdgcn_cvt_pk_fp8_f32(v1[2], v1[3], hi, true);
                                u32x2 pk; pk.x = lo; pk.y = hi; *(u32x2*)(yp + bj * HALF) = pk; } } }
                    asm volatile("" ::: "memory"); }
        }
        if (!has_next) break;
#pragma unroll
        for (int a = 0; a < 2; ++a)
#pragma unroll
            for (int b = 0; b < 2; ++b)
#pragma unroll
                for (int m = 0; m < 4; ++m)
#pragma unroll
                    for (int n = 0; n < 2; ++n) acc[a][b][m][n] = (f32x4){0.f, 0.f, 0.f, 0.f};
        cu = nu;
#pragma unroll
        for (int i = 0; i < 4; ++i) oa[i] = na[i];
        ob[0] = nb[0]; ob[1] = nb[1];
        if (wr == 1) PG8_BAR;
    }
    PG8_WAIT_V(0);
    PG8_BAR;
#undef PG8_SA
#undef PG8_SB
#undef MOE_DMA
#undef MOE_STA
#undef MOE_STAK
#undef MOE_STB
#undef PG8_LDA
#undef PG8_LDB
#undef MOE_LD32
#undef MOE_MFMA
#undef PG8_MMA
#undef PG8_WAIT_V
#undef PG8_WAIT_L
#undef PG8_BAR
#undef PG8_SCHED
}
}

struct Ctx {
    lbyte* lds; int tid, lane, wave, G, bid;
    const Args* a;
};
#define WSP(T, off) ((T*)(A.ws + (off)))

template <class RowMap>
__device__ __forceinline__ void transpose_item(const float* W, int K, int N, bf16_t* WT, RowMap rowmap, lfloat* scr, int item, int lane) {
    const int nblk = N / 32, kb = item / nblk, nb = item % nblk, k0 = 64 * kb, n0 = 32 * nb;
#pragma unroll 8
    for (int i = 0; i < 32; ++i) { const int kk = 2 * i + (lane >> 5); scr[kk * 33 + (lane & 31)] = W[(size_t)(k0 + kk) * N + n0 + (lane & 31)]; }
    asm volatile("s_waitcnt lgkmcnt(0)" ::: "memory");
    const int c = lane & 7;
#pragma unroll
    for (int j = 0; j < 4; ++j) { const int n = (lane >> 3) + 8 * j; const lfloat* s = scr + (8 * c) * 33 + n;
        u32x4 o; o.x = pk2(s[0 * 33], s[1 * 33]); o.y = pk2(s[2 * 33], s[3 * 33]); o.z = pk2(s[4 * 33], s[5 * 33]); o.w = pk2(s[6 * 33], s[7 * 33]);
        *(u32x4*)(WT + (size_t)rowmap(n0 + n) * K + k0 + 8 * c) = o; }
    asm volatile("s_waitcnt lgkmcnt(0)" ::: "memory");
}
template <class RowMap>
__device__ __forceinline__ void transpose_item_fp8(const float* W, int K, int N, unsigned char* WT, RowMap rowmap, float sc, lfloat* scr, int item, int lane) {
    const int nblk = N / 32, kb = item / nblk, nb = item % nblk, k0 = 64 * kb, n0 = 32 * nb;
#pragma unroll 8
    for (int i = 0; i < 32; ++i) { const int kk = 2 * i + (lane >> 5); scr[kk * 33 + (lane & 31)] = W[(size_t)(k0 + kk) * N + n0 + (lane & 31)] * sc; }
    asm volatile("s_waitcnt lgkmcnt(0)" ::: "memory");
    const int c = lane & 7;
#pragma unroll
    for (int j = 0; j < 4; ++j) { const int n = (lane >> 3) + 8 * j; const lfloat* s = scr + (8 * c) * 33 + n;
        u32x2 o; o.x = pk4_fp8(s[0 * 33], s[1 * 33], s[2 * 33], s[3 * 33]); o.y = pk4_fp8(s[4 * 33], s[5 * 33], s[6 * 33], s[7 * 33]);
        *(u32x2*)(WT + (size_t)rowmap(n0 + n) * K + k0 + 8 * c) = o; }
    asm volatile("s_waitcnt lgkmcnt(0)" ::: "memory");
}
template <class RowMap>
__device__ __forceinline__ void transpose_pair_fp8(const float* W, int K, int N, unsigned char* WT, RowMap rowmap, float sc, lfloat* scr, int pair, int lane) {
    const int nblk = N / 32, kbp = pair / nblk, nb = pair % nblk, k0 = 128 * kbp, n0 = 32 * nb;
    const int kr = lane >> 3, n4 = (lane & 7) * 4;
    f32x4 ld[2][8];
#pragma unroll
    for (int h = 0; h < 2; ++h)
#pragma unroll
        for (int i = 0; i < 8; ++i) ld[h][i] = *(const f32x4*)(W + (size_t)(k0 + 64 * h + 8 * i + kr) * N + n0 + n4);
    const int c = lane & 7;
    u32x2 o[2][4];
#pragma unroll
    for (int h = 0; h < 2; ++h) {
#pragma unroll
        for (int i = 0; i < 8; ++i) { lfloat* d = scr + (8 * i + kr) * 33 + n4; d[0] = ld[h][i].x * sc; d[1] = ld[h][i].y * sc; d[2] = ld[h][i].z * sc; d[3] = ld[h][i].w * sc; }
        asm volatile("s_waitcnt lgkmcnt(0)" ::: "memory");
#pragma unroll
        for (int j = 0; j < 4; ++j) { const int n = (lane >> 3) + 8 * j; const lfloat* s = scr + (8 * c) * 33 + n;
            o[h][j].x = pk4_fp8(s[0 * 33], s[1 * 33], s[2 * 33], s[3 * 33]); o[h][j].y = pk4_fp8(s[4 * 33], s[5 * 33], s[6 * 33], s[7 * 33]); }
        asm volatile("s_waitcnt lgkmcnt(0)" ::: "memory");
    }
#pragma unroll
    for (int j = 0; j < 4; ++j) { const int n = (lane >> 3) + 8 * j; unsigned char* p = WT + (size_t)rowmap(n0 + n) * K + k0 + 8 * c;
        *(u32x2*)p = o[0][j]; *(u32x2*)(p + 64) = o[1][j]; }
}
struct RowId { __device__ int operator()(int n) const { return n; } };
struct RowGLU { int base; __device__ int operator()(int n) const { return ((n >> 7) << 8) + base + (n & 127); } };

__device__ __forceinline__ void norm_mod_row(const float* xrow, const float* g, const float* sc, const float* sh, bf16_t* orow, int lane, unsigned* o8row = nullptr) {
    const f32x4* xr = (const f32x4*)xrow + lane;
    f32x4 v[4]; float s = 0.f;
#pragma unroll
    for (int j = 0; j < 4; ++j) { v[j] = xr[64 * j]; s += (v[j].x * v[j].x + v[j].y * v[j].y) + (v[j].z * v[j].z + v[j].w * v[j].w); }
    const float rstd = __builtin_amdgcn_rsqf(wave_sum(s) * (1.f / D) + NORM_EPS);
    u32x2* o8 = (u32x2*)orow + lane;
#pragma unroll
    for (int j = 0; j < 4; ++j) { const f32x4 gg = ((const f32x4*)g)[lane + 64 * j], ss = ((const f32x4*)sc)[lane + 64 * j], hh = ((const f32x4*)sh)[lane + 64 * j];
        const f32x4 y = v[j] * rstd * gg * (ss + 1.f) + hh;
        if (orow) { u32x2 w; w.x = pk2(y.x, y.y); w.y = pk2(y.z, y.w); o8[64 * j] = w; }
        if (o8row) o8row[lane + 64 * j] = pk4_fp8(y.x, y.y, y.z, y.w); }
}

__device__ __forceinline__ void phase_p0(const Args& A, Ctx& C) {
    float* mod = WSP(float, WS_MOD);
    {
        lfloat* sc = (lfloat*)C.lds;
        lfloat* red = (lfloat*)(C.lds + 17 * 1024 * 4);
        const float* wada = A.in[I_WADA]; const float* bada = A.in[I_BADA];
        for (int it = C.bid; it < 96 * 2; it += C.G) {
            const int chunk = it >> 1, pass = it & 1, r0 = pass * 17, nr = pass ? 16 : 17, col0 = chunk * 64;
            __syncthreads();
            for (int i = C.tid; i < nr * 1024; i += 512) { const int r = i >> 10, k = i & 1023; const int rr = r0 + r;
                const float cv = rr < 32 ? A.in[I_C][rr * 1024 + k] : A.in[I_CCTX][k]; sc[r * 1024 + k] = siluf_(cv); }
            __syncthreads();
            const int col = C.tid & 63, kq = C.tid >> 6;
            float acc[17];
#pragma unroll
            for (int r = 0; r < 17; ++r) acc[r] = 0.f;
            for (int k = kq * 128; k < kq * 128 + 128; k += 4) {
                float w[4];
#pragma unroll
                for (int j = 0; j < 4; ++j) w[j] = wada[(size_t)(k + j) * MODW + col0 + col];
#pragma unroll
                for (int r = 0; r < 17; ++r) { const f32x4 s4 = *(const LAS f32x4*)(sc + r * 1024 + k); acc[r] += s4.x * w[0] + s4.y * w[1] + s4.z * w[2] + s4.w * w[3]; }
            }
#pragma unroll
            for (int r = 0; r < 17; ++r) red[(kq * 17 + r) * 64 + col] = acc[r];
            __syncthreads();
            for (int i = C.tid; i < nr * 64; i += 512) { const int r = i >> 6, cc = i & 63; float s = 0.f;
#pragma unroll
                for (int q = 0; q < 8; ++q) s += red[(q * 17 + r) * 64 + cc];
                mod[(size_t)(r0 + r) * MODW + col0 + cc] = s + bada[col0 + cc]; }
        }
        __syncthreads();
    }
    {
        lfloat* scr = (lfloat*)(C.lds + C.wave * 16384);
        const int gw = C.bid * 8 + C.wave, NGW = C.G * 8;
        unsigned char* btin8 = A.ws + WS_BTIN; bf16_t* btout = WSP(bf16_t, WS_BTOUT); bf16_t* btr = WSP(bf16_t, WS_BTR);
        constexpr int I_IN = (D / 64) * 124, I_OUT = (D / 64) * (D / 32), I_R = (D / 64) * (NE / 32), I_G = (128 / 64) * (DA / 32);
        for (int it = gw; it < I_IN + I_OUT + I_R + I_G; it += NGW) {
            int r = it;
            if (r < I_IN) {
                const int kb = r / 124, nb = r % 124, k0 = 64 * kb, n0 = 32 * nb; const float* W = A.in[I_WIN];
#pragma unroll 8
                for (int i = 0; i < 32; ++i) { const int kk = 2 * i + (C.lane >> 5); scr[kk * 33 + (C.lane & 31)] = W[(size_t)(k0 + kk) * IN_COLS + n0 + (C.lane & 31)] * SWIN; }
                asm volatile("s_waitcnt lgkmcnt(0)" ::: "memory");
                const int c = C.lane & 7;
#pragma unroll
                for (int j = 0; j < 4; ++j) { const int n = (C.lane >> 3) + 8 * j; const lfloat* s = scr + (8 * c) * 33 + n;
                    u32x2 o; o.x = pk4_fp8(s[0 * 33], s[1 * 33], s[2 * 33], s[3 * 33]); o.y = pk4_fp8(s[4 * 33], s[5 * 33], s[6 * 33], s[7 * 33]);
                    *(u32x2*)(btin8 + (size_t)(n0 + n) * D + k0 + 8 * c) = o; }
                asm volatile("s_waitcnt lgkmcnt(0)" ::: "memory");
                continue; }
            r -= I_IN;
            if (r < I_OUT) { transpose_item(A.in[I_WOUT], D, D, btout, RowId(), scr, r, C.lane); continue; } r -= I_OUT;
            if (r < I_R) { transpose_item(A.in[I_RW], D, NE, btr, RowId(), scr, r, C.lane); continue; } r -= I_R;
            transpose_item(A.in[I_GUP], 128, DA, WSP(bf16_t, WS_GUPT), RowId(), scr, r, C.lane);
        }
        for (int i = C.bid * 512 + C.tid; i < 16 * D / 4; i += C.G * 512) { const int n = 3968 + (i >> 8), k = (i & 255) * 4; const float* W = A.in[I_WIN];
            *(unsigned*)(btin8 + (size_t)n * D + k) = pk4_fp8(W[(size_t)k * IN_COLS + n] * SWIN, W[(size_t)(k + 1) * IN_COLS + n] * SWIN, W[(size_t)(k + 2) * IN_COLS + n] * SWIN, W[(size_t)(k + 3) * IN_COLS + n] * SWIN); }
        for (int i = C.bid * 512 + C.tid; i < (PLD - IN_COLS) * D / 16; i += C.G * 512) ((u32x4*)(btin8 + (size_t)IN_COLS * D))[i] = (u32x4){0u, 0u, 0u, 0u};
    }
}

__device__ __forceinline__ void phase_p1(const Args& A, Ctx& C) {
    const float* mod = WSP(float, WS_MOD); bf16_t* xn = WSP(bf16_t, WS_XN);
    const int gw = C.bid * 8 + C.wave, NGW = C.G * 8;
    for (int row = gw; row < NROWS; row += NGW) {
        const float* xr; int mb;
        if (row < NLAT) { xr = A.in[I_X] + (size_t)row * D; mb = row >> 11; } else { xr = A.in[I_CTX] + (size_t)(row - NLAT) * D; mb = 32; }
        const float* m = mod + (size_t)mb * MODW;
        norm_mod_row(xr, A.in[I_N1G], m + D, m, nullptr, C.lane, (unsigned*)(A.ws + WS_XN) + (size_t)row * (D / 4));
    }
}

__device__ __forceinline__ float bfsel(unsigned w, unsigned sh) { return __builtin_bit_cast(float, (w << sh) & 0xffff0000u); }
template <int NK>
__device__ __forceinline__ f32x4 mm_tile(const lbyte* Ap, int lda, const lbyte* Bp, int ldb, f32x4 acc, int lane) {
    const int r = lane & 15, g = lane >> 4;
#pragma unroll
    for (int ks = 0; ks < NK; ++ks) {
        const bf16x8 a = *(const LAS bf16x8*)(Ap + r * lda + ks * 64 + g * 16);
        const bf16x8 b = *(const LAS bf16x8*)(Bp + r * ldb + ks * 64 + g * 16);
        acc = __builtin_amdgcn_mfma_f32_16x16x32_bf16(a, b, acc, 0, 0, 0);
    }
    return acc;
}

__device__ __forceinline__ void st_bf16x4(lbyte* p, f32x4 v) { u32x2 w; w.x = cvtpk(v.x, v.y); w.y = cvtpk(v.z, v.w); *(LAS u32x2*)p = w; }
__device__ __forceinline__ void st_bf16(lbyte* p, float v) { *(LAS unsigned short*)p = (unsigned short)cvtpk(v, v); }
__device__ __forceinline__ float rdlane(float v, int l) { return __builtin_bit_cast(float, __builtin_amdgcn_readlane(__builtin_bit_cast(int, v), l)); }

__device__ __forceinline__ void tri_inv16(const f32x4 m, int lane, lbyte* scr, float (&X)[16]) {
    *(LAS f32x4*)(scr + (lane & 15) * 64 + (lane >> 4) * 16) = m;
    asm volatile("s_waitcnt lgkmcnt(0)" ::: "memory");
    float Mr[16];
#pragma unroll
    for (int kq = 0; kq < 4; ++kq) { const f32x4 r = *(const LAS f32x4*)(scr + (lane & 15) * 64 + kq * 16); Mr[4 * kq] = r.x; Mr[4 * kq + 1] = r.y; Mr[4 * kq + 2] = r.z; Mr[4 * kq + 3] = r.w; }
    const int l16 = lane & 15;
    X[0] = (l16 == 0) ? 1.f : 0.f;
    { float a0 = (l16 == 1) ? 1.f : 0.f, a1 = 0.f, a2 = 0.f, a3 = 0.f;
      asm("s_nop 1\n\t" "v_fmac_f32_dpp %0, -%2, %3 row_newbcast:1 row_mask:0xf bank_mask:0xf\n\t" : "+v"(a0), "+v"(a1) : "v"(Mr[0]), "v"(X[0]));
      X[1] = (a0 + a1) + (a2 + a3); }
    { float a0 = (l16 == 2) ? 1.f : 0.f, a1 = 0.f, a2 = 0.f, a3 = 0.f;
      asm("s_nop 1\n\t" "v_fmac_f32_dpp %0, -%2, %3 row_newbcast:2 row_mask:0xf bank_mask:0xf\n\t" "v_fmac_f32_dpp %1, -%4, %5 row_newbcast:2 row_mask:0xf bank_mask:0xf\n\t" : "+v"(a0), "+v"(a1) : "v"(Mr[0]), "v"(X[0]), "v"(Mr[1]), "v"(X[1]));
      X[2] = (a0 + a1) + (a2 + a3); }
    { float a0 = (l16 == 3) ? 1.f : 0.f, a1 = 0.f, a2 = 0.f, a3 = 0.f;
      asm("s_nop 1\n\t" "v_fmac_f32_dpp %0, -%2, %3 row_newbcast:3 row_mask:0xf bank_mask:0xf\n\t" "v_fmac_f32_dpp %1, -%4, %5 row_newbcast:3 row_mask:0xf bank_mask:0xf\n\t" : "+v"(a0), "+v"(a1) : "v"(Mr[0]), "v"(X[0]), "v"(Mr[1]), "v"(X[1]));
      asm("s_nop 1\n\t" "v_fmac_f32_dpp %0, -%2, %3 row_newbcast:3 row_mask:0xf bank_mask:0xf\n\t" : "+v"(a2), "+v"(a3) : "v"(Mr[2]), "v"(X[2]));
      X[3] = (a0 + a1) + (a2 + a3); }
    { float a0 = (l16 == 4) ? 1.f : 0.f, a1 = 0.f, a2 = 0.f, a3 = 0.f;
      asm("s_nop 1\n\t" "v_fmac_f32_dpp %0, -%2, %3 row_newbcast:4 row_mask:0xf bank_mask:0xf\n\t" "v_fmac_f32_dpp %1, -%4, %5 row_newbcast:4 row_mask:0xf bank_mask:0xf\n\t" : "+v"(a0), "+v"(a1) : "v"(Mr[0]), "v"(X[0]), "v"(Mr[1]), "v"(X[1]));
      asm("s_nop 1\n\t" "v_fmac_f32_dpp %0, -%2, %3 row_newbcast:4 row_mask:0xf bank_mask:0xf\n\t" "v_fmac_f32_dpp %1, -%4, %5 row_newbcast:4 row_mask:0xf bank_mask:0xf\n\t" : "+v"(a2), "+v"(a3) : "v"(Mr[2]), "v"(X[2]), "v"(Mr[3]), "v"(X[3]));
      X[4] = (a0 + a1) + (a2 + a3); }
    { float a0 = (l16 == 5) ? 1.f : 0.f, a1 = 0.f, a2 = 0.f, a3 = 0.f;
      asm("s_nop 1\n\t" "v_fmac_f32_dpp %0, -%2, %3 row_newbcast:5 row_mask:0xf bank_mask:0xf\n\t" "v_fmac_f32_dpp %1, -%4, %5 row_newbcast:5 row_mask:0xf bank_mask:0xf\n\t" "v_fmac_f32_dpp %0, -%6, %7 row_newbcast:5 row_mask:0xf bank_mask:0xf\n\t" : "+v"(a0), "+v"(a1) : "v"(Mr[0]), "v"(X[0]), "v"(Mr[1]), "v"(X[1]), "v"(Mr[4]), "v"(X[4]));
      asm("s_nop 1\n\t" "v_fmac_f32_dpp %0, -%2, %3 row_newbcast:5 row_mask:0xf bank_mask:0xf\n\t" "v_fmac_f32_dpp %1, -%4, %5 row_newbcast:5 row_mask:0xf bank_mask:0xf\n\t" : "+v"(a2), "+v"(a3) : "v"(Mr[2]), "v"(X[2]), "v"(Mr[3]), "v"(X[3]));
      X[5] = (a0 + a1) + (a2 + a3); }
    { float a0 = (l16 == 6) ? 1.f : 0.f, a1 = 0.f, a2 = 0.f, a3 = 0.f;
      asm("s_nop 1\n\t" "v_fmac_f32_dpp %0, -%2, %3 row_newbcast:6 row_mask:0xf bank_mask:0xf\n\t" "v_fmac_f32_dpp %1, -%4, %5 row_newbcast:6 row_mask:0xf bank_mask:0xf\n\t" "v_fmac_f32_dpp %0, -%6, %7 row_newbcast:6 row_mask:0xf bank_mask:0xf\n\t" "v_fmac_f32_dpp %1, -%8, %9 row_newbcast:6 row_mask:0xf bank_mask:0xf\n\t" : "+v"(a0), "+v"(a1) : "v"(Mr[0]), "v"(X[0]), "v"(Mr[1]), "v"(X[1]), "v"(Mr[4]), "v"(X[4]), "v"(Mr[5]), "v"(X[5]));
      asm("s_nop 1\n\t" "v_fmac_f32_dpp %0, -%2, %3 row_newbcast:6 row_mask:0xf bank_mask:0xf\n\t" "v_fmac_f32_dpp %1, -%4, %5 row_newbcast:6 row_mask:0xf bank_mask:0xf\n\t" : "+v"(a2), "+v"(a3) : "v"(Mr[2]), "v"(X[2]), "v"(Mr[3]), "v"(X[3]));
      X[6] = (a0 + a1) + (a2 + a3); }
    { float a0 = (l16 == 7) ? 1.f : 0.f, a1 = 0.f, a2 = 0.f, a3 = 0.f;
      asm("s_nop 1\n\t" "v_fmac_f32_dpp %0, -%2, %3 row_newbcast:7 row_mask:0xf bank_mask:0xf\n\t" "v_fmac_f32_dpp %1, -%4, %5 row_newbcast:7 row_mask:0xf bank_mask:0xf\n\t" "v_fmac_f32_dpp %0, -%6, %7 row_newbcast:7 row_mask:0xf bank_mask:0xf\n\t" "v_fmac_f32_dpp %1, -%8, %9 row_newbcast:7 row_mask:0xf bank_mask:0xf\n\t" : "+v"(a0), "+v"(a1) : "v"(Mr[0]), "v"(X[0]), "v"(Mr[1]), "v"(X[1]), "v"(Mr[4]), "v"(X[4]), "v"(Mr[5]), "v"(X[5]));
      asm("s_nop 1\n\t" "v_fmac_f32_dpp %0, -%2, %3 row_newbcast:7 row_mask:0xf bank_mask:0xf\n\t" "v_fmac_f32_dpp %1, -%4, %5 row_newbcast:7 row_mask:0xf bank_mask:0xf\n\t" "v_fmac_f32_dpp %0, -%6, %7 row_newbcast:7 row_mask:0xf bank_mask:0xf\n\t" : "+v"(a2), "+v"(a3) : "v"(Mr[2]), "v"(X[2]), "v"(Mr[3]), "v"(X[3]), "v"(Mr[6]), "v"(X[6]));
      X[7] = (a0 + a1) + (a2 + a3); }
    { float a0 = (l16 == 8) ? 1.f : 0.f, a1 = 0.f, a2 = 0.f, a3 = 0.f;
      asm("s_nop 1\n\t" "v_fmac_f32_dpp %0, -%2, %3 row_newbcast:8 row_mask:0xf bank_mask:0xf\n\t" "v_fmac_f32_dpp %1, -%4, %5 row_newbcast:8 row_mask:0xf bank_mask:0xf\n\t" "v_fmac_f32_dpp %0, -%6, %7 row_newbcast:8 row_mask:0xf bank_mask:0xf\n\t" "v_fmac_f32_dpp %1, -%8, %9 row_newbcast:8 row_mask:0xf bank_mask:0xf\n\t" : "+v"(a0), "+v"(a1) : "v"(Mr[0]), "v"(X[0]), "v"(Mr[1]), "v"(X[1]), "v"(Mr[4]), "v"(X[4]), "v"(Mr[5]), "v"(X[5]));
      asm("s_nop 1\n\t" "v_fmac_f32_dpp %0, -%2, %3 row_newbcast:8 row_mask:0xf bank_mask:0xf\n\t" "v_fmac_f32_dpp %1, -%4, %5 row_newbcast:8 row_mask:0xf bank_mask:0xf\n\t" "v_fmac_f32_dpp %0, -%6, %7 row_newbcast:8 row_mask:0xf bank_mask:0xf\n\t" "v_fmac_f32_dpp %1, -%8, %9 row_newbcast:8 row_mask:0xf bank_mask:0xf\n\t" : "+v"(a2), "+v"(a3) : "v"(Mr[2]), "v"(X[2]), "v"(Mr[3]), "v"(X[3]), "v"(Mr[6]), "v"(X[6]), "v"(Mr[7]), "v"(X[7]));
      X[8] = (a0 + a1) + (a2 + a3); }
    { float a0 = (l16 == 9) ? 1.f : 0.f, a1 = 0.f, a2 = 0.f, a3 = 0.f;
      asm("s_nop 1\n\t" "v_fmac_f32_dpp %0, -%2, %3 row_newbcast:9 row_mask:0xf bank_mask:0xf\n\t" "v_fmac_f32_dpp %1, -%4, %5 row_newbcast:9 row_mask:0xf bank_mask:0xf\n\t" "v_fmac_f32_dpp %0, -%6, %7 row_newbcast:9 row_mask:0xf bank_mask:0xf\n\t" "v_fmac_f32_dpp %1, -%8, %9 row_newbcast:9 row_mask:0xf bank_mask:0xf\n\t" "v_fmac_f32_dpp %0, -%10, %11 row_newbcast:9 row_mask:0xf bank_mask:0xf\n\t" : "+v"(a0), "+v"(a1) : "v"(Mr[0]), "v"(X[0]), "v"(Mr[1]), "v"(X[1]), "v"(Mr[4]), "v"(X[4]), "v"(Mr[5]), "v"(X[5]), "v"(Mr[8]), "v"(X[8]));
      asm("s_nop 1\n\t" "v_fmac_f32_dpp %0, -%2, %3 row_newbcast:9 row_mask:0xf bank_mask:0xf\n\t" "v_fmac_f32_dpp %1, -%4, %5 row_newbcast:9 row_mask:0xf bank_mask:0xf\n\t" "v_fmac_f32_dpp %0, -%6, %7 row_newbcast:9 row_mask:0xf bank_mask:0xf\n\t" "v_fmac_f32_dpp %1, -%8, %9 row_newbcast:9 row_mask:0xf bank_mask:0xf\n\t" : "+v"(a2), "+v"(a3) : "v"(Mr[2]), "v"(X[2]), "v"(Mr[3]), "v"(X[3]), "v"(Mr[6]), "v"(X[6]), "v"(Mr[7]), "v"(X[7]));
      X[9] = (a0 + a1) + (a2 + a3); }
    { float a0 = (l16 == 10) ? 1.f : 0.f, a1 = 0.f, a2 = 0.f, a3 = 0.f;
      asm("s_nop 1\n\t" "v_fmac_f32_dpp %0, -%2, %3 row_newbcast:10 row_mask:0xf bank_mask:0xf\n\t" "v_fmac_f32_dpp %1, -%4, %5 row_newbcast:10 row_mask:0xf bank_mask:0xf\n\t" "v_fmac_f32_dpp %0, -%6, %7 row_newbcast:10 row_mask:0xf bank_mask:0xf\n\t" "v_fmac_f32_dpp %1, -%8, %9 row_newbcast:10 row_mask:0xf bank_mask:0xf\n\t" "v_fmac_f32_dpp %0, -%10, %11 row_newbcast:10 row_mask:0xf bank_mask:0xf\n\t" "v_fmac_f32_dpp %1, -%12, %13 row_newbcast:10 row_mask:0xf bank_mask:0xf\n\t" : "+v"(a0), "+v"(a1) : "v"(Mr[0]), "v"(X[0]), "v"(Mr[1]), "v"(X[1]), "v"(Mr[4]), "v"(X[4]), "v"(Mr[5]), "v"(X[5]), "v"(Mr[8]), "v"(X[8]), "v"(Mr[9]), "v"(X[9]));
      asm("s_nop 1\n\t" "v_fmac_f32_dpp %0, -%2, %3 row_newbcast:10 row_mask:0xf bank_mask:0xf\n\t" "v_fmac_f32_dpp %1, -%4, %5 row_newbcast:10 row_mask:0xf bank_mask:0xf\n\t" "v_fmac_f32_dpp %0, -%6, %7 row_newbcast:10 row_mask:0xf bank_mask:0xf\n\t" "v_fmac_f32_dpp %1, -%8, %9 row_newbcast:10 row_mask:0xf bank_mask:0xf\n\t" : "+v"(a2), "+v"(a3) : "v"(Mr[2]), "v"(X[2]), "v"(Mr[3]), "v"(X[3]), "v"(Mr[6]), "v"(X[6]), "v"(Mr[7]), "v"(X[7]));
      X[10] = (a0 + a1) + (a2 + a3); }
    { float a0 = (l16 == 11) ? 1.f : 0.f, a1 = 0.f, a2 = 0.f, a3 = 0.f;
      asm("s_nop 1\n\t" "v_fmac_f32_dpp %0, -%2, %3 row_newbcast:11 row_mask:0xf bank_mask:0xf\n\t" "v_fmac_f32_dpp %1, -%4, %5 row_newbcast:11 row_mask:0xf bank_mask:0xf\n\t" "v_fmac_f32_dpp %0, -%6, %7 row_newbcast:11 row_mask:0xf bank_mask:0xf\n\t" "v_fmac_f32_dpp %1, -%8, %9 row_newbcast:11 row_mask:0xf bank_mask:0xf\n\t" "v_fmac_f32_dpp %0, -%10, %11 row_newbcast:11 row_mask:0xf bank_mask:0xf\n\t" "v_fmac_f32_dpp %1, -%12, %13 row_newbcast:11 row_mask:0xf bank_mask:0xf\n\t" : "+v"(a0), "+v"(a1) : "v"(Mr[0]), "v"(X[0]), "v"(Mr[1]), "v"(X[1]), "v"(Mr[4]), "v"(X[4]), "v"(Mr[5]), "v"(X[5]), "v"(Mr[8]), "v"(X[8]), "v"(Mr[9]), "v"(X[9]));
      asm("s_nop 1\n\t" "v_fmac_f32_dpp %0, -%2, %3 row_newbcast:11 row_mask:0xf bank_mask:0xf\n\t" "v_fmac_f32_dpp %1, -%4, %5 row_newbcast:11 row_mask:0xf bank_mask:0xf\n\t" "v_fmac_f32_dpp %0, -%6, %7 row_newbcast:11 row_mask:0xf bank_mask:0xf\n\t" "v_fmac_f32_dpp %1, -%8, %9 row_newbcast:11 row_mask:0xf bank_mask:0xf\n\t" "v_fmac_f32_dpp %0, -%10, %11 row_newbcast:11 row_mask:0xf bank_mask:0xf\n\t" : "+v"(a2), "+v"(a3) : "v"(Mr[2]), "v"(X[2]), "v"(Mr[3]), "v"(X[3]), "v"(Mr[6]), "v"(X[6]), "v"(Mr[7]), "v"(X[7]), "v"(Mr[10]), "v"(X[10]));
      X[11] = (a0 + a1) + (a2 + a3); }
    { float a0 = (l16 == 12) ? 1.f : 0.f, a1 = 0.f, a2 = 0.f, a3 = 0.f;
      asm("s_nop 1\n\t" "v_fmac_f32_dpp %0, -%2, %3 row_newbcast:12 row_mask:0xf bank_mask:0xf\n\t" "v_fmac_f32_dpp %1, -%4, %5 row_newbcast:12 row_mask:0xf bank_mask:0xf\n\t" "v_fmac_f32_dpp %0, -%6, %7 row_newbcast:12 row_mask:0xf bank_mask:0xf\n\t" "v_fmac_f32_dpp %1, -%8, %9 row_newbcast:12 row_mask:0xf bank_mask:0xf\n\t" "v_fmac_f32_dpp %0, -%10, %11 row_newbcast:12 row_mask:0xf bank_mask:0xf\n\t" "v_fmac_f32_dpp %1, -%12, %13 row_newbcast:12 row_mask:0xf bank_mask:0xf\n\t" : "+v"(a0), "+v"(a1) : "v"(Mr[0]), "v"(X[0]), "v"(Mr[1]), "v"(X[1]), "v"(Mr[4]), "v"(X[4]), "v"(Mr[5]), "v"(X[5]), "v"(Mr[8]), "v"(X[8]), "v"(Mr[9]), "v"(X[9]));
      asm("s_nop 1\n\t" "v_fmac_f32_dpp %0, -%2, %3 row_newbcast:12 row_mask:0xf bank_mask:0xf\n\t" "v_fmac_f32_dpp %1, -%4, %5 row_newbcast:12 row_mask:0xf bank_mask:0xf\n\t" "v_fmac_f32_dpp %0, -%6, %7 row_newbcast:12 row_mask:0xf bank_mask:0xf\n\t" "v_fmac_f32_dpp %1, -%8, %9 row_newbcast:12 row_mask:0xf bank_mask:0xf\n\t" "v_fmac_f32_dpp %0, -%10, %11 row_newbcast:12 row_mask:0xf bank_mask:0xf\n\t" "v_fmac_f32_dpp %1, -%12, %13 row_newbcast:12 row_mask:0xf bank_mask:0xf\n\t" : "+v"(a2), "+v"(a3) : "v"(Mr[2]), "v"(X[2]), "v"(Mr[3]), "v"(X[3]), "v"(Mr[6]), "v"(X[6]), "v"(Mr[7]), "v"(X[7]), "v"(Mr[10]), "v"(X[10]), "v"(Mr[11]), "v"(X[11]));
      X[12] = (a0 + a1) + (a2 + a3); }
    { float a0 = (l16 == 13) ? 1.f : 0.f, a1 = 0.f, a2 = 0.f, a3 = 0.f;
      asm("s_nop 1\n\t" "v_fmac_f32_dpp %0, -%2, %3 row_newbcast:13 row_mask:0xf bank_mask:0xf\n\t" "v_fmac_f32_dpp %1, -%4, %5 row_newbcast:13 row_mask:0xf bank_mask:0xf\n\t" "v_fmac_f32_dpp %0, -%6, %7 row_newbcast:13 row_mask:0xf bank_mask:0xf\n\t" "v_fmac_f32_dpp %1, -%8, %9 row_newbcast:13 row_mask:0xf bank_mask:0xf\n\t" "v_fmac_f32_dpp %0, -%10, %11 row_newbcast:13 row_mask:0xf bank_mask:0xf\n\t" "v_fmac_f32_dpp %1, -%12, %13 row_newbcast:13 row_mask:0xf bank_mask:0xf\n\t" "v_fmac_f32_dpp %0, -%14, %15 row_newbcast:13 row_mask:0xf bank_mask:0xf\n\t" : "+v"(a0), "+v"(a1) : "v"(Mr[0]), "v"(X[0]), "v"(Mr[1]), "v"(X[1]), "v"(Mr[4]), "v"(X[4]), "v"(Mr[5]), "v"(X[5]), "v"(Mr[8]), "v"(X[8]), "v"(Mr[9]), "v"(X[9]), "v"(Mr[12]), "v"(X[12]));
      asm("s_nop 1\n\t" "v_fmac_f32_dpp %0, -%2, %3 row_newbcast:13 row_mask:0xf bank_mask:0xf\n\t" "v_fmac_f32_dpp %1, -%4, %5 row_newbcast:13 row_mask:0xf bank_mask:0xf\n\t" "v_fmac_f32_dpp %0, -%6, %7 row_newbcast:13 row_mask:0xf bank_mask:0xf\n\t" "v_fmac_f32_dpp %1, -%8, %9 row_newbcast:13 row_mask:0xf bank_mask:0xf\n\t" "v_fmac_f32_dpp %0, -%10, %11 row_newbcast:13 row_mask:0xf bank_mask:0xf\n\t" "v_fmac_f32_dpp %1, -%12, %13 row_newbcast:13 row_mask:0xf bank_mask:0xf\n\t" : "+v"(a2), "+v"(a3) : "v"(Mr[2]), "v"(X[2]), "v"(Mr[3]), "v"(X[3]), "v"(Mr[6]), "v"(X[6]), "v"(Mr[7]), "v"(X[7]), "v"(Mr[10]), "v"(X[10]), "v"(Mr[11]), "v"(X[11]));
      X[13] = (a0 + a1) + (a2 + a3); }
    { float a0 = (l16 == 14) ? 1.f : 0.f, a1 = 0.f, a2 = 0.f, a3 = 0.f;
      asm("s_nop 1\n\t" "v_fmac_f32_dpp %0, -%2, %3 row_newbcast:14 row_mask:0xf bank_mask:0xf\n\t" "v_fmac_f32_dpp %1, -%4, %5 row_newbcast:14 row_mask:0xf bank_mask:0xf\n\t" "v_fmac_f32_dpp %0, -%6, %7 row_newbcast:14 row_mask:0xf bank_mask:0xf\n\t" "v_fmac_f32_dpp %1, -%8, %9 row_newbcast:14 row_mask:0xf bank_mask:0xf\n\t" "v_fmac_f32_dpp %0, -%10, %11 row_newbcast:14 row_mask:0xf bank_mask:0xf\n\t" "v_fmac_f32_dpp %1, -%12, %13 row_newbcast:14 row_mask:0xf bank_mask:0xf\n\t" "v_fmac_f32_dpp %0, -%14, %15 row_newbcast:14 row_mask:0xf bank_mask:0xf\n\t" "v_fmac_f32_dpp %1, -%16, %17 row_newbcast:14 row_mask:0xf bank_mask:0xf\n\t" : "+v"(a0), "+v"(a1) : "v"(Mr[0]), "v"(X[0]), "v"(Mr[1]), "v"(X[1]), "v"(Mr[4]), "v"(X[4]), "v"(Mr[5]), "v"(X[5]), "v"(Mr[8]), "v"(X[8]), "v"(Mr[9]), "v"(X[9]), "v"(Mr[12]), "v"(X[12]), "v"(Mr[13]), "v"(X[13]));
      asm("s_nop 1\n\t" "v_fmac_f32_dpp %0, -%2, %3 row_newbcast:14 row_mask:0xf bank_mask:0xf\n\t" "v_fmac_f32_dpp %1, -%4, %5 row_newbcast:14 row_mask:0xf bank_mask:0xf\n\t" "v_fmac_f32_dpp %0, -%6, %7 row_newbcast:14 row_mask:0xf bank_mask:0xf\n\t" "v_fmac_f32_dpp %1, -%8, %9 row_newbcast:14 row_mask:0xf bank_mask:0xf\n\t" "v_fmac_f32_dpp %0, -%10, %11 row_newbcast:14 row_mask:0xf bank_mask:0xf\n\t" "v_fmac_f32_dpp %1, -%12, %13 row_newbcast:14 row_mask:0xf bank_mask:0xf\n\t" : "+v"(a2), "+v"(a3) : "v"(Mr[2]), "v"(X[2]), "v"(Mr[3]), "v"(X[3]), "v"(Mr[6]), "v"(X[6]), "v"(Mr[7]), "v"(X[7]), "v"(Mr[10]), "v"(X[10]), "v"(Mr[11]), "v"(X[11]));
      X[14] = (a0 + a1) + (a2 + a3); }
    { float a0 = (l16 == 15) ? 1.f : 0.f, a1 = 0.f, a2 = 0.f, a3 = 0.f;
      asm("s_nop 1\n\t" "v_fmac_f32_dpp %0, -%2, %3 row_newbcast:15 row_mask:0xf bank_mask:0xf\n\t" "v_fmac_f32_dpp %1, -%4, %5 row_newbcast:15 row_mask:0xf bank_mask:0xf\n\t" "v_fmac_f32_dpp %0, -%6, %7 row_newbcast:15 row_mask:0xf bank_mask:0xf\n\t" "v_fmac_f32_dpp %1, -%8, %9 row_newbcast:15 row_mask:0xf bank_mask:0xf\n\t" "v_fmac_f32_dpp %0, -%10, %11 row_newbcast:15 row_mask:0xf bank_mask:0xf\n\t" "v_fmac_f32_dpp %1, -%12, %13 row_newbcast:15 row_mask:0xf bank_mask:0xf\n\t" "v_fmac_f32_dpp %0, -%14, %15 row_newbcast:15 row_mask:0xf bank_mask:0xf\n\t" "v_fmac_f32_dpp %1, -%16, %17 row_newbcast:15 row_mask:0xf bank_mask:0xf\n\t" : "+v"(a0), "+v"(a1) : "v"(Mr[0]), "v"(X[0]), "v"(Mr[1]), "v"(X[1]), "v"(Mr[4]), "v"(X[4]), "v"(Mr[5]), "v"(X[5]), "v"(Mr[8]), "v"(X[8]), "v"(Mr[9]), "v"(X[9]), "v"(Mr[12]), "v"(X[12]), "v"(Mr[13]), "v"(X[13]));
      asm("s_nop 1\n\t" "v_fmac_f32_dpp %0, -%2, %3 row_newbcast:15 row_mask:0xf bank_mask:0xf\n\t" "v_fmac_f32_dpp %1, -%4, %5 row_newbcast:15 row_mask:0xf bank_mask:0xf\n\t" "v_fmac_f32_dpp %0, -%6, %7 row_newbcast:15 row_mask:0xf bank_mask:0xf\n\t" "v_fmac_f32_dpp %1, -%8, %9 row_newbcast:15 row_mask:0xf bank_mask:0xf\n\t" "v_fmac_f32_dpp %0, -%10, %11 row_newbcast:15 row_mask:0xf bank_mask:0xf\n\t" "v_fmac_f32_dpp %1, -%12, %13 row_newbcast:15 row_mask:0xf bank_mask:0xf\n\t" "v_fmac_f32_dpp %0, -%14, %15 row_newbcast:15 row_mask:0xf bank_mask:0xf\n\t" : "+v"(a2), "+v"(a3) : "v"(Mr[2]), "v"(X[2]), "v"(Mr[3]), "v"(X[3]), "v"(Mr[6]), "v"(X[6]), "v"(Mr[7]), "v"(X[7]), "v"(Mr[10]), "v"(X[10]), "v"(Mr[11]), "v"(X[11]), "v"(Mr[14]), "v"(X[14]));
      X[15] = (a0 + a1) + (a2 + a3); }
}

#ifndef RWKV_REP
#define RWKV_REP 1
#endif
namespace rk {
constexpr int S64 = 160, S32 = 80, SW = 144;
constexpr int O_WUP = 0, O_AUP = O_WUP + 64 * SW, O_WLT = O_AUP + 64 * SW, O_ALT = O_WLT + 16 * S64, O_LW = O_ALT + 16 * S64, O_LA = O_LW + 4096,
              O_KKT = O_LA + 4096, O_RT = O_KKT + 16 * S64, O_BT = O_RT + 16 * S64, O_KDT = O_BT + 16 * S64,
              O_VT = O_KDT + 16 * S64, O_BHT = O_VT + 64 * S32, O_KHT = O_BHT + 64 * S32, O_UT = O_KHT + 64 * S32, O_UTT = O_WLT  ,
              O_TI = O_UT + 64 * S32, O_MK = O_TI + 16 * S32, O_NB = O_MK + 16 * S32, O_NK = O_NB + 16 * S32,
              O_SBF = O_NK + 16 * S32, O_WC = O_SBF + 64 * S64, O_WT = O_WC + 256, TEAM_BYTES = O_WT + 1024;
static_assert(2 * TEAM_BYTES <= LDS_MISC, "rwkv LDS");
}
__device__ __forceinline__ void rwkv_pair_chunked(const Args& A, Ctx& C, int pair) {
    using namespace rk;
    const int b = pair >> 3, h = pair & 7;
    const int dir = C.wave >> 2;
    const int t4 = C.tid & 255, q = C.wave & 3, lane = C.lane;
    lbyte* L = C.lds + dir * TEAM_BYTES;
    const bf16_t* P = WSP(bf16_t, WS_P);
    bf16_t* ydir = WSP(bf16_t, WS_YDIR) + (size_t)dir * NLAT * D;
    float* bon = WSP(float, WS_BON) + (size_t)dir * NLAT * 8;
    __syncthreads();
#pragma unroll 2
    for (int i = t4; i < 4096; i += 256) { const int l = i >> 6, c = i & 63;
        st_bf16(L + O_WUP + c * SW + l * 2, A.in[I_WUP][((size_t)dir * 64 + l) * DA + 64 * h + c]);
        st_bf16(L + O_AUP + c * SW + l * 2, A.in[I_AUP][((size_t)dir * 64 + l) * DA + 64 * h + c]); }
#pragma unroll 2
    for (int i = t4; i < (4 * 64 * S32 + 4 * 16 * S32 + 64 * S64) / 4; i += 256) ((LAS unsigned*)(L + O_VT))[i] = 0u;
    for (int i = t4; i < (2 * 16 * S64) / 4; i += 256) ((LAS unsigned*)(L + O_WLT))[i] = 0u;
    const int c = lane;
    const int col5[5] = {64 * h + c, 512 + 64 * h + c, 1024 + 64 * h + c, 1536 + 64 * dir + c, 1664 + 64 * dir + c};
    float mu5[5]; unsigned coff[5], nm[5], nlo[5], nrg[5]; int ndb[5];
#pragma unroll
    for (int e = 0; e < 5; ++e) { mu5[e] = A.in[I_MU][col5[e]]; coff[e] = (unsigned)col5[e] * 2u; }
    auto set_rules = [&](bool ctx) {
#pragma unroll
        for (int e = 0; e < 5; ++e) { const int col = col5[e];
            if (ctx) { nm[e] = 0xffffffffu; nlo[e] = col < 960 ? 1u : 0u; nrg[e] = (unsigned)(CTX - 2); ndb[e] = (col < 960 ? -PLD : PLD) * 2; }
            else { const int cls = col < 480 ? 0 : (col < 960 ? 1 : (col < 1440 ? 2 : 3));
                nm[e] = cls < 2 ? 63u : 0xffffffffu; nlo[e] = cls == 0 ? 1u : (cls == 2 ? 64u : 0u); nrg[e] = cls < 2 ? 62u : (unsigned)(SEQ - 65);
                ndb[e] = (cls == 0 ? -PLD : (cls == 1 ? PLD : (cls == 2 ? -64 * PLD : 64 * PLD))) * 2; } } };
    set_rules(true);
    const char* wsb = (const char*)A.ws;
    const float kkc = A.in[I_KK][64 * h + c], kac = A.in[I_KA][64 * h + c], rkc = A.in[I_RK][64 * h + c];
    const float w0c = A.in[I_W0][dir * DA + 64 * h + c], a0c = A.in[I_A0][dir * DA + 64 * h + c];
    f32x4 Sacc[4];
#pragma unroll
    for (int i = 0; i < 4; ++i) Sacc[i] = (f32x4){0.f, 0.f, 0.f, 0.f};
    const int fr = lane & 15, fg = lane >> 4;
    unsigned short rawp[4][5], raws[4][5];
    auto chunk_geom = [&](int ch, bool& isctx, int& sbase, int& T, size_t& rowbase) { isctx = ch < 16; sbase = isctx ? ch * 16 : (ch - 16) * 16; T = isctx ? CTX : SEQ; rowbase = isctx ? (size_t)NLAT + (size_t)b * CTX : (size_t)b * SEQ; };
    auto issue_loads = [&](int ch) { bool isctx; int sbase, T; size_t rowbase; chunk_geom(ch, isctx, sbase, T, rowbase);
#pragma unroll
        for (int j = 0; j < 4; ++j) { const int i = 4 * q + j; const int t = __builtin_amdgcn_readfirstlane(dir ? (T - 1 - (sbase + i)) : (sbase + i));
            const unsigned rowoff = (unsigned)WS_P + (unsigned)(rowbase + t) * (unsigned)(PLD * 2);
#pragma unroll
            for (int e = 0; e < 5; ++e) { const unsigned vs = rowoff + coff[e]; const bool ok = (((unsigned)t & nm[e]) - nlo[e]) <= nrg[e]; const unsigned vn = ok ? vs + (unsigned)ndb[e] : 8u;
                rawp[j][e] = *(const bf16_t*)(wsb + vs); raws[j][e] = *(const bf16_t*)(wsb + vn); } } };
    u32x2 ypend; ypend.x = 0u; ypend.y = 0u; float bpend[4] = {0.f, 0.f, 0.f, 0.f};
    auto flush = [&](int pch) { bool pisctx; int psb, pT; size_t prb; chunk_geom(pch, pisctx, psb, pT, prb);
        if (!pisctx) { const int t = dir ? (pT - 1 - (psb + fr)) : (psb + fr);
            *(u32x2*)(ydir + ((size_t)b * SEQ + t) * D + 64 * h + 16 * q + 4 * fg) = ypend;
            if (lane == 0) {
#pragma unroll
                for (int j = 0; j < 4; ++j) { const int i = 4 * q + j; const int tj = dir ? (pT - 1 - (psb + i)) : (psb + i); bon[((size_t)b * SEQ + tj) * 8 + h] = bpend[j]; } } } };
    issue_loads(0);
    for (int ch = 0; ch < 144; ++ch) {
        bool isctx; int sbase, T; size_t rowbase; chunk_geom(ch, isctx, sbase, T, rowbase);
        float vr[4], vk[4], vv[4], vkk[4], lw[4], av[4];
        __syncthreads();
        float mxa[4][5];
#pragma unroll
        for (int j = 0; j < 4; ++j) {
#pragma unroll
            for (int e = 0; e < 5; ++e) { const float pv = bf2f(rawp[j][e]); const float sv = bf2f(raws[j][e]); mxa[j][e] = pv + mu5[e] * (sv - pv); } }
        asm volatile("" :: "v"(mxa[0][0]), "v"(mxa[0][1]), "v"(mxa[0][2]), "v"(mxa[0][3]), "v"(mxa[0][4]), "v"(mxa[1][0]), "v"(mxa[1][1]), "v"(mxa[1][2]), "v"(mxa[1][3]), "v"(mxa[1][4]),
                        "v"(mxa[2][0]), "v"(mxa[2][1]), "v"(mxa[2][2]), "v"(mxa[2][3]), "v"(mxa[2][4]), "v"(mxa[3][0]), "v"(mxa[3][1]), "v"(mxa[3][2]), "v"(mxa[3][3]), "v"(mxa[3][4]) : "memory");
        if (ch > 0) flush(ch - 1);
        if (ch == 15) set_rules(false);
        if (ch + 1 < 144) issue_loads(ch + 1);
        float cl[4];
        _Pragma("unroll") for (int rrep = 0; rrep < RWKV_REP; ++rrep) {
#pragma unroll
        for (int j = 0; j < 4; ++j) {
            const int i = 4 * q + j;
            float mx[5];
#pragma unroll
            for (int e = 0; e < 5; ++e) mx[e] = mxa[j][e];
            vr[j] = mx[0]; vk[j] = mx[1]; vv[j] = mx[2];
            *(LAS unsigned short*)(L + O_WLT + i * S64 + c * 2) = (unsigned short)cvtpk(tanhf_(mx[3]), 0.f); *(LAS unsigned short*)(L + O_ALT + i * S64 + c * 2) = (unsigned short)cvtpk(mx[4], 0.f);
            const float kx = vk[j] * kkc; const float ss = wave_sum(kx * kx);
            vkk[j] = kx * __builtin_amdgcn_rsqf(ss + 1e-6f);
        }
        __syncthreads();
        {
            const f32x4 z = (f32x4){0.f, 0.f, 0.f, 0.f};
            const f32x4 tw = mm_tile<2>(L + O_WLT, S64, L + O_WUP + 16 * q * SW, SW, z, lane);
            const f32x4 ta = mm_tile<2>(L + O_ALT, S64, L + O_AUP + 16 * q * SW, SW, z, lane);
#pragma unroll
            for (int e = 0; e < 4; ++e) { ((LAS float*)(L + O_LW))[(4 * fg + e) * 64 + 16 * q + fr] = tw[e]; ((LAS float*)(L + O_LA))[(4 * fg + e) * 64 + 16 * q + fr] = ta[e]; }
        }
        __syncthreads();
        { float run = 0.f;
#pragma unroll
        for (int j = 0; j < 4; ++j) { const int i = 4 * q + j;
            const float wlog = -softplusf_(-(w0c + ((LAS float*)(L + O_LW))[i * 64 + c])) - 0.5f;
            lw[j] = -__expf(wlog);
            av[j] = sigmoidf_(a0c + ((LAS float*)(L + O_LA))[i * 64 + c]);
            run += lw[j]; cl[j] = run; }
        ((LAS float*)(L + O_WT))[q * 64 + c] = run; }
        __syncthreads();
        }
        {
            float off = 0.f, cumC = 0.f;
#pragma unroll
            for (int qq = 0; qq < 4; ++qq) { const float tv = ((LAS float*)(L + O_WT))[qq * 64 + c]; cumC += tv; off += (qq < q) ? tv : 0.f; }
            float tv_[4], tb_[4], tk_[4];
            float Wprev = __expf(off); const float eC = __expf(cumC);
#pragma unroll
            for (int j = 0; j < 4; ++j) { const int i = 4 * q + j;
                const float cum = off + cl[j];
                const float Wt = __expf(cum), Wp = Wprev, Wi = __builtin_amdgcn_rcpf(Wt), Wc = eC * Wi; Wprev = Wt;
                const float kd = vk[j] * (1.f + (av[j] - 1.f) * kac), bb = vkk[j] * av[j];
                const unsigned p0 = cvtpk(vkk[j] * Wp, vr[j] * Wt), p1 = cvtpk(bb * Wi, kd * Wi);
                *(LAS unsigned short*)(L + O_KKT + i * S64 + c * 2) = (unsigned short)p0; *(LAS unsigned short*)(L + O_RT + i * S64 + c * 2) = (unsigned short)(p0 >> 16);
                *(LAS unsigned short*)(L + O_BT + i * S64 + c * 2) = (unsigned short)p1; *(LAS unsigned short*)(L + O_KDT + i * S64 + c * 2) = (unsigned short)(p1 >> 16);
                tv_[j] = vv[j]; tb_[j] = bb * Wc; tk_[j] = kd * Wc;
                const float bs = wave_sum(vr[j] * kd * rkc);
                bpend[j] = bs;
            }
            { u32x2 w2;
                w2.x = cvtpk(tv_[0], tv_[1]); w2.y = cvtpk(tv_[2], tv_[3]); *(LAS u32x2*)(L + O_VT + c * S32 + q * 8) = w2;
                w2.x = cvtpk(tb_[0], tb_[1]); w2.y = cvtpk(tb_[2], tb_[3]); *(LAS u32x2*)(L + O_BHT + c * S32 + q * 8) = w2;
                w2.x = cvtpk(tk_[0], tk_[1]); w2.y = cvtpk(tk_[2], tk_[3]); *(LAS u32x2*)(L + O_KHT + c * S32 + q * 8) = w2; }
            if (q == 3) ((LAS float*)(L + O_WC))[c] = eC;
        }
        __syncthreads();
        {
            const int role = (q + dir) & 3;
            const lbyte* Aj = L + ((role & 1) ? O_KDT : O_BT);
            const lbyte* Bt = L + ((role & 2) ? O_RT : O_KKT);
            f32x4 g4 = mm_tile<2>(Aj, S64, Bt, S64, (f32x4){0.f, 0.f, 0.f, 0.f}, lane);
#pragma unroll
            for (int e = 0; e < 4; ++e) { const int j = 4 * fg + e; const bool keep = (role & 2) ? (j <= fr) : (j < fr); g4[e] = keep ? g4[e] : 0.f; }
            if (role == 0) { float X[16]; tri_inv16(g4, lane, L + O_LW, X);
                if (lane < 16) {
#pragma unroll
                    for (int i = 0; i < 16; ++i) *(LAS unsigned short*)(L + O_TI + i * S32 + lane * 2) = (unsigned short)cvtpk(X[i], 0.f); } }
            else st_bf16x4(L + (role == 1 ? O_MK : (role == 2 ? O_NB : O_NK)) + fr * S32 + fg * 8, g4);
        }
        __syncthreads();
        f32x4 yacc;
        {
            f32x4 u4 = mm_tile<2>(L + O_KKT, S64, L + O_SBF + 16 * q * S64, S64, (f32x4){0.f, 0.f, 0.f, 0.f}, lane);
            u4 = mm_tile<1>(L + O_MK, S32, L + O_VT + 16 * q * S32, S32, u4, lane);
            st_bf16x4(L + O_UTT + (16 * q + fr) * S32 + fg * 8, u4);
            yacc = mm_tile<2>(L + O_SBF + 16 * q * S64, S64, L + O_RT, S64, (f32x4){0.f, 0.f, 0.f, 0.f}, lane);
            yacc = mm_tile<1>(L + O_VT + 16 * q * S32, S32, L + O_NK, S32, yacc, lane);
        }
        asm volatile("s_waitcnt lgkmcnt(0)" ::: "memory");
        {
            f32x4 u4 = mm_tile<1>(L + O_TI, S32, L + O_UTT + 16 * q * S32, S32, (f32x4){0.f, 0.f, 0.f, 0.f}, lane);
            st_bf16x4(L + O_UT + (16 * q + fr) * S32 + fg * 8, -u4);
        }
        __syncthreads();
        {
            yacc = mm_tile<1>(L + O_UT + 16 * q * S32, S32, L + O_NB, S32, yacc, lane);
            ypend.x = cvtpk(yacc[0], yacc[1]); ypend.y = cvtpk(yacc[2], yacc[3]);
            const f32x4 wc4 = *(LAS f32x4*)(L + O_WC + (16 * q + 4 * fg) * 4);
#pragma unroll
            for (int vi = 0; vi < 4; ++vi) {
                f32x4 s4 = Sacc[vi] * wc4;
                s4 = mm_tile<1>(L + O_KHT + 16 * q * S32, S32, L + O_VT + 16 * vi * S32, S32, s4, lane);
                s4 = mm_tile<1>(L + O_BHT + 16 * q * S32, S32, L + O_UT + 16 * vi * S32, S32, s4, lane);
                Sacc[vi] = s4;
                st_bf16x4(L + O_SBF + (16 * vi + fr) * S64 + (16 * q + 4 * fg) * 2, s4);
            }
        }
    }
    flush(143);
    __syncthreads();
}

__device__ __forceinline__ void phase_gdn_prep(const Args& A, Ctx& C) {
    const bf16_t* P = WSP(bf16_t, WS_P);
    bf16_t* QKV = (bf16_t*)A.out; float* NRM = WSP(float, WS_NRM);
    const int lane = C.lane, w = C.wave, hq = w >> 1, th = w & 1;
    const int ch0 = 128 * hq + 2 * lane;
    float cw[3][2][5];
#pragma unroll
    for (int g = 0; g < 3; ++g)
#pragma unroll
        for (int xx = 0; xx < 2; ++xx)
#pragma unroll
            for (int e = 0; e < 5; ++e) cw[g][xx][e] = A.in[I_CONVW][e * 1536 + g * 512 + ch0 + xx];
    auto geom = [&](int tile, int& T, int& tb, size_t& rowbase) { const int row0 = tile * 16; int ta;
        if (row0 < NLAT) { T = SEQ; rowbase = (size_t)(row0 >> 11) * SEQ; ta = row0 & (SEQ - 1); } else { T = CTX; const int r = row0 - NLAT; rowbase = (size_t)NLAT + (size_t)(r >> 8) * CTX; ta = r & (CTX - 1); }
        tb = ta + 8 * th; };
    unsigned raw[12][3];
    auto issue = [&](int tile) { int T, tb; size_t rowbase; geom(tile, T, tb, rowbase);
#pragma unroll
        for (int e = 0; e < 12; ++e) { const int t = tb - 2 + e; const bool ok = (t >= 0 && t < T); const unsigned* pr = (const unsigned*)(P + (rowbase + (ok ? t : tb)) * PLD + RW_COLS + ch0);
#pragma unroll
            for (int g = 0; g < 3; ++g) raw[e][g] = pr[g * 256]; } };
    if (C.bid < NROWS / 16) issue(C.bid);
    for (int tile = C.bid; tile < NROWS / 16; tile += C.G) {
        int T, tb; size_t rowbase; geom(tile, T, tb, rowbase);
        float x[3][2][12];
#pragma unroll
        for (int e = 0; e < 12; ++e) { const int t = tb - 2 + e; const bool ok = (t >= 0 && t < T);
#pragma unroll
            for (int g = 0; g < 3; ++g) { const unsigned wv = raw[e][g]; x[g][0][e] = ok ? bflo(wv) : 0.f; x[g][1][e] = ok ? bfhi(wv) : 0.f; } }
        if (tile + C.G < NROWS / 16) issue(tile + C.G);
#pragma unroll
        for (int i = 0; i < 8; ++i) { float y[3][2];
#pragma unroll
            for (int g = 0; g < 3; ++g)
#pragma unroll
                for (int xx = 0; xx < 2; ++xx) { float sacc = 0.f;
#pragma unroll
                    for (int f = 0; f < 5; ++f) sacc += cw[g][xx][f] * x[g][xx][i + f];
                    y[g][xx] = siluf_(sacc); }
            const size_t row = rowbase + tb + i;
            unsigned* orow = (unsigned*)(QKV + row * 1536 + ch0);
            orow[0] = cvtpk(y[0][0], y[0][1]); orow[256] = cvtpk(y[1][0], y[1][1]); orow[512] = cvtpk(y[2][0], y[2][1]);
            const float sq = wave_sum(y[0][0] * y[0][0] + y[0][1] * y[0][1]), sk = wave_sum(y[1][0] * y[1][0] + y[1][1] * y[1][1]);
            if (lane == 0) { NRM[row * 8 + hq] = __builtin_amdgcn_rsqf(sq + 1e-6f) * 0.08838834764831845f; NRM[row * 8 + 4 + hq] = __builtin_amdgcn_rsqf(sk + 1e-6f); } }
    }
    __syncthreads();
}

namespace gd {
constexpr int S128 = 288, S32 = 80;
constexpr int O_KT = 0, O_QT = O_KT + 32 * S128, O_KKT = O_QT + 32 * S128, O_RT = O_KKT + 32 * S128,
              O_VT = O_RT + 32 * S128, O_BHT = O_VT + 128 * S32, O_KHT = O_BHT + 128 * S32, O_UT = O_KHT + 128 * S32, O_UTT = O_UT + 128 * S32,
              O_TI = O_UTT + 128 * S32, O_MK = O_TI + 32 * S32, O_NB = O_MK + 32 * S32, O_NK = O_NB + 32 * S32,
              O_M21 = O_NK + 32 * S32, O_T11T = O_M21 + 16 * S32, O_T22 = O_T11T + 16 * S32, O_XT = O_T22 + 16 * S32,
              O_SBF = O_XT + 16 * S32, O_SC = O_SBF + 128 * S128, O_MS = O_SC + 512, GD_BYTES = O_MS + 2048;
static_assert(GD_BYTES <= LDS_MISC, "gdn LDS");
}
__device__ __forceinline__ void gdn_chain_chunked(const Args& A, Ctx& C, int chain) {
    using namespace gd;
    const int b = chain >> 3, h = (chain >> 1) & 3, dir = chain & 1;
    lbyte* L = C.lds;
    LAS float* SC = (LAS float*)(L + O_SC);
    const bf16_t* P = WSP(bf16_t, WS_P);
    bf16_t* ydir = WSP(bf16_t, WS_YDIR) + (size_t)dir * NLAT * D;
    const int tid = C.tid, lane = C.lane, w = C.wave, fr = lane & 15, fg = lane >> 4;
    const int grp = w >> 1, idx = tid & 127;
    const float Aexp = __expf(A.in[I_ALOG][dir * 4 + h]), dtb = A.in[I_DTB][dir * 4 + h];
    const f32x4 z4 = (f32x4){0.f, 0.f, 0.f, 0.f};
    __syncthreads();
#pragma unroll 2
    for (int i = tid; i < (O_SC - O_VT) / 4; i += 512) ((LAS unsigned*)(L + O_VT))[i] = 0u;
    f32x4 Sacc[8];
#pragma unroll
    for (int i = 0; i < 8; ++i) Sacc[i] = z4;
    const bf16_t* QKV = (const bf16_t*)A.out; const float* NRM = WSP(const float, WS_NRM);
    unsigned rq[8], rk[8], rv[8]; float nq[8], nk[8]; unsigned raw_al = 0, raw_be = 0;
    const unsigned codd = (idx & 1) ? 0u : 16u, godd = (h & 1) ? 0u : 16u;
    auto chunk_geom = [&](int ch, bool& isctx, int& sbase, int& T, size_t& rowbase) { isctx = ch < 8; sbase = isctx ? ch * 32 : (ch - 8) * 32; T = isctx ? CTX : SEQ;
        rowbase = isctx ? (size_t)NLAT + (size_t)b * CTX : (size_t)b * SEQ; };
    auto issue_loads = [&](int ch) { bool isctx; int sbase, T; size_t rowbase; chunk_geom(ch, isctx, sbase, T, rowbase);
#pragma unroll
        for (int j = 0; j < 8; ++j) { const int i = 8 * grp + j; const int t = dir ? (T - 1 - (sbase + i)) : (sbase + i); const size_t row = rowbase + t;
            const unsigned* qr = (const unsigned*)(QKV + row * 1536 + 128 * h + (idx & ~1)); rq[j] = qr[0]; rk[j] = qr[256]; rv[j] = qr[512]; nq[j] = NRM[row * 8 + h]; nk[j] = NRM[row * 8 + 4 + h]; }
        if (w == 7 && lane < 32) { const int t = dir ? (T - 1 - (sbase + lane)) : (sbase + lane); const unsigned* pr = (const unsigned*)(P + (rowbase + t) * PLD + RW_COLS + 2048 + ((dir * 4 + h) & ~1)); raw_al = pr[0]; raw_be = pr[4]; } };
    u32x2 ypend[2]; ypend[0].x = ypend[0].y = ypend[1].x = ypend[1].y = 0u;
    auto flush = [&](int pch) { bool pisctx; int psb, pT; size_t prb; chunk_geom(pch, pisctx, psb, pT, prb);
        if (!pisctx) {
#pragma unroll
            for (int tb = 0; tb < 2; ++tb) { const int tl = psb + tb * 16 + fr; const int t = dir ? (pT - 1 - tl) : tl;
                *(u32x2*)(ydir + ((size_t)b * SEQ + t) * D + 512 + 128 * h + 16 * w + 4 * fg) = ypend[tb]; } } };
    issue_loads(0);
    for (int ch = 0; ch < 72; ++ch) {
        bool isctx; int sbase, T; size_t rowbase; chunk_geom(ch, isctx, sbase, T, rowbase);
        __syncthreads();
        float qv[8], kv[8], vv[8], nqv[8], nkv[8];
#pragma unroll
        for (int j = 0; j < 8; ++j) { qv[j] = bfsel(rq[j], codd); kv[j] = bfsel(rk[j], codd); vv[j] = bfsel(rv[j], codd); nqv[j] = nq[j]; nkv[j] = nk[j]; }
        if (w == 7) {
            const float gi = (lane < 32) ? -Aexp * softplusf_(bfsel(raw_al, godd) + dtb) : 0.f;
            float cum = gi;
            cum += __builtin_bit_cast(float, __builtin_amdgcn_update_dpp(0, __builtin_bit_cast(int, cum), 0x111, 0xf, 0xf, true));
            cum += __builtin_bit_cast(float, __builtin_amdgcn_update_dpp(0, __builtin_bit_cast(int, cum), 0x112, 0xf, 0xf, true));
            cum += __builtin_bit_cast(float, __builtin_amdgcn_update_dpp(0, __builtin_bit_cast(int, cum), 0x114, 0xf, 0xf, true));
            cum += __builtin_bit_cast(float, __builtin_amdgcn_update_dpp(0, __builtin_bit_cast(int, cum), 0x118, 0xf, 0xf, true));
            const float r0 = rdlane(cum, 15);
            cum += (lane >= 16) ? r0 : 0.f;
            if (lane < 32) { SC[lane] = sigmoidf_(bfsel(raw_be, godd)); SC[32 + lane + 1] = cum; if (lane == 0) SC[32] = 0.f; }
        }
        asm volatile("" :: "v"(qv[0]), "v"(qv[1]), "v"(qv[2]), "v"(qv[3]), "v"(qv[4]), "v"(qv[5]), "v"(qv[6]), "v"(qv[7]), "v"(kv[0]), "v"(kv[1]), "v"(kv[2]), "v"(kv[3]), "v"(kv[4]), "v"(kv[5]), "v"(kv[6]), "v"(kv[7]),
                        "v"(vv[0]), "v"(vv[1]), "v"(vv[2]), "v"(vv[3]), "v"(vv[4]), "v"(vv[5]), "v"(vv[6]), "v"(vv[7]) : "memory");
        asm volatile("" :: "v"(nqv[0]), "v"(nqv[1]), "v"(nqv[2]), "v"(nqv[3]), "v"(nqv[4]), "v"(nqv[5]), "v"(nqv[6]), "v"(nqv[7]), "v"(nkv[0]), "v"(nkv[1]), "v"(nkv[2]), "v"(nkv[3]), "v"(nkv[4]), "v"(nkv[5]), "v"(nkv[6]), "v"(nkv[7]),
                        "v"(raw_al), "v"(raw_be) : "memory");
        if (ch > 0) flush(ch - 1);
        if (ch + 1 < 72) issue_loads(ch + 1);
        __syncthreads();
        {
            const int c = idx; const float gcC = SC[32 + 32];
            float bh[8], kh[8];
#pragma unroll
            for (int j = 0; j < 8; ++j) { const int i = 8 * grp + j;
                const float kn = kv[j] * nkv[j], qn = qv[j] * nqv[j];
                const float gm = SC[32 + i], gi = SC[32 + i + 1], be = SC[i];
                const unsigned p0 = cvtpk(kn, qn), p1 = cvtpk(kn * __expf(gm), qn * __expf(gi));
                *(LAS unsigned short*)(L + O_KT + i * S128 + c * 2) = (unsigned short)p0; *(LAS unsigned short*)(L + O_QT + i * S128 + c * 2) = (unsigned short)(p0 >> 16);
                *(LAS unsigned short*)(L + O_KKT + i * S128 + c * 2) = (unsigned short)p1; *(LAS unsigned short*)(L + O_RT + i * S128 + c * 2) = (unsigned short)(p1 >> 16);
                bh[j] = be * kn * __expf(gcC - gm); kh[j] = be * kn * __expf(gcC - gi); }
            u32x4 w4;
            w4.x = cvtpk(bh[0], bh[1]); w4.y = cvtpk(bh[2], bh[3]); w4.z = cvtpk(bh[4], bh[5]); w4.w = cvtpk(bh[6], bh[7]); *(LAS u32x4*)(L + O_BHT + c * S32 + grp * 16) = w4;
            w4.x = cvtpk(kh[0], kh[1]); w4.y = cvtpk(kh[2], kh[3]); w4.z = cvtpk(kh[4], kh[5]); w4.w = cvtpk(kh[6], kh[7]); *(LAS u32x4*)(L + O_KHT + c * S32 + grp * 16) = w4;
            w4.x = cvtpk(vv[0], vv[1]); w4.y = cvtpk(vv[2], vv[3]); w4.z = cvtpk(vv[4], vv[5]); w4.w = cvtpk(vv[6], vv[7]); *(LAS u32x4*)(L + O_VT + c * S32 + grp * 16) = w4;
        }
        __syncthreads();
        {
            const int isq = w >> 2, tb = (w >> 1) & 1, jb = w & 1;
            if (jb <= tb) {
                const f32x4 g4 = mm_tile<4>(L + O_KT + jb * 16 * S128, S128, L + (isq ? O_QT : O_KT) + tb * 16 * S128, S128, z4, lane);
                const int t = tb * 16 + fr;
                const float gt = SC[32 + t + isq];
                f32x4 m0, m1;
#pragma unroll
                for (int e = 0; e < 4; ++e) { const int j = jb * 16 + 4 * fg + e; const bool keep = isq ? (j <= t) : (j < t);
                    const float bj = SC[j] * g4[e];
                    m0[e] = keep ? bj * __expf(gt - SC[32 + j]) : 0.f;
                    m1[e] = keep ? bj * __expf(gt - SC[32 + j + 1]) : 0.f; }
                const int off = t * S32 + (jb * 16 + 4 * fg) * 2;
                if (isq) { st_bf16x4(L + O_NB + off, m0); st_bf16x4(L + O_NK + off, m1); }
                else {
                    st_bf16x4(L + O_MK + off, m1);
                    if (tb != jb) st_bf16x4(L + O_M21 + fr * S32 + fg * 8, m0);
                    else { float X[16]; tri_inv16(m0, lane, L + O_MS + tb * 1024, X);
                        if (lane < 16) {
#pragma unroll
                            for (int i = 0; i < 16; ++i) *(LAS unsigned short*)(L + O_TI + (tb * 16 + i) * S32 + (tb * 16 + lane) * 2) = (unsigned short)cvtpk(X[i], 0.f);
                            if (tb == 0) { u32x4 a0, a1;
                                a0.x = cvtpk(X[0], X[1]); a0.y = cvtpk(X[2], X[3]); a0.z = cvtpk(X[4], X[5]); a0.w = cvtpk(X[6], X[7]);
                                a1.x = cvtpk(X[8], X[9]); a1.y = cvtpk(X[10], X[11]); a1.z = cvtpk(X[12], X[13]); a1.w = cvtpk(X[14], X[15]);
                                *(LAS u32x4*)(L + O_T11T + lane * S32) = a0; *(LAS u32x4*)(L + O_T11T + lane * S32 + 16) = a1; }
                            else {
#pragma unroll
                                for (int i = 0; i < 16; ++i) *(LAS unsigned short*)(L + O_T22 + i * S32 + lane * 2) = (unsigned short)cvtpk(X[i], 0.f); }
                        } }
                }
            }
        }
        __syncthreads();
        if (w == 1) {
            const f32x4 x4 = mm_tile<1>(L + O_M21, S32, L + O_T11T, S32, z4, lane);
            st_bf16x4(L + O_XT + fr * S32 + fg * 8, x4);
            asm volatile("s_waitcnt lgkmcnt(0)" ::: "memory");
            const f32x4 t4 = mm_tile<1>(L + O_XT, S32, L + O_T22, S32, z4, lane);
            st_bf16x4(L + O_TI + (16 + fr) * S32 + fg * 8, -t4);
        }
        f32x4 yacc[2];
#pragma unroll
        for (int tb = 0; tb < 2; ++tb) {
            f32x4 u4 = mm_tile<4>(L + O_KKT + tb * 16 * S128, S128, L + O_SBF + 16 * w * S128, S128, z4, lane);
            u4 = mm_tile<1>(L + O_MK + tb * 16 * S32, S32, L + O_VT + 16 * w * S32, S32, u4, lane);
            st_bf16x4(L + O_UTT + (16 * w + fr) * S32 + tb * 32 + fg * 8, u4);
            yacc[tb] = mm_tile<4>(L + O_SBF + 16 * w * S128, S128, L + O_RT + tb * 16 * S128, S128, z4, lane);
            yacc[tb] = mm_tile<1>(L + O_VT + 16 * w * S32, S32, L + O_NK + tb * 16 * S32, S32, yacc[tb], lane);
        }
        __syncthreads();
#pragma unroll
        for (int tb = 0; tb < 2; ++tb) {
            const f32x4 u4 = mm_tile<1>(L + O_TI + tb * 16 * S32, S32, L + O_UTT + 16 * w * S32, S32, z4, lane);
            st_bf16x4(L + O_UT + (16 * w + fr) * S32 + tb * 32 + fg * 8, -u4);
        }
        __syncthreads();
        {
#pragma unroll
            for (int tb = 0; tb < 2; ++tb) {
                yacc[tb] = mm_tile<1>(L + O_UT + 16 * w * S32, S32, L + O_NB + tb * 16 * S32, S32, yacc[tb], lane);
                ypend[tb].x = cvtpk(yacc[tb][0], yacc[tb][1]); ypend[tb].y = cvtpk(yacc[tb][2], yacc[tb][3]);
            }
            const float wc = __expf(SC[32 + 32]);
#pragma unroll
            for (int vi = 0; vi < 8; ++vi) {
                f32x4 s4 = Sacc[vi] * wc;
                s4 = mm_tile<1>(L + O_KHT + 16 * w * S32, S32, L + O_VT + 16 * vi * S32, S32, s4, lane);
                s4 = mm_tile<1>(L + O_BHT + 16 * w * S32, S32, L + O_UT + 16 * vi * S32, S32, s4, lane);
                Sacc[vi] = s4;
                st_bf16x4(L + O_SBF + (16 * vi + fr) * S128 + (16 * w + 4 * fg) * 2, s4);
            }
        }
    }
    flush(71);
    __syncthreads();
}

__device__ __forceinline__ void unpack8(const u32x4 w, float (&f)[8]) { f[0] = bflo(w.x); f[1] = bfhi(w.x); f[2] = bflo(w.y); f[3] = bfhi(w.y); f[4] = bflo(w.z); f[5] = bfhi(w.z); f[6] = bflo(w.w); f[7] = bfhi(w.w); }
__device__ __forceinline__ void phase_p4(const Args& A, Ctx& C) {
    const bf16_t* P = WSP(bf16_t, WS_P);
    const bf16_t* yf = WSP(bf16_t, WS_YDIR); const bf16_t* yb = yf + (size_t)NLAT * D;
    const float* bon = WSP(float, WS_BON);
    bf16_t* ymix = WSP(bf16_t, WS_YMIX);
    lbyte* SGb = C.lds;
    lfloat* GO = (lfloat*)(C.lds + 8192);
    const int tid = C.tid, lane = C.lane, w = C.wave;
    const bf16_t* gupt = WSP(const bf16_t, WS_GUPT);
    const int fr = lane & 15, fg = lane >> 4;
    const int c8 = 8 * lane;
    float lnw[8], lnb[8], ong[8], muv[8];
#pragma unroll
    for (int e = 0; e < 8; ++e) { lnw[e] = A.in[I_LNW][c8 + e]; lnb[e] = A.in[I_LNB][c8 + e]; ong[e] = A.in[I_ONG][(c8 + e) & 127]; muv[e] = A.in[I_MU][1024 + c8 + e]; }
    const int tkA = tid >> 5, lA = 4 * (tid & 31);
    float muA[4];
#pragma unroll
    for (int e = 0; e < 4; ++e) muA[e] = A.in[I_MU][1792 + lA + e];
    const bool vup = (1024 + c8) < 1440;
    bf16x8 gq[4][4];
#pragma unroll
    for (int i = 0; i < 4; ++i)
#pragma unroll
        for (int ks = 0; ks < 4; ++ks) gq[i][ks] = *(const bf16x8*)(gupt + (size_t)(64 * w + 16 * i + fr) * 128 + ks * 32 + fg * 8);
    u32x2 pwA, swA;
    auto issueA = [&](int tile) { const int row = tile * 16 + tkA, t = row & (SEQ - 1); const bool ok = t < SEQ - 64;
        pwA = *(const u32x2*)(P + (size_t)row * PLD + 1792 + lA); swA = *(const u32x2*)(P + (size_t)(row + (ok ? 64 : 0)) * PLD + 1792 + lA); };
    if (C.bid < NLAT / 16) issueA(C.bid);
    for (int tile = C.bid; tile < NLAT / 16; tile += C.G) {
        const int row0 = tile * 16;
        u32x4 wyf[2], wyb[2], wpv[2], wsv[2], wof[2], wob[2], wz[2]; float bsv[2];
#pragma unroll
        for (int tt = 0; tt < 2; ++tt) {
            const int tk = 2 * w + tt, row = row0 + tk, t = row & (SEQ - 1);
            const bool okv = vup ? (t >= 64) : (t < SEQ - 64);
            wyf[tt] = *(const u32x4*)(yf + (size_t)row * D + c8); wyb[tt] = *(const u32x4*)(yb + (size_t)row * D + c8);
            wpv[tt] = *(const u32x4*)(P + (size_t)row * PLD + 1024 + c8); wsv[tt] = *(const u32x4*)(P + (size_t)(row + (okv ? (vup ? -64 : 64) : 0)) * PLD + 1024 + c8);
            wof[tt] = *(const u32x4*)(yf + (size_t)row * D + 512 + c8); wob[tt] = *(const u32x4*)(yb + (size_t)row * D + 512 + c8);
            wz[tt] = *(const u32x4*)(P + (size_t)row * PLD + RW_COLS + 1536 + c8);
            bsv[tt] = bon[(size_t)row * 8 + (lane >> 3)] + bon[((size_t)NLAT + row) * 8 + (lane >> 3)];
        }
        __syncthreads();
        {
            const int row = row0 + tkA, t = row & (SEQ - 1); const bool ok = t < SEQ - 64;
            const u32x2 pw = pwA, sw = swA;
            const float pv[4] = {bflo(pw.x), bfhi(pw.x), bflo(pw.y), bfhi(pw.y)}; const float sv[4] = {bflo(sw.x), bfhi(sw.x), bflo(sw.y), bfhi(sw.y)};
            float o[4];
#pragma unroll
            for (int e = 0; e < 4; ++e) o[e] = sigmoidf_(pv[e] + muA[e] * ((ok ? sv[e] : 0.f) - pv[e]));
            u32x2 ow; ow.x = cvtpk(o[0], o[1]); ow.y = cvtpk(o[2], o[3]); *(LAS u32x2*)(SGb + tkA * 288 + lA * 2) = ow;
        }
        if (tile + C.G < NLAT / 16) issueA(tile + C.G);
        __syncthreads();
#pragma unroll
        for (int i = 0; i < 4; ++i) { const int c0 = 64 * w + 16 * i; f32x4 acc = (f32x4){0.f, 0.f, 0.f, 0.f};
#pragma unroll
            for (int ks = 0; ks < 4; ++ks) { const bf16x8 a = *(const LAS bf16x8*)(SGb + fr * 288 + ks * 64 + fg * 16);
                acc = __builtin_amdgcn_mfma_f32_16x16x32_bf16(a, gq[i][ks], acc, 0, 0, 0); }
#pragma unroll
            for (int e = 0; e < 4; ++e) GO[(4 * fg + e) * 512 + c0 + fr] = acc[e]; }
        __syncthreads();
#pragma unroll
        for (int tt = 0; tt < 2; ++tt) {
            const int tk = 2 * w + tt, row = row0 + tk, t = row & (SEQ - 1);
            const bool okv = vup ? (t >= 64) : (t < SEQ - 64);
            const float bs = bsv[tt];
            const f32x4 g0 = *(const LAS f32x4*)(GO + tk * 512 + c8), g1 = *(const LAS f32x4*)(GO + tk * 512 + c8 + 4);
            const float gg[8] = {g0.x, g0.y, g0.z, g0.w, g1.x, g1.y, g1.z, g1.w};
            float a[8], bq[8], pv[8], sv[8], y[8];
            unpack8(wyf[tt], a); unpack8(wyb[tt], bq); unpack8(wpv[tt], pv); unpack8(wsv[tt], sv);
            float s1 = 0.f;
#pragma unroll
            for (int e = 0; e < 8; ++e) { y[e] = a[e] + bq[e]; s1 += y[e]; }
            s1 += __shfl_xor(s1, 1); s1 += __shfl_xor(s1, 2); s1 += __shfl_xor(s1, 4);
            const float m = s1 * (1.f / 64.f);
            float s2 = 0.f;
#pragma unroll
            for (int e = 0; e < 8; ++e) { y[e] -= m; s2 += y[e] * y[e]; }
            s2 += __shfl_xor(s2, 1); s2 += __shfl_xor(s2, 2); s2 += __shfl_xor(s2, 4);
            const float rs = __builtin_amdgcn_rsqf(s2 * (1.f / 64.f) + RWKV_EPS);
            float o[8];
#pragma unroll
            for (int e = 0; e < 8; ++e) { const float vv = pv[e] + muv[e] * ((okv ? sv[e] : 0.f) - pv[e]); o[e] = (y[e] * rs * lnw[e] + lnb[e] + bs * vv) * gg[e]; }
            u32x4 ow; ow.x = cvtpk(o[0], o[1]); ow.y = cvtpk(o[2], o[3]); ow.z = cvtpk(o[4], o[5]); ow.w = cvtpk(o[6], o[7]);
            *(u32x4*)(ymix + (size_t)row * D + c8) = ow;
            float of[8], ob[8], z[8];
            unpack8(wof[tt], of); unpack8(wob[tt], ob); unpack8(wz[tt], z);
            float s3 = 0.f;
#pragma unroll
            for (int e = 0; e < 8; ++e) { of[e] += ob[e]; s3 += of[e] * of[e]; }
            s3 += __shfl_xor(s3, 1); s3 += __shfl_xor(s3, 2); s3 += __shfl_xor(s3, 4); s3 += __shfl_xor(s3, 8);
            const float rg = __builtin_amdgcn_rsqf(s3 * (1.f / 128.f) + NORM_EPS);
#pragma unroll
            for (int e = 0; e < 8; ++e) o[e] = of[e] * rg * ong[e] * siluf_(z[e]);
            ow.x = cvtpk(o[0], o[1]); ow.y = cvtpk(o[2], o[3]); ow.z = cvtpk(o[4], o[5]); ow.w = cvtpk(o[6], o[7]);
            *(u32x4*)(ymix + (size_t)row * D + 512 + c8) = ow;
        }
    }
}

__device__ __forceinline__ void convert_experts(const Args& A, Ctx& C) {
    lfloat* scr = (lfloat*)(C.lds + C.wave * 16384);
    const int gw = C.bid * 8 + C.wave, NGW = C.G * 8;
    constexpr int I13 = (D / 128) * (DE / 32);
    constexpr int I2 = (DE / 128) * (D / 32);
    constexpr int PER = 2 * I13 + I2;
    for (int it = gw; it < 257 * PER; it += NGW) {
        const int e = it / PER; int r = it % PER;
        unsigned char* bt13 = A.ws + WS_WEXP + (size_t)e * WEXP_STRIDE; unsigned char* bt2 = bt13 + 512 * 1024;
        const float* w1 = e < NE ? A.in[I_EW1] + (size_t)e * D * DE : A.in[I_SW1];
        const float* w3 = e < NE ? A.in[I_EW3] + (size_t)e * D * DE : A.in[I_SW3];
        const float* w2 = e < NE ? A.in[I_EW2] + (size_t)e * DE * D : A.in[I_SW2];
        if (r < I13) { transpose_pair_fp8(w1, D, DE, bt13, RowGLU{0}, SW13, scr, r, C.lane); continue; } r -= I13;
        if (r < I13) { transpose_pair_fp8(w3, D, DE, bt13, RowGLU{128}, SW13, scr, r, C.lane); continue; } r -= I13;
        transpose_pair_fp8(w2, DE, D, bt2, RowId(), SW2, scr, r, C.lane);
    }
}

__device__ __forceinline__ void phase_p6(const Args& A, Ctx& C) {
    const float* mod = WSP(float, WS_MOD); bf16_t* h2n = WSP(bf16_t, WS_H2N);
    const int gw = C.bid * 8 + C.wave, NGW = C.G * 8;
    for (int row = gw; row < NLAT; row += NGW) {
        const float* m = mod + (size_t)(row >> 11) * MODW;
        norm_mod_row(A.out + (size_t)row * D, A.in[I_N2G], m + 4 * D, m + 3 * D, h2n + (size_t)row * D, C.lane, (unsigned*)(A.ws + WS_H2N8) + (size_t)row * (D / 4));
    }
}

__device__ __forceinline__ void phase_p8(const Args& A, Ctx& C) {
    const float* logit = WSP(float, WS_LOGIT);
    int* tope = WSP(int, WS_TOPE); float* topw = WSP(float, WS_TOPW); int* pos = WSP(int, WS_POS);
    unsigned* cnt = WSP(unsigned, WS_CTL) + CW_CNT;
    const int lane = C.lane;
    const f32x4 rb = ((const f32x4*)A.in[I_RB])[lane];
    LAS unsigned* hist = (LAS unsigned*)C.lds;
    LAS unsigned* base = hist + 256;
    LAS unsigned* lpe = base + 256;
    for (int blk = C.bid; blk < NLAT / 256; blk += C.G) {
    __syncthreads();
    if (C.tid < 256) hist[C.tid] = 0u;
    __syncthreads();
    f32x4 nlg = ((const f32x4*)(logit + (size_t)(blk * 256 + C.wave * 32) * NE))[lane];
    for (int ti = 0; ti < 32; ++ti) {
        const int tl = C.wave * 32 + ti, tok = blk * 256 + tl;
        const f32x4 lg = nlg;
        if (ti + 1 < 32) nlg = ((const f32x4*)(logit + (size_t)(tok + 1) * NE))[lane];
        float s[4], sel[4];
#pragma unroll
        for (int i = 0; i < 4; ++i) { s[i] = sigmoidf_(lg[i]); sel[i] = s[i] + rb[i]; }
        float m1 = fmaxf(fmaxf(sel[0], sel[1]), fmaxf(sel[2], sel[3]));
        float m2;
        {
            float a = fmaxf(sel[0], sel[1]), bq = fminf(sel[0], sel[1]), cq = fmaxf(sel[2], sel[3]), dq = fminf(sel[2], sel[3]);
            m2 = fmaxf(fminf(a, cq), fmaxf(bq, dq)); }
#define P8_MERGE(CTRL) { const float o1 = dpp_f<CTRL>(m1), o2 = dpp_f<CTRL>(m2); const float n1 = fmaxf(m1, o1); const float n2 = fmaxf(fminf(m1, o1), fmaxf(m2, o2)); m1 = n1; m2 = n2; }
        P8_MERGE(0xB1) P8_MERGE(0x4E) P8_MERGE(0x141)
#undef P8_MERGE
        const float gs = m1 + m2;
        const int grp = lane >> 3;
        int rank = 0;
#pragma unroll
        for (int gq = 0; gq < 8; ++gq) { const float og = __shfl(gs, gq * 8); rank += (og > gs || (og == gs && gq < grp)) ? 1 : 0; }
        const bool gsel = rank < 4;
        float cand[4];
#pragma unroll
        for (int i = 0; i < 4; ++i) cand[i] = gsel ? sel[i] : -INFINITY;
        int my_e = 0; float my_w = 0.f; float wsum = 0.f;
#pragma unroll
        for (int r = 0; r < 8; ++r) {
            float bv = cand[0]; int bi = 0;
#pragma unroll
            for (int i = 1; i < 4; ++i) if (cand[i] > bv) { bv = cand[i]; bi = i; }
            float wm = bv;
            wm = fmaxf(wm, dpp_f<0x128>(wm)); wm = fmaxf(wm, dpp_f<0x124>(wm)); wm = fmaxf(wm, dpp_f<0x122>(wm)); wm = fmaxf(wm, dpp_f<0x121>(wm));
            const float gv = fmaxf(fmaxf(rdlane(wm, 0), rdlane(wm, 16)), fmaxf(rdlane(wm, 32), rdlane(wm, 48)));
            const unsigned long long bal = __ballot(bv == gv);
            const int ol = __builtin_amdgcn_readfirstlane((int)__builtin_ctzll(bal));
            const int oi = __builtin_amdgcn_readlane(bi, ol);
            const int be = ol * 4 + oi;
            const float mys = oi == 0 ? s[0] : (oi == 1 ? s[1] : (oi == 2 ? s[2] : s[3]));
            const float ws_ = rdlane(mys, ol);
            const bool mine = lane == ol;
#pragma unroll
            for (int i = 0; i < 4; ++i) cand[i] = (mine && oi == i) ? -INFINITY : cand[i];
            wsum += ws_;
            if (lane == r) { my_e = be; my_w = ws_; }
        }
        if (lane < 8) {
            const float w = my_w / wsum * 2.5f;
            const unsigned lp = __hip_atomic_fetch_add(hist + my_e, 1u, __ATOMIC_RELAXED, __HIP_MEMORY_SCOPE_WORKGROUP);
            tope[(size_t)tok * 8 + lane] = my_e; topw[(size_t)tok * 8 + lane] = w; lpe[tl * 8 + lane] = ((unsigned)my_e << 16) | lp;
        }
    }
    __syncthreads();
    if (C.tid < 256) { const unsigned c = hist[C.tid]; base[C.tid] = c ? atomicAdd(cnt + C.tid * CNT_STRIDE, c) : 0u; }
    __syncthreads();
    for (int i = C.tid; i < 2048; i += 512) { const unsigned v = lpe[i]; pos[(size_t)blk * 2048 + i] = (int)(base[v >> 16] + (v & 0xffffu)); }
    }
}

__device__ __forceinline__ void tile_prefix(const Args& A, Ctx& C, LAS int* tb) {
    const unsigned* cnt = WSP(unsigned, WS_CTL) + CW_CNT;
    int v = 0;
    if (C.tid < NE) v = ((int)cnt[C.tid * CNT_STRIDE] + 255) >> 8;
#pragma unroll
    for (int d = 1; d < 64; d <<= 1) { const int t = __shfl_up(v, d); if (C.lane >= d) v += t; }
    if (C.tid < NE && C.lane == 63) tb[260 + C.wave] = v;
    __syncthreads();
    if (C.tid < NE) { int off = 0;
#pragma unroll
        for (int q = 0; q < 3; ++q) off += (q < C.wave) ? tb[260 + q] : 0;
        tb[C.tid + 1] = off + v; if (C.tid == 0) tb[0] = 0; }
    __syncthreads();
}
__device__ __forceinline__ void phase_p9(const Args& A, Ctx& C) {
    LAS int* tb = (LAS int*)C.lds;
    tile_prefix(A, C, tb);
    const unsigned* cnt = WSP(unsigned, WS_CTL) + CW_CNT;
    const int* tope = WSP(int, WS_TOPE); const float* topw = WSP(float, WS_TOPW); const int* pos = WSP(int, WS_POS);
    int* rowl = WSP(int, WS_ROWL); float* roww = WSP(float, WS_ROWW); int* tile_e = WSP(int, WS_TILEE);
    const int nrt = tb[NE];
    for (int i = C.bid * 512 + C.tid; i < NLAT * 8; i += C.G * 512) { const int e = tope[i]; const int pr = tb[e] * 256 + pos[i]; rowl[pr] = i; roww[pr] = topw[i]; }
    for (int e = C.bid; e < NE; e += C.G) { const int n = (int)cnt[e * CNT_STRIDE], nt = tb[e + 1] - tb[e];
        for (int j = n + C.tid; j < nt * 256; j += 512) { rowl[tb[e] * 256 + j] = -1; roww[tb[e] * 256 + j] = 0.f; }
        for (int k = C.tid; k < nt; k += 512) tile_e[tb[e] + k] = e; }
    for (int i = C.bid * 512 + C.tid; i < NLAT; i += C.G * 512) { rowl[nrt * 256 + i] = i; roww[nrt * 256 + i] = 1.f; }
    for (int k = C.bid * 512 + C.tid; k < NLAT / 256; k += C.G * 512) tile_e[nrt + k] = NE;
    __syncthreads();
}

__device__ __forceinline__ void phase_moe(const Args& A, Ctx& C, int dry_shared) {
    LAS int* tb = (LAS int*)(C.lds + 131072);
    LAS int* tbl = tb + 320;
    tile_prefix(A, C, tb);
    pg8::MoeCtx M;
    M.nrt = tb[NE]; M.ntiles = M.nrt + NLAT / 256; M.G = C.G; M.vc = (C.G % 8 == 0) ? (C.bid % 8) * (C.G / 8) + C.bid / 8 : C.bid;
    M.tb = tb; M.tbl = tbl; M.cnt = WSP(unsigned, WS_CTL) + CW_CNT; M.rowl = WSP(int, WS_ROWL); M.roww = WSP(float, WS_ROWW);
    M.wexp = (const char*)(A.ws + WS_WEXP); M.h2n = (const char*)(A.ws + WS_H2N8); M.Hs = (char*)(A.ws + WS_HS) + (size_t)C.bid * 2 * 65536;
    M.Y = (unsigned char*)(A.ws + WS_Y); M.out = A.out; M.mod = WSP(const float, WS_MOD); M.dry_shared = dry_shared;
    pg8::gemm_moe(C.lds, M);
    __syncthreads();
}

__device__ __forceinline__ void phase_final(const Args& A, Ctx& C, float* dst) {
    const int gw = C.bid * 8 + C.wave, NGW = C.G * 8;
    const float* fg = A.in[I_FG]; const float* mod = WSP(const float, WS_MOD);
    const unsigned* Y = (const unsigned*)(A.ws + WS_Y);
    for (int row = gw; row < NLAT; row += NGW) {
        f32x4* xr = (f32x4*)(A.out + (size_t)row * D) + C.lane;
        const f32x4* gt = (const f32x4*)(mod + (size_t)(row >> 11) * MODW + 5 * D) + C.lane;
        const unsigned* yr = Y + (size_t)row * 8 * (D / 4) + C.lane;
        f32x4 v[4]; float s = 0.f;
#pragma unroll
        for (int j = 0; j < 4; ++j) {
            f32x4 a = (f32x4){0.f, 0.f, 0.f, 0.f};
#pragma unroll
            for (int sl = 0; sl < 8; ++sl) { const unsigned w = yr[sl * (D / 4) + 64 * j];
                const f32x2 lo = __builtin_amdgcn_cvt_pk_f32_fp8(w, false), hi = __builtin_amdgcn_cvt_pk_f32_fp8(w, true);
                a.x += lo.x; a.y += lo.y; a.z += hi.x; a.w += hi.y; }
            v[j] = xr[64 * j] + gt[64 * j] * a * (1.f / pg8::YSCALE);
            s += (v[j].x * v[j].x + v[j].y * v[j].y) + (v[j].z * v[j].z + v[j].w * v[j].w); }
        const float rstd = __builtin_amdgcn_rsqf(wave_sum(s) * (1.f / D) + NORM_EPS);
        f32x4* orow = (f32x4*)(dst + (size_t)row * D) + C.lane;
#pragma unroll
        for (int j = 0; j < 4; ++j) orow[64 * j] = v[j] * rstd * ((const f32x4*)fg)[C.lane + 64 * j];
    }
}

constexpr int NPHASE = 13;
__global__ void __launch_bounds__(512, 2) fwd_kernel(Args A) {
    extern __shared__ __attribute__((aligned(16))) unsigned char lds_raw[];
    Ctx C; C.lds = (lbyte*)lds_raw; C.tid = threadIdx.x; C.lane = C.tid & 63; C.wave = __builtin_amdgcn_readfirstlane(C.tid >> 6);
    C.G = gridDim.x; C.bid = blockIdx.x; C.a = &A;
    volatile LAS unsigned* misc = (volatile LAS unsigned*)(C.lds + LDS_MISC);
    if (C.tid < 16) misc[C.tid] = 0u;
    __syncthreads();
    XcdBarrier bar; bar.bar = WSP(unsigned, WS_CTL) + CW_BAR; bar.x = 0; bar.st = nullptr;
    const int lo = A.ph_lo, hi = A.ph_hi;
    const bool multi = (hi - lo) > 1;
    if (multi) bar = xcd_barrier_post(WSP(unsigned, WS_CTL) + CW_BAR, misc);
#ifndef PHASE_MASK
#define PHASE_MASK 0x1FFF
#endif
#define IN(k) (((PHASE_MASK >> (k)) & 1) && lo <= (k) && (k) < hi)
#define SEAM(k) do { if (IN(k) && IN((k) + 1)) xcd_barrier(bar); } while (0)
#ifndef REP_MASK
#define REP_MASK 0
#endif
#define REPS(k) (((REP_MASK >> (k)) & 1) ? 2 : 1)

    if (IN(0)) _Pragma("unroll") for (int rep = 0; rep < REPS(0); ++rep) { phase_p0(A, C); __syncthreads(); } SEAM(0);
    if (IN(1)) _Pragma("unroll") for (int rep = 0; rep < REPS(1); ++rep) { phase_p1(A, C); } SEAM(1);
    if (IN(2)) _Pragma("unroll") for (int rep = 0; rep < REPS(2); ++rep) {
        pg8::Gemm g{WSP(bf16_t, WS_XN), D}; pg8::StaticOrder S; S.init(NROWS, PLD, C.G, C.bid, WSP(bf16_t, WS_BTIN), D, 1);
        pg8::EpiBf16 E{WSP(bf16_t, WS_P), PLD, 1.f / SWIN};
        pg8::gemm_phase<pg8::EpiBf16, pg8::StaticOrder, false, 0, false, true>(C.lds, g, S, E);
    } SEAM(2);
    if (IN(3)) _Pragma("unroll") for (int rep = 0; rep < REPS(3); ++rep) { phase_gdn_prep(A, C); } SEAM(3);
#ifdef PROBE_BARRIERS
    if (multi) for (int kq = 0; kq < PROBE_BARRIERS; ++kq) xcd_barrier(bar);
#endif
    if (IN(4)) {
        for (int ch = C.bid; ch < NB * HB * 2; ch += C.G) gdn_chain_chunked(A, C, ch);
        for (int pr = C.bid; pr < NB * HA; pr += C.G) rwkv_pair_chunked(A, C, pr);
    } SEAM(4);
    if (IN(5)) _Pragma("unroll") for (int rep = 0; rep < REPS(5); ++rep) { phase_p4(A, C); } SEAM(5);
    if (IN(6)) _Pragma("unroll") for (int rep = 0; rep < REPS(6); ++rep) {
        pg8::Gemm g{WSP(bf16_t, WS_YMIX), D}; pg8::StaticOrder S; S.init(NLAT, D, C.G, C.bid, WSP(bf16_t, WS_BTOUT), D);
        pg8::EpiResGate E{A.in[I_X], A.out, WSP(float, WS_MOD), 2 * D};
        pg8::gemm_phase<pg8::EpiResGate, pg8::StaticOrder, false>(C.lds, g, S, E);
    } SEAM(6);
    if (IN(7)) _Pragma("unroll") for (int rep = 0; rep < REPS(7); ++rep) { phase_p6(A, C); __syncthreads(); convert_experts(A, C); __syncthreads(); } SEAM(7);
    if (IN(8)) _Pragma("unroll") for (int rep = 0; rep < REPS(8); ++rep) {
        pg8::Gemm g{WSP(bf16_t, WS_H2N), D}; pg8::StaticOrder S; S.init(NLAT, NE, C.G, C.bid, WSP(bf16_t, WS_BTR), D);
        pg8::EpiF32 E{WSP(float, WS_LOGIT), NE};
        pg8::gemm_phase<pg8::EpiF32, pg8::StaticOrder, false>(C.lds, g, S, E);
    } SEAM(8);
    if (IN(9)) { phase_p8(A, C); } SEAM(9);
    if (IN(10)) _Pragma("unroll") for (int rep = 0; rep < REPS(10); ++rep) { phase_p9(A, C); } SEAM(10);
    if (IN(11)) { phase_moe(A, C, 0); if (REPS(11) > 1) { __syncthreads(); phase_moe(A, C, 1); } } SEAM(11);
    if (IN(12)) { if (REPS(12) > 1) { phase_final(A, C, (float*)(A.ws + WS_WEXP)); __syncthreads(); } phase_final(A, C, A.out); }
#undef IN
#undef SEAM
}

extern "C" void kernel_launch(void* const* d_in, const int* in_sizes, int n_in, void* d_out, int out_size, void* d_ws, size_t ws_size, hipStream_t stream) {
    static int grid = 0;
    if (grid == 0) {
        if (n_in != 34 || out_size != NLAT * D || ws_size < WS_END) { fprintf(stderr, "kernel_launch: unexpected shapes (n_in %d out %d ws %zu need %zu)\n", n_in, out_size, ws_size, (size_t)WS_END); grid = -1; return; }
        int dev = 0, cus = 0;
        if (hipGetDevice(&dev) != hipSuccess || hipDeviceGetAttribute(&cus, hipDeviceAttributeMultiprocessorCount, dev) != hipSuccess) { grid = -1; return; }
        if (hipFuncSetAttribute((const void*)fwd_kernel, hipFuncAttributeMaxDynamicSharedMemorySize, LDS_BYTES) != hipSuccess) { fprintf(stderr, "kernel_launch: hipFuncSetAttribute failed\n"); grid = -1; return; }
        int per_cu = 0;
        if (hipOccupancyMaxActiveBlocksPerMultiprocessor(&per_cu, (const void*)fwd_kernel, 512, LDS_BYTES) != hipSuccess || per_cu < 1) { fprintf(stderr, "kernel_launch: occupancy query says %d\n", per_cu); }
        (void)hipGetLastError();
        grid = cus;
    }
    if (grid < 0) return;
    (void)hipMemsetAsync((char*)d_ws + WS_CTL, 0, CTL_BYTES, stream);
    Args a{};
    for (int i = 0; i < 34; ++i) a.in[i] = (const float*)d_in[i];
    a.out = (float*)d_out; a.ws = (unsigned char*)d_ws;
#if MK_PER_PHASE
    for (int p = 0; p < NPHASE; ++p) { a.ph_lo = p; a.ph_hi = p + 1; hipLaunchKernelGGL(fwd_kernel, dim3(grid), dim3(512), LDS_BYTES, stream, a); }
#else
    a.ph_lo = 0; a.ph_hi = NPHASE; hipLaunchKernelGGL(fwd_kernel, dim3(grid), dim3(512), LDS_BYTES, stream, a);
#endif
}
```

```cpp
#include <hip/hip_runtime.h>
#include <cstdio>
#include <cstdint>

#ifndef MK_PER_PHASE
#define MK_PER_PHASE 0
#endif

#define LAS __attribute__((address_space(3)))
typedef unsigned short bf16_t;
typedef short bf16x8 __attribute__((ext_vector_type(8)));
typedef float f32x4 __attribute__((ext_vector_type(4)));
typedef float f32x2 __attribute__((ext_vector_type(2)));
typedef unsigned u32x4 __attribute__((ext_vector_type(4)));
typedef unsigned u32x2 __attribute__((ext_vector_type(2)));
typedef int i32x4 __attribute__((ext_vector_type(4)));
typedef int i32x8 __attribute__((ext_vector_type(8)));
typedef LAS float lfloat;
typedef LAS unsigned char lbyte;

constexpr int D = 1024, NB = 32, SEQ = 2048, CTX = 256, GW = 64;
constexpr int NLAT = NB * SEQ;
constexpr int NCTX = NB * CTX;
constexpr int NROWS = NLAT + NCTX;
constexpr int DA = 512, HA = 8, NA = 64;
constexpr int RW_COLS = 1920, GD_COLS = 2064, IN_COLS = 3984, PLD = 4096;
constexpr int DB = 512, HB = 4, KB = 128;
constexpr int NE = 256, TOPK = 8, DE = 256;
constexpr int MODW = 6 * D;
constexpr float NORM_EPS = 1e-6f, RWKV_EPS = 64e-5f;
constexpr int MAXTILES = (NLAT * TOPK + NE * 255) / 256 + 1;

constexpr size_t MiB = 1u << 20;
constexpr size_t WS_CTL = 0, CTL_BYTES = 1 * MiB;
constexpr size_t WS_MOD = 1 * MiB;
constexpr size_t WS_BTIN = 2 * MiB, WS_BTOUT = 10 * MiB, WS_BTR = 12 * MiB, WS_BON = 13 * MiB, WS_GUPT = 17 * MiB, WS_NRM = 978 * MiB;
constexpr size_t WS_P = 18 * MiB, WS_XN = 594 * MiB, WS_YDIR = 594 * MiB, WS_YMIX = 850 * MiB;
constexpr size_t WS_H2N8 = 900 * MiB;
constexpr size_t WS_H2N = 18 * MiB, WS_LOGIT = 146 * MiB, WS_TOPE = 210 * MiB, WS_TOPW = 212 * MiB, WS_POS = 214 * MiB, WS_Y = 146 * MiB;
constexpr size_t WS_ROWL = 658 * MiB, WS_ROWW = 661 * MiB, WS_TILEE = 664 * MiB, WS_HS = 672 * MiB, WS_WEXP = 704 * MiB;
constexpr size_t WEXP_STRIDE = (size_t)(512 * 1024 + 1024 * 256);
constexpr float SW13 = 64.f, SW2 = 32.f, SHS = 8.f, SWIN = 32.f;
constexpr size_t WS_END = 1090 * MiB;
static_assert(WS_WEXP + 257 * WEXP_STRIDE <= WS_END && WS_Y + (size_t)NLAT * 8 * D <= WS_ROWL, "ws map");
constexpr int CW_BAR = 4096;
constexpr int CW_CNT = 16384;
constexpr int CNT_STRIDE = 32;

constexpr int LDS_BYTES = 159744;
constexpr int LDS_MISC = LDS_BYTES - 64;

__device__ __forceinline__ unsigned f2bf(float f) { unsigned u = __builtin_bit_cast(unsigned, f); return (u + 0x7fffu + ((u >> 16) & 1u)) >> 16; }
typedef __bf16 bf16x2_t __attribute__((ext_vector_type(2)));
__device__ __forceinline__ unsigned cvtpk(float lo, float hi) { f32x2 v = {lo, hi}; return __builtin_bit_cast(unsigned, __builtin_convertvector(v, bf16x2_t)); }
__device__ __forceinline__ unsigned pk2(float lo, float hi) { return cvtpk(lo, hi); }
__device__ __forceinline__ unsigned pk4_fp8(float a, float b, float c, float d) { unsigned w = 0u;
    w = __builtin_amdgcn_cvt_pk_fp8_f32(__builtin_amdgcn_fmed3f(a, -448.f, 448.f), __builtin_amdgcn_fmed3f(b, -448.f, 448.f), w, false);
    w = __builtin_amdgcn_cvt_pk_fp8_f32(__builtin_amdgcn_fmed3f(c, -448.f, 448.f), __builtin_amdgcn_fmed3f(d, -448.f, 448.f), w, true); return w; }
__device__ __forceinline__ float bf2f(unsigned short b) { return __builtin_bit_cast(float, ((unsigned)b) << 16); }
__device__ __forceinline__ float bflo(unsigned w) { return __builtin_bit_cast(float, w << 16); }
__device__ __forceinline__ float bfhi(unsigned w) { return __builtin_bit_cast(float, w & 0xffff0000u); }
template <int CTRL> __device__ __forceinline__ float dpp_f(float v) { return __builtin_bit_cast(float, __builtin_amdgcn_update_dpp(0, __builtin_bit_cast(int, v), CTRL, 0xf, 0xf, false)); }
__device__ __forceinline__ float wave_sum(float v) {
    v += dpp_f<0x128>(v);
    v += dpp_f<0x124>(v);
    v += dpp_f<0x122>(v);
    v += dpp_f<0x121>(v);
    const int vi = __builtin_bit_cast(int, v);
    const float r0 = __builtin_bit_cast(float, __builtin_amdgcn_readlane(vi, 0)), r1 = __builtin_bit_cast(float, __builtin_amdgcn_readlane(vi, 16)),
                r2 = __builtin_bit_cast(float, __builtin_amdgcn_readlane(vi, 32)), r3 = __builtin_bit_cast(float, __builtin_amdgcn_readlane(vi, 48));
    return (r0 + r1) + (r2 + r3);
}
__device__ __forceinline__ float sigmoidf_(float x) { return __builtin_amdgcn_rcpf(1.f + __expf(-x)); }
__device__ __forceinline__ float siluf_(float x) { return x * __builtin_amdgcn_rcpf(1.f + __expf(-x)); }
__device__ __forceinline__ float softplusf_(float x) { return fmaxf(x, 0.f) + __logf(1.f + __expf(-fabsf(x))); }
__device__ __forceinline__ float tanhf_(float x) { const float e = __expf(-2.f * fabsf(x)); const float t = (1.f - e) * __builtin_amdgcn_rcpf(1.f + e); return x < 0.f ? -t : t; }

#define XB_TMO      128
#define XB_XCNT(j)  (256  + 64 * (j))
#define XB_XSUB(j)  (1280 + 64 * (j))
#define XB_XGEN(j)  (2304 + 64 * (j))
#define XB_TOP      3328
#define XB_TOPGEN   3392
#define XCD_BAR_WORDS 3456
#define XB_SPIN_CAP (1u << 22)
__device__ __forceinline__ unsigned xb_ld(unsigned* p)              { return __hip_atomic_load(p, __ATOMIC_RELAXED, __HIP_MEMORY_SCOPE_AGENT); }
__device__ __forceinline__ unsigned xb_add(unsigned* p, unsigned v) { return __hip_atomic_fetch_add(p, v, __ATOMIC_RELAXED, __HIP_MEMORY_SCOPE_AGENT); }
__device__ __forceinline__ unsigned xb_xcc_id() { return (unsigned)__builtin_amdgcn_s_getreg((3 << 11) | 20) & 0xFu; }
#define XB_SPIN(cond, bar) do { unsigned _sp = 0; while (cond) { __builtin_amdgcn_s_sleep(1); \
    if ((++_sp & 255u) == 0u) { if (xb_ld(&(bar)[XB_TMO])) break; if (_sp > XB_SPIN_CAP) { atomicAdd(&(bar)[XB_TMO], 1u); break; } } } } while (0)
struct XcdBarrier { unsigned* bar; unsigned x; volatile LAS unsigned* st; };
__device__ __forceinline__ XcdBarrier xcd_barrier_post(unsigned* bar, volatile LAS unsigned* st) {
    XcdBarrier b; b.bar = bar; b.x = xb_xcc_id(); b.st = st;
    if (threadIdx.x == 0) (void)xb_add(&bar[XB_XCNT(b.x)], 1u);
    return b;
}
__device__ __forceinline__ void xcd_barrier_complete(unsigned* bar, unsigned x, unsigned& nloc, unsigned& nx) {
    const unsigned G = gridDim.x * gridDim.y * gridDim.z;
    unsigned sum, cnt, mine, sp = 0u;
    for (;;) {
        sum = 0u; cnt = 0u; mine = 0u;
#pragma unroll
        for (unsigned j = 0; j < 16; ++j) { const unsigned c = xb_ld(&bar[XB_XCNT(j)]); sum += c; cnt += (c > 0u) ? 1u : 0u; mine = (j == x) ? c : mine; }
        if (sum == G) break;
        __builtin_amdgcn_s_sleep(1);
        if ((++sp & 255u) == 0u) { if (xb_ld(&bar[XB_TMO])) break; if (sp > XB_SPIN_CAP) { atomicAdd(&bar[XB_TMO], 1u); break; } }
    }
    nloc = mine > 0u ? mine : 1u; nx = cnt > 0u ? cnt : 1u;
}
__device__ __forceinline__ void xcd_barrier(const XcdBarrier& b) {
    asm volatile("s_waitcnt vmcnt(0)" ::: "memory");
    __syncthreads();
    if (threadIdx.x == 0) {
        unsigned* bar = b.bar;
        __builtin_amdgcn_s_waitcnt(0);
        unsigned nloc = b.st[0], nx = b.st[1];
        if (nloc == 0u) { xcd_barrier_complete(bar, b.x, nloc, nx); b.st[0] = nloc; b.st[1] = nx; }
        const unsigned old = xb_add(&bar[XB_XSUB(b.x)], 1u);
        const unsigned gen = old / nloc;
        if (old + 1u == (gen + 1u) * nloc) {
            __builtin_amdgcn_fence(__ATOMIC_RELEASE, "agent");
            asm volatile("s_waitcnt vmcnt(0)" ::: "memory");
            const unsigned og = xb_add(&bar[XB_TOP], 1u);
            const unsigned tg = og / nx;
            if (og + 1u == (tg + 1u) * nx) xb_add(&bar[XB_TOPGEN], 1u);
            else XB_SPIN(xb_ld(&bar[XB_TOPGEN]) == tg, bar);
            __builtin_amdgcn_fence(__ATOMIC_ACQUIRE, "agent");
            xb_add(&bar[XB_XGEN(b.x)], 1u);
            asm volatile("s_waitcnt vmcnt(0)" ::: "memory");
        } else {
            XB_SPIN(xb_ld(&bar[XB_XGEN(b.x)]) == gen, bar);
            __builtin_amdgcn_fence(__ATOMIC_ACQUIRE, "agent");
            asm volatile("s_waitcnt vmcnt(0)" ::: "memory");
        }
    }
    __syncthreads();
}

struct Args {
    const float* in[34];
    float* out;
    unsigned char* ws;
    int ph_lo, ph_hi;
};
enum { I_X = 0, I_C, I_CTX, I_CCTX, I_WADA, I_BADA, I_N1G, I_WIN, I_MU, I_W0, I_WUP, I_A0, I_AUP, I_GUP, I_KK, I_KA, I_RK, I_LNW, I_LNB,
       I_CONVW, I_ALOG, I_DTB, I_ONG, I_WOUT, I_N2G, I_RW, I_RB, I_EW1, I_EW3, I_EW2, I_SW1, I_SW3, I_SW2, I_FG };

namespace pg8 {
constexpr int BM = 256, BK = 64, HALF = 128, HTB = HALF * BK * 2, STAGE_BYTES = 8 * HTB, NXCD = 8, WGM = 8;
__host__ __device__ __forceinline__ int lds_byte(int r, int c) { const int st = (r >> 4) * 2 + (c >> 5), rr = r & 15, cc = c & 31, ob = rr * 64 + cc * 2; return st * 1024 + (ob ^ (((ob >> 9) & 1) << 5)); }
__host__ __device__ __forceinline__ void stage_rc(int b, int& R, int& C) { const int st = b / 1024, sb = b % 1024, swz = sb ^ (((sb >> 9) & 1) << 5); R = (st >> 1) * 16 + swz / 64; C = (st & 1) * 32 + (swz % 64) / 2; }
__host__ __device__ __forceinline__ int perm32(int rho) { const int n = rho >> 4, i = rho & 15; return 8 * (i >> 2) + 4 * n + (i & 3); }
struct Unit { int pm, pn; };
struct Gemm { const bf16_t* A; int K; };
struct StaticOrder {
    int nM, nN, nwg, G, c; const char* Bt; size_t tstepB;
    __device__ void init(int M, int N, int G_, int c_, const void* Bt_, int K, int es = 2) { nM = M / BM; nN = N / BM; nwg = nM * nN; G = G_; c = c_; Bt = (const char*)Bt_; tstepB = (size_t)BM * K * es; }
    __device__ bool next(int i, Unit& u) const {
        const long L = (long)i * G + c; if (L >= nwg) return false;
        int wgid = (int)L; { const int q = nwg / NXCD, r = nwg % NXCD, xcd = wgid % NXCD, off = wgid / NXCD; wgid = (xcd < r ? xcd * (q + 1) : r * (q + 1) + (xcd - r) * q) + off; }
        const int nig = WGM * nN, gid = wgid / nig, fm = gid * WGM, gsz = (nM - fm) < WGM ? (nM - fm) : WGM;
        u.pm = fm + ((wgid % nig) % gsz); u.pn = (wgid % nig) / gsz; return true;
    }
    __device__ __forceinline__ const char* bptr(const Unit& u) const { return Bt + (size_t)u.pn * tstepB; }
    __device__ __forceinline__ int rowsel(const Unit&, int) const { return 0; }
};
struct TileOrder {
    int nunits, npn, G, c; const int* tile_e; const char* wbase; size_t wstride, woff, tstepB; const int* rowl;
    __device__ bool next(int i, Unit& u) const { const int L = i * G + c; if (L >= nunits) return false; u.pm = L / npn; u.pn = L - u.pm * npn; return true; }
    __device__ __forceinline__ const char* bptr(const Unit& u) const { const int e = __builtin_amdgcn_readfirstlane(tile_e[u.pm]); return wbase + (size_t)e * wstride + woff + (size_t)u.pn * tstepB; }
    __device__ __forceinline__ int rowsel(const Unit& u, int r) const { const int t = rowl[(size_t)u.pm * 256 + r]; return t < 0 ? 0 : t; }
};
struct SeqOrder {
    int n; const char* Bt; size_t tstepB; const LAS int* rsel;
    __device__ bool next(int i, Unit& u) const { if (i >= n) return false; u.pm = 0; u.pn = i; return true; }
    __device__ __forceinline__ const char* bptr(const Unit& u) const { return Bt + (size_t)u.pn * tstepB; }
    __device__ __forceinline__ int rowsel(const Unit&, int r) const { return rsel[r]; }
};
__device__ __forceinline__ unsigned cvt_pk_bf16(float lo, float hi) { return cvtpk(lo, hi); }

template <class Epi, class Sched, bool GATHER, int A_AUX = 0, bool ALIGN = true, bool FP8 = false>
__device__ __forceinline__ void gemm_phase(lbyte* lds, const Gemm g, const Sched& S, const Epi& E) {
    int tid_ = threadIdx.x; asm volatile("" : "+v"(tid_));
    const int tid = tid_, wid = __builtin_amdgcn_readfirstlane(tid >> 6), lane = tid & 63, wr = wid >> 2, wc = wid & 3, fr = lane & 15, fq = lane >> 4;
    constexpr unsigned ES = FP8 ? 1u : 2u;
    const int K = g.K, nt = FP8 ? K / 128 : K / BK;
    Unit cur, nxt; int ui = 0;
    if (!S.next(0, cur)) return;
    int Rst[2], Cst[2];
    unsigned voffA[2], voffA1[2], voffB[2], nvA[2], nvA1[2];
#pragma unroll
    for (int i = 0; i < 2; ++i) { int R, C; stage_rc(tid * 16 + i * 8192, R, C); const int Rb = Epi::PERM ? ((R & ~31) + perm32(R & 31)) : R; Rst[i] = R; Cst[i] = C;
        if (GATHER) { voffA[i] = (unsigned)S.rowsel(cur, R) * (unsigned)K * ES + (unsigned)C * 2u; voffA1[i] = (unsigned)S.rowsel(cur, 128 + R) * (unsigned)K * ES + (unsigned)C * 2u; }
        else { voffA[i] = (unsigned)(R * K) * ES + (unsigned)C * 2u; voffA1[i] = voffA[i]; }
        nvA[i] = voffA[i]; nvA1[i] = voffA1[i];
        voffB[i] = (unsigned)(Rb * K) * ES + (unsigned)C * 2u; }
    const size_t kstep = (size_t)(BK * 2);
    const size_t hstep = (size_t)HALF * K * ES;
    const size_t hstepA = GATHER ? 0 : hstep;
    const size_t tstep = 2 * hstep;
    const unsigned ldsw = (unsigned)wid * 1024u;
    const int aoff = lds_byte(wr * 64 + fr, fq * 8), boff = lds_byte(wc * 32 + fr, fq * 8);
#define PG8_SA(b, h) (((b) * 2 + (h)) * HTB)
#define PG8_SB(b, h) ((4 + (b) * 2 + (h)) * HTB)
#define PG8_STAGE2(bufoff, gbase, v0, v1) do { \
        __builtin_amdgcn_global_load_lds((const unsigned*)((const char*)(gbase) + (v0)), (LAS unsigned*)(lds + (bufoff) + ldsw), 16, 0, 0); \
        __builtin_amdgcn_global_load_lds((const unsigned*)((const char*)(gbase) + (v1)), (LAS unsigned*)(lds + (bufoff) + ldsw + 8192), 16, 0, 0); } while (0)
#define PG8_STAGE2A(bufoff, gbase, v0, v1) do { if constexpr (A_AUX == 16) { \
        __builtin_amdgcn_global_load_lds((const unsigned*)((const char*)(gbase) + (v0)), (LAS unsigned*)(lds + (bufoff) + ldsw), 16, 0, 16); \
        __builtin_amdgcn_global_load_lds((const unsigned*)((const char*)(gbase) + (v1)), (LAS unsigned*)(lds + (bufoff) + ldsw + 8192), 16, 0, 16); } else { PG8_STAGE2(bufoff, gbase, v0, v1); } } while (0)
#define PG8_STAGE(bufoff, gbase, voff) PG8_STAGE2(bufoff, gbase, (voff)[0], (voff)[1])
#define PG8_STAGEA(bufoff, gbase, voff) PG8_STAGE2A(bufoff, gbase, (voff)[0], (voff)[1])
#define G_LD32(p) __builtin_shufflevector(*(const LAS i32x4*)(p), *(const LAS i32x4*)((p) + 1024), 0, 1, 2, 3, 4, 5, 6, 7)
#define G_MFMA8(c, a, b) asm volatile("v_mfma_scale_f32_16x16x128_f8f6f4 %0, %1, %2, %0, %3, %3 op_sel_hi:[0,0,0]" : "+v"(c) : "v"(a), "v"(b), "v"(one_scale))
#define PG8_LDA(dst, b, h) do { if constexpr (FP8) { _Pragma("unroll") for (int m = 0; m < 4; ++m) dst##8[m] = G_LD32(lds + PG8_SA(b, h) + aoff + m * 2048); } else { \
        _Pragma("unroll") for (int m = 0; m < 4; ++m) _Pragma("unroll") for (int k = 0; k < 2; ++k) dst[m][k] = *(const LAS bf16x8*)(lds + PG8_SA(b, h) + aoff + m * 2048 + k * 1024); } } while (0)
#define PG8_LDB(dst, b, h) do { if constexpr (FP8) { _Pragma("unroll") for (int n = 0; n < 2; ++n) dst##8[n] = G_LD32(lds + PG8_SB(b, h) + boff + n * 2048); } else { \
        _Pragma("unroll") for (int n = 0; n < 2; ++n) _Pragma("unroll") for (int k = 0; k < 2; ++k) dst[n][k] = *(const LAS bf16x8*)(lds + PG8_SB(b, h) + boff + n * 2048 + k * 1024); } } while (0)
#define PG8_MMA(ai, bj, At, Bt) do { __builtin_amdgcn_s_setprio(1); if constexpr (FP8) { _Pragma("unroll") for (int m = 0; m < 4; ++m) _Pragma("unroll") for (int n = 0; n < 2; ++n) G_MFMA8(acc[ai][bj][m][n], Bt##8[n], At##8[m]); } else { \
        _Pragma("unroll") for (int m = 0; m < 4; ++m) _Pragma("unroll") for (int n = 0; n < 2; ++n) _Pragma("unroll") for (int k = 0; k < 2; ++k) \
        acc[ai][bj][m][n] = __builtin_amdgcn_mfma_f32_16x16x32_bf16(Bt[n][k], At[m][k], acc[ai][bj][m][n], 0, 0, 0); } __builtin_amdgcn_s_setprio(0); } while (0)
#define PG8_WAIT_V(n) asm volatile("s_waitcnt vmcnt(" #n ")" ::: "memory")
#define PG8_WAIT_L(n) asm volatile("s_waitcnt lgkmcnt(" #n ")" ::: "memory")
#define PG8_BAR __builtin_amdgcn_s_barrier()
#define PG8_SCHED __builtin_amdgcn_sched_barrier(0)
    f32x4 acc[2][2][4][2];
#pragma unroll
    for (int a = 0; a < 2; ++a)
#pragma unroll
        for (int b = 0; b < 2; ++b)
#pragma unroll
            for (int m = 0; m < 4; ++m)
#pragma unroll
                for (int n = 0; n < 2; ++n) acc[a][b][m][n] = (f32x4){0.f, 0.f, 0.f, 0.f};
    bf16x8 At[4][2], B0[2][2], B1[2][2]; i32x8 At8[4], B08[2], B18[2];
    int one_scale = 0x7F7F7F7F; asm volatile("" : "+v"(one_scale));
    const char* cA = (const char*)g.A + (GATHER ? (size_t)0 : (size_t)cur.pm * tstep); const char* cB = S.bptr(cur);
    PG8_STAGE(PG8_SB(0, 0), cB, voffB); PG8_STAGE(PG8_SB(0, 1), cB + hstep, voffB); PG8_STAGEA(PG8_SA(0, 0), cA, voffA); PG8_STAGEA(PG8_SA(0, 1), cA + hstepA, voffA1);
    if (wr == 1) PG8_BAR;
    PG8_WAIT_V(2); PG8_BAR;
    PG8_STAGE(PG8_SB(1, 0), cB + kstep, voffB); PG8_STAGEA(PG8_SA(1, 0), cA + kstep, voffA); PG8_STAGE(PG8_SB(1, 1), cB + hstep + kstep, voffB);
    PG8_WAIT_V(6); PG8_BAR;
    for (;;) {
        const bool has_next = S.next(ui + 1, nxt);
        const char* nA = has_next ? (const char*)g.A + (GATHER ? (size_t)0 : (size_t)nxt.pm * tstep) : cA; const char* nB = has_next ? S.bptr(nxt) : cB;
        for (int t = 0; t < nt; t += 2) {
            const bool last = (t == nt - 2);
            const char* a1 = cA + (size_t)(t + 1) * kstep;
            const char* a2 = last ? nA : cA + (size_t)(t + 2) * kstep; const char* b2 = last ? nB : cB + (size_t)(t + 2) * kstep;
            const char* a3 = a2 + kstep; const char* b3 = b2 + kstep;
            if (GATHER && last && has_next) {
#pragma unroll
                for (int i = 0; i < 2; ++i) { nvA[i] = (unsigned)S.rowsel(nxt, Rst[i]) * (unsigned)K * ES + (unsigned)Cst[i] * 2u; nvA1[i] = (unsigned)S.rowsel(nxt, 128 + Rst[i]) * (unsigned)K * ES + (unsigned)Cst[i] * 2u; }
            }
            const unsigned x0 = (GATHER && last) ? nvA[0] : voffA[0], x1 = (GATHER && last) ? nvA[1] : voffA[1];
            const unsigned y0 = (GATHER && last) ? nvA1[0] : voffA1[0], y1 = (GATHER && last) ? nvA1[1] : voffA1[1];
            PG8_LDB(B0, 0, 0); PG8_LDB(B1, 0, 1); PG8_SCHED; PG8_LDA(At, 0, 0); PG8_STAGEA(PG8_SA(1, 1), a1 + hstepA, voffA1);
            PG8_WAIT_V(8); PG8_WAIT_L(0); PG8_BAR; PG8_MMA(0, 0, At, B0); PG8_MMA(0, 1, At, B1); PG8_BAR; PG8_SCHED;
            PG8_LDA(At, 0, 1); PG8_STAGE(PG8_SB(0, 0), b2, voffB); PG8_STAGE(PG8_SB(0, 1), b2 + hstep, voffB); PG8_STAGE2A(PG8_SA(0, 0), a2, x0, x1);
            PG8_WAIT_V(8); PG8_WAIT_L(0); PG8_BAR; PG8_MMA(1, 0, At, B0); PG8_MMA(1, 1, At, B1); PG8_BAR; PG8_SCHED;
            PG8_LDB(B0, 1, 0); PG8_LDB(B1, 1, 1); PG8_SCHED; PG8_LDA(At, 1, 0); PG8_STAGE2A(PG8_SA(0, 1), a2 + hstepA, y0, y1);
            PG8_WAIT_V(8); PG8_WAIT_L(0); PG8_BAR; PG8_MMA(0, 0, At, B0); PG8_MMA(0, 1, At, B1); PG8_BAR; PG8_SCHED;
            PG8_LDA(At, 1, 1); PG8_STAGE(PG8_SB(1, 0), b3, voffB); PG8_STAGE(PG8_SB(1, 1), b3 + hstep, voffB); PG8_STAGE2A(PG8_SA(1, 0), a3, x0, x1);
            PG8_WAIT_V(8); PG8_WAIT_L(0); PG8_BAR; PG8_MMA(1, 0, At, B0); PG8_MMA(1, 1, At, B1); PG8_BAR; PG8_SCHED;
        }
        if (ALIGN && wr == 0) PG8_BAR;
        if constexpr (FP8) asm volatile("s_nop 15\n\ts_nop 15" ::: "memory");
        E(acc, cur, wr, wc, fr, fq);
        if (!has_next) break;
#pragma unroll
        for (int a = 0; a < 2; ++a)
#pragma unroll
            for (int b = 0; b < 2; ++b)
#pragma unroll
                for (int m = 0; m < 4; ++m)
#pragma unroll
                    for (int n = 0; n < 2; ++n) acc[a][b][m][n] = (f32x4){0.f, 0.f, 0.f, 0.f};
        cur = nxt; cA = nA; cB = nB; ++ui;
        if (GATHER) { voffA[0] = nvA[0]; voffA[1] = nvA[1]; voffA1[0] = nvA1[0]; voffA1[1] = nvA1[1]; }
        if (ALIGN && wr == 1) PG8_BAR;
    }
    PG8_WAIT_V(0);
    if (!ALIGN && wr == 0) PG8_BAR;
    PG8_BAR;
#undef PG8_SA
#undef PG8_SB
#undef PG8_STAGE
#undef PG8_STAGE2
#undef PG8_STAGE2A
#undef PG8_STAGEA
#undef G_LD32
#undef G_MFMA8
#undef PG8_LDA
#undef PG8_LDB
#undef PG8_MMA
#undef PG8_WAIT_V
#undef PG8_WAIT_L
#undef PG8_BAR
#undef PG8_SCHED
}

struct EpiBf16 {
    static constexpr bool PERM = true;
    bf16_t* O; int ldc; float scale;
    __device__ __forceinline__ void operator()(const f32x4 (&acc)[2][2][4][2], const Unit& u, int wr, int wc, int fr, int fq) const {
        const int row0 = u.pm * BM + wr * 64 + fr; const int col0 = u.pn * BM + wc * 32 + 8 * fq;
#pragma unroll
        for (int ai = 0; ai < 2; ++ai)
#pragma unroll
            for (int m = 0; m < 4; ++m) { bf16_t* rowp = O + (size_t)(row0 + ai * HALF + m * 16) * ldc + col0;
#pragma unroll
                for (int bj = 0; bj < 2; ++bj) { const f32x4 v0 = acc[ai][bj][m][0] * scale, v1 = acc[ai][bj][m][1] * scale;
                    u32x4 w; w.x = cvt_pk_bf16(v0[0], v0[1]); w.y = cvt_pk_bf16(v0[2], v0[3]); w.z = cvt_pk_bf16(v1[0], v1[1]); w.w = cvt_pk_bf16(v1[2], v1[3]);
                    *(u32x4*)(rowp + bj * HALF) = w; } }
    }
};
struct EpiF32 {
    static constexpr bool PERM = false;
    float* C; int ldc;
    __device__ __forceinline__ void operator()(const f32x4 (&acc)[2][2][4][2], const Unit& u, int wr, int wc, int fr, int fq) const {
        const int row0 = u.pm * BM + wr * 64 + fr, col0 = u.pn * BM + wc * 32 + 4 * fq;
#pragma unroll
        for (int ai = 0; ai < 2; ++ai)
#pragma unroll
            for (int m = 0; m < 4; ++m) { float* rowp = C + (size_t)(row0 + ai * HALF + m * 16) * ldc + col0;
#pragma unroll
                for (int bj = 0; bj < 2; ++bj)
#pragma unroll
                    for (int n = 0; n < 2; ++n) *(f32x4*)(rowp + bj * HALF + n * 16) = acc[ai][bj][m][n]; }
    }
};
struct EpiResGate {
    static constexpr bool PERM = false;
    const float* x; float* out; const float* mod; int gate_off;
    __device__ __forceinline__ void operator()(const f32x4 (&acc)[2][2][4][2], const Unit& u, int wr, int wc, int fr, int fq) const {
        const int row0 = u.pm * BM + wr * 64 + fr, col0 = u.pn * BM + wc * 32 + 4 * fq;
        const float* gp = mod + (size_t)((u.pm * BM) >> 11) * MODW + gate_off + col0;
        f32x4 gv[2][2];
#pragma unroll
        for (int bj = 0; bj < 2; ++bj)
#pragma unroll
            for (int n = 0; n < 2; ++n) gv[bj][n] = *(const f32x4*)(gp + bj * HALF + n * 16);
#pragma unroll
        for (int ai = 0; ai < 2; ++ai)
#pragma unroll
            for (int m = 0; m < 4; ++m) { const size_t off = (size_t)(row0 + ai * HALF + m * 16) * D + col0;
#pragma unroll
                for (int bj = 0; bj < 2; ++bj)
#pragma unroll
                    for (int n = 0; n < 2; ++n) { const f32x4 xv = *(const f32x4*)(x + off + bj * HALF + n * 16);
                        *(f32x4*)(out + off + bj * HALF + n * 16) = xv + gv[bj][n] * acc[ai][bj][m][n]; }
                asm volatile("" ::: "memory"); }
    }
};
struct EpiGLU {
    static constexpr bool PERM = true;
    bf16_t* H;
    __device__ __forceinline__ void operator()(const f32x4 (&acc)[2][2][4][2], const Unit& u, int wr, int wc, int fr, int fq) const {
        const int row0 = u.pm * BM + wr * 64 + fr; const int col0 = u.pn * 128 + wc * 32 + 8 * fq;
#pragma unroll
        for (int ai = 0; ai < 2; ++ai)
#pragma unroll
            for (int m = 0; m < 4; ++m) { bf16_t* rowp = H + (size_t)(row0 + ai * HALF + m * 16) * 256 + col0;
                f32x4 h0, h1;
#pragma unroll
                for (int j = 0; j < 4; ++j) { const float a0 = acc[ai][0][m][0][j], a1 = acc[ai][0][m][1][j];
                    h0[j] = siluf_(a0) * acc[ai][1][m][0][j]; h1[j] = siluf_(a1) * acc[ai][1][m][1][j]; }
                u32x4 w; w.x = cvt_pk_bf16(h0[0], h0[1]); w.y = cvt_pk_bf16(h0[2], h0[3]); w.z = cvt_pk_bf16(h1[0], h1[1]); w.w = cvt_pk_bf16(h1[2], h1[3]);
                *(u32x4*)rowp = w; }
    }
};
constexpr float YSCALE = 8.f;
struct EpiY {
    static constexpr bool PERM = true;
    unsigned char* Y; float* out; const float* mod; const LAS int* rtok; const LAS float* rw; int shared;
    __device__ __forceinline__ void operator()(const f32x4 (&acc)[2][2][4][2], const Unit& u, int wr, int wc, int fr, int fq) const {
        const int col0 = u.pn * BM + wc * 32 + 8 * fq;
#pragma unroll
        for (int ai = 0; ai < 2; ++ai)
#pragma unroll
            for (int m = 0; m < 4; ++m) { const int r = wr * 64 + fr + ai * HALF + m * 16; const int ts = rtok[r]; const float w = rw[r];
                if (ts >= 0) {
                    if (shared) { const unsigned goff = (unsigned)(ts >> 11) * MODW + 5 * D + col0; const unsigned ooff = (unsigned)ts * D + col0;
#pragma unroll
                        for (int bj = 0; bj < 2; ++bj)
#pragma unroll
                            for (int n = 0; n < 2; ++n) { const f32x4 gv = *(const f32x4*)(mod + goff + bj * HALF + n * 4); f32x4* op = (f32x4*)(out + ooff + bj * HALF + n * 4);
                                *op = *op + gv * acc[ai][bj][m][n]; }
                    } else { unsigned char* yp = Y + (size_t)(unsigned)ts * D + col0; const float ws_ = w * YSCALE;
#pragma unroll
                        for (int bj = 0; bj < 2; ++bj) { f32x4 v0 = acc[ai][bj][m][0] * ws_, v1 = acc[ai][bj][m][1] * ws_;
#pragma unroll
                                for (int j = 0; j < 4; ++j) { v0[j] = __builtin_amdgcn_fmed3f(v0[j], -448.f, 448.f); v1[j] = __builtin_amdgcn_fmed3f(v1[j], -448.f, 448.f); }
                            unsigned lo = 0u, hi = 0u;
                            lo = __builtin_amdgcn_cvt_pk_fp8_f32(v0[0], v0[1], lo, false); lo = __builtin_amdgcn_cvt_pk_fp8_f32(v0[2], v0[3], lo, true);
                            hi = __builtin_amdgcn_cvt_pk_fp8_f32(v1[0], v1[1], hi, false); hi = __builtin_amdgcn_cvt_pk_fp8_f32(v1[2], v1[3], hi, true);
                            u32x2 pk; pk.x = lo; pk.y = hi; *(u32x2*)(yp + bj * HALF) = pk; } } }
                asm volatile("" ::: "memory"); }
    }
};

struct MoeCtx {
    int ntiles, nrt, G, vc;
    const LAS int* tb; LAS int* tbl;
    const unsigned* cnt; const int* rowl; const float* roww;
    const char* wexp; const char* h2n; char* Hs; unsigned char* Y; float* out; const float* mod; int dry_shared;
};
__device__ __forceinline__ void gemm_moe(lbyte* lds, const MoeCtx& M) {
    int tid_ = threadIdx.x; asm volatile("" : "+v"(tid_));
    const int tid = tid_, wid = __builtin_amdgcn_readfirstlane(tid >> 6), lane = tid & 63, wr = wid >> 2, wc = wid & 3, fr = lane & 15, fq = lane >> 4;
    const int ntl = (M.ntiles - M.vc + M.G - 1) / M.G;
    if (M.vc >= M.ntiles) return;
    const int nunits = ntl * 6;
    const unsigned ldsw = (unsigned)wid * 1024u;
    const int aoff = lds_byte(wr * 64 + fr, fq * 8), boff = lds_byte(wc * 32 + fr, fq * 8);
    auto tile_expert = [&](int tile, int& e, int& k) { if (tile < M.nrt) { int lo = 0, hi = NE - 1; while (lo < hi) { const int mid = (lo + hi + 1) >> 1; if (M.tb[mid] <= tile) lo = mid; else hi = mid - 1; } e = lo; k = tile - M.tb[lo]; } else { e = NE; k = tile - M.nrt; } };
    auto fill = [&](int j) { if (j < ntl && tid < 256) { const int tile = M.vc + j * M.G; int e, k; tile_expert(tile, e, k); LAS int* T = M.tbl + (j % 3) * 768;
            int ts; float w;
            if (e < NE) { const int valid = (int)M.cnt[e * CNT_STRIDE] - 256 * k; if (tid < valid) { ts = M.rowl[(size_t)tile * 256 + tid]; w = M.roww[(size_t)tile * 256 + tid]; } else { ts = -1; w = 0.f; } T[tid] = ts < 0 ? 0 : (ts >> 3); }
            else { ts = k * 256 + tid; w = 1.f; T[tid] = ts; }
            T[256 + tid] = ts; ((LAS float*)T)[512 + tid] = w; } };
    struct UP { const char* aB; const char* bB; unsigned bh; int nt, kind, pn, slot, shared, e, hbuf, fillnext; };
    auto unit_params = [&](int ui, int prev_e, UP& u, unsigned (&oa)[4], unsigned (&ob)[2]) {
        int tq = threadIdx.x; asm volatile("" : "+v"(tq));
        int Rst[2], Cst[2], Rbp[2];
#pragma unroll
        for (int i = 0; i < 2; ++i) { int R, C; stage_rc(tq * 16 + i * 8192, R, C); Rst[i] = R; Cst[i] = C; Rbp[i] = (R & ~31) + perm32(R & 31); }
        int j, sub;
        if (ui < 2) { j = 0; sub = ui; }
        else { const int qq = ui - 2, g = qq / 6, r = qq - 6 * g; if (g < ntl - 1 && r < 2) { j = g + 1; sub = r; } else { j = g; sub = (g < ntl - 1) ? r : r + 2; } }
        const int tile = M.vc + j * M.G; int e, k;
        if (sub == 0 || sub == 2) tile_expert(tile, e, k); else e = prev_e;
        u.e = e;
        const char* w = M.wexp + (size_t)e * WEXP_STRIDE;
        u.slot = j % 3; u.hbuf = j & 1; u.fillnext = (sub == 1) ? j + 1 : -1; u.shared = (e == NE) ? 1 : 0;
        if (sub < 2) { u.kind = 0; u.pn = sub; u.nt = D / 128; u.aB = M.h2n; u.bB = w + (size_t)sub * 256 * D; u.bh = 128u * D;
            const LAS int* T = M.tbl + (j % 3) * 768;
#pragma unroll
            for (int i = 0; i < 2; ++i) { oa[i] = (unsigned)T[Rst[i]] * (unsigned)D + 2u * (unsigned)Cst[i]; oa[2 + i] = (unsigned)T[128 + Rst[i]] * (unsigned)D + 2u * (unsigned)Cst[i]; ob[i] = (unsigned)(Rbp[i] * D + 2 * Cst[i]); } }
        else { u.kind = 1; u.pn = sub - 2; u.nt = DE / 128; u.aB = M.Hs + (j & 1) * 65536; u.bB = w + (size_t)512 * 1024 + (size_t)(sub - 2) * 256 * DE; u.bh = 128u * DE;
#pragma unroll
            for (int i = 0; i < 2; ++i) { oa[i] = (unsigned)(Rst[i] * DE + 2 * Cst[i]); oa[2 + i] = (unsigned)((128 + Rst[i]) * DE + 2 * Cst[i]); ob[i] = (unsigned)(Rbp[i] * DE + 2 * Cst[i]); } }
    };
#define PG8_SA(b, h) (((b) * 2 + (h)) * HTB)
#define PG8_SB(b, h) ((4 + (b) * 2 + (h)) * HTB)
#define MOE_DMA(bufoff, ptr, aux) __builtin_amdgcn_global_load_lds((const unsigned*)(ptr), (LAS unsigned*)(lds + (bufoff)), 16, 0, aux)
#define MOE_STA(bufoff, base, o0, o1) do { MOE_DMA((bufoff) + ldsw, (base) + (o0), 16); MOE_DMA((bufoff) + ldsw + 8192, (base) + (o1), 16); } while (0)
#define MOE_STAK(kindv, bufoff, base, o0, o1) do { if ((kindv) == 0) { MOE_DMA((bufoff) + ldsw, (base) + (o0), 0); MOE_DMA((bufoff) + ldsw + 8192, (base) + (o1), 0); } else MOE_STA(bufoff, base, o0, o1); } while (0)
#define MOE_STB(bufoff, base, o0, o1) do { MOE_DMA((bufoff) + ldsw, (base) + (o0), 0); MOE_DMA((bufoff) + ldsw + 8192, (base) + (o1), 0); } while (0)
#define MOE_LD32(p) __builtin_shufflevector(*(const LAS i32x4*)(p), *(const LAS i32x4*)((p) + 1024), 0, 1, 2, 3, 4, 5, 6, 7)
#define PG8_LDA(dst, b, h) do { _Pragma("unroll") for (int m = 0; m < 4; ++m) dst[m] = MOE_LD32(lds + PG8_SA(b, h) + aoff + m * 2048); } while (0)
#define PG8_LDB(dst, b, h) do { _Pragma("unroll") for (int n = 0; n < 2; ++n) dst[n] = MOE_LD32(lds + PG8_SB(b, h) + boff + n * 2048); } while (0)
#define MOE_MFMA(c, a, b) asm volatile("v_mfma_scale_f32_16x16x128_f8f6f4 %0, %1, %2, %0, %3, %3 op_sel_hi:[0,0,0]" : "+v"(c) : "v"(a), "v"(b), "v"(one_scale))
#define PG8_MMA(ai, bj, At, Bt) do { __builtin_amdgcn_s_setprio(1); _Pragma("unroll") for (int m = 0; m < 4; ++m) _Pragma("unroll") for (int n = 0; n < 2; ++n) \
        MOE_MFMA(acc[ai][bj][m][n], Bt[n], At[m]); __builtin_amdgcn_s_setprio(0); } while (0)
#define PG8_WAIT_V(n) asm volatile("s_waitcnt vmcnt(" #n ")" ::: "memory")
#define PG8_WAIT_L(n) asm volatile("s_waitcnt lgkmcnt(" #n ")" ::: "memory")
#define PG8_BAR __builtin_amdgcn_s_barrier()
#define PG8_SCHED __builtin_amdgcn_sched_barrier(0)
    fill(0);
    asm volatile("s_waitcnt vmcnt(0) lgkmcnt(0)" ::: "memory");
    __syncthreads();
    UP cu, nu; unsigned oa[4], ob[2], na[4], nb[2];
    unit_params(0, 0, cu, oa, ob);
    nu = cu;
#pragma unroll
    for (int i = 0; i < 4; ++i) na[i] = oa[i];
    nb[0] = ob[0]; nb[1] = ob[1];
    f32x4 acc[2][2][4][2];
#pragma unroll
    for (int a = 0; a < 2; ++a)
#pragma unroll
        for (int b = 0; b < 2; ++b)
#pragma unroll
            for (int m = 0; m < 4; ++m)
#pragma unroll
                for (int n = 0; n < 2; ++n) acc[a][b][m][n] = (f32x4){0.f, 0.f, 0.f, 0.f};
    i32x8 At[4], B0[2], B1[2];
    int one_scale = 0x7F7F7F7F; asm volatile("" : "+v"(one_scale));
    const size_t kstep = (size_t)128;
    {   const char* cA = cu.aB; const char* cB = cu.bB;
        MOE_STB(PG8_SB(0, 0), cB, ob[0], ob[1]); MOE_STB(PG8_SB(0, 1), cB + cu.bh, ob[0], ob[1]); MOE_STAK(cu.kind, PG8_SA(0, 0), cA, oa[0], oa[1]); MOE_STAK(cu.kind, PG8_SA(0, 1), cA, oa[2], oa[3]);
        if (wr == 1) PG8_BAR;
        PG8_WAIT_V(2); PG8_BAR;
        MOE_STB(PG8_SB(1, 0), cB + kstep, ob[0], ob[1]); MOE_STAK(cu.kind, PG8_SA(1, 0), cA + kstep, oa[0], oa[1]); MOE_STB(PG8_SB(1, 1), cB + cu.bh + kstep, ob[0], ob[1]);
        PG8_WAIT_V(6); PG8_BAR; }
    for (int ui = 0;; ++ui) {
        const bool has_next = (ui + 1 < nunits);
        if (cu.fillnext >= 0) fill(cu.fillnext);
        const char* cA = cu.aB; const char* cB = cu.bB; const int nt = cu.nt; const unsigned bh = cu.bh;
        for (int t = 0; t < nt; t += 2) {
            const bool last = (t == nt - 2);
            if (last && has_next) unit_params(ui + 1, cu.e, nu, na, nb);
            const char* a1 = cA + (size_t)(t + 1) * kstep;
            const char* a2 = last ? nu.aB : cA + (size_t)(t + 2) * kstep; const char* b2 = last ? nu.bB : cB + (size_t)(t + 2) * kstep;
            const char* a3 = a2 + kstep; const char* b3 = b2 + kstep;
            const unsigned bh2 = last ? nu.bh : bh;
            const unsigned x0 = last ? na[0] : oa[0], x1 = last ? na[1] : oa[1], y0 = last ? na[2] : oa[2], y1 = last ? na[3] : oa[3];
            const unsigned z0 = last ? nb[0] : ob[0], z1 = last ? nb[1] : ob[1];
            const int k2 = last ? nu.kind : cu.kind;
            PG8_LDB(B0, 0, 0); PG8_LDB(B1, 0, 1); PG8_SCHED; PG8_LDA(At, 0, 0); MOE_STAK(cu.kind, PG8_SA(1, 1), a1, oa[2], oa[3]);
            PG8_WAIT_V(8); PG8_WAIT_L(0); PG8_BAR; PG8_MMA(0, 0, At, B0); PG8_MMA(0, 1, At, B1); PG8_BAR; PG8_SCHED;
            PG8_LDA(At, 0, 1); MOE_STB(PG8_SB(0, 0), b2, z0, z1); MOE_STB(PG8_SB(0, 1), b2 + bh2, z0, z1); MOE_STAK(k2, PG8_SA(0, 0), a2, x0, x1);
            PG8_WAIT_V(8); PG8_WAIT_L(0); PG8_BAR; PG8_MMA(1, 0, At, B0); PG8_MMA(1, 1, At, B1); PG8_BAR; PG8_SCHED;
            PG8_LDB(B0, 1, 0); PG8_LDB(B1, 1, 1); PG8_SCHED; PG8_LDA(At, 1, 0); MOE_STAK(k2, PG8_SA(0, 1), a2, y0, y1);
            PG8_WAIT_V(8); PG8_WAIT_L(0); PG8_BAR; PG8_MMA(0, 0, At, B0); PG8_MMA(0, 1, At, B1); PG8_BAR; PG8_SCHED;
            PG8_LDA(At, 1, 1); MOE_STB(PG8_SB(1, 0), b3, z0, z1); MOE_STB(PG8_SB(1, 1), b3 + bh2, z0, z1); MOE_STAK(k2, PG8_SA(1, 0), a3, x0, x1);
            PG8_WAIT_V(8); PG8_WAIT_L(0); PG8_BAR; PG8_MMA(1, 0, At, B0); PG8_MMA(1, 1, At, B1); PG8_BAR; PG8_SCHED;
        }
        if (wr == 0) PG8_BAR;
        asm volatile("s_nop 15\n\ts_nop 15" ::: "memory");
        if (cu.kind == 0) {
            const int row0 = wr * 64 + fr; const int col0 = cu.pn * 128 + wc * 32 + 8 * fq;
            constexpr float is13 = 1.f / SW13;
#pragma unroll
            for (int ai = 0; ai < 2; ++ai)
#pragma unroll
                for (int m = 0; m < 4; ++m) { unsigned char* rowp = (unsigned char*)M.Hs + cu.hbuf * 65536 + (size_t)(row0 + ai * HALF + m * 16) * 256 + col0;
                    f32x4 h0, h1;
#pragma unroll
                    for (int j = 0; j < 4; ++j) { h0[j] = siluf_(acc[ai][0][m][0][j] * is13) * (acc[ai][1][m][0][j] * (is13 * SHS)); h1[j] = siluf_(acc[ai][0][m][1][j] * is13) * (acc[ai][1][m][1][j] * (is13 * SHS)); }
                    u32x2 w; w.x = pk4_fp8(h0[0], h0[1], h0[2], h0[3]); w.y = pk4_fp8(h1[0], h1[1], h1[2], h1[3]);
                    *(u32x2*)rowp = w; }
        } else {
            const LAS int* rtok = M.tbl + cu.slot * 768 + 256; const LAS float* rw = (const LAS float*)(M.tbl + cu.slot * 768 + 512);
            const int col0 = cu.pn * BM + wc * 32 + 8 * fq;
#pragma unroll
            for (int ai = 0; ai < 2; ++ai)
#pragma unroll
                for (int m = 0; m < 4; ++m) { const int r = wr * 64 + fr + ai * HALF + m * 16; const int ts = rtok[r]; const float w = rw[r];
                    if (ts >= 0) {
                        if (cu.shared) { const unsigned goff = (unsigned)(ts >> 11) * MODW + 5 * D + col0; const unsigned ooff = (unsigned)ts * D + col0;
#pragma unroll
                            for (int bj = 0; bj < 2; ++bj)
#pragma unroll
                                for (int n = 0; n < 2; ++n) { const f32x4 gv = *(const f32x4*)(M.mod + goff + bj * HALF + n * 4); f32x4* op = (f32x4*)(M.out + ooff + bj * HALF + n * 4);
                                    const f32x4 nv = *op + gv * acc[ai][bj][m][n] * (1.f / (SHS * SW2)); if (!M.dry_shared) *op = nv; else asm volatile("" :: "v"(nv)); }
                        } else { unsigned char* yp = M.Y + (size_t)(unsigned)ts * D + col0; const float ws_ = w * (YSCALE / (SHS * SW2));
#pragma unroll
                            for (int bj = 0; bj < 2; ++bj) { f32x4 v0 = acc[ai][bj][m][0] * ws_, v1 = acc[ai][bj][m][1] * ws_;
#pragma unroll
                                for (int j = 0; j < 4; ++j) { v0[j] = __builtin_amdgcn_fmed3f(v0[j], -448.f, 448.f); v1[j] = __builtin_amdgcn_fmed3f(v1[j], -448.f, 448.f); }
                                unsigned lo = 0u, hi = 0u;
                                lo = __builtin_amdgcn_cvt_pk_fp8_f32(v0[0], v0[1], lo, false); lo = __builtin_amdgcn_cvt_pk_fp8_f32(v0[2], v0[3], lo, true);
                                hi = __builtin_amdgcn_cvt_pk_fp8_f32(v1[0], v1[1], hi, false); hi = __builtin_amdgcn_cvt_pk_fp8_f32(v1[2], v1[3], hi, true);
                                u32x2 pk; pk.x = lo; pk.y = hi; *(u32x2*)(yp + bj * HALF) = pk; } } }
                    asm volatile("" ::: "memory"); }
        }
        if (!has_next) break;
#pragma unroll
        for (int a = 0; a < 2; ++a)
#pragma unroll
            for (int b = 0; b < 2; ++b)
#pragma unroll
                for (int m = 0; m < 4; ++m)
#pragma unroll
                    for (int n = 0; n < 2; ++n) acc[a][b][m][n] = (f32x4){0.f, 0.f, 0.f, 0.f};
        cu = nu;
#pragma unroll
        for (int i = 0; i < 4; ++i) oa[i] = na[i];
        ob[0] = nb[0]; ob[1] = nb[1];
        if (wr == 1) PG8_BAR;
    }
    PG8_WAIT_V(0);
    PG8_BAR;
#undef PG8_SA
#undef PG8_SB
#undef MOE_DMA
#undef MOE_STA
#undef MOE_STAK
#undef MOE_STB
#undef PG8_LDA
#undef PG8_LDB
#undef MOE_LD32
#undef MOE_MFMA
#undef PG8_MMA
#undef PG8_WAIT_V
#undef PG8_WAIT_L
#undef PG8_BAR
#undef PG8_SCHED
}
}

struct Ctx {
    lbyte* lds; int tid, lane, wave, G, bid;
    const Args* a;
};
#define WSP(T, off) ((T*)(A.ws + (off)))

template <class RowMap>
__device__ __forceinline__ void transpose_item(const float* W, int K, int N, bf16_t* WT, RowMap rowmap, lfloat* scr, int item, int lane) {
    const int nblk = N / 32, kb = item / nblk, nb = item % nblk, k0 = 64 * kb, n0 = 32 * nb;
#pragma unroll 8
    for (int i = 0; i < 32; ++i) { const int kk = 2 * i + (lane >> 5); scr[kk * 33 + (lane & 31)] = W[(size_t)(k0 + kk) * N + n0 + (lane & 31)]; }
    asm volatile("s_waitcnt lgkmcnt(0)" ::: "memory");
    const int c = lane & 7;
#pragma unroll
    for (int j = 0; j < 4; ++j) { const int n = (lane >> 3) + 8 * j; const lfloat* s = scr + (8 * c) * 33 + n;
        u32x4 o; o.x = pk2(s[0 * 33], s[1 * 33]); o.y = pk2(s[2 * 33], s[3 * 33]); o.z = pk2(s[4 * 33], s[5 * 33]); o.w = pk2(s[6 * 33], s[7 * 33]);
        *(u32x4*)(WT + (size_t)rowmap(n0 + n) * K + k0 + 8 * c) = o; }
    asm volatile("s_waitcnt lgkmcnt(0)" ::: "memory");
}
template <class RowMap>
__device__ __forceinline__ void transpose_item_fp8(const float* W, int K, int N, unsigned char* WT, RowMap rowmap, float sc, lfloat* scr, int item, int lane) {
    const int nblk = N / 32, kb = item / nblk, nb = item % nblk, k0 = 64 * kb, n0 = 32 * nb;
#pragma unroll 8
    for (int i = 0; i < 32; ++i) { const int kk = 2 * i + (lane >> 5); scr[kk * 33 + (lane & 31)] = W[(size_t)(k0 + kk) * N + n0 + (lane & 31)] * sc; }
    asm volatile("s_waitcnt lgkmcnt(0)" ::: "memory");
    const int c = lane & 7;
#pragma unroll
    for (int j = 0; j < 4; ++j) { const int n = (lane >> 3) + 8 * j; const lfloat* s = scr + (8 * c) * 33 + n;
        u32x2 o; o.x = pk4_fp8(s[0 * 33], s[1 * 33], s[2 * 33], s[3 * 33]); o.y = pk4_fp8(s[4 * 33], s[5 * 33], s[6 * 33], s[7 * 33]);
        *(u32x2*)(WT + (size_t)rowmap(n0 + n) * K + k0 + 8 * c) = o; }
    asm volatile("s_waitcnt lgkmcnt(0)" ::: "memory");
}
template <class RowMap>
__device__ __forceinline__ void transpose_pair_fp8(const float* W, int K, int N, unsigned char* WT, RowMap rowmap, float sc, lfloat* scr, int pair, int lane) {
    const int nblk = N / 32, kbp = pair / nblk, nb = pair % nblk, k0 = 128 * kbp, n0 = 32 * nb;
    const int kr = lane >> 3, n4 = (lane & 7) * 4;
    f32x4 ld[2][8];
#pragma unroll
    for (int h = 0; h < 2; ++h)
#pragma unroll
        for (int i = 0; i < 8; ++i) ld[h][i] = *(const f32x4*)(W + (size_t)(k0 + 64 * h + 8 * i + kr) * N + n0 + n4);
    const int c = lane & 7;
    u32x2 o[2][4];
#pragma unroll
    for (int h = 0; h < 2; ++h) {
#pragma unroll
        for (int i = 0; i < 8; ++i) { lfloat* d = scr + (8 * i + kr) * 33 + n4; d[0] = ld[h][i].x * sc; d[1] = ld[h][i].y * sc; d[2] = ld[h][i].z * sc; d[3] = ld[h][i].w * sc; }
        asm volatile("s_waitcnt lgkmcnt(0)" ::: "memory");
#pragma unroll
        for (int j = 0; j < 4; ++j) { const int n = (lane >> 3) + 8 * j; const lfloat* s = scr + (8 * c) * 33 + n;
            o[h][j].x = pk4_fp8(s[0 * 33], s[1 * 33], s[2 * 33], s[3 * 33]); o[h][j].y = pk4_fp8(s[4 * 33], s[5 * 33], s[6 * 33], s[7 * 33]); }
        asm volatile("s_waitcnt lgkmcnt(0)" ::: "memory");
    }
#pragma unroll
    for (int j = 0; j < 4; ++j) { const int n = (lane >> 3) + 8 * j; unsigned char* p = WT + (size_t)rowmap(n0 + n) * K + k0 + 8 * c;
        *(u32x2*)p = o[0][j]; *(u32x2*)(p + 64) = o[1][j]; }
}
struct RowId { __device__ int operator()(int n) const { return n; } };
struct RowGLU { int base; __device__ int operator()(int n) const { return ((n >> 7) << 8) + base + (n & 127); } };

__device__ __forceinline__ void norm_mod_row(const float* xrow, const float* g, const float* sc, const float* sh, bf16_t* orow, int lane, unsigned* o8row = nullptr) {
    const f32x4* xr = (const f32x4*)xrow + lane;
    f32x4 v[4]; float s = 0.f;
#pragma unroll
    for (int j = 0; j < 4; ++j) { v[j] = xr[64 * j]; s += (v[j].x * v[j].x + v[j].y * v[j].y) + (v[j].z * v[j].z + v[j].w * v[j].w); }
    const float rstd = __builtin_amdgcn_rsqf(wave_sum(s) * (1.f / D) + NORM_EPS);
    u32x2* o8 = (u32x2*)orow + lane;
#pragma unroll
    for (int j = 0; j < 4; ++j) { const f32x4 gg = ((const f32x4*)g)[lane + 64 * j], ss = ((const f32x4*)sc)[lane + 64 * j], hh = ((const f32x4*)sh)[lane + 64 * j];
        const f32x4 y = v[j] * rstd * gg * (ss + 1.f) + hh;
        if (orow) { u32x2 w; w.x = pk2(y.x, y.y); w.y = pk2(y.z, y.w); o8[64 * j] = w; }
        if (o8row) o8row[lane + 64 * j] = pk4_fp8(y.x, y.y, y.z, y.w); }
}

__device__ __forceinline__ void phase_p0(const Args& A, Ctx& C) {
    float* mod = WSP(float, WS_MOD);
    {
        lfloat* sc = (lfloat*)C.lds;
        lfloat* red = (lfloat*)(C.lds + 17 * 1024 * 4);
        const float* wada = A.in[I_WADA]; const float* bada = A.in[I_BADA];
        for (int it = C.bid; it < 96 * 2; it += C.G) {
            const int chunk = it >> 1, pass = it & 1, r0 = pass * 17, nr = pass ? 16 : 17, col0 = chunk * 64;
            __syncthreads();
            for (int i = C.tid; i < nr * 1024; i += 512) { const int r = i >> 10, k = i & 1023; const int rr = r0 + r;
                const float cv = rr < 32 ? A.in[I_C][rr * 1024 + k] : A.in[I_CCTX][k]; sc[r * 1024 + k] = siluf_(cv); }
            __syncthreads();
            const int col = C.tid & 63, kq = C.tid >> 6;
            float acc[17];
#pragma unroll
            for (int r = 0; r < 17; ++r) acc[r] = 0.f;
            for (int k = kq * 128; k < kq * 128 + 128; k += 4) {
                float w[4];
#pragma unroll
                for (int j = 0; j < 4; ++j) w[j] = wada[(size_t)(k + j) * MODW + col0 + col];
#pragma unroll
                for (int r = 0; r < 17; ++r) { const f32x4 s4 = *(const LAS f32x4*)(sc + r * 1024 + k); acc[r] += s4.x * w[0] + s4.y * w[1] + s4.z * w[2] + s4.w * w[3]; }
            }
#pragma unroll
            for (int r = 0; r < 17; ++r) red[(kq * 17 + r) * 64 + col] = acc[r];
            __syncthreads();
            for (int i = C.tid; i < nr * 64; i += 512) { const int r = i >> 6, cc = i & 63; float s = 0.f;
#pragma unroll
                for (int q = 0; q < 8; ++q) s += red[(q * 17 + r) * 64 + cc];
                mod[(size_t)(r0 + r) * MODW + col0 + cc] = s + bada[col0 + cc]; }
        }
        __syncthreads();
    }
    {
        lfloat* scr = (lfloat*)(C.lds + C.wave * 16384);
        const int gw = C.bid * 8 + C.wave, NGW = C.G * 8;
        unsigned char* btin8 = A.ws + WS_BTIN; bf16_t* btout = WSP(bf16_t, WS_BTOUT); bf16_t* btr = WSP(bf16_t, WS_BTR);
        constexpr int I_IN = (D / 64) * 124, I_OUT = (D / 64) * (D / 32), I_R = (D / 64) * (NE / 32), I_G = (128 / 64) * (DA / 32);
        for (int it = gw; it < I_IN + I_OUT + I_R + I_G; it += NGW) {
            int r = it;
            if (r < I_IN) {
                const int kb = r / 124, nb = r % 124, k0 = 64 * kb, n0 = 32 * nb; const float* W = A.in[I_WIN];
#pragma unroll 8
                for (int i = 0; i < 32; ++i) { const int kk = 2 * i + (C.lane >> 5); scr[kk * 33 + (C.lane & 31)] = W[(size_t)(k0 + kk) * IN_COLS + n0 + (C.lane & 31)] * SWIN; }
                asm volatile("s_waitcnt lgkmcnt(0)" ::: "memory");
                const int c = C.lane & 7;
#pragma unroll
                for (int j = 0; j < 4; ++j) { const int n = (C.lane >> 3) + 8 * j; const lfloat* s = scr + (8 * c) * 33 + n;
                    u32x2 o; o.x = pk4_fp8(s[0 * 33], s[1 * 33], s[2 * 33], s[3 * 33]); o.y = pk4_fp8(s[4 * 33], s[5 * 33], s[6 * 33], s[7 * 33]);
                    *(u32x2*)(btin8 + (size_t)(n0 + n) * D + k0 + 8 * c) = o; }
                asm volatile("s_waitcnt lgkmcnt(0)" ::: "memory");
                continue; }
            r -= I_IN;
            if (r < I_OUT) { transpose_item(A.in[I_WOUT], D, D, btout, RowId(), scr, r, C.lane); continue; } r -= I_OUT;
            if (r < I_R) { transpose_item(A.in[I_RW], D, NE, btr, RowId(), scr, r, C.lane); continue; } r -= I_R;
            transpose_item(A.in[I_GUP], 128, DA, WSP(bf16_t, WS_GUPT), RowId(), scr, r, C.lane);
        }
        for (int i = C.bid * 512 + C.tid; i < 16 * D / 4; i += C.G * 512) { const int n = 3968 + (i >> 8), k = (i & 255) * 4; const float* W = A.in[I_WIN];
            *(unsigned*)(btin8 + (size_t)n * D + k) = pk4_fp8(W[(size_t)k * IN_COLS + n] * SWIN, W[(size_t)(k + 1) * IN_COLS + n] * SWIN, W[(size_t)(k + 2) * IN_COLS + n] * SWIN, W[(size_t)(k + 3) * IN_COLS + n] * SWIN); }
        for (int i = C.bid * 512 + C.tid; i < (PLD - IN_COLS) * D / 16; i += C.G * 512) ((u32x4*)(btin8 + (size_t)IN_COLS * D))[i] = (u32x4){0u, 0u, 0u, 0u};
    }
}

__device__ __forceinline__ void phase_p1(const Args& A, Ctx& C) {
    const float* mod = WSP(float, WS_MOD); bf16_t* xn = WSP(bf16_t, WS_XN);
    const int gw = C.bid * 8 + C.wave, NGW = C.G * 8;
    for (int row = gw; row < NROWS; row += NGW) {
        const float* xr; int mb;
        if (row < NLAT) { xr = A.in[I_X] + (size_t)row * D; mb = row >> 11; } else { xr = A.in[I_CTX] + (size_t)(row - NLAT) * D; mb = 32; }
        const float* m = mod + (size_t)mb * MODW;
        norm_mod_row(xr, A.in[I_N1G], m + D, m, nullptr, C.lane, (unsigned*)(A.ws + WS_XN) + (size_t)row * (D / 4));
    }
}

__device__ __forceinline__ float bfsel(unsigned w, unsigned sh) { return __builtin_bit_cast(float, (w << sh) & 0xffff0000u); }
template <int NK>
__device__ __forceinline__ f32x4 mm_tile(const lbyte* Ap, int lda, const lbyte* Bp, int ldb, f32x4 acc, int lane) {
    const int r = lane & 15, g = lane >> 4;
#pragma unroll
    for (int ks = 0; ks < NK; ++ks) {
        const bf16x8 a = *(const LAS bf16x8*)(Ap + r * lda + ks * 64 + g * 16);
        const bf16x8 b = *(const LAS bf16x8*)(Bp + r * ldb + ks * 64 + g * 16);
        acc = __builtin_amdgcn_mfma_f32_16x16x32_bf16(a, b, acc, 0, 0, 0);
    }
    return acc;
}

__device__ __forceinline__ void st_bf16x4(lbyte* p, f32x4 v) { u32x2 w; w.x = cvtpk(v.x, v.y); w.y = cvtpk(v.z, v.w); *(LAS u32x2*)p = w; }
__device__ __forceinline__ void st_bf16(lbyte* p, float v) { *(LAS unsigned short*)p = (unsigned short)cvtpk(v, v); }
__device__ __forceinline__ float rdlane(float v, int l) { return __builtin_bit_cast(float, __builtin_amdgcn_readlane(__builtin_bit_cast(int, v), l)); }

__device__ __forceinline__ void tri_inv16(const f32x4 m, int lane, lbyte* scr, float (&X)[16]) {
    *(LAS f32x4*)(scr + (lane & 15) * 64 + (lane >> 4) * 16) = m;
    asm volatile("s_waitcnt lgkmcnt(0)" ::: "memory");
    float Mr[16];
#pragma unroll
    for (int kq = 0; kq < 4; ++kq) { const f32x4 r = *(const LAS f32x4*)(scr + (lane & 15) * 64 + kq * 16); Mr[4 * kq] = r.x; Mr[4 * kq + 1] = r.y; Mr[4 * kq + 2] = r.z; Mr[4 * kq + 3] = r.w; }
    const int l16 = lane & 15;
    X[0] = (l16 == 0) ? 1.f : 0.f;
    { float a0 = (l16 == 1) ? 1.f : 0.f, a1 = 0.f, a2 = 0.f, a3 = 0.f;
      asm("s_nop 1\n\t" "v_fmac_f32_dpp %0, -%2, %3 row_newbcast:1 row_mask:0xf bank_mask:0xf\n\t" : "+v"(a0), "+v"(a1) : "v"(Mr[0]), "v"(X[0]));
      X[1] = (a0 + a1) + (a2 + a3); }
    { float a0 = (l16 == 2) ? 1.f : 0.f, a1 = 0.f, a2 = 0.f, a3 = 0.f;
      asm("s_nop 1\n\t" "v_fmac_f32_dpp %0, -%2, %3 row_newbcast:2 row_mask:0xf bank_mask:0xf\n\t" "v_fmac_f32_dpp %1, -%4, %5 row_newbcast:2 row_mask:0xf bank_mask:0xf\n\t" : "+v"(a0), "+v"(a1) : "v"(Mr[0]), "v"(X[0]), "v"(Mr[1]), "v"(X[1]));
      X[2] = (a0 + a1) + (a2 + a3); }
    { float a0 = (l16 == 3) ? 1.f : 0.f, a1 = 0.f, a2 = 0.f, a3 = 0.f;
      asm("s_nop 1\n\t" "v_fmac_f32_dpp %0, -%2, %3 row_newbcast:3 row_mask:0xf bank_mask:0xf\n\t" "v_fmac_f32_dpp %1, -%4, %5 row_newbcast:3 row_mask:0xf bank_mask:0xf\n\t" : "+v"(a0), "+v"(a1) : "v"(Mr[0]), "v"(X[0]), "v"(Mr[1]), "v"(X[1]));
      asm("s_nop 1\n\t" "v_fmac_f32_dpp %0, -%2, %3 row_newbcast:3 row_mask:0xf bank_mask:0xf\n\t" : "+v"(a2), "+v"(a3) : "v"(Mr[2]), "v"(X[2]));
      X[3] = (a0 + a1) + (a2 + a3); }
    { float a0 = (l16 == 4) ? 1.f : 0.f, a1 = 0.f, a2 = 0.f, a3 = 0.f;
      asm("s_nop 1\n\t" "v_fmac_f32_dpp %0, -%2, %3 row_newbcast:4 row_mask:0xf bank_mask:0xf\n\t" "v_fmac_f32_dpp %1, -%4, %5 row_newbcast:4 row_mask:0xf bank_mask:0xf\n\t" : "+v"(a0), "+v"(a1) : "v"(Mr[0]), "v"(X[0]), "v"(Mr[1]), "v"(X[1]));
      asm("s_nop 1\n\t" "v_fmac_f32_dpp %0, -%2, %3 row_newbcast:4 row_mask:0xf bank_mask:0xf\n\t" "v_fmac_f32_dpp %1, -%4, %5 row_newbcast:4 row_mask:0xf bank_mask:0xf\n\t" : "+v"(a2), "+v"(a3) : "v"(Mr[2]), "v"(X[2]), "v"(Mr[3]), "v"(X[3]));
      X[4] = (a0 + a1) + (a2 + a3); }
    { float a0 = (l16 == 5) ? 1.f : 0.f, a1 = 0.f, a2 = 0.f, a3 = 0.f;
      asm("s_nop 1\n\t" "v_fmac_f32_dpp %0, -%2, %3 row_newbcast:5 row_mask:0xf bank_mask:0xf\n\t" "v_fmac_f32_dpp %1, -%4, %5 row_newbcast:5 row_mask:0xf bank_mask:0xf\n\t" "v_fmac_f32_dpp %0, -%6, %7 row_newbcast:5 row_mask:0xf bank_mask:0xf\n\t" : "+v"(a0), "+v"(a1) : "v"(Mr[0]), "v"(X[0]), "v"(Mr[1]), "v"(X[1]), "v"(Mr[4]), "v"(X[4]));
      asm("s_nop 1\n\t" "v_fmac_f32_dpp %0, -%2, %3 row_newbcast:5 row_mask:0xf bank_mask:0xf\n\t" "v_fmac_f32_dpp %1, -%4, %5 row_newbcast:5 row_mask:0xf bank_mask:0xf\n\t" : "+v"(a2), "+v"(a3) : "v"(Mr[2]), "v"(X[2]), "v"(Mr[3]), "v"(X[3]));
      X[5] = (a0 + a1) + (a2 + a3); }
    { float a0 = (l16 == 6) ? 1.f : 0.f, a1 = 0.f, a2 = 0.f, a3 = 0.f;
      asm("s_nop 1\n\t" "v_fmac_f32_dpp %0, -%2, %3 row_newbcast:6 row_mask:0xf bank_mask:0xf\n\t" "v_fmac_f32_dpp %1, -%4, %5 row_newbcast:6 row_mask:0xf bank_mask:0xf\n\t" "v_fmac_f32_dpp %0, -%6, %7 row_newbcast:6 row_mask:0xf bank_mask:0xf\n\t" "v_fmac_f32_dpp %1, -%8, %9 row_newbcast:6 row_mask:0xf bank_mask:0xf\n\t" : "+v"(a0), "+v"(a1) : "v"(Mr[0]), "v"(X[0]), "v"(Mr[1]), "v"(X[1]), "v"(Mr[4]), "v"(X[4]), "v"(Mr[5]), "v"(X[5]));
      asm("s_nop 1\n\t" "v_fmac_f32_dpp %0, -%2, %3 row_newbcast:6 row_mask:0xf bank_mask:0xf\n\t" "v_fmac_f32_dpp %1, -%4, %5 row_newbcast:6 row_mask:0xf bank_mask:0xf\n\t" : "+v"(a2), "+v"(a3) : "v"(Mr[2]), "v"(X[2]), "v"(Mr[3]), "v"(X[3]));
      X[6] = (a0 + a1) + (a2 + a3); }
    { float a0 = (l16 == 7) ? 1.f : 0.f, a1 = 0.f, a2 = 0.f, a3 = 0.f;
      asm("s_nop 1\n\t" "v_fmac_f32_dpp %0, -%2, %3 row_newbcast:7 row_mask:0xf bank_mask:0xf\n\t" "v_fmac_f32_dpp %1, -%4, %5 row_newbcast:7 row_mask:0xf bank_mask:0xf\n\t" "v_fmac_f32_dpp %0, -%6, %7 row_newbcast:7 row_mask:0xf bank_mask:0xf\n\t" "v_fmac_f32_dpp %1, -%8, %9 row_newbcast:7 row_mask:0xf bank_mask:0xf\n\t" : "+v"(a0), "+v"(a1) : "v"(Mr[0]), "v"(X[0]), "v"(Mr[1]), "v"(X[1]), "v"(Mr[4]), "v"(X[4]), "v"(Mr[5]), "v"(X[5]));
      asm("s_nop 1\n\t" "v_fmac_f32_dpp %0, -%2, %3 row_newbcast:7 row_mask:0xf bank_mask:0xf\n\t" "v_fmac_f32_dpp %1, -%4, %5 row_newbcast:7 row_mask:0xf bank_mask:0xf\n\t" "v_fmac_f32_dpp %0, -%6, %7 row_newbcast:7 row_mask:0xf bank_mask:0xf\n\t" : "+v"(a2), "+v"(a3) : "v"(Mr[2]), "v"(X[2]), "v"(Mr[3]), "v"(X[3]), "v"(Mr[6]), "v"(X[6]));
      X[7] = (a0 + a1) + (a2 + a3); }
    { float a0 = (l16 == 8) ? 1.f : 0.f, a1 = 0.f, a2 = 0.f, a3 = 0.f;
      asm("s_nop 1\n\t" "v_fmac_f32_dpp %0, -%2, %3 row_newbcast:8 row_mask:0xf bank_mask:0xf\n\t" "v_fmac_f32_dpp %1, -%4, %5 row_newbcast:8 row_mask:0xf bank_mask:0xf\n\t" "v_fmac_f32_dpp %0, -%6, %7 row_newbcast:8 row_mask:0xf bank_mask:0xf\n\t" "v_fmac_f32_dpp %1, -%8, %9 row_newbcast:8 row_mask:0xf bank_mask:0xf\n\t" : "+v"(a0), "+v"(a1) : "v"(Mr[0]), "v"(X[0]), "v"(Mr[1]), "v"(X[1]), "v"(Mr[4]), "v"(X[4]), "v"(Mr[5]), "v"(X[5]));
      asm("s_nop 1\n\t" "v_fmac_f32_dpp %0, -%2, %3 row_newbcast:8 row_mask:0xf bank_mask:0xf\n\t" "v_fmac_f32_dpp %1, -%4, %5 row_newbcast:8 row_mask:0xf bank_mask:0xf\n\t" "v_fmac_f32_dpp %0, -%6, %7 row_newbcast:8 row_mask:0xf bank_mask:0xf\n\t" "v_fmac_f32_dpp %1, -%8, %9 row_newbcast:8 row_mask:0xf bank_mask:0xf\n\t" : "+v"(a2), "+v"(a3) : "v"(Mr[2]), "v"(X[2]), "v"(Mr[3]), "v"(X[3]), "v"(Mr[6]), "v"(X[6]), "v"(Mr[7]), "v"(X[7]));
      X[8] = (a0 + a1) + (a2 + a3); }
    { float a0 = (l16 == 9) ? 1.f : 0.f, a1 = 0.f, a2 = 0.f, a3 = 0.f;
      asm("s_nop 1\n\t" "v_fmac_f32_dpp %0, -%2, %3 row_newbcast:9 row_mask:0xf bank_mask:0xf\n\t" "v_fmac_f32_dpp %1, -%4, %5 row_newbcast:9 row_mask:0xf bank_mask:0xf\n\t" "v_fmac_f32_dpp %0, -%6, %7 row_newbcast:9 row_mask:0xf bank_mask:0xf\n\t" "v_fmac_f32_dpp %1, -%8, %9 row_newbcast:9 row_mask:0xf bank_mask:0xf\n\t" "v_fmac_f32_dpp %0, -%10, %11 row_newbcast:9 row_mask:0xf bank_mask:0xf\n\t" : "+v"(a0), "+v"(a1) : "v"(Mr[0]), "v"(X[0]), "v"(Mr[1]), "v"(X[1]), "v"(Mr[4]), "v"(X[4]), "v"(Mr[5]), "v"(X[5]), "v"(Mr[8]), "v"(X[8]));
      asm("s_nop 1\n\t" "v_fmac_f32_dpp %0, -%2, %3 row_newbcast:9 row_mask:0xf bank_mask:0xf\n\t" "v_fmac_f32_dpp %1, -%4, %5 row_newbcast:9 row_mask:0xf bank_mask:0xf\n\t" "v_fmac_f32_dpp %0, -%6, %7 row_newbcast:9 row_mask:0xf bank_mask:0xf\n\t" "v_fmac_f32_dpp %1, -%8, %9 row_newbcast:9 row_mask:0xf bank_mask:0xf\n\t" : "+v"(a2), "+v"(a3) : "v"(Mr[2]), "v"(X[2]), "v"(Mr[3]), "v"(X[3]), "v"(Mr[6]), "v"(X[6]), "v"(Mr[7]), "v"(X[7]));
      X[9] = (a0 + a1) + (a2 + a3); }
    { float a0 = (l16 == 10) ? 1.f : 0.f, a1 = 0.f, a2 = 0.f, a3 = 0.f;
      asm("s_nop 1\n\t" "v_fmac_f32_dpp %0, -%2, %3 row_newbcast:10 row_mask:0xf bank_mask:0xf\n\t" "v_fmac_f32_dpp %1, -%4, %5 row_newbcast:10 row_mask:0xf bank_mask:0xf\n\t" "v_fmac_f32_dpp %0, -%6, %7 row_newbcast:10 row_mask:0xf bank_mask:0xf\n\t" "v_fmac_f32_dpp %1, -%8, %9 row_newbcast:10 row_mask:0xf bank_mask:0xf\n\t" "v_fmac_f32_dpp %0, -%10, %11 row_newbcast:10 row_mask:0xf bank_mask:0xf\n\t" "v_fmac_f32_dpp %1, -%12, %13 row_newbcast:10 row_mask:0xf bank_mask:0xf\n\t" : "+v"(a0), "+v"(a1) : "v"(Mr[0]), "v"(X[0]), "v"(Mr[1]), "v"(X[1]), "v"(Mr[4]), "v"(X[4]), "v"(Mr[5]), "v"(X[5]), "v"(Mr[8]), "v"(X[8]), "v"(Mr[9]), "v"(X[9]));
      asm("s_nop 1\n\t" "v_fmac_f32_dpp %0, -%2, %3 row_newbcast:10 row_mask:0xf bank_mask:0xf\n\t" "v_fmac_f32_dpp %1, -%4, %5 row_newbcast:10 row_mask:0xf bank_mask:0xf\n\t" "v_fmac_f32_dpp %0, -%6, %7 row_newbcast:10 row_mask:0xf bank_mask:0xf\n\t" "v_fmac_f32_dpp %1, -%8, %9 row_newbcast:10 row_mask:0xf bank_mask:0xf\n\t" : "+v"(a2), "+v"(a3) : "v"(Mr[2]), "v"(X[2]), "v"(Mr[3]), "v"(X[3]), "v"(Mr[6]), "v"(X[6]), "v"(Mr[7]), "v"(X[7]));
      X[10] = (a0 + a1) + (a2 + a3); }
    { float a0 = (l16 == 11) ? 1.f : 0.f, a1 = 0.f, a2 = 0.f, a3 = 0.f;
      asm("s_nop 1\n\t" "v_fmac_f32_dpp %0, -%2, %3 row_newbcast:11 row_mask:0xf bank_mask:0xf\n\t" "v_fmac_f32_dpp %1, -%4, %5 row_newbcast:11 row_mask:0xf bank_mask:0xf\n\t" "v_fmac_f32_dpp %0, -%6, %7 row_newbcast:11 row_mask:0xf bank_mask:0xf\n\t" "v_fmac_f32_dpp %1, -%8, %9 row_newbcast:11 row_mask:0xf bank_mask:0xf\n\t" "v_fmac_f32_dpp %0, -%10, %11 row_newbcast:11 row_mask:0xf bank_mask:0xf\n\t" "v_fmac_f32_dpp %1, -%12, %13 row_newbcast:11 row_mask:0xf bank_mask:0xf\n\t" : "+v"(a0), "+v"(a1) : "v"(Mr[0]), "v"(X[0]), "v"(Mr[1]), "v"(X[1]), "v"(Mr[4]), "v"(X[4]), "v"(Mr[5]), "v"(X[5]), "v"(Mr[8]), "v"(X[8]), "v"(Mr[9]), "v"(X[9]));
      asm("s_nop 1\n\t" "v_fmac_f32_dpp %0, -%2, %3 row_newbcast:11 row_mask:0xf bank_mask:0xf\n\t" "v_fmac_f32_dpp %1, -%4, %5 row_newbcast:11 row_mask:0xf bank_mask:0xf\n\t" "v_fmac_f32_dpp %0, -%6, %7 row_newbcast:11 row_mask:0xf bank_mask:0xf\n\t" "v_fmac_f32_dpp %1, -%8, %9 row_newbcast:11 row_mask:0xf bank_mask:0xf\n\t" "v_fmac_f32_dpp %0, -%10, %11 row_newbcast:11 row_mask:0xf bank_mask:0xf\n\t" : "+v"(a2), "+v"(a3) : "v"(Mr[2]), "v"(X[2]), "v"(Mr[3]), "v"(X[3]), "v"(Mr[6]), "v"(X[6]), "v"(Mr[7]), "v"(X[7]), "v"(Mr[10]), "v"(X[10]));
      X[11] = (a0 + a1) + (a2 + a3); }
    { float a0 = (l16 == 12) ? 1.f : 0.f, a1 = 0.f, a2 = 0.f, a3 = 0.f;
      asm("s_nop 1\n\t" "v_fmac_f32_dpp %0, -%2, %3 row_newbcast:12 row_mask:0xf bank_mask:0xf\n\t" "v_fmac_f32_dpp %1, -%4, %5 row_newbcast:12 row_mask:0xf bank_mask:0xf\n\t" "v_fmac_f32_dpp %0, -%6, %7 row_newbcast:12 row_mask:0xf bank_mask:0xf\n\t" "v_fmac_f32_dpp %1, -%8, %9 row_newbcast:12 row_mask:0xf bank_mask:0xf\n\t" "v_fmac_f32_dpp %0, -%10, %11 row_newbcast:12 row_mask:0xf bank_mask:0xf\n\t" "v_fmac_f32_dpp %1, -%12, %13 row_newbcast:12 row_mask:0xf bank_mask:0xf\n\t" : "+v"(a0), "+v"(a1) : "v"(Mr[0]), "v"(X[0]), "v"(Mr[1]), "v"(X[1]), "v"(Mr[4]), "v"(X[4]), "v"(Mr[5]), "v"(X[5]), "v"(Mr[8]), "v"(X[8]), "v"(Mr[9]), "v"(X[9]));
      asm("s_nop 1\n\t" "v_fmac_f32_dpp %0, -%2, %3 row_newbcast:12 row_mask:0xf bank_mask:0xf\n\t" "v_fmac_f32_dpp %1, -%4, %5 row_newbcast:12 row_mask:0xf bank_mask:0xf\n\t" "v_fmac_f32_dpp %0, -%6, %7 row_newbcast:12 row_mask:0xf bank_mask:0xf\n\t" "v_fmac_f32_dpp %1, -%8, %9 row_newbcast:12 row_mask:0xf bank_mask:0xf\n\t" "v_fmac_f32_dpp %0, -%10, %11 row_newbcast:12 row_mask:0xf bank_mask:0xf\n\t" "v_fmac_f32_dpp %1, -%12, %13 row_newbcast:12 row_mask:0xf bank_mask:0xf\n\t" : "+v"(a2), "+v"(a3) : "v"(Mr[2]), "v"(X[2]), "v"(Mr[3]), "v"(X[3]), "v"(Mr[6]), "v"(X[6]), "v"(Mr[7]), "v"(X[7]), "v"(Mr[10]), "v"(X[10]), "v"(Mr[11]), "v"(X[11]));
      X[12] = (a0 + a1) + (a2 + a3); }
    { float a0 = (l16 == 13) ? 1.f : 0.f, a1 = 0.f, a2 = 0.f, a3 = 0.f;
      asm("s_nop 1\n\t" "v_fmac_f32_dpp %0, -%2, %3 row_newbcast:13 row_mask:0xf bank_mask:0xf\n\t" "v_fmac_f32_dpp %1, -%4, %5 row_newbcast:13 row_mask:0xf bank_mask:0xf\n\t" "v_fmac_f32_dpp %0, -%6, %7 row_newbcast:13 row_mask:0xf bank_mask:0xf\n\t" "v_fmac_f32_dpp %1, -%8, %9 row_newbcast:13 row_mask:0xf bank_mask:0xf\n\t" "v_fmac_f32_dpp %0, -%10, %11 row_newbcast:13 row_mask:0xf bank_mask:0xf\n\t" "v_fmac_f32_dpp %1, -%12, %13 row_newbcast:13 row_mask:0xf bank_mask:0xf\n\t" "v_fmac_f32_dpp %0, -%14, %15 row_newbcast:13 row_mask:0xf bank_mask:0xf\n\t" : "+v"(a0), "+v"(a1) : "v"(Mr[0]), "v"(X[0]), "v"(Mr[1]), "v"(X[1]), "v"(Mr[4]), "v"(X[4]), "v"(Mr[5]), "v"(X[5]), "v"(Mr[8]), "v"(X[8]), "v"(Mr[9]), "v"(X[9]), "v"(Mr[12]), "v"(X[12]));
      asm("s_nop 1\n\t" "v_fmac_f32_dpp %0, -%2, %3 row_newbcast:13 row_mask:0xf bank_mask:0xf\n\t" "v_fmac_f32_dpp %1, -%4, %5 row_newbcast:13 row_mask:0xf bank_mask:0xf\n\t" "v_fmac_f32_dpp %0, -%6, %7 row_newbcast:13 row_mask:0xf bank_mask:0xf\n\t" "v_fmac_f32_dpp %1, -%8, %9 row_newbcast:13 row_mask:0xf bank_mask:0xf\n\t" "v_fmac_f32_dpp %0, -%10, %11 row_newbcast:13 row_mask:0xf bank_mask:0xf\n\t" "v_fmac_f32_dpp %1, -%12, %13 row_newbcast:13 row_mask:0xf bank_mask:0xf\n\t" : "+v"(a2), "+v"(a3) : "v"(Mr[2]), "v"(X[2]), "v"(Mr[3]), "v"(X[3]), "v"(Mr[6]), "v"(X[6]), "v"(Mr[7]), "v"(X[7]), "v"(Mr[10]), "v"(X[10]), "v"(Mr[11]), "v"(X[11]));
      X[13] = (a0 + a1) + (a2 + a3); }
    { float a0 = (l16 == 14) ? 1.f : 0.f, a1 = 0.f, a2 = 0.f, a3 = 0.f;
      asm("s_nop 1\n\t" "v_fmac_f32_dpp %0, -%2, %3 row_newbcast:14 row_mask:0xf bank_mask:0xf\n\t" "v_fmac_f32_dpp %1, -%4, %5 row_newbcast:14 row_mask:0xf bank_mask:0xf\n\t" "v_fmac_f32_dpp %0, -%6, %7 row_newbcast:14 row_mask:0xf bank_mask:0xf\n\t" "v_fmac_f32_dpp %1, -%8, %9 row_newbcast:14 row_mask:0xf bank_mask:0xf\n\t" "v_fmac_f32_dpp %0, -%10, %11 row_newbcast:14 row_mask:0xf bank_mask:0xf\n\t" "v_fmac_f32_dpp %1, -%12, %13 row_newbcast:14 row_mask:0xf bank_mask:0xf\n\t" "v_fmac_f32_dpp %0, -%14, %15 row_newbcast:14 row_mask:0xf bank_mask:0xf\n\t" "v_fmac_f32_dpp %1, -%16, %17 row_newbcast:14 row_mask:0xf bank_mask:0xf\n\t" : "+v"(a0), "+v"(a1) : "v"(Mr[0]), "v"(X[0]), "v"(Mr[1]), "v"(X[1]), "v"(Mr[4]), "v"(X[4]), "v"(Mr[5]), "v"(X[5]), "v"(Mr[8]), "v"(X[8]), "v"(Mr[9]), "v"(X[9]), "v"(Mr[12]), "v"(X[12]), "v"(Mr[13]), "v"(X[13]));
      asm("s_nop 1\n\t" "v_fmac_f32_dpp %0, -%2, %3 row_newbcast:14 row_mask:0xf bank_mask:0xf\n\t" "v_fmac_f32_dpp %1, -%4, %5 row_newbcast:14 row_mask:0xf bank_mask:0xf\n\t" "v_fmac_f32_dpp %0, -%6, %7 row_newbcast:14 row_mask:0xf bank_mask:0xf\n\t" "v_fmac_f32_dpp %1, -%8, %9 row_newbcast:14 row_mask:0xf bank_mask:0xf\n\t" "v_fmac_f32_dpp %0, -%10, %11 row_newbcast:14 row_mask:0xf bank_mask:0xf\n\t" "v_fmac_f32_dpp %1, -%12, %13 row_newbcast:14 row_mask:0xf bank_mask:0xf\n\t" : "+v"(a2), "+v"(a3) : "v"(Mr[2]), "v"(X[2]), "v"(Mr[3]), "v"(X[3]), "v"(Mr[6]), "v"(X[6]), "v"(Mr[7]), "v"(X[7]), "v"(Mr[10]), "v"(X[10]), "v"(Mr[11]), "v"(X[11]));
      X[14] = (a0 + a1) + (a2 + a3); }
    { float a0 = (l16 == 15) ? 1.f : 0.f, a1 = 0.f, a2 = 0.f, a3 = 0.f;
      asm("s_nop 1\n\t" "v_fmac_f32_dpp %0, -%2, %3 row_newbcast:15 row_mask:0xf bank_mask:0xf\n\t" "v_fmac_f32_dpp %1, -%4, %5 row_newbcast:15 row_mask:0xf bank_mask:0xf\n\t" "v_fmac_f32_dpp %0, -%6, %7 row_newbcast:15 row_mask:0xf bank_mask:0xf\n\t" "v_fmac_f32_dpp %1, -%8, %9 row_newbcast:15 row_mask:0xf bank_mask:0xf\n\t" "v_fmac_f32_dpp %0, -%10, %11 row_newbcast:15 row_mask:0xf bank_mask:0xf\n\t" "v_fmac_f32_dpp %1, -%12, %13 row_newbcast:15 row_mask:0xf bank_mask:0xf\n\t" "v_fmac_f32_dpp %0, -%14, %15 row_newbcast:15 row_mask:0xf bank_mask:0xf\n\t" "v_fmac_f32_dpp %1, -%16, %17 row_newbcast:15 row_mask:0xf bank_mask:0xf\n\t" : "+v"(a0), "+v"(a1) : "v"(Mr[0]), "v"(X[0]), "v"(Mr[1]), "v"(X[1]), "v"(Mr[4]), "v"(X[4]), "v"(Mr[5]), "v"(X[5]), "v"(Mr[8]), "v"(X[8]), "v"(Mr[9]), "v"(X[9]), "v"(Mr[12]), "v"(X[12]), "v"(Mr[13]), "v"(X[13]));
      asm("s_nop 1\n\t" "v_fmac_f32_dpp %0, -%2, %3 row_newbcast:15 row_mask:0xf bank_mask:0xf\n\t" "v_fmac_f32_dpp %1, -%4, %5 row_newbcast:15 row_mask:0xf bank_mask:0xf\n\t" "v_fmac_f32_dpp %0, -%6, %7 row_newbcast:15 row_mask:0xf bank_mask:0xf\n\t" "v_fmac_f32_dpp %1, -%8, %9 row_newbcast:15 row_mask:0xf bank_mask:0xf\n\t" "v_fmac_f32_dpp %0, -%10, %11 row_newbcast:15 row_mask:0xf bank_mask:0xf\n\t" "v_fmac_f32_dpp %1, -%12, %13 row_newbcast:15 row_mask:0xf bank_mask:0xf\n\t" "v_fmac_f32_dpp %0, -%14, %15 row_newbcast:15 row_mask:0xf bank_mask:0xf\n\t" : "+v"(a2), "+v"(a3) : "v"(Mr[2]), "v"(X[2]), "v"(Mr[3]), "v"(X[3]), "v"(Mr[6]), "v"(X[6]), "v"(Mr[7]), "v"(X[7]), "v"(Mr[10]), "v"(X[10]), "v"(Mr[11]), "v"(X[11]), "v"(Mr[14]), "v"(X[14]));
      X[15] = (a0 + a1) + (a2 + a3); }
}

#ifndef RWKV_REP
#define RWKV_REP 1
#endif
namespace rk {
constexpr int S64 = 160, S32 = 80, SW = 144;
constexpr int O_WUP = 0, O_AUP = O_WUP + 64 * SW, O_WLT = O_AUP + 64 * SW, O_ALT = O_WLT + 16 * S64, O_LW = O_ALT + 16 * S64, O_LA = O_LW + 4096,
              O_KKT = O_LA + 4096, O_RT = O_KKT + 16 * S64, O_BT = O_RT + 16 * S64, O_KDT = O_BT + 16 * S64,
              O_VT = O_KDT + 16 * S64, O_BHT = O_VT + 64 * S32, O_KHT = O_BHT + 64 * S32, O_UT = O_KHT + 64 * S32, O_UTT = O_WLT  ,
              O_TI = O_UT + 64 * S32, O_MK = O_TI + 16 * S32, O_NB = O_MK + 16 * S32, O_NK = O_NB + 16 * S32,
              O_SBF = O_NK + 16 * S32, O_WC = O_SBF + 64 * S64, O_WT = O_WC + 256, TEAM_BYTES = O_WT + 1024;
static_assert(2 * TEAM_BYTES <= LDS_MISC, "rwkv LDS");
}
__device__ __forceinline__ void rwkv_pair_chunked(const Args& A, Ctx& C, int pair) {
    using namespace rk;
    const int b = pair >> 3, h = pair & 7;
    const int dir = C.wave >> 2;
    const int t4 = C.tid & 255, q = C.wave & 3, lane = C.lane;
    lbyte* L = C.lds + dir * TEAM_BYTES;
    const bf16_t* P = WSP(bf16_t, WS_P);
    bf16_t* ydir = WSP(bf16_t, WS_YDIR) + (size_t)dir * NLAT * D;
    float* bon = WSP(float, WS_BON) + (size_t)dir * NLAT * 8;
    __syncthreads();
#pragma unroll 2
    for (int i = t4; i < 4096; i += 256) { const int l = i >> 6, c = i & 63;
        st_bf16(L + O_WUP + c * SW + l * 2, A.in[I_WUP][((size_t)dir * 64 + l) * DA + 64 * h + c]);
        st_bf16(L + O_AUP + c * SW + l * 2, A.in[I_AUP][((size_t)dir * 64 + l) * DA + 64 * h + c]); }
#pragma unroll 2
    for (int i = t4; i < (4 * 64 * S32 + 4 * 16 * S32 + 64 * S64) / 4; i += 256) ((LAS unsigned*)(L + O_VT))[i] = 0u;
    for (int i = t4; i < (2 * 16 * S64) / 4; i += 256) ((LAS unsigned*)(L + O_WLT))[i] = 0u;
    const int c = lane;
    const int col5[5] = {64 * h + c, 512 + 64 * h + c, 1024 + 64 * h + c, 1536 + 64 * dir + c, 1664 + 64 * dir + c};
    float mu5[5]; unsigned coff[5], nm[5], nlo[5], nrg[5]; int ndb[5];
#pragma unroll
    for (int e = 0; e < 5; ++e) { mu5[e] = A.in[I_MU][col5[e]]; coff[e] = (unsigned)col5[e] * 2u; }
    auto set_rules = [&](bool ctx) {
#pragma unroll
        for (int e = 0; e < 5; ++e) { const int col = col5[e];
            if (ctx) { nm[e] = 0xffffffffu; nlo[e] = col < 960 ? 1u : 0u; nrg[e] = (unsigned)(CTX - 2); ndb[e] = (col < 960 ? -PLD : PLD) * 2; }
            else { const int cls = col < 480 ? 0 : (col < 960 ? 1 : (col < 1440 ? 2 : 3));
                nm[e] = cls < 2 ? 63u : 0xffffffffu; nlo[e] = cls == 0 ? 1u : (cls == 2 ? 64u : 0u); nrg[e] = cls < 2 ? 62u : (unsigned)(SEQ - 65);
                ndb[e] = (cls == 0 ? -PLD : (cls == 1 ? PLD : (cls == 2 ? -64 * PLD : 64 * PLD))) * 2; } } };
    set_rules(true);
    const char* wsb = (const char*)A.ws;
    const float kkc = A.in[I_KK][64 * h + c], kac = A.in[I_KA][64 * h + c], rkc = A.in[I_RK][64 * h + c];
    const float w0c = A.in[I_W0][dir * DA + 64 * h + c], a0c = A.in[I_A0][dir * DA + 64 * h + c];
    f32x4 Sacc[4];
#pragma unroll
    for (int i = 0; i < 4; ++i) Sacc[i] = (f32x4){0.f, 0.f, 0.f, 0.f};
    const int fr = lane & 15, fg = lane >> 4;
    unsigned short rawp[4][5], raws[4][5];
    auto chunk_geom = [&](int ch, bool& isctx, int& sbase, int& T, size_t& rowbase) { isctx = ch < 16; sbase = isctx ? ch * 16 : (ch - 16) * 16; T = isctx ? CTX : SEQ; rowbase = isctx ? (size_t)NLAT + (size_t)b * CTX : (size_t)b * SEQ; };
    auto issue_loads = [&](int ch) { bool isctx; int sbase, T; size_t rowbase; chunk_geom(ch, isctx, sbase, T, rowbase);
#pragma unroll
        for (int j = 0; j < 4; ++j) { const int i = 4 * q + j; const int t = __builtin_amdgcn_readfirstlane(dir ? (T - 1 - (sbase + i)) : (sbase + i));
            const unsigned rowoff = (unsigned)WS_P + (unsigned)(rowbase + t) * (unsigned)(PLD * 2);
#pragma unroll
            for (int e = 0; e < 5; ++e) { const unsigned vs = rowoff + coff[e]; const bool ok = (((unsigned)t & nm[e]) - nlo[e]) <= nrg[e]; const unsigned vn = ok ? vs + (unsigned)ndb[e] : 8u;
                rawp[j][e] = *(const bf16_t*)(wsb + vs); raws[j][e] = *(const bf16_t*)(wsb + vn); } } };
    u32x2 ypend; ypend.x = 0u; ypend.y = 0u; float bpend[4] = {0.f, 0.f, 0.f, 0.f};
    auto flush = [&](int pch) { bool pisctx; int psb, pT; size_t prb; chunk_geom(pch, pisctx, psb, pT, prb);
        if (!pisctx) { const int t = dir ? (pT - 1 - (psb + fr)) : (psb + fr);
            *(u32x2*)(ydir + ((size_t)b * SEQ + t) * D + 64 * h + 16 * q + 4 * fg) = ypend;
            if (lane == 0) {
#pragma unroll
                for (int j = 0; j < 4; ++j) { const int i = 4 * q + j; const int tj = dir ? (pT - 1 - (psb + i)) : (psb + i); bon[((size_t)b * SEQ + tj) * 8 + h] = bpend[j]; } } } };
    issue_loads(0);
    for (int ch = 0; ch < 144; ++ch) {
        bool isctx; int sbase, T; size_t rowbase; chunk_geom(ch, isctx, sbase, T, rowbase);
        float vr[4], vk[4], vv[4], vkk[4], lw[4], av[4];
        __syncthreads();
        float mxa[4][5];
#pragma unroll
        for (int j = 0; j < 4; ++j) {
#pragma unroll
            for (int e = 0; e < 5; ++e) { const float pv = bf2f(rawp[j][e]); const float sv = bf2f(raws[j][e]); mxa[j][e] = pv + mu5[e] * (sv - pv); } }
        asm volatile("" :: "v"(mxa[0][0]), "v"(mxa[0][1]), "v"(mxa[0][2]), "v"(mxa[0][3]), "v"(mxa[0][4]), "v"(mxa[1][0]), "v"(mxa[1][1]), "v"(mxa[1][2]), "v"(mxa[1][3]), "v"(mxa[1][4]),
                        "v"(mxa[2][0]), "v"(mxa[2][1]), "v"(mxa[2][2]), "v"(mxa[2][3]), "v"(mxa[2][4]), "v"(mxa[3][0]), "v"(mxa[3][1]), "v"(mxa[3][2]), "v"(mxa[3][3]), "v"(mxa[3][4]) : "memory");
        if (ch > 0) flush(ch - 1);
        if (ch == 15) set_rules(false);
        if (ch + 1 < 144) issue_loads(ch + 1);
        float cl[4];
        _Pragma("unroll") for (int rrep = 0; rrep < RWKV_REP; ++rrep) {
#pragma unroll
        for (int j = 0; j < 4; ++j) {
            const int i = 4 * q + j;
            float mx[5];
#pragma unroll
            for (int e = 0; e < 5; ++e) mx[e] = mxa[j][e];
            vr[j] = mx[0]; vk[j] = mx[1]; vv[j] = mx[2];
            *(LAS unsigned short*)(L + O_WLT + i * S64 + c * 2) = (unsigned short)cvtpk(tanhf_(mx[3]), 0.f); *(LAS unsigned short*)(L + O_ALT + i * S64 + c * 2) = (unsigned short)cvtpk(mx[4], 0.f);
            const float kx = vk[j] * kkc; const float ss = wave_sum(kx * kx);
            vkk[j] = kx * __builtin_amdgcn_rsqf(ss + 1e-6f);
        }
        __syncthreads();
        {
            const f32x4 z = (f32x4){0.f, 0.f, 0.f, 0.f};
            const f32x4 tw = mm_tile<2>(L + O_WLT, S64, L + O_WUP + 16 * q * SW, SW, z, lane);
            const f32x4 ta = mm_tile<2>(L + O_ALT, S64, L + O_AUP + 16 * q * SW, SW, z, lane);
#pragma unroll
            for (int e = 0; e < 4; ++e) { ((LAS float*)(L + O_LW))[(4 * fg + e) * 64 + 16 * q + fr] = tw[e]; ((LAS float*)(L + O_LA))[(4 * fg + e) * 64 + 16 * q + fr] = ta[e]; }
        }
        __syncthreads();
        { float run = 0.f;
#pragma unroll
        for (int j = 0; j < 4; ++j) { const int i = 4 * q + j;
            const float wlog = -softplusf_(-(w0c + ((LAS float*)(L + O_LW))[i * 64 + c])) - 0.5f;
            lw[j] = -__expf(wlog);
            av[j] = sigmoidf_(a0c + ((LAS float*)(L + O_LA))[i * 64 + c]);
            run += lw[j]; cl[j] = run; }
        ((LAS float*)(L + O_WT))[q * 64 + c] = run; }
        __syncthreads();
        }
        {
            float off = 0.f, cumC = 0.f;
#pragma unroll
            for (int qq = 0; qq < 4; ++qq) { const float tv = ((LAS float*)(L + O_WT))[qq * 64 + c]; cumC += tv; off += (qq < q) ? tv : 0.f; }
            float tv_[4], tb_[4], tk_[4];
            float Wprev = __expf(off); const float eC = __expf(cumC);
#pragma unroll
            for (int j = 0; j < 4; ++j) { const int i = 4 * q + j;
                const float cum = off + cl[j];
                const float Wt = __expf(cum), Wp = Wprev, Wi = __builtin_amdgcn_rcpf(Wt), Wc = eC * Wi; Wprev = Wt;
                const float kd = vk[j] * (1.f + (av[j] - 1.f) * kac), bb = vkk[j] * av[j];
                const unsigned p0 = cvtpk(vkk[j] * Wp, vr[j] * Wt), p1 = cvtpk(bb * Wi, kd * Wi);
                *(LAS unsigned short*)(L + O_KKT + i * S64 + c * 2) = (unsigned short)p0; *(LAS unsigned short*)(L + O_RT + i * S64 + c * 2) = (unsigned short)(p0 >> 16);
                *(LAS unsigned short*)(L + O_BT + i * S64 + c * 2) = (unsigned short)p1; *(LAS unsigned short*)(L + O_KDT + i * S64 + c * 2) = (unsigned short)(p1 >> 16);
                tv_[j] = vv[j]; tb_[j] = bb * Wc; tk_[j] = kd * Wc;
                const float bs = wave_sum(vr[j] * kd * rkc);
                bpend[j] = bs;
            }
            { u32x2 w2;
                w2.x = cvtpk(tv_[0], tv_[1]); w2.y = cvtpk(tv_[2], tv_[3]); *(LAS u32x2*)(L + O_VT + c * S32 + q * 8) = w2;
                w2.x = cvtpk(tb_[0], tb_[1]); w2.y = cvtpk(tb_[2], tb_[3]); *(LAS u32x2*)(L + O_BHT + c * S32 + q * 8) = w2;
                w2.x = cvtpk(tk_[0], tk_[1]); w2.y = cvtpk(tk_[2], tk_[3]); *(LAS u32x2*)(L + O_KHT + c * S32 + q * 8) = w2; }
            if (q == 3) ((LAS float*)(L + O_WC))[c] = eC;
        }
        __syncthreads();
        {
            const int role = (q + dir) & 3;
            const lbyte* Aj = L + ((role & 1) ? O_KDT : O_BT);
            const lbyte* Bt = L + ((role & 2) ? O_RT : O_KKT);
            f32x4 g4 = mm_tile<2>(Aj, S64, Bt, S64, (f32x4){0.f, 0.f, 0.f, 0.f}, lane);
#pragma unroll
            for (int e = 0; e < 4; ++e) { const int j = 4 * fg + e; const bool keep = (role & 2) ? (j <= fr) : (j < fr); g4[e] = keep ? g4[e] : 0.f; }
            if (role == 0) { float X[16]; tri_inv16(g4, lane, L + O_LW, X);
                if (lane < 16) {
#pragma unroll
                    for (int i = 0; i < 16; ++i) *(LAS unsigned short*)(L + O_TI + i * S32 + lane * 2) = (unsigned short)cvtpk(X[i], 0.f); } }
            else st_bf16x4(L + (role == 1 ? O_MK : (role == 2 ? O_NB : O_NK)) + fr * S32 + fg * 8, g4);
        }
        __syncthreads();
        f32x4 yacc;
        {
            f32x4 u4 = mm_tile<2>(L + O_KKT, S64, L + O_SBF + 16 * q * S64, S64, (f32x4){0.f, 0.f, 0.f, 0.f}, lane);
            u4 = mm_tile<1>(L + O_MK, S32, L + O_VT + 16 * q * S32, S32, u4, lane);
            st_bf16x4(L + O_UTT + (16 * q + fr) * S32 + fg * 8, u4);
            yacc = mm_tile<2>(L + O_SBF + 16 * q * S64, S64, L + O_RT, S64, (f32x4){0.f, 0.f, 0.f, 0.f}, lane);
            yacc = mm_tile<1>(L + O_VT + 16 * q * S32, S32, L + O_NK, S32, yacc, lane);
        }
        asm volatile("s_waitcnt lgkmcnt(0)" ::: "memory");
        {
            f32x4 u4 = mm_tile<1>(L + O_TI, S32, L + O_UTT + 16 * q * S32, S32, (f32x4){0.f, 0.f, 0.f, 0.f}, lane);
            st_bf16x4(L + O_UT + (16 * q + fr) * S32 + fg * 8, -u4);
        }
        __syncthreads();
        {
            yacc = mm_tile<1>(L + O_UT + 16 * q * S32, S32, L + O_NB, S32, yacc, lane);
            ypend.x = cvtpk(yacc[0], yacc[1]); ypend.y = cvtpk(yacc[2], yacc[3]);
            const f32x4 wc4 = *(LAS f32x4*)(L + O_WC + (16 * q + 4 * fg) * 4);
#pragma unroll
            for (int vi = 0; vi < 4; ++vi) {
                f32x4 s4 = Sacc[vi] * wc4;
                s4 = mm_tile<1>(L + O_KHT + 16 * q * S32, S32, L + O_VT + 16 * vi * S32, S32, s4, lane);
                s4 = mm_tile<1>(L + O_BHT + 16 * q * S32, S32, L + O_UT + 16 * vi * S32, S32, s4, lane);
                Sacc[vi] = s4;
                st_bf16x4(L + O_SBF + (16 * vi + fr) * S64 + (16 * q + 4 * fg) * 2, s4);
            }
        }
    }
    flush(143);
    __syncthreads();
}

__device__ __forceinline__ void phase_gdn_prep(const Args& A, Ctx& C) {
    const bf16_t* P = WSP(bf16_t, WS_P);
    bf16_t* QKV = (bf16_t*)A.out; float* NRM = WSP(float, WS_NRM);
    const int lane = C.lane, w = C.wave, hq = w >> 1, th = w & 1;
    const int ch0 = 128 * hq + 2 * lane;
    float cw[3][2][5];
#pragma unroll
    for (int g = 0; g < 3; ++g)
#pragma unroll
        for (int xx = 0; xx < 2; ++xx)
#pragma unroll
            for (int e = 0; e < 5; ++e) cw[g][xx][e] = A.in[I_CONVW][e * 1536 + g * 512 + ch0 + xx];
    auto geom = [&](int tile, int& T, int& tb, size_t& rowbase) { const int row0 = tile * 16; int ta;
        if (row0 < NLAT) { T = SEQ; rowbase = (size_t)(row0 >> 11) * SEQ; ta = row0 & (SEQ - 1); } else { T = CTX; const int r = row0 - NLAT; rowbase = (size_t)NLAT + (size_t)(r >> 8) * CTX; ta = r & (CTX - 1); }
        tb = ta + 8 * th; };
    unsigned raw[12][3];
    auto issue = [&](int tile) { int T, tb; size_t rowbase; geom(tile, T, tb, rowbase);
#pragma unroll
        for (int e = 0; e < 12; ++e) { const int t = tb - 2 + e; const bool ok = (t >= 0 && t < T); const unsigned* pr = (const unsigned*)(P + (rowbase + (ok ? t : tb)) * PLD + RW_COLS + ch0);
#pragma unroll
            for (int g = 0; g < 3; ++g) raw[e][g] = pr[g * 256]; } };
    if (C.bid < NROWS / 16) issue(C.bid);
    for (int tile = C.bid; tile < NROWS / 16; tile += C.G) {
        int T, tb; size_t rowbase; geom(tile, T, tb, rowbase);
        float x[3][2][12];
#pragma unroll
        for (int e = 0; e < 12; ++e) { const int t = tb - 2 + e; const bool ok = (t >= 0 && t < T);
#pragma unroll
            for (int g = 0; g < 3; ++g) { const unsigned wv = raw[e][g]; x[g][0][e] = ok ? bflo(wv) : 0.f; x[g][1][e] = ok ? bfhi(wv) : 0.f; } }
        if (tile + C.G < NROWS / 16) issue(tile + C.G);
#pragma unroll
        for (int i = 0; i < 8; ++i) { float y[3][2];
#pragma unroll
            for (int g = 0; g < 3; ++g)
#pragma unroll
                for (int xx = 0; xx < 2; ++xx) { float sacc = 0.f;
#pragma unroll
                    for (int f = 0; f < 5; ++f) sacc += cw[g][xx][f] * x[g][xx][i + f];
                    y[g][xx] = siluf_(sacc); }
            const size_t row = rowbase + tb + i;
            unsigned* orow = (unsigned*)(QKV + row * 1536 + ch0);
            orow[0] = cvtpk(y[0][0], y[0][1]); orow[256] = cvtpk(y[1][0], y[1][1]); orow[512] = cvtpk(y[2][0], y[2][1]);
            const float sq = wave_sum(y[0][0] * y[0][0] + y[0][1] * y[0][1]), sk = wave_sum(y[1][0] * y[1][0] + y[1][1] * y[1][1]);
            if (lane == 0) { NRM[row * 8 + hq] = __builtin_amdgcn_rsqf(sq + 1e-6f) * 0.08838834764831845f; NRM[row * 8 + 4 + hq] = __builtin_amdgcn_rsqf(sk + 1e-6f); } }
    }
    __syncthreads();
}

namespace gd {
constexpr int S128 = 288, S32 = 80;
constexpr int O_KT = 0, O_QT = O_KT + 32 * S128, O_KKT = O_QT + 32 * S128, O_RT = O_KKT + 32 * S128,
              O_VT = O_RT + 32 * S128, O_BHT = O_VT + 128 * S32, O_KHT = O_BHT + 128 * S32, O_UT = O_KHT + 128 * S32, O_UTT = O_UT + 128 * S32,
              O_TI = O_UTT + 128 * S32, O_MK = O_TI + 32 * S32, O_NB = O_MK + 32 * S32, O_NK = O_NB + 32 * S32,
              O_M21 = O_NK + 32 * S32, O_T11T = O_M21 + 16 * S32, O_T22 = O_T11T + 16 * S32, O_XT = O_T22 + 16 * S32,
              O_SBF = O_XT + 16 * S32, O_SC = O_SBF + 128 * S128, O_MS = O_SC + 512, GD_BYTES = O_MS + 2048;
static_assert(GD_BYTES <= LDS_MISC, "gdn LDS");
}
__device__ __forceinline__ void gdn_chain_chunked(const Args& A, Ctx& C, int chain) {
    using namespace gd;
    const int b = chain >> 3, h = (chain >> 1) & 3, dir = chain & 1;
    lbyte* L = C.lds;
    LAS float* SC = (LAS float*)(L + O_SC);
    const bf16_t* P = WSP(bf16_t, WS_P);
    bf16_t* ydir = WSP(bf16_t, WS_YDIR) + (size_t)dir * NLAT * D;
    const int tid = C.tid, lane = C.lane, w = C.wave, fr = lane & 15, fg = lane >> 4;
    const int grp = w >> 1, idx = tid & 127;
    const float Aexp = __expf(A.in[I_ALOG][dir * 4 + h]), dtb = A.in[I_DTB][dir * 4 + h];
    const f32x4 z4 = (f32x4){0.f, 0.f, 0.f, 0.f};
    __syncthreads();
#pragma unroll 2
    for (int i = tid; i < (O_SC - O_VT) / 4; i += 512) ((LAS unsigned*)(L + O_VT))[i] = 0u;
    f32x4 Sacc[8];
#pragma unroll
    for (int i = 0; i < 8; ++i) Sacc[i] = z4;
    const bf16_t* QKV = (const bf16_t*)A.out; const float* NRM = WSP(const float, WS_NRM);
    unsigned rq[8], rk[8], rv[8]; float nq[8], nk[8]; unsigned raw_al = 0, raw_be = 0;
    const unsigned codd = (idx & 1) ? 0u : 16u, godd = (h & 1) ? 0u : 16u;
    auto chunk_geom = [&](int ch, bool& isctx, int& sbase, int& T, size_t& rowbase) { isctx = ch < 8; sbase = isctx ? ch * 32 : (ch - 8) * 32; T = isctx ? CTX : SEQ;
        rowbase = isctx ? (size_t)NLAT + (size_t)b * CTX : (size_t)b * SEQ; };
    auto issue_loads = [&](int ch) { bool isctx; int sbase, T; size_t rowbase; chunk_geom(ch, isctx, sbase, T, rowbase);
#pragma unroll
        for (int j = 0; j < 8; ++j) { const int i = 8 * grp + j; const int t = dir ? (T - 1 - (sbase + i)) : (sbase + i); const size_t row = rowbase + t;
            const unsigned* qr = (const unsigned*)(QKV + row * 1536 + 128 * h + (idx & ~1)); rq[j] = qr[0]; rk[j] = qr[256]; rv[j] = qr[512]; nq[j] = NRM[row * 8 + h]; nk[j] = NRM[row * 8 + 4 + h]; }
        if (w == 7 && lane < 32) { const int t = dir ? (T - 1 - (sbase + lane)) : (sbase + lane); const unsigned* pr = (const unsigned*)(P + (rowbase + t) * PLD + RW_COLS + 2048 + ((dir * 4 + h) & ~1)); raw_al = pr[0]; raw_be = pr[4]; } };
    u32x2 ypend[2]; ypend[0].x = ypend[0].y = ypend[1].x = ypend[1].y = 0u;
    auto flush = [&](int pch) { bool pisctx; int psb, pT; size_t prb; chunk_geom(pch, pisctx, psb, pT, prb);
        if (!pisctx) {
#pragma unroll
            for (int tb = 0; tb < 2; ++tb) { const int tl = psb + tb * 16 + fr; const int t = dir ? (pT - 1 - tl) : tl;
                *(u32x2*)(ydir + ((size_t)b * SEQ + t) * D + 512 + 128 * h + 16 * w + 4 * fg) = ypend[tb]; } } };
    issue_loads(0);
    for (int ch = 0; ch < 72; ++ch) {
        bool isctx; int sbase, T; size_t rowbase; chunk_geom(ch, isctx, sbase, T, rowbase);
        __syncthreads();
        float qv[8], kv[8], vv[8], nqv[8], nkv[8];
#pragma unroll
        for (int j = 0; j < 8; ++j) { qv[j] = bfsel(rq[j], codd); kv[j] = bfsel(rk[j], codd); vv[j] = bfsel(rv[j], codd); nqv[j] = nq[j]; nkv[j] = nk[j]; }
        if (w == 7) {
            const float gi = (lane < 32) ? -Aexp * softplusf_(bfsel(raw_al, godd) + dtb) : 0.f;
            float cum = gi;
            cum += __builtin_bit_cast(float, __builtin_amdgcn_update_dpp(0, __builtin_bit_cast(int, cum), 0x111, 0xf, 0xf, true));
            cum += __builtin_bit_cast(float, __builtin_amdgcn_update_dpp(0, __builtin_bit_cast(int, cum), 0x112, 0xf, 0xf, true));
            cum += __builtin_bit_cast(float, __builtin_amdgcn_update_dpp(0, __builtin_bit_cast(int, cum), 0x114, 0xf, 0xf, true));
            cum += __builtin_bit_cast(float, __builtin_amdgcn_update_dpp(0, __builtin_bit_cast(int, cum), 0x118, 0xf, 0xf, true));
            const float r0 = rdlane(cum, 15);
            cum += (lane >= 16) ? r0 : 0.f;
            if (lane < 32) { SC[lane] = sigmoidf_(bfsel(raw_be, godd)); SC[32 + lane + 1] = cum; if (lane == 0) SC[32] = 0.f; }
        }
        asm volatile("" :: "v"(qv[0]), "v"(qv[1]), "v"(qv[2]), "v"(qv[3]), "v"(qv[4]), "v"(qv[5]), "v"(qv[6]), "v"(qv[7]), "v"(kv[0]), "v"(kv[1]), "v"(kv[2]), "v"(kv[3]), "v"(kv[4]), "v"(kv[5]), "v"(kv[6]), "v"(kv[7]),
                        "v"(vv[0]), "v"(vv[1]), "v"(vv[2]), "v"(vv[3]), "v"(vv[4]), "v"(vv[5]), "v"(vv[6]), "v"(vv[7]) : "memory");
        asm volatile("" :: "v"(nqv[0]), "v"(nqv[1]), "v"(nqv[2]), "v"(nqv[3]), "v"(nqv[4]), "v"(nqv[5]), "v"(nqv[6]), "v"(nqv[7]), "v"(nkv[0]), "v"(nkv[1]), "v"(nkv[2]), "v"(nkv[3]), "v"(nkv[4]), "v"(nkv[5]), "v"(nkv[6]), "v"(nkv[7]),
                        "v"(raw_al), "v"(raw_be) : "memory");
        if (ch > 0) flush(ch - 1);
        if (ch + 1 < 72) issue_loads(ch + 1);
        __syncthreads();
        {
            const int c = idx; const float gcC = SC[32 + 32];
            float bh[8], kh[8];
#pragma unroll
            for (int j = 0; j < 8; ++j) { const int i = 8 * grp + j;
                const float kn = kv[j] * nkv[j], qn = qv[j] * nqv[j];
                const float gm = SC[32 + i], gi = SC[32 + i + 1], be = SC[i];
                const unsigned p0 = cvtpk(kn, qn), p1 = cvtpk(kn * __expf(gm), qn * __expf(gi));
                *(LAS unsigned short*)(L + O_KT + i * S128 + c * 2) = (unsigned short)p0; *(LAS unsigned short*)(L + O_QT + i * S128 + c * 2) = (unsigned short)(p0 >> 16);
                *(LAS unsigned short*)(L + O_KKT + i * S128 + c * 2) = (unsigned short)p1; *(LAS unsigned short*)(L + O_RT + i * S128 + c * 2) = (unsigned short)(p1 >> 16);
                bh[j] = be * kn * __expf(gcC - gm); kh[j] = be * kn * __expf(gcC - gi); }
            u32x4 w4;
            w4.x = cvtpk(bh[0], bh[1]); w4.y = cvtpk(bh[2], bh[3]); w4.z = cvtpk(bh[4], bh[5]); w4.w = cvtpk(bh[6], bh[7]); *(LAS u32x4*)(L + O_BHT + c * S32 + grp * 16) = w4;
            w4.x = cvtpk(kh[0], kh[1]); w4.y = cvtpk(kh[2], kh[3]); w4.z = cvtpk(kh[4], kh[5]); w4.w = cvtpk(kh[6], kh[7]); *(LAS u32x4*)(L + O_KHT + c * S32 + grp * 16) = w4;
            w4.x = cvtpk(vv[0], vv[1]); w4.y = cvtpk(vv[2], vv[3]); w4.z = cvtpk(vv[4], vv[5]); w4.w = cvtpk(vv[6], vv[7]); *(LAS u32x4*)(L + O_VT + c * S32 + grp * 16) = w4;
        }
        __syncthreads();
        {
            const int isq = w >> 2, tb = (w >> 1) & 1, jb = w & 1;
            if (jb <= tb) {
                const f32x4 g4 = mm_tile<4>(L + O_KT + jb * 16 * S128, S128, L + (isq ? O_QT : O_KT) + tb * 16 * S128, S128, z4, lane);
                const int t = tb * 16 + fr;
                const float gt = SC[32 + t + isq];
                f32x4 m0, m1;
#pragma unroll
                for (int e = 0; e < 4; ++e) { const int j = jb * 16 + 4 * fg + e; const bool keep = isq ? (j <= t) : (j < t);
                    const float bj = SC[j] * g4[e];
                    m0[e] = keep ? bj * __expf(gt - SC[32 + j]) : 0.f;
                    m1[e] = keep ? bj * __expf(gt - SC[32 + j + 1]) : 0.f; }
                const int off = t * S32 + (jb * 16 + 4 * fg) * 2;
                if (isq) { st_bf16x4(L + O_NB + off, m0); st_bf16x4(L + O_NK + off, m1); }
                else {
                    st_bf16x4(L + O_MK + off, m1);
                    if (tb != jb) st_bf16x4(L + O_M21 + fr * S32 + fg * 8, m0);
                    else { float X[16]; tri_inv16(m0, lane, L + O_MS + tb * 1024, X);
                        if (lane < 16) {
#pragma unroll
                            for (int i = 0; i < 16; ++i) *(LAS unsigned short*)(L + O_TI + (tb * 16 + i) * S32 + (tb * 16 + lane) * 2) = (unsigned short)cvtpk(X[i], 0.f);
                            if (tb == 0) { u32x4 a0, a1;
                                a0.x = cvtpk(X[0], X[1]); a0.y = cvtpk(X[2], X[3]); a0.z = cvtpk(X[4], X[5]); a0.w = cvtpk(X[6], X[7]);
                                a1.x = cvtpk(X[8], X[9]); a1.y = cvtpk(X[10], X[11]); a1.z = cvtpk(X[12], X[13]); a1.w = cvtpk(X[14], X[15]);
                                *(LAS u32x4*)(L + O_T11T + lane * S32) = a0; *(LAS u32x4*)(L + O_T11T + lane * S32 + 16) = a1; }
                            else {
#pragma unroll
                                for (int i = 0; i < 16; ++i) *(LAS unsigned short*)(L + O_T22 + i * S32 + lane * 2) = (unsigned short)cvtpk(X[i], 0.f); }
                        } }
                }
            }
        }
        __syncthreads();
        if (w == 1) {
            const f32x4 x4 = mm_tile<1>(L + O_M21, S32, L + O_T11T, S32, z4, lane);
            st_bf16x4(L + O_XT + fr * S32 + fg * 8, x4);
            asm volatile("s_waitcnt lgkmcnt(0)" ::: "memory");
            const f32x4 t4 = mm_tile<1>(L + O_XT, S32, L + O_T22, S32, z4, lane);
            st_bf16x4(L + O_TI + (16 + fr) * S32 + fg * 8, -t4);
        }
        f32x4 yacc[2];
#pragma unroll
        for (int tb = 0; tb < 2; ++tb) {
            f32x4 u4 = mm_tile<4>(L + O_KKT + tb * 16 * S128, S128, L + O_SBF + 16 * w * S128, S128, z4, lane);
            u4 = mm_tile<1>(L + O_MK + tb * 16 * S32, S32, L + O_VT + 16 * w * S32, S32, u4, lane);
            st_bf16x4(L + O_UTT + (16 * w + fr) * S32 + tb * 32 + fg * 8, u4);
            yacc[tb] = mm_tile<4>(L + O_SBF + 16 * w * S128, S128, L + O_RT + tb * 16 * S128, S128, z4, lane);
            yacc[tb] = mm_tile<1>(L + O_VT + 16 * w * S32, S32, L + O_NK + tb * 16 * S32, S32, yacc[tb], lane);
        }
        __syncthreads();
#pragma unroll
        for (int tb = 0; tb < 2; ++tb) {
            const f32x4 u4 = mm_tile<1>(L + O_TI + tb * 16 * S32, S32, L + O_UTT + 16 * w * S32, S32, z4, lane);
            st_bf16x4(L + O_UT + (16 * w + fr) * S32 + tb * 32 + fg * 8, -u4);
        }
        __syncthreads();
        {
#pragma unroll
            for (int tb = 0; tb < 2; ++tb) {
                yacc[tb] = mm_tile<1>(L + O_UT + 16 * w * S32, S32, L + O_NB + tb * 16 * S32, S32, yacc[tb], lane);
                ypend[tb].x = cvtpk(yacc[tb][0], yacc[tb][1]); ypend[tb].y = cvtpk(yacc[tb][2], yacc[tb][3]);
            }
            const float wc = __expf(SC[32 + 32]);
#pragma unroll
            for (int vi = 0; vi < 8; ++vi) {
                f32x4 s4 = Sacc[vi] * wc;
                s4 = mm_tile<1>(L + O_KHT + 16 * w * S32, S32, L + O_VT + 16 * vi * S32, S32, s4, lane);
                s4 = mm_tile<1>(L + O_BHT + 16 * w * S32, S32, L + O_UT + 16 * vi * S32, S32, s4, lane);
                Sacc[vi] = s4;
                st_bf16x4(L + O_SBF + (16 * vi + fr) * S128 + (16 * w + 4 * fg) * 2, s4);
            }
        }
    }
    flush(71);
    __syncthreads();
}

__device__ __forceinline__ void unpack8(const u32x4 w, float (&f)[8]) { f[0] = bflo(w.x); f[1] = bfhi(w.x); f[2] = bflo(w.y); f[3] = bfhi(w.y); f[4] = bflo(w.z); f[5] = bfhi(w.z); f[6] = bflo(w.w); f[7] = bfhi(w.w); }
__device__ __forceinline__ void phase_p4(const Args& A, Ctx& C) {
    const bf16_t* P = WSP(bf16_t, WS_P);
    const bf16_t* yf = WSP(bf16_t, WS_YDIR); const bf16_t* yb = yf + (size_t)NLAT * D;
    const float* bon = WSP(float, WS_BON);
    bf16_t* ymix = WSP(bf16_t, WS_YMIX);
    lbyte* SGb = C.lds;
    lfloat* GO = (lfloat*)(C.lds + 8192);
    const int tid = C.tid, lane = C.lane, w = C.wave;
    const bf16_t* gupt = WSP(const bf16_t, WS_GUPT);
    const int fr = lane & 15, fg = lane >> 4;
    const int c8 = 8 * lane;
    float lnw[8], lnb[8], ong[8], muv[8];
#pragma unroll
    for (int e = 0; e < 8; ++e) { lnw[e] = A.in[I_LNW][c8 + e]; lnb[e] = A.in[I_LNB][c8 + e]; ong[e] = A.in[I_ONG][(c8 + e) & 127]; muv[e] = A.in[I_MU][1024 + c8 + e]; }
    const int tkA = tid >> 5, lA = 4 * (tid & 31);
    float muA[4];
#pragma unroll
    for (int e = 0; e < 4; ++e) muA[e] = A.in[I_MU][1792 + lA + e];
    const bool vup = (1024 + c8) < 1440;
    bf16x8 gq[4][4];
#pragma unroll
    for (int i = 0; i < 4; ++i)
#pragma unroll
        for (int ks = 0; ks < 4; ++ks) gq[i][ks] = *(const bf16x8*)(gupt + (size_t)(64 * w + 16 * i + fr) * 128 + ks * 32 + fg * 8);
    u32x2 pwA, swA;
    auto issueA = [&](int tile) { const int row = tile * 16 + tkA, t = row & (SEQ - 1); const bool ok = t < SEQ - 64;
        pwA = *(const u32x2*)(P + (size_t)row * PLD + 1792 + lA); swA = *(const u32x2*)(P + (size_t)(row + (ok ? 64 : 0)) * PLD + 1792 + lA); };
    if (C.bid < NLAT / 16) issueA(C.bid);
    for (int tile = C.bid; tile < NLAT / 16; tile += C.G) {
        const int row0 = tile * 16;
        u32x4 wyf[2], wyb[2], wpv[2], wsv[2], wof[2], wob[2], wz[2]; float bsv[2];
#pragma unroll
        for (int tt = 0; tt < 2; ++tt) {
            const int tk = 2 * w + tt, row = row0 + tk, t = row & (SEQ - 1);
            const bool okv = vup ? (t >= 64) : (t < SEQ - 64);
            wyf[tt] = *(const u32x4*)(yf + (size_t)row * D + c8); wyb[tt] = *(const u32x4*)(yb + (size_t)row * D + c8);
            wpv[tt] = *(const u32x4*)(P + (size_t)row * PLD + 1024 + c8); wsv[tt] = *(const u32x4*)(P + (size_t)(row + (okv ? (vup ? -64 : 64) : 0)) * PLD + 1024 + c8);
            wof[tt] = *(const u32x4*)(yf + (size_t)row * D + 512 + c8); wob[tt] = *(const u32x4*)(yb + (size_t)row * D + 512 + c8);
            wz[tt] = *(const u32x4*)(P + (size_t)row * PLD + RW_COLS + 1536 + c8);
            bsv[tt] = bon[(size_t)row * 8 + (lane >> 3)] + bon[((size_t)NLAT + row) * 8 + (lane >> 3)];
        }
        __syncthreads();
        {
            const int row = row0 + tkA, t = row & (SEQ - 1); const bool ok = t < SEQ - 64;
            const u32x2 pw = pwA, sw = swA;
            const float pv[4] = {bflo(pw.x), bfhi(pw.x), bflo(pw.y), bfhi(pw.y)}; const float sv[4] = {bflo(sw.x), bfhi(sw.x), bflo(sw.y), bfhi(sw.y)};
            float o[4];
#pragma unroll
            for (int e = 0; e < 4; ++e) o[e] = sigmoidf_(pv[e] + muA[e] * ((ok ? sv[e] : 0.f) - pv[e]));
            u32x2 ow; ow.x = cvtpk(o[0], o[1]); ow.y = cvtpk(o[2], o[3]); *(LAS u32x2*)(SGb + tkA * 288 + lA * 2) = ow;
        }
        if (tile + C.G < NLAT / 16) issueA(tile + C.G);
        __syncthreads();
#pragma unroll
        for (int i = 0; i < 4; ++i) { const int c0 = 64 * w + 16 * i; f32x4 acc = (f32x4){0.f, 0.f, 0.f, 0.f};
#pragma unroll
            for (int ks = 0; ks < 4; ++ks) { const bf16x8 a = *(const LAS bf16x8*)(SGb + fr * 288 + ks * 64 + fg * 16);
                acc = __builtin_amdgcn_mfma_f32_16x16x32_bf16(a, gq[i][ks], acc, 0, 0, 0); }
#pragma unroll
            for (int e = 0; e < 4; ++e) GO[(4 * fg + e) * 512 + c0 + fr] = acc[e]; }
        __syncthreads();
#pragma unroll
        for (int tt = 0; tt < 2; ++tt) {
            const int tk = 2 * w + tt, row = row0 + tk, t = row & (SEQ - 1);
            const bool okv = vup ? (t >= 64) : (t < SEQ - 64);
            const float bs = bsv[tt];
            const f32x4 g0 = *(const LAS f32x4*)(GO + tk * 512 + c8), g1 = *(const LAS f32x4*)(GO + tk * 512 + c8 + 4);
            const float gg[8] = {g0.x, g0.y, g0.z, g0.w, g1.x, g1.y, g1.z, g1.w};
            float a[8], bq[8], pv[8], sv[8], y[8];
            unpack8(wyf[tt], a); unpack8(wyb[tt], bq); unpack8(wpv[tt], pv); unpack8(wsv[tt], sv);
            float s1 = 0.f;
#pragma unroll
            for (int e = 0; e < 8; ++e) { y[e] = a[e] + bq[e]; s1 += y[e]; }
            s1 += __shfl_xor(s1, 1); s1 += __shfl_xor(s1, 2); s1 += __shfl_xor(s1, 4);
            const float m = s1 * (1.f / 64.f);
            float s2 = 0.f;
#pragma unroll
            for (int e = 0; e < 8; ++e) { y[e] -= m; s2 += y[e] * y[e]; }
            s2 += __shfl_xor(s2, 1); s2 += __shfl_xor(s2, 2); s2 += __shfl_xor(s2, 4);
            const float rs = __builtin_amdgcn_rsqf(s2 * (1.f / 64.f) + RWKV_EPS);
            float o[8];
#pragma unroll
            for (int e = 0; e < 8; ++e) { const float vv = pv[e] + muv[e] * ((okv ? sv[e] : 0.f) - pv[e]); o[e] = (y[e] * rs * lnw[e] + lnb[e] + bs * vv) * gg[e]; }
            u32x4 ow; ow.x = cvtpk(o[0], o[1]); ow.y = cvtpk(o[2], o[3]); ow.z = cvtpk(o[4], o[5]); ow.w = cvtpk(o[6], o[7]);
            *(u32x4*)(ymix + (size_t)row * D + c8) = ow;
            float of[8], ob[8], z[8];
            unpack8(wof[tt], of); unpack8(wob[tt], ob); unpack8(wz[tt], z);
            float s3 = 0.f;
#pragma unroll
            for (int e = 0; e < 8; ++e) { of[e] += ob[e]; s3 += of[e] * of[e]; }
            s3 += __shfl_xor(s3, 1); s3 += __shfl_xor(s3, 2); s3 += __shfl_xor(s3, 4); s3 += __shfl_xor(s3, 8);
            const float rg = __builtin_amdgcn_rsqf(s3 * (1.f / 128.f) + NORM_EPS);
#pragma unroll
            for (int e = 0; e < 8; ++e) o[e] = of[e] * rg * ong[e] * siluf_(z[e]);
            ow.x = cvtpk(o[0], o[1]); ow.y = cvtpk(o[2], o[3]); ow.z = cvtpk(o[4], o[5]); ow.w = cvtpk(o[6], o[7]);
            *(u32x4*)(ymix + (size_t)row * D + 512 + c8) = ow;
        }
    }
}

__device__ __forceinline__ void convert_experts(const Args& A, Ctx& C) {
    lfloat* scr = (lfloat*)(C.lds + C.wave * 16384);
    const int gw = C.bid * 8 + C.wave, NGW = C.G * 8;
    constexpr int I13 = (D / 128) * (DE / 32);
    constexpr int I2 = (DE / 128) * (D / 32);
    constexpr int PER = 2 * I13 + I2;
    for (int it = gw; it < 257 * PER; it += NGW) {
        const int e = it / PER; int r = it % PER;
        unsigned char* bt13 = A.ws + WS_WEXP + (size_t)e * WEXP_STRIDE; unsigned char* bt2 = bt13 + 512 * 1024;
        const float* w1 = e < NE ? A.in[I_EW1] + (size_t)e * D * DE : A.in[I_SW1];
        const float* w3 = e < NE ? A.in[I_EW3] + (size_t)e * D * DE : A.in[I_SW3];
        const float* w2 = e < NE ? A.in[I_EW2] + (size_t)e * DE * D : A.in[I_SW2];
        if (r < I13) { transpose_pair_fp8(w1, D, DE, bt13, RowGLU{0}, SW13, scr, r, C.lane); continue; } r -= I13;
        if (r < I13) { transpose_pair_fp8(w3, D, DE, bt13, RowGLU{128}, SW13, scr, r, C.lane); continue; } r -= I13;
        transpose_pair_fp8(w2, DE, D, bt2, RowId(), SW2, scr, r, C.lane);
    }
}

__device__ __forceinline__ void phase_p6(const Args& A, Ctx& C) {
    const float* mod = WSP(float, WS_MOD); bf16_t* h2n = WSP(bf16_t, WS_H2N);
    const int gw = C.bid * 8 + C.wave, NGW = C.G * 8;
    for (int row = gw; row < NLAT; row += NGW) {
        const float* m = mod + (size_t)(row >> 11) * MODW;
        norm_mod_row(A.out + (size_t)row * D, A.in[I_N2G], m + 4 * D, m + 3 * D, h2n + (size_t)row * D, C.lane, (unsigned*)(A.ws + WS_H2N8) + (size_t)row * (D / 4));
    }
}

__device__ __forceinline__ void phase_p8(const Args& A, Ctx& C) {
    const float* logit = WSP(float, WS_LOGIT);
    int* tope = WSP(int, WS_TOPE); float* topw = WSP(float, WS_TOPW); int* pos = WSP(int, WS_POS);
    unsigned* cnt = WSP(unsigned, WS_CTL) + CW_CNT;
    const int lane = C.lane;
    const f32x4 rb = ((const f32x4*)A.in[I_RB])[lane];
    LAS unsigned* hist = (LAS unsigned*)C.lds;
    LAS unsigned* base = hist + 256;
    LAS unsigned* lpe = base + 256;
    for (int blk = C.bid; blk < NLAT / 256; blk += C.G) {
    __syncthreads();
    if (C.tid < 256) hist[C.tid] = 0u;
    __syncthreads();
    f32x4 nlg = ((const f32x4*)(logit + (size_t)(blk * 256 + C.wave * 32) * NE))[lane];
    for (int ti = 0; ti < 32; ++ti) {
        const int tl = C.wave * 32 + ti, tok = blk * 256 + tl;
        const f32x4 lg = nlg;
        if (ti + 1 < 32) nlg = ((const f32x4*)(logit + (size_t)(tok + 1) * NE))[lane];
        float s[4], sel[4];
#pragma unroll
        for (int i = 0; i < 4; ++i) { s[i] = sigmoidf_(lg[i]); sel[i] = s[i] + rb[i]; }
        float m1 = fmaxf(fmaxf(sel[0], sel[1]), fmaxf(sel[2], sel[3]));
        float m2;
        {
            float a = fmaxf(sel[0], sel[1]), bq = fminf(sel[0], sel[1]), cq = fmaxf(sel[2], sel[3]), dq = fminf(sel[2], sel[3]);
            m2 = fmaxf(fminf(a, cq), fmaxf(bq, dq)); }
#define P8_MERGE(CTRL) { const float o1 = dpp_f<CTRL>(m1), o2 = dpp_f<CTRL>(m2); const float n1 = fmaxf(m1, o1); const float n2 = fmaxf(fminf(m1, o1), fmaxf(m2, o2)); m1 = n1; m2 = n2; }
        P8_MERGE(0xB1) P8_MERGE(0x4E) P8_MERGE(0x141)
#undef P8_MERGE
        const float gs = m1 + m2;
        const int grp = lane >> 3;
        int rank = 0;
#pragma unroll
        for (int gq = 0; gq < 8; ++gq) { const float og = __shfl(gs, gq * 8); rank += (og > gs || (og == gs && gq < grp)) ? 1 : 0; }
        const bool gsel = rank < 4;
        float cand[4];
#pragma unroll
        for (int i = 0; i < 4; ++i) cand[i] = gsel ? sel[i] : -INFINITY;
        int my_e = 0; float my_w = 0.f; float wsum = 0.f;
#pragma unroll
        for (int r = 0; r < 8; ++r) {
            float bv = cand[0]; int bi = 0;
#pragma unroll
            for (int i = 1; i < 4; ++i) if (cand[i] > bv) { bv = cand[i]; bi = i; }
            float wm = bv;
            wm = fmaxf(wm, dpp_f<0x128>(wm)); wm = fmaxf(wm, dpp_f<0x124>(wm)); wm = fmaxf(wm, dpp_f<0x122>(wm)); wm = fmaxf(wm, dpp_f<0x121>(wm));
            const float gv = fmaxf(fmaxf(rdlane(wm, 0), rdlane(wm, 16)), fmaxf(rdlane(wm, 32), rdlane(wm, 48)));
            const unsigned long long bal = __ballot(bv == gv);
            const int ol = __builtin_amdgcn_readfirstlane((int)__builtin_ctzll(bal));
            const int oi = __builtin_amdgcn_readlane(bi, ol);
            const int be = ol * 4 + oi;
            const float mys = oi == 0 ? s[0] : (oi == 1 ? s[1] : (oi == 2 ? s[2] : s[3]));
            const float ws_ = rdlane(mys, ol);
            const bool mine = lane == ol;
#pragma unroll
            for (int i = 0; i < 4; ++i) cand[i] = (mine && oi == i) ? -INFINITY : cand[i];
            wsum += ws_;
            if (lane == r) { my_e = be; my_w = ws_; }
        }
        if (lane < 8) {
            const float w = my_w / wsum * 2.5f;
            const unsigned lp = __hip_atomic_fetch_add(hist + my_e, 1u, __ATOMIC_RELAXED, __HIP_MEMORY_SCOPE_WORKGROUP);
            tope[(size_t)tok * 8 + lane] = my_e; topw[(size_t)tok * 8 + lane] = w; lpe[tl * 8 + lane] = ((unsigned)my_e << 16) | lp;
        }
    }
    __syncthreads();
    if (C.tid < 256) { const unsigned c = hist[C.tid]; base[C.tid] = c ? atomicAdd(cnt + C.tid * CNT_STRIDE, c) : 0u; }
    __syncthreads();
    for (int i = C.tid; i < 2048; i += 512) { const unsigned v = lpe[i]; pos[(size_t)blk * 2048 + i] = (int)(base[v >> 16] + (v & 0xffffu)); }
    }
}

__device__ __forceinline__ void tile_prefix(const Args& A, Ctx& C, LAS int* tb) {
    const unsigned* cnt = WSP(unsigned, WS_CTL) + CW_CNT;
    int v = 0;
    if (C.tid < NE) v = ((int)cnt[C.tid * CNT_STRIDE] + 255) >> 8;
#pragma unroll
    for (int d = 1; d < 64; d <<= 1) { const int t = __shfl_up(v, d); if (C.lane >= d) v += t; }
    if (C.tid < NE && C.lane == 63) tb[260 + C.wave] = v;
    __syncthreads();
    if (C.tid < NE) { int off = 0;
#pragma unroll
        for (int q = 0; q < 3; ++q) off += (q < C.wave) ? tb[260 + q] : 0;
        tb[C.tid + 1] = off + v; if (C.tid == 0) tb[0] = 0; }
    __syncthreads();
}
__device__ __forceinline__ void phase_p9(const Args& A, Ctx& C) {
    LAS int* tb = (LAS int*)C.lds;
    tile_prefix(A, C, tb);
    const unsigned* cnt = WSP(unsigned, WS_CTL) + CW_CNT;
    const int* tope = WSP(int, WS_TOPE); const float* topw = WSP(float, WS_TOPW); const int* pos = WSP(int, WS_POS);
    int* rowl = WSP(int, WS_ROWL); float* roww = WSP(float, WS_ROWW); int* tile_e = WSP(int, WS_TILEE);
    const int nrt = tb[NE];
    for (int i = C.bid * 512 + C.tid; i < NLAT * 8; i += C.G * 512) { const int e = tope[i]; const int pr = tb[e] * 256 + pos[i]; rowl[pr] = i; roww[pr] = topw[i]; }
    for (int e = C.bid; e < NE; e += C.G) { const int n = (int)cnt[e * CNT_STRIDE], nt = tb[e + 1] - tb[e];
        for (int j = n + C.tid; j < nt * 256; j += 512) { rowl[tb[e] * 256 + j] = -1; roww[tb[e] * 256 + j] = 0.f; }
        for (int k = C.tid; k < nt; k += 512) tile_e[tb[e] + k] = e; }
    for (int i = C.bid * 512 + C.tid; i < NLAT; i += C.G * 512) { rowl[nrt * 256 + i] = i; roww[nrt * 256 + i] = 1.f; }
    for (int k = C.bid * 512 + C.tid; k < NLAT / 256; k += C.G * 512) tile_e[nrt + k] = NE;
    __syncthreads();
}

__device__ __forceinline__ void phase_moe(const Args& A, Ctx& C, int dry_shared) {
    LAS int* tb = (LAS int*)(C.lds + 131072);
    LAS int* tbl = tb + 320;
    tile_prefix(A, C, tb);
    pg8::MoeCtx M;
    M.nrt = tb[NE]; M.ntiles = M.nrt + NLAT / 256; M.G = C.G; M.vc = (C.G % 8 == 0) ? (C.bid % 8) * (C.G / 8) + C.bid / 8 : C.bid;
    M.tb = tb; M.tbl = tbl; M.cnt = WSP(unsigned, WS_CTL) + CW_CNT; M.rowl = WSP(int, WS_ROWL); M.roww = WSP(float, WS_ROWW);
    M.wexp = (const char*)(A.ws + WS_WEXP); M.h2n = (const char*)(A.ws + WS_H2N8); M.Hs = (char*)(A.ws + WS_HS) + (size_t)C.bid * 2 * 65536;
    M.Y = (unsigned char*)(A.ws + WS_Y); M.out = A.out; M.mod = WSP(const float, WS_MOD); M.dry_shared = dry_shared;
    pg8::gemm_moe(C.lds, M);
    __syncthreads();
}

__device__ __forceinline__ void phase_final(const Args& A, Ctx& C, float* dst) {
    const int gw = C.bid * 8 + C.wave, NGW = C.G * 8;
    const float* fg = A.in[I_FG]; const float* mod = WSP(const float, WS_MOD);
    const unsigned* Y = (const unsigned*)(A.ws + WS_Y);
    for (int row = gw; row < NLAT; row += NGW) {
        f32x4* xr = (f32x4*)(A.out + (size_t)row * D) + C.lane;
        const f32x4* gt = (const f32x4*)(mod + (size_t)(row >> 11) * MODW + 5 * D) + C.lane;
        const unsigned* yr = Y + (size_t)row * 8 * (D / 4) + C.lane;
        f32x4 v[4]; float s = 0.f;
#pragma unroll
        for (int j = 0; j < 4; ++j) {
            f32x4 a = (f32x4){0.f, 0.f, 0.f, 0.f};
#pragma unroll
            for (int sl = 0; sl < 8; ++sl) { const unsigned w = yr[sl * (D / 4) + 64 * j];
                const f32x2 lo = __builtin_amdgcn_cvt_pk_f32_fp8(w, false), hi = __builtin_amdgcn_cvt_pk_f32_fp8(w, true);
                a.x += lo.x; a.y += lo.y; a.z += hi.x; a.w += hi.y; }
            v[j] = xr[64 * j] + gt[64 * j] * a * (1.f / pg8::YSCALE);
            s += (v[j].x * v[j].x + v[j].y * v[j].y) + (v[j].z * v[j].z + v[j].w * v[j].w); }
        const float rstd = __builtin_amdgcn_rsqf(wave_sum(s) * (1.f / D) + NORM_EPS);
        f32x4* orow = (f32x4*)(dst + (size_t)row * D) + C.lane;
#pragma unroll
        for (int j = 0; j < 4; ++j) orow[64 * j] = v[j] * rstd * ((const f32x4*)fg)[C.lane + 64 * j];
    }
}

constexpr int NPHASE = 13;
__global__ void __launch_bounds__(512, 2) fwd_kernel(Args A) {
    extern __shared__ __attribute__((aligned(16))) unsigned char lds_raw[];
    Ctx C; C.lds = (lbyte*)lds_raw; C.tid = threadIdx.x; C.lane = C.tid & 63; C.wave = __builtin_amdgcn_readfirstlane(C.tid >> 6);
    C.G = gridDim.x; C.bid = blockIdx.x; C.a = &A;
    volatile LAS unsigned* misc = (volatile LAS unsigned*)(C.lds + LDS_MISC);
    if (C.tid < 16) misc[C.tid] = 0u;
    __syncthreads();
    XcdBarrier bar; bar.bar = WSP(unsigned, WS_CTL) + CW_BAR; bar.x = 0; bar.st = nullptr;
    const int lo = A.ph_lo, hi = A.ph_hi;
    const bool multi = (hi - lo) > 1;
    if (multi) bar = xcd_barrier_post(WSP(unsigned, WS_CTL) + CW_BAR, misc);
#ifndef PHASE_MASK
#define PHASE_MASK 0x1FFF
#endif
#define IN(k) (((PHASE_MASK >> (k)) & 1) && lo <= (k) && (k) < hi)
#define SEAM(k) do { if (IN(k) && IN((k) + 1)) xcd_barrier(bar); } while (0)
#ifndef REP_MASK
#define REP_MASK 0
#endif
#define REPS(k) (((REP_MASK >> (k)) & 1) ? 2 : 1)

    if (IN(0)) _Pragma("unroll") for (int rep = 0; rep < REPS(0); ++rep) { phase_p0(A, C); __syncthreads(); } SEAM(0);
    if (IN(1)) _Pragma("unroll") for (int rep = 0; rep < REPS(1); ++rep) { phase_p1(A, C); } SEAM(1);
    if (IN(2)) _Pragma("unroll") for (int rep = 0; rep < REPS(2); ++rep) {
        pg8::Gemm g{WSP(bf16_t, WS_XN), D}; pg8::StaticOrder S; S.init(NROWS, PLD, C.G, C.bid, WSP(bf16_t, WS_BTIN), D, 1);
        pg8::EpiBf16 E{WSP(bf16_t, WS_P), PLD, 1.f / SWIN};
        pg8::gemm_phase<pg8::EpiBf16, pg8::StaticOrder, false, 0, false, true>(C.lds, g, S, E);
    } SEAM(2);
    if (IN(3)) _Pragma("unroll") for (int rep = 0; rep < REPS(3); ++rep) { phase_gdn_prep(A, C); } SEAM(3);
#ifdef PROBE_BARRIERS
    if (multi) for (int kq = 0; kq < PROBE_BARRIERS; ++kq) xcd_barrier(bar);
#endif
    if (IN(4)) {
        for (int ch = C.bid; ch < NB * HB * 2; ch += C.G) gdn_chain_chunked(A, C, ch);
        for (int pr = C.bid; pr < NB * HA; pr += C.G) rwkv_pair_chunked(A, C, pr);
    } SEAM(4);
    if (IN(5)) _Pragma("unroll") for (int rep = 0; rep < REPS(5); ++rep) { phase_p4(A, C); } SEAM(5);
    if (IN(6)) _Pragma("unroll") for (int rep = 0; rep < REPS(6); ++rep) {
        pg8::Gemm g{WSP(bf16_t, WS_YMIX), D}; pg8::StaticOrder S; S.init(NLAT, D, C.G, C.bid, WSP(bf16_t, WS_BTOUT), D);
        pg8::EpiResGate E{A.in[I_X], A.out, WSP(float, WS_MOD), 2 * D};
        pg8::gemm_phase<pg8::EpiResGate, pg8::StaticOrder, false>(C.lds, g, S, E);
    } SEAM(6);
    if (IN(7)) _Pragma("unroll") for (int rep = 0; rep < REPS(7); ++rep) { phase_p6(A, C); __syncthreads(); convert_experts(A, C); __syncthreads(); } SEAM(7);
    if (IN(8)) _Pragma("unroll") for (int rep = 0; rep < REPS(8); ++rep) {
        pg8::Gemm g{WSP(bf16_t, WS_H2N), D}; pg8::StaticOrder S; S.init(NLAT, NE, C.G, C.bid, WSP(bf16_t, WS_BTR), D);
        pg8::EpiF32 E{WSP(float, WS_LOGIT), NE};
        pg8::gemm_phase<pg8::EpiF32, pg8::StaticOrder, false>(C.lds, g, S, E);
    } SEAM(8);
    if (IN(9)) { phase_p8(A, C); } SEAM(9);
    if (IN(10)) _Pragma("unroll") for (int rep = 0; rep < REPS(10); ++rep) { phase_p9(A, C); } SEAM(10);
    if (IN(11)) { phase_moe(A, C, 0); if (REPS(11) > 1) { __syncthreads(); phase_moe(A, C, 1); } } SEAM(11);
    if (IN(12)) { if (REPS(12) > 1) { phase_final(A, C, (float*)(A.ws + WS_WEXP)); __syncthreads(); } phase_final(A, C, A.out); }
#undef IN
#undef SEAM
}

extern "C" void kernel_launch(void* const* d_in, const int* in_sizes, int n_in, void* d_out, int out_size, void* d_ws, size_t ws_size, hipStream_t stream) {
    static int grid = 0;
    if (grid == 0) {
        if (n_in != 34 || out_size != NLAT * D || ws_size < WS_END) { fprintf(stderr, "kernel_launch: unexpected shapes (n_in %d out %d ws %zu need %zu)\n", n_in, out_size, ws_size, (size_t)WS_END); grid = -1; return; }
        int dev = 0, cus = 0;
        if (hipGetDevice(&dev) != hipSuccess || hipDeviceGetAttribute(&cus, hipDeviceAttributeMultiprocessorCount, dev) != hipSuccess) { grid = -1; return; }
        if (hipFuncSetAttribute((const void*)fwd_kernel, hipFuncAttributeMaxDynamicSharedMemorySize, LDS_BYTES) != hipSuccess) { fprintf(stderr, "kernel_launch: hipFuncSetAttribute failed\n"); grid = -1; return; }
        int per_cu = 0;
        if (hipOccupancyMaxActiveBlocksPerMultiprocessor(&per_cu, (const void*)fwd_kernel, 512, LDS_BYTES) != hipSuccess || per_cu < 1) { fprintf(stderr, "kernel_launch: occupancy query says %d\n", per_cu); }
        (void)hipGetLastError();
        grid = cus;
    }
    if (grid < 0) return;
    (void)hipMemsetAsync((char*)d_ws + WS_CTL, 0, CTL_BYTES, stream);
    Args a{};
    for (int i = 0; i < 34; ++i) a.in[i] = (const float*)d_in[i];
    a.out = (float*)d_out; a.ws = (unsigned char*)d_ws;
#if MK_PER_PHASE
    for (int p = 0; p < NPHASE; ++p) { a.ph_lo = p; a.ph_hi = p + 1; hipLaunchKernelGGL(fwd_kernel, dim3(grid), dim3(512), LDS_BYTES, stream, a); }
#else
    a.ph_lo = 0; a.ph_hi = NPHASE; hipLaunchKernelGGL(fwd_kernel, dim3(grid), dim3(512), LDS_BYTES, stream, a);
#endif
}
```

```cpp
#include <hip/hip_runtime.h>
#include <cstdio>
#include <cstdint>

#ifndef MK_PER_PHASE
#define MK_PER_PHASE 0
#endif

#define LAS __attribute__((address_space(3)))
typedef unsigned short bf16_t;
typedef short bf16x8 __attribute__((ext_vector_type(8)));
typedef float f32x4 __attribute__((ext_vector_type(4)));
typedef float f32x2 __attribute__((ext_vector_type(2)));
typedef unsigned u32x4 __attribute__((ext_vector_type(4)));
typedef unsigned u32x2 __attribute__((ext_vector_type(2)));
typedef int i32x4 __attribute__((ext_vector_type(4)));
typedef int i32x8 __attribute__((ext_vector_type(8)));
typedef LAS float lfloat;
typedef LAS unsigned char lbyte;

constexpr int D = 1024, NB = 32, SEQ = 2048, CTX = 256, GW = 64;
constexpr int NLAT = NB * SEQ;
constexpr int NCTX = NB * CTX;
constexpr int NROWS = NLAT + NCTX;
constexpr int DA = 512, HA = 8, NA = 64;
constexpr int RW_COLS = 1920, GD_COLS = 2064, IN_COLS = 3984, PLD = 4096;
constexpr int DB = 512, HB = 4, KB = 128;
constexpr int NE = 256, TOPK = 8, DE = 256;
constexpr int MODW = 6 * D;
constexpr float NORM_EPS = 1e-6f, RWKV_EPS = 64e-5f;
constexpr int MAXTILES = (NLAT * TOPK + NE * 255) / 256 + 1;

constexpr size_t MiB = 1u << 20;
constexpr size_t WS_CTL = 0, CTL_BYTES = 1 * MiB;
constexpr size_t WS_MOD = 1 * MiB;
constexpr size_t WS_BTIN = 2 * MiB, WS_BTOUT = 10 * MiB, WS_BTR = 12 * MiB, WS_BON = 13 * MiB, WS_GUPT = 17 * MiB, WS_NRM = 978 * MiB;
constexpr size_t WS_P = 18 * MiB, WS_XN = 594 * MiB, WS_YDIR = 594 * MiB, WS_YMIX = 850 * MiB;
constexpr size_t WS_H2N8 = 900 * MiB;
constexpr size_t WS_H2N = 18 * MiB, WS_LOGIT = 146 * MiB, WS_TOPE = 210 * MiB, WS_TOPW = 212 * MiB, WS_POS = 214 * MiB, WS_Y = 146 * MiB;
constexpr size_t WS_ROWL = 658 * MiB, WS_ROWW = 661 * MiB, WS_TILEE = 664 * MiB, WS_HS = 672 * MiB, WS_WEXP = 704 * MiB;
constexpr size_t WEXP_STRIDE = (size_t)(512 * 1024 + 1024 * 256);
constexpr float SW13 = 64.f, SW2 = 32.f, SHS = 8.f, SWIN = 32.f;
constexpr size_t WS_END = 1090 * MiB;
static_assert(WS_WEXP + 257 * WEXP_STRIDE <= WS_END && WS_Y + (size_t)NLAT * 8 * D <= WS_ROWL, "ws map");
constexpr int CW_BAR = 4096;
constexpr int CW_CNT = 16384;
constexpr int CNT_STRIDE = 32;

constexpr int LDS_BYTES = 159744;
constexpr int LDS_MISC = LDS_BYTES - 64;

__device__ __forceinline__ unsigned f2bf(float f) { unsigned u = __builtin_bit_cast(unsigned, f); return (u + 0x7fffu + ((u >> 16) & 1u)) >> 16; }
typedef __bf16 bf16x2_t __attribute__((ext_vector_type(2)));
__device__ __forceinline__ unsigned cvtpk(float lo, float hi) { f32x2 v = {lo, hi}; return __builtin_bit_cast(unsigned, __builtin_convertvector(v, bf16x2_t)); }
__device__ __forceinline__ unsigned pk2(float lo, float hi) { return cvtpk(lo, hi); }
__device__ __forceinline__ unsigned pk4_fp8(float a, float b, float c, float d) { unsigned w = 0u;
    w = __builtin_amdgcn_cvt_pk_fp8_f32(__builtin_amdgcn_fmed3f(a, -448.f, 448.f), __builtin_amdgcn_fmed3f(b, -448.f, 448.f), w, false);
    w = __builtin_amdgcn_cvt_pk_fp8_f32(__builtin_amdgcn_fmed3f(c, -448.f, 448.f), __builtin_amdgcn_fmed3f(d, -448.f, 448.f), w, true); return w; }
__device__ __forceinline__ float bf2f(unsigned short b) { return __builtin_bit_cast(float, ((unsigned)b) << 16); }
__device__ __forceinline__ float bflo(unsigned w) { return __builtin_bit_cast(float, w << 16); }
__device__ __forceinline__ float bfhi(unsigned w) { return __builtin_bit_cast(float, w & 0xffff0000u); }
template <int CTRL> __device__ __forceinline__ float dpp_f(float v) { return __builtin_bit_cast(float, __builtin_amdgcn_update_dpp(0, __builtin_bit_cast(int, v), CTRL, 0xf, 0xf, false)); }
__device__ __forceinline__ float wave_sum(float v) {
    v += dpp_f<0x128>(v);
    v += dpp_f<0x124>(v);
    v += dpp_f<0x122>(v);
    v += dpp_f<0x121>(v);
    const int vi = __builtin_bit_cast(int, v);
    const float r0 = __builtin_bit_cast(float, __builtin_amdgcn_readlane(vi, 0)), r1 = __builtin_bit_cast(float, __builtin_amdgcn_readlane(vi, 16)),
                r2 = __builtin_bit_cast(float, __builtin_amdgcn_readlane(vi, 32)), r3 = __builtin_bit_cast(float, __builtin_amdgcn_readlane(vi, 48));
    return (r0 + r1) + (r2 + r3);
}
__device__ __forceinline__ float sigmoidf_(float x) { return __builtin_amdgcn_rcpf(1.f + __expf(-x)); }
__device__ __forceinline__ float siluf_(float x) { return x * __builtin_amdgcn_rcpf(1.f + __expf(-x)); }
__device__ __forceinline__ float softplusf_(float x) { return fmaxf(x, 0.f) + __logf(1.f + __expf(-fabsf(x))); }
__device__ __forceinline__ float tanhf_(float x) { const float e = __expf(-2.f * fabsf(x)); const float t = (1.f - e) * __builtin_amdgcn_rcpf(1.f + e); return x < 0.f ? -t : t; }

#define XB_TMO      128
#define XB_XCNT(j)  (256  + 64 * (j))
#define XB_XSUB(j)  (1280 + 64 * (j))
#define XB_XGEN(j)  (2304 + 64 * (j))
#define XB_TOP      3328
#define XB_TOPGEN   3392
#define XCD_BAR_WORDS 3456
#define XB_SPIN_CAP (1u << 22)
__device__ __forceinline__ unsigned xb_ld(unsigned* p)              { return __hip_atomic_load(p, __ATOMIC_RELAXED, __HIP_MEMORY_SCOPE_AGENT); }
__device__ __forceinline__ unsigned xb_add(unsigned* p, unsigned v) { return __hip_atomic_fetch_add(p, v, __ATOMIC_RELAXED, __HIP_MEMORY_SCOPE_AGENT); }
__device__ __forceinline__ unsigned xb_xcc_id() { return (unsigned)__builtin_amdgcn_s_getreg((3 << 11) | 20) & 0xFu; }
#define XB_SPIN(cond, bar) do { unsigned _sp = 0; while (cond) { __builtin_amdgcn_s_sleep(1); \
    if ((++_sp & 255u) == 0u) { if (xb_ld(&(bar)[XB_TMO])) break; if (_sp > XB_SPIN_CAP) { atomicAdd(&(bar)[XB_TMO], 1u); break; } } } } while (0)
struct XcdBarrier { unsigned* bar; unsigned x; volatile LAS unsigned* st; };
__device__ __forceinline__ XcdBarrier xcd_barrier_post(unsigned* bar, volatile LAS unsigned* st) {
    XcdBarrier b; b.bar = bar; b.x = xb_xcc_id(); b.st = st;
    if (threadIdx.x == 0) (void)xb_add(&bar[XB_XCNT(b.x)], 1u);
    return b;
}
__device__ __forceinline__ void xcd_barrier_complete(unsigned* bar, unsigned x, unsigned& nloc, unsigned& nx) {
    const unsigned G = gridDim.x * gridDim.y * gridDim.z;
    unsigned sum, cnt, mine, sp = 0u;
    for (;;) {
        sum = 0u; cnt = 0u; mine = 0u;
#pragma unroll
        for (unsigned j = 0; j < 16; ++j) { const unsigned c = xb_ld(&bar[XB_XCNT(j)]); sum += c; cnt += (c > 0u) ? 1u : 0u; mine = (j == x) ? c : mine; }
        if (sum == G) break;
        __builtin_amdgcn_s_sleep(1);
        if ((++sp & 255u) == 0u) { if (xb_ld(&bar[XB_TMO])) break; if (sp > XB_SPIN_CAP) { atomicAdd(&bar[XB_TMO], 1u); break; } }
    }
    nloc = mine > 0u ? mine : 1u; nx = cnt > 0u ? cnt : 1u;
}
__device__ __forceinline__ void xcd_barrier(const XcdBarrier& b) {
    asm volatile("s_waitcnt vmcnt(0)" ::: "memory");
    __syncthreads();
    if (threadIdx.x == 0) {
        unsigned* bar = b.bar;
        __builtin_amdgcn_s_waitcnt(0);
        unsigned nloc = b.st[0], nx = b.st[1];
        if (nloc == 0u) { xcd_barrier_complete(bar, b.x, nloc, nx); b.st[0] = nloc; b.st[1] = nx; }
        const unsigned old = xb_add(&bar[XB_XSUB(b.x)], 1u);
        const unsigned gen = old / nloc;
        if (old + 1u == (gen + 1u) * nloc) {
            __builtin_amdgcn_fence(__ATOMIC_RELEASE, "agent");
            asm volatile("s_waitcnt vmcnt(0)" ::: "memory");
            const unsigned og = xb_add(&bar[XB_TOP], 1u);
            const unsigned tg = og / nx;
            if (og + 1u == (tg + 1u) * nx) xb_add(&bar[XB_TOPGEN], 1u);
            else XB_SPIN(xb_ld(&bar[XB_TOPGEN]) == tg, bar);
            __builtin_amdgcn_fence(__ATOMIC_ACQUIRE, "agent");
            xb_add(&bar[XB_XGEN(b.x)], 1u);
            asm volatile("s_waitcnt vmcnt(0)" ::: "memory");
        } else {
            XB_SPIN(xb_ld(&bar[XB_XGEN(b.x)]) == gen, bar);
            __builtin_amdgcn_fence(__ATOMIC_ACQUIRE, "agent");
            asm volatile("s_waitcnt vmcnt(0)" ::: "memory");
        }
    }
    __syncthreads();
}

struct Args {
    const float* in[34];
    float* out;
    unsigned char* ws;
    int ph_lo, ph_hi;
};
enum { I_X = 0, I_C, I_CTX, I_CCTX, I_WADA, I_BADA, I_N1G, I_WIN, I_MU, I_W0, I_WUP, I_A0, I_AUP, I_GUP, I_KK, I_KA, I_RK, I_LNW, I_LNB,
       I_CONVW, I_ALOG, I_DTB, I_ONG, I_WOUT, I_N2G, I_RW, I_RB, I_EW1, I_EW3, I_EW2, I_SW1, I_SW3, I_SW2, I_FG };

namespace pg8 {
constexpr int BM = 256, BK = 64, HALF = 128, HTB = HALF * BK * 2, STAGE_BYTES = 8 * HTB, NXCD = 8, WGM = 8;
__host__ __device__ __forceinline__ int lds_byte(int r, int c) { const int st = (r >> 4) * 2 + (c >> 5), rr = r & 15, cc = c & 31, ob = rr * 64 + cc * 2; return st * 1024 + (ob ^ (((ob >> 9) & 1) << 5)); }
__host__ __device__ __forceinline__ void stage_rc(int b, int& R, int& C) { const int st = b / 1024, sb = b % 1024, swz = sb ^ (((sb >> 9) & 1) << 5); R = (st >> 1) * 16 + swz / 64; C = (st & 1) * 32 + (swz % 64) / 2; }
__host__ __device__ __forceinline__ int perm32(int rho) { const int n = rho >> 4, i = rho & 15; return 8 * (i >> 2) + 4 * n + (i & 3); }
struct Unit { int pm, pn; };
struct Gemm { const bf16_t* A; int K; };
struct StaticOrder {
    int nM, nN, nwg, G, c; const char* Bt; size_t tstepB;
    __device__ void init(int M, int N, int G_, int c_, const void* Bt_, int K, int es = 2) { nM = M / BM; nN = N / BM; nwg = nM * nN; G = G_; c = c_; Bt = (const char*)Bt_; tstepB = (size_t)BM * K * es; }
    __device__ bool next(int i, Unit& u) const {
        const long L = (long)i * G + c; if (L >= nwg) return false;
        int wgid = (int)L; { const int q = nwg / NXCD, r = nwg % NXCD, xcd = wgid % NXCD, off = wgid / NXCD; wgid = (xcd < r ? xcd * (q + 1) : r * (q + 1) + (xcd - r) * q) + off; }
        const int nig = WGM * nN, gid = wgid / nig, fm = gid * WGM, gsz = (nM - fm) < WGM ? (nM - fm) : WGM;
        u.pm = fm + ((wgid % nig) % gsz); u.pn = (wgid % nig) / gsz; return true;
    }
    __device__ __forceinline__ const char* bptr(const Unit& u) const { return Bt + (size_t)u.pn * tstepB; }
    __device__ __forceinline__ int rowsel(const Unit&, int) const { return 0; }
};
struct TileOrder {
    int nunits, npn, G, c; const int* tile_e; const char* wbase; size_t wstride, woff, tstepB; const int* rowl;
    __device__ bool next(int i, Unit& u) const { const int L = i * G + c; if (L >= nunits) return false; u.pm = L / npn; u.pn = L - u.pm * npn; return true; }
    __device__ __forceinline__ const char* bptr(const Unit& u) const { const int e = __builtin_amdgcn_readfirstlane(tile_e[u.pm]); return wbase + (size_t)e * wstride + woff + (size_t)u.pn * tstepB; }
    __device__ __forceinline__ int rowsel(const Unit& u, int r) const { const int t = rowl[(size_t)u.pm * 256 + r]; return t < 0 ? 0 : t; }
};
struct SeqOrder {
    int n; const char* Bt; size_t tstepB; const LAS int* rsel;
    __device__ bool next(int i, Unit& u) const { if (i >= n) return false; u.pm = 0; u.pn = i; return true; }
    __device__ __forceinline__ const char* bptr(const Unit& u) const { return Bt + (size_t)u.pn * tstepB; }
    __device__ __forceinline__ int rowsel(const Unit&, int r) const { return rsel[r]; }
};
__device__ __forceinline__ unsigned cvt_pk_bf16(float lo, float hi) { return cvtpk(lo, hi); }

template <class Epi, class Sched, bool GATHER, int A_AUX = 0, bool ALIGN = true, bool FP8 = false>
__device__ __forceinline__ void gemm_phase(lbyte* lds, const Gemm g, const Sched& S, const Epi& E) {
    int tid_ = threadIdx.x; asm volatile("" : "+v"(tid_));
    const int tid = tid_, wid = __builtin_amdgcn_readfirstlane(tid >> 6), lane = tid & 63, wr = wid >> 2, wc = wid & 3, fr = lane & 15, fq = lane >> 4;
    constexpr unsigned ES = FP8 ? 1u : 2u;
    const int K = g.K, nt = FP8 ? K / 128 : K / BK;
    Unit cur, nxt; int ui = 0;
    if (!S.next(0, cur)) return;
    int Rst[2], Cst[2];
    unsigned voffA[2], voffA1[2], voffB[2], nvA[2], nvA1[2];
#pragma unroll
    for (int i = 0; i < 2; ++i) { int R, C; stage_rc(tid * 16 + i * 8192, R, C); const int Rb = Epi::PERM ? ((R & ~31) + perm32(R & 31)) : R; Rst[i] = R; Cst[i] = C;
        if (GATHER) { voffA[i] = (unsigned)S.rowsel(cur, R) * (unsigned)K * ES + (unsigned)C * 2u; voffA1[i] = (unsigned)S.rowsel(cur, 128 + R) * (unsigned)K * ES + (unsigned)C * 2u; }
        else { voffA[i] = (unsigned)(R * K) * ES + (unsigned)C * 2u; voffA1[i] = voffA[i]; }
        nvA[i] = voffA[i]; nvA1[i] = voffA1[i];
        voffB[i] = (unsigned)(Rb * K) * ES + (unsigned)C * 2u; }
    const size_t kstep = (size_t)(BK * 2);
    const size_t hstep = (size_t)HALF * K * ES;
    const size_t hstepA = GATHER ? 0 : hstep;
    const size_t tstep = 2 * hstep;
    const unsigned ldsw = (unsigned)wid * 1024u;
    const int aoff = lds_byte(wr * 64 + fr, fq * 8), boff = lds_byte(wc * 32 + fr, fq * 8);
#define PG8_SA(b, h) (((b) * 2 + (h)) * HTB)
#define PG8_SB(b, h) ((4 + (b) * 2 + (h)) * HTB)
#define PG8_STAGE2(bufoff, gbase, v0, v1) do { \
        __builtin_amdgcn_global_load_lds((const unsigned*)((const char*)(gbase) + (v0)), (LAS unsigned*)(lds + (bufoff) + ldsw), 16, 0, 0); \
        __builtin_amdgcn_global_load_lds((const unsigned*)((const char*)(gbase) + (v1)), (LAS unsigned*)(lds + (bufoff) + ldsw + 8192), 16, 0, 0); } while (0)
#define PG8_STAGE2A(bufoff, gbase, v0, v1) do { if constexpr (A_AUX == 16) { \
        __builtin_amdgcn_global_load_lds((const unsigned*)((const char*)(gbase) + (v0)), (LAS unsigned*)(lds + (bufoff) + ldsw), 16, 0, 16); \
        __builtin_amdgcn_global_load_lds((const unsigned*)((const char*)(gbase) + (v1)), (LAS unsigned*)(lds + (bufoff) + ldsw + 8192), 16, 0, 16); } else { PG8_STAGE2(bufoff, gbase, v0, v1); } } while (0)
#define PG8_STAGE(bufoff, gbase, voff) PG8_STAGE2(bufoff, gbase, (voff)[0], (voff)[1])
#define PG8_STAGEA(bufoff, gbase, voff) PG8_STAGE2A(bufoff, gbase, (voff)[0], (voff)[1])
#define G_LD32(p) __builtin_shufflevector(*(const LAS i32x4*)(p), *(const LAS i32x4*)((p) + 1024), 0, 1, 2, 3, 4, 5, 6, 7)
#define G_MFMA8(c, a, b) asm volatile("v_mfma_scale_f32_16x16x128_f8f6f4 %0, %1, %2, %0, %3, %3 op_sel_hi:[0,0,0]" : "+v"(c) : "v"(a), "v"(b), "v"(one_scale))
#define PG8_LDA(dst, b, h) do { if constexpr (FP8) { _Pragma("unroll") for (int m = 0; m < 4; ++m) dst##8[m] = G_LD32(lds + PG8_SA(b, h) + aoff + m * 2048); } else { \
        _Pragma("unroll") for (int m = 0; m < 4; ++m) _Pragma("unroll") for (int k = 0; k < 2; ++k) dst[m][k] = *(const LAS bf16x8*)(lds + PG8_SA(b, h) + aoff + m * 2048 + k * 1024); } } while (0)
#define PG8_LDB(dst, b, h) do { if constexpr (FP8) { _Pragma("unroll") for (int n = 0; n < 2; ++n) dst##8[n] = G_LD32(lds + PG8_SB(b, h) + boff + n * 2048); } else { \
        _Pragma("unroll") for (int n = 0; n < 2; ++n) _Pragma("unroll") for (int k = 0; k < 2; ++k) dst[n][k] = *(const LAS bf16x8*)(lds + PG8_SB(b, h) + boff + n * 2048 + k * 1024); } } while (0)
#define PG8_MMA(ai, bj, At, Bt) do { __builtin_amdgcn_s_setprio(1); if constexpr (FP8) { _Pragma("unroll") for (int m = 0; m < 4; ++m) _Pragma("unroll") for (int n = 0; n < 2; ++n) G_MFMA8(acc[ai][bj][m][n], Bt##8[n], At##8[m]); } else { \
        _Pragma("unroll") for (int m = 0; m < 4; ++m) _Pragma("unroll") for (int n = 0; n < 2; ++n) _Pragma("unroll") for (int k = 0; k < 2; ++k) \
        acc[ai][bj][m][n] = __builtin_amdgcn_mfma_f32_16x16x32_bf16(Bt[n][k], At[m][k], acc[ai][bj][m][n], 0, 0, 0); } __builtin_amdgcn_s_setprio(0); } while (0)
#define PG8_WAIT_V(n) asm volatile("s_waitcnt vmcnt(" #n ")" ::: "memory")
#define PG8_WAIT_L(n) asm volatile("s_waitcnt lgkmcnt(" #n ")" ::: "memory")
#define PG8_BAR __builtin_amdgcn_s_barrier()
#define PG8_SCHED __builtin_amdgcn_sched_barrier(0)
    f32x4 acc[2][2][4][2];
#pragma unroll
    for (int a = 0; a < 2; ++a)
#pragma unroll
        for (int b = 0; b < 2; ++b)
#pragma unroll
            for (int m = 0; m < 4; ++m)
#pragma unroll
                for (int n = 0; n < 2; ++n) acc[a][b][m][n] = (f32x4){0.f, 0.f, 0.f, 0.f};
    bf16x8 At[4][2], B0[2][2], B1[2][2]; i32x8 At8[4], B08[2], B18[2];
    int one_scale = 0x7F7F7F7F; asm volatile("" : "+v"(one_scale));
    const char* cA = (const char*)g.A + (GATHER ? (size_t)0 : (size_t)cur.pm * tstep); const char* cB = S.bptr(cur);
    PG8_STAGE(PG8_SB(0, 0), cB, voffB); PG8_STAGE(PG8_SB(0, 1), cB + hstep, voffB); PG8_STAGEA(PG8_SA(0, 0), cA, voffA); PG8_STAGEA(PG8_SA(0, 1), cA + hstepA, voffA1);
    if (wr == 1) PG8_BAR;
    PG8_WAIT_V(2); PG8_BAR;
    PG8_STAGE(PG8_SB(1, 0), cB + kstep, voffB); PG8_STAGEA(PG8_SA(1, 0), cA + kstep, voffA); PG8_STAGE(PG8_SB(1, 1), cB + hstep + kstep, voffB);
    PG8_WAIT_V(6); PG8_BAR;
    for (;;) {
        const bool has_next = S.next(ui + 1, nxt);
        const char* nA = has_next ? (const char*)g.A + (GATHER ? (size_t)0 : (size_t)nxt.pm * tstep) : cA; const char* nB = has_next ? S.bptr(nxt) : cB;
        for (int t = 0; t < nt; t += 2) {
            const bool last = (t == nt - 2);
            const char* a1 = cA + (size_t)(t + 1) * kstep;
            const char* a2 = last ? nA : cA + (size_t)(t + 2) * kstep; const char* b2 = last ? nB : cB + (size_t)(t + 2) * kstep;
            const char* a3 = a2 + kstep; const char* b3 = b2 + kstep;
            if (GATHER && last && has_next) {
#pragma unroll
                for (int i = 0; i < 2; ++i) { nvA[i] = (unsigned)S.rowsel(nxt, Rst[i]) * (unsigned)K * ES + (unsigned)Cst[i] * 2u; nvA1[i] = (unsigned)S.rowsel(nxt, 128 + Rst[i]) * (unsigned)K * ES + (unsigned)Cst[i] * 2u; }
            }
            const unsigned x0 = (GATHER && last) ? nvA[0] : voffA[0], x1 = (GATHER && last) ? nvA[1] : voffA[1];
            const unsigned y0 = (GATHER && last) ? nvA1[0] : voffA1[0], y1 = (GATHER && last) ? nvA1[1] : voffA1[1];
            PG8_LDB(B0, 0, 0); PG8_LDB(B1, 0, 1); PG8_SCHED; PG8_LDA(At, 0, 0); PG8_STAGEA(PG8_SA(1, 1), a1 + hstepA, voffA1);
            PG8_WAIT_V(8); PG8_WAIT_L(0); PG8_BAR; PG8_MMA(0, 0, At, B0); PG8_MMA(0, 1, At, B1); PG8_BAR; PG8_SCHED;
            PG8_LDA(At, 0, 1); PG8_STAGE(PG8_SB(0, 0), b2, voffB); PG8_STAGE(PG8_SB(0, 1), b2 + hstep, voffB); PG8_STAGE2A(PG8_SA(0, 0), a2, x0, x1);
            PG8_WAIT_V(8); PG8_WAIT_L(0); PG8_BAR; PG8_MMA(1, 0, At, B0); PG8_MMA(1, 1, At, B1); PG8_BAR; PG8_SCHED;
            PG8_LDB(B0, 1, 0); PG8_LDB(B1, 1, 1); PG8_SCHED; PG8_LDA(At, 1, 0); PG8_STAGE2A(PG8_SA(0, 1), a2 + hstepA, y0, y1);
            PG8_WAIT_V(8); PG8_WAIT_L(0); PG8_BAR; PG8_MMA(0, 0, At, B0); PG8_MMA(0, 1, At, B1); PG8_BAR; PG8_SCHED;
            PG8_LDA(At, 1, 1); PG8_STAGE(PG8_SB(1, 0), b3, voffB); PG8_STAGE(PG8_SB(1, 1), b3 + hstep, voffB); PG8_STAGE2A(PG8_SA(1, 0), a3, x0, x1);
            PG8_WAIT_V(8); PG8_WAIT_L(0); PG8_BAR; PG8_MMA(1, 0, At, B0); PG8_MMA(1, 1, At, B1); PG8_BAR; PG8_SCHED;
        }
        if (ALIGN && wr == 0) PG8_BAR;
        if constexpr (FP8) asm volatile("s_nop 15\n\ts_nop 15" ::: "memory");
        E(acc, cur, wr, wc, fr, fq);
        if (!has_next) break;
#pragma unroll
        for (int a = 0; a < 2; ++a)
#pragma unroll
            for (int b = 0; b < 2; ++b)
#pragma unroll
                for (int m = 0; m < 4; ++m)
#pragma unroll
                    for (int n = 0; n < 2; ++n) acc[a][b][m][n] = (f32x4){0.f, 0.f, 0.f, 0.f};
        cur = nxt; cA = nA; cB = nB; ++ui;
        if (GATHER) { voffA[0] = nvA[0]; voffA[1] = nvA[1]; voffA1[0] = nvA1[0]; voffA1[1] = nvA1[1]; }
        if (ALIGN && wr == 1) PG8_BAR;
    }
    PG8_WAIT_V(0);
    if (!ALIGN && wr == 0) PG8_BAR;
    PG8_BAR;
#undef PG8_SA
#undef PG8_SB
#undef PG8_STAGE
#undef PG8_STAGE2
#undef PG8_STAGE2A
#undef PG8_STAGEA
#undef G_LD32
#undef G_MFMA8
#undef PG8_LDA
#undef PG8_LDB
#undef PG8_MMA
#undef PG8_WAIT_V
#undef PG8_WAIT_L
#undef PG8_BAR
#undef PG8_SCHED
}

struct EpiBf16 {
    static constexpr bool PERM = true;
    bf16_t* O; int ldc; float scale;
    __device__ __forceinline__ void operator()(const f32x4 (&acc)[2][2][4][2], const Unit& u, int wr, int wc, int fr, int fq) const {
        const int row0 = u.pm * BM + wr * 64 + fr; const int col0 = u.pn * BM + wc * 32 + 8 * fq;
#pragma unroll
        for (int ai = 0; ai < 2; ++ai)
#pragma unroll
            for (int m = 0; m < 4; ++m) { bf16_t* rowp = O + (size_t)(row0 + ai * HALF + m * 16) * ldc + col0;
#pragma unroll
                for (int bj = 0; bj < 2; ++bj) { const f32x4 v0 = acc[ai][bj][m][0] * scale, v1 = acc[ai][bj][m][1] * scale;
                    u32x4 w; w.x = cvt_pk_bf16(v0[0], v0[1]); w.y = cvt_pk_bf16(v0[2], v0[3]); w.z = cvt_pk_bf16(v1[0], v1[1]); w.w = cvt_pk_bf16(v1[2], v1[3]);
                    *(u32x4*)(rowp + bj * HALF) = w; } }
    }
};
struct EpiF32 {
    static constexpr bool PERM = false;
    float* C; int ldc;
    __device__ __forceinline__ void operator()(const f32x4 (&acc)[2][2][4][2], const Unit& u, int wr, int wc, int fr, int fq) const {
        const int row0 = u.pm * BM + wr * 64 + fr, col0 = u.pn * BM + wc * 32 + 4 * fq;
#pragma unroll
        for (int ai = 0; ai < 2; ++ai)
#pragma unroll
            for (int m = 0; m < 4; ++m) { float* rowp = C + (size_t)(row0 + ai * HALF + m * 16) * ldc + col0;
#pragma unroll
                for (int bj = 0; bj < 2; ++bj)
#pragma unroll
                    for (int n = 0; n < 2; ++n) *(f32x4*)(rowp + bj * HALF + n * 16) = acc[ai][bj][m][n]; }
    }
};
struct EpiResGate {
    static constexpr bool PERM = false;
    const float* x; float* out; const float* mod; int gate_off;
    __device__ __forceinline__ void operator()(const f32x4 (&acc)[2][2][4][2], const Unit& u, int wr, int wc, int fr, int fq) const {
        const int row0 = u.pm * BM + wr * 64 + fr, col0 = u.pn * BM + wc * 32 + 4 * fq;
        const float* gp = mod + (size_t)((u.pm * BM) >> 11) * MODW + gate_off + col0;
        f32x4 gv[2][2];
#pragma unroll
        for (int bj = 0; bj < 2; ++bj)
#pragma unroll
            for (int n = 0; n < 2; ++n) gv[bj][n] = *(const f32x4*)(gp + bj * HALF + n * 16);
#pragma unroll
        for (int ai = 0; ai < 2; ++ai)
#pragma unroll
            for (int m = 0; m < 4; ++m) { const size_t off = (size_t)(row0 + ai * HALF + m * 16) * D + col0;
#pragma unroll
                for (int bj = 0; bj < 2; ++bj)
#pragma unroll
                    for (int n = 0; n < 2; ++n) { const f32x4 xv = *(const f32x4*)(x + off + bj * HALF + n * 16);
                        *(f32x4*)(out + off + bj * HALF + n * 16) = xv + gv[bj][n] * acc[ai][bj][m][n]; }
                asm volatile("" ::: "memory"); }
    }
};
struct EpiGLU {
    static constexpr bool PERM = true;
    bf16_t* H;
    __device__ __forceinline__ void operator()(const f32x4 (&acc)[2][2][4][2], const Unit& u, int wr, int wc, int fr, int fq) const {
        const int row0 = u.pm * BM + wr * 64 + fr; const int col0 = u.pn * 128 + wc * 32 + 8 * fq;
#pragma unroll
        for (int ai = 0; ai < 2; ++ai)
#pragma unroll
            for (int m = 0; m < 4; ++m) { bf16_t* rowp = H + (size_t)(row0 + ai * HALF + m * 16) * 256 + col0;
                f32x4 h0, h1;
#pragma unroll
                for (int j = 0; j < 4; ++j) { const float a0 = acc[ai][0][m][0][j], a1 = acc[ai][0][m][1][j];
                    h0[j] = siluf_(a0) * acc[ai][1][m][0][j]; h1[j] = siluf_(a1) * acc[ai][1][m][1][j]; }
                u32x4 w; w.x = cvt_pk_bf16(h0[0], h0[1]); w.y = cvt_pk_bf16(h0[2], h0[3]); w.z = cvt_pk_bf16(h1[0], h1[1]); w.w = cvt_pk_bf16(h1[2], h1[3]);
                *(u32x4*)rowp = w; }
    }
};
constexpr float YSCALE = 8.f;
struct EpiY {
    static constexpr bool PERM = true;
    unsigned char* Y; float* out; const float* mod; const LAS int* rtok; const LAS float* rw; int shared;
    __device__ __forceinline__ void operator()(const f32x4 (&acc)[2][2][4][2], const Unit& u, int wr, int wc, int fr, int fq) const {
        const int col0 = u.pn * BM + wc * 32 + 8 * fq;
#pragma unroll
        for (int ai = 0; ai < 2; ++ai)
#pragma unroll
            for (int m = 0; m < 4; ++m) { const int r = wr * 64 + fr + ai * HALF + m * 16; const int ts = rtok[r]; const float w = rw[r];
                if (ts >= 0) {
                    if (shared) { const unsigned goff = (unsigned)(ts >> 11) * MODW + 5 * D + col0; const unsigned ooff = (unsigned)ts * D + col0;
#pragma unroll
                        for (int bj = 0; bj < 2; ++bj)
#pragma unroll
                            for (int n = 0; n < 2; ++n) { const f32x4 gv = *(const f32x4*)(mod + goff + bj * HALF + n * 4); f32x4* op = (f32x4*)(out + ooff + bj * HALF + n * 4);
                                *op = *op + gv * acc[ai][bj][m][n]; }
                    } else { unsigned char* yp = Y + (size_t)(unsigned)ts * D + col0; const float ws_ = w * YSCALE;
#pragma unroll
                        for (int bj = 0; bj < 2; ++bj) { f32x4 v0 = acc[ai][bj][m][0] * ws_, v1 = acc[ai][bj][m][1] * ws_;
#pragma unroll
                                for (int j = 0; j < 4; ++j) { v0[j] = __builtin_amdgcn_fmed3f(v0[j], -448.f, 448.f); v1[j] = __builtin_amdgcn_fmed3f(v1[j], -448.f, 448.f); }
                            unsigned lo = 0u, hi = 0u;
                            lo = __builtin_amdgcn_cvt_pk_fp8_f32(v0[0], v0[1], lo, false); lo = __builtin_amdgcn_cvt_pk_fp8_f32(v0[2], v0[3], lo, true);
                            hi = __builtin_amdgcn_cvt_pk_fp8_f32(v1[0], v1[1], hi, false); hi = __builtin_amdgcn_cvt_pk_fp8_f32(v1[2], v1[3], hi, true);
                            u32x2 pk; pk.x = lo; pk.y = hi; *(u32x2*)(yp + bj * HALF) = pk; } } }
                asm volatile("" ::: "memory"); }
    }
};

struct MoeCtx {
    int ntiles, nrt, G, vc;
    const LAS int* tb; LAS int* tbl;
    const unsigned* cnt; const int* rowl; const float* roww;
    const char* wexp; const char* h2n; char* Hs; unsigned char* Y; float* out; const float* mod; int dry_shared;
};
__device__ __forceinline__ void gemm_moe(lbyte* lds, const MoeCtx& M) {
    int tid_ = threadIdx.x; asm volatile("" : "+v"(tid_));
    const int tid = tid_, wid = __builtin_amdgcn_readfirstlane(tid >> 6), lane = tid & 63, wr = wid >> 2, wc = wid & 3, fr = lane & 15, fq = lane >> 4;
    const int ntl = (M.ntiles - M.vc + M.G - 1) / M.G;
    if (M.vc >= M.ntiles) return;
    const int nunits = ntl * 6;
    const unsigned ldsw = (unsigned)wid * 1024u;
    const int aoff = lds_byte(wr * 64 + fr, fq * 8), boff = lds_byte(wc * 32 + fr, fq * 8);
    auto tile_expert = [&](int tile, int& e, int& k) { if (tile < M.nrt) { int lo = 0, hi = NE - 1; while (lo < hi) { const int mid = (lo + hi + 1) >> 1; if (M.tb[mid] <= tile) lo = mid; else hi = mid - 1; } e = lo; k = tile - M.tb[lo]; } else { e = NE; k = tile - M.nrt; } };
    auto fill = [&](int j) { if (j < ntl && tid < 256) { const int tile = M.vc + j * M.G; int e, k; tile_expert(tile, e, k); LAS int* T = M.tbl + (j % 3) * 768;
            int ts; float w;
            if (e < NE) { const int valid = (int)M.cnt[e * CNT_STRIDE] - 256 * k; if (tid < valid) { ts = M.rowl[(size_t)tile * 256 + tid]; w = M.roww[(size_t)tile * 256 + tid]; } else { ts = -1; w = 0.f; } T[tid] = ts < 0 ? 0 : (ts >> 3); }
            else { ts = k * 256 + tid; w = 1.f; T[tid] = ts; }
            T[256 + tid] = ts; ((LAS float*)T)[512 + tid] = w; } };
    struct UP { const char* aB; const char* bB; unsigned bh; int nt, kind, pn, slot, shared, e, hbuf, fillnext; };
    auto unit_params = [&](int ui, int prev_e, UP& u, unsigned (&oa)[4], unsigned (&ob)[2]) {
        int tq = threadIdx.x; asm volatile("" : "+v"(tq));
        int Rst[2], Cst[2], Rbp[2];
#pragma unroll
        for (int i = 0; i < 2; ++i) { int R, C; stage_rc(tq * 16 + i * 8192, R, C); Rst[i] = R; Cst[i] = C; Rbp[i] = (R & ~31) + perm32(R & 31); }
        int j, sub;
        if (ui < 2) { j = 0; sub = ui; }
        else { const int qq = ui - 2, g = qq / 6, r = qq - 6 * g; if (g < ntl - 1 && r < 2) { j = g + 1; sub = r; } else { j = g; sub = (g < ntl - 1) ? r : r + 2; } }
        const int tile = M.vc + j * M.G; int e, k;
        if (sub == 0 || sub == 2) tile_expert(tile, e, k); else e = prev_e;
        u.e = e;
        const char* w = M.wexp + (size_t)e * WEXP_STRIDE;
        u.slot = j % 3; u.hbuf = j & 1; u.fillnext = (sub == 1) ? j + 1 : -1; u.shared = (e == NE) ? 1 : 0;
        if (sub < 2) { u.kind = 0; u.pn = sub; u.nt = D / 128; u.aB = M.h2n; u.bB = w + (size_t)sub * 256 * D; u.bh = 128u * D;
            const LAS int* T = M.tbl + (j % 3) * 768;
#pragma unroll
            for (int i = 0; i < 2; ++i) { oa[i] = (unsigned)T[Rst[i]] * (unsigned)D + 2u * (unsigned)Cst[i]; oa[2 + i] = (unsigned)T[128 + Rst[i]] * (unsigned)D + 2u * (unsigned)Cst[i]; ob[i] = (unsigned)(Rbp[i] * D + 2 * Cst[i]); } }
        else { u.kind = 1; u.pn = sub - 2; u.nt = DE / 128; u.aB = M.Hs + (j & 1) * 65536; u.bB = w + (size_t)512 * 1024 + (size_t)(sub - 2) * 256 * DE; u.bh = 128u * DE;
#pragma unroll
            for (int i = 0; i < 2; ++i) { oa[i] = (unsigned)(Rst[i] * DE + 2 * Cst[i]); oa[2 + i] = (unsigned)((128 + Rst[i]) * DE + 2 * Cst[i]); ob[i] = (unsigned)(Rbp[i] * DE + 2 * Cst[i]); } }
    };
#define PG8_SA(b, h) (((b) * 2 + (h)) * HTB)
#define PG8_SB(b, h) ((4 + (b) * 2 + (h)) * HTB)
#define MOE_DMA(bufoff, ptr, aux) __builtin_amdgcn_global_load_lds((const unsigned*)(ptr), (LAS unsigned*)(lds + (bufoff)), 16, 0, aux)
#define MOE_STA(bufoff, base, o0, o1) do { MOE_DMA((bufoff) + ldsw, (base) + (o0), 16); MOE_DMA((bufoff) + ldsw + 8192, (base) + (o1), 16); } while (0)
#define MOE_STAK(kindv, bufoff, base, o0, o1) do { if ((kindv) == 0) { MOE_DMA((bufoff) + ldsw, (base) + (o0), 0); MOE_DMA((bufoff) + ldsw + 8192, (base) + (o1), 0); } else MOE_STA(bufoff, base, o0, o1); } while (0)
#define MOE_STB(bufoff, base, o0, o1) do { MOE_DMA((bufoff) + ldsw, (base) + (o0), 0); MOE_DMA((bufoff) + ldsw + 8192, (base) + (o1), 0); } while (0)
#define MOE_LD32(p) __builtin_shufflevector(*(const LAS i32x4*)(p), *(const LAS i32x4*)((p) + 1024), 0, 1, 2, 3, 4, 5, 6, 7)
#define PG8_LDA(dst, b, h) do { _Pragma("unroll") for (int m = 0; m < 4; ++m) dst[m] = MOE_LD32(lds + PG8_SA(b, h) + aoff + m * 2048); } while (0)
#define PG8_LDB(dst, b, h) do { _Pragma("unroll") for (int n = 0; n < 2; ++n) dst[n] = MOE_LD32(lds + PG8_SB(b, h) + boff + n * 2048); } while (0)
#define MOE_MFMA(c, a, b) asm volatile("v_mfma_scale_f32_16x16x128_f8f6f4 %0, %1, %2, %0, %3, %3 op_sel_hi:[0,0,0]" : "+v"(c) : "v"(a), "v"(b), "v"(one_scale))
#define PG8_MMA(ai, bj, At, Bt) do { __builtin_amdgcn_s_setprio(1); _Pragma("unroll") for (int m = 0; m < 4; ++m) _Pragma("unroll") for (int n = 0; n < 2; ++n) \
        MOE_MFMA(acc[ai][bj][m][n], Bt[n], At[m]); __builtin_amdgcn_s_setprio(0); } while (0)
#define PG8_WAIT_V(n) asm volatile("s_waitcnt vmcnt(" #n ")" ::: "memory")
#define PG8_WAIT_L(n) asm volatile("s_waitcnt lgkmcnt(" #n ")" ::: "memory")
#define PG8_BAR __builtin_amdgcn_s_barrier()
#define PG8_SCHED __builtin_amdgcn_sched_barrier(0)
    fill(0);
    asm volatile("s_waitcnt vmcnt(0) lgkmcnt(0)" ::: "memory");
    __syncthreads();
    UP cu, nu; unsigned oa[4], ob[2], na[4], nb[2];
    unit_params(0, 0, cu, oa, ob);
    nu = cu;
#pragma unroll
    for (int i = 0; i < 4; ++i) na[i] = oa[i];
    nb[0] = ob[0]; nb[1] = ob[1];
    f32x4 acc[2][2][4][2];
#pragma unroll
    for (int a = 0; a < 2; ++a)
#pragma unroll
        for (int b = 0; b < 2; ++b)
#pragma unroll
            for (int m = 0; m < 4; ++m)
#pragma unroll
                for (int n = 0; n < 2; ++n) acc[a][b][m][n] = (f32x4){0.f, 0.f, 0.f, 0.f};
    i32x8 At[4], B0[2], B1[2];
    int one_scale = 0x7F7F7F7F; asm volatile("" : "+v"(one_scale));
    const size_t kstep = (size_t)128;
    {   const char* cA = cu.aB; const char* cB = cu.bB;
        MOE_STB(PG8_SB(0, 0), cB, ob[0], ob[1]); MOE_STB(PG8_SB(0, 1), cB + cu.bh, ob[0], ob[1]); MOE_STAK(cu.kind, PG8_SA(0, 0), cA, oa[0], oa[1]); MOE_STAK(cu.kind, PG8_SA(0, 1), cA, oa[2], oa[3]);
        if (wr == 1) PG8_BAR;
        PG8_WAIT_V(2); PG8_BAR;
        MOE_STB(PG8_SB(1, 0), cB + kstep, ob[0], ob[1]); MOE_STAK(cu.kind, PG8_SA(1, 0), cA + kstep, oa[0], oa[1]); MOE_STB(PG8_SB(1, 1), cB + cu.bh + kstep, ob[0], ob[1]);
        PG8_WAIT_V(6); PG8_BAR; }
    for (int ui = 0;; ++ui) {
        const bool has_next = (ui + 1 < nunits);
        if (cu.fillnext >= 0) fill(cu.fillnext);
        const char* cA = cu.aB; const char* cB = cu.bB; const int nt = cu.nt; const unsigned bh = cu.bh;
        for (int t = 0; t < nt; t += 2) {
            const bool last = (t == nt - 2);
            if (last && has_next) unit_params(ui + 1, cu.e, nu, na, nb);
            const char* a1 = cA + (size_t)(t + 1) * kstep;
            const char* a2 = last ? nu.aB : cA + (size_t)(t + 2) * kstep; const char* b2 = last ? nu.bB : cB + (size_t)(t + 2) * kstep;
            const char* a3 = a2 + kstep; const char* b3 = b2 + kstep;
            const unsigned bh2 = last ? nu.bh : bh;
            const unsigned x0 = last ? na[0] : oa[0], x1 = last ? na[1] : oa[1], y0 = last ? na[2] : oa[2], y1 = last ? na[3] : oa[3];
            const unsigned z0 = last ? nb[0] : ob[0], z1 = last ? nb[1] : ob[1];
            const int k2 = last ? nu.kind : cu.kind;
            PG8_LDB(B0, 0, 0); PG8_LDB(B1, 0, 1); PG8_SCHED; PG8_LDA(At, 0, 0); MOE_STAK(cu.kind, PG8_SA(1, 1), a1, oa[2], oa[3]);
            PG8_WAIT_V(8); PG8_WAIT_L(0); PG8_BAR; PG8_MMA(0, 0, At, B0); PG8_MMA(0, 1, At, B1); PG8_BAR; PG8_SCHED;
            PG8_LDA(At, 0, 1); MOE_STB(PG8_SB(0, 0), b2, z0, z1); MOE_STB(PG8_SB(0, 1), b2 + bh2, z0, z1); MOE_STAK(k2, PG8_SA(0, 0), a2, x0, x1);
            PG8_WAIT_V(8); PG8_WAIT_L(0); PG8_BAR; PG8_MMA(1, 0, At, B0); PG8_MMA(1, 1, At, B1); PG8_BAR; PG8_SCHED;
            PG8_LDB(B0, 1, 0); PG8_LDB(B1, 1, 1); PG8_SCHED; PG8_LDA(At, 1, 0); MOE_STAK(k2, PG8_SA(0, 1), a2, y0, y1);
            PG8_WAIT_V(8); PG8_WAIT_L(0); PG8_BAR; PG8_MMA(0, 0, At, B0); PG8_MMA(0, 1, At, B1); PG8_BAR; PG8_SCHED;
            PG8_LDA(At, 1, 1); MOE_STB(PG8_SB(1, 0), b3, z0, z1); MOE_STB(PG8_SB(1, 1), b3 + bh2, z0, z1); MOE_STAK(k2, PG8_SA(1, 0), a3, x0, x1);
            PG8_WAIT_V(8); PG8_WAIT_L(0); PG8_BAR; PG8_MMA(1, 0, At, B0); PG8_MMA(1, 1, At, B1); PG8_BAR; PG8_SCHED;
        }
        if (wr == 0) PG8_BAR;
        asm volatile("s_nop 15\n\ts_nop 15" ::: "memory");
        if (cu.kind == 0) {
            const int row0 = wr * 64 + fr; const int col0 = cu.pn * 128 + wc * 32 + 8 * fq;
            constexpr float is13 = 1.f / SW13;
#pragma unroll
            for (int ai = 0; ai < 2; ++ai)
#pragma unroll
                for (int m = 0; m < 4; ++m) { unsigned char* rowp = (unsigned char*)M.Hs + cu.hbuf * 65536 + (size_t)(row0 + ai * HALF + m * 16) * 256 + col0;
                    f32x4 h0, h1;
#pragma unroll
                    for (int j = 0; j < 4; ++j) { h0[j] = siluf_(acc[ai][0][m][0][j] * is13) * (acc[ai][1][m][0][j] * (is13 * SHS)); h1[j] = siluf_(acc[ai][0][m][1][j] * is13) * (acc[ai][1][m][1][j] * (is13 * SHS)); }
                    u32x2 w; w.x = pk4_fp8(h0[0], h0[1], h0[2], h0[3]); w.y = pk4_fp8(h1[0], h1[1], h1[2], h1[3]);
                    *(u32x2*)rowp = w; }
        } else {
            const LAS int* rtok = M.tbl + cu.slot * 768 + 256; const LAS float* rw = (const LAS float*)(M.tbl + cu.slot * 768 + 512);
            const int col0 = cu.pn * BM + wc * 32 + 8 * fq;
#pragma unroll
            for (int ai = 0; ai < 2; ++ai)
#pragma unroll
                for (int m = 0; m < 4; ++m) { const int r = wr * 64 + fr + ai * HALF + m * 16; const int ts = rtok[r]; const float w = rw[r];
                    if (ts >= 0) {
                        if (cu.shared) { const unsigned goff = (unsigned)(ts >> 11) * MODW + 5 * D + col0; const unsigned ooff = (unsigned)ts * D + col0;
#pragma unroll
                            for (int bj = 0; bj < 2; ++bj)
#pragma unroll
                                for (int n = 0; n < 2; ++n) { const f32x4 gv = *(const f32x4*)(M.mod + goff + bj * HALF + n * 4); f32x4* op = (f32x4*)(M.out + ooff + bj * HALF + n * 4);
                                    const f32x4 nv = *op + gv * acc[ai][bj][m][n] * (1.f / (SHS * SW2)); if (!M.dry_shared) *op = nv; else asm volatile("" :: "v"(nv)); }
                        } else { unsigned char* yp = M.Y + (size_t)(unsigned)ts * D + col0; const float ws_ = w * (YSCALE / (SHS * SW2));
#pragma unroll
                            for (int bj = 0; bj < 2; ++bj) { f32x4 v0 = acc[ai][bj][m][0] * ws_, v1 = acc[ai][bj][m][1] * ws_;
#pragma unroll
                                for (int j = 0; j < 4; ++j) { v0[j] = __builtin_amdgcn_fmed3f(v0[j], -448.f, 448.f); v1[j] = __builtin_amdgcn_fmed3f(v1[j], -448.f, 448.f); }
                                unsigned lo = 0u, hi = 0u;
                                lo = __builtin_amdgcn_cvt_pk_fp8_f32(v0[0], v0[1], lo, false); lo = __builtin_amdgcn_cvt_pk_fp8_f32(v0[2], v0[3], lo, true);
                                hi = __builtin_amdgcn_cvt_pk_fp8_f32(v1[0], v1[1], hi, false); hi = __builtin_amdgcn_cvt_pk_fp8_f32(v1[2], v1[3], hi, true);
                                u32x2 pk; pk.x = lo; pk.y = hi; *(u32x2*)(yp + bj * HALF) = pk; } } }
                    asm volatile("" ::: "memory"); }
        }
        if (!has_next) break;
#pragma unroll
        for (int a = 0; a < 2; ++a)
#pragma unroll
            for (int b = 0; b < 2; ++b)
#pragma unroll
                for (int m = 0; m < 4; ++m)
#pragma unroll
                    for (int n = 0; n < 2; ++n) acc[a][b][m][n] = (f32x4){0.f, 0.f, 0.f, 0.f};
        cu = nu;
#pragma unroll
        for (int i = 0; i < 4; ++i) oa[i] = na[i];
        ob[0] = nb[0]; ob[1] = nb[1];
        if (wr == 1) PG8_BAR;
    }
    PG8_WAIT_V(0);
    PG8_BAR;
#undef PG8_SA
#undef PG8_SB
#undef MOE_DMA
#undef MOE_STA
#undef MOE_STAK
#undef MOE_STB
#undef PG8_LDA
#undef PG8_LDB
#undef MOE_LD32
#undef MOE_MFMA
#undef PG8_MMA
#undef PG8_WAIT_V
#undef PG8_WAIT_L
#undef PG8_BAR
#undef PG8_SCHED
}
}

struct Ctx {
    lbyte* lds; int tid, lane, wave, G, bid;
    const Args* a;
};
#define WSP(T, off) ((T*)(A.ws + (off)))

template <class RowMap>
__device__ __forceinline__ void transpose_item(const float* W, int K, int N, bf16_t* WT, RowMap rowmap, lfloat* scr, int item, int lane) {
    const int nblk = N / 32, kb = item / nblk, nb = item % nblk, k0 = 64 * kb, n0 = 32 * nb;
#pragma unroll 8
    for (int i = 0; i < 32; ++i) { const int kk = 2 * i + (lane >> 5); scr[kk * 33 + (lane & 31)] = W[(size_t)(k0 + kk) * N + n0 + (lane & 31)]; }
    asm volatile("s_waitcnt lgkmcnt(0)" ::: "memory");
    const int c = lane & 7;
#pragma unroll
    for (int j = 0; j < 4; ++j) { const int n = (lane >> 3) + 8 * j; const lfloat* s = scr + (8 * c) * 33 + n;
        u32x4 o; o.x = pk2(s[0 * 33], s[1 * 33]); o.y = pk2(s[2 * 33], s[3 * 33]); o.z = pk2(s[4 * 33], s[5 * 33]); o.w = pk2(s[6 * 33], s[7 * 33]);
        *(u32x4*)(WT + (size_t)rowmap(n0 + n) * K + k0 + 8 * c) = o; }
    asm volatile("s_waitcnt lgkmcnt(0)" ::: "memory");
}
template <class RowMap>
__device__ __forceinline__ void transpose_item_fp8(const float* W, int K, int N, unsigned char* WT, RowMap rowmap, float sc, lfloat* scr, int item, int lane) {
    const int nblk = N / 32, kb = item / nblk, nb = item % nblk, k0 = 64 * kb, n0 = 32 * nb;
#pragma unroll 8
    for (int i = 0; i < 32; ++i) { const int kk = 2 * i + (lane >> 5); scr[kk * 33 + (lane & 31)] = W[(size_t)(k0 + kk) * N + n0 + (lane & 31)] * sc; }
    asm volatile("s_waitcnt lgkmcnt(0)" ::: "memory");
    const int c = lane & 7;
#pragma unroll
    for (int j = 0; j < 4; ++j) { const int n = (lane >> 3) + 8 * j; const lfloat* s = scr + (8 * c) * 33 + n;
        u32x2 o; o.x = pk4_fp8(s[0 * 33], s[1 * 33], s[2 * 33], s[3 * 33]); o.y = pk4_fp8(s[4 * 33], s[5 * 33], s[6 * 33], s[7 * 33]);
        *(u32x2*)(WT + (size_t)rowmap(n0 + n) * K + k0 + 8 * c) = o; }
    asm volatile("s_waitcnt lgkmcnt(0)" ::: "memory");
}
template <class RowMap>
__device__ __forceinline__ void transpose_pair_fp8(const float* W, int K, int N, unsigned char* WT, RowMap rowmap, float sc, lfloat* scr, int pair, int lane) {
    const int nblk = N / 32, kbp = pair / nblk, nb = pair % nblk, k0 = 128 * kbp, n0 = 32 * nb;
    const int kr = lane >> 3, n4 = (lane & 7) * 4;
    f32x4 ld[2][8];
#pragma unroll
    for (int h = 0; h < 2; ++h)
#pragma unroll
        for (int i = 0; i < 8; ++i) ld[h][i] = *(const f32x4*)(W + (size_t)(k0 + 64 * h + 8 * i + kr) * N + n0 + n4);
    const int c = lane & 7;
    u32x2 o[2][4];
#pragma unroll
    for (int h = 0; h < 2; ++h) {
#pragma unroll
        for (int i = 0; i < 8; ++i) { lfloat* d = scr + (8 * i + kr) * 33 + n4; d[0] = ld[h][i].x * sc; d[1] = ld[h][i].y * sc; d[2] = ld[h][i].z * sc; d[3] = ld[h][i].w * sc; }
        asm volatile("s_waitcnt lgkmcnt(0)" ::: "memory");
#pragma unroll
        for (int j = 0; j < 4; ++j) { const int n = (lane >> 3) + 8 * j; const lfloat* s = scr + (8 * c) * 33 + n;
            o[h][j].x = pk4_fp8(s[0 * 33], s[1 * 33], s[2 * 33], s[3 * 33]); o[h][j].y = pk4_fp8(s[4 * 33], s[5 * 33], s[6 * 33], s[7 * 33]); }
        asm volatile("s_waitcnt lgkmcnt(0)" ::: "memory");
    }
#pragma unroll
    for (int j = 0; j < 4; ++j) { const int n = (lane >> 3) + 8 * j; unsigned char* p = WT + (size_t)rowmap(n0 + n) * K + k0 + 8 * c;
        *(u32x2*)p = o[0][j]; *(u32x2*)(p + 64) = o[1][j]; }
}
struct RowId { __device__ int operator()(int n) const { return n; } };
struct RowGLU { int base; __device__ int operator()(int n) const { return ((n >> 7) << 8) + base + (n & 127); } };

__device__ __forceinline__ void norm_mod_row(const float* xrow, const float* g, const float* sc, const float* sh, bf16_t* orow, int lane, unsigned* o8row = nullptr) {
    const f32x4* xr = (const f32x4*)xrow + lane;
    f32x4 v[4]; float s = 0.f;
#pragma unroll
    for (int j = 0; j < 4; ++j) { v[j] = xr[64 * j]; s += (v[j].x * v[j].x + v[j].y * v[j].y) + (v[j].z * v[j].z + v[j].w * v[j].w); }
    const float rstd = __builtin_amdgcn_rsqf(wave_sum(s) * (1.f / D) + NORM_EPS);
    u32x2* o8 = (u32x2*)orow + lane;
#pragma unroll
    for (int j = 0; j < 4; ++j) { const f32x4 gg = ((const f32x4*)g)[lane + 64 * j], ss = ((const f32x4*)sc)[lane + 64 * j], hh = ((const f32x4*)sh)[lane + 64 * j];
        const f32x4 y = v[j] * rstd * gg * (ss + 1.f) + hh;
        if (orow) { u32x2 w; w.x = pk2(y.x, y.y); w.y = pk2(y.z, y.w); o8[64 * j] = w; }
        if (o8row) o8row[lane + 64 * j] = pk4_fp8(y.x, y.y, y.z, y.w); }
}

__device__ __forceinline__ void phase_p0(const Args& A, Ctx& C) {
    float* mod = WSP(float, WS_MOD);
    {
        lfloat* sc = (lfloat*)C.lds;
        lfloat* red = (lfloat*)(C.lds + 17 * 1024 * 4);
        const float* wada = A.in[I_WADA]; const float* bada = A.in[I_BADA];
        for (int it = C.bid; it < 96 * 2; it += C.G) {
            const int chunk = it >> 1, pass = it & 1, r0 = pass * 17, nr = pass ? 16 : 17, col0 = chunk * 64;
            __syncthreads();
            for (int i = C.tid; i < nr * 1024; i += 512) { const int r = i >> 10, k = i & 1023; const int rr = r0 + r;
                const float cv = rr < 32 ? A.in[I_C][rr * 1024 + k] : A.in[I_CCTX][k]; sc[r * 1024 + k] = siluf_(cv); }
            __syncthreads();
            const int col = C.tid & 63, kq = C.tid >> 6;
            float acc[17];
#pragma unroll
            for (int r = 0; r < 17; ++r) acc[r] = 0.f;
            for (int k = kq * 128; k < kq * 128 + 128; k += 4) {
                float w[4];
#pragma unroll
                for (int j = 0; j < 4; ++j) w[j] = wada[(size_t)(k + j) * MODW + col0 + col];
#pragma unroll
                for (int r = 0; r < 17; ++r) { const f32x4 s4 = *(const LAS f32x4*)(sc + r * 1024 + k); acc[r] += s4.x * w[0] + s4.y * w[1] + s4.z * w[2] + s4.w * w[3]; }
            }
#pragma unroll
            for (int r = 0; r < 17; ++r) red[(kq * 17 + r) * 64 + col] = acc[r];
            __syncthreads();
            for (int i = C.tid; i < nr * 64; i += 512) { const int r = i >> 6, cc = i & 63; float s = 0.f;
#pragma unroll
                for (int q = 0; q < 8; ++q) s += red[(q * 17 + r) * 64 + cc];
                mod[(size_t)(r0 + r) * MODW + col0 + cc] = s + bada[col0 + cc]; }
        }
        __syncthreads();
    }
    {
        lfloat* scr = (lfloat*)(C.lds + C.wave * 16384);
        const int gw = C.bid * 8 + C.wave, NGW = C.G * 8;
        unsigned char* btin8 = A.ws + WS_BTIN; bf16_t* btout = WSP(bf16_t, WS_BTOUT); bf16_t* btr = WSP(bf16_t, WS_BTR);
        constexpr int I_IN = (D / 64) * 124, I_OUT = (D / 64) * (D / 32), I_R = (D / 64) * (NE / 32), I_G = (128 / 64) * (DA / 32);
        for (int it = gw; it < I_IN + I_OUT + I_R + I_G; it += NGW) {
            int r = it;
            if (r < I_IN) {
                const int kb = r / 124, nb = r % 124, k0 = 64 * kb, n0 = 32 * nb; const float* W = A.in[I_WIN];
#pragma unroll 8
                for (int i = 0; i < 32; ++i) { const int kk = 2 * i + (C.lane >> 5); scr[kk * 33 + (C.lane & 31)] = W[(size_t)(k0 + kk) * IN_COLS + n0 + (C.lane & 31)] * SWIN; }
                asm volatile("s_waitcnt lgkmcnt(0)" ::: "memory");
                const int c = C.lane & 7;
#pragma unroll
                for (int j = 0; j < 4; ++j) { const int n = (C.lane >> 3) + 8 * j; const lfloat* s = scr + (8 * c) * 33 + n;
                    u32x2 o; o.x = pk4_fp8(s[0 * 33], s[1 * 33], s[2 * 33], s[3 * 33]); o.y = pk4_fp8(s[4 * 33], s[5 * 33], s[6 * 33], s[7 * 33]);
                    *(u32x2*)(btin8 + (size_t)(n0 + n) * D + k0 + 8 * c) = o; }
                asm volatile("s_waitcnt lgkmcnt(0)" ::: "memory");
                continue; }
            r -= I_IN;
            if (r < I_OUT) { transpose_item(A.in[I_WOUT], D, D, btout, RowId(), scr, r, C.lane); continue; } r -= I_OUT;
            if (r < I_R) { transpose_item(A.in[I_RW], D, NE, btr, RowId(), scr, r, C.lane); continue; } r -= I_R;
            transpose_item(A.in[I_GUP], 128, DA, WSP(bf16_t, WS_GUPT), RowId(), scr, r, C.lane);
        }
        for (int i = C.bid * 512 + C.tid; i < 16 * D / 4; i += C.G * 512) { const int n = 3968 + (i >> 8), k = (i & 255) * 4; const float* W = A.in[I_WIN];
            *(unsigned*)(btin8 + (size_t)n * D + k) = pk4_fp8(W[(size_t)k * IN_COLS + n] * SWIN, W[(size_t)(k + 1) * IN_COLS + n] * SWIN, W[(size_t)(k + 2) * IN_COLS + n] * SWIN, W[(size_t)(k + 3) * IN_COLS + n] * SWIN); }
        for (int i = C.bid * 512 + C.tid; i < (PLD - IN_COLS) * D / 16; i += C.G * 512) ((u32x4*)(btin8 + (size_t)IN_COLS * D))[i] = (u32x4){0u, 0u, 0u, 0u};
    }
}

__device__ __forceinline__ void phase_p1(const Args& A, Ctx& C) {
    const float* mod = WSP(float, WS_MOD); bf16_t* xn = WSP(bf16_t, WS_XN);
    const int gw = C.bid * 8 + C.wave, NGW = C.G * 8;
    for (int row = gw; row < NROWS; row += NGW) {
        const float* xr; int mb;
        if (row < NLAT) { xr = A.in[I_X] + (size_t)row * D; mb = row >> 11; } else { xr = A.in[I_CTX] + (size_t)(row - NLAT) * D; mb = 32; }
        const float* m = mod + (size_t)mb * MODW;
        norm_mod_row(xr, A.in[I_N1G], m + D, m, nullptr, C.lane, (unsigned*)(A.ws + WS_XN) + (size_t)row * (D / 4));
    }
}

__device__ __forceinline__ float bfsel(unsigned w, unsigned sh) { return __builtin_bit_cast(float, (w << sh) & 0xffff0000u); }
template <int NK>
__device__ __forceinline__ f32x4 mm_tile(const lbyte* Ap, int lda, const lbyte* Bp, int ldb, f32x4 acc, int lane) {
    const int r = lane & 15, g = lane >> 4;
#pragma unroll
    for (int ks = 0; ks < NK; ++ks) {
        const bf16x8 a = *(const LAS bf16x8*)(Ap + r * lda + ks * 64 + g * 16);
        const bf16x8 b = *(const LAS bf16x8*)(Bp + r * ldb + ks * 64 + g * 16);
        acc = __builtin_amdgcn_mfma_f32_16x16x32_bf16(a, b, acc, 0, 0, 0);
    }
    return acc;
}

__device__ __forceinline__ void st_bf16x4(lbyte* p, f32x4 v) { u32x2 w; w.x = cvtpk(v.x, v.y); w.y = cvtpk(v.z, v.w); *(LAS u32x2*)p = w; }
__device__ __forceinline__ void st_bf16(lbyte* p, float v) { *(LAS unsigned short*)p = (unsigned short)cvtpk(v, v); }
__device__ __forceinline__ float rdlane(float v, int l) { return __builtin_bit_cast(float, __builtin_amdgcn_readlane(__builtin_bit_cast(int, v), l)); }

__device__ __forceinline__ void tri_inv16(const f32x4 m, int lane, lbyte* scr, float (&X)[16]) {
    *(LAS f32x4*)(scr + (lane & 15) * 64 + (lane >> 4) * 16) = m;
    asm volatile("s_waitcnt lgkmcnt(0)" ::: "memory");
    float Mr[16];
#pragma unroll
    for (int kq = 0; kq < 4; ++kq) { const f32x4 r = *(const LAS f32x4*)(scr + (lane & 15) * 64 + kq * 16); Mr[4 * kq] = r.x; Mr[4 * kq + 1] = r.y; Mr[4 * kq + 2] = r.z; Mr[4 * kq + 3] = r.w; }
    const int l16 = lane & 15;
    X[0] = (l16 == 0) ? 1.f : 0.f;
    { float a0 = (l16 == 1) ? 1.f : 0.f, a1 = 0.f, a2 = 0.f, a3 = 0.f;
      asm("s_nop 1\n\t" "v_fmac_f32_dpp %0, -%2, %3 row_newbcast:1 row_mask:0xf bank_mask:0xf\n\t" : "+v"(a0), "+v"(a1) : "v"(Mr[0]), "v"(X[0]));
      X[1] = (a0 + a1) + (a2 + a3); }
    { float a0 = (l16 == 2) ? 1.f : 0.f, a1 = 0.f, a2 = 0.f, a3 = 0.f;
      asm("s_nop 1\n\t" "v_fmac_f32_dpp %0, -%2, %3 row_newbcast:2 row_mask:0xf bank_mask:0xf\n\t" "v_fmac_f32_dpp %1, -%4, %5 row_newbcast:2 row_mask:0xf bank_mask:0xf\n\t" : "+v"(a0), "+v"(a1) : "v"(Mr[0]), "v"(X[0]), "v"(Mr[1]), "v"(X[1]));
      X[2] = (a0 + a1) + (a2 + a3); }
    { float a0 = (l16 == 3) ? 1.f : 0.f, a1 = 0.f, a2 = 0.f, a3 = 0.f;
      asm("s_nop 1\n\t" "v_fmac_f32_dpp %0, -%2, %3 row_newbcast:3 row_mask:0xf bank_mask:0xf\n\t" "v_fmac_f32_dpp %1, -%4, %5 row_newbcast:3 row_mask:0xf bank_mask:0xf\n\t" : "+v"(a0), "+v"(a1) : "v"(Mr[0]), "v"(X[0]), "v"(Mr[1]), "v"(X[1]));
      asm("s_nop 1\n\t" "v_fmac_f32_dpp %0, -%2, %3 row_newbcast:3 row_mask:0xf bank_mask:0xf\n\t" : "+v"(a2), "+v"(a3) : "v"(Mr[2]), "v"(X[2]));
      X[3] = (a0 + a1) + (a2 + a3); }
    { float a0 = (l16 == 4) ? 1.f : 0.f, a1 = 0.f, a2 = 0.f, a3 = 0.f;
      asm("s_nop 1\n\t" "v_fmac_f32_dpp %0, -%2, %3 row_newbcast:4 row_mask:0xf bank_mask:0xf\n\t" "v_fmac_f32_dpp %1, -%4, %5 row_newbcast:4 row_mask:0xf bank_mask:0xf\n\t" : "+v"(a0), "+v"(a1) : "v"(Mr[0]), "v"(X[0]), "v"(Mr[1]), "v"(X[1]));
      asm("s_nop 1\n\t" "v_fmac_f32_dpp %0, -%2, %3 row_newbcast:4 row_mask:0xf bank_mask:0xf\n\t" "v_fmac_f32_dpp %1, -%4, %5 row_newbcast:4 row_mask:0xf bank_mask:0xf\n\t" : "+v"(a2), "+v"(a3) : "v"(Mr[2]), "v"(X[2]), "v"(Mr[3]), "v"(X[3]));
      X[4] = (a0 + a1) + (a2 + a3); }
    { float a0 = (l16 == 5) ? 1.f : 0.f, a1 = 0.f, a2 = 0.f, a3 = 0.f;
      asm("s_nop 1\n\t" "v_fmac_f32_dpp %0, -%2, %3 row_newbcast:5 row_mask:0xf bank_mask:0xf\n\t" "v_fmac_f32_dpp %1, -%4, %5 row_newbcast:5 row_mask:0xf bank_mask:0xf\n\t" "v_fmac_f32_dpp %0, -%6, %7 row_newbcast:5 row_mask:0xf bank_mask:0xf\n\t" : "+v"(a0), "+v"(a1) : "v"(Mr[0]), "v"(X[0]), "v"(Mr[1]), "v"(X[1]), "v"(Mr[4]), "v"(X[4]));
      asm("s_nop 1\n\t" "v_fmac_f32_dpp %0, -%2, %3 row_newbcast:5 row_mask:0xf bank_mask:0xf\n\t" "v_fmac_f32_dpp %1, -%4, %5 row_newbcast:5 row_mask:0xf bank_mask:0xf\n\t" : "+v"(a2), "+v"(a3) : "v"(Mr[2]), "v"(X[2]), "v"(Mr[3]), "v"(X[3]));
      X[5] = (a0 + a1) + (a2 + a3); }
    { float a0 = (l16 == 6) ? 1.f : 0.f, a1 = 0.f, a2 = 0.f, a3 = 0.f;
      asm("s_nop 1\n\t" "v_fmac_f32_dpp %0, -%2, %3 row_newbcast:6 row_mask:0xf bank_mask:0xf\n\t" "v_fmac_f32_dpp %1, -%4, %5 row_newbcast:6 row_mask:0xf bank_mask:0xf\n\t" "v_fmac_f32_dpp %0, -%6, %7 row_newbcast:6 row_mask:0xf bank_mask:0xf\n\t" "v_fmac_f32_dpp %1, -%8, %9 row_newbcast:6 row_mask:0xf bank_mask:0xf\n\t" : "+v"(a0), "+v"(a1) : "v"(Mr[0]), "v"(X[0]), "v"(Mr[1]), "v"(X[1]), "v"(Mr[4]), "v"(X[4]), "v"(Mr[5]), "v"(X[5]));
      asm("s_nop 1\n\t" "v_fmac_f32_dpp %0, -%2, %3 row_newbcast:6 row_mask:0xf bank_mask:0xf\n\t" "v_fmac_f32_dpp %1, -%4, %5 row_newbcast:6 row_mask:0xf bank_mask:0xf\n\t" : "+v"(a2), "+v"(a3) : "v"(Mr[2]), "v"(X[2]), "v"(Mr[3]), "v"(X[3]));
      X[6] = (a0 + a1) + (a2 + a3); }
    { float a0 = (l16 == 7) ? 1.f : 0.f, a1 = 0.f, a2 = 0.f, a3 = 0.f;
      asm("s_nop 1\n\t" "v_fmac_f32_dpp %0, -%2, %3 row_newbcast:7 row_mask:0xf bank_mask:0xf\n\t" "v_fmac_f32_dpp %1, -%4, %5 row_newbcast:7 row_mask:0xf bank_mask:0xf\n\t" "v_fmac_f32_dpp %0, -%6, %7 row_newbcast:7 row_mask:0xf bank_mask:0xf\n\t" "v_fmac_f32_dpp %1, -%8, %9 row_newbcast:7 row_mask:0xf bank_mask:0xf\n\t" : "+v"(a0), "+v"(a1) : "v"(Mr[0]), "v"(X[0]), "v"(Mr[1]), "v"(X[1]), "v"(Mr[4]), "v"(X[4]), "v"(Mr[5]), "v"(X[5]));
      asm("s_nop 1\n\t" "v_fmac_f32_dpp %0, -%2, %3 row_newbcast:7 row_mask:0xf bank_mask:0xf\n\t" "v_fmac_f32_dpp %1, -%4, %5 row_newbcast:7 row_mask:0xf bank_mask:0xf\n\t" "v_fmac_f32_dpp %0, -%6, %7 row_newbcast:7 row_mask:0xf bank_mask:0xf\n\t" : "+v"(a2), "+v"(a3) : "v"(Mr[2]), "v"(X[2]), "v"(Mr[3]), "v"(X[3]), "v"(Mr[6]), "v"(X[6]));
      X[7] = (a0 + a1) + (a2 + a3); }
    { float a0 = (l16 == 8) ? 1.f : 0.f, a1 = 0.f, a2 = 0.f, a3 = 0.f;
      asm("s_nop 1\n\t" "v_fmac_f32_dpp %0, -%2, %3 row_newbcast:8 row_mask:0xf bank_mask:0xf\n\t" "v_fmac_f32_dpp %1, -%4, %5 row_newbcast:8 row_mask:0xf bank_mask:0xf\n\t" "v_fmac_f32_dpp %0, -%6, %7 row_newbcast:8 row_mask:0xf bank_mask:0xf\n\t" "v_fmac_f32_dpp %1, -%8, %9 row_newbcast:8 row_mask:0xf bank_mask:0xf\n\t" : "+v"(a0), "+v"(a1) : "v"(Mr[0]), "v"(X[0]), "v"(Mr[1]), "v"(X[1]), "v"(Mr[4]), "v"(X[4]), "v"(Mr[5]), "v"(X[5]));
      asm("s_nop 1\n\t" "v_fmac_f32_dpp %0, -%2, %3 row_newbcast:8 row_mask:0xf bank_mask:0xf\n\t" "v_fmac_f32_dpp %1, -%4, %5 row_newbcast:8 row_mask:0xf bank_mask:0xf\n\t" "v_fmac_f32_dpp %0, -%6, %7 row_newbcast:8 row_mask:0xf bank_mask:0xf\n\t" "v_fmac_f32_dpp %1, -%8, %9 row_newbcast:8 row_mask:0xf bank_mask:0xf\n\t" : "+v"(a2), "+v"(a3) : "v"(Mr[2]), "v"(X[2]), "v"(Mr[3]), "v"(X[3]), "v"(Mr[6]), "v"(X[6]), "v"(Mr[7]), "v"(X[7]));
      X[8] = (a0 + a1) + (a2 + a3); }
    { float a0 = (l16 == 9) ? 1.f : 0.f, a1 = 0.f, a2 = 0.f, a3 = 0.f;
      asm("s_nop 1\n\t" "v_fmac_f32_dpp %0, -%2, %3 row_newbcast:9 row_mask:0xf bank_mask:0xf\n\t" "v_fmac_f32_dpp %1, -%4, %5 row_newbcast:9 row_mask:0xf bank_mask:0xf\n\t" "v_fmac_f32_dpp %0, -%6, %7 row_newbcast:9 row_mask:0xf bank_mask:0xf\n\t" "v_fmac_f32_dpp %1, -%8, %9 row_newbcast:9 row_mask:0xf bank_mask:0xf\n\t" "v_fmac_f32_dpp %0, -%10, %11 row_newbcast:9 row_mask:0xf bank_mask:0xf\n\t" : "+v"(a0), "+v"(a1) : "v"(Mr[0]), "v"(X[0]), "v"(Mr[1]), "v"(X[1]), "v"(Mr[4]), "v"(X[4]), "v"(Mr[5]), "v"(X[5]), "v"(Mr[8]), "v"(X[8]));
      asm("s_nop 1\n\t" "v_fmac_f32_dpp %0, -%2, %3 row_newbcast:9 row_mask:0xf bank_mask:0xf\n\t" "v_fmac_f32_dpp %1, -%4, %5 row_newbcast:9 row_mask:0xf bank_mask:0xf\n\t" "v_fmac_f32_dpp %0, -%6, %7 row_newbcast:9 row_mask:0xf bank_mask:0xf\n\t" "v_fmac_f32_dpp %1, -%8, %9 row_newbcast:9 row_mask:0xf bank_mask:0xf\n\t" : "+v"(a2), "+v"(a3) : "v"(Mr[2]), "v"(X[2]), "v"(Mr[3]), "v"(X[3]), "v"(Mr[6]), "v"(X[6]), "v"(Mr[7]), "v"(X[7]));
      X[9] = (a0 + a1) + (a2 + a3); }
    { float a0 = (l16 == 10) ? 1.f : 0.f, a1 = 0.f, a2 = 0.f, a3 = 0.f;
      asm("s_nop 1\n\t" "v_fmac_f32_dpp %0, -%2, %3 row_newbcast:10 row_mask:0xf bank_mask:0xf\n\t" "v_fmac_f32_dpp %1, -%4, %5 row_newbcast:10 row_mask:0xf bank_mask:0xf\n\t" "v_fmac_f32_dpp %0, -%6, %7 row_newbcast:10 row_mask:0xf bank_mask:0xf\n\t" "v_fmac_f32_dpp %1, -%8, %9 row_newbcast:10 row_mask:0xf bank_mask:0xf\n\t" "v_fmac_f32_dpp %0, -%10, %11 row_newbcast:10 row_mask:0xf bank_mask:0xf\n\t" "v_fmac_f32_dpp %1, -%12, %13 row_newbcast:10 row_mask:0xf bank_mask:0xf\n\t" : "+v"(a0), "+v"(a1) : "v"(Mr[0]), "v"(X[0]), "v"(Mr[1]), "v"(X[1]), "v"(Mr[4]), "v"(X[4]), "v"(Mr[5]), "v"(X[5]), "v"(Mr[8]), "v"(X[8]), "v"(Mr[9]), "v"(X[9]));
      asm("s_nop 1\n\t" "v_fmac_f32_dpp %0, -%2, %3 row_newbcast:10 row_mask:0xf bank_mask:0xf\n\t" "v_fmac_f32_dpp %1, -%4, %5 row_newbcast:10 row_mask:0xf bank_mask:0xf\n\t" "v_fmac_f32_dpp %0, -%6, %7 row_newbcast:10 row_mask:0xf bank_mask:0xf\n\t" "v_fmac_f32_dpp %1, -%8, %9 row_newbcast:10 row_mask:0xf bank_mask:0xf\n\t" : "+v"(a2), "+v"(a3) : "v"(Mr[2]), "v"(X[2]), "v"(Mr[3]), "v"(X[3]), "v"(Mr[6]), "v"(X[6]), "v"(Mr[7]), "v"(X[7]));
      X[10] = (a0 + a1) + (a2 + a3); }
    { float a0 = (l16 == 11) ? 1.f : 0.f, a1 = 0.f, a2 = 0.f, a3 = 0.f;
      asm("s_nop 1\n\t" "v_fmac_f32_dpp %0, -%2, %3 row_newbcast:11 row_mask:0xf bank_mask:0xf\n\t" "v_fmac_f32_dpp %1, -%4, %5 row_newbcast:11 row_mask:0xf bank_mask:0xf\n\t" "v_fmac_f32_dpp %0, -%6, %7 row_newbcast:11 row_mask:0xf bank_mask:0xf\n\t" "v_fmac_f32_dpp %1, -%8, %9 row_newbcast:11 row_mask:0xf bank_mask:0xf\n\t" "v_fmac_f32_dpp %0, -%10, %11 row_newbcast:11 row_mask:0xf bank_mask:0xf\n\t" "v_fmac_f32_dpp %1, -%12, %13 row_newbcast:11 row_mask:0xf bank_mask:0xf\n\t" : "+v"(a0), "+v"(a1) : "v"(Mr[0]), "v"(X[0]), "v"(Mr[1]), "v"(X[1]), "v"(Mr[4]), "v"(X[4]), "v"(Mr[5]), "v"(X[5]), "v"(Mr[8]), "v"(X[8]), "v"(Mr[9]), "v"(X[9]));
      asm("s_nop 1\n\t" "v_fmac_f32_dpp %0, -%2, %3 row_newbcast:11 row_mask:0xf bank_mask:0xf\n\t" "v_fmac_f32_dpp %1, -%4, %5 row_newbcast:11 row_mask:0xf bank_mask:0xf\n\t" "v_fmac_f32_dpp %0, -%6, %7 row_newbcast:11 row_mask:0xf bank_mask:0xf\n\t" "v_fmac_f32_dpp %1, -%8, %9 row_newbcast:11 row_mask:0xf bank_mask:0xf\n\t" "v_fmac_f32_dpp %0, -%10, %11 row_newbcast:11 row_mask:0xf bank_mask:0xf\n\t" : "+v"(a2), "+v"(a3) : "v"(Mr[2]), "v"(X[2]), "v"(Mr[3]), "v"(X[3]), "v"(Mr[6]), "v"(X[6]), "v"(Mr[7]), "v"(X[7]), "v"(Mr[10]), "v"(X[10]));
      X[11] = (a0 + a1) + (a2 + a3); }
    { float a0 = (l16 == 12) ? 1.f : 0.f, a1 = 0.f, a2 = 0.f, a3 = 0.f;
      asm("s_nop 1\n\t" "v_fmac_f32_dpp %0, -%2, %3 row_newbcast:12 row_mask:0xf bank_mask:0xf\n\t" "v_fmac_f32_dpp %1, -%4, %5 row_newbcast:12 row_mask:0xf bank_mask:0xf\n\t" "v_fmac_f32_dpp %0, -%6, %7 row_newbcast:12 row_mask:0xf bank_mask:0xf\n\t" "v_fmac_f32_dpp %1, -%8, %9 row_newbcast:12 row_mask:0xf bank_mask:0xf\n\t" "v_fmac_f32_dpp %0, -%10, %11 row_newbcast:12 row_mask:0xf bank_mask:0xf\n\t" "v_fmac_f32_dpp %1, -%12, %13 row_newbcast:12 row_mask:0xf bank_mask:0xf\n\t" : "+v"(a0), "+v"(a1) : "v"(Mr[0]), "v"(X[0]), "v"(Mr[1]), "v"(X[1]), "v"(Mr[4]), "v"(X[4]), "v"(Mr[5]), "v"(X[5]), "v"(Mr[8]), "v"(X[8]), "v"(Mr[9]), "v"(X[9]));
      asm("s_nop 1\n\t" "v_fmac_f32_dpp %0, -%2, %3 row_newbcast:12 row_mask:0xf bank_mask:0xf\n\t" "v_fmac_f32_dpp %1, -%4, %5 row_newbcast:12 row_mask:0xf bank_mask:0xf\n\t" "v_fmac_f32_dpp %0, -%6, %7 row_newbcast:12 row_mask:0xf bank_mask:0xf\n\t" "v_fmac_f32_dpp %1, -%8, %9 row_newbcast:12 row_mask:0xf bank_mask:0xf\n\t" "v_fmac_f32_dpp %0, -%10, %11 row_newbcast:12 row_mask:0xf bank_mask:0xf\n\t" "v_fmac_f32_dpp %1, -%12, %13 row_newbcast:12 row_mask:0xf bank_mask:0xf\n\t" : "+v"(a2), "+v"(a3) : "v"(Mr[2]), "v"(X[2]), "v"(Mr[3]), "v"(X[3]), "v"(Mr[6]), "v"(X[6]), "v"(Mr[7]), "v"(X[7]), "v"(Mr[10]), "v"(X[10]), "v"(Mr[11]), "v"(X[11]));
      X[12] = (a0 + a1) + (a2 + a3); }
    { float a0 = (l16 == 13) ? 1.f : 0.f, a1 = 0.f, a2 = 0.f, a3 = 0.f;
      asm("s_nop 1\n\t" "v_fmac_f32_dpp %0, -%2, %3 row_newbcast:13 row_mask:0xf bank_mask:0xf\n\t" "v_fmac_f32_dpp %1, -%4, %5 row_newbcast:13 row_mask:0xf bank_mask:0xf\n\t" "v_fmac_f32_dpp %0, -%6, %7 row_newbcast:13 row_mask:0xf bank_mask:0xf\n\t" "v_fmac_f32_dpp %1, -%8, %9 row_newbcast:13 row_mask:0xf bank_mask:0xf\n\t" "v_fmac_f32_dpp %0, -%10, %11 row_newbcast:13 row_mask:0xf bank_mask:0xf\n\t" "v_fmac_f32_dpp %1, -%12, %13 row_newbcast:13 row_mask:0xf bank_mask:0xf\n\t" "v_fmac_f32_dpp %0, -%14, %15 row_newbcast:13 row_mask:0xf bank_mask:0xf\n\t" : "+v"(a0), "+v"(a1) : "v"(Mr[0]), "v"(X[0]), "v"(Mr[1]), "v"(X[1]), "v"(Mr[4]), "v"(X[4]), "v"(Mr[5]), "v"(X[5]), "v"(Mr[8]), "v"(X[8]), "v"(Mr[9]), "v"(X[9]), "v"(Mr[12]), "v"(X[12]));
      asm("s_nop 1\n\t" "v_fmac_f32_dpp %0, -%2, %3 row_newbcast:13 row_mask:0xf bank_mask:0xf\n\t" "v_fmac_f32_dpp %1, -%4, %5 row_newbcast:13 row_mask:0xf bank_mask:0xf\n\t" "v_fmac_f32_dpp %0, -%6, %7 row_newbcast:13 row_mask:0xf bank_mask:0xf\n\t" "v_fmac_f32_dpp %1, -%8, %9 row_newbcast:13 row_mask:0xf bank_mask:0xf\n\t" "v_fmac_f32_dpp %0, -%10, %11 row_newbcast:13 row_mask:0xf bank_mask:0xf\n\t" "v_fmac_f32_dpp %1, -%12, %13 row_newbcast:13 row_mask:0xf bank_mask:0xf\n\t" : "+v"(a2), "+v"(a3) : "v"(Mr[2]), "v"(X[2]), "v"(Mr[3]), "v"(X[3]), "v"(Mr[6]), "v"(X[6]), "v"(Mr[7]), "v"(X[7]), "v"(Mr[10]), "v"(X[10]), "v"(Mr[11]), "v"(X[11]));
      X[13] = (a0 + a1) + (a2 + a3); }
    { float a0 = (l16 == 14) ? 1.f : 0.f, a1 = 0.f, a2 = 0.f, a3 = 0.f;
      asm("s_nop 1\n\t" "v_fmac_f32_dpp %0, -%2, %3 row_newbcast:14 row_mask:0xf bank_mask:0xf\n\t" "v_fmac_f32_dpp %1, -%4, %5 row_newbcast:14 row_mask:0xf bank_mask:0xf\n\t" "v_fmac_f32_dpp %0, -%6, %7 row_newbcast:14 row_mask:0xf bank_mask:0xf\n\t" "v_fmac_f32_dpp %1, -%8, %9 row_newbcast:14 row_mask:0xf bank_mask:0xf\n\t" "v_fmac_f32_dpp %0, -%10, %11 row_newbcast:14 row_mask:0xf bank_mask:0xf\n\t" "v_fmac_f32_dpp %1, -%12, %13 row_newbcast:14 row_mask:0xf bank_mask:0xf\n\t" "v_fmac_f32_dpp %0, -%14, %15 row_newbcast:14 row_mask:0xf bank_mask:0xf\n\t" "v_fmac_f32_dpp %1, -%16, %17 row_newbcast:14 row_mask:0xf bank_mask:0xf\n\t" : "+v"(a0), "+v"(a1) : "v"(Mr[0]), "v"(X[0]), "v"(Mr[1]), "v"(X[1]), "v"(Mr[4]), "v"(X[4]), "v"(Mr[5]), "v"(X[5]), "v"(Mr[8]), "v"(X[8]), "v"(Mr[9]), "v"(X[9]), "v"(Mr[12]), "v"(X[12]), "v"(Mr[13]), "v"(X[13]));
      asm("s_nop 1\n\t" "v_fmac_f32_dpp %0, -%2, %3 row_newbcast:14 row_mask:0xf bank_mask:0xf\n\t" "v_fmac_f32_dpp %1, -%4, %5 row_newbcast:14 row_mask:0xf bank_mask:0xf\n\t" "v_fmac_f32_dpp %0, -%6, %7 row_newbcast:14 row_mask:0xf bank_mask:0xf\n\t" "v_fmac_f32_dpp %1, -%8, %9 row_newbcast:14 row_mask:0xf bank_mask:0xf\n\t" "v_fmac_f32_dpp %0, -%10, %11 row_newbcast:14 row_mask:0xf bank_mask:0xf\n\t" "v_fmac_f32_dpp %1, -%12, %13 row_newbcast:14 row_mask:0xf bank_mask:0xf\n\t" : "+v"(a2), "+v"(a3) : "v"(Mr[2]), "v"(X[2]), "v"(Mr[3]), "v"(X[3]), "v"(Mr[6]), "v"(X[6]), "v"(Mr[7]), "v"(X[7]), "v"(Mr[10]), "v"(X[10]), "v"(Mr[11]), "v"(X[11]));
      X[14] = (a0 + a1) + (a2 + a3); }
    { float a0 = (l16 == 15) ? 1.f : 0.f, a1 = 0.f, a2 = 0.f, a3 = 0.f;
      asm("s_nop 1\n\t" "v_fmac_f32_dpp %0, -%2, %3 row_newbcast:15 row_mask:0xf bank_mask:0xf\n\t" "v_fmac_f32_dpp %1, -%4, %5 row_newbcast:15 row_mask:0xf bank_mask:0xf\n\t" "v_fmac_f32_dpp %0, -%6, %7 row_newbcast:15 row_mask:0xf bank_mask:0xf\n\t" "v_fmac_f32_dpp %1, -%8, %9 row_newbcast:15 row_mask:0xf bank_mask:0xf\n\t" "v_fmac_f32_dpp %0, -%10, %11 row_newbcast:15 row_mask:0xf bank_mask:0xf\n\t" "v_fmac_f32_dpp %1, -%12, %13 row_newbcast:15 row_mask:0xf bank_mask:0xf\n\t" "v_fmac_f32_dpp %0, -%14, %15 row_newbcast:15 row_mask:0xf bank_mask:0xf\n\t" "v_fmac_f32_dpp %1, -%16, %17 row_newbcast:15 row_mask:0xf bank_mask:0xf\n\t" : "+v"(a0), "+v"(a1) : "v"(Mr[0]), "v"(X[0]), "v"(Mr[1]), "v"(X[1]), "v"(Mr[4]), "v"(X[4]), "v"(Mr[5]), "v"(X[5]), "v"(Mr[8]), "v"(X[8]), "v"(Mr[9]), "v"(X[9]), "v"(Mr[12]), "v"(X[12]), "v"(Mr[13]), "v"(X[13]));
      asm("s_nop 1\n\t" "v_fmac_f32_dpp %0, -%2, %3 row_newbcast:15 row_mask:0xf bank_mask:0xf\n\t" "v_fmac_f32_dpp %1, -%4, %5 row_newbcast:15 row_mask:0xf bank_mask:0xf\n\t" "v_fmac_f32_dpp %0, -%6, %7 row_newbcast:15 row_mask:0xf bank_mask:0xf\n\t" "v_fmac_f32_dpp %1, -%8, %9 row_newbcast:15 row_mask:0xf bank_mask:0xf\n\t" "v_fmac_f32_dpp %0, -%10, %11 row_newbcast:15 row_mask:0xf bank_mask:0xf\n\t" "v_fmac_f32_dpp %1, -%12, %13 row_newbcast:15 row_mask:0xf bank_mask:0xf\n\t" "v_fmac_f32_dpp %0, -%14, %15 row_newbcast:15 row_mask:0xf bank_mask:0xf\n\t" : "+v"(a2), "+v"(a3) : "v"(Mr[2]), "v"(X[2]), "v"(Mr[3]), "v"(X[3]), "v"(Mr[6]), "v"(X[6]), "v"(Mr[7]), "v"(X[7]), "v"(Mr[10]), "v"(X[10]), "v"(Mr[11]), "v"(X[11]), "v"(Mr[14]), "v"(X[14]));
      X[15] = (a0 + a1) + (a2 + a3); }
}

#ifndef RWKV_REP
#define RWKV_REP 1
#endif
namespace rk {
constexpr int S64 = 160, S32 = 80, SW = 144;
constexpr int O_WUP = 0, O_AUP = O_WUP + 64 * SW, O_WLT = O_AUP + 64 * SW, O_ALT = O_WLT + 16 * S64, O_LW = O_ALT + 16 * S64, O_LA = O_LW + 4096,
              O_KKT = O_LA + 4096, O_RT = O_KKT + 16 * S64, O_BT = O_RT + 16 * S64, O_KDT = O_BT + 16 * S64,
              O_VT = O_KDT + 16 * S64, O_BHT = O_VT + 64 * S32, O_KHT = O_BHT + 64 * S32, O_UT = O_KHT + 64 * S32, O_UTT = O_WLT  ,
              O_TI = O_UT + 64 * S32, O_MK = O_TI + 16 * S32, O_NB = O_MK + 16 * S32, O_NK = O_NB + 16 * S32,
              O_SBF = O_NK + 16 * S32, O_WC = O_SBF + 64 * S64, O_WT = O_WC + 256, TEAM_BYTES = O_WT + 1024;
static_assert(2 * TEAM_BYTES <= LDS_MISC, "rwkv LDS");
}
__device__ __forceinline__ void rwkv_pair_chunked(const Args& A, Ctx& C, int pair) {
    using namespace rk;
    const int b = pair >> 3, h = pair & 7;
    const int dir = C.wave >> 2;
    const int t4 = C.tid & 255, q = C.wave & 3, lane = C.lane;
    lbyte* L = C.lds + dir * TEAM_BYTES;
    const bf16_t* P = WSP(bf16_t, WS_P);
    bf16_t* ydir = WSP(bf16_t, WS_YDIR) + (size_t)dir * NLAT * D;
    float* bon = WSP(float, WS_BON) + (size_t)dir * NLAT * 8;
    __syncthreads();
#pragma unroll 2
    for (int i = t4; i < 4096; i += 256) { const int l = i >> 6, c = i & 63;
        st_bf16(L + O_WUP + c * SW + l * 2, A.in[I_WUP][((size_t)dir * 64 + l) * DA + 64 * h + c]);
        st_bf16(L + O_AUP + c * SW + l * 2, A.in[I_AUP][((size_t)dir * 64 + l) * DA + 64 * h + c]); }
#pragma unroll 2
    for (int i = t4; i < (4 * 64 * S32 + 4 * 16 * S32 + 64 * S64) / 4; i += 256) ((LAS unsigned*)(L + O_VT))[i] = 0u;
    for (int i = t4; i < (2 * 16 * S64) / 4; i += 256) ((LAS unsigned*)(L + O_WLT))[i] = 0u;
    const int c = lane;
    const int col5[5] = {64 * h + c, 512 + 64 * h + c, 1024 + 64 * h + c, 1536 + 64 * dir + c, 1664 + 64 * dir + c};
    float mu5[5]; unsigned coff[5], nm[5], nlo[5], nrg[5]; int ndb[5];
#pragma unroll
    for (int e = 0; e < 5; ++e) { mu5[e] = A.in[I_MU][col5[e]]; coff[e] = (unsigned)col5[e] * 2u; }
    auto set_rules = [&](bool ctx) {
#pragma unroll
        for (int e = 0; e < 5; ++e) { const int col = col5[e];
            if (ctx) { nm[e] = 0xffffffffu; nlo[e] = col < 960 ? 1u : 0u; nrg[e] = (unsigned)(CTX - 2); ndb[e] = (col < 960 ? -PLD : PLD) * 2; }
            else { const int cls = col < 480 ? 0 : (col < 960 ? 1 : (col < 1440 ? 2 : 3));
                nm[e] = cls < 2 ? 63u : 0xffffffffu; nlo[e] = cls == 0 ? 1u : (cls == 2 ? 64u : 0u); nrg[e] = cls < 2 ? 62u : (unsigned)(SEQ - 65);
                ndb[e] = (cls == 0 ? -PLD : (cls == 1 ? PLD : (cls == 2 ? -64 * PLD : 64 * PLD))) * 2; } } };
    set_rules(true);
    const char* wsb = (const char*)A.ws;
    const float kkc = A.in[I_KK][64 * h + c], kac = A.in[I_KA][64 * h + c], rkc = A.in[I_RK][64 * h + c];
    const float w0c = A.in[I_W0][dir * DA + 64 * h + c], a0c = A.in[I_A0][dir * DA + 64 * h + c];
    f32x4 Sacc[4];
#pragma unroll
    for (int i = 0; i < 4; ++i) Sacc[i] = (f32x4){0.f, 0.f, 0.f, 0.f};
    const int fr = lane & 15, fg = lane >> 4;
    unsigned short rawp[4][5], raws[4][5];
    auto chunk_geom = [&](int ch, bool& isctx, int& sbase, int& T, size_t& rowbase) { isctx = ch < 16; sbase = isctx ? ch * 16 : (ch - 16) * 16; T = isctx ? CTX : SEQ; rowbase = isctx ? (size_t)NLAT + (size_t)b * CTX : (size_t)b * SEQ; };
    auto issue_loads = [&](int ch) { bool isctx; int sbase, T; size_t rowbase; chunk_geom(ch, isctx, sbase, T, rowbase);
#pragma unroll
        for (int j = 0; j < 4; ++j) { const int i = 4 * q + j; const int t = __builtin_amdgcn_readfirstlane(dir ? (T - 1 - (sbase + i)) : (sbase + i));
            const unsigned rowoff = (unsigned)WS_P + (unsigned)(rowbase + t) * (unsigned)(PLD * 2);
#pragma unroll
            for (int e = 0; e < 5; ++e) { const unsigned vs = rowoff + coff[e]; const bool ok = (((unsigned)t & nm[e]) - nlo[e]) <= nrg[e]; const unsigned vn = ok ? vs + (unsigned)ndb[e] : 8u;
                rawp[j][e] = *(const bf16_t*)(wsb + vs); raws[j][e] = *(const bf16_t*)(wsb + vn); } } };
    u32x2 ypend; ypend.x = 0u; ypend.y = 0u; float bpend[4] = {0.f, 0.f, 0.f, 0.f};
    auto flush = [&](int pch) { bool pisctx; int psb, pT; size_t prb; chunk_geom(pch, pisctx, psb, pT, prb);
        if (!pisctx) { const int t = dir ? (pT - 1 - (psb + fr)) : (psb + fr);
            *(u32x2*)(ydir + ((size_t)b * SEQ + t) * D + 64 * h + 16 * q + 4 * fg) = ypend;
            if (lane == 0) {
#pragma unroll
                for (int j = 0; j < 4; ++j) { const int i = 4 * q + j; const int tj = dir ? (pT - 1 - (psb + i)) : (psb + i); bon[((size_t)b * SEQ + tj) * 8 + h] = bpend[j]; } } } };
    issue_loads(0);
    for (int ch = 0; ch < 144; ++ch) {
        bool isctx; int sbase, T; size_t rowbase; chunk_geom(ch, isctx, sbase, T, rowbase);
        float vr[4], vk[4], vv[4], vkk[4], lw[4], av[4];
        __syncthreads();
        float mxa[4][5];
#pragma unroll
        for (int j = 0; j < 4; ++j) {
#pragma unroll
            for (int e = 0; e < 5; ++e) { const float pv = bf2f(rawp[j][e]); const float sv = bf2f(raws[j][e]); mxa[j][e] = pv + mu5[e] * (sv - pv); } }
        asm volatile("" :: "v"(mxa[0][0]), "v"(mxa[0][1]), "v"(mxa[0][2]), "v"(mxa[0][3]), "v"(mxa[0][4]), "v"(mxa[1][0]), "v"(mxa[1][1]), "v"(mxa[1][2]), "v"(mxa[1][3]), "v"(mxa[1][4]),
                        "v"(mxa[2][0]), "v"(mxa[2][1]), "v"(mxa[2][2]), "v"(mxa[2][3]), "v"(mxa[2][4]), "v"(mxa[3][0]), "v"(mxa[3][1]), "v"(mxa[3][2]), "v"(mxa[3][3]), "v"(mxa[3][4]) : "memory");
        if (ch > 0) flush(ch - 1);
        if (ch == 15) set_rules(false);
        if (ch + 1 < 144) issue_loads(ch + 1);
        float cl[4];
        _Pragma("unroll") for (int rrep = 0; rrep < RWKV_REP; ++rrep) {
#pragma unroll
        for (int j = 0; j < 4; ++j) {
            const int i = 4 * q + j;
            float mx[5];
#pragma unroll
            for (int e = 0; e < 5; ++e) mx[e] = mxa[j][e];
            vr[j] = mx[0]; vk[j] = mx[1]; vv[j] = mx[2];
            *(LAS unsigned short*)(L + O_WLT + i * S64 + c * 2) = (unsigned short)cvtpk(tanhf_(mx[3]), 0.f); *(LAS unsigned short*)(L + O_ALT + i * S64 + c * 2) = (unsigned short)cvtpk(mx[4], 0.f);
            const float kx = vk[j] * kkc; const float ss = wave_sum(kx * kx);
            vkk[j] = kx * __builtin_amdgcn_rsqf(ss + 1e-6f);
        }
        __syncthreads();
        {
            const f32x4 z = (f32x4){0.f, 0.f, 0.f, 0.f};
            const f32x4 tw = mm_tile<2>(L + O_WLT, S64, L + O_WUP + 16 * q * SW, SW, z, lane);
            const f32x4 ta = mm_tile<2>(L + O_ALT, S64, L + O_AUP + 16 * q * SW, SW, z, lane);
#pragma unroll
            for (int e = 0; e < 4; ++e) { ((LAS float*)(L + O_LW))[(4 * fg + e) * 64 + 16 * q + fr] = tw[e]; ((LAS float*)(L + O_LA))[(4 * fg + e) * 64 + 16 * q + fr] = ta[e]; }
        }
        __syncthreads();
        { float run = 0.f;
#pragma unroll
        for (int j = 0; j < 4; ++j) { const int i = 4 * q + j;
            const float wlog = -softplusf_(-(w0c + ((LAS float*)(L + O_LW))[i * 64 + c])) - 0.5f;
            lw[j] = -__expf(wlog);
            av[j] = sigmoidf_(a0c + ((LAS float*)(L + O_LA))[i * 64 + c]);
            run += lw[j]; cl[j] = run; }
        ((LAS float*)(L + O_WT))[q * 64 + c] = run; }
        __syncthreads();
        }
        {
            float off = 0.f, cumC = 0.f;
#pragma unroll
            for (int qq = 0; qq < 4; ++qq) { const float tv = ((LAS float*)(L + O_WT))[qq * 64 + c]; cumC += tv; off += (qq < q) ? tv : 0.f; }
            float tv_[4], tb_[4], tk_[4];
            float Wprev = __expf(off); const float eC = __expf(cumC);
#pragma unroll
            for (int j = 0; j < 4; ++j) { const int i = 4 * q + j;
                const float cum = off + cl[j];
                const float Wt = __expf(cum), Wp = Wprev, Wi = __builtin_amdgcn_rcpf(Wt), Wc = eC * Wi; Wprev = Wt;
                const float kd = vk[j] * (1.f + (av[j] - 1.f) * kac), bb = vkk[j] * av[j];
                const unsigned p0 = cvtpk(vkk[j] * Wp, vr[j] * Wt), p1 = cvtpk(bb * Wi, kd * Wi);
                *(LAS unsigned short*)(L + O_KKT + i * S64 + c * 2) = (unsigned short)p0; *(LAS unsigned short*)(L + O_RT + i * S64 + c * 2) = (unsigned short)(p0 >> 16);
                *(LAS unsigned short*)(L + O_BT + i * S64 + c * 2) = (unsigned short)p1; *(LAS unsigned short*)(L + O_KDT + i * S64 + c * 2) = (unsigned short)(p1 >> 16);
                tv_[j] = vv[j]; tb_[j] = bb * Wc; tk_[j] = kd * Wc;
                const float bs = wave_sum(vr[j] * kd * rkc);
                bpend[j] = bs;
            }
            { u32x2 w2;
                w2.x = cvtpk(tv_[0], tv_[1]); w2.y = cvtpk(tv_[2], tv_[3]); *(LAS u32x2*)(L + O_VT + c * S32 + q * 8) = w2;
                w2.x = cvtpk(tb_[0], tb_[1]); w2.y = cvtpk(tb_[2], tb_[3]); *(LAS u32x2*)(L + O_BHT + c * S32 + q * 8) = w2;
                w2.x = cvtpk(tk_[0], tk_[1]); w2.y = cvtpk(tk_[2], tk_[3]); *(LAS u32x2*)(L + O_KHT + c * S32 + q * 8) = w2; }
            if (q == 3) ((LAS float*)(L + O_WC))[c] = eC;
        }
        __syncthreads();
        {
            const int role = (q + dir) & 3;
            const lbyte* Aj = L + ((role & 1) ? O_KDT : O_BT);
            const lbyte* Bt = L + ((role & 2) ? O_RT : O_KKT);
            f32x4 g4 = mm_tile<2>(Aj, S64, Bt, S64, (f32x4){0.f, 0.f, 0.f, 0.f}, lane);
#pragma unroll
            for (int e = 0; e < 4; ++e) { const int j = 4 * fg + e; const bool keep = (role & 2) ? (j <= fr) : (j < fr); g4[e] = keep ? g4[e] : 0.f; }
            if (role == 0) { float X[16]; tri_inv16(g4, lane, L + O_LW, X);
                if (lane < 16) {
#pragma unroll
                    for (int i = 0; i < 16; ++i) *(LAS unsigned short*)(L + O_TI + i * S32 + lane * 2) = (unsigned short)cvtpk(X[i], 0.f); } }
            else st_bf16x4(L + (role == 1 ? O_MK : (role == 2 ? O_NB : O_NK)) + fr * S32 + fg * 8, g4);
        }
        __syncthreads();
        f32x4 yacc;
        {
            f32x4 u4 = mm_tile<2>(L + O_KKT, S64, L + O_SBF + 16 * q * S64, S64, (f32x4){0.f, 0.f, 0.f, 0.f}, lane);
            u4 = mm_tile<1>(L + O_MK, S32, L + O_VT + 16 * q * S32, S32, u4, lane);
            st_bf16x4(L + O_UTT + (16 * q + fr) * S32 + fg * 8, u4);
            yacc = mm_tile<2>(L + O_SBF + 16 * q * S64, S64, L + O_RT, S64, (f32x4){0.f, 0.f, 0.f, 0.f}, lane);
            yacc = mm_tile<1>(L + O_VT + 16 * q * S32, S32, L + O_NK, S32, yacc, lane);
        }
        asm volatile("s_waitcnt lgkmcnt(0)" ::: "memory");
        {
            f32x4 u4 = mm_tile<1>(L + O_TI, S32, L + O_UTT + 16 * q * S32, S32, (f32x4){0.f, 0.f, 0.f, 0.f}, lane);
            st_bf16x4(L + O_UT + (16 * q + fr) * S32 + fg * 8, -u4);
        }
        __syncthreads();
        {
            yacc = mm_tile<1>(L + O_UT + 16 * q * S32, S32, L + O_NB, S32, yacc, lane);
            ypend.x = cvtpk(yacc[0], yacc[1]); ypend.y = cvtpk(yacc[2], yacc[3]);
            const f32x4 wc4 = *(LAS f32x4*)(L + O_WC + (16 * q + 4 * fg) * 4);
#pragma unroll
            for (int vi = 0; vi < 4; ++vi) {
                f32x4 s4 = Sacc[vi] * wc4;
                s4 = mm_tile<1>(L + O_KHT + 16 * q * S32, S32, L + O_VT + 16 * vi * S32, S32, s4, lane);
                s4 = mm_tile<1>(L + O_BHT + 16 * q * S32, S32, L + O_UT + 16 * vi * S32, S32, s4, lane);
                Sacc[vi] = s4;
                st_bf16x4(L + O_SBF + (16 * vi + fr) * S64 + (16 * q + 4 * fg) * 2, s4);
            }
        }
    }
    flush(143);
    __syncthreads();
}

__device__ __forceinline__ void phase_gdn_prep(const Args& A, Ctx& C) {
    const bf16_t* P = WSP(bf16_t, WS_P);
    bf16_t* QKV = (bf16_t*)A.out; float* NRM = WSP(float, WS_NRM);
    const int lane = C.lane, w = C.wave, hq = w >> 1, th = w & 1;
    const int ch0 = 128 * hq + 2 * lane;
    float cw[3][2][5];
#pragma unroll
    for (int g = 0; g < 3; ++g)
#pragma unroll
        for (int xx = 0; xx < 2; ++xx)
#pragma unroll
            for (int e = 0; e < 5; ++e) cw[g][xx][e] = A.in[I_CONVW][e * 1536 + g * 512 + ch0 + xx];
    auto geom = [&](int tile, int& T, int& tb, size_t& rowbase) { const int row0 = tile * 16; int ta;
        if (row0 < NLAT) { T = SEQ; rowbase = (size_t)(row0 >> 11) * SEQ; ta = row0 & (SEQ - 1); } else { T = CTX; const int r = row0 - NLAT; rowbase = (size_t)NLAT + (size_t)(r >> 8) * CTX; ta = r & (CTX - 1); }
        tb = ta + 8 * th; };
    unsigned raw[12][3];
    auto issue = [&](int tile) { int T, tb; size_t rowbase; geom(tile, T, tb, rowbase);
#pragma unroll
        for (int e = 0; e < 12; ++e) { const int t = tb - 2 + e; const bool ok = (t >= 0 && t < T); const unsigned* pr = (const unsigned*)(P + (rowbase + (ok ? t : tb)) * PLD + RW_COLS + ch0);
#pragma unroll
            for (int g = 0; g < 3; ++g) raw[e][g] = pr[g * 256]; } };
    if (C.bid < NROWS / 16) issue(C.bid);
    for (int tile = C.bid; tile < NROWS / 16; tile += C.G) {
        int T, tb; size_t rowbase; geom(tile, T, tb, rowbase);
        float x[3][2][12];
#pragma unroll
        for (int e = 0; e < 12; ++e) { const int t = tb - 2 + e; const bool ok = (t >= 0 && t < T);
#pragma unroll
            for (int g = 0; g < 3; ++g) { const unsigned wv = raw[e][g]; x[g][0][e] = ok ? bflo(wv) : 0.f; x[g][1][e] = ok ? bfhi(wv) : 0.f; } }
        if (tile + C.G < NROWS / 16) issue(tile + C.G);
#pragma unroll
        for (int i = 0; i < 8; ++i) { float y[3][2];
#pragma unroll
            for (int g = 0; g < 3; ++g)
#pragma unroll
                for (int xx = 0; xx < 2; ++xx) { float sacc = 0.f;
#pragma unroll
                    for (int f = 0; f < 5; ++f) sacc += cw[g][xx][f] * x[g][xx][i + f];
                    y[g][xx] = siluf_(sacc); }
            const size_t row = rowbase + tb + i;
            unsigned* orow = (unsigned*)(QKV + row * 1536 + ch0);
            orow[0] = cvtpk(y[0][0], y[0][1]); orow[256] = cvtpk(y[1][0], y[1][1]); orow[512] = cvtpk(y[2][0], y[2][1]);
            const float sq = wave_sum(y[0][0] * y[0][0] + y[0][1] * y[0][1]), sk = wave_sum(y[1][0] * y[1][0] + y[1][1] * y[1][1]);
            if (lane == 0) { NRM[row * 8 + hq] = __builtin_amdgcn_rsqf(sq + 1e-6f) * 0.08838834764831845f; NRM[row * 8 + 4 + hq] = __builtin_amdgcn_rsqf(sk + 1e-6f); } }
    }
    __syncthreads();
}

namespace gd {
constexpr int S128 = 288, S32 = 80;
constexpr int O_KT = 0, O_QT = O_KT + 32 * S128, O_KKT = O_QT + 32 * S128, O_RT = O_KKT + 32 * S128,
              O_VT = O_RT + 32 * S128, O_BHT = O_VT + 128 * S32, O_KHT = O_BHT + 128 * S32, O_UT = O_KHT + 128 * S32, O_UTT = O_UT + 128 * S32,
              O_TI = O_UTT + 128 * S32, O_MK = O_TI + 32 * S32, O_NB = O_MK + 32 * S32, O_NK = O_NB + 32 * S32,
              O_M21 = O_NK + 32 * S32, O_T11T = O_M21 + 16 * S32, O_T22 = O_T11T + 16 * S32, O_XT = O_T22 + 16 * S32,
              O_SBF = O_XT + 16 * S32, O_SC = O_SBF + 128 * S128, O_MS = O_SC + 512, GD_BYTES = O_MS + 2048;
static_assert(GD_BYTES <= LDS_MISC, "gdn LDS");
}
__device__ __forceinline__ void gdn_chain_chunked(const Args& A, Ctx& C, int chain) {
    using namespace gd;
    const int b = chain >> 3, h = (chain >> 1) & 3, dir = chain & 1;
    lbyte* L = C.lds;
    LAS float* SC = (LAS float*)(L + O_SC);
    const bf16_t* P = WSP(bf16_t, WS_P);
    bf16_t* ydir = WSP(bf16_t, WS_YDIR) + (size_t)dir * NLAT * D;
    const int tid = C.tid, lane = C.lane, w = C.wave, fr = lane & 15, fg = lane >> 4;
    const int grp = w >> 1, idx = tid & 127;
    const float Aexp = __expf(A.in[I_ALOG][dir * 4 + h]), dtb = A.in[I_DTB][dir * 4 + h];
    const f32x4 z4 = (f32x4){0.f, 0.f, 0.f, 0.f};
    __syncthreads();
#pragma unroll 2
    for (int i = tid; i < (O_SC - O_VT) / 4; i += 512) ((LAS unsigned*)(L + O_VT))[i] = 0u;
    f32x4 Sacc[8];
#pragma unroll
    for (int i = 0; i < 8; ++i) Sacc[i] = z4;
    const bf16_t* QKV = (const bf16_t*)A.out; const float* NRM = WSP(const float, WS_NRM);
    unsigned rq[8], rk[8], rv[8]; float nq[8], nk[8]; unsigned raw_al = 0, raw_be = 0;
    const unsigned codd = (idx & 1) ? 0u : 16u, godd = (h & 1) ? 0u : 16u;
    auto chunk_geom = [&](int ch, bool& isctx, int& sbase, int& T, size_t& rowbase) { isctx = ch < 8; sbase = isctx ? ch * 32 : (ch - 8) * 32; T = isctx ? CTX : SEQ;
        rowbase = isctx ? (size_t)NLAT + (size_t)b * CTX : (size_t)b * SEQ; };
    auto issue_loads = [&](int ch) { bool isctx; int sbase, T; size_t rowbase; chunk_geom(ch, isctx, sbase, T, rowbase);
#pragma unroll
        for (int j = 0; j < 8; ++j) { const int i = 8 * grp + j; const int t = dir ? (T - 1 - (sbase + i)) : (sbase + i); const size_t row = rowbase + t;
            const unsigned* qr = (const unsigned*)(QKV + row * 1536 + 128 * h + (idx & ~1)); rq[j] = qr[0]; rk[j] = qr[256]; rv[j] = qr[512]; nq[j] = NRM[row * 8 + h]; nk[j] = NRM[row * 8 + 4 + h]; }
        if (w == 7 && lane < 32) { const int t = dir ? (T - 1 - (sbase + lane)) : (sbase + lane); const unsigned* pr = (const unsigned*)(P + (rowbase + t) * PLD + RW_COLS + 2048 + ((dir * 4 + h) & ~1)); raw_al = pr[0]; raw_be = pr[4]; } };
    u32x2 ypend[2]; ypend[0].x = ypend[0].y = ypend[1].x = ypend[1].y = 0u;
    auto flush = [&](int pch) { bool pisctx; int psb, pT; size_t prb; chunk_geom(pch, pisctx, psb, pT, prb);
        if (!pisctx) {
#pragma unroll
            for (int tb = 0; tb < 2; ++tb) { const int tl = psb + tb * 16 + fr; const int t = dir ? (pT - 1 - tl) : tl;
                *(u32x2*)(ydir + ((size_t)b * SEQ + t) * D + 512 + 128 * h + 16 * w + 4 * fg) = ypend[tb]; } } };
    issue_loads(0);
    for (int ch = 0; ch < 72; ++ch) {
        bool isctx; int sbase, T; size_t rowbase; chunk_geom(ch, isctx, sbase, T, rowbase);
        __syncthreads();
        float qv[8], kv[8], vv[8], nqv[8], nkv[8];
#pragma unroll
        for (int j = 0; j < 8; ++j) { qv[j] = bfsel(rq[j], codd); kv[j] = bfsel(rk[j], codd); vv[j] = bfsel(rv[j], codd); nqv[j] = nq[j]; nkv[j] = nk[j]; }
        if (w == 7) {
            const float gi = (lane < 32) ? -Aexp * softplusf_(bfsel(raw_al, godd) + dtb) : 0.f;
            float cum = gi;
            cum += __builtin_bit_cast(float, __builtin_amdgcn_update_dpp(0, __builtin_bit_cast(int, cum), 0x111, 0xf, 0xf, true));
            cum += __builtin_bit_cast(float, __builtin_amdgcn_update_dpp(0, __builtin_bit_cast(int, cum), 0x112, 0xf, 0xf, true));
            cum += __builtin_bit_cast(float, __builtin_amdgcn_update_dpp(0, __builtin_bit_cast(int, cum), 0x114, 0xf, 0xf, true));
            cum += __builtin_bit_cast(float, __builtin_amdgcn_update_dpp(0, __builtin_bit_cast(int, cum), 0x118, 0xf, 0xf, true));
            const float r0 = rdlane(cum, 15);
            cum += (lane >= 16) ? r0 : 0.f;
            if (lane < 32) { SC[lane] = sigmoidf_(bfsel(raw_be, godd)); SC[32 + lane + 1] = cum; if (lane == 0) SC[32] = 0.f; }
        }
        asm volatile("" :: "v"(qv[0]), "v"(qv[1]), "v"(qv[2]), "v"(qv[3]), "v"(qv[4]), "v"(qv[5]), "v"(qv[6]), "v"(qv[7]), "v"(kv[0]), "v"(kv[1]), "v"(kv[2]), "v"(kv[3]), "v"(kv[4]), "v"(kv[5]), "v"(kv[6]), "v"(kv[7]),
                        "v"(vv[0]), "v"(vv[1]), "v"(vv[2]), "v"(vv[3]), "v"(vv[4]), "v"(vv[5]), "v"(vv[6]), "v"(vv[7]) : "memory");
        asm volatile("" :: "v"(nqv[0]), "v"(nqv[1]), "v"(nqv[2]), "v"(nqv[3]), "v"(nqv[4]), "v"(nqv[5]), "v"(nqv[6]), "v"(nqv[7]), "v"(nkv[0]), "v"(nkv[1]), "v"(nkv[2]), "v"(nkv[3]), "v"(nkv[4]), "v"(nkv[5]), "v"(nkv[6]), "v"(nkv[7]),
                        "v"(raw_al), "v"(raw_be) : "memory");
        if (ch > 0) flush(ch - 1);
        if (ch + 1 < 72) issue_loads(ch + 1);
        __syncthreads();
        {
            const int c = idx; const float gcC = SC[32 + 32];
            float bh[8], kh[8];
#pragma unroll
            for (int j = 0; j < 8; ++j) { const int i = 8 * grp + j;
                const float kn = kv[j] * nkv[j], qn = qv[j] * nqv[j];
                const float gm = SC[32 + i], gi = SC[32 + i + 1], be = SC[i];
                const unsigned p0 = cvtpk(kn, qn);
                *(LAS unsigned short*)(L + O_KT + i * S128 + c * 2) = (unsigned short)p0; *(LAS unsigned short*)(L + O_QT + i * S128 + c * 2) = (unsigned short)(p0 >> 16);
                bh[j] = be * kn * __expf(gcC - gm); kh[j] = be * kn * __expf(gcC - gi); }
            u32x4 w4;
            w4.x = cvtpk(bh[0], bh[1]); w4.y = cvtpk(bh[2], bh[3]); w4.z = cvtpk(bh[4], bh[5]); w4.w = cvtpk(bh[6], bh[7]); *(LAS u32x4*)(L + O_BHT + c * S32 + grp * 16) = w4;
            w4.x = cvtpk(kh[0], kh[1]); w4.y = cvtpk(kh[2], kh[3]); w4.z = cvtpk(kh[4], kh[5]); w4.w = cvtpk(kh[6], kh[7]); *(LAS u32x4*)(L + O_KHT + c * S32 + grp * 16) = w4;
            w4.x = cvtpk(vv[0], vv[1]); w4.y = cvtpk(vv[2], vv[3]); w4.z = cvtpk(vv[4], vv[5]); w4.w = cvtpk(vv[6], vv[7]); *(LAS u32x4*)(L + O_VT + c * S32 + grp * 16) = w4;
        }
        __syncthreads();
        {
            const int isq = w >> 2, tb = (w >> 1) & 1, jb = w & 1;
            if (jb <= tb) {
                const f32x4 g4 = mm_tile<4>(L + O_KT + jb * 16 * S128, S128, L + (isq ? O_QT : O_KT) + tb * 16 * S128, S128, z4, lane);
                const int t = tb * 16 + fr;
                const float gt = SC[32 + t + isq];
                f32x4 m0, m1;
#pragma unroll
                for (int e = 0; e < 4; ++e) { const int j = jb * 16 + 4 * fg + e; const bool keep = isq ? (j <= t) : (j < t);
                    const float bj = SC[j] * g4[e];
                    m0[e] = keep ? bj * __expf(gt - SC[32 + j]) : 0.f;
                    m1[e] = keep ? bj * __expf(gt - SC[32 + j + 1]) : 0.f; }
                const int off = t * S32 + (jb * 16 + 4 * fg) * 2;
                if (isq) { st_bf16x4(L + O_NB + off, m0); st_bf16x4(L + O_NK + off, m1); }
                else {
                    st_bf16x4(L + O_MK + off, m1);
                    if (tb != jb) st_bf16x4(L + O_M21 + fr * S32 + fg * 8, m0);
                    else { float X[16]; tri_inv16(m0, lane, L + O_MS + tb * 1024, X);
                        if (lane < 16) {
#pragma unroll
                            for (int i = 0; i < 16; ++i) *(LAS unsigned short*)(L + O_TI + (tb * 16 + i) * S32 + (tb * 16 + lane) * 2) = (unsigned short)cvtpk(X[i], 0.f);
                            if (tb == 0) { u32x4 a0, a1;
                                a0.x = cvtpk(X[0], X[1]); a0.y = cvtpk(X[2], X[3]); a0.z = cvtpk(X[4], X[5]); a0.w = cvtpk(X[6], X[7]);
                                a1.x = cvtpk(X[8], X[9]); a1.y = cvtpk(X[10], X[11]); a1.z = cvtpk(X[12], X[13]); a1.w = cvtpk(X[14], X[15]);
                                *(LAS u32x4*)(L + O_T11T + lane * S32) = a0; *(LAS u32x4*)(L + O_T11T + lane * S32 + 16) = a1; }
                            else {
#pragma unroll
                                for (int i = 0; i < 16; ++i) *(LAS unsigned short*)(L + O_T22 + i * S32 + lane * 2) = (unsigned short)cvtpk(X[i], 0.f); }
                        } }
                }
            }
        }
        __syncthreads();
        if (w == 1) {
            const f32x4 x4 = mm_tile<1>(L + O_M21, S32, L + O_T11T, S32, z4, lane);
            st_bf16x4(L + O_XT + fr * S32 + fg * 8, x4);
            asm volatile("s_waitcnt lgkmcnt(0)" ::: "memory");
            const f32x4 t4 = mm_tile<1>(L + O_XT, S32, L + O_T22, S32, z4, lane);
            st_bf16x4(L + O_TI + (16 + fr) * S32 + fg * 8, -t4);
        }
        f32x4 yacc[2];
#pragma unroll
        for (int tb = 0; tb < 2; ++tb) {
            f32x4 u4 = mm_tile<4>(L + O_KT + tb * 16 * S128, S128, L + O_SBF + 16 * w * S128, S128, z4, lane);
            { const f32x4 gp = *(LAS f32x4*)(SC + 32 + 16 * tb + 4 * fg);
                u4.x *= __expf(gp.x); u4.y *= __expf(gp.y); u4.z *= __expf(gp.z); u4.w *= __expf(gp.w); }
            u4 = mm_tile<1>(L + O_MK + tb * 16 * S32, S32, L + O_VT + 16 * w * S32, S32, u4, lane);
            st_bf16x4(L + O_UTT + (16 * w + fr) * S32 + tb * 32 + fg * 8, u4);
            yacc[tb] = mm_tile<4>(L + O_SBF + 16 * w * S128, S128, L + O_QT + tb * 16 * S128, S128, z4, lane);
            yacc[tb] = yacc[tb] * __expf(SC[32 + 16 * tb + fr + 1]);
            yacc[tb] = mm_tile<1>(L + O_VT + 16 * w * S32, S32, L + O_NK + tb * 16 * S32, S32, yacc[tb], lane);
        }
        __syncthreads();
#pragma unroll
        for (int tb = 0; tb < 2; ++tb) {
            const f32x4 u4 = mm_tile<1>(L + O_TI + tb * 16 * S32, S32, L + O_UTT + 16 * w * S32, S32, z4, lane);
            st_bf16x4(L + O_UT + (16 * w + fr) * S32 + tb * 32 + fg * 8, -u4);
        }
        __syncthreads();
        {
#pragma unroll
            for (int tb = 0; tb < 2; ++tb) {
                yacc[tb] = mm_tile<1>(L + O_UT + 16 * w * S32, S32, L + O_NB + tb * 16 * S32, S32, yacc[tb], lane);
                ypend[tb].x = cvtpk(yacc[tb][0], yacc[tb][1]); ypend[tb].y = cvtpk(yacc[tb][2], yacc[tb][3]);
            }
            const float wc = __expf(SC[32 + 32]);
#pragma unroll
            for (int vi = 0; vi < 8; ++vi) {
                f32x4 s4 = Sacc[vi] * wc;
                s4 = mm_tile<1>(L + O_KHT + 16 * w * S32, S32, L + O_VT + 16 * vi * S32, S32, s4, lane);
                s4 = mm_tile<1>(L + O_BHT + 16 * w * S32, S32, L + O_UT + 16 * vi * S32, S32, s4, lane);
                Sacc[vi] = s4;
                st_bf16x4(L + O_SBF + (16 * vi + fr) * S128 + (16 * w + 4 * fg) * 2, s4);
            }
        }
    }
    flush(71);
    __syncthreads();
}

__device__ __forceinline__ void unpack8(const u32x4 w, float (&f)[8]) { f[0] = bflo(w.x); f[1] = bfhi(w.x); f[2] = bflo(w.y); f[3] = bfhi(w.y); f[4] = bflo(w.z); f[5] = bfhi(w.z); f[6] = bflo(w.w); f[7] = bfhi(w.w); }
__device__ __forceinline__ void phase_p4(const Args& A, Ctx& C) {
    const bf16_t* P = WSP(bf16_t, WS_P);
    const bf16_t* yf = WSP(bf16_t, WS_YDIR); const bf16_t* yb = yf + (size_t)NLAT * D;
    const float* bon = WSP(float, WS_BON);
    bf16_t* ymix = WSP(bf16_t, WS_YMIX);
    lbyte* SGb = C.lds;
    lfloat* GO = (lfloat*)(C.lds + 8192);
    const int tid = C.tid, lane = C.lane, w = C.wave;
    const bf16_t* gupt = WSP(const bf16_t, WS_GUPT);
    const int fr = lane & 15, fg = lane >> 4;
    const int c8 = 8 * lane;
    float lnw[8], lnb[8], ong[8], muv[8];
#pragma unroll
    for (int e = 0; e < 8; ++e) { lnw[e] = A.in[I_LNW][c8 + e]; lnb[e] = A.in[I_LNB][c8 + e]; ong[e] = A.in[I_ONG][(c8 + e) & 127]; muv[e] = A.in[I_MU][1024 + c8 + e]; }
    const int tkA = tid >> 5, lA = 4 * (tid & 31);
    float muA[4];
#pragma unroll
    for (int e = 0; e < 4; ++e) muA[e] = A.in[I_MU][1792 + lA + e];
    const bool vup = (1024 + c8) < 1440;
    bf16x8 gq[4][4];
#pragma unroll
    for (int i = 0; i < 4; ++i)
#pragma unroll
        for (int ks = 0; ks < 4; ++ks) gq[i][ks] = *(const bf16x8*)(gupt + (size_t)(64 * w + 16 * i + fr) * 128 + ks * 32 + fg * 8);
    u32x2 pwA, swA;
    auto issueA = [&](int tile) { const int row = tile * 16 + tkA, t = row & (SEQ - 1); const bool ok = t < SEQ - 64;
        pwA = *(const u32x2*)(P + (size_t)row * PLD + 1792 + lA); swA = *(const u32x2*)(P + (size_t)(row + (ok ? 64 : 0)) * PLD + 1792 + lA); };
    if (C.bid < NLAT / 16) issueA(C.bid);
    for (int tile = C.bid; tile < NLAT / 16; tile += C.G) {
        const int row0 = tile * 16;
        u32x4 wyf[2], wyb[2], wpv[2], wsv[2], wof[2], wob[2], wz[2]; float bsv[2];
#pragma unroll
        for (int tt = 0; tt < 2; ++tt) {
            const int tk = 2 * w + tt, row = row0 + tk, t = row & (SEQ - 1);
            const bool okv = vup ? (t >= 64) : (t < SEQ - 64);
            wyf[tt] = *(const u32x4*)(yf + (size_t)row * D + c8); wyb[tt] = *(const u32x4*)(yb + (size_t)row * D + c8);
            wpv[tt] = *(const u32x4*)(P + (size_t)row * PLD + 1024 + c8); wsv[tt] = *(const u32x4*)(P + (size_t)(row + (okv ? (vup ? -64 : 64) : 0)) * PLD + 1024 + c8);
            wof[tt] = *(const u32x4*)(yf + (size_t)row * D + 512 + c8); wob[tt] = *(const u32x4*)(yb + (size_t)row * D + 512 + c8);
            wz[tt] = *(const u32x4*)(P + (size_t)row * PLD + RW_COLS + 1536 + c8);
            bsv[tt] = bon[(size_t)row * 8 + (lane >> 3)] + bon[((size_t)NLAT + row) * 8 + (lane >> 3)];
        }
        __syncthreads();
        {
            const int row = row0 + tkA, t = row & (SEQ - 1); const bool ok = t < SEQ - 64;
            const u32x2 pw = pwA, sw = swA;
            const float pv[4] = {bflo(pw.x), bfhi(pw.x), bflo(pw.y), bfhi(pw.y)}; const float sv[4] = {bflo(sw.x), bfhi(sw.x), bflo(sw.y), bfhi(sw.y)};
            float o[4];
#pragma unroll
            for (int e = 0; e < 4; ++e) o[e] = sigmoidf_(pv[e] + muA[e] * ((ok ? sv[e] : 0.f) - pv[e]));
            u32x2 ow; ow.x = cvtpk(o[0], o[1]); ow.y = cvtpk(o[2], o[3]); *(LAS u32x2*)(SGb + tkA * 288 + lA * 2) = ow;
        }
        if (tile + C.G < NLAT / 16) issueA(tile + C.G);
        __syncthreads();
#pragma unroll
        for (int i = 0; i < 4; ++i) { const int c0 = 64 * w + 16 * i; f32x4 acc = (f32x4){0.f, 0.f, 0.f, 0.f};
#pragma unroll
            for (int ks = 0; ks < 4; ++ks) { const bf16x8 a = *(const LAS bf16x8*)(SGb + fr * 288 + ks * 64 + fg * 16);
                acc = __builtin_amdgcn_mfma_f32_16x16x32_bf16(a, gq[i][ks], acc, 0, 0, 0); }
#pragma unroll
            for (int e = 0; e < 4; ++e) GO[(4 * fg + e) * 512 + c0 + fr] = acc[e]; }
        __syncthreads();
#pragma unroll
        for (int tt = 0; tt < 2; ++tt) {
            const int tk = 2 * w + tt, row = row0 + tk, t = row & (SEQ - 1);
            const bool okv = vup ? (t >= 64) : (t < SEQ - 64);
            const float bs = bsv[tt];
            const f32x4 g0 = *(const LAS f32x4*)(GO + tk * 512 + c8), g1 = *(const LAS f32x4*)(GO + tk * 512 + c8 + 4);
            const float gg[8] = {g0.x, g0.y, g0.z, g0.w, g1.x, g1.y, g1.z, g1.w};
            float a[8], bq[8], pv[8], sv[8], y[8];
            unpack8(wyf[tt], a); unpack8(wyb[tt], bq); unpack8(wpv[tt], pv); unpack8(wsv[tt], sv);
            float s1 = 0.f;
#pragma unroll
            for (int e = 0; e < 8; ++e) { y[e] = a[e] + bq[e]; s1 += y[e]; }
            s1 += __shfl_xor(s1, 1); s1 += __shfl_xor(s1, 2); s1 += __shfl_xor(s1, 4);
            const float m = s1 * (1.f / 64.f);
            float s2 = 0.f;
#pragma unroll
            for (int e = 0; e < 8; ++e) { y[e] -= m; s2 += y[e] * y[e]; }
            s2 += __shfl_xor(s2, 1); s2 += __shfl_xor(s2, 2); s2 += __shfl_xor(s2, 4);
            const float rs = __builtin_amdgcn_rsqf(s2 * (1.f / 64.f) + RWKV_EPS);
            float o[8];
#pragma unroll
            for (int e = 0; e < 8; ++e) { const float vv = pv[e] + muv[e] * ((okv ? sv[e] : 0.f) - pv[e]); o[e] = (y[e] * rs * lnw[e] + lnb[e] + bs * vv) * gg[e]; }
            u32x4 ow; ow.x = cvtpk(o[0], o[1]); ow.y = cvtpk(o[2], o[3]); ow.z = cvtpk(o[4], o[5]); ow.w = cvtpk(o[6], o[7]);
            *(u32x4*)(ymix + (size_t)row * D + c8) = ow;
            float of[8], ob[8], z[8];
            unpack8(wof[tt], of); unpack8(wob[tt], ob); unpack8(wz[tt], z);
            float s3 = 0.f;
#pragma unroll
            for (int e = 0; e < 8; ++e) { of[e] += ob[e]; s3 += of[e] * of[e]; }
            s3 += __shfl_xor(s3, 1); s3 += __shfl_xor(s3, 2); s3 += __shfl_xor(s3, 4); s3 += __shfl_xor(s3, 8);
            const float rg = __builtin_amdgcn_rsqf(s3 * (1.f / 128.f) + NORM_EPS);
#pragma unroll
            for (int e = 0; e < 8; ++e) o[e] = of[e] * rg * ong[e] * siluf_(z[e]);
            ow.x = cvtpk(o[0], o[1]); ow.y = cvtpk(o[2], o[3]); ow.z = cvtpk(o[4], o[5]); ow.w = cvtpk(o[6], o[7]);
            *(u32x4*)(ymix + (size_t)row * D + 512 + c8) = ow;
        }
    }
}

__device__ __forceinline__ void convert_experts(const Args& A, Ctx& C) {
    lfloat* scr = (lfloat*)(C.lds + C.wave * 16384);
    const int gw = C.bid * 8 + C.wave, NGW = C.G * 8;
    constexpr int I13 = (D / 128) * (DE / 32);
    constexpr int I2 = (DE / 128) * (D / 32);
    constexpr int PER = 2 * I13 + I2;
    for (int it = gw; it < 257 * PER; it += NGW) {
        const int e = it / PER; int r = it % PER;
        unsigned char* bt13 = A.ws + WS_WEXP + (size_t)e * WEXP_STRIDE; unsigned char* bt2 = bt13 + 512 * 1024;
        const float* w1 = e < NE ? A.in[I_EW1] + (size_t)e * D * DE : A.in[I_SW1];
        const float* w3 = e < NE ? A.in[I_EW3] + (size_t)e * D * DE : A.in[I_SW3];
        const float* w2 = e < NE ? A.in[I_EW2] + (size_t)e * DE * D : A.in[I_SW2];
        if (r < I13) { transpose_pair_fp8(w1, D, DE, bt13, RowGLU{0}, SW13, scr, r, C.lane); continue; } r -= I13;
        if (r < I13) { transpose_pair_fp8(w3, D, DE, bt13, RowGLU{128}, SW13, scr, r, C.lane); continue; } r -= I13;
        transpose_pair_fp8(w2, DE, D, bt2, RowId(), SW2, scr, r, C.lane);
    }
}

__device__ __forceinline__ void phase_p6(const Args& A, Ctx& C) {
    const float* mod = WSP(float, WS_MOD); bf16_t* h2n = WSP(bf16_t, WS_H2N);
    const int gw = C.bid * 8 + C.wave, NGW = C.G * 8;
    for (int row = gw; row < NLAT; row += NGW) {
        const float* m = mod + (size_t)(row >> 11) * MODW;
        norm_mod_row(A.out + (size_t)row * D, A.in[I_N2G], m + 4 * D, m + 3 * D, h2n + (size_t)row * D, C.lane, (unsigned*)(A.ws + WS_H2N8) + (size_t)row * (D / 4));
    }
}

__device__ __forceinline__ void phase_p8(const Args& A, Ctx& C) {
    const float* logit = WSP(float, WS_LOGIT);
    int* tope = WSP(int, WS_TOPE); float* topw = WSP(float, WS_TOPW); int* pos = WSP(int, WS_POS);
    unsigned* cnt = WSP(unsigned, WS_CTL) + CW_CNT;
    const int lane = C.lane;
    const f32x4 rb = ((const f32x4*)A.in[I_RB])[lane];
    LAS unsigned* hist = (LAS unsigned*)C.lds;
    LAS unsigned* base = hist + 256;
    LAS unsigned* lpe = base + 256;
    for (int blk = C.bid; blk < NLAT / 256; blk += C.G) {
    __syncthreads();
    if (C.tid < 256) hist[C.tid] = 0u;
    __syncthreads();
    f32x4 nlg = ((const f32x4*)(logit + (size_t)(blk * 256 + C.wave * 32) * NE))[lane];
    for (int ti = 0; ti < 32; ++ti) {
        const int tl = C.wave * 32 + ti, tok = blk * 256 + tl;
        const f32x4 lg = nlg;
        if (ti + 1 < 32) nlg = ((const f32x4*)(logit + (size_t)(tok + 1) * NE))[lane];
        float s[4], sel[4];
#pragma unroll
        for (int i = 0; i < 4; ++i) { s[i] = sigmoidf_(lg[i]); sel[i] = s[i] + rb[i]; }
        float m1 = fmaxf(fmaxf(sel[0], sel[1]), fmaxf(sel[2], sel[3]));
        float m2;
        {
            float a = fmaxf(sel[0], sel[1]), bq = fminf(sel[0], sel[1]), cq = fmaxf(sel[2], sel[3]), dq = fminf(sel[2], sel[3]);
            m2 = fmaxf(fminf(a, cq), fmaxf(bq, dq)); }
#define P8_MERGE(CTRL) { const float o1 = dpp_f<CTRL>(m1), o2 = dpp_f<CTRL>(m2); const float n1 = fmaxf(m1, o1); const float n2 = fmaxf(fminf(m1, o1), fmaxf(m2, o2)); m1 = n1; m2 = n2; }
        P8_MERGE(0xB1) P8_MERGE(0x4E) P8_MERGE(0x141)
#undef P8_MERGE
        const float gs = m1 + m2;
        const int grp = lane >> 3;
        int rank = 0;
#pragma unroll
        for (int gq = 0; gq < 8; ++gq) { const float og = __shfl(gs, gq * 8); rank += (og > gs || (og == gs && gq < grp)) ? 1 : 0; }
        const bool gsel = rank < 4;
        float cand[4];
#pragma unroll
        for (int i = 0; i < 4; ++i) cand[i] = gsel ? sel[i] : -INFINITY;
        int my_e = 0; float my_w = 0.f; float wsum = 0.f;
#pragma unroll
        for (int r = 0; r < 8; ++r) {
            float bv = cand[0]; int bi = 0;
#pragma unroll
            for (int i = 1; i < 4; ++i) if (cand[i] > bv) { bv = cand[i]; bi = i; }
            float wm = bv;
            wm = fmaxf(wm, dpp_f<0x128>(wm)); wm = fmaxf(wm, dpp_f<0x124>(wm)); wm = fmaxf(wm, dpp_f<0x122>(wm)); wm = fmaxf(wm, dpp_f<0x121>(wm));
            const float gv = fmaxf(fmaxf(rdlane(wm, 0), rdlane(wm, 16)), fmaxf(rdlane(wm, 32), rdlane(wm, 48)));
            const unsigned long long bal = __ballot(bv == gv);
            const int ol = __builtin_amdgcn_readfirstlane((int)__builtin_ctzll(bal));
            const int oi = __builtin_amdgcn_readlane(bi, ol);
            const int be = ol * 4 + oi;
            const float mys = oi == 0 ? s[0] : (oi == 1 ? s[1] : (oi == 2 ? s[2] : s[3]));
            const float ws_ = rdlane(mys, ol);
            const bool mine = lane == ol;
#pragma unroll
            for (int i = 0; i < 4; ++i) cand[i] = (mine && oi == i) ? -INFINITY : cand[i];
            wsum += ws_;
            if (lane == r) { my_e = be; my_w = ws_; }
        }
        if (lane < 8) {
            const float w = my_w / wsum * 2.5f;
            const unsigned lp = __hip_atomic_fetch_add(hist + my_e, 1u, __ATOMIC_RELAXED, __HIP_MEMORY_SCOPE_WORKGROUP);
            tope[(size_t)tok * 8 + lane] = my_e; topw[(size_t)tok * 8 + lane] = w; lpe[tl * 8 + lane] = ((unsigned)my_e << 16) | lp;
        }
    }
    __syncthreads();
    if (C.tid < 256) { const unsigned c = hist[C.tid]; base[C.tid] = c ? atomicAdd(cnt + C.tid * CNT_STRIDE, c) : 0u; }
    __syncthreads();
    for (int i = C.tid; i < 2048; i += 512) { const unsigned v = lpe[i]; pos[(size_t)blk * 2048 + i] = (int)(base[v >> 16] + (v & 0xffffu)); }
    }
}

__device__ __forceinline__ void tile_prefix(const Args& A, Ctx& C, LAS int* tb) {
    const unsigned* cnt = WSP(unsigned, WS_CTL) + CW_CNT;
    int v = 0;
    if (C.tid < NE) v = ((int)cnt[C.tid * CNT_STRIDE] + 255) >> 8;
#pragma unroll
    for (int d = 1; d < 64; d <<= 1) { const int t = __shfl_up(v, d); if (C.lane >= d) v += t; }
    if (C.tid < NE && C.lane == 63) tb[260 + C.wave] = v;
    __syncthreads();
    if (C.tid < NE) { int off = 0;
#pragma unroll
        for (int q = 0; q < 3; ++q) off += (q < C.wave) ? tb[260 + q] : 0;
        tb[C.tid + 1] = off + v; if (C.tid == 0) tb[0] = 0; }
    __syncthreads();
}
__device__ __forceinline__ void phase_p9(const Args& A, Ctx& C) {
    LAS int* tb = (LAS int*)C.lds;
    tile_prefix(A, C, tb);
    const unsigned* cnt = WSP(unsigned, WS_CTL) + CW_CNT;
    const int* tope = WSP(int, WS_TOPE); const float* topw = WSP(float, WS_TOPW); const int* pos = WSP(int, WS_POS);
    int* rowl = WSP(int, WS_ROWL); float* roww = WSP(float, WS_ROWW); int* tile_e = WSP(int, WS_TILEE);
    const int nrt = tb[NE];
    for (int i = C.bid * 512 + C.tid; i < NLAT * 8; i += C.G * 512) { const int e = tope[i]; const int pr = tb[e] * 256 + pos[i]; rowl[pr] = i; roww[pr] = topw[i]; }
    for (int e = C.bid; e < NE; e += C.G) { const int n = (int)cnt[e * CNT_STRIDE], nt = tb[e + 1] - tb[e];
        for (int j = n + C.tid; j < nt * 256; j += 512) { rowl[tb[e] * 256 + j] = -1; roww[tb[e] * 256 + j] = 0.f; }
        for (int k = C.tid; k < nt; k += 512) tile_e[tb[e] + k] = e; }
    for (int i = C.bid * 512 + C.tid; i < NLAT; i += C.G * 512) { rowl[nrt * 256 + i] = i; roww[nrt * 256 + i] = 1.f; }
    for (int k = C.bid * 512 + C.tid; k < NLAT / 256; k += C.G * 512) tile_e[nrt + k] = NE;
    __syncthreads();
}

__device__ __forceinline__ void phase_moe(const Args& A, Ctx& C, int dry_shared) {
    LAS int* tb = (LAS int*)(C.lds + 131072);
    LAS int* tbl = tb + 320;
    tile_prefix(A, C, tb);
    pg8::MoeCtx M;
    M.nrt = tb[NE]; M.ntiles = M.nrt + NLAT / 256; M.G = C.G; M.vc = (C.G % 8 == 0) ? (C.bid % 8) * (C.G / 8) + C.bid / 8 : C.bid;
    M.tb = tb; M.tbl = tbl; M.cnt = WSP(unsigned, WS_CTL) + CW_CNT; M.rowl = WSP(int, WS_ROWL); M.roww = WSP(float, WS_ROWW);
    M.wexp = (const char*)(A.ws + WS_WEXP); M.h2n = (const char*)(A.ws + WS_H2N8); M.Hs = (char*)(A.ws + WS_HS) + (size_t)C.bid * 2 * 65536;
    M.Y = (unsigned char*)(A.ws + WS_Y); M.out = A.out; M.mod = WSP(const float, WS_MOD); M.dry_shared = dry_shared;
    pg8::gemm_moe(C.lds, M);
    __syncthreads();
}

__device__ __forceinline__ void phase_final(const Args& A, Ctx& C, float* dst) {
    const int gw = C.bid * 8 + C.wave, NGW = C.G * 8;
    const float* fg = A.in[I_FG]; const float* mod = WSP(const float, WS_MOD);
    const unsigned* Y = (const unsigned*)(A.ws + WS_Y);
    for (int row = gw; row < NLAT; row += NGW) {
        f32x4* xr = (f32x4*)(A.out + (size_t)row * D) + C.lane;
        const f32x4* gt = (const f32x4*)(mod + (size_t)(row >> 11) * MODW + 5 * D) + C.lane;
        const unsigned* yr = Y + (size_t)row * 8 * (D / 4) + C.lane;
        f32x4 v[4]; float s = 0.f;
#pragma unroll
        for (int j = 0; j < 4; ++j) {
            f32x4 a = (f32x4){0.f, 0.f, 0.f, 0.f};
#pragma unroll
            for (int sl = 0; sl < 8; ++sl) { const unsigned w = yr[sl * (D / 4) + 64 * j];
                const f32x2 lo = __builtin_amdgcn_cvt_pk_f32_fp8(w, false), hi = __builtin_amdgcn_cvt_pk_f32_fp8(w, true);
                a.x += lo.x; a.y += lo.y; a.z += hi.x; a.w += hi.y; }
            v[j] = xr[64 * j] + gt[64 * j] * a * (1.f / pg8::YSCALE);
            s += (v[j].x * v[j].x + v[j].y * v[j].y) + (v[j].z * v[j].z + v[j].w * v[j].w); }
        const float rstd = __builtin_amdgcn_rsqf(wave_sum(s) * (1.f / D) + NORM_EPS);
        f32x4* orow = (f32x4*)(dst + (size_t)row * D) + C.lane;
#pragma unroll
        for (int j = 0; j < 4; ++j) orow[64 * j] = v[j] * rstd * ((const f32x4*)fg)[C.lane + 64 * j];
    }
}

constexpr int NPHASE = 13;
__global__ void __launch_bounds__(512, 2) fwd_kernel(Args A) {
    extern __shared__ __attribute__((aligned(16))) unsigned char lds_raw[];
    Ctx C; C.lds = (lbyte*)lds_raw; C.tid = threadIdx.x; C.lane = C.tid & 63; C.wave = __builtin_amdgcn_readfirstlane(C.tid >> 6);
    C.G = gridDim.x; C.bid = blockIdx.x; C.a = &A;
    volatile LAS unsigned* misc = (volatile LAS unsigned*)(C.lds + LDS_MISC);
    if (C.tid < 16) misc[C.tid] = 0u;
    __syncthreads();
    XcdBarrier bar; bar.bar = WSP(unsigned, WS_CTL) + CW_BAR; bar.x = 0; bar.st = nullptr;
    const int lo = A.ph_lo, hi = A.ph_hi;
    const bool multi = (hi - lo) > 1;
    if (multi) bar = xcd_barrier_post(WSP(unsigned, WS_CTL) + CW_BAR, misc);
#ifndef PHASE_MASK
#define PHASE_MASK 0x1FFF
#endif
#define IN(k) (((PHASE_MASK >> (k)) & 1) && lo <= (k) && (k) < hi)
#define SEAM(k) do { if (IN(k) && IN((k) + 1)) xcd_barrier(bar); } while (0)
#ifndef REP_MASK
#define REP_MASK 0
#endif
#define REPS(k) (((REP_MASK >> (k)) & 1) ? 2 : 1)

    if (IN(0)) _Pragma("unroll") for (int rep = 0; rep < REPS(0); ++rep) { phase_p0(A, C); __syncthreads(); } SEAM(0);
    if (IN(1)) _Pragma("unroll") for (int rep = 0; rep < REPS(1); ++rep) { phase_p1(A, C); } SEAM(1);
    if (IN(2)) _Pragma("unroll") for (int rep = 0; rep < REPS(2); ++rep) {
        pg8::Gemm g{WSP(bf16_t, WS_XN), D}; pg8::StaticOrder S; S.init(NROWS, PLD, C.G, C.bid, WSP(bf16_t, WS_BTIN), D, 1);
        pg8::EpiBf16 E{WSP(bf16_t, WS_P), PLD, 1.f / SWIN};
        pg8::gemm_phase<pg8::EpiBf16, pg8::StaticOrder, false, 0, false, true>(C.lds, g, S, E);
    } SEAM(2);
    if (IN(3)) _Pragma("unroll") for (int rep = 0; rep < REPS(3); ++rep) { phase_gdn_prep(A, C); } SEAM(3);
#ifdef PROBE_BARRIERS
    if (multi) for (int kq = 0; kq < PROBE_BARRIERS; ++kq) xcd_barrier(bar);
#endif
    if (IN(4)) {
        for (int ch = C.bid; ch < NB * HB * 2; ch += C.G) gdn_chain_chunked(A, C, ch);
        for (int pr = C.bid; pr < NB * HA; pr += C.G) rwkv_pair_chunked(A, C, pr);
    } SEAM(4);
    if (IN(5)) _Pragma("unroll") for (int rep = 0; rep < REPS(5); ++rep) { phase_p4(A, C); } SEAM(5);
    if (IN(6)) _Pragma("unroll") for (int rep = 0; rep < REPS(6); ++rep) {
        pg8::Gemm g{WSP(bf16_t, WS_YMIX), D}; pg8::StaticOrder S; S.init(NLAT, D, C.G, C.bid, WSP(bf16_t, WS_BTOUT), D);
        pg8::EpiResGate E{A.in[I_X], A.out, WSP(float, WS_MOD), 2 * D};
        pg8::gemm_phase<pg8::EpiResGate, pg8::StaticOrder, false>(C.lds, g, S, E);
    } SEAM(6);
    if (IN(7)) _Pragma("unroll") for (int rep = 0; rep < REPS(7); ++rep) { phase_p6(A, C); __syncthreads(); convert_experts(A, C); __syncthreads(); } SEAM(7);
    if (IN(8)) _Pragma("unroll") for (int rep = 0; rep < REPS(8); ++rep) {
        pg8::Gemm g{WSP(bf16_t, WS_H2N), D}; pg8::StaticOrder S; S.init(NLAT, NE, C.G, C.bid, WSP(bf16_t, WS_BTR), D);
        pg8::EpiF32 E{WSP(float, WS_LOGIT), NE};
        pg8::gemm_phase<pg8::EpiF32, pg8::StaticOrder, false>(C.lds, g, S, E);
    } SEAM(8);
    if (IN(9)) { phase_p8(A, C); } SEAM(9);
    if (IN(10)) _Pragma("unroll") for (int rep = 0; rep < REPS(10); ++rep) { phase_p9(A, C); } SEAM(10);
    if (IN(11)) { phase_moe(A, C, 0); if (REPS(11) > 1) { __syncthreads(); phase_moe(A, C, 1); } } SEAM(11);
    if (IN(12)) { if (REPS(12) > 1) { phase_final(A, C, (float*)(A.ws + WS_WEXP)); __syncthreads(); } phase_final(A, C, A.out); }
#undef IN
#undef SEAM
}

extern "C" void kernel_launch(void* const* d_in, const int* in_sizes, int n_in, void* d_out, int out_size, void* d_ws, size_t ws_size, hipStream_t stream) {
    static int grid = 0;
    if (grid == 0) {
        if (n_in != 34 || out_size != NLAT * D || ws_size < WS_END) { fprintf(stderr, "kernel_launch: unexpected shapes (n_in %d out %d ws %zu need %zu)\n", n_in, out_size, ws_size, (size_t)WS_END); grid = -1; return; }
        int dev = 0, cus = 0;
        if (hipGetDevice(&dev) != hipSuccess || hipDeviceGetAttribute(&cus, hipDeviceAttributeMultiprocessorCount, dev) != hipSuccess) { grid = -1; return; }
        if (hipFuncSetAttribute((const void*)fwd_kernel, hipFuncAttributeMaxDynamicSharedMemorySize, LDS_BYTES) != hipSuccess) { fprintf(stderr, "kernel_launch: hipFuncSetAttribute failed\n"); grid = -1; return; }
        int per_cu = 0;
        if (hipOccupancyMaxActiveBlocksPerMultiprocessor(&per_cu, (const void*)fwd_kernel, 512, LDS_BYTES) != hipSuccess || per_cu < 1) { fprintf(stderr, "kernel_launch: occupancy query says %d\n", per_cu); }
        (void)hipGetLastError();
        grid = cus;
    }
    if (grid < 0) return;
    (void)hipMemsetAsync((char*)d_ws + WS_CTL, 0, CTL_BYTES, stream);
    Args a{};
    for (int i = 0; i < 34; ++i) a.in[i] = (const float*)d_in[i];
    a.out = (float*)d_out; a.ws = (unsigned char*)d_ws;
#if MK_PER_PHASE
    for (int p = 0; p < NPHASE; ++p) { a.ph_lo = p; a.ph_hi = p + 1; hipLaunchKernelGGL(fwd_kernel, dim3(grid), dim3(512), LDS_BYTES, stream, a); }
#else
    a.ph_lo = 0; a.ph_hi = NPHASE; hipLaunchKernelGGL(fwd_kernel, dim3(grid), dim3(512), LDS_BYTES, stream, a);
#endif
}
```

```cpp
#include <hip/hip_runtime.h>
#include <cstdio>
#include <cstdint>

#ifndef MK_PER_PHASE
#define MK_PER_PHASE 0
#endif

#define LAS __attribute__((address_space(3)))
typedef unsigned short bf16_t;
typedef short bf16x8 __attribute__((ext_vector_type(8)));
typedef float f32x4 __attribute__((ext_vector_type(4)));
typedef float f32x2 __attribute__((ext_vector_type(2)));
typedef unsigned u32x4 __attribute__((ext_vector_type(4)));
typedef unsigned u32x2 __attribute__((ext_vector_type(2)));
typedef int i32x4 __attribute__((ext_vector_type(4)));
typedef int i32x8 __attribute__((ext_vector_type(8)));
typedef LAS float lfloat;
typedef LAS unsigned char lbyte;

constexpr int D = 1024, NB = 32, SEQ = 2048, CTX = 256, GW = 64;
constexpr int NLAT = NB * SEQ;
constexpr int NCTX = NB * CTX;
constexpr int NROWS = NLAT + NCTX;
constexpr int DA = 512, HA = 8, NA = 64;
constexpr int RW_COLS = 1920, GD_COLS = 2064, IN_COLS = 3984, PLD = 4096;
constexpr int DB = 512, HB = 4, KB = 128;
constexpr int NE = 256, TOPK = 8, DE = 256;
constexpr int MODW = 6 * D;
constexpr float NORM_EPS = 1e-6f, RWKV_EPS = 64e-5f;
constexpr int MAXTILES = (NLAT * TOPK + NE * 255) / 256 + 1;

constexpr size_t MiB = 1u << 20;
constexpr size_t WS_CTL = 0, CTL_BYTES = 1 * MiB;
constexpr size_t WS_MOD = 1 * MiB;
constexpr size_t WS_BTIN = 2 * MiB, WS_BTOUT = 10 * MiB, WS_BTR = 12 * MiB, WS_BON = 13 * MiB, WS_GUPT = 17 * MiB, WS_NRM = 978 * MiB;
constexpr size_t WS_P = 18 * MiB, WS_XN = 594 * MiB, WS_YDIR = 594 * MiB, WS_YMIX = 850 * MiB;
constexpr size_t WS_H2N8 = 900 * MiB;
constexpr size_t WS_H2N = 18 * MiB, WS_LOGIT = 146 * MiB, WS_TOPE = 210 * MiB, WS_TOPW = 212 * MiB, WS_POS = 214 * MiB, WS_Y = 146 * MiB;
constexpr size_t WS_ROWL = 658 * MiB, WS_ROWW = 661 * MiB, WS_TILEE = 664 * MiB, WS_HS = 672 * MiB, WS_WEXP = 704 * MiB;
constexpr size_t WEXP_STRIDE = (size_t)(512 * 1024 + 1024 * 256);
constexpr float SW13 = 64.f, SW2 = 32.f, SHS = 8.f, SWIN = 32.f;
constexpr size_t WS_END = 1090 * MiB;
static_assert(WS_WEXP + 257 * WEXP_STRIDE <= WS_END && WS_Y + (size_t)NLAT * 8 * D <= WS_ROWL, "ws map");
constexpr int CW_BAR = 4096;
constexpr int CW_CNT = 16384;
constexpr int CNT_STRIDE = 32;

constexpr int LDS_BYTES = 159744;
constexpr int LDS_MISC = LDS_BYTES - 64;

__device__ __forceinline__ unsigned f2bf(float f) { unsigned u = __builtin_bit_cast(unsigned, f); return (u + 0x7fffu + ((u >> 16) & 1u)) >> 16; }
typedef __bf16 bf16x2_t __attribute__((ext_vector_type(2)));
__device__ __forceinline__ unsigned cvtpk(float lo, float hi) { f32x2 v = {lo, hi}; return __builtin_bit_cast(unsigned, __builtin_convertvector(v, bf16x2_t)); }
__device__ __forceinline__ unsigned pk2(float lo, float hi) { return cvtpk(lo, hi); }
__device__ __forceinline__ unsigned pk4_fp8(float a, float b, float c, float d) { unsigned w = 0u;
    w = __builtin_amdgcn_cvt_pk_fp8_f32(__builtin_amdgcn_fmed3f(a, -448.f, 448.f), __builtin_amdgcn_fmed3f(b, -448.f, 448.f), w, false);
    w = __builtin_amdgcn_cvt_pk_fp8_f32(__builtin_amdgcn_fmed3f(c, -448.f, 448.f), __builtin_amdgcn_fmed3f(d, -448.f, 448.f), w, true); return w; }
__device__ __forceinline__ float bf2f(unsigned short b) { return __builtin_bit_cast(float, ((unsigned)b) << 16); }
__device__ __forceinline__ float bflo(unsigned w) { return __builtin_bit_cast(float, w << 16); }
__device__ __forceinline__ float bfhi(unsigned w) { return __builtin_bit_cast(float, w & 0xffff0000u); }
template <int CTRL> __device__ __forceinline__ float dpp_f(float v) { return __builtin_bit_cast(float, __builtin_amdgcn_update_dpp(0, __builtin_bit_cast(int, v), CTRL, 0xf, 0xf, false)); }
__device__ __forceinline__ float wave_sum(float v) {
    v += dpp_f<0x128>(v);
    v += dpp_f<0x124>(v);
    v += dpp_f<0x122>(v);
    v += dpp_f<0x121>(v);
    const int vi = __builtin_bit_cast(int, v);
    const float r0 = __builtin_bit_cast(float, __builtin_amdgcn_readlane(vi, 0)), r1 = __builtin_bit_cast(float, __builtin_amdgcn_readlane(vi, 16)),
                r2 = __builtin_bit_cast(float, __builtin_amdgcn_readlane(vi, 32)), r3 = __builtin_bit_cast(float, __builtin_amdgcn_readlane(vi, 48));
    return (r0 + r1) + (r2 + r3);
}
__device__ __forceinline__ float sigmoidf_(float x) { return __builtin_amdgcn_rcpf(1.f + __expf(-x)); }
__device__ __forceinline__ float siluf_(float x) { return x * __builtin_amdgcn_rcpf(1.f + __expf(-x)); }
__device__ __forceinline__ float softplusf_(float x) { return fmaxf(x, 0.f) + __logf(1.f + __expf(-fabsf(x))); }
__device__ __forceinline__ float tanhf_(float x) { const float e = __expf(-2.f * fabsf(x)); const float t = (1.f - e) * __builtin_amdgcn_rcpf(1.f + e); return x < 0.f ? -t : t; }

#define XB_TMO      128
#define XB_XCNT(j)  (256  + 64 * (j))
#define XB_XSUB(j)  (1280 + 64 * (j))
#define XB_XGEN(j)  (2304 + 64 * (j))
#define XB_TOP      3328
#define XB_TOPGEN   3392
#define XCD_BAR_WORDS 3456
#define XB_SPIN_CAP (1u << 22)
__device__ __forceinline__ unsigned xb_ld(unsigned* p)              { return __hip_atomic_load(p, __ATOMIC_RELAXED, __HIP_MEMORY_SCOPE_AGENT); }
__device__ __forceinline__ unsigned xb_add(unsigned* p, unsigned v) { return __hip_atomic_fetch_add(p, v, __ATOMIC_RELAXED, __HIP_MEMORY_SCOPE_AGENT); }
__device__ __forceinline__ unsigned xb_xcc_id() { return (unsigned)__builtin_amdgcn_s_getreg((3 << 11) | 20) & 0xFu; }
#define XB_SPIN(cond, bar) do { unsigned _sp = 0; while (cond) { __builtin_amdgcn_s_sleep(1); \
    if ((++_sp & 255u) == 0u) { if (xb_ld(&(bar)[XB_TMO])) break; if (_sp > XB_SPIN_CAP) { atomicAdd(&(bar)[XB_TMO], 1u); break; } } } } while (0)
struct XcdBarrier { unsigned* bar; unsigned x; volatile LAS unsigned* st; };
__device__ __forceinline__ XcdBarrier xcd_barrier_post(unsigned* bar, volatile LAS unsigned* st) {
    XcdBarrier b; b.bar = bar; b.x = xb_xcc_id(); b.st = st;
    if (threadIdx.x == 0) (void)xb_add(&bar[XB_XCNT(b.x)], 1u);
    return b;
}
__device__ __forceinline__ void xcd_barrier_complete(unsigned* bar, unsigned x, unsigned& nloc, unsigned& nx) {
    const unsigned G = gridDim.x * gridDim.y * gridDim.z;
    unsigned sum, cnt, mine, sp = 0u;
    for (;;) {
        sum = 0u; cnt = 0u; mine = 0u;
#pragma unroll
        for (unsigned j = 0; j < 16; ++j) { const unsigned c = xb_ld(&bar[XB_XCNT(j)]); sum += c; cnt += (c > 0u) ? 1u : 0u; mine = (j == x) ? c : mine; }
        if (sum == G) break;
        __builtin_amdgcn_s_sleep(1);
        if ((++sp & 255u) == 0u) { if (xb_ld(&bar[XB_TMO])) break; if (sp > XB_SPIN_CAP) { atomicAdd(&bar[XB_TMO], 1u); break; } }
    }
    nloc = mine > 0u ? mine : 1u; nx = cnt > 0u ? cnt : 1u;
}
__device__ __forceinline__ void xcd_barrier(const XcdBarrier& b) {
    asm volatile("s_waitcnt vmcnt(0)" ::: "memory");
    __syncthreads();
    if (threadIdx.x == 0) {
        unsigned* bar = b.bar;
        __builtin_amdgcn_s_waitcnt(0);
        unsigned nloc = b.st[0], nx = b.st[1];
        if (nloc == 0u) { xcd_barrier_complete(bar, b.x, nloc, nx); b.st[0] = nloc; b.st[1] = nx; }
        const unsigned old = xb_add(&bar[XB_XSUB(b.x)], 1u);
        const unsigned gen = old / nloc;
        if (old + 1u == (gen + 1u) * nloc) {
            __builtin_amdgcn_fence(__ATOMIC_RELEASE, "agent");
            asm volatile("s_waitcnt vmcnt(0)" ::: "memory");
            const unsigned og = xb_add(&bar[XB_TOP], 1u);
            const unsigned tg = og / nx;
            if (og + 1u == (tg + 1u) * nx) xb_add(&bar[XB_TOPGEN], 1u);
            else XB_SPIN(xb_ld(&bar[XB_TOPGEN]) == tg, bar);
            __builtin_amdgcn_fence(__ATOMIC_ACQUIRE, "agent");
            xb_add(&bar[XB_XGEN(b.x)], 1u);
            asm volatile("s_waitcnt vmcnt(0)" ::: "memory");
        } else {
            XB_SPIN(xb_ld(&bar[XB_XGEN(b.x)]) == gen, bar);
            __builtin_amdgcn_fence(__ATOMIC_ACQUIRE, "agent");
            asm volatile("s_waitcnt vmcnt(0)" ::: "memory");
        }
    }
    __syncthreads();
}

struct Args {
    const float* in[34];
    float* out;
    unsigned char* ws;
    int ph_lo, ph_hi;
};
enum { I_X = 0, I_C, I_CTX, I_CCTX, I_WADA, I_BADA, I_N1G, I_WIN, I_MU, I_W0, I_WUP, I_A0, I_AUP, I_GUP, I_KK, I_KA, I_RK, I_LNW, I_LNB,
       I_CONVW, I_ALOG, I_DTB, I_ONG, I_WOUT, I_N2G, I_RW, I_RB, I_EW1, I_EW3, I_EW2, I_SW1, I_SW3, I_SW2, I_FG };

namespace pg8 {
constexpr int BM = 256, BK = 64, HALF = 128, HTB = HALF * BK * 2, STAGE_BYTES = 8 * HTB, NXCD = 8, WGM = 8;
__host__ __device__ __forceinline__ int lds_byte(int r, int c) { const int st = (r >> 4) * 2 + (c >> 5), rr = r & 15, cc = c & 31, ob = rr * 64 + cc * 2; return st * 1024 + (ob ^ (((ob >> 9) & 1) << 5)); }
__host__ __device__ __forceinline__ void stage_rc(int b, int& R, int& C) { const int st = b / 1024, sb = b % 1024, swz = sb ^ (((sb >> 9) & 1) << 5); R = (st >> 1) * 16 + swz / 64; C = (st & 1) * 32 + (swz % 64) / 2; }
__host__ __device__ __forceinline__ int perm32(int rho) { const int n = rho >> 4, i = rho & 15; return 8 * (i >> 2) + 4 * n + (i & 3); }
struct Unit { int pm, pn; };
struct Gemm { const bf16_t* A; int K; };
struct StaticOrder {
    int nM, nN, nwg, G, c; const char* Bt; size_t tstepB;
    __device__ void init(int M, int N, int G_, int c_, const void* Bt_, int K, int es = 2) { nM = M / BM; nN = N / BM; nwg = nM * nN; G = G_; c = c_; Bt = (const char*)Bt_; tstepB = (size_t)BM * K * es; }
    __device__ bool next(int i, Unit& u) const {
        const long L = (long)i * G + c; if (L >= nwg) return false;
        int wgid = (int)L; { const int q = nwg / NXCD, r = nwg % NXCD, xcd = wgid % NXCD, off = wgid / NXCD; wgid = (xcd < r ? xcd * (q + 1) : r * (q + 1) + (xcd - r) * q) + off; }
        const int nig = WGM * nN, gid = wgid / nig, fm = gid * WGM, gsz = (nM - fm) < WGM ? (nM - fm) : WGM;
        u.pm = fm + ((wgid % nig) % gsz); u.pn = (wgid % nig) / gsz; return true;
    }
    __device__ __forceinline__ const char* bptr(const Unit& u) const { return Bt + (size_t)u.pn * tstepB; }
    __device__ __forceinline__ int rowsel(const Unit&, int) const { return 0; }
};
struct TileOrder {
    int nunits, npn, G, c; const int* tile_e; const char* wbase; size_t wstride, woff, tstepB; const int* rowl;
    __device__ bool next(int i, Unit& u) const { const int L = i * G + c; if (L >= nunits) return false; u.pm = L / npn; u.pn = L - u.pm * npn; return true; }
    __device__ __forceinline__ const char* bptr(const Unit& u) const { const int e = __builtin_amdgcn_readfirstlane(tile_e[u.pm]); return wbase + (size_t)e * wstride + woff + (size_t)u.pn * tstepB; }
    __device__ __forceinline__ int rowsel(const Unit& u, int r) const { const int t = rowl[(size_t)u.pm * 256 + r]; return t < 0 ? 0 : t; }
};
struct SeqOrder {
    int n; const char* Bt; size_t tstepB; const LAS int* rsel;
    __device__ bool next(int i, Unit& u) const { if (i >= n) return false; u.pm = 0; u.pn = i; return true; }
    __device__ __forceinline__ const char* bptr(const Unit& u) const { return Bt + (size_t)u.pn * tstepB; }
    __device__ __forceinline__ int rowsel(const Unit&, int r) const { return rsel[r]; }
};
__device__ __forceinline__ unsigned cvt_pk_bf16(float lo, float hi) { return cvtpk(lo, hi); }

template <class Epi, class Sched, bool GATHER, int A_AUX = 0, bool ALIGN = true, bool FP8 = false>
__device__ __forceinline__ void gemm_phase(lbyte* lds, const Gemm g, const Sched& S, const Epi& E) {
    int tid_ = threadIdx.x; asm volatile("" : "+v"(tid_));
    const int tid = tid_, wid = __builtin_amdgcn_readfirstlane(tid >> 6), lane = tid & 63, wr = wid >> 2, wc = wid & 3, fr = lane & 15, fq = lane >> 4;
    constexpr unsigned ES = FP8 ? 1u : 2u;
    const int K = g.K, nt = FP8 ? K / 128 : K / BK;
    Unit cur, nxt; int ui = 0;
    if (!S.next(0, cur)) return;
    int Rst[2], Cst[2];
    unsigned voffA[2], voffA1[2], voffB[2], nvA[2], nvA1[2];
#pragma unroll
    for (int i = 0; i < 2; ++i) { int R, C; stage_rc(tid * 16 + i * 8192, R, C); const int Rb = Epi::PERM ? ((R & ~31) + perm32(R & 31)) : R; Rst[i] = R; Cst[i] = C;
        if (GATHER) { voffA[i] = (unsigned)S.rowsel(cur, R) * (unsigned)K * ES + (unsigned)C * 2u; voffA1[i] = (unsigned)S.rowsel(cur, 128 + R) * (unsigned)K * ES + (unsigned)C * 2u; }
        else { voffA[i] = (unsigned)(R * K) * ES + (unsigned)C * 2u; voffA1[i] = voffA[i]; }
        nvA[i] = voffA[i]; nvA1[i] = voffA1[i];
        voffB[i] = (unsigned)(Rb * K) * ES + (unsigned)C * 2u; }
    const size_t kstep = (size_t)(BK * 2);
    const size_t hstep = (size_t)HALF * K * ES;
    const size_t hstepA = GATHER ? 0 : hstep;
    const size_t tstep = 2 * hstep;
    const unsigned ldsw = (unsigned)wid * 1024u;
    const int aoff = lds_byte(wr * 64 + fr, fq * 8), boff = lds_byte(wc * 32 + fr, fq * 8);
#define PG8_SA(b, h) (((b) * 2 + (h)) * HTB)
#define PG8_SB(b, h) ((4 + (b) * 2 + (h)) * HTB)
#define PG8_STAGE2(bufoff, gbase, v0, v1) do { \
        __builtin_amdgcn_global_load_lds((const unsigned*)((const char*)(gbase) + (v0)), (LAS unsigned*)(lds + (bufoff) + ldsw), 16, 0, 0); \
        __builtin_amdgcn_global_load_lds((const unsigned*)((const char*)(gbase) + (v1)), (LAS unsigned*)(lds + (bufoff) + ldsw + 8192), 16, 0, 0); } while (0)
#define PG8_STAGE2A(bufoff, gbase, v0, v1) do { if constexpr (A_AUX == 16) { \
        __builtin_amdgcn_global_load_lds((const unsigned*)((const char*)(gbase) + (v0)), (LAS unsigned*)(lds + (bufoff) + ldsw), 16, 0, 16); \
        __builtin_amdgcn_global_load_lds((const unsigned*)((const char*)(gbase) + (v1)), (LAS unsigned*)(lds + (bufoff) + ldsw + 8192), 16, 0, 16); } else { PG8_STAGE2(bufoff, gbase, v0, v1); } } while (0)
#define PG8_STAGE(bufoff, gbase, voff) PG8_STAGE2(bufoff, gbase, (voff)[0], (voff)[1])
#define PG8_STAGEA(bufoff, gbase, voff) PG8_STAGE2A(bufoff, gbase, (voff)[0], (voff)[1])
#define G_LD32(p) __builtin_shufflevector(*(const LAS i32x4*)(p), *(const LAS i32x4*)((p) + 1024), 0, 1, 2, 3, 4, 5, 6, 7)
#define G_MFMA8(c, a, b) asm volatile("v_mfma_scale_f32_16x16x128_f8f6f4 %0, %1, %2, %0, %3, %3 op_sel_hi:[0,0,0]" : "+v"(c) : "v"(a), "v"(b), "v"(one_scale))
#define PG8_LDA(dst, b, h) do { if constexpr (FP8) { _Pragma("unroll") for (int m = 0; m < 4; ++m) dst##8[m] = G_LD32(lds + PG8_SA(b, h) + aoff + m * 2048); } else { \
        _Pragma("unroll") for (int m = 0; m < 4; ++m) _Pragma("unroll") for (int k = 0; k < 2; ++k) dst[m][k] = *(const LAS bf16x8*)(lds + PG8_SA(b, h) + aoff + m * 2048 + k * 1024); } } while (0)
#define PG8_LDB(dst, b, h) do { if constexpr (FP8) { _Pragma("unroll") for (int n = 0; n < 2; ++n) dst##8[n] = G_LD32(lds + PG8_SB(b, h) + boff + n * 2048); } else { \
        _Pragma("unroll") for (int n = 0; n < 2; ++n) _Pragma("unroll") for (int k = 0; k < 2; ++k) dst[n][k] = *(const LAS bf16x8*)(lds + PG8_SB(b, h) + boff + n * 2048 + k * 1024); } } while (0)
#define PG8_MMA(ai, bj, At, Bt) do { __builtin_amdgcn_s_setprio(1); if constexpr (FP8) { _Pragma("unroll") for (int m = 0; m < 4; ++m) _Pragma("unroll") for (int n = 0; n < 2; ++n) G_MFMA8(acc[ai][bj][m][n], Bt##8[n], At##8[m]); } else { \
        _Pragma("unroll") for (int m = 0; m < 4; ++m) _Pragma("unroll") for (int n = 0; n < 2; ++n) _Pragma("unroll") for (int k = 0; k < 2; ++k) \
        acc[ai][bj][m][n] = __builtin_amdgcn_mfma_f32_16x16x32_bf16(Bt[n][k], At[m][k], acc[ai][bj][m][n], 0, 0, 0); } __builtin_amdgcn_s_setprio(0); } while (0)
#define PG8_WAIT_V(n) asm volatile("s_waitcnt vmcnt(" #n ")" ::: "memory")
#define PG8_WAIT_L(n) asm volatile("s_waitcnt lgkmcnt(" #n ")" ::: "memory")
#define PG8_BAR __builtin_amdgcn_s_barrier()
#define PG8_SCHED __builtin_amdgcn_sched_barrier(0)
    f32x4 acc[2][2][4][2];
#pragma unroll
    for (int a = 0; a < 2; ++a)
#pragma unroll
        for (int b = 0; b < 2; ++b)
#pragma unroll
            for (int m = 0; m < 4; ++m)
#pragma unroll
                for (int n = 0; n < 2; ++n) acc[a][b][m][n] = (f32x4){0.f, 0.f, 0.f, 0.f};
    bf16x8 At[4][2], B0[2][2], B1[2][2]; i32x8 At8[4], B08[2], B18[2];
    int one_scale = 0x7F7F7F7F; asm volatile("" : "+v"(one_scale));
    const char* cA = (const char*)g.A + (GATHER ? (size_t)0 : (size_t)cur.pm * tstep); const char* cB = S.bptr(cur);
    PG8_STAGE(PG8_SB(0, 0), cB, voffB); PG8_STAGE(PG8_SB(0, 1), cB + hstep, voffB); PG8_STAGEA(PG8_SA(0, 0), cA, voffA); PG8_STAGEA(PG8_SA(0, 1), cA + hstepA, voffA1);
    if (wr == 1) PG8_BAR;
    PG8_WAIT_V(2); PG8_BAR;
    PG8_STAGE(PG8_SB(1, 0), cB + kstep, voffB); PG8_STAGEA(PG8_SA(1, 0), cA + kstep, voffA); PG8_STAGE(PG8_SB(1, 1), cB + hstep + kstep, voffB);
    PG8_WAIT_V(6); PG8_BAR;
    for (;;) {
        const bool has_next = S.next(ui + 1, nxt);
        const char* nA = has_next ? (const char*)g.A + (GATHER ? (size_t)0 : (size_t)nxt.pm * tstep) : cA; const char* nB = has_next ? S.bptr(nxt) : cB;
        for (int t = 0; t < nt; t += 2) {
            const bool last = (t == nt - 2);
            const char* a1 = cA + (size_t)(t + 1) * kstep;
            const char* a2 = last ? nA : cA + (size_t)(t + 2) * kstep; const char* b2 = last ? nB : cB + (size_t)(t + 2) * kstep;
            const char* a3 = a2 + kstep; const char* b3 = b2 + kstep;
            if (GATHER && last && has_next) {
#pragma unroll
                for (int i = 0; i < 2; ++i) { nvA[i] = (unsigned)S.rowsel(nxt, Rst[i]) * (unsigned)K * ES + (unsigned)Cst[i] * 2u; nvA1[i] = (unsigned)S.rowsel(nxt, 128 + Rst[i]) * (unsigned)K * ES + (unsigned)Cst[i] * 2u; }
            }
            const unsigned x0 = (GATHER && last) ? nvA[0] : voffA[0], x1 = (GATHER && last) ? nvA[1] : voffA[1];
            const unsigned y0 = (GATHER && last) ? nvA1[0] : voffA1[0], y1 = (GATHER && last) ? nvA1[1] : voffA1[1];
            PG8_LDB(B0, 0, 0); PG8_LDB(B1, 0, 1); PG8_SCHED; PG8_LDA(At, 0, 0); PG8_STAGEA(PG8_SA(1, 1), a1 + hstepA, voffA1);
            PG8_WAIT_V(8); PG8_WAIT_L(0); PG8_BAR; PG8_MMA(0, 0, At, B0); PG8_MMA(0, 1, At, B1); PG8_BAR; PG8_SCHED;
            PG8_LDA(At, 0, 1); PG8_STAGE(PG8_SB(0, 0), b2, voffB); PG8_STAGE(PG8_SB(0, 1), b2 + hstep, voffB); PG8_STAGE2A(PG8_SA(0, 0), a2, x0, x1);
            PG8_WAIT_V(8); PG8_WAIT_L(0); PG8_BAR; PG8_MMA(1, 0, At, B0); PG8_MMA(1, 1, At, B1); PG8_BAR; PG8_SCHED;
            PG8_LDB(B0, 1, 0); PG8_LDB(B1, 1, 1); PG8_SCHED; PG8_LDA(At, 1, 0); PG8_STAGE2A(PG8_SA(0, 1), a2 + hstepA, y0, y1);
            PG8_WAIT_V(8); PG8_WAIT_L(0); PG8_BAR; PG8_MMA(0, 0, At, B0); PG8_MMA(0, 1, At, B1); PG8_BAR; PG8_SCHED;
            PG8_LDA(At, 1, 1); PG8_STAGE(PG8_SB(1, 0), b3, voffB); PG8_STAGE(PG8_SB(1, 1), b3 + hstep, voffB); PG8_STAGE2A(PG8_SA(1, 0), a3, x0, x1);
            PG8_WAIT_V(8); PG8_WAIT_L(0); PG8_BAR; PG8_MMA(1, 0, At, B0); PG8_MMA(1, 1, At, B1); PG8_BAR; PG8_SCHED;
        }
        if (ALIGN && wr == 0) PG8_BAR;
        if constexpr (FP8) asm volatile("s_nop 15\n\ts_nop 15" ::: "memory");
        E(acc, cur, wr, wc, fr, fq);
        if (!has_next) break;
#pragma unroll
        for (int a = 0; a < 2; ++a)
#pragma unroll
            for (int b = 0; b < 2; ++b)
#pragma unroll
                for (int m = 0; m < 4; ++m)
#pragma unroll
                    for (int n = 0; n < 2; ++n) acc[a][b][m][n] = (f32x4){0.f, 0.f, 0.f, 0.f};
        cur = nxt; cA = nA; cB = nB; ++ui;
        if (GATHER) { voffA[0] = nvA[0]; voffA[1] = nvA[1]; voffA1[0] = nvA1[0]; voffA1[1] = nvA1[1]; }
        if (ALIGN && wr == 1) PG8_BAR;
    }
    PG8_WAIT_V(0);
    if (!ALIGN && wr == 0) PG8_BAR;
    PG8_BAR;
#undef PG8_SA
#undef PG8_SB
#undef PG8_STAGE
#undef PG8_STAGE2
#undef PG8_STAGE2A
#undef PG8_STAGEA
#undef G_LD32
#undef G_MFMA8
#undef PG8_LDA
#undef PG8_LDB
#undef PG8_MMA
#undef PG8_WAIT_V
#undef PG8_WAIT_L
#undef PG8_BAR
#undef PG8_SCHED
}

struct EpiBf16 {
    static constexpr bool PERM = true;
    bf16_t* O; int ldc; float scale;
    __device__ __forceinline__ void operator()(const f32x4 (&acc)[2][2][4][2], const Unit& u, int wr, int wc, int fr, int fq) const {
        const int row0 = u.pm * BM + wr * 64 + fr; const int col0 = u.pn * BM + wc * 32 + 8 * fq;
#pragma unroll
        for (int ai = 0; ai < 2; ++ai)
#pragma unroll
            for (int m = 0; m < 4; ++m) { bf16_t* rowp = O + (size_t)(row0 + ai * HALF + m * 16) * ldc + col0;
#pragma unroll
                for (int bj = 0; bj < 2; ++bj) { const f32x4 v0 = acc[ai][bj][m][0] * scale, v1 = acc[ai][bj][m][1] * scale;
                    u32x4 w; w.x = cvt_pk_bf16(v0[0], v0[1]); w.y = cvt_pk_bf16(v0[2], v0[3]); w.z = cvt_pk_bf16(v1[0], v1[1]); w.w = cvt_pk_bf16(v1[2], v1[3]);
                    *(u32x4*)(rowp + bj * HALF) = w; } }
    }
};
struct EpiF32 {
    static constexpr bool PERM = false;
    float* C; int ldc;
    __device__ __forceinline__ void operator()(const f32x4 (&acc)[2][2][4][2], const Unit& u, int wr, int wc, int fr, int fq) const {
        const int row0 = u.pm * BM + wr * 64 + fr, col0 = u.pn * BM + wc * 32 + 4 * fq;
#pragma unroll
        for (int ai = 0; ai < 2; ++ai)
#pragma unroll
            for (int m = 0; m < 4; ++m) { float* rowp = C + (size_t)(row0 + ai * HALF + m * 16) * ldc + col0;
#pragma unroll
                for (int bj = 0; bj < 2; ++bj)
#pragma unroll
                    for (int n = 0; n < 2; ++n) *(f32x4*)(rowp + bj * HALF + n * 16) = acc[ai][bj][m][n]; }
    }
};
struct EpiResGate {
    static constexpr bool PERM = false;
    const float* x; float* out; const float* mod; int gate_off;
    __device__ __forceinline__ void operator()(const f32x4 (&acc)[2][2][4][2], const Unit& u, int wr, int wc, int fr, int fq) const {
        const int row0 = u.pm * BM + wr * 64 + fr, col0 = u.pn * BM + wc * 32 + 4 * fq;
        const float* gp = mod + (size_t)((u.pm * BM) >> 11) * MODW + gate_off + col0;
        f32x4 gv[2][2];
#pragma unroll
        for (int bj = 0; bj < 2; ++bj)
#pragma unroll
            for (int n = 0; n < 2; ++n) gv[bj][n] = *(const f32x4*)(gp + bj * HALF + n * 16);
#pragma unroll
        for (int ai = 0; ai < 2; ++ai)
#pragma unroll
            for (int m = 0; m < 4; ++m) { const size_t off = (size_t)(row0 + ai * HALF + m * 16) * D + col0;
#pragma unroll
                for (int bj = 0; bj < 2; ++bj)
#pragma unroll
                    for (int n = 0; n < 2; ++n) { const f32x4 xv = *(const f32x4*)(x + off + bj * HALF + n * 16);
                        *(f32x4*)(out + off + bj * HALF + n * 16) = xv + gv[bj][n] * acc[ai][bj][m][n]; }
                asm volatile("" ::: "memory"); }
    }
};
struct EpiGLU {
    static constexpr bool PERM = true;
    bf16_t* H;
    __device__ __forceinline__ void operator()(const f32x4 (&acc)[2][2][4][2], const Unit& u, int wr, int wc, int fr, int fq) const {
        const int row0 = u.pm * BM + wr * 64 + fr; const int col0 = u.pn * 128 + wc * 32 + 8 * fq;
#pragma unroll
        for (int ai = 0; ai < 2; ++ai)
#pragma unroll
            for (int m = 0; m < 4; ++m) { bf16_t* rowp = H + (size_t)(row0 + ai * HALF + m * 16) * 256 + col0;
                f32x4 h0, h1;
#pragma unroll
                for (int j = 0; j < 4; ++j) { const float a0 = acc[ai][0][m][0][j], a1 = acc[ai][0][m][1][j];
                    h0[j] = siluf_(a0) * acc[ai][1][m][0][j]; h1[j] = siluf_(a1) * acc[ai][1][m][1][j]; }
                u32x4 w; w.x = cvt_pk_bf16(h0[0], h0[1]); w.y = cvt_pk_bf16(h0[2], h0[3]); w.z = cvt_pk_bf16(h1[0], h1[1]); w.w = cvt_pk_bf16(h1[2], h1[3]);
                *(u32x4*)rowp = w; }
    }
};
constexpr float YSCALE = 8.f;
struct EpiY {
    static constexpr bool PERM = true;
    unsigned char* Y; float* out; const float* mod; const LAS int* rtok; const LAS float* rw; int shared;
    __device__ __forceinline__ void operator()(const f32x4 (&acc)[2][2][4][2], const Unit& u, int wr, int wc, int fr, int fq) const {
        const int col0 = u.pn * BM + wc * 32 + 8 * fq;
#pragma unroll
        for (int ai = 0; ai < 2; ++ai)
#pragma unroll
            for (int m = 0; m < 4; ++m) { const int r = wr * 64 + fr + ai * HALF + m * 16; const int ts = rtok[r]; const float w = rw[r];
                if (ts >= 0) {
                    if (shared) { const unsigned goff = (unsigned)(ts >> 11) * MODW + 5 * D + col0; const unsigned ooff = (unsigned)ts * D + col0;
#pragma unroll
                        for (int bj = 0; bj < 2; ++bj)
#pragma unroll
                            for (int n = 0; n < 2; ++n) { const f32x4 gv = *(const f32x4*)(mod + goff + bj * HALF + n * 4); f32x4* op = (f32x4*)(out + ooff + bj * HALF + n * 4);
                                *op = *op + gv * acc[ai][bj][m][n]; }
                    } else { unsigned char* yp = Y + (size_t)(unsigned)ts * D + col0; const float ws_ = w * YSCALE;
#pragma unroll
                        for (int bj = 0; bj < 2; ++bj) { f32x4 v0 = acc[ai][bj][m][0] * ws_, v1 = acc[ai][bj][m][1] * ws_;
#pragma unroll
                                for (int j = 0; j < 4; ++j) { v0[j] = __builtin_amdgcn_fmed3f(v0[j], -448.f, 448.f); v1[j] = __builtin_amdgcn_fmed3f(v1[j], -448.f, 448.f); }
                            unsigned lo = 0u, hi = 0u;
                            lo = __builtin_amdgcn_cvt_pk_fp8_f32(v0[0], v0[1], lo, false); lo = __builtin_amdgcn_cvt_pk_fp8_f32(v0[2], v0[3], lo, true);
                            hi = __builtin_amdgcn_cvt_pk_fp8_f32(v1[0], v1[1], hi, false); hi = __builtin_amdgcn_cvt_pk_fp8_f32(v1[2], v1[3], hi, true);
                            u32x2 pk; pk.x = lo; pk.y = hi; *(u32x2*)(yp + bj * HALF) = pk; } } }
                asm volatile("" ::: "memory"); }
    }
};

struct MoeCtx {
    int ntiles, nrt, G, vc;
    const LAS int* tb; LAS int* tbl;
    const unsigned* cnt; const int* rowl; const float* roww;
    const char* wexp; const char* h2n; char* Hs; unsigned char* Y; float* out; const float* mod; int dry_shared;
};
__device__ __forceinline__ void gemm_moe(lbyte* lds, const MoeCtx& M) {
    int tid_ = threadIdx.x; asm volatile("" : "+v"(tid_));
    const int tid = tid_, wid = __builtin_amdgcn_readfirstlane(tid >> 6), lane = tid & 63, wr = wid >> 2, wc = wid & 3, fr = lane & 15, fq = lane >> 4;
    const int ntl = (M.ntiles - M.vc + M.G - 1) / M.G;
    if (M.vc >= M.ntiles) return;
    const int nunits = ntl * 6;
    const unsigned ldsw = (unsigned)wid * 1024u;
    const int aoff = lds_byte(wr * 64 + fr, fq * 8), boff = lds_byte(wc * 32 + fr, fq * 8);
    auto tile_expert = [&](int tile, int& e, int& k) { if (tile < M.nrt) { int lo = 0, hi = NE - 1; while (lo < hi) { const int mid = (lo + hi + 1) >> 1; if (M.tb[mid] <= tile) lo = mid; else hi = mid - 1; } e = lo; k = tile - M.tb[lo]; } else { e = NE; k = tile - M.nrt; } };
    auto fill = [&](int j) { if (j < ntl && tid < 256) { const int tile = M.vc + j * M.G; int e, k; tile_expert(tile, e, k); LAS int* T = M.tbl + (j % 3) * 768;
            int ts; float w;
            if (e < NE) { const int valid = (int)M.cnt[e * CNT_STRIDE] - 256 * k; if (tid < valid) { ts = M.rowl[(size_t)tile * 256 + tid]; w = M.roww[(size_t)tile * 256 + tid]; } else { ts = -1; w = 0.f; } T[tid] = ts < 0 ? 0 : (ts >> 3); }
            else { ts = k * 256 + tid; w = 1.f; T[tid] = ts; }
            T[256 + tid] = ts; ((LAS float*)T)[512 + tid] = w; } };
    struct UP { const char* aB; const char* bB; unsigned bh; int nt, kind, pn, slot, shared, e, hbuf, fillnext; };
    auto unit_params = [&](int ui, int prev_e, UP& u, unsigned (&oa)[4], unsigned (&ob)[2]) {
        int tq = threadIdx.x; asm volatile("" : "+v"(tq));
        int Rst[2], Cst[2], Rbp[2];
#pragma unroll
        for (int i = 0; i < 2; ++i) { int R, C; stage_rc(tq * 16 + i * 8192, R, C); Rst[i] = R; Cst[i] = C; Rbp[i] = (R & ~31) + perm32(R & 31); }
        int j, sub;
        if (ui < 2) { j = 0; sub = ui; }
        else { const int qq = ui - 2, g = qq / 6, r = qq - 6 * g; if (g < ntl - 1 && r < 2) { j = g + 1; sub = r; } else { j = g; sub = (g < ntl - 1) ? r : r + 2; } }
        const int tile = M.vc + j * M.G; int e, k;
        if (sub == 0 || sub == 2) tile_expert(tile, e, k); else e = prev_e;
        u.e = e;
        const char* w = M.wexp + (size_t)e * WEXP_STRIDE;
        u.slot = j % 3; u.hbuf = j & 1; u.fillnext = (sub == 1) ? j + 1 : -1; u.shared = (e == NE) ? 1 : 0;
        if (sub < 2) { u.kind = 0; u.pn = sub; u.nt = D / 128; u.aB = M.h2n; u.bB = w + (size_t)sub * 256 * D; u.bh = 128u * D;
            const LAS int* T = M.tbl + (j % 3) * 768;
#pragma unroll
            for (int i = 0; i < 2; ++i) { oa[i] = (unsigned)T[Rst[i]] * (unsigned)D + 2u * (unsigned)Cst[i]; oa[2 + i] = (unsigned)T[128 + Rst[i]] * (unsigned)D + 2u * (unsigned)Cst[i]; ob[i] = (unsigned)(Rbp[i] * D + 2 * Cst[i]); } }
        else { u.kind = 1; u.pn = sub - 2; u.nt = DE / 128; u.aB = M.Hs + (j & 1) * 65536; u.bB = w + (size_t)512 * 1024 + (size_t)(sub - 2) * 256 * DE; u.bh = 128u * DE;
#pragma unroll
            for (int i = 0; i < 2; ++i) { oa[i] = (unsigned)(Rst[i] * DE + 2 * Cst[i]); oa[2 + i] = (unsigned)((128 + Rst[i]) * DE + 2 * Cst[i]); ob[i] = (unsigned)(Rbp[i] * DE + 2 * Cst[i]); } }
    };
#define PG8_SA(b, h) (((b) * 2 + (h)) * HTB)
#define PG8_SB(b, h) ((4 + (b) * 2 + (h)) * HTB)
#define MOE_DMA(bufoff, ptr, aux) __builtin_amdgcn_global_load_lds((const unsigned*)(ptr), (LAS unsigned*)(lds + (bufoff)), 16, 0, aux)
#define MOE_STA(bufoff, base, o0, o1) do { MOE_DMA((bufoff) + ldsw, (base) + (o0), 16); MOE_DMA((bufoff) + ldsw + 8192, (base) + (o1), 16); } while (0)
#define MOE_STAK(kindv, bufoff, base, o0, o1) do { if ((kindv) == 0) { MOE_DMA((bufoff) + ldsw, (base) + (o0), 0); MOE_DMA((bufoff) + ldsw + 8192, (base) + (o1), 0); } else MOE_STA(bufoff, base, o0, o1); } while (0)
#define MOE_STB(bufoff, base, o0, o1) do { MOE_DMA((bufoff) + ldsw, (base) + (o0), 0); MOE_DMA((bufoff) + ldsw + 8192, (base) + (o1), 0); } while (0)
#define MOE_LD32(p) __builtin_shufflevector(*(const LAS i32x4*)(p), *(const LAS i32x4*)((p) + 1024), 0, 1, 2, 3, 4, 5, 6, 7)
#define PG8_LDA(dst, b, h) do { _Pragma("unroll") for (int m = 0; m < 4; ++m) dst[m] = MOE_LD32(lds + PG8_SA(b, h) + aoff + m * 2048); } while (0)
#define PG8_LDB(dst, b, h) do { _Pragma("unroll") for (int n = 0; n < 2; ++n) dst[n] = MOE_LD32(lds + PG8_SB(b, h) + boff + n * 2048); } while (0)
#define MOE_MFMA(c, a, b) asm volatile("v_mfma_scale_f32_16x16x128_f8f6f4 %0, %1, %2, %0, %3, %3 op_sel_hi:[0,0,0]" : "+v"(c) : "v"(a), "v"(b), "v"(one_scale))
#define PG8_MMA(ai, bj, At, Bt) do { __builtin_amdgcn_s_setprio(1); _Pragma("unroll") for (int m = 0; m < 4; ++m) _Pragma("unroll") for (int n = 0; n < 2; ++n) \
        MOE_MFMA(acc[ai][bj][m][n], Bt[n], At[m]); __builtin_amdgcn_s_setprio(0); } while (0)
#define PG8_WAIT_V(n) asm volatile("s_waitcnt vmcnt(" #n ")" ::: "memory")
#define PG8_WAIT_L(n) asm volatile("s_waitcnt lgkmcnt(" #n ")" ::: "memory")
#define PG8_BAR __builtin_amdgcn_s_barrier()
#define PG8_SCHED __builtin_amdgcn_sched_barrier(0)
    fill(0);
    asm volatile("s_waitcnt vmcnt(0) lgkmcnt(0)" ::: "memory");
    __syncthreads();
    UP cu, nu; unsigned oa[4], ob[2], na[4], nb[2];
    unit_params(0, 0, cu, oa, ob);
    nu = cu;
#pragma unroll
    for (int i = 0; i < 4; ++i) na[i] = oa[i];
    nb[0] = ob[0]; nb[1] = ob[1];
    f32x4 acc[2][2][4][2];
#pragma unroll
    for (int a = 0; a < 2; ++a)
#pragma unroll
        for (int b = 0; b < 2; ++b)
#pragma unroll
            for (int m = 0; m < 4; ++m)
#pragma unroll
                for (int n = 0; n < 2; ++n) acc[a][b][m][n] = (f32x4){0.f, 0.f, 0.f, 0.f};
    i32x8 At[4], B0[2], B1[2];
    int one_scale = 0x7F7F7F7F; asm volatile("" : "+v"(one_scale));
    const size_t kstep = (size_t)128;
    {   const char* cA = cu.aB; const char* cB = cu.bB;
        MOE_STB(PG8_SB(0, 0), cB, ob[0], ob[1]); MOE_STB(PG8_SB(0, 1), cB + cu.bh, ob[0], ob[1]); MOE_STAK(cu.kind, PG8_SA(0, 0), cA, oa[0], oa[1]); MOE_STAK(cu.kind, PG8_SA(0, 1), cA, oa[2], oa[3]);
        if (wr == 1) PG8_BAR;
        PG8_WAIT_V(2); PG8_BAR;
        MOE_STB(PG8_SB(1, 0), cB + kstep, ob[0], ob[1]); MOE_STAK(cu.kind, PG8_SA(1, 0), cA + kstep, oa[0], oa[1]); MOE_STB(PG8_SB(1, 1), cB + cu.bh + kstep, ob[0], ob[1]);
        PG8_WAIT_V(6); PG8_BAR; }
    for (int ui = 0;; ++ui) {
        const bool has_next = (ui + 1 < nunits);
        if (cu.fillnext >= 0) fill(cu.fillnext);
        const char* cA = cu.aB; const char* cB = cu.bB; const int nt = cu.nt; const unsigned bh = cu.bh;
        for (int t = 0; t < nt; t += 2) {
            const bool last = (t == nt - 2);
            if (last && has_next) unit_params(ui + 1, cu.e, nu, na, nb);
            const char* a1 = cA + (size_t)(t + 1) * kstep;
            const char* a2 = last ? nu.aB : cA + (size_t)(t + 2) * kstep; const char* b2 = last ? nu.bB : cB + (size_t)(t + 2) * kstep;
            const char* a3 = a2 + kstep; const char* b3 = b2 + kstep;
            const unsigned bh2 = last ? nu.bh : bh;
            const unsigned x0 = last ? na[0] : oa[0], x1 = last ? na[1] : oa[1], y0 = last ? na[2] : oa[2], y1 = last ? na[3] : oa[3];
            const unsigned z0 = last ? nb[0] : ob[0], z1 = last ? nb[1] : ob[1];
            const int k2 = last ? nu.kind : cu.kind;
            PG8_LDB(B0, 0, 0); PG8_LDB(B1, 0, 1); PG8_SCHED; PG8_LDA(At, 0, 0); MOE_STAK(cu.kind, PG8_SA(1, 1), a1, oa[2], oa[3]);
            PG8_WAIT_V(8); PG8_WAIT_L(0); PG8_BAR; PG8_MMA(0, 0, At, B0); PG8_MMA(0, 1, At, B1); PG8_BAR; PG8_SCHED;
            PG8_LDA(At, 0, 1); MOE_STB(PG8_SB(0, 0), b2, z0, z1); MOE_STB(PG8_SB(0, 1), b2 + bh2, z0, z1); MOE_STAK(k2, PG8_SA(0, 0), a2, x0, x1);
            PG8_WAIT_V(8); PG8_WAIT_L(0); PG8_BAR; PG8_MMA(1, 0, At, B0); PG8_MMA(1, 1, At, B1); PG8_BAR; PG8_SCHED;
            PG8_LDB(B0, 1, 0); PG8_LDB(B1, 1, 1); PG8_SCHED; PG8_LDA(At, 1, 0); MOE_STAK(k2, PG8_SA(0, 1), a2, y0, y1);
            PG8_WAIT_V(8); PG8_WAIT_L(0); PG8_BAR; PG8_MMA(0, 0, At, B0); PG8_MMA(0, 1, At, B1); PG8_BAR; PG8_SCHED;
            PG8_LDA(At, 1, 1); MOE_STB(PG8_SB(1, 0), b3, z0, z1); MOE_STB(PG8_SB(1, 1), b3 + bh2, z0, z1); MOE_STAK(k2, PG8_SA(1, 0), a3, x0, x1);
            PG8_WAIT_V(8); PG8_WAIT_L(0); PG8_BAR; PG8_MMA(1, 0, At, B0); PG8_MMA(1, 1, At, B1); PG8_BAR; PG8_SCHED;
        }
        if (wr == 0) PG8_BAR;
        asm volatile("s_nop 15\n\ts_nop 15" ::: "memory");
        if (cu.kind == 0) {
            const int row0 = wr * 64 + fr; const int col0 = cu.pn * 128 + wc * 32 + 8 * fq;
            constexpr float is13 = 1.f / SW13;
#pragma unroll
            for (int ai = 0; ai < 2; ++ai)
#pragma unroll
                for (int m = 0; m < 4; ++m) { unsigned char* rowp = (unsigned char*)M.Hs + cu.hbuf * 65536 + (size_t)(row0 + ai * HALF + m * 16) * 256 + col0;
                    f32x4 h0, h1;
#pragma unroll
                    for (int j = 0; j < 4; ++j) { h0[j] = siluf_(acc[ai][0][m][0][j] * is13) * (acc[ai][1][m][0][j] * (is13 * SHS)); h1[j] = siluf_(acc[ai][0][m][1][j] * is13) * (acc[ai][1][m][1][j] * (is13 * SHS)); }
                    u32x2 w; w.x = pk4_fp8(h0[0], h0[1], h0[2], h0[3]); w.y = pk4_fp8(h1[0], h1[1], h1[2], h1[3]);
                    *(u32x2*)rowp = w; }
        } else {
            const LAS int* rtok = M.tbl + cu.slot * 768 + 256; const LAS float* rw = (const LAS float*)(M.tbl + cu.slot * 768 + 512);
            const int col0 = cu.pn * BM + wc * 32 + 8 * fq;
#pragma unroll
            for (int ai = 0; ai < 2; ++ai)
#pragma unroll
                for (int m = 0; m < 4; ++m) { const int r = wr * 64 + fr + ai * HALF + m * 16; const int ts = rtok[r]; const float w = rw[r];
                    if (ts >= 0) {
                        if (cu.shared) { const unsigned goff = (unsigned)(ts >> 11) * MODW + 5 * D + col0; const unsigned ooff = (unsigned)ts * D + col0;
#pragma unroll
                            for (int bj = 0; bj < 2; ++bj)
#pragma unroll
                                for (int n = 0; n < 2; ++n) { const f32x4 gv = *(const f32x4*)(M.mod + goff + bj * HALF + n * 4); f32x4* op = (f32x4*)(M.out + ooff + bj * HALF + n * 4);
                                    const f32x4 nv = *op + gv * acc[ai][bj][m][n] * (1.f / (SHS * SW2)); if (!M.dry_shared) *op = nv; else asm volatile("" :: "v"(nv)); }
                        } else { unsigned char* yp = M.Y + (size_t)(unsigned)ts * D + col0; const float ws_ = w * (YSCALE / (SHS * SW2));
#pragma unroll
                            for (int bj = 0; bj < 2; ++bj) { f32x4 v0 = acc[ai][bj][m][0] * ws_, v1 = acc[ai][bj][m][1] * ws_;
#pragma unroll
                                for (int j = 0; j < 4; ++j) { v0[j] = __builtin_amdgcn_fmed3f(v0[j], -448.f, 448.f); v1[j] = __builtin_amdgcn_fmed3f(v1[j], -448.f, 448.f); }
                                unsigned lo = 0u, hi = 0u;
                                lo = __builtin_amdgcn_cvt_pk_fp8_f32(v0[0], v0[1], lo, false); lo = __builtin_amdgcn_cvt_pk_fp8_f32(v0[2], v0[3], lo, true);
                                hi = __builtin_amdgcn_cvt_pk_fp8_f32(v1[0], v1[1], hi, false); hi = __builtin_amdgcn_cvt_pk_fp8_f32(v1[2], v1[3], hi, true);
                                u32x2 pk; pk.x = lo; pk.y = hi; *(u32x2*)(yp + bj * HALF) = pk; } } }
                    asm volatile("" ::: "memory"); }
        }
        if (!has_next) break;
#pragma unroll
        for (int a = 0; a < 2; ++a)
#pragma unroll
            for (int b = 0; b < 2; ++b)
#pragma unroll
                for (int m = 0; m < 4; ++m)
#pragma unroll
                    for (int n = 0; n < 2; ++n) acc[a][b][m][n] = (f32x4){0.f, 0.f, 0.f, 0.f};
        cu = nu;
#pragma unroll
        for (int i = 0; i < 4; ++i) oa[i] = na[i];
        ob[0] = nb[0]; ob[1] = nb[1];
        if (wr == 1) PG8_BAR;
    }
    PG8_WAIT_V(0);
    PG8_BAR;
#undef PG8_SA
#undef PG8_SB
#undef MOE_DMA
#undef MOE_STA
#undef MOE_STAK
#undef MOE_STB
#undef PG8_LDA
#undef PG8_LDB
#undef MOE_LD32
#undef MOE_MFMA
#undef PG8_MMA
#undef PG8_WAIT_V
#undef PG8_WAIT_L
#undef PG8_BAR
#undef PG8_SCHED
}
}

struct Ctx {
    lbyte* lds; int tid, lane, wave, G, bid;
    const Args* a;
};
#define WSP(T, off) ((T*)(A.ws + (off)))

template <class RowMap>
__device__ __forceinline__ void transpose_item(const float* W, int K, int N, bf16_t* WT, RowMap rowmap, lfloat* scr, int item, int lane) {
    const int nblk = N / 32, kb = item / nblk, nb = item % nblk, k0 = 64 * kb, n0 = 32 * nb;
#pragma unroll 8
    for (int i = 0; i < 32; ++i) { const int kk = 2 * i + (lane >> 5); scr[kk * 33 + (lane & 31)] = W[(size_t)(k0 + kk) * N + n0 + (lane & 31)]; }
    asm volatile("s_waitcnt lgkmcnt(0)" ::: "memory");
    const int c = lane & 7;
#pragma unroll
    for (int j = 0; j < 4; ++j) { const int n = (lane >> 3) + 8 * j; const lfloat* s = scr + (8 * c) * 33 + n;
        u32x4 o; o.x = pk2(s[0 * 33], s[1 * 33]); o.y = pk2(s[2 * 33], s[3 * 33]); o.z = pk2(s[4 * 33], s[5 * 33]); o.w = pk2(s[6 * 33], s[7 * 33]);
        *(u32x4*)(WT + (size_t)rowmap(n0 + n) * K + k0 + 8 * c) = o; }
    asm volatile("s_waitcnt lgkmcnt(0)" ::: "memory");
}
template <class RowMap>
__device__ __forceinline__ void transpose_item_fp8(const float* W, int K, int N, unsigned char* WT, RowMap rowmap, float sc, lfloat* scr, int item, int lane) {
    const int nblk = N / 32, kb = item / nblk, nb = item % nblk, k0 = 64 * kb, n0 = 32 * nb;
#pragma unroll 8
    for (int i = 0; i < 32; ++i) { const int kk = 2 * i + (lane >> 5); scr[kk * 33 + (lane & 31)] = W[(size_t)(k0 + kk) * N + n0 + (lane & 31)] * sc; }
    asm volatile("s_waitcnt lgkmcnt(0)" ::: "memory");
    const int c = lane & 7;
#pragma unroll
    for (int j = 0; j < 4; ++j) { const int n = (lane >> 3) + 8 * j; const lfloat* s = scr + (8 * c) * 33 + n;
        u32x2 o; o.x = pk4_fp8(s[0 * 33], s[1 * 33], s[2 * 33], s[3 * 33]); o.y = pk4_fp8(s[4 * 33], s[5 * 33], s[6 * 33], s[7 * 33]);
        *(u32x2*)(WT + (size_t)rowmap(n0 + n) * K + k0 + 8 * c) = o; }
    asm volatile("s_waitcnt lgkmcnt(0)" ::: "memory");
}
template <class RowMap>
__device__ __forceinline__ void transpose_pair_fp8(const float* W, int K, int N, unsigned char* WT, RowMap rowmap, float sc, lfloat* scr, int pair, int lane) {
    const int nblk = N / 32, kbp = pair / nblk, nb = pair % nblk, k0 = 128 * kbp, n0 = 32 * nb;
    const int kr = lane >> 3, n4 = (lane & 7) * 4;
    f32x4 ld[2][8];
#pragma unroll
    for (int h = 0; h < 2; ++h)
#pragma unroll
        for (int i = 0; i < 8; ++i) ld[h][i] = *(const f32x4*)(W + (size_t)(k0 + 64 * h + 8 * i + kr) * N + n0 + n4);
    const int c = lane & 7;
    u32x2 o[2][4];
#pragma unroll
    for (int h = 0; h < 2; ++h) {
#pragma unroll
        for (int i = 0; i < 8; ++i) { lfloat* d = scr + (8 * i + kr) * 33 + n4; d[0] = ld[h][i].x * sc; d[1] = ld[h][i].y * sc; d[2] = ld[h][i].z * sc; d[3] = ld[h][i].w * sc; }
        asm volatile("s_waitcnt lgkmcnt(0)" ::: "memory");
#pragma unroll
        for (int j = 0; j < 4; ++j) { const int n = (lane >> 3) + 8 * j; const lfloat* s = scr + (8 * c) * 33 + n;
            o[h][j].x = pk4_fp8(s[0 * 33], s[1 * 33], s[2 * 33], s[3 * 33]); o[h][j].y = pk4_fp8(s[4 * 33], s[5 * 33], s[6 * 33], s[7 * 33]); }
        asm volatile("s_waitcnt lgkmcnt(0)" ::: "memory");
    }
#pragma unroll
    for (int j = 0; j < 4; ++j) { const int n = (lane >> 3) + 8 * j; unsigned char* p = WT + (size_t)rowmap(n0 + n) * K + k0 + 8 * c;
        *(u32x2*)p = o[0][j]; *(u32x2*)(p + 64) = o[1][j]; }
}
struct RowId { __device__ int operator()(int n) const { return n; } };
struct RowGLU { int base; __device__ int operator()(int n) const { return ((n >> 7) << 8) + base + (n & 127); } };

__device__ __forceinline__ void norm_mod_row(const float* xrow, const float* g, const float* sc, const float* sh, bf16_t* orow, int lane, unsigned* o8row = nullptr) {
    const f32x4* xr = (const f32x4*)xrow + lane;
    f32x4 v[4]; float s = 0.f;
#pragma unroll
    for (int j = 0; j < 4; ++j) { v[j] = xr[64 * j]; s += (v[j].x * v[j].x + v[j].y * v[j].y) + (v[j].z * v[j].z + v[j].w * v[j].w); }
    const float rstd = __builtin_amdgcn_rsqf(wave_sum(s) * (1.f / D) + NORM_EPS);
    u32x2* o8 = (u32x2*)orow + lane;
#pragma unroll
    for (int j = 0; j < 4; ++j) { const f32x4 gg = ((const f32x4*)g)[lane + 64 * j], ss = ((const f32x4*)sc)[lane + 64 * j], hh = ((const f32x4*)sh)[lane + 64 * j];
        const f32x4 y = v[j] * rstd * gg * (ss + 1.f) + hh;
        if (orow) { u32x2 w; w.x = pk2(y.x, y.y); w.y = pk2(y.z, y.w); o8[64 * j] = w; }
        if (o8row) o8row[lane + 64 * j] = pk4_fp8(y.x, y.y, y.z, y.w); }
}

__device__ __forceinline__ void phase_p0(const Args& A, Ctx& C) {
    float* mod = WSP(float, WS_MOD);
    {
        lfloat* sc = (lfloat*)C.lds;
        lfloat* red = (lfloat*)(C.lds + 17 * 1024 * 4);
        const float* wada = A.in[I_WADA]; const float* bada = A.in[I_BADA];
        for (int it = C.bid; it < 96 * 2; it += C.G) {
            const int chunk = it >> 1, pass = it & 1, r0 = pass * 17, nr = pass ? 16 : 17, col0 = chunk * 64;
            __syncthreads();
            for (int i = C.tid; i < nr * 1024; i += 512) { const int r = i >> 10, k = i & 1023; const int rr = r0 + r;
                const float cv = rr < 32 ? A.in[I_C][rr * 1024 + k] : A.in[I_CCTX][k]; sc[r * 1024 + k] = siluf_(cv); }
            __syncthreads();
            const int col = C.tid & 63, kq = C.tid >> 6;
            float acc[17];
#pragma unroll
            for (int r = 0; r < 17; ++r) acc[r] = 0.f;
            for (int k = kq * 128; k < kq * 128 + 128; k += 4) {
                float w[4];
#pragma unroll
                for (int j = 0; j < 4; ++j) w[j] = wada[(size_t)(k + j) * MODW + col0 + col];
#pragma unroll
                for (int r = 0; r < 17; ++r) { const f32x4 s4 = *(const LAS f32x4*)(sc + r * 1024 + k); acc[r] += s4.x * w[0] + s4.y * w[1] + s4.z * w[2] + s4.w * w[3]; }
            }
#pragma unroll
            for (int r = 0; r < 17; ++r) red[(kq * 17 + r) * 64 + col] = acc[r];
            __syncthreads();
            for (int i = C.tid; i < nr * 64; i += 512) { const int r = i >> 6, cc = i & 63; float s = 0.f;
#pragma unroll
                for (int q = 0; q < 8; ++q) s += red[(q * 17 + r) * 64 + cc];
                mod[(size_t)(r0 + r) * MODW + col0 + cc] = s + bada[col0 + cc]; }
        }
        __syncthreads();
    }
    {
        lfloat* scr = (lfloat*)(C.lds + C.wave * 16384);
        const int gw = C.bid * 8 + C.wave, NGW = C.G * 8;
        unsigned char* btin8 = A.ws + WS_BTIN; bf16_t* btout = WSP(bf16_t, WS_BTOUT); bf16_t* btr = WSP(bf16_t, WS_BTR);
        constexpr int I_IN = (D / 64) * 124, I_OUT = (D / 64) * (D / 32), I_R = (D / 64) * (NE / 32), I_G = (128 / 64) * (DA / 32);
        for (int it = gw; it < I_IN + I_OUT + I_R + I_G; it += NGW) {
            int r = it;
            if (r < I_IN) {
                const int kb = r / 124, nb = r % 124, k0 = 64 * kb, n0 = 32 * nb; const float* W = A.in[I_WIN];
#pragma unroll 8
                for (int i = 0; i < 32; ++i) { const int kk = 2 * i + (C.lane >> 5); scr[kk * 33 + (C.lane & 31)] = W[(size_t)(k0 + kk) * IN_COLS + n0 + (C.lane & 31)] * SWIN; }
                asm volatile("s_waitcnt lgkmcnt(0)" ::: "memory");
                const int c = C.lane & 7;
#pragma unroll
                for (int j = 0; j < 4; ++j) { const int n = (C.lane >> 3) + 8 * j; const lfloat* s = scr + (8 * c) * 33 + n;
                    u32x2 o; o.x = pk4_fp8(s[0 * 33], s[1 * 33], s[2 * 33], s[3 * 33]); o.y = pk4_fp8(s[4 * 33], s[5 * 33], s[6 * 33], s[7 * 33]);
                    *(u32x2*)(btin8 + (size_t)(n0 + n) * D + k0 + 8 * c) = o; }
                asm volatile("s_waitcnt lgkmcnt(0)" ::: "memory");
                continue; }
            r -= I_IN;
            if (r < I_OUT) { transpose_item(A.in[I_WOUT], D, D, btout, RowId(), scr, r, C.lane); continue; } r -= I_OUT;
            if (r < I_R) { transpose_item(A.in[I_RW], D, NE, btr, RowId(), scr, r, C.lane); continue; } r -= I_R;
            transpose_item(A.in[I_GUP], 128, DA, WSP(bf16_t, WS_GUPT), RowId(), scr, r, C.lane);
        }
        for (int i = C.bid * 512 + C.tid; i < 16 * D / 4; i += C.G * 512) { const int n = 3968 + (i >> 8), k = (i & 255) * 4; const float* W = A.in[I_WIN];
            *(unsigned*)(btin8 + (size_t)n * D + k) = pk4_fp8(W[(size_t)k * IN_COLS + n] * SWIN, W[(size_t)(k + 1) * IN_COLS + n] * SWIN, W[(size_t)(k + 2) * IN_COLS + n] * SWIN, W[(size_t)(k + 3) * IN_COLS + n] * SWIN); }
        for (int i = C.bid * 512 + C.tid; i < (PLD - IN_COLS) * D / 16; i += C.G * 512) ((u32x4*)(btin8 + (size_t)IN_COLS * D))[i] = (u32x4){0u, 0u, 0u, 0u};
    }
}

__device__ __forceinline__ void phase_p1(const Args& A, Ctx& C) {
    const float* mod = WSP(float, WS_MOD); bf16_t* xn = WSP(bf16_t, WS_XN);
    const int gw = C.bid * 8 + C.wave, NGW = C.G * 8;
    for (int row = gw; row < NROWS; row += NGW) {
        const float* xr; int mb;
        if (row < NLAT) { xr = A.in[I_X] + (size_t)row * D; mb = row >> 11; } else { xr = A.in[I_CTX] + (size_t)(row - NLAT) * D; mb = 32; }
        const float* m = mod + (size_t)mb * MODW;
        norm_mod_row(xr, A.in[I_N1G], m + D, m, nullptr, C.lane, (unsigned*)(A.ws + WS_XN) + (size_t)row * (D / 4));
    }
}

__device__ __forceinline__ float bfsel(unsigned w, unsigned sh) { return __builtin_bit_cast(float, (w << sh) & 0xffff0000u); }
template <int NK>
__device__ __forceinline__ f32x4 mm_tile(const lbyte* Ap, int lda, const lbyte* Bp, int ldb, f32x4 acc, int lane) {
    const int r = lane & 15, g = lane >> 4;
#pragma unroll
    for (int ks = 0; ks < NK; ++ks) {
        const bf16x8 a = *(const LAS bf16x8*)(Ap + r * lda + ks * 64 + g * 16);
        const bf16x8 b = *(const LAS bf16x8*)(Bp + r * ldb + ks * 64 + g * 16);
        acc = __builtin_amdgcn_mfma_f32_16x16x32_bf16(a, b, acc, 0, 0, 0);
    }
    return acc;
}

__device__ __forceinline__ void st_bf16x4(lbyte* p, f32x4 v) { u32x2 w; w.x = cvtpk(v.x, v.y); w.y = cvtpk(v.z, v.w); *(LAS u32x2*)p = w; }
__device__ __forceinline__ void st_bf16(lbyte* p, float v) { *(LAS unsigned short*)p = (unsigned short)cvtpk(v, v); }
__device__ __forceinline__ float rdlane(float v, int l) { return __builtin_bit_cast(float, __builtin_amdgcn_readlane(__builtin_bit_cast(int, v), l)); }

__device__ __forceinline__ void tri_inv16(const f32x4 m, int lane, lbyte* scr, float (&X)[16]) {
    *(LAS f32x4*)(scr + (lane & 15) * 64 + (lane >> 4) * 16) = m;
    asm volatile("s_waitcnt lgkmcnt(0)" ::: "memory");
    float Mr[16];
#pragma unroll
    for (int kq = 0; kq < 4; ++kq) { const f32x4 r = *(const LAS f32x4*)(scr + (lane & 15) * 64 + kq * 16); Mr[4 * kq] = r.x; Mr[4 * kq + 1] = r.y; Mr[4 * kq + 2] = r.z; Mr[4 * kq + 3] = r.w; }
    const int l16 = lane & 15;
    X[0] = (l16 == 0) ? 1.f : 0.f;
    { float a0 = (l16 == 1) ? 1.f : 0.f, a1 = 0.f, a2 = 0.f, a3 = 0.f;
      asm("s_nop 1\n\t" "v_fmac_f32_dpp %0, -%2, %3 row_newbcast:1 row_mask:0xf bank_mask:0xf\n\t" : "+v"(a0), "+v"(a1) : "v"(Mr[0]), "v"(X[0]));
      X[1] = (a0 + a1) + (a2 + a3); }
    { float a0 = (l16 == 2) ? 1.f : 0.f, a1 = 0.f, a2 = 0.f, a3 = 0.f;
      asm("s_nop 1\n\t" "v_fmac_f32_dpp %0, -%2, %3 row_newbcast:2 row_mask:0xf bank_mask:0xf\n\t" "v_fmac_f32_dpp %1, -%4, %5 row_newbcast:2 row_mask:0xf bank_mask:0xf\n\t" : "+v"(a0), "+v"(a1) : "v"(Mr[0]), "v"(X[0]), "v"(Mr[1]), "v"(X[1]));
      X[2] = (a0 + a1) + (a2 + a3); }
    { float a0 = (l16 == 3) ? 1.f : 0.f, a1 = 0.f, a2 = 0.f, a3 = 0.f;
      asm("s_nop 1\n\t" "v_fmac_f32_dpp %0, -%2, %3 row_newbcast:3 row_mask:0xf bank_mask:0xf\n\t" "v_fmac_f32_dpp %1, -%4, %5 row_newbcast:3 row_mask:0xf bank_mask:0xf\n\t" : "+v"(a0), "+v"(a1) : "v"(Mr[0]), "v"(X[0]), "v"(Mr[1]), "v"(X[1]));
      asm("s_nop 1\n\t" "v_fmac_f32_dpp %0, -%2, %3 row_newbcast:3 row_mask:0xf bank_mask:0xf\n\t" : "+v"(a2), "+v"(a3) : "v"(Mr[2]), "v"(X[2]));
      X[3] = (a0 + a1) + (a2 + a3); }
    { float a0 = (l16 == 4) ? 1.f : 0.f, a1 = 0.f, a2 = 0.f, a3 = 0.f;
      asm("s_nop 1\n\t" "v_fmac_f32_dpp %0, -%2, %3 row_newbcast:4 row_mask:0xf bank_mask:0xf\n\t" "v_fmac_f32_dpp %1, -%4, %5 row_newbcast:4 row_mask:0xf bank_mask:0xf\n\t" : "+v"(a0), "+v"(a1) : "v"(Mr[0]), "v"(X[0]), "v"(Mr[1]), "v"(X[1]));
      asm("s_nop 1\n\t" "v_fmac_f32_dpp %0, -%2, %3 row_newbcast:4 row_mask:0xf bank_mask:0xf\n\t" "v_fmac_f32_dpp %1, -%4, %5 row_newbcast:4 row_mask:0xf bank_mask:0xf\n\t" : "+v"(a2), "+v"(a3) : "v"(Mr[2]), "v"(X[2]), "v"(Mr[3]), "v"(X[3]));
      X[4] = (a0 + a1) + (a2 + a3); }
    { float a0 = (l16 == 5) ? 1.f : 0.f, a1 = 0.f, a2 = 0.f, a3 = 0.f;
      asm("s_nop 1\n\t" "v_fmac_f32_dpp %0, -%2, %3 row_newbcast:5 row_mask:0xf bank_mask:0xf\n\t" "v_fmac_f32_dpp %1, -%4, %5 row_newbcast:5 row_mask:0xf bank_mask:0xf\n\t" "v_fmac_f32_dpp %0, -%6, %7 row_newbcast:5 row_mask:0xf bank_mask:0xf\n\t" : "+v"(a0), "+v"(a1) : "v"(Mr[0]), "v"(X[0]), "v"(Mr[1]), "v"(X[1]), "v"(Mr[4]), "v"(X[4]));
      asm("s_nop 1\n\t" "v_fmac_f32_dpp %0, -%2, %3 row_newbcast:5 row_mask:0xf bank_mask:0xf\n\t" "v_fmac_f32_dpp %1, -%4, %5 row_newbcast:5 row_mask:0xf bank_mask:0xf\n\t" : "+v"(a2), "+v"(a3) : "v"(Mr[2]), "v"(X[2]), "v"(Mr[3]), "v"(X[3]));
      X[5] = (a0 + a1) + (a2 + a3); }
    { float a0 = (l16 == 6) ? 1.f : 0.f, a1 = 0.f, a2 = 0.f, a3 = 0.f;
      asm("s_nop 1\n\t" "v_fmac_f32_dpp %0, -%2, %3 row_newbcast:6 row_mask:0xf bank_mask:0xf\n\t" "v_fmac_f32_dpp %1, -%4, %5 row_newbcast:6 row_mask:0xf bank_mask:0xf\n\t" "v_fmac_f32_dpp %0, -%6, %7 row_newbcast:6 row_mask:0xf bank_mask:0xf\n\t" "v_fmac_f32_dpp %1, -%8, %9 row_newbcast:6 row_mask:0xf bank_mask:0xf\n\t" : "+v"(a0), "+v"(a1) : "v"(Mr[0]), "v"(X[0]), "v"(Mr[1]), "v"(X[1]), "v"(Mr[4]), "v"(X[4]), "v"(Mr[5]), "v"(X[5]));
      asm("s_nop 1\n\t" "v_fmac_f32_dpp %0, -%2, %3 row_newbcast:6 row_mask:0xf bank_mask:0xf\n\t" "v_fmac_f32_dpp %1, -%4, %5 row_newbcast:6 row_mask:0xf bank_mask:0xf\n\t" : "+v"(a2), "+v"(a3) : "v"(Mr[2]), "v"(X[2]), "v"(Mr[3]), "v"(X[3]));
      X[6] = (a0 + a1) + (a2 + a3); }
    { float a0 = (l16 == 7) ? 1.f : 0.f, a1 = 0.f, a2 = 0.f, a3 = 0.f;
      asm("s_nop 1\n\t" "v_fmac_f32_dpp %0, -%2, %3 row_newbcast:7 row_mask:0xf bank_mask:0xf\n\t" "v_fmac_f32_dpp %1, -%4, %5 row_newbcast:7 row_mask:0xf bank_mask:0xf\n\t" "v_fmac_f32_dpp %0, -%6, %7 row_newbcast:7 row_mask:0xf bank_mask:0xf\n\t" "v_fmac_f32_dpp %1, -%8, %9 row_newbcast:7 row_mask:0xf bank_mask:0xf\n\t" : "+v"(a0), "+v"(a1) : "v"(Mr[0]), "v"(X[0]), "v"(Mr[1]), "v"(X[1]), "v"(Mr[4]), "v"(X[4]), "v"(Mr[5]), "v"(X[5]));
      asm("s_nop 1\n\t" "v_fmac_f32_dpp %0, -%2, %3 row_newbcast:7 row_mask:0xf bank_mask:0xf\n\t" "v_fmac_f32_dpp %1, -%4, %5 row_newbcast:7 row_mask:0xf bank_mask:0xf\n\t" "v_fmac_f32_dpp %0, -%6, %7 row_newbcast:7 row_mask:0xf bank_mask:0xf\n\t" : "+v"(a2), "+v"(a3) : "v"(Mr[2]), "v"(X[2]), "v"(Mr[3]), "v"(X[3]), "v"(Mr[6]), "v"(X[6]));
      X[7] = (a0 + a1) + (a2 + a3); }
    { float a0 = (l16 == 8) ? 1.f : 0.f, a1 = 0.f, a2 = 0.f, a3 = 0.f;
      asm("s_nop 1\n\t" "v_fmac_f32_dpp %0, -%2, %3 row_newbcast:8 row_mask:0xf bank_mask:0xf\n\t" "v_fmac_f32_dpp %1, -%4, %5 row_newbcast:8 row_mask:0xf bank_mask:0xf\n\t" "v_fmac_f32_dpp %0, -%6, %7 row_newbcast:8 row_mask:0xf bank_mask:0xf\n\t" "v_fmac_f32_dpp %1, -%8, %9 row_newbcast:8 row_mask:0xf bank_mask:0xf\n\t" : "+v"(a0), "+v"(a1) : "v"(Mr[0]), "v"(X[0]), "v"(Mr[1]), "v"(X[1]), "v"(Mr[4]), "v"(X[4]), "v"(Mr[5]), "v"(X[5]));
      asm("s_nop 1\n\t" "v_fmac_f32_dpp %0, -%2, %3 row_newbcast:8 row_mask:0xf bank_mask:0xf\n\t" "v_fmac_f32_dpp %1, -%4, %5 row_newbcast:8 row_mask:0xf bank_mask:0xf\n\t" "v_fmac_f32_dpp %0, -%6, %7 row_newbcast:8 row_mask:0xf bank_mask:0xf\n\t" "v_fmac_f32_dpp %1, -%8, %9 row_newbcast:8 row_mask:0xf bank_mask:0xf\n\t" : "+v"(a2), "+v"(a3) : "v"(Mr[2]), "v"(X[2]), "v"(Mr[3]), "v"(X[3]), "v"(Mr[6]), "v"(X[6]), "v"(Mr[7]), "v"(X[7]));
      X[8] = (a0 + a1) + (a2 + a3); }
    { float a0 = (l16 == 9) ? 1.f : 0.f, a1 = 0.f, a2 = 0.f, a3 = 0.f;
      asm("s_nop 1\n\t" "v_fmac_f32_dpp %0, -%2, %3 row_newbcast:9 row_mask:0xf bank_mask:0xf\n\t" "v_fmac_f32_dpp %1, -%4, %5 row_newbcast:9 row_mask:0xf bank_mask:0xf\n\t" "v_fmac_f32_dpp %0, -%6, %7 row_newbcast:9 row_mask:0xf bank_mask:0xf\n\t" "v_fmac_f32_dpp %1, -%8, %9 row_newbcast:9 row_mask:0xf bank_mask:0xf\n\t" "v_fmac_f32_dpp %0, -%10, %11 row_newbcast:9 row_mask:0xf bank_mask:0xf\n\t" : "+v"(a0), "+v"(a1) : "v"(Mr[0]), "v"(X[0]), "v"(Mr[1]), "v"(X[1]), "v"(Mr[4]), "v"(X[4]), "v"(Mr[5]), "v"(X[5]), "v"(Mr[8]), "v"(X[8]));
      asm("s_nop 1\n\t" "v_fmac_f32_dpp %0, -%2, %3 row_newbcast:9 row_mask:0xf bank_mask:0xf\n\t" "v_fmac_f32_dpp %1, -%4, %5 row_newbcast:9 row_mask:0xf bank_mask:0xf\n\t" "v_fmac_f32_dpp %0, -%6, %7 row_newbcast:9 row_mask:0xf bank_mask:0xf\n\t" "v_fmac_f32_dpp %1, -%8, %9 row_newbcast:9 row_mask:0xf bank_mask:0xf\n\t" : "+v"(a2), "+v"(a3) : "v"(Mr[2]), "v"(X[2]), "v"(Mr[3]), "v"(X[3]), "v"(Mr[6]), "v"(X[6]), "v"(Mr[7]), "v"(X[7]));
      X[9] = (a0 + a1) + (a2 + a3); }
    { float a0 = (l16 == 10) ? 1.f : 0.f, a1 = 0.f, a2 = 0.f, a3 = 0.f;
      asm("s_nop 1\n\t" "v_fmac_f32_dpp %0, -%2, %3 row_newbcast:10 row_mask:0xf bank_mask:0xf\n\t" "v_fmac_f32_dpp %1, -%4, %5 row_newbcast:10 row_mask:0xf bank_mask:0xf\n\t" "v_fmac_f32_dpp %0, -%6, %7 row_newbcast:10 row_mask:0xf bank_mask:0xf\n\t" "v_fmac_f32_dpp %1, -%8, %9 row_newbcast:10 row_mask:0xf bank_mask:0xf\n\t" "v_fmac_f32_dpp %0, -%10, %11 row_newbcast:10 row_mask:0xf bank_mask:0xf\n\t" "v_fmac_f32_dpp %1, -%12, %13 row_newbcast:10 row_mask:0xf bank_mask:0xf\n\t" : "+v"(a0), "+v"(a1) : "v"(Mr[0]), "v"(X[0]), "v"(Mr[1]), "v"(X[1]), "v"(Mr[4]), "v"(X[4]), "v"(Mr[5]), "v"(X[5]), "v"(Mr[8]), "v"(X[8]), "v"(Mr[9]), "v"(X[9]));
      asm("s_nop 1\n\t" "v_fmac_f32_dpp %0, -%2, %3 row_newbcast:10 row_mask:0xf bank_mask:0xf\n\t" "v_fmac_f32_dpp %1, -%4, %5 row_newbcast:10 row_mask:0xf bank_mask:0xf\n\t" "v_fmac_f32_dpp %0, -%6, %7 row_newbcast:10 row_mask:0xf bank_mask:0xf\n\t" "v_fmac_f32_dpp %1, -%8, %9 row_newbcast:10 row_mask:0xf bank_mask:0xf\n\t" : "+v"(a2), "+v"(a3) : "v"(Mr[2]), "v"(X[2]), "v"(Mr[3]), "v"(X[3]), "v"(Mr[6]), "v"(X[6]), "v"(Mr[7]), "v"(X[7]));
      X[10] = (a0 + a1) + (a2 + a3); }
    { float a0 = (l16 == 11) ? 1.f : 0.f, a1 = 0.f, a2 = 0.f, a3 = 0.f;
      asm("s_nop 1\n\t" "v_fmac_f32_dpp %0, -%2, %3 row_newbcast:11 row_mask:0xf bank_mask:0xf\n\t" "v_fmac_f32_dpp %1, -%4, %5 row_newbcast:11 row_mask:0xf bank_mask:0xf\n\t" "v_fmac_f32_dpp %0, -%6, %7 row_newbcast:11 row_mask:0xf bank_mask:0xf\n\t" "v_fmac_f32_dpp %1, -%8, %9 row_newbcast:11 row_mask:0xf bank_mask:0xf\n\t" "v_fmac_f32_dpp %0, -%10, %11 row_newbcast:11 row_mask:0xf bank_mask:0xf\n\t" "v_fmac_f32_dpp %1, -%12, %13 row_newbcast:11 row_mask:0xf bank_mask:0xf\n\t" : "+v"(a0), "+v"(a1) : "v"(Mr[0]), "v"(X[0]), "v"(Mr[1]), "v"(X[1]), "v"(Mr[4]), "v"(X[4]), "v"(Mr[5]), "v"(X[5]), "v"(Mr[8]), "v"(X[8]), "v"(Mr[9]), "v"(X[9]));
      asm("s_nop 1\n\t" "v_fmac_f32_dpp %0, -%2, %3 row_newbcast:11 row_mask:0xf bank_mask:0xf\n\t" "v_fmac_f32_dpp %1, -%4, %5 row_newbcast:11 row_mask:0xf bank_mask:0xf\n\t" "v_fmac_f32_dpp %0, -%6, %7 row_newbcast:11 row_mask:0xf bank_mask:0xf\n\t" "v_fmac_f32_dpp %1, -%8, %9 row_newbcast:11 row_mask:0xf bank_mask:0xf\n\t" "v_fmac_f32_dpp %0, -%10, %11 row_newbcast:11 row_mask:0xf bank_mask:0xf\n\t" : "+v"(a2), "+v"(a3) : "v"(Mr[2]), "v"(X[2]), "v"(Mr[3]), "v"(X[3]), "v"(Mr[6]), "v"(X[6]), "v"(Mr[7]), "v"(X[7]), "v"(Mr[10]), "v"(X[10]));
      X[11] = (a0 + a1) + (a2 + a3); }
    { float a0 = (l16 == 12) ? 1.f : 0.f, a1 = 0.f, a2 = 0.f, a3 = 0.f;
      asm("s_nop 1\n\t" "v_fmac_f32_dpp %0, -%2, %3 row_newbcast:12 row_mask:0xf bank_mask:0xf\n\t" "v_fmac_f32_dpp %1, -%4, %5 row_newbcast:12 row_mask:0xf bank_mask:0xf\n\t" "v_fmac_f32_dpp %0, -%6, %7 row_newbcast:12 row_mask:0xf bank_mask:0xf\n\t" "v_fmac_f32_dpp %1, -%8, %9 row_newbcast:12 row_mask:0xf bank_mask:0xf\n\t" "v_fmac_f32_dpp %0, -%10, %11 row_newbcast:12 row_mask:0xf bank_mask:0xf\n\t" "v_fmac_f32_dpp %1, -%12, %13 row_newbcast:12 row_mask:0xf bank_mask:0xf\n\t" : "+v"(a0), "+v"(a1) : "v"(Mr[0]), "v"(X[0]), "v"(Mr[1]), "v"(X[1]), "v"(Mr[4]), "v"(X[4]), "v"(Mr[5]), "v"(X[5]), "v"(Mr[8]), "v"(X[8]), "v"(Mr[9]), "v"(X[9]));
      asm("s_nop 1\n\t" "v_fmac_f32_dpp %0, -%2, %3 row_newbcast:12 row_mask:0xf bank_mask:0xf\n\t" "v_fmac_f32_dpp %1, -%4, %5 row_newbcast:12 row_mask:0xf bank_mask:0xf\n\t" "v_fmac_f32_dpp %0, -%6, %7 row_newbcast:12 row_mask:0xf bank_mask:0xf\n\t" "v_fmac_f32_dpp %1, -%8, %9 row_newbcast:12 row_mask:0xf bank_mask:0xf\n\t" "v_fmac_f32_dpp %0, -%10, %11 row_newbcast:12 row_mask:0xf bank_mask:0xf\n\t" "v_fmac_f32_dpp %1, -%12, %13 row_newbcast:12 row_mask:0xf bank_mask:0xf\n\t" : "+v"(a2), "+v"(a3) : "v"(Mr[2]), "v"(X[2]), "v"(Mr[3]), "v"(X[3]), "v"(Mr[6]), "v"(X[6]), "v"(Mr[7]), "v"(X[7]), "v"(Mr[10]), "v"(X[10]), "v"(Mr[11]), "v"(X[11]));
      X[12] = (a0 + a1) + (a2 + a3); }
    { float a0 = (l16 == 13) ? 1.f : 0.f, a1 = 0.f, a2 = 0.f, a3 = 0.f;
      asm("s_nop 1\n\t" "v_fmac_f32_dpp %0, -%2, %3 row_newbcast:13 row_mask:0xf bank_mask:0xf\n\t" "v_fmac_f32_dpp %1, -%4, %5 row_newbcast:13 row_mask:0xf bank_mask:0xf\n\t" "v_fmac_f32_dpp %0, -%6, %7 row_newbcast:13 row_mask:0xf bank_mask:0xf\n\t" "v_fmac_f32_dpp %1, -%8, %9 row_newbcast:13 row_mask:0xf bank_mask:0xf\n\t" "v_fmac_f32_dpp %0, -%10, %11 row_newbcast:13 row_mask:0xf bank_mask:0xf\n\t" "v_fmac_f32_dpp %1, -%12, %13 row_newbcast:13 row_mask:0xf bank_mask:0xf\n\t" "v_fmac_f32_dpp %0, -%14, %15 row_newbcast:13 row_mask:0xf bank_mask:0xf\n\t" : "+v"(a0), "+v"(a1) : "v"(Mr[0]), "v"(X[0]), "v"(Mr[1]), "v"(X[1]), "v"(Mr[4]), "v"(X[4]), "v"(Mr[5]), "v"(X[5]), "v"(Mr[8]), "v"(X[8]), "v"(Mr[9]), "v"(X[9]), "v"(Mr[12]), "v"(X[12]));
      asm("s_nop 1\n\t" "v_fmac_f32_dpp %0, -%2, %3 row_newbcast:13 row_mask:0xf bank_mask:0xf\n\t" "v_fmac_f32_dpp %1, -%4, %5 row_newbcast:13 row_mask:0xf bank_mask:0xf\n\t" "v_fmac_f32_dpp %0, -%6, %7 row_newbcast:13 row_mask:0xf bank_mask:0xf\n\t" "v_fmac_f32_dpp %1, -%8, %9 row_newbcast:13 row_mask:0xf bank_mask:0xf\n\t" "v_fmac_f32_dpp %0, -%10, %11 row_newbcast:13 row_mask:0xf bank_mask:0xf\n\t" "v_fmac_f32_dpp %1, -%12, %13 row_newbcast:13 row_mask:0xf bank_mask:0xf\n\t" : "+v"(a2), "+v"(a3) : "v"(Mr[2]), "v"(X[2]), "v"(Mr[3]), "v"(X[3]), "v"(Mr[6]), "v"(X[6]), "v"(Mr[7]), "v"(X[7]), "v"(Mr[10]), "v"(X[10]), "v"(Mr[11]), "v"(X[11]));
      X[13] = (a0 + a1) + (a2 + a3); }
    { float a0 = (l16 == 14) ? 1.f : 0.f, a1 = 0.f, a2 = 0.f, a3 = 0.f;
      asm("s_nop 1\n\t" "v_fmac_f32_dpp %0, -%2, %3 row_newbcast:14 row_mask:0xf bank_mask:0xf\n\t" "v_fmac_f32_dpp %1, -%4, %5 row_newbcast:14 row_mask:0xf bank_mask:0xf\n\t" "v_fmac_f32_dpp %0, -%6, %7 row_newbcast:14 row_mask:0xf bank_mask:0xf\n\t" "v_fmac_f32_dpp %1, -%8, %9 row_newbcast:14 row_mask:0xf bank_mask:0xf\n\t" "v_fmac_f32_dpp %0, -%10, %11 row_newbcast:14 row_mask:0xf bank_mask:0xf\n\t" "v_fmac_f32_dpp %1, -%12, %13 row_newbcast:14 row_mask:0xf bank_mask:0xf\n\t" "v_fmac_f32_dpp %0, -%14, %15 row_newbcast:14 row_mask:0xf bank_mask:0xf\n\t" "v_fmac_f32_dpp %1, -%16, %17 row_newbcast:14 row_mask:0xf bank_mask:0xf\n\t" : "+v"(a0), "+v"(a1) : "v"(Mr[0]), "v"(X[0]), "v"(Mr[1]), "v"(X[1]), "v"(Mr[4]), "v"(X[4]), "v"(Mr[5]), "v"(X[5]), "v"(Mr[8]), "v"(X[8]), "v"(Mr[9]), "v"(X[9]), "v"(Mr[12]), "v"(X[12]), "v"(Mr[13]), "v"(X[13]));
      asm("s_nop 1\n\t" "v_fmac_f32_dpp %0, -%2, %3 row_newbcast:14 row_mask:0xf bank_mask:0xf\n\t" "v_fmac_f32_dpp %1, -%4, %5 row_newbcast:14 row_mask:0xf bank_mask:0xf\n\t" "v_fmac_f32_dpp %0, -%6, %7 row_newbcast:14 row_mask:0xf bank_mask:0xf\n\t" "v_fmac_f32_dpp %1, -%8, %9 row_newbcast:14 row_mask:0xf bank_mask:0xf\n\t" "v_fmac_f32_dpp %0, -%10, %11 row_newbcast:14 row_mask:0xf bank_mask:0xf\n\t" "v_fmac_f32_dpp %1, -%12, %13 row_newbcast:14 row_mask:0xf bank_mask:0xf\n\t" : "+v"(a2), "+v"(a3) : "v"(Mr[2]), "v"(X[2]), "v"(Mr[3]), "v"(X[3]), "v"(Mr[6]), "v"(X[6]), "v"(Mr[7]), "v"(X[7]), "v"(Mr[10]), "v"(X[10]), "v"(Mr[11]), "v"(X[11]));
      X[14] = (a0 + a1) + (a2 + a3); }
    { float a0 = (l16 == 15) ? 1.f : 0.f, a1 = 0.f, a2 = 0.f, a3 = 0.f;
      asm("s_nop 1\n\t" "v_fmac_f32_dpp %0, -%2, %3 row_newbcast:15 row_mask:0xf bank_mask:0xf\n\t" "v_fmac_f32_dpp %1, -%4, %5 row_newbcast:15 row_mask:0xf bank_mask:0xf\n\t" "v_fmac_f32_dpp %0, -%6, %7 row_newbcast:15 row_mask:0xf bank_mask:0xf\n\t" "v_fmac_f32_dpp %1, -%8, %9 row_newbcast:15 row_mask:0xf bank_mask:0xf\n\t" "v_fmac_f32_dpp %0, -%10, %11 row_newbcast:15 row_mask:0xf bank_mask:0xf\n\t" "v_fmac_f32_dpp %1, -%12, %13 row_newbcast:15 row_mask:0xf bank_mask:0xf\n\t" "v_fmac_f32_dpp %0, -%14, %15 row_newbcast:15 row_mask:0xf bank_mask:0xf\n\t" "v_fmac_f32_dpp %1, -%16, %17 row_newbcast:15 row_mask:0xf bank_mask:0xf\n\t" : "+v"(a0), "+v"(a1) : "v"(Mr[0]), "v"(X[0]), "v"(Mr[1]), "v"(X[1]), "v"(Mr[4]), "v"(X[4]), "v"(Mr[5]), "v"(X[5]), "v"(Mr[8]), "v"(X[8]), "v"(Mr[9]), "v"(X[9]), "v"(Mr[12]), "v"(X[12]), "v"(Mr[13]), "v"(X[13]));
      asm("s_nop 1\n\t" "v_fmac_f32_dpp %0, -%2, %3 row_newbcast:15 row_mask:0xf bank_mask:0xf\n\t" "v_fmac_f32_dpp %1, -%4, %5 row_newbcast:15 row_mask:0xf bank_mask:0xf\n\t" "v_fmac_f32_dpp %0, -%6, %7 row_newbcast:15 row_mask:0xf bank_mask:0xf\n\t" "v_fmac_f32_dpp %1, -%8, %9 row_newbcast:15 row_mask:0xf bank_mask:0xf\n\t" "v_fmac_f32_dpp %0, -%10, %11 row_newbcast:15 row_mask:0xf bank_mask:0xf\n\t" "v_fmac_f32_dpp %1, -%12, %13 row_newbcast:15 row_mask:0xf bank_mask:0xf\n\t" "v_fmac_f32_dpp %0, -%14, %15 row_newbcast:15 row_mask:0xf bank_mask:0xf\n\t" : "+v"(a2), "+v"(a3) : "v"(Mr[2]), "v"(X[2]), "v"(Mr[3]), "v"(X[3]), "v"(Mr[6]), "v"(X[6]), "v"(Mr[7]), "v"(X[7]), "v"(Mr[10]), "v"(X[10]), "v"(Mr[11]), "v"(X[11]), "v"(Mr[14]), "v"(X[14]));
      X[15] = (a0 + a1) + (a2 + a3); }
}

#ifndef RWKV_REP
#define RWKV_REP 1
#endif
namespace rk {
constexpr int S64 = 160, S32 = 80, SW = 144;
constexpr int O_WUP = 0, O_AUP = O_WUP + 64 * SW, O_WLT = O_AUP + 64 * SW, O_ALT = O_WLT + 16 * S64, O_LW = O_ALT + 16 * S64, O_LA = O_LW + 4096,
              O_KKT = O_LA + 4096, O_RT = O_KKT + 16 * S64, O_BT = O_RT + 16 * S64, O_KDT = O_BT + 16 * S64,
              O_VT = O_KDT + 16 * S64, O_BHT = O_VT + 64 * S32, O_KHT = O_BHT + 64 * S32, O_UT = O_KHT + 64 * S32, O_UTT = O_WLT  ,
              O_TI = O_UT + 64 * S32, O_MK = O_TI + 16 * S32, O_NB = O_MK + 16 * S32, O_NK = O_NB + 16 * S32,
              O_SBF = O_NK + 16 * S32, O_WC = O_SBF + 64 * S64, O_WT = O_WC + 256, TEAM_BYTES = O_WT + 1024;
static_assert(2 * TEAM_BYTES <= LDS_MISC, "rwkv LDS");
}
__device__ __forceinline__ void rwkv_pair_chunked(const Args& A, Ctx& C, int pair) {
    using namespace rk;
    const int b = pair >> 3, h = pair & 7;
    const int dir = C.wave >> 2;
    const int t4 = C.tid & 255, q = C.wave & 3, lane = C.lane;
    lbyte* L = C.lds + dir * TEAM_BYTES;
    const bf16_t* P = WSP(bf16_t, WS_P);
    bf16_t* ydir = WSP(bf16_t, WS_YDIR) + (size_t)dir * NLAT * D;
    float* bon = WSP(float, WS_BON) + (size_t)dir * NLAT * 8;
    __syncthreads();
#pragma unroll 2
    for (int i = t4; i < 4096; i += 256) { const int l = i >> 6, c = i & 63;
        st_bf16(L + O_WUP + c * SW + l * 2, A.in[I_WUP][((size_t)dir * 64 + l) * DA + 64 * h + c]);
        st_bf16(L + O_AUP + c * SW + l * 2, A.in[I_AUP][((size_t)dir * 64 + l) * DA + 64 * h + c]); }
#pragma unroll 2
    for (int i = t4; i < (4 * 64 * S32 + 4 * 16 * S32 + 64 * S64) / 4; i += 256) ((LAS unsigned*)(L + O_VT))[i] = 0u;
    for (int i = t4; i < (2 * 16 * S64) / 4; i += 256) ((LAS unsigned*)(L + O_WLT))[i] = 0u;
    const int c = lane;
    const int col5[5] = {64 * h + c, 512 + 64 * h + c, 1024 + 64 * h + c, 1536 + 64 * dir + c, 1664 + 64 * dir + c};
    float mu5[5]; unsigned coff[5], nm[5], nlo[5], nrg[5]; int ndb[5];
#pragma unroll
    for (int e = 0; e < 5; ++e) { mu5[e] = A.in[I_MU][col5[e]]; coff[e] = (unsigned)col5[e] * 2u; }
    auto set_rules = [&](bool ctx) {
#pragma unroll
        for (int e = 0; e < 5; ++e) { const int col = col5[e];
            if (ctx) { nm[e] = 0xffffffffu; nlo[e] = col < 960 ? 1u : 0u; nrg[e] = (unsigned)(CTX - 2); ndb[e] = (col < 960 ? -PLD : PLD) * 2; }
            else { const int cls = col < 480 ? 0 : (col < 960 ? 1 : (col < 1440 ? 2 : 3));
                nm[e] = cls < 2 ? 63u : 0xffffffffu; nlo[e] = cls == 0 ? 1u : (cls == 2 ? 64u : 0u); nrg[e] = cls < 2 ? 62u : (unsigned)(SEQ - 65);
                ndb[e] = (cls == 0 ? -PLD : (cls == 1 ? PLD : (cls == 2 ? -64 * PLD : 64 * PLD))) * 2; } } };
    set_rules(true);
    const char* wsb = (const char*)A.ws;
    const float kkc = A.in[I_KK][64 * h + c], kac = A.in[I_KA][64 * h + c], rkc = A.in[I_RK][64 * h + c];
    const float w0c = A.in[I_W0][dir * DA + 64 * h + c], a0c = A.in[I_A0][dir * DA + 64 * h + c];
    f32x4 Sacc[4];
#pragma unroll
    for (int i = 0; i < 4; ++i) Sacc[i] = (f32x4){0.f, 0.f, 0.f, 0.f};
    const int fr = lane & 15, fg = lane >> 4;
    unsigned short rawp[4][5], raws[4][5];
    auto chunk_geom = [&](int ch, bool& isctx, int& sbase, int& T, size_t& rowbase) { isctx = ch < 16; sbase = isctx ? ch * 16 : (ch - 16) * 16; T = isctx ? CTX : SEQ; rowbase = isctx ? (size_t)NLAT + (size_t)b * CTX : (size_t)b * SEQ; };
    auto issue_loads = [&](int ch) { bool isctx; int sbase, T; size_t rowbase; chunk_geom(ch, isctx, sbase, T, rowbase);
#pragma unroll
        for (int j = 0; j < 4; ++j) { const int i = 4 * q + j; const int t = __builtin_amdgcn_readfirstlane(dir ? (T - 1 - (sbase + i)) : (sbase + i));
            const unsigned rowoff = (unsigned)WS_P + (unsigned)(rowbase + t) * (unsigned)(PLD * 2);
            const bool edge = isctx ? (t == 0 || t == CTX - 1) : (((t & 63) == 0) || ((t & 63) == 63) || t < 64 || t >= SEQ - 64);
            if (!edge) {
#pragma unroll
                for (int e = 0; e < 5; ++e) { rawp[j][e] = *(const bf16_t*)(wsb + (rowoff + coff[e])); raws[j][e] = *(const bf16_t*)(wsb + (rowoff + coff[e] + (unsigned)ndb[e])); }
            } else {
#pragma unroll
                for (int e = 0; e < 5; ++e) { const unsigned vs = rowoff + coff[e]; const bool ok = (((unsigned)t & nm[e]) - nlo[e]) <= nrg[e]; const unsigned vn = ok ? vs + (unsigned)ndb[e] : 8u;
                    rawp[j][e] = *(const bf16_t*)(wsb + vs); raws[j][e] = *(const bf16_t*)(wsb + vn); } } } };
    u32x2 ypend; ypend.x = 0u; ypend.y = 0u; float bpend[4] = {0.f, 0.f, 0.f, 0.f};
    auto flush = [&](int pch) { bool pisctx; int psb, pT; size_t prb; chunk_geom(pch, pisctx, psb, pT, prb);
        if (!pisctx) { const int t = dir ? (pT - 1 - (psb + fr)) : (psb + fr);
            *(u32x2*)(ydir + ((size_t)b * SEQ + t) * D + 64 * h + 16 * q + 4 * fg) = ypend;
            if (lane == 0) {
#pragma unroll
                for (int j = 0; j < 4; ++j) { const int i = 4 * q + j; const int tj = dir ? (pT - 1 - (psb + i)) : (psb + i); bon[((size_t)b * SEQ + tj) * 8 + h] = bpend[j]; } } } };
    issue_loads(0);
    for (int ch = 0; ch < 144; ++ch) {
        bool isctx; int sbase, T; size_t rowbase; chunk_geom(ch, isctx, sbase, T, rowbase);
        float vr[4], vk[4], vv[4], vkk[4], lw[4], av[4];
        __syncthreads();
        float mxa[4][5];
#pragma unroll
        for (int j = 0; j < 4; ++j) {
#pragma unroll
            for (int e = 0; e < 5; ++e) { const float pv = bf2f(rawp[j][e]); const float sv = bf2f(raws[j][e]); mxa[j][e] = pv + mu5[e] * (sv - pv); } }
        asm volatile("" :: "v"(mxa[0][0]), "v"(mxa[0][1]), "v"(mxa[0][2]), "v"(mxa[0][3]), "v"(mxa[0][4]), "v"(mxa[1][0]), "v"(mxa[1][1]), "v"(mxa[1][2]), "v"(mxa[1][3]), "v"(mxa[1][4]),
                        "v"(mxa[2][0]), "v"(mxa[2][1]), "v"(mxa[2][2]), "v"(mxa[2][3]), "v"(mxa[2][4]), "v"(mxa[3][0]), "v"(mxa[3][1]), "v"(mxa[3][2]), "v"(mxa[3][3]), "v"(mxa[3][4]) : "memory");
        if (ch > 0) flush(ch - 1);
        if (ch == 15) set_rules(false);
        if (ch + 1 < 144) issue_loads(ch + 1);
        float cl[4];
        _Pragma("unroll") for (int rrep = 0; rrep < RWKV_REP; ++rrep) {
#pragma unroll
        for (int j = 0; j < 4; ++j) {
            const int i = 4 * q + j;
            float mx[5];
#pragma unroll
            for (int e = 0; e < 5; ++e) mx[e] = mxa[j][e];
            vr[j] = mx[0]; vk[j] = mx[1]; vv[j] = mx[2];
            *(LAS unsigned short*)(L + O_WLT + i * S64 + c * 2) = (unsigned short)cvtpk(tanhf_(mx[3]), 0.f); *(LAS unsigned short*)(L + O_ALT + i * S64 + c * 2) = (unsigned short)cvtpk(mx[4], 0.f);
            const float kx = vk[j] * kkc; const float ss = wave_sum(kx * kx);
            vkk[j] = kx * __builtin_amdgcn_rsqf(ss + 1e-6f);
        }
        __syncthreads();
        {
            const f32x4 z = (f32x4){0.f, 0.f, 0.f, 0.f};
            const f32x4 tw = mm_tile<2>(L + O_WLT, S64, L + O_WUP + 16 * q * SW, SW, z, lane);
            const f32x4 ta = mm_tile<2>(L + O_ALT, S64, L + O_AUP + 16 * q * SW, SW, z, lane);
#pragma unroll
            for (int e = 0; e < 4; ++e) { ((LAS float*)(L + O_LW))[(4 * fg + e) * 64 + 16 * q + fr] = tw[e]; ((LAS float*)(L + O_LA))[(4 * fg + e) * 64 + 16 * q + fr] = ta[e]; }
        }
        __syncthreads();
        { float run = 0.f;
#pragma unroll
        for (int j = 0; j < 4; ++j) { const int i = 4 * q + j;
            lw[j] = -0.6065306597126334f * sigmoidf_(w0c + ((LAS float*)(L + O_LW))[i * 64 + c]);
            av[j] = sigmoidf_(a0c + ((LAS float*)(L + O_LA))[i * 64 + c]);
            run += lw[j]; cl[j] = run; }
        ((LAS float*)(L + O_WT))[q * 64 + c] = run; }
        __syncthreads();
        }
        {
            float off = 0.f, cumC = 0.f;
#pragma unroll
            for (int qq = 0; qq < 4; ++qq) { const float tv = ((LAS float*)(L + O_WT))[qq * 64 + c]; cumC += tv; off += (qq < q) ? tv : 0.f; }
            float tv_[4], tb_[4], tk_[4];
            float Wprev = __expf(off); const float eC = __expf(cumC);
#pragma unroll
            for (int j = 0; j < 4; ++j) { const int i = 4 * q + j;
                const float cum = off + cl[j];
                const float Wt = __expf(cum), Wp = Wprev, Wi = __builtin_amdgcn_rcpf(Wt), Wc = eC * Wi; Wprev = Wt;
                const float kd = vk[j] * (1.f + (av[j] - 1.f) * kac), bb = vkk[j] * av[j];
                const unsigned p0 = cvtpk(vkk[j] * Wp, vr[j] * Wt), p1 = cvtpk(bb * Wi, kd * Wi);
                *(LAS unsigned short*)(L + O_KKT + i * S64 + c * 2) = (unsigned short)p0; *(LAS unsigned short*)(L + O_RT + i * S64 + c * 2) = (unsigned short)(p0 >> 16);
                *(LAS unsigned short*)(L + O_BT + i * S64 + c * 2) = (unsigned short)p1; *(LAS unsigned short*)(L + O_KDT + i * S64 + c * 2) = (unsigned short)(p1 >> 16);
                tv_[j] = vv[j]; tb_[j] = bb * Wc; tk_[j] = kd * Wc;
                const float bs = wave_sum(vr[j] * kd * rkc);
                bpend[j] = bs;
            }
            { u32x2 w2;
                w2.x = cvtpk(tv_[0], tv_[1]); w2.y = cvtpk(tv_[2], tv_[3]); *(LAS u32x2*)(L + O_VT + c * S32 + q * 8) = w2;
                w2.x = cvtpk(tb_[0], tb_[1]); w2.y = cvtpk(tb_[2], tb_[3]); *(LAS u32x2*)(L + O_BHT + c * S32 + q * 8) = w2;
                w2.x = cvtpk(tk_[0], tk_[1]); w2.y = cvtpk(tk_[2], tk_[3]); *(LAS u32x2*)(L + O_KHT + c * S32 + q * 8) = w2; }
            if (q == 3) ((LAS float*)(L + O_WC))[c] = eC;
        }
        __syncthreads();
        {
            const int role = (q + dir) & 3;
            const lbyte* Aj = L + ((role & 1) ? O_KDT : O_BT);
            const lbyte* Bt = L + ((role & 2) ? O_RT : O_KKT);
            f32x4 g4 = mm_tile<2>(Aj, S64, Bt, S64, (f32x4){0.f, 0.f, 0.f, 0.f}, lane);
#pragma unroll
            for (int e = 0; e < 4; ++e) { const int j = 4 * fg + e; const bool keep = (role & 2) ? (j <= fr) : (j < fr); g4[e] = keep ? g4[e] : 0.f; }
            if (role == 0) { float X[16]; tri_inv16(g4, lane, L + O_LW, X);
                if (lane < 16) {
#pragma unroll
                    for (int i = 0; i < 16; ++i) *(LAS unsigned short*)(L + O_TI + i * S32 + lane * 2) = (unsigned short)cvtpk(X[i], 0.f); } }
            else st_bf16x4(L + (role == 1 ? O_MK : (role == 2 ? O_NB : O_NK)) + fr * S32 + fg * 8, g4);
        }
        __syncthreads();
        f32x4 yacc;
        {
            f32x4 u4 = mm_tile<2>(L + O_KKT, S64, L + O_SBF + 16 * q * S64, S64, (f32x4){0.f, 0.f, 0.f, 0.f}, lane);
            u4 = mm_tile<1>(L + O_MK, S32, L + O_VT + 16 * q * S32, S32, u4, lane);
            st_bf16x4(L + O_UTT + (16 * q + fr) * S32 + fg * 8, u4);
            yacc = mm_tile<2>(L + O_SBF + 16 * q * S64, S64, L + O_RT, S64, (f32x4){0.f, 0.f, 0.f, 0.f}, lane);
            yacc = mm_tile<1>(L + O_VT + 16 * q * S32, S32, L + O_NK, S32, yacc, lane);
        }
        asm volatile("s_waitcnt lgkmcnt(0)" ::: "memory");
        {
            f32x4 u4 = mm_tile<1>(L + O_TI, S32, L + O_UTT + 16 * q * S32, S32, (f32x4){0.f, 0.f, 0.f, 0.f}, lane);
            st_bf16x4(L + O_UT + (16 * q + fr) * S32 + fg * 8, -u4);
        }
        __syncthreads();
        {
            yacc = mm_tile<1>(L + O_UT + 16 * q * S32, S32, L + O_NB, S32, yacc, lane);
            ypend.x = cvtpk(yacc[0], yacc[1]); ypend.y = cvtpk(yacc[2], yacc[3]);
            const f32x4 wc4 = *(LAS f32x4*)(L + O_WC + (16 * q + 4 * fg) * 4);
#pragma unroll
            for (int vi = 0; vi < 4; ++vi) {
                f32x4 s4 = Sacc[vi] * wc4;
                s4 = mm_tile<1>(L + O_KHT + 16 * q * S32, S32, L + O_VT + 16 * vi * S32, S32, s4, lane);
                s4 = mm_tile<1>(L + O_BHT + 16 * q * S32, S32, L + O_UT + 16 * vi * S32, S32, s4, lane);
                Sacc[vi] = s4;
                st_bf16x4(L + O_SBF + (16 * vi + fr) * S64 + (16 * q + 4 * fg) * 2, s4);
            }
        }
    }
    flush(143);
    __syncthreads();
}

__device__ __forceinline__ void phase_gdn_prep(const Args& A, Ctx& C) {
    const bf16_t* P = WSP(bf16_t, WS_P);
    bf16_t* QKV = (bf16_t*)A.out; float* NRM = WSP(float, WS_NRM);
    const int lane = C.lane, w = C.wave, hq = w >> 1, th = w & 1;
    const int ch0 = 128 * hq + 2 * lane;
    float cw[3][2][5];
#pragma unroll
    for (int g = 0; g < 3; ++g)
#pragma unroll
        for (int xx = 0; xx < 2; ++xx)
#pragma unroll
            for (int e = 0; e < 5; ++e) cw[g][xx][e] = A.in[I_CONVW][e * 1536 + g * 512 + ch0 + xx];
    auto geom = [&](int tile, int& T, int& tb, size_t& rowbase) { const int row0 = tile * 16; int ta;
        if (row0 < NLAT) { T = SEQ; rowbase = (size_t)(row0 >> 11) * SEQ; ta = row0 & (SEQ - 1); } else { T = CTX; const int r = row0 - NLAT; rowbase = (size_t)NLAT + (size_t)(r >> 8) * CTX; ta = r & (CTX - 1); }
        tb = ta + 8 * th; };
    unsigned raw[12][3];
    auto issue = [&](int tile) { int T, tb; size_t rowbase; geom(tile, T, tb, rowbase);
#pragma unroll
        for (int e = 0; e < 12; ++e) { const int t = tb - 2 + e; const bool ok = (t >= 0 && t < T); const unsigned* pr = (const unsigned*)(P + (rowbase + (ok ? t : tb)) * PLD + RW_COLS + ch0);
#pragma unroll
            for (int g = 0; g < 3; ++g) raw[e][g] = pr[g * 256]; } };
    if (C.bid < NROWS / 16) issue(C.bid);
    for (int tile = C.bid; tile < NROWS / 16; tile += C.G) {
        int T, tb; size_t rowbase; geom(tile, T, tb, rowbase);
        float x[3][2][12];
#pragma unroll
        for (int e = 0; e < 12; ++e) { const int t = tb - 2 + e; const bool ok = (t >= 0 && t < T);
#pragma unroll
            for (int g = 0; g < 3; ++g) { const unsigned wv = raw[e][g]; x[g][0][e] = ok ? bflo(wv) : 0.f; x[g][1][e] = ok ? bfhi(wv) : 0.f; } }
        if (tile + C.G < NROWS / 16) issue(tile + C.G);
#pragma unroll
        for (int i = 0; i < 8; ++i) { float y[3][2];
#pragma unroll
            for (int g = 0; g < 3; ++g)
#pragma unroll
                for (int xx = 0; xx < 2; ++xx) { float sacc = 0.f;
#pragma unroll
                    for (int f = 0; f < 5; ++f) sacc += cw[g][xx][f] * x[g][xx][i + f];
                    y[g][xx] = siluf_(sacc); }
            const size_t row = rowbase + tb + i;
            unsigned* orow = (unsigned*)(QKV + row * 1536 + ch0);
            orow[0] = cvtpk(y[0][0], y[0][1]); orow[256] = cvtpk(y[1][0], y[1][1]); orow[512] = cvtpk(y[2][0], y[2][1]);
            const float sq = wave_sum(y[0][0] * y[0][0] + y[0][1] * y[0][1]), sk = wave_sum(y[1][0] * y[1][0] + y[1][1] * y[1][1]);
            if (lane == 0) { NRM[row * 8 + hq] = __builtin_amdgcn_rsqf(sq + 1e-6f) * 0.08838834764831845f; NRM[row * 8 + 4 + hq] = __builtin_amdgcn_rsqf(sk + 1e-6f); } }
    }
    __syncthreads();
}

namespace gd {
constexpr int S128 = 288, S32 = 80;
constexpr int O_KT = 0, O_QT = O_KT + 32 * S128, O_KKT = O_QT + 32 * S128, O_RT = O_KKT + 32 * S128,
              O_VT = O_RT + 32 * S128, O_BHT = O_VT + 128 * S32, O_KHT = O_BHT + 128 * S32, O_UT = O_KHT + 128 * S32, O_UTT = O_UT + 128 * S32,
              O_TI = O_UTT + 128 * S32, O_MK = O_TI + 32 * S32, O_NB = O_MK + 32 * S32, O_NK = O_NB + 32 * S32,
              O_M21 = O_NK + 32 * S32, O_T11T = O_M21 + 16 * S32, O_T22 = O_T11T + 16 * S32, O_XT = O_T22 + 16 * S32,
              O_SBF = O_XT + 16 * S32, O_SC = O_SBF + 128 * S128, O_MS = O_SC + 512, GD_BYTES = O_MS + 2048;
static_assert(GD_BYTES <= LDS_MISC, "gdn LDS");
}
__device__ __forceinline__ void gdn_chain_chunked(const Args& A, Ctx& C, int chain) {
    using namespace gd;
    const int b = chain >> 3, h = (chain >> 1) & 3, dir = chain & 1;
    lbyte* L = C.lds;
    LAS float* SC = (LAS float*)(L + O_SC);
    const bf16_t* P = WSP(bf16_t, WS_P);
    bf16_t* ydir = WSP(bf16_t, WS_YDIR) + (size_t)dir * NLAT * D;
    const int tid = C.tid, lane = C.lane, w = C.wave, fr = lane & 15, fg = lane >> 4;
    const int grp = w >> 1, idx = tid & 127;
    const float Aexp = __expf(A.in[I_ALOG][dir * 4 + h]), dtb = A.in[I_DTB][dir * 4 + h];
    const f32x4 z4 = (f32x4){0.f, 0.f, 0.f, 0.f};
    __syncthreads();
#pragma unroll 2
    for (int i = tid; i < (O_SC - O_VT) / 4; i += 512) ((LAS unsigned*)(L + O_VT))[i] = 0u;
    f32x4 Sacc[8];
#pragma unroll
    for (int i = 0; i < 8; ++i) Sacc[i] = z4;
    const bf16_t* QKV = (const bf16_t*)A.out; const float* NRM = WSP(const float, WS_NRM);
    unsigned rq[8], rk[8], rv[8]; float nq[8], nk[8]; unsigned raw_al = 0, raw_be = 0;
    const unsigned codd = (idx & 1) ? 0u : 16u, godd = (h & 1) ? 0u : 16u;
    auto chunk_geom = [&](int ch, bool& isctx, int& sbase, int& T, size_t& rowbase) { isctx = ch < 8; sbase = isctx ? ch * 32 : (ch - 8) * 32; T = isctx ? CTX : SEQ;
        rowbase = isctx ? (size_t)NLAT + (size_t)b * CTX : (size_t)b * SEQ; };
    auto issue_loads = [&](int ch) { bool isctx; int sbase, T; size_t rowbase; chunk_geom(ch, isctx, sbase, T, rowbase);
#pragma unroll
        for (int j = 0; j < 8; ++j) { const int i = 8 * grp + j; const int t = dir ? (T - 1 - (sbase + i)) : (sbase + i); const size_t row = rowbase + t;
            const unsigned* qr = (const unsigned*)(QKV + row * 1536 + 128 * h + (idx & ~1)); rq[j] = qr[0]; rk[j] = qr[256]; rv[j] = qr[512]; nq[j] = NRM[row * 8 + h]; nk[j] = NRM[row * 8 + 4 + h]; }
        if (w == 7 && lane < 32) { const int t = dir ? (T - 1 - (sbase + lane)) : (sbase + lane); const unsigned* pr = (const unsigned*)(P + (rowbase + t) * PLD + RW_COLS + 2048 + ((dir * 4 + h) & ~1)); raw_al = pr[0]; raw_be = pr[4]; } };
    u32x2 ypend[2]; ypend[0].x = ypend[0].y = ypend[1].x = ypend[1].y = 0u;
    auto flush = [&](int pch) { bool pisctx; int psb, pT; size_t prb; chunk_geom(pch, pisctx, psb, pT, prb);
        if (!pisctx) {
#pragma unroll
            for (int tb = 0; tb < 2; ++tb) { const int tl = psb + tb * 16 + fr; const int t = dir ? (pT - 1 - tl) : tl;
                *(u32x2*)(ydir + ((size_t)b * SEQ + t) * D + 512 + 128 * h + 16 * w + 4 * fg) = ypend[tb]; } } };
    issue_loads(0);
    for (int ch = 0; ch < 72; ++ch) {
        bool isctx; int sbase, T; size_t rowbase; chunk_geom(ch, isctx, sbase, T, rowbase);
        __syncthreads();
        float qv[8], kv[8], vv[8], nqv[8], nkv[8];
#pragma unroll
        for (int j = 0; j < 8; ++j) { qv[j] = bfsel(rq[j], codd); kv[j] = bfsel(rk[j], codd); vv[j] = bfsel(rv[j], codd); nqv[j] = nq[j]; nkv[j] = nk[j]; }
        if (w == 7) {
            const float gi = (lane < 32) ? -Aexp * softplusf_(bfsel(raw_al, godd) + dtb) : 0.f;
            float cum = gi;
            cum += __builtin_bit_cast(float, __builtin_amdgcn_update_dpp(0, __builtin_bit_cast(int, cum), 0x111, 0xf, 0xf, true));
            cum += __builtin_bit_cast(float, __builtin_amdgcn_update_dpp(0, __builtin_bit_cast(int, cum), 0x112, 0xf, 0xf, true));
            cum += __builtin_bit_cast(float, __builtin_amdgcn_update_dpp(0, __builtin_bit_cast(int, cum), 0x114, 0xf, 0xf, true));
            cum += __builtin_bit_cast(float, __builtin_amdgcn_update_dpp(0, __builtin_bit_cast(int, cum), 0x118, 0xf, 0xf, true));
            const float r0 = rdlane(cum, 15);
            cum += (lane >= 16) ? r0 : 0.f;
            if (lane < 32) { SC[lane] = sigmoidf_(bfsel(raw_be, godd)); SC[32 + lane + 1] = cum; if (lane == 0) SC[32] = 0.f; }
        }
        asm volatile("" :: "v"(qv[0]), "v"(qv[1]), "v"(qv[2]), "v"(qv[3]), "v"(qv[4]), "v"(qv[5]), "v"(qv[6]), "v"(qv[7]), "v"(kv[0]), "v"(kv[1]), "v"(kv[2]), "v"(kv[3]), "v"(kv[4]), "v"(kv[5]), "v"(kv[6]), "v"(kv[7]),
                        "v"(vv[0]), "v"(vv[1]), "v"(vv[2]), "v"(vv[3]), "v"(vv[4]), "v"(vv[5]), "v"(vv[6]), "v"(vv[7]) : "memory");
        asm volatile("" :: "v"(nqv[0]), "v"(nqv[1]), "v"(nqv[2]), "v"(nqv[3]), "v"(nqv[4]), "v"(nqv[5]), "v"(nqv[6]), "v"(nqv[7]), "v"(nkv[0]), "v"(nkv[1]), "v"(nkv[2]), "v"(nkv[3]), "v"(nkv[4]), "v"(nkv[5]), "v"(nkv[6]), "v"(nkv[7]),
                        "v"(raw_al), "v"(raw_be) : "memory");
        if (ch > 0) flush(ch - 1);
        if (ch + 1 < 72) issue_loads(ch + 1);
        __syncthreads();
        {
            const int c = idx; const float gcC = SC[32 + 32];
            float bh[8], kh[8];
#pragma unroll
            for (int j = 0; j < 8; ++j) { const int i = 8 * grp + j;
                const float kn = kv[j] * nkv[j], qn = qv[j] * nqv[j];
                const float gm = SC[32 + i], gi = SC[32 + i + 1], be = SC[i];
                const unsigned p0 = cvtpk(kn, qn);
                *(LAS unsigned short*)(L + O_KT + i * S128 + c * 2) = (unsigned short)p0; *(LAS unsigned short*)(L + O_QT + i * S128 + c * 2) = (unsigned short)(p0 >> 16);
                bh[j] = be * kn * __expf(gcC - gm); kh[j] = be * kn * __expf(gcC - gi); }
            u32x4 w4;
            w4.x = cvtpk(bh[0], bh[1]); w4.y = cvtpk(bh[2], bh[3]); w4.z = cvtpk(bh[4], bh[5]); w4.w = cvtpk(bh[6], bh[7]); *(LAS u32x4*)(L + O_BHT + c * S32 + grp * 16) = w4;
            w4.x = cvtpk(kh[0], kh[1]); w4.y = cvtpk(kh[2], kh[3]); w4.z = cvtpk(kh[4], kh[5]); w4.w = cvtpk(kh[6], kh[7]); *(LAS u32x4*)(L + O_KHT + c * S32 + grp * 16) = w4;
            w4.x = cvtpk(vv[0], vv[1]); w4.y = cvtpk(vv[2], vv[3]); w4.z = cvtpk(vv[4], vv[5]); w4.w = cvtpk(vv[6], vv[7]); *(LAS u32x4*)(L + O_VT + c * S32 + grp * 16) = w4;
        }
        __syncthreads();
        {
            const int isq = w >> 2, tb = (w >> 1) & 1, jb = w & 1;
            if (jb <= tb) {
                const f32x4 g4 = mm_tile<4>(L + O_KT + jb * 16 * S128, S128, L + (isq ? O_QT : O_KT) + tb * 16 * S128, S128, z4, lane);
                const int t = tb * 16 + fr;
                const float gt = SC[32 + t + isq];
                f32x4 m0, m1;
#pragma unroll
                for (int e = 0; e < 4; ++e) { const int j = jb * 16 + 4 * fg + e; const bool keep = isq ? (j <= t) : (j < t);
                    const float bj = SC[j] * g4[e];
                    m0[e] = keep ? bj * __expf(gt - SC[32 + j]) : 0.f;
                    m1[e] = keep ? bj * __expf(gt - SC[32 + j + 1]) : 0.f; }
                const int off = t * S32 + (jb * 16 + 4 * fg) * 2;
                if (isq) { st_bf16x4(L + O_NB + off, m0); st_bf16x4(L + O_NK + off, m1); }
                else {
                    st_bf16x4(L + O_MK + off, m1);
                    if (tb != jb) st_bf16x4(L + O_M21 + fr * S32 + fg * 8, m0);
                    else { float X[16]; tri_inv16(m0, lane, L + O_MS + tb * 1024, X);
                        if (lane < 16) {
#pragma unroll
                            for (int i = 0; i < 16; ++i) *(LAS unsigned short*)(L + O_TI + (tb * 16 + i) * S32 + (tb * 16 + lane) * 2) = (unsigned short)cvtpk(X[i], 0.f);
                            if (tb == 0) { u32x4 a0, a1;
                                a0.x = cvtpk(X[0], X[1]); a0.y = cvtpk(X[2], X[3]); a0.z = cvtpk(X[4], X[5]); a0.w = cvtpk(X[6], X[7]);
                                a1.x = cvtpk(X[8], X[9]); a1.y = cvtpk(X[10], X[11]); a1.z = cvtpk(X[12], X[13]); a1.w = cvtpk(X[14], X[15]);
                                *(LAS u32x4*)(L + O_T11T + lane * S32) = a0; *(LAS u32x4*)(L + O_T11T + lane * S32 + 16) = a1; }
                            else {
#pragma unroll
                                for (int i = 0; i < 16; ++i) *(LAS unsigned short*)(L + O_T22 + i * S32 + lane * 2) = (unsigned short)cvtpk(X[i], 0.f); }
                        } }
                }
            }
        }
        __syncthreads();
        if (w == 1) {
            const f32x4 x4 = mm_tile<1>(L + O_M21, S32, L + O_T11T, S32, z4, lane);
            st_bf16x4(L + O_XT + fr * S32 + fg * 8, x4);
            asm volatile("s_waitcnt lgkmcnt(0)" ::: "memory");
            const f32x4 t4 = mm_tile<1>(L + O_XT, S32, L + O_T22, S32, z4, lane);
            st_bf16x4(L + O_TI + (16 + fr) * S32 + fg * 8, -t4);
        }
        f32x4 yacc[2];
#pragma unroll
        for (int tb = 0; tb < 2; ++tb) {
            f32x4 u4 = mm_tile<4>(L + O_KT + tb * 16 * S128, S128, L + O_SBF + 16 * w * S128, S128, z4, lane);
            { const f32x4 gp = *(LAS f32x4*)(SC + 32 + 16 * tb + 4 * fg);
                u4.x *= __expf(gp.x); u4.y *= __expf(gp.y); u4.z *= __expf(gp.z); u4.w *= __expf(gp.w); }
            u4 = mm_tile<1>(L + O_MK + tb * 16 * S32, S32, L + O_VT + 16 * w * S32, S32, u4, lane);
            st_bf16x4(L + O_UTT + (16 * w + fr) * S32 + tb * 32 + fg * 8, u4);
            yacc[tb] = mm_tile<4>(L + O_SBF + 16 * w * S128, S128, L + O_QT + tb * 16 * S128, S128, z4, lane);
            yacc[tb] = yacc[tb] * __expf(SC[32 + 16 * tb + fr + 1]);
            yacc[tb] = mm_tile<1>(L + O_VT + 16 * w * S32, S32, L + O_NK + tb * 16 * S32, S32, yacc[tb], lane);
        }
        __syncthreads();
#pragma unroll
        for (int tb = 0; tb < 2; ++tb) {
            const f32x4 u4 = mm_tile<1>(L + O_TI + tb * 16 * S32, S32, L + O_UTT + 16 * w * S32, S32, z4, lane);
            st_bf16x4(L + O_UT + (16 * w + fr) * S32 + tb * 32 + fg * 8, -u4);
        }
        __syncthreads();
        {
#pragma unroll
            for (int tb = 0; tb < 2; ++tb) {
                yacc[tb] = mm_tile<1>(L + O_UT + 16 * w * S32, S32, L + O_NB + tb * 16 * S32, S32, yacc[tb], lane);
                ypend[tb].x = cvtpk(yacc[tb][0], yacc[tb][1]); ypend[tb].y = cvtpk(yacc[tb][2], yacc[tb][3]);
            }
            const float wc = __expf(SC[32 + 32]);
#pragma unroll
            for (int vi = 0; vi < 8; ++vi) {
                f32x4 s4 = Sacc[vi] * wc;
                s4 = mm_tile<1>(L + O_KHT + 16 * w * S32, S32, L + O_VT + 16 * vi * S32, S32, s4, lane);
                s4 = mm_tile<1>(L + O_BHT + 16 * w * S32, S32, L + O_UT + 16 * vi * S32, S32, s4, lane);
                Sacc[vi] = s4;
                st_bf16x4(L + O_SBF + (16 * vi + fr) * S128 + (16 * w + 4 * fg) * 2, s4);
            }
        }
    }
    flush(71);
    __syncthreads();
}

__device__ __forceinline__ void unpack8(const u32x4 w, float (&f)[8]) { f[0] = bflo(w.x); f[1] = bfhi(w.x); f[2] = bflo(w.y); f[3] = bfhi(w.y); f[4] = bflo(w.z); f[5] = bfhi(w.z); f[6] = bflo(w.w); f[7] = bfhi(w.w); }
__device__ __forceinline__ void phase_p4(const Args& A, Ctx& C) {
    const bf16_t* P = WSP(bf16_t, WS_P);
    const bf16_t* yf = WSP(bf16_t, WS_YDIR); const bf16_t* yb = yf + (size_t)NLAT * D;
    const float* bon = WSP(float, WS_BON);
    bf16_t* ymix = WSP(bf16_t, WS_YMIX);
    lbyte* SGb = C.lds;
    lfloat* GO = (lfloat*)(C.lds + 8192);
    const int tid = C.tid, lane = C.lane, w = C.wave;
    const bf16_t* gupt = WSP(const bf16_t, WS_GUPT);
    const int fr = lane & 15, fg = lane >> 4;
    const int c8 = 8 * lane;
    float lnw[8], lnb[8], ong[8], muv[8];
#pragma unroll
    for (int e = 0; e < 8; ++e) { lnw[e] = A.in[I_LNW][c8 + e]; lnb[e] = A.in[I_LNB][c8 + e]; ong[e] = A.in[I_ONG][(c8 + e) & 127]; muv[e] = A.in[I_MU][1024 + c8 + e]; }
    const int tkA = tid >> 5, lA = 4 * (tid & 31);
    float muA[4];
#pragma unroll
    for (int e = 0; e < 4; ++e) muA[e] = A.in[I_MU][1792 + lA + e];
    const bool vup = (1024 + c8) < 1440;
    bf16x8 gq[4][4];
#pragma unroll
    for (int i = 0; i < 4; ++i)
#pragma unroll
        for (int ks = 0; ks < 4; ++ks) gq[i][ks] = *(const bf16x8*)(gupt + (size_t)(64 * w + 16 * i + fr) * 128 + ks * 32 + fg * 8);
    u32x2 pwA, swA;
    auto issueA = [&](int tile) { const int row = tile * 16 + tkA, t = row & (SEQ - 1); const bool ok = t < SEQ - 64;
        pwA = *(const u32x2*)(P + (size_t)row * PLD + 1792 + lA); swA = *(const u32x2*)(P + (size_t)(row + (ok ? 64 : 0)) * PLD + 1792 + lA); };
    if (C.bid < NLAT / 16) issueA(C.bid);
    for (int tile = C.bid; tile < NLAT / 16; tile += C.G) {
        const int row0 = tile * 16;
        u32x4 wyf[2], wyb[2], wpv[2], wsv[2], wof[2], wob[2], wz[2]; float bsv[2];
#pragma unroll
        for (int tt = 0; tt < 2; ++tt) {
            const int tk = 2 * w + tt, row = row0 + tk, t = row & (SEQ - 1);
            const bool okv = vup ? (t >= 64) : (t < SEQ - 64);
            wyf[tt] = *(const u32x4*)(yf + (size_t)row * D + c8); wyb[tt] = *(const u32x4*)(yb + (size_t)row * D + c8);
            wpv[tt] = *(const u32x4*)(P + (size_t)row * PLD + 1024 + c8); wsv[tt] = *(const u32x4*)(P + (size_t)(row + (okv ? (vup ? -64 : 64) : 0)) * PLD + 1024 + c8);
            wof[tt] = *(const u32x4*)(yf + (size_t)row * D + 512 + c8); wob[tt] = *(const u32x4*)(yb + (size_t)row * D + 512 + c8);
            wz[tt] = *(const u32x4*)(P + (size_t)row * PLD + RW_COLS + 1536 + c8);
            bsv[tt] = bon[(size_t)row * 8 + (lane >> 3)] + bon[((size_t)NLAT + row) * 8 + (lane >> 3)];
        }
        __syncthreads();
        {
            const int row = row0 + tkA, t = row & (SEQ - 1); const bool ok = t < SEQ - 64;
            const u32x2 pw = pwA, sw = swA;
            const float pv[4] = {bflo(pw.x), bfhi(pw.x), bflo(pw.y), bfhi(pw.y)}; const float sv[4] = {bflo(sw.x), bfhi(sw.x), bflo(sw.y), bfhi(sw.y)};
            float o[4];
#pragma unroll
            for (int e = 0; e < 4; ++e) o[e] = sigmoidf_(pv[e] + muA[e] * ((ok ? sv[e] : 0.f) - pv[e]));
            u32x2 ow; ow.x = cvtpk(o[0], o[1]); ow.y = cvtpk(o[2], o[3]); *(LAS u32x2*)(SGb + tkA * 288 + lA * 2) = ow;
        }
        if (tile + C.G < NLAT / 16) issueA(tile + C.G);
        __syncthreads();
#pragma unroll
        for (int i = 0; i < 4; ++i) { const int c0 = 64 * w + 16 * i; f32x4 acc = (f32x4){0.f, 0.f, 0.f, 0.f};
#pragma unroll
            for (int ks = 0; ks < 4; ++ks) { const bf16x8 a = *(const LAS bf16x8*)(SGb + fr * 288 + ks * 64 + fg * 16);
                acc = __builtin_amdgcn_mfma_f32_16x16x32_bf16(a, gq[i][ks], acc, 0, 0, 0); }
#pragma unroll
            for (int e = 0; e < 4; ++e) GO[(4 * fg + e) * 512 + c0 + fr] = acc[e]; }
        __syncthreads();
#pragma unroll
        for (int tt = 0; tt < 2; ++tt) {
            const int tk = 2 * w + tt, row = row0 + tk, t = row & (SEQ - 1);
            const bool okv = vup ? (t >= 64) : (t < SEQ - 64);
            const float bs = bsv[tt];
            const f32x4 g0 = *(const LAS f32x4*)(GO + tk * 512 + c8), g1 = *(const LAS f32x4*)(GO + tk * 512 + c8 + 4);
            const float gg[8] = {g0.x, g0.y, g0.z, g0.w, g1.x, g1.y, g1.z, g1.w};
            float a[8], bq[8], pv[8], sv[8], y[8];
            unpack8(wyf[tt], a); unpack8(wyb[tt], bq); unpack8(wpv[tt], pv); unpack8(wsv[tt], sv);
            float s1 = 0.f;
#pragma unroll
            for (int e = 0; e < 8; ++e) { y[e] = a[e] + bq[e]; s1 += y[e]; }
            s1 += __shfl_xor(s1, 1); s1 += __shfl_xor(s1, 2); s1 += __shfl_xor(s1, 4);
            const float m = s1 * (1.f / 64.f);
            float s2 = 0.f;
#pragma unroll
            for (int e = 0; e < 8; ++e) { y[e] -= m; s2 += y[e] * y[e]; }
            s2 += __shfl_xor(s2, 1); s2 += __shfl_xor(s2, 2); s2 += __shfl_xor(s2, 4);
            const float rs = __builtin_amdgcn_rsqf(s2 * (1.f / 64.f) + RWKV_EPS);
            float o[8];
#pragma unroll
            for (int e = 0; e < 8; ++e) { const float vv = pv[e] + muv[e] * ((okv ? sv[e] : 0.f) - pv[e]); o[e] = (y[e] * rs * lnw[e] + lnb[e] + bs * vv) * gg[e]; }
            u32x4 ow; ow.x = cvtpk(o[0], o[1]); ow.y = cvtpk(o[2], o[3]); ow.z = cvtpk(o[4], o[5]); ow.w = cvtpk(o[6], o[7]);
            *(u32x4*)(ymix + (size_t)row * D + c8) = ow;
            float of[8], ob[8], z[8];
            unpack8(wof[tt], of); unpack8(wob[tt], ob); unpack8(wz[tt], z);
            float s3 = 0.f;
#pragma unroll
            for (int e = 0; e < 8; ++e) { of[e] += ob[e]; s3 += of[e] * of[e]; }
            s3 += __shfl_xor(s3, 1); s3 += __shfl_xor(s3, 2); s3 += __shfl_xor(s3, 4); s3 += __shfl_xor(s3, 8);
            const float rg = __builtin_amdgcn_rsqf(s3 * (1.f / 128.f) + NORM_EPS);
#pragma unroll
            for (int e = 0; e < 8; ++e) o[e] = of[e] * rg * ong[e] * siluf_(z[e]);
            ow.x = cvtpk(o[0], o[1]); ow.y = cvtpk(o[2], o[3]); ow.z = cvtpk(o[4], o[5]); ow.w = cvtpk(o[6], o[7]);
            *(u32x4*)(ymix + (size_t)row * D + 512 + c8) = ow;
        }
    }
}

__device__ __forceinline__ void convert_experts(const Args& A, Ctx& C) {
    lfloat* scr = (lfloat*)(C.lds + C.wave * 16384);
    const int gw = C.bid * 8 + C.wave, NGW = C.G * 8;
    constexpr int I13 = (D / 128) * (DE / 32);
    constexpr int I2 = (DE / 128) * (D / 32);
    constexpr int PER = 2 * I13 + I2;
    for (int it = gw; it < 257 * PER; it += NGW) {
        const int e = it / PER; int r = it % PER;
        unsigned char* bt13 = A.ws + WS_WEXP + (size_t)e * WEXP_STRIDE; unsigned char* bt2 = bt13 + 512 * 1024;
        const float* w1 = e < NE ? A.in[I_EW1] + (size_t)e * D * DE : A.in[I_SW1];
        const float* w3 = e < NE ? A.in[I_EW3] + (size_t)e * D * DE : A.in[I_SW3];
        const float* w2 = e < NE ? A.in[I_EW2] + (size_t)e * DE * D : A.in[I_SW2];
        if (r < I13) { transpose_pair_fp8(w1, D, DE, bt13, RowGLU{0}, SW13, scr, r, C.lane); continue; } r -= I13;
        if (r < I13) { transpose_pair_fp8(w3, D, DE, bt13, RowGLU{128}, SW13, scr, r, C.lane); continue; } r -= I13;
        transpose_pair_fp8(w2, DE, D, bt2, RowId(), SW2, scr, r, C.lane);
    }
}

__device__ __forceinline__ void phase_p6(const Args& A, Ctx& C) {
    const float* mod = WSP(float, WS_MOD); bf16_t* h2n = WSP(bf16_t, WS_H2N);
    const int gw = C.bid * 8 + C.wave, NGW = C.G * 8;
    for (int row = gw; row < NLAT; row += NGW) {
        const float* m = mod + (size_t)(row >> 11) * MODW;
        norm_mod_row(A.out + (size_t)row * D, A.in[I_N2G], m + 4 * D, m + 3 * D, h2n + (size_t)row * D, C.lane, (unsigned*)(A.ws + WS_H2N8) + (size_t)row * (D / 4));
    }
}

__device__ __forceinline__ void phase_p8(const Args& A, Ctx& C) {
    const float* logit = WSP(float, WS_LOGIT);
    int* tope = WSP(int, WS_TOPE); float* topw = WSP(float, WS_TOPW); int* pos = WSP(int, WS_POS);
    unsigned* cnt = WSP(unsigned, WS_CTL) + CW_CNT;
    const int lane = C.lane;
    const f32x4 rb = ((const f32x4*)A.in[I_RB])[lane];
    LAS unsigned* hist = (LAS unsigned*)C.lds;
    LAS unsigned* base = hist + 256;
    LAS unsigned* lpe = base + 256;
    for (int blk = C.bid; blk < NLAT / 256; blk += C.G) {
    __syncthreads();
    if (C.tid < 256) hist[C.tid] = 0u;
    __syncthreads();
    f32x4 nlg = ((const f32x4*)(logit + (size_t)(blk * 256 + C.wave * 32) * NE))[lane];
    for (int ti = 0; ti < 32; ++ti) {
        const int tl = C.wave * 32 + ti, tok = blk * 256 + tl;
        const f32x4 lg = nlg;
        if (ti + 1 < 32) nlg = ((const f32x4*)(logit + (size_t)(tok + 1) * NE))[lane];
        float s[4], sel[4];
#pragma unroll
        for (int i = 0; i < 4; ++i) { s[i] = sigmoidf_(lg[i]); sel[i] = s[i] + rb[i]; }
        float m1 = fmaxf(fmaxf(sel[0], sel[1]), fmaxf(sel[2], sel[3]));
        float m2;
        {
            float a = fmaxf(sel[0], sel[1]), bq = fminf(sel[0], sel[1]), cq = fmaxf(sel[2], sel[3]), dq = fminf(sel[2], sel[3]);
            m2 = fmaxf(fminf(a, cq), fmaxf(bq, dq)); }
#define P8_MERGE(CTRL) { const float o1 = dpp_f<CTRL>(m1), o2 = dpp_f<CTRL>(m2); const float n1 = fmaxf(m1, o1); const float n2 = fmaxf(fminf(m1, o1), fmaxf(m2, o2)); m1 = n1; m2 = n2; }
        P8_MERGE(0xB1) P8_MERGE(0x4E) P8_MERGE(0x141)
#undef P8_MERGE
        const float gs = m1 + m2;
        const int grp = lane >> 3;
        int rank = 0;
#pragma unroll
        for (int gq = 0; gq < 8; ++gq) { const float og = __shfl(gs, gq * 8); rank += (og > gs || (og == gs && gq < grp)) ? 1 : 0; }
        const bool gsel = rank < 4;
        float cand[4];
#pragma unroll
        for (int i = 0; i < 4; ++i) cand[i] = gsel ? sel[i] : -INFINITY;
        int my_e = 0; float my_w = 0.f; float wsum = 0.f;
#pragma unroll
        for (int r = 0; r < 8; ++r) {
            float bv = cand[0]; int bi = 0;
#pragma unroll
            for (int i = 1; i < 4; ++i) if (cand[i] > bv) { bv = cand[i]; bi = i; }
            float wm = bv;
            wm = fmaxf(wm, dpp_f<0x128>(wm)); wm = fmaxf(wm, dpp_f<0x124>(wm)); wm = fmaxf(wm, dpp_f<0x122>(wm)); wm = fmaxf(wm, dpp_f<0x121>(wm));
            const float gv = fmaxf(fmaxf(rdlane(wm, 0), rdlane(wm, 16)), fmaxf(rdlane(wm, 32), rdlane(wm, 48)));
            const unsigned long long bal = __ballot(bv == gv);
            const int ol = __builtin_amdgcn_readfirstlane((int)__builtin_ctzll(bal));
            const int oi = __builtin_amdgcn_readlane(bi, ol);
            const int be = ol * 4 + oi;
            const float mys = oi == 0 ? s[0] : (oi == 1 ? s[1] : (oi == 2 ? s[2] : s[3]));
            const float ws_ = rdlane(mys, ol);
            const bool mine = lane == ol;
#pragma unroll
            for (int i = 0; i < 4; ++i) cand[i] = (mine && oi == i) ? -INFINITY : cand[i];
            wsum += ws_;
            if (lane == r) { my_e = be; my_w = ws_; }
        }
        if (lane < 8) {
            const float w = my_w / wsum * 2.5f;
            const unsigned lp = __hip_atomic_fetch_add(hist + my_e, 1u, __ATOMIC_RELAXED, __HIP_MEMORY_SCOPE_WORKGROUP);
            tope[(size_t)tok * 8 + lane] = my_e; topw[(size_t)tok * 8 + lane] = w; lpe[tl * 8 + lane] = ((unsigned)my_e << 16) | lp;
        }
    }
    __syncthreads();
    if (C.tid < 256) { const unsigned c = hist[C.tid]; base[C.tid] = c ? atomicAdd(cnt + C.tid * CNT_STRIDE, c) : 0u; }
    __syncthreads();
    for (int i = C.tid; i < 2048; i += 512) { const unsigned v = lpe[i]; pos[(size_t)blk * 2048 + i] = (int)(base[v >> 16] + (v & 0xffffu)); }
    }
}

__device__ __forceinline__ void tile_prefix(const Args& A, Ctx& C, LAS int* tb) {
    const unsigned* cnt = WSP(unsigned, WS_CTL) + CW_CNT;
    int v = 0;
    if (C.tid < NE) v = ((int)cnt[C.tid * CNT_STRIDE] + 255) >> 8;
#pragma unroll
    for (int d = 1; d < 64; d <<= 1) { const int t = __shfl_up(v, d); if (C.lane >= d) v += t; }
    if (C.tid < NE && C.lane == 63) tb[260 + C.wave] = v;
    __syncthreads();
    if (C.tid < NE) { int off = 0;
#pragma unroll
        for (int q = 0; q < 3; ++q) off += (q < C.wave) ? tb[260 + q] : 0;
        tb[C.tid + 1] = off + v; if (C.tid == 0) tb[0] = 0; }
    __syncthreads();
}
__device__ __forceinline__ void phase_p9(const Args& A, Ctx& C) {
    LAS int* tb = (LAS int*)C.lds;
    tile_prefix(A, C, tb);
    const unsigned* cnt = WSP(unsigned, WS_CTL) + CW_CNT;
    const int* tope = WSP(int, WS_TOPE); const float* topw = WSP(float, WS_TOPW); const int* pos = WSP(int, WS_POS);
    int* rowl = WSP(int, WS_ROWL); float* roww = WSP(float, WS_ROWW); int* tile_e = WSP(int, WS_TILEE);
    const int nrt = tb[NE];
    for (int i = C.bid * 512 + C.tid; i < NLAT * 8; i += C.G * 512) { const int e = tope[i]; const int pr = tb[e] * 256 + pos[i]; rowl[pr] = i; roww[pr] = topw[i]; }
    for (int e = C.bid; e < NE; e += C.G) { const int n = (int)cnt[e * CNT_STRIDE], nt = tb[e + 1] - tb[e];
        for (int j = n + C.tid; j < nt * 256; j += 512) { rowl[tb[e] * 256 + j] = -1; roww[tb[e] * 256 + j] = 0.f; }
        for (int k = C.tid; k < nt; k += 512) tile_e[tb[e] + k] = e; }
    for (int i = C.bid * 512 + C.tid; i < NLAT; i += C.G * 512) { rowl[nrt * 256 + i] = i; roww[nrt * 256 + i] = 1.f; }
    for (int k = C.bid * 512 + C.tid; k < NLAT / 256; k += C.G * 512) tile_e[nrt + k] = NE;
    __syncthreads();
}

__device__ __forceinline__ void phase_moe(const Args& A, Ctx& C, int dry_shared) {
    LAS int* tb = (LAS int*)(C.lds + 131072);
    LAS int* tbl = tb + 320;
    tile_prefix(A, C, tb);
    pg8::MoeCtx M;
    M.nrt = tb[NE]; M.ntiles = M.nrt + NLAT / 256; M.G = C.G; M.vc = (C.G % 8 == 0) ? (C.bid % 8) * (C.G / 8) + C.bid / 8 : C.bid;
    M.tb = tb; M.tbl = tbl; M.cnt = WSP(unsigned, WS_CTL) + CW_CNT; M.rowl = WSP(int, WS_ROWL); M.roww = WSP(float, WS_ROWW);
    M.wexp = (const char*)(A.ws + WS_WEXP); M.h2n = (const char*)(A.ws + WS_H2N8); M.Hs = (char*)(A.ws + WS_HS) + (size_t)C.bid * 2 * 65536;
    M.Y = (unsigned char*)(A.ws + WS_Y); M.out = A.out; M.mod = WSP(const float, WS_MOD); M.dry_shared = dry_shared;
    pg8::gemm_moe(C.lds, M);
    __syncthreads();
}

__device__ __forceinline__ void phase_final(const Args& A, Ctx& C, float* dst) {
    const int gw = C.bid * 8 + C.wave, NGW = C.G * 8;
    const float* fg = A.in[I_FG]; const float* mod = WSP(const float, WS_MOD);
    const unsigned* Y = (const unsigned*)(A.ws + WS_Y);
    for (int row = gw; row < NLAT; row += NGW) {
        f32x4* xr = (f32x4*)(A.out + (size_t)row * D) + C.lane;
        const f32x4* gt = (const f32x4*)(mod + (size_t)(row >> 11) * MODW + 5 * D) + C.lane;
        const unsigned* yr = Y + (size_t)row * 8 * (D / 4) + C.lane;
        f32x4 v[4]; float s = 0.f;
#pragma unroll
        for (int j = 0; j < 4; ++j) {
            f32x4 a = (f32x4){0.f, 0.f, 0.f, 0.f};
#pragma unroll
            for (int sl = 0; sl < 8; ++sl) { const unsigned w = yr[sl * (D / 4) + 64 * j];
                const f32x2 lo = __builtin_amdgcn_cvt_pk_f32_fp8(w, false), hi = __builtin_amdgcn_cvt_pk_f32_fp8(w, true);
                a.x += lo.x; a.y += lo.y; a.z += hi.x; a.w += hi.y; }
            v[j] = xr[64 * j] + gt[64 * j] * a * (1.f / pg8::YSCALE);
            s += (v[j].x * v[j].x + v[j].y * v[j].y) + (v[j].z * v[j].z + v[j].w * v[j].w); }
        const float rstd = __builtin_amdgcn_rsqf(wave_sum(s) * (1.f / D) + NORM_EPS);
        f32x4* orow = (f32x4*)(dst + (size_t)row * D) + C.lane;
#pragma unroll
        for (int j = 0; j < 4; ++j) orow[64 * j] = v[j] * rstd * ((const f32x4*)fg)[C.lane + 64 * j];
    }
}

constexpr int NPHASE = 13;
__global__ void __launch_bounds__(512, 2) fwd_kernel(Args A) {
    extern __shared__ __attribute__((aligned(16))) unsigned char lds_raw[];
    Ctx C; C.lds = (lbyte*)lds_raw; C.tid = threadIdx.x; C.lane = C.tid & 63; C.wave = __builtin_amdgcn_readfirstlane(C.tid >> 6);
    C.G = gridDim.x; C.bid = blockIdx.x; C.a = &A;
    volatile LAS unsigned* misc = (volatile LAS unsigned*)(C.lds + LDS_MISC);
    if (C.tid < 16) misc[C.tid] = 0u;
    __syncthreads();
    XcdBarrier bar; bar.bar = WSP(unsigned, WS_CTL) + CW_BAR; bar.x = 0; bar.st = nullptr;
    const int lo = A.ph_lo, hi = A.ph_hi;
    const bool multi = (hi - lo) > 1;
    if (multi) bar = xcd_barrier_post(WSP(unsigned, WS_CTL) + CW_BAR, misc);
#ifndef PHASE_MASK
#define PHASE_MASK 0x1FFF
#endif
#define IN(k) (((PHASE_MASK >> (k)) & 1) && lo <= (k) && (k) < hi)
#define SEAM(k) do { if (IN(k) && IN((k) + 1)) xcd_barrier(bar); } while (0)
#ifndef REP_MASK
#define REP_MASK 0
#endif
#define REPS(k) (((REP_MASK >> (k)) & 1) ? 2 : 1)

    if (IN(0)) _Pragma("unroll") for (int rep = 0; rep < REPS(0); ++rep) { phase_p0(A, C); __syncthreads(); } SEAM(0);
    if (IN(1)) _Pragma("unroll") for (int rep = 0; rep < REPS(1); ++rep) { phase_p1(A, C); } SEAM(1);
    if (IN(2)) _Pragma("unroll") for (int rep = 0; rep < REPS(2); ++rep) {
        pg8::Gemm g{WSP(bf16_t, WS_XN), D}; pg8::StaticOrder S; S.init(NROWS, PLD, C.G, C.bid, WSP(bf16_t, WS_BTIN), D, 1);
        pg8::EpiBf16 E{WSP(bf16_t, WS_P), PLD, 1.f / SWIN};
        pg8::gemm_phase<pg8::EpiBf16, pg8::StaticOrder, false, 0, false, true>(C.lds, g, S, E);
    } SEAM(2);
    if (IN(3)) _Pragma("unroll") for (int rep = 0; rep < REPS(3); ++rep) { phase_gdn_prep(A, C); } SEAM(3);
#ifdef PROBE_BARRIERS
    if (multi) for (int kq = 0; kq < PROBE_BARRIERS; ++kq) xcd_barrier(bar);
#endif
    if (IN(4)) {
        for (int ch = C.bid; ch < NB * HB * 2; ch += C.G) gdn_chain_chunked(A, C, ch);
        for (int pr = C.bid; pr < NB * HA; pr += C.G) rwkv_pair_chunked(A, C, pr);
    } SEAM(4);
    if (IN(5)) _Pragma("unroll") for (int rep = 0; rep < REPS(5); ++rep) { phase_p4(A, C); } SEAM(5);
    if (IN(6)) _Pragma("unroll") for (int rep = 0; rep < REPS(6); ++rep) {
        pg8::Gemm g{WSP(bf16_t, WS_YMIX), D}; pg8::StaticOrder S; S.init(NLAT, D, C.G, C.bid, WSP(bf16_t, WS_BTOUT), D);
        pg8::EpiResGate E{A.in[I_X], A.out, WSP(float, WS_MOD), 2 * D};
        pg8::gemm_phase<pg8::EpiResGate, pg8::StaticOrder, false>(C.lds, g, S, E);
    } SEAM(6);
    if (IN(7)) _Pragma("unroll") for (int rep = 0; rep < REPS(7); ++rep) { phase_p6(A, C); __syncthreads(); convert_experts(A, C); __syncthreads(); } SEAM(7);
    if (IN(8)) _Pragma("unroll") for (int rep = 0; rep < REPS(8); ++rep) {
        pg8::Gemm g{WSP(bf16_t, WS_H2N), D}; pg8::StaticOrder S; S.init(NLAT, NE, C.G, C.bid, WSP(bf16_t, WS_BTR), D);
        pg8::EpiF32 E{WSP(float, WS_LOGIT), NE};
        pg8::gemm_phase<pg8::EpiF32, pg8::StaticOrder, false>(C.lds, g, S, E);
    } SEAM(8);
    if (IN(9)) { phase_p8(A, C); } SEAM(9);
    if (IN(10)) _Pragma("unroll") for (int rep = 0; rep < REPS(10); ++rep) { phase_p9(A, C); } SEAM(10);
    if (IN(11)) { phase_moe(A, C, 0); if (REPS(11) > 1) { __syncthreads(); phase_moe(A, C, 1); } } SEAM(11);
    if (IN(12)) { if (REPS(12) > 1) { phase_final(A, C, (float*)(A.ws + WS_WEXP)); __syncthreads(); } phase_final(A, C, A.out); }
#undef IN
#undef SEAM
}

extern "C" void kernel_launch(void* const* d_in, const int* in_sizes, int n_in, void* d_out, int out_size, void* d_ws, size_t ws_size, hipStream_t stream) {
    static int grid = 0;
    if (grid == 0) {
        if (n_in != 34 || out_size != NLAT * D || ws_size < WS_END) { fprintf(stderr, "kernel_launch: unexpected shapes (n_in %d out %d ws %zu need %zu)\n", n_in, out_size, ws_size, (size_t)WS_END); grid = -1; return; }
        int dev = 0, cus = 0;
        if (hipGetDevice(&dev) != hipSuccess || hipDeviceGetAttribute(&cus, hipDeviceAttributeMultiprocessorCount, dev) != hipSuccess) { grid = -1; return; }
        if (hipFuncSetAttribute((const void*)fwd_kernel, hipFuncAttributeMaxDynamicSharedMemorySize, LDS_BYTES) != hipSuccess) { fprintf(stderr, "kernel_launch: hipFuncSetAttribute failed\n"); grid = -1; return; }
        int per_cu = 0;
        if (hipOccupancyMaxActiveBlocksPerMultiprocessor(&per_cu, (const void*)fwd_kernel, 512, LDS_BYTES) != hipSuccess || per_cu < 1) { fprintf(stderr, "kernel_launch: occupancy query says %d\n", per_cu); }
        (void)hipGetLastError();
        grid = cus;
    }
    if (grid < 0) return;
    (void)hipMemsetAsync((char*)d_ws + WS_CTL, 0, CTL_BYTES, stream);
    Args a{};
    for (int i = 0; i < 34; ++i) a.in[i] = (const float*)d_in[i];
    a.out = (float*)d_out; a.ws = (unsigned char*)d_ws;
#if MK_PER_PHASE
    for (int p = 0; p < NPHASE; ++p) { a.ph_lo = p; a.ph_hi = p + 1; hipLaunchKernelGGL(fwd_kernel, dim3(grid), dim3(512), LDS_BYTES, stream, a); }
#else
    a.ph_lo = 0; a.ph_hi = NPHASE; hipLaunchKernelGGL(fwd_kernel, dim3(grid), dim3(512), LDS_BYTES, stream, a);
#endif
}
```

```cpp
#include <hip/hip_runtime.h>
#include <cstdio>
#include <cstdint>

#ifndef MK_PER_PHASE
#define MK_PER_PHASE 0
#endif

#define LAS __attribute__((address_space(3)))
typedef unsigned short bf16_t;
typedef short bf16x8 __attribute__((ext_vector_type(8)));
typedef float f32x4 __attribute__((ext_vector_type(4)));
typedef float f32x2 __attribute__((ext_vector_type(2)));
typedef unsigned u32x4 __attribute__((ext_vector_type(4)));
typedef unsigned u32x2 __attribute__((ext_vector_type(2)));
typedef int i32x4 __attribute__((ext_vector_type(4)));
typedef int i32x8 __attribute__((ext_vector_type(8)));
typedef LAS float lfloat;
typedef LAS unsigned char lbyte;

constexpr int D = 1024, NB = 32, SEQ = 2048, CTX = 256, GW = 64;
constexpr int NLAT = NB * SEQ;
constexpr int NCTX = NB * CTX;
constexpr int NROWS = NLAT + NCTX;
constexpr int DA = 512, HA = 8, NA = 64;
constexpr int RW_COLS = 1920, GD_COLS = 2064, IN_COLS = 3984, PLD = 4096;
constexpr int DB = 512, HB = 4, KB = 128;
constexpr int NE = 256, TOPK = 8, DE = 256;
constexpr int MODW = 6 * D;
constexpr float NORM_EPS = 1e-6f, RWKV_EPS = 64e-5f;
constexpr int MAXTILES = (NLAT * TOPK + NE * 255) / 256 + 1;

constexpr size_t MiB = 1u << 20;
constexpr size_t WS_CTL = 0, CTL_BYTES = 1 * MiB;
constexpr size_t WS_MOD = 1 * MiB;
constexpr size_t WS_BTIN = 2 * MiB, WS_BTOUT = 10 * MiB, WS_BTR = 12 * MiB, WS_BON = 13 * MiB, WS_GUPT = 17 * MiB, WS_NRM = 978 * MiB;
constexpr size_t WS_P = 18 * MiB, WS_XN = 594 * MiB, WS_YDIR = 594 * MiB, WS_YMIX = 850 * MiB;
constexpr size_t WS_Y8 = 964 * MiB;
constexpr size_t WS_H2N8 = 900 * MiB;
constexpr size_t WS_H1B = 18 * MiB;
constexpr size_t WS_H2N = 216 * MiB, WS_LOGIT = 146 * MiB, WS_TOPE = 210 * MiB, WS_TOPW = 212 * MiB, WS_POS = 214 * MiB, WS_Y = 146 * MiB;
constexpr size_t WS_ROWL = 658 * MiB, WS_ROWW = 661 * MiB, WS_TILEE = 664 * MiB, WS_HS = 672 * MiB, WS_WEXP = 704 * MiB;
constexpr size_t WEXP_STRIDE = (size_t)(512 * 1024 + 1024 * 256);
constexpr float SW13 = 64.f, SW2 = 32.f, SHS = 8.f, SWIN = 32.f;
constexpr size_t WS_END = 1092 * MiB;
static_assert(WS_WEXP + 257 * WEXP_STRIDE <= WS_END && WS_Y + (size_t)NLAT * 8 * D <= WS_ROWL, "ws map");
constexpr int CW_BAR = 4096;
constexpr int CW_CNT = 16384;
constexpr int CNT_STRIDE = 32;

constexpr int LDS_BYTES = 159744;
constexpr int LDS_MISC = LDS_BYTES - 64;

__device__ __forceinline__ unsigned f2bf(float f) { unsigned u = __builtin_bit_cast(unsigned, f); return (u + 0x7fffu + ((u >> 16) & 1u)) >> 16; }
typedef __bf16 bf16x2_t __attribute__((ext_vector_type(2)));
__device__ __forceinline__ unsigned cvtpk(float lo, float hi) { f32x2 v = {lo, hi}; return __builtin_bit_cast(unsigned, __builtin_convertvector(v, bf16x2_t)); }
__device__ __forceinline__ unsigned pk2(float lo, float hi) { return cvtpk(lo, hi); }
__device__ __forceinline__ unsigned pk4_fp8(float a, float b, float c, float d) { unsigned w = 0u;
    w = __builtin_amdgcn_cvt_pk_fp8_f32(__builtin_amdgcn_fmed3f(a, -448.f, 448.f), __builtin_amdgcn_fmed3f(b, -448.f, 448.f), w, false);
    w = __builtin_amdgcn_cvt_pk_fp8_f32(__builtin_amdgcn_fmed3f(c, -448.f, 448.f), __builtin_amdgcn_fmed3f(d, -448.f, 448.f), w, true); return w; }
__device__ __forceinline__ float bf2f(unsigned short b) { return __builtin_bit_cast(float, ((unsigned)b) << 16); }
__device__ __forceinline__ float bflo(unsigned w) { return __builtin_bit_cast(float, w << 16); }
__device__ __forceinline__ float bfhi(unsigned w) { return __builtin_bit_cast(float, w & 0xffff0000u); }
template <int CTRL> __device__ __forceinline__ float dpp_f(float v) { return __builtin_bit_cast(float, __builtin_amdgcn_update_dpp(0, __builtin_bit_cast(int, v), CTRL, 0xf, 0xf, false)); }
__device__ __forceinline__ float wave_sum(float v) {
    v += dpp_f<0x128>(v);
    v += dpp_f<0x124>(v);
    v += dpp_f<0x122>(v);
    v += dpp_f<0x121>(v);
    const int vi = __builtin_bit_cast(int, v);
    const float r0 = __builtin_bit_cast(float, __builtin_amdgcn_readlane(vi, 0)), r1 = __builtin_bit_cast(float, __builtin_amdgcn_readlane(vi, 16)),
                r2 = __builtin_bit_cast(float, __builtin_amdgcn_readlane(vi, 32)), r3 = __builtin_bit_cast(float, __builtin_amdgcn_readlane(vi, 48));
    return (r0 + r1) + (r2 + r3);
}
__device__ __forceinline__ void wave_sum4(float v0, float v1, float v2, float v3, int lane, float (&s)[4]) {
    const bool b0 = lane & 1, b1 = lane & 2;
    const float a = (b0 ? v1 : v0) + dpp_f<0xB1>(b0 ? v0 : v1);
    const float b = (b0 ? v3 : v2) + dpp_f<0xB1>(b0 ? v2 : v3);
    float c = (b1 ? b : a) + dpp_f<0x4E>(b1 ? a : b);
    c += dpp_f<0x124>(c); c += dpp_f<0x128>(c);
    { const unsigned u = __builtin_bit_cast(unsigned, c); const auto r = __builtin_amdgcn_permlane16_swap(u, u, false, false);
      c = __builtin_bit_cast(float, (unsigned)r[0]) + __builtin_bit_cast(float, (unsigned)r[1]); }
    { const unsigned u = __builtin_bit_cast(unsigned, c); const auto r = __builtin_amdgcn_permlane32_swap(u, u, false, false);
      c = __builtin_bit_cast(float, (unsigned)r[0]) + __builtin_bit_cast(float, (unsigned)r[1]); }
    const int ci = __builtin_bit_cast(int, c);
    s[0] = __builtin_bit_cast(float, __builtin_amdgcn_readlane(ci, 0)); s[1] = __builtin_bit_cast(float, __builtin_amdgcn_readlane(ci, 1));
    s[2] = __builtin_bit_cast(float, __builtin_amdgcn_readlane(ci, 2)); s[3] = __builtin_bit_cast(float, __builtin_amdgcn_readlane(ci, 3));
}
__device__ __forceinline__ float sigmoidf_(float x) { return __builtin_amdgcn_rcpf(1.f + __expf(-x)); }
__device__ __forceinline__ float siluf_(float x) { return x * __builtin_amdgcn_rcpf(1.f + __expf(-x)); }
__device__ __forceinline__ float softplusf_(float x) { return fmaxf(x, 0.f) + __logf(1.f + __expf(-fabsf(x))); }
__device__ __forceinline__ float tanhf_(float x) { return 2.f * __builtin_amdgcn_rcpf(1.f + __expf(-2.f * x)) - 1.f; }

#define XB_TMO      128
#define XB_XCNT(j)  (256  + 64 * (j))
#define XB_XSUB(j)  (1280 + 64 * (j))
#define XB_XGEN(j)  (2304 + 64 * (j))
#define XB_TOP      3328
#define XB_TOPGEN   3392
#define XCD_BAR_WORDS 3456
#define XB_SPIN_CAP (1u << 22)
__device__ __forceinline__ unsigned xb_ld(unsigned* p)              { return __hip_atomic_load(p, __ATOMIC_RELAXED, __HIP_MEMORY_SCOPE_AGENT); }
__device__ __forceinline__ unsigned xb_add(unsigned* p, unsigned v) { return __hip_atomic_fetch_add(p, v, __ATOMIC_RELAXED, __HIP_MEMORY_SCOPE_AGENT); }
__device__ __forceinline__ unsigned xb_xcc_id() { return (unsigned)__builtin_amdgcn_s_getreg((3 << 11) | 20) & 0xFu; }
#define XB_SPIN(cond, bar) do { unsigned _sp = 0; while (cond) { __builtin_amdgcn_s_sleep(1); \
    if ((++_sp & 255u) == 0u) { if (xb_ld(&(bar)[XB_TMO])) break; if (_sp > XB_SPIN_CAP) { atomicAdd(&(bar)[XB_TMO], 1u); break; } } } } while (0)
struct XcdBarrier { unsigned* bar; unsigned x; volatile LAS unsigned* st; };
__device__ __forceinline__ XcdBarrier xcd_barrier_post(unsigned* bar, volatile LAS unsigned* st) {
    XcdBarrier b; b.bar = bar; b.x = xb_xcc_id(); b.st = st;
    if (threadIdx.x == 0) (void)xb_add(&bar[XB_XCNT(b.x)], 1u);
    return b;
}
__device__ __forceinline__ void xcd_barrier_complete(unsigned* bar, unsigned x, unsigned& nloc, unsigned& nx) {
    const unsigned G = gridDim.x * gridDim.y * gridDim.z;
    unsigned sum, cnt, mine, sp = 0u;
    for (;;) {
        sum = 0u; cnt = 0u; mine = 0u;
#pragma unroll
        for (unsigned j = 0; j < 16; ++j) { const unsigned c = xb_ld(&bar[XB_XCNT(j)]); sum += c; cnt += (c > 0u) ? 1u : 0u; mine = (j == x) ? c : mine; }
        if (sum == G) break;
        __builtin_amdgcn_s_sleep(1);
        if ((++sp & 255u) == 0u) { if (xb_ld(&bar[XB_TMO])) break; if (sp > XB_SPIN_CAP) { atomicAdd(&bar[XB_TMO], 1u); break; } }
    }
    nloc = mine > 0u ? mine : 1u; nx = cnt > 0u ? cnt : 1u;
}
__device__ __forceinline__ void xcd_barrier(const XcdBarrier& b) {
    asm volatile("s_waitcnt vmcnt(0)" ::: "memory");
    __syncthreads();
    if (threadIdx.x == 0) {
        unsigned* bar = b.bar;
        __builtin_amdgcn_s_waitcnt(0);
        unsigned nloc = b.st[0], nx = b.st[1];
        if (nloc == 0u) { xcd_barrier_complete(bar, b.x, nloc, nx); b.st[0] = nloc; b.st[1] = nx; }
        const unsigned old = xb_add(&bar[XB_XSUB(b.x)], 1u);
        const unsigned gen = old / nloc;
        if (old + 1u == (gen + 1u) * nloc) {
            __builtin_amdgcn_fence(__ATOMIC_RELEASE, "agent");
            asm volatile("s_waitcnt vmcnt(0)" ::: "memory");
            const unsigned og = xb_add(&bar[XB_TOP], 1u);
            const unsigned tg = og / nx;
            if (og + 1u == (tg + 1u) * nx) xb_add(&bar[XB_TOPGEN], 1u);
            else XB_SPIN(xb_ld(&bar[XB_TOPGEN]) == tg, bar);
            __builtin_amdgcn_fence(__ATOMIC_ACQUIRE, "agent");
            xb_add(&bar[XB_XGEN(b.x)], 1u);
            asm volatile("s_waitcnt vmcnt(0)" ::: "memory");
        } else {
            XB_SPIN(xb_ld(&bar[XB_XGEN(b.x)]) == gen, bar);
            __builtin_amdgcn_fence(__ATOMIC_ACQUIRE, "agent");
            asm volatile("s_waitcnt vmcnt(0)" ::: "memory");
        }
    }
    __syncthreads();
}

struct Args {
    const float* in[34];
    float* out;
    unsigned char* ws;
    int ph_lo, ph_hi;
};
enum { I_X = 0, I_C, I_CTX, I_CCTX, I_WADA, I_BADA, I_N1G, I_WIN, I_MU, I_W0, I_WUP, I_A0, I_AUP, I_GUP, I_KK, I_KA, I_RK, I_LNW, I_LNB,
       I_CONVW, I_ALOG, I_DTB, I_ONG, I_WOUT, I_N2G, I_RW, I_RB, I_EW1, I_EW3, I_EW2, I_SW1, I_SW3, I_SW2, I_FG };

namespace pg8 {
constexpr int BM = 256, BK = 64, HALF = 128, HTB = HALF * BK * 2, STAGE_BYTES = 8 * HTB, NXCD = 8, WGM = 8;
__host__ __device__ __forceinline__ int lds_byte(int r, int c) { const int st = (r >> 4) * 2 + (c >> 5), rr = r & 15, cc = c & 31, ob = rr * 64 + cc * 2; return st * 1024 + (ob ^ (((ob >> 9) & 1) << 5)); }
__host__ __device__ __forceinline__ void stage_rc(int b, int& R, int& C) { const int st = b / 1024, sb = b % 1024, swz = sb ^ (((sb >> 9) & 1) << 5); R = (st >> 1) * 16 + swz / 64; C = (st & 1) * 32 + (swz % 64) / 2; }
__host__ __device__ __forceinline__ int perm32(int rho) { const int n = rho >> 4, i = rho & 15; return 8 * (i >> 2) + 4 * n + (i & 3); }
struct Unit { int pm, pn; };
struct Gemm { const bf16_t* A; int K; };
struct StaticOrder {
    int nM, nN, nwg, G, c; const char* Bt; size_t tstepB;
    __device__ void init(int M, int N, int G_, int c_, const void* Bt_, int K, int es = 2) { nM = M / BM; nN = N / BM; nwg = nM * nN; G = G_; c = c_; Bt = (const char*)Bt_; tstepB = (size_t)BM * K * es; }
    __device__ bool next(int i, Unit& u) const {
        const long L = (long)i * G + c; if (L >= nwg) return false;
        int wgid = (int)L; { const int q = nwg / NXCD, r = nwg % NXCD, xcd = wgid % NXCD, off = wgid / NXCD; wgid = (xcd < r ? xcd * (q + 1) : r * (q + 1) + (xcd - r) * q) + off; }
        const int nig = WGM * nN, gid = wgid / nig, fm = gid * WGM, gsz = (nM - fm) < WGM ? (nM - fm) : WGM;
        u.pm = fm + ((wgid % nig) % gsz); u.pn = (wgid % nig) / gsz; return true;
    }
    __device__ __forceinline__ const char* bptr(const Unit& u) const { return Bt + (size_t)u.pn * tstepB; }
    __device__ __forceinline__ int rowsel(const Unit&, int) const { return 0; }
};
struct TileOrder {
    int nunits, npn, G, c; const int* tile_e; const char* wbase; size_t wstride, woff, tstepB; const int* rowl;
    __device__ bool next(int i, Unit& u) const { const int L = i * G + c; if (L >= nunits) return false; u.pm = L / npn; u.pn = L - u.pm * npn; return true; }
    __device__ __forceinline__ const char* bptr(const Unit& u) const { const int e = __builtin_amdgcn_readfirstlane(tile_e[u.pm]); return wbase + (size_t)e * wstride + woff + (size_t)u.pn * tstepB; }
    __device__ __forceinline__ int rowsel(const Unit& u, int r) const { const int t = rowl[(size_t)u.pm * 256 + r]; return t < 0 ? 0 : t; }
};
struct SeqOrder {
    int n; const char* Bt; size_t tstepB; const LAS int* rsel;
    __device__ bool next(int i, Unit& u) const { if (i >= n) return false; u.pm = 0; u.pn = i; return true; }
    __device__ __forceinline__ const char* bptr(const Unit& u) const { return Bt + (size_t)u.pn * tstepB; }
    __device__ __forceinline__ int rowsel(const Unit&, int r) const { return rsel[r]; }
};
__device__ __forceinline__ unsigned cvt_pk_bf16(float lo, float hi) { return cvtpk(lo, hi); }

template <class Epi, class Sched, bool GATHER, int A_AUX = 0, bool ALIGN = true, bool FP8 = false>
__device__ __forceinline__ void gemm_phase(lbyte* lds, const Gemm g, const Sched& S, const Epi& E) {
    int tid_ = threadIdx.x; asm volatile("" : "+v"(tid_));
    const int tid = tid_, wid = __builtin_amdgcn_readfirstlane(tid >> 6), lane = tid & 63, wr = wid >> 2, wc = wid & 3, fr = lane & 15, fq = lane >> 4;
    constexpr unsigned ES = FP8 ? 1u : 2u;
    const int K = g.K, nt = FP8 ? K / 128 : K / BK;
    Unit cur, nxt; int ui = 0;
    if (!S.next(0, cur)) return;
    int Rst[2], Cst[2];
    unsigned voffA[2], voffA1[2], voffB[2], nvA[2], nvA1[2];
#pragma unroll
    for (int i = 0; i < 2; ++i) { int R, C; stage_rc(tid * 16 + i * 8192, R, C); const int Rb = Epi::PERM ? ((R & ~31) + perm32(R & 31)) : R; Rst[i] = R; Cst[i] = C;
        if (GATHER) { voffA[i] = (unsigned)S.rowsel(cur, R) * (unsigned)K * ES + (unsigned)C * 2u; voffA1[i] = (unsigned)S.rowsel(cur, 128 + R) * (unsigned)K * ES + (unsigned)C * 2u; }
        else { voffA[i] = (unsigned)(R * K) * ES + (unsigned)C * 2u; voffA1[i] = voffA[i]; }
        nvA[i] = voffA[i]; nvA1[i] = voffA1[i];
        voffB[i] = (unsigned)(Rb * K) * ES + (unsigned)C * 2u; }
    const size_t kstep = (size_t)(BK * 2);
    const size_t hstep = (size_t)HALF * K * ES;
    const size_t hstepA = GATHER ? 0 : hstep;
    const size_t tstep = 2 * hstep;
    const unsigned ldsw = (unsigned)wid * 1024u;
    const int aoff = lds_byte(wr * 64 + fr, fq * 8), boff = lds_byte(wc * 32 + fr, fq * 8);
#define PG8_SA(b, h) (((b) * 2 + (h)) * HTB)
#define PG8_SB(b, h) ((4 + (b) * 2 + (h)) * HTB)
#define PG8_STAGE2(bufoff, gbase, v0, v1) do { \
        __builtin_amdgcn_global_load_lds((const unsigned*)((const char*)(gbase) + (v0)), (LAS unsigned*)(lds + (bufoff) + ldsw), 16, 0, 0); \
        __builtin_amdgcn_global_load_lds((const unsigned*)((const char*)(gbase) + (v1)), (LAS unsigned*)(lds + (bufoff) + ldsw + 8192), 16, 0, 0); } while (0)
#define PG8_STAGE2A(bufoff, gbase, v0, v1) do { if constexpr (A_AUX == 16) { \
        __builtin_amdgcn_global_load_lds((const unsigned*)((const char*)(gbase) + (v0)), (LAS unsigned*)(lds + (bufoff) + ldsw), 16, 0, 16); \
        __builtin_amdgcn_global_load_lds((const unsigned*)((const char*)(gbase) + (v1)), (LAS unsigned*)(lds + (bufoff) + ldsw + 8192), 16, 0, 16); } else { PG8_STAGE2(bufoff, gbase, v0, v1); } } while (0)
#define PG8_STAGE(bufoff, gbase, voff) PG8_STAGE2(bufoff, gbase, (voff)[0], (voff)[1])
#define PG8_STAGEA(bufoff, gbase, voff) PG8_STAGE2A(bufoff, gbase, (voff)[0], (voff)[1])
#define G_LD32(p) __builtin_shufflevector(*(const LAS i32x4*)(p), *(const LAS i32x4*)((p) + 1024), 0, 1, 2, 3, 4, 5, 6, 7)
#define G_MFMA8(c, a, b) asm volatile("v_mfma_scale_f32_16x16x128_f8f6f4 %0, %1, %2, %0, %3, %3 op_sel_hi:[0,0,0]" : "+v"(c) : "v"(a), "v"(b), "v"(one_scale))
#define PG8_LDA(dst, b, h) do { if constexpr (FP8) { _Pragma("unroll") for (int m = 0; m < 4; ++m) dst##8[m] = G_LD32(lds + PG8_SA(b, h) + aoff + m * 2048); } else { \
        _Pragma("unroll") for (int m = 0; m < 4; ++m) _Pragma("unroll") for (int k = 0; k < 2; ++k) dst[m][k] = *(const LAS bf16x8*)(lds + PG8_SA(b, h) + aoff + m * 2048 + k * 1024); } } while (0)
#define PG8_LDB(dst, b, h) do { if constexpr (FP8) { _Pragma("unroll") for (int n = 0; n < 2; ++n) dst##8[n] = G_LD32(lds + PG8_SB(b, h) + boff + n * 2048); } else { \
        _Pragma("unroll") for (int n = 0; n < 2; ++n) _Pragma("unroll") for (int k = 0; k < 2; ++k) dst[n][k] = *(const LAS bf16x8*)(lds + PG8_SB(b, h) + boff + n * 2048 + k * 1024); } } while (0)
#define PG8_MMA(ai, bj, At, Bt) do { __builtin_amdgcn_s_setprio(1); if constexpr (FP8) { _Pragma("unroll") for (int m = 0; m < 4; ++m) _Pragma("unroll") for (int n = 0; n < 2; ++n) G_MFMA8(acc[ai][bj][m][n], Bt##8[n], At##8[m]); } else { \
        _Pragma("unroll") for (int m = 0; m < 4; ++m) _Pragma("unroll") for (int n = 0; n < 2; ++n) _Pragma("unroll") for (int k = 0; k < 2; ++k) \
        acc[ai][bj][m][n] = __builtin_amdgcn_mfma_f32_16x16x32_bf16(Bt[n][k], At[m][k], acc[ai][bj][m][n], 0, 0, 0); } __builtin_amdgcn_s_setprio(0); } while (0)
#define PG8_WAIT_V(n) asm volatile("s_waitcnt vmcnt(" #n ")" ::: "memory")
#define PG8_WAIT_L(n) asm volatile("s_waitcnt lgkmcnt(" #n ")" ::: "memory")
#define PG8_BAR __builtin_amdgcn_s_barrier()
#define PG8_SCHED __builtin_amdgcn_sched_barrier(0)
    f32x4 acc[2][2][4][2];
#pragma unroll
    for (int a = 0; a < 2; ++a)
#pragma unroll
        for (int b = 0; b < 2; ++b)
#pragma unroll
            for (int m = 0; m < 4; ++m)
#pragma unroll
                for (int n = 0; n < 2; ++n) acc[a][b][m][n] = (f32x4){0.f, 0.f, 0.f, 0.f};
    bf16x8 At[4][2], B0[2][2], B1[2][2]; i32x8 At8[4], B08[2], B18[2];
    int one_scale = 0x7F7F7F7F; asm volatile("" : "+v"(one_scale));
    const char* cA = (const char*)g.A + (GATHER ? (size_t)0 : (size_t)cur.pm * tstep); const char* cB = S.bptr(cur);
    PG8_STAGE(PG8_SB(0, 0), cB, voffB); PG8_STAGE(PG8_SB(0, 1), cB + hstep, voffB); PG8_STAGEA(PG8_SA(0, 0), cA, voffA); PG8_STAGEA(PG8_SA(0, 1), cA + hstepA, voffA1);
    if (wr == 1) PG8_BAR;
    PG8_WAIT_V(2); PG8_BAR;
    PG8_STAGE(PG8_SB(1, 0), cB + kstep, voffB); PG8_STAGEA(PG8_SA(1, 0), cA + kstep, voffA); PG8_STAGE(PG8_SB(1, 1), cB + hstep + kstep, voffB);
    PG8_WAIT_V(6); PG8_BAR;
    for (;;) {
        const bool has_next = S.next(ui + 1, nxt);
        const char* nA = has_next ? (const char*)g.A + (GATHER ? (size_t)0 : (size_t)nxt.pm * tstep) : cA; const char* nB = has_next ? S.bptr(nxt) : cB;
        for (int t = 0; t < nt; t += 2) {
            const bool last = (t == nt - 2);
            const char* a1 = cA + (size_t)(t + 1) * kstep;
            const char* a2 = last ? nA : cA + (size_t)(t + 2) * kstep; const char* b2 = last ? nB : cB + (size_t)(t + 2) * kstep;
            const char* a3 = a2 + kstep; const char* b3 = b2 + kstep;
            if (GATHER && last && has_next) {
#pragma unroll
                for (int i = 0; i < 2; ++i) { nvA[i] = (unsigned)S.rowsel(nxt, Rst[i]) * (unsigned)K * ES + (unsigned)Cst[i] * 2u; nvA1[i] = (unsigned)S.rowsel(nxt, 128 + Rst[i]) * (unsigned)K * ES + (unsigned)Cst[i] * 2u; }
            }
            const unsigned x0 = (GATHER && last) ? nvA[0] : voffA[0], x1 = (GATHER && last) ? nvA[1] : voffA[1];
            const unsigned y0 = (GATHER && last) ? nvA1[0] : voffA1[0], y1 = (GATHER && last) ? nvA1[1] : voffA1[1];
            PG8_LDB(B0, 0, 0); PG8_LDB(B1, 0, 1); PG8_SCHED; PG8_LDA(At, 0, 0); PG8_STAGEA(PG8_SA(1, 1), a1 + hstepA, voffA1);
            PG8_WAIT_V(8); PG8_WAIT_L(0); PG8_BAR; PG8_MMA(0, 0, At, B0); PG8_MMA(0, 1, At, B1); PG8_BAR; PG8_SCHED;
            PG8_LDA(At, 0, 1); PG8_STAGE(PG8_SB(0, 0), b2, voffB); PG8_STAGE(PG8_SB(0, 1), b2 + hstep, voffB); PG8_STAGE2A(PG8_SA(0, 0), a2, x0, x1);
            PG8_WAIT_V(8); PG8_WAIT_L(0); PG8_BAR; PG8_MMA(1, 0, At, B0); PG8_MMA(1, 1, At, B1); PG8_BAR; PG8_SCHED;
            PG8_LDB(B0, 1, 0); PG8_LDB(B1, 1, 1); PG8_SCHED; PG8_LDA(At, 1, 0); PG8_STAGE2A(PG8_SA(0, 1), a2 + hstepA, y0, y1);
            PG8_WAIT_V(8); PG8_WAIT_L(0); PG8_BAR; PG8_MMA(0, 0, At, B0); PG8_MMA(0, 1, At, B1); PG8_BAR; PG8_SCHED;
            PG8_LDA(At, 1, 1); PG8_STAGE(PG8_SB(1, 0), b3, voffB); PG8_STAGE(PG8_SB(1, 1), b3 + hstep, voffB); PG8_STAGE2A(PG8_SA(1, 0), a3, x0, x1);
            PG8_WAIT_V(8); PG8_WAIT_L(0); PG8_BAR; PG8_MMA(1, 0, At, B0); PG8_MMA(1, 1, At, B1); PG8_BAR; PG8_SCHED;
        }
        if (ALIGN && wr == 0) PG8_BAR;
        if constexpr (FP8) asm volatile("s_nop 15\n\ts_nop 15" ::: "memory");
        E(acc, cur, wr, wc, fr, fq);
        if (!has_next) break;
#pragma unroll
        for (int a = 0; a < 2; ++a)
#pragma unroll
            for (int b = 0; b < 2; ++b)
#pragma unroll
                for (int m = 0; m < 4; ++m)
#pragma unroll
                    for (int n = 0; n < 2; ++n) acc[a][b][m][n] = (f32x4){0.f, 0.f, 0.f, 0.f};
        cur = nxt; cA = nA; cB = nB; ++ui;
        if (GATHER) { voffA[0] = nvA[0]; voffA[1] = nvA[1]; voffA1[0] = nvA1[0]; voffA1[1] = nvA1[1]; }
        if (ALIGN && wr == 1) PG8_BAR;
    }
    PG8_WAIT_V(0);
    if (!ALIGN && wr == 0) PG8_BAR;
    PG8_BAR;
#undef PG8_SA
#undef PG8_SB
#undef PG8_STAGE
#undef PG8_STAGE2
#undef PG8_STAGE2A
#undef PG8_STAGEA
#undef G_LD32
#undef G_MFMA8
#undef PG8_LDA
#undef PG8_LDB
#undef PG8_MMA
#undef PG8_WAIT_V
#undef PG8_WAIT_L
#undef PG8_BAR
#undef PG8_SCHED
}

struct EpiBf16 {
    static constexpr bool PERM = true;
    bf16_t* O; int ldc; float scale;
    __device__ __forceinline__ void operator()(const f32x4 (&acc)[2][2][4][2], const Unit& u, int wr, int wc, int fr, int fq) const {
        const int row0 = u.pm * BM + wr * 64 + fr; const int col0 = u.pn * BM + wc * 32 + 8 * fq;
#pragma unroll
        for (int ai = 0; ai < 2; ++ai)
#pragma unroll
            for (int m = 0; m < 4; ++m) { bf16_t* rowp = O + (size_t)(row0 + ai * HALF + m * 16) * ldc + col0;
#pragma unroll
                for (int bj = 0; bj < 2; ++bj) { const f32x4 v0 = acc[ai][bj][m][0] * scale, v1 = acc[ai][bj][m][1] * scale;
                    u32x4 w; w.x = cvt_pk_bf16(v0[0], v0[1]); w.y = cvt_pk_bf16(v0[2], v0[3]); w.z = cvt_pk_bf16(v1[0], v1[1]); w.w = cvt_pk_bf16(v1[2], v1[3]);
                    *(u32x4*)(rowp + bj * HALF) = w; } }
    }
};
struct EpiF32 {
    static constexpr bool PERM = false;
    float* C; int ldc;
    __device__ __forceinline__ void operator()(const f32x4 (&acc)[2][2][4][2], const Unit& u, int wr, int wc, int fr, int fq) const {
        const int row0 = u.pm * BM + wr * 64 + fr, col0 = u.pn * BM + wc * 32 + 4 * fq;
#pragma unroll
        for (int ai = 0; ai < 2; ++ai)
#pragma unroll
            for (int m = 0; m < 4; ++m) { float* rowp = C + (size_t)(row0 + ai * HALF + m * 16) * ldc + col0;
#pragma unroll
                for (int bj = 0; bj < 2; ++bj)
#pragma unroll
                    for (int n = 0; n < 2; ++n) *(f32x4*)(rowp + bj * HALF + n * 16) = acc[ai][bj][m][n]; }
    }
};
struct EpiResGate {
    static constexpr bool PERM = false;
    const float* x; float* out; const float* mod; int gate_off;
    __device__ __forceinline__ void operator()(const f32x4 (&acc)[2][2][4][2], const Unit& u, int wr, int wc, int fr, int fq) const {
        const int row0 = u.pm * BM + wr * 64 + fr, col0 = u.pn * BM + wc * 32 + 4 * fq;
        const float* gp = mod + (size_t)((u.pm * BM) >> 11) * MODW + gate_off + col0;
        f32x4 gv[2][2];
#pragma unroll
        for (int bj = 0; bj < 2; ++bj)
#pragma unroll
            for (int n = 0; n < 2; ++n) gv[bj][n] = *(const f32x4*)(gp + bj * HALF + n * 16);
#pragma unroll
        for (int ai = 0; ai < 2; ++ai)
#pragma unroll
            for (int m = 0; m < 4; ++m) { const size_t off = (size_t)(row0 + ai * HALF + m * 16) * D + col0;
#pragma unroll
                for (int bj = 0; bj < 2; ++bj)
#pragma unroll
                    for (int n = 0; n < 2; ++n) { const f32x4 xv = *(const f32x4*)(x + off + bj * HALF + n * 16);
                        *(f32x4*)(out + off + bj * HALF + n * 16) = xv + gv[bj][n] * acc[ai][bj][m][n]; }
                asm volatile("" ::: "memory"); }
    }
};
struct EpiResGateB {
    static constexpr bool PERM = true;
    const float* x; bf16_t* out; const float* mod; int gate_off;
    __device__ __forceinline__ void operator()(const f32x4 (&acc)[2][2][4][2], const Unit& u, int wr, int wc, int fr, int fq) const {
        const int row0 = u.pm * BM + wr * 64 + fr, col0 = u.pn * BM + wc * 32 + 8 * fq;
        const float* gp = mod + (size_t)((u.pm * BM) >> 11) * MODW + gate_off + col0;
        f32x4 gv[2][2];
#pragma unroll
        for (int bj = 0; bj < 2; ++bj)
#pragma unroll
            for (int n = 0; n < 2; ++n) gv[bj][n] = *(const f32x4*)(gp + bj * HALF + n * 4);
#pragma unroll
        for (int ai = 0; ai < 2; ++ai)
#pragma unroll
            for (int m = 0; m < 4; ++m) { const size_t off = (size_t)(row0 + ai * HALF + m * 16) * D + col0;
#pragma unroll
                for (int bj = 0; bj < 2; ++bj) { const f32x4 x0 = *(const f32x4*)(x + off + bj * HALF), x1 = *(const f32x4*)(x + off + bj * HALF + 4);
                    const f32x4 v0 = x0 + gv[bj][0] * acc[ai][bj][m][0], v1 = x1 + gv[bj][1] * acc[ai][bj][m][1];
                    u32x4 w; w.x = cvt_pk_bf16(v0[0], v0[1]); w.y = cvt_pk_bf16(v0[2], v0[3]); w.z = cvt_pk_bf16(v1[0], v1[1]); w.w = cvt_pk_bf16(v1[2], v1[3]);
                    *(u32x4*)(out + off + bj * HALF) = w; }
                asm volatile("" ::: "memory"); }
    }
};
struct EpiGLU {
    static constexpr bool PERM = true;
    bf16_t* H;
    __device__ __forceinline__ void operator()(const f32x4 (&acc)[2][2][4][2], const Unit& u, int wr, int wc, int fr, int fq) const {
        const int row0 = u.pm * BM + wr * 64 + fr; const int col0 = u.pn * 128 + wc * 32 + 8 * fq;
#pragma unroll
        for (int ai = 0; ai < 2; ++ai)
#pragma unroll
            for (int m = 0; m < 4; ++m) { bf16_t* rowp = H + (size_t)(row0 + ai * HALF + m * 16) * 256 + col0;
                f32x4 h0, h1;
#pragma unroll
                for (int j = 0; j < 4; ++j) { const float a0 = acc[ai][0][m][0][j], a1 = acc[ai][0][m][1][j];
                    h0[j] = siluf_(a0) * acc[ai][1][m][0][j]; h1[j] = siluf_(a1) * acc[ai][1][m][1][j]; }
                u32x4 w; w.x = cvt_pk_bf16(h0[0], h0[1]); w.y = cvt_pk_bf16(h0[2], h0[3]); w.z = cvt_pk_bf16(h1[0], h1[1]); w.w = cvt_pk_bf16(h1[2], h1[3]);
                *(u32x4*)rowp = w; }
    }
};
constexpr float YSCALE = 8.f;
struct EpiY {
    static constexpr bool PERM = true;
    unsigned char* Y; float* out; const float* mod; const LAS int* rtok; const LAS float* rw; int shared;
    __device__ __forceinline__ void operator()(const f32x4 (&acc)[2][2][4][2], const Unit& u, int wr, int wc, int fr, int fq) const {
        const int col0 = u.pn * BM + wc * 32 + 8 * fq;
#pragma unroll
        for (int ai = 0; ai < 2; ++ai)
#pragma unroll
            for (int m = 0; m < 4; ++m) { const int r = wr * 64 + fr + ai * HALF + m * 16; const int ts = rtok[r]; const float w = rw[r];
                if (ts >= 0) {
                    if (shared) { const unsigned goff = (unsigned)(ts >> 11) * MODW + 5 * D + col0; const unsigned ooff = (unsigned)ts * D + col0;
#pragma unroll
                        for (int bj = 0; bj < 2; ++bj)
#pragma unroll
                            for (int n = 0; n < 2; ++n) { const f32x4 gv = *(const f32x4*)(mod + goff + bj * HALF + n * 4); f32x4* op = (f32x4*)(out + ooff + bj * HALF + n * 4);
                                *op = *op + gv * acc[ai][bj][m][n]; }
                    } else { unsigned char* yp = Y + (size_t)(unsigned)ts * D + col0; const float ws_ = w * YSCALE;
#pragma unroll
                        for (int bj = 0; bj < 2; ++bj) { f32x4 v0 = acc[ai][bj][m][0] * ws_, v1 = acc[ai][bj][m][1] * ws_;
#pragma unroll
                                for (int j = 0; j < 4; ++j) { v0[j] = __builtin_amdgcn_fmed3f(v0[j], -448.f, 448.f); v1[j] = __builtin_amdgcn_fmed3f(v1[j], -448.f, 448.f); }
                            unsigned lo = 0u, hi = 0u;
                            lo = __builtin_amdgcn_cvt_pk_fp8_f32(v0[0], v0[1], lo, false); lo = __builtin_amdgcn_cvt_pk_fp8_f32(v0[2], v0[3], lo, true);
                            hi = __builtin_amdgcn_cvt_pk_fp8_f32(v1[0], v1[1], hi, false); hi = __builtin_amdgcn_cvt_pk_fp8_f32(v1[2], v1[3], hi, true);
                            u32x2 pk; pk.x = lo; pk.y = hi; *(u32x2*)(yp + bj * HALF) = pk; } } }
                asm volatile("" ::: "memory"); }
    }
};

struct MoeCtx {
    int ntiles, nrt, G, vc;
    const LAS int* tb; LAS int* tbl;
    const unsigned* cnt; const int* rowl; const float* roww;
    const char* wexp; const char* h2n; char* Hs; unsigned char* Y; float* out; const float* mod; int dry_shared;
};
__device__ __forceinline__ void gemm_moe(lbyte* lds, const MoeCtx& M) {
    int tid_ = threadIdx.x; asm volatile("" : "+v"(tid_));
    const int tid = tid_, wid = __builtin_amdgcn_readfirstlane(tid >> 6), lane = tid & 63, wr = wid >> 2, wc = wid & 3, fr = lane & 15, fq = lane >> 4;
    const int ntl = (M.ntiles - M.vc + M.G - 1) / M.G;
    if (M.vc >= M.ntiles) return;
    const int nunits = ntl * 6;
    const unsigned ldsw = (unsigned)wid * 1024u;
    const int aoff = lds_byte(wr * 64 + fr, fq * 8), boff = lds_byte(wc * 32 + fr, fq * 8);
    auto tile_expert = [&](int tile, int& e, int& k) { if (tile < M.nrt) { int lo = 0, hi = NE - 1; while (lo < hi) { const int mid = (lo + hi + 1) >> 1; if (M.tb[mid] <= tile) lo = mid; else hi = mid - 1; } e = lo; k = tile - M.tb[lo]; } else { e = NE; k = tile - M.nrt; } };
    auto fill = [&](int j) { if (j < ntl && tid < 256) { const int tile = M.vc + j * M.G; int e, k; tile_expert(tile, e, k); LAS int* T = M.tbl + (j % 3) * 768;
            int ts; float w;
            if (e < NE) { const int valid = (int)M.cnt[e * CNT_STRIDE] - 256 * k; if (tid < valid) { ts = M.rowl[(size_t)tile * 256 + tid]; w = M.roww[(size_t)tile * 256 + tid]; } else { ts = -1; w = 0.f; } T[tid] = ts < 0 ? 0 : (ts >> 3); }
            else { ts = k * 256 + tid; w = 1.f; T[tid] = ts; }
            T[256 + tid] = ts; ((LAS float*)T)[512 + tid] = w; } };
    struct UP { const char* aB; const char* bB; unsigned bh; int nt, kind, pn, slot, shared, e, hbuf, fillnext; };
    auto unit_params = [&](int ui, int prev_e, UP& u, unsigned (&oa)[4], unsigned (&ob)[2]) {
        int tq = threadIdx.x; asm volatile("" : "+v"(tq));
        int Rst[2], Cst[2], Rbp[2];
#pragma unroll
        for (int i = 0; i < 2; ++i) { int R, C; stage_rc(tq * 16 + i * 8192, R, C); Rst[i] = R; Cst[i] = C; Rbp[i] = (R & ~31) + perm32(R & 31); }
        int j, sub;
        if (ui < 2) { j = 0; sub = ui; }
        else { const int qq = ui - 2, g = qq / 6, r = qq - 6 * g; if (g < ntl - 1 && r < 2) { j = g + 1; sub = r; } else { j = g; sub = (g < ntl - 1) ? r : r + 2; } }
        const int tile = M.vc + j * M.G; int e, k;
        if (sub == 0 || sub == 2) tile_expert(tile, e, k); else e = prev_e;
        u.e = e;
        const char* w = M.wexp + (size_t)e * WEXP_STRIDE;
        u.slot = j % 3; u.hbuf = j & 1; u.fillnext = (sub == 1) ? j + 1 : -1; u.shared = (e == NE) ? 1 : 0;
        if (sub < 2) { u.kind = 0; u.pn = sub; u.nt = D / 128; u.aB = M.h2n; u.bB = w + (size_t)sub * 256 * D; u.bh = 128u * D;
            const LAS int* T = M.tbl + (j % 3) * 768;
#pragma unroll
            for (int i = 0; i < 2; ++i) { oa[i] = (unsigned)T[Rst[i]] * (unsigned)D + 2u * (unsigned)Cst[i]; oa[2 + i] = (unsigned)T[128 + Rst[i]] * (unsigned)D + 2u * (unsigned)Cst[i]; ob[i] = (unsigned)(Rbp[i] * D + 2 * Cst[i]); } }
        else { u.kind = 1; u.pn = sub - 2; u.nt = DE / 128; u.aB = M.Hs + (j & 1) * 65536; u.bB = w + (size_t)512 * 1024 + (size_t)(sub - 2) * 256 * DE; u.bh = 128u * DE;
#pragma unroll
            for (int i = 0; i < 2; ++i) { oa[i] = (unsigned)(Rst[i] * DE + 2 * Cst[i]); oa[2 + i] = (unsigned)((128 + Rst[i]) * DE + 2 * Cst[i]); ob[i] = (unsigned)(Rbp[i] * DE + 2 * Cst[i]); } }
    };
#define PG8_SA(b, h) (((b) * 2 + (h)) * HTB)
#define PG8_SB(b, h) ((4 + (b) * 2 + (h)) * HTB)
#define MOE_DMA(bufoff, ptr, aux) __builtin_amdgcn_global_load_lds((const unsigned*)(ptr), (LAS unsigned*)(lds + (bufoff)), 16, 0, aux)
#define MOE_STA(bufoff, base, o0, o1) do { MOE_DMA((bufoff) + ldsw, (base) + (o0), 16); MOE_DMA((bufoff) + ldsw + 8192, (base) + (o1), 16); } while (0)
#define MOE_STAK(kindv, bufoff, base, o0, o1) do { if ((kindv) == 0) { MOE_DMA((bufoff) + ldsw, (base) + (o0), 0); MOE_DMA((bufoff) + ldsw + 8192, (base) + (o1), 0); } else MOE_STA(bufoff, base, o0, o1); } while (0)
#define MOE_STB(bufoff, base, o0, o1) do { MOE_DMA((bufoff) + ldsw, (base) + (o0), 0); MOE_DMA((bufoff) + ldsw + 8192, (base) + (o1), 0); } while (0)
#define MOE_LD32(p) __builtin_shufflevector(*(const LAS i32x4*)(p), *(const LAS i32x4*)((p) + 1024), 0, 1, 2, 3, 4, 5, 6, 7)
#define PG8_LDA(dst, b, h) do { _Pragma("unroll") for (int m = 0; m < 4; ++m) dst[m] = MOE_LD32(lds + PG8_SA(b, h) + aoff + m * 2048); } while (0)
#define PG8_LDB(dst, b, h) do { _Pragma("unroll") for (int n = 0; n < 2; ++n) dst[n] = MOE_LD32(lds + PG8_SB(b, h) + boff + n * 2048); } while (0)
#define MOE_MFMA(c, a, b) asm volatile("v_mfma_scale_f32_16x16x128_f8f6f4 %0, %1, %2, %0, %3, %3 op_sel_hi:[0,0,0]" : "+v"(c) : "v"(a), "v"(b), "v"(one_scale))
#define PG8_MMA(ai, bj, At, Bt) do { __builtin_amdgcn_s_setprio(1); _Pragma("unroll") for (int m = 0; m < 4; ++m) _Pragma("unroll") for (int n = 0; n < 2; ++n) \
        MOE_MFMA(acc[ai][bj][m][n], Bt[n], At[m]); __builtin_amdgcn_s_setprio(0); } while (0)
#define PG8_WAIT_V(n) asm volatile("s_waitcnt vmcnt(" #n ")" ::: "memory")
#define PG8_WAIT_L(n) asm volatile("s_waitcnt lgkmcnt(" #n ")" ::: "memory")
#define PG8_BAR __builtin_amdgcn_s_barrier()
#define PG8_SCHED __builtin_amdgcn_sched_barrier(0)
    fill(0);
    asm volatile("s_waitcnt vmcnt(0) lgkmcnt(0)" ::: "memory");
    __syncthreads();
    UP cu, nu; unsigned oa[4], ob[2], na[4], nb[2];
    unit_params(0, 0, cu, oa, ob);
    nu = cu;
#pragma unroll
    for (int i = 0; i < 4; ++i) na[i] = oa[i];
    nb[0] = ob[0]; nb[1] = ob[1];
    f32x4 acc[2][2][4][2];
#pragma unroll
    for (int a = 0; a < 2; ++a)
#pragma unroll
        for (int b = 0; b < 2; ++b)
#pragma unroll
            for (int m = 0; m < 4; ++m)
#pragma unroll
                for (int n = 0; n < 2; ++n) acc[a][b][m][n] = (f32x4){0.f, 0.f, 0.f, 0.f};
    i32x8 At[4], B0[2], B1[2];
    int one_scale = 0x7F7F7F7F; asm volatile("" : "+v"(one_scale));
    const size_t kstep = (size_t)128;
    {   const char* cA = cu.aB; const char* cB = cu.bB;
        MOE_STB(PG8_SB(0, 0), cB, ob[0], ob[1]); MOE_STB(PG8_SB(0, 1), cB + cu.bh, ob[0], ob[1]); MOE_STAK(cu.kind, PG8_SA(0, 0), cA, oa[0], oa[1]); MOE_STAK(cu.kind, PG8_SA(0, 1), cA, oa[2], oa[3]);
        if (wr == 1) PG8_BAR;
        PG8_WAIT_V(2); PG8_BAR;
        MOE_STB(PG8_SB(1, 0), cB + kstep, ob[0], ob[1]); MOE_STAK(cu.kind, PG8_SA(1, 0), cA + kstep, oa[0], oa[1]); MOE_STB(PG8_SB(1, 1), cB + cu.bh + kstep, ob[0], ob[1]);
        PG8_WAIT_V(6); PG8_BAR; }
    for (int ui = 0;; ++ui) {
        const bool has_next = (ui + 1 < nunits);
        if (cu.fillnext >= 0) fill(cu.fillnext);
        const char* cA = cu.aB; const char* cB = cu.bB; const int nt = cu.nt; const unsigned bh = cu.bh;
        for (int t = 0; t < nt; t += 2) {
            const bool last = (t == nt - 2);
            if (last && has_next) unit_params(ui + 1, cu.e, nu, na, nb);
            const char* a1 = cA + (size_t)(t + 1) * kstep;
            const char* a2 = last ? nu.aB : cA + (size_t)(t + 2) * kstep; const char* b2 = last ? nu.bB : cB + (size_t)(t + 2) * kstep;
            const char* a3 = a2 + kstep; const char* b3 = b2 + kstep;
            const unsigned bh2 = last ? nu.bh : bh;
            const unsigned x0 = last ? na[0] : oa[0], x1 = last ? na[1] : oa[1], y0 = last ? na[2] : oa[2], y1 = last ? na[3] : oa[3];
            const unsigned z0 = last ? nb[0] : ob[0], z1 = last ? nb[1] : ob[1];
            const int k2 = last ? nu.kind : cu.kind;
            PG8_LDB(B0, 0, 0); PG8_LDB(B1, 0, 1); PG8_SCHED; PG8_LDA(At, 0, 0); MOE_STAK(cu.kind, PG8_SA(1, 1), a1, oa[2], oa[3]);
            PG8_WAIT_V(8); PG8_WAIT_L(0); PG8_BAR; PG8_MMA(0, 0, At, B0); PG8_MMA(0, 1, At, B1); PG8_BAR; PG8_SCHED;
            PG8_LDA(At, 0, 1); MOE_STB(PG8_SB(0, 0), b2, z0, z1); MOE_STB(PG8_SB(0, 1), b2 + bh2, z0, z1); MOE_STAK(k2, PG8_SA(0, 0), a2, x0, x1);
            PG8_WAIT_V(8); PG8_WAIT_L(0); PG8_BAR; PG8_MMA(1, 0, At, B0); PG8_MMA(1, 1, At, B1); PG8_BAR; PG8_SCHED;
            PG8_LDB(B0, 1, 0); PG8_LDB(B1, 1, 1); PG8_SCHED; PG8_LDA(At, 1, 0); MOE_STAK(k2, PG8_SA(0, 1), a2, y0, y1);
            PG8_WAIT_V(8); PG8_WAIT_L(0); PG8_BAR; PG8_MMA(0, 0, At, B0); PG8_MMA(0, 1, At, B1); PG8_BAR; PG8_SCHED;
            PG8_LDA(At, 1, 1); MOE_STB(PG8_SB(1, 0), b3, z0, z1); MOE_STB(PG8_SB(1, 1), b3 + bh2, z0, z1); MOE_STAK(k2, PG8_SA(1, 0), a3, x0, x1);
            PG8_WAIT_V(8); PG8_WAIT_L(0); PG8_BAR; PG8_MMA(1, 0, At, B0); PG8_MMA(1, 1, At, B1); PG8_BAR; PG8_SCHED;
        }
        if (wr == 0) PG8_BAR;
        asm volatile("s_nop 15\n\ts_nop 15" ::: "memory");
        if (cu.kind == 0) {
            const int row0 = wr * 64 + fr; const int col0 = cu.pn * 128 + wc * 32 + 8 * fq;
            constexpr float is13 = 1.f / SW13;
#pragma unroll
            for (int ai = 0; ai < 2; ++ai)
#pragma unroll
                for (int m = 0; m < 4; ++m) { unsigned char* rowp = (unsigned char*)M.Hs + cu.hbuf * 65536 + (size_t)(row0 + ai * HALF + m * 16) * 256 + col0;
                    f32x4 h0, h1;
#pragma unroll
                    for (int j = 0; j < 4; ++j) { h0[j] = siluf_(acc[ai][0][m][0][j] * is13) * (acc[ai][1][m][0][j] * (is13 * SHS)); h1[j] = siluf_(acc[ai][0][m][1][j] * is13) * (acc[ai][1][m][1][j] * (is13 * SHS)); }
                    u32x2 w; w.x = pk4_fp8(h0[0], h0[1], h0[2], h0[3]); w.y = pk4_fp8(h1[0], h1[1], h1[2], h1[3]);
                    *(u32x2*)rowp = w; }
        } else {
            const LAS int* rtok = M.tbl + cu.slot * 768 + 256; const LAS float* rw = (const LAS float*)(M.tbl + cu.slot * 768 + 512);
            const int col0 = cu.pn * BM + wc * 32 + 8 * fq;
#pragma unroll
            for (int ai = 0; ai < 2; ++ai)
#pragma unroll
                for (int m = 0; m < 4; ++m) { const int r = wr * 64 + fr + ai * HALF + m * 16; const int ts = rtok[r]; const float w = rw[r];
                    if (ts >= 0) {
                        if (cu.shared) { bf16_t* sp = (bf16_t*)M.out + (size_t)(unsigned)ts * D + col0;
#pragma unroll
                            for (int bj = 0; bj < 2; ++bj) { const f32x4 v0 = acc[ai][bj][m][0] * (1.f / (SHS * SW2)), v1 = acc[ai][bj][m][1] * (1.f / (SHS * SW2));
                                u32x4 pk; pk.x = cvt_pk_bf16(v0[0], v0[1]); pk.y = cvt_pk_bf16(v0[2], v0[3]); pk.z = cvt_pk_bf16(v1[0], v1[1]); pk.w = cvt_pk_bf16(v1[2], v1[3]);
                                *(u32x4*)(sp + bj * HALF) = pk; }
                        } else { unsigned char* yp = M.Y + (size_t)(unsigned)ts * D + col0; const float ws_ = w * (YSCALE / (SHS * SW2));
#pragma unroll
                            for (int bj = 0; bj < 2; ++bj) { f32x4 v0 = acc[ai][bj][m][0] * ws_, v1 = acc[ai][bj][m][1] * ws_;
#pragma unroll
                                for (int j = 0; j < 4; ++j) { v0[j] = __builtin_amdgcn_fmed3f(v0[j], -448.f, 448.f); v1[j] = __builtin_amdgcn_fmed3f(v1[j], -448.f, 448.f); }
                                unsigned lo = 0u, hi = 0u;
                                lo = __builtin_amdgcn_cvt_pk_fp8_f32(v0[0], v0[1], lo, false); lo = __builtin_amdgcn_cvt_pk_fp8_f32(v0[2], v0[3], lo, true);
                                hi = __builtin_amdgcn_cvt_pk_fp8_f32(v1[0], v1[1], hi, false); hi = __builtin_amdgcn_cvt_pk_fp8_f32(v1[2], v1[3], hi, true);
                                u32x2 pk; pk.x = lo; pk.y = hi; *(u32x2*)(yp + bj * HALF) = pk; } } }
                    asm volatile("" ::: "memory"); }
        }
        if (!has_next) break;
#pragma unroll
        for (int a = 0; a < 2; ++a)
#pragma unroll
            for (int b = 0; b < 2; ++b)
#pragma unroll
                for (int m = 0; m < 4; ++m)
#pragma unroll
                    for (int n = 0; n < 2; ++n) acc[a][b][m][n] = (f32x4){0.f, 0.f, 0.f, 0.f};
        cu = nu;
#pragma unroll
        for (int i = 0; i < 4; ++i) oa[i] = na[i];
        ob[0] = nb[0]; ob[1] = nb[1];
        if (wr == 1) PG8_BAR;
    }
    PG8_WAIT_V(0);
    PG8_BAR;
#undef PG8_SA
#undef PG8_SB
#undef MOE_DMA
#undef MOE_STA
#undef MOE_STAK
#undef MOE_STB
#undef PG8_LDA
#undef PG8_LDB
#undef MOE_LD32
#undef MOE_MFMA
#undef PG8_MMA
#undef PG8_WAIT_V
#undef PG8_WAIT_L
#undef PG8_BAR
#undef PG8_SCHED
}
}

struct Ctx {
    lbyte* lds; int tid, lane, wave, G, bid;
    const Args* a;
};
#define WSP(T, off) ((T*)(A.ws + (off)))

template <class RowMap>
__device__ __forceinline__ void transpose_item(const float* W, int K, int N, bf16_t* WT, RowMap rowmap, lfloat* scr, int item, int lane) {
    const int nblk = N / 32, kb = item / nblk, nb = item % nblk, k0 = 64 * kb, n0 = 32 * nb;
#pragma unroll 8
    for (int i = 0; i < 32; ++i) { const int kk = 2 * i + (lane >> 5); scr[kk * 33 + (lane & 31)] = W[(size_t)(k0 + kk) * N + n0 + (lane & 31)]; }
    asm volatile("s_waitcnt lgkmcnt(0)" ::: "memory");
    const int c = lane & 7;
#pragma unroll
    for (int j = 0; j < 4; ++j) { const int n = (lane >> 3) + 8 * j; const lfloat* s = scr + (8 * c) * 33 + n;
        u32x4 o; o.x = pk2(s[0 * 33], s[1 * 33]); o.y = pk2(s[2 * 33], s[3 * 33]); o.z = pk2(s[4 * 33], s[5 * 33]); o.w = pk2(s[6 * 33], s[7 * 33]);
        *(u32x4*)(WT + (size_t)rowmap(n0 + n) * K + k0 + 8 * c) = o; }
    asm volatile("s_waitcnt lgkmcnt(0)" ::: "memory");
}
template <class RowMap>
__device__ __forceinline__ void transpose_item_fp8(const float* W, int K, int N, unsigned char* WT, RowMap rowmap, float sc, lfloat* scr, int item, int lane) {
    const int nblk = N / 32, kb = item / nblk, nb = item % nblk, k0 = 64 * kb, n0 = 32 * nb;
#pragma unroll 8
    for (int i = 0; i < 32; ++i) { const int kk = 2 * i + (lane >> 5); scr[kk * 33 + (lane & 31)] = W[(size_t)(k0 + kk) * N + n0 + (lane & 31)] * sc; }
    asm volatile("s_waitcnt lgkmcnt(0)" ::: "memory");
    const int c = lane & 7;
#pragma unroll
    for (int j = 0; j < 4; ++j) { const int n = (lane >> 3) + 8 * j; const lfloat* s = scr + (8 * c) * 33 + n;
        u32x2 o; o.x = pk4_fp8(s[0 * 33], s[1 * 33], s[2 * 33], s[3 * 33]); o.y = pk4_fp8(s[4 * 33], s[5 * 33], s[6 * 33], s[7 * 33]);
        *(u32x2*)(WT + (size_t)rowmap(n0 + n) * K + k0 + 8 * c) = o; }
    asm volatile("s_waitcnt lgkmcnt(0)" ::: "memory");
}
template <class RowMap>
__device__ __forceinline__ void transpose_pair_fp8(const float* W, int K, int N, unsigned char* WT, RowMap rowmap, float sc, lfloat* scr, int pair, int lane) {
    const int nblk = N / 32, kbp = pair / nblk, nb = pair % nblk, k0 = 128 * kbp, n0 = 32 * nb;
    const int kr = lane >> 3, n4 = (lane & 7) * 4;
    f32x4 ld[2][8];
#pragma unroll
    for (int h = 0; h < 2; ++h)
#pragma unroll
        for (int i = 0; i < 8; ++i) ld[h][i] = *(const f32x4*)(W + (size_t)(k0 + 64 * h + 8 * i + kr) * N + n0 + n4);
    const int c = lane & 7;
    u32x2 o[2][4];
#pragma unroll
    for (int h = 0; h < 2; ++h) {
#pragma unroll
        for (int i = 0; i < 8; ++i) { lfloat* d = scr + (8 * i + kr) * 33 + n4; d[0] = ld[h][i].x * sc; d[1] = ld[h][i].y * sc; d[2] = ld[h][i].z * sc; d[3] = ld[h][i].w * sc; }
        asm volatile("s_waitcnt lgkmcnt(0)" ::: "memory");
#pragma unroll
        for (int j = 0; j < 4; ++j) { const int n = (lane >> 3) + 8 * j; const lfloat* s = scr + (8 * c) * 33 + n;
            o[h][j].x = pk4_fp8(s[0 * 33], s[1 * 33], s[2 * 33], s[3 * 33]); o[h][j].y = pk4_fp8(s[4 * 33], s[5 * 33], s[6 * 33], s[7 * 33]); }
        asm volatile("s_waitcnt lgkmcnt(0)" ::: "memory");
    }
#pragma unroll
    for (int j = 0; j < 4; ++j) { const int n = (lane >> 3) + 8 * j; unsigned char* p = WT + (size_t)rowmap(n0 + n) * K + k0 + 8 * c;
        *(u32x2*)p = o[0][j]; *(u32x2*)(p + 64) = o[1][j]; }
}
struct RowId { __device__ int operator()(int n) const { return n; } };
struct RowGLU { int base; __device__ int operator()(int n) const { return ((n >> 7) << 8) + base + (n & 127); } };

__device__ __forceinline__ void load_row_bf16(const bf16_t* xrow, int lane, f32x4 (&v)[4]) {
    const u32x2* xr = (const u32x2*)xrow + lane;
#pragma unroll
    for (int j = 0; j < 4; ++j) { const u32x2 w = xr[64 * j]; v[j] = (f32x4){bflo(w.x), bfhi(w.x), bflo(w.y), bfhi(w.y)}; }
}
__device__ __forceinline__ void norm_mod_vals(const f32x4 (&v)[4], const float* g, const float* sc, const float* sh, bf16_t* orow, int lane, unsigned* o8row);
__device__ __forceinline__ void norm_mod_row(const float* xrow, const float* g, const float* sc, const float* sh, bf16_t* orow, int lane, unsigned* o8row = nullptr) {
    const f32x4* xr = (const f32x4*)xrow + lane;
    f32x4 v[4];
#pragma unroll
    for (int j = 0; j < 4; ++j) v[j] = xr[64 * j];
    norm_mod_vals(v, g, sc, sh, orow, lane, o8row);
}
__device__ __forceinline__ void norm_mod_vals(const f32x4 (&v)[4], const float* g, const float* sc, const float* sh, bf16_t* orow, int lane, unsigned* o8row) {
    float s = 0.f;
#pragma unroll
    for (int j = 0; j < 4; ++j) s += (v[j].x * v[j].x + v[j].y * v[j].y) + (v[j].z * v[j].z + v[j].w * v[j].w);
    const float rstd = __builtin_amdgcn_rsqf(wave_sum(s) * (1.f / D) + NORM_EPS);
    u32x2* o8 = (u32x2*)orow + lane;
#pragma unroll
    for (int j = 0; j < 4; ++j) { const f32x4 gg = ((const f32x4*)g)[lane + 64 * j], ss = ((const f32x4*)sc)[lane + 64 * j], hh = ((const f32x4*)sh)[lane + 64 * j];
        const f32x4 y = v[j] * rstd * gg * (ss + 1.f) + hh;
        if (orow) { u32x2 w; w.x = pk2(y.x, y.y); w.y = pk2(y.z, y.w); o8[64 * j] = w; }
        if (o8row) o8row[lane + 64 * j] = pk4_fp8(y.x, y.y, y.z, y.w); }
}

__device__ __forceinline__ void phase_p0(const Args& A, Ctx& C) {
    float* mod = WSP(float, WS_MOD);
    {
        lfloat* sc = (lfloat*)C.lds;
        lfloat* red = (lfloat*)(C.lds + 17 * 1024 * 4);
        const float* wada = A.in[I_WADA]; const float* bada = A.in[I_BADA];
        for (int it = C.bid; it < 96 * 2; it += C.G) {
            const int chunk = it >> 1, pass = it & 1, r0 = pass * 17, nr = pass ? 16 : 17, col0 = chunk * 64;
            __syncthreads();
            for (int i = C.tid; i < nr * 1024; i += 512) { const int r = i >> 10, k = i & 1023; const int rr = r0 + r;
                const float cv = rr < 32 ? A.in[I_C][rr * 1024 + k] : A.in[I_CCTX][k]; sc[r * 1024 + k] = siluf_(cv); }
            __syncthreads();
            const int col = C.tid & 63, kq = C.tid >> 6;
            float acc[17];
#pragma unroll
            for (int r = 0; r < 17; ++r) acc[r] = 0.f;
            for (int k = kq * 128; k < kq * 128 + 128; k += 4) {
                float w[4];
#pragma unroll
                for (int j = 0; j < 4; ++j) w[j] = wada[(size_t)(k + j) * MODW + col0 + col];
#pragma unroll
                for (int r = 0; r < 17; ++r) { const f32x4 s4 = *(const LAS f32x4*)(sc + r * 1024 + k); acc[r] += s4.x * w[0] + s4.y * w[1] + s4.z * w[2] + s4.w * w[3]; }
            }
#pragma unroll
            for (int r = 0; r < 17; ++r) red[(kq * 17 + r) * 64 + col] = acc[r];
            __syncthreads();
            for (int i = C.tid; i < nr * 64; i += 512) { const int r = i >> 6, cc = i & 63; float s = 0.f;
#pragma unroll
                for (int q = 0; q < 8; ++q) s += red[(q * 17 + r) * 64 + cc];
                mod[(size_t)(r0 + r) * MODW + col0 + cc] = s + bada[col0 + cc]; }
        }
        __syncthreads();
    }
    {
        lfloat* scr = (lfloat*)(C.lds + C.wave * 16384);
        const int gw = C.bid * 8 + C.wave, NGW = C.G * 8;
        unsigned char* btin8 = A.ws + WS_BTIN; bf16_t* btout = WSP(bf16_t, WS_BTOUT); bf16_t* btr = WSP(bf16_t, WS_BTR);
        constexpr int I_IN = (D / 64) * 124, I_OUT = (D / 64) * (D / 32), I_R = (D / 64) * (NE / 32), I_G = (128 / 64) * (DA / 32);
        for (int it = gw; it < I_IN + I_OUT + I_R + I_G; it += NGW) {
            int r = it;
            if (r < I_IN) {
                const int kb = r / 124, nb = r % 124, k0 = 64 * kb, n0 = 32 * nb; const float* W = A.in[I_WIN];
#pragma unroll 8
                for (int i = 0; i < 32; ++i) { const int kk = 2 * i + (C.lane >> 5); scr[kk * 33 + (C.lane & 31)] = W[(size_t)(k0 + kk) * IN_COLS + n0 + (C.lane & 31)] * SWIN; }
                asm volatile("s_waitcnt lgkmcnt(0)" ::: "memory");
                const int c = C.lane & 7;
#pragma unroll
                for (int j = 0; j < 4; ++j) { const int n = (C.lane >> 3) + 8 * j; const lfloat* s = scr + (8 * c) * 33 + n;
                    u32x2 o; o.x = pk4_fp8(s[0 * 33], s[1 * 33], s[2 * 33], s[3 * 33]); o.y = pk4_fp8(s[4 * 33], s[5 * 33], s[6 * 33], s[7 * 33]);
                    *(u32x2*)(btin8 + (size_t)(n0 + n) * D + k0 + 8 * c) = o; }
                asm volatile("s_waitcnt lgkmcnt(0)" ::: "memory");
                continue; }
            r -= I_IN;
            if (r < I_OUT) { transpose_item(A.in[I_WOUT], D, D, btout, RowId(), scr, r, C.lane); continue; } r -= I_OUT;
            if (r < I_R) { transpose_item(A.in[I_RW], D, NE, btr, RowId(), scr, r, C.lane); continue; } r -= I_R;
            transpose_item(A.in[I_GUP], 128, DA, WSP(bf16_t, WS_GUPT), RowId(), scr, r, C.lane);
        }
        for (int i = C.bid * 512 + C.tid; i < 16 * D / 4; i += C.G * 512) { const int n = 3968 + (i >> 8), k = (i & 255) * 4; const float* W = A.in[I_WIN];
            *(unsigned*)(btin8 + (size_t)n * D + k) = pk4_fp8(W[(size_t)k * IN_COLS + n] * SWIN, W[(size_t)(k + 1) * IN_COLS + n] * SWIN, W[(size_t)(k + 2) * IN_COLS + n] * SWIN, W[(size_t)(k + 3) * IN_COLS + n] * SWIN); }
        for (int i = C.bid * 512 + C.tid; i < (PLD - IN_COLS) * D / 16; i += C.G * 512) ((u32x4*)(btin8 + (size_t)IN_COLS * D))[i] = (u32x4){0u, 0u, 0u, 0u};
    }
}

__device__ __forceinline__ void phase_p1(const Args& A, Ctx& C) {
    const float* mod = WSP(float, WS_MOD); bf16_t* xn = WSP(bf16_t, WS_XN);
    const int gw = C.bid * 8 + C.wave, NGW = C.G * 8;
    for (int row = gw; row < NROWS; row += NGW) {
        const float* xr; int mb;
        if (row < NLAT) { xr = A.in[I_X] + (size_t)row * D; mb = row >> 11; } else { xr = A.in[I_CTX] + (size_t)(row - NLAT) * D; mb = 32; }
        const float* m = mod + (size_t)mb * MODW;
        norm_mod_row(xr, A.in[I_N1G], m + D, m, nullptr, C.lane, (unsigned*)(A.ws + WS_XN) + (size_t)row * (D / 4));
    }
}

__device__ __forceinline__ float bfsel(unsigned w, unsigned sh) { return __builtin_bit_cast(float, __builtin_amdgcn_perm(0u, w, sh ? 0x01000c0cu : 0x03020c0cu)); }
template <int NK>
__device__ __forceinline__ f32x4 mm_tile(const lbyte* Ap, int lda, const lbyte* Bp, int ldb, f32x4 acc, int lane) {
    const int r = lane & 15, g = lane >> 4;
#pragma unroll
    for (int ks = 0; ks < NK; ++ks) {
        const bf16x8 a = *(const LAS bf16x8*)(Ap + r * lda + ks * 64 + g * 16);
        const bf16x8 b = *(const LAS bf16x8*)(Bp + r * ldb + ks * 64 + g * 16);
        acc = __builtin_amdgcn_mfma_f32_16x16x32_bf16(a, b, acc, 0, 0, 0);
    }
    return acc;
}

__device__ __forceinline__ void st_bf16x4(lbyte* p, f32x4 v) { u32x2 w; w.x = cvtpk(v.x, v.y); w.y = cvtpk(v.z, v.w); *(LAS u32x2*)p = w; }
__device__ __forceinline__ void st_bf16(lbyte* p, float v) { *(LAS unsigned short*)p = (unsigned short)cvtpk(v, v); }
__device__ __forceinline__ float rdlane(float v, int l) { return __builtin_bit_cast(float, __builtin_amdgcn_readlane(__builtin_bit_cast(int, v), l)); }

__device__ __forceinline__ void tri_inv16(const f32x4 m, int lane, lbyte* scr, float (&X)[16]) {
    *(LAS f32x4*)(scr + (lane & 15) * 64 + (lane >> 4) * 16) = m;
    asm volatile("s_waitcnt lgkmcnt(0)" ::: "memory");
    float Mr[16];
#pragma unroll
    for (int kq = 0; kq < 4; ++kq) { const f32x4 r = *(const LAS f32x4*)(scr + (lane & 15) * 64 + kq * 16); Mr[4 * kq] = r.x; Mr[4 * kq + 1] = r.y; Mr[4 * kq + 2] = r.z; Mr[4 * kq + 3] = r.w; }
    const int l16 = lane & 15;
    X[0] = (l16 == 0) ? 1.f : 0.f;
    { float a0 = (l16 == 1) ? 1.f : 0.f, a1 = 0.f, a2 = 0.f, a3 = 0.f;
      asm("s_nop 1\n\t" "v_fmac_f32_dpp %0, -%2, %3 row_newbcast:1 row_mask:0xf bank_mask:0xf\n\t" : "+v"(a0), "+v"(a1) : "v"(Mr[0]), "v"(X[0]));
      X[1] = (a0 + a1) + (a2 + a3); }
    { float a0 = (l16 == 2) ? 1.f : 0.f, a1 = 0.f, a2 = 0.f, a3 = 0.f;
      asm("s_nop 1\n\t" "v_fmac_f32_dpp %0, -%2, %3 row_newbcast:2 row_mask:0xf bank_mask:0xf\n\t" "v_fmac_f32_dpp %1, -%4, %5 row_newbcast:2 row_mask:0xf bank_mask:0xf\n\t" : "+v"(a0), "+v"(a1) : "v"(Mr[0]), "v"(X[0]), "v"(Mr[1]), "v"(X[1]));
      X[2] = (a0 + a1) + (a2 + a3); }
    { float a0 = (l16 == 3) ? 1.f : 0.f, a1 = 0.f, a2 = 0.f, a3 = 0.f;
      asm("s_nop 1\n\t" "v_fmac_f32_dpp %0, -%2, %3 row_newbcast:3 row_mask:0xf bank_mask:0xf\n\t" "v_fmac_f32_dpp %1, -%4, %5 row_newbcast:3 row_mask:0xf bank_mask:0xf\n\t" : "+v"(a0), "+v"(a1) : "v"(Mr[0]), "v"(X[0]), "v"(Mr[1]), "v"(X[1]));
      asm("s_nop 1\n\t" "v_fmac_f32_dpp %0, -%2, %3 row_newbcast:3 row_mask:0xf bank_mask:0xf\n\t" : "+v"(a2), "+v"(a3) : "v"(Mr[2]), "v"(X[2]));
      X[3] = (a0 + a1) + (a2 + a3); }
    { float a0 = (l16 == 4) ? 1.f : 0.f, a1 = 0.f, a2 = 0.f, a3 = 0.f;
      asm("s_nop 1\n\t" "v_fmac_f32_dpp %0, -%2, %3 row_newbcast:4 row_mask:0xf bank_mask:0xf\n\t" "v_fmac_f32_dpp %1, -%4, %5 row_newbcast:4 row_mask:0xf bank_mask:0xf\n\t" : "+v"(a0), "+v"(a1) : "v"(Mr[0]), "v"(X[0]), "v"(Mr[1]), "v"(X[1]));
      asm("s_nop 1\n\t" "v_fmac_f32_dpp %0, -%2, %3 row_newbcast:4 row_mask:0xf bank_mask:0xf\n\t" "v_fmac_f32_dpp %1, -%4, %5 row_newbcast:4 row_mask:0xf bank_mask:0xf\n\t" : "+v"(a2), "+v"(a3) : "v"(Mr[2]), "v"(X[2]), "v"(Mr[3]), "v"(X[3]));
      X[4] = (a0 + a1) + (a2 + a3); }
    { float a0 = (l16 == 5) ? 1.f : 0.f, a1 = 0.f, a2 = 0.f, a3 = 0.f;
      asm("s_nop 1\n\t" "v_fmac_f32_dpp %0, -%2, %3 row_newbcast:5 row_mask:0xf bank_mask:0xf\n\t" "v_fmac_f32_dpp %1, -%4, %5 row_newbcast:5 row_mask:0xf bank_mask:0xf\n\t" "v_fmac_f32_dpp %0, -%6, %7 row_newbcast:5 row_mask:0xf bank_mask:0xf\n\t" : "+v"(a0), "+v"(a1) : "v"(Mr[0]), "v"(X[0]), "v"(Mr[1]), "v"(X[1]), "v"(Mr[4]), "v"(X[4]));
      asm("s_nop 1\n\t" "v_fmac_f32_dpp %0, -%2, %3 row_newbcast:5 row_mask:0xf bank_mask:0xf\n\t" "v_fmac_f32_dpp %1, -%4, %5 row_newbcast:5 row_mask:0xf bank_mask:0xf\n\t" : "+v"(a2), "+v"(a3) : "v"(Mr[2]), "v"(X[2]), "v"(Mr[3]), "v"(X[3]));
      X[5] = (a0 + a1) + (a2 + a3); }
    { float a0 = (l16 == 6) ? 1.f : 0.f, a1 = 0.f, a2 = 0.f, a3 = 0.f;
      asm("s_nop 1\n\t" "v_fmac_f32_dpp %0, -%2, %3 row_newbcast:6 row_mask:0xf bank_mask:0xf\n\t" "v_fmac_f32_dpp %1, -%4, %5 row_newbcast:6 row_mask:0xf bank_mask:0xf\n\t" "v_fmac_f32_dpp %0, -%6, %7 row_newbcast:6 row_mask:0xf bank_mask:0xf\n\t" "v_fmac_f32_dpp %1, -%8, %9 row_newbcast:6 row_mask:0xf bank_mask:0xf\n\t" : "+v"(a0), "+v"(a1) : "v"(Mr[0]), "v"(X[0]), "v"(Mr[1]), "v"(X[1]), "v"(Mr[4]), "v"(X[4]), "v"(Mr[5]), "v"(X[5]));
      asm("s_nop 1\n\t" "v_fmac_f32_dpp %0, -%2, %3 row_newbcast:6 row_mask:0xf bank_mask:0xf\n\t" "v_fmac_f32_dpp %1, -%4, %5 row_newbcast:6 row_mask:0xf bank_mask:0xf\n\t" : "+v"(a2), "+v"(a3) : "v"(Mr[2]), "v"(X[2]), "v"(Mr[3]), "v"(X[3]));
      X[6] = (a0 + a1) + (a2 + a3); }
    { float a0 = (l16 == 7) ? 1.f : 0.f, a1 = 0.f, a2 = 0.f, a3 = 0.f;
      asm("s_nop 1\n\t" "v_fmac_f32_dpp %0, -%2, %3 row_newbcast:7 row_mask:0xf bank_mask:0xf\n\t" "v_fmac_f32_dpp %1, -%4, %5 row_newbcast:7 row_mask:0xf bank_mask:0xf\n\t" "v_fmac_f32_dpp %0, -%6, %7 row_newbcast:7 row_mask:0xf bank_mask:0xf\n\t" "v_fmac_f32_dpp %1, -%8, %9 row_newbcast:7 row_mask:0xf bank_mask:0xf\n\t" : "+v"(a0), "+v"(a1) : "v"(Mr[0]), "v"(X[0]), "v"(Mr[1]), "v"(X[1]), "v"(Mr[4]), "v"(X[4]), "v"(Mr[5]), "v"(X[5]));
      asm("s_nop 1\n\t" "v_fmac_f32_dpp %0, -%2, %3 row_newbcast:7 row_mask:0xf bank_mask:0xf\n\t" "v_fmac_f32_dpp %1, -%4, %5 row_newbcast:7 row_mask:0xf bank_mask:0xf\n\t" "v_fmac_f32_dpp %0, -%6, %7 row_newbcast:7 row_mask:0xf bank_mask:0xf\n\t" : "+v"(a2), "+v"(a3) : "v"(Mr[2]), "v"(X[2]), "v"(Mr[3]), "v"(X[3]), "v"(Mr[6]), "v"(X[6]));
      X[7] = (a0 + a1) + (a2 + a3); }
    { float a0 = (l16 == 8) ? 1.f : 0.f, a1 = 0.f, a2 = 0.f, a3 = 0.f;
      asm("s_nop 1\n\t" "v_fmac_f32_dpp %0, -%2, %3 row_newbcast:8 row_mask:0xf bank_mask:0xf\n\t" "v_fmac_f32_dpp %1, -%4, %5 row_newbcast:8 row_mask:0xf bank_mask:0xf\n\t" "v_fmac_f32_dpp %0, -%6, %7 row_newbcast:8 row_mask:0xf bank_mask:0xf\n\t" "v_fmac_f32_dpp %1, -%8, %9 row_newbcast:8 row_mask:0xf bank_mask:0xf\n\t" : "+v"(a0), "+v"(a1) : "v"(Mr[0]), "v"(X[0]), "v"(Mr[1]), "v"(X[1]), "v"(Mr[4]), "v"(X[4]), "v"(Mr[5]), "v"(X[5]));
      asm("s_nop 1\n\t" "v_fmac_f32_dpp %0, -%2, %3 row_newbcast:8 row_mask:0xf bank_mask:0xf\n\t" "v_fmac_f32_dpp %1, -%4, %5 row_newbcast:8 row_mask:0xf bank_mask:0xf\n\t" "v_fmac_f32_dpp %0, -%6, %7 row_newbcast:8 row_mask:0xf bank_mask:0xf\n\t" "v_fmac_f32_dpp %1, -%8, %9 row_newbcast:8 row_mask:0xf bank_mask:0xf\n\t" : "+v"(a2), "+v"(a3) : "v"(Mr[2]), "v"(X[2]), "v"(Mr[3]), "v"(X[3]), "v"(Mr[6]), "v"(X[6]), "v"(Mr[7]), "v"(X[7]));
      X[8] = (a0 + a1) + (a2 + a3); }
    { float a0 = (l16 == 9) ? 1.f : 0.f, a1 = 0.f, a2 = 0.f, a3 = 0.f;
      asm("s_nop 1\n\t" "v_fmac_f32_dpp %0, -%2, %3 row_newbcast:9 row_mask:0xf bank_mask:0xf\n\t" "v_fmac_f32_dpp %1, -%4, %5 row_newbcast:9 row_mask:0xf bank_mask:0xf\n\t" "v_fmac_f32_dpp %0, -%6, %7 row_newbcast:9 row_mask:0xf bank_mask:0xf\n\t" "v_fmac_f32_dpp %1, -%8, %9 row_newbcast:9 row_mask:0xf bank_mask:0xf\n\t" "v_fmac_f32_dpp %0, -%10, %11 row_newbcast:9 row_mask:0xf bank_mask:0xf\n\t" : "+v"(a0), "+v"(a1) : "v"(Mr[0]), "v"(X[0]), "v"(Mr[1]), "v"(X[1]), "v"(Mr[4]), "v"(X[4]), "v"(Mr[5]), "v"(X[5]), "v"(Mr[8]), "v"(X[8]));
      asm("s_nop 1\n\t" "v_fmac_f32_dpp %0, -%2, %3 row_newbcast:9 row_mask:0xf bank_mask:0xf\n\t" "v_fmac_f32_dpp %1, -%4, %5 row_newbcast:9 row_mask:0xf bank_mask:0xf\n\t" "v_fmac_f32_dpp %0, -%6, %7 row_newbcast:9 row_mask:0xf bank_mask:0xf\n\t" "v_fmac_f32_dpp %1, -%8, %9 row_newbcast:9 row_mask:0xf bank_mask:0xf\n\t" : "+v"(a2), "+v"(a3) : "v"(Mr[2]), "v"(X[2]), "v"(Mr[3]), "v"(X[3]), "v"(Mr[6]), "v"(X[6]), "v"(Mr[7]), "v"(X[7]));
      X[9] = (a0 + a1) + (a2 + a3); }
    { float a0 = (l16 == 10) ? 1.f : 0.f, a1 = 0.f, a2 = 0.f, a3 = 0.f;
      asm("s_nop 1\n\t" "v_fmac_f32_dpp %0, -%2, %3 row_newbcast:10 row_mask:0xf bank_mask:0xf\n\t" "v_fmac_f32_dpp %1, -%4, %5 row_newbcast:10 row_mask:0xf bank_mask:0xf\n\t" "v_fmac_f32_dpp %0, -%6, %7 row_newbcast:10 row_mask:0xf bank_mask:0xf\n\t" "v_fmac_f32_dpp %1, -%8, %9 row_newbcast:10 row_mask:0xf bank_mask:0xf\n\t" "v_fmac_f32_dpp %0, -%10, %11 row_newbcast:10 row_mask:0xf bank_mask:0xf\n\t" "v_fmac_f32_dpp %1, -%12, %13 row_newbcast:10 row_mask:0xf bank_mask:0xf\n\t" : "+v"(a0), "+v"(a1) : "v"(Mr[0]), "v"(X[0]), "v"(Mr[1]), "v"(X[1]), "v"(Mr[4]), "v"(X[4]), "v"(Mr[5]), "v"(X[5]), "v"(Mr[8]), "v"(X[8]), "v"(Mr[9]), "v"(X[9]));
      asm("s_nop 1\n\t" "v_fmac_f32_dpp %0, -%2, %3 row_newbcast:10 row_mask:0xf bank_mask:0xf\n\t" "v_fmac_f32_dpp %1, -%4, %5 row_newbcast:10 row_mask:0xf bank_mask:0xf\n\t" "v_fmac_f32_dpp %0, -%6, %7 row_newbcast:10 row_mask:0xf bank_mask:0xf\n\t" "v_fmac_f32_dpp %1, -%8, %9 row_newbcast:10 row_mask:0xf bank_mask:0xf\n\t" : "+v"(a2), "+v"(a3) : "v"(Mr[2]), "v"(X[2]), "v"(Mr[3]), "v"(X[3]), "v"(Mr[6]), "v"(X[6]), "v"(Mr[7]), "v"(X[7]));
      X[10] = (a0 + a1) + (a2 + a3); }
    { float a0 = (l16 == 11) ? 1.f : 0.f, a1 = 0.f, a2 = 0.f, a3 = 0.f;
      asm("s_nop 1\n\t" "v_fmac_f32_dpp %0, -%2, %3 row_newbcast:11 row_mask:0xf bank_mask:0xf\n\t" "v_fmac_f32_dpp %1, -%4, %5 row_newbcast:11 row_mask:0xf bank_mask:0xf\n\t" "v_fmac_f32_dpp %0, -%6, %7 row_newbcast:11 row_mask:0xf bank_mask:0xf\n\t" "v_fmac_f32_dpp %1, -%8, %9 row_newbcast:11 row_mask:0xf bank_mask:0xf\n\t" "v_fmac_f32_dpp %0, -%10, %11 row_newbcast:11 row_mask:0xf bank_mask:0xf\n\t" "v_fmac_f32_dpp %1, -%12, %13 row_newbcast:11 row_mask:0xf bank_mask:0xf\n\t" : "+v"(a0), "+v"(a1) : "v"(Mr[0]), "v"(X[0]), "v"(Mr[1]), "v"(X[1]), "v"(Mr[4]), "v"(X[4]), "v"(Mr[5]), "v"(X[5]), "v"(Mr[8]), "v"(X[8]), "v"(Mr[9]), "v"(X[9]));
      asm("s_nop 1\n\t" "v_fmac_f32_dpp %0, -%2, %3 row_newbcast:11 row_mask:0xf bank_mask:0xf\n\t" "v_fmac_f32_dpp %1, -%4, %5 row_newbcast:11 row_mask:0xf bank_mask:0xf\n\t" "v_fmac_f32_dpp %0, -%6, %7 row_newbcast:11 row_mask:0xf bank_mask:0xf\n\t" "v_fmac_f32_dpp %1, -%8, %9 row_newbcast:11 row_mask:0xf bank_mask:0xf\n\t" "v_fmac_f32_dpp %0, -%10, %11 row_newbcast:11 row_mask:0xf bank_mask:0xf\n\t" : "+v"(a2), "+v"(a3) : "v"(Mr[2]), "v"(X[2]), "v"(Mr[3]), "v"(X[3]), "v"(Mr[6]), "v"(X[6]), "v"(Mr[7]), "v"(X[7]), "v"(Mr[10]), "v"(X[10]));
      X[11] = (a0 + a1) + (a2 + a3); }
    { float a0 = (l16 == 12) ? 1.f : 0.f, a1 = 0.f, a2 = 0.f, a3 = 0.f;
      asm("s_nop 1\n\t" "v_fmac_f32_dpp %0, -%2, %3 row_newbcast:12 row_mask:0xf bank_mask:0xf\n\t" "v_fmac_f32_dpp %1, -%4, %5 row_newbcast:12 row_mask:0xf bank_mask:0xf\n\t" "v_fmac_f32_dpp %0, -%6, %7 row_newbcast:12 row_mask:0xf bank_mask:0xf\n\t" "v_fmac_f32_dpp %1, -%8, %9 row_newbcast:12 row_mask:0xf bank_mask:0xf\n\t" "v_fmac_f32_dpp %0, -%10, %11 row_newbcast:12 row_mask:0xf bank_mask:0xf\n\t" "v_fmac_f32_dpp %1, -%12, %13 row_newbcast:12 row_mask:0xf bank_mask:0xf\n\t" : "+v"(a0), "+v"(a1) : "v"(Mr[0]), "v"(X[0]), "v"(Mr[1]), "v"(X[1]), "v"(Mr[4]), "v"(X[4]), "v"(Mr[5]), "v"(X[5]), "v"(Mr[8]), "v"(X[8]), "v"(Mr[9]), "v"(X[9]));
      asm("s_nop 1\n\t" "v_fmac_f32_dpp %0, -%2, %3 row_newbcast:12 row_mask:0xf bank_mask:0xf\n\t" "v_fmac_f32_dpp %1, -%4, %5 row_newbcast:12 row_mask:0xf bank_mask:0xf\n\t" "v_fmac_f32_dpp %0, -%6, %7 row_newbcast:12 row_mask:0xf bank_mask:0xf\n\t" "v_fmac_f32_dpp %1, -%8, %9 row_newbcast:12 row_mask:0xf bank_mask:0xf\n\t" "v_fmac_f32_dpp %0, -%10, %11 row_newbcast:12 row_mask:0xf bank_mask:0xf\n\t" "v_fmac_f32_dpp %1, -%12, %13 row_newbcast:12 row_mask:0xf bank_mask:0xf\n\t" : "+v"(a2), "+v"(a3) : "v"(Mr[2]), "v"(X[2]), "v"(Mr[3]), "v"(X[3]), "v"(Mr[6]), "v"(X[6]), "v"(Mr[7]), "v"(X[7]), "v"(Mr[10]), "v"(X[10]), "v"(Mr[11]), "v"(X[11]));
      X[12] = (a0 + a1) + (a2 + a3); }
    { float a0 = (l16 == 13) ? 1.f : 0.f, a1 = 0.f, a2 = 0.f, a3 = 0.f;
      asm("s_nop 1\n\t" "v_fmac_f32_dpp %0, -%2, %3 row_newbcast:13 row_mask:0xf bank_mask:0xf\n\t" "v_fmac_f32_dpp %1, -%4, %5 row_newbcast:13 row_mask:0xf bank_mask:0xf\n\t" "v_fmac_f32_dpp %0, -%6, %7 row_newbcast:13 row_mask:0xf bank_mask:0xf\n\t" "v_fmac_f32_dpp %1, -%8, %9 row_newbcast:13 row_mask:0xf bank_mask:0xf\n\t" "v_fmac_f32_dpp %0, -%10, %11 row_newbcast:13 row_mask:0xf bank_mask:0xf\n\t" "v_fmac_f32_dpp %1, -%12, %13 row_newbcast:13 row_mask:0xf bank_mask:0xf\n\t" "v_fmac_f32_dpp %0, -%14, %15 row_newbcast:13 row_mask:0xf bank_mask:0xf\n\t" : "+v"(a0), "+v"(a1) : "v"(Mr[0]), "v"(X[0]), "v"(Mr[1]), "v"(X[1]), "v"(Mr[4]), "v"(X[4]), "v"(Mr[5]), "v"(X[5]), "v"(Mr[8]), "v"(X[8]), "v"(Mr[9]), "v"(X[9]), "v"(Mr[12]), "v"(X[12]));
      asm("s_nop 1\n\t" "v_fmac_f32_dpp %0, -%2, %3 row_newbcast:13 row_mask:0xf bank_mask:0xf\n\t" "v_fmac_f32_dpp %1, -%4, %5 row_newbcast:13 row_mask:0xf bank_mask:0xf\n\t" "v_fmac_f32_dpp %0, -%6, %7 row_newbcast:13 row_mask:0xf bank_mask:0xf\n\t" "v_fmac_f32_dpp %1, -%8, %9 row_newbcast:13 row_mask:0xf bank_mask:0xf\n\t" "v_fmac_f32_dpp %0, -%10, %11 row_newbcast:13 row_mask:0xf bank_mask:0xf\n\t" "v_fmac_f32_dpp %1, -%12, %13 row_newbcast:13 row_mask:0xf bank_mask:0xf\n\t" : "+v"(a2), "+v"(a3) : "v"(Mr[2]), "v"(X[2]), "v"(Mr[3]), "v"(X[3]), "v"(Mr[6]), "v"(X[6]), "v"(Mr[7]), "v"(X[7]), "v"(Mr[10]), "v"(X[10]), "v"(Mr[11]), "v"(X[11]));
      X[13] = (a0 + a1) + (a2 + a3); }
    { float a0 = (l16 == 14) ? 1.f : 0.f, a1 = 0.f, a2 = 0.f, a3 = 0.f;
      asm("s_nop 1\n\t" "v_fmac_f32_dpp %0, -%2, %3 row_newbcast:14 row_mask:0xf bank_mask:0xf\n\t" "v_fmac_f32_dpp %1, -%4, %5 row_newbcast:14 row_mask:0xf bank_mask:0xf\n\t" "v_fmac_f32_dpp %0, -%6, %7 row_newbcast:14 row_mask:0xf bank_mask:0xf\n\t" "v_fmac_f32_dpp %1, -%8, %9 row_newbcast:14 row_mask:0xf bank_mask:0xf\n\t" "v_fmac_f32_dpp %0, -%10, %11 row_newbcast:14 row_mask:0xf bank_mask:0xf\n\t" "v_fmac_f32_dpp %1, -%12, %13 row_newbcast:14 row_mask:0xf bank_mask:0xf\n\t" "v_fmac_f32_dpp %0, -%14, %15 row_newbcast:14 row_mask:0xf bank_mask:0xf\n\t" "v_fmac_f32_dpp %1, -%16, %17 row_newbcast:14 row_mask:0xf bank_mask:0xf\n\t" : "+v"(a0), "+v"(a1) : "v"(Mr[0]), "v"(X[0]), "v"(Mr[1]), "v"(X[1]), "v"(Mr[4]), "v"(X[4]), "v"(Mr[5]), "v"(X[5]), "v"(Mr[8]), "v"(X[8]), "v"(Mr[9]), "v"(X[9]), "v"(Mr[12]), "v"(X[12]), "v"(Mr[13]), "v"(X[13]));
      asm("s_nop 1\n\t" "v_fmac_f32_dpp %0, -%2, %3 row_newbcast:14 row_mask:0xf bank_mask:0xf\n\t" "v_fmac_f32_dpp %1, -%4, %5 row_newbcast:14 row_mask:0xf bank_mask:0xf\n\t" "v_fmac_f32_dpp %0, -%6, %7 row_newbcast:14 row_mask:0xf bank_mask:0xf\n\t" "v_fmac_f32_dpp %1, -%8, %9 row_newbcast:14 row_mask:0xf bank_mask:0xf\n\t" "v_fmac_f32_dpp %0, -%10, %11 row_newbcast:14 row_mask:0xf bank_mask:0xf\n\t" "v_fmac_f32_dpp %1, -%12, %13 row_newbcast:14 row_mask:0xf bank_mask:0xf\n\t" : "+v"(a2), "+v"(a3) : "v"(Mr[2]), "v"(X[2]), "v"(Mr[3]), "v"(X[3]), "v"(Mr[6]), "v"(X[6]), "v"(Mr[7]), "v"(X[7]), "v"(Mr[10]), "v"(X[10]), "v"(Mr[11]), "v"(X[11]));
      X[14] = (a0 + a1) + (a2 + a3); }
    { float a0 = (l16 == 15) ? 1.f : 0.f, a1 = 0.f, a2 = 0.f, a3 = 0.f;
      asm("s_nop 1\n\t" "v_fmac_f32_dpp %0, -%2, %3 row_newbcast:15 row_mask:0xf bank_mask:0xf\n\t" "v_fmac_f32_dpp %1, -%4, %5 row_newbcast:15 row_mask:0xf bank_mask:0xf\n\t" "v_fmac_f32_dpp %0, -%6, %7 row_newbcast:15 row_mask:0xf bank_mask:0xf\n\t" "v_fmac_f32_dpp %1, -%8, %9 row_newbcast:15 row_mask:0xf bank_mask:0xf\n\t" "v_fmac_f32_dpp %0, -%10, %11 row_newbcast:15 row_mask:0xf bank_mask:0xf\n\t" "v_fmac_f32_dpp %1, -%12, %13 row_newbcast:15 row_mask:0xf bank_mask:0xf\n\t" "v_fmac_f32_dpp %0, -%14, %15 row_newbcast:15 row_mask:0xf bank_mask:0xf\n\t" "v_fmac_f32_dpp %1, -%16, %17 row_newbcast:15 row_mask:0xf bank_mask:0xf\n\t" : "+v"(a0), "+v"(a1) : "v"(Mr[0]), "v"(X[0]), "v"(Mr[1]), "v"(X[1]), "v"(Mr[4]), "v"(X[4]), "v"(Mr[5]), "v"(X[5]), "v"(Mr[8]), "v"(X[8]), "v"(Mr[9]), "v"(X[9]), "v"(Mr[12]), "v"(X[12]), "v"(Mr[13]), "v"(X[13]));
      asm("s_nop 1\n\t" "v_fmac_f32_dpp %0, -%2, %3 row_newbcast:15 row_mask:0xf bank_mask:0xf\n\t" "v_fmac_f32_dpp %1, -%4, %5 row_newbcast:15 row_mask:0xf bank_mask:0xf\n\t" "v_fmac_f32_dpp %0, -%6, %7 row_newbcast:15 row_mask:0xf bank_mask:0xf\n\t" "v_fmac_f32_dpp %1, -%8, %9 row_newbcast:15 row_mask:0xf bank_mask:0xf\n\t" "v_fmac_f32_dpp %0, -%10, %11 row_newbcast:15 row_mask:0xf bank_mask:0xf\n\t" "v_fmac_f32_dpp %1, -%12, %13 row_newbcast:15 row_mask:0xf bank_mask:0xf\n\t" "v_fmac_f32_dpp %0, -%14, %15 row_newbcast:15 row_mask:0xf bank_mask:0xf\n\t" : "+v"(a2), "+v"(a3) : "v"(Mr[2]), "v"(X[2]), "v"(Mr[3]), "v"(X[3]), "v"(Mr[6]), "v"(X[6]), "v"(Mr[7]), "v"(X[7]), "v"(Mr[10]), "v"(X[10]), "v"(Mr[11]), "v"(X[11]), "v"(Mr[14]), "v"(X[14]));
      X[15] = (a0 + a1) + (a2 + a3); }
}

#ifndef RWKV_REP
#define RWKV_REP 1
#endif
namespace rk {
constexpr int S64 = 160, S32 = 80, SW = 144;
constexpr int O_WUP = 0, O_AUP = O_WUP + 64 * SW, O_WLT = O_AUP + 64 * SW, O_ALT = O_WLT + 16 * S64, O_LW = O_ALT + 16 * S64, O_LA = O_LW + 4096,
              O_KKT = O_LA + 4096, O_RT = O_KKT + 16 * S64, O_BT = O_RT + 16 * S64, O_KDT = O_BT + 16 * S64,
              O_VT = O_KDT + 16 * S64, O_BHT = O_VT + 64 * S32, O_KHT = O_BHT + 64 * S32, O_UT = O_KHT + 64 * S32, O_UTT = O_WLT  ,
              O_TI = O_UT + 64 * S32, O_MK = O_TI + 16 * S32, O_NB = O_MK + 16 * S32, O_NK = O_NB + 16 * S32,
              O_SBF = O_NK + 16 * S32, O_WC = O_SBF + 64 * S64, O_WT = O_WC + 256, TEAM_BYTES = O_WT + 1024;
static_assert(2 * TEAM_BYTES <= LDS_MISC, "rwkv LDS");
}
__device__ __forceinline__ void rwkv_pair_chunked(const Args& A, Ctx& C, int pair) {
    using namespace rk;
    const int b = pair >> 3, h = pair & 7;
    const int dir = C.wave >> 2;
    const int t4 = C.tid & 255, q = C.wave & 3, lane = C.lane;
    lbyte* L = C.lds + dir * TEAM_BYTES;
    const bf16_t* P = WSP(bf16_t, WS_P);
    bf16_t* ydir = WSP(bf16_t, WS_YDIR) + (size_t)dir * NLAT * D;
    float* bon = WSP(float, WS_BON) + (size_t)dir * NLAT * 8;
    __syncthreads();
#pragma unroll 2
    for (int i = t4; i < 4096; i += 256) { const int l = i >> 6, c = i & 63;
        st_bf16(L + O_WUP + c * SW + l * 2, A.in[I_WUP][((size_t)dir * 64 + l) * DA + 64 * h + c]);
        st_bf16(L + O_AUP + c * SW + l * 2, A.in[I_AUP][((size_t)dir * 64 + l) * DA + 64 * h + c]); }
#pragma unroll 2
    for (int i = t4; i < (4 * 64 * S32 + 4 * 16 * S32 + 64 * S64) / 4; i += 256) ((LAS unsigned*)(L + O_VT))[i] = 0u;
    for (int i = t4; i < (2 * 16 * S64) / 4; i += 256) ((LAS unsigned*)(L + O_WLT))[i] = 0u;
    const int c = lane;
    const int col5[5] = {64 * h + c, 512 + 64 * h + c, 1024 + 64 * h + c, 1536 + 64 * dir + c, 1664 + 64 * dir + c};
    float mu5[5]; unsigned coff[5], nm[5], nlo[5], nrg[5]; int ndb[5];
#pragma unroll
    for (int e = 0; e < 5; ++e) { mu5[e] = A.in[I_MU][col5[e]]; coff[e] = (unsigned)col5[e] * 2u; }
    auto set_rules = [&](bool ctx) {
#pragma unroll
        for (int e = 0; e < 5; ++e) { const int col = col5[e];
            if (ctx) { nm[e] = 0xffffffffu; nlo[e] = col < 960 ? 1u : 0u; nrg[e] = (unsigned)(CTX - 2); ndb[e] = (col < 960 ? -PLD : PLD) * 2; }
            else { const int cls = col < 480 ? 0 : (col < 960 ? 1 : (col < 1440 ? 2 : 3));
                nm[e] = cls < 2 ? 63u : 0xffffffffu; nlo[e] = cls == 0 ? 1u : (cls == 2 ? 64u : 0u); nrg[e] = cls < 2 ? 62u : (unsigned)(SEQ - 65);
                ndb[e] = (cls == 0 ? -PLD : (cls == 1 ? PLD : (cls == 2 ? -64 * PLD : 64 * PLD))) * 2; } } };
    set_rules(true);
    const char* wsb = (const char*)A.ws;
    const float kkc = A.in[I_KK][64 * h + c], kac = A.in[I_KA][64 * h + c], rkc = A.in[I_RK][64 * h + c]; const float kac1 = 1.f - kac;
    const float w0c = A.in[I_W0][dir * DA + 64 * h + c], a0c = A.in[I_A0][dir * DA + 64 * h + c];
    const float w0n = -1.4426950408889634f * w0c, a0n = -1.4426950408889634f * a0c;
    f32x4 Sacc[4];
#pragma unroll
    for (int i = 0; i < 4; ++i) Sacc[i] = (f32x4){0.f, 0.f, 0.f, 0.f};
    const int fr = lane & 15, fg = lane >> 4;
    unsigned short rawp[4][5], raws[4][5];
    auto chunk_geom = [&](int ch, bool& isctx, int& sbase, int& T, size_t& rowbase) { isctx = ch < 16; sbase = isctx ? ch * 16 : (ch - 16) * 16; T = isctx ? CTX : SEQ; rowbase = isctx ? (size_t)NLAT + (size_t)b * CTX : (size_t)b * SEQ; };
    auto issue_loads = [&](int ch) { bool isctx; int sbase, T; size_t rowbase; chunk_geom(ch, isctx, sbase, T, rowbase);
#pragma unroll
        for (int j = 0; j < 4; ++j) { const int i = 4 * q + j; const int t = __builtin_amdgcn_readfirstlane(dir ? (T - 1 - (sbase + i)) : (sbase + i));
            const unsigned rowoff = (unsigned)WS_P + (unsigned)(rowbase + t) * (unsigned)(PLD * 2);
            const bool edge = isctx ? (t == 0 || t == CTX - 1) : (((t & 63) == 0) || ((t & 63) == 63) || t < 64 || t >= SEQ - 64);
            if (!edge) {
#pragma unroll
                for (int e = 0; e < 5; ++e) { rawp[j][e] = *(const bf16_t*)(wsb + (rowoff + coff[e])); raws[j][e] = *(const bf16_t*)(wsb + (rowoff + coff[e] + (unsigned)ndb[e])); }
            } else {
#pragma unroll
                for (int e = 0; e < 5; ++e) { const unsigned vs = rowoff + coff[e]; const bool ok = (((unsigned)t & nm[e]) - nlo[e]) <= nrg[e]; const unsigned vn = ok ? vs + (unsigned)ndb[e] : 8u;
                    rawp[j][e] = *(const bf16_t*)(wsb + vs); raws[j][e] = *(const bf16_t*)(wsb + vn); } } } };
    u32x2 ypend; ypend.x = 0u; ypend.y = 0u; float bpend[4] = {0.f, 0.f, 0.f, 0.f};
    auto flush = [&](int pch) { bool pisctx; int psb, pT; size_t prb; chunk_geom(pch, pisctx, psb, pT, prb);
        if (!pisctx) { const int t = dir ? (pT - 1 - (psb + fr)) : (psb + fr);
            *(u32x2*)(ydir + ((size_t)b * SEQ + t) * D + 64 * h + 16 * q + 4 * fg) = ypend;
            if (lane == 0) {
#pragma unroll
                for (int j = 0; j < 4; ++j) { const int i = 4 * q + j; const int tj = dir ? (pT - 1 - (psb + i)) : (psb + i); bon[((size_t)b * SEQ + tj) * 8 + h] = bpend[j]; } } } };
    issue_loads(0);
    for (int ch = 0; ch < 144; ++ch) {
        bool isctx; int sbase, T; size_t rowbase; chunk_geom(ch, isctx, sbase, T, rowbase);
        float vr[4], vk[4], vv[4], vkk[4], lw[4], av[4];
        __syncthreads();
        float mxa[4][5];
#pragma unroll
        for (int jp = 0; jp < 2; ++jp) {
#pragma unroll
            for (int e = 0; e < 5; ++e) { const f32x2 pv = (f32x2){bf2f(rawp[2 * jp][e]), bf2f(rawp[2 * jp + 1][e])}, sv = (f32x2){bf2f(raws[2 * jp][e]), bf2f(raws[2 * jp + 1][e])};
                const f32x2 r = pv + mu5[e] * (sv - pv); mxa[2 * jp][e] = r.x; mxa[2 * jp + 1][e] = r.y; } }
        asm volatile("" :: "v"(mxa[0][0]), "v"(mxa[0][1]), "v"(mxa[0][2]), "v"(mxa[0][3]), "v"(mxa[0][4]), "v"(mxa[1][0]), "v"(mxa[1][1]), "v"(mxa[1][2]), "v"(mxa[1][3]), "v"(mxa[1][4]),
                        "v"(mxa[2][0]), "v"(mxa[2][1]), "v"(mxa[2][2]), "v"(mxa[2][3]), "v"(mxa[2][4]), "v"(mxa[3][0]), "v"(mxa[3][1]), "v"(mxa[3][2]), "v"(mxa[3][3]), "v"(mxa[3][4]) : "memory");
        if (ch > 0) flush(ch - 1);
        if (ch == 15) set_rules(false);
        if (ch + 1 < 144) issue_loads(ch + 1);
        float cl[4];
        _Pragma("unroll") for (int rrep = 0; rrep < RWKV_REP; ++rrep) {
#pragma unroll
        for (int j = 0; j < 4; ++j) {
            const int i = 4 * q + j;
            float mx[5];
#pragma unroll
            for (int e = 0; e < 5; ++e) mx[e] = mxa[j][e];
            vr[j] = mx[0]; vk[j] = mx[1]; vv[j] = mx[2];
            *(LAS unsigned short*)(L + O_WLT + i * S64 + c * 2) = (unsigned short)cvtpk(tanhf_(mx[3]), 0.f); *(LAS unsigned short*)(L + O_ALT + i * S64 + c * 2) = (unsigned short)cvtpk(mx[4], 0.f);
            vkk[j] = vk[j] * kkc;
        }
        { float ss[4]; wave_sum4(vkk[0] * vkk[0], vkk[1] * vkk[1], vkk[2] * vkk[2], vkk[3] * vkk[3], lane, ss);
#pragma unroll
          for (int j = 0; j < 4; ++j) vkk[j] *= __builtin_amdgcn_rsqf(ss[j] + 1e-6f); }
        __syncthreads();
        {
            const f32x4 z = (f32x4){0.f, 0.f, 0.f, 0.f};
            const f32x4 tw = mm_tile<2>(L + O_WLT, S64, L + O_WUP + 16 * q * SW, SW, z, lane);
            const f32x4 ta = mm_tile<2>(L + O_ALT, S64, L + O_AUP + 16 * q * SW, SW, z, lane);
#pragma unroll
            for (int e = 0; e < 4; ++e) { ((LAS float*)(L + O_LW))[(4 * fg + e) * 64 + 16 * q + fr] = tw[e]; ((LAS float*)(L + O_LA))[(4 * fg + e) * 64 + 16 * q + fr] = ta[e]; }
        }
        __syncthreads();
        { float run = 0.f;
#pragma unroll
        for (int j = 0; j < 4; ++j) { const int i = 4 * q + j;
            lw[j] = -0.8750612633917001f * __builtin_amdgcn_rcpf(1.f + __builtin_amdgcn_exp2f(__builtin_fmaf(((LAS float*)(L + O_LW))[i * 64 + c], -1.4426950408889634f, w0n)));
            av[j] = __builtin_amdgcn_rcpf(1.f + __builtin_amdgcn_exp2f(__builtin_fmaf(((LAS float*)(L + O_LA))[i * 64 + c], -1.4426950408889634f, a0n)));
            run += lw[j]; cl[j] = run; }
        ((LAS float*)(L + O_WT))[q * 64 + c] = run; }
        __syncthreads();
        }
        {
            float off = 0.f, cumC = 0.f;
#pragma unroll
            for (int qq = 0; qq < 4; ++qq) { const float tv = ((LAS float*)(L + O_WT))[qq * 64 + c]; cumC += tv; off += (qq < q) ? tv : 0.f; }
            float tv_[4], tb_[4], tk_[4];
            float Wprev = __builtin_amdgcn_exp2f(off); const float eC = __builtin_amdgcn_exp2f(cumC);
#pragma unroll
            for (int j = 0; j < 4; ++j) { const int i = 4 * q + j;
                const float cum = off + cl[j];
                const float Wt = __builtin_amdgcn_exp2f(cum), Wp = Wprev, Wi = __builtin_amdgcn_rcpf(Wt), Wc = eC * Wi; Wprev = Wt;
                const float kd = vk[j] * (kac1 + av[j] * kac), bb = vkk[j] * av[j];
                const unsigned p0 = cvtpk(vkk[j] * Wp, vr[j] * Wt), p1 = cvtpk(bb * Wi, kd * Wi);
                *(LAS unsigned short*)(L + O_KKT + i * S64 + c * 2) = (unsigned short)p0; *(LAS unsigned short*)(L + O_RT + i * S64 + c * 2) = (unsigned short)(p0 >> 16);
                *(LAS unsigned short*)(L + O_BT + i * S64 + c * 2) = (unsigned short)p1; *(LAS unsigned short*)(L + O_KDT + i * S64 + c * 2) = (unsigned short)(p1 >> 16);
                tv_[j] = vv[j]; tb_[j] = bb * Wc; tk_[j] = kd * Wc;
                bpend[j] = vr[j] * kd * rkc;
            }
            wave_sum4(bpend[0], bpend[1], bpend[2], bpend[3], lane, bpend);
            { u32x2 w2;
                w2.x = cvtpk(tv_[0], tv_[1]); w2.y = cvtpk(tv_[2], tv_[3]); *(LAS u32x2*)(L + O_VT + c * S32 + q * 8) = w2;
                w2.x = cvtpk(tb_[0], tb_[1]); w2.y = cvtpk(tb_[2], tb_[3]); *(LAS u32x2*)(L + O_BHT + c * S32 + q * 8) = w2;
                w2.x = cvtpk(tk_[0], tk_[1]); w2.y = cvtpk(tk_[2], tk_[3]); *(LAS u32x2*)(L + O_KHT + c * S32 + q * 8) = w2; }
            if (q == 3) ((LAS float*)(L + O_WC))[c] = eC;
        }
        __syncthreads();
        {
            const int role = (q + dir) & 3;
            const lbyte* Aj = L + ((role & 1) ? O_KDT : O_BT);
            const lbyte* Bt = L + ((role & 2) ? O_RT : O_KKT);
            f32x4 g4 = mm_tile<2>(Aj, S64, Bt, S64, (f32x4){0.f, 0.f, 0.f, 0.f}, lane);
#pragma unroll
            for (int e = 0; e < 4; ++e) { const int j = 4 * fg + e; const bool keep = (role & 2) ? (j <= fr) : (j < fr); g4[e] = keep ? g4[e] : 0.f; }
            if (role == 0) { float X[16]; __builtin_amdgcn_s_setprio(3); tri_inv16(g4, lane, L + O_LW, X); __builtin_amdgcn_s_setprio(0);
                if (lane < 16) {
#pragma unroll
                    for (int i = 0; i < 16; ++i) *(LAS unsigned short*)(L + O_TI + i * S32 + lane * 2) = (unsigned short)cvtpk(X[i], 0.f); } }
            else st_bf16x4(L + (role == 1 ? O_MK : (role == 2 ? O_NB : O_NK)) + fr * S32 + fg * 8, g4);
        }
        __syncthreads();
        f32x4 yacc;
        {
            f32x4 u4 = mm_tile<2>(L + O_KKT, S64, L + O_SBF + 16 * q * S64, S64, (f32x4){0.f, 0.f, 0.f, 0.f}, lane);
            u4 = mm_tile<1>(L + O_MK, S32, L + O_VT + 16 * q * S32, S32, u4, lane);
            st_bf16x4(L + O_UTT + (16 * q + fr) * S32 + fg * 8, u4);
            yacc = mm_tile<2>(L + O_SBF + 16 * q * S64, S64, L + O_RT, S64, (f32x4){0.f, 0.f, 0.f, 0.f}, lane);
            yacc = mm_tile<1>(L + O_VT + 16 * q * S32, S32, L + O_NK, S32, yacc, lane);
        }
        asm volatile("s_waitcnt lgkmcnt(0)" ::: "memory");
        {
            f32x4 u4 = mm_tile<1>(L + O_TI, S32, L + O_UTT + 16 * q * S32, S32, (f32x4){0.f, 0.f, 0.f, 0.f}, lane);
            st_bf16x4(L + O_UT + (16 * q + fr) * S32 + fg * 8, -u4);
        }
        __syncthreads();
        {
            yacc = mm_tile<1>(L + O_UT + 16 * q * S32, S32, L + O_NB, S32, yacc, lane);
            ypend.x = cvtpk(yacc[0], yacc[1]); ypend.y = cvtpk(yacc[2], yacc[3]);
            const f32x4 wc4 = *(LAS f32x4*)(L + O_WC + (16 * q + 4 * fg) * 4);
#pragma unroll
            for (int vi = 0; vi < 4; ++vi) {
                f32x4 s4 = Sacc[vi] * wc4;
                s4 = mm_tile<1>(L + O_KHT + 16 * q * S32, S32, L + O_VT + 16 * vi * S32, S32, s4, lane);
                s4 = mm_tile<1>(L + O_BHT + 16 * q * S32, S32, L + O_UT + 16 * vi * S32, S32, s4, lane);
                Sacc[vi] = s4;
                st_bf16x4(L + O_SBF + (16 * vi + fr) * S64 + (16 * q + 4 * fg) * 2, s4);
            }
        }
    }
    flush(143);
    __syncthreads();
}

__device__ __forceinline__ void phase_gdn_prep(const Args& A, Ctx& C) {
    const bf16_t* P = WSP(bf16_t, WS_P);
    bf16_t* QKV = (bf16_t*)A.out; float* NRM = WSP(float, WS_NRM);
    const int lane = C.lane, w = C.wave, hq = w >> 1, th = w & 1;
    const int ch0 = 128 * hq + 2 * lane;
    float cw[3][2][5];
#pragma unroll
    for (int g = 0; g < 3; ++g)
#pragma unroll
        for (int xx = 0; xx < 2; ++xx)
#pragma unroll
            for (int e = 0; e < 5; ++e) cw[g][xx][e] = A.in[I_CONVW][e * 1536 + g * 512 + ch0 + xx];
    auto geom = [&](int tile, int& T, int& tb, size_t& rowbase) { const int row0 = tile * 16; int ta;
        if (row0 < NLAT) { T = SEQ; rowbase = (size_t)(row0 >> 11) * SEQ; ta = row0 & (SEQ - 1); } else { T = CTX; const int r = row0 - NLAT; rowbase = (size_t)NLAT + (size_t)(r >> 8) * CTX; ta = r & (CTX - 1); }
        tb = ta + 8 * th; };
    unsigned raw[12][3];
    auto issue = [&](int tile) { int T, tb; size_t rowbase; geom(tile, T, tb, rowbase);
#pragma unroll
        for (int e = 0; e < 12; ++e) { const int t = tb - 2 + e; const bool ok = (t >= 0 && t < T); const unsigned* pr = (const unsigned*)(P + (rowbase + (ok ? t : tb)) * PLD + RW_COLS + ch0);
#pragma unroll
            for (int g = 0; g < 3; ++g) raw[e][g] = pr[g * 256]; } };
    if (C.bid < NROWS / 16) issue(C.bid);
    for (int tile = C.bid; tile < NROWS / 16; tile += C.G) {
        int T, tb; size_t rowbase; geom(tile, T, tb, rowbase);
        float x[3][2][12];
#pragma unroll
        for (int e = 0; e < 12; ++e) { const int t = tb - 2 + e; const bool ok = (t >= 0 && t < T);
#pragma unroll
            for (int g = 0; g < 3; ++g) { const unsigned wv = raw[e][g]; x[g][0][e] = ok ? bflo(wv) : 0.f; x[g][1][e] = ok ? bfhi(wv) : 0.f; } }
        if (tile + C.G < NROWS / 16) issue(tile + C.G);
#pragma unroll
        for (int i = 0; i < 8; ++i) { float y[3][2];
#pragma unroll
            for (int g = 0; g < 3; ++g)
#pragma unroll
                for (int xx = 0; xx < 2; ++xx) { float sacc = 0.f;
#pragma unroll
                    for (int f = 0; f < 5; ++f) sacc += cw[g][xx][f] * x[g][xx][i + f];
                    y[g][xx] = siluf_(sacc); }
            const size_t row = rowbase + tb + i;
            unsigned* orow = (unsigned*)(QKV + row * 1536 + ch0);
            orow[0] = cvtpk(y[0][0], y[0][1]); orow[256] = cvtpk(y[1][0], y[1][1]); orow[512] = cvtpk(y[2][0], y[2][1]);
            const float sq = wave_sum(y[0][0] * y[0][0] + y[0][1] * y[0][1]), sk = wave_sum(y[1][0] * y[1][0] + y[1][1] * y[1][1]);
            if (lane == 0) { NRM[row * 8 + hq] = __builtin_amdgcn_rsqf(sq + 1e-6f) * 0.08838834764831845f; NRM[row * 8 + 4 + hq] = __builtin_amdgcn_rsqf(sk + 1e-6f); } }
    }
    __syncthreads();
}

namespace gd {
constexpr int S128 = 288, S32 = 80;
constexpr int O_KT = 0, O_QT = O_KT + 32 * S128, O_KKT = O_QT + 32 * S128, O_RT = O_KKT + 32 * S128,
              O_VT = O_RT + 32 * S128, O_BHT = O_VT + 128 * S32, O_KHT = O_BHT + 128 * S32, O_UT = O_KHT + 128 * S32, O_UTT = O_UT + 128 * S32,
              O_TI = O_UTT + 128 * S32, O_MK = O_TI + 32 * S32, O_NB = O_MK + 32 * S32, O_NK = O_NB + 32 * S32,
              O_M21 = O_NK + 32 * S32, O_T11T = O_M21 + 16 * S32, O_T22 = O_T11T + 16 * S32, O_XT = O_T22 + 16 * S32,
              O_SBF = O_XT + 16 * S32, O_SC = O_SBF + 128 * S128, O_MS = O_SC + 512, GD_BYTES = O_MS + 2048;
static_assert(GD_BYTES <= LDS_MISC, "gdn LDS");
}
__device__ __forceinline__ void gdn_chain_chunked(const Args& A, Ctx& C, int chain) {
    using namespace gd;
    const int b = chain >> 3, h = (chain >> 1) & 3, dir = chain & 1;
    lbyte* L = C.lds;
    LAS float* SC = (LAS float*)(L + O_SC);
    const bf16_t* P = WSP(bf16_t, WS_P);
    bf16_t* ydir = WSP(bf16_t, WS_YDIR) + (size_t)dir * NLAT * D;
    const int tid = C.tid, lane = C.lane, w = C.wave, fr = lane & 15, fg = lane >> 4;
    const int grp = w >> 1, idx = tid & 127;
    const float Aexp = __expf(A.in[I_ALOG][dir * 4 + h]), dtb = A.in[I_DTB][dir * 4 + h];
    const f32x4 z4 = (f32x4){0.f, 0.f, 0.f, 0.f};
    __syncthreads();
#pragma unroll 2
    for (int i = tid; i < (O_SC - O_VT) / 4; i += 512) ((LAS unsigned*)(L + O_VT))[i] = 0u;
    f32x4 Sacc[8];
#pragma unroll
    for (int i = 0; i < 8; ++i) Sacc[i] = z4;
    const bf16_t* QKV = (const bf16_t*)A.out; const float* NRM = WSP(const float, WS_NRM);
    struct PF { unsigned rq[8], rk[8], rv[8]; float nrm; unsigned al, be; };
    PF pfA, pfB; pfA.nrm = pfB.nrm = 0.f; pfA.al = pfA.be = pfB.al = pfB.be = 0u;
    const unsigned codd = (idx & 1) ? 0u : 16u, godd = (h & 1) ? 0u : 16u;
    auto chunk_geom = [&](int ch, bool& isctx, int& sbase, int& T, size_t& rowbase) { isctx = ch < 8; sbase = isctx ? ch * 32 : (ch - 8) * 32; T = isctx ? CTX : SEQ;
        rowbase = isctx ? (size_t)NLAT + (size_t)b * CTX : (size_t)b * SEQ; };
    auto issue_loads = [&](int ch, PF& pf) { bool isctx; int sbase, T; size_t rowbase; chunk_geom(ch, isctx, sbase, T, rowbase);
#pragma unroll
        for (int j = 0; j < 8; ++j) { const int i = 8 * grp + j; const int t = dir ? (T - 1 - (sbase + i)) : (sbase + i); const size_t row = rowbase + t;
            const unsigned* qr = (const unsigned*)(QKV + row * 1536 + 128 * h + (idx & ~1)); pf.rq[j] = qr[0]; pf.rk[j] = qr[256]; pf.rv[j] = qr[512]; }
        { const int i = 8 * grp + (lane & 7); const int t = dir ? (T - 1 - (sbase + i)) : (sbase + i); pf.nrm = NRM[(rowbase + t) * 8 + ((lane & 8) ? 4 : 0) + h]; }
        if (w == 7 && lane < 32) { const int t = dir ? (T - 1 - (sbase + lane)) : (sbase + lane); const unsigned* pr = (const unsigned*)(P + (rowbase + t) * PLD + RW_COLS + 2048 + ((dir * 4 + h) & ~1)); pf.al = pr[0]; pf.be = pr[4]; } };
    u32x2 ypend[2]; ypend[0].x = ypend[0].y = ypend[1].x = ypend[1].y = 0u;
    auto flush = [&](int pch) { bool pisctx; int psb, pT; size_t prb; chunk_geom(pch, pisctx, psb, pT, prb);
        if (!pisctx) {
#pragma unroll
            for (int tb = 0; tb < 2; ++tb) { const int tl = psb + tb * 16 + fr; const int t = dir ? (pT - 1 - tl) : tl;
                *(u32x2*)(ydir + ((size_t)b * SEQ + t) * D + 512 + 128 * h + 16 * w + 4 * fg) = ypend[tb]; } } };
    issue_loads(0, pfA); issue_loads(1, pfB);
    auto chunk = [&](int ch, PF& pf) __attribute__((always_inline)) {
        bool isctx; int sbase, T; size_t rowbase; chunk_geom(ch, isctx, sbase, T, rowbase);
        __syncthreads();
        float qv[8], kv[8], vv[8], nqv[8], nkv[8];
#pragma unroll
        for (int j = 0; j < 8; ++j) { qv[j] = bfsel(pf.rq[j], codd); kv[j] = bfsel(pf.rk[j], codd); vv[j] = bfsel(pf.rv[j], codd); nqv[j] = rdlane(pf.nrm, j); nkv[j] = rdlane(pf.nrm, 8 + j); }
        if (w == 7) {
            const float gi = (lane < 32) ? -Aexp * softplusf_(bfsel(pf.al, godd) + dtb) : 0.f;
            float cum = gi;
            cum += __builtin_bit_cast(float, __builtin_amdgcn_update_dpp(0, __builtin_bit_cast(int, cum), 0x111, 0xf, 0xf, true));
            cum += __builtin_bit_cast(float, __builtin_amdgcn_update_dpp(0, __builtin_bit_cast(int, cum), 0x112, 0xf, 0xf, true));
            cum += __builtin_bit_cast(float, __builtin_amdgcn_update_dpp(0, __builtin_bit_cast(int, cum), 0x114, 0xf, 0xf, true));
            cum += __builtin_bit_cast(float, __builtin_amdgcn_update_dpp(0, __builtin_bit_cast(int, cum), 0x118, 0xf, 0xf, true));
            const float r0 = rdlane(cum, 15);
            cum += (lane >= 16) ? r0 : 0.f;
            if (lane < 32) { SC[lane] = sigmoidf_(bfsel(pf.be, godd)); SC[32 + lane + 1] = cum; if (lane == 0) SC[32] = 0.f; }
        }
        asm volatile("" :: "v"(qv[0]), "v"(qv[1]), "v"(qv[2]), "v"(qv[3]), "v"(qv[4]), "v"(qv[5]), "v"(qv[6]), "v"(qv[7]), "v"(kv[0]), "v"(kv[1]), "v"(kv[2]), "v"(kv[3]), "v"(kv[4]), "v"(kv[5]), "v"(kv[6]), "v"(kv[7]),
                        "v"(vv[0]), "v"(vv[1]), "v"(vv[2]), "v"(vv[3]), "v"(vv[4]), "v"(vv[5]), "v"(vv[6]), "v"(vv[7]) : "memory");
        asm volatile("" :: "v"(nqv[0]), "v"(nqv[1]), "v"(nqv[2]), "v"(nqv[3]), "v"(nqv[4]), "v"(nqv[5]), "v"(nqv[6]), "v"(nqv[7]), "v"(nkv[0]), "v"(nkv[1]), "v"(nkv[2]), "v"(nkv[3]), "v"(nkv[4]), "v"(nkv[5]), "v"(nkv[6]), "v"(nkv[7]),
                        "v"(pf.al), "v"(pf.be) : "memory");
        if (ch > 0) flush(ch - 1);
        if (ch + 2 < 72) issue_loads(ch + 2, pf);
        __syncthreads();
        {
            const int c = idx; const float gcC = SC[32 + 32];
            float bh[8], kh[8];
#pragma unroll
            for (int j = 0; j < 8; ++j) { const int i = 8 * grp + j;
                const float kn = kv[j] * nkv[j], qn = qv[j] * nqv[j];
                const float gm = SC[32 + i], gi = SC[32 + i + 1], be = SC[i];
                const unsigned p0 = cvtpk(kn, qn);
                *(LAS unsigned short*)(L + O_KT + i * S128 + c * 2) = (unsigned short)p0; *(LAS unsigned short*)(L + O_QT + i * S128 + c * 2) = (unsigned short)(p0 >> 16);
                bh[j] = be * kn * __expf(gcC - gm); kh[j] = be * kn * __expf(gcC - gi); }
            u32x4 w4;
            w4.x = cvtpk(bh[0], bh[1]); w4.y = cvtpk(bh[2], bh[3]); w4.z = cvtpk(bh[4], bh[5]); w4.w = cvtpk(bh[6], bh[7]); *(LAS u32x4*)(L + O_BHT + c * S32 + grp * 16) = w4;
            w4.x = cvtpk(kh[0], kh[1]); w4.y = cvtpk(kh[2], kh[3]); w4.z = cvtpk(kh[4], kh[5]); w4.w = cvtpk(kh[6], kh[7]); *(LAS u32x4*)(L + O_KHT + c * S32 + grp * 16) = w4;
            w4.x = cvtpk(vv[0], vv[1]); w4.y = cvtpk(vv[2], vv[3]); w4.z = cvtpk(vv[4], vv[5]); w4.w = cvtpk(vv[6], vv[7]); *(LAS u32x4*)(L + O_VT + c * S32 + grp * 16) = w4;
        }
        __syncthreads();
        {
            const int isq = w >> 2, tb = (w >> 1) & 1, jb = w & 1;
            if (jb <= tb) {
                const f32x4 g4 = mm_tile<4>(L + O_KT + jb * 16 * S128, S128, L + (isq ? O_QT : O_KT) + tb * 16 * S128, S128, z4, lane);
                const int t = tb * 16 + fr;
                const float gt = SC[32 + t + isq];
                f32x4 m0, m1;
#pragma unroll
                for (int e = 0; e < 4; ++e) { const int j = jb * 16 + 4 * fg + e; const bool keep = isq ? (j <= t) : (j < t);
                    const float bj = SC[j] * g4[e];
                    m0[e] = keep ? bj * __expf(gt - SC[32 + j]) : 0.f;
                    m1[e] = keep ? bj * __expf(gt - SC[32 + j + 1]) : 0.f; }
                const int off = t * S32 + (jb * 16 + 4 * fg) * 2;
                if (isq) { st_bf16x4(L + O_NB + off, m0); st_bf16x4(L + O_NK + off, m1); }
                else {
                    st_bf16x4(L + O_MK + off, m1);
                    if (tb != jb) st_bf16x4(L + O_M21 + fr * S32 + fg * 8, m0);
                    else { float X[16]; __builtin_amdgcn_s_setprio(3); tri_inv16(m0, lane, L + O_MS + tb * 1024, X); __builtin_amdgcn_s_setprio(0);
                        if (lane < 16) {
#pragma unroll
                            for (int i = 0; i < 16; ++i) *(LAS unsigned short*)(L + O_TI + (tb * 16 + i) * S32 + (tb * 16 + lane) * 2) = (unsigned short)cvtpk(X[i], 0.f);
                            if (tb == 0) { u32x4 a0, a1;
                                a0.x = cvtpk(X[0], X[1]); a0.y = cvtpk(X[2], X[3]); a0.z = cvtpk(X[4], X[5]); a0.w = cvtpk(X[6], X[7]);
                                a1.x = cvtpk(X[8], X[9]); a1.y = cvtpk(X[10], X[11]); a1.z = cvtpk(X[12], X[13]); a1.w = cvtpk(X[14], X[15]);
                                *(LAS u32x4*)(L + O_T11T + lane * S32) = a0; *(LAS u32x4*)(L + O_T11T + lane * S32 + 16) = a1; }
                            else {
#pragma unroll
                                for (int i = 0; i < 16; ++i) *(LAS unsigned short*)(L + O_T22 + i * S32 + lane * 2) = (unsigned short)cvtpk(X[i], 0.f); }
                        } }
                }
            }
        }
        __syncthreads();
        if (w == 1) {
            const f32x4 x4 = mm_tile<1>(L + O_M21, S32, L + O_T11T, S32, z4, lane);
            st_bf16x4(L + O_XT + fr * S32 + fg * 8, x4);
            asm volatile("s_waitcnt lgkmcnt(0)" ::: "memory");
            const f32x4 t4 = mm_tile<1>(L + O_XT, S32, L + O_T22, S32, z4, lane);
            st_bf16x4(L + O_TI + (16 + fr) * S32 + fg * 8, -t4);
        }
        f32x4 yacc[2];
#pragma unroll
        for (int tb = 0; tb < 2; ++tb) {
            f32x4 u4 = mm_tile<4>(L + O_KT + tb * 16 * S128, S128, L + O_SBF + 16 * w * S128, S128, z4, lane);
            { const f32x4 gp = *(LAS f32x4*)(SC + 32 + 16 * tb + 4 * fg);
                u4.x *= __expf(gp.x); u4.y *= __expf(gp.y); u4.z *= __expf(gp.z); u4.w *= __expf(gp.w); }
            u4 = mm_tile<1>(L + O_MK + tb * 16 * S32, S32, L + O_VT + 16 * w * S32, S32, u4, lane);
            st_bf16x4(L + O_UTT + (16 * w + fr) * S32 + tb * 32 + fg * 8, u4);
            yacc[tb] = mm_tile<4>(L + O_SBF + 16 * w * S128, S128, L + O_QT + tb * 16 * S128, S128, z4, lane);
            yacc[tb] = yacc[tb] * __expf(SC[32 + 16 * tb + fr + 1]);
            yacc[tb] = mm_tile<1>(L + O_VT + 16 * w * S32, S32, L + O_NK + tb * 16 * S32, S32, yacc[tb], lane);
        }
        __syncthreads();
#pragma unroll
        for (int tb = 0; tb < 2; ++tb) {
            const f32x4 u4 = mm_tile<1>(L + O_TI + tb * 16 * S32, S32, L + O_UTT + 16 * w * S32, S32, z4, lane);
            st_bf16x4(L + O_UT + (16 * w + fr) * S32 + tb * 32 + fg * 8, -u4);
        }
        __syncthreads();
        {
#pragma unroll
            for (int tb = 0; tb < 2; ++tb) {
                yacc[tb] = mm_tile<1>(L + O_UT + 16 * w * S32, S32, L + O_NB + tb * 16 * S32, S32, yacc[tb], lane);
                ypend[tb].x = cvtpk(yacc[tb][0], yacc[tb][1]); ypend[tb].y = cvtpk(yacc[tb][2], yacc[tb][3]);
            }
            const float wc = __expf(SC[32 + 32]);
#pragma unroll
            for (int vi = 0; vi < 8; ++vi) {
                f32x4 s4 = Sacc[vi] * wc;
                s4 = mm_tile<1>(L + O_KHT + 16 * w * S32, S32, L + O_VT + 16 * vi * S32, S32, s4, lane);
                s4 = mm_tile<1>(L + O_BHT + 16 * w * S32, S32, L + O_UT + 16 * vi * S32, S32, s4, lane);
                Sacc[vi] = s4;
                st_bf16x4(L + O_SBF + (16 * vi + fr) * S128 + (16 * w + 4 * fg) * 2, s4);
            }
        }
    };
    for (int ch = 0; ch < 72; ch += 2) { chunk(ch, pfA); chunk(ch + 1, pfB); }
    flush(71);
    __syncthreads();
}

__device__ __forceinline__ void unpack8(const u32x4 w, float (&f)[8]) { f[0] = bflo(w.x); f[1] = bfhi(w.x); f[2] = bflo(w.y); f[3] = bfhi(w.y); f[4] = bflo(w.z); f[5] = bfhi(w.z); f[6] = bflo(w.w); f[7] = bfhi(w.w); }
__device__ __forceinline__ void phase_p4(const Args& A, Ctx& C) {
    const bf16_t* P = WSP(bf16_t, WS_P);
    const bf16_t* yf = WSP(bf16_t, WS_YDIR); const bf16_t* yb = yf + (size_t)NLAT * D;
    const float* bon = WSP(float, WS_BON);
    bf16_t* ymix = WSP(bf16_t, WS_YMIX);
    lbyte* SGb = C.lds;
    lfloat* GO = (lfloat*)(C.lds + 8192);
    const int tid = C.tid, lane = C.lane, w = C.wave;
    const bf16_t* gupt = WSP(const bf16_t, WS_GUPT);
    const int fr = lane & 15, fg = lane >> 4;
    const int c8 = 8 * lane;
    float lnw[8], lnb[8], ong[8], muv[8];
#pragma unroll
    for (int e = 0; e < 8; ++e) { lnw[e] = A.in[I_LNW][c8 + e]; lnb[e] = A.in[I_LNB][c8 + e]; ong[e] = A.in[I_ONG][(c8 + e) & 127]; muv[e] = A.in[I_MU][1024 + c8 + e]; }
    const int tkA = tid >> 5, lA = 4 * (tid & 31);
    float muA[4];
#pragma unroll
    for (int e = 0; e < 4; ++e) muA[e] = A.in[I_MU][1792 + lA + e];
    const bool vup = (1024 + c8) < 1440;
    bf16x8 gq[4][4];
#pragma unroll
    for (int i = 0; i < 4; ++i)
#pragma unroll
        for (int ks = 0; ks < 4; ++ks) gq[i][ks] = *(const bf16x8*)(gupt + (size_t)(64 * w + 16 * i + fr) * 128 + ks * 32 + fg * 8);
    u32x2 pwA, swA;
    auto issueA = [&](int tile) { const int row = tile * 16 + tkA, t = row & (SEQ - 1); const bool ok = t < SEQ - 64;
        pwA = *(const u32x2*)(P + (size_t)row * PLD + 1792 + lA); swA = *(const u32x2*)(P + (size_t)(row + (ok ? 64 : 0)) * PLD + 1792 + lA); };
    if (C.bid < NLAT / 16) issueA(C.bid);
    for (int tile = C.bid; tile < NLAT / 16; tile += C.G) {
        const int row0 = tile * 16;
        u32x4 wyf[2], wyb[2], wpv[2], wsv[2], wof[2], wob[2], wz[2]; float bsv[2];
#pragma unroll
        for (int tt = 0; tt < 2; ++tt) {
            const int tk = 2 * w + tt, row = row0 + tk, t = row & (SEQ - 1);
            const bool okv = vup ? (t >= 64) : (t < SEQ - 64);
            wyf[tt] = *(const u32x4*)(yf + (size_t)row * D + c8); wyb[tt] = *(const u32x4*)(yb + (size_t)row * D + c8);
            wpv[tt] = *(const u32x4*)(P + (size_t)row * PLD + 1024 + c8); wsv[tt] = *(const u32x4*)(P + (size_t)(row + (okv ? (vup ? -64 : 64) : 0)) * PLD + 1024 + c8);
            wof[tt] = *(const u32x4*)(yf + (size_t)row * D + 512 + c8); wob[tt] = *(const u32x4*)(yb + (size_t)row * D + 512 + c8);
            wz[tt] = *(const u32x4*)(P + (size_t)row * PLD + RW_COLS + 1536 + c8);
            bsv[tt] = bon[(size_t)row * 8 + (lane >> 3)] + bon[((size_t)NLAT + row) * 8 + (lane >> 3)];
        }
        __syncthreads();
        {
            const int row = row0 + tkA, t = row & (SEQ - 1); const bool ok = t < SEQ - 64;
            const u32x2 pw = pwA, sw = swA;
            const float pv[4] = {bflo(pw.x), bfhi(pw.x), bflo(pw.y), bfhi(pw.y)}; const float sv[4] = {bflo(sw.x), bfhi(sw.x), bflo(sw.y), bfhi(sw.y)};
            float o[4];
#pragma unroll
            for (int e = 0; e < 4; ++e) o[e] = sigmoidf_(pv[e] + muA[e] * ((ok ? sv[e] : 0.f) - pv[e]));
            u32x2 ow; ow.x = cvtpk(o[0], o[1]); ow.y = cvtpk(o[2], o[3]); *(LAS u32x2*)(SGb + tkA * 288 + lA * 2) = ow;
        }
        if (tile + C.G < NLAT / 16) issueA(tile + C.G);
        __syncthreads();
#pragma unroll
        for (int i = 0; i < 4; ++i) { const int c0 = 64 * w + 16 * i; f32x4 acc = (f32x4){0.f, 0.f, 0.f, 0.f};
#pragma unroll
            for (int ks = 0; ks < 4; ++ks) { const bf16x8 a = *(const LAS bf16x8*)(SGb + fr * 288 + ks * 64 + fg * 16);
                acc = __builtin_amdgcn_mfma_f32_16x16x32_bf16(a, gq[i][ks], acc, 0, 0, 0); }
#pragma unroll
            for (int e = 0; e < 4; ++e) GO[(4 * fg + e) * 512 + c0 + fr] = acc[e]; }
        __syncthreads();
#pragma unroll
        for (int tt = 0; tt < 2; ++tt) {
            const int tk = 2 * w + tt, row = row0 + tk, t = row & (SEQ - 1);
            const bool okv = vup ? (t >= 64) : (t < SEQ - 64);
            const float bs = bsv[tt];
            const f32x4 g0 = *(const LAS f32x4*)(GO + tk * 512 + c8), g1 = *(const LAS f32x4*)(GO + tk * 512 + c8 + 4);
            const float gg[8] = {g0.x, g0.y, g0.z, g0.w, g1.x, g1.y, g1.z, g1.w};
            float a[8], bq[8], pv[8], sv[8], y[8];
            unpack8(wyf[tt], a); unpack8(wyb[tt], bq); unpack8(wpv[tt], pv); unpack8(wsv[tt], sv);
            float s1 = 0.f;
#pragma unroll
            for (int e = 0; e < 8; ++e) { y[e] = a[e] + bq[e]; s1 += y[e]; }
            s1 += __shfl_xor(s1, 1); s1 += __shfl_xor(s1, 2); s1 += __shfl_xor(s1, 4);
            const float m = s1 * (1.f / 64.f);
            float s2 = 0.f;
#pragma unroll
            for (int e = 0; e < 8; ++e) { y[e] -= m; s2 += y[e] * y[e]; }
            s2 += __shfl_xor(s2, 1); s2 += __shfl_xor(s2, 2); s2 += __shfl_xor(s2, 4);
            const float rs = __builtin_amdgcn_rsqf(s2 * (1.f / 64.f) + RWKV_EPS);
            float o[8];
#pragma unroll
            for (int e = 0; e < 8; ++e) { const float vv = pv[e] + muv[e] * ((okv ? sv[e] : 0.f) - pv[e]); o[e] = (y[e] * rs * lnw[e] + lnb[e] + bs * vv) * gg[e]; }
            u32x4 ow; ow.x = cvtpk(o[0], o[1]); ow.y = cvtpk(o[2], o[3]); ow.z = cvtpk(o[4], o[5]); ow.w = cvtpk(o[6], o[7]);
            *(u32x4*)(ymix + (size_t)row * D + c8) = ow;
            float of[8], ob[8], z[8];
            unpack8(wof[tt], of); unpack8(wob[tt], ob); unpack8(wz[tt], z);
            float s3 = 0.f;
#pragma unroll
            for (int e = 0; e < 8; ++e) { of[e] += ob[e]; s3 += of[e] * of[e]; }
            s3 += __shfl_xor(s3, 1); s3 += __shfl_xor(s3, 2); s3 += __shfl_xor(s3, 4); s3 += __shfl_xor(s3, 8);
            const float rg = __builtin_amdgcn_rsqf(s3 * (1.f / 128.f) + NORM_EPS);
#pragma unroll
            for (int e = 0; e < 8; ++e) o[e] = of[e] * rg * ong[e] * siluf_(z[e]);
            ow.x = cvtpk(o[0], o[1]); ow.y = cvtpk(o[2], o[3]); ow.z = cvtpk(o[4], o[5]); ow.w = cvtpk(o[6], o[7]);
            *(u32x4*)(ymix + (size_t)row * D + 512 + c8) = ow;
        }
    }
}

__device__ __forceinline__ void convert_experts(const Args& A, Ctx& C) {
    lfloat* scr = (lfloat*)(C.lds + C.wave * 16384);
    const int gw = C.bid * 8 + C.wave, NGW = C.G * 8;
    constexpr int I13 = (D / 128) * (DE / 32);
    constexpr int I2 = (DE / 128) * (D / 32);
    constexpr int PER = 2 * I13 + I2;
    for (int it = gw; it < 257 * PER; it += NGW) {
        const int e = it / PER; int r = it % PER;
        unsigned char* bt13 = A.ws + WS_WEXP + (size_t)e * WEXP_STRIDE; unsigned char* bt2 = bt13 + 512 * 1024;
        const float* w1 = e < NE ? A.in[I_EW1] + (size_t)e * D * DE : A.in[I_SW1];
        const float* w3 = e < NE ? A.in[I_EW3] + (size_t)e * D * DE : A.in[I_SW3];
        const float* w2 = e < NE ? A.in[I_EW2] + (size_t)e * DE * D : A.in[I_SW2];
        if (r < I13) { transpose_pair_fp8(w1, D, DE, bt13, RowGLU{0}, SW13, scr, r, C.lane); continue; } r -= I13;
        if (r < I13) { transpose_pair_fp8(w3, D, DE, bt13, RowGLU{128}, SW13, scr, r, C.lane); continue; } r -= I13;
        transpose_pair_fp8(w2, DE, D, bt2, RowId(), SW2, scr, r, C.lane);
    }
}

__device__ __forceinline__ void phase_p6(const Args& A, Ctx& C) {
    const float* mod = WSP(float, WS_MOD); bf16_t* h2n = WSP(bf16_t, WS_H2N);
    const int gw = C.bid * 8 + C.wave, NGW = C.G * 8;
    for (int row = gw; row < NLAT; row += NGW) {
        const float* m = mod + (size_t)(row >> 11) * MODW;
        f32x4 v[4]; load_row_bf16(WSP(const bf16_t, WS_H1B) + (size_t)row * D, C.lane, v);
        norm_mod_vals(v, A.in[I_N2G], m + 4 * D, m + 3 * D, h2n + (size_t)row * D, C.lane, (unsigned*)(A.ws + WS_H2N8) + (size_t)row * (D / 4));
    }
}

__device__ __forceinline__ void phase_p8(const Args& A, Ctx& C) {
    const float* logit = WSP(float, WS_LOGIT);
    int* tope = WSP(int, WS_TOPE); float* topw = WSP(float, WS_TOPW); int* pos = WSP(int, WS_POS);
    unsigned* cnt = WSP(unsigned, WS_CTL) + CW_CNT;
    const int lane = C.lane;
    const f32x4 rb = ((const f32x4*)A.in[I_RB])[lane];
    LAS unsigned* hist = (LAS unsigned*)C.lds;
    LAS unsigned* base = hist + 256;
    LAS unsigned* lpe = base + 256;
    constexpr int CI13 = (D / 128) * (DE / 32), CI2 = (DE / 128) * (D / 32), CPER = 2 * CI13 + CI2, NPAIR = 257 * CPER;
    lfloat* scr = (lfloat*)(C.lds + 16384 + C.wave * 8448);
    const int NGWc = C.G * 8; int cit = C.bid * 8 + C.wave;
    const int ckr = lane >> 3, cn4 = (lane & 7) * 4, cc8 = lane & 7;
    const float* cW = nullptr; unsigned char* cWT = nullptr; int cK = 0, cN = 0, cglu = 0, ck0 = 0, cn0 = 0; float csc = 0.f;
    f32x4 cld[2][8];
    auto conv_issue = [&]() { const int ex = cit / CPER; int r = cit % CPER;
        unsigned char* bt13 = A.ws + WS_WEXP + (size_t)ex * WEXP_STRIDE;
        if (r < 2 * CI13) { const int which = r >= CI13; r -= which * CI13; cW = which ? (ex < NE ? A.in[I_EW3] + (size_t)ex * D * DE : A.in[I_SW3]) : (ex < NE ? A.in[I_EW1] + (size_t)ex * D * DE : A.in[I_SW1]);
            cWT = bt13; cK = D; cN = DE; cglu = which ? 128 : 0; csc = SW13; }
        else { r -= 2 * CI13; cW = ex < NE ? A.in[I_EW2] + (size_t)ex * DE * D : A.in[I_SW2]; cWT = bt13 + 512 * 1024; cK = DE; cN = D; cglu = -1; csc = SW2; }
        const int nblk = cN / 32; ck0 = 128 * (r / nblk); cn0 = 32 * (r % nblk);
#pragma unroll
        for (int h = 0; h < 2; ++h)
#pragma unroll
            for (int i = 0; i < 8; ++i) cld[h][i] = *(const f32x4*)(cW + (size_t)(ck0 + 64 * h + 8 * i + ckr) * cN + cn0 + cn4); };
    auto conv_finish = [&]() { u32x2 o[2][4];
#pragma unroll
        for (int h = 0; h < 2; ++h) {
#pragma unroll
            for (int i = 0; i < 8; ++i) { lfloat* d = scr + (8 * i + ckr) * 33 + cn4; d[0] = cld[h][i].x * csc; d[1] = cld[h][i].y * csc; d[2] = cld[h][i].z * csc; d[3] = cld[h][i].w * csc; }
            asm volatile("s_waitcnt lgkmcnt(0)" ::: "memory");
#pragma unroll
            for (int j = 0; j < 4; ++j) { const int n = (lane >> 3) + 8 * j; const lfloat* sp = scr + (8 * cc8) * 33 + n;
                o[h][j].x = pk4_fp8(sp[0 * 33], sp[1 * 33], sp[2 * 33], sp[3 * 33]); o[h][j].y = pk4_fp8(sp[4 * 33], sp[5 * 33], sp[6 * 33], sp[7 * 33]); }
            asm volatile("s_waitcnt lgkmcnt(0)" ::: "memory"); }
#pragma unroll
        for (int j = 0; j < 4; ++j) { const int n = cn0 + (lane >> 3) + 8 * j; const int row = cglu >= 0 ? ((n >> 7) << 8) + cglu + (n & 127) : n;
            unsigned char* p = cWT + (size_t)row * cK + ck0 + 8 * cc8; *(u32x2*)p = o[0][j]; *(u32x2*)(p + 64) = o[1][j]; }
        cit += NGWc; };
    for (int blk = C.bid; blk < NLAT / 256; blk += C.G) {
    __syncthreads();
    if (C.tid < 256) hist[C.tid] = 0u;
    __syncthreads();
    f32x4 nlg = ((const f32x4*)(logit + (size_t)(blk * 256 + C.wave * 32) * NE))[lane];
    for (int ti = 0; ti < 32; ++ti) {
        const int tl = C.wave * 32 + ti, tok = blk * 256 + tl;
        const f32x4 lg = nlg;
        if (ti + 1 < 32) nlg = ((const f32x4*)(logit + (size_t)(tok + 1) * NE))[lane];
        const bool cv = cit < NPAIR;
        if (cv) conv_issue();
        float s[4], sel[4];
#pragma unroll
        for (int i = 0; i < 4; ++i) { s[i] = sigmoidf_(lg[i]); sel[i] = s[i] + rb[i]; }
        float m1 = fmaxf(fmaxf(sel[0], sel[1]), fmaxf(sel[2], sel[3]));
        float m2;
        {
            float a = fmaxf(sel[0], sel[1]), bq = fminf(sel[0], sel[1]), cq = fmaxf(sel[2], sel[3]), dq = fminf(sel[2], sel[3]);
            m2 = fmaxf(fminf(a, cq), fmaxf(bq, dq)); }
#define P8_MERGE(CTRL) { const float o1 = dpp_f<CTRL>(m1), o2 = dpp_f<CTRL>(m2); const float n1 = fmaxf(m1, o1); const float n2 = fmaxf(fminf(m1, o1), fmaxf(m2, o2)); m1 = n1; m2 = n2; }
        P8_MERGE(0xB1) P8_MERGE(0x4E) P8_MERGE(0x141)
#undef P8_MERGE
        const float gs = m1 + m2;
        const int grp = lane >> 3;
        int rank = 0;
#pragma unroll
        for (int gq = 0; gq < 8; ++gq) { const float og = __shfl(gs, gq * 8); rank += (og > gs || (og == gs && gq < grp)) ? 1 : 0; }
        const bool gsel = rank < 4;
        float cand[4];
#pragma unroll
        for (int i = 0; i < 4; ++i) cand[i] = gsel ? sel[i] : -INFINITY;
        int my_e = 0; float my_w = 0.f; float wsum = 0.f;
#pragma unroll
        for (int r = 0; r < 8; ++r) {
            float bv = cand[0]; int bi = 0;
#pragma unroll
            for (int i = 1; i < 4; ++i) if (cand[i] > bv) { bv = cand[i]; bi = i; }
            float wm = bv;
            wm = fmaxf(wm, dpp_f<0x128>(wm)); wm = fmaxf(wm, dpp_f<0x124>(wm)); wm = fmaxf(wm, dpp_f<0x122>(wm)); wm = fmaxf(wm, dpp_f<0x121>(wm));
            const float gv = fmaxf(fmaxf(rdlane(wm, 0), rdlane(wm, 16)), fmaxf(rdlane(wm, 32), rdlane(wm, 48)));
            const unsigned long long bal = __ballot(bv == gv);
            const int ol = __builtin_amdgcn_readfirstlane((int)__builtin_ctzll(bal));
            const int oi = __builtin_amdgcn_readlane(bi, ol);
            const int be = ol * 4 + oi;
            const float mys = oi == 0 ? s[0] : (oi == 1 ? s[1] : (oi == 2 ? s[2] : s[3]));
            const float ws_ = rdlane(mys, ol);
            const bool mine = lane == ol;
#pragma unroll
            for (int i = 0; i < 4; ++i) cand[i] = (mine && oi == i) ? -INFINITY : cand[i];
            wsum += ws_;
            if (lane == r) { my_e = be; my_w = ws_; }
        }
        if (lane < 8) {
            const float w = my_w / wsum * 2.5f;
            const unsigned lp = __hip_atomic_fetch_add(hist + my_e, 1u, __ATOMIC_RELAXED, __HIP_MEMORY_SCOPE_WORKGROUP);
            tope[(size_t)tok * 8 + lane] = my_e; topw[(size_t)tok * 8 + lane] = w; lpe[tl * 8 + lane] = ((unsigned)my_e << 16) | lp;
        }
        if (cv) conv_finish();
    }
    __syncthreads();
    if (C.tid < 256) { const unsigned c = hist[C.tid]; base[C.tid] = c ? atomicAdd(cnt + C.tid * CNT_STRIDE, c) : 0u; }
    __syncthreads();
    for (int i = C.tid; i < 2048; i += 512) { const unsigned v = lpe[i]; pos[(size_t)blk * 2048 + i] = (int)(base[v >> 16] + (v & 0xffffu)); }
    }
    while (cit < NPAIR) { conv_issue(); conv_finish(); }
}

__device__ __forceinline__ void tile_prefix(const Args& A, Ctx& C, LAS int* tb) {
    const unsigned* cnt = WSP(unsigned, WS_CTL) + CW_CNT;
    int v = 0;
    if (C.tid < NE) v = ((int)cnt[C.tid * CNT_STRIDE] + 255) >> 8;
#pragma unroll
    for (int d = 1; d < 64; d <<= 1) { const int t = __shfl_up(v, d); if (C.lane >= d) v += t; }
    if (C.tid < NE && C.lane == 63) tb[260 + C.wave] = v;
    __syncthreads();
    if (C.tid < NE) { int off = 0;
#pragma unroll
        for (int q = 0; q < 3; ++q) off += (q < C.wave) ? tb[260 + q] : 0;
        tb[C.tid + 1] = off + v; if (C.tid == 0) tb[0] = 0; }
    __syncthreads();
}
__device__ __forceinline__ void phase_p9(const Args& A, Ctx& C) {
    LAS int* tb = (LAS int*)C.lds;
    tile_prefix(A, C, tb);
    const unsigned* cnt = WSP(unsigned, WS_CTL) + CW_CNT;
    const int* tope = WSP(int, WS_TOPE); const float* topw = WSP(float, WS_TOPW); const int* pos = WSP(int, WS_POS);
    int* rowl = WSP(int, WS_ROWL); float* roww = WSP(float, WS_ROWW); int* tile_e = WSP(int, WS_TILEE);
    const int nrt = tb[NE];
    for (int i = C.bid * 512 + C.tid; i < NLAT * 8; i += C.G * 512) { const int e = tope[i]; const int pr = tb[e] * 256 + pos[i]; rowl[pr] = i; roww[pr] = topw[i]; }
    for (int e = C.bid; e < NE; e += C.G) { const int n = (int)cnt[e * CNT_STRIDE], nt = tb[e + 1] - tb[e];
        for (int j = n + C.tid; j < nt * 256; j += 512) { rowl[tb[e] * 256 + j] = -1; roww[tb[e] * 256 + j] = 0.f; }
        for (int k = C.tid; k < nt; k += 512) tile_e[tb[e] + k] = e; }
    for (int i = C.bid * 512 + C.tid; i < NLAT; i += C.G * 512) { rowl[nrt * 256 + i] = i; roww[nrt * 256 + i] = 1.f; }
    for (int k = C.bid * 512 + C.tid; k < NLAT / 256; k += C.G * 512) tile_e[nrt + k] = NE;
    __syncthreads();
}

__device__ __forceinline__ void phase_moe(const Args& A, Ctx& C, int dry_shared) {
    LAS int* tb = (LAS int*)(C.lds + 131072);
    LAS int* tbl = tb + 320;
    tile_prefix(A, C, tb);
    pg8::MoeCtx M;
    M.nrt = tb[NE]; M.ntiles = M.nrt + NLAT / 256; M.G = C.G; M.vc = (C.G % 8 == 0) ? (C.bid % 8) * (C.G / 8) + C.bid / 8 : C.bid;
    M.tb = tb; M.tbl = tbl; M.cnt = WSP(unsigned, WS_CTL) + CW_CNT; M.rowl = WSP(int, WS_ROWL); M.roww = WSP(float, WS_ROWW);
    M.wexp = (const char*)(A.ws + WS_WEXP); M.h2n = (const char*)(A.ws + WS_H2N8); M.Hs = (char*)(A.ws + WS_HS) + (size_t)C.bid * 2 * 65536;
    M.Y = (unsigned char*)(A.ws + WS_Y); M.out = (float*)(A.ws + WS_Y8); M.mod = WSP(const float, WS_MOD); M.dry_shared = dry_shared;
    pg8::gemm_moe(C.lds, M);
    __syncthreads();
}

__device__ __forceinline__ void phase_final(const Args& A, Ctx& C, float* dst) {
    const int gw = C.bid * 8 + C.wave, NGW = C.G * 8;
    const float* fg = A.in[I_FG]; const float* mod = WSP(const float, WS_MOD);
    const unsigned* Y = (const unsigned*)(A.ws + WS_Y); const u32x2* Y8 = (const u32x2*)(A.ws + WS_Y8);
    for (int row = gw; row < NLAT; row += NGW) {
        f32x4 xr[4]; load_row_bf16(WSP(const bf16_t, WS_H1B) + (size_t)row * D, C.lane, xr);
        const f32x4* gt = (const f32x4*)(mod + (size_t)(row >> 11) * MODW + 5 * D) + C.lane;
        const unsigned* yr = Y + (size_t)row * 8 * (D / 4) + C.lane;
        f32x4 v[4]; float s = 0.f;
#pragma unroll
        for (int j = 0; j < 4; ++j) {
            f32x4 a = (f32x4){0.f, 0.f, 0.f, 0.f};
#pragma unroll
            for (int sl = 0; sl < 8; ++sl) { const unsigned w = yr[sl * (D / 4) + 64 * j];
                const f32x2 lo = __builtin_amdgcn_cvt_pk_f32_fp8(w, false), hi = __builtin_amdgcn_cvt_pk_f32_fp8(w, true);
                a.x += lo.x; a.y += lo.y; a.z += hi.x; a.w += hi.y; }
            const u32x2 sw = Y8[(size_t)row * (D / 4) + 64 * j + C.lane];
            a = a * (1.f / pg8::YSCALE) + (f32x4){bflo(sw.x), bfhi(sw.x), bflo(sw.y), bfhi(sw.y)};
            v[j] = xr[j] + gt[64 * j] * a;
            s += (v[j].x * v[j].x + v[j].y * v[j].y) + (v[j].z * v[j].z + v[j].w * v[j].w); }
        const float rstd = __builtin_amdgcn_rsqf(wave_sum(s) * (1.f / D) + NORM_EPS);
        f32x4* orow = (f32x4*)(dst + (size_t)row * D) + C.lane;
#pragma unroll
        for (int j = 0; j < 4; ++j) orow[64 * j] = v[j] * rstd * ((const f32x4*)fg)[C.lane + 64 * j];
    }
}

constexpr int NPHASE = 13;
__global__ void __launch_bounds__(512, 2) fwd_kernel(Args A) {
    extern __shared__ __attribute__((aligned(16))) unsigned char lds_raw[];
    Ctx C; C.lds = (lbyte*)lds_raw; C.tid = threadIdx.x; C.lane = C.tid & 63; C.wave = __builtin_amdgcn_readfirstlane(C.tid >> 6);
    C.G = gridDim.x; C.bid = blockIdx.x; C.a = &A;
    volatile LAS unsigned* misc = (volatile LAS unsigned*)(C.lds + LDS_MISC);
    if (C.tid < 16) misc[C.tid] = 0u;
    __syncthreads();
    XcdBarrier bar; bar.bar = WSP(unsigned, WS_CTL) + CW_BAR; bar.x = 0; bar.st = nullptr;
    const int lo = A.ph_lo, hi = A.ph_hi;
    const bool multi = (hi - lo) > 1;
    if (multi) bar = xcd_barrier_post(WSP(unsigned, WS_CTL) + CW_BAR, misc);
#ifndef PHASE_MASK
#define PHASE_MASK 0x1FFF
#endif
#define IN(k) (((PHASE_MASK >> (k)) & 1) && lo <= (k) && (k) < hi)
#define SEAM(k) do { if (IN(k) && IN((k) + 1)) xcd_barrier(bar); } while (0)
#ifndef REP_MASK
#define REP_MASK 0
#endif
#define REPS(k) (((REP_MASK >> (k)) & 1) ? 2 : 1)

    if (IN(0)) _Pragma("unroll") for (int rep = 0; rep < REPS(0); ++rep) { phase_p0(A, C); __syncthreads(); } SEAM(0);
    if (IN(1)) _Pragma("unroll") for (int rep = 0; rep < REPS(1); ++rep) { phase_p1(A, C); } SEAM(1);
    if (IN(2)) _Pragma("unroll") for (int rep = 0; rep < REPS(2); ++rep) {
        pg8::Gemm g{WSP(bf16_t, WS_XN), D}; pg8::StaticOrder S; S.init(NROWS, PLD, C.G, C.bid, WSP(bf16_t, WS_BTIN), D, 1);
        pg8::EpiBf16 E{WSP(bf16_t, WS_P), PLD, 1.f / SWIN};
        pg8::gemm_phase<pg8::EpiBf16, pg8::StaticOrder, false, 0, false, true>(C.lds, g, S, E);
    } SEAM(2);
    if (IN(3)) _Pragma("unroll") for (int rep = 0; rep < REPS(3); ++rep) { phase_gdn_prep(A, C); } SEAM(3);
#ifdef PROBE_BARRIERS
    if (multi) for (int kq = 0; kq < PROBE_BARRIERS; ++kq) xcd_barrier(bar);
#endif
    if (IN(4)) {
        for (int ch = C.bid; ch < NB * HB * 2; ch += C.G) gdn_chain_chunked(A, C, ch);
        for (int pr = C.bid; pr < NB * HA; pr += C.G) rwkv_pair_chunked(A, C, pr);
    } SEAM(4);
    if (IN(5)) _Pragma("unroll") for (int rep = 0; rep < REPS(5); ++rep) { phase_p4(A, C); } SEAM(5);
    if (IN(6)) _Pragma("unroll") for (int rep = 0; rep < REPS(6); ++rep) {
        pg8::Gemm g{WSP(bf16_t, WS_YMIX), D}; pg8::StaticOrder S; S.init(NLAT, D, C.G, C.bid, WSP(bf16_t, WS_BTOUT), D);
        pg8::EpiResGateB E{A.in[I_X], WSP(bf16_t, WS_H1B), WSP(float, WS_MOD), 2 * D};
        pg8::gemm_phase<pg8::EpiResGateB, pg8::StaticOrder, false>(C.lds, g, S, E);
    } SEAM(6);
    if (IN(7)) _Pragma("unroll") for (int rep = 0; rep < REPS(7); ++rep) { phase_p6(A, C); __syncthreads(); } SEAM(7);
    if (IN(8)) _Pragma("unroll") for (int rep = 0; rep < REPS(8); ++rep) {
        pg8::Gemm g{WSP(bf16_t, WS_H2N), D}; pg8::StaticOrder S; S.init(NLAT, NE, C.G, C.bid, WSP(bf16_t, WS_BTR), D);
        pg8::EpiF32 E{WSP(float, WS_LOGIT), NE};
        pg8::gemm_phase<pg8::EpiF32, pg8::StaticOrder, false>(C.lds, g, S, E);
    } SEAM(8);
    if (IN(9)) { phase_p8(A, C); } SEAM(9);
    if (IN(10)) _Pragma("unroll") for (int rep = 0; rep < REPS(10); ++rep) { phase_p9(A, C); } SEAM(10);
    if (IN(11)) { phase_moe(A, C, 0); if (REPS(11) > 1) { __syncthreads(); phase_moe(A, C, 1); } } SEAM(11);
    if (IN(12)) { if (REPS(12) > 1) { phase_final(A, C, (float*)(A.ws + WS_WEXP)); __syncthreads(); } phase_final(A, C, A.out); }
#undef IN
#undef SEAM
}

extern "C" void kernel_launch(void* const* d_in, const int* in_sizes, int n_in, void* d_out, int out_size, void* d_ws, size_t ws_size, hipStream_t stream) {
    static int grid = 0;
    if (grid == 0) {
        if (n_in != 34 || out_size != NLAT * D || ws_size < WS_END) { fprintf(stderr, "kernel_launch: unexpected shapes (n_in %d out %d ws %zu need %zu)\n", n_in, out_size, ws_size, (size_t)WS_END); grid = -1; return; }
        int dev = 0, cus = 0;
        if (hipGetDevice(&dev) != hipSuccess || hipDeviceGetAttribute(&cus, hipDeviceAttributeMultiprocessorCount, dev) != hipSuccess) { grid = -1; return; }
        if (hipFuncSetAttribute((const void*)fwd_kernel, hipFuncAttributeMaxDynamicSharedMemorySize, LDS_BYTES) != hipSuccess) { fprintf(stderr, "kernel_launch: hipFuncSetAttribute failed\n"); grid = -1; return; }
        int per_cu = 0;
        if (hipOccupancyMaxActiveBlocksPerMultiprocessor(&per_cu, (const void*)fwd_kernel, 512, LDS_BYTES) != hipSuccess || per_cu < 1) { fprintf(stderr, "kernel_launch: occupancy query says %d\n", per_cu); }
        (void)hipGetLastError();
        grid = cus;
    }
    if (grid < 0) return;
    (void)hipMemsetAsync((char*)d_ws + WS_CTL, 0, CTL_BYTES, stream);
    Args a{};
    for (int i = 0; i < 34; ++i) a.in[i] = (const float*)d_in[i];
    a.out = (float*)d_out; a.ws = (unsigned char*)d_ws;
#if MK_PER_PHASE
    for (int p = 0; p < NPHASE; ++p) { a.ph_lo = p; a.ph_hi = p + 1; hipLaunchKernelGGL(fwd_kernel, dim3(grid), dim3(512), LDS_BYTES, stream, a); }
#else
    a.ph_lo = 0; a.ph_hi = NPHASE; hipLaunchKernelGGL(fwd_kernel, dim3(grid), dim3(512), LDS_BYTES, stream, a);
#endif
}
```
